# Optimizing an MI355X kernel written in HIP

```python
import jax, jax.numpy as jnp
from jax import lax
import numpy as np

D_MODEL = 1024
BATCH = 8
SEQ = 4096
DEPTH = 2
DEC_BATCH = 8
DEC_SEQ = 32
PAST_LEN = 1024

CHUNK = 64
D_MIX = D_MODEL
A_WIDTH = D_MIX // 2
A_HEADS = 8
A_HD = A_WIDTH // A_HEADS
A_CONV = 4
RG_C = 8.0
B_WIDTH = D_MIX // 4
B_CONV = 3
C_WIDTH = D_MIX // 4
C_HEADS = 4
C_HD = C_WIDTH // C_HEADS
MLP_CHUNK = 128
N_MEM = 256
X_HEADS = 4
X_HD = D_MODEL // X_HEADS
D_FF = ((8 * D_MODEL // 3 + 127) // 128) * 128
FFN_CONV = 3
EPS = 1e-6
IN_COLS = 2 * A_WIDTH + 3 * B_WIDTH + 2 * C_WIDTH
SPLITS = (A_WIDTH, 2 * A_WIDTH, 2 * A_WIDTH + B_WIDTH, 2 * A_WIDTH + 2 * B_WIDTH,
          2 * A_WIDTH + 3 * B_WIDTH, 2 * A_WIDTH + 3 * B_WIDTH + C_WIDTH)

kernel_name = "hybrid_stream_rglru_shortconv_chunkmlp_step"


def rms_norm(x, g):
    x32 = x.astype(jnp.float32)
    y = x32 * lax.rsqrt(jnp.mean(x32 * x32, axis=-1, keepdims=True) + EPS)
    return (y * g.astype(jnp.float32)).astype(x.dtype)


def group_rms_norm(x, g):
    bsz, t, _ = x.shape
    xg = x.reshape(bsz, t, C_HEADS, C_HD).astype(jnp.float32)
    y = xg * lax.rsqrt(jnp.mean(xg * xg, axis=-1, keepdims=True) + EPS)
    return (y.reshape(bsz, t, C_WIDTH) * g.astype(jnp.float32)).astype(x.dtype)


def causal_dwconv(x, prev, w):
    width = w.shape[0]
    t = x.shape[1]
    xp = jnp.concatenate([prev.astype(x.dtype), x], axis=1)
    y = xp[:, 0:t] * w[0]
    for k in range(1, width):
        y = y + xp[:, k:k + t] * w[k]
    return y, xp[:, t:]


def rg_lru(x, h0, w_r, b_r, w_i, b_i, lam):
    bsz, t, _ = x.shape
    f32 = jnp.float32
    x32 = x.astype(f32)
    xh = x32.reshape(bsz, t, A_HEADS, A_HD)
    r = jax.nn.sigmoid(jnp.einsum('bthi,hij->bthj', xh, w_r.astype(f32)).reshape(bsz, t, A_WIDTH) + b_r.astype(f32))
    gi = jax.nn.sigmoid(jnp.einsum('bthi,hij->bthj', xh, w_i.astype(f32)).reshape(bsz, t, A_WIDTH) + b_i.astype(f32))
    log_a = -RG_C * r * jax.nn.softplus(-lam.astype(f32))
    a = jnp.exp(log_a)
    b = jnp.sqrt(-jnp.expm1(2.0 * log_a)) * (gi * x32)
    b = b.at[:, 0].add(a[:, 0] * h0.astype(f32))

    def combine(left, right):
        a_l, b_l = left
        a_r, b_rr = right
        return a_l * a_r, a_r * b_l + b_rr

    _, h = lax.associative_scan(combine, (a, b), axis=1)
    return h.astype(x.dtype), h[:, -1].astype(x.dtype)


def chunk_spatial_gate(u, v, w_s, b_s):
    bsz, t, _ = v.shape
    L = min(t, MLP_CHUNK)
    n = t // L
    mask = jnp.tril(jnp.ones((L, L), dtype=bool))
    w = jnp.where(mask, w_s[:, :L, :L], 0)
    vc = v.reshape(bsz, n, L, C_HEADS, C_HD)
    bias = jnp.transpose(b_s[:, :L])[None, None, :, :, None]
    mixed = jnp.einsum('hts,bnshc->bnthc', w, vc) + bias
    return u * mixed.reshape(bsz, t, C_WIDTH)


def memory_kv(mem, w_k, w_v):
    bsz, m, _ = mem.shape
    k = (mem @ w_k).reshape(bsz, m, X_HEADS, X_HD)
    v = (mem @ w_v).reshape(bsz, m, X_HEADS, X_HD)
    return k, v


def cross_attend(xn, k, v, w_q, w_o):
    bsz, t, _ = xn.shape
    f32 = jnp.float32
    q = (xn @ w_q).reshape(bsz, t, X_HEADS, X_HD)
    s = jnp.einsum('bthd,bmhd->bhtm', q.astype(f32), k.astype(f32)) * (X_HD ** -0.5)
    p = jax.nn.softmax(s, axis=-1)
    o = jnp.einsum('bhtm,bmhd->bthd', p, v.astype(f32)).astype(xn.dtype)
    return o.reshape(bsz, t, D_MODEL) @ w_o


def trunk_layer(x, mem_k, mem_v, conv_a_prev, h_prev, conv_b_prev, ffn_prev, lp):
    xn = rms_norm(x, lp['g_mix'])
    z = xn @ lp['w_in']
    xa, ga, xb, gb, gc, uc, vc = jnp.split(z, SPLITS, axis=-1)
    xa, conv_a_new = causal_dwconv(xa, conv_a_prev, lp['conv_a_w'])
    xa = xa + lp['conv_a_b']
    ha, h_new = rg_lru(xa, h_prev, lp['w_rg'], lp['b_rg'], lp['w_ig'], lp['b_ig'], lp['lam'])
    y_a = jax.nn.gelu(ga) * ha
    zb, conv_b_new = causal_dwconv(gc * xb, conv_b_prev, lp['conv_b_w'])
    y_b = gb * zb
    uc = jax.nn.gelu(uc)
    vc = group_rms_norm(jax.nn.gelu(vc), lp['g_v'])
    y_c = chunk_spatial_gate(uc, vc, lp['w_s'], lp['b_s'])
    x = x + jnp.concatenate([y_a, y_b, y_c], axis=-1) @ lp['w_out']
    x = x + cross_attend(rms_norm(x, lp['g_x']), mem_k, mem_v, lp['w_q'], lp['w_o'])
    gu = rms_norm(x, lp['g_ffn']) @ lp['w_up']
    g, u = jnp.split(gu, 2, axis=-1)
    g, ffn_new = causal_dwconv(g, ffn_prev, lp['conv_f_w'])
    x = x + (jax.nn.silu(g) * u) @ lp['w_down']
    return x, conv_a_new, h_new, conv_b_new, ffn_new, vc


def setup_inputs(seed: int = 0) -> dict:
    key = jax.random.key(seed)
    ks = iter(jax.random.split(key, 40))

    def nrm(shape, scale):
        return jax.random.normal(next(ks), shape, jnp.float32) * scale

    def gain(shape):
        return 1.0 + nrm(shape, 0.05)

    u = jax.random.uniform(next(ks), (DEPTH, A_WIDTH), jnp.float32, minval=0.9, maxval=0.999)
    a_base = u ** (1.0 / RG_C)
    lam = jnp.log(a_base) - jnp.log1p(-a_base)
    return {
        "x_prompt": nrm((BATCH, SEQ, D_MODEL), 1.0),
        "x_sample": nrm((DEC_BATCH, DEC_SEQ, D_MODEL), 1.0),
        "mem_prompt": nrm((BATCH, N_MEM, D_MODEL), 1.0),
        "cache_mem_k": nrm((DEPTH, DEC_BATCH, N_MEM, X_HEADS, X_HD), 1.0),
        "cache_mem_v": nrm((DEPTH, DEC_BATCH, N_MEM, X_HEADS, X_HD), 1.0),
        "state_conv_a": nrm((DEPTH, DEC_BATCH, A_CONV - 1, A_WIDTH), 1.0),
        "state_h_a": nrm((DEPTH, DEC_BATCH, A_WIDTH), 0.5),
        "state_conv_b": nrm((DEPTH, DEC_BATCH, B_CONV - 1, B_WIDTH), 1.0),
        "state_conv_ffn": nrm((DEPTH, DEC_BATCH, FFN_CONV - 1, D_FF), 1.0),
        "g_mix": gain((DEPTH, D_MODEL)),
        "w_in": nrm((DEPTH, D_MODEL, IN_COLS), D_MODEL ** -0.5),
        "conv_a_w": nrm((DEPTH, A_CONV, A_WIDTH), A_CONV ** -0.5),
        "conv_a_b": nrm((DEPTH, A_WIDTH), 0.02),
        "w_rg": nrm((DEPTH, A_HEADS, A_HD, A_HD), A_HD ** -0.5),
        "b_rg": nrm((DEPTH, A_WIDTH), 0.02),
        "w_ig": nrm((DEPTH, A_HEADS, A_HD, A_HD), A_HD ** -0.5),
        "b_ig": nrm((DEPTH, A_WIDTH), 0.02),
        "lam": lam,
        "conv_b_w": nrm((DEPTH, B_CONV, B_WIDTH), B_CONV ** -0.5),
        "g_v": gain((DEPTH, C_WIDTH)),
        "w_s": nrm((DEPTH, C_HEADS, MLP_CHUNK, MLP_CHUNK), 0.5 * MLP_CHUNK ** -0.5),
        "b_s": 1.0 + nrm((DEPTH, C_HEADS, MLP_CHUNK), 0.1),
        "w_out": nrm((DEPTH, D_MIX, D_MODEL), D_MIX ** -0.5),
        "g_x": gain((DEPTH, D_MODEL)),
        "w_q": nrm((DEPTH, D_MODEL, D_MODEL), D_MODEL ** -0.5),
        "w_k": nrm((DEPTH, D_MODEL, D_MODEL), D_MODEL ** -0.5),
        "w_v": nrm((DEPTH, D_MODEL, D_MODEL), D_MODEL ** -0.5),
        "w_o": nrm((DEPTH, D_MODEL, D_MODEL), D_MODEL ** -0.5),
        "g_ffn": gain((DEPTH, D_MODEL)),
        "w_up": nrm((DEPTH, D_MODEL, 2 * D_FF), D_MODEL ** -0.5),
        "conv_f_w": nrm((DEPTH, FFN_CONV, D_FF), FFN_CONV ** -0.5),
        "w_down": nrm((DEPTH, D_FF, D_MODEL), D_FF ** -0.5),
        "g_final": gain((D_MODEL,)),
    }


def reference(x_prompt, x_sample, mem_prompt, cache_mem_k, cache_mem_v, state_conv_a, state_h_a,
              state_conv_b, state_conv_ffn, g_mix, w_in, conv_a_w, conv_a_b, w_rg, b_rg, w_ig, b_ig,
              lam, conv_b_w, g_v, w_s, b_s, w_out, g_x, w_q, w_k, w_v, w_o, g_ffn, w_up, conv_f_w,
              w_down, g_final):
    bp = x_prompt.shape[0]
    xp, xs = x_prompt, x_sample
    p_ca, p_h, p_cb, p_cf, p_mk, p_mv = [], [], [], [], [], []
    s_ca, s_h, s_cb, s_cf, s_vc = [], [], [], [], []
    for l in range(DEPTH):
        lp = dict(g_mix=g_mix[l], w_in=w_in[l], conv_a_w=conv_a_w[l], conv_a_b=conv_a_b[l],
                  w_rg=w_rg[l], b_rg=b_rg[l], w_ig=w_ig[l], b_ig=b_ig[l], lam=lam[l],
                  conv_b_w=conv_b_w[l], g_v=g_v[l], w_s=w_s[l], b_s=b_s[l], w_out=w_out[l],
                  g_x=g_x[l], w_q=w_q[l], w_o=w_o[l], g_ffn=g_ffn[l], w_up=w_up[l],
                  conv_f_w=conv_f_w[l], w_down=w_down[l])
        mk, mv = memory_kv(mem_prompt, w_k[l], w_v[l])
        dt = xp.dtype
        xp, ca, hh, cb, cf, _ = trunk_layer(
            xp, mk, mv,
            jnp.zeros((bp, A_CONV - 1, A_WIDTH), dt), jnp.zeros((bp, A_WIDTH), dt),
            jnp.zeros((bp, B_CONV - 1, B_WIDTH), dt), jnp.zeros((bp, FFN_CONV - 1, D_FF), dt), lp)
        p_ca.append(ca); p_h.append(hh); p_cb.append(cb); p_cf.append(cf); p_mk.append(mk); p_mv.append(mv)
        xs, ca2, hh2, cb2, cf2, vc2 = trunk_layer(
            xs, cache_mem_k[l], cache_mem_v[l], state_conv_a[l], state_h_a[l],
            state_conv_b[l], state_conv_ffn[l], lp)
        s_ca.append(ca2); s_h.append(hh2); s_cb.append(cb2); s_cf.append(cf2); s_vc.append(vc2)
    y_prompt = rms_norm(xp, g_final)
    y_sample = rms_norm(xs, g_final)
    return (y_prompt, y_sample,
            jnp.stack(p_ca), jnp.stack(p_h), jnp.stack(p_cb), jnp.stack(p_cf), jnp.stack(p_mk), jnp.stack(p_mv),
            jnp.stack(s_ca), jnp.stack(s_h), jnp.stack(s_cb), jnp.stack(s_cf), jnp.stack(s_vc))
```

```cpp
#include <hip/hip_runtime.h>
#include <hip/hip_cooperative_groups.h>
#include <cstdio>
#include <cstdint>
namespace cg = cooperative_groups;

#define LAS __attribute__((address_space(3)))
typedef unsigned short bf16_t;
typedef short bf16x8 __attribute__((ext_vector_type(8)));
typedef float f32x4 __attribute__((ext_vector_type(4)));
typedef float f32x2 __attribute__((ext_vector_type(2)));
typedef unsigned u32x4 __attribute__((ext_vector_type(4)));
typedef unsigned u32x2 __attribute__((ext_vector_type(2)));

constexpr int D = 1024, BP = 8, SEQ = 4096, BS = 8, TS = 32, DEPTH = 2;
constexpr int MP = BP * SEQ, MS = BS * TS, MT = MP + MS;
constexpr int INC = 2304, DFF = 2816, NMEM = 256, AW = 512, BW = 256, CW = 256;
constexpr int Z_XA = 0, Z_GA = 512, Z_XB = 1024, Z_GB = 1280, Z_GC = 1536, Z_UC = 1792, Z_VC = 2048;
constexpr float EPS = 1e-6f;
constexpr int NWAVES = 8, NTHREADS = 512;

constexpr size_t O_YP = 0, O_YS = O_YP + (size_t)MP * D, O_CAP = O_YS + (size_t)MS * D, O_HAP = O_CAP + DEPTH * BP * 3 * AW,
                 O_CBP = O_HAP + DEPTH * BP * AW, O_CFP = O_CBP + DEPTH * BP * 2 * BW, O_MKP = O_CFP + DEPTH * BP * 2 * DFF,
                 O_MVP = O_MKP + (size_t)DEPTH * BP * NMEM * D, O_CAS = O_MVP + (size_t)DEPTH * BP * NMEM * D, O_HAS = O_CAS + DEPTH * BS * 3 * AW,
                 O_CBS = O_HAS + DEPTH * BS * AW, O_CFS = O_CBS + DEPTH * BS * 2 * BW, O_VCS = O_CFS + DEPTH * BS * 2 * DFF,
                 O_END = O_VCS + DEPTH * BS * TS * CW;

constexpr size_t MiB = 1u << 20;
constexpr size_t WS_WIN = 0, WS_WOUT = 5 * MiB, WS_WQ = 7 * MiB, WS_WK = 9 * MiB, WS_WV = 11 * MiB, WS_WO = 13 * MiB, WS_WUP = 15 * MiB, WS_WDN = 26 * MiB;
constexpr size_t WS_MEMB = 32 * MiB, WS_KBP = 36 * MiB, WS_VTP = 40 * MiB, WS_KBS = 44 * MiB, WS_VTS = 48 * MiB, WS_WST = 52 * MiB, WS_GT = WS_WST + 131072, WS_AGG = 53 * MiB;
constexpr size_t WS_XN = 56 * MiB, WS_BIG = 121 * MiB;
constexpr size_t B_Z = WS_BIG, B_HLOC = WS_BIG + 146 * MiB, B_PCUM = WS_BIG + 211 * MiB, B_Y = WS_BIG + 276 * MiB;
constexpr size_t B_Q = WS_BIG, B_P = WS_BIG + 65 * MiB, B_O = WS_BIG + 130 * MiB, B_PS = WS_BIG + 195 * MiB;
constexpr size_t B_GU = WS_BIG;
constexpr size_t WS_END = WS_BIG + (size_t)MT * 2 * DFF * 2;
static_assert(WS_END <= 512 * MiB, "workspace");
static_assert(WS_XN + (size_t)MT * D * 2 <= WS_BIG, "xn");

constexpr int LDS_RING = 131072, LDS_EX = LDS_RING, LDS_BYTES = 147456;

enum { I_XP = 0, I_XS, I_MEM, I_CK, I_CV, I_SCA, I_SHA, I_SCB, I_SCF, I_GMIX, I_WIN, I_CAW, I_CAB, I_WRG, I_BRG, I_WIG, I_BIG, I_LAM, I_CBW, I_GV, I_WS, I_BSS,
       I_WOUT, I_GX, I_WQ, I_WK, I_WV, I_WO, I_GFFN, I_WUP, I_CFW, I_WDN, I_GFIN, N_IN };

struct Args { const float* in[N_IN]; float* out; unsigned char* ws; };

__device__ __forceinline__ unsigned f2bf(float f) { unsigned u = __builtin_bit_cast(unsigned, f); return (u + 0x7fffu + ((u >> 16) & 1u)) >> 16; }
__device__ __forceinline__ unsigned pk2(float lo, float hi) { return f2bf(lo) | (f2bf(hi) << 16); }
__device__ __forceinline__ float bf2f(unsigned v) { return __builtin_bit_cast(float, v << 16); }
__device__ __forceinline__ float bflo(unsigned w) { return __builtin_bit_cast(float, w << 16); }
__device__ __forceinline__ float bfhi(unsigned w) { return __builtin_bit_cast(float, w & 0xffff0000u); }
__device__ __forceinline__ unsigned cvt_pk_bf16(float lo, float hi) { unsigned r; asm volatile("v_cvt_pk_bf16_f32 %0, %1, %2" : "=v"(r) : "v"(lo), "v"(hi)); return r; }
__device__ __forceinline__ float fexp(float x) { return __builtin_amdgcn_exp2f(x * 1.4426950408889634f); }
__device__ __forceinline__ float sigm(float x) { return __builtin_amdgcn_rcpf(1.0f + fexp(-x)); }
__device__ __forceinline__ float gelu_t(float x) { const float u = 0.7978845608028654f * (x + 0.044715f * x * x * x); return x * sigm(2.0f * u); }
__device__ __forceinline__ float silu(float x) { return x * sigm(x); }
__device__ __forceinline__ float shx(float v, int m, int lane) { return __builtin_bit_cast(float, __builtin_amdgcn_ds_bpermute((lane ^ m) << 2, __builtin_bit_cast(int, v))); }
__device__ __forceinline__ float wave_sum(float v, int lane) {
#pragma unroll
    for (int o = 1; o < 64; o <<= 1) v += shx(v, o, lane);
    return v;
}
#define LDS_WAIT() asm volatile("s_waitcnt lgkmcnt(0)" ::: "memory")
__device__ __forceinline__ int opaque_tid() { int t = threadIdx.x; asm volatile("" : "+v"(t)); return t; }

namespace pg8 {
constexpr int BM = 256, BK = 64, HALF = 128, HTB = HALF * BK * 2, NXCD = 8, WGM = 8;
__device__ __forceinline__ int lds_byte(int r, int c) { const int st = (r >> 4) * 2 + (c >> 5), rr = r & 15, cc = c & 31, ob = rr * 64 + cc * 2; return st * 1024 + (ob ^ (((ob >> 9) & 1) << 5)); }
__device__ __forceinline__ void stage_rc(int b, int& R, int& C) { const int st = b / 1024, sb = b % 1024, swz = sb ^ (((sb >> 9) & 1) << 5); R = (st >> 1) * 16 + swz / 64; C = (st & 1) * 32 + (swz % 64) / 2; }
__device__ __forceinline__ int perm32(int rho) { const int n = rho >> 4, i = rho & 15; return 8 * (i >> 2) + 4 * n + (i & 3); }

struct Unit { int pm, pn; };
struct Gemm { const bf16_t* A; const bf16_t* Bt; int lda, ldb, K; };

struct GSched {
    int nM, nN, nwg, G, c, mode;
    size_t aPm, aPn, bPn, bPm; int bShift;
    __device__ __forceinline__ void init(int nM_, int nN_, int G_, int c_) { nM = nM_; nN = nN_; nwg = nM * nN; G = G_; c = c_; mode = 0; aPm = 0; aPn = 0; bPn = 0; bPm = 0; bShift = 0; }
    __device__ __forceinline__ bool next(int i, Unit& u) const {
        const long L = (long)i * G + c; if (L >= nwg) return false;
        int wgid = (int)L; { const int q = nwg / NXCD, r = nwg % NXCD, xcd = wgid % NXCD, off = wgid / NXCD; wgid = (xcd < r ? xcd * (q + 1) : r * (q + 1) + (xcd - r) * q) + off; }
        const int nig = WGM * nN, gid = wgid / nig, fm = gid * WGM, gsz = (nM - fm) < WGM ? (nM - fm) : WGM;
        u.pm = fm + ((wgid % nig) % gsz); u.pn = (wgid % nig) / gsz; return true;
    }
    __device__ __forceinline__ size_t offA(const Unit& u) const { return mode == 1 ? (size_t)(u.pn & 3) * 512 : (size_t)u.pm * aPm + (size_t)u.pn * aPn; }
    __device__ __forceinline__ size_t offB(const Unit& u) const { return mode == 1 ? (size_t)(u.pn >> 2) * (256 * 1024 * 2) + (size_t)(u.pn & 3) * 512 : (size_t)u.pn * bPn + (size_t)(u.pm >> bShift) * bPm; }
};

struct EpiBf16 {
    static constexpr bool PERM = true;
    bf16_t* O; int ldc; float scale;
    __device__ __forceinline__ void operator()(f32x4 (&acc)[2][2][4][2], const Unit& u, int wr, int wc, int fr, int fq, LAS unsigned char*) const {
        asm volatile("" : "+v"(fr), "+v"(fq)); asm volatile("" : "+s"(wr), "+s"(wc));
        const int row0 = u.pm * BM + wr * 64 + fr, col0 = u.pn * BM + wc * 32 + 8 * fq;
#pragma unroll
        for (int ai = 0; ai < 2; ++ai)
#pragma unroll
            for (int m = 0; m < 4; ++m) { bf16_t* rowp = O + (size_t)(row0 + ai * HALF + m * 16) * ldc + col0;
#pragma unroll
                for (int bj = 0; bj < 2; ++bj) { const f32x4 v0 = acc[ai][bj][m][0] * scale, v1 = acc[ai][bj][m][1] * scale;
                    u32x4 w; w.x = cvt_pk_bf16(v0[0], v0[1]); w.y = cvt_pk_bf16(v0[2], v0[3]); w.z = cvt_pk_bf16(v1[0], v1[1]); w.w = cvt_pk_bf16(v1[2], v1[3]);
                    *(u32x4*)(rowp + bj * HALF) = w; } }
    }
};
struct EpiResid {
    static constexpr bool PERM = false;
    const float* baseP; const float* baseS; float* out;
    __device__ __forceinline__ void operator()(f32x4 (&acc)[2][2][4][2], const Unit& u, int wr, int wc, int fr, int fq, LAS unsigned char*) const {
        asm volatile("" : "+v"(fr), "+v"(fq)); asm volatile("" : "+s"(wr), "+s"(wc));
        const int col0 = u.pn * BM + wc * 32 + 4 * fq;
        const float* base = (u.pm < 128) ? baseP + (size_t)u.pm * BM * D : baseS;
        float* o = out + (size_t)u.pm * BM * D;
#pragma unroll
        for (int ai = 0; ai < 2; ++ai)
#pragma unroll
            for (int m = 0; m < 4; ++m) { const size_t off = (size_t)(ai * HALF + wr * 64 + m * 16 + fr) * D + col0;
#pragma unroll
                for (int bj = 0; bj < 2; ++bj)
#pragma unroll
                    for (int n = 0; n < 2; ++n) { const f32x4 bs = *(const f32x4*)(base + off + bj * HALF + n * 16); *(f32x4*)(o + off + bj * HALF + n * 16) = bs + acc[ai][bj][m][n]; } }
    }
};
struct EpiKV {
    static constexpr bool PERM = false;
    float* outK; float* outV; bf16_t* KB; bf16_t* VT;
    __device__ __forceinline__ void operator()(f32x4 (&acc)[2][2][4][2], const Unit& u, int wr, int wc, int fr, int fq, LAS unsigned char*) const {
        asm volatile("" : "+v"(fr), "+v"(fq)); asm volatile("" : "+s"(wr), "+s"(wc));
        const int kind = u.pm >> 4, pm = u.pm & 15;
        const int col0 = u.pn * BM + wc * 32 + 4 * fq;
        float* of = kind == 0 ? outK : outV; bf16_t* ob = kind == 0 ? KB : VT; const int ldb_ = kind == 2 ? 2048 : 1024;
#pragma unroll
        for (int ai = 0; ai < 2; ++ai)
#pragma unroll
            for (int m = 0; m < 4; ++m) { const int row = pm * BM + ai * HALF + wr * 64 + m * 16 + fr;
#pragma unroll
                for (int bj = 0; bj < 2; ++bj)
#pragma unroll
                    for (int n = 0; n < 2; ++n) { const f32x4 v = acc[ai][bj][m][n]; const int col = col0 + bj * HALF + n * 16;
                        if (kind != 2) *(f32x4*)(of + (size_t)row * 1024 + col) = v;
                        if (kind != 1) { u32x2 w; w.x = cvt_pk_bf16(v[0], v[1]); w.y = cvt_pk_bf16(v[2], v[3]); *(u32x2*)(ob + (size_t)row * ldb_ + col) = w; } } }
    }
};
struct EpiSoftmax {
    static constexpr bool PERM = true;
    bf16_t* O; int ldc; int smp;
    __device__ __forceinline__ void operator()(f32x4 (&acc)[2][2][4][2], const Unit& u, int wr, int wc, int fr, int fq, LAS unsigned char* lds) const {
        asm volatile("" : "+v"(fr), "+v"(fq)); asm volatile("" : "+s"(wr), "+s"(wc));
        LAS f32x2* EX = (LAS f32x2*)(lds + LDS_EX);
        const int lane = fq * 16 + fr;
        const float L2E = 1.4426950408889634f;
#pragma unroll
        for (int ai = 0; ai < 2; ++ai)
#pragma unroll
            for (int m = 0; m < 4; ++m) {
                float mx = -3.0e38f;
#pragma unroll
                for (int bj = 0; bj < 2; ++bj)
#pragma unroll
                    for (int n = 0; n < 2; ++n) { const f32x4 x = acc[ai][bj][m][n]; mx = fmaxf(mx, fmaxf(fmaxf(x[0], x[1]), fmaxf(x[2], x[3]))); }
                mx = fmaxf(mx, shx(mx, 16, lane)); mx = fmaxf(mx, shx(mx, 32, lane));
                float s = 0.f;
#pragma unroll
                for (int bj = 0; bj < 2; ++bj)
#pragma unroll
                    for (int n = 0; n < 2; ++n) { f32x4 x = acc[ai][bj][m][n];
#pragma unroll
                        for (int j = 0; j < 4; ++j) { x[j] = __builtin_amdgcn_exp2f((x[j] - mx) * L2E); s += x[j]; }
                        acc[ai][bj][m][n] = x; }
                s += shx(s, 16, lane); s += shx(s, 32, lane);
                if (fq == 0) EX[(ai * HALF + wr * 64 + m * 16 + fr) * 4 + wc] = (f32x2){mx, s};
            }
        asm volatile("s_waitcnt lgkmcnt(0)" ::: "memory"); __builtin_amdgcn_s_barrier(); asm volatile("" ::: "memory");
        int colb = u.pn * BM, j_ = 0;
        if (smp) { colb = (u.pn & 3) * 2048 + (u.pn >> 2) * 256; j_ = u.pn >> 2; }
        const int col0 = colb + wc * 32 + 8 * fq;
#pragma unroll
        for (int ai = 0; ai < 2; ++ai)
#pragma unroll
            for (int m = 0; m < 4; ++m) {
                const int rl = ai * HALF + wr * 64 + m * 16 + fr;
                const f32x2 e0 = EX[rl * 4 + 0], e1 = EX[rl * 4 + 1], e2 = EX[rl * 4 + 2], e3 = EX[rl * 4 + 3];
                const float M = fmaxf(fmaxf(e0.x, e1.x), fmaxf(e2.x, e3.x));
                const float tot = e0.y * __builtin_amdgcn_exp2f((e0.x - M) * L2E) + e1.y * __builtin_amdgcn_exp2f((e1.x - M) * L2E) + e2.y * __builtin_amdgcn_exp2f((e2.x - M) * L2E) + e3.y * __builtin_amdgcn_exp2f((e3.x - M) * L2E);
                const float own = wc == 0 ? e0.x : (wc == 1 ? e1.x : (wc == 2 ? e2.x : e3.x));
                float f = __builtin_amdgcn_exp2f((own - M) * L2E) / tot;
                if (smp && (rl >> 5) != j_) f = 0.f;
                bf16_t* rowp = O + (size_t)(u.pm * BM + rl) * ldc + col0;
#pragma unroll
                for (int bj = 0; bj < 2; ++bj) { const f32x4 v0 = acc[ai][bj][m][0] * f, v1 = acc[ai][bj][m][1] * f;
                    u32x4 w; w.x = cvt_pk_bf16(v0[0], v0[1]); w.y = cvt_pk_bf16(v0[2], v0[3]); w.z = cvt_pk_bf16(v1[0], v1[1]); w.w = cvt_pk_bf16(v1[2], v1[3]);
                    *(u32x4*)(rowp + bj * HALF) = w; } }
    }
};

template <class Epi, class Sched, bool ALIGN_EPI>
__device__ __forceinline__ void gemm_phase(LAS unsigned char* lds, const Gemm g, const Sched& S, const Epi& E) {
    const int tid = opaque_tid(), wid = __builtin_amdgcn_readfirstlane(tid >> 6), lane = tid & 63, wr = wid >> 2, wc = wid & 3, fr = lane & 15, fq = lane >> 4;
    const int nt = g.K / BK;
    unsigned voffA[2], voffB[2];
#pragma unroll
    for (int i = 0; i < 2; ++i) { int R, C; stage_rc(tid * 16 + i * 8192, R, C); const int Rb = Epi::PERM ? ((R & ~31) + perm32(R & 31)) : R;
        voffA[i] = (unsigned)(R * g.lda + C) * 2u; voffB[i] = (unsigned)(Rb * g.ldb + C) * 2u; }
    const size_t kstep = (size_t)(BK * 2);
    const size_t hstepA = (size_t)HALF * g.lda * 2, hstepB = (size_t)HALF * g.ldb * 2;
    const unsigned ldsw = (unsigned)wid * 1024u;
    const int aoff = lds_byte(wr * 64 + fr, fq * 8), boff = lds_byte(wc * 32 + fr, fq * 8);
#define PG8_SA(b, h) (((b) * 2 + (h)) * HTB)
#define PG8_SB(b, h) ((4 + (b) * 2 + (h)) * HTB)
#define PG8_STAGE(bufoff, gbase, voff) do { _Pragma("unroll") for (int _i = 0; _i < 2; ++_i) \
        __builtin_amdgcn_global_load_lds((const unsigned*)((const char*)(gbase) + (voff)[_i]), (LAS unsigned*)(lds + (bufoff) + ldsw + _i * 8192), 16, 0, 0); } while (0)
#define PG8_LDA(dst, b, h) do { _Pragma("unroll") for (int m = 0; m < 4; ++m) _Pragma("unroll") for (int k = 0; k < 2; ++k) dst[m][k] = *(const LAS bf16x8*)(lds + PG8_SA(b, h) + aoff + m * 2048 + k * 1024); } while (0)
#define PG8_LDB(dst, b, h) do { _Pragma("unroll") for (int n = 0; n < 2; ++n) _Pragma("unroll") for (int k = 0; k < 2; ++k) dst[n][k] = *(const LAS bf16x8*)(lds + PG8_SB(b, h) + boff + n * 2048 + k * 1024); } while (0)
#define PG8_MMA(ai, bj, At, Bt) do { __builtin_amdgcn_s_setprio(1); _Pragma("unroll") for (int m = 0; m < 4; ++m) _Pragma("unroll") for (int n = 0; n < 2; ++n) _Pragma("unroll") for (int k = 0; k < 2; ++k) \
        acc[ai][bj][m][n] = __builtin_amdgcn_mfma_f32_16x16x32_bf16(Bt[n][k], At[m][k], acc[ai][bj][m][n], 0, 0, 0); __builtin_amdgcn_s_setprio(0); } while (0)
#define PG8_WAIT_V(n) asm volatile("s_waitcnt vmcnt(" #n ")" ::: "memory")
#define PG8_WAIT_L(n) asm volatile("s_waitcnt lgkmcnt(" #n ")" ::: "memory")
#define PG8_BAR __builtin_amdgcn_s_barrier()
#define PG8_SCHED __builtin_amdgcn_sched_barrier(0)
    Unit cur, nxt; int ui = 0;
    if (!S.next(0, cur)) return;
    f32x4 acc[2][2][4][2];
#pragma unroll
    for (int a = 0; a < 2; ++a)
#pragma unroll
        for (int b = 0; b < 2; ++b)
#pragma unroll
            for (int m = 0; m < 4; ++m)
#pragma unroll
                for (int n = 0; n < 2; ++n) acc[a][b][m][n] = (f32x4){0.f, 0.f, 0.f, 0.f};
    bf16x8 At[4][2], B0[2][2], B1[2][2];
    const char* cA = (const char*)g.A + S.offA(cur); const char* cB = (const char*)g.Bt + S.offB(cur);
    PG8_STAGE(PG8_SB(0, 0), cB, voffB); PG8_STAGE(PG8_SB(0, 1), cB + hstepB, voffB); PG8_STAGE(PG8_SA(0, 0), cA, voffA); PG8_STAGE(PG8_SA(0, 1), cA + hstepA, voffA);
    if (wr == 1) PG8_BAR;
    PG8_WAIT_V(2); PG8_BAR;
    PG8_STAGE(PG8_SB(1, 0), cB + kstep, voffB); PG8_STAGE(PG8_SA(1, 0), cA + kstep, voffA); PG8_STAGE(PG8_SB(1, 1), cB + hstepB + kstep, voffB);
    PG8_WAIT_V(6); PG8_BAR;
    for (;;) {
        const bool has_next = S.next(ui + 1, nxt);
        const char* nA = has_next ? (const char*)g.A + S.offA(nxt) : cA; const char* nB = has_next ? (const char*)g.Bt + S.offB(nxt) : cB;
        for (int t = 0; t < nt; t += 2) {
            const bool last = (t == nt - 2);
            const char* a1 = cA + (size_t)(t + 1) * kstep;
            const char* a2 = last ? nA : cA + (size_t)(t + 2) * kstep; const char* b2 = last ? nB : cB + (size_t)(t + 2) * kstep;
            const char* a3 = a2 + kstep; const char* b3 = b2 + kstep;
            PG8_LDB(B0, 0, 0); PG8_LDB(B1, 0, 1); PG8_SCHED; PG8_LDA(At, 0, 0); PG8_STAGE(PG8_SA(1, 1), a1 + hstepA, voffA);
            PG8_WAIT_V(8); PG8_WAIT_L(0); PG8_BAR; PG8_MMA(0, 0, At, B0); PG8_MMA(0, 1, At, B1); PG8_BAR; PG8_SCHED;
            PG8_LDA(At, 0, 1); PG8_STAGE(PG8_SB(0, 0), b2, voffB); PG8_STAGE(PG8_SB(0, 1), b2 + hstepB, voffB); PG8_STAGE(PG8_SA(0, 0), a2, voffA);
            PG8_WAIT_V(8); PG8_WAIT_L(0); PG8_BAR; PG8_MMA(1, 0, At, B0); PG8_MMA(1, 1, At, B1); PG8_BAR; PG8_SCHED;
            PG8_LDB(B0, 1, 0); PG8_LDB(B1, 1, 1); PG8_SCHED; PG8_LDA(At, 1, 0); PG8_STAGE(PG8_SA(0, 1), a2 + hstepA, voffA);
            PG8_WAIT_V(8); PG8_WAIT_L(0); PG8_BAR; PG8_MMA(0, 0, At, B0); PG8_MMA(0, 1, At, B1); PG8_BAR; PG8_SCHED;
            PG8_LDA(At, 1, 1); PG8_STAGE(PG8_SB(1, 0), b3, voffB); PG8_STAGE(PG8_SB(1, 1), b3 + hstepB, voffB); PG8_STAGE(PG8_SA(1, 0), a3, voffA);
            PG8_WAIT_V(8); PG8_WAIT_L(0); PG8_BAR; PG8_MMA(1, 0, At, B0); PG8_MMA(1, 1, At, B1); PG8_BAR; PG8_SCHED;
        }
        if constexpr (ALIGN_EPI) { if (wr == 0) PG8_BAR; }
        E(acc, cur, wr, wc, fr, fq, lds);
        if (!has_next) break;
#pragma unroll
        for (int a = 0; a < 2; ++a)
#pragma unroll
            for (int b = 0; b < 2; ++b)
#pragma unroll
                for (int m = 0; m < 4; ++m)
#pragma unroll
                    for (int n = 0; n < 2; ++n) acc[a][b][m][n] = (f32x4){0.f, 0.f, 0.f, 0.f};
        cur = nxt; cA = nA; cB = nB; ++ui;
        if constexpr (ALIGN_EPI) { if (wr == 1) PG8_BAR; }
    }
    PG8_WAIT_V(0);
    if constexpr (!ALIGN_EPI) { if (wr == 0) PG8_BAR; }
    PG8_BAR;
#undef PG8_SA
#undef PG8_SB
#undef PG8_STAGE
#undef PG8_LDA
#undef PG8_LDB
#undef PG8_MMA
#undef PG8_WAIT_V
#undef PG8_WAIT_L
#undef PG8_BAR
#undef PG8_SCHED
}
}

struct KVSched {
    int c, G; const char* ws;
    __device__ __forceinline__ bool next(int i, pg8::Unit& u) const {
        const int L = i * G + c; if (c < 0 || L >= 96) return false;
        const int kind = L >> 5, r = L & 31;
        if (kind < 2) { u.pm = kind * 16 + (r >> 2); u.pn = r & 3; } else { u.pm = 32 + (r >> 3); u.pn = r & 7; }
        return true;
    }
    __device__ __forceinline__ size_t offA(const pg8::Unit& u) const { const int kind = u.pm >> 4, pm = u.pm & 15; int k2 = (kind == 2); asm volatile("" : "+v"(k2));
        return (size_t)ws + WS_MEMB + (size_t)k2 * (WS_WV - WS_MEMB) + (size_t)pm * 256 * 1024 * 2; }
    __device__ __forceinline__ size_t offB(const pg8::Unit& u) const { const int kind = u.pm >> 4; int k1 = (kind == 1), k2 = (kind == 2); asm volatile("" : "+v"(k1), "+v"(k2));
        return (size_t)ws + WS_WK + (size_t)k1 * (WS_WV - WS_WK) + (size_t)k2 * (WS_MEMB - WS_WK) + (size_t)u.pn * 256 * 1024 * 2; }
};

__device__ __forceinline__ void transpose_item(const float* W, int K, int N, bf16_t* WT, LAS float* scr, int item, int lane) {
    const int nblk = N / 32, kb = item / nblk, nb = item % nblk, k0 = 64 * kb, n0 = 32 * nb;
#pragma unroll 8
    for (int i = 0; i < 32; ++i) { const int kk = 2 * i + (lane >> 5); scr[kk * 33 + (lane & 31)] = W[(size_t)(k0 + kk) * N + n0 + (lane & 31)]; }
    LDS_WAIT();
    const int c = lane & 7;
#pragma unroll
    for (int j = 0; j < 4; ++j) { const int n = (lane >> 3) + 8 * j; const LAS float* s = scr + (8 * c) * 33 + n;
        u32x4 o; o.x = pk2(s[0 * 33], s[1 * 33]); o.y = pk2(s[2 * 33], s[3 * 33]); o.z = pk2(s[4 * 33], s[5 * 33]); o.w = pk2(s[6 * 33], s[7 * 33]);
        *(u32x4*)(WT + (size_t)(n0 + n) * K + k0 + 8 * c) = o; }
    LDS_WAIT();
}

__device__ __forceinline__ void norm_rows(const float* X, const float* gain, bf16_t* XN, int gw, int NGW, int lane) {
    f32x4 gv[4];
#pragma unroll
    for (int j = 0; j < 4; ++j) gv[j] = ((const f32x4*)gain)[lane + 64 * j];
    for (int m = gw; m < MT; m += NGW) {
        const f32x4* xr = (const f32x4*)(X + (size_t)m * D) + lane;
        f32x4 v[4]; float s = 0.f;
#pragma unroll
        for (int j = 0; j < 4; ++j) { v[j] = xr[64 * j]; s += (v[j].x * v[j].x + v[j].y * v[j].y) + (v[j].z * v[j].z + v[j].w * v[j].w); }
        const float rstd = 1.0f / sqrtf(wave_sum(s, lane) * (1.f / D) + EPS);
        u32x2* o8 = (u32x2*)(XN + (size_t)m * D) + lane;
#pragma unroll
        for (int j = 0; j < 4; ++j) { u32x2 w; w.x = pk2(v[j].x * rstd * gv[j].x, v[j].y * rstd * gv[j].y); w.y = pk2(v[j].z * rstd * gv[j].z, v[j].w * rstd * gv[j].w); o8[64 * j] = w; }
    }
}


typedef __attribute__((address_space(4))) const unsigned char* kptr_t;
typedef const float* cfp_t; typedef float* fp_t; typedef unsigned char* ucp_t;
#define INP(k) (*(const __attribute__((address_space(4))) cfp_t*)(kp + 8 * (k)))
#define X out
#define WIN_T ((bf16_t*)(ws + WS_WIN))
#define WOUT_T ((bf16_t*)(ws + WS_WOUT))
#define WQ_T ((bf16_t*)(ws + WS_WQ))
#define WK_T ((bf16_t*)(ws + WS_WK))
#define WV_T ((bf16_t*)(ws + WS_WV))
#define WO_T ((bf16_t*)(ws + WS_WO))
#define WUP_T ((bf16_t*)(ws + WS_WUP))
#define WDN_T ((bf16_t*)(ws + WS_WDN))
#define MEMB ((bf16_t*)(ws + WS_MEMB))
#define KBP ((bf16_t*)(ws + WS_KBP))
#define VTP ((bf16_t*)(ws + WS_VTP))
#define KBS ((bf16_t*)(ws + WS_KBS))
#define VTS ((bf16_t*)(ws + WS_VTS))
#define WST ((bf16_t*)(ws + WS_WST))
#define AGG ((float*)(ws + WS_AGG))
#define GT_R ((bf16_t*)(ws + WS_GT))
#define GT_I ((bf16_t*)(ws + WS_GT + 65536))
#define XN ((bf16_t*)(ws + WS_XN))
#define gZ ((bf16_t*)(ws + B_Z))
#define HLOC ((float*)(ws + B_HLOC))
#define PCUM ((float*)(ws + B_PCUM))
#define gY ((bf16_t*)(ws + B_Y))
#define gQ ((bf16_t*)(ws + B_Q))
#define gP ((bf16_t*)(ws + B_P))
#define gO ((bf16_t*)(ws + B_O))
#define PS ((bf16_t*)(ws + B_PS))
#define GU ((bf16_t*)(ws + B_GU))
__global__ void __launch_bounds__(NTHREADS, 2) trunk_fwd(Args args) {
    extern __shared__ __attribute__((aligned(16))) unsigned char lds_raw[];
    LAS unsigned char* lds = (LAS unsigned char*)lds_raw;
    cg::grid_group grid = cg::this_grid();
#define LANE_STATE() int G = gridDim.x, bid = blockIdx.x; asm volatile("" : "+s"(G), "+s"(bid)); const int NGW = G * NWAVES, NGT = G * NTHREADS; (void)NGW; (void)NGT; \
    const int tid = opaque_tid(), lane = tid & 63, wave = __builtin_amdgcn_readfirstlane(tid >> 6); const int gw = bid * NWAVES + wave; const int gt = bid * NTHREADS + tid; (void)lane; (void)gw; (void)gt; \
    kptr_t kp = (kptr_t)__builtin_amdgcn_kernarg_segment_ptr(); asm volatile("" : "+s"(kp)); \
    float* const out = *(const __attribute__((address_space(4))) fp_t*)(kp + 8 * N_IN); unsigned char* const ws = *(const __attribute__((address_space(4))) ucp_t*)(kp + 8 * N_IN + 8); (void)out; (void)ws
    {
        LANE_STATE();
        const f32x4* sp = (const f32x4*)INP(I_XP); const f32x4* ss = (const f32x4*)INP(I_XS); f32x4* dx = (f32x4*)X;
        for (size_t i = gt; i < (size_t)MT * D / 4; i += NGT) dx[i] = i < (size_t)MP * D / 4 ? sp[i] : ss[i - (size_t)MP * D / 4];
    }
    grid.sync();

    for (int l = 0; l < DEPTH; ++l) {
        {
            LANE_STATE();
            LAS float* scr = (LAS float*)(lds + wave * 16384);
            const float* w_in = INP(I_WIN) + (size_t)l * D * INC; const float* w_out = INP(I_WOUT) + (size_t)l * D * D; const float* w_q = INP(I_WQ) + (size_t)l * D * D;
            const float* w_k = INP(I_WK) + (size_t)l * D * D; const float* w_v = INP(I_WV) + (size_t)l * D * D; const float* w_o = INP(I_WO) + (size_t)l * D * D;
            const float* w_up = INP(I_WUP) + (size_t)l * D * 2 * DFF; const float* w_dn = INP(I_WDN) + (size_t)l * DFF * D; const float* c_v = INP(I_CV) + (size_t)l * BS * NMEM * D;
            constexpr int T_IN = 16 * (INC / 32), T_SQ = 16 * 32, T_UP = 16 * (2 * DFF / 32), T_DN = (DFF / 64) * 32, T_CV = 32 * 32;
            constexpr int T_G = 16;
            constexpr int NIT = T_IN + 5 * T_SQ + T_UP + T_DN + T_CV + 2 * T_G;
            for (int it = gw; it < NIT; it += NGW) {
                int r = it;
                if (r < T_IN) { transpose_item(w_in, D, INC, WIN_T, scr, r, lane); continue; } r -= T_IN;
                if (r < T_SQ) { transpose_item(w_out, D, D, WOUT_T, scr, r, lane); continue; } r -= T_SQ;
                if (r < T_SQ) { transpose_item(w_q, D, D, WQ_T, scr, r, lane); continue; } r -= T_SQ;
                if (r < T_SQ) { transpose_item(w_k, D, D, WK_T, scr, r, lane); continue; } r -= T_SQ;
                if (r < T_SQ) { transpose_item(w_v, D, D, WV_T, scr, r, lane); continue; } r -= T_SQ;
                if (r < T_SQ) { transpose_item(w_o, D, D, WO_T, scr, r, lane); continue; } r -= T_SQ;
                if (r < T_UP) { transpose_item(w_up, D, 2 * DFF, WUP_T, scr, r, lane); continue; } r -= T_UP;
                if (r < T_DN) { transpose_item(w_dn, DFF, D, WDN_T, scr, r, lane); continue; } r -= T_DN;
                if (r < T_CV) { transpose_item(c_v, BS * NMEM, D, VTS, scr, r, lane); continue; } r -= T_CV;
                if (r < T_G) { transpose_item(INP(I_WRG) + ((size_t)l * 8 + (r >> 1)) * 4096, 64, 64, GT_R + (r >> 1) * 4096, scr, r & 1, lane); continue; } r -= T_G;
                transpose_item(INP(I_WIG) + ((size_t)l * 8 + (r >> 1)) * 4096, 64, 64, GT_I + (r >> 1) * 4096, scr, r & 1, lane);
            }
            {
                const f32x4* ck = (const f32x4*)(INP(I_CK) + (size_t)l * BS * NMEM * D); u32x2* dk = (u32x2*)KBS;
                for (int i = gt; i < BS * NMEM * D / 4; i += NGT) { const f32x4 v = ck[i]; u32x2 w; w.x = pk2(v.x, v.y); w.y = pk2(v.z, v.w); dk[i] = w; }
                if (l == 0) { const f32x4* mm = (const f32x4*)INP(I_MEM); u32x2* dm = (u32x2*)MEMB;
                    for (int i = gt; i < BP * NMEM * D / 4; i += NGT) { const f32x4 v = mm[i]; u32x2 w; w.x = pk2(v.x, v.y); w.y = pk2(v.z, v.w); dm[i] = w; } }
                const float* wsl = INP(I_WS) + (size_t)l * 4 * 128 * 128;
                for (int i = gt; i < 4 * 128 * 128; i += NGT) { const int s = i & 127, t = (i >> 7) & 127; WST[i] = (bf16_t)f2bf(s <= t ? wsl[i] : 0.f); }
            }
            norm_rows(X, INP(I_GMIX) + l * D, XN, gw, NGW, lane);
        }
        grid.sync();
        {
            LANE_STATE();
            KVSched S; S.G = G; S.c = bid >= 160 ? bid - 160 : -1; S.ws = (const char*)ws;
            pg8::Gemm g{(const bf16_t*)nullptr, (const bf16_t*)nullptr, D, D, D};
            pg8::EpiKV E{out + O_MKP + (size_t)l * BP * NMEM * D, out + O_MVP + (size_t)l * BP * NMEM * D, KBP, VTP};
            pg8::gemm_phase<pg8::EpiKV, KVSched, true>(lds, g, S, E);
        }
#define GEMM_BF16(s_) do { const int s = (s_); pg8::GSched S; pg8::Gemm g; pg8::EpiBf16 E; E.scale = 1.f; \
        if (s == 0) { S.init(MT / 256, INC / 256, G, bid); S.aPm = (size_t)256 * D * 2; S.bPn = (size_t)256 * D * 2; g = pg8::Gemm{XN, WIN_T, D, D, D}; E.O = gZ; E.ldc = INC; } \
        else if (s == 1) { S.init(MT / 256, D / 256, G, bid); S.aPm = (size_t)256 * D * 2; S.bPn = (size_t)256 * D * 2; g = pg8::Gemm{XN, WQ_T, D, D, D}; E.O = gQ; E.ldc = D; E.scale = 0.0625f; } \
        else if (s == 2) { S.init(MP / 256, 4, G, bid); S.aPm = (size_t)256 * D * 2; S.aPn = 512; S.bPn = (size_t)256 * 2048 * 2; S.bPm = 512; S.bShift = 4; g = pg8::Gemm{gP, VTP, D, 2048, 256}; E.O = gO; E.ldc = D; } \
        else if (s == 3) { S.init(1, 4, G, (bid + G - 8) % G); S.aPn = 4096; S.bPn = (size_t)256 * 2048 * 2; g = pg8::Gemm{PS, VTS, 8192, 2048, 2048}; E.O = gO + (size_t)MP * D; E.ldc = D; } \
        else { S.init(MT / 256, 2 * DFF / 256, G, bid); S.aPm = (size_t)256 * D * 2; S.bPn = (size_t)256 * D * 2; g = pg8::Gemm{XN, WUP_T, D, D, D}; E.O = GU; E.ldc = 2 * DFF; } \
        pg8::gemm_phase<pg8::EpiBf16, pg8::GSched, true>(lds, g, S, E); } while (0)
#define GEMM_RES(s_) do { const int s = (s_); pg8::GSched S; S.init(MT / 256, D / 256, G, bid); pg8::Gemm g; \
        if (s == 0) { g = pg8::Gemm{gY, WOUT_T, D, D, D}; S.aPm = (size_t)256 * D * 2; } \
        else if (s == 1) { g = pg8::Gemm{gO, WO_T, D, D, D}; S.aPm = (size_t)256 * D * 2; } \
        else { g = pg8::Gemm{GU + DFF, WDN_T, 2 * DFF, DFF, DFF}; S.aPm = (size_t)256 * 2 * DFF * 2; } \
        S.bPn = (size_t)256 * g.ldb * 2; \
        pg8::EpiResid E{X, X + (size_t)MP * D, X}; \
        pg8::gemm_phase<pg8::EpiResid, pg8::GSched, true>(lds, g, S, E); } while (0)

        for (int rep = 0; rep < 13; ++rep) {
            if (rep == 0 || rep == 5 || rep == 7 || rep == 10) {
                LANE_STATE();
                const int s0 = rep == 0 ? 0 : (rep == 5 ? 1 : (rep == 7 ? 2 : 4)), ns = rep == 7 ? 2 : 1;
                for (int q = 0; q < ns; ++q) GEMM_BF16(s0 + q);
            } else if (rep == 1) {
                LANE_STATE();
                {
                    LAS bf16_t* vT = (LAS bf16_t*)lds;
                    constexpr int VP = 136;
                    const float* gvp = INP(I_GV) + l * CW; const float* bsp = INP(I_BSS) + l * 4 * 128;
                    for (int un = bid; un < 8 + 256; un += G) {
                        int rowbase, nrows, sb = -1;
                        if (un < 8) { sb = un; rowbase = MP + un * TS; nrows = TS; } else { rowbase = (un - 8) * 128; nrows = 128; }
                        {
                            const int rl = tid >> 5, cgp = tid & 31;
                            f32x4 g0 = *(const f32x4*)(gvp + cgp * 8), g1 = *(const f32x4*)(gvp + cgp * 8 + 4);
                            for (int p = 0; p < nrows / 16; ++p) {
                                const int r = p * 16 + rl;
                                const u32x4 raw = *(const u32x4*)(gZ + (size_t)(rowbase + r) * INC + Z_VC + cgp * 8);
                                float v[8] = {bflo(raw.x), bfhi(raw.x), bflo(raw.y), bfhi(raw.y), bflo(raw.z), bfhi(raw.z), bflo(raw.w), bfhi(raw.w)};
                                float ss = 0.f;
#pragma unroll
                                for (int k = 0; k < 8; ++k) { v[k] = gelu_t(v[k]); ss += v[k] * v[k]; }
                                ss += shx(ss, 1, lane); ss += shx(ss, 2, lane); ss += shx(ss, 4, lane);
                                const float rstd = 1.0f / sqrtf(ss * (1.f / 64.f) + EPS);
                                const float gg[8] = {g0.x, g0.y, g0.z, g0.w, g1.x, g1.y, g1.z, g1.w};
#pragma unroll
                                for (int k = 0; k < 8; ++k) { v[k] = v[k] * rstd * gg[k]; vT[(cgp * 8 + k) * VP + r] = (bf16_t)f2bf(v[k]); }
                                if (sb >= 0) { float* vo = out + O_VCS + ((size_t)(l * BS + sb) * TS + r) * CW + cgp * 8;
                                    *(f32x4*)vo = (f32x4){v[0], v[1], v[2], v[3]}; *(f32x4*)(vo + 4) = (f32x4){v[4], v[5], v[6], v[7]}; }
                            }
                        }
                        __syncthreads();
                        {
                            const int hh = wave & 3, rh = wave >> 2, fr = lane & 15, fq = lane >> 4;
                            const int nmt = nrows == 128 ? 4 : (rh == 0 ? 2 : 0);
                            for (int mi = 0; mi < nmt; ++mi) {
                                const int mt = rh * 4 + mi, nks = (mt * 16 + 15) / 32 + 1;
                                f32x4 acc[4];
#pragma unroll
                                for (int n = 0; n < 4; ++n) acc[n] = (f32x4){0.f, 0.f, 0.f, 0.f};
                                for (int ks = 0; ks < nks; ++ks) {
                                    const bf16x8 a = *(const bf16x8*)(WST + ((size_t)(hh * 128 + mt * 16 + fr) * 128 + ks * 32 + fq * 8));
#pragma unroll
                                    for (int n = 0; n < 4; ++n) { const bf16x8 b = *(const LAS bf16x8*)(vT + (hh * 64 + n * 16 + fr) * VP + ks * 32 + fq * 8);
                                        acc[n] = __builtin_amdgcn_mfma_f32_16x16x32_bf16(a, b, acc[n], 0, 0, 0); }
                                }
#pragma unroll
                                for (int j = 0; j < 4; ++j) { const int t = mt * 16 + fq * 4 + j; const float bias = bsp[hh * 128 + t]; const size_t row = (size_t)(rowbase + t);
#pragma unroll
                                    for (int n = 0; n < 4; ++n) { const int c = hh * 64 + n * 16 + fr; const float u = gelu_t(bf2f(gZ[row * INC + Z_UC + c]));
                                        gY[row * D + 768 + c] = (bf16_t)f2bf(u * (acc[n][j] + bias)); } }
                            }
                        }
                        __syncthreads();
                    }
                }
                {
                    LAS unsigned char* wl = lds + wave * 16384;
                    LAS bf16_t* tile = (LAS bf16_t*)wl;
                    LAS float* pre_r = (LAS float*)(wl + 2560);
                    LAS float* pre_i = (LAS float*)(wl + 2560 + 4096);
                    LAS float* xcf = (LAS float*)(wl + 2560 + 8192);
                    const int fr = lane & 15, fq = lane >> 4;
                    for (int un = gw; un < 64 + 2048; un += NGW) {
                        int b, hd, rowbase, nrows, t0; bool smp = un < 64;
                        if (smp) { b = un >> 3; hd = un & 7; rowbase = MP + b * TS; nrows = TS; t0 = 0; }
                        else { const int v = un - 64; const int ch = v & 31; hd = (v >> 5) & 7; b = v >> 8; t0 = ch * 128; rowbase = b * SEQ + t0; nrows = 128; }
                        const int cidx = l * AW + hd * 64 + lane;
                        const float br = INP(I_BRG)[cidx], bi = INP(I_BIG)[cidx];
                        const float c8sp = 8.0f * log1pf(__expf(-INP(I_LAM)[cidx]));
                        const float* caw = INP(I_CAW) + (size_t)l * 4 * AW + hd * 64 + lane;
                        const float cw0 = caw[0], cw1 = caw[AW], cw2 = caw[2 * AW], cw3 = caw[3 * AW], cb = INP(I_CAB)[cidx];
                        bf16x8 bR[4][2], bI[4][2];
#pragma unroll
                        for (int n = 0; n < 4; ++n)
#pragma unroll
                            for (int ks = 0; ks < 2; ++ks) { const size_t o_ = (size_t)(hd * 64 + n * 16 + fr) * 64 + ks * 32 + fq * 8;
                                bR[n][ks] = *(const bf16x8*)(GT_R + o_); bI[n][ks] = *(const bf16x8*)(GT_I + o_); }
                        float xm3 = 0.f, xm2 = 0.f, xm1 = 0.f;
                        if (smp) { const float* st = INP(I_SCA) + ((size_t)(l * BS + b) * 3) * AW + hd * 64 + lane; xm3 = st[0]; xm2 = st[AW]; xm1 = st[2 * AW]; }
                        else if (t0 > 0) { const bf16_t* zp = gZ + (size_t)(rowbase - 3) * INC + Z_XA + hd * 64 + lane; xm3 = bf2f(zp[0]); xm2 = bf2f(zp[INC]); xm1 = bf2f(zp[2 * INC]); }
                        float h = 0.f, pc = 1.f;
                        const bf16_t* zp = gZ + (size_t)rowbase * INC + Z_XA + hd * 64 + lane;
                        float* hp = HLOC + (size_t)rowbase * AW + hd * 64 + lane; float* pp = PCUM + (size_t)rowbase * AW + hd * 64 + lane;
                        for (int st = 0; st < nrows / 16; ++st) {
#pragma unroll 4
                            for (int i = 0; i < 16; ++i) { const float xv = bf2f(*zp); zp += INC;
                                const float xc = cw0 * xm3 + cw1 * xm2 + cw2 * xm1 + cw3 * xv + cb; xm3 = xm2; xm2 = xm1; xm1 = xv; xcf[i * 64 + lane] = xc; tile[i * 72 + lane] = (bf16_t)f2bf(xc); }
                            LDS_WAIT();
                            const bf16x8 a0 = *(const LAS bf16x8*)(tile + fr * 72 + fq * 8), a1 = *(const LAS bf16x8*)(tile + fr * 72 + 32 + fq * 8);
#pragma unroll
                            for (int n = 0; n < 4; ++n) {
                                f32x4 ar = (f32x4){0.f, 0.f, 0.f, 0.f}, ai = (f32x4){0.f, 0.f, 0.f, 0.f};
                                ar = __builtin_amdgcn_mfma_f32_16x16x32_bf16(a0, bR[n][0], ar, 0, 0, 0); ar = __builtin_amdgcn_mfma_f32_16x16x32_bf16(a1, bR[n][1], ar, 0, 0, 0);
                                ai = __builtin_amdgcn_mfma_f32_16x16x32_bf16(a0, bI[n][0], ai, 0, 0, 0); ai = __builtin_amdgcn_mfma_f32_16x16x32_bf16(a1, bI[n][1], ai, 0, 0, 0);
#pragma unroll
                                for (int j = 0; j < 4; ++j) { pre_r[(fq * 4 + j) * 64 + n * 16 + fr] = ar[j]; pre_i[(fq * 4 + j) * 64 + n * 16 + fr] = ai[j]; }
                            }
                            LDS_WAIT();
#pragma unroll 4
                            for (int i = 0; i < 16; ++i) {
                                const float r = sigm(pre_r[i * 64 + lane] + br), gi = sigm(pre_i[i * 64 + lane] + bi);
                                const float la = -c8sp * r, a = __expf(la), bm = sqrtf(-expm1f(2.0f * la));
                                h = a * h + bm * gi * xcf[i * 64 + lane]; pc = pc * a;
                                *hp = h; *pp = pc; hp += AW; pp += AW;
                            }
                            LDS_WAIT();
                        }
                        AGG[(size_t)un * 128 + lane] = pc; AGG[(size_t)un * 128 + 64 + lane] = h;
                    }
                }
                {
                    const float* cbw = INP(I_CBW) + (size_t)l * 3 * BW;
                    for (int it = gt; it < (MT / 16) * 32; it += NGT) {
                        const int rb = it >> 5, c0 = (it & 31) * 8;
                        int b, t0, T, rowbase; bool smp = rb >= MP / 16;
                        if (!smp) { b = rb >> 8; t0 = (rb & 255) * 16; T = SEQ; rowbase = rb * 16; } else { const int sbk = rb - MP / 16; b = sbk >> 1; t0 = (sbk & 1) * 16; T = TS; rowbase = MP + sbk * 16; }
                        float w0[8], w1[8], w2[8], pm2[8], pm1[8];
#pragma unroll
                        for (int k = 0; k < 8; ++k) { w0[k] = cbw[c0 + k]; w1[k] = cbw[BW + c0 + k]; w2[k] = cbw[2 * BW + c0 + k]; pm2[k] = 0.f; pm1[k] = 0.f; }
                        if (t0 == 0) { if (smp) { const float* st = INP(I_SCB) + ((size_t)(l * BS + b) * 2) * BW + c0;
#pragma unroll
                                for (int k = 0; k < 8; ++k) { pm2[k] = st[k]; pm1[k] = st[BW + k]; } } }
                        else {
#pragma unroll
                            for (int rr = 0; rr < 2; ++rr) { const bf16_t* zr = gZ + (size_t)(rowbase - 2 + rr) * INC; const u32x4 xb = *(const u32x4*)(zr + Z_XB + c0), gc = *(const u32x4*)(zr + Z_GC + c0);
                                float pv[8] = {bflo(xb.x) * bflo(gc.x), bfhi(xb.x) * bfhi(gc.x), bflo(xb.y) * bflo(gc.y), bfhi(xb.y) * bfhi(gc.y), bflo(xb.z) * bflo(gc.z), bfhi(xb.z) * bfhi(gc.z), bflo(xb.w) * bflo(gc.w), bfhi(xb.w) * bfhi(gc.w)};
#pragma unroll
                                for (int k = 0; k < 8; ++k) { if (rr == 0) pm2[k] = pv[k]; else pm1[k] = pv[k]; } }
                        }
                        for (int i = 0; i < 16; ++i) {
                            const bf16_t* zr = gZ + (size_t)(rowbase + i) * INC; const u32x4 xb = *(const u32x4*)(zr + Z_XB + c0), gc = *(const u32x4*)(zr + Z_GC + c0), gb = *(const u32x4*)(zr + Z_GB + c0);
                            const float pv[8] = {bflo(xb.x) * bflo(gc.x), bfhi(xb.x) * bfhi(gc.x), bflo(xb.y) * bflo(gc.y), bfhi(xb.y) * bfhi(gc.y), bflo(xb.z) * bflo(gc.z), bfhi(xb.z) * bfhi(gc.z), bflo(xb.w) * bflo(gc.w), bfhi(xb.w) * bfhi(gc.w)};
                            const float gbv[8] = {bflo(gb.x), bfhi(gb.x), bflo(gb.y), bfhi(gb.y), bflo(gb.z), bfhi(gb.z), bflo(gb.w), bfhi(gb.w)};
                            float yv[8];
#pragma unroll
                            for (int k = 0; k < 8; ++k) { yv[k] = gbv[k] * (w0[k] * pm2[k] + w1[k] * pm1[k] + w2[k] * pv[k]); pm2[k] = pm1[k]; pm1[k] = pv[k]; }
                            u32x4 w; w.x = pk2(yv[0], yv[1]); w.y = pk2(yv[2], yv[3]); w.z = pk2(yv[4], yv[5]); w.w = pk2(yv[6], yv[7]);
                            *(u32x4*)(gY + (size_t)(rowbase + i) * D + 512 + c0) = w;
                        }
                        if (t0 + 16 == T) { float* o = out + (smp ? O_CBS : O_CBP) + ((size_t)(l * 8 + b) * 2) * BW + c0;
#pragma unroll
                            for (int k = 0; k < 8; ++k) { o[k] = pm2[k]; o[BW + k] = pm1[k]; } }
                    }
                }
            } else if (rep == 2) {
                LANE_STATE();
                for (int un = gw; un < 64 + 2048; un += NGW) {
                    int b, hd, rowbase, nrows, ch = 0; bool smp = un < 64;
                    if (smp) { b = un >> 3; hd = un & 7; rowbase = MP + b * TS; nrows = TS; }
                    else { const int v = un - 64; ch = v & 31; hd = (v >> 5) & 7; b = v >> 8; rowbase = b * SEQ + ch * 128; nrows = 128; }
                    const int c = hd * 64 + lane;
                    float carry = 0.f;
                    if (smp) carry = INP(I_SHA)[(size_t)(l * BS + b) * AW + c];
                    else { const float* ag = AGG + (size_t)(un - ch) * 128 + lane; for (int k = 0; k < ch; ++k) carry = ag[(size_t)k * 128] * carry + ag[(size_t)k * 128 + 64]; }
                    float hl = 0.f;
                    for (int i = 0; i < nrows; ++i) { const size_t row = (size_t)(rowbase + i);
                        hl = HLOC[row * AW + c] + PCUM[row * AW + c] * carry;
                        gY[row * D + c] = (bf16_t)f2bf(gelu_t(bf2f(gZ[row * INC + Z_GA + c])) * hl); }
                    if (smp || ch == 31) {
                        out[(smp ? O_HAS : O_HAP) + (size_t)(l * 8 + b) * AW + c] = hl;
                        float* o = out + (smp ? O_CAS : O_CAP) + ((size_t)(l * 8 + b) * 3) * AW + c;
#pragma unroll
                        for (int k = 0; k < 3; ++k) o[k * AW] = bf2f(gZ[(size_t)(rowbase + nrows - 3 + k) * INC + Z_XA + c]);
                    }
                }
            } else if (rep == 3 || rep == 8 || rep == 12) {
                LANE_STATE();
                GEMM_RES(rep == 3 ? 0 : (rep == 8 ? 1 : 2));
            } else if (rep == 4 || rep == 9) {
                LANE_STATE();
                norm_rows(X, (rep == 4 ? INP(I_GX) : INP(I_GFFN)) + l * D, XN, gw, NGW, lane);
            } else if (rep == 6) {
                LANE_STATE();
                for (int sub = 0; sub < 2; ++sub) {
                    pg8::GSched S; pg8::Gemm g; pg8::EpiSoftmax E;
                    if (sub == 0) { S.init(MP / 256, 4, G, bid); S.aPm = (size_t)256 * D * 2; S.aPn = 512; S.bPn = 512; S.bPm = (size_t)256 * D * 2; S.bShift = 4; g = pg8::Gemm{gQ, KBP, D, D, 256}; E.O = gP; E.ldc = D; E.smp = 0; }
                    else { S.init(1, 32, G, (bid + G - 64) % G); S.mode = 1; g = pg8::Gemm{gQ + (size_t)MP * D, KBS, D, D, 256}; E.O = PS; E.ldc = 8192; E.smp = 1; }
                    pg8::gemm_phase<pg8::EpiSoftmax, pg8::GSched, true>(lds, g, S, E);
                }
            } else if (rep == 11) {
                LANE_STATE();
        {
            const float* cfw = INP(I_CFW) + (size_t)l * 3 * DFF;
            for (int it = gt; it < (MT / 16) * (DFF / 8); it += NGT) {
                const int rb = it / (DFF / 8), c0 = (it % (DFF / 8)) * 8;
                int b, t0, T, rowbase; bool smp = rb >= MP / 16;
                if (!smp) { b = rb >> 8; t0 = (rb & 255) * 16; T = SEQ; rowbase = rb * 16; } else { const int sbk = rb - MP / 16; b = sbk >> 1; t0 = (sbk & 1) * 16; T = TS; rowbase = MP + sbk * 16; }
                float w0[8], w1[8], w2[8], gm2[8], gm1[8];
#pragma unroll
                for (int k = 0; k < 8; ++k) { w0[k] = cfw[c0 + k]; w1[k] = cfw[DFF + c0 + k]; w2[k] = cfw[2 * DFF + c0 + k]; gm2[k] = 0.f; gm1[k] = 0.f; }
                if (t0 == 0) { if (smp) { const float* st = INP(I_SCF) + ((size_t)(l * BS + b) * 2) * DFF + c0;
#pragma unroll
                        for (int k = 0; k < 8; ++k) { gm2[k] = st[k]; gm1[k] = st[DFF + k]; } } }
                else {
                    const u32x4 ga = *(const u32x4*)(GU + (size_t)(rowbase - 2) * (2 * DFF) + c0), gb = *(const u32x4*)(GU + (size_t)(rowbase - 1) * (2 * DFF) + c0);
                    const float a_[8] = {bflo(ga.x), bfhi(ga.x), bflo(ga.y), bfhi(ga.y), bflo(ga.z), bfhi(ga.z), bflo(ga.w), bfhi(ga.w)};
                    const float b_[8] = {bflo(gb.x), bfhi(gb.x), bflo(gb.y), bfhi(gb.y), bflo(gb.z), bfhi(gb.z), bflo(gb.w), bfhi(gb.w)};
#pragma unroll
                    for (int k = 0; k < 8; ++k) { gm2[k] = a_[k]; gm1[k] = b_[k]; }
                }
                for (int i = 0; i < 16; ++i) {
                    bf16_t* gr = GU + (size_t)(rowbase + i) * (2 * DFF) + c0;
                    const u32x4 gq = *(const u32x4*)gr, uq = *(const u32x4*)(gr + DFF);
                    const float gv[8] = {bflo(gq.x), bfhi(gq.x), bflo(gq.y), bfhi(gq.y), bflo(gq.z), bfhi(gq.z), bflo(gq.w), bfhi(gq.w)};
                    const float uv[8] = {bflo(uq.x), bfhi(uq.x), bflo(uq.y), bfhi(uq.y), bflo(uq.z), bfhi(uq.z), bflo(uq.w), bfhi(uq.w)};
                    float hv[8];
#pragma unroll
                    for (int k = 0; k < 8; ++k) { const float cv = w0[k] * gm2[k] + w1[k] * gm1[k] + w2[k] * gv[k]; hv[k] = silu(cv) * uv[k]; gm2[k] = gm1[k]; gm1[k] = gv[k]; }
                    u32x4 w; w.x = pk2(hv[0], hv[1]); w.y = pk2(hv[2], hv[3]); w.z = pk2(hv[4], hv[5]); w.w = pk2(hv[6], hv[7]);
                    *(u32x4*)(gr + DFF) = w;
                }
                if (t0 + 16 == T) { float* o = out + (smp ? O_CFS : O_CFP) + ((size_t)(l * 8 + b) * 2) * DFF + c0;
#pragma unroll
                    for (int k = 0; k < 8; ++k) { o[k] = gm2[k]; o[DFF + k] = gm1[k]; } }
            }
        }
            }
            grid.sync();
        }
    }
    {
        LANE_STATE();
        const float* gain = INP(I_GFIN);
        f32x4 gv[4];
#pragma unroll
        for (int j = 0; j < 4; ++j) gv[j] = ((const f32x4*)gain)[lane + 64 * j];
        for (int m = gw; m < MT; m += NGW) {
            f32x4* xr = (f32x4*)(X + (size_t)m * D) + lane;
            f32x4 v[4]; float s = 0.f;
#pragma unroll
            for (int j = 0; j < 4; ++j) { v[j] = xr[64 * j]; s += (v[j].x * v[j].x + v[j].y * v[j].y) + (v[j].z * v[j].z + v[j].w * v[j].w); }
            const float rstd = 1.0f / sqrtf(wave_sum(s, lane) * (1.f / D) + EPS);
#pragma unroll
            for (int j = 0; j < 4; ++j) xr[64 * j] = v[j] * rstd * gv[j];
        }
    }
}

extern "C" void kernel_launch(void* const* d_in, const int* in_sizes, int n_in, void* d_out, int out_size, void* d_ws, size_t ws_size, hipStream_t stream) {
    static int grid = 0;
    if (grid == 0) {
        if (n_in != N_IN || (size_t)out_size != O_END || ws_size < WS_END) { fprintf(stderr, "kernel_launch: unexpected sizes n_in %d out %d ws %zu (need %zu)\n", n_in, out_size, ws_size, (size_t)WS_END); grid = -1; return; }
        int dev = 0, cus = 0, per_cu = 0;
        (void)hipGetDevice(&dev); (void)hipDeviceGetAttribute(&cus, hipDeviceAttributeMultiprocessorCount, dev);
        if (hipFuncSetAttribute((const void*)trunk_fwd, hipFuncAttributeMaxDynamicSharedMemorySize, LDS_BYTES) != hipSuccess) { fprintf(stderr, "kernel_launch: hipFuncSetAttribute failed\n"); grid = -1; return; }
        if (hipOccupancyMaxActiveBlocksPerMultiprocessor(&per_cu, (const void*)trunk_fwd, NTHREADS, LDS_BYTES) != hipSuccess || per_cu < 1) { fprintf(stderr, "kernel_launch: occupancy query gave %d\n", per_cu); per_cu = 1; }
        (void)hipGetLastError();
        grid = cus * 1;
        if (grid != 256) fprintf(stderr, "kernel_launch: note: %d CUs\n", grid);
    }
    if (grid < 0) return;
    Args a{};
    for (int i = 0; i < N_IN; ++i) a.in[i] = (const float*)d_in[i];
    a.out = (float*)d_out; a.ws = (unsigned char*)d_ws;
    void* kargs[] = {&a};
    hipError_t e = hipLaunchCooperativeKernel((const void*)trunk_fwd, dim3(grid), dim3(NTHREADS), kargs, LDS_BYTES, stream);
    if (e != hipSuccess) fprintf(stderr, "kernel_launch: cooperative launch failed: %s (grid %d)\n", hipGetErrorString(e), grid);
}
```

```cpp
#include <hip/hip_runtime.h>
#include <hip/hip_cooperative_groups.h>
#include <cstdio>
#include <cstdint>
namespace cg = cooperative_groups;
#ifndef PROBE
#define PROBE 0
#endif

#define LAS __attribute__((address_space(3)))
typedef unsigned short bf16_t;
typedef short bf16x8 __attribute__((ext_vector_type(8)));
typedef float f32x4 __attribute__((ext_vector_type(4)));
typedef float f32x2 __attribute__((ext_vector_type(2)));
typedef unsigned u32x4 __attribute__((ext_vector_type(4)));
typedef unsigned u32x2 __attribute__((ext_vector_type(2)));

constexpr int D = 1024, BP = 8, SEQ = 4096, BS = 8, TS = 32, DEPTH = 2;
constexpr int MP = BP * SEQ, MS = BS * TS, MT = MP + MS;
constexpr int INC = 2304, DFF = 2816, NMEM = 256, AW = 512, BW = 256, CW = 256;
constexpr int Z_XA = 0, Z_GA = 512, Z_XB = 1024, Z_GB = 1280, Z_GC = 1536, Z_UC = 1792, Z_VC = 2048;
constexpr float EPS = 1e-6f;
constexpr int NWAVES = 8, NTHREADS = 512;

constexpr size_t O_YP = 0, O_YS = O_YP + (size_t)MP * D, O_CAP = O_YS + (size_t)MS * D, O_HAP = O_CAP + DEPTH * BP * 3 * AW,
                 O_CBP = O_HAP + DEPTH * BP * AW, O_CFP = O_CBP + DEPTH * BP * 2 * BW, O_MKP = O_CFP + DEPTH * BP * 2 * DFF,
                 O_MVP = O_MKP + (size_t)DEPTH * BP * NMEM * D, O_CAS = O_MVP + (size_t)DEPTH * BP * NMEM * D, O_HAS = O_CAS + DEPTH * BS * 3 * AW,
                 O_CBS = O_HAS + DEPTH * BS * AW, O_CFS = O_CBS + DEPTH * BS * 2 * BW, O_VCS = O_CFS + DEPTH * BS * 2 * DFF,
                 O_END = O_VCS + DEPTH * BS * TS * CW;

constexpr size_t MiB = 1u << 20;
constexpr size_t WS_WIN = 0, WS_WOUT = 5 * MiB, WS_WQ = 7 * MiB, WS_WK = 9 * MiB, WS_WV = 11 * MiB, WS_WO = 13 * MiB, WS_WUP = 15 * MiB, WS_WDN = 26 * MiB;
constexpr size_t WS_MEMB = 32 * MiB, WS_KBP = 36 * MiB, WS_VTP = 40 * MiB, WS_KBS = 44 * MiB, WS_VTS = 48 * MiB, WS_WST = 52 * MiB, WS_GT = WS_WST + 131072, WS_AGG = 53 * MiB, WS_BAR = 55 * MiB;
constexpr size_t WS_XN = 56 * MiB, WS_BIG = 121 * MiB;
constexpr size_t B_Z = WS_BIG, B_HLOC = WS_BIG + 146 * MiB, B_PCUM = WS_BIG + 211 * MiB, B_Y = WS_BIG + 276 * MiB;
constexpr size_t B_Q = WS_BIG, B_P = WS_BIG + 65 * MiB, B_O = WS_BIG + 130 * MiB, B_PS = WS_BIG + 195 * MiB;
constexpr size_t B_GU = WS_BIG;
constexpr size_t WS_END = WS_BIG + (size_t)MT * 2 * DFF * 2;
static_assert(WS_END <= 512 * MiB, "workspace");
static_assert(WS_XN + (size_t)MT * D * 2 <= WS_BIG, "xn");

constexpr int LDS_RING = 131072, LDS_EX = LDS_RING, LDS_MISC = LDS_EX + 8192, LDS_BYTES = 147456;

enum { I_XP = 0, I_XS, I_MEM, I_CK, I_CV, I_SCA, I_SHA, I_SCB, I_SCF, I_GMIX, I_WIN, I_CAW, I_CAB, I_WRG, I_BRG, I_WIG, I_BIG, I_LAM, I_CBW, I_GV, I_WS, I_BSS,
       I_WOUT, I_GX, I_WQ, I_WK, I_WV, I_WO, I_GFFN, I_WUP, I_CFW, I_WDN, I_GFIN, N_IN };

struct Args { const float* in[N_IN]; float* out; unsigned char* ws; };

__device__ __forceinline__ unsigned f2bf(float f) { unsigned u = __builtin_bit_cast(unsigned, f); return (u + 0x7fffu + ((u >> 16) & 1u)) >> 16; }
__device__ __forceinline__ unsigned pk2(float lo, float hi) { return f2bf(lo) | (f2bf(hi) << 16); }
__device__ __forceinline__ float bf2f(unsigned v) { return __builtin_bit_cast(float, v << 16); }
__device__ __forceinline__ float bflo(unsigned w) { return __builtin_bit_cast(float, w << 16); }
__device__ __forceinline__ float bfhi(unsigned w) { return __builtin_bit_cast(float, w & 0xffff0000u); }
__device__ __forceinline__ unsigned cvt_pk_bf16(float lo, float hi) { unsigned r; asm volatile("v_cvt_pk_bf16_f32 %0, %1, %2" : "=v"(r) : "v"(lo), "v"(hi)); return r; }
__device__ __forceinline__ float fexp(float x) { return __builtin_amdgcn_exp2f(x * 1.4426950408889634f); }
__device__ __forceinline__ float sigm(float x) { return __builtin_amdgcn_rcpf(1.0f + fexp(-x)); }
__device__ __forceinline__ float gelu_t(float x) { const float u = 0.7978845608028654f * (x + 0.044715f * x * x * x); return x * sigm(2.0f * u); }
__device__ __forceinline__ float silu(float x) { return x * sigm(x); }
__device__ __forceinline__ float shx(float v, int m, int lane) { return __builtin_bit_cast(float, __builtin_amdgcn_ds_bpermute((lane ^ m) << 2, __builtin_bit_cast(int, v))); }
__device__ __forceinline__ float wave_sum(float v, int lane) {
#pragma unroll
    for (int o = 1; o < 64; o <<= 1) v += shx(v, o, lane);
    return v;
}
#define LDS_WAIT() asm volatile("s_waitcnt lgkmcnt(0)" ::: "memory")
__device__ __forceinline__ int opaque_tid() { int t = threadIdx.x; asm volatile("" : "+v"(t)); return t; }

namespace pg8 {
constexpr int BM = 256, BK = 64, HALF = 128, HTB = HALF * BK * 2, NXCD = 8, WGM = 8;
__device__ __forceinline__ int lds_byte(int r, int c) { const int st = (r >> 4) * 2 + (c >> 5), rr = r & 15, cc = c & 31, ob = rr * 64 + cc * 2; return st * 1024 + (ob ^ (((ob >> 9) & 1) << 5)); }
__device__ __forceinline__ void stage_rc(int b, int& R, int& C) { const int st = b / 1024, sb = b % 1024, swz = sb ^ (((sb >> 9) & 1) << 5); R = (st >> 1) * 16 + swz / 64; C = (st & 1) * 32 + (swz % 64) / 2; }
__device__ __forceinline__ int perm32(int rho) { const int n = rho >> 4, i = rho & 15; return 8 * (i >> 2) + 4 * n + (i & 3); }

struct Unit { int pm, pn; };
struct Gemm { const bf16_t* A; const bf16_t* Bt; int lda, ldb, K; };

struct GSched {
    int nM, nN, nwg, G, c, mode;
    size_t aPm, aPn, bPn, bPm; int bShift;
    __device__ __forceinline__ void init(int nM_, int nN_, int G_, int c_) { nM = nM_; nN = nN_; nwg = nM * nN; G = G_; c = c_; mode = 0; aPm = 0; aPn = 0; bPn = 0; bPm = 0; bShift = 0; }
    __device__ __forceinline__ bool next(int i, Unit& u) const {
        const long L = (long)i * G + c; if (L >= nwg) return false;
        int wgid = (int)L; { const int q = nwg / NXCD, r = nwg % NXCD, xcd = wgid % NXCD, off = wgid / NXCD; wgid = (xcd < r ? xcd * (q + 1) : r * (q + 1) + (xcd - r) * q) + off; }
        const int nig = WGM * nN, gid = wgid / nig, fm = gid * WGM, gsz = (nM - fm) < WGM ? (nM - fm) : WGM;
        u.pm = fm + ((wgid % nig) % gsz); u.pn = (wgid % nig) / gsz; return true;
    }
    __device__ __forceinline__ size_t offA(const Unit& u) const { return mode == 1 ? (size_t)(u.pn & 3) * 512 : (size_t)u.pm * aPm + (size_t)u.pn * aPn; }
    __device__ __forceinline__ size_t offB(const Unit& u) const { return mode == 1 ? (size_t)(u.pn >> 2) * (256 * 1024 * 2) + (size_t)(u.pn & 3) * 512 : (size_t)u.pn * bPn + (size_t)(u.pm >> bShift) * bPm; }
};

struct EpiBf16 {
    static constexpr bool PERM = true;
    bf16_t* O; int ldc; float scale;
    __device__ __forceinline__ void operator()(f32x4 (&acc)[2][2][4][2], const Unit& u, int wr, int wc, int fr, int fq, LAS unsigned char*) const {
        asm volatile("" : "+v"(fr), "+v"(fq)); asm volatile("" : "+s"(wr), "+s"(wc));
        const int row0 = u.pm * BM + wr * 64 + fr, col0 = u.pn * BM + wc * 32 + 8 * fq;
#pragma unroll
        for (int ai = 0; ai < 2; ++ai)
#pragma unroll
            for (int m = 0; m < 4; ++m) { bf16_t* rowp = O + (size_t)(row0 + ai * HALF + m * 16) * ldc + col0;
#pragma unroll
                for (int bj = 0; bj < 2; ++bj) { const f32x4 v0 = acc[ai][bj][m][0] * scale, v1 = acc[ai][bj][m][1] * scale;
                    u32x4 w; w.x = cvt_pk_bf16(v0[0], v0[1]); w.y = cvt_pk_bf16(v0[2], v0[3]); w.z = cvt_pk_bf16(v1[0], v1[1]); w.w = cvt_pk_bf16(v1[2], v1[3]);
                    *(u32x4*)(rowp + bj * HALF) = w; } }
    }
};
struct EpiResid {
    static constexpr bool PERM = false;
    const float* baseP; const float* baseS; float* out;
    __device__ __forceinline__ void operator()(f32x4 (&acc)[2][2][4][2], const Unit& u, int wr, int wc, int fr, int fq, LAS unsigned char*) const {
        asm volatile("" : "+v"(fr), "+v"(fq)); asm volatile("" : "+s"(wr), "+s"(wc));
        const int col0 = u.pn * BM + wc * 32 + 4 * fq;
        const float* base = (u.pm < 128) ? baseP + (size_t)u.pm * BM * D : baseS;
        float* o = out + (size_t)u.pm * BM * D;
#pragma unroll
        for (int ai = 0; ai < 2; ++ai)
#pragma unroll
            for (int m = 0; m < 4; ++m) { const size_t off = (size_t)(ai * HALF + wr * 64 + m * 16 + fr) * D + col0;
#pragma unroll
                for (int bj = 0; bj < 2; ++bj)
#pragma unroll
                    for (int n = 0; n < 2; ++n) { const f32x4 bs = *(const f32x4*)(base + off + bj * HALF + n * 16); *(f32x4*)(o + off + bj * HALF + n * 16) = bs + acc[ai][bj][m][n]; } }
    }
};
struct EpiKV {
    static constexpr bool PERM = false;
    float* outK; float* outV; bf16_t* KB; bf16_t* VT;
    __device__ __forceinline__ void operator()(f32x4 (&acc)[2][2][4][2], const Unit& u, int wr, int wc, int fr, int fq, LAS unsigned char*) const {
        asm volatile("" : "+v"(fr), "+v"(fq)); asm volatile("" : "+s"(wr), "+s"(wc));
        const int kind = u.pm >> 4, pm = u.pm & 15;
        const int col0 = u.pn * BM + wc * 32 + 4 * fq;
        float* of = kind == 0 ? outK : outV; bf16_t* ob = kind == 0 ? KB : VT; const int ldb_ = kind == 2 ? 2048 : 1024;
#pragma unroll
        for (int ai = 0; ai < 2; ++ai)
#pragma unroll
            for (int m = 0; m < 4; ++m) { const int row = pm * BM + ai * HALF + wr * 64 + m * 16 + fr;
#pragma unroll
                for (int bj = 0; bj < 2; ++bj)
#pragma unroll
                    for (int n = 0; n < 2; ++n) { const f32x4 v = acc[ai][bj][m][n]; const int col = col0 + bj * HALF + n * 16;
                        if (kind != 2) *(f32x4*)(of + (size_t)row * 1024 + col) = v;
                        if (kind != 1) { u32x2 w; w.x = cvt_pk_bf16(v[0], v[1]); w.y = cvt_pk_bf16(v[2], v[3]); *(u32x2*)(ob + (size_t)row * ldb_ + col) = w; } } }
    }
};
struct EpiSoftmax {
    static constexpr bool PERM = true;
    bf16_t* O; int ldc; int smp;
    __device__ __forceinline__ void operator()(f32x4 (&acc)[2][2][4][2], const Unit& u, int wr, int wc, int fr, int fq, LAS unsigned char* lds) const {
        asm volatile("" : "+v"(fr), "+v"(fq)); asm volatile("" : "+s"(wr), "+s"(wc));
        LAS f32x2* EX = (LAS f32x2*)(lds + LDS_EX);
        const int lane = fq * 16 + fr;
        const float L2E = 1.4426950408889634f;
#pragma unroll
        for (int ai = 0; ai < 2; ++ai)
#pragma unroll
            for (int m = 0; m < 4; ++m) {
                float mx = -3.0e38f;
#pragma unroll
                for (int bj = 0; bj < 2; ++bj)
#pragma unroll
                    for (int n = 0; n < 2; ++n) { const f32x4 x = acc[ai][bj][m][n]; mx = fmaxf(mx, fmaxf(fmaxf(x[0], x[1]), fmaxf(x[2], x[3]))); }
                mx = fmaxf(mx, shx(mx, 16, lane)); mx = fmaxf(mx, shx(mx, 32, lane));
                float s = 0.f;
#pragma unroll
                for (int bj = 0; bj < 2; ++bj)
#pragma unroll
                    for (int n = 0; n < 2; ++n) { f32x4 x = acc[ai][bj][m][n];
#pragma unroll
                        for (int j = 0; j < 4; ++j) { x[j] = __builtin_amdgcn_exp2f((x[j] - mx) * L2E); s += x[j]; }
                        acc[ai][bj][m][n] = x; }
                s += shx(s, 16, lane); s += shx(s, 32, lane);
                if (fq == 0) EX[(ai * HALF + wr * 64 + m * 16 + fr) * 4 + wc] = (f32x2){mx, s};
            }
        asm volatile("s_waitcnt lgkmcnt(0)" ::: "memory"); __builtin_amdgcn_s_barrier(); asm volatile("" ::: "memory");
        int colb = u.pn * BM, j_ = 0;
        if (smp) { colb = (u.pn & 3) * 2048 + (u.pn >> 2) * 256; j_ = u.pn >> 2; }
        const int col0 = colb + wc * 32 + 8 * fq;
#pragma unroll
        for (int ai = 0; ai < 2; ++ai)
#pragma unroll
            for (int m = 0; m < 4; ++m) {
                const int rl = ai * HALF + wr * 64 + m * 16 + fr;
                const f32x2 e0 = EX[rl * 4 + 0], e1 = EX[rl * 4 + 1], e2 = EX[rl * 4 + 2], e3 = EX[rl * 4 + 3];
                const float M = fmaxf(fmaxf(e0.x, e1.x), fmaxf(e2.x, e3.x));
                const float tot = e0.y * __builtin_amdgcn_exp2f((e0.x - M) * L2E) + e1.y * __builtin_amdgcn_exp2f((e1.x - M) * L2E) + e2.y * __builtin_amdgcn_exp2f((e2.x - M) * L2E) + e3.y * __builtin_amdgcn_exp2f((e3.x - M) * L2E);
                const float own = wc == 0 ? e0.x : (wc == 1 ? e1.x : (wc == 2 ? e2.x : e3.x));
                float f = __builtin_amdgcn_exp2f((own - M) * L2E) / tot;
                if (smp && (rl >> 5) != j_) f = 0.f;
                bf16_t* rowp = O + (size_t)(u.pm * BM + rl) * ldc + col0;
#pragma unroll
                for (int bj = 0; bj < 2; ++bj) { const f32x4 v0 = acc[ai][bj][m][0] * f, v1 = acc[ai][bj][m][1] * f;
                    u32x4 w; w.x = cvt_pk_bf16(v0[0], v0[1]); w.y = cvt_pk_bf16(v0[2], v0[3]); w.z = cvt_pk_bf16(v1[0], v1[1]); w.w = cvt_pk_bf16(v1[2], v1[3]);
                    *(u32x4*)(rowp + bj * HALF) = w; } }
    }
};

template <class Epi, class Sched, bool ALIGN_EPI>
__device__ __forceinline__ void gemm_phase(LAS unsigned char* lds, const Gemm g, const Sched& S, const Epi& E) {
    const int tid = opaque_tid(), wid = __builtin_amdgcn_readfirstlane(tid >> 6), lane = tid & 63, wr = wid >> 2, wc = wid & 3, fr = lane & 15, fq = lane >> 4;
    const int nt = g.K / BK;
    unsigned voffA[2], voffB[2];
#pragma unroll
    for (int i = 0; i < 2; ++i) { int R, C; stage_rc(tid * 16 + i * 8192, R, C); const int Rb = Epi::PERM ? ((R & ~31) + perm32(R & 31)) : R;
        voffA[i] = (unsigned)(R * g.lda + C) * 2u; voffB[i] = (unsigned)(Rb * g.ldb + C) * 2u; }
    const size_t kstep = (size_t)(BK * 2);
    const size_t hstepA = (size_t)HALF * g.lda * 2, hstepB = (size_t)HALF * g.ldb * 2;
    const unsigned ldsw = (unsigned)wid * 1024u;
    const int aoff = lds_byte(wr * 64 + fr, fq * 8), boff = lds_byte(wc * 32 + fr, fq * 8);
#define PG8_SA(b, h) (((b) * 2 + (h)) * HTB)
#define PG8_SB(b, h) ((4 + (b) * 2 + (h)) * HTB)
#define PG8_STAGE(bufoff, gbase, voff) do { _Pragma("unroll") for (int _i = 0; _i < 2; ++_i) \
        __builtin_amdgcn_global_load_lds((const unsigned*)((const char*)(gbase) + (voff)[_i]), (LAS unsigned*)(lds + (bufoff) + ldsw + _i * 8192), 16, 0, 0); } while (0)
#define PG8_LDA(dst, b, h) do { _Pragma("unroll") for (int m = 0; m < 4; ++m) _Pragma("unroll") for (int k = 0; k < 2; ++k) dst[m][k] = *(const LAS bf16x8*)(lds + PG8_SA(b, h) + aoff + m * 2048 + k * 1024); } while (0)
#define PG8_LDB(dst, b, h) do { _Pragma("unroll") for (int n = 0; n < 2; ++n) _Pragma("unroll") for (int k = 0; k < 2; ++k) dst[n][k] = *(const LAS bf16x8*)(lds + PG8_SB(b, h) + boff + n * 2048 + k * 1024); } while (0)
#define PG8_MMA(ai, bj, At, Bt) do { __builtin_amdgcn_s_setprio(1); _Pragma("unroll") for (int m = 0; m < 4; ++m) _Pragma("unroll") for (int n = 0; n < 2; ++n) _Pragma("unroll") for (int k = 0; k < 2; ++k) \
        acc[ai][bj][m][n] = __builtin_amdgcn_mfma_f32_16x16x32_bf16(Bt[n][k], At[m][k], acc[ai][bj][m][n], 0, 0, 0); __builtin_amdgcn_s_setprio(0); } while (0)
#define PG8_WAIT_V(n) asm volatile("s_waitcnt vmcnt(" #n ")" ::: "memory")
#define PG8_WAIT_L(n) asm volatile("s_waitcnt lgkmcnt(" #n ")" ::: "memory")
#define PG8_BAR __builtin_amdgcn_s_barrier()
#define PG8_SCHED __builtin_amdgcn_sched_barrier(0)
    Unit cur, nxt; int ui = 0;
    if (!S.next(0, cur)) return;
    f32x4 acc[2][2][4][2];
#pragma unroll
    for (int a = 0; a < 2; ++a)
#pragma unroll
        for (int b = 0; b < 2; ++b)
#pragma unroll
            for (int m = 0; m < 4; ++m)
#pragma unroll
                for (int n = 0; n < 2; ++n) acc[a][b][m][n] = (f32x4){0.f, 0.f, 0.f, 0.f};
    bf16x8 At[4][2], B0[2][2], B1[2][2];
    const char* cA = (const char*)g.A + S.offA(cur); const char* cB = (const char*)g.Bt + S.offB(cur);
    PG8_STAGE(PG8_SB(0, 0), cB, voffB); PG8_STAGE(PG8_SB(0, 1), cB + hstepB, voffB); PG8_STAGE(PG8_SA(0, 0), cA, voffA); PG8_STAGE(PG8_SA(0, 1), cA + hstepA, voffA);
    if (wr == 1) PG8_BAR;
    PG8_WAIT_V(2); PG8_BAR;
    PG8_STAGE(PG8_SB(1, 0), cB + kstep, voffB); PG8_STAGE(PG8_SA(1, 0), cA + kstep, voffA); PG8_STAGE(PG8_SB(1, 1), cB + hstepB + kstep, voffB);
    PG8_WAIT_V(6); PG8_BAR;
    for (;;) {
        const bool has_next = S.next(ui + 1, nxt);
        const char* nA = has_next ? (const char*)g.A + S.offA(nxt) : cA; const char* nB = has_next ? (const char*)g.Bt + S.offB(nxt) : cB;
        for (int t = 0; t < nt; t += 2) {
            const bool last = (t == nt - 2);
            const char* a1 = cA + (size_t)(t + 1) * kstep;
            const char* a2 = last ? nA : cA + (size_t)(t + 2) * kstep; const char* b2 = last ? nB : cB + (size_t)(t + 2) * kstep;
            const char* a3 = a2 + kstep; const char* b3 = b2 + kstep;
            PG8_LDB(B0, 0, 0); PG8_LDB(B1, 0, 1); PG8_SCHED; PG8_LDA(At, 0, 0); PG8_STAGE(PG8_SA(1, 1), a1 + hstepA, voffA);
            PG8_WAIT_V(8); PG8_WAIT_L(0); PG8_BAR; PG8_MMA(0, 0, At, B0); PG8_MMA(0, 1, At, B1); PG8_BAR; PG8_SCHED;
            PG8_LDA(At, 0, 1); PG8_STAGE(PG8_SB(0, 0), b2, voffB); PG8_STAGE(PG8_SB(0, 1), b2 + hstepB, voffB); PG8_STAGE(PG8_SA(0, 0), a2, voffA);
            PG8_WAIT_V(8); PG8_WAIT_L(0); PG8_BAR; PG8_MMA(1, 0, At, B0); PG8_MMA(1, 1, At, B1); PG8_BAR; PG8_SCHED;
            PG8_LDB(B0, 1, 0); PG8_LDB(B1, 1, 1); PG8_SCHED; PG8_LDA(At, 1, 0); PG8_STAGE(PG8_SA(0, 1), a2 + hstepA, voffA);
            PG8_WAIT_V(8); PG8_WAIT_L(0); PG8_BAR; PG8_MMA(0, 0, At, B0); PG8_MMA(0, 1, At, B1); PG8_BAR; PG8_SCHED;
            PG8_LDA(At, 1, 1); PG8_STAGE(PG8_SB(1, 0), b3, voffB); PG8_STAGE(PG8_SB(1, 1), b3 + hstepB, voffB); PG8_STAGE(PG8_SA(1, 0), a3, voffA);
            PG8_WAIT_V(8); PG8_WAIT_L(0); PG8_BAR; PG8_MMA(1, 0, At, B0); PG8_MMA(1, 1, At, B1); PG8_BAR; PG8_SCHED;
        }
        if constexpr (ALIGN_EPI) { if (wr == 0) PG8_BAR; }
        E(acc, cur, wr, wc, fr, fq, lds);
        if (!has_next) break;
#pragma unroll
        for (int a = 0; a < 2; ++a)
#pragma unroll
            for (int b = 0; b < 2; ++b)
#pragma unroll
                for (int m = 0; m < 4; ++m)
#pragma unroll
                    for (int n = 0; n < 2; ++n) acc[a][b][m][n] = (f32x4){0.f, 0.f, 0.f, 0.f};
        cur = nxt; cA = nA; cB = nB; ++ui;
        if constexpr (ALIGN_EPI) { if (wr == 1) PG8_BAR; }
    }
    PG8_WAIT_V(0);
    if constexpr (!ALIGN_EPI) { if (wr == 0) PG8_BAR; }
    PG8_BAR;
#undef PG8_SA
#undef PG8_SB
#undef PG8_STAGE
#undef PG8_LDA
#undef PG8_LDB
#undef PG8_MMA
#undef PG8_WAIT_V
#undef PG8_WAIT_L
#undef PG8_BAR
#undef PG8_SCHED
}
}

struct KVSched {
    int c, G; const char* ws;
    __device__ __forceinline__ bool next(int i, pg8::Unit& u) const {
        const int L = i * G + c; if (c < 0 || L >= 96) return false;
        const int kind = L >> 5, r = L & 31;
        if (kind < 2) { u.pm = kind * 16 + (r >> 2); u.pn = r & 3; } else { u.pm = 32 + (r >> 3); u.pn = r & 7; }
        return true;
    }
    __device__ __forceinline__ size_t offA(const pg8::Unit& u) const { const int kind = u.pm >> 4, pm = u.pm & 15; int k2 = (kind == 2); asm volatile("" : "+v"(k2));
        return (size_t)ws + WS_MEMB + (size_t)k2 * (WS_WV - WS_MEMB) + (size_t)pm * 256 * 1024 * 2; }
    __device__ __forceinline__ size_t offB(const pg8::Unit& u) const { const int kind = u.pm >> 4; int k1 = (kind == 1), k2 = (kind == 2); asm volatile("" : "+v"(k1), "+v"(k2));
        return (size_t)ws + WS_WK + (size_t)k1 * (WS_WV - WS_WK) + (size_t)k2 * (WS_MEMB - WS_WK) + (size_t)u.pn * 256 * 1024 * 2; }
};


#define XB_TMO      128
#define XB_XCNT(j)  (256  + 64 * (j))
#define XB_XSUB(j)  (1280 + 64 * (j))
#define XB_XGEN(j)  (2304 + 64 * (j))
#define XB_TOP      3328
#define XB_TOPGEN   3392
#define XCD_BAR_WORDS 3456
#define XB_SPIN_CAP (1u << 22)
__device__ __forceinline__ unsigned xb_ld(unsigned* p)              { return __hip_atomic_load(p, __ATOMIC_RELAXED, __HIP_MEMORY_SCOPE_AGENT); }
__device__ __forceinline__ unsigned xb_add(unsigned* p, unsigned v) { return __hip_atomic_fetch_add(p, v, __ATOMIC_RELAXED, __HIP_MEMORY_SCOPE_AGENT); }
__device__ __forceinline__ unsigned xb_xcc_id() { return (unsigned)__builtin_amdgcn_s_getreg((3 << 11) | 20) & 0xFu; }
#define XB_SPIN(cond, bar) do { unsigned _sp = 0; while (cond) { __builtin_amdgcn_s_sleep(1); \
    if ((++_sp & 255u) == 0u) { if (xb_ld(&(bar)[XB_TMO])) break; if (_sp > XB_SPIN_CAP) { atomicAdd(&(bar)[XB_TMO], 1u); break; } } } } while (0)
struct XcdBarrier { unsigned* bar; unsigned x; volatile LAS unsigned* st; };
__device__ __forceinline__ void xcd_barrier_complete(unsigned* bar, unsigned x, unsigned& nloc, unsigned& nx) {
    const unsigned G = gridDim.x * gridDim.y * gridDim.z;
    unsigned sum, cnt, mine, sp = 0u;
    for (;;) {
        sum = 0u; cnt = 0u; mine = 0u;
#pragma unroll
        for (unsigned j = 0; j < 16; ++j) { const unsigned c = xb_ld(&bar[XB_XCNT(j)]); sum += c; cnt += (c > 0u) ? 1u : 0u; mine = (j == x) ? c : mine; }
        if (sum == G) break;
        __builtin_amdgcn_s_sleep(1);
        if ((++sp & 255u) == 0u) { if (xb_ld(&bar[XB_TMO])) break; if (sp > XB_SPIN_CAP) { atomicAdd(&bar[XB_TMO], 1u); break; } }
    }
    nloc = mine > 0u ? mine : 1u; nx = cnt > 0u ? cnt : 1u;
}
__device__ __forceinline__ void xcd_barrier(const XcdBarrier& b) {
    asm volatile("s_waitcnt vmcnt(0)" ::: "memory");
    __syncthreads();
    if (threadIdx.x == 0) {
        unsigned* bar = b.bar;
        __builtin_amdgcn_s_waitcnt(0);
        unsigned nloc = b.st[0], nx = b.st[1];
        if (nloc == 0u) { xcd_barrier_complete(bar, b.x, nloc, nx); b.st[0] = nloc; b.st[1] = nx; }
        const unsigned old = xb_add(&bar[XB_XSUB(b.x)], 1u);
        const unsigned gen = old / nloc;
        if (old + 1u == (gen + 1u) * nloc) {
            __builtin_amdgcn_fence(__ATOMIC_RELEASE, "agent");
            asm volatile("s_waitcnt vmcnt(0)" ::: "memory");
            const unsigned og = xb_add(&bar[XB_TOP], 1u);
            const unsigned tg = og / nx;
            if (og + 1u == (tg + 1u) * nx) xb_add(&bar[XB_TOPGEN], 1u);
            else XB_SPIN(xb_ld(&bar[XB_TOPGEN]) == tg, bar);
            __builtin_amdgcn_fence(__ATOMIC_ACQUIRE, "agent");
            xb_add(&bar[XB_XGEN(b.x)], 1u);
            asm volatile("s_waitcnt vmcnt(0)" ::: "memory");
        } else {
            XB_SPIN(xb_ld(&bar[XB_XGEN(b.x)]) == gen, bar);
            __builtin_amdgcn_fence(__ATOMIC_ACQUIRE, "agent");
            asm volatile("s_waitcnt vmcnt(0)" ::: "memory");
        }
    }
    __syncthreads();
}

__device__ __forceinline__ void transpose_item(const float* W, int K, int N, bf16_t* WT, LAS float* scr, int item, int lane) {
    const int nblk = N / 32, kb = item / nblk, nb = item % nblk, k0 = 64 * kb, n0 = 32 * nb;
#pragma unroll 8
    for (int i = 0; i < 32; ++i) { const int kk = 2 * i + (lane >> 5); scr[kk * 33 + (lane & 31)] = W[(size_t)(k0 + kk) * N + n0 + (lane & 31)]; }
    LDS_WAIT();
    const int c = lane & 7;
#pragma unroll
    for (int j = 0; j < 4; ++j) { const int n = (lane >> 3) + 8 * j; const LAS float* s = scr + (8 * c) * 33 + n;
        u32x4 o; o.x = pk2(s[0 * 33], s[1 * 33]); o.y = pk2(s[2 * 33], s[3 * 33]); o.z = pk2(s[4 * 33], s[5 * 33]); o.w = pk2(s[6 * 33], s[7 * 33]);
        *(u32x4*)(WT + (size_t)(n0 + n) * K + k0 + 8 * c) = o; }
    LDS_WAIT();
}

__device__ __forceinline__ void norm_rows(const float* Xp, const float* Xs, const float* gain, bf16_t* XN, int gw, int NGW, int lane) {
    f32x4 gv[4];
#pragma unroll
    for (int j = 0; j < 4; ++j) gv[j] = ((const f32x4*)gain)[lane + 64 * j];
    for (int m = gw; m < MT; m += NGW) {
        const f32x4* xr = (const f32x4*)(m < MP ? Xp + (size_t)m * D : Xs + (size_t)(m - MP) * D) + lane;
        f32x4 v[4]; float s = 0.f;
#pragma unroll
        for (int j = 0; j < 4; ++j) { v[j] = xr[64 * j]; s += (v[j].x * v[j].x + v[j].y * v[j].y) + (v[j].z * v[j].z + v[j].w * v[j].w); }
        const float rstd = 1.0f / sqrtf(wave_sum(s, lane) * (1.f / D) + EPS);
        u32x2* o8 = (u32x2*)(XN + (size_t)m * D) + lane;
#pragma unroll
        for (int j = 0; j < 4; ++j) { u32x2 w; w.x = pk2(v[j].x * rstd * gv[j].x, v[j].y * rstd * gv[j].y); w.y = pk2(v[j].z * rstd * gv[j].z, v[j].w * rstd * gv[j].w); o8[64 * j] = w; }
    }
}


typedef __attribute__((address_space(4))) const unsigned char* kptr_t;
typedef const float* cfp_t; typedef float* fp_t; typedef unsigned char* ucp_t;
#define INP(k) (*(const __attribute__((address_space(4))) cfp_t*)(kp + 8 * (k)))
#define X out
#define WIN_T ((bf16_t*)(ws + WS_WIN))
#define WOUT_T ((bf16_t*)(ws + WS_WOUT))
#define WQ_T ((bf16_t*)(ws + WS_WQ))
#define WK_T ((bf16_t*)(ws + WS_WK))
#define WV_T ((bf16_t*)(ws + WS_WV))
#define WO_T ((bf16_t*)(ws + WS_WO))
#define WUP_T ((bf16_t*)(ws + WS_WUP))
#define WDN_T ((bf16_t*)(ws + WS_WDN))
#define MEMB ((bf16_t*)(ws + WS_MEMB))
#define KBP ((bf16_t*)(ws + WS_KBP))
#define VTP ((bf16_t*)(ws + WS_VTP))
#define KBS ((bf16_t*)(ws + WS_KBS))
#define VTS ((bf16_t*)(ws + WS_VTS))
#define WST ((bf16_t*)(ws + WS_WST))
#define AGG ((float*)(ws + WS_AGG))
#define GT_R ((bf16_t*)(ws + WS_GT))
#define GT_I ((bf16_t*)(ws + WS_GT + 65536))
#define XN ((bf16_t*)(ws + WS_XN))
#define gZ ((bf16_t*)(ws + B_Z))
#define HLOC ((float*)(ws + B_HLOC))
#define PCUM ((float*)(ws + B_PCUM))
#define gY ((bf16_t*)(ws + B_Y))
#define gQ ((bf16_t*)(ws + B_Q))
#define gP ((bf16_t*)(ws + B_P))
#define gO ((bf16_t*)(ws + B_O))
#define PS ((bf16_t*)(ws + B_PS))
#define GU ((bf16_t*)(ws + B_GU))
__global__ void __launch_bounds__(NTHREADS, 2) trunk_fwd(Args args) {
    extern __shared__ __attribute__((aligned(16))) unsigned char lds_raw[];
    LAS unsigned char* lds = (LAS unsigned char*)lds_raw;
    cg::grid_group grid = cg::this_grid();
#define LANE_STATE() int G = gridDim.x, bid = blockIdx.x; asm volatile("" : "+s"(G), "+s"(bid)); const int NGW = G * NWAVES, NGT = G * NTHREADS; (void)NGW; (void)NGT; \
    const int tid = opaque_tid(), lane = tid & 63, wave = __builtin_amdgcn_readfirstlane(tid >> 6); const int gw = bid * NWAVES + wave; const int gt = bid * NTHREADS + tid; (void)lane; (void)gw; (void)gt; \
    kptr_t kp = (kptr_t)__builtin_amdgcn_kernarg_segment_ptr(); asm volatile("" : "+s"(kp)); \
    float* const out = *(const __attribute__((address_space(4))) fp_t*)(kp + 8 * N_IN); unsigned char* const ws = *(const __attribute__((address_space(4))) ucp_t*)(kp + 8 * N_IN + 8); (void)out; (void)ws
    {
        LANE_STATE();
        if (bid == 0) for (int i = tid; i < XCD_BAR_WORDS; i += NTHREADS) __hip_atomic_store((unsigned*)(ws + WS_BAR) + i, 0u, __ATOMIC_RELAXED, __HIP_MEMORY_SCOPE_AGENT);
        if (tid < 32) ((LAS unsigned*)(lds + LDS_MISC))[tid] = 0u;
        __threadfence();
        grid.sync();
        if (tid == 0) (void)xb_add((unsigned*)(ws + WS_BAR) + XB_XCNT(xb_xcc_id()), 1u);
    }
#define GRID_SYNC() do { kptr_t kp_ = (kptr_t)__builtin_amdgcn_kernarg_segment_ptr(); asm volatile("" : "+s"(kp_)); \
        XcdBarrier b_; b_.bar = (unsigned*)(*(const __attribute__((address_space(4))) ucp_t*)(kp_ + 8 * N_IN + 8) + WS_BAR); b_.x = xb_xcc_id(); b_.st = (volatile LAS unsigned*)(lds + LDS_MISC); \
        xcd_barrier(b_); if (PROBE == 3) xcd_barrier(b_); } while (0)

    for (int l = 0; l < DEPTH; ++l) {
        for (int dup0 = 0; dup0 < (PROBE == 1 ? 2 : 1); ++dup0) {
        {
            LANE_STATE();
            LAS float* scr = (LAS float*)(lds + wave * 16384);
            const float* w_in = INP(I_WIN) + (size_t)l * D * INC; const float* w_out = INP(I_WOUT) + (size_t)l * D * D; const float* w_q = INP(I_WQ) + (size_t)l * D * D;
            const float* w_k = INP(I_WK) + (size_t)l * D * D; const float* w_v = INP(I_WV) + (size_t)l * D * D; const float* w_o = INP(I_WO) + (size_t)l * D * D;
            const float* w_up = INP(I_WUP) + (size_t)l * D * 2 * DFF; const float* w_dn = INP(I_WDN) + (size_t)l * DFF * D; const float* c_v = INP(I_CV) + (size_t)l * BS * NMEM * D;
            constexpr int T_IN = 16 * (INC / 32), T_SQ = 16 * 32, T_UP = 16 * (2 * DFF / 32), T_DN = (DFF / 64) * 32, T_CV = 32 * 32;
            constexpr int T_G = 16;
            constexpr int NIT = T_IN + 5 * T_SQ + T_UP + T_DN + T_CV + 2 * T_G;
            for (int it = gw; it < NIT; it += NGW) {
                int r = it;
                if (r < T_IN) { transpose_item(w_in, D, INC, WIN_T, scr, r, lane); continue; } r -= T_IN;
                if (r < T_SQ) { transpose_item(w_out, D, D, WOUT_T, scr, r, lane); continue; } r -= T_SQ;
                if (r < T_SQ) { transpose_item(w_q, D, D, WQ_T, scr, r, lane); continue; } r -= T_SQ;
                if (r < T_SQ) { transpose_item(w_k, D, D, WK_T, scr, r, lane); continue; } r -= T_SQ;
                if (r < T_SQ) { transpose_item(w_v, D, D, WV_T, scr, r, lane); continue; } r -= T_SQ;
                if (r < T_SQ) { transpose_item(w_o, D, D, WO_T, scr, r, lane); continue; } r -= T_SQ;
                if (r < T_UP) { transpose_item(w_up, D, 2 * DFF, WUP_T, scr, r, lane); continue; } r -= T_UP;
                if (r < T_DN) { transpose_item(w_dn, DFF, D, WDN_T, scr, r, lane); continue; } r -= T_DN;
                if (r < T_CV) { transpose_item(c_v, BS * NMEM, D, VTS, scr, r, lane); continue; } r -= T_CV;
                if (r < T_G) { transpose_item(INP(I_WRG) + ((size_t)l * 8 + (r >> 1)) * 4096, 64, 64, GT_R + (r >> 1) * 4096, scr, r & 1, lane); continue; } r -= T_G;
                transpose_item(INP(I_WIG) + ((size_t)l * 8 + (r >> 1)) * 4096, 64, 64, GT_I + (r >> 1) * 4096, scr, r & 1, lane);
            }
            {
                const f32x4* ck = (const f32x4*)(INP(I_CK) + (size_t)l * BS * NMEM * D); u32x2* dk = (u32x2*)KBS;
                for (int i = gt; i < BS * NMEM * D / 4; i += NGT) { const f32x4 v = ck[i]; u32x2 w; w.x = pk2(v.x, v.y); w.y = pk2(v.z, v.w); dk[i] = w; }
                if (l == 0) { const f32x4* mm = (const f32x4*)INP(I_MEM); u32x2* dm = (u32x2*)MEMB;
                    for (int i = gt; i < BP * NMEM * D / 4; i += NGT) { const f32x4 v = mm[i]; u32x2 w; w.x = pk2(v.x, v.y); w.y = pk2(v.z, v.w); dm[i] = w; } }
                const float* wsl = INP(I_WS) + (size_t)l * 4 * 128 * 128;
                for (int i = gt; i < 4 * 128 * 128; i += NGT) { const int s = i & 127, t = (i >> 7) & 127; WST[i] = (bf16_t)f2bf(s <= t ? wsl[i] : 0.f); }
            }
            norm_rows(l == 0 ? INP(I_XP) : X, l == 0 ? INP(I_XS) : X + (size_t)MP * D, INP(I_GMIX) + l * D, XN, gw, NGW, lane);
        }
        GRID_SYNC();
        }
        {
            LANE_STATE();
            KVSched S; S.G = G; S.c = bid >= 160 ? bid - 160 : -1; S.ws = (const char*)ws;
            pg8::Gemm g{(const bf16_t*)nullptr, (const bf16_t*)nullptr, D, D, D};
            pg8::EpiKV E{out + O_MKP + (size_t)l * BP * NMEM * D, out + O_MVP + (size_t)l * BP * NMEM * D, KBP, VTP};
            pg8::gemm_phase<pg8::EpiKV, KVSched, true>(lds, g, S, E);
        }
#define GEMM_BF16(s_) do { const int s = (s_); pg8::GSched S; pg8::Gemm g; pg8::EpiBf16 E; E.scale = 1.f; \
        if (s == 0) { S.init(MT / 256, INC / 256, G, bid); S.aPm = (size_t)256 * D * 2; S.bPn = (size_t)256 * D * 2; g = pg8::Gemm{XN, WIN_T, D, D, D}; E.O = gZ; E.ldc = INC; } \
        else if (s == 1) { S.init(MT / 256, D / 256, G, bid); S.aPm = (size_t)256 * D * 2; S.bPn = (size_t)256 * D * 2; g = pg8::Gemm{XN, WQ_T, D, D, D}; E.O = gQ; E.ldc = D; E.scale = 0.0625f; } \
        else if (s == 2) { S.init(MP / 256, 4, G, bid); S.aPm = (size_t)256 * D * 2; S.aPn = 512; S.bPn = (size_t)256 * 2048 * 2; S.bPm = 512; S.bShift = 4; g = pg8::Gemm{gP, VTP, D, 2048, 256}; E.O = gO; E.ldc = D; } \
        else if (s == 3) { S.init(1, 4, G, (bid + G - 8) % G); S.aPn = 4096; S.bPn = (size_t)256 * 2048 * 2; g = pg8::Gemm{PS, VTS, 8192, 2048, 2048}; E.O = gO + (size_t)MP * D; E.ldc = D; } \
        else { S.init(MT / 256, 2 * DFF / 256, G, bid); S.aPm = (size_t)256 * D * 2; S.bPn = (size_t)256 * D * 2; g = pg8::Gemm{XN, WUP_T, D, D, D}; E.O = GU; E.ldc = 2 * DFF; } \
        pg8::gemm_phase<pg8::EpiBf16, pg8::GSched, true>(lds, g, S, E); } while (0)
#define GEMM_RES(s_) do { const int s = (s_); pg8::GSched S; S.init(MT / 256, D / 256, G, bid); pg8::Gemm g; \
        if (s == 0) { g = pg8::Gemm{gY, WOUT_T, D, D, D}; S.aPm = (size_t)256 * D * 2; } \
        else if (s == 1) { g = pg8::Gemm{gO, WO_T, D, D, D}; S.aPm = (size_t)256 * D * 2; } \
        else { g = pg8::Gemm{GU + DFF, WDN_T, 2 * DFF, DFF, DFF}; S.aPm = (size_t)256 * 2 * DFF * 2; } \
        S.bPn = (size_t)256 * g.ldb * 2; \
        pg8::EpiResid E{(l == 0 && s == 0) ? INP(I_XP) : X, (l == 0 && s == 0) ? INP(I_XS) : X + (size_t)MP * D, X}; \
        pg8::gemm_phase<pg8::EpiResid, pg8::GSched, true>(lds, g, S, E); } while (0)

        for (int rep = 0; rep < 13; ++rep) {
          const int ndup = (PROBE == 1 && (rep == 1 || rep == 2 || rep == 4 || rep == 9)) ? 2 : ((PROBE == 2 && (rep == 0 || rep == 5 || rep == 6 || rep == 7 || rep == 10)) ? 2 : 1);
          for (int dup = 0; dup < ndup; ++dup) {
            if (rep == 0 || rep == 5 || rep == 7 || rep == 10) {
                LANE_STATE();
                const int s0 = rep == 0 ? 0 : (rep == 5 ? 1 : (rep == 7 ? 2 : 4)), ns = rep == 7 ? 2 : 1;
                for (int q = 0; q < ns; ++q) GEMM_BF16(s0 + q);
            } else if (rep == 1) {
                LANE_STATE();
                {
                    LAS bf16_t* vT = (LAS bf16_t*)lds;
                    constexpr int VP = 136;
                    const float* gvp = INP(I_GV) + l * CW; const float* bsp = INP(I_BSS) + l * 4 * 128;
                    for (int un = bid; un < 8 + 256; un += G) {
                        int rowbase, nrows, sb = -1;
                        if (un < 8) { sb = un; rowbase = MP + un * TS; nrows = TS; } else { rowbase = (un - 8) * 128; nrows = 128; }
                        {
                            const int rl = tid >> 5, cgp = tid & 31;
                            f32x4 g0 = *(const f32x4*)(gvp + cgp * 8), g1 = *(const f32x4*)(gvp + cgp * 8 + 4);
                            for (int p = 0; p < nrows / 16; ++p) {
                                const int r = p * 16 + rl;
                                const u32x4 raw = *(const u32x4*)(gZ + (size_t)(rowbase + r) * INC + Z_VC + cgp * 8);
                                float v[8] = {bflo(raw.x), bfhi(raw.x), bflo(raw.y), bfhi(raw.y), bflo(raw.z), bfhi(raw.z), bflo(raw.w), bfhi(raw.w)};
                                float ss = 0.f;
#pragma unroll
                                for (int k = 0; k < 8; ++k) { v[k] = gelu_t(v[k]); ss += v[k] * v[k]; }
                                ss += shx(ss, 1, lane); ss += shx(ss, 2, lane); ss += shx(ss, 4, lane);
                                const float rstd = 1.0f / sqrtf(ss * (1.f / 64.f) + EPS);
                                const float gg[8] = {g0.x, g0.y, g0.z, g0.w, g1.x, g1.y, g1.z, g1.w};
#pragma unroll
                                for (int k = 0; k < 8; ++k) { v[k] = v[k] * rstd * gg[k]; vT[(cgp * 8 + k) * VP + r] = (bf16_t)f2bf(v[k]); }
                                if (sb >= 0) { float* vo = out + O_VCS + ((size_t)(l * BS + sb) * TS + r) * CW + cgp * 8;
                                    *(f32x4*)vo = (f32x4){v[0], v[1], v[2], v[3]}; *(f32x4*)(vo + 4) = (f32x4){v[4], v[5], v[6], v[7]}; }
                            }
                        }
                        __syncthreads();
                        {
                            const int hh = wave & 3, rh = wave >> 2, fr = lane & 15, fq = lane >> 4;
                            const int nmt = nrows == 128 ? 4 : (rh == 0 ? 2 : 0);
                            for (int mi = 0; mi < nmt; ++mi) {
                                const int mt = rh * 4 + mi, nks = (mt * 16 + 15) / 32 + 1;
                                f32x4 acc[4];
#pragma unroll
                                for (int n = 0; n < 4; ++n) acc[n] = (f32x4){0.f, 0.f, 0.f, 0.f};
                                for (int ks = 0; ks < nks; ++ks) {
                                    const bf16x8 a = *(const bf16x8*)(WST + ((size_t)(hh * 128 + mt * 16 + fr) * 128 + ks * 32 + fq * 8));
#pragma unroll
                                    for (int n = 0; n < 4; ++n) { const bf16x8 b = *(const LAS bf16x8*)(vT + (hh * 64 + n * 16 + fr) * VP + ks * 32 + fq * 8);
                                        acc[n] = __builtin_amdgcn_mfma_f32_16x16x32_bf16(a, b, acc[n], 0, 0, 0); }
                                }
#pragma unroll
                                for (int j = 0; j < 4; ++j) { const int t = mt * 16 + fq * 4 + j; const float bias = bsp[hh * 128 + t]; const size_t row = (size_t)(rowbase + t);
#pragma unroll
                                    for (int n = 0; n < 4; ++n) { const int c = hh * 64 + n * 16 + fr; const float u = gelu_t(bf2f(gZ[row * INC + Z_UC + c]));
                                        gY[row * D + 768 + c] = (bf16_t)f2bf(u * (acc[n][j] + bias)); } }
                            }
                        }
                        __syncthreads();
                    }
                }
                {
                    LAS unsigned char* wl = lds + wave * 16384;
                    LAS bf16_t* tile = (LAS bf16_t*)wl;
                    LAS float* pre_r = (LAS float*)(wl + 2560);
                    LAS float* pre_i = (LAS float*)(wl + 2560 + 4096);
                    LAS float* xcf = (LAS float*)(wl + 2560 + 8192);
                    const int fr = lane & 15, fq = lane >> 4;
                    for (int un = gw; un < 64 + 2048; un += NGW) {
                        int b, hd, rowbase, nrows, t0; bool smp = un < 64;
                        if (smp) { b = un >> 3; hd = un & 7; rowbase = MP + b * TS; nrows = TS; t0 = 0; }
                        else { const int v = un - 64; const int ch = v & 31; hd = (v >> 5) & 7; b = v >> 8; t0 = ch * 128; rowbase = b * SEQ + t0; nrows = 128; }
                        const int cidx = l * AW + hd * 64 + lane;
                        const float br = INP(I_BRG)[cidx], bi = INP(I_BIG)[cidx];
                        const float c8sp = 8.0f * log1pf(__expf(-INP(I_LAM)[cidx]));
                        const float* caw = INP(I_CAW) + (size_t)l * 4 * AW + hd * 64 + lane;
                        const float cw0 = caw[0], cw1 = caw[AW], cw2 = caw[2 * AW], cw3 = caw[3 * AW], cb = INP(I_CAB)[cidx];
                        bf16x8 bR[4][2], bI[4][2];
#pragma unroll
                        for (int n = 0; n < 4; ++n)
#pragma unroll
                            for (int ks = 0; ks < 2; ++ks) { const size_t o_ = (size_t)(hd * 64 + n * 16 + fr) * 64 + ks * 32 + fq * 8;
                                bR[n][ks] = *(const bf16x8*)(GT_R + o_); bI[n][ks] = *(const bf16x8*)(GT_I + o_); }
                        float xm3 = 0.f, xm2 = 0.f, xm1 = 0.f;
                        if (smp) { const float* st = INP(I_SCA) + ((size_t)(l * BS + b) * 3) * AW + hd * 64 + lane; xm3 = st[0]; xm2 = st[AW]; xm1 = st[2 * AW]; }
                        else if (t0 > 0) { const bf16_t* zp = gZ + (size_t)(rowbase - 3) * INC + Z_XA + hd * 64 + lane; xm3 = bf2f(zp[0]); xm2 = bf2f(zp[INC]); xm1 = bf2f(zp[2 * INC]); }
                        float h = 0.f, pc = 1.f;
                        const bf16_t* zp = gZ + (size_t)rowbase * INC + Z_XA + hd * 64 + lane;
                        float* hp = HLOC + (size_t)rowbase * AW + hd * 64 + lane; float* pp = PCUM + (size_t)rowbase * AW + hd * 64 + lane;
                        for (int st = 0; st < nrows / 16; ++st) {
#pragma unroll 4
                            for (int i = 0; i < 16; ++i) { const float xv = bf2f(*zp); zp += INC;
                                const float xc = cw0 * xm3 + cw1 * xm2 + cw2 * xm1 + cw3 * xv + cb; xm3 = xm2; xm2 = xm1; xm1 = xv; xcf[i * 64 + lane] = xc; tile[i * 72 + lane] = (bf16_t)f2bf(xc); }
                            LDS_WAIT();
                            const bf16x8 a0 = *(const LAS bf16x8*)(tile + fr * 72 + fq * 8), a1 = *(const LAS bf16x8*)(tile + fr * 72 + 32 + fq * 8);
#pragma unroll
                            for (int n = 0; n < 4; ++n) {
                                f32x4 ar = (f32x4){0.f, 0.f, 0.f, 0.f}, ai = (f32x4){0.f, 0.f, 0.f, 0.f};
                                ar = __builtin_amdgcn_mfma_f32_16x16x32_bf16(a0, bR[n][0], ar, 0, 0, 0); ar = __builtin_amdgcn_mfma_f32_16x16x32_bf16(a1, bR[n][1], ar, 0, 0, 0);
                                ai = __builtin_amdgcn_mfma_f32_16x16x32_bf16(a0, bI[n][0], ai, 0, 0, 0); ai = __builtin_amdgcn_mfma_f32_16x16x32_bf16(a1, bI[n][1], ai, 0, 0, 0);
#pragma unroll
                                for (int j = 0; j < 4; ++j) { pre_r[(fq * 4 + j) * 64 + n * 16 + fr] = ar[j]; pre_i[(fq * 4 + j) * 64 + n * 16 + fr] = ai[j]; }
                            }
                            LDS_WAIT();
#pragma unroll 4
                            for (int i = 0; i < 16; ++i) {
                                const float r = sigm(pre_r[i * 64 + lane] + br), gi = sigm(pre_i[i * 64 + lane] + bi);
                                const float la = -c8sp * r, a = __expf(la), bm = sqrtf(-expm1f(2.0f * la));
                                h = a * h + bm * gi * xcf[i * 64 + lane]; pc = pc * a;
                                *hp = h; *pp = pc; hp += AW; pp += AW;
                            }
                            LDS_WAIT();
                        }
                        AGG[(size_t)un * 128 + lane] = pc; AGG[(size_t)un * 128 + 64 + lane] = h;
                    }
                }
                {
                    const float* cbw = INP(I_CBW) + (size_t)l * 3 * BW;
                    for (int it = gt; it < (MT / 16) * 32; it += NGT) {
                        const int rb = it >> 5, c0 = (it & 31) * 8;
                        int b, t0, T, rowbase; bool smp = rb >= MP / 16;
                        if (!smp) { b = rb >> 8; t0 = (rb & 255) * 16; T = SEQ; rowbase = rb * 16; } else { const int sbk = rb - MP / 16; b = sbk >> 1; t0 = (sbk & 1) * 16; T = TS; rowbase = MP + sbk * 16; }
                        float w0[8], w1[8], w2[8], pm2[8], pm1[8];
#pragma unroll
                        for (int k = 0; k < 8; ++k) { w0[k] = cbw[c0 + k]; w1[k] = cbw[BW + c0 + k]; w2[k] = cbw[2 * BW + c0 + k]; pm2[k] = 0.f; pm1[k] = 0.f; }
                        if (t0 == 0) { if (smp) { const float* st = INP(I_SCB) + ((size_t)(l * BS + b) * 2) * BW + c0;
#pragma unroll
                                for (int k = 0; k < 8; ++k) { pm2[k] = st[k]; pm1[k] = st[BW + k]; } } }
                        else {
#pragma unroll
                            for (int rr = 0; rr < 2; ++rr) { const bf16_t* zr = gZ + (size_t)(rowbase - 2 + rr) * INC; const u32x4 xb = *(const u32x4*)(zr + Z_XB + c0), gc = *(const u32x4*)(zr + Z_GC + c0);
                                float pv[8] = {bflo(xb.x) * bflo(gc.x), bfhi(xb.x) * bfhi(gc.x), bflo(xb.y) * bflo(gc.y), bfhi(xb.y) * bfhi(gc.y), bflo(xb.z) * bflo(gc.z), bfhi(xb.z) * bfhi(gc.z), bflo(xb.w) * bflo(gc.w), bfhi(xb.w) * bfhi(gc.w)};
#pragma unroll
                                for (int k = 0; k < 8; ++k) { if (rr == 0) pm2[k] = pv[k]; else pm1[k] = pv[k]; } }
                        }
                        for (int i = 0; i < 16; ++i) {
                            const bf16_t* zr = gZ + (size_t)(rowbase + i) * INC; const u32x4 xb = *(const u32x4*)(zr + Z_XB + c0), gc = *(const u32x4*)(zr + Z_GC + c0), gb = *(const u32x4*)(zr + Z_GB + c0);
                            const float pv[8] = {bflo(xb.x) * bflo(gc.x), bfhi(xb.x) * bfhi(gc.x), bflo(xb.y) * bflo(gc.y), bfhi(xb.y) * bfhi(gc.y), bflo(xb.z) * bflo(gc.z), bfhi(xb.z) * bfhi(gc.z), bflo(xb.w) * bflo(gc.w), bfhi(xb.w) * bfhi(gc.w)};
                            const float gbv[8] = {bflo(gb.x), bfhi(gb.x), bflo(gb.y), bfhi(gb.y), bflo(gb.z), bfhi(gb.z), bflo(gb.w), bfhi(gb.w)};
                            float yv[8];
#pragma unroll
                            for (int k = 0; k < 8; ++k) { yv[k] = gbv[k] * (w0[k] * pm2[k] + w1[k] * pm1[k] + w2[k] * pv[k]); pm2[k] = pm1[k]; pm1[k] = pv[k]; }
                            u32x4 w; w.x = pk2(yv[0], yv[1]); w.y = pk2(yv[2], yv[3]); w.z = pk2(yv[4], yv[5]); w.w = pk2(yv[6], yv[7]);
                            *(u32x4*)(gY + (size_t)(rowbase + i) * D + 512 + c0) = w;
                        }
                        if (t0 + 16 == T) { float* o = out + (smp ? O_CBS : O_CBP) + ((size_t)(l * 8 + b) * 2) * BW + c0;
#pragma unroll
                            for (int k = 0; k < 8; ++k) { o[k] = pm2[k]; o[BW + k] = pm1[k]; } }
                    }
                }
            } else if (rep == 2) {
                LANE_STATE();
                for (int un = gw; un < 64 + 2048; un += NGW) {
                    int b, hd, rowbase, nrows, ch = 0; bool smp = un < 64;
                    if (smp) { b = un >> 3; hd = un & 7; rowbase = MP + b * TS; nrows = TS; }
                    else { const int v = un - 64; ch = v & 31; hd = (v >> 5) & 7; b = v >> 8; rowbase = b * SEQ + ch * 128; nrows = 128; }
                    const int c = hd * 64 + lane;
                    float carry = 0.f;
                    if (smp) carry = INP(I_SHA)[(size_t)(l * BS + b) * AW + c];
                    else { const float* ag = AGG + (size_t)(un - ch) * 128 + lane; for (int k = 0; k < ch; ++k) carry = ag[(size_t)k * 128] * carry + ag[(size_t)k * 128 + 64]; }
                    float hl = 0.f;
                    for (int i = 0; i < nrows; ++i) { const size_t row = (size_t)(rowbase + i);
                        hl = HLOC[row * AW + c] + PCUM[row * AW + c] * carry;
                        gY[row * D + c] = (bf16_t)f2bf(gelu_t(bf2f(gZ[row * INC + Z_GA + c])) * hl); }
                    if (smp || ch == 31) {
                        out[(smp ? O_HAS : O_HAP) + (size_t)(l * 8 + b) * AW + c] = hl;
                        float* o = out + (smp ? O_CAS : O_CAP) + ((size_t)(l * 8 + b) * 3) * AW + c;
#pragma unroll
                        for (int k = 0; k < 3; ++k) o[k * AW] = bf2f(gZ[(size_t)(rowbase + nrows - 3 + k) * INC + Z_XA + c]);
                    }
                }
            } else if (rep == 3 || rep == 8 || rep == 12) {
                LANE_STATE();
                GEMM_RES(rep == 3 ? 0 : (rep == 8 ? 1 : 2));
            } else if (rep == 4 || rep == 9) {
                LANE_STATE();
                norm_rows(X, X + (size_t)MP * D, (rep == 4 ? INP(I_GX) : INP(I_GFFN)) + l * D, XN, gw, NGW, lane);
            } else if (rep == 6) {
                LANE_STATE();
                for (int sub = 0; sub < 2; ++sub) {
                    pg8::GSched S; pg8::Gemm g; pg8::EpiSoftmax E;
                    if (sub == 0) { S.init(MP / 256, 4, G, bid); S.aPm = (size_t)256 * D * 2; S.aPn = 512; S.bPn = 512; S.bPm = (size_t)256 * D * 2; S.bShift = 4; g = pg8::Gemm{gQ, KBP, D, D, 256}; E.O = gP; E.ldc = D; E.smp = 0; }
                    else { S.init(1, 32, G, (bid + G - 64) % G); S.mode = 1; g = pg8::Gemm{gQ + (size_t)MP * D, KBS, D, D, 256}; E.O = PS; E.ldc = 8192; E.smp = 1; }
                    pg8::gemm_phase<pg8::EpiSoftmax, pg8::GSched, true>(lds, g, S, E);
                }
            } else if (rep == 11) {
                LANE_STATE();
        {
            const float* cfw = INP(I_CFW) + (size_t)l * 3 * DFF;
            for (int it = gt; it < (MT / 16) * (DFF / 8); it += NGT) {
                const int rb = it / (DFF / 8), c0 = (it % (DFF / 8)) * 8;
                int b, t0, T, rowbase; bool smp = rb >= MP / 16;
                if (!smp) { b = rb >> 8; t0 = (rb & 255) * 16; T = SEQ; rowbase = rb * 16; } else { const int sbk = rb - MP / 16; b = sbk >> 1; t0 = (sbk & 1) * 16; T = TS; rowbase = MP + sbk * 16; }
                float w0[8], w1[8], w2[8], gm2[8], gm1[8];
#pragma unroll
                for (int k = 0; k < 8; ++k) { w0[k] = cfw[c0 + k]; w1[k] = cfw[DFF + c0 + k]; w2[k] = cfw[2 * DFF + c0 + k]; gm2[k] = 0.f; gm1[k] = 0.f; }
                if (t0 == 0) { if (smp) { const float* st = INP(I_SCF) + ((size_t)(l * BS + b) * 2) * DFF + c0;
#pragma unroll
                        for (int k = 0; k < 8; ++k) { gm2[k] = st[k]; gm1[k] = st[DFF + k]; } } }
                else {
                    const u32x4 ga = *(const u32x4*)(GU + (size_t)(rowbase - 2) * (2 * DFF) + c0), gb = *(const u32x4*)(GU + (size_t)(rowbase - 1) * (2 * DFF) + c0);
                    const float a_[8] = {bflo(ga.x), bfhi(ga.x), bflo(ga.y), bfhi(ga.y), bflo(ga.z), bfhi(ga.z), bflo(ga.w), bfhi(ga.w)};
                    const float b_[8] = {bflo(gb.x), bfhi(gb.x), bflo(gb.y), bfhi(gb.y), bflo(gb.z), bfhi(gb.z), bflo(gb.w), bfhi(gb.w)};
#pragma unroll
                    for (int k = 0; k < 8; ++k) { gm2[k] = a_[k]; gm1[k] = b_[k]; }
                }
                for (int i = 0; i < 16; ++i) {
                    bf16_t* gr = GU + (size_t)(rowbase + i) * (2 * DFF) + c0;
                    const u32x4 gq = *(const u32x4*)gr, uq = *(const u32x4*)(gr + DFF);
                    const float gv[8] = {bflo(gq.x), bfhi(gq.x), bflo(gq.y), bfhi(gq.y), bflo(gq.z), bfhi(gq.z), bflo(gq.w), bfhi(gq.w)};
                    const float uv[8] = {bflo(uq.x), bfhi(uq.x), bflo(uq.y), bfhi(uq.y), bflo(uq.z), bfhi(uq.z), bflo(uq.w), bfhi(uq.w)};
                    float hv[8];
#pragma unroll
                    for (int k = 0; k < 8; ++k) { const float cv = w0[k] * gm2[k] + w1[k] * gm1[k] + w2[k] * gv[k]; hv[k] = silu(cv) * uv[k]; gm2[k] = gm1[k]; gm1[k] = gv[k]; }
                    u32x4 w; w.x = pk2(hv[0], hv[1]); w.y = pk2(hv[2], hv[3]); w.z = pk2(hv[4], hv[5]); w.w = pk2(hv[6], hv[7]);
                    *(u32x4*)(gr + DFF) = w;
                }
                if (t0 + 16 == T) { float* o = out + (smp ? O_CFS : O_CFP) + ((size_t)(l * 8 + b) * 2) * DFF + c0;
#pragma unroll
                    for (int k = 0; k < 8; ++k) { o[k] = gm2[k]; o[DFF + k] = gm1[k]; } }
            }
        }
            }
            GRID_SYNC();
          }
        }
    }
    {
        LANE_STATE();
        const float* gain = INP(I_GFIN);
        f32x4 gv[4];
#pragma unroll
        for (int j = 0; j < 4; ++j) gv[j] = ((const f32x4*)gain)[lane + 64 * j];
        for (int m = gw; m < MT; m += NGW) {
            f32x4* xr = (f32x4*)(X + (size_t)m * D) + lane;
            f32x4 v[4]; float s = 0.f;
#pragma unroll
            for (int j = 0; j < 4; ++j) { v[j] = xr[64 * j]; s += (v[j].x * v[j].x + v[j].y * v[j].y) + (v[j].z * v[j].z + v[j].w * v[j].w); }
            const float rstd = 1.0f / sqrtf(wave_sum(s, lane) * (1.f / D) + EPS);
#pragma unroll
            for (int j = 0; j < 4; ++j) xr[64 * j] = v[j] * rstd * gv[j];
        }
    }
}

extern "C" void kernel_launch(void* const* d_in, const int* in_sizes, int n_in, void* d_out, int out_size, void* d_ws, size_t ws_size, hipStream_t stream) {
    static int grid = 0;
    if (grid == 0) {
        if (n_in != N_IN || (size_t)out_size != O_END || ws_size < WS_END) { fprintf(stderr, "kernel_launch: unexpected sizes n_in %d out %d ws %zu (need %zu)\n", n_in, out_size, ws_size, (size_t)WS_END); grid = -1; return; }
        int dev = 0, cus = 0, per_cu = 0;
        (void)hipGetDevice(&dev); (void)hipDeviceGetAttribute(&cus, hipDeviceAttributeMultiprocessorCount, dev);
        if (hipFuncSetAttribute((const void*)trunk_fwd, hipFuncAttributeMaxDynamicSharedMemorySize, LDS_BYTES) != hipSuccess) { fprintf(stderr, "kernel_launch: hipFuncSetAttribute failed\n"); grid = -1; return; }
        if (hipOccupancyMaxActiveBlocksPerMultiprocessor(&per_cu, (const void*)trunk_fwd, NTHREADS, LDS_BYTES) != hipSuccess || per_cu < 1) { fprintf(stderr, "kernel_launch: occupancy query gave %d\n", per_cu); per_cu = 1; }
        (void)hipGetLastError();
        grid = cus * 1;
        if (grid != 256) fprintf(stderr, "kernel_launch: note: %d CUs\n", grid);
    }
    if (grid < 0) return;
    Args a{};
    for (int i = 0; i < N_IN; ++i) a.in[i] = (const float*)d_in[i];
    a.out = (float*)d_out; a.ws = (unsigned char*)d_ws;
    void* kargs[] = {&a};
    hipError_t e = hipLaunchCooperativeKernel((const void*)trunk_fwd, dim3(grid), dim3(NTHREADS), kargs, LDS_BYTES, stream);
    if (e != hipSuccess) fprintf(stderr, "kernel_launch: cooperative launch failed: %s (grid %d)\n", hipGetErrorString(e), grid);
}
```

```cpp
#include <hip/hip_runtime.h>
#include <hip/hip_cooperative_groups.h>
#include <cstdio>
#include <cstdint>
namespace cg = cooperative_groups;
#ifndef PROBE
#define PROBE 0
#endif

#define LAS __attribute__((address_space(3)))
typedef unsigned short bf16_t;
typedef short bf16x8 __attribute__((ext_vector_type(8)));
typedef float f32x4 __attribute__((ext_vector_type(4)));
typedef float f32x2 __attribute__((ext_vector_type(2)));
typedef unsigned u32x4 __attribute__((ext_vector_type(4)));
typedef unsigned u32x2 __attribute__((ext_vector_type(2)));

constexpr int D = 1024, BP = 8, SEQ = 4096, BS = 8, TS = 32, DEPTH = 2;
constexpr int MP = BP * SEQ, MS = BS * TS, MT = MP + MS;
constexpr int INC = 2304, DFF = 2816, NMEM = 256, AW = 512, BW = 256, CW = 256;
constexpr int Z_XA = 0, Z_GA = 512, Z_XB = 1024, Z_GB = 1280, Z_GC = 1536, Z_UC = 1792, Z_VC = 2048;
constexpr float EPS = 1e-6f;
constexpr int NWAVES = 8, NTHREADS = 512;

constexpr size_t O_YP = 0, O_YS = O_YP + (size_t)MP * D, O_CAP = O_YS + (size_t)MS * D, O_HAP = O_CAP + DEPTH * BP * 3 * AW,
                 O_CBP = O_HAP + DEPTH * BP * AW, O_CFP = O_CBP + DEPTH * BP * 2 * BW, O_MKP = O_CFP + DEPTH * BP * 2 * DFF,
                 O_MVP = O_MKP + (size_t)DEPTH * BP * NMEM * D, O_CAS = O_MVP + (size_t)DEPTH * BP * NMEM * D, O_HAS = O_CAS + DEPTH * BS * 3 * AW,
                 O_CBS = O_HAS + DEPTH * BS * AW, O_CFS = O_CBS + DEPTH * BS * 2 * BW, O_VCS = O_CFS + DEPTH * BS * 2 * DFF,
                 O_END = O_VCS + DEPTH * BS * TS * CW;

constexpr size_t MiB = 1u << 20;
constexpr size_t WS_WIN = 0, WS_WOUT = 5 * MiB, WS_WQ = 7 * MiB, WS_WK = 9 * MiB, WS_WV = 11 * MiB, WS_WO = 13 * MiB, WS_WUP = 15 * MiB, WS_WDN = 26 * MiB;
constexpr size_t WS_MEMB = 32 * MiB, WS_KBP = 36 * MiB, WS_VTP = 40 * MiB, WS_KBS = 44 * MiB, WS_VTS = 48 * MiB, WS_WST = 52 * MiB, WS_GT = WS_WST + 131072, WS_AGG = 53 * MiB, WS_SS = 54 * MiB + 256 * 1024, WS_BAR = 55 * MiB + 512 * 1024;
constexpr size_t WS_XN = 56 * MiB, WS_BIG = 121 * MiB;
constexpr size_t B_Z = WS_BIG, B_HLOC = WS_BIG + 146 * MiB, B_PCUM = WS_BIG + 211 * MiB, B_Y = WS_BIG + 276 * MiB;
constexpr size_t B_Q = WS_BIG, B_P = WS_BIG + 65 * MiB, B_O = WS_BIG + 130 * MiB, B_PS = WS_BIG + 195 * MiB;
constexpr size_t B_GU = WS_BIG;
constexpr size_t WS_END = WS_BIG + (size_t)MT * 2 * DFF * 2;
constexpr size_t WS_SSP = 476 * MiB;
static_assert(WS_END <= WS_SSP && WS_SSP + (size_t)7 * MT * 64 <= 512 * MiB, "workspace");
static_assert(WS_XN + (size_t)MT * D * 2 <= WS_BIG, "xn");

constexpr int LDS_RING = 131072, LDS_EX = LDS_RING, LDS_MISC = LDS_EX + 8192, LDS_BYTES = 147456;

enum { I_XP = 0, I_XS, I_MEM, I_CK, I_CV, I_SCA, I_SHA, I_SCB, I_SCF, I_GMIX, I_WIN, I_CAW, I_CAB, I_WRG, I_BRG, I_WIG, I_BIG, I_LAM, I_CBW, I_GV, I_WS, I_BSS,
       I_WOUT, I_GX, I_WQ, I_WK, I_WV, I_WO, I_GFFN, I_WUP, I_CFW, I_WDN, I_GFIN, N_IN };

struct Args { const float* in[N_IN]; float* out; unsigned char* ws; };

__device__ __forceinline__ unsigned f2bf(float f) { unsigned u = __builtin_bit_cast(unsigned, f); return (u + 0x7fffu + ((u >> 16) & 1u)) >> 16; }
__device__ __forceinline__ unsigned pk2(float lo, float hi) { return f2bf(lo) | (f2bf(hi) << 16); }
__device__ __forceinline__ float bf2f(unsigned v) { return __builtin_bit_cast(float, v << 16); }
__device__ __forceinline__ float bflo(unsigned w) { return __builtin_bit_cast(float, w << 16); }
__device__ __forceinline__ float bfhi(unsigned w) { return __builtin_bit_cast(float, w & 0xffff0000u); }
__device__ __forceinline__ unsigned cvt_pk_bf16(float lo, float hi) { unsigned r; asm volatile("v_cvt_pk_bf16_f32 %0, %1, %2" : "=v"(r) : "v"(lo), "v"(hi)); return r; }
__device__ __forceinline__ float fexp(float x) { return __builtin_amdgcn_exp2f(x * 1.4426950408889634f); }
__device__ __forceinline__ float sigm(float x) { return __builtin_amdgcn_rcpf(1.0f + fexp(-x)); }
__device__ __forceinline__ float gelu_t(float x) { const float u = 0.7978845608028654f * (x + 0.044715f * x * x * x); return x * sigm(2.0f * u); }
__device__ __forceinline__ float silu(float x) { return x * sigm(x); }
__device__ __forceinline__ float shx(float v, int m, int lane) { return __builtin_bit_cast(float, __builtin_amdgcn_ds_bpermute((lane ^ m) << 2, __builtin_bit_cast(int, v))); }
__device__ __forceinline__ float wave_sum(float v, int lane) {
#pragma unroll
    for (int o = 1; o < 64; o <<= 1) v += shx(v, o, lane);
    return v;
}
#define LDS_WAIT() asm volatile("s_waitcnt lgkmcnt(0)" ::: "memory")
__device__ __forceinline__ float ss_rstd(f32x4 p) { return 1.0f / sqrtf(((p[0] + p[1]) + (p[2] + p[3])) * (1.f / 1024.f) + 1e-6f); }
__device__ __forceinline__ int opaque_tid(int wave_s) { int l; asm volatile("v_mbcnt_lo_u32_b32 %0, -1, 0\n\tv_mbcnt_hi_u32_b32 %0, -1, %0" : "=v"(l)); return wave_s * 64 + l; }

namespace pg8 {
constexpr int BM = 256, BK = 64, HALF = 128, HTB = HALF * BK * 2, NXCD = 8, WGM = 8;
__device__ __forceinline__ int lds_byte(int r, int c) { const int st = (r >> 4) * 2 + (c >> 5), rr = r & 15, cc = c & 31, ob = rr * 64 + cc * 2; return st * 1024 + (ob ^ (((ob >> 9) & 1) << 5)); }
__device__ __forceinline__ void stage_rc(int b, int& R, int& C) { const int st = b / 1024, sb = b % 1024, swz = sb ^ (((sb >> 9) & 1) << 5); R = (st >> 1) * 16 + swz / 64; C = (st & 1) * 32 + (swz % 64) / 2; }
__device__ __forceinline__ int perm32(int rho) { const int n = rho >> 4, i = rho & 15; return 8 * (i >> 2) + 4 * n + (i & 3); }

struct Unit { int pm, pn; };
struct Gemm { const bf16_t* A; const bf16_t* Bt; int lda, ldb, K; };

struct GSched {
    int nM, nN, nwg, G, c, mode;
    size_t aPm, aPn, bPn, bPm; int bShift;
    __device__ __forceinline__ void init(int nM_, int nN_, int G_, int c_) { nM = nM_; nN = nN_; nwg = nM * nN; G = G_; c = c_; mode = 0; aPm = 0; aPn = 0; bPn = 0; bPm = 0; bShift = 0; }
    __device__ __forceinline__ bool next(int i, Unit& u) const {
        const long L = (long)i * G + c; if (L >= nwg) return false;
        int wgid = (int)L; { const int q = nwg / NXCD, r = nwg % NXCD, xcd = wgid % NXCD, off = wgid / NXCD; wgid = (xcd < r ? xcd * (q + 1) : r * (q + 1) + (xcd - r) * q) + off; }
        const int nig = WGM * nN, gid = wgid / nig, fm = gid * WGM, gsz = (nM - fm) < WGM ? (nM - fm) : WGM;
        u.pm = fm + ((wgid % nig) % gsz); u.pn = (wgid % nig) / gsz; return true;
    }
    __device__ __forceinline__ size_t offA(const Unit& u) const { return mode == 1 ? (size_t)(u.pn & 3) * 512 : (size_t)u.pm * aPm + (size_t)u.pn * aPn; }
    __device__ __forceinline__ size_t offB(const Unit& u) const { return mode == 1 ? (size_t)(u.pn >> 2) * (256 * 1024 * 2) + (size_t)(u.pn & 3) * 512 : (size_t)u.pn * bPn + (size_t)(u.pm >> bShift) * bPm; }
};

struct EpiBf16 {
    static constexpr bool PERM = true;
    bf16_t* O; int ldc; float scale; const float* ss;
    __device__ __forceinline__ void operator()(f32x4 (&acc)[2][2][4][2], const Unit& u, int wr, int wc, int fr, int fq, LAS unsigned char*) const {
        asm volatile("" : "+v"(fr), "+v"(fq)); asm volatile("" : "+s"(wr), "+s"(wc));
        const int row0 = u.pm * BM + wr * 64 + fr, col0 = u.pn * BM + wc * 32 + 8 * fq;
        f32x4 rs[2][4];
#pragma unroll
        for (int ai = 0; ai < 2; ++ai)
#pragma unroll
            for (int m = 0; m < 4; ++m) rs[ai][m] = ss ? *(const f32x4*)(ss + (size_t)(row0 + ai * HALF + m * 16) * 4) : (f32x4){0.f, 0.f, 0.f, 0.f};
#pragma unroll
        for (int ai = 0; ai < 2; ++ai)
#pragma unroll
            for (int m = 0; m < 4; ++m) { bf16_t* rowp = O + (size_t)(row0 + ai * HALF + m * 16) * ldc + col0;
                float sc = scale; if (ss) sc *= ss_rstd(rs[ai][m]);
#pragma unroll
                for (int bj = 0; bj < 2; ++bj) { const f32x4 v0 = acc[ai][bj][m][0] * sc, v1 = acc[ai][bj][m][1] * sc;
                    u32x4 w; w.x = cvt_pk_bf16(v0[0], v0[1]); w.y = cvt_pk_bf16(v0[2], v0[3]); w.z = cvt_pk_bf16(v1[0], v1[1]); w.w = cvt_pk_bf16(v1[2], v1[3]);
                    *(u32x4*)(rowp + bj * HALF) = w; } }
    }
};
struct EpiResid {
    static constexpr bool PERM = false;
    bf16_t* xb; float* ss;
    __device__ __forceinline__ void operator()(f32x4 (&acc)[2][2][4][2], const Unit& u, int wr, int wc, int fr, int fq, LAS unsigned char* lds) const {
        asm volatile("" : "+v"(fr), "+v"(fq)); asm volatile("" : "+s"(wr), "+s"(wc));
        const int col0 = u.pn * BM + wc * 32 + 4 * fq, lane = fq * 16 + fr;
        LAS float* PS = (LAS float*)(lds + LDS_EX);
        bf16_t* ob = xb + (size_t)u.pm * BM * D;
#pragma unroll
        for (int ai = 0; ai < 2; ++ai) {
            u32x2 pre[4][2][2];
#pragma unroll
            for (int m = 0; m < 4; ++m)
#pragma unroll
                for (int bj = 0; bj < 2; ++bj)
#pragma unroll
                    for (int n = 0; n < 2; ++n) pre[m][bj][n] = *(const u32x2*)(ob + (size_t)(ai * HALF + wr * 64 + m * 16 + fr) * D + col0 + bj * HALF + n * 16);
            asm volatile("" ::: "memory");
#pragma unroll
            for (int m = 0; m < 4; ++m) { const int rl = ai * HALF + wr * 64 + m * 16 + fr; const size_t off = (size_t)rl * D + col0; float q = 0.f;
#pragma unroll
                for (int bj = 0; bj < 2; ++bj)
#pragma unroll
                    for (int n = 0; n < 2; ++n) { const u32x2 p = pre[m][bj][n]; const f32x4 a = acc[ai][bj][m][n];
                        const float v0 = bflo(p.x) + a[0], v1 = bfhi(p.x) + a[1], v2 = bflo(p.y) + a[2], v3 = bfhi(p.y) + a[3];
                        u32x2 w; w.x = cvt_pk_bf16(v0, v1); w.y = cvt_pk_bf16(v2, v3); *(u32x2*)(ob + off + bj * HALF + n * 16) = w;
                        q += (v0 * v0 + v1 * v1) + (v2 * v2 + v3 * v3); }
                q += shx(q, 16, lane); q += shx(q, 32, lane);
                if (fq == 0) PS[rl * 4 + wc] = q; }
            asm volatile("" ::: "memory");
        }
        asm volatile("s_waitcnt lgkmcnt(0)" ::: "memory"); __builtin_amdgcn_s_barrier(); asm volatile("" ::: "memory");
        { const int t = (wr * 4 + wc) * 64 + lane; if (t < 256) { const f32x4 p = *(const LAS f32x4*)(PS + t * 4); ss[(size_t)(u.pm * BM + t) * 4 + u.pn] = (p[0] + p[1]) + (p[2] + p[3]); } }
    }
};
struct EpiKV {
    static constexpr bool PERM = false;
    float* outK; float* outV; bf16_t* KB; bf16_t* VT;
    __device__ __forceinline__ void operator()(f32x4 (&acc)[2][2][4][2], const Unit& u, int wr, int wc, int fr, int fq, LAS unsigned char*) const {
        asm volatile("" : "+v"(fr), "+v"(fq)); asm volatile("" : "+s"(wr), "+s"(wc));
        const int kind = u.pm >> 4, pm = u.pm & 15;
        const int col0 = u.pn * BM + wc * 32 + 4 * fq;
        float* of = kind == 0 ? outK : outV; bf16_t* ob = kind == 0 ? KB : VT; const int ldb_ = kind == 2 ? 2048 : 1024;
#pragma unroll
        for (int ai = 0; ai < 2; ++ai)
#pragma unroll
            for (int m = 0; m < 4; ++m) { const int row = pm * BM + ai * HALF + wr * 64 + m * 16 + fr;
#pragma unroll
                for (int bj = 0; bj < 2; ++bj)
#pragma unroll
                    for (int n = 0; n < 2; ++n) { const f32x4 v = acc[ai][bj][m][n]; const int col = col0 + bj * HALF + n * 16;
                        if (kind != 2) *(f32x4*)(of + (size_t)row * 1024 + col) = v;
                        if (kind != 1) { u32x2 w; w.x = cvt_pk_bf16(v[0], v[1]); w.y = cvt_pk_bf16(v[2], v[3]); *(u32x2*)(ob + (size_t)row * ldb_ + col) = w; } } }
    }
};
struct EpiSoftmax {
    static constexpr bool PERM = true;
    bf16_t* O; int ldc; int smp;
    __device__ __forceinline__ void operator()(f32x4 (&acc)[2][2][4][2], const Unit& u, int wr, int wc, int fr, int fq, LAS unsigned char* lds) const {
        asm volatile("" : "+v"(fr), "+v"(fq)); asm volatile("" : "+s"(wr), "+s"(wc));
        LAS f32x2* EX = (LAS f32x2*)(lds + LDS_EX);
        const int lane = fq * 16 + fr;
        const float L2E = 1.4426950408889634f;
#pragma unroll
        for (int ai = 0; ai < 2; ++ai)
#pragma unroll
            for (int m = 0; m < 4; ++m) {
                float mx = -3.0e38f;
#pragma unroll
                for (int bj = 0; bj < 2; ++bj)
#pragma unroll
                    for (int n = 0; n < 2; ++n) { const f32x4 x = acc[ai][bj][m][n]; mx = fmaxf(mx, fmaxf(fmaxf(x[0], x[1]), fmaxf(x[2], x[3]))); }
                mx = fmaxf(mx, shx(mx, 16, lane)); mx = fmaxf(mx, shx(mx, 32, lane));
                float s = 0.f;
#pragma unroll
                for (int bj = 0; bj < 2; ++bj)
#pragma unroll
                    for (int n = 0; n < 2; ++n) { f32x4 x = acc[ai][bj][m][n];
#pragma unroll
                        for (int j = 0; j < 4; ++j) { x[j] = __builtin_amdgcn_exp2f((x[j] - mx) * L2E); s += x[j]; }
                        acc[ai][bj][m][n] = x; }
                s += shx(s, 16, lane); s += shx(s, 32, lane);
                if (fq == 0) EX[(ai * HALF + wr * 64 + m * 16 + fr) * 4 + wc] = (f32x2){mx, s};
            }
        asm volatile("s_waitcnt lgkmcnt(0)" ::: "memory"); __builtin_amdgcn_s_barrier(); asm volatile("" ::: "memory");
        int colb = u.pn * BM, j_ = 0;
        if (smp) { colb = (u.pn & 3) * 2048 + (u.pn >> 2) * 256; j_ = u.pn >> 2; }
        const int col0 = colb + wc * 32 + 8 * fq;
#pragma unroll
        for (int ai = 0; ai < 2; ++ai)
#pragma unroll
            for (int m = 0; m < 4; ++m) {
                const int rl = ai * HALF + wr * 64 + m * 16 + fr;
                const f32x2 e0 = EX[rl * 4 + 0], e1 = EX[rl * 4 + 1], e2 = EX[rl * 4 + 2], e3 = EX[rl * 4 + 3];
                const float M = fmaxf(fmaxf(e0.x, e1.x), fmaxf(e2.x, e3.x));
                const float tot = e0.y * __builtin_amdgcn_exp2f((e0.x - M) * L2E) + e1.y * __builtin_amdgcn_exp2f((e1.x - M) * L2E) + e2.y * __builtin_amdgcn_exp2f((e2.x - M) * L2E) + e3.y * __builtin_amdgcn_exp2f((e3.x - M) * L2E);
                const float own = wc == 0 ? e0.x : (wc == 1 ? e1.x : (wc == 2 ? e2.x : e3.x));
                float f = __builtin_amdgcn_exp2f((own - M) * L2E) / tot;
                if (smp && (rl >> 5) != j_) f = 0.f;
                bf16_t* rowp = O + (size_t)(u.pm * BM + rl) * ldc + col0;
#pragma unroll
                for (int bj = 0; bj < 2; ++bj) { const f32x4 v0 = acc[ai][bj][m][0] * f, v1 = acc[ai][bj][m][1] * f;
                    u32x4 w; w.x = cvt_pk_bf16(v0[0], v0[1]); w.y = cvt_pk_bf16(v0[2], v0[3]); w.z = cvt_pk_bf16(v1[0], v1[1]); w.w = cvt_pk_bf16(v1[2], v1[3]);
                    *(u32x4*)(rowp + bj * HALF) = w; } }
    }
};

template <class Epi, class Sched, bool ALIGN_EPI>
__device__ __forceinline__ void gemm_phase(LAS unsigned char* lds, const Gemm g, const Sched& S, const Epi& E, const int wave_s) {
    const int tid = opaque_tid(wave_s), wid = __builtin_amdgcn_readfirstlane(tid >> 6), lane = tid & 63, wr = wid >> 2, wc = wid & 3, fr = lane & 15, fq = lane >> 4;
    const int nt = g.K / BK;
    unsigned voffA[2], voffB[2];
#pragma unroll
    for (int i = 0; i < 2; ++i) { int R, C; stage_rc(tid * 16 + i * 8192, R, C); const int Rb = Epi::PERM ? ((R & ~31) + perm32(R & 31)) : R;
        voffA[i] = (unsigned)(R * g.lda + C) * 2u; voffB[i] = (unsigned)(Rb * g.ldb + C) * 2u; }
    const size_t kstep = (size_t)(BK * 2);
    const size_t hstepA = (size_t)HALF * g.lda * 2, hstepB = (size_t)HALF * g.ldb * 2;
    const unsigned ldsw = (unsigned)wid * 1024u;
    const int aoff = lds_byte(wr * 64 + fr, fq * 8), boff = lds_byte(wc * 32 + fr, fq * 8);
#define PG8_SA(b, h) (((b) * 2 + (h)) * HTB)
#define PG8_SB(b, h) ((4 + (b) * 2 + (h)) * HTB)
#define PG8_STAGE(bufoff, gbase, voff) do { _Pragma("unroll") for (int _i = 0; _i < 2; ++_i) \
        __builtin_amdgcn_global_load_lds((const unsigned*)((const char*)(gbase) + (voff)[_i]), (LAS unsigned*)(lds + (bufoff) + ldsw + _i * 8192), 16, 0, 0); } while (0)
#define PG8_LDA(dst, b, h) do { _Pragma("unroll") for (int m = 0; m < 4; ++m) _Pragma("unroll") for (int k = 0; k < 2; ++k) dst[m][k] = *(const LAS bf16x8*)(lds + PG8_SA(b, h) + aoff + m * 2048 + k * 1024); } while (0)
#define PG8_LDB(dst, b, h) do { _Pragma("unroll") for (int n = 0; n < 2; ++n) _Pragma("unroll") for (int k = 0; k < 2; ++k) dst[n][k] = *(const LAS bf16x8*)(lds + PG8_SB(b, h) + boff + n * 2048 + k * 1024); } while (0)
#define PG8_MMA(ai, bj, At, Bt) do { __builtin_amdgcn_s_setprio(1); _Pragma("unroll") for (int m = 0; m < 4; ++m) _Pragma("unroll") for (int n = 0; n < 2; ++n) _Pragma("unroll") for (int k = 0; k < 2; ++k) \
        acc[ai][bj][m][n] = __builtin_amdgcn_mfma_f32_16x16x32_bf16(Bt[n][k], At[m][k], acc[ai][bj][m][n], 0, 0, 0); __builtin_amdgcn_s_setprio(0); } while (0)
#define PG8_WAIT_V(n) asm volatile("s_waitcnt vmcnt(" #n ")" ::: "memory")
#define PG8_WAIT_L(n) asm volatile("s_waitcnt lgkmcnt(" #n ")" ::: "memory")
#define PG8_BAR __builtin_amdgcn_s_barrier()
#define PG8_SCHED __builtin_amdgcn_sched_barrier(0)
    Unit cur, nxt; int ui = 0;
    if (!S.next(0, cur)) return;
    f32x4 acc[2][2][4][2];
#pragma unroll
    for (int a = 0; a < 2; ++a)
#pragma unroll
        for (int b = 0; b < 2; ++b)
#pragma unroll
            for (int m = 0; m < 4; ++m)
#pragma unroll
                for (int n = 0; n < 2; ++n) acc[a][b][m][n] = (f32x4){0.f, 0.f, 0.f, 0.f};
    bf16x8 At[4][2], B0[2][2], B1[2][2];
    const char* cA = (const char*)g.A + S.offA(cur); const char* cB = (const char*)g.Bt + S.offB(cur);
    PG8_STAGE(PG8_SB(0, 0), cB, voffB); PG8_STAGE(PG8_SB(0, 1), cB + hstepB, voffB); PG8_STAGE(PG8_SA(0, 0), cA, voffA); PG8_STAGE(PG8_SA(0, 1), cA + hstepA, voffA);
    if (wr == 1) PG8_BAR;
    PG8_WAIT_V(2); PG8_BAR;
    PG8_STAGE(PG8_SB(1, 0), cB + kstep, voffB); PG8_STAGE(PG8_SA(1, 0), cA + kstep, voffA); PG8_STAGE(PG8_SB(1, 1), cB + hstepB + kstep, voffB);
    PG8_WAIT_V(6); PG8_BAR;
    for (;;) {
        const bool has_next = S.next(ui + 1, nxt);
        const char* nA = has_next ? (const char*)g.A + S.offA(nxt) : cA; const char* nB = has_next ? (const char*)g.Bt + S.offB(nxt) : cB;
        for (int t = 0; t < nt; t += 2) {
            const bool last = (t == nt - 2);
            const char* a1 = cA + (size_t)(t + 1) * kstep;
            const char* a2 = last ? nA : cA + (size_t)(t + 2) * kstep; const char* b2 = last ? nB : cB + (size_t)(t + 2) * kstep;
            const char* a3 = a2 + kstep; const char* b3 = b2 + kstep;
            PG8_LDB(B0, 0, 0); PG8_LDB(B1, 0, 1); PG8_SCHED; PG8_LDA(At, 0, 0); PG8_STAGE(PG8_SA(1, 1), a1 + hstepA, voffA);
            PG8_WAIT_V(8); PG8_WAIT_L(0); PG8_BAR; PG8_MMA(0, 0, At, B0); PG8_MMA(0, 1, At, B1); PG8_BAR; PG8_SCHED;
            PG8_LDA(At, 0, 1); PG8_STAGE(PG8_SB(0, 0), b2, voffB); PG8_STAGE(PG8_SB(0, 1), b2 + hstepB, voffB); PG8_STAGE(PG8_SA(0, 0), a2, voffA);
            PG8_WAIT_V(8); PG8_WAIT_L(0); PG8_BAR; PG8_MMA(1, 0, At, B0); PG8_MMA(1, 1, At, B1); PG8_BAR; PG8_SCHED;
            PG8_LDB(B0, 1, 0); PG8_LDB(B1, 1, 1); PG8_SCHED; PG8_LDA(At, 1, 0); PG8_STAGE(PG8_SA(0, 1), a2 + hstepA, voffA);
            PG8_WAIT_V(8); PG8_WAIT_L(0); PG8_BAR; PG8_MMA(0, 0, At, B0); PG8_MMA(0, 1, At, B1); PG8_BAR; PG8_SCHED;
            PG8_LDA(At, 1, 1); PG8_STAGE(PG8_SB(1, 0), b3, voffB); PG8_STAGE(PG8_SB(1, 1), b3 + hstepB, voffB); PG8_STAGE(PG8_SA(1, 0), a3, voffA);
            PG8_WAIT_V(8); PG8_WAIT_L(0); PG8_BAR; PG8_MMA(1, 0, At, B0); PG8_MMA(1, 1, At, B1); PG8_BAR; PG8_SCHED;
        }
        if constexpr (ALIGN_EPI) { if (wr == 0) PG8_BAR; }
        E(acc, cur, wr, wc, fr, fq, lds);
        if (!has_next) break;
#pragma unroll
        for (int a = 0; a < 2; ++a)
#pragma unroll
            for (int b = 0; b < 2; ++b)
#pragma unroll
                for (int m = 0; m < 4; ++m)
#pragma unroll
                    for (int n = 0; n < 2; ++n) acc[a][b][m][n] = (f32x4){0.f, 0.f, 0.f, 0.f};
        cur = nxt; cA = nA; cB = nB; ++ui;
        if constexpr (ALIGN_EPI) { if (wr == 1) PG8_BAR; }
    }
    PG8_WAIT_V(0);
    if constexpr (!ALIGN_EPI) { if (wr == 0) PG8_BAR; }
    PG8_BAR;
#undef PG8_SA
#undef PG8_SB
#undef PG8_STAGE
#undef PG8_LDA
#undef PG8_LDB
#undef PG8_MMA
#undef PG8_WAIT_V
#undef PG8_WAIT_L
#undef PG8_BAR
#undef PG8_SCHED
}
}

struct KVSched {
    int c, G; const char* ws;
    __device__ __forceinline__ bool next(int i, pg8::Unit& u) const {
        const int L = i * G + c; if (c < 0 || L >= 96) return false;
        const int kind = L >> 5, r = L & 31;
        if (kind < 2) { u.pm = kind * 16 + (r >> 2); u.pn = r & 3; } else { u.pm = 32 + (r >> 3); u.pn = r & 7; }
        return true;
    }
    __device__ __forceinline__ size_t offA(const pg8::Unit& u) const { const int kind = u.pm >> 4, pm = u.pm & 15; int k2 = (kind == 2); asm volatile("" : "+v"(k2));
        return (size_t)ws + WS_MEMB + (size_t)k2 * (WS_WV - WS_MEMB) + (size_t)pm * 256 * 1024 * 2; }
    __device__ __forceinline__ size_t offB(const pg8::Unit& u) const { const int kind = u.pm >> 4; int k1 = (kind == 1), k2 = (kind == 2); asm volatile("" : "+v"(k1), "+v"(k2));
        return (size_t)ws + WS_WK + (size_t)k1 * (WS_WV - WS_WK) + (size_t)k2 * (WS_MEMB - WS_WK) + (size_t)u.pn * 256 * 1024 * 2; }
};


#define XB_TMO      128
#define XB_XCNT(j)  (256  + 64 * (j))
#define XB_XSUB(j)  (1280 + 64 * (j))
#define XB_XGEN(j)  (2304 + 64 * (j))
#define XB_TOP      3328
#define XB_TOPGEN   3392
#define XCD_BAR_WORDS 3456
#define XB_SPIN_CAP (1u << 22)
__device__ __forceinline__ unsigned xb_ld(unsigned* p)              { return __hip_atomic_load(p, __ATOMIC_RELAXED, __HIP_MEMORY_SCOPE_AGENT); }
__device__ __forceinline__ unsigned xb_add(unsigned* p, unsigned v) { return __hip_atomic_fetch_add(p, v, __ATOMIC_RELAXED, __HIP_MEMORY_SCOPE_AGENT); }
__device__ __forceinline__ unsigned xb_xcc_id() { return (unsigned)__builtin_amdgcn_s_getreg((3 << 11) | 20) & 0xFu; }
#define XB_SPIN(cond, bar) do { unsigned _sp = 0; while (cond) { __builtin_amdgcn_s_sleep(1); \
    if ((++_sp & 255u) == 0u) { if (xb_ld(&(bar)[XB_TMO])) break; if (_sp > XB_SPIN_CAP) { atomicAdd(&(bar)[XB_TMO], 1u); break; } } } } while (0)
struct XcdBarrier { unsigned* bar; unsigned x; volatile LAS unsigned* st; };
__device__ __forceinline__ void xcd_barrier_complete(unsigned* bar, unsigned x, unsigned& nloc, unsigned& nx) {
    const unsigned G = gridDim.x * gridDim.y * gridDim.z;
    unsigned sum, cnt, mine, sp = 0u;
    for (;;) {
        sum = 0u; cnt = 0u; mine = 0u;
#pragma unroll
        for (unsigned j = 0; j < 16; ++j) { const unsigned c = xb_ld(&bar[XB_XCNT(j)]); sum += c; cnt += (c > 0u) ? 1u : 0u; mine = (j == x) ? c : mine; }
        if (sum == G) break;
        __builtin_amdgcn_s_sleep(1);
        if ((++sp & 255u) == 0u) { if (xb_ld(&bar[XB_TMO])) break; if (sp > XB_SPIN_CAP) { atomicAdd(&bar[XB_TMO], 1u); break; } }
    }
    nloc = mine > 0u ? mine : 1u; nx = cnt > 0u ? cnt : 1u;
}
__device__ __forceinline__ void xcd_barrier(const XcdBarrier& b) {
    asm volatile("s_waitcnt vmcnt(0)" ::: "memory");
    __syncthreads();
    if (threadIdx.x == 0) {
        unsigned* bar = b.bar;
        __builtin_amdgcn_s_waitcnt(0);
        unsigned nloc = b.st[0], nx = b.st[1];
        if (nloc == 0u) { xcd_barrier_complete(bar, b.x, nloc, nx); b.st[0] = nloc; b.st[1] = nx; }
        const unsigned old = xb_add(&bar[XB_XSUB(b.x)], 1u);
        const unsigned gen = old / nloc;
        if (old + 1u == (gen + 1u) * nloc) {
            __builtin_amdgcn_fence(__ATOMIC_RELEASE, "agent");
            asm volatile("s_waitcnt vmcnt(0)" ::: "memory");
            const unsigned og = xb_add(&bar[XB_TOP], 1u);
            const unsigned tg = og / nx;
            if (og + 1u == (tg + 1u) * nx) xb_add(&bar[XB_TOPGEN], 1u);
            else XB_SPIN(xb_ld(&bar[XB_TOPGEN]) == tg, bar);
            __builtin_amdgcn_fence(__ATOMIC_ACQUIRE, "agent");
            xb_add(&bar[XB_XGEN(b.x)], 1u);
            asm volatile("s_waitcnt vmcnt(0)" ::: "memory");
        } else {
            XB_SPIN(xb_ld(&bar[XB_XGEN(b.x)]) == gen, bar);
            __builtin_amdgcn_fence(__ATOMIC_ACQUIRE, "agent");
            asm volatile("s_waitcnt vmcnt(0)" ::: "memory");
        }
    }
    __syncthreads();
}

__device__ __forceinline__ void transpose_item(const float* W, int K, int N, bf16_t* WT, LAS float* scr, int item, int lane, const float* gain = nullptr) {
    const int nblk = N / 32, kb = item / nblk, nb = item % nblk, k0 = 64 * kb, n0 = 32 * nb;
#pragma unroll 8
    for (int i = 0; i < 32; ++i) { const int kk = 2 * i + (lane >> 5); float w = W[(size_t)(k0 + kk) * N + n0 + (lane & 31)]; if (gain) w *= gain[k0 + kk]; scr[kk * 33 + (lane & 31)] = w; }
    LDS_WAIT();
    const int c = lane & 7;
#pragma unroll
    for (int j = 0; j < 4; ++j) { const int n = (lane >> 3) + 8 * j; const LAS float* s = scr + (8 * c) * 33 + n;
        u32x4 o; o.x = pk2(s[0 * 33], s[1 * 33]); o.y = pk2(s[2 * 33], s[3 * 33]); o.z = pk2(s[4 * 33], s[5 * 33]); o.w = pk2(s[6 * 33], s[7 * 33]);
        *(u32x4*)(WT + (size_t)(n0 + n) * K + k0 + 8 * c) = o; }
    LDS_WAIT();
}

__device__ __forceinline__ void first_rows(const float* Xp, const float* Xs, bf16_t* XNo, float* ss, int gw, int NGW, int lane) {
    for (int m = gw; m < MT; m += NGW) {
        const f32x4* xr = (const f32x4*)(m < MP ? Xp + (size_t)m * D : Xs + (size_t)(m - MP) * D) + lane;
        f32x4 v[4]; float s = 0.f;
#pragma unroll
        for (int j = 0; j < 4; ++j) { v[j] = xr[64 * j]; s += (v[j].x * v[j].x + v[j].y * v[j].y) + (v[j].z * v[j].z + v[j].w * v[j].w); }
        s = wave_sum(s, lane);
        if (lane < 4) ss[(size_t)m * 4 + lane] = lane == 0 ? s : 0.f;
        u32x2* o8 = (u32x2*)(XNo + (size_t)m * D) + lane;
#pragma unroll
        for (int j = 0; j < 4; ++j) { u32x2 w; w.x = pk2(v[j].x, v[j].y); w.y = pk2(v[j].z, v[j].w); o8[64 * j] = w; }
    }
}

typedef __attribute__((address_space(4))) const unsigned char* kptr_t;
typedef const float* cfp_t; typedef float* fp_t; typedef unsigned char* ucp_t;
#define INP(k) (*(const __attribute__((address_space(4))) cfp_t*)(kp + 8 * (k)))
#define X out
#define WIN_T ((bf16_t*)(ws + WS_WIN))
#define WOUT_T ((bf16_t*)(ws + WS_WOUT))
#define WQ_T ((bf16_t*)(ws + WS_WQ))
#define WK_T ((bf16_t*)(ws + WS_WK))
#define WV_T ((bf16_t*)(ws + WS_WV))
#define WO_T ((bf16_t*)(ws + WS_WO))
#define WUP_T ((bf16_t*)(ws + WS_WUP))
#define WDN_T ((bf16_t*)(ws + WS_WDN))
#define MEMB ((bf16_t*)(ws + WS_MEMB))
#define KBP ((bf16_t*)(ws + WS_KBP))
#define VTP ((bf16_t*)(ws + WS_VTP))
#define KBS ((bf16_t*)(ws + WS_KBS))
#define VTS ((bf16_t*)(ws + WS_VTS))
#define WST ((bf16_t*)(ws + WS_WST))
#define AGG ((float*)(ws + WS_AGG))
#define SSQ(i) ((float*)(ws + WS_SSP) + (size_t)(i) * MT * 4)
#define GT_R ((bf16_t*)(ws + WS_GT))
#define GT_I ((bf16_t*)(ws + WS_GT + 65536))
#define XN ((bf16_t*)(ws + WS_XN))
#define gZ ((bf16_t*)(ws + B_Z))
#define HLOC ((float*)(ws + B_HLOC))
#define PCUM ((float*)(ws + B_PCUM))
#define gY ((bf16_t*)(ws + B_Y))
#define gQ ((bf16_t*)(ws + B_Q))
#define gP ((bf16_t*)(ws + B_P))
#define gO ((bf16_t*)(ws + B_O))
#define PS ((bf16_t*)(ws + B_PS))
#define GU ((bf16_t*)(ws + B_GU))
__global__ void __launch_bounds__(NTHREADS, 2) trunk_fwd(Args args) {
    extern __shared__ __attribute__((aligned(16))) unsigned char lds_raw[];
    LAS unsigned char* lds = (LAS unsigned char*)lds_raw;
    cg::grid_group grid = cg::this_grid();
    const int wave_s = __builtin_amdgcn_readfirstlane(threadIdx.x >> 6);
#define LANE_STATE() int G = gridDim.x, bid = blockIdx.x; asm volatile("" : "+s"(G), "+s"(bid)); const int NGW = G * NWAVES, NGT = G * NTHREADS; (void)NGW; (void)NGT; \
    const int tid = opaque_tid(wave_s), lane = tid & 63, wave = wave_s; const int gw = bid * NWAVES + wave; const int gt = bid * NTHREADS + tid; (void)lane; (void)gw; (void)gt; \
    kptr_t kp = (kptr_t)__builtin_amdgcn_kernarg_segment_ptr(); asm volatile("" : "+s"(kp)); \
    float* const out = *(const __attribute__((address_space(4))) fp_t*)(kp + 8 * N_IN); unsigned char* const ws = *(const __attribute__((address_space(4))) ucp_t*)(kp + 8 * N_IN + 8); (void)out; (void)ws
    {
        LANE_STATE();
        if (bid == 0) for (int i = tid; i < XCD_BAR_WORDS; i += NTHREADS) __hip_atomic_store((unsigned*)(ws + WS_BAR) + i, 0u, __ATOMIC_RELAXED, __HIP_MEMORY_SCOPE_AGENT);
        if (tid < 32) ((LAS unsigned*)(lds + LDS_MISC))[tid] = 0u;
        __threadfence();
        grid.sync();
        if (tid == 0) (void)xb_add((unsigned*)(ws + WS_BAR) + XB_XCNT(xb_xcc_id()), 1u);
    }
#define GRID_SYNC() do { kptr_t kp_ = (kptr_t)__builtin_amdgcn_kernarg_segment_ptr(); asm volatile("" : "+s"(kp_)); \
        XcdBarrier b_; b_.bar = (unsigned*)(*(const __attribute__((address_space(4))) ucp_t*)(kp_ + 8 * N_IN + 8) + WS_BAR); b_.x = xb_xcc_id(); b_.st = (volatile LAS unsigned*)(lds + LDS_MISC); \
        xcd_barrier(b_); if (PROBE == 3) xcd_barrier(b_); } while (0)

    for (int l = 0; l < DEPTH; ++l) {
        for (int dup0 = 0; dup0 < ((PROBE == 1 || PROBE == 5) ? 2 : 1); ++dup0) {
        {
            LANE_STATE();
            LAS float* scr = (LAS float*)(lds + wave * 16384);
            const float* w_in = INP(I_WIN) + (size_t)l * D * INC; const float* w_out = INP(I_WOUT) + (size_t)l * D * D; const float* w_q = INP(I_WQ) + (size_t)l * D * D;
            const float* w_k = INP(I_WK) + (size_t)l * D * D; const float* w_v = INP(I_WV) + (size_t)l * D * D; const float* w_o = INP(I_WO) + (size_t)l * D * D;
            const float* w_up = INP(I_WUP) + (size_t)l * D * 2 * DFF; const float* w_dn = INP(I_WDN) + (size_t)l * DFF * D; const float* c_v = INP(I_CV) + (size_t)l * BS * NMEM * D;
            constexpr int T_IN = 16 * (INC / 32), T_SQ = 16 * 32, T_UP = 16 * (2 * DFF / 32), T_DN = (DFF / 64) * 32, T_CV = 32 * 32;
            constexpr int T_G = 16;
            constexpr int NIT = T_IN + 5 * T_SQ + T_UP + T_DN + T_CV + 2 * T_G;
            for (int it = gw; it < NIT; it += NGW) {
                int r = it;
                if (r < T_IN) { transpose_item(w_in, D, INC, WIN_T, scr, r, lane, INP(I_GMIX) + l * D); continue; } r -= T_IN;
                if (r < T_SQ) { transpose_item(w_out, D, D, WOUT_T, scr, r, lane); continue; } r -= T_SQ;
                if (r < T_SQ) { transpose_item(w_q, D, D, WQ_T, scr, r, lane, INP(I_GX) + l * D); continue; } r -= T_SQ;
                if (r < T_SQ) { transpose_item(w_k, D, D, WK_T, scr, r, lane); continue; } r -= T_SQ;
                if (r < T_SQ) { transpose_item(w_v, D, D, WV_T, scr, r, lane); continue; } r -= T_SQ;
                if (r < T_SQ) { transpose_item(w_o, D, D, WO_T, scr, r, lane); continue; } r -= T_SQ;
                if (r < T_UP) { transpose_item(w_up, D, 2 * DFF, WUP_T, scr, r, lane, INP(I_GFFN) + l * D); continue; } r -= T_UP;
                if (r < T_DN) { transpose_item(w_dn, DFF, D, WDN_T, scr, r, lane); continue; } r -= T_DN;
                if (r < T_CV) { transpose_item(c_v, BS * NMEM, D, VTS, scr, r, lane); continue; } r -= T_CV;
                if (r < T_G) { transpose_item(INP(I_WRG) + ((size_t)l * 8 + (r >> 1)) * 4096, 64, 64, GT_R + (r >> 1) * 4096, scr, r & 1, lane); continue; } r -= T_G;
                transpose_item(INP(I_WIG) + ((size_t)l * 8 + (r >> 1)) * 4096, 64, 64, GT_I + (r >> 1) * 4096, scr, r & 1, lane);
            }
            {
                const f32x4* ck = (const f32x4*)(INP(I_CK) + (size_t)l * BS * NMEM * D); u32x2* dk = (u32x2*)KBS;
                for (int i = gt; i < BS * NMEM * D / 4; i += NGT) { const f32x4 v = ck[i]; u32x2 w; w.x = pk2(v.x, v.y); w.y = pk2(v.z, v.w); dk[i] = w; }
                if (l == 0) { const f32x4* mm = (const f32x4*)INP(I_MEM); u32x2* dm = (u32x2*)MEMB;
                    for (int i = gt; i < BP * NMEM * D / 4; i += NGT) { const f32x4 v = mm[i]; u32x2 w; w.x = pk2(v.x, v.y); w.y = pk2(v.z, v.w); dm[i] = w; } }
                const float* wsl = INP(I_WS) + (size_t)l * 4 * 128 * 128;
                for (int i = gt; i < 4 * 128 * 128; i += NGT) { const int s = i & 127, t = (i >> 7) & 127; WST[i] = (bf16_t)f2bf(s <= t ? wsl[i] : 0.f); }
            }
            if (l == 0) first_rows(INP(I_XP), INP(I_XS), XN, SSQ(0), gw, NGW, lane);
        }
        GRID_SYNC();
        }
        {
            LANE_STATE();
            KVSched S; S.G = G; S.c = bid >= 160 ? bid - 160 : -1; S.ws = (const char*)ws;
            pg8::Gemm g{(const bf16_t*)nullptr, (const bf16_t*)nullptr, D, D, D};
            pg8::EpiKV E{out + O_MKP + (size_t)l * BP * NMEM * D, out + O_MVP + (size_t)l * BP * NMEM * D, KBP, VTP};
            pg8::gemm_phase<pg8::EpiKV, KVSched, true>(lds, g, S, E, wave_s);
        }
#define GEMM_BF16(s_) do { const int s = (s_); pg8::GSched S; pg8::Gemm g; pg8::EpiBf16 E; E.scale = 1.f; E.ss = nullptr; \
        if (s == 0) { S.init(MT / 256, INC / 256, G, bid); S.aPm = (size_t)256 * D * 2; S.bPn = (size_t)256 * D * 2; g = pg8::Gemm{XN, WIN_T, D, D, D}; E.O = gZ; E.ldc = INC; E.ss = SSQ(3 * l); } \
        else if (s == 1) { S.init(MT / 256, D / 256, G, bid); S.aPm = (size_t)256 * D * 2; S.bPn = (size_t)256 * D * 2; g = pg8::Gemm{XN, WQ_T, D, D, D}; E.O = gQ; E.ldc = D; E.scale = 0.0625f; E.ss = SSQ(3 * l + 1); } \
        else if (s == 2) { S.init(MP / 256, 4, G, bid); S.aPm = (size_t)256 * D * 2; S.aPn = 512; S.bPn = (size_t)256 * 2048 * 2; S.bPm = 512; S.bShift = 4; g = pg8::Gemm{gP, VTP, D, 2048, 256}; E.O = gO; E.ldc = D; } \
        else if (s == 3) { S.init(1, 4, G, (bid + G - 8) % G); S.aPn = 4096; S.bPn = (size_t)256 * 2048 * 2; g = pg8::Gemm{PS, VTS, 8192, 2048, 2048}; E.O = gO + (size_t)MP * D; E.ldc = D; } \
        else { S.init(MT / 256, 2 * DFF / 256, G, bid); S.aPm = (size_t)256 * D * 2; S.bPn = (size_t)256 * D * 2; g = pg8::Gemm{XN, WUP_T, D, D, D}; E.O = GU; E.ldc = 2 * DFF; E.ss = SSQ(3 * l + 2); } \
        pg8::gemm_phase<pg8::EpiBf16, pg8::GSched, true>(lds, g, S, E, wave_s); } while (0)
#define GEMM_RES(s_) do { const int s = (s_); pg8::GSched S; S.init(MT / 256, D / 256, G, bid); pg8::Gemm g; \
        if (s == 0) { g = pg8::Gemm{gY, WOUT_T, D, D, D}; S.aPm = (size_t)256 * D * 2; } \
        else if (s == 1) { g = pg8::Gemm{gO, WO_T, D, D, D}; S.aPm = (size_t)256 * D * 2; } \
        else { g = pg8::Gemm{GU + DFF, WDN_T, 2 * DFF, DFF, DFF}; S.aPm = (size_t)256 * 2 * DFF * 2; } \
        S.bPn = (size_t)256 * g.ldb * 2; \
        pg8::EpiResid E{XN, SSQ(3 * l + 1 + s)}; \
        pg8::gemm_phase<pg8::EpiResid, pg8::GSched, true>(lds, g, S, E, wave_s); } while (0)

        for (int rep = 0; rep < 13; ++rep) { if (rep == 4 || rep == 9) continue;
          const int ndup = ((PROBE == 1 && (rep == 1 || rep == 2)) || (PROBE == 4 && rep == 1) || (PROBE == 6 && rep == 2)) ? 2 : ((PROBE == 2 && (rep == 0 || rep == 5 || rep == 6 || rep == 7 || rep == 10)) ? 2 : 1);
          for (int dup = 0; dup < ndup; ++dup) {
            if (rep == 0 || rep == 5 || rep == 7 || rep == 10) {
                LANE_STATE();
                const int s0 = rep == 0 ? 0 : (rep == 5 ? 1 : (rep == 7 ? 2 : 4)), ns = rep == 7 ? 2 : 1;
                for (int q = 0; q < ns; ++q) GEMM_BF16(s0 + q);
            } else if (rep == 1) {
                LANE_STATE();
                {
                    LAS bf16_t* vT = (LAS bf16_t*)lds;
                    constexpr int VP = 136;
                    const float* gvp = INP(I_GV) + l * CW; const float* bsp = INP(I_BSS) + l * 4 * 128;
                    for (int un = bid; un < 8 + 256; un += G) {
                        int rowbase, nrows, sb = -1;
                        if (un < 8) { sb = un; rowbase = MP + un * TS; nrows = TS; } else { rowbase = (un - 8) * 128; nrows = 128; }
                        {
                            const int rl = tid >> 5, cgp = tid & 31;
                            f32x4 g0 = *(const f32x4*)(gvp + cgp * 8), g1 = *(const f32x4*)(gvp + cgp * 8 + 4);
                            for (int p = 0; p < nrows / 16; ++p) {
                                const int r = p * 16 + rl;
                                const u32x4 raw = *(const u32x4*)(gZ + (size_t)(rowbase + r) * INC + Z_VC + cgp * 8);
                                float v[8] = {bflo(raw.x), bfhi(raw.x), bflo(raw.y), bfhi(raw.y), bflo(raw.z), bfhi(raw.z), bflo(raw.w), bfhi(raw.w)};
                                float ss = 0.f;
#pragma unroll
                                for (int k = 0; k < 8; ++k) { v[k] = gelu_t(v[k]); ss += v[k] * v[k]; }
                                ss += shx(ss, 1, lane); ss += shx(ss, 2, lane); ss += shx(ss, 4, lane);
                                const float rstd = 1.0f / sqrtf(ss * (1.f / 64.f) + EPS);
                                const float gg[8] = {g0.x, g0.y, g0.z, g0.w, g1.x, g1.y, g1.z, g1.w};
#pragma unroll
                                for (int k = 0; k < 8; ++k) { v[k] = v[k] * rstd * gg[k]; vT[(cgp * 8 + k) * VP + r] = (bf16_t)f2bf(v[k]); }
                                if (sb >= 0) { float* vo = out + O_VCS + ((size_t)(l * BS + sb) * TS + r) * CW + cgp * 8;
                                    *(f32x4*)vo = (f32x4){v[0], v[1], v[2], v[3]}; *(f32x4*)(vo + 4) = (f32x4){v[4], v[5], v[6], v[7]}; }
                            }
                        }
                        __syncthreads();
                        {
                            const int hh = wave & 3, rh = wave >> 2, fr = lane & 15, fq = lane >> 4;
                            const int nmt = nrows == 128 ? 4 : (rh == 0 ? 2 : 0);
                            for (int mi = 0; mi < nmt; ++mi) {
                                const int mt = rh * 4 + mi, nks = (mt * 16 + 15) / 32 + 1;
                                f32x4 acc[4];
#pragma unroll
                                for (int n = 0; n < 4; ++n) acc[n] = (f32x4){0.f, 0.f, 0.f, 0.f};
                                for (int ks = 0; ks < nks; ++ks) {
                                    const bf16x8 a = *(const bf16x8*)(WST + ((size_t)(hh * 128 + mt * 16 + fr) * 128 + ks * 32 + fq * 8));
#pragma unroll
                                    for (int n = 0; n < 4; ++n) { const bf16x8 b = *(const LAS bf16x8*)(vT + (hh * 64 + n * 16 + fr) * VP + ks * 32 + fq * 8);
                                        acc[n] = __builtin_amdgcn_mfma_f32_16x16x32_bf16(a, b, acc[n], 0, 0, 0); }
                                }
#pragma unroll
                                for (int j = 0; j < 4; ++j) { const int t = mt * 16 + fq * 4 + j; const float bias = bsp[hh * 128 + t]; const size_t row = (size_t)(rowbase + t);
#pragma unroll
                                    for (int n = 0; n < 4; ++n) { const int c = hh * 64 + n * 16 + fr; const float u = gelu_t(bf2f(gZ[row * INC + Z_UC + c]));
                                        gY[row * D + 768 + c] = (bf16_t)f2bf(u * (acc[n][j] + bias)); } }
                            }
                        }
                        __syncthreads();
                    }
                }
                {
                    LAS unsigned char* wl = lds + wave * 16384;
                    LAS bf16_t* tile = (LAS bf16_t*)wl;
                    LAS float* pre_r = (LAS float*)(wl + 2560);
                    LAS float* pre_i = (LAS float*)(wl + 2560 + 4096);
                    LAS float* xcf = (LAS float*)(wl + 2560 + 8192);
                    const int fr = lane & 15, fq = lane >> 4;
                    for (int un = gw; un < 64 + 2048; un += NGW) {
                        int b, hd, rowbase, nrows, t0; bool smp = un < 64;
                        if (smp) { b = un >> 3; hd = un & 7; rowbase = MP + b * TS; nrows = TS; t0 = 0; }
                        else { const int v = un - 64; const int ch = v & 31; hd = (v >> 5) & 7; b = v >> 8; t0 = ch * 128; rowbase = b * SEQ + t0; nrows = 128; }
                        const int cidx = l * AW + hd * 64 + lane;
                        const float br = INP(I_BRG)[cidx], bi = INP(I_BIG)[cidx];
                        const float c8sp = 8.0f * log1pf(__expf(-INP(I_LAM)[cidx]));
                        const float* caw = INP(I_CAW) + (size_t)l * 4 * AW + hd * 64 + lane;
                        const float cw0 = caw[0], cw1 = caw[AW], cw2 = caw[2 * AW], cw3 = caw[3 * AW], cb = INP(I_CAB)[cidx];
                        bf16x8 bR[4][2], bI[4][2];
#pragma unroll
                        for (int n = 0; n < 4; ++n)
#pragma unroll
                            for (int ks = 0; ks < 2; ++ks) { const size_t o_ = (size_t)(hd * 64 + n * 16 + fr) * 64 + ks * 32 + fq * 8;
                                bR[n][ks] = *(const bf16x8*)(GT_R + o_); bI[n][ks] = *(const bf16x8*)(GT_I + o_); }
                        float xm3 = 0.f, xm2 = 0.f, xm1 = 0.f;
                        if (smp) { const float* st = INP(I_SCA) + ((size_t)(l * BS + b) * 3) * AW + hd * 64 + lane; xm3 = st[0]; xm2 = st[AW]; xm1 = st[2 * AW]; }
                        else if (t0 > 0) { const bf16_t* zp = gZ + (size_t)(rowbase - 3) * INC + Z_XA + hd * 64 + lane; xm3 = bf2f(zp[0]); xm2 = bf2f(zp[INC]); xm1 = bf2f(zp[2 * INC]); }
                        float h = 0.f, pc = 1.f;
                        const bf16_t* zp = gZ + (size_t)rowbase * INC + Z_XA + hd * 64 + lane;
                        float* hp = HLOC + (size_t)rowbase * AW + hd * 64 + lane; float* pp = PCUM + (size_t)rowbase * AW + hd * 64 + lane;
                        float xnx[16];
#pragma unroll
                        for (int i = 0; i < 16; ++i) xnx[i] = bf2f(zp[(size_t)i * INC]);
                        for (int st = 0; st < nrows / 16; ++st) {
                            float xcur[16];
#pragma unroll
                            for (int i = 0; i < 16; ++i) xcur[i] = xnx[i];
                            zp += (size_t)16 * INC;
                            if (st + 1 < nrows / 16) {
#pragma unroll
                                for (int i = 0; i < 16; ++i) xnx[i] = bf2f(zp[(size_t)i * INC]);
                            }
#pragma unroll
                            for (int i = 0; i < 16; ++i) { const float xv = xcur[i];
                                const float xc = cw0 * xm3 + cw1 * xm2 + cw2 * xm1 + cw3 * xv + cb; xm3 = xm2; xm2 = xm1; xm1 = xv; xcf[i * 64 + lane] = xc; tile[i * 72 + lane] = (bf16_t)f2bf(xc); }
                            LDS_WAIT();
                            const bf16x8 a0 = *(const LAS bf16x8*)(tile + fr * 72 + fq * 8), a1 = *(const LAS bf16x8*)(tile + fr * 72 + 32 + fq * 8);
#pragma unroll
                            for (int n = 0; n < 4; ++n) {
                                f32x4 ar = (f32x4){0.f, 0.f, 0.f, 0.f}, ai = (f32x4){0.f, 0.f, 0.f, 0.f};
                                ar = __builtin_amdgcn_mfma_f32_16x16x32_bf16(a0, bR[n][0], ar, 0, 0, 0); ar = __builtin_amdgcn_mfma_f32_16x16x32_bf16(a1, bR[n][1], ar, 0, 0, 0);
                                ai = __builtin_amdgcn_mfma_f32_16x16x32_bf16(a0, bI[n][0], ai, 0, 0, 0); ai = __builtin_amdgcn_mfma_f32_16x16x32_bf16(a1, bI[n][1], ai, 0, 0, 0);
#pragma unroll
                                for (int j = 0; j < 4; ++j) { pre_r[(fq * 4 + j) * 64 + n * 16 + fr] = ar[j]; pre_i[(fq * 4 + j) * 64 + n * 16 + fr] = ai[j]; }
                            }
                            LDS_WAIT();
#pragma unroll 4
                            for (int i = 0; i < 16; ++i) {
                                const float r = sigm(pre_r[i * 64 + lane] + br), gi = sigm(pre_i[i * 64 + lane] + bi);
                                const float la = -c8sp * r, a = __expf(la), bm = sqrtf(-expm1f(2.0f * la));
                                h = a * h + bm * gi * xcf[i * 64 + lane]; pc = pc * a;
                                *hp = h; *pp = pc; hp += AW; pp += AW;
                            }
                            LDS_WAIT();
                        }
                        AGG[(size_t)un * 128 + lane] = pc; AGG[(size_t)un * 128 + 64 + lane] = h;
                    }
                }
                {
                    const float* cbw = INP(I_CBW) + (size_t)l * 3 * BW;
                    for (int it = gt; it < (MT / 16) * 32; it += NGT) {
                        const int rb = it >> 5, c0 = (it & 31) * 8;
                        int b, t0, T, rowbase; bool smp = rb >= MP / 16;
                        if (!smp) { b = rb >> 8; t0 = (rb & 255) * 16; T = SEQ; rowbase = rb * 16; } else { const int sbk = rb - MP / 16; b = sbk >> 1; t0 = (sbk & 1) * 16; T = TS; rowbase = MP + sbk * 16; }
                        float w0[8], w1[8], w2[8], pm2[8], pm1[8];
#pragma unroll
                        for (int k = 0; k < 8; ++k) { w0[k] = cbw[c0 + k]; w1[k] = cbw[BW + c0 + k]; w2[k] = cbw[2 * BW + c0 + k]; pm2[k] = 0.f; pm1[k] = 0.f; }
                        if (t0 == 0) { if (smp) { const float* st = INP(I_SCB) + ((size_t)(l * BS + b) * 2) * BW + c0;
#pragma unroll
                                for (int k = 0; k < 8; ++k) { pm2[k] = st[k]; pm1[k] = st[BW + k]; } } }
                        else {
#pragma unroll
                            for (int rr = 0; rr < 2; ++rr) { const bf16_t* zr = gZ + (size_t)(rowbase - 2 + rr) * INC; const u32x4 xb = *(const u32x4*)(zr + Z_XB + c0), gc = *(const u32x4*)(zr + Z_GC + c0);
                                float pv[8] = {bflo(xb.x) * bflo(gc.x), bfhi(xb.x) * bfhi(gc.x), bflo(xb.y) * bflo(gc.y), bfhi(xb.y) * bfhi(gc.y), bflo(xb.z) * bflo(gc.z), bfhi(xb.z) * bfhi(gc.z), bflo(xb.w) * bflo(gc.w), bfhi(xb.w) * bfhi(gc.w)};
#pragma unroll
                                for (int k = 0; k < 8; ++k) { if (rr == 0) pm2[k] = pv[k]; else pm1[k] = pv[k]; } }
                        }
                        for (int i = 0; i < 16; ++i) {
                            const bf16_t* zr = gZ + (size_t)(rowbase + i) * INC; const u32x4 xb = *(const u32x4*)(zr + Z_XB + c0), gc = *(const u32x4*)(zr + Z_GC + c0), gb = *(const u32x4*)(zr + Z_GB + c0);
                            const float pv[8] = {bflo(xb.x) * bflo(gc.x), bfhi(xb.x) * bfhi(gc.x), bflo(xb.y) * bflo(gc.y), bfhi(xb.y) * bfhi(gc.y), bflo(xb.z) * bflo(gc.z), bfhi(xb.z) * bfhi(gc.z), bflo(xb.w) * bflo(gc.w), bfhi(xb.w) * bfhi(gc.w)};
                            const float gbv[8] = {bflo(gb.x), bfhi(gb.x), bflo(gb.y), bfhi(gb.y), bflo(gb.z), bfhi(gb.z), bflo(gb.w), bfhi(gb.w)};
                            float yv[8];
#pragma unroll
                            for (int k = 0; k < 8; ++k) { yv[k] = gbv[k] * (w0[k] * pm2[k] + w1[k] * pm1[k] + w2[k] * pv[k]); pm2[k] = pm1[k]; pm1[k] = pv[k]; }
                            u32x4 w; w.x = pk2(yv[0], yv[1]); w.y = pk2(yv[2], yv[3]); w.z = pk2(yv[4], yv[5]); w.w = pk2(yv[6], yv[7]);
                            *(u32x4*)(gY + (size_t)(rowbase + i) * D + 512 + c0) = w;
                        }
                        if (t0 + 16 == T) { float* o = out + (smp ? O_CBS : O_CBP) + ((size_t)(l * 8 + b) * 2) * BW + c0;
#pragma unroll
                            for (int k = 0; k < 8; ++k) { o[k] = pm2[k]; o[BW + k] = pm1[k]; } }
                    }
                }
            } else if (rep == 2) {
                LANE_STATE();
                for (int un = gw; un < 64 + 2048; un += NGW) {
                    int b, hd, rowbase, nrows, ch = 0; bool smp = un < 64;
                    if (smp) { b = un >> 3; hd = un & 7; rowbase = MP + b * TS; nrows = TS; }
                    else { const int v = un - 64; ch = v & 31; hd = (v >> 5) & 7; b = v >> 8; rowbase = b * SEQ + ch * 128; nrows = 128; }
                    const int c = hd * 64 + lane;
                    float carry = 0.f;
                    if (smp) carry = INP(I_SHA)[(size_t)(l * BS + b) * AW + c];
                    else { const float* ag = AGG + (size_t)(un - ch) * 128 + lane; for (int k = 0; k < ch; ++k) carry = ag[(size_t)k * 128] * carry + ag[(size_t)k * 128 + 64]; }
                    float hl = 0.f;
                    for (int i0 = 0; i0 < nrows; i0 += 8) {
                        float hv[8], pv[8], gv[8];
#pragma unroll
                        for (int k = 0; k < 8; ++k) { const size_t row = (size_t)(rowbase + i0 + k); hv[k] = HLOC[row * AW + c]; pv[k] = PCUM[row * AW + c]; gv[k] = bf2f(gZ[row * INC + Z_GA + c]); }
#pragma unroll
                        for (int k = 0; k < 8; ++k) { const size_t row = (size_t)(rowbase + i0 + k); hl = hv[k] + pv[k] * carry; gY[row * D + c] = (bf16_t)f2bf(gelu_t(gv[k]) * hl); }
                    }
                    if (smp || ch == 31) {
                        out[(smp ? O_HAS : O_HAP) + (size_t)(l * 8 + b) * AW + c] = hl;
                        float* o = out + (smp ? O_CAS : O_CAP) + ((size_t)(l * 8 + b) * 3) * AW + c;
#pragma unroll
                        for (int k = 0; k < 3; ++k) o[k * AW] = bf2f(gZ[(size_t)(rowbase + nrows - 3 + k) * INC + Z_XA + c]);
                    }
                }
            } else if (rep == 3 || rep == 8 || rep == 12) {
                LANE_STATE();
                GEMM_RES(rep == 3 ? 0 : (rep == 8 ? 1 : 2));
            } else if (rep == 6) {
                LANE_STATE();
                for (int sub = 0; sub < 2; ++sub) {
                    pg8::GSched S; pg8::Gemm g; pg8::EpiSoftmax E;
                    if (sub == 0) { S.init(MP / 256, 4, G, bid); S.aPm = (size_t)256 * D * 2; S.aPn = 512; S.bPn = 512; S.bPm = (size_t)256 * D * 2; S.bShift = 4; g = pg8::Gemm{gQ, KBP, D, D, 256}; E.O = gP; E.ldc = D; E.smp = 0; }
                    else { S.init(1, 32, G, (bid + G - 64) % G); S.mode = 1; g = pg8::Gemm{gQ + (size_t)MP * D, KBS, D, D, 256}; E.O = PS; E.ldc = 8192; E.smp = 1; }
                    pg8::gemm_phase<pg8::EpiSoftmax, pg8::GSched, true>(lds, g, S, E, wave_s);
                }
            } else if (rep == 11) {
                LANE_STATE();
        {
            const float* cfw = INP(I_CFW) + (size_t)l * 3 * DFF;
            for (int it = gt; it < (MT / 16) * (DFF / 8); it += NGT) {
                const int rb = it / (DFF / 8), c0 = (it % (DFF / 8)) * 8;
                int b, t0, T, rowbase; bool smp = rb >= MP / 16;
                if (!smp) { b = rb >> 8; t0 = (rb & 255) * 16; T = SEQ; rowbase = rb * 16; } else { const int sbk = rb - MP / 16; b = sbk >> 1; t0 = (sbk & 1) * 16; T = TS; rowbase = MP + sbk * 16; }
                float w0[8], w1[8], w2[8], gm2[8], gm1[8];
#pragma unroll
                for (int k = 0; k < 8; ++k) { w0[k] = cfw[c0 + k]; w1[k] = cfw[DFF + c0 + k]; w2[k] = cfw[2 * DFF + c0 + k]; gm2[k] = 0.f; gm1[k] = 0.f; }
                if (t0 == 0) { if (smp) { const float* st = INP(I_SCF) + ((size_t)(l * BS + b) * 2) * DFF + c0;
#pragma unroll
                        for (int k = 0; k < 8; ++k) { gm2[k] = st[k]; gm1[k] = st[DFF + k]; } } }
                else {
                    const u32x4 ga = *(const u32x4*)(GU + (size_t)(rowbase - 2) * (2 * DFF) + c0), gb = *(const u32x4*)(GU + (size_t)(rowbase - 1) * (2 * DFF) + c0);
                    const float a_[8] = {bflo(ga.x), bfhi(ga.x), bflo(ga.y), bfhi(ga.y), bflo(ga.z), bfhi(ga.z), bflo(ga.w), bfhi(ga.w)};
                    const float b_[8] = {bflo(gb.x), bfhi(gb.x), bflo(gb.y), bfhi(gb.y), bflo(gb.z), bfhi(gb.z), bflo(gb.w), bfhi(gb.w)};
#pragma unroll
                    for (int k = 0; k < 8; ++k) { gm2[k] = a_[k]; gm1[k] = b_[k]; }
                }
                for (int i = 0; i < 16; ++i) {
                    bf16_t* gr = GU + (size_t)(rowbase + i) * (2 * DFF) + c0;
                    const u32x4 gq = *(const u32x4*)gr, uq = *(const u32x4*)(gr + DFF);
                    const float gv[8] = {bflo(gq.x), bfhi(gq.x), bflo(gq.y), bfhi(gq.y), bflo(gq.z), bfhi(gq.z), bflo(gq.w), bfhi(gq.w)};
                    const float uv[8] = {bflo(uq.x), bfhi(uq.x), bflo(uq.y), bfhi(uq.y), bflo(uq.z), bfhi(uq.z), bflo(uq.w), bfhi(uq.w)};
                    float hv[8];
#pragma unroll
                    for (int k = 0; k < 8; ++k) { const float cv = w0[k] * gm2[k] + w1[k] * gm1[k] + w2[k] * gv[k]; hv[k] = silu(cv) * uv[k]; gm2[k] = gm1[k]; gm1[k] = gv[k]; }
                    u32x4 w; w.x = pk2(hv[0], hv[1]); w.y = pk2(hv[2], hv[3]); w.z = pk2(hv[4], hv[5]); w.w = pk2(hv[6], hv[7]);
                    *(u32x4*)(gr + DFF) = w;
                }
                if (t0 + 16 == T) { float* o = out + (smp ? O_CFS : O_CFP) + ((size_t)(l * 8 + b) * 2) * DFF + c0;
#pragma unroll
                    for (int k = 0; k < 8; ++k) { o[k] = gm2[k]; o[DFF + k] = gm1[k]; } }
            }
        }
            }
            GRID_SYNC();
          }
        }
    }
    {
        LANE_STATE();
        const float* gain = INP(I_GFIN);
        f32x4 gv[4];
#pragma unroll
        for (int j = 0; j < 4; ++j) gv[j] = ((const f32x4*)gain)[lane + 64 * j];
        for (int m = gw; m < MT; m += NGW) {
            f32x4* yr = (f32x4*)(out + (size_t)m * D) + lane; const u32x2* xr = (const u32x2*)(XN + (size_t)m * D) + lane;
            const float rstd = ss_rstd(*(const f32x4*)(SSQ(6) + (size_t)m * 4));
#pragma unroll
            for (int j = 0; j < 4; ++j) { const u32x2 p = xr[64 * j]; yr[64 * j] = (f32x4){bflo(p.x), bfhi(p.x), bflo(p.y), bfhi(p.y)} * rstd * gv[j]; }
        }
    }
}

extern "C" void kernel_launch(void* const* d_in, const int* in_sizes, int n_in, void* d_out, int out_size, void* d_ws, size_t ws_size, hipStream_t stream) {
    static int grid = 0;
    if (grid == 0) {
        if (n_in != N_IN || (size_t)out_size != O_END || ws_size < WS_END) { fprintf(stderr, "kernel_launch: unexpected sizes n_in %d out %d ws %zu (need %zu)\n", n_in, out_size, ws_size, (size_t)WS_END); grid = -1; return; }
        int dev = 0, cus = 0, per_cu = 0;
        (void)hipGetDevice(&dev); (void)hipDeviceGetAttribute(&cus, hipDeviceAttributeMultiprocessorCount, dev);
        if (hipFuncSetAttribute((const void*)trunk_fwd, hipFuncAttributeMaxDynamicSharedMemorySize, LDS_BYTES) != hipSuccess) { fprintf(stderr, "kernel_launch: hipFuncSetAttribute failed\n"); grid = -1; return; }
        if (hipOccupancyMaxActiveBlocksPerMultiprocessor(&per_cu, (const void*)trunk_fwd, NTHREADS, LDS_BYTES) != hipSuccess || per_cu < 1) { fprintf(stderr, "kernel_launch: occupancy query gave %d\n", per_cu); per_cu = 1; }
        (void)hipGetLastError();
        grid = cus * 1;
        if (grid != 256) fprintf(stderr, "kernel_launch: note: %d CUs\n", grid);
    }
    if (grid < 0) return;
    Args a{};
    for (int i = 0; i < N_IN; ++i) a.in[i] = (const float*)d_in[i];
    a.out = (float*)d_out; a.ws = (unsigned char*)d_ws;
    void* kargs[] = {&a};
    hipError_t e = hipLaunchCooperativeKernel((const void*)trunk_fwd, dim3(grid), dim3(NTHREADS), kargs, LDS_BYTES, stream);
    if (e != hipSuccess) fprintf(stderr, "kernel_launch: cooperative launch failed: %s (grid %d)\n", hipGetErrorString(e), grid);
}
```

```cpp
#include <hip/hip_runtime.h>
#include <hip/hip_cooperative_groups.h>
#include <cstdio>
#include <cstdint>
namespace cg = cooperative_groups;
#ifndef PROBE
#define PROBE 0
#endif

#define LAS __attribute__((address_space(3)))
typedef unsigned short bf16_t;
typedef short bf16x8 __attribute__((ext_vector_type(8)));
typedef float f32x4 __attribute__((ext_vector_type(4)));
typedef float f32x2 __attribute__((ext_vector_type(2)));
typedef unsigned u32x4 __attribute__((ext_vector_type(4)));
typedef unsigned u32x2 __attribute__((ext_vector_type(2)));

constexpr int D = 1024, BP = 8, SEQ = 4096, BS = 8, TS = 32, DEPTH = 2;
constexpr int MP = BP * SEQ, MS = BS * TS, MT = MP + MS;
constexpr int INC = 2304, DFF = 2816, NMEM = 256, AW = 512, BW = 256, CW = 256;
constexpr int Z_XA = 0, Z_GA = 512, Z_XB = 1024, Z_GB = 1280, Z_GC = 1536, Z_UC = 1792, Z_VC = 2048;
constexpr float EPS = 1e-6f;
constexpr int NWAVES = 8, NTHREADS = 512;

constexpr size_t O_YP = 0, O_YS = O_YP + (size_t)MP * D, O_CAP = O_YS + (size_t)MS * D, O_HAP = O_CAP + DEPTH * BP * 3 * AW,
                 O_CBP = O_HAP + DEPTH * BP * AW, O_CFP = O_CBP + DEPTH * BP * 2 * BW, O_MKP = O_CFP + DEPTH * BP * 2 * DFF,
                 O_MVP = O_MKP + (size_t)DEPTH * BP * NMEM * D, O_CAS = O_MVP + (size_t)DEPTH * BP * NMEM * D, O_HAS = O_CAS + DEPTH * BS * 3 * AW,
                 O_CBS = O_HAS + DEPTH * BS * AW, O_CFS = O_CBS + DEPTH * BS * 2 * BW, O_VCS = O_CFS + DEPTH * BS * 2 * DFF,
                 O_END = O_VCS + DEPTH * BS * TS * CW;

constexpr size_t MiB = 1u << 20;
constexpr size_t WS_WIN = 0, WS_WOUT = 5 * MiB, WS_WQ = 7 * MiB, WS_WK = 9 * MiB, WS_WV = 11 * MiB, WS_WO = 13 * MiB, WS_WUP = 15 * MiB, WS_WDN = 26 * MiB;
constexpr size_t WS_MEMB = 32 * MiB, WS_KBP = 36 * MiB, WS_VTP = 40 * MiB, WS_KBS = 44 * MiB, WS_VTS = 48 * MiB, WS_WST = 52 * MiB, WS_GT = WS_WST + 131072, WS_AGG = 53 * MiB, WS_SS = 54 * MiB + 256 * 1024, WS_BAR = 55 * MiB + 512 * 1024;
constexpr size_t WS_XN = 56 * MiB, WS_BIG = 121 * MiB;
constexpr size_t B_Z = WS_BIG, B_HLOC = WS_BIG + 146 * MiB, B_PCUM = WS_BIG + 211 * MiB, B_Y = WS_BIG + 276 * MiB;
constexpr size_t B_Q = WS_BIG, B_P = WS_BIG + 65 * MiB, B_O = WS_BIG + 130 * MiB, B_PS = WS_BIG + 195 * MiB;
constexpr size_t B_GU = WS_BIG;
constexpr size_t B_GUS = WS_BIG + 200 * MiB;
constexpr size_t B_SBG = WS_BIG + 204 * MiB, B_SBU = WS_BIG + 207 * MiB, B_SBL = WS_BIG + 210 * MiB;
constexpr size_t WS_END = WS_BIG + (size_t)MT * 2 * DFF * 2;
constexpr size_t WS_SSP = 476 * MiB;
static_assert(WS_END <= WS_SSP && WS_SSP + (size_t)7 * MT * 64 <= 512 * MiB, "workspace");
static_assert(WS_XN + (size_t)MT * D * 2 <= WS_BIG, "xn");

constexpr int LDS_RING = 131072, LDS_EX = LDS_RING, LDS_MISC = LDS_EX + 8192, LDS_BYTES = 147456;

enum { I_XP = 0, I_XS, I_MEM, I_CK, I_CV, I_SCA, I_SHA, I_SCB, I_SCF, I_GMIX, I_WIN, I_CAW, I_CAB, I_WRG, I_BRG, I_WIG, I_BIG, I_LAM, I_CBW, I_GV, I_WS, I_BSS,
       I_WOUT, I_GX, I_WQ, I_WK, I_WV, I_WO, I_GFFN, I_WUP, I_CFW, I_WDN, I_GFIN, N_IN };

struct Args { const float* in[N_IN]; float* out; unsigned char* ws; };

__device__ __forceinline__ unsigned f2bf(float f) { unsigned u = __builtin_bit_cast(unsigned, f); return (u + 0x7fffu + ((u >> 16) & 1u)) >> 16; }
__device__ __forceinline__ unsigned pk2(float lo, float hi) { return f2bf(lo) | (f2bf(hi) << 16); }
__device__ __forceinline__ float bf2f(unsigned v) { return __builtin_bit_cast(float, v << 16); }
__device__ __forceinline__ float bflo(unsigned w) { return __builtin_bit_cast(float, w << 16); }
__device__ __forceinline__ float bfhi(unsigned w) { return __builtin_bit_cast(float, w & 0xffff0000u); }
__device__ __forceinline__ unsigned cvt_pk_bf16(float lo, float hi) { unsigned r; asm volatile("v_cvt_pk_bf16_f32 %0, %1, %2" : "=v"(r) : "v"(lo), "v"(hi)); return r; }
__device__ __forceinline__ float fexp(float x) { return __builtin_amdgcn_exp2f(x * 1.4426950408889634f); }
__device__ __forceinline__ float sigm(float x) { return __builtin_amdgcn_rcpf(1.0f + fexp(-x)); }
__device__ __forceinline__ float gelu_t(float x) { const float u = 0.7978845608028654f * (x + 0.044715f * x * x * x); return x * sigm(2.0f * u); }
__device__ __forceinline__ float silu(float x) { return x * sigm(x); }
__device__ __forceinline__ float shx(float v, int m, int lane) { return __builtin_bit_cast(float, __builtin_amdgcn_ds_bpermute((lane ^ m) << 2, __builtin_bit_cast(int, v))); }
__device__ __forceinline__ float wave_sum(float v, int lane) {
#pragma unroll
    for (int o = 1; o < 64; o <<= 1) v += shx(v, o, lane);
    return v;
}
#define LDS_WAIT() asm volatile("s_waitcnt lgkmcnt(0)" ::: "memory")
__device__ __forceinline__ float ss_rstd(f32x4 p) { return 1.0f / sqrtf(((p[0] + p[1]) + (p[2] + p[3])) * (1.f / 1024.f) + 1e-6f); }
__device__ __forceinline__ int opaque_tid(int wave_s) { int l; asm volatile("v_mbcnt_lo_u32_b32 %0, -1, 0\n\tv_mbcnt_hi_u32_b32 %0, -1, %0" : "=v"(l)); return wave_s * 64 + l; }

namespace pg8 {
constexpr int BM = 256, BK = 64, HALF = 128, HTB = HALF * BK * 2, NXCD = 8, WGM = 8;
__device__ __forceinline__ int lds_byte(int r, int c) { const int st = (r >> 4) * 2 + (c >> 5), rr = r & 15, cc = c & 31, ob = rr * 64 + cc * 2; return st * 1024 + (ob ^ (((ob >> 9) & 1) << 5)); }
__device__ __forceinline__ void stage_rc(int b, int& R, int& C) { const int st = b / 1024, sb = b % 1024, swz = sb ^ (((sb >> 9) & 1) << 5); R = (st >> 1) * 16 + swz / 64; C = (st & 1) * 32 + (swz % 64) / 2; }
__device__ __forceinline__ int perm32(int rho) { const int n = rho >> 4, i = rho & 15; return 8 * (i >> 2) + 4 * n + (i & 3); }

struct Unit { int pm, pn; };
struct Gemm { const bf16_t* A; const bf16_t* Bt; int lda, ldb, K; };

struct GSched {
    int nM, nN, nwg, G, c, mode;
    size_t aPm, aPn, bPn, bPm; int bShift;
    __device__ __forceinline__ void init(int nM_, int nN_, int G_, int c_) { nM = nM_; nN = nN_; nwg = nM * nN; G = G_; c = c_; mode = 0; aPm = 0; aPn = 0; bPn = 0; bPm = 0; bShift = 0; }
    __device__ __forceinline__ bool next(int i, Unit& u) const {
        const long L = (long)i * G + c; if (L >= nwg) return false;
        int wgid = (int)L; { const int q = nwg / NXCD, r = nwg % NXCD, xcd = wgid % NXCD, off = wgid / NXCD; wgid = (xcd < r ? xcd * (q + 1) : r * (q + 1) + (xcd - r) * q) + off; }
        const int nig = WGM * nN, gid = wgid / nig, fm = gid * WGM, gsz = (nM - fm) < WGM ? (nM - fm) : WGM;
        u.pm = fm + ((wgid % nig) % gsz); u.pn = (wgid % nig) / gsz; return true;
    }
    __device__ __forceinline__ size_t offA(const Unit& u) const { return mode == 1 ? (size_t)(u.pn & 3) * 512 : (size_t)u.pm * aPm + (size_t)u.pn * aPn; }
    __device__ __forceinline__ size_t offB(const Unit& u) const { return mode == 1 ? (size_t)(u.pn >> 2) * (256 * 1024 * 2) + (size_t)(u.pn & 3) * 512 : (size_t)u.pn * bPn + (size_t)(u.pm >> bShift) * bPm; }
};

struct EpiBf16 {
    static constexpr bool PERM = true;
    bf16_t* O; int ldc; float scale; const float* ss;
    __device__ __forceinline__ void operator()(f32x4 (&acc)[2][2][4][2], const Unit& u, int wr, int wc, int fr, int fq, LAS unsigned char*) const {
        asm volatile("" : "+v"(fr), "+v"(fq)); asm volatile("" : "+s"(wr), "+s"(wc));
        const int row0 = u.pm * BM + wr * 64 + fr, col0 = u.pn * BM + wc * 32 + 8 * fq;
        f32x4 rs[2][4];
#pragma unroll
        for (int ai = 0; ai < 2; ++ai)
#pragma unroll
            for (int m = 0; m < 4; ++m) rs[ai][m] = ss ? *(const f32x4*)(ss + (size_t)(row0 + ai * HALF + m * 16) * 4) : (f32x4){0.f, 0.f, 0.f, 0.f};
#pragma unroll
        for (int ai = 0; ai < 2; ++ai)
#pragma unroll
            for (int m = 0; m < 4; ++m) { bf16_t* rowp = O + (size_t)(row0 + ai * HALF + m * 16) * ldc + col0;
                float sc = scale; if (ss) sc *= ss_rstd(rs[ai][m]);
#pragma unroll
                for (int bj = 0; bj < 2; ++bj) { const f32x4 v0 = acc[ai][bj][m][0] * sc, v1 = acc[ai][bj][m][1] * sc;
                    u32x4 w; w.x = cvt_pk_bf16(v0[0], v0[1]); w.y = cvt_pk_bf16(v0[2], v0[3]); w.z = cvt_pk_bf16(v1[0], v1[1]); w.w = cvt_pk_bf16(v1[2], v1[3]);
                    *(u32x4*)(rowp + bj * HALF) = w; } }
    }
};
struct EpiResid {
    static constexpr bool PERM = false;
    bf16_t* xb; float* ss;
    __device__ __forceinline__ void operator()(f32x4 (&acc)[2][2][4][2], const Unit& u, int wr, int wc, int fr, int fq, LAS unsigned char* lds) const {
        asm volatile("" : "+v"(fr), "+v"(fq)); asm volatile("" : "+s"(wr), "+s"(wc));
        const int col0 = u.pn * BM + wc * 32 + 4 * fq, lane = fq * 16 + fr;
        LAS float* PS = (LAS float*)(lds + LDS_EX);
        bf16_t* ob = xb + (size_t)u.pm * BM * D;
#pragma unroll
        for (int ai = 0; ai < 2; ++ai) {
            u32x2 pre[4][2][2];
#pragma unroll
            for (int m = 0; m < 4; ++m)
#pragma unroll
                for (int bj = 0; bj < 2; ++bj)
#pragma unroll
                    for (int n = 0; n < 2; ++n) pre[m][bj][n] = *(const u32x2*)(ob + (size_t)(ai * HALF + wr * 64 + m * 16 + fr) * D + col0 + bj * HALF + n * 16);
            asm volatile("" ::: "memory");
#pragma unroll
            for (int m = 0; m < 4; ++m) { const int rl = ai * HALF + wr * 64 + m * 16 + fr; const size_t off = (size_t)rl * D + col0; float q = 0.f;
#pragma unroll
                for (int bj = 0; bj < 2; ++bj)
#pragma unroll
                    for (int n = 0; n < 2; ++n) { const u32x2 p = pre[m][bj][n]; const f32x4 a = acc[ai][bj][m][n];
                        const float v0 = bflo(p.x) + a[0], v1 = bfhi(p.x) + a[1], v2 = bflo(p.y) + a[2], v3 = bfhi(p.y) + a[3];
                        u32x2 w; w.x = cvt_pk_bf16(v0, v1); w.y = cvt_pk_bf16(v2, v3); *(u32x2*)(ob + off + bj * HALF + n * 16) = w;
                        q += (v0 * v0 + v1 * v1) + (v2 * v2 + v3 * v3); }
                q += shx(q, 16, lane); q += shx(q, 32, lane);
                if (fq == 0) PS[rl * 4 + wc] = q; }
            asm volatile("" ::: "memory");
        }
        asm volatile("s_waitcnt lgkmcnt(0)" ::: "memory"); __builtin_amdgcn_s_barrier(); asm volatile("" ::: "memory");
        { const int t = (wr * 4 + wc) * 64 + lane; if (t < 256) { const f32x4 p = *(const LAS f32x4*)(PS + t * 4); ss[(size_t)(u.pm * BM + t) * 4 + u.pn] = (p[0] + p[1]) + (p[2] + p[3]); } }
    }
};
struct EpiKV {
    static constexpr bool PERM = false;
    float* outK; float* outV; bf16_t* KB; bf16_t* VT;
    __device__ __forceinline__ void operator()(f32x4 (&acc)[2][2][4][2], const Unit& u, int wr, int wc, int fr, int fq, LAS unsigned char*) const {
        asm volatile("" : "+v"(fr), "+v"(fq)); asm volatile("" : "+s"(wr), "+s"(wc));
        const int kind = u.pm >> 4, pm = u.pm & 15;
        const int col0 = u.pn * BM + wc * 32 + 4 * fq;
        float* of = kind == 0 ? outK : outV; bf16_t* ob = kind == 0 ? KB : VT; const int ldb_ = kind == 2 ? 2048 : 1024;
#pragma unroll
        for (int ai = 0; ai < 2; ++ai)
#pragma unroll
            for (int m = 0; m < 4; ++m) { const int row = pm * BM + ai * HALF + wr * 64 + m * 16 + fr;
#pragma unroll
                for (int bj = 0; bj < 2; ++bj)
#pragma unroll
                    for (int n = 0; n < 2; ++n) { const f32x4 v = acc[ai][bj][m][n]; const int col = col0 + bj * HALF + n * 16;
                        if (kind != 2) *(f32x4*)(of + (size_t)row * 1024 + col) = v;
                        if (kind != 1) { u32x2 w; w.x = cvt_pk_bf16(v[0], v[1]); w.y = cvt_pk_bf16(v[2], v[3]); *(u32x2*)(ob + (size_t)row * ldb_ + col) = w; } } }
    }
};
struct EpiSoftmax {
    static constexpr bool PERM = true;
    bf16_t* O; int ldc; int smp;
    __device__ __forceinline__ void operator()(f32x4 (&acc)[2][2][4][2], const Unit& u, int wr, int wc, int fr, int fq, LAS unsigned char* lds) const {
        asm volatile("" : "+v"(fr), "+v"(fq)); asm volatile("" : "+s"(wr), "+s"(wc));
        LAS f32x2* EX = (LAS f32x2*)(lds + LDS_EX);
        const int lane = fq * 16 + fr;
        const float L2E = 1.4426950408889634f;
#pragma unroll
        for (int ai = 0; ai < 2; ++ai)
#pragma unroll
            for (int m = 0; m < 4; ++m) {
                float mx = -3.0e38f;
#pragma unroll
                for (int bj = 0; bj < 2; ++bj)
#pragma unroll
                    for (int n = 0; n < 2; ++n) { const f32x4 x = acc[ai][bj][m][n]; mx = fmaxf(mx, fmaxf(fmaxf(x[0], x[1]), fmaxf(x[2], x[3]))); }
                mx = fmaxf(mx, shx(mx, 16, lane)); mx = fmaxf(mx, shx(mx, 32, lane));
                float s = 0.f;
#pragma unroll
                for (int bj = 0; bj < 2; ++bj)
#pragma unroll
                    for (int n = 0; n < 2; ++n) { f32x4 x = acc[ai][bj][m][n];
#pragma unroll
                        for (int j = 0; j < 4; ++j) { x[j] = __builtin_amdgcn_exp2f((x[j] - mx) * L2E); s += x[j]; }
                        acc[ai][bj][m][n] = x; }
                s += shx(s, 16, lane); s += shx(s, 32, lane);
                if (fq == 0) EX[(ai * HALF + wr * 64 + m * 16 + fr) * 4 + wc] = (f32x2){mx, s};
            }
        asm volatile("s_waitcnt lgkmcnt(0)" ::: "memory"); __builtin_amdgcn_s_barrier(); asm volatile("" ::: "memory");
        int colb = u.pn * BM, j_ = 0;
        if (smp) { colb = (u.pn & 3) * 2048 + (u.pn >> 2) * 256; j_ = u.pn >> 2; }
        const int col0 = colb + wc * 32 + 8 * fq;
#pragma unroll
        for (int ai = 0; ai < 2; ++ai)
#pragma unroll
            for (int m = 0; m < 4; ++m) {
                const int rl = ai * HALF + wr * 64 + m * 16 + fr;
                const f32x2 e0 = EX[rl * 4 + 0], e1 = EX[rl * 4 + 1], e2 = EX[rl * 4 + 2], e3 = EX[rl * 4 + 3];
                const float M = fmaxf(fmaxf(e0.x, e1.x), fmaxf(e2.x, e3.x));
                const float tot = e0.y * __builtin_amdgcn_exp2f((e0.x - M) * L2E) + e1.y * __builtin_amdgcn_exp2f((e1.x - M) * L2E) + e2.y * __builtin_amdgcn_exp2f((e2.x - M) * L2E) + e3.y * __builtin_amdgcn_exp2f((e3.x - M) * L2E);
                const float own = wc == 0 ? e0.x : (wc == 1 ? e1.x : (wc == 2 ? e2.x : e3.x));
                float f = __builtin_amdgcn_exp2f((own - M) * L2E) / tot;
                if (smp && (rl >> 5) != j_) f = 0.f;
                bf16_t* rowp = O + (size_t)(u.pm * BM + rl) * ldc + col0;
#pragma unroll
                for (int bj = 0; bj < 2; ++bj) { const f32x4 v0 = acc[ai][bj][m][0] * f, v1 = acc[ai][bj][m][1] * f;
                    u32x4 w; w.x = cvt_pk_bf16(v0[0], v0[1]); w.y = cvt_pk_bf16(v0[2], v0[3]); w.z = cvt_pk_bf16(v1[0], v1[1]); w.w = cvt_pk_bf16(v1[2], v1[3]);
                    *(u32x4*)(rowp + bj * HALF) = w; } }
    }
};


__device__ __forceinline__ float dpp_ror1(float v) { return __builtin_bit_cast(float, __builtin_amdgcn_update_dpp(0, __builtin_bit_cast(int, v), 0x121, 0xf, 0xf, false)); }
__device__ __forceinline__ float dpp_ror2(float v) { return __builtin_bit_cast(float, __builtin_amdgcn_update_dpp(0, __builtin_bit_cast(int, v), 0x122, 0xf, 0xf, false)); }
struct EpiAct {
    static constexpr bool PERM = true;
    bf16_t* H; bf16_t* GUs; float* sbg; float* sbu; float* sbl; const float* cfw; const float* ss;
    __device__ __forceinline__ void operator()(f32x4 (&acc)[2][2][4][2], const Unit& u, int wr, int wc, int fr, int fq, LAS unsigned char* lds) const {
        asm volatile("" : "+s"(wr), "+s"(wc));
        int lane; asm volatile("v_mbcnt_lo_u32_b32 %0, -1, 0\n\tv_mbcnt_hi_u32_b32 %0, -1, %0" : "=v"(lane));
        fr = lane & 15; fq = lane >> 4;
        const int fl = wc * 32 + 8 * fq, f0 = u.pn * 128 + fl; int rowt = wr * 64 + fr;
        {
            float rst[2][4];
            f32x4 rsl[2][4];
#pragma unroll
            for (int ai = 0; ai < 2; ++ai)
#pragma unroll
                for (int m = 0; m < 4; ++m) rsl[ai][m] = *(const f32x4*)(ss + (size_t)(u.pm * BM + ai * HALF + rowt + m * 16) * 4);
#pragma unroll
            for (int ai = 0; ai < 2; ++ai)
#pragma unroll
                for (int m = 0; m < 4; ++m) { rst[ai][m] = ss_rstd(rsl[ai][m]); }
#pragma unroll
            for (int ai = 0; ai < 2; ++ai)
#pragma unroll
                for (int m = 0; m < 4; ++m) { acc[ai][0][m][0] = acc[ai][0][m][0] * rst[ai][m]; acc[ai][0][m][1] = acc[ai][0][m][1] * rst[ai][m]; acc[ai][1][m][0] = acc[ai][1][m][0] * rst[ai][m]; acc[ai][1][m][1] = acc[ai][1][m][1] * rst[ai][m]; }
        }
        if (u.pm == 128) {
#pragma unroll
            for (int ai = 0; ai < 2; ++ai)
#pragma unroll
                for (int m = 0; m < 4; ++m) { bf16_t* rp = GUs + (size_t)(ai * HALF + rowt + m * 16) * (2 * DFF) + f0; const float sc = 1.f;
#pragma unroll
                    for (int bj = 0; bj < 2; ++bj) { const f32x4 v0 = acc[ai][bj][m][0] * sc, v1 = acc[ai][bj][m][1] * sc;
                        u32x4 w; w.x = cvt_pk_bf16(v0[0], v0[1]); w.y = cvt_pk_bf16(v0[2], v0[3]); w.z = cvt_pk_bf16(v1[0], v1[1]); w.w = cvt_pk_bf16(v1[2], v1[3]);
                        *(u32x4*)(rp + bj * DFF) = w; } }
            return;
        }
        asm volatile("" : "+v"(rowt));
        LAS float* BND = (LAS float*)(lds + LDS_EX);
        if (fr >= 14) {
#pragma unroll
            for (int ai = 0; ai < 2; ++ai)
#pragma unroll
                for (int n = 0; n < 2; ++n) *(LAS f32x4*)(BND + ((ai * 2 + wr) * 2 + (fr - 14)) * 128 + fl + 4 * n) = acc[ai][0][3][n];
            if (wr == 1) {
#pragma unroll
                for (int n = 0; n < 2; ++n) *(f32x4*)(sbl + ((size_t)u.pm * 2 + (fr - 14)) * DFF + f0 + 4 * n) = acc[1][0][3][n];
            }
        }
        asm volatile("s_waitcnt lgkmcnt(0)" ::: "memory"); __builtin_amdgcn_s_barrier(); asm volatile("" ::: "memory");
#pragma unroll
        for (int ai = 0; ai < 2; ++ai) {
            const int pg = wr == 1 ? ai * 2 : 1;
#pragma unroll
            for (int n = 0; n < 2; ++n) {
                const f32x4 w0 = *(const f32x4*)(cfw + f0 + 4 * n), w1 = *(const f32x4*)(cfw + DFF + f0 + 4 * n), w2 = *(const f32x4*)(cfw + 2 * DFF + f0 + 4 * n);
                const f32x4 h2 = *(const LAS f32x4*)(BND + (pg * 2 + 0) * 128 + fl + 4 * n), h1 = *(const LAS f32x4*)(BND + (pg * 2 + 1) * 128 + fl + 4 * n);
                u32x2 hp[4];
#pragma unroll
                for (int jp = 0; jp < 2; ++jp) {
                    float hv[4][2];
#pragma unroll
                    for (int jj = 0; jj < 2; ++jj) { const int j = jp * 2 + jj;
                        float r1p = h1[j], r2p = fr == 0 ? h2[j] : h1[j];
#pragma unroll
                        for (int m = 0; m < 4; ++m) { const float g = acc[ai][0][m][n][j];
                            const float r1 = dpp_ror1(g), r2 = dpp_ror2(g);
                            const float gm1 = fr >= 1 ? r1 : r1p, gm2 = fr >= 2 ? r2 : r2p;
                            r1p = r1; r2p = r2;
                            const float cv = w0[j] * gm2 + w1[j] * gm1 + w2[j] * g;
                            hv[m][jj] = silu(cv) * acc[ai][1][m][n][j]; } }
#pragma unroll
                    for (int m = 0; m < 4; ++m) { const unsigned pk = cvt_pk_bf16(hv[m][0], hv[m][1]); if (jp == 0) hp[m].x = pk; else hp[m].y = pk; }
                }
#pragma unroll
                for (int m = 0; m < 4; ++m) {
                    const int rl = ai * HALF + rowt + m * 16;
                    if (ai == 0 && m == 0 && wr == 0 && fr < 2) {
                        *(f32x4*)(sbg + ((size_t)u.pm * 2 + fr) * DFF + f0 + 4 * n) = acc[0][0][0][n]; *(f32x4*)(sbu + ((size_t)u.pm * 2 + fr) * DFF + f0 + 4 * n) = acc[0][1][0][n];
                    } else {
                        *(u32x2*)(H + (size_t)(u.pm * BM + rl) * DFF + f0 + 4 * n) = hp[m];
                    }
                }
            }
        }
    }
};

template <class Epi, class Sched, bool ALIGN_EPI>
__device__ __forceinline__ void gemm_phase(LAS unsigned char* lds, const Gemm g, const Sched& S, const Epi& E, const int wave_s) {
    const int tid = opaque_tid(wave_s), wid = __builtin_amdgcn_readfirstlane(tid >> 6), lane = tid & 63, wr = wid >> 2, wc = wid & 3, fr = lane & 15, fq = lane >> 4;
    const int nt = g.K / BK;
    unsigned voffA[2], voffB[2];
#pragma unroll
    for (int i = 0; i < 2; ++i) { int R, C; stage_rc(tid * 16 + i * 8192, R, C); const int Rb = Epi::PERM ? ((R & ~31) + perm32(R & 31)) : R;
        voffA[i] = (unsigned)(R * g.lda + C) * 2u; voffB[i] = (unsigned)(Rb * g.ldb + C) * 2u; }
    const size_t kstep = (size_t)(BK * 2);
    const size_t hstepA = (size_t)HALF * g.lda * 2, hstepB = (size_t)HALF * g.ldb * 2;
    const unsigned ldsw = (unsigned)wid * 1024u;
    const int aoff = lds_byte(wr * 64 + fr, fq * 8), boff = lds_byte(wc * 32 + fr, fq * 8);
#define PG8_SA(b, h) (((b) * 2 + (h)) * HTB)
#define PG8_SB(b, h) ((4 + (b) * 2 + (h)) * HTB)
#define PG8_STAGE(bufoff, gbase, voff) do { _Pragma("unroll") for (int _i = 0; _i < 2; ++_i) \
        __builtin_amdgcn_global_load_lds((const unsigned*)((const char*)(gbase) + (voff)[_i]), (LAS unsigned*)(lds + (bufoff) + ldsw + _i * 8192), 16, 0, 0); } while (0)
#define PG8_LDA(dst, b, h) do { _Pragma("unroll") for (int m = 0; m < 4; ++m) _Pragma("unroll") for (int k = 0; k < 2; ++k) dst[m][k] = *(const LAS bf16x8*)(lds + PG8_SA(b, h) + aoff + m * 2048 + k * 1024); } while (0)
#define PG8_LDB(dst, b, h) do { _Pragma("unroll") for (int n = 0; n < 2; ++n) _Pragma("unroll") for (int k = 0; k < 2; ++k) dst[n][k] = *(const LAS bf16x8*)(lds + PG8_SB(b, h) + boff + n * 2048 + k * 1024); } while (0)
#define PG8_MMA(ai, bj, At, Bt) do { __builtin_amdgcn_s_setprio(1); _Pragma("unroll") for (int m = 0; m < 4; ++m) _Pragma("unroll") for (int n = 0; n < 2; ++n) _Pragma("unroll") for (int k = 0; k < 2; ++k) \
        acc[ai][bj][m][n] = __builtin_amdgcn_mfma_f32_16x16x32_bf16(Bt[n][k], At[m][k], acc[ai][bj][m][n], 0, 0, 0); __builtin_amdgcn_s_setprio(0); } while (0)
#define PG8_WAIT_V(n) asm volatile("s_waitcnt vmcnt(" #n ")" ::: "memory")
#define PG8_WAIT_L(n) asm volatile("s_waitcnt lgkmcnt(" #n ")" ::: "memory")
#define PG8_BAR __builtin_amdgcn_s_barrier()
#define PG8_SCHED __builtin_amdgcn_sched_barrier(0)
    Unit cur, nxt; int ui = 0;
    if (!S.next(0, cur)) return;
    f32x4 acc[2][2][4][2];
#pragma unroll
    for (int a = 0; a < 2; ++a)
#pragma unroll
        for (int b = 0; b < 2; ++b)
#pragma unroll
            for (int m = 0; m < 4; ++m)
#pragma unroll
                for (int n = 0; n < 2; ++n) acc[a][b][m][n] = (f32x4){0.f, 0.f, 0.f, 0.f};
    bf16x8 At[4][2], B0[2][2], B1[2][2];
    const char* cA = (const char*)g.A + S.offA(cur); const char* cB = (const char*)g.Bt + S.offB(cur);
    PG8_STAGE(PG8_SB(0, 0), cB, voffB); PG8_STAGE(PG8_SB(0, 1), cB + hstepB, voffB); PG8_STAGE(PG8_SA(0, 0), cA, voffA); PG8_STAGE(PG8_SA(0, 1), cA + hstepA, voffA);
    if (wr == 1) PG8_BAR;
    PG8_WAIT_V(2); PG8_BAR;
    PG8_STAGE(PG8_SB(1, 0), cB + kstep, voffB); PG8_STAGE(PG8_SA(1, 0), cA + kstep, voffA); PG8_STAGE(PG8_SB(1, 1), cB + hstepB + kstep, voffB);
    PG8_WAIT_V(6); PG8_BAR;
    for (;;) {
        const bool has_next = S.next(ui + 1, nxt);
        const char* nA = has_next ? (const char*)g.A + S.offA(nxt) : cA; const char* nB = has_next ? (const char*)g.Bt + S.offB(nxt) : cB;
        for (int t = 0; t < nt; t += 2) {
            const bool last = (t == nt - 2);
            const char* a1 = cA + (size_t)(t + 1) * kstep;
            const char* a2 = last ? nA : cA + (size_t)(t + 2) * kstep; const char* b2 = last ? nB : cB + (size_t)(t + 2) * kstep;
            const char* a3 = a2 + kstep; const char* b3 = b2 + kstep;
            PG8_LDB(B0, 0, 0); PG8_LDB(B1, 0, 1); PG8_SCHED; PG8_LDA(At, 0, 0); PG8_STAGE(PG8_SA(1, 1), a1 + hstepA, voffA);
            PG8_WAIT_V(8); PG8_WAIT_L(0); PG8_BAR; PG8_MMA(0, 0, At, B0); PG8_MMA(0, 1, At, B1); PG8_BAR; PG8_SCHED;
            PG8_LDA(At, 0, 1); PG8_STAGE(PG8_SB(0, 0), b2, voffB); PG8_STAGE(PG8_SB(0, 1), b2 + hstepB, voffB); PG8_STAGE(PG8_SA(0, 0), a2, voffA);
            PG8_WAIT_V(8); PG8_WAIT_L(0); PG8_BAR; PG8_MMA(1, 0, At, B0); PG8_MMA(1, 1, At, B1); PG8_BAR; PG8_SCHED;
            PG8_LDB(B0, 1, 0); PG8_LDB(B1, 1, 1); PG8_SCHED; PG8_LDA(At, 1, 0); PG8_STAGE(PG8_SA(0, 1), a2 + hstepA, voffA);
            PG8_WAIT_V(8); PG8_WAIT_L(0); PG8_BAR; PG8_MMA(0, 0, At, B0); PG8_MMA(0, 1, At, B1); PG8_BAR; PG8_SCHED;
            PG8_LDA(At, 1, 1); PG8_STAGE(PG8_SB(1, 0), b3, voffB); PG8_STAGE(PG8_SB(1, 1), b3 + hstepB, voffB); PG8_STAGE(PG8_SA(1, 0), a3, voffA);
            PG8_WAIT_V(8); PG8_WAIT_L(0); PG8_BAR; PG8_MMA(1, 0, At, B0); PG8_MMA(1, 1, At, B1); PG8_BAR; PG8_SCHED;
        }
        if constexpr (ALIGN_EPI) { if (wr == 0) PG8_BAR; }
        E(acc, cur, wr, wc, fr, fq, lds);
        if (!has_next) break;
#pragma unroll
        for (int a = 0; a < 2; ++a)
#pragma unroll
            for (int b = 0; b < 2; ++b)
#pragma unroll
                for (int m = 0; m < 4; ++m)
#pragma unroll
                    for (int n = 0; n < 2; ++n) acc[a][b][m][n] = (f32x4){0.f, 0.f, 0.f, 0.f};
        cur = nxt; cA = nA; cB = nB; ++ui;
        if constexpr (ALIGN_EPI) { if (wr == 1) PG8_BAR; }
    }
    PG8_WAIT_V(0);
    if constexpr (!ALIGN_EPI) { if (wr == 0) PG8_BAR; }
    PG8_BAR;
#undef PG8_SA
#undef PG8_SB
#undef PG8_STAGE
#undef PG8_LDA
#undef PG8_LDB
#undef PG8_MMA
#undef PG8_WAIT_V
#undef PG8_WAIT_L
#undef PG8_BAR
#undef PG8_SCHED
}
}

struct KVSched {
    int c, G; const char* ws;
    __device__ __forceinline__ bool next(int i, pg8::Unit& u) const {
        const int L = i * G + c; if (c < 0 || L >= 96) return false;
        const int kind = L >> 5, r = L & 31;
        if (kind < 2) { u.pm = kind * 16 + (r >> 2); u.pn = r & 3; } else { u.pm = 32 + (r >> 3); u.pn = r & 7; }
        return true;
    }
    __device__ __forceinline__ size_t offA(const pg8::Unit& u) const { const int kind = u.pm >> 4, pm = u.pm & 15; int k2 = (kind == 2); asm volatile("" : "+v"(k2));
        return (size_t)ws + WS_MEMB + (size_t)k2 * (WS_WV - WS_MEMB) + (size_t)pm * 256 * 1024 * 2; }
    __device__ __forceinline__ size_t offB(const pg8::Unit& u) const { const int kind = u.pm >> 4; int k1 = (kind == 1), k2 = (kind == 2); asm volatile("" : "+v"(k1), "+v"(k2));
        return (size_t)ws + WS_WK + (size_t)k1 * (WS_WV - WS_WK) + (size_t)k2 * (WS_MEMB - WS_WK) + (size_t)u.pn * 256 * 1024 * 2; }
};


#define XB_TMO      128
#define XB_XCNT(j)  (256  + 64 * (j))
#define XB_XSUB(j)  (1280 + 64 * (j))
#define XB_XGEN(j)  (2304 + 64 * (j))
#define XB_TOP      3328
#define XB_TOPGEN   3392
#define XCD_BAR_WORDS 3456
#define XB_SPIN_CAP (1u << 22)
__device__ __forceinline__ unsigned xb_ld(unsigned* p)              { return __hip_atomic_load(p, __ATOMIC_RELAXED, __HIP_MEMORY_SCOPE_AGENT); }
__device__ __forceinline__ unsigned xb_add(unsigned* p, unsigned v) { return __hip_atomic_fetch_add(p, v, __ATOMIC_RELAXED, __HIP_MEMORY_SCOPE_AGENT); }
__device__ __forceinline__ unsigned xb_xcc_id() { return (unsigned)__builtin_amdgcn_s_getreg((3 << 11) | 20) & 0xFu; }
#define XB_SPIN(cond, bar) do { unsigned _sp = 0; while (cond) { __builtin_amdgcn_s_sleep(1); \
    if ((++_sp & 255u) == 0u) { if (xb_ld(&(bar)[XB_TMO])) break; if (_sp > XB_SPIN_CAP) { atomicAdd(&(bar)[XB_TMO], 1u); break; } } } } while (0)
struct XcdBarrier { unsigned* bar; unsigned x; volatile LAS unsigned* st; };
__device__ __forceinline__ void xcd_barrier_complete(unsigned* bar, unsigned x, unsigned& nloc, unsigned& nx) {
    const unsigned G = gridDim.x * gridDim.y * gridDim.z;
    unsigned sum, cnt, mine, sp = 0u;
    for (;;) {
        sum = 0u; cnt = 0u; mine = 0u;
#pragma unroll
        for (unsigned j = 0; j < 16; ++j) { const unsigned c = xb_ld(&bar[XB_XCNT(j)]); sum += c; cnt += (c > 0u) ? 1u : 0u; mine = (j == x) ? c : mine; }
        if (sum == G) break;
        __builtin_amdgcn_s_sleep(1);
        if ((++sp & 255u) == 0u) { if (xb_ld(&bar[XB_TMO])) break; if (sp > XB_SPIN_CAP) { atomicAdd(&bar[XB_TMO], 1u); break; } }
    }
    nloc = mine > 0u ? mine : 1u; nx = cnt > 0u ? cnt : 1u;
}
__device__ __forceinline__ void xcd_barrier(const XcdBarrier& b) {
    asm volatile("s_waitcnt vmcnt(0)" ::: "memory");
    __syncthreads();
    if (threadIdx.x == 0) {
        unsigned* bar = b.bar;
        __builtin_amdgcn_s_waitcnt(0);
        unsigned nloc = b.st[0], nx = b.st[1];
        if (nloc == 0u) { xcd_barrier_complete(bar, b.x, nloc, nx); b.st[0] = nloc; b.st[1] = nx; }
        const unsigned old = xb_add(&bar[XB_XSUB(b.x)], 1u);
        const unsigned gen = old / nloc;
        if (old + 1u == (gen + 1u) * nloc) {
            __builtin_amdgcn_fence(__ATOMIC_RELEASE, "agent");
            asm volatile("s_waitcnt vmcnt(0)" ::: "memory");
            const unsigned og = xb_add(&bar[XB_TOP], 1u);
            const unsigned tg = og / nx;
            if (og + 1u == (tg + 1u) * nx) xb_add(&bar[XB_TOPGEN], 1u);
            else XB_SPIN(xb_ld(&bar[XB_TOPGEN]) == tg, bar);
            __builtin_amdgcn_fence(__ATOMIC_ACQUIRE, "agent");
            xb_add(&bar[XB_XGEN(b.x)], 1u);
            asm volatile("s_waitcnt vmcnt(0)" ::: "memory");
        } else {
            XB_SPIN(xb_ld(&bar[XB_XGEN(b.x)]) == gen, bar);
            __builtin_amdgcn_fence(__ATOMIC_ACQUIRE, "agent");
            asm volatile("s_waitcnt vmcnt(0)" ::: "memory");
        }
    }
    __syncthreads();
}

__device__ __forceinline__ void transpose_item(const float* W, int K, int N, bf16_t* WT, LAS float* scr, int item, int lane, const float* gain = nullptr, int gu = 0) {
    const int nblk = N / 32, kb = item / nblk, nb = item % nblk, k0 = 64 * kb, n0 = 32 * nb;
#pragma unroll 8
    for (int i = 0; i < 32; ++i) { const int kk = 2 * i + (lane >> 5); float w = W[(size_t)(k0 + kk) * N + n0 + (lane & 31)]; if (gain) w *= gain[k0 + kk]; scr[kk * 33 + (lane & 31)] = w; }
    LDS_WAIT();
    const int c = lane & 7;
#pragma unroll
    for (int j = 0; j < 4; ++j) { const int n = (lane >> 3) + 8 * j; const LAS float* s = scr + (8 * c) * 33 + n;
        u32x4 o; o.x = pk2(s[0 * 33], s[1 * 33]); o.y = pk2(s[2 * 33], s[3 * 33]); o.z = pk2(s[4 * 33], s[5 * 33]); o.w = pk2(s[6 * 33], s[7 * 33]);
        int drow = n0 + n; if (gu) { const int up = drow >= gu, f = up ? drow - gu : drow; drow = ((f >> 7) << 8) + (up << 7) + (f & 127); }
        *(u32x4*)(WT + (size_t)drow * K + k0 + 8 * c) = o; }
    LDS_WAIT();
}

__device__ __forceinline__ void first_rows(const float* Xp, const float* Xs, bf16_t* XNo, float* ss, int gw, int NGW, int lane) {
    for (int m = gw; m < MT; m += NGW) {
        const f32x4* xr = (const f32x4*)(m < MP ? Xp + (size_t)m * D : Xs + (size_t)(m - MP) * D) + lane;
        f32x4 v[4]; float s = 0.f;
#pragma unroll
        for (int j = 0; j < 4; ++j) { v[j] = xr[64 * j]; s += (v[j].x * v[j].x + v[j].y * v[j].y) + (v[j].z * v[j].z + v[j].w * v[j].w); }
        s = wave_sum(s, lane);
        if (lane < 4) ss[(size_t)m * 4 + lane] = lane == 0 ? s : 0.f;
        u32x2* o8 = (u32x2*)(XNo + (size_t)m * D) + lane;
#pragma unroll
        for (int j = 0; j < 4; ++j) { u32x2 w; w.x = pk2(v[j].x, v[j].y); w.y = pk2(v[j].z, v[j].w); o8[64 * j] = w; }
    }
}

typedef __attribute__((address_space(4))) const unsigned char* kptr_t;
typedef const float* cfp_t; typedef float* fp_t; typedef unsigned char* ucp_t;
#define INP(k) (*(const __attribute__((address_space(4))) cfp_t*)(kp + 8 * (k)))
#define X out
#define WIN_T ((bf16_t*)(ws + WS_WIN))
#define WOUT_T ((bf16_t*)(ws + WS_WOUT))
#define WQ_T ((bf16_t*)(ws + WS_WQ))
#define WK_T ((bf16_t*)(ws + WS_WK))
#define WV_T ((bf16_t*)(ws + WS_WV))
#define WO_T ((bf16_t*)(ws + WS_WO))
#define WUP_T ((bf16_t*)(ws + WS_WUP))
#define WDN_T ((bf16_t*)(ws + WS_WDN))
#define MEMB ((bf16_t*)(ws + WS_MEMB))
#define KBP ((bf16_t*)(ws + WS_KBP))
#define VTP ((bf16_t*)(ws + WS_VTP))
#define KBS ((bf16_t*)(ws + WS_KBS))
#define VTS ((bf16_t*)(ws + WS_VTS))
#define WST ((bf16_t*)(ws + WS_WST))
#define AGG ((float*)(ws + WS_AGG))
#define SSQ(i) ((float*)(ws + WS_SSP) + (size_t)(i) * MT * 4)
#define GT_R ((bf16_t*)(ws + WS_GT))
#define GT_I ((bf16_t*)(ws + WS_GT + 65536))
#define XN ((bf16_t*)(ws + WS_XN))
#define gZ ((bf16_t*)(ws + B_Z))
#define HLOC ((float*)(ws + B_HLOC))
#define PCUM ((float*)(ws + B_PCUM))
#define gY ((bf16_t*)(ws + B_Y))
#define gQ ((bf16_t*)(ws + B_Q))
#define gP ((bf16_t*)(ws + B_P))
#define gO ((bf16_t*)(ws + B_O))
#define PS ((bf16_t*)(ws + B_PS))
#define GU ((bf16_t*)(ws + B_GU))
#define GUS ((bf16_t*)(ws + B_GUS))
#define SBG ((float*)(ws + B_SBG))
#define SBU ((float*)(ws + B_SBU))
#define SBL ((float*)(ws + B_SBL))
__global__ void __launch_bounds__(NTHREADS, 2) trunk_fwd(Args args) {
    extern __shared__ __attribute__((aligned(16))) unsigned char lds_raw[];
    LAS unsigned char* lds = (LAS unsigned char*)lds_raw;
    cg::grid_group grid = cg::this_grid();
    const int wave_s = __builtin_amdgcn_readfirstlane(threadIdx.x >> 6);
#define LANE_STATE() int G = gridDim.x, bid = blockIdx.x; asm volatile("" : "+s"(G), "+s"(bid)); const int NGW = G * NWAVES, NGT = G * NTHREADS; (void)NGW; (void)NGT; \
    const int tid = opaque_tid(wave_s), lane = tid & 63, wave = wave_s; const int gw = bid * NWAVES + wave; const int gt = bid * NTHREADS + tid; (void)lane; (void)gw; (void)gt; \
    kptr_t kp = (kptr_t)__builtin_amdgcn_kernarg_segment_ptr(); asm volatile("" : "+s"(kp)); \
    float* const out = *(const __attribute__((address_space(4))) fp_t*)(kp + 8 * N_IN); unsigned char* const ws = *(const __attribute__((address_space(4))) ucp_t*)(kp + 8 * N_IN + 8); (void)out; (void)ws
    {
        LANE_STATE();
        if (bid == 0) for (int i = tid; i < XCD_BAR_WORDS; i += NTHREADS) __hip_atomic_store((unsigned*)(ws + WS_BAR) + i, 0u, __ATOMIC_RELAXED, __HIP_MEMORY_SCOPE_AGENT);
        if (tid < 32) ((LAS unsigned*)(lds + LDS_MISC))[tid] = 0u;
        __threadfence();
        grid.sync();
        if (tid == 0) (void)xb_add((unsigned*)(ws + WS_BAR) + XB_XCNT(xb_xcc_id()), 1u);
    }
#define GRID_SYNC() do { kptr_t kp_ = (kptr_t)__builtin_amdgcn_kernarg_segment_ptr(); asm volatile("" : "+s"(kp_)); \
        XcdBarrier b_; b_.bar = (unsigned*)(*(const __attribute__((address_space(4))) ucp_t*)(kp_ + 8 * N_IN + 8) + WS_BAR); b_.x = xb_xcc_id(); b_.st = (volatile LAS unsigned*)(lds + LDS_MISC); \
        xcd_barrier(b_); if (PROBE == 3) xcd_barrier(b_); } while (0)

    for (int l = 0; l < DEPTH; ++l) {
        for (int dup0 = 0; dup0 < ((PROBE == 1 || PROBE == 5) ? 2 : 1); ++dup0) {
        {
            LANE_STATE();
            LAS float* scr = (LAS float*)(lds + wave * 16384);
            const float* w_in = INP(I_WIN) + (size_t)l * D * INC; const float* w_out = INP(I_WOUT) + (size_t)l * D * D; const float* w_q = INP(I_WQ) + (size_t)l * D * D;
            const float* w_k = INP(I_WK) + (size_t)l * D * D; const float* w_v = INP(I_WV) + (size_t)l * D * D; const float* w_o = INP(I_WO) + (size_t)l * D * D;
            const float* w_up = INP(I_WUP) + (size_t)l * D * 2 * DFF; const float* w_dn = INP(I_WDN) + (size_t)l * DFF * D; const float* c_v = INP(I_CV) + (size_t)l * BS * NMEM * D;
            constexpr int T_IN = 16 * (INC / 32), T_SQ = 16 * 32, T_UP = 16 * (2 * DFF / 32), T_DN = (DFF / 64) * 32, T_CV = 32 * 32;
            constexpr int T_G = 16;
            constexpr int NIT = T_IN + 5 * T_SQ + T_UP + T_DN + T_CV + 2 * T_G;
            for (int it = gw; it < NIT; it += NGW) {
                int r = it;
                if (r < T_IN) { transpose_item(w_in, D, INC, WIN_T, scr, r, lane, INP(I_GMIX) + l * D); continue; } r -= T_IN;
                if (r < T_SQ) { transpose_item(w_out, D, D, WOUT_T, scr, r, lane); continue; } r -= T_SQ;
                if (r < T_SQ) { transpose_item(w_q, D, D, WQ_T, scr, r, lane, INP(I_GX) + l * D); continue; } r -= T_SQ;
                if (r < T_SQ) { transpose_item(w_k, D, D, WK_T, scr, r, lane); continue; } r -= T_SQ;
                if (r < T_SQ) { transpose_item(w_v, D, D, WV_T, scr, r, lane); continue; } r -= T_SQ;
                if (r < T_SQ) { transpose_item(w_o, D, D, WO_T, scr, r, lane); continue; } r -= T_SQ;
                if (r < T_UP) { transpose_item(w_up, D, 2 * DFF, WUP_T, scr, r, lane, INP(I_GFFN) + l * D, DFF); continue; } r -= T_UP;
                if (r < T_DN) { transpose_item(w_dn, DFF, D, WDN_T, scr, r, lane); continue; } r -= T_DN;
                if (r < T_CV) { transpose_item(c_v, BS * NMEM, D, VTS, scr, r, lane); continue; } r -= T_CV;
                if (r < T_G) { transpose_item(INP(I_WRG) + ((size_t)l * 8 + (r >> 1)) * 4096, 64, 64, GT_R + (r >> 1) * 4096, scr, r & 1, lane); continue; } r -= T_G;
                transpose_item(INP(I_WIG) + ((size_t)l * 8 + (r >> 1)) * 4096, 64, 64, GT_I + (r >> 1) * 4096, scr, r & 1, lane);
            }
            {
                const f32x4* ck = (const f32x4*)(INP(I_CK) + (size_t)l * BS * NMEM * D); u32x2* dk = (u32x2*)KBS;
                for (int i = gt; i < BS * NMEM * D / 4; i += NGT) { const f32x4 v = ck[i]; u32x2 w; w.x = pk2(v.x, v.y); w.y = pk2(v.z, v.w); dk[i] = w; }
                if (l == 0) { const f32x4* mm = (const f32x4*)INP(I_MEM); u32x2* dm = (u32x2*)MEMB;
                    for (int i = gt; i < BP * NMEM * D / 4; i += NGT) { const f32x4 v = mm[i]; u32x2 w; w.x = pk2(v.x, v.y); w.y = pk2(v.z, v.w); dm[i] = w; } }
                const float* wsl = INP(I_WS) + (size_t)l * 4 * 128 * 128;
                for (int i = gt; i < 4 * 128 * 128; i += NGT) { const int s = i & 127, t = (i >> 7) & 127; WST[i] = (bf16_t)f2bf(s <= t ? wsl[i] : 0.f); }
            }
            if (l == 0) first_rows(INP(I_XP), INP(I_XS), XN, SSQ(0), gw, NGW, lane);
        }
        GRID_SYNC();
        }
        {
            LANE_STATE();
            KVSched S; S.G = G; S.c = bid >= 160 ? bid - 160 : -1; S.ws = (const char*)ws;
            pg8::Gemm g{(const bf16_t*)nullptr, (const bf16_t*)nullptr, D, D, D};
            pg8::EpiKV E{out + O_MKP + (size_t)l * BP * NMEM * D, out + O_MVP + (size_t)l * BP * NMEM * D, KBP, VTP};
            pg8::gemm_phase<pg8::EpiKV, KVSched, true>(lds, g, S, E, wave_s);
        }
#define GEMM_BF16(s_) do { const int s = (s_); pg8::GSched S; pg8::Gemm g; pg8::EpiBf16 E; E.scale = 1.f; E.ss = nullptr; \
        if (s == 0) { S.init(MT / 256, INC / 256, G, bid); S.aPm = (size_t)256 * D * 2; S.bPn = (size_t)256 * D * 2; g = pg8::Gemm{XN, WIN_T, D, D, D}; E.O = gZ; E.ldc = INC; E.ss = SSQ(3 * l); } \
        else if (s == 1) { S.init(MT / 256, D / 256, G, bid); S.aPm = (size_t)256 * D * 2; S.bPn = (size_t)256 * D * 2; g = pg8::Gemm{XN, WQ_T, D, D, D}; E.O = gQ; E.ldc = D; E.scale = 0.0625f; E.ss = SSQ(3 * l + 1); } \
        else if (s == 2) { S.init(MP / 256, 4, G, bid); S.aPm = (size_t)256 * D * 2; S.aPn = 512; S.bPn = (size_t)256 * 2048 * 2; S.bPm = 512; S.bShift = 4; g = pg8::Gemm{gP, VTP, D, 2048, 256}; E.O = gO; E.ldc = D; } \
        else { S.init(1, 4, G, (bid + G - 8) % G); S.aPn = 4096; S.bPn = (size_t)256 * 2048 * 2; g = pg8::Gemm{PS, VTS, 8192, 2048, 2048}; E.O = gO + (size_t)MP * D; E.ldc = D; } \
        pg8::gemm_phase<pg8::EpiBf16, pg8::GSched, true>(lds, g, S, E, wave_s); } while (0)
#define GEMM_RES(s_) do { const int s = (s_); pg8::GSched S; S.init(MT / 256, D / 256, G, bid); pg8::Gemm g; \
        if (s == 0) { g = pg8::Gemm{gY, WOUT_T, D, D, D}; S.aPm = (size_t)256 * D * 2; } \
        else if (s == 1) { g = pg8::Gemm{gO, WO_T, D, D, D}; S.aPm = (size_t)256 * D * 2; } \
        else { g = pg8::Gemm{GU, WDN_T, DFF, DFF, DFF}; S.aPm = (size_t)256 * DFF * 2; } \
        S.bPn = (size_t)256 * g.ldb * 2; \
        pg8::EpiResid E{XN, SSQ(3 * l + 1 + s)}; \
        pg8::gemm_phase<pg8::EpiResid, pg8::GSched, true>(lds, g, S, E, wave_s); } while (0)

        for (int rep = 0; rep < 13; ++rep) { if (rep == 4 || rep == 9) continue;
          const int ndup = ((PROBE == 1 && (rep == 1 || rep == 2)) || (PROBE == 4 && rep == 1) || (PROBE == 6 && rep == 2)) ? 2 : ((PROBE == 2 && (rep == 0 || rep == 5 || rep == 6 || rep == 7 || rep == 10)) ? 2 : 1);
          for (int dup = 0; dup < ndup; ++dup) {
            if (rep == 0 || rep == 5 || rep == 7) {
                LANE_STATE();
                const int s0 = rep == 0 ? 0 : (rep == 5 ? 1 : 2), ns = rep == 7 ? 2 : 1;
                for (int q = 0; q < ns; ++q) GEMM_BF16(s0 + q);
            } else if (rep == 10) {
                LANE_STATE();
                pg8::GSched S; S.init(MT / 256, 2 * DFF / 256, G, bid); S.aPm = (size_t)256 * D * 2; S.bPn = (size_t)256 * D * 2;
                const pg8::Gemm g{XN, WUP_T, D, D, D};
                const pg8::EpiAct E{GU, GUS, SBG, SBU, SBL, INP(I_CFW) + (size_t)l * 3 * DFF, SSQ(3 * l + 2)};
                pg8::gemm_phase<pg8::EpiAct, pg8::GSched, true>(lds, g, S, E, wave_s);
            } else if (rep == 1) {
                LANE_STATE();
                {
                    LAS bf16_t* vT = (LAS bf16_t*)lds;
                    constexpr int VP = 136;
                    const float* gvp = INP(I_GV) + l * CW; const float* bsp = INP(I_BSS) + l * 4 * 128;
                    for (int un = bid; un < 8 + 256; un += G) {
                        int rowbase, nrows, sb = -1;
                        if (un < 8) { sb = un; rowbase = MP + un * TS; nrows = TS; } else { rowbase = (un - 8) * 128; nrows = 128; }
                        {
                            const int rl = tid >> 5, cgp = tid & 31;
                            f32x4 g0 = *(const f32x4*)(gvp + cgp * 8), g1 = *(const f32x4*)(gvp + cgp * 8 + 4);
                            for (int p = 0; p < nrows / 16; ++p) {
                                const int r = p * 16 + rl;
                                const u32x4 raw = *(const u32x4*)(gZ + (size_t)(rowbase + r) * INC + Z_VC + cgp * 8);
                                float v[8] = {bflo(raw.x), bfhi(raw.x), bflo(raw.y), bfhi(raw.y), bflo(raw.z), bfhi(raw.z), bflo(raw.w), bfhi(raw.w)};
                                float ss = 0.f;
#pragma unroll
                                for (int k = 0; k < 8; ++k) { v[k] = gelu_t(v[k]); ss += v[k] * v[k]; }
                                ss += shx(ss, 1, lane); ss += shx(ss, 2, lane); ss += shx(ss, 4, lane);
                                const float rstd = 1.0f / sqrtf(ss * (1.f / 64.f) + EPS);
                                const float gg[8] = {g0.x, g0.y, g0.z, g0.w, g1.x, g1.y, g1.z, g1.w};
#pragma unroll
                                for (int k = 0; k < 8; ++k) { v[k] = v[k] * rstd * gg[k]; vT[(cgp * 8 + k) * VP + r] = (bf16_t)f2bf(v[k]); }
                                if (sb >= 0) { float* vo = out + O_VCS + ((size_t)(l * BS + sb) * TS + r) * CW + cgp * 8;
                                    *(f32x4*)vo = (f32x4){v[0], v[1], v[2], v[3]}; *(f32x4*)(vo + 4) = (f32x4){v[4], v[5], v[6], v[7]}; }
                            }
                        }
                        __syncthreads();
                        {
                            const int hh = wave & 3, rh = wave >> 2, fr = lane & 15, fq = lane >> 4;
                            const int nmt = nrows == 128 ? 4 : (rh == 0 ? 2 : 0);
                            for (int mi = 0; mi < nmt; ++mi) {
                                const int mt = rh * 4 + mi, nks = (mt * 16 + 15) / 32 + 1;
                                f32x4 acc[4];
#pragma unroll
                                for (int n = 0; n < 4; ++n) acc[n] = (f32x4){0.f, 0.f, 0.f, 0.f};
                                for (int ks = 0; ks < nks; ++ks) {
                                    const bf16x8 a = *(const bf16x8*)(WST + ((size_t)(hh * 128 + mt * 16 + fr) * 128 + ks * 32 + fq * 8));
#pragma unroll
                                    for (int n = 0; n < 4; ++n) { const bf16x8 b = *(const LAS bf16x8*)(vT + (hh * 64 + n * 16 + fr) * VP + ks * 32 + fq * 8);
                                        acc[n] = __builtin_amdgcn_mfma_f32_16x16x32_bf16(a, b, acc[n], 0, 0, 0); }
                                }
#pragma unroll
                                for (int j = 0; j < 4; ++j) { const int t = mt * 16 + fq * 4 + j; const float bias = bsp[hh * 128 + t]; const size_t row = (size_t)(rowbase + t);
#pragma unroll
                                    for (int n = 0; n < 4; ++n) { const int c = hh * 64 + n * 16 + fr; const float u = gelu_t(bf2f(gZ[row * INC + Z_UC + c]));
                                        gY[row * D + 768 + c] = (bf16_t)f2bf(u * (acc[n][j] + bias)); } }
                            }
                        }
                        __syncthreads();
                    }
                }
                {
                    LAS unsigned char* wl = lds + wave * 16384;
                    LAS bf16_t* tile = (LAS bf16_t*)wl;
                    LAS float* pre_r = (LAS float*)(wl + 2560);
                    LAS float* pre_i = (LAS float*)(wl + 2560 + 4096);
                    LAS float* xcf = (LAS float*)(wl + 2560 + 8192);
                    const int fr = lane & 15, fq = lane >> 4;
                    for (int un = gw; un < 64 + 2048; un += NGW) {
                        int b, hd, rowbase, nrows, t0; bool smp = un < 64;
                        if (smp) { b = un >> 3; hd = un & 7; rowbase = MP + b * TS; nrows = TS; t0 = 0; }
                        else { const int v = un - 64; const int ch = v & 31; hd = (v >> 5) & 7; b = v >> 8; t0 = ch * 128; rowbase = b * SEQ + t0; nrows = 128; }
                        const int cidx = l * AW + hd * 64 + lane;
                        const float br = INP(I_BRG)[cidx], bi = INP(I_BIG)[cidx];
                        const float c8sp = 8.0f * log1pf(__expf(-INP(I_LAM)[cidx]));
                        const float* caw = INP(I_CAW) + (size_t)l * 4 * AW + hd * 64 + lane;
                        const float cw0 = caw[0], cw1 = caw[AW], cw2 = caw[2 * AW], cw3 = caw[3 * AW], cb = INP(I_CAB)[cidx];
                        bf16x8 bR[4][2], bI[4][2];
#pragma unroll
                        for (int n = 0; n < 4; ++n)
#pragma unroll
                            for (int ks = 0; ks < 2; ++ks) { const size_t o_ = (size_t)(hd * 64 + n * 16 + fr) * 64 + ks * 32 + fq * 8;
                                bR[n][ks] = *(const bf16x8*)(GT_R + o_); bI[n][ks] = *(const bf16x8*)(GT_I + o_); }
                        float xm3 = 0.f, xm2 = 0.f, xm1 = 0.f;
                        if (smp) { const float* st = INP(I_SCA) + ((size_t)(l * BS + b) * 3) * AW + hd * 64 + lane; xm3 = st[0]; xm2 = st[AW]; xm1 = st[2 * AW]; }
                        else if (t0 > 0) { const bf16_t* zp = gZ + (size_t)(rowbase - 3) * INC + Z_XA + hd * 64 + lane; xm3 = bf2f(zp[0]); xm2 = bf2f(zp[INC]); xm1 = bf2f(zp[2 * INC]); }
                        float h = 0.f, pc = 1.f;
                        const bf16_t* zp = gZ + (size_t)rowbase * INC + Z_XA + hd * 64 + lane;
                        float* hp = HLOC + (size_t)rowbase * AW + hd * 64 + lane; float* pp = PCUM + (size_t)rowbase * AW + hd * 64 + lane;
                        float xnx[16];
#pragma unroll
                        for (int i = 0; i < 16; ++i) xnx[i] = bf2f(zp[(size_t)i * INC]);
                        for (int st = 0; st < nrows / 16; ++st) {
                            float xcur[16];
#pragma unroll
                            for (int i = 0; i < 16; ++i) xcur[i] = xnx[i];
                            zp += (size_t)16 * INC;
                            if (st + 1 < nrows / 16) {
#pragma unroll
                                for (int i = 0; i < 16; ++i) xnx[i] = bf2f(zp[(size_t)i * INC]);
                            }
#pragma unroll
                            for (int i = 0; i < 16; ++i) { const float xv = xcur[i];
                                const float xc = cw0 * xm3 + cw1 * xm2 + cw2 * xm1 + cw3 * xv + cb; xm3 = xm2; xm2 = xm1; xm1 = xv; xcf[i * 64 + lane] = xc; tile[i * 72 + lane] = (bf16_t)f2bf(xc); }
                            LDS_WAIT();
                            const bf16x8 a0 = *(const LAS bf16x8*)(tile + fr * 72 + fq * 8), a1 = *(const LAS bf16x8*)(tile + fr * 72 + 32 + fq * 8);
#pragma unroll
                            for (int n = 0; n < 4; ++n) {
                                f32x4 ar = (f32x4){0.f, 0.f, 0.f, 0.f}, ai = (f32x4){0.f, 0.f, 0.f, 0.f};
                                ar = __builtin_amdgcn_mfma_f32_16x16x32_bf16(a0, bR[n][0], ar, 0, 0, 0); ar = __builtin_amdgcn_mfma_f32_16x16x32_bf16(a1, bR[n][1], ar, 0, 0, 0);
                                ai = __builtin_amdgcn_mfma_f32_16x16x32_bf16(a0, bI[n][0], ai, 0, 0, 0); ai = __builtin_amdgcn_mfma_f32_16x16x32_bf16(a1, bI[n][1], ai, 0, 0, 0);
#pragma unroll
                                for (int j = 0; j < 4; ++j) { pre_r[(fq * 4 + j) * 64 + n * 16 + fr] = ar[j]; pre_i[(fq * 4 + j) * 64 + n * 16 + fr] = ai[j]; }
                            }
                            LDS_WAIT();
#pragma unroll 4
                            for (int i = 0; i < 16; ++i) {
                                const float r = sigm(pre_r[i * 64 + lane] + br), gi = sigm(pre_i[i * 64 + lane] + bi);
                                const float la = -c8sp * r, a = __expf(la), bm = sqrtf(-expm1f(2.0f * la));
                                h = a * h + bm * gi * xcf[i * 64 + lane]; pc = pc * a;
                                *hp = h; *pp = pc; hp += AW; pp += AW;
                            }
                            LDS_WAIT();
                        }
                        AGG[(size_t)un * 128 + lane] = pc; AGG[(size_t)un * 128 + 64 + lane] = h;
                    }
                }
                {
                    const float* cbw = INP(I_CBW) + (size_t)l * 3 * BW;
                    for (int it = gt; it < (MT / 16) * 32; it += NGT) {
                        const int rb = it >> 5, c0 = (it & 31) * 8;
                        int b, t0, T, rowbase; bool smp = rb >= MP / 16;
                        if (!smp) { b = rb >> 8; t0 = (rb & 255) * 16; T = SEQ; rowbase = rb * 16; } else { const int sbk = rb - MP / 16; b = sbk >> 1; t0 = (sbk & 1) * 16; T = TS; rowbase = MP + sbk * 16; }
                        float w0[8], w1[8], w2[8], pm2[8], pm1[8];
#pragma unroll
                        for (int k = 0; k < 8; ++k) { w0[k] = cbw[c0 + k]; w1[k] = cbw[BW + c0 + k]; w2[k] = cbw[2 * BW + c0 + k]; pm2[k] = 0.f; pm1[k] = 0.f; }
                        if (t0 == 0) { if (smp) { const float* st = INP(I_SCB) + ((size_t)(l * BS + b) * 2) * BW + c0;
#pragma unroll
                                for (int k = 0; k < 8; ++k) { pm2[k] = st[k]; pm1[k] = st[BW + k]; } } }
                        else {
#pragma unroll
                            for (int rr = 0; rr < 2; ++rr) { const bf16_t* zr = gZ + (size_t)(rowbase - 2 + rr) * INC; const u32x4 xb = *(const u32x4*)(zr + Z_XB + c0), gc = *(const u32x4*)(zr + Z_GC + c0);
                                float pv[8] = {bflo(xb.x) * bflo(gc.x), bfhi(xb.x) * bfhi(gc.x), bflo(xb.y) * bflo(gc.y), bfhi(xb.y) * bfhi(gc.y), bflo(xb.z) * bflo(gc.z), bfhi(xb.z) * bfhi(gc.z), bflo(xb.w) * bflo(gc.w), bfhi(xb.w) * bfhi(gc.w)};
#pragma unroll
                                for (int k = 0; k < 8; ++k) { if (rr == 0) pm2[k] = pv[k]; else pm1[k] = pv[k]; } }
                        }
                        for (int i = 0; i < 16; ++i) {
                            const bf16_t* zr = gZ + (size_t)(rowbase + i) * INC; const u32x4 xb = *(const u32x4*)(zr + Z_XB + c0), gc = *(const u32x4*)(zr + Z_GC + c0), gb = *(const u32x4*)(zr + Z_GB + c0);
                            const float pv[8] = {bflo(xb.x) * bflo(gc.x), bfhi(xb.x) * bfhi(gc.x), bflo(xb.y) * bflo(gc.y), bfhi(xb.y) * bfhi(gc.y), bflo(xb.z) * bflo(gc.z), bfhi(xb.z) * bfhi(gc.z), bflo(xb.w) * bflo(gc.w), bfhi(xb.w) * bfhi(gc.w)};
                            const float gbv[8] = {bflo(gb.x), bfhi(gb.x), bflo(gb.y), bfhi(gb.y), bflo(gb.z), bfhi(gb.z), bflo(gb.w), bfhi(gb.w)};
                            float yv[8];
#pragma unroll
                            for (int k = 0; k < 8; ++k) { yv[k] = gbv[k] * (w0[k] * pm2[k] + w1[k] * pm1[k] + w2[k] * pv[k]); pm2[k] = pm1[k]; pm1[k] = pv[k]; }
                            u32x4 w; w.x = pk2(yv[0], yv[1]); w.y = pk2(yv[2], yv[3]); w.z = pk2(yv[4], yv[5]); w.w = pk2(yv[6], yv[7]);
                            *(u32x4*)(gY + (size_t)(rowbase + i) * D + 512 + c0) = w;
                        }
                        if (t0 + 16 == T) { float* o = out + (smp ? O_CBS : O_CBP) + ((size_t)(l * 8 + b) * 2) * BW + c0;
#pragma unroll
                            for (int k = 0; k < 8; ++k) { o[k] = pm2[k]; o[BW + k] = pm1[k]; } }
                    }
                }
            } else if (rep == 2) {
                LANE_STATE();
                for (int un = gw; un < 64 + 2048; un += NGW) {
                    int b, hd, rowbase, nrows, ch = 0; bool smp = un < 64;
                    if (smp) { b = un >> 3; hd = un & 7; rowbase = MP + b * TS; nrows = TS; }
                    else { const int v = un - 64; ch = v & 31; hd = (v >> 5) & 7; b = v >> 8; rowbase = b * SEQ + ch * 128; nrows = 128; }
                    const int c = hd * 64 + lane;
                    float carry = 0.f;
                    if (smp) carry = INP(I_SHA)[(size_t)(l * BS + b) * AW + c];
                    else { const float* ag = AGG + (size_t)(un - ch) * 128 + lane; for (int k = 0; k < ch; ++k) carry = ag[(size_t)k * 128] * carry + ag[(size_t)k * 128 + 64]; }
                    float hl = 0.f;
                    for (int i0 = 0; i0 < nrows; i0 += 8) {
                        float hv[8], pv[8], gv[8];
#pragma unroll
                        for (int k = 0; k < 8; ++k) { const size_t row = (size_t)(rowbase + i0 + k); hv[k] = HLOC[row * AW + c]; pv[k] = PCUM[row * AW + c]; gv[k] = bf2f(gZ[row * INC + Z_GA + c]); }
#pragma unroll
                        for (int k = 0; k < 8; ++k) { const size_t row = (size_t)(rowbase + i0 + k); hl = hv[k] + pv[k] * carry; gY[row * D + c] = (bf16_t)f2bf(gelu_t(gv[k]) * hl); }
                    }
                    if (smp || ch == 31) {
                        out[(smp ? O_HAS : O_HAP) + (size_t)(l * 8 + b) * AW + c] = hl;
                        float* o = out + (smp ? O_CAS : O_CAP) + ((size_t)(l * 8 + b) * 3) * AW + c;
#pragma unroll
                        for (int k = 0; k < 3; ++k) o[k * AW] = bf2f(gZ[(size_t)(rowbase + nrows - 3 + k) * INC + Z_XA + c]);
                    }
                }
            } else if (rep == 3 || rep == 8 || rep == 12) {
                LANE_STATE();
                GEMM_RES(rep == 3 ? 0 : (rep == 8 ? 1 : 2));
            } else if (rep == 6) {
                LANE_STATE();
                for (int sub = 0; sub < 2; ++sub) {
                    pg8::GSched S; pg8::Gemm g; pg8::EpiSoftmax E;
                    if (sub == 0) { S.init(MP / 256, 4, G, bid); S.aPm = (size_t)256 * D * 2; S.aPn = 512; S.bPn = 512; S.bPm = (size_t)256 * D * 2; S.bShift = 4; g = pg8::Gemm{gQ, KBP, D, D, 256}; E.O = gP; E.ldc = D; E.smp = 0; }
                    else { S.init(1, 32, G, (bid + G - 64) % G); S.mode = 1; g = pg8::Gemm{gQ + (size_t)MP * D, KBS, D, D, 256}; E.O = PS; E.ldc = 8192; E.smp = 1; }
                    pg8::gemm_phase<pg8::EpiSoftmax, pg8::GSched, true>(lds, g, S, E, wave_s);
                }
            } else if (rep == 11) {
                LANE_STATE();
                {
                    const float* cfw = INP(I_CFW) + (size_t)l * 3 * DFF;
                    for (int it = gt; it < (MP / 256) * (DFF / 8); it += NGT) {
                        const int pm = it / (DFF / 8), c0 = (it % (DFF / 8)) * 8, b = pm >> 4;
                        float w0[8], w1[8], w2[8], p2[8], p1[8], g0[8], g1[8], u0[8], u1[8];
#pragma unroll
                        for (int k = 0; k < 8; ++k) { w0[k] = cfw[c0 + k]; w1[k] = cfw[DFF + c0 + k]; w2[k] = cfw[2 * DFF + c0 + k]; p2[k] = 0.f; p1[k] = 0.f; }
                        if ((pm & 15) != 0) {
#pragma unroll
                            for (int k = 0; k < 8; ++k) { p2[k] = SBL[((size_t)(pm - 1) * 2 + 0) * DFF + c0 + k]; p1[k] = SBL[((size_t)(pm - 1) * 2 + 1) * DFF + c0 + k]; } }
#pragma unroll
                        for (int k = 0; k < 8; ++k) { g0[k] = SBG[((size_t)pm * 2 + 0) * DFF + c0 + k]; g1[k] = SBG[((size_t)pm * 2 + 1) * DFF + c0 + k]; u0[k] = SBU[((size_t)pm * 2 + 0) * DFF + c0 + k]; u1[k] = SBU[((size_t)pm * 2 + 1) * DFF + c0 + k]; }
                        float ha[8], hb[8];
#pragma unroll
                        for (int k = 0; k < 8; ++k) { ha[k] = silu(w0[k] * p2[k] + w1[k] * p1[k] + w2[k] * g0[k]) * u0[k]; hb[k] = silu(w0[k] * p1[k] + w1[k] * g0[k] + w2[k] * g1[k]) * u1[k]; }
                        u32x4 w; w.x = pk2(ha[0], ha[1]); w.y = pk2(ha[2], ha[3]); w.z = pk2(ha[4], ha[5]); w.w = pk2(ha[6], ha[7]);
                        *(u32x4*)(GU + (size_t)(pm * 256) * DFF + c0) = w;
                        w.x = pk2(hb[0], hb[1]); w.y = pk2(hb[2], hb[3]); w.z = pk2(hb[4], hb[5]); w.w = pk2(hb[6], hb[7]);
                        *(u32x4*)(GU + (size_t)(pm * 256 + 1) * DFF + c0) = w;
                        if ((pm & 15) == 15) { float* o = out + O_CFP + ((size_t)(l * 8 + b) * 2) * DFF + c0;
#pragma unroll
                            for (int k = 0; k < 8; ++k) { o[k] = SBL[((size_t)pm * 2 + 0) * DFF + c0 + k]; o[DFF + k] = SBL[((size_t)pm * 2 + 1) * DFF + c0 + k]; } }
                    }
                    for (int it = gt; it < (MS / 16) * (DFF / 8); it += NGT) {
                        const int sbk = it / (DFF / 8), c0 = (it % (DFF / 8)) * 8, b = sbk >> 1, t0 = (sbk & 1) * 16, rowl = sbk * 16;
                        float w0[8], w1[8], w2[8], gm2[8], gm1[8];
#pragma unroll
                        for (int k = 0; k < 8; ++k) { w0[k] = cfw[c0 + k]; w1[k] = cfw[DFF + c0 + k]; w2[k] = cfw[2 * DFF + c0 + k]; }
                        if (t0 == 0) { const float* st = INP(I_SCF) + ((size_t)(l * BS + b) * 2) * DFF + c0;
#pragma unroll
                            for (int k = 0; k < 8; ++k) { gm2[k] = st[k]; gm1[k] = st[DFF + k]; } }
                        else {
                            const u32x4 ga = *(const u32x4*)(GUS + (size_t)(rowl - 2) * (2 * DFF) + c0), gb = *(const u32x4*)(GUS + (size_t)(rowl - 1) * (2 * DFF) + c0);
                            const float a_[8] = {bflo(ga.x), bfhi(ga.x), bflo(ga.y), bfhi(ga.y), bflo(ga.z), bfhi(ga.z), bflo(ga.w), bfhi(ga.w)};
                            const float b_[8] = {bflo(gb.x), bfhi(gb.x), bflo(gb.y), bfhi(gb.y), bflo(gb.z), bfhi(gb.z), bflo(gb.w), bfhi(gb.w)};
#pragma unroll
                            for (int k = 0; k < 8; ++k) { gm2[k] = a_[k]; gm1[k] = b_[k]; }
                        }
                        for (int i = 0; i < 16; ++i) {
                            const bf16_t* gr = GUS + (size_t)(rowl + i) * (2 * DFF) + c0;
                            const u32x4 gq = *(const u32x4*)gr, uq = *(const u32x4*)(gr + DFF);
                            const float gv[8] = {bflo(gq.x), bfhi(gq.x), bflo(gq.y), bfhi(gq.y), bflo(gq.z), bfhi(gq.z), bflo(gq.w), bfhi(gq.w)};
                            const float uv[8] = {bflo(uq.x), bfhi(uq.x), bflo(uq.y), bfhi(uq.y), bflo(uq.z), bfhi(uq.z), bflo(uq.w), bfhi(uq.w)};
                            float hv[8];
#pragma unroll
                            for (int k = 0; k < 8; ++k) { const float cv = w0[k] * gm2[k] + w1[k] * gm1[k] + w2[k] * gv[k]; hv[k] = silu(cv) * uv[k]; gm2[k] = gm1[k]; gm1[k] = gv[k]; }
                            u32x4 w; w.x = pk2(hv[0], hv[1]); w.y = pk2(hv[2], hv[3]); w.z = pk2(hv[4], hv[5]); w.w = pk2(hv[6], hv[7]);
                            *(u32x4*)(GU + (size_t)(MP + rowl + i) * DFF + c0) = w;
                        }
                        if (t0 + 16 == TS) { float* o = out + O_CFS + ((size_t)(l * 8 + b) * 2) * DFF + c0;
#pragma unroll
                            for (int k = 0; k < 8; ++k) { o[k] = gm2[k]; o[DFF + k] = gm1[k]; } }
                    }
                }
            }
            GRID_SYNC();
          }
        }
    }
    {
        LANE_STATE();
        const float* gain = INP(I_GFIN);
        f32x4 gv[4];
#pragma unroll
        for (int j = 0; j < 4; ++j) gv[j] = ((const f32x4*)gain)[lane + 64 * j];
        for (int m = gw; m < MT; m += NGW) {
            f32x4* yr = (f32x4*)(out + (size_t)m * D) + lane; const u32x2* xr = (const u32x2*)(XN + (size_t)m * D) + lane;
            const float rstd = ss_rstd(*(const f32x4*)(SSQ(6) + (size_t)m * 4));
#pragma unroll
            for (int j = 0; j < 4; ++j) { const u32x2 p = xr[64 * j]; yr[64 * j] = (f32x4){bflo(p.x), bfhi(p.x), bflo(p.y), bfhi(p.y)} * rstd * gv[j]; }
        }
    }
}

extern "C" void kernel_launch(void* const* d_in, const int* in_sizes, int n_in, void* d_out, int out_size, void* d_ws, size_t ws_size, hipStream_t stream) {
    static int grid = 0;
    if (grid == 0) {
        if (n_in != N_IN || (size_t)out_size != O_END || ws_size < WS_END) { fprintf(stderr, "kernel_launch: unexpected sizes n_in %d out %d ws %zu (need %zu)\n", n_in, out_size, ws_size, (size_t)WS_END); grid = -1; return; }
        int dev = 0, cus = 0, per_cu = 0;
        (void)hipGetDevice(&dev); (void)hipDeviceGetAttribute(&cus, hipDeviceAttributeMultiprocessorCount, dev);
        if (hipFuncSetAttribute((const void*)trunk_fwd, hipFuncAttributeMaxDynamicSharedMemorySize, LDS_BYTES) != hipSuccess) { fprintf(stderr, "kernel_launch: hipFuncSetAttribute failed\n"); grid = -1; return; }
        if (hipOccupancyMaxActiveBlocksPerMultiprocessor(&per_cu, (const void*)trunk_fwd, NTHREADS, LDS_BYTES) != hipSuccess || per_cu < 1) { fprintf(stderr, "kernel_launch: occupancy query gave %d\n", per_cu); per_cu = 1; }
        (void)hipGetLastError();
        grid = cus * 1;
        if (grid != 256) fprintf(stderr, "kernel_launch: note: %d CUs\n", grid);
    }
    if (grid < 0) return;
    Args a{};
    for (int i = 0; i < N_IN; ++i) a.in[i] = (const float*)d_in[i];
    a.out = (float*)d_out; a.ws = (unsigned char*)d_ws;
    void* kargs[] = {&a};
    hipError_t e = hipLaunchCooperativeKernel((const void*)trunk_fwd, dim3(grid), dim3(NTHREADS), kargs, LDS_BYTES, stream);
    if (e != hipSuccess) fprintf(stderr, "kernel_launch: cooperative launch failed: %s (grid %d)\n", hipGetErrorString(e), grid);
}
```

```cpp
#include <hip/hip_runtime.h>
#include <hip/hip_cooperative_groups.h>
#include <cstdio>
#include <cstdint>
namespace cg = cooperative_groups;
#ifndef PROBE
#define PROBE 0
#endif

#define LAS __attribute__((address_space(3)))
typedef unsigned short bf16_t;
typedef short bf16x8 __attribute__((ext_vector_type(8)));
typedef float f32x4 __attribute__((ext_vector_type(4)));
typedef float f32x2 __attribute__((ext_vector_type(2)));
typedef unsigned u32x4 __attribute__((ext_vector_type(4)));
typedef unsigned u32x2 __attribute__((ext_vector_type(2)));

constexpr int D = 1024, BP = 8, SEQ = 4096, BS = 8, TS = 32, DEPTH = 2;
constexpr int MP = BP * SEQ, MS = BS * TS, MT = MP + MS;
constexpr int INC = 2304, DFF = 2816, NMEM = 256, AW = 512, BW = 256, CW = 256;
constexpr int Z_XA = 0, Z_GA = 512, Z_XB = 1024, Z_GB = 1280, Z_GC = 1536, Z_UC = 1792, Z_VC = 2048;
constexpr float EPS = 1e-6f;
constexpr int NWAVES = 8, NTHREADS = 512;

constexpr size_t O_YP = 0, O_YS = O_YP + (size_t)MP * D, O_CAP = O_YS + (size_t)MS * D, O_HAP = O_CAP + DEPTH * BP * 3 * AW,
                 O_CBP = O_HAP + DEPTH * BP * AW, O_CFP = O_CBP + DEPTH * BP * 2 * BW, O_MKP = O_CFP + DEPTH * BP * 2 * DFF,
                 O_MVP = O_MKP + (size_t)DEPTH * BP * NMEM * D, O_CAS = O_MVP + (size_t)DEPTH * BP * NMEM * D, O_HAS = O_CAS + DEPTH * BS * 3 * AW,
                 O_CBS = O_HAS + DEPTH * BS * AW, O_CFS = O_CBS + DEPTH * BS * 2 * BW, O_VCS = O_CFS + DEPTH * BS * 2 * DFF,
                 O_END = O_VCS + DEPTH * BS * TS * CW;

constexpr size_t MiB = 1u << 20;
constexpr size_t WS_WIN = 0, WS_WOUT = 5 * MiB, WS_WQ = 7 * MiB, WS_WK = 9 * MiB, WS_WV = 11 * MiB, WS_WO = 13 * MiB, WS_WUP = 15 * MiB, WS_WDN = 26 * MiB;
constexpr size_t WS_MEMB = 32 * MiB, WS_KBP = 36 * MiB, WS_VTP = 40 * MiB, WS_KBS = 44 * MiB, WS_VTS = 48 * MiB, WS_WST = 52 * MiB, WS_GT = WS_WST + 131072, WS_AGG = 53 * MiB, WS_SS = 54 * MiB + 256 * 1024, WS_BAR = 55 * MiB + 512 * 1024;
constexpr size_t WS_XN = 56 * MiB, WS_BIG = 121 * MiB;
constexpr size_t B_Z = WS_BIG, B_HLOC = WS_BIG + 146 * MiB, B_PCUM = WS_BIG + 211 * MiB, B_Y = WS_BIG + 276 * MiB;
constexpr size_t B_Q = WS_BIG, B_P = WS_BIG + 65 * MiB, B_O = WS_BIG + 130 * MiB, B_PS = WS_BIG + 195 * MiB;
constexpr size_t B_GU = WS_BIG;
constexpr size_t B_GUS = WS_BIG + 200 * MiB;
constexpr size_t B_SBG = WS_BIG + 204 * MiB, B_SBU = WS_BIG + 207 * MiB, B_SBL = WS_BIG + 210 * MiB;
constexpr size_t WS_END = WS_BIG + (size_t)MT * 2 * DFF * 2;
constexpr size_t WS_SSP = 476 * MiB;
static_assert(WS_END <= WS_SSP && WS_SSP + (size_t)7 * MT * 64 <= 512 * MiB, "workspace");
static_assert(WS_XN + (size_t)MT * D * 2 <= WS_BIG, "xn");

constexpr int LDS_RING = 131072, LDS_EX = LDS_RING, LDS_MISC = LDS_EX + 8192, LDS_BYTES = 147456;

enum { I_XP = 0, I_XS, I_MEM, I_CK, I_CV, I_SCA, I_SHA, I_SCB, I_SCF, I_GMIX, I_WIN, I_CAW, I_CAB, I_WRG, I_BRG, I_WIG, I_BIG, I_LAM, I_CBW, I_GV, I_WS, I_BSS,
       I_WOUT, I_GX, I_WQ, I_WK, I_WV, I_WO, I_GFFN, I_WUP, I_CFW, I_WDN, I_GFIN, N_IN };

struct Args { const float* in[N_IN]; float* out; unsigned char* ws; };

__device__ __forceinline__ unsigned f2bf(float f) { unsigned u = __builtin_bit_cast(unsigned, f); return (u + 0x7fffu + ((u >> 16) & 1u)) >> 16; }
__device__ __forceinline__ unsigned pk2(float lo, float hi) { return f2bf(lo) | (f2bf(hi) << 16); }
__device__ __forceinline__ float bf2f(unsigned v) { return __builtin_bit_cast(float, v << 16); }
__device__ __forceinline__ float bflo(unsigned w) { return __builtin_bit_cast(float, w << 16); }
__device__ __forceinline__ float bfhi(unsigned w) { return __builtin_bit_cast(float, w & 0xffff0000u); }
__device__ __forceinline__ unsigned cvt_pk_bf16(float lo, float hi) { unsigned r; asm volatile("v_cvt_pk_bf16_f32 %0, %1, %2" : "=v"(r) : "v"(lo), "v"(hi)); return r; }
__device__ __forceinline__ float fexp(float x) { return __builtin_amdgcn_exp2f(x * 1.4426950408889634f); }
__device__ __forceinline__ float sigm(float x) { return __builtin_amdgcn_rcpf(1.0f + fexp(-x)); }
__device__ __forceinline__ float gelu_t(float x) { const float u = 0.7978845608028654f * (x + 0.044715f * x * x * x); return x * sigm(2.0f * u); }
__device__ __forceinline__ float silu(float x) { return x * sigm(x); }
__device__ __forceinline__ float shx(float v, int m, int lane) { return __builtin_bit_cast(float, __builtin_amdgcn_ds_bpermute((lane ^ m) << 2, __builtin_bit_cast(int, v))); }
__device__ __forceinline__ float wave_sum(float v, int lane) {
#pragma unroll
    for (int o = 1; o < 64; o <<= 1) v += shx(v, o, lane);
    return v;
}
#define LDS_WAIT() asm volatile("s_waitcnt lgkmcnt(0)" ::: "memory")
__device__ __forceinline__ float ss_rstd(f32x4 p) { return 1.0f / sqrtf(((p[0] + p[1]) + (p[2] + p[3])) * (1.f / 1024.f) + 1e-6f); }
__device__ __forceinline__ int opaque_tid(int wave_s) { int l; asm volatile("v_mbcnt_lo_u32_b32 %0, -1, 0\n\tv_mbcnt_hi_u32_b32 %0, -1, %0" : "=v"(l)); return wave_s * 64 + l; }

namespace pg8 {
constexpr int BM = 256, BK = 64, HALF = 128, HTB = HALF * BK * 2, NXCD = 8, WGM = 8;
__device__ __forceinline__ int lds_byte(int r, int c) { const int st = (r >> 4) * 2 + (c >> 5), rr = r & 15, cc = c & 31, ob = rr * 64 + cc * 2; return st * 1024 + (ob ^ (((ob >> 9) & 1) << 5)); }
__device__ __forceinline__ void stage_rc(int b, int& R, int& C) { const int st = b / 1024, sb = b % 1024, swz = sb ^ (((sb >> 9) & 1) << 5); R = (st >> 1) * 16 + swz / 64; C = (st & 1) * 32 + (swz % 64) / 2; }
__device__ __forceinline__ int perm32(int rho) { const int n = rho >> 4, i = rho & 15; return 8 * (i >> 2) + 4 * n + (i & 3); }

struct Unit { int pm, pn; };
struct Gemm { const bf16_t* A; const bf16_t* Bt; int lda, ldb, K; };

struct GSched {
    int nM, nN, nwg, G, c, mode;
    size_t aPm, aPn, bPn, bPm; int bShift;
    __device__ __forceinline__ void init(int nM_, int nN_, int G_, int c_) { nM = nM_; nN = nN_; nwg = nM * nN; G = G_; c = c_; mode = 0; aPm = 0; aPn = 0; bPn = 0; bPm = 0; bShift = 0; }
    __device__ __forceinline__ bool next(int i, Unit& u) const {
        const long L = (long)i * G + c; if (L >= nwg) return false;
        int wgid = (int)L; { const int q = nwg / NXCD, r = nwg % NXCD, xcd = wgid % NXCD, off = wgid / NXCD; wgid = (xcd < r ? xcd * (q + 1) : r * (q + 1) + (xcd - r) * q) + off; }
        const int nig = WGM * nN, gid = wgid / nig, fm = gid * WGM, gsz = (nM - fm) < WGM ? (nM - fm) : WGM;
        u.pm = fm + ((wgid % nig) % gsz); u.pn = (wgid % nig) / gsz; return true;
    }
    __device__ __forceinline__ size_t offA(const Unit& u) const { return mode == 1 ? (size_t)(u.pn & 3) * 512 : (size_t)u.pm * aPm + (size_t)u.pn * aPn; }
    __device__ __forceinline__ size_t offB(const Unit& u) const { return mode == 1 ? (size_t)(u.pn >> 2) * (256 * 1024 * 2) + (size_t)(u.pn & 3) * 512 : (size_t)u.pn * bPn + (size_t)(u.pm >> bShift) * bPm; }
};

struct EpiBf16 {
    static constexpr bool PERM = true;
    bf16_t* O; int ldc; float scale; const float* ss;
    __device__ __forceinline__ void operator()(f32x4 (&acc)[2][2][4][2], const Unit& u, int wr, int wc, int fr, int fq, LAS unsigned char*) const {
        asm volatile("" : "+v"(fr), "+v"(fq)); asm volatile("" : "+s"(wr), "+s"(wc));
        const int row0 = u.pm * BM + wr * 64 + fr, col0 = u.pn * BM + wc * 32 + 8 * fq;
        f32x4 rs[2][4];
#pragma unroll
        for (int ai = 0; ai < 2; ++ai)
#pragma unroll
            for (int m = 0; m < 4; ++m) rs[ai][m] = ss ? *(const f32x4*)(ss + (size_t)(row0 + ai * HALF + m * 16) * 4) : (f32x4){0.f, 0.f, 0.f, 0.f};
#pragma unroll
        for (int ai = 0; ai < 2; ++ai)
#pragma unroll
            for (int m = 0; m < 4; ++m) { bf16_t* rowp = O + (size_t)(row0 + ai * HALF + m * 16) * ldc + col0;
                float sc = scale; if (ss) sc *= ss_rstd(rs[ai][m]);
#pragma unroll
                for (int bj = 0; bj < 2; ++bj) { const f32x4 v0 = acc[ai][bj][m][0] * sc, v1 = acc[ai][bj][m][1] * sc;
                    u32x4 w; w.x = cvt_pk_bf16(v0[0], v0[1]); w.y = cvt_pk_bf16(v0[2], v0[3]); w.z = cvt_pk_bf16(v1[0], v1[1]); w.w = cvt_pk_bf16(v1[2], v1[3]);
                    *(u32x4*)(rowp + bj * HALF) = w; } }
    }
};
struct EpiResid {
    static constexpr bool PERM = false;
    bf16_t* xb; float* ss;
    __device__ __forceinline__ void operator()(f32x4 (&acc)[2][2][4][2], const Unit& u, int wr, int wc, int fr, int fq, LAS unsigned char* lds) const {
        asm volatile("" : "+v"(fr), "+v"(fq)); asm volatile("" : "+s"(wr), "+s"(wc));
        const int col0 = u.pn * BM + wc * 32 + 4 * fq, lane = fq * 16 + fr;
        LAS float* PS = (LAS float*)(lds + LDS_EX);
        bf16_t* ob = xb + (size_t)u.pm * BM * D;
#pragma unroll
        for (int ai = 0; ai < 2; ++ai) {
            u32x2 pre[4][2][2];
#pragma unroll
            for (int m = 0; m < 4; ++m)
#pragma unroll
                for (int bj = 0; bj < 2; ++bj)
#pragma unroll
                    for (int n = 0; n < 2; ++n) pre[m][bj][n] = *(const u32x2*)(ob + (size_t)(ai * HALF + wr * 64 + m * 16 + fr) * D + col0 + bj * HALF + n * 16);
            asm volatile("" ::: "memory");
#pragma unroll
            for (int m = 0; m < 4; ++m) { const int rl = ai * HALF + wr * 64 + m * 16 + fr; const size_t off = (size_t)rl * D + col0; float q = 0.f;
#pragma unroll
                for (int bj = 0; bj < 2; ++bj)
#pragma unroll
                    for (int n = 0; n < 2; ++n) { const u32x2 p = pre[m][bj][n]; const f32x4 a = acc[ai][bj][m][n];
                        const float v0 = bflo(p.x) + a[0], v1 = bfhi(p.x) + a[1], v2 = bflo(p.y) + a[2], v3 = bfhi(p.y) + a[3];
                        u32x2 w; w.x = cvt_pk_bf16(v0, v1); w.y = cvt_pk_bf16(v2, v3); *(u32x2*)(ob + off + bj * HALF + n * 16) = w;
                        q += (v0 * v0 + v1 * v1) + (v2 * v2 + v3 * v3); }
                q += shx(q, 16, lane); q += shx(q, 32, lane);
                if (fq == 0) PS[rl * 4 + wc] = q; }
            asm volatile("" ::: "memory");
        }
        asm volatile("s_waitcnt lgkmcnt(0)" ::: "memory"); __builtin_amdgcn_s_barrier(); asm volatile("" ::: "memory");
        { const int t = (wr * 4 + wc) * 64 + lane; if (t < 256) { const f32x4 p = *(const LAS f32x4*)(PS + t * 4); ss[(size_t)(u.pm * BM + t) * 4 + u.pn] = (p[0] + p[1]) + (p[2] + p[3]); } }
    }
};
struct EpiKV {
    static constexpr bool PERM = false;
    float* outK; float* outV; bf16_t* KB; bf16_t* VT;
    __device__ __forceinline__ void operator()(f32x4 (&acc)[2][2][4][2], const Unit& u, int wr, int wc, int fr, int fq, LAS unsigned char*) const {
        asm volatile("" : "+v"(fr), "+v"(fq)); asm volatile("" : "+s"(wr), "+s"(wc));
        const int kind = u.pm >> 4, pm = u.pm & 15;
        const int col0 = u.pn * BM + wc * 32 + 4 * fq;
        float* of = kind == 0 ? outK : outV; bf16_t* ob = kind == 0 ? KB : VT; const int ldb_ = kind == 2 ? 2048 : 1024;
#pragma unroll
        for (int ai = 0; ai < 2; ++ai)
#pragma unroll
            for (int m = 0; m < 4; ++m) { const int row = pm * BM + ai * HALF + wr * 64 + m * 16 + fr;
#pragma unroll
                for (int bj = 0; bj < 2; ++bj)
#pragma unroll
                    for (int n = 0; n < 2; ++n) { const f32x4 v = acc[ai][bj][m][n]; const int col = col0 + bj * HALF + n * 16;
                        if (kind != 2) *(f32x4*)(of + (size_t)row * 1024 + col) = v;
                        if (kind != 1) { u32x2 w; w.x = cvt_pk_bf16(v[0], v[1]); w.y = cvt_pk_bf16(v[2], v[3]); *(u32x2*)(ob + (size_t)row * ldb_ + col) = w; } } }
    }
};
struct EpiSoftmax {
    static constexpr bool PERM = true;
    bf16_t* O; int ldc; int smp;
    __device__ __forceinline__ void operator()(f32x4 (&acc)[2][2][4][2], const Unit& u, int wr, int wc, int fr, int fq, LAS unsigned char* lds) const {
        asm volatile("" : "+v"(fr), "+v"(fq)); asm volatile("" : "+s"(wr), "+s"(wc));
        LAS f32x2* EX = (LAS f32x2*)(lds + LDS_EX);
        const int lane = fq * 16 + fr;
        const float L2E = 1.4426950408889634f;
#pragma unroll
        for (int ai = 0; ai < 2; ++ai)
#pragma unroll
            for (int m = 0; m < 4; ++m) {
                float mx = -3.0e38f;
#pragma unroll
                for (int bj = 0; bj < 2; ++bj)
#pragma unroll
                    for (int n = 0; n < 2; ++n) { const f32x4 x = acc[ai][bj][m][n]; mx = fmaxf(mx, fmaxf(fmaxf(x[0], x[1]), fmaxf(x[2], x[3]))); }
                mx = fmaxf(mx, shx(mx, 16, lane)); mx = fmaxf(mx, shx(mx, 32, lane));
                float s = 0.f;
#pragma unroll
                for (int bj = 0; bj < 2; ++bj)
#pragma unroll
                    for (int n = 0; n < 2; ++n) { f32x4 x = acc[ai][bj][m][n];
#pragma unroll
                        for (int j = 0; j < 4; ++j) { x[j] = __builtin_amdgcn_exp2f((x[j] - mx) * L2E); s += x[j]; }
                        acc[ai][bj][m][n] = x; }
                s += shx(s, 16, lane); s += shx(s, 32, lane);
                if (fq == 0) EX[(ai * HALF + wr * 64 + m * 16 + fr) * 4 + wc] = (f32x2){mx, s};
            }
        asm volatile("s_waitcnt lgkmcnt(0)" ::: "memory"); __builtin_amdgcn_s_barrier(); asm volatile("" ::: "memory");
        int colb = u.pn * BM, j_ = 0;
        if (smp) { colb = (u.pn & 3) * 2048 + (u.pn >> 2) * 256; j_ = u.pn >> 2; }
        const int col0 = colb + wc * 32 + 8 * fq;
#pragma unroll
        for (int ai = 0; ai < 2; ++ai)
#pragma unroll
            for (int m = 0; m < 4; ++m) {
                const int rl = ai * HALF + wr * 64 + m * 16 + fr;
                const f32x2 e0 = EX[rl * 4 + 0], e1 = EX[rl * 4 + 1], e2 = EX[rl * 4 + 2], e3 = EX[rl * 4 + 3];
                const float M = fmaxf(fmaxf(e0.x, e1.x), fmaxf(e2.x, e3.x));
                const float tot = e0.y * __builtin_amdgcn_exp2f((e0.x - M) * L2E) + e1.y * __builtin_amdgcn_exp2f((e1.x - M) * L2E) + e2.y * __builtin_amdgcn_exp2f((e2.x - M) * L2E) + e3.y * __builtin_amdgcn_exp2f((e3.x - M) * L2E);
                const float own = wc == 0 ? e0.x : (wc == 1 ? e1.x : (wc == 2 ? e2.x : e3.x));
                float f = __builtin_amdgcn_exp2f((own - M) * L2E) / tot;
                if (smp && (rl >> 5) != j_) f = 0.f;
                bf16_t* rowp = O + (size_t)(u.pm * BM + rl) * ldc + col0;
#pragma unroll
                for (int bj = 0; bj < 2; ++bj) { const f32x4 v0 = acc[ai][bj][m][0] * f, v1 = acc[ai][bj][m][1] * f;
                    u32x4 w; w.x = cvt_pk_bf16(v0[0], v0[1]); w.y = cvt_pk_bf16(v0[2], v0[3]); w.z = cvt_pk_bf16(v1[0], v1[1]); w.w = cvt_pk_bf16(v1[2], v1[3]);
                    *(u32x4*)(rowp + bj * HALF) = w; } }
    }
};


__device__ __forceinline__ float dpp_ror1(float v) { return __builtin_bit_cast(float, __builtin_amdgcn_update_dpp(0, __builtin_bit_cast(int, v), 0x121, 0xf, 0xf, false)); }
__device__ __forceinline__ float dpp_ror2(float v) { return __builtin_bit_cast(float, __builtin_amdgcn_update_dpp(0, __builtin_bit_cast(int, v), 0x122, 0xf, 0xf, false)); }
struct EpiAct {
    static constexpr bool PERM = true;
    bf16_t* H; bf16_t* GUs; float* sbg; float* sbu; float* sbl; const float* cfw; const float* ss;
    __device__ __forceinline__ void operator()(f32x4 (&acc)[2][2][4][2], const Unit& u, int wr, int wc, int fr, int fq, LAS unsigned char* lds) const {
        asm volatile("" : "+s"(wr), "+s"(wc));
        int lane; asm volatile("v_mbcnt_lo_u32_b32 %0, -1, 0\n\tv_mbcnt_hi_u32_b32 %0, -1, %0" : "=v"(lane));
        fr = lane & 15; fq = lane >> 4;
        const int fl = wc * 32 + 8 * fq, f0 = u.pn * 128 + fl; int rowt = wr * 64 + fr;
        {
            float rst[2][4];
            f32x4 rsl[2][4];
#pragma unroll
            for (int ai = 0; ai < 2; ++ai)
#pragma unroll
                for (int m = 0; m < 4; ++m) rsl[ai][m] = *(const f32x4*)(ss + (size_t)(u.pm * BM + ai * HALF + rowt + m * 16) * 4);
#pragma unroll
            for (int ai = 0; ai < 2; ++ai)
#pragma unroll
                for (int m = 0; m < 4; ++m) { rst[ai][m] = ss_rstd(rsl[ai][m]); }
#pragma unroll
            for (int ai = 0; ai < 2; ++ai)
#pragma unroll
                for (int m = 0; m < 4; ++m) { acc[ai][0][m][0] = acc[ai][0][m][0] * rst[ai][m]; acc[ai][0][m][1] = acc[ai][0][m][1] * rst[ai][m]; acc[ai][1][m][0] = acc[ai][1][m][0] * rst[ai][m]; acc[ai][1][m][1] = acc[ai][1][m][1] * rst[ai][m]; }
        }
        if (u.pm == 128) {
#pragma unroll
            for (int ai = 0; ai < 2; ++ai)
#pragma unroll
                for (int m = 0; m < 4; ++m) { bf16_t* rp = GUs + (size_t)(ai * HALF + rowt + m * 16) * (2 * DFF) + f0; const float sc = 1.f;
#pragma unroll
                    for (int bj = 0; bj < 2; ++bj) { const f32x4 v0 = acc[ai][bj][m][0] * sc, v1 = acc[ai][bj][m][1] * sc;
                        u32x4 w; w.x = cvt_pk_bf16(v0[0], v0[1]); w.y = cvt_pk_bf16(v0[2], v0[3]); w.z = cvt_pk_bf16(v1[0], v1[1]); w.w = cvt_pk_bf16(v1[2], v1[3]);
                        *(u32x4*)(rp + bj * DFF) = w; } }
            return;
        }
        asm volatile("" : "+v"(rowt));
        LAS float* BND = (LAS float*)(lds + LDS_EX);
        if (fr >= 14) {
#pragma unroll
            for (int ai = 0; ai < 2; ++ai)
#pragma unroll
                for (int n = 0; n < 2; ++n) *(LAS f32x4*)(BND + ((ai * 2 + wr) * 2 + (fr - 14)) * 128 + fl + 4 * n) = acc[ai][0][3][n];
            if (wr == 1) {
#pragma unroll
                for (int n = 0; n < 2; ++n) *(f32x4*)(sbl + ((size_t)u.pm * 2 + (fr - 14)) * DFF + f0 + 4 * n) = acc[1][0][3][n];
            }
        }
        asm volatile("s_waitcnt lgkmcnt(0)" ::: "memory"); __builtin_amdgcn_s_barrier(); asm volatile("" ::: "memory");
#pragma unroll
        for (int ai = 0; ai < 2; ++ai) {
            const int pg = wr == 1 ? ai * 2 : 1;
#pragma unroll
            for (int n = 0; n < 2; ++n) {
                const f32x4 w0 = *(const f32x4*)(cfw + f0 + 4 * n), w1 = *(const f32x4*)(cfw + DFF + f0 + 4 * n), w2 = *(const f32x4*)(cfw + 2 * DFF + f0 + 4 * n);
                const f32x4 h2 = *(const LAS f32x4*)(BND + (pg * 2 + 0) * 128 + fl + 4 * n), h1 = *(const LAS f32x4*)(BND + (pg * 2 + 1) * 128 + fl + 4 * n);
                u32x2 hp[4];
#pragma unroll
                for (int jp = 0; jp < 2; ++jp) {
                    float hv[4][2];
#pragma unroll
                    for (int jj = 0; jj < 2; ++jj) { const int j = jp * 2 + jj;
                        float r1p = h1[j], r2p = fr == 0 ? h2[j] : h1[j];
#pragma unroll
                        for (int m = 0; m < 4; ++m) { const float g = acc[ai][0][m][n][j];
                            const float r1 = dpp_ror1(g), r2 = dpp_ror2(g);
                            const float gm1 = fr >= 1 ? r1 : r1p, gm2 = fr >= 2 ? r2 : r2p;
                            r1p = r1; r2p = r2;
                            const float cv = w0[j] * gm2 + w1[j] * gm1 + w2[j] * g;
                            hv[m][jj] = silu(cv) * acc[ai][1][m][n][j]; } }
#pragma unroll
                    for (int m = 0; m < 4; ++m) { const unsigned pk = cvt_pk_bf16(hv[m][0], hv[m][1]); if (jp == 0) hp[m].x = pk; else hp[m].y = pk; }
                }
#pragma unroll
                for (int m = 0; m < 4; ++m) {
                    const int rl = ai * HALF + rowt + m * 16;
                    if (ai == 0 && m == 0 && wr == 0 && fr < 2) {
                        *(f32x4*)(sbg + ((size_t)u.pm * 2 + fr) * DFF + f0 + 4 * n) = acc[0][0][0][n]; *(f32x4*)(sbu + ((size_t)u.pm * 2 + fr) * DFF + f0 + 4 * n) = acc[0][1][0][n];
                    } else {
                        *(u32x2*)(H + (size_t)(u.pm * BM + rl) * DFF + f0 + 4 * n) = hp[m];
                    }
                }
            }
        }
    }
};

template <class Epi, class Sched, bool ALIGN_EPI>
__device__ __forceinline__ void gemm_phase(LAS unsigned char* lds, const Gemm g, const Sched& S, const Epi& E, const int wave_s) {
    const int tid = opaque_tid(wave_s), wid = __builtin_amdgcn_readfirstlane(tid >> 6), lane = tid & 63, wr = wid >> 2, wc = wid & 3, fr = lane & 15, fq = lane >> 4;
    const int nt = g.K / BK;
    unsigned voffA[2], voffB[2];
#pragma unroll
    for (int i = 0; i < 2; ++i) { int R, C; stage_rc(tid * 16 + i * 8192, R, C); const int Rb = Epi::PERM ? ((R & ~31) + perm32(R & 31)) : R;
        voffA[i] = (unsigned)(R * g.lda + C) * 2u; voffB[i] = (unsigned)(Rb * g.ldb + C) * 2u; }
    const size_t kstep = (size_t)(BK * 2);
    const size_t hstepA = (size_t)HALF * g.lda * 2, hstepB = (size_t)HALF * g.ldb * 2;
    const unsigned ldsw = (unsigned)wid * 1024u;
    const int aoff = lds_byte(wr * 64 + fr, fq * 8), boff = lds_byte(wc * 32 + fr, fq * 8);
#define PG8_SA(b, h) (((b) * 2 + (h)) * HTB)
#define PG8_SB(b, h) ((4 + (b) * 2 + (h)) * HTB)
#define PG8_STAGE(bufoff, gbase, voff) do { _Pragma("unroll") for (int _i = 0; _i < 2; ++_i) \
        __builtin_amdgcn_global_load_lds((const unsigned*)((const char*)(gbase) + (voff)[_i]), (LAS unsigned*)(lds + (bufoff) + ldsw + _i * 8192), 16, 0, 0); } while (0)
#define PG8_LDA(dst, b, h) do { _Pragma("unroll") for (int m = 0; m < 4; ++m) _Pragma("unroll") for (int k = 0; k < 2; ++k) dst[m][k] = *(const LAS bf16x8*)(lds + PG8_SA(b, h) + aoff + m * 2048 + k * 1024); } while (0)
#define PG8_LDB(dst, b, h) do { _Pragma("unroll") for (int n = 0; n < 2; ++n) _Pragma("unroll") for (int k = 0; k < 2; ++k) dst[n][k] = *(const LAS bf16x8*)(lds + PG8_SB(b, h) + boff + n * 2048 + k * 1024); } while (0)
#define PG8_MMA(ai, bj, At, Bt) do { __builtin_amdgcn_s_setprio(1); _Pragma("unroll") for (int m = 0; m < 4; ++m) _Pragma("unroll") for (int n = 0; n < 2; ++n) _Pragma("unroll") for (int k = 0; k < 2; ++k) \
        acc[ai][bj][m][n] = __builtin_amdgcn_mfma_f32_16x16x32_bf16(Bt[n][k], At[m][k], acc[ai][bj][m][n], 0, 0, 0); __builtin_amdgcn_s_setprio(0); } while (0)
#define PG8_WAIT_V(n) asm volatile("s_waitcnt vmcnt(" #n ")" ::: "memory")
#define PG8_WAIT_L(n) asm volatile("s_waitcnt lgkmcnt(" #n ")" ::: "memory")
#define PG8_BAR __builtin_amdgcn_s_barrier()
#define PG8_SCHED __builtin_amdgcn_sched_barrier(0)
    Unit cur, nxt; int ui = 0;
    if (!S.next(0, cur)) return;
    f32x4 acc[2][2][4][2];
#pragma unroll
    for (int a = 0; a < 2; ++a)
#pragma unroll
        for (int b = 0; b < 2; ++b)
#pragma unroll
            for (int m = 0; m < 4; ++m)
#pragma unroll
                for (int n = 0; n < 2; ++n) acc[a][b][m][n] = (f32x4){0.f, 0.f, 0.f, 0.f};
    bf16x8 At[4][2], B0[2][2], B1[2][2];
    const char* cA = (const char*)g.A + S.offA(cur); const char* cB = (const char*)g.Bt + S.offB(cur);
    PG8_STAGE(PG8_SB(0, 0), cB, voffB); PG8_STAGE(PG8_SB(0, 1), cB + hstepB, voffB); PG8_STAGE(PG8_SA(0, 0), cA, voffA); PG8_STAGE(PG8_SA(0, 1), cA + hstepA, voffA);
    if (wr == 1) PG8_BAR;
    PG8_WAIT_V(2); PG8_BAR;
    PG8_STAGE(PG8_SB(1, 0), cB + kstep, voffB); PG8_STAGE(PG8_SA(1, 0), cA + kstep, voffA); PG8_STAGE(PG8_SB(1, 1), cB + hstepB + kstep, voffB);
    PG8_WAIT_V(6); PG8_BAR;
    for (;;) {
        const bool has_next = S.next(ui + 1, nxt);
        const char* nA = has_next ? (const char*)g.A + S.offA(nxt) : cA; const char* nB = has_next ? (const char*)g.Bt + S.offB(nxt) : cB;
        for (int t = 0; t < nt; t += 2) {
            const bool last = (t == nt - 2);
            const char* a1 = cA + (size_t)(t + 1) * kstep;
            const char* a2 = last ? nA : cA + (size_t)(t + 2) * kstep; const char* b2 = last ? nB : cB + (size_t)(t + 2) * kstep;
            const char* a3 = a2 + kstep; const char* b3 = b2 + kstep;
            PG8_LDB(B0, 0, 0); PG8_LDB(B1, 0, 1); PG8_SCHED; PG8_LDA(At, 0, 0); PG8_STAGE(PG8_SA(1, 1), a1 + hstepA, voffA);
            PG8_WAIT_V(8); PG8_WAIT_L(0); PG8_BAR; PG8_MMA(0, 0, At, B0); PG8_MMA(0, 1, At, B1); PG8_BAR; PG8_SCHED;
            PG8_LDA(At, 0, 1); PG8_STAGE(PG8_SB(0, 0), b2, voffB); PG8_STAGE(PG8_SB(0, 1), b2 + hstepB, voffB); PG8_STAGE(PG8_SA(0, 0), a2, voffA);
            PG8_WAIT_V(8); PG8_WAIT_L(0); PG8_BAR; PG8_MMA(1, 0, At, B0); PG8_MMA(1, 1, At, B1); PG8_BAR; PG8_SCHED;
            PG8_LDB(B0, 1, 0); PG8_LDB(B1, 1, 1); PG8_SCHED; PG8_LDA(At, 1, 0); PG8_STAGE(PG8_SA(0, 1), a2 + hstepA, voffA);
            PG8_WAIT_V(8); PG8_WAIT_L(0); PG8_BAR; PG8_MMA(0, 0, At, B0); PG8_MMA(0, 1, At, B1); PG8_BAR; PG8_SCHED;
            PG8_LDA(At, 1, 1); PG8_STAGE(PG8_SB(1, 0), b3, voffB); PG8_STAGE(PG8_SB(1, 1), b3 + hstepB, voffB); PG8_STAGE(PG8_SA(1, 0), a3, voffA);
            PG8_WAIT_V(8); PG8_WAIT_L(0); PG8_BAR; PG8_MMA(1, 0, At, B0); PG8_MMA(1, 1, At, B1); PG8_BAR; PG8_SCHED;
        }
        if constexpr (ALIGN_EPI) { if (wr == 0) PG8_BAR; }
        E(acc, cur, wr, wc, fr, fq, lds);
        if (!has_next) break;
#pragma unroll
        for (int a = 0; a < 2; ++a)
#pragma unroll
            for (int b = 0; b < 2; ++b)
#pragma unroll
                for (int m = 0; m < 4; ++m)
#pragma unroll
                    for (int n = 0; n < 2; ++n) acc[a][b][m][n] = (f32x4){0.f, 0.f, 0.f, 0.f};
        cur = nxt; cA = nA; cB = nB; ++ui;
        if constexpr (ALIGN_EPI) { if (wr == 1) PG8_BAR; }
    }
    PG8_WAIT_V(0);
    if constexpr (!ALIGN_EPI) { if (wr == 0) PG8_BAR; }
    PG8_BAR;
#undef PG8_SA
#undef PG8_SB
#undef PG8_STAGE
#undef PG8_LDA
#undef PG8_LDB
#undef PG8_MMA
#undef PG8_WAIT_V
#undef PG8_WAIT_L
#undef PG8_BAR
#undef PG8_SCHED
}
}

struct KVSched {
    int c, G; const char* ws;
    __device__ __forceinline__ bool next(int i, pg8::Unit& u) const {
        const int L = i * G + c; if (c < 0 || L >= 96) return false;
        const int kind = L >> 5, r = L & 31;
        if (kind < 2) { u.pm = kind * 16 + (r >> 2); u.pn = r & 3; } else { u.pm = 32 + (r >> 3); u.pn = r & 7; }
        return true;
    }
    __device__ __forceinline__ size_t offA(const pg8::Unit& u) const { const int kind = u.pm >> 4, pm = u.pm & 15; int k2 = (kind == 2); asm volatile("" : "+v"(k2));
        return (size_t)ws + WS_MEMB + (size_t)k2 * (WS_WV - WS_MEMB) + (size_t)pm * 256 * 1024 * 2; }
    __device__ __forceinline__ size_t offB(const pg8::Unit& u) const { const int kind = u.pm >> 4; int k1 = (kind == 1), k2 = (kind == 2); asm volatile("" : "+v"(k1), "+v"(k2));
        return (size_t)ws + WS_WK + (size_t)k1 * (WS_WV - WS_WK) + (size_t)k2 * (WS_MEMB - WS_WK) + (size_t)u.pn * 256 * 1024 * 2; }
};


#define XB_TMO      128
#define XB_XCNT(j)  (256  + 64 * (j))
#define XB_XSUB(j)  (1280 + 64 * (j))
#define XB_XGEN(j)  (2304 + 64 * (j))
#define XB_TOP      3328
#define XB_TOPGEN   3392
#define XCD_BAR_WORDS 3456
#define XB_SPIN_CAP (1u << 22)
__device__ __forceinline__ unsigned xb_ld(unsigned* p)              { return __hip_atomic_load(p, __ATOMIC_RELAXED, __HIP_MEMORY_SCOPE_AGENT); }
__device__ __forceinline__ unsigned xb_add(unsigned* p, unsigned v) { return __hip_atomic_fetch_add(p, v, __ATOMIC_RELAXED, __HIP_MEMORY_SCOPE_AGENT); }
__device__ __forceinline__ unsigned xb_xcc_id() { return (unsigned)__builtin_amdgcn_s_getreg((3 << 11) | 20) & 0xFu; }
#define XB_SPIN(cond, bar) do { unsigned _sp = 0; while (cond) { __builtin_amdgcn_s_sleep(1); \
    if ((++_sp & 255u) == 0u) { if (xb_ld(&(bar)[XB_TMO])) break; if (_sp > XB_SPIN_CAP) { atomicAdd(&(bar)[XB_TMO], 1u); break; } } } } while (0)
struct XcdBarrier { unsigned* bar; unsigned x; volatile LAS unsigned* st; };
__device__ __forceinline__ void xcd_barrier_complete(unsigned* bar, unsigned x, unsigned& nloc, unsigned& nx) {
    const unsigned G = gridDim.x * gridDim.y * gridDim.z;
    unsigned sum, cnt, mine, sp = 0u;
    for (;;) {
        sum = 0u; cnt = 0u; mine = 0u;
#pragma unroll
        for (unsigned j = 0; j < 16; ++j) { const unsigned c = xb_ld(&bar[XB_XCNT(j)]); sum += c; cnt += (c > 0u) ? 1u : 0u; mine = (j == x) ? c : mine; }
        if (sum == G) break;
        __builtin_amdgcn_s_sleep(1);
        if ((++sp & 255u) == 0u) { if (xb_ld(&bar[XB_TMO])) break; if (sp > XB_SPIN_CAP) { atomicAdd(&bar[XB_TMO], 1u); break; } }
    }
    nloc = mine > 0u ? mine : 1u; nx = cnt > 0u ? cnt : 1u;
}
__device__ __forceinline__ void xcd_barrier(const XcdBarrier& b) {
    asm volatile("s_waitcnt vmcnt(0)" ::: "memory");
    __syncthreads();
    if (threadIdx.x == 0) {
        unsigned* bar = b.bar;
        __builtin_amdgcn_s_waitcnt(0);
        unsigned nloc = b.st[0], nx = b.st[1];
        if (nloc == 0u) { xcd_barrier_complete(bar, b.x, nloc, nx); b.st[0] = nloc; b.st[1] = nx; }
        const unsigned old = xb_add(&bar[XB_XSUB(b.x)], 1u);
        const unsigned gen = old / nloc;
        if (old + 1u == (gen + 1u) * nloc) {
            __builtin_amdgcn_fence(__ATOMIC_RELEASE, "agent");
            asm volatile("s_waitcnt vmcnt(0)" ::: "memory");
            const unsigned og = xb_add(&bar[XB_TOP], 1u);
            const unsigned tg = og / nx;
            if (og + 1u == (tg + 1u) * nx) xb_add(&bar[XB_TOPGEN], 1u);
            else XB_SPIN(xb_ld(&bar[XB_TOPGEN]) == tg, bar);
            __builtin_amdgcn_fence(__ATOMIC_ACQUIRE, "agent");
            xb_add(&bar[XB_XGEN(b.x)], 1u);
            asm volatile("s_waitcnt vmcnt(0)" ::: "memory");
        } else {
            XB_SPIN(xb_ld(&bar[XB_XGEN(b.x)]) == gen, bar);
            __builtin_amdgcn_fence(__ATOMIC_ACQUIRE, "agent");
            asm volatile("s_waitcnt vmcnt(0)" ::: "memory");
        }
    }
    __syncthreads();
}

__device__ __forceinline__ void transpose_item(const float* W, int K, int N, bf16_t* WT, LAS float* scr, int item, int lane, const float* gain = nullptr, int gu = 0) {
    const int nblk = N / 32, kb = item / nblk, nb = item % nblk, k0 = 64 * kb, n0 = 32 * nb;
#pragma unroll 8
    for (int i = 0; i < 32; ++i) { const int kk = 2 * i + (lane >> 5); float w = W[(size_t)(k0 + kk) * N + n0 + (lane & 31)]; if (gain) w *= gain[k0 + kk]; scr[kk * 33 + (lane & 31)] = w; }
    LDS_WAIT();
    const int c = lane & 7;
#pragma unroll
    for (int j = 0; j < 4; ++j) { const int n = (lane >> 3) + 8 * j; const LAS float* s = scr + (8 * c) * 33 + n;
        u32x4 o; o.x = pk2(s[0 * 33], s[1 * 33]); o.y = pk2(s[2 * 33], s[3 * 33]); o.z = pk2(s[4 * 33], s[5 * 33]); o.w = pk2(s[6 * 33], s[7 * 33]);
        int drow = n0 + n; if (gu) { const int up = drow >= gu, f = up ? drow - gu : drow; drow = ((f >> 7) << 8) + (up << 7) + (f & 127); }
        *(u32x4*)(WT + (size_t)drow * K + k0 + 8 * c) = o; }
    LDS_WAIT();
}

__device__ __forceinline__ void first_rows(const float* Xp, const float* Xs, bf16_t* XNo, float* ss, int gw, int NGW, int lane) {
    for (int m = gw; m < MT; m += NGW) {
        const f32x4* xr = (const f32x4*)(m < MP ? Xp + (size_t)m * D : Xs + (size_t)(m - MP) * D) + lane;
        f32x4 v[4]; float s = 0.f;
#pragma unroll
        for (int j = 0; j < 4; ++j) { v[j] = xr[64 * j]; s += (v[j].x * v[j].x + v[j].y * v[j].y) + (v[j].z * v[j].z + v[j].w * v[j].w); }
        s = wave_sum(s, lane);
        if (lane < 4) ss[(size_t)m * 4 + lane] = lane == 0 ? s : 0.f;
        u32x2* o8 = (u32x2*)(XNo + (size_t)m * D) + lane;
#pragma unroll
        for (int j = 0; j < 4; ++j) { u32x2 w; w.x = pk2(v[j].x, v[j].y); w.y = pk2(v[j].z, v[j].w); o8[64 * j] = w; }
    }
}

typedef __attribute__((address_space(4))) const unsigned char* kptr_t;
typedef const float* cfp_t; typedef float* fp_t; typedef unsigned char* ucp_t;
#define INP(k) (*(const __attribute__((address_space(4))) cfp_t*)(kp + 8 * (k)))
#define X out
#define WIN_T ((bf16_t*)(ws + WS_WIN))
#define WOUT_T ((bf16_t*)(ws + WS_WOUT))
#define WQ_T ((bf16_t*)(ws + WS_WQ))
#define WK_T ((bf16_t*)(ws + WS_WK))
#define WV_T ((bf16_t*)(ws + WS_WV))
#define WO_T ((bf16_t*)(ws + WS_WO))
#define WUP_T ((bf16_t*)(ws + WS_WUP))
#define WDN_T ((bf16_t*)(ws + WS_WDN))
#define MEMB ((bf16_t*)(ws + WS_MEMB))
#define KBP ((bf16_t*)(ws + WS_KBP))
#define VTP ((bf16_t*)(ws + WS_VTP))
#define KBS ((bf16_t*)(ws + WS_KBS))
#define VTS ((bf16_t*)(ws + WS_VTS))
#define WST ((bf16_t*)(ws + WS_WST))
#define AGG ((float*)(ws + WS_AGG))
#define SSQ(i) ((float*)(ws + WS_SSP) + (size_t)(i) * MT * 4)
#define GT_R ((bf16_t*)(ws + WS_GT))
#define GT_I ((bf16_t*)(ws + WS_GT + 65536))
#define XN ((bf16_t*)(ws + WS_XN))
#define gZ ((bf16_t*)(ws + B_Z))
#define HLOC ((float*)(ws + B_HLOC))
#define PCUM ((float*)(ws + B_PCUM))
#define gY ((bf16_t*)(ws + B_Y))
#define gQ ((bf16_t*)(ws + B_Q))
#define gP ((bf16_t*)(ws + B_P))
#define gO ((bf16_t*)(ws + B_O))
#define PS ((bf16_t*)(ws + B_PS))
#define GU ((bf16_t*)(ws + B_GU))
#define GUS ((bf16_t*)(ws + B_GUS))
#define SBG ((float*)(ws + B_SBG))
#define SBU ((float*)(ws + B_SBU))
#define SBL ((float*)(ws + B_SBL))
__global__ void __launch_bounds__(NTHREADS, 2) trunk_fwd(Args args) {
    extern __shared__ __attribute__((aligned(16))) unsigned char lds_raw[];
    LAS unsigned char* lds = (LAS unsigned char*)lds_raw;
    cg::grid_group grid = cg::this_grid();
    const int wave_s = __builtin_amdgcn_readfirstlane(threadIdx.x >> 6);
#define LANE_STATE() int G = gridDim.x, bid = blockIdx.x; asm volatile("" : "+s"(G), "+s"(bid)); const int NGW = G * NWAVES, NGT = G * NTHREADS; (void)NGW; (void)NGT; \
    const int tid = opaque_tid(wave_s), lane = tid & 63, wave = wave_s; const int gw = bid * NWAVES + wave; const int gt = bid * NTHREADS + tid; (void)lane; (void)gw; (void)gt; \
    kptr_t kp = (kptr_t)__builtin_amdgcn_kernarg_segment_ptr(); asm volatile("" : "+s"(kp)); \
    float* const out = *(const __attribute__((address_space(4))) fp_t*)(kp + 8 * N_IN); unsigned char* const ws = *(const __attribute__((address_space(4))) ucp_t*)(kp + 8 * N_IN + 8); (void)out; (void)ws
    {
        LANE_STATE();
        if (bid == 0) for (int i = tid; i < XCD_BAR_WORDS; i += NTHREADS) __hip_atomic_store((unsigned*)(ws + WS_BAR) + i, 0u, __ATOMIC_RELAXED, __HIP_MEMORY_SCOPE_AGENT);
        if (tid < 32) ((LAS unsigned*)(lds + LDS_MISC))[tid] = 0u;
        __threadfence();
        grid.sync();
        if (tid == 0) (void)xb_add((unsigned*)(ws + WS_BAR) + XB_XCNT(xb_xcc_id()), 1u);
    }
#define GRID_SYNC() do { kptr_t kp_ = (kptr_t)__builtin_amdgcn_kernarg_segment_ptr(); asm volatile("" : "+s"(kp_)); \
        XcdBarrier b_; b_.bar = (unsigned*)(*(const __attribute__((address_space(4))) ucp_t*)(kp_ + 8 * N_IN + 8) + WS_BAR); b_.x = xb_xcc_id(); b_.st = (volatile LAS unsigned*)(lds + LDS_MISC); \
        xcd_barrier(b_); if (PROBE == 3) xcd_barrier(b_); } while (0)

    for (int l = 0; l < DEPTH; ++l) {
        for (int dup0 = 0; dup0 < ((PROBE == 1 || PROBE == 5) ? 2 : 1); ++dup0) {
        {
            LANE_STATE();
            LAS float* scr = (LAS float*)(lds + wave * 16384);
            const float* w_in = INP(I_WIN) + (size_t)l * D * INC; const float* w_out = INP(I_WOUT) + (size_t)l * D * D; const float* w_q = INP(I_WQ) + (size_t)l * D * D;
            const float* w_k = INP(I_WK) + (size_t)l * D * D; const float* w_v = INP(I_WV) + (size_t)l * D * D; const float* w_o = INP(I_WO) + (size_t)l * D * D;
            const float* w_up = INP(I_WUP) + (size_t)l * D * 2 * DFF; const float* w_dn = INP(I_WDN) + (size_t)l * DFF * D; const float* c_v = INP(I_CV) + (size_t)l * BS * NMEM * D;
            constexpr int T_IN = 16 * (INC / 32), T_SQ = 16 * 32, T_UP = 16 * (2 * DFF / 32), T_DN = (DFF / 64) * 32, T_CV = 32 * 32;
            constexpr int T_G = 16;
            constexpr int NIT = T_IN + 5 * T_SQ + T_UP + T_DN + T_CV + 2 * T_G;
            for (int it = gw; it < NIT; it += NGW) {
                int r = it;
                if (r < T_IN) { transpose_item(w_in, D, INC, WIN_T, scr, r, lane, INP(I_GMIX) + l * D); continue; } r -= T_IN;
                if (r < T_SQ) { transpose_item(w_out, D, D, WOUT_T, scr, r, lane); continue; } r -= T_SQ;
                if (r < T_SQ) { transpose_item(w_q, D, D, WQ_T, scr, r, lane, INP(I_GX) + l * D); continue; } r -= T_SQ;
                if (r < T_SQ) { transpose_item(w_k, D, D, WK_T, scr, r, lane); continue; } r -= T_SQ;
                if (r < T_SQ) { transpose_item(w_v, D, D, WV_T, scr, r, lane); continue; } r -= T_SQ;
                if (r < T_SQ) { transpose_item(w_o, D, D, WO_T, scr, r, lane); continue; } r -= T_SQ;
                if (r < T_UP) { transpose_item(w_up, D, 2 * DFF, WUP_T, scr, r, lane, INP(I_GFFN) + l * D, DFF); continue; } r -= T_UP;
                if (r < T_DN) { transpose_item(w_dn, DFF, D, WDN_T, scr, r, lane); continue; } r -= T_DN;
                if (r < T_CV) { transpose_item(c_v, BS * NMEM, D, VTS, scr, r, lane); continue; } r -= T_CV;
                if (r < T_G) { transpose_item(INP(I_WRG) + ((size_t)l * 8 + (r >> 1)) * 4096, 64, 64, GT_R + (r >> 1) * 4096, scr, r & 1, lane); continue; } r -= T_G;
                transpose_item(INP(I_WIG) + ((size_t)l * 8 + (r >> 1)) * 4096, 64, 64, GT_I + (r >> 1) * 4096, scr, r & 1, lane);
            }
            {
                const f32x4* ck = (const f32x4*)(INP(I_CK) + (size_t)l * BS * NMEM * D); u32x2* dk = (u32x2*)KBS;
                for (int i = gt; i < BS * NMEM * D / 4; i += NGT) { const f32x4 v = ck[i]; u32x2 w; w.x = pk2(v.x, v.y); w.y = pk2(v.z, v.w); dk[i] = w; }
                if (l == 0) { const f32x4* mm = (const f32x4*)INP(I_MEM); u32x2* dm = (u32x2*)MEMB;
                    for (int i = gt; i < BP * NMEM * D / 4; i += NGT) { const f32x4 v = mm[i]; u32x2 w; w.x = pk2(v.x, v.y); w.y = pk2(v.z, v.w); dm[i] = w; } }
                const float* wsl = INP(I_WS) + (size_t)l * 4 * 128 * 128;
                for (int i = gt; i < 4 * 128 * 128; i += NGT) { const int s = i & 127, t = (i >> 7) & 127; WST[i] = (bf16_t)f2bf(s <= t ? wsl[i] : 0.f); }
            }
            if (l == 0) first_rows(INP(I_XP), INP(I_XS), XN, SSQ(0), gw, NGW, lane);
        }
        GRID_SYNC();
        }
        {
            LANE_STATE();
            KVSched S; S.G = G; S.c = bid >= 160 ? bid - 160 : -1; S.ws = (const char*)ws;
            pg8::Gemm g{(const bf16_t*)nullptr, (const bf16_t*)nullptr, D, D, D};
            pg8::EpiKV E{out + O_MKP + (size_t)l * BP * NMEM * D, out + O_MVP + (size_t)l * BP * NMEM * D, KBP, VTP};
            pg8::gemm_phase<pg8::EpiKV, KVSched, true>(lds, g, S, E, wave_s);
        }
#define GEMM_BF16(s_) do { const int s = (s_); pg8::GSched S; pg8::Gemm g; pg8::EpiBf16 E; E.scale = 1.f; E.ss = nullptr; \
        if (s == 0) { S.init(MT / 256, INC / 256, G, bid); S.aPm = (size_t)256 * D * 2; S.bPn = (size_t)256 * D * 2; g = pg8::Gemm{XN, WIN_T, D, D, D}; E.O = gZ; E.ldc = INC; E.ss = SSQ(3 * l); } \
        else if (s == 1) { S.init(MT / 256, D / 256, G, bid); S.aPm = (size_t)256 * D * 2; S.bPn = (size_t)256 * D * 2; g = pg8::Gemm{XN, WQ_T, D, D, D}; E.O = gQ; E.ldc = D; E.scale = 0.0625f; E.ss = SSQ(3 * l + 1); } \
        else if (s == 2) { S.init(MP / 256, 4, G, bid); S.aPm = (size_t)256 * D * 2; S.aPn = 512; S.bPn = (size_t)256 * 2048 * 2; S.bPm = 512; S.bShift = 4; g = pg8::Gemm{gP, VTP, D, 2048, 256}; E.O = gO; E.ldc = D; } \
        else { S.init(1, 4, G, (bid + G - 8) % G); S.aPn = 4096; S.bPn = (size_t)256 * 2048 * 2; g = pg8::Gemm{PS, VTS, 8192, 2048, 2048}; E.O = gO + (size_t)MP * D; E.ldc = D; } \
        pg8::gemm_phase<pg8::EpiBf16, pg8::GSched, true>(lds, g, S, E, wave_s); } while (0)
#define GEMM_RES(s_) do { const int s = (s_); pg8::GSched S; S.init(MT / 256, D / 256, G, bid); pg8::Gemm g; \
        if (s == 0) { g = pg8::Gemm{gY, WOUT_T, D, D, D}; S.aPm = (size_t)256 * D * 2; } \
        else if (s == 1) { g = pg8::Gemm{gO, WO_T, D, D, D}; S.aPm = (size_t)256 * D * 2; } \
        else { g = pg8::Gemm{GU, WDN_T, DFF, DFF, DFF}; S.aPm = (size_t)256 * DFF * 2; } \
        S.bPn = (size_t)256 * g.ldb * 2; \
        pg8::EpiResid E{XN, SSQ(3 * l + 1 + s)}; \
        pg8::gemm_phase<pg8::EpiResid, pg8::GSched, true>(lds, g, S, E, wave_s); } while (0)

        for (int rep = 0; rep < 13; ++rep) { if (rep == 4 || rep == 9) continue;
          const int ndup = ((PROBE == 1 && (rep == 1 || rep == 2)) || (PROBE == 4 && rep == 1) || (PROBE == 6 && rep == 2)) ? 2 : ((PROBE == 2 && (rep == 0 || rep == 5 || rep == 6 || rep == 7 || rep == 10)) ? 2 : 1);
          for (int dup = 0; dup < ndup; ++dup) {
            if (rep == 0 || rep == 5 || rep == 7) {
                LANE_STATE();
                const int s0 = rep == 0 ? 0 : (rep == 5 ? 1 : 2), ns = rep == 7 ? 2 : 1;
                for (int q = 0; q < ns; ++q) GEMM_BF16(s0 + q);
            } else if (rep == 10) {
                LANE_STATE();
                pg8::GSched S; S.init(MT / 256, 2 * DFF / 256, G, bid); S.aPm = (size_t)256 * D * 2; S.bPn = (size_t)256 * D * 2;
                const pg8::Gemm g{XN, WUP_T, D, D, D};
                const pg8::EpiAct E{GU, GUS, SBG, SBU, SBL, INP(I_CFW) + (size_t)l * 3 * DFF, SSQ(3 * l + 2)};
                pg8::gemm_phase<pg8::EpiAct, pg8::GSched, true>(lds, g, S, E, wave_s);
            } else if (rep == 1) {
                LANE_STATE();
                {
                    LAS bf16_t* vT = (LAS bf16_t*)lds;
                    constexpr int VP = 136;
                    const float* gvp = INP(I_GV) + l * CW; const float* bsp = INP(I_BSS) + l * 4 * 128;
                    for (int un = bid; un < 8 + 256; un += G) {
                        int rowbase, nrows, sb = -1;
                        if (un < 8) { sb = un; rowbase = MP + un * TS; nrows = TS; } else { rowbase = (un - 8) * 128; nrows = 128; }
                        {
                            const int rl = tid >> 5, cgp = tid & 31;
                            f32x4 g0 = *(const f32x4*)(gvp + cgp * 8), g1 = *(const f32x4*)(gvp + cgp * 8 + 4);
                            for (int p = 0; p < nrows / 16; ++p) {
                                const int r = p * 16 + rl;
                                const u32x4 raw = *(const u32x4*)(gZ + (size_t)(rowbase + r) * INC + Z_VC + cgp * 8);
                                float v[8] = {bflo(raw.x), bfhi(raw.x), bflo(raw.y), bfhi(raw.y), bflo(raw.z), bfhi(raw.z), bflo(raw.w), bfhi(raw.w)};
                                float ss = 0.f;
#pragma unroll
                                for (int k = 0; k < 8; ++k) { v[k] = gelu_t(v[k]); ss += v[k] * v[k]; }
                                ss += shx(ss, 1, lane); ss += shx(ss, 2, lane); ss += shx(ss, 4, lane);
                                const float rstd = 1.0f / sqrtf(ss * (1.f / 64.f) + EPS);
                                const float gg[8] = {g0.x, g0.y, g0.z, g0.w, g1.x, g1.y, g1.z, g1.w};
#pragma unroll
                                for (int k = 0; k < 8; ++k) { v[k] = v[k] * rstd * gg[k]; vT[(cgp * 8 + k) * VP + r] = (bf16_t)f2bf(v[k]); }
                                if (sb >= 0) { float* vo = out + O_VCS + ((size_t)(l * BS + sb) * TS + r) * CW + cgp * 8;
                                    *(f32x4*)vo = (f32x4){v[0], v[1], v[2], v[3]}; *(f32x4*)(vo + 4) = (f32x4){v[4], v[5], v[6], v[7]}; }
                            }
                        }
                        __syncthreads();
                        {
                            const int hh = wave & 3, rh = wave >> 2, fr = lane & 15, fq = lane >> 4;
                            const int nmt = nrows == 128 ? 4 : (rh == 0 ? 2 : 0);
                            for (int mi = 0; mi < nmt; ++mi) {
                                const int mt = rh * 4 + mi, nks = (mt * 16 + 15) / 32 + 1;
                                f32x4 acc[4];
#pragma unroll
                                for (int n = 0; n < 4; ++n) acc[n] = (f32x4){0.f, 0.f, 0.f, 0.f};
                                for (int ks = 0; ks < nks; ++ks) {
                                    const bf16x8 a = *(const bf16x8*)(WST + ((size_t)(hh * 128 + mt * 16 + fr) * 128 + ks * 32 + fq * 8));
#pragma unroll
                                    for (int n = 0; n < 4; ++n) { const bf16x8 b = *(const LAS bf16x8*)(vT + (hh * 64 + n * 16 + fr) * VP + ks * 32 + fq * 8);
                                        acc[n] = __builtin_amdgcn_mfma_f32_16x16x32_bf16(b, a, acc[n], 0, 0, 0); }
                                }
                                { const int t = mt * 16 + fr; const float bias = bsp[hh * 128 + t]; const size_t row = (size_t)(rowbase + t);
#pragma unroll
                                    for (int n = 0; n < 4; ++n) { const int c = hh * 64 + n * 16 + fq * 4; const u32x2 uq = *(const u32x2*)(gZ + row * INC + Z_UC + c);
                                        u32x2 w; w.x = pk2(gelu_t(bflo(uq.x)) * (acc[n][0] + bias), gelu_t(bfhi(uq.x)) * (acc[n][1] + bias)); w.y = pk2(gelu_t(bflo(uq.y)) * (acc[n][2] + bias), gelu_t(bfhi(uq.y)) * (acc[n][3] + bias));
                                        *(u32x2*)(gY + row * D + 768 + c) = w; } }
                            }
                        }
                        __syncthreads();
                    }
                }
                {
                    LAS unsigned char* wl = lds + wave * 16384;
                    LAS bf16_t* tile = (LAS bf16_t*)wl;
                    LAS float* pre_r = (LAS float*)(wl + 2560);
                    LAS float* pre_i = (LAS float*)(wl + 2560 + 4096);
                    LAS float* xcf = (LAS float*)(wl + 2560 + 8192);
                    const int fr = lane & 15, fq = lane >> 4;
                    for (int un = gw; un < 64 + 2048; un += NGW) {
                        int b, hd, rowbase, nrows, t0; bool smp = un < 64;
                        if (smp) { b = un >> 3; hd = un & 7; rowbase = MP + b * TS; nrows = TS; t0 = 0; }
                        else { const int v = un - 64; const int ch = v & 31; hd = (v >> 5) & 7; b = v >> 8; t0 = ch * 128; rowbase = b * SEQ + t0; nrows = 128; }
                        const int cidx = l * AW + hd * 64 + lane;
                        const float br = INP(I_BRG)[cidx], bi = INP(I_BIG)[cidx];
                        const float c8sp = 8.0f * log1pf(__expf(-INP(I_LAM)[cidx]));
                        const float* caw = INP(I_CAW) + (size_t)l * 4 * AW + hd * 64 + lane;
                        const float cw0 = caw[0], cw1 = caw[AW], cw2 = caw[2 * AW], cw3 = caw[3 * AW], cb = INP(I_CAB)[cidx];
                        bf16x8 bR[4][2], bI[4][2];
#pragma unroll
                        for (int n = 0; n < 4; ++n)
#pragma unroll
                            for (int ks = 0; ks < 2; ++ks) { const size_t o_ = (size_t)(hd * 64 + n * 16 + fr) * 64 + ks * 32 + fq * 8;
                                bR[n][ks] = *(const bf16x8*)(GT_R + o_); bI[n][ks] = *(const bf16x8*)(GT_I + o_); }
                        float xm3 = 0.f, xm2 = 0.f, xm1 = 0.f;
                        if (smp) { const float* st = INP(I_SCA) + ((size_t)(l * BS + b) * 3) * AW + hd * 64 + lane; xm3 = st[0]; xm2 = st[AW]; xm1 = st[2 * AW]; }
                        else if (t0 > 0) { const bf16_t* zp = gZ + (size_t)(rowbase - 3) * INC + Z_XA + hd * 64 + lane; xm3 = bf2f(zp[0]); xm2 = bf2f(zp[INC]); xm1 = bf2f(zp[2 * INC]); }
                        float h = 0.f, pc = 1.f;
                        const bf16_t* zp = gZ + (size_t)rowbase * INC + Z_XA + hd * 64 + lane;
                        float* hp = HLOC + (size_t)rowbase * AW + hd * 64 + lane; float* pp = PCUM + (size_t)rowbase * AW + hd * 64 + lane;
                        float xnx[16];
#pragma unroll
                        for (int i = 0; i < 16; ++i) xnx[i] = bf2f(zp[(size_t)i * INC]);
                        for (int st = 0; st < nrows / 16; ++st) {
                            float xcur[16];
#pragma unroll
                            for (int i = 0; i < 16; ++i) xcur[i] = xnx[i];
                            zp += (size_t)16 * INC;
                            if (st + 1 < nrows / 16) {
#pragma unroll
                                for (int i = 0; i < 16; ++i) xnx[i] = bf2f(zp[(size_t)i * INC]);
                            }
#pragma unroll
                            for (int i = 0; i < 16; ++i) { const float xv = xcur[i];
                                const float xc = cw0 * xm3 + cw1 * xm2 + cw2 * xm1 + cw3 * xv + cb; xm3 = xm2; xm2 = xm1; xm1 = xv; xcf[i * 64 + lane] = xc; tile[i * 72 + lane] = (bf16_t)f2bf(xc); }
                            LDS_WAIT();
                            const bf16x8 a0 = *(const LAS bf16x8*)(tile + fr * 72 + fq * 8), a1 = *(const LAS bf16x8*)(tile + fr * 72 + 32 + fq * 8);
#pragma unroll
                            for (int n = 0; n < 4; ++n) {
                                f32x4 ar = (f32x4){0.f, 0.f, 0.f, 0.f}, ai = (f32x4){0.f, 0.f, 0.f, 0.f};
                                ar = __builtin_amdgcn_mfma_f32_16x16x32_bf16(a0, bR[n][0], ar, 0, 0, 0); ar = __builtin_amdgcn_mfma_f32_16x16x32_bf16(a1, bR[n][1], ar, 0, 0, 0);
                                ai = __builtin_amdgcn_mfma_f32_16x16x32_bf16(a0, bI[n][0], ai, 0, 0, 0); ai = __builtin_amdgcn_mfma_f32_16x16x32_bf16(a1, bI[n][1], ai, 0, 0, 0);
#pragma unroll
                                for (int j = 0; j < 4; ++j) { pre_r[(fq * 4 + j) * 64 + n * 16 + fr] = ar[j]; pre_i[(fq * 4 + j) * 64 + n * 16 + fr] = ai[j]; }
                            }
                            LDS_WAIT();
#pragma unroll 4
                            for (int i = 0; i < 16; ++i) {
                                const float r = sigm(pre_r[i * 64 + lane] + br), gi = sigm(pre_i[i * 64 + lane] + bi);
                                const float la = -c8sp * r, a = __expf(la), bm = sqrtf(-expm1f(2.0f * la));
                                h = a * h + bm * gi * xcf[i * 64 + lane]; pc = pc * a;
                                *hp = h; *pp = pc; hp += AW; pp += AW;
                            }
                            LDS_WAIT();
                        }
                        AGG[(size_t)un * 128 + lane] = pc; AGG[(size_t)un * 128 + 64 + lane] = h;
                    }
                }
                {
                    const float* cbw = INP(I_CBW) + (size_t)l * 3 * BW;
                    for (int it = gt; it < (MT / 16) * 32; it += NGT) {
                        const int rb = it >> 5, c0 = (it & 31) * 8;
                        int b, t0, T, rowbase; bool smp = rb >= MP / 16;
                        if (!smp) { b = rb >> 8; t0 = (rb & 255) * 16; T = SEQ; rowbase = rb * 16; } else { const int sbk = rb - MP / 16; b = sbk >> 1; t0 = (sbk & 1) * 16; T = TS; rowbase = MP + sbk * 16; }
                        float w0[8], w1[8], w2[8], pm2[8], pm1[8];
#pragma unroll
                        for (int k = 0; k < 8; ++k) { w0[k] = cbw[c0 + k]; w1[k] = cbw[BW + c0 + k]; w2[k] = cbw[2 * BW + c0 + k]; pm2[k] = 0.f; pm1[k] = 0.f; }
                        if (t0 == 0) { if (smp) { const float* st = INP(I_SCB) + ((size_t)(l * BS + b) * 2) * BW + c0;
#pragma unroll
                                for (int k = 0; k < 8; ++k) { pm2[k] = st[k]; pm1[k] = st[BW + k]; } } }
                        else {
#pragma unroll
                            for (int rr = 0; rr < 2; ++rr) { const bf16_t* zr = gZ + (size_t)(rowbase - 2 + rr) * INC; const u32x4 xb = *(const u32x4*)(zr + Z_XB + c0), gc = *(const u32x4*)(zr + Z_GC + c0);
                                float pv[8] = {bflo(xb.x) * bflo(gc.x), bfhi(xb.x) * bfhi(gc.x), bflo(xb.y) * bflo(gc.y), bfhi(xb.y) * bfhi(gc.y), bflo(xb.z) * bflo(gc.z), bfhi(xb.z) * bfhi(gc.z), bflo(xb.w) * bflo(gc.w), bfhi(xb.w) * bfhi(gc.w)};
#pragma unroll
                                for (int k = 0; k < 8; ++k) { if (rr == 0) pm2[k] = pv[k]; else pm1[k] = pv[k]; } }
                        }
                        for (int i = 0; i < 16; ++i) {
                            const bf16_t* zr = gZ + (size_t)(rowbase + i) * INC; const u32x4 xb = *(const u32x4*)(zr + Z_XB + c0), gc = *(const u32x4*)(zr + Z_GC + c0), gb = *(const u32x4*)(zr + Z_GB + c0);
                            const float pv[8] = {bflo(xb.x) * bflo(gc.x), bfhi(xb.x) * bfhi(gc.x), bflo(xb.y) * bflo(gc.y), bfhi(xb.y) * bfhi(gc.y), bflo(xb.z) * bflo(gc.z), bfhi(xb.z) * bfhi(gc.z), bflo(xb.w) * bflo(gc.w), bfhi(xb.w) * bfhi(gc.w)};
                            const float gbv[8] = {bflo(gb.x), bfhi(gb.x), bflo(gb.y), bfhi(gb.y), bflo(gb.z), bfhi(gb.z), bflo(gb.w), bfhi(gb.w)};
                            float yv[8];
#pragma unroll
                            for (int k = 0; k < 8; ++k) { yv[k] = gbv[k] * (w0[k] * pm2[k] + w1[k] * pm1[k] + w2[k] * pv[k]); pm2[k] = pm1[k]; pm1[k] = pv[k]; }
                            u32x4 w; w.x = pk2(yv[0], yv[1]); w.y = pk2(yv[2], yv[3]); w.z = pk2(yv[4], yv[5]); w.w = pk2(yv[6], yv[7]);
                            *(u32x4*)(gY + (size_t)(rowbase + i) * D + 512 + c0) = w;
                        }
                        if (t0 + 16 == T) { float* o = out + (smp ? O_CBS : O_CBP) + ((size_t)(l * 8 + b) * 2) * BW + c0;
#pragma unroll
                            for (int k = 0; k < 8; ++k) { o[k] = pm2[k]; o[BW + k] = pm1[k]; } }
                    }
                }
            } else if (rep == 2) {
                LANE_STATE();
                {
                    LAS float* cr = (LAS float*)lds;
                    for (int un = bid; un < 8 + 256; un += G) {
                        int b, ch, rowbase, nrows; const bool smp = un < 8;
                        if (smp) { b = un; ch = 0; rowbase = MP + b * TS; nrows = TS; } else { const int v = un - 8; b = v >> 5; ch = v & 31; rowbase = b * SEQ + ch * 128; nrows = 128; }
                        {
                            const int c = tid, hd = c >> 6, ln = c & 63; float carry = 0.f;
                            if (smp) carry = INP(I_SHA)[(size_t)(l * BS + b) * AW + c];
                            else { const float* ag = AGG + (size_t)(64 + (b << 8) + (hd << 5)) * 128 + ln; for (int k = 0; k < ch; ++k) carry = ag[(size_t)k * 128] * carry + ag[(size_t)k * 128 + 64]; }
                            cr[c] = carry;
                        }
                        __syncthreads();
                        const int c0 = (tid & 63) * 8, rsub = tid >> 6;
                        const f32x4 ca = *(const LAS f32x4*)(cr + c0), cb = *(const LAS f32x4*)(cr + c0 + 4);
                        for (int p = 0; p < nrows / 8; ++p) {
                            const int rloc = p * 8 + rsub; const size_t row = (size_t)(rowbase + rloc);
                            const f32x4 h0 = *(const f32x4*)(HLOC + row * AW + c0), h1 = *(const f32x4*)(HLOC + row * AW + c0 + 4), p0 = *(const f32x4*)(PCUM + row * AW + c0), p1 = *(const f32x4*)(PCUM + row * AW + c0 + 4);
                            const u32x4 gq = *(const u32x4*)(gZ + row * INC + Z_GA + c0);
                            const f32x4 a0 = h0 + p0 * ca, a1 = h1 + p1 * cb;
                            u32x4 w; w.x = pk2(gelu_t(bflo(gq.x)) * a0[0], gelu_t(bfhi(gq.x)) * a0[1]); w.y = pk2(gelu_t(bflo(gq.y)) * a0[2], gelu_t(bfhi(gq.y)) * a0[3]);
                            w.z = pk2(gelu_t(bflo(gq.z)) * a1[0], gelu_t(bfhi(gq.z)) * a1[1]); w.w = pk2(gelu_t(bflo(gq.w)) * a1[2], gelu_t(bfhi(gq.w)) * a1[3]);
                            *(u32x4*)(gY + row * D + c0) = w;
                            if ((smp || ch == 31) && rloc == nrows - 1) { float* o = out + (smp ? O_HAS : O_HAP) + (size_t)(l * 8 + b) * AW + c0; *(f32x4*)o = a0; *(f32x4*)(o + 4) = a1; }
                        }
                        if ((smp || ch == 31) && tid < 192) {
                            const int k = tid >> 6; const u32x4 xq = *(const u32x4*)(gZ + (size_t)(rowbase + nrows - 3 + k) * INC + Z_XA + c0);
                            float* o = out + (smp ? O_CAS : O_CAP) + ((size_t)(l * 8 + b) * 3 + k) * AW + c0;
                            *(f32x4*)o = (f32x4){bflo(xq.x), bfhi(xq.x), bflo(xq.y), bfhi(xq.y)}; *(f32x4*)(o + 4) = (f32x4){bflo(xq.z), bfhi(xq.z), bflo(xq.w), bfhi(xq.w)};
                        }
                        __syncthreads();
                    }
                }
            } else if (rep == 3 || rep == 8 || rep == 12) {
                LANE_STATE();
                GEMM_RES(rep == 3 ? 0 : (rep == 8 ? 1 : 2));
            } else if (rep == 6) {
                LANE_STATE();
                for (int sub = 0; sub < 2; ++sub) {
                    pg8::GSched S; pg8::Gemm g; pg8::EpiSoftmax E;
                    if (sub == 0) { S.init(MP / 256, 4, G, bid); S.aPm = (size_t)256 * D * 2; S.aPn = 512; S.bPn = 512; S.bPm = (size_t)256 * D * 2; S.bShift = 4; g = pg8::Gemm{gQ, KBP, D, D, 256}; E.O = gP; E.ldc = D; E.smp = 0; }
                    else { S.init(1, 32, G, (bid + G - 64) % G); S.mode = 1; g = pg8::Gemm{gQ + (size_t)MP * D, KBS, D, D, 256}; E.O = PS; E.ldc = 8192; E.smp = 1; }
                    pg8::gemm_phase<pg8::EpiSoftmax, pg8::GSched, true>(lds, g, S, E, wave_s);
                }
            } else if (rep == 11) {
                LANE_STATE();
                {
                    const float* cfw = INP(I_CFW) + (size_t)l * 3 * DFF;
                    for (int it = gt; it < (MP / 256) * (DFF / 8); it += NGT) {
                        const int pm = it / (DFF / 8), c0 = (it % (DFF / 8)) * 8, b = pm >> 4;
                        float w0[8], w1[8], w2[8], p2[8], p1[8], g0[8], g1[8], u0[8], u1[8];
#pragma unroll
                        for (int k = 0; k < 8; ++k) { w0[k] = cfw[c0 + k]; w1[k] = cfw[DFF + c0 + k]; w2[k] = cfw[2 * DFF + c0 + k]; p2[k] = 0.f; p1[k] = 0.f; }
                        if ((pm & 15) != 0) {
#pragma unroll
                            for (int k = 0; k < 8; ++k) { p2[k] = SBL[((size_t)(pm - 1) * 2 + 0) * DFF + c0 + k]; p1[k] = SBL[((size_t)(pm - 1) * 2 + 1) * DFF + c0 + k]; } }
#pragma unroll
                        for (int k = 0; k < 8; ++k) { g0[k] = SBG[((size_t)pm * 2 + 0) * DFF + c0 + k]; g1[k] = SBG[((size_t)pm * 2 + 1) * DFF + c0 + k]; u0[k] = SBU[((size_t)pm * 2 + 0) * DFF + c0 + k]; u1[k] = SBU[((size_t)pm * 2 + 1) * DFF + c0 + k]; }
                        float ha[8], hb[8];
#pragma unroll
                        for (int k = 0; k < 8; ++k) { ha[k] = silu(w0[k] * p2[k] + w1[k] * p1[k] + w2[k] * g0[k]) * u0[k]; hb[k] = silu(w0[k] * p1[k] + w1[k] * g0[k] + w2[k] * g1[k]) * u1[k]; }
                        u32x4 w; w.x = pk2(ha[0], ha[1]); w.y = pk2(ha[2], ha[3]); w.z = pk2(ha[4], ha[5]); w.w = pk2(ha[6], ha[7]);
                        *(u32x4*)(GU + (size_t)(pm * 256) * DFF + c0) = w;
                        w.x = pk2(hb[0], hb[1]); w.y = pk2(hb[2], hb[3]); w.z = pk2(hb[4], hb[5]); w.w = pk2(hb[6], hb[7]);
                        *(u32x4*)(GU + (size_t)(pm * 256 + 1) * DFF + c0) = w;
                        if ((pm & 15) == 15) { float* o = out + O_CFP + ((size_t)(l * 8 + b) * 2) * DFF + c0;
#pragma unroll
                            for (int k = 0; k < 8; ++k) { o[k] = SBL[((size_t)pm * 2 + 0) * DFF + c0 + k]; o[DFF + k] = SBL[((size_t)pm * 2 + 1) * DFF + c0 + k]; } }
                    }
                    for (int it = gt; it < (MS / 16) * (DFF / 8); it += NGT) {
                        const int sbk = it / (DFF / 8), c0 = (it % (DFF / 8)) * 8, b = sbk >> 1, t0 = (sbk & 1) * 16, rowl = sbk * 16;
                        float w0[8], w1[8], w2[8], gm2[8], gm1[8];
#pragma unroll
                        for (int k = 0; k < 8; ++k) { w0[k] = cfw[c0 + k]; w1[k] = cfw[DFF + c0 + k]; w2[k] = cfw[2 * DFF + c0 + k]; }
                        if (t0 == 0) { const float* st = INP(I_SCF) + ((size_t)(l * BS + b) * 2) * DFF + c0;
#pragma unroll
                            for (int k = 0; k < 8; ++k) { gm2[k] = st[k]; gm1[k] = st[DFF + k]; } }
                        else {
                            const u32x4 ga = *(const u32x4*)(GUS + (size_t)(rowl - 2) * (2 * DFF) + c0), gb = *(const u32x4*)(GUS + (size_t)(rowl - 1) * (2 * DFF) + c0);
                            const float a_[8] = {bflo(ga.x), bfhi(ga.x), bflo(ga.y), bfhi(ga.y), bflo(ga.z), bfhi(ga.z), bflo(ga.w), bfhi(ga.w)};
                            const float b_[8] = {bflo(gb.x), bfhi(gb.x), bflo(gb.y), bfhi(gb.y), bflo(gb.z), bfhi(gb.z), bflo(gb.w), bfhi(gb.w)};
#pragma unroll
                            for (int k = 0; k < 8; ++k) { gm2[k] = a_[k]; gm1[k] = b_[k]; }
                        }
                        for (int i = 0; i < 16; ++i) {
                            const bf16_t* gr = GUS + (size_t)(rowl + i) * (2 * DFF) + c0;
                            const u32x4 gq = *(const u32x4*)gr, uq = *(const u32x4*)(gr + DFF);
                            const float gv[8] = {bflo(gq.x), bfhi(gq.x), bflo(gq.y), bfhi(gq.y), bflo(gq.z), bfhi(gq.z), bflo(gq.w), bfhi(gq.w)};
                            const float uv[8] = {bflo(uq.x), bfhi(uq.x), bflo(uq.y), bfhi(uq.y), bflo(uq.z), bfhi(uq.z), bflo(uq.w), bfhi(uq.w)};
                            float hv[8];
#pragma unroll
                            for (int k = 0; k < 8; ++k) { const float cv = w0[k] * gm2[k] + w1[k] * gm1[k] + w2[k] * gv[k]; hv[k] = silu(cv) * uv[k]; gm2[k] = gm1[k]; gm1[k] = gv[k]; }
                            u32x4 w; w.x = pk2(hv[0], hv[1]); w.y = pk2(hv[2], hv[3]); w.z = pk2(hv[4], hv[5]); w.w = pk2(hv[6], hv[7]);
                            *(u32x4*)(GU + (size_t)(MP + rowl + i) * DFF + c0) = w;
                        }
                        if (t0 + 16 == TS) { float* o = out + O_CFS + ((size_t)(l * 8 + b) * 2) * DFF + c0;
#pragma unroll
                            for (int k = 0; k < 8; ++k) { o[k] = gm2[k]; o[DFF + k] = gm1[k]; } }
                    }
                }
            }
            GRID_SYNC();
          }
        }
    }
    {
        LANE_STATE();
        const float* gain = INP(I_GFIN);
        f32x4 gv[4];
#pragma unroll
        for (int j = 0; j < 4; ++j) gv[j] = ((const f32x4*)gain)[lane + 64 * j];
        for (int m = gw; m < MT; m += NGW) {
            f32x4* yr = (f32x4*)(out + (size_t)m * D) + lane; const u32x2* xr = (const u32x2*)(XN + (size_t)m * D) + lane;
            const float rstd = ss_rstd(*(const f32x4*)(SSQ(6) + (size_t)m * 4));
#pragma unroll
            for (int j = 0; j < 4; ++j) { const u32x2 p = xr[64 * j]; yr[64 * j] = (f32x4){bflo(p.x), bfhi(p.x), bflo(p.y), bfhi(p.y)} * rstd * gv[j]; }
        }
    }
}

extern "C" void kernel_launch(void* const* d_in, const int* in_sizes, int n_in, void* d_out, int out_size, void* d_ws, size_t ws_size, hipStream_t stream) {
    static int grid = 0;
    if (grid == 0) {
        if (n_in != N_IN || (size_t)out_size != O_END || ws_size < WS_END) { fprintf(stderr, "kernel_launch: unexpected sizes n_in %d out %d ws %zu (need %zu)\n", n_in, out_size, ws_size, (size_t)WS_END); grid = -1; return; }
        int dev = 0, cus = 0, per_cu = 0;
        (void)hipGetDevice(&dev); (void)hipDeviceGetAttribute(&cus, hipDeviceAttributeMultiprocessorCount, dev);
        if (hipFuncSetAttribute((const void*)trunk_fwd, hipFuncAttributeMaxDynamicSharedMemorySize, LDS_BYTES) != hipSuccess) { fprintf(stderr, "kernel_launch: hipFuncSetAttribute failed\n"); grid = -1; return; }
        if (hipOccupancyMaxActiveBlocksPerMultiprocessor(&per_cu, (const void*)trunk_fwd, NTHREADS, LDS_BYTES) != hipSuccess || per_cu < 1) { fprintf(stderr, "kernel_launch: occupancy query gave %d\n", per_cu); per_cu = 1; }
        (void)hipGetLastError();
        grid = cus * 1;
        if (grid != 256) fprintf(stderr, "kernel_launch: note: %d CUs\n", grid);
    }
    if (grid < 0) return;
    Args a{};
    for (int i = 0; i < N_IN; ++i) a.in[i] = (const float*)d_in[i];
    a.out = (float*)d_out; a.ws = (unsigned char*)d_ws;
    void* kargs[] = {&a};
    hipError_t e = hipLaunchCooperativeKernel((const void*)trunk_fwd, dim3(grid), dim3(NTHREADS), kargs, LDS_BYTES, stream);
    if (e != hipSuccess) fprintf(stderr, "kernel_launch: cooperative launch failed: %s (grid %d)\n", hipGetErrorString(e), grid);
}
```

```cpp
#include <hip/hip_runtime.h>
#include <hip/hip_cooperative_groups.h>
#include <cstdio>
#include <cstdint>
namespace cg = cooperative_groups;
#ifndef PROBE
#define PROBE 0
#endif

#define LAS __attribute__((address_space(3)))
typedef unsigned short bf16_t;
typedef short bf16x8 __attribute__((ext_vector_type(8)));
typedef float f32x4 __attribute__((ext_vector_type(4)));
typedef float f32x2 __attribute__((ext_vector_type(2)));
typedef unsigned u32x4 __attribute__((ext_vector_type(4)));
typedef unsigned u32x2 __attribute__((ext_vector_type(2)));

constexpr int D = 1024, BP = 8, SEQ = 4096, BS = 8, TS = 32, DEPTH = 2;
constexpr int MP = BP * SEQ, MS = BS * TS, MT = MP + MS;
constexpr int INC = 2304, DFF = 2816, NMEM = 256, AW = 512, BW = 256, CW = 256;
constexpr int Z_XA = 0, Z_GA = 512, Z_XB = 1024, Z_GB = 1280, Z_GC = 1536, Z_UC = 1792, Z_VC = 2048;
constexpr float EPS = 1e-6f;
constexpr int NWAVES = 8, NTHREADS = 512;

constexpr size_t O_YP = 0, O_YS = O_YP + (size_t)MP * D, O_CAP = O_YS + (size_t)MS * D, O_HAP = O_CAP + DEPTH * BP * 3 * AW,
                 O_CBP = O_HAP + DEPTH * BP * AW, O_CFP = O_CBP + DEPTH * BP * 2 * BW, O_MKP = O_CFP + DEPTH * BP * 2 * DFF,
                 O_MVP = O_MKP + (size_t)DEPTH * BP * NMEM * D, O_CAS = O_MVP + (size_t)DEPTH * BP * NMEM * D, O_HAS = O_CAS + DEPTH * BS * 3 * AW,
                 O_CBS = O_HAS + DEPTH * BS * AW, O_CFS = O_CBS + DEPTH * BS * 2 * BW, O_VCS = O_CFS + DEPTH * BS * 2 * DFF,
                 O_END = O_VCS + DEPTH * BS * TS * CW;

constexpr size_t MiB = 1u << 20;
constexpr size_t WS_WIN = 0, WS_WOUT = 5 * MiB, WS_WQ = 7 * MiB, WS_WK = 9 * MiB, WS_WV = 11 * MiB, WS_WO = 13 * MiB, WS_WUP = 15 * MiB, WS_WDN = 26 * MiB;
constexpr size_t WS_MEMB = 32 * MiB, WS_KBP = 36 * MiB, WS_VTP = 40 * MiB, WS_KBS = 44 * MiB, WS_VTS = 48 * MiB, WS_WST = 52 * MiB, WS_GT = WS_WST + 131072, WS_AGG = 53 * MiB, WS_SS = 54 * MiB + 256 * 1024, WS_BAR = 55 * MiB + 512 * 1024;
constexpr size_t WS_XN = 56 * MiB, WS_BIG = 121 * MiB;
constexpr size_t B_Z = WS_BIG, B_HLOC = WS_BIG + 146 * MiB, B_PCUM = WS_BIG + 211 * MiB, B_Y = WS_BIG + 276 * MiB;
constexpr size_t B_Q = WS_BIG, B_P = WS_BIG + 65 * MiB, B_O = WS_BIG + 130 * MiB, B_PS = WS_BIG + 195 * MiB;
constexpr size_t B_GU = WS_BIG;
constexpr size_t B_GUS = WS_BIG + 200 * MiB;
constexpr size_t B_SBG = WS_BIG + 204 * MiB, B_SBU = WS_BIG + 207 * MiB, B_SBL = WS_BIG + 210 * MiB;
constexpr size_t WS_END = WS_BIG + (size_t)MT * 2 * DFF * 2;
constexpr size_t WS_SSP = 476 * MiB;
static_assert(WS_END <= WS_SSP && WS_SSP + (size_t)7 * MT * 64 <= 512 * MiB, "workspace");
static_assert(WS_XN + (size_t)MT * D * 2 <= WS_BIG, "xn");

constexpr int LDS_RING = 131072, LDS_EX = LDS_RING, LDS_MISC = LDS_EX + 8192, LDS_BYTES = 147456;

enum { I_XP = 0, I_XS, I_MEM, I_CK, I_CV, I_SCA, I_SHA, I_SCB, I_SCF, I_GMIX, I_WIN, I_CAW, I_CAB, I_WRG, I_BRG, I_WIG, I_BIG, I_LAM, I_CBW, I_GV, I_WS, I_BSS,
       I_WOUT, I_GX, I_WQ, I_WK, I_WV, I_WO, I_GFFN, I_WUP, I_CFW, I_WDN, I_GFIN, N_IN };

struct Args { const float* in[N_IN]; float* out; unsigned char* ws; };

__device__ __forceinline__ unsigned f2bf(float f) { unsigned u = __builtin_bit_cast(unsigned, f); return (u + 0x7fffu + ((u >> 16) & 1u)) >> 16; }
__device__ __forceinline__ unsigned pk2(float lo, float hi) { return f2bf(lo) | (f2bf(hi) << 16); }
__device__ __forceinline__ float bf2f(unsigned v) { return __builtin_bit_cast(float, v << 16); }
__device__ __forceinline__ float bflo(unsigned w) { return __builtin_bit_cast(float, w << 16); }
__device__ __forceinline__ float bfhi(unsigned w) { return __builtin_bit_cast(float, w & 0xffff0000u); }
__device__ __forceinline__ unsigned cvt_pk_bf16(float lo, float hi) { unsigned r; asm volatile("v_cvt_pk_bf16_f32 %0, %1, %2" : "=v"(r) : "v"(lo), "v"(hi)); return r; }
__device__ __forceinline__ float fexp(float x) { return __builtin_amdgcn_exp2f(x * 1.4426950408889634f); }
__device__ __forceinline__ float sigm(float x) { return __builtin_amdgcn_rcpf(1.0f + fexp(-x)); }
__device__ __forceinline__ float gelu_t(float x) { const float u = 0.7978845608028654f * (x + 0.044715f * x * x * x); return x * sigm(2.0f * u); }
__device__ __forceinline__ float silu(float x) { return x * sigm(x); }
__device__ __forceinline__ float shx(float v, int m, int lane) { return __builtin_bit_cast(float, __builtin_amdgcn_ds_bpermute((lane ^ m) << 2, __builtin_bit_cast(int, v))); }
__device__ __forceinline__ float wave_sum(float v, int lane) {
#pragma unroll
    for (int o = 1; o < 64; o <<= 1) v += shx(v, o, lane);
    return v;
}
#define LDS_WAIT() asm volatile("s_waitcnt lgkmcnt(0)" ::: "memory")
__device__ __forceinline__ float ss_rstd(f32x4 p) { return 1.0f / sqrtf(((p[0] + p[1]) + (p[2] + p[3])) * (1.f / 1024.f) + 1e-6f); }
__device__ __forceinline__ int opaque_tid(int wave_s) { int l; asm volatile("v_mbcnt_lo_u32_b32 %0, -1, 0\n\tv_mbcnt_hi_u32_b32 %0, -1, %0" : "=v"(l)); return wave_s * 64 + l; }

namespace pg8 {
constexpr int BM = 256, BK = 64, HALF = 128, HTB = HALF * BK * 2, NXCD = 8, WGM = 8;
__device__ __forceinline__ int lds_byte(int r, int c) { const int st = (r >> 4) * 2 + (c >> 5), rr = r & 15, cc = c & 31, ob = rr * 64 + cc * 2; return st * 1024 + (ob ^ (((ob >> 9) & 1) << 5)); }
__device__ __forceinline__ void stage_rc(int b, int& R, int& C) { const int st = b / 1024, sb = b % 1024, swz = sb ^ (((sb >> 9) & 1) << 5); R = (st >> 1) * 16 + swz / 64; C = (st & 1) * 32 + (swz % 64) / 2; }
__device__ __forceinline__ int perm32(int rho) { const int n = rho >> 4, i = rho & 15; return 8 * (i >> 2) + 4 * n + (i & 3); }

struct Unit { int pm, pn; };
struct Gemm { const bf16_t* A; const bf16_t* Bt; int lda, ldb, K; };

struct GSched {
    int nM, nN, nwg, G, c, mode;
    size_t aPm, aPn, bPn, bPm; int bShift;
    __device__ __forceinline__ void init(int nM_, int nN_, int G_, int c_) { nM = nM_; nN = nN_; nwg = nM * nN; G = G_; c = c_; mode = 0; aPm = 0; aPn = 0; bPn = 0; bPm = 0; bShift = 0; }
    __device__ __forceinline__ bool next(int i, Unit& u) const {
        const long L = (long)i * G + c; if (L >= nwg) return false;
        int wgid = (int)L; { const int q = nwg / NXCD, r = nwg % NXCD, xcd = wgid % NXCD, off = wgid / NXCD; wgid = (xcd < r ? xcd * (q + 1) : r * (q + 1) + (xcd - r) * q) + off; }
        const int nig = WGM * nN, gid = wgid / nig, fm = gid * WGM, gsz = (nM - fm) < WGM ? (nM - fm) : WGM;
        u.pm = fm + ((wgid % nig) % gsz); u.pn = (wgid % nig) / gsz; return true;
    }
    __device__ __forceinline__ size_t offA(const Unit& u) const { return mode == 1 ? (size_t)(u.pn & 3) * 512 : (size_t)u.pm * aPm + (size_t)u.pn * aPn; }
    __device__ __forceinline__ size_t offB(const Unit& u) const { return mode == 1 ? (size_t)(u.pn >> 2) * (256 * 1024 * 2) + (size_t)(u.pn & 3) * 512 : (size_t)u.pn * bPn + (size_t)(u.pm >> bShift) * bPm; }
};

struct EpiBf16 {
    static constexpr bool PERM = true;
    bf16_t* O; int ldc; float scale; const float* ss;
    __device__ __forceinline__ void operator()(f32x4 (&acc)[2][2][4][2], const Unit& u, int wr, int wc, int fr, int fq, LAS unsigned char*) const {
        asm volatile("" : "+v"(fr), "+v"(fq)); asm volatile("" : "+s"(wr), "+s"(wc));
        const int row0 = u.pm * BM + wr * 64 + fr, col0 = u.pn * BM + wc * 32 + 8 * fq;
        f32x4 rs[2][4];
#pragma unroll
        for (int ai = 0; ai < 2; ++ai)
#pragma unroll
            for (int m = 0; m < 4; ++m) rs[ai][m] = ss ? *(const f32x4*)(ss + (size_t)(row0 + ai * HALF + m * 16) * 4) : (f32x4){0.f, 0.f, 0.f, 0.f};
#pragma unroll
        for (int ai = 0; ai < 2; ++ai)
#pragma unroll
            for (int m = 0; m < 4; ++m) { bf16_t* rowp = O + (size_t)(row0 + ai * HALF + m * 16) * ldc + col0;
                float sc = scale; if (ss) sc *= ss_rstd(rs[ai][m]);
#pragma unroll
                for (int bj = 0; bj < 2; ++bj) { const f32x4 v0 = acc[ai][bj][m][0] * sc, v1 = acc[ai][bj][m][1] * sc;
                    u32x4 w; w.x = cvt_pk_bf16(v0[0], v0[1]); w.y = cvt_pk_bf16(v0[2], v0[3]); w.z = cvt_pk_bf16(v1[0], v1[1]); w.w = cvt_pk_bf16(v1[2], v1[3]);
                    *(u32x4*)(rowp + bj * HALF) = w; } }
    }
};
struct EpiResid {
    static constexpr bool PERM = true;
    bf16_t* xb; float* ss;
    __device__ __forceinline__ void operator()(f32x4 (&acc)[2][2][4][2], const Unit& u, int wr, int wc, int fr, int fq, LAS unsigned char* lds) const {
        asm volatile("" : "+v"(fr), "+v"(fq)); asm volatile("" : "+s"(wr), "+s"(wc));
        const int col0 = u.pn * BM + wc * 32 + 8 * fq, lane = fq * 16 + fr;
        LAS float* PS = (LAS float*)(lds + LDS_EX);
        bf16_t* ob = xb + (size_t)u.pm * BM * D;
#pragma unroll
        for (int ai = 0; ai < 2; ++ai) {
            u32x4 pre[4][2];
#pragma unroll
            for (int m = 0; m < 4; ++m)
#pragma unroll
                for (int bj = 0; bj < 2; ++bj) pre[m][bj] = *(const u32x4*)(ob + (size_t)(ai * HALF + wr * 64 + m * 16 + fr) * D + col0 + bj * HALF);
            asm volatile("" ::: "memory");
#pragma unroll
            for (int m = 0; m < 4; ++m) { const int rl = ai * HALF + wr * 64 + m * 16 + fr; const size_t off = (size_t)rl * D + col0; float q = 0.f;
#pragma unroll
                for (int bj = 0; bj < 2; ++bj) { const u32x4 p = pre[m][bj]; const f32x4 a0 = acc[ai][bj][m][0], a1 = acc[ai][bj][m][1];
                    const float v0 = bflo(p.x) + a0[0], v1 = bfhi(p.x) + a0[1], v2 = bflo(p.y) + a0[2], v3 = bfhi(p.y) + a0[3], v4 = bflo(p.z) + a1[0], v5 = bfhi(p.z) + a1[1], v6 = bflo(p.w) + a1[2], v7 = bfhi(p.w) + a1[3];
                    u32x4 w; w.x = cvt_pk_bf16(v0, v1); w.y = cvt_pk_bf16(v2, v3); w.z = cvt_pk_bf16(v4, v5); w.w = cvt_pk_bf16(v6, v7); *(u32x4*)(ob + off + bj * HALF) = w;
                    q += ((v0 * v0 + v1 * v1) + (v2 * v2 + v3 * v3)) + ((v4 * v4 + v5 * v5) + (v6 * v6 + v7 * v7)); }
                q += shx(q, 16, lane); q += shx(q, 32, lane);
                if (fq == 0) PS[rl * 4 + wc] = q; }
            asm volatile("" ::: "memory");
        }
        asm volatile("s_waitcnt lgkmcnt(0)" ::: "memory"); __builtin_amdgcn_s_barrier(); asm volatile("" ::: "memory");
        { const int t = (wr * 4 + wc) * 64 + lane; if (t < 256) { const f32x4 p = *(const LAS f32x4*)(PS + t * 4); ss[(size_t)(u.pm * BM + t) * 4 + u.pn] = (p[0] + p[1]) + (p[2] + p[3]); } }
    }
};
struct EpiKV {
    static constexpr bool PERM = false;
    float* outK; float* outV; bf16_t* KB; bf16_t* VT;
    __device__ __forceinline__ void operator()(f32x4 (&acc)[2][2][4][2], const Unit& u, int wr, int wc, int fr, int fq, LAS unsigned char*) const {
        asm volatile("" : "+v"(fr), "+v"(fq)); asm volatile("" : "+s"(wr), "+s"(wc));
        const int kind = u.pm >> 4, pm = u.pm & 15;
        const int col0 = u.pn * BM + wc * 32 + 4 * fq;
        float* of = kind == 0 ? outK : outV; bf16_t* ob = kind == 0 ? KB : VT; const int ldb_ = kind == 2 ? 2048 : 1024;
#pragma unroll
        for (int ai = 0; ai < 2; ++ai)
#pragma unroll
            for (int m = 0; m < 4; ++m) { const int row = pm * BM + ai * HALF + wr * 64 + m * 16 + fr;
#pragma unroll
                for (int bj = 0; bj < 2; ++bj)
#pragma unroll
                    for (int n = 0; n < 2; ++n) { const f32x4 v = acc[ai][bj][m][n]; const int col = col0 + bj * HALF + n * 16;
                        if (kind != 2) *(f32x4*)(of + (size_t)row * 1024 + col) = v;
                        if (kind != 1) { u32x2 w; w.x = cvt_pk_bf16(v[0], v[1]); w.y = cvt_pk_bf16(v[2], v[3]); *(u32x2*)(ob + (size_t)row * ldb_ + col) = w; } } }
    }
};
struct EpiSoftmax {
    static constexpr bool PERM = true;
    bf16_t* O; int ldc; int smp;
    __device__ __forceinline__ void operator()(f32x4 (&acc)[2][2][4][2], const Unit& u, int wr, int wc, int fr, int fq, LAS unsigned char* lds) const {
        asm volatile("" : "+v"(fr), "+v"(fq)); asm volatile("" : "+s"(wr), "+s"(wc));
        LAS f32x2* EX = (LAS f32x2*)(lds + LDS_EX);
        const int lane = fq * 16 + fr;
        const float L2E = 1.4426950408889634f;
#pragma unroll
        for (int ai = 0; ai < 2; ++ai)
#pragma unroll
            for (int m = 0; m < 4; ++m) {
                float mx = -3.0e38f;
#pragma unroll
                for (int bj = 0; bj < 2; ++bj)
#pragma unroll
                    for (int n = 0; n < 2; ++n) { const f32x4 x = acc[ai][bj][m][n]; mx = fmaxf(mx, fmaxf(fmaxf(x[0], x[1]), fmaxf(x[2], x[3]))); }
                mx = fmaxf(mx, shx(mx, 16, lane)); mx = fmaxf(mx, shx(mx, 32, lane));
                float s = 0.f;
#pragma unroll
                for (int bj = 0; bj < 2; ++bj)
#pragma unroll
                    for (int n = 0; n < 2; ++n) { f32x4 x = acc[ai][bj][m][n];
#pragma unroll
                        for (int j = 0; j < 4; ++j) { x[j] = __builtin_amdgcn_exp2f((x[j] - mx) * L2E); s += x[j]; }
                        acc[ai][bj][m][n] = x; }
                s += shx(s, 16, lane); s += shx(s, 32, lane);
                if (fq == 0) EX[(ai * HALF + wr * 64 + m * 16 + fr) * 4 + wc] = (f32x2){mx, s};
            }
        asm volatile("s_waitcnt lgkmcnt(0)" ::: "memory"); __builtin_amdgcn_s_barrier(); asm volatile("" ::: "memory");
        int colb = u.pn * BM, j_ = 0;
        if (smp) { colb = (u.pn & 3) * 2048 + (u.pn >> 2) * 256; j_ = u.pn >> 2; }
        const int col0 = colb + wc * 32 + 8 * fq;
#pragma unroll
        for (int ai = 0; ai < 2; ++ai)
#pragma unroll
            for (int m = 0; m < 4; ++m) {
                const int rl = ai * HALF + wr * 64 + m * 16 + fr;
                const f32x2 e0 = EX[rl * 4 + 0], e1 = EX[rl * 4 + 1], e2 = EX[rl * 4 + 2], e3 = EX[rl * 4 + 3];
                const float M = fmaxf(fmaxf(e0.x, e1.x), fmaxf(e2.x, e3.x));
                const float tot = e0.y * __builtin_amdgcn_exp2f((e0.x - M) * L2E) + e1.y * __builtin_amdgcn_exp2f((e1.x - M) * L2E) + e2.y * __builtin_amdgcn_exp2f((e2.x - M) * L2E) + e3.y * __builtin_amdgcn_exp2f((e3.x - M) * L2E);
                const float own = wc == 0 ? e0.x : (wc == 1 ? e1.x : (wc == 2 ? e2.x : e3.x));
                float f = __builtin_amdgcn_exp2f((own - M) * L2E) / tot;
                if (smp && (rl >> 5) != j_) f = 0.f;
                bf16_t* rowp = O + (size_t)(u.pm * BM + rl) * ldc + col0;
#pragma unroll
                for (int bj = 0; bj < 2; ++bj) { const f32x4 v0 = acc[ai][bj][m][0] * f, v1 = acc[ai][bj][m][1] * f;
                    u32x4 w; w.x = cvt_pk_bf16(v0[0], v0[1]); w.y = cvt_pk_bf16(v0[2], v0[3]); w.z = cvt_pk_bf16(v1[0], v1[1]); w.w = cvt_pk_bf16(v1[2], v1[3]);
                    *(u32x4*)(rowp + bj * HALF) = w; } }
    }
};


__device__ __forceinline__ float dpp_ror1(float v) { return __builtin_bit_cast(float, __builtin_amdgcn_update_dpp(0, __builtin_bit_cast(int, v), 0x121, 0xf, 0xf, false)); }
__device__ __forceinline__ float dpp_ror2(float v) { return __builtin_bit_cast(float, __builtin_amdgcn_update_dpp(0, __builtin_bit_cast(int, v), 0x122, 0xf, 0xf, false)); }
struct EpiAct {
    static constexpr bool PERM = true;
    bf16_t* H; bf16_t* GUs; float* sbg; float* sbu; float* sbl; const float* cfw; const float* ss;
    __device__ __forceinline__ void operator()(f32x4 (&acc)[2][2][4][2], const Unit& u, int wr, int wc, int fr, int fq, LAS unsigned char* lds) const {
        asm volatile("" : "+s"(wr), "+s"(wc));
        int lane; asm volatile("v_mbcnt_lo_u32_b32 %0, -1, 0\n\tv_mbcnt_hi_u32_b32 %0, -1, %0" : "=v"(lane));
        fr = lane & 15; fq = lane >> 4;
        const int fl = wc * 32 + 8 * fq, f0 = u.pn * 128 + fl; int rowt = wr * 64 + fr;
        {
            float rst[2][4];
            f32x4 rsl[2][4];
#pragma unroll
            for (int ai = 0; ai < 2; ++ai)
#pragma unroll
                for (int m = 0; m < 4; ++m) rsl[ai][m] = *(const f32x4*)(ss + (size_t)(u.pm * BM + ai * HALF + rowt + m * 16) * 4);
#pragma unroll
            for (int ai = 0; ai < 2; ++ai)
#pragma unroll
                for (int m = 0; m < 4; ++m) { rst[ai][m] = ss_rstd(rsl[ai][m]); }
#pragma unroll
            for (int ai = 0; ai < 2; ++ai)
#pragma unroll
                for (int m = 0; m < 4; ++m) { acc[ai][0][m][0] = acc[ai][0][m][0] * rst[ai][m]; acc[ai][0][m][1] = acc[ai][0][m][1] * rst[ai][m]; acc[ai][1][m][0] = acc[ai][1][m][0] * rst[ai][m]; acc[ai][1][m][1] = acc[ai][1][m][1] * rst[ai][m]; }
        }
        if (u.pm == 128) {
#pragma unroll
            for (int ai = 0; ai < 2; ++ai)
#pragma unroll
                for (int m = 0; m < 4; ++m) { bf16_t* rp = GUs + (size_t)(ai * HALF + rowt + m * 16) * (2 * DFF) + f0; const float sc = 1.f;
#pragma unroll
                    for (int bj = 0; bj < 2; ++bj) { const f32x4 v0 = acc[ai][bj][m][0] * sc, v1 = acc[ai][bj][m][1] * sc;
                        u32x4 w; w.x = cvt_pk_bf16(v0[0], v0[1]); w.y = cvt_pk_bf16(v0[2], v0[3]); w.z = cvt_pk_bf16(v1[0], v1[1]); w.w = cvt_pk_bf16(v1[2], v1[3]);
                        *(u32x4*)(rp + bj * DFF) = w; } }
            return;
        }
        asm volatile("" : "+v"(rowt));
        LAS float* BND = (LAS float*)(lds + LDS_EX);
        if (fr >= 14) {
#pragma unroll
            for (int ai = 0; ai < 2; ++ai)
#pragma unroll
                for (int n = 0; n < 2; ++n) *(LAS f32x4*)(BND + ((ai * 2 + wr) * 2 + (fr - 14)) * 128 + fl + 4 * n) = acc[ai][0][3][n];
            if (wr == 1) {
#pragma unroll
                for (int n = 0; n < 2; ++n) *(f32x4*)(sbl + ((size_t)u.pm * 2 + (fr - 14)) * DFF + f0 + 4 * n) = acc[1][0][3][n];
            }
        }
        asm volatile("s_waitcnt lgkmcnt(0)" ::: "memory"); __builtin_amdgcn_s_barrier(); asm volatile("" ::: "memory");
#pragma unroll
        for (int ai = 0; ai < 2; ++ai) {
            const int pg = wr == 1 ? ai * 2 : 1;
            u32x2 hp[2][4];
#pragma unroll
            for (int n = 0; n < 2; ++n) {
                const f32x4 w0 = *(const f32x4*)(cfw + f0 + 4 * n), w1 = *(const f32x4*)(cfw + DFF + f0 + 4 * n), w2 = *(const f32x4*)(cfw + 2 * DFF + f0 + 4 * n);
                const f32x4 h2 = *(const LAS f32x4*)(BND + (pg * 2 + 0) * 128 + fl + 4 * n), h1 = *(const LAS f32x4*)(BND + (pg * 2 + 1) * 128 + fl + 4 * n);
#pragma unroll
                for (int jp = 0; jp < 2; ++jp) {
                    float hv[4][2];
#pragma unroll
                    for (int jj = 0; jj < 2; ++jj) { const int j = jp * 2 + jj;
                        float r1p = h1[j], r2p = fr == 0 ? h2[j] : h1[j];
#pragma unroll
                        for (int m = 0; m < 4; ++m) { const float g = acc[ai][0][m][n][j];
                            const float r1 = dpp_ror1(g), r2 = dpp_ror2(g);
                            const float gm1 = fr >= 1 ? r1 : r1p, gm2 = fr >= 2 ? r2 : r2p;
                            r1p = r1; r2p = r2;
                            const float cv = w0[j] * gm2 + w1[j] * gm1 + w2[j] * g;
                            hv[m][jj] = silu(cv) * acc[ai][1][m][n][j]; } }
#pragma unroll
                    for (int m = 0; m < 4; ++m) { const unsigned pk = cvt_pk_bf16(hv[m][0], hv[m][1]); if (jp == 0) hp[n][m].x = pk; else hp[n][m].y = pk; }
                }
            }
#pragma unroll
            for (int m = 0; m < 4; ++m) {
                const int rl = ai * HALF + rowt + m * 16;
                if (ai == 0 && m == 0 && wr == 0 && fr < 2) {
#pragma unroll
                    for (int n = 0; n < 2; ++n) { *(f32x4*)(sbg + ((size_t)u.pm * 2 + fr) * DFF + f0 + 4 * n) = acc[0][0][0][n]; *(f32x4*)(sbu + ((size_t)u.pm * 2 + fr) * DFF + f0 + 4 * n) = acc[0][1][0][n]; }
                } else {
                    u32x4 w; w.x = hp[0][m].x; w.y = hp[0][m].y; w.z = hp[1][m].x; w.w = hp[1][m].y;
                    *(u32x4*)(H + (size_t)(u.pm * BM + rl) * DFF + f0) = w;
                }
            }
        }
    }
};

template <class Epi, class Sched, bool ALIGN_EPI>
__device__ __forceinline__ void gemm_phase(LAS unsigned char* lds, const Gemm g, const Sched& S, const Epi& E, const int wave_s) {
    const int tid = opaque_tid(wave_s), wid = __builtin_amdgcn_readfirstlane(tid >> 6), lane = tid & 63, wr = wid >> 2, wc = wid & 3, fr = lane & 15, fq = lane >> 4;
    const int nt = g.K / BK;
    unsigned voffA[2], voffB[2];
#pragma unroll
    for (int i = 0; i < 2; ++i) { int R, C; stage_rc(tid * 16 + i * 8192, R, C); const int Rb = Epi::PERM ? ((R & ~31) + perm32(R & 31)) : R;
        voffA[i] = (unsigned)(R * g.lda + C) * 2u; voffB[i] = (unsigned)(Rb * g.ldb + C) * 2u; }
    const size_t kstep = (size_t)(BK * 2);
    const size_t hstepA = (size_t)HALF * g.lda * 2, hstepB = (size_t)HALF * g.ldb * 2;
    const unsigned ldsw = (unsigned)wid * 1024u;
    const int aoff = lds_byte(wr * 64 + fr, fq * 8), boff = lds_byte(wc * 32 + fr, fq * 8);
#define PG8_SA(b, h) (((b) * 2 + (h)) * HTB)
#define PG8_SB(b, h) ((4 + (b) * 2 + (h)) * HTB)
#define PG8_STAGE(bufoff, gbase, voff) do { _Pragma("unroll") for (int _i = 0; _i < 2; ++_i) \
        __builtin_amdgcn_global_load_lds((const unsigned*)((const char*)(gbase) + (voff)[_i]), (LAS unsigned*)(lds + (bufoff) + ldsw + _i * 8192), 16, 0, 0); } while (0)
#define PG8_LDA(dst, b, h) do { _Pragma("unroll") for (int m = 0; m < 4; ++m) _Pragma("unroll") for (int k = 0; k < 2; ++k) dst[m][k] = *(const LAS bf16x8*)(lds + PG8_SA(b, h) + aoff + m * 2048 + k * 1024); } while (0)
#define PG8_LDB(dst, b, h) do { _Pragma("unroll") for (int n = 0; n < 2; ++n) _Pragma("unroll") for (int k = 0; k < 2; ++k) dst[n][k] = *(const LAS bf16x8*)(lds + PG8_SB(b, h) + boff + n * 2048 + k * 1024); } while (0)
#define PG8_MMA(ai, bj, At, Bt) do { __builtin_amdgcn_s_setprio(1); _Pragma("unroll") for (int m = 0; m < 4; ++m) _Pragma("unroll") for (int n = 0; n < 2; ++n) _Pragma("unroll") for (int k = 0; k < 2; ++k) \
        acc[ai][bj][m][n] = __builtin_amdgcn_mfma_f32_16x16x32_bf16(Bt[n][k], At[m][k], acc[ai][bj][m][n], 0, 0, 0); __builtin_amdgcn_s_setprio(0); } while (0)
#define PG8_WAIT_V(n) asm volatile("s_waitcnt vmcnt(" #n ")" ::: "memory")
#define PG8_WAIT_L(n) asm volatile("s_waitcnt lgkmcnt(" #n ")" ::: "memory")
#define PG8_BAR __builtin_amdgcn_s_barrier()
#define PG8_SCHED __builtin_amdgcn_sched_barrier(0)
    Unit cur, nxt; int ui = 0;
    if (!S.next(0, cur)) return;
    f32x4 acc[2][2][4][2];
#pragma unroll
    for (int a = 0; a < 2; ++a)
#pragma unroll
        for (int b = 0; b < 2; ++b)
#pragma unroll
            for (int m = 0; m < 4; ++m)
#pragma unroll
                for (int n = 0; n < 2; ++n) acc[a][b][m][n] = (f32x4){0.f, 0.f, 0.f, 0.f};
    bf16x8 At[4][2], B0[2][2], B1[2][2];
    const char* cA = (const char*)g.A + S.offA(cur); const char* cB = (const char*)g.Bt + S.offB(cur);
    PG8_STAGE(PG8_SB(0, 0), cB, voffB); PG8_STAGE(PG8_SB(0, 1), cB + hstepB, voffB); PG8_STAGE(PG8_SA(0, 0), cA, voffA); PG8_STAGE(PG8_SA(0, 1), cA + hstepA, voffA);
    if (wr == 1) PG8_BAR;
    PG8_WAIT_V(2); PG8_BAR;
    PG8_STAGE(PG8_SB(1, 0), cB + kstep, voffB); PG8_STAGE(PG8_SA(1, 0), cA + kstep, voffA); PG8_STAGE(PG8_SB(1, 1), cB + hstepB + kstep, voffB);
    PG8_WAIT_V(6); PG8_BAR;
    for (;;) {
        const bool has_next = S.next(ui + 1, nxt);
        const char* nA = has_next ? (const char*)g.A + S.offA(nxt) : cA; const char* nB = has_next ? (const char*)g.Bt + S.offB(nxt) : cB;
        for (int t = 0; t < nt; t += 2) {
            const bool last = (t == nt - 2);
            const char* a1 = cA + (size_t)(t + 1) * kstep;
            const char* a2 = last ? nA : cA + (size_t)(t + 2) * kstep; const char* b2 = last ? nB : cB + (size_t)(t + 2) * kstep;
            const char* a3 = a2 + kstep; const char* b3 = b2 + kstep;
            PG8_LDB(B0, 0, 0); PG8_LDB(B1, 0, 1); PG8_SCHED; PG8_LDA(At, 0, 0); PG8_STAGE(PG8_SA(1, 1), a1 + hstepA, voffA);
            PG8_WAIT_V(8); PG8_WAIT_L(0); PG8_BAR; PG8_MMA(0, 0, At, B0); PG8_MMA(0, 1, At, B1); PG8_BAR; PG8_SCHED;
            PG8_LDA(At, 0, 1); PG8_STAGE(PG8_SB(0, 0), b2, voffB); PG8_STAGE(PG8_SB(0, 1), b2 + hstepB, voffB); PG8_STAGE(PG8_SA(0, 0), a2, voffA);
            PG8_WAIT_V(8); PG8_WAIT_L(0); PG8_BAR; PG8_MMA(1, 0, At, B0); PG8_MMA(1, 1, At, B1); PG8_BAR; PG8_SCHED;
            PG8_LDB(B0, 1, 0); PG8_LDB(B1, 1, 1); PG8_SCHED; PG8_LDA(At, 1, 0); PG8_STAGE(PG8_SA(0, 1), a2 + hstepA, voffA);
            PG8_WAIT_V(8); PG8_WAIT_L(0); PG8_BAR; PG8_MMA(0, 0, At, B0); PG8_MMA(0, 1, At, B1); PG8_BAR; PG8_SCHED;
            PG8_LDA(At, 1, 1); PG8_STAGE(PG8_SB(1, 0), b3, voffB); PG8_STAGE(PG8_SB(1, 1), b3 + hstepB, voffB); PG8_STAGE(PG8_SA(1, 0), a3, voffA);
            PG8_WAIT_V(8); PG8_WAIT_L(0); PG8_BAR; PG8_MMA(1, 0, At, B0); PG8_MMA(1, 1, At, B1); PG8_BAR; PG8_SCHED;
        }
        if constexpr (ALIGN_EPI) { if (wr == 0) PG8_BAR; }
        E(acc, cur, wr, wc, fr, fq, lds);
        if (!has_next) break;
#pragma unroll
        for (int a = 0; a < 2; ++a)
#pragma unroll
            for (int b = 0; b < 2; ++b)
#pragma unroll
                for (int m = 0; m < 4; ++m)
#pragma unroll
                    for (int n = 0; n < 2; ++n) acc[a][b][m][n] = (f32x4){0.f, 0.f, 0.f, 0.f};
        cur = nxt; cA = nA; cB = nB; ++ui;
        if constexpr (ALIGN_EPI) { if (wr == 1) PG8_BAR; }
    }
    PG8_WAIT_V(0);
    if constexpr (!ALIGN_EPI) { if (wr == 0) PG8_BAR; }
    PG8_BAR;
#undef PG8_SA
#undef PG8_SB
#undef PG8_STAGE
#undef PG8_LDA
#undef PG8_LDB
#undef PG8_MMA
#undef PG8_WAIT_V
#undef PG8_WAIT_L
#undef PG8_BAR
#undef PG8_SCHED
}
}

struct KVSched {
    int c, G; const char* ws;
    __device__ __forceinline__ bool next(int i, pg8::Unit& u) const {
        const int L = i * G + c; if (c < 0 || L >= 96) return false;
        const int kind = L >> 5, r = L & 31;
        if (kind < 2) { u.pm = kind * 16 + (r >> 2); u.pn = r & 3; } else { u.pm = 32 + (r >> 3); u.pn = r & 7; }
        return true;
    }
    __device__ __forceinline__ size_t offA(const pg8::Unit& u) const { const int kind = u.pm >> 4, pm = u.pm & 15; int k2 = (kind == 2); asm volatile("" : "+v"(k2));
        return (size_t)ws + WS_MEMB + (size_t)k2 * (WS_WV - WS_MEMB) + (size_t)pm * 256 * 1024 * 2; }
    __device__ __forceinline__ size_t offB(const pg8::Unit& u) const { const int kind = u.pm >> 4; int k1 = (kind == 1), k2 = (kind == 2); asm volatile("" : "+v"(k1), "+v"(k2));
        return (size_t)ws + WS_WK + (size_t)k1 * (WS_WV - WS_WK) + (size_t)k2 * (WS_MEMB - WS_WK) + (size_t)u.pn * 256 * 1024 * 2; }
};


#define XB_TMO      128
#define XB_XCNT(j)  (256  + 64 * (j))
#define XB_XSUB(j)  (1280 + 64 * (j))
#define XB_XGEN(j)  (2304 + 64 * (j))
#define XB_TOP      3328
#define XB_TOPGEN   3392
#define XCD_BAR_WORDS 3456
#define XB_SPIN_CAP (1u << 22)
__device__ __forceinline__ unsigned xb_ld(unsigned* p)              { return __hip_atomic_load(p, __ATOMIC_RELAXED, __HIP_MEMORY_SCOPE_AGENT); }
__device__ __forceinline__ unsigned xb_add(unsigned* p, unsigned v) { return __hip_atomic_fetch_add(p, v, __ATOMIC_RELAXED, __HIP_MEMORY_SCOPE_AGENT); }
__device__ __forceinline__ unsigned xb_xcc_id() { return (unsigned)__builtin_amdgcn_s_getreg((3 << 11) | 20) & 0xFu; }
#define XB_SPIN(cond, bar) do { unsigned _sp = 0; while (cond) { __builtin_amdgcn_s_sleep(1); \
    if ((++_sp & 255u) == 0u) { if (xb_ld(&(bar)[XB_TMO])) break; if (_sp > XB_SPIN_CAP) { atomicAdd(&(bar)[XB_TMO], 1u); break; } } } } while (0)
struct XcdBarrier { unsigned* bar; unsigned x; volatile LAS unsigned* st; };
__device__ __forceinline__ void xcd_barrier_complete(unsigned* bar, unsigned x, unsigned& nloc, unsigned& nx) {
    const unsigned G = gridDim.x * gridDim.y * gridDim.z;
    unsigned sum, cnt, mine, sp = 0u;
    for (;;) {
        sum = 0u; cnt = 0u; mine = 0u;
#pragma unroll
        for (unsigned j = 0; j < 16; ++j) { const unsigned c = xb_ld(&bar[XB_XCNT(j)]); sum += c; cnt += (c > 0u) ? 1u : 0u; mine = (j == x) ? c : mine; }
        if (sum == G) break;
        __builtin_amdgcn_s_sleep(1);
        if ((++sp & 255u) == 0u) { if (xb_ld(&bar[XB_TMO])) break; if (sp > XB_SPIN_CAP) { atomicAdd(&bar[XB_TMO], 1u); break; } }
    }
    nloc = mine > 0u ? mine : 1u; nx = cnt > 0u ? cnt : 1u;
}
__device__ __forceinline__ void xcd_barrier(const XcdBarrier& b) {
    asm volatile("s_waitcnt vmcnt(0)" ::: "memory");
    __syncthreads();
    if (threadIdx.x == 0) {
        unsigned* bar = b.bar;
        __builtin_amdgcn_s_waitcnt(0);
        unsigned nloc = b.st[0], nx = b.st[1];
        if (nloc == 0u) { xcd_barrier_complete(bar, b.x, nloc, nx); b.st[0] = nloc; b.st[1] = nx; }
        const unsigned old = xb_add(&bar[XB_XSUB(b.x)], 1u);
        const unsigned gen = old / nloc;
        if (old + 1u == (gen + 1u) * nloc) {
            __builtin_amdgcn_fence(__ATOMIC_RELEASE, "agent");
            asm volatile("s_waitcnt vmcnt(0)" ::: "memory");
            const unsigned og = xb_add(&bar[XB_TOP], 1u);
            const unsigned tg = og / nx;
            if (og + 1u == (tg + 1u) * nx) xb_add(&bar[XB_TOPGEN], 1u);
            else XB_SPIN(xb_ld(&bar[XB_TOPGEN]) == tg, bar);
            __builtin_amdgcn_fence(__ATOMIC_ACQUIRE, "agent");
            xb_add(&bar[XB_XGEN(b.x)], 1u);
            asm volatile("s_waitcnt vmcnt(0)" ::: "memory");
        } else {
            XB_SPIN(xb_ld(&bar[XB_XGEN(b.x)]) == gen, bar);
            __builtin_amdgcn_fence(__ATOMIC_ACQUIRE, "agent");
            asm volatile("s_waitcnt vmcnt(0)" ::: "memory");
        }
    }
    __syncthreads();
}

__device__ __forceinline__ void transpose_item(const float* W, int K, int N, bf16_t* WT, LAS float* scr, int item, int lane, const float* gain = nullptr, int gu = 0) {
    const int nblk = N / 32, kb = item / nblk, nb = item % nblk, k0 = 64 * kb, n0 = 32 * nb;
    {
        f32x4 v[8];
#pragma unroll
        for (int i = 0; i < 8; ++i) v[i] = *(const f32x4*)(W + (size_t)(k0 + (lane >> 3) + 8 * i) * N + n0 + (lane & 7) * 4);
#pragma unroll
        for (int i = 0; i < 8; ++i) { const int kk = (lane >> 3) + 8 * i; f32x4 w = v[i]; if (gain) w = w * gain[k0 + kk];
            LAS float* d = scr + kk * 33 + (lane & 7) * 4; d[0] = w[0]; d[1] = w[1]; d[2] = w[2]; d[3] = w[3]; }
    }
    LDS_WAIT();
    const int c = lane & 7;
#pragma unroll
    for (int j = 0; j < 4; ++j) { const int n = (lane >> 3) + 8 * j; const LAS float* s = scr + (8 * c) * 33 + n;
        u32x4 o; o.x = pk2(s[0 * 33], s[1 * 33]); o.y = pk2(s[2 * 33], s[3 * 33]); o.z = pk2(s[4 * 33], s[5 * 33]); o.w = pk2(s[6 * 33], s[7 * 33]);
        int drow = n0 + n; if (gu) { const int up = drow >= gu, f = up ? drow - gu : drow; drow = ((f >> 7) << 8) + (up << 7) + (f & 127); }
        *(u32x4*)(WT + (size_t)drow * K + k0 + 8 * c) = o; }
    LDS_WAIT();
}

__device__ __forceinline__ void first_rows(const float* Xp, const float* Xs, bf16_t* XNo, float* ss, int gw, int NGW, int lane) {
    for (int m = gw; m < MT; m += NGW) {
        const f32x4* xr = (const f32x4*)(m < MP ? Xp + (size_t)m * D : Xs + (size_t)(m - MP) * D) + lane;
        f32x4 v[4]; float s = 0.f;
#pragma unroll
        for (int j = 0; j < 4; ++j) { v[j] = xr[64 * j]; s += (v[j].x * v[j].x + v[j].y * v[j].y) + (v[j].z * v[j].z + v[j].w * v[j].w); }
        s = wave_sum(s, lane);
        if (lane < 4) ss[(size_t)m * 4 + lane] = lane == 0 ? s : 0.f;
        u32x2* o8 = (u32x2*)(XNo + (size_t)m * D) + lane;
#pragma unroll
        for (int j = 0; j < 4; ++j) { u32x2 w; w.x = pk2(v[j].x, v[j].y); w.y = pk2(v[j].z, v[j].w); o8[64 * j] = w; }
    }
}

typedef __attribute__((address_space(4))) const unsigned char* kptr_t;
typedef const float* cfp_t; typedef float* fp_t; typedef unsigned char* ucp_t;
#define INP(k) (*(const __attribute__((address_space(4))) cfp_t*)(kp + 8 * (k)))
#define X out
#define WIN_T ((bf16_t*)(ws + WS_WIN))
#define WOUT_T ((bf16_t*)(ws + WS_WOUT))
#define WQ_T ((bf16_t*)(ws + WS_WQ))
#define WK_T ((bf16_t*)(ws + WS_WK))
#define WV_T ((bf16_t*)(ws + WS_WV))
#define WO_T ((bf16_t*)(ws + WS_WO))
#define WUP_T ((bf16_t*)(ws + WS_WUP))
#define WDN_T ((bf16_t*)(ws + WS_WDN))
#define MEMB ((bf16_t*)(ws + WS_MEMB))
#define KBP ((bf16_t*)(ws + WS_KBP))
#define VTP ((bf16_t*)(ws + WS_VTP))
#define KBS ((bf16_t*)(ws + WS_KBS))
#define VTS ((bf16_t*)(ws + WS_VTS))
#define WST ((bf16_t*)(ws + WS_WST))
#define AGG ((float*)(ws + WS_AGG))
#define SSQ(i) ((float*)(ws + WS_SSP) + (size_t)(i) * MT * 4)
#define GT_R ((bf16_t*)(ws + WS_GT))
#define GT_I ((bf16_t*)(ws + WS_GT + 65536))
#define XN ((bf16_t*)(ws + WS_XN))
#define gZ ((bf16_t*)(ws + B_Z))
#define HLOC ((float*)(ws + B_HLOC))
#define PCUM ((float*)(ws + B_PCUM))
#define gY ((bf16_t*)(ws + B_Y))
#define gQ ((bf16_t*)(ws + B_Q))
#define gP ((bf16_t*)(ws + B_P))
#define gO ((bf16_t*)(ws + B_O))
#define PS ((bf16_t*)(ws + B_PS))
#define GU ((bf16_t*)(ws + B_GU))
#define GUS ((bf16_t*)(ws + B_GUS))
#define SBG ((float*)(ws + B_SBG))
#define SBU ((float*)(ws + B_SBU))
#define SBL ((float*)(ws + B_SBL))
__global__ void __launch_bounds__(NTHREADS, 2) trunk_fwd(Args args) {
    extern __shared__ __attribute__((aligned(16))) unsigned char lds_raw[];
    LAS unsigned char* lds = (LAS unsigned char*)lds_raw;
    cg::grid_group grid = cg::this_grid();
    const int wave_s = __builtin_amdgcn_readfirstlane(threadIdx.x >> 6);
#define LANE_STATE() int G = gridDim.x, bid = blockIdx.x; asm volatile("" : "+s"(G), "+s"(bid)); const int NGW = G * NWAVES, NGT = G * NTHREADS; (void)NGW; (void)NGT; \
    const int tid = opaque_tid(wave_s), lane = tid & 63, wave = wave_s; const int gw = bid * NWAVES + wave; const int gt = bid * NTHREADS + tid; (void)lane; (void)gw; (void)gt; \
    kptr_t kp = (kptr_t)__builtin_amdgcn_kernarg_segment_ptr(); asm volatile("" : "+s"(kp)); \
    float* const out = *(const __attribute__((address_space(4))) fp_t*)(kp + 8 * N_IN); unsigned char* const ws = *(const __attribute__((address_space(4))) ucp_t*)(kp + 8 * N_IN + 8); (void)out; (void)ws
    {
        LANE_STATE();
        if (bid == 0) for (int i = tid; i < XCD_BAR_WORDS; i += NTHREADS) __hip_atomic_store((unsigned*)(ws + WS_BAR) + i, 0u, __ATOMIC_RELAXED, __HIP_MEMORY_SCOPE_AGENT);
        if (tid < 32) ((LAS unsigned*)(lds + LDS_MISC))[tid] = 0u;
        __threadfence();
        grid.sync();
        if (tid == 0) (void)xb_add((unsigned*)(ws + WS_BAR) + XB_XCNT(xb_xcc_id()), 1u);
    }
#define GRID_SYNC() do { kptr_t kp_ = (kptr_t)__builtin_amdgcn_kernarg_segment_ptr(); asm volatile("" : "+s"(kp_)); \
        XcdBarrier b_; b_.bar = (unsigned*)(*(const __attribute__((address_space(4))) ucp_t*)(kp_ + 8 * N_IN + 8) + WS_BAR); b_.x = xb_xcc_id(); b_.st = (volatile LAS unsigned*)(lds + LDS_MISC); \
        xcd_barrier(b_); if (PROBE == 3) xcd_barrier(b_); } while (0)

    for (int l = 0; l < DEPTH; ++l) {
        for (int dup0 = 0; dup0 < ((PROBE == 1 || PROBE == 5) ? 2 : 1); ++dup0) {
        {
            LANE_STATE();
            LAS float* scr = (LAS float*)(lds + wave * 16384);
            const float* w_in = INP(I_WIN) + (size_t)l * D * INC; const float* w_out = INP(I_WOUT) + (size_t)l * D * D; const float* w_q = INP(I_WQ) + (size_t)l * D * D;
            const float* w_k = INP(I_WK) + (size_t)l * D * D; const float* w_v = INP(I_WV) + (size_t)l * D * D; const float* w_o = INP(I_WO) + (size_t)l * D * D;
            const float* w_up = INP(I_WUP) + (size_t)l * D * 2 * DFF; const float* w_dn = INP(I_WDN) + (size_t)l * DFF * D; const float* c_v = INP(I_CV) + (size_t)l * BS * NMEM * D;
            constexpr int T_IN = 16 * (INC / 32), T_SQ = 16 * 32, T_UP = 16 * (2 * DFF / 32), T_DN = (DFF / 64) * 32, T_CV = 32 * 32;
            constexpr int T_G = 16;
            constexpr int NIT = T_IN + 5 * T_SQ + T_UP + T_DN + T_CV + 2 * T_G;
            for (int it = gw; it < NIT; it += NGW) {
                int r = it;
                if (r < T_IN) { transpose_item(w_in, D, INC, WIN_T, scr, r, lane, INP(I_GMIX) + l * D); continue; } r -= T_IN;
                if (r < T_SQ) { transpose_item(w_out, D, D, WOUT_T, scr, r, lane); continue; } r -= T_SQ;
                if (r < T_SQ) { transpose_item(w_q, D, D, WQ_T, scr, r, lane, INP(I_GX) + l * D); continue; } r -= T_SQ;
                if (r < T_SQ) { transpose_item(w_k, D, D, WK_T, scr, r, lane); continue; } r -= T_SQ;
                if (r < T_SQ) { transpose_item(w_v, D, D, WV_T, scr, r, lane); continue; } r -= T_SQ;
                if (r < T_SQ) { transpose_item(w_o, D, D, WO_T, scr, r, lane); continue; } r -= T_SQ;
                if (r < T_UP) { transpose_item(w_up, D, 2 * DFF, WUP_T, scr, r, lane, INP(I_GFFN) + l * D, DFF); continue; } r -= T_UP;
                if (r < T_DN) { transpose_item(w_dn, DFF, D, WDN_T, scr, r, lane); continue; } r -= T_DN;
                if (r < T_CV) { transpose_item(c_v, BS * NMEM, D, VTS, scr, r, lane); continue; } r -= T_CV;
                if (r < T_G) { transpose_item(INP(I_WRG) + ((size_t)l * 8 + (r >> 1)) * 4096, 64, 64, GT_R + (r >> 1) * 4096, scr, r & 1, lane); continue; } r -= T_G;
                transpose_item(INP(I_WIG) + ((size_t)l * 8 + (r >> 1)) * 4096, 64, 64, GT_I + (r >> 1) * 4096, scr, r & 1, lane);
            }
            {
                const f32x4* ck = (const f32x4*)(INP(I_CK) + (size_t)l * BS * NMEM * D); u32x2* dk = (u32x2*)KBS;
                for (int i = gt; i < BS * NMEM * D / 4; i += NGT) { const f32x4 v = ck[i]; u32x2 w; w.x = pk2(v.x, v.y); w.y = pk2(v.z, v.w); dk[i] = w; }
                if (l == 0) { const f32x4* mm = (const f32x4*)INP(I_MEM); u32x2* dm = (u32x2*)MEMB;
                    for (int i = gt; i < BP * NMEM * D / 4; i += NGT) { const f32x4 v = mm[i]; u32x2 w; w.x = pk2(v.x, v.y); w.y = pk2(v.z, v.w); dm[i] = w; } }
                const float* wsl = INP(I_WS) + (size_t)l * 4 * 128 * 128;
                for (int i = gt; i < 4 * 128 * 128; i += NGT) { const int s = i & 127, t = (i >> 7) & 127; WST[i] = (bf16_t)f2bf(s <= t ? wsl[i] : 0.f); }
            }
            if (l == 0) first_rows(INP(I_XP), INP(I_XS), XN, SSQ(0), gw, NGW, lane);
        }
        GRID_SYNC();
        }
        {
            LANE_STATE();
            KVSched S; S.G = G; S.c = bid >= 160 ? bid - 160 : -1; S.ws = (const char*)ws;
            pg8::Gemm g{(const bf16_t*)nullptr, (const bf16_t*)nullptr, D, D, D};
            pg8::EpiKV E{out + O_MKP + (size_t)l * BP * NMEM * D, out + O_MVP + (size_t)l * BP * NMEM * D, KBP, VTP};
            pg8::gemm_phase<pg8::EpiKV, KVSched, true>(lds, g, S, E, wave_s);
        }
#define GEMM_BF16(s_) do { const int s = (s_); pg8::GSched S; pg8::Gemm g; pg8::EpiBf16 E; E.scale = 1.f; E.ss = nullptr; \
        if (s == 0) { S.init(MT / 256, INC / 256, G, bid); S.aPm = (size_t)256 * D * 2; S.bPn = (size_t)256 * D * 2; g = pg8::Gemm{XN, WIN_T, D, D, D}; E.O = gZ; E.ldc = INC; E.ss = SSQ(3 * l); } \
        else if (s == 1) { S.init(MT / 256, D / 256, G, bid); S.aPm = (size_t)256 * D * 2; S.bPn = (size_t)256 * D * 2; g = pg8::Gemm{XN, WQ_T, D, D, D}; E.O = gQ; E.ldc = D; E.scale = 0.0625f; E.ss = SSQ(3 * l + 1); } \
        else if (s == 2) { S.init(MP / 256, 4, G, bid); S.aPm = (size_t)256 * D * 2; S.aPn = 512; S.bPn = (size_t)256 * 2048 * 2; S.bPm = 512; S.bShift = 4; g = pg8::Gemm{gP, VTP, D, 2048, 256}; E.O = gO; E.ldc = D; } \
        else { S.init(1, 4, G, (bid + G - 8) % G); S.aPn = 4096; S.bPn = (size_t)256 * 2048 * 2; g = pg8::Gemm{PS, VTS, 8192, 2048, 2048}; E.O = gO + (size_t)MP * D; E.ldc = D; } \
        pg8::gemm_phase<pg8::EpiBf16, pg8::GSched, true>(lds, g, S, E, wave_s); } while (0)
#define GEMM_RES(s_) do { const int s = (s_); pg8::GSched S; S.init(MT / 256, D / 256, G, bid); pg8::Gemm g; \
        if (s == 0) { g = pg8::Gemm{gY, WOUT_T, D, D, D}; S.aPm = (size_t)256 * D * 2; } \
        else if (s == 1) { g = pg8::Gemm{gO, WO_T, D, D, D}; S.aPm = (size_t)256 * D * 2; } \
        else { g = pg8::Gemm{GU, WDN_T, DFF, DFF, DFF}; S.aPm = (size_t)256 * DFF * 2; } \
        S.bPn = (size_t)256 * g.ldb * 2; \
        pg8::EpiResid E{XN, SSQ(3 * l + 1 + s)}; \
        pg8::gemm_phase<pg8::EpiResid, pg8::GSched, true>(lds, g, S, E, wave_s); } while (0)

        for (int rep = 0; rep < 13; ++rep) { if (rep == 4 || rep == 9) continue;
          const int ndup = ((PROBE == 1 && (rep == 1 || rep == 2)) || (PROBE == 4 && rep == 1) || (PROBE == 6 && rep == 2)) ? 2 : ((PROBE == 2 && (rep == 0 || rep == 5 || rep == 6 || rep == 7 || rep == 10)) ? 2 : 1);
          for (int dup = 0; dup < ndup; ++dup) {
            if (rep == 0 || rep == 5 || rep == 7) {
                LANE_STATE();
                const int s0 = rep == 0 ? 0 : (rep == 5 ? 1 : 2), ns = rep == 7 ? 2 : 1;
                for (int q = 0; q < ns; ++q) GEMM_BF16(s0 + q);
            } else if (rep == 10) {
                LANE_STATE();
                pg8::GSched S; S.init(MT / 256, 2 * DFF / 256, G, bid); S.aPm = (size_t)256 * D * 2; S.bPn = (size_t)256 * D * 2;
                const pg8::Gemm g{XN, WUP_T, D, D, D};
                const pg8::EpiAct E{GU, GUS, SBG, SBU, SBL, INP(I_CFW) + (size_t)l * 3 * DFF, SSQ(3 * l + 2)};
                pg8::gemm_phase<pg8::EpiAct, pg8::GSched, true>(lds, g, S, E, wave_s);
            } else if (rep == 1) {
                LANE_STATE();
                {
                    LAS bf16_t* vT = (LAS bf16_t*)lds;
                    constexpr int VP = 136;
                    const float* gvp = INP(I_GV) + l * CW; const float* bsp = INP(I_BSS) + l * 4 * 128;
                    for (int un = bid; un < 8 + 256; un += G) {
                        int rowbase, nrows, sb = -1;
                        if (un < 8) { sb = un; rowbase = MP + un * TS; nrows = TS; } else { rowbase = (un - 8) * 128; nrows = 128; }
                        {
                            const int rl = tid >> 5, cgp = tid & 31;
                            f32x4 g0 = *(const f32x4*)(gvp + cgp * 8), g1 = *(const f32x4*)(gvp + cgp * 8 + 4);
                            for (int p = 0; p < nrows / 16; ++p) {
                                const int r = p * 16 + rl;
                                const u32x4 raw = *(const u32x4*)(gZ + (size_t)(rowbase + r) * INC + Z_VC + cgp * 8);
                                float v[8] = {bflo(raw.x), bfhi(raw.x), bflo(raw.y), bfhi(raw.y), bflo(raw.z), bfhi(raw.z), bflo(raw.w), bfhi(raw.w)};
                                float ss = 0.f;
#pragma unroll
                                for (int k = 0; k < 8; ++k) { v[k] = gelu_t(v[k]); ss += v[k] * v[k]; }
                                ss += shx(ss, 1, lane); ss += shx(ss, 2, lane); ss += shx(ss, 4, lane);
                                const float rstd = 1.0f / sqrtf(ss * (1.f / 64.f) + EPS);
                                const float gg[8] = {g0.x, g0.y, g0.z, g0.w, g1.x, g1.y, g1.z, g1.w};
#pragma unroll
                                for (int k = 0; k < 8; ++k) { v[k] = v[k] * rstd * gg[k]; vT[(cgp * 8 + k) * VP + r] = (bf16_t)f2bf(v[k]); }
                                if (sb >= 0) { float* vo = out + O_VCS + ((size_t)(l * BS + sb) * TS + r) * CW + cgp * 8;
                                    *(f32x4*)vo = (f32x4){v[0], v[1], v[2], v[3]}; *(f32x4*)(vo + 4) = (f32x4){v[4], v[5], v[6], v[7]}; }
                            }
                        }
                        __syncthreads();
                        {
                            const int hh = wave & 3, rh = wave >> 2, fr = lane & 15, fq = lane >> 4;
                            const int nmt = nrows == 128 ? 4 : (rh == 0 ? 2 : 0);
                            for (int mi = 0; mi < nmt; ++mi) {
                                const int mt = rh * 4 + mi, nks = (mt * 16 + 15) / 32 + 1;
                                f32x4 acc[4];
#pragma unroll
                                for (int n = 0; n < 4; ++n) acc[n] = (f32x4){0.f, 0.f, 0.f, 0.f};
                                for (int ks = 0; ks < nks; ++ks) {
                                    const bf16x8 a = *(const bf16x8*)(WST + ((size_t)(hh * 128 + mt * 16 + fr) * 128 + ks * 32 + fq * 8));
#pragma unroll
                                    for (int n = 0; n < 4; ++n) { const bf16x8 b = *(const LAS bf16x8*)(vT + (hh * 64 + n * 16 + fr) * VP + ks * 32 + fq * 8);
                                        acc[n] = __builtin_amdgcn_mfma_f32_16x16x32_bf16(b, a, acc[n], 0, 0, 0); }
                                }
                                { const int t = mt * 16 + fr; const float bias = bsp[hh * 128 + t]; const size_t row = (size_t)(rowbase + t);
#pragma unroll
                                    for (int n = 0; n < 4; ++n) { const int c = hh * 64 + n * 16 + fq * 4; const u32x2 uq = *(const u32x2*)(gZ + row * INC + Z_UC + c);
                                        u32x2 w; w.x = pk2(gelu_t(bflo(uq.x)) * (acc[n][0] + bias), gelu_t(bfhi(uq.x)) * (acc[n][1] + bias)); w.y = pk2(gelu_t(bflo(uq.y)) * (acc[n][2] + bias), gelu_t(bfhi(uq.y)) * (acc[n][3] + bias));
                                        *(u32x2*)(gY + row * D + 768 + c) = w; } }
                            }
                        }
                        __syncthreads();
                    }
                }
                {
                    LAS unsigned char* wl = lds + wave * 16384;
                    LAS bf16_t* tile = (LAS bf16_t*)wl;
                    LAS float* pre_r = (LAS float*)(wl + 2560);
                    LAS float* pre_i = (LAS float*)(wl + 2560 + 4096);
                    LAS float* xcf = (LAS float*)(wl + 2560 + 8192);
                    const int fr = lane & 15, fq = lane >> 4;
                    for (int un = gw; un < 64 + 2048; un += NGW) {
                        int b, hd, rowbase, nrows, t0; bool smp = un < 64;
                        if (smp) { b = un >> 3; hd = un & 7; rowbase = MP + b * TS; nrows = TS; t0 = 0; }
                        else { const int v = un - 64; const int ch = v & 31; hd = (v >> 5) & 7; b = v >> 8; t0 = ch * 128; rowbase = b * SEQ + t0; nrows = 128; }
                        const int cidx = l * AW + hd * 64 + lane;
                        const float br = INP(I_BRG)[cidx], bi = INP(I_BIG)[cidx];
                        const float c8sp = 8.0f * log1pf(__expf(-INP(I_LAM)[cidx]));
                        const float* caw = INP(I_CAW) + (size_t)l * 4 * AW + hd * 64 + lane;
                        const float cw0 = caw[0], cw1 = caw[AW], cw2 = caw[2 * AW], cw3 = caw[3 * AW], cb = INP(I_CAB)[cidx];
                        bf16x8 bR[4][2], bI[4][2];
#pragma unroll
                        for (int n = 0; n < 4; ++n)
#pragma unroll
                            for (int ks = 0; ks < 2; ++ks) { const size_t o_ = (size_t)(hd * 64 + n * 16 + fr) * 64 + ks * 32 + fq * 8;
                                bR[n][ks] = *(const bf16x8*)(GT_R + o_); bI[n][ks] = *(const bf16x8*)(GT_I + o_); }
                        float xm3 = 0.f, xm2 = 0.f, xm1 = 0.f;
                        if (smp) { const float* st = INP(I_SCA) + ((size_t)(l * BS + b) * 3) * AW + hd * 64 + lane; xm3 = st[0]; xm2 = st[AW]; xm1 = st[2 * AW]; }
                        else if (t0 > 0) { const bf16_t* zp = gZ + (size_t)(rowbase - 3) * INC + Z_XA + hd * 64 + lane; xm3 = bf2f(zp[0]); xm2 = bf2f(zp[INC]); xm1 = bf2f(zp[2 * INC]); }
                        float h = 0.f, pc = 1.f;
                        const bf16_t* zq = gZ + (size_t)(rowbase + (lane >> 3)) * INC + Z_XA + hd * 64 + (lane & 7) * 8;
                        float* hp = HLOC + (size_t)rowbase * AW + hd * 64 + lane; float* pp = PCUM + (size_t)rowbase * AW + hd * 64 + lane;
                        LAS bf16_t* xraw = (LAS bf16_t*)pre_r;
                        u32x4 xn0 = *(const u32x4*)zq, xn1 = *(const u32x4*)(zq + (size_t)8 * INC);
                        for (int st = 0; st < nrows / 16; ++st) {
                            *(LAS u32x4*)(xraw + (lane >> 3) * 64 + (lane & 7) * 8) = xn0; *(LAS u32x4*)(xraw + ((lane >> 3) + 8) * 64 + (lane & 7) * 8) = xn1;
                            zq += (size_t)16 * INC;
                            if (st + 1 < nrows / 16) { xn0 = *(const u32x4*)zq; xn1 = *(const u32x4*)(zq + (size_t)8 * INC); }
                            LDS_WAIT();
#pragma unroll
                            for (int i = 0; i < 16; ++i) { const float xv = bf2f(xraw[i * 64 + lane]);
                                const float xc = cw0 * xm3 + cw1 * xm2 + cw2 * xm1 + cw3 * xv + cb; xm3 = xm2; xm2 = xm1; xm1 = xv; xcf[i * 64 + lane] = xc; tile[i * 72 + lane] = (bf16_t)f2bf(xc); }
                            LDS_WAIT();
                            const bf16x8 a0 = *(const LAS bf16x8*)(tile + fr * 72 + fq * 8), a1 = *(const LAS bf16x8*)(tile + fr * 72 + 32 + fq * 8);
#pragma unroll
                            for (int n = 0; n < 4; ++n) {
                                f32x4 ar = (f32x4){0.f, 0.f, 0.f, 0.f}, ai = (f32x4){0.f, 0.f, 0.f, 0.f};
                                ar = __builtin_amdgcn_mfma_f32_16x16x32_bf16(a0, bR[n][0], ar, 0, 0, 0); ar = __builtin_amdgcn_mfma_f32_16x16x32_bf16(a1, bR[n][1], ar, 0, 0, 0);
                                ai = __builtin_amdgcn_mfma_f32_16x16x32_bf16(a0, bI[n][0], ai, 0, 0, 0); ai = __builtin_amdgcn_mfma_f32_16x16x32_bf16(a1, bI[n][1], ai, 0, 0, 0);
#pragma unroll
                                for (int j = 0; j < 4; ++j) { pre_r[(fq * 4 + j) * 64 + n * 16 + fr] = ar[j]; pre_i[(fq * 4 + j) * 64 + n * 16 + fr] = ai[j]; }
                            }
                            LDS_WAIT();
#pragma unroll 4
                            for (int i = 0; i < 16; ++i) {
                                const float r = sigm(pre_r[i * 64 + lane] + br), gi = sigm(pre_i[i * 64 + lane] + bi);
                                const float la = -c8sp * r; float a, om;
                                if (la > -0.125f) { const float x = 2.0f * la; om = -x * (1.0f + x * (0.5f + x * (0.16666667f + x * (0.041666668f + x * (0.0083333338f + x * 0.0013888889f))))); a = 1.0f + la * (1.0f + la * (0.5f + la * (0.16666667f + la * (0.041666668f + la * 0.0083333338f)))); }
                                else { a = __expf(la); om = -expm1f(2.0f * la); }
                                const float bm = sqrtf(om);
                                h = a * h + bm * gi * xcf[i * 64 + lane]; pc = pc * a;
                                *hp = h; *pp = pc; hp += AW; pp += AW;
                            }
                            LDS_WAIT();
                        }
                        AGG[(size_t)un * 128 + lane] = pc; AGG[(size_t)un * 128 + 64 + lane] = h;
                    }
                }
                {
                    const float* cbw = INP(I_CBW) + (size_t)l * 3 * BW;
                    for (int it = gt; it < (MT / 16) * 32; it += NGT) {
                        const int rb = it >> 5, c0 = (it & 31) * 8;
                        int b, t0, T, rowbase; bool smp = rb >= MP / 16;
                        if (!smp) { b = rb >> 8; t0 = (rb & 255) * 16; T = SEQ; rowbase = rb * 16; } else { const int sbk = rb - MP / 16; b = sbk >> 1; t0 = (sbk & 1) * 16; T = TS; rowbase = MP + sbk * 16; }
                        float w0[8], w1[8], w2[8], pm2[8], pm1[8];
#pragma unroll
                        for (int k = 0; k < 8; ++k) { w0[k] = cbw[c0 + k]; w1[k] = cbw[BW + c0 + k]; w2[k] = cbw[2 * BW + c0 + k]; pm2[k] = 0.f; pm1[k] = 0.f; }
                        if (t0 == 0) { if (smp) { const float* st = INP(I_SCB) + ((size_t)(l * BS + b) * 2) * BW + c0;
#pragma unroll
                                for (int k = 0; k < 8; ++k) { pm2[k] = st[k]; pm1[k] = st[BW + k]; } } }
                        else {
#pragma unroll
                            for (int rr = 0; rr < 2; ++rr) { const bf16_t* zr = gZ + (size_t)(rowbase - 2 + rr) * INC; const u32x4 xb = *(const u32x4*)(zr + Z_XB + c0), gc = *(const u32x4*)(zr + Z_GC + c0);
                                float pv[8] = {bflo(xb.x) * bflo(gc.x), bfhi(xb.x) * bfhi(gc.x), bflo(xb.y) * bflo(gc.y), bfhi(xb.y) * bfhi(gc.y), bflo(xb.z) * bflo(gc.z), bfhi(xb.z) * bfhi(gc.z), bflo(xb.w) * bflo(gc.w), bfhi(xb.w) * bfhi(gc.w)};
#pragma unroll
                                for (int k = 0; k < 8; ++k) { if (rr == 0) pm2[k] = pv[k]; else pm1[k] = pv[k]; } }
                        }
                        for (int i = 0; i < 16; ++i) {
                            const bf16_t* zr = gZ + (size_t)(rowbase + i) * INC; const u32x4 xb = *(const u32x4*)(zr + Z_XB + c0), gc = *(const u32x4*)(zr + Z_GC + c0), gb = *(const u32x4*)(zr + Z_GB + c0);
                            const float pv[8] = {bflo(xb.x) * bflo(gc.x), bfhi(xb.x) * bfhi(gc.x), bflo(xb.y) * bflo(gc.y), bfhi(xb.y) * bfhi(gc.y), bflo(xb.z) * bflo(gc.z), bfhi(xb.z) * bfhi(gc.z), bflo(xb.w) * bflo(gc.w), bfhi(xb.w) * bfhi(gc.w)};
                            const float gbv[8] = {bflo(gb.x), bfhi(gb.x), bflo(gb.y), bfhi(gb.y), bflo(gb.z), bfhi(gb.z), bflo(gb.w), bfhi(gb.w)};
                            float yv[8];
#pragma unroll
                            for (int k = 0; k < 8; ++k) { yv[k] = gbv[k] * (w0[k] * pm2[k] + w1[k] * pm1[k] + w2[k] * pv[k]); pm2[k] = pm1[k]; pm1[k] = pv[k]; }
                            u32x4 w; w.x = pk2(yv[0], yv[1]); w.y = pk2(yv[2], yv[3]); w.z = pk2(yv[4], yv[5]); w.w = pk2(yv[6], yv[7]);
                            *(u32x4*)(gY + (size_t)(rowbase + i) * D + 512 + c0) = w;
                        }
                        if (t0 + 16 == T) { float* o = out + (smp ? O_CBS : O_CBP) + ((size_t)(l * 8 + b) * 2) * BW + c0;
#pragma unroll
                            for (int k = 0; k < 8; ++k) { o[k] = pm2[k]; o[BW + k] = pm1[k]; } }
                    }
                }
            } else if (rep == 2) {
                LANE_STATE();
                {
                    LAS float* cr = (LAS float*)lds;
                    for (int un = bid; un < 8 + 256; un += G) {
                        int b, ch, rowbase, nrows; const bool smp = un < 8;
                        if (smp) { b = un; ch = 0; rowbase = MP + b * TS; nrows = TS; } else { const int v = un - 8; b = v >> 5; ch = v & 31; rowbase = b * SEQ + ch * 128; nrows = 128; }
                        {
                            const int c = tid, hd = c >> 6, ln = c & 63; float carry = 0.f;
                            if (smp) carry = INP(I_SHA)[(size_t)(l * BS + b) * AW + c];
                            else { const float* ag = AGG + (size_t)(64 + (b << 8) + (hd << 5)) * 128 + ln; for (int k = 0; k < ch; ++k) carry = ag[(size_t)k * 128] * carry + ag[(size_t)k * 128 + 64]; }
                            cr[c] = carry;
                        }
                        __syncthreads();
                        const int c0 = (tid & 63) * 8, rsub = tid >> 6;
                        const f32x4 ca = *(const LAS f32x4*)(cr + c0), cb = *(const LAS f32x4*)(cr + c0 + 4);
                        for (int p = 0; p < nrows / 8; ++p) {
                            const int rloc = p * 8 + rsub; const size_t row = (size_t)(rowbase + rloc);
                            const f32x4 h0 = *(const f32x4*)(HLOC + row * AW + c0), h1 = *(const f32x4*)(HLOC + row * AW + c0 + 4), p0 = *(const f32x4*)(PCUM + row * AW + c0), p1 = *(const f32x4*)(PCUM + row * AW + c0 + 4);
                            const u32x4 gq = *(const u32x4*)(gZ + row * INC + Z_GA + c0);
                            const f32x4 a0 = h0 + p0 * ca, a1 = h1 + p1 * cb;
                            u32x4 w; w.x = pk2(gelu_t(bflo(gq.x)) * a0[0], gelu_t(bfhi(gq.x)) * a0[1]); w.y = pk2(gelu_t(bflo(gq.y)) * a0[2], gelu_t(bfhi(gq.y)) * a0[3]);
                            w.z = pk2(gelu_t(bflo(gq.z)) * a1[0], gelu_t(bfhi(gq.z)) * a1[1]); w.w = pk2(gelu_t(bflo(gq.w)) * a1[2], gelu_t(bfhi(gq.w)) * a1[3]);
                            *(u32x4*)(gY + row * D + c0) = w;
                            if ((smp || ch == 31) && rloc == nrows - 1) { float* o = out + (smp ? O_HAS : O_HAP) + (size_t)(l * 8 + b) * AW + c0; *(f32x4*)o = a0; *(f32x4*)(o + 4) = a1; }
                        }
                        if ((smp || ch == 31) && tid < 192) {
                            const int k = tid >> 6; const u32x4 xq = *(const u32x4*)(gZ + (size_t)(rowbase + nrows - 3 + k) * INC + Z_XA + c0);
                            float* o = out + (smp ? O_CAS : O_CAP) + ((size_t)(l * 8 + b) * 3 + k) * AW + c0;
                            *(f32x4*)o = (f32x4){bflo(xq.x), bfhi(xq.x), bflo(xq.y), bfhi(xq.y)}; *(f32x4*)(o + 4) = (f32x4){bflo(xq.z), bfhi(xq.z), bflo(xq.w), bfhi(xq.w)};
                        }
                        __syncthreads();
                    }
                }
            } else if (rep == 3 || rep == 8 || rep == 12) {
                LANE_STATE();
                GEMM_RES(rep == 3 ? 0 : (rep == 8 ? 1 : 2));
            } else if (rep == 6) {
                LANE_STATE();
                for (int sub = 0; sub < 2; ++sub) {
                    pg8::GSched S; pg8::Gemm g; pg8::EpiSoftmax E;
                    if (sub == 0) { S.init(MP / 256, 4, G, bid); S.aPm = (size_t)256 * D * 2; S.aPn = 512; S.bPn = 512; S.bPm = (size_t)256 * D * 2; S.bShift = 4; g = pg8::Gemm{gQ, KBP, D, D, 256}; E.O = gP; E.ldc = D; E.smp = 0; }
                    else { S.init(1, 32, G, (bid + G - 64) % G); S.mode = 1; g = pg8::Gemm{gQ + (size_t)MP * D, KBS, D, D, 256}; E.O = PS; E.ldc = 8192; E.smp = 1; }
                    pg8::gemm_phase<pg8::EpiSoftmax, pg8::GSched, true>(lds, g, S, E, wave_s);
                }
            } else if (rep == 11) {
                LANE_STATE();
                {
                    const float* cfw = INP(I_CFW) + (size_t)l * 3 * DFF;
                    for (int it = gt; it < (MP / 256) * (DFF / 8); it += NGT) {
                        const int pm = it / (DFF / 8), c0 = (it % (DFF / 8)) * 8, b = pm >> 4;
                        float w0[8], w1[8], w2[8], p2[8], p1[8], g0[8], g1[8], u0[8], u1[8];
#pragma unroll
                        for (int k = 0; k < 8; ++k) { w0[k] = cfw[c0 + k]; w1[k] = cfw[DFF + c0 + k]; w2[k] = cfw[2 * DFF + c0 + k]; p2[k] = 0.f; p1[k] = 0.f; }
                        if ((pm & 15) != 0) {
#pragma unroll
                            for (int k = 0; k < 8; ++k) { p2[k] = SBL[((size_t)(pm - 1) * 2 + 0) * DFF + c0 + k]; p1[k] = SBL[((size_t)(pm - 1) * 2 + 1) * DFF + c0 + k]; } }
#pragma unroll
                        for (int k = 0; k < 8; ++k) { g0[k] = SBG[((size_t)pm * 2 + 0) * DFF + c0 + k]; g1[k] = SBG[((size_t)pm * 2 + 1) * DFF + c0 + k]; u0[k] = SBU[((size_t)pm * 2 + 0) * DFF + c0 + k]; u1[k] = SBU[((size_t)pm * 2 + 1) * DFF + c0 + k]; }
                        float ha[8], hb[8];
#pragma unroll
                        for (int k = 0; k < 8; ++k) { ha[k] = silu(w0[k] * p2[k] + w1[k] * p1[k] + w2[k] * g0[k]) * u0[k]; hb[k] = silu(w0[k] * p1[k] + w1[k] * g0[k] + w2[k] * g1[k]) * u1[k]; }
                        u32x4 w; w.x = pk2(ha[0], ha[1]); w.y = pk2(ha[2], ha[3]); w.z = pk2(ha[4], ha[5]); w.w = pk2(ha[6], ha[7]);
                        *(u32x4*)(GU + (size_t)(pm * 256) * DFF + c0) = w;
                        w.x = pk2(hb[0], hb[1]); w.y = pk2(hb[2], hb[3]); w.z = pk2(hb[4], hb[5]); w.w = pk2(hb[6], hb[7]);
                        *(u32x4*)(GU + (size_t)(pm * 256 + 1) * DFF + c0) = w;
                        if ((pm & 15) == 15) { float* o = out + O_CFP + ((size_t)(l * 8 + b) * 2) * DFF + c0;
#pragma unroll
                            for (int k = 0; k < 8; ++k) { o[k] = SBL[((size_t)pm * 2 + 0) * DFF + c0 + k]; o[DFF + k] = SBL[((size_t)pm * 2 + 1) * DFF + c0 + k]; } }
                    }
                    for (int it = gt; it < (MS / 16) * (DFF / 8); it += NGT) {
                        const int sbk = it / (DFF / 8), c0 = (it % (DFF / 8)) * 8, b = sbk >> 1, t0 = (sbk & 1) * 16, rowl = sbk * 16;
                        float w0[8], w1[8], w2[8], gm2[8], gm1[8];
#pragma unroll
                        for (int k = 0; k < 8; ++k) { w0[k] = cfw[c0 + k]; w1[k] = cfw[DFF + c0 + k]; w2[k] = cfw[2 * DFF + c0 + k]; }
                        if (t0 == 0) { const float* st = INP(I_SCF) + ((size_t)(l * BS + b) * 2) * DFF + c0;
#pragma unroll
                            for (int k = 0; k < 8; ++k) { gm2[k] = st[k]; gm1[k] = st[DFF + k]; } }
                        else {
                            const u32x4 ga = *(const u32x4*)(GUS + (size_t)(rowl - 2) * (2 * DFF) + c0), gb = *(const u32x4*)(GUS + (size_t)(rowl - 1) * (2 * DFF) + c0);
                            const float a_[8] = {bflo(ga.x), bfhi(ga.x), bflo(ga.y), bfhi(ga.y), bflo(ga.z), bfhi(ga.z), bflo(ga.w), bfhi(ga.w)};
                            const float b_[8] = {bflo(gb.x), bfhi(gb.x), bflo(gb.y), bfhi(gb.y), bflo(gb.z), bfhi(gb.z), bflo(gb.w), bfhi(gb.w)};
#pragma unroll
                            for (int k = 0; k < 8; ++k) { gm2[k] = a_[k]; gm1[k] = b_[k]; }
                        }
                        for (int i = 0; i < 16; ++i) {
                            const bf16_t* gr = GUS + (size_t)(rowl + i) * (2 * DFF) + c0;
                            const u32x4 gq = *(const u32x4*)gr, uq = *(const u32x4*)(gr + DFF);
                            const float gv[8] = {bflo(gq.x), bfhi(gq.x), bflo(gq.y), bfhi(gq.y), bflo(gq.z), bfhi(gq.z), bflo(gq.w), bfhi(gq.w)};
                            const float uv[8] = {bflo(uq.x), bfhi(uq.x), bflo(uq.y), bfhi(uq.y), bflo(uq.z), bfhi(uq.z), bflo(uq.w), bfhi(uq.w)};
                            float hv[8];
#pragma unroll
                            for (int k = 0; k < 8; ++k) { const float cv = w0[k] * gm2[k] + w1[k] * gm1[k] + w2[k] * gv[k]; hv[k] = silu(cv) * uv[k]; gm2[k] = gm1[k]; gm1[k] = gv[k]; }
                            u32x4 w; w.x = pk2(hv[0], hv[1]); w.y = pk2(hv[2], hv[3]); w.z = pk2(hv[4], hv[5]); w.w = pk2(hv[6], hv[7]);
                            *(u32x4*)(GU + (size_t)(MP + rowl + i) * DFF + c0) = w;
                        }
                        if (t0 + 16 == TS) { float* o = out + O_CFS + ((size_t)(l * 8 + b) * 2) * DFF + c0;
#pragma unroll
                            for (int k = 0; k < 8; ++k) { o[k] = gm2[k]; o[DFF + k] = gm1[k]; } }
                    }
                }
            }
            GRID_SYNC();
          }
        }
    }
    {
        LANE_STATE();
        const float* gain = INP(I_GFIN);
        f32x4 gv[4];
#pragma unroll
        for (int j = 0; j < 4; ++j) gv[j] = ((const f32x4*)gain)[lane + 64 * j];
        for (int m = gw; m < MT; m += NGW) {
            f32x4* yr = (f32x4*)(out + (size_t)m * D) + lane; const u32x2* xr = (const u32x2*)(XN + (size_t)m * D) + lane;
            const float rstd = ss_rstd(*(const f32x4*)(SSQ(6) + (size_t)m * 4));
#pragma unroll
            for (int j = 0; j < 4; ++j) { const u32x2 p = xr[64 * j]; yr[64 * j] = (f32x4){bflo(p.x), bfhi(p.x), bflo(p.y), bfhi(p.y)} * rstd * gv[j]; }
        }
    }
}

extern "C" void kernel_launch(void* const* d_in, const int* in_sizes, int n_in, void* d_out, int out_size, void* d_ws, size_t ws_size, hipStream_t stream) {
    static int grid = 0;
    if (grid == 0) {
        if (n_in != N_IN || (size_t)out_size != O_END || ws_size < WS_END) { fprintf(stderr, "kernel_launch: unexpected sizes n_in %d out %d ws %zu (need %zu)\n", n_in, out_size, ws_size, (size_t)WS_END); grid = -1; return; }
        int dev = 0, cus = 0, per_cu = 0;
        (void)hipGetDevice(&dev); (void)hipDeviceGetAttribute(&cus, hipDeviceAttributeMultiprocessorCount, dev);
        if (hipFuncSetAttribute((const void*)trunk_fwd, hipFuncAttributeMaxDynamicSharedMemorySize, LDS_BYTES) != hipSuccess) { fprintf(stderr, "kernel_launch: hipFuncSetAttribute failed\n"); grid = -1; return; }
        if (hipOccupancyMaxActiveBlocksPerMultiprocessor(&per_cu, (const void*)trunk_fwd, NTHREADS, LDS_BYTES) != hipSuccess || per_cu < 1) { fprintf(stderr, "kernel_launch: occupancy query gave %d\n", per_cu); per_cu = 1; }
        (void)hipGetLastError();
        grid = cus * 1;
        if (grid != 256) fprintf(stderr, "kernel_launch: note: %d CUs\n", grid);
    }
    if (grid < 0) return;
    Args a{};
    for (int i = 0; i < N_IN; ++i) a.in[i] = (const float*)d_in[i];
    a.out = (float*)d_out; a.ws = (unsigned char*)d_ws;
    void* kargs[] = {&a};
    hipError_t e = hipLaunchCooperativeKernel((const void*)trunk_fwd, dim3(grid), dim3(NTHREADS), kargs, LDS_BYTES, stream);
    if (e != hipSuccess) fprintf(stderr, "kernel_launch: cooperative launch failed: %s (grid %d)\n", hipGetErrorString(e), grid);
}
```

```cpp
#include <hip/hip_runtime.h>
#include <hip/hip_cooperative_groups.h>
#include <cstdio>
#include <cstdint>
namespace cg = cooperative_groups;
#ifndef PROBE
#define PROBE 0
#endif

#define LAS __attribute__((address_space(3)))
typedef unsigned short bf16_t;
typedef short bf16x8 __attribute__((ext_vector_type(8)));
typedef float f32x4 __attribute__((ext_vector_type(4)));
typedef float f32x2 __attribute__((ext_vector_type(2)));
typedef unsigned u32x4 __attribute__((ext_vector_type(4)));
typedef unsigned u32x2 __attribute__((ext_vector_type(2)));

constexpr int D = 1024, BP = 8, SEQ = 4096, BS = 8, TS = 32, DEPTH = 2;
constexpr int MP = BP * SEQ, MS = BS * TS, MT = MP + MS;
constexpr int INC = 2304, DFF = 2816, NMEM = 256, AW = 512, BW = 256, CW = 256;
constexpr int Z_XA = 0, Z_GA = 512, Z_XB = 1024, Z_GB = 1280, Z_GC = 1536, Z_UC = 1792, Z_VC = 2048;
constexpr float EPS = 1e-6f;
constexpr int NWAVES = 8, NTHREADS = 512;

constexpr size_t O_YP = 0, O_YS = O_YP + (size_t)MP * D, O_CAP = O_YS + (size_t)MS * D, O_HAP = O_CAP + DEPTH * BP * 3 * AW,
                 O_CBP = O_HAP + DEPTH * BP * AW, O_CFP = O_CBP + DEPTH * BP * 2 * BW, O_MKP = O_CFP + DEPTH * BP * 2 * DFF,
                 O_MVP = O_MKP + (size_t)DEPTH * BP * NMEM * D, O_CAS = O_MVP + (size_t)DEPTH * BP * NMEM * D, O_HAS = O_CAS + DEPTH * BS * 3 * AW,
                 O_CBS = O_HAS + DEPTH * BS * AW, O_CFS = O_CBS + DEPTH * BS * 2 * BW, O_VCS = O_CFS + DEPTH * BS * 2 * DFF,
                 O_END = O_VCS + DEPTH * BS * TS * CW;

constexpr size_t MiB = 1u << 20;
constexpr size_t WS_WIN = 0, WS_WOUT = 5 * MiB, WS_WQ = 7 * MiB, WS_WK = 9 * MiB, WS_WV = 11 * MiB, WS_WO = 13 * MiB, WS_WUP = 15 * MiB, WS_WDN = 26 * MiB;
constexpr size_t WS_MEMB = 32 * MiB, WS_KBP = 36 * MiB, WS_VTP = 40 * MiB, WS_KBS = 44 * MiB, WS_VTS = 48 * MiB, WS_WST = 52 * MiB, WS_GT = WS_WST + 131072, WS_AGG = 53 * MiB, WS_SS = 54 * MiB + 256 * 1024, WS_BAR = 55 * MiB + 512 * 1024;
constexpr size_t WS_XN = 56 * MiB, WS_BIG = 121 * MiB;
constexpr size_t B_Z = WS_BIG, B_HLOC = WS_BIG + 146 * MiB, B_PCUM = WS_BIG + 211 * MiB, B_Y = WS_BIG + 276 * MiB;
constexpr size_t B_Q = WS_BIG, B_P = WS_BIG + 65 * MiB, B_O = WS_BIG + 130 * MiB, B_PS = WS_BIG + 195 * MiB;
constexpr size_t B_GU = WS_BIG;
constexpr size_t B_GUS = WS_BIG + 200 * MiB;
constexpr size_t B_SBG = WS_BIG + 204 * MiB, B_SBU = WS_BIG + 207 * MiB, B_SBL = WS_BIG + 210 * MiB;
constexpr size_t WS_END = WS_BIG + (size_t)MT * 2 * DFF * 2;
constexpr size_t WS_SSP = 476 * MiB;
static_assert(WS_END <= WS_SSP && WS_SSP + (size_t)7 * MT * 64 <= 512 * MiB, "workspace");
static_assert(WS_XN + (size_t)MT * D * 2 <= WS_BIG, "xn");

constexpr int LDS_RING = 131072, LDS_EX = LDS_RING, LDS_MISC = LDS_EX + 8192, LDS_BYTES = 147456;

enum { I_XP = 0, I_XS, I_MEM, I_CK, I_CV, I_SCA, I_SHA, I_SCB, I_SCF, I_GMIX, I_WIN, I_CAW, I_CAB, I_WRG, I_BRG, I_WIG, I_BIG, I_LAM, I_CBW, I_GV, I_WS, I_BSS,
       I_WOUT, I_GX, I_WQ, I_WK, I_WV, I_WO, I_GFFN, I_WUP, I_CFW, I_WDN, I_GFIN, N_IN };

struct Args { const float* in[N_IN]; float* out; unsigned char* ws; };

__device__ __forceinline__ unsigned f2bf(float f) { unsigned u = __builtin_bit_cast(unsigned, f); return (u + 0x7fffu + ((u >> 16) & 1u)) >> 16; }
__device__ __forceinline__ unsigned pk2(float lo, float hi) { return f2bf(lo) | (f2bf(hi) << 16); }
__device__ __forceinline__ float bf2f(unsigned v) { return __builtin_bit_cast(float, v << 16); }
__device__ __forceinline__ float bflo(unsigned w) { return __builtin_bit_cast(float, w << 16); }
__device__ __forceinline__ float bfhi(unsigned w) { return __builtin_bit_cast(float, w & 0xffff0000u); }
__device__ __forceinline__ unsigned cvt_pk_bf16(float lo, float hi) { unsigned r; asm volatile("v_cvt_pk_bf16_f32 %0, %1, %2" : "=v"(r) : "v"(lo), "v"(hi)); return r; }
__device__ __forceinline__ float fexp(float x) { return __builtin_amdgcn_exp2f(x * 1.4426950408889634f); }
__device__ __forceinline__ float sigm(float x) { return __builtin_amdgcn_rcpf(1.0f + fexp(-x)); }
__device__ __forceinline__ float gelu_t(float x) { const float u = 0.7978845608028654f * (x + 0.044715f * x * x * x); return x * sigm(2.0f * u); }
__device__ __forceinline__ float silu(float x) { return x * sigm(x); }
__device__ __forceinline__ float shx(float v, int m, int lane) { return __builtin_bit_cast(float, __builtin_amdgcn_ds_bpermute((lane ^ m) << 2, __builtin_bit_cast(int, v))); }
__device__ __forceinline__ float wave_sum(float v, int lane) {
#pragma unroll
    for (int o = 1; o < 64; o <<= 1) v += shx(v, o, lane);
    return v;
}
#define LDS_WAIT() asm volatile("s_waitcnt lgkmcnt(0)" ::: "memory")
__device__ __forceinline__ float ss_rstd(f32x4 p) { return 1.0f / sqrtf(((p[0] + p[1]) + (p[2] + p[3])) * (1.f / 1024.f) + 1e-6f); }
__device__ __forceinline__ int opaque_tid(int wave_s) { int l; asm volatile("v_mbcnt_lo_u32_b32 %0, -1, 0\n\tv_mbcnt_hi_u32_b32 %0, -1, %0" : "=v"(l)); return wave_s * 64 + l; }

namespace pg8 {
constexpr int BM = 256, BK = 64, HALF = 128, HTB = HALF * BK * 2, NXCD = 8, WGM = 8;
__device__ __forceinline__ int lds_byte(int r, int c) { const int st = (r >> 4) * 2 + (c >> 5), rr = r & 15, cc = c & 31, ob = rr * 64 + cc * 2; return st * 1024 + (ob ^ (((ob >> 9) & 1) << 5)); }
__device__ __forceinline__ void stage_rc(int b, int& R, int& C) { const int st = b / 1024, sb = b % 1024, swz = sb ^ (((sb >> 9) & 1) << 5); R = (st >> 1) * 16 + swz / 64; C = (st & 1) * 32 + (swz % 64) / 2; }
__device__ __forceinline__ int perm32(int rho) { const int n = rho >> 4, i = rho & 15; return 8 * (i >> 2) + 4 * n + (i & 3); }

struct Unit { int pm, pn; };
struct Gemm { const bf16_t* A; const bf16_t* Bt; int lda, ldb, K; };

struct GSched {
    int nM, nN, nwg, G, c, mode;
    size_t aPm, aPn, bPn, bPm; int bShift;
    __device__ __forceinline__ void init(int nM_, int nN_, int G_, int c_) { nM = nM_; nN = nN_; nwg = nM * nN; G = G_; c = c_; mode = 0; aPm = 0; aPn = 0; bPn = 0; bPm = 0; bShift = 0; }
    __device__ __forceinline__ bool next(int i, Unit& u) const {
        const long L = (long)i * G + c; if (L >= nwg) return false;
        int wgid = (int)L; { const int q = nwg / NXCD, r = nwg % NXCD, xcd = wgid % NXCD, off = wgid / NXCD; wgid = (xcd < r ? xcd * (q + 1) : r * (q + 1) + (xcd - r) * q) + off; }
        const int nig = WGM * nN, gid = wgid / nig, fm = gid * WGM, gsz = (nM - fm) < WGM ? (nM - fm) : WGM;
        u.pm = fm + ((wgid % nig) % gsz); u.pn = (wgid % nig) / gsz; return true;
    }
    __device__ __forceinline__ size_t offA(const Unit& u) const { return mode == 1 ? (size_t)(u.pn & 3) * 512 : (mode == 2 ? (size_t)(u.pn & 3) * 4096 + (size_t)(u.pn >> 2) * 512 : (size_t)u.pm * aPm + (size_t)u.pn * aPn); }
    __device__ __forceinline__ size_t offB(const Unit& u) const { return mode == 1 ? (size_t)(u.pn >> 2) * (256 * 1024 * 2) + (size_t)(u.pn & 3) * 512 : (mode == 2 ? (size_t)(u.pn & 3) * (256 * 2048 * 2) + (size_t)(u.pn >> 2) * 512 : (size_t)u.pn * bPn + (size_t)(u.pm >> bShift) * bPm); }
};

struct EpiBf16 {
    static constexpr bool PERM = true;
    bf16_t* O; int ldc; float scale; const float* ss; int smp;
    __device__ __forceinline__ void operator()(f32x4 (&acc)[2][2][4][2], const Unit& u, int wr, int wc, int fr, int fq, LAS unsigned char*) const {
        asm volatile("" : "+v"(fr), "+v"(fq)); asm volatile("" : "+s"(wr), "+s"(wc));
        const int row0 = u.pm * BM + wr * 64 + fr, col0 = (smp ? (u.pn & 3) : u.pn) * BM + wc * 32 + 8 * fq;
        f32x4 rs[2][4];
#pragma unroll
        for (int ai = 0; ai < 2; ++ai)
#pragma unroll
            for (int m = 0; m < 4; ++m) rs[ai][m] = ss ? *(const f32x4*)(ss + (size_t)(row0 + ai * HALF + m * 16) * 4) : (f32x4){0.f, 0.f, 0.f, 0.f};
#pragma unroll
        for (int ai = 0; ai < 2; ++ai)
#pragma unroll
            for (int m = 0; m < 4; ++m) { bf16_t* rowp = O + (size_t)(row0 + ai * HALF + m * 16) * ldc + col0;
                float sc = scale; if (ss) sc *= ss_rstd(rs[ai][m]);
                if (smp && ((ai * HALF + wr * 64 + m * 16 + fr) >> 5) != (u.pn >> 2)) continue;
#pragma unroll
                for (int bj = 0; bj < 2; ++bj) { const f32x4 v0 = acc[ai][bj][m][0] * sc, v1 = acc[ai][bj][m][1] * sc;
                    u32x4 w; w.x = cvt_pk_bf16(v0[0], v0[1]); w.y = cvt_pk_bf16(v0[2], v0[3]); w.z = cvt_pk_bf16(v1[0], v1[1]); w.w = cvt_pk_bf16(v1[2], v1[3]);
                    *(u32x4*)(rowp + bj * HALF) = w; } }
    }
};
struct EpiResid {
    static constexpr bool PERM = true;
    bf16_t* xb; float* ss;
    __device__ __forceinline__ void operator()(f32x4 (&acc)[2][2][4][2], const Unit& u, int wr, int wc, int fr, int fq, LAS unsigned char* lds) const {
        asm volatile("" : "+v"(fr), "+v"(fq)); asm volatile("" : "+s"(wr), "+s"(wc));
        const int col0 = u.pn * BM + wc * 32 + 8 * fq, lane = fq * 16 + fr;
        LAS float* PS = (LAS float*)(lds + LDS_EX);
        bf16_t* ob = xb + (size_t)u.pm * BM * D;
#pragma unroll
        for (int ai = 0; ai < 2; ++ai) {
            u32x4 pre[4][2];
#pragma unroll
            for (int m = 0; m < 4; ++m)
#pragma unroll
                for (int bj = 0; bj < 2; ++bj) pre[m][bj] = *(const u32x4*)(ob + (size_t)(ai * HALF + wr * 64 + m * 16 + fr) * D + col0 + bj * HALF);
            asm volatile("" ::: "memory");
#pragma unroll
            for (int m = 0; m < 4; ++m) { const int rl = ai * HALF + wr * 64 + m * 16 + fr; const size_t off = (size_t)rl * D + col0; float q = 0.f;
#pragma unroll
                for (int bj = 0; bj < 2; ++bj) { const u32x4 p = pre[m][bj]; const f32x4 a0 = acc[ai][bj][m][0], a1 = acc[ai][bj][m][1];
                    const float v0 = bflo(p.x) + a0[0], v1 = bfhi(p.x) + a0[1], v2 = bflo(p.y) + a0[2], v3 = bfhi(p.y) + a0[3], v4 = bflo(p.z) + a1[0], v5 = bfhi(p.z) + a1[1], v6 = bflo(p.w) + a1[2], v7 = bfhi(p.w) + a1[3];
                    u32x4 w; w.x = cvt_pk_bf16(v0, v1); w.y = cvt_pk_bf16(v2, v3); w.z = cvt_pk_bf16(v4, v5); w.w = cvt_pk_bf16(v6, v7); *(u32x4*)(ob + off + bj * HALF) = w;
                    q += ((v0 * v0 + v1 * v1) + (v2 * v2 + v3 * v3)) + ((v4 * v4 + v5 * v5) + (v6 * v6 + v7 * v7)); }
                q += shx(q, 16, lane); q += shx(q, 32, lane);
                if (fq == 0) PS[rl * 4 + wc] = q; }
            asm volatile("" ::: "memory");
        }
        asm volatile("s_waitcnt lgkmcnt(0)" ::: "memory"); __builtin_amdgcn_s_barrier(); asm volatile("" ::: "memory");
        { const int t = (wr * 4 + wc) * 64 + lane; if (t < 256) { const f32x4 p = *(const LAS f32x4*)(PS + t * 4); ss[(size_t)(u.pm * BM + t) * 4 + u.pn] = (p[0] + p[1]) + (p[2] + p[3]); } }
    }
};
struct EpiKV {
    static constexpr bool PERM = false;
    float* outK; float* outV; bf16_t* KB; bf16_t* VT;
    __device__ __forceinline__ void operator()(f32x4 (&acc)[2][2][4][2], const Unit& u, int wr, int wc, int fr, int fq, LAS unsigned char*) const {
        asm volatile("" : "+v"(fr), "+v"(fq)); asm volatile("" : "+s"(wr), "+s"(wc));
        const int kind = u.pm >> 4, pm = u.pm & 15;
        const int col0 = u.pn * BM + wc * 32 + 4 * fq;
        float* of = kind == 0 ? outK : outV; bf16_t* ob = kind == 0 ? KB : VT; const int ldb_ = kind == 2 ? 2048 : 1024;
#pragma unroll
        for (int ai = 0; ai < 2; ++ai)
#pragma unroll
            for (int m = 0; m < 4; ++m) { const int row = pm * BM + ai * HALF + wr * 64 + m * 16 + fr;
#pragma unroll
                for (int bj = 0; bj < 2; ++bj)
#pragma unroll
                    for (int n = 0; n < 2; ++n) { const f32x4 v = acc[ai][bj][m][n]; const int col = col0 + bj * HALF + n * 16;
                        if (kind != 2) *(f32x4*)(of + (size_t)row * 1024 + col) = v;
                        if (kind != 1) { u32x2 w; w.x = cvt_pk_bf16(v[0], v[1]); w.y = cvt_pk_bf16(v[2], v[3]); *(u32x2*)(ob + (size_t)row * ldb_ + col) = w; } } }
    }
};
struct EpiSoftmax {
    static constexpr bool PERM = true;
    bf16_t* O; int ldc; int smp;
    __device__ __forceinline__ void operator()(f32x4 (&acc)[2][2][4][2], const Unit& u, int wr, int wc, int fr, int fq, LAS unsigned char* lds) const {
        asm volatile("" : "+v"(fr), "+v"(fq)); asm volatile("" : "+s"(wr), "+s"(wc));
        LAS f32x2* EX = (LAS f32x2*)(lds + LDS_EX);
        const int lane = fq * 16 + fr;
        const float L2E = 1.4426950408889634f;
#pragma unroll
        for (int ai = 0; ai < 2; ++ai)
#pragma unroll
            for (int m = 0; m < 4; ++m) {
                float mx = -3.0e38f;
#pragma unroll
                for (int bj = 0; bj < 2; ++bj)
#pragma unroll
                    for (int n = 0; n < 2; ++n) { const f32x4 x = acc[ai][bj][m][n]; mx = fmaxf(mx, fmaxf(fmaxf(x[0], x[1]), fmaxf(x[2], x[3]))); }
                mx = fmaxf(mx, shx(mx, 16, lane)); mx = fmaxf(mx, shx(mx, 32, lane));
                float s = 0.f;
#pragma unroll
                for (int bj = 0; bj < 2; ++bj)
#pragma unroll
                    for (int n = 0; n < 2; ++n) { f32x4 x = acc[ai][bj][m][n];
#pragma unroll
                        for (int j = 0; j < 4; ++j) { x[j] = __builtin_amdgcn_exp2f((x[j] - mx) * L2E); s += x[j]; }
                        acc[ai][bj][m][n] = x; }
                s += shx(s, 16, lane); s += shx(s, 32, lane);
                if (fq == 0) EX[(ai * HALF + wr * 64 + m * 16 + fr) * 4 + wc] = (f32x2){mx, s};
            }
        asm volatile("s_waitcnt lgkmcnt(0)" ::: "memory"); __builtin_amdgcn_s_barrier(); asm volatile("" ::: "memory");
        int colb = u.pn * BM, j_ = 0;
        if (smp) { colb = (u.pn & 3) * 2048 + (u.pn >> 2) * 256; j_ = u.pn >> 2; }
        const int col0 = colb + wc * 32 + 8 * fq;
#pragma unroll
        for (int ai = 0; ai < 2; ++ai)
#pragma unroll
            for (int m = 0; m < 4; ++m) {
                const int rl = ai * HALF + wr * 64 + m * 16 + fr;
                const f32x2 e0 = EX[rl * 4 + 0], e1 = EX[rl * 4 + 1], e2 = EX[rl * 4 + 2], e3 = EX[rl * 4 + 3];
                const float M = fmaxf(fmaxf(e0.x, e1.x), fmaxf(e2.x, e3.x));
                const float tot = e0.y * __builtin_amdgcn_exp2f((e0.x - M) * L2E) + e1.y * __builtin_amdgcn_exp2f((e1.x - M) * L2E) + e2.y * __builtin_amdgcn_exp2f((e2.x - M) * L2E) + e3.y * __builtin_amdgcn_exp2f((e3.x - M) * L2E);
                const float own = wc == 0 ? e0.x : (wc == 1 ? e1.x : (wc == 2 ? e2.x : e3.x));
                float f = __builtin_amdgcn_exp2f((own - M) * L2E) / tot;
                if (smp && (rl >> 5) != j_) f = 0.f;
                bf16_t* rowp = O + (size_t)(u.pm * BM + rl) * ldc + col0;
#pragma unroll
                for (int bj = 0; bj < 2; ++bj) { const f32x4 v0 = acc[ai][bj][m][0] * f, v1 = acc[ai][bj][m][1] * f;
                    u32x4 w; w.x = cvt_pk_bf16(v0[0], v0[1]); w.y = cvt_pk_bf16(v0[2], v0[3]); w.z = cvt_pk_bf16(v1[0], v1[1]); w.w = cvt_pk_bf16(v1[2], v1[3]);
                    *(u32x4*)(rowp + bj * HALF) = w; } }
    }
};


__device__ __forceinline__ float dpp_ror1(float v) { return __builtin_bit_cast(float, __builtin_amdgcn_update_dpp(0, __builtin_bit_cast(int, v), 0x121, 0xf, 0xf, false)); }
__device__ __forceinline__ float dpp_ror2(float v) { return __builtin_bit_cast(float, __builtin_amdgcn_update_dpp(0, __builtin_bit_cast(int, v), 0x122, 0xf, 0xf, false)); }
struct EpiAct {
    static constexpr bool PERM = true;
    bf16_t* H; bf16_t* GUs; float* sbg; float* sbu; float* sbl; const float* cfw; const float* ss;
    __device__ __forceinline__ void operator()(f32x4 (&acc)[2][2][4][2], const Unit& u, int wr, int wc, int fr, int fq, LAS unsigned char* lds) const {
        asm volatile("" : "+s"(wr), "+s"(wc));
        int lane; asm volatile("v_mbcnt_lo_u32_b32 %0, -1, 0\n\tv_mbcnt_hi_u32_b32 %0, -1, %0" : "=v"(lane));
        fr = lane & 15; fq = lane >> 4;
        const int fl = wc * 32 + 8 * fq, f0 = u.pn * 128 + fl; int rowt = wr * 64 + fr;
        {
            float rst[2][4];
            f32x4 rsl[2][4];
#pragma unroll
            for (int ai = 0; ai < 2; ++ai)
#pragma unroll
                for (int m = 0; m < 4; ++m) rsl[ai][m] = *(const f32x4*)(ss + (size_t)(u.pm * BM + ai * HALF + rowt + m * 16) * 4);
#pragma unroll
            for (int ai = 0; ai < 2; ++ai)
#pragma unroll
                for (int m = 0; m < 4; ++m) { rst[ai][m] = ss_rstd(rsl[ai][m]); }
#pragma unroll
            for (int ai = 0; ai < 2; ++ai)
#pragma unroll
                for (int m = 0; m < 4; ++m) { acc[ai][0][m][0] = acc[ai][0][m][0] * rst[ai][m]; acc[ai][0][m][1] = acc[ai][0][m][1] * rst[ai][m]; acc[ai][1][m][0] = acc[ai][1][m][0] * rst[ai][m]; acc[ai][1][m][1] = acc[ai][1][m][1] * rst[ai][m]; }
        }
        if (u.pm == 128) {
#pragma unroll
            for (int ai = 0; ai < 2; ++ai)
#pragma unroll
                for (int m = 0; m < 4; ++m) { bf16_t* rp = GUs + (size_t)(ai * HALF + rowt + m * 16) * (2 * DFF) + f0; const float sc = 1.f;
#pragma unroll
                    for (int bj = 0; bj < 2; ++bj) { const f32x4 v0 = acc[ai][bj][m][0] * sc, v1 = acc[ai][bj][m][1] * sc;
                        u32x4 w; w.x = cvt_pk_bf16(v0[0], v0[1]); w.y = cvt_pk_bf16(v0[2], v0[3]); w.z = cvt_pk_bf16(v1[0], v1[1]); w.w = cvt_pk_bf16(v1[2], v1[3]);
                        *(u32x4*)(rp + bj * DFF) = w; } }
            return;
        }
        asm volatile("" : "+v"(rowt));
        LAS float* BND = (LAS float*)(lds + LDS_EX);
        if (fr >= 14) {
#pragma unroll
            for (int ai = 0; ai < 2; ++ai)
#pragma unroll
                for (int n = 0; n < 2; ++n) *(LAS f32x4*)(BND + ((ai * 2 + wr) * 2 + (fr - 14)) * 128 + fl + 4 * n) = acc[ai][0][3][n];
            if (wr == 1) {
#pragma unroll
                for (int n = 0; n < 2; ++n) *(f32x4*)(sbl + ((size_t)u.pm * 2 + (fr - 14)) * DFF + f0 + 4 * n) = acc[1][0][3][n];
            }
        }
        asm volatile("s_waitcnt lgkmcnt(0)" ::: "memory"); __builtin_amdgcn_s_barrier(); asm volatile("" ::: "memory");
#pragma unroll
        for (int ai = 0; ai < 2; ++ai) {
            const int pg = wr == 1 ? ai * 2 : 1;
            u32x2 hp[2][4];
#pragma unroll
            for (int n = 0; n < 2; ++n) {
                const f32x4 w0 = *(const f32x4*)(cfw + f0 + 4 * n), w1 = *(const f32x4*)(cfw + DFF + f0 + 4 * n), w2 = *(const f32x4*)(cfw + 2 * DFF + f0 + 4 * n);
                const f32x4 h2 = *(const LAS f32x4*)(BND + (pg * 2 + 0) * 128 + fl + 4 * n), h1 = *(const LAS f32x4*)(BND + (pg * 2 + 1) * 128 + fl + 4 * n);
#pragma unroll
                for (int jp = 0; jp < 2; ++jp) {
                    float hv[4][2];
#pragma unroll
                    for (int jj = 0; jj < 2; ++jj) { const int j = jp * 2 + jj;
                        float r1p = h1[j], r2p = fr == 0 ? h2[j] : h1[j];
#pragma unroll
                        for (int m = 0; m < 4; ++m) { const float g = acc[ai][0][m][n][j];
                            const float r1 = dpp_ror1(g), r2 = dpp_ror2(g);
                            const float gm1 = fr >= 1 ? r1 : r1p, gm2 = fr >= 2 ? r2 : r2p;
                            r1p = r1; r2p = r2;
                            const float cv = w0[j] * gm2 + w1[j] * gm1 + w2[j] * g;
                            hv[m][jj] = silu(cv) * acc[ai][1][m][n][j]; } }
#pragma unroll
                    for (int m = 0; m < 4; ++m) { const unsigned pk = cvt_pk_bf16(hv[m][0], hv[m][1]); if (jp == 0) hp[n][m].x = pk; else hp[n][m].y = pk; }
                }
            }
#pragma unroll
            for (int m = 0; m < 4; ++m) {
                const int rl = ai * HALF + rowt + m * 16;
                if (ai == 0 && m == 0 && wr == 0 && fr < 2) {
#pragma unroll
                    for (int n = 0; n < 2; ++n) { *(f32x4*)(sbg + ((size_t)u.pm * 2 + fr) * DFF + f0 + 4 * n) = acc[0][0][0][n]; *(f32x4*)(sbu + ((size_t)u.pm * 2 + fr) * DFF + f0 + 4 * n) = acc[0][1][0][n]; }
                } else {
                    u32x4 w; w.x = hp[0][m].x; w.y = hp[0][m].y; w.z = hp[1][m].x; w.w = hp[1][m].y;
                    *(u32x4*)(H + (size_t)(u.pm * BM + rl) * DFF + f0) = w;
                }
            }
        }
    }
};

template <class Epi, class Sched, bool ALIGN_EPI>
__device__ __forceinline__ void gemm_phase(LAS unsigned char* lds, const Gemm g, const Sched& S, const Epi& E, const int wave_s) {
    const int tid = opaque_tid(wave_s), wid = __builtin_amdgcn_readfirstlane(tid >> 6), lane = tid & 63, wr = wid >> 2, wc = wid & 3, fr = lane & 15, fq = lane >> 4;
    const int nt = g.K / BK;
    unsigned voffA[2], voffB[2];
#pragma unroll
    for (int i = 0; i < 2; ++i) { int R, C; stage_rc(tid * 16 + i * 8192, R, C); const int Rb = Epi::PERM ? ((R & ~31) + perm32(R & 31)) : R;
        voffA[i] = (unsigned)(R * g.lda + C) * 2u; voffB[i] = (unsigned)(Rb * g.ldb + C) * 2u; }
    const size_t kstep = (size_t)(BK * 2);
    const size_t hstepA = (size_t)HALF * g.lda * 2, hstepB = (size_t)HALF * g.ldb * 2;
    const unsigned ldsw = (unsigned)wid * 1024u;
    const int aoff = lds_byte(wr * 64 + fr, fq * 8), boff = lds_byte(wc * 32 + fr, fq * 8);
#define PG8_SA(b, h) (((b) * 2 + (h)) * HTB)
#define PG8_SB(b, h) ((4 + (b) * 2 + (h)) * HTB)
#define PG8_STAGE(bufoff, gbase, voff) do { _Pragma("unroll") for (int _i = 0; _i < 2; ++_i) \
        __builtin_amdgcn_global_load_lds((const unsigned*)((const char*)(gbase) + (voff)[_i]), (LAS unsigned*)(lds + (bufoff) + ldsw + _i * 8192), 16, 0, 0); } while (0)
#define PG8_LDA(dst, b, h) do { _Pragma("unroll") for (int m = 0; m < 4; ++m) _Pragma("unroll") for (int k = 0; k < 2; ++k) dst[m][k] = *(const LAS bf16x8*)(lds + PG8_SA(b, h) + aoff + m * 2048 + k * 1024); } while (0)
#define PG8_LDB(dst, b, h) do { _Pragma("unroll") for (int n = 0; n < 2; ++n) _Pragma("unroll") for (int k = 0; k < 2; ++k) dst[n][k] = *(const LAS bf16x8*)(lds + PG8_SB(b, h) + boff + n * 2048 + k * 1024); } while (0)
#define PG8_MMA(ai, bj, At, Bt) do { __builtin_amdgcn_s_setprio(1); _Pragma("unroll") for (int m = 0; m < 4; ++m) _Pragma("unroll") for (int n = 0; n < 2; ++n) _Pragma("unroll") for (int k = 0; k < 2; ++k) \
        acc[ai][bj][m][n] = __builtin_amdgcn_mfma_f32_16x16x32_bf16(Bt[n][k], At[m][k], acc[ai][bj][m][n], 0, 0, 0); __builtin_amdgcn_s_setprio(0); } while (0)
#define PG8_WAIT_V(n) asm volatile("s_waitcnt vmcnt(" #n ")" ::: "memory")
#define PG8_WAIT_L(n) asm volatile("s_waitcnt lgkmcnt(" #n ")" ::: "memory")
#define PG8_BAR __builtin_amdgcn_s_barrier()
#define PG8_SCHED __builtin_amdgcn_sched_barrier(0)
    Unit cur, nxt; int ui = 0;
    if (!S.next(0, cur)) return;
    f32x4 acc[2][2][4][2];
#pragma unroll
    for (int a = 0; a < 2; ++a)
#pragma unroll
        for (int b = 0; b < 2; ++b)
#pragma unroll
            for (int m = 0; m < 4; ++m)
#pragma unroll
                for (int n = 0; n < 2; ++n) acc[a][b][m][n] = (f32x4){0.f, 0.f, 0.f, 0.f};
    bf16x8 At[4][2], B0[2][2], B1[2][2];
    const char* cA = (const char*)g.A + S.offA(cur); const char* cB = (const char*)g.Bt + S.offB(cur);
    PG8_STAGE(PG8_SB(0, 0), cB, voffB); PG8_STAGE(PG8_SB(0, 1), cB + hstepB, voffB); PG8_STAGE(PG8_SA(0, 0), cA, voffA); PG8_STAGE(PG8_SA(0, 1), cA + hstepA, voffA);
    if (wr == 1) PG8_BAR;
    PG8_WAIT_V(2); PG8_BAR;
    PG8_STAGE(PG8_SB(1, 0), cB + kstep, voffB); PG8_STAGE(PG8_SA(1, 0), cA + kstep, voffA); PG8_STAGE(PG8_SB(1, 1), cB + hstepB + kstep, voffB);
    PG8_WAIT_V(6); PG8_BAR;
    for (;;) {
        const bool has_next = S.next(ui + 1, nxt);
        const char* nA = has_next ? (const char*)g.A + S.offA(nxt) : cA; const char* nB = has_next ? (const char*)g.Bt + S.offB(nxt) : cB;
        for (int t = 0; t < nt; t += 2) {
            const bool last = (t == nt - 2);
            const char* a1 = cA + (size_t)(t + 1) * kstep;
            const char* a2 = last ? nA : cA + (size_t)(t + 2) * kstep; const char* b2 = last ? nB : cB + (size_t)(t + 2) * kstep;
            const char* a3 = a2 + kstep; const char* b3 = b2 + kstep;
            PG8_LDB(B0, 0, 0); PG8_LDB(B1, 0, 1); PG8_SCHED; PG8_LDA(At, 0, 0); PG8_STAGE(PG8_SA(1, 1), a1 + hstepA, voffA);
            PG8_WAIT_V(8); PG8_WAIT_L(0); PG8_BAR; PG8_MMA(0, 0, At, B0); PG8_MMA(0, 1, At, B1); PG8_BAR; PG8_SCHED;
            PG8_LDA(At, 0, 1); PG8_STAGE(PG8_SB(0, 0), b2, voffB); PG8_STAGE(PG8_SB(0, 1), b2 + hstepB, voffB); PG8_STAGE(PG8_SA(0, 0), a2, voffA);
            PG8_WAIT_V(8); PG8_WAIT_L(0); PG8_BAR; PG8_MMA(1, 0, At, B0); PG8_MMA(1, 1, At, B1); PG8_BAR; PG8_SCHED;
            PG8_LDB(B0, 1, 0); PG8_LDB(B1, 1, 1); PG8_SCHED; PG8_LDA(At, 1, 0); PG8_STAGE(PG8_SA(0, 1), a2 + hstepA, voffA);
            PG8_WAIT_V(8); PG8_WAIT_L(0); PG8_BAR; PG8_MMA(0, 0, At, B0); PG8_MMA(0, 1, At, B1); PG8_BAR; PG8_SCHED;
            PG8_LDA(At, 1, 1); PG8_STAGE(PG8_SB(1, 0), b3, voffB); PG8_STAGE(PG8_SB(1, 1), b3 + hstepB, voffB); PG8_STAGE(PG8_SA(1, 0), a3, voffA);
            PG8_WAIT_V(8); PG8_WAIT_L(0); PG8_BAR; PG8_MMA(1, 0, At, B0); PG8_MMA(1, 1, At, B1); PG8_BAR; PG8_SCHED;
        }
        if constexpr (ALIGN_EPI) { if (wr == 0) PG8_BAR; }
        E(acc, cur, wr, wc, fr, fq, lds);
        if (!has_next) break;
#pragma unroll
        for (int a = 0; a < 2; ++a)
#pragma unroll
            for (int b = 0; b < 2; ++b)
#pragma unroll
                for (int m = 0; m < 4; ++m)
#pragma unroll
                    for (int n = 0; n < 2; ++n) acc[a][b][m][n] = (f32x4){0.f, 0.f, 0.f, 0.f};
        cur = nxt; cA = nA; cB = nB; ++ui;
        if constexpr (ALIGN_EPI) { if (wr == 1) PG8_BAR; }
    }
    PG8_WAIT_V(0);
    if constexpr (!ALIGN_EPI) { if (wr == 0) PG8_BAR; }
    PG8_BAR;
#undef PG8_SA
#undef PG8_SB
#undef PG8_STAGE
#undef PG8_LDA
#undef PG8_LDB
#undef PG8_MMA
#undef PG8_WAIT_V
#undef PG8_WAIT_L
#undef PG8_BAR
#undef PG8_SCHED
}
}

struct KVSched {
    int c, G; const char* ws;
    __device__ __forceinline__ bool next(int i, pg8::Unit& u) const {
        const int L = i * G + c; if (c < 0 || L >= 96) return false;
        const int kind = L >> 5, r = L & 31;
        if (kind < 2) { u.pm = kind * 16 + (r >> 2); u.pn = r & 3; } else { u.pm = 32 + (r >> 3); u.pn = r & 7; }
        return true;
    }
    __device__ __forceinline__ size_t offA(const pg8::Unit& u) const { const int kind = u.pm >> 4, pm = u.pm & 15; int k2 = (kind == 2); asm volatile("" : "+v"(k2));
        return (size_t)ws + WS_MEMB + (size_t)k2 * (WS_WV - WS_MEMB) + (size_t)pm * 256 * 1024 * 2; }
    __device__ __forceinline__ size_t offB(const pg8::Unit& u) const { const int kind = u.pm >> 4; int k1 = (kind == 1), k2 = (kind == 2); asm volatile("" : "+v"(k1), "+v"(k2));
        return (size_t)ws + WS_WK + (size_t)k1 * (WS_WV - WS_WK) + (size_t)k2 * (WS_MEMB - WS_WK) + (size_t)u.pn * 256 * 1024 * 2; }
};


#define XB_TMO      128
#define XB_XCNT(j)  (256  + 64 * (j))
#define XB_XSUB(j)  (1280 + 64 * (j))
#define XB_XGEN(j)  (2304 + 64 * (j))
#define XB_TOP      3328
#define XB_TOPGEN   3392
#define XCD_BAR_WORDS 3456
#define XB_SPIN_CAP (1u << 22)
__device__ __forceinline__ unsigned xb_ld(unsigned* p)              { return __hip_atomic_load(p, __ATOMIC_RELAXED, __HIP_MEMORY_SCOPE_AGENT); }
__device__ __forceinline__ unsigned xb_add(unsigned* p, unsigned v) { return __hip_atomic_fetch_add(p, v, __ATOMIC_RELAXED, __HIP_MEMORY_SCOPE_AGENT); }
__device__ __forceinline__ unsigned xb_xcc_id() { return (unsigned)__builtin_amdgcn_s_getreg((3 << 11) | 20) & 0xFu; }
#define XB_SPIN(cond, bar) do { unsigned _sp = 0; while (cond) { __builtin_amdgcn_s_sleep(1); \
    if ((++_sp & 255u) == 0u) { if (xb_ld(&(bar)[XB_TMO])) break; if (_sp > XB_SPIN_CAP) { atomicAdd(&(bar)[XB_TMO], 1u); break; } } } } while (0)
struct XcdBarrier { unsigned* bar; unsigned x; volatile LAS unsigned* st; };
__device__ __forceinline__ void xcd_barrier_complete(unsigned* bar, unsigned x, unsigned& nloc, unsigned& nx) {
    const unsigned G = gridDim.x * gridDim.y * gridDim.z;
    unsigned sum, cnt, mine, sp = 0u;
    for (;;) {
        sum = 0u; cnt = 0u; mine = 0u;
#pragma unroll
        for (unsigned j = 0; j < 16; ++j) { const unsigned c = xb_ld(&bar[XB_XCNT(j)]); sum += c; cnt += (c > 0u) ? 1u : 0u; mine = (j == x) ? c : mine; }
        if (sum == G) break;
        __builtin_amdgcn_s_sleep(1);
        if ((++sp & 255u) == 0u) { if (xb_ld(&bar[XB_TMO])) break; if (sp > XB_SPIN_CAP) { atomicAdd(&bar[XB_TMO], 1u); break; } }
    }
    nloc = mine > 0u ? mine : 1u; nx = cnt > 0u ? cnt : 1u;
}
__device__ __forceinline__ void xcd_barrier(const XcdBarrier& b) {
    asm volatile("s_waitcnt vmcnt(0)" ::: "memory");
    __syncthreads();
    if (threadIdx.x == 0) {
        unsigned* bar = b.bar;
        __builtin_amdgcn_s_waitcnt(0);
        unsigned nloc = b.st[0], nx = b.st[1];
        if (nloc == 0u) { xcd_barrier_complete(bar, b.x, nloc, nx); b.st[0] = nloc; b.st[1] = nx; }
        const unsigned old = xb_add(&bar[XB_XSUB(b.x)], 1u);
        const unsigned gen = old / nloc;
        if (old + 1u == (gen + 1u) * nloc) {
            __builtin_amdgcn_fence(__ATOMIC_RELEASE, "agent");
            asm volatile("s_waitcnt vmcnt(0)" ::: "memory");
            const unsigned og = xb_add(&bar[XB_TOP], 1u);
            const unsigned tg = og / nx;
            if (og + 1u == (tg + 1u) * nx) xb_add(&bar[XB_TOPGEN], 1u);
            else XB_SPIN(xb_ld(&bar[XB_TOPGEN]) == tg, bar);
            __builtin_amdgcn_fence(__ATOMIC_ACQUIRE, "agent");
            xb_add(&bar[XB_XGEN(b.x)], 1u);
            asm volatile("s_waitcnt vmcnt(0)" ::: "memory");
        } else {
            XB_SPIN(xb_ld(&bar[XB_XGEN(b.x)]) == gen, bar);
            __builtin_amdgcn_fence(__ATOMIC_ACQUIRE, "agent");
            asm volatile("s_waitcnt vmcnt(0)" ::: "memory");
        }
    }
    __syncthreads();
}

__device__ __forceinline__ void transpose_item(const float* W, int K, int N, bf16_t* WT, LAS float* scr, int item, int lane, const float* gain = nullptr, int gu = 0) {
    const int nblk = N / 32, kb = item / nblk, nb = item % nblk, k0 = 64 * kb, n0 = 32 * nb;
    {
        f32x4 v[8];
#pragma unroll
        for (int i = 0; i < 8; ++i) v[i] = *(const f32x4*)(W + (size_t)(k0 + (lane >> 3) + 8 * i) * N + n0 + (lane & 7) * 4);
#pragma unroll
        for (int i = 0; i < 8; ++i) { const int kk = (lane >> 3) + 8 * i; f32x4 w = v[i]; if (gain) w = w * gain[k0 + kk];
            LAS float* d = scr + kk * 33 + (lane & 7) * 4; d[0] = w[0]; d[1] = w[1]; d[2] = w[2]; d[3] = w[3]; }
    }
    LDS_WAIT();
    const int c = lane & 7;
#pragma unroll
    for (int j = 0; j < 4; ++j) { const int n = (lane >> 3) + 8 * j; const LAS float* s = scr + (8 * c) * 33 + n;
        u32x4 o; o.x = pk2(s[0 * 33], s[1 * 33]); o.y = pk2(s[2 * 33], s[3 * 33]); o.z = pk2(s[4 * 33], s[5 * 33]); o.w = pk2(s[6 * 33], s[7 * 33]);
        int drow = n0 + n; if (gu) { const int up = drow >= gu, f = up ? drow - gu : drow; drow = ((f >> 7) << 8) + (up << 7) + (f & 127); }
        *(u32x4*)(WT + (size_t)drow * K + k0 + 8 * c) = o; }
    LDS_WAIT();
}

__device__ __forceinline__ void first_rows(const float* Xp, const float* Xs, bf16_t* XNo, float* ss, int gw, int NGW, int lane) {
    for (int m = gw; m < MT; m += NGW) {
        const f32x4* xr = (const f32x4*)(m < MP ? Xp + (size_t)m * D : Xs + (size_t)(m - MP) * D) + lane;
        f32x4 v[4]; float s = 0.f;
#pragma unroll
        for (int j = 0; j < 4; ++j) { v[j] = xr[64 * j]; s += (v[j].x * v[j].x + v[j].y * v[j].y) + (v[j].z * v[j].z + v[j].w * v[j].w); }
        s = wave_sum(s, lane);
        if (lane < 4) ss[(size_t)m * 4 + lane] = lane == 0 ? s : 0.f;
        u32x2* o8 = (u32x2*)(XNo + (size_t)m * D) + lane;
#pragma unroll
        for (int j = 0; j < 4; ++j) { u32x2 w; w.x = pk2(v[j].x, v[j].y); w.y = pk2(v[j].z, v[j].w); o8[64 * j] = w; }
    }
}

typedef __attribute__((address_space(4))) const unsigned char* kptr_t;
typedef const float* cfp_t; typedef float* fp_t; typedef unsigned char* ucp_t;
#define INP(k) (*(const __attribute__((address_space(4))) cfp_t*)(kp + 8 * (k)))
#define X out
#define WIN_T ((bf16_t*)(ws + WS_WIN))
#define WOUT_T ((bf16_t*)(ws + WS_WOUT))
#define WQ_T ((bf16_t*)(ws + WS_WQ))
#define WK_T ((bf16_t*)(ws + WS_WK))
#define WV_T ((bf16_t*)(ws + WS_WV))
#define WO_T ((bf16_t*)(ws + WS_WO))
#define WUP_T ((bf16_t*)(ws + WS_WUP))
#define WDN_T ((bf16_t*)(ws + WS_WDN))
#define MEMB ((bf16_t*)(ws + WS_MEMB))
#define KBP ((bf16_t*)(ws + WS_KBP))
#define VTP ((bf16_t*)(ws + WS_VTP))
#define KBS ((bf16_t*)(ws + WS_KBS))
#define VTS ((bf16_t*)(ws + WS_VTS))
#define WST ((bf16_t*)(ws + WS_WST))
#define AGG ((float*)(ws + WS_AGG))
#define SSQ(i) ((float*)(ws + WS_SSP) + (size_t)(i) * MT * 4)
#define GT_R ((bf16_t*)(ws + WS_GT))
#define GT_I ((bf16_t*)(ws + WS_GT + 65536))
#define XN ((bf16_t*)(ws + WS_XN))
#define gZ ((bf16_t*)(ws + B_Z))
#define HLOC ((float*)(ws + B_HLOC))
#define PCUM ((float*)(ws + B_PCUM))
#define gY ((bf16_t*)(ws + B_Y))
#define gQ ((bf16_t*)(ws + B_Q))
#define gP ((bf16_t*)(ws + B_P))
#define gO ((bf16_t*)(ws + B_O))
#define PS ((bf16_t*)(ws + B_PS))
#define GU ((bf16_t*)(ws + B_GU))
#define GUS ((bf16_t*)(ws + B_GUS))
#define SBG ((float*)(ws + B_SBG))
#define SBU ((float*)(ws + B_SBU))
#define SBL ((float*)(ws + B_SBL))
__global__ void __launch_bounds__(NTHREADS, 2) trunk_fwd(Args args) {
    extern __shared__ __attribute__((aligned(16))) unsigned char lds_raw[];
    LAS unsigned char* lds = (LAS unsigned char*)lds_raw;
    cg::grid_group grid = cg::this_grid();
    const int wave_s = __builtin_amdgcn_readfirstlane(threadIdx.x >> 6);
#define LANE_STATE() int G = gridDim.x, bid = blockIdx.x; asm volatile("" : "+s"(G), "+s"(bid)); const int NGW = G * NWAVES, NGT = G * NTHREADS; (void)NGW; (void)NGT; \
    const int tid = opaque_tid(wave_s), lane = tid & 63, wave = wave_s; const int gw = bid * NWAVES + wave; const int gt = bid * NTHREADS + tid; (void)lane; (void)gw; (void)gt; \
    kptr_t kp = (kptr_t)__builtin_amdgcn_kernarg_segment_ptr(); asm volatile("" : "+s"(kp)); \
    float* const out = *(const __attribute__((address_space(4))) fp_t*)(kp + 8 * N_IN); unsigned char* const ws = *(const __attribute__((address_space(4))) ucp_t*)(kp + 8 * N_IN + 8); (void)out; (void)ws
    {
        LANE_STATE();
        if (bid == 0) for (int i = tid; i < XCD_BAR_WORDS; i += NTHREADS) __hip_atomic_store((unsigned*)(ws + WS_BAR) + i, 0u, __ATOMIC_RELAXED, __HIP_MEMORY_SCOPE_AGENT);
        if (tid < 32) ((LAS unsigned*)(lds + LDS_MISC))[tid] = 0u;
        __threadfence();
        grid.sync();
        if (tid == 0) (void)xb_add((unsigned*)(ws + WS_BAR) + XB_XCNT(xb_xcc_id()), 1u);
    }
#define GRID_SYNC() do { kptr_t kp_ = (kptr_t)__builtin_amdgcn_kernarg_segment_ptr(); asm volatile("" : "+s"(kp_)); \
        XcdBarrier b_; b_.bar = (unsigned*)(*(const __attribute__((address_space(4))) ucp_t*)(kp_ + 8 * N_IN + 8) + WS_BAR); b_.x = xb_xcc_id(); b_.st = (volatile LAS unsigned*)(lds + LDS_MISC); \
        xcd_barrier(b_); if (PROBE == 3) xcd_barrier(b_); } while (0)

    for (int l = 0; l < DEPTH; ++l) {
        for (int dup0 = 0; dup0 < ((PROBE == 1 || PROBE == 5) ? 2 : 1); ++dup0) {
        {
            LANE_STATE();
            LAS float* scr = (LAS float*)(lds + wave * 16384);
            const float* w_in = INP(I_WIN) + (size_t)l * D * INC; const float* w_out = INP(I_WOUT) + (size_t)l * D * D; const float* w_q = INP(I_WQ) + (size_t)l * D * D;
            const float* w_k = INP(I_WK) + (size_t)l * D * D; const float* w_v = INP(I_WV) + (size_t)l * D * D; const float* w_o = INP(I_WO) + (size_t)l * D * D;
            const float* w_up = INP(I_WUP) + (size_t)l * D * 2 * DFF; const float* w_dn = INP(I_WDN) + (size_t)l * DFF * D; const float* c_v = INP(I_CV) + (size_t)l * BS * NMEM * D;
            constexpr int T_IN = 16 * (INC / 32), T_SQ = 16 * 32, T_UP = 16 * (2 * DFF / 32), T_DN = (DFF / 64) * 32, T_CV = 32 * 32;
            constexpr int T_G = 16;
            constexpr int NIT = T_IN + 5 * T_SQ + T_UP + T_DN + T_CV + 2 * T_G;
            for (int it = gw; it < NIT; it += NGW) {
                int r = it;
                if (r < T_IN) { transpose_item(w_in, D, INC, WIN_T, scr, r, lane, INP(I_GMIX) + l * D); continue; } r -= T_IN;
                if (r < T_SQ) { transpose_item(w_out, D, D, WOUT_T, scr, r, lane); continue; } r -= T_SQ;
                if (r < T_SQ) { transpose_item(w_q, D, D, WQ_T, scr, r, lane, INP(I_GX) + l * D); continue; } r -= T_SQ;
                if (r < T_SQ) { transpose_item(w_k, D, D, WK_T, scr, r, lane); continue; } r -= T_SQ;
                if (r < T_SQ) { transpose_item(w_v, D, D, WV_T, scr, r, lane); continue; } r -= T_SQ;
                if (r < T_SQ) { transpose_item(w_o, D, D, WO_T, scr, r, lane); continue; } r -= T_SQ;
                if (r < T_UP) { transpose_item(w_up, D, 2 * DFF, WUP_T, scr, r, lane, INP(I_GFFN) + l * D, DFF); continue; } r -= T_UP;
                if (r < T_DN) { transpose_item(w_dn, DFF, D, WDN_T, scr, r, lane); continue; } r -= T_DN;
                if (r < T_CV) { transpose_item(c_v, BS * NMEM, D, VTS, scr, r, lane); continue; } r -= T_CV;
                if (r < T_G) { transpose_item(INP(I_WRG) + ((size_t)l * 8 + (r >> 1)) * 4096, 64, 64, GT_R + (r >> 1) * 4096, scr, r & 1, lane); continue; } r -= T_G;
                transpose_item(INP(I_WIG) + ((size_t)l * 8 + (r >> 1)) * 4096, 64, 64, GT_I + (r >> 1) * 4096, scr, r & 1, lane);
            }
            {
                const f32x4* ck = (const f32x4*)(INP(I_CK) + (size_t)l * BS * NMEM * D); u32x2* dk = (u32x2*)KBS;
                for (int i = gt; i < BS * NMEM * D / 4; i += NGT) { const f32x4 v = ck[i]; u32x2 w; w.x = pk2(v.x, v.y); w.y = pk2(v.z, v.w); dk[i] = w; }
                if (l == 0) { const f32x4* mm = (const f32x4*)INP(I_MEM); u32x2* dm = (u32x2*)MEMB;
                    for (int i = gt; i < BP * NMEM * D / 4; i += NGT) { const f32x4 v = mm[i]; u32x2 w; w.x = pk2(v.x, v.y); w.y = pk2(v.z, v.w); dm[i] = w; } }
                const float* wsl = INP(I_WS) + (size_t)l * 4 * 128 * 128;
                for (int i = gt; i < 4 * 128 * 128; i += NGT) { const int s = i & 127, t = (i >> 7) & 127; WST[i] = (bf16_t)f2bf(s <= t ? wsl[i] : 0.f); }
            }
            if (l == 0) first_rows(INP(I_XP), INP(I_XS), XN, SSQ(0), gw, NGW, lane);
        }
        GRID_SYNC();
        }
        {
            LANE_STATE();
            KVSched S; S.G = G; S.c = bid >= 160 ? bid - 160 : -1; S.ws = (const char*)ws;
            pg8::Gemm g{(const bf16_t*)nullptr, (const bf16_t*)nullptr, D, D, D};
            pg8::EpiKV E{out + O_MKP + (size_t)l * BP * NMEM * D, out + O_MVP + (size_t)l * BP * NMEM * D, KBP, VTP};
            pg8::gemm_phase<pg8::EpiKV, KVSched, true>(lds, g, S, E, wave_s);
        }
#define GEMM_BF16(s_) do { const int s = (s_); pg8::GSched S; pg8::Gemm g; pg8::EpiBf16 E; E.scale = 1.f; E.ss = nullptr; E.smp = 0; \
        if (s == 0) { S.init(MT / 256, INC / 256, G, bid); S.aPm = (size_t)256 * D * 2; S.bPn = (size_t)256 * D * 2; g = pg8::Gemm{XN, WIN_T, D, D, D}; E.O = gZ; E.ldc = INC; E.ss = SSQ(3 * l); } \
        else if (s == 1) { S.init(MT / 256, D / 256, G, bid); S.aPm = (size_t)256 * D * 2; S.bPn = (size_t)256 * D * 2; g = pg8::Gemm{XN, WQ_T, D, D, D}; E.O = gQ; E.ldc = D; E.scale = 0.0625f; E.ss = SSQ(3 * l + 1); } \
        else if (s == 2) { S.init(MP / 256, 4, G, bid); S.aPm = (size_t)256 * D * 2; S.aPn = 512; S.bPn = (size_t)256 * 2048 * 2; S.bPm = 512; S.bShift = 4; g = pg8::Gemm{gP, VTP, D, 2048, 256}; E.O = gO; E.ldc = D; } \
        else { S.init(1, 32, G, (bid + G - 64) % G); S.mode = 2; g = pg8::Gemm{PS, VTS, 8192, 2048, 256}; E.O = gO + (size_t)MP * D; E.ldc = D; E.smp = 1; } \
        pg8::gemm_phase<pg8::EpiBf16, pg8::GSched, true>(lds, g, S, E, wave_s); } while (0)
#define GEMM_RES(s_) do { const int s = (s_); pg8::GSched S; S.init(MT / 256, D / 256, G, bid); pg8::Gemm g; \
        if (s == 0) { g = pg8::Gemm{gY, WOUT_T, D, D, D}; S.aPm = (size_t)256 * D * 2; } \
        else if (s == 1) { g = pg8::Gemm{gO, WO_T, D, D, D}; S.aPm = (size_t)256 * D * 2; } \
        else { g = pg8::Gemm{GU, WDN_T, DFF, DFF, DFF}; S.aPm = (size_t)256 * DFF * 2; } \
        S.bPn = (size_t)256 * g.ldb * 2; \
        pg8::EpiResid E{XN, SSQ(3 * l + 1 + s)}; \
        pg8::gemm_phase<pg8::EpiResid, pg8::GSched, true>(lds, g, S, E, wave_s); } while (0)

        for (int rep = 0; rep < 13; ++rep) { if (rep == 4 || rep == 9) continue;
          const int ndup = ((PROBE == 1 && (rep == 1 || rep == 2)) || (PROBE == 4 && rep == 1) || (PROBE == 6 && rep == 2)) ? 2 : ((PROBE == 2 && (rep == 0 || rep == 5 || rep == 6 || rep == 7 || rep == 10)) ? 2 : 1);
          for (int dup = 0; dup < ndup; ++dup) {
            if (rep == 0 || rep == 5 || rep == 7) {
                LANE_STATE();
                const int s0 = rep == 0 ? 0 : (rep == 5 ? 1 : 2), ns = rep == 7 ? 2 : 1;
                for (int q = 0; q < ns; ++q) GEMM_BF16(s0 + q);
            } else if (rep == 10) {
                LANE_STATE();
                pg8::GSched S; S.init(MT / 256, 2 * DFF / 256, G, bid); S.aPm = (size_t)256 * D * 2; S.bPn = (size_t)256 * D * 2;
                const pg8::Gemm g{XN, WUP_T, D, D, D};
                const pg8::EpiAct E{GU, GUS, SBG, SBU, SBL, INP(I_CFW) + (size_t)l * 3 * DFF, SSQ(3 * l + 2)};
                pg8::gemm_phase<pg8::EpiAct, pg8::GSched, true>(lds, g, S, E, wave_s);
            } else if (rep == 1) {
                LANE_STATE();
                {
                    LAS bf16_t* vT = (LAS bf16_t*)lds;
                    constexpr int VP = 136;
                    const float* gvp = INP(I_GV) + l * CW; const float* bsp = INP(I_BSS) + l * 4 * 128;
                    for (int un = bid; un < 8 + 256; un += G) {
                        int rowbase, nrows, sb = -1;
                        if (un < 8) { sb = un; rowbase = MP + un * TS; nrows = TS; } else { rowbase = (un - 8) * 128; nrows = 128; }
                        {
                            const int rl = tid >> 5, cgp = tid & 31;
                            f32x4 g0 = *(const f32x4*)(gvp + cgp * 8), g1 = *(const f32x4*)(gvp + cgp * 8 + 4);
                            for (int p = 0; p < nrows / 16; ++p) {
                                const int r = p * 16 + rl;
                                const u32x4 raw = *(const u32x4*)(gZ + (size_t)(rowbase + r) * INC + Z_VC + cgp * 8);
                                float v[8] = {bflo(raw.x), bfhi(raw.x), bflo(raw.y), bfhi(raw.y), bflo(raw.z), bfhi(raw.z), bflo(raw.w), bfhi(raw.w)};
                                float ss = 0.f;
#pragma unroll
                                for (int k = 0; k < 8; ++k) { v[k] = gelu_t(v[k]); ss += v[k] * v[k]; }
                                ss += shx(ss, 1, lane); ss += shx(ss, 2, lane); ss += shx(ss, 4, lane);
                                const float rstd = 1.0f / sqrtf(ss * (1.f / 64.f) + EPS);
                                const float gg[8] = {g0.x, g0.y, g0.z, g0.w, g1.x, g1.y, g1.z, g1.w};
#pragma unroll
                                for (int k = 0; k < 8; ++k) { v[k] = v[k] * rstd * gg[k]; vT[(cgp * 8 + k) * VP + r] = (bf16_t)f2bf(v[k]); }
                                if (sb >= 0) { float* vo = out + O_VCS + ((size_t)(l * BS + sb) * TS + r) * CW + cgp * 8;
                                    *(f32x4*)vo = (f32x4){v[0], v[1], v[2], v[3]}; *(f32x4*)(vo + 4) = (f32x4){v[4], v[5], v[6], v[7]}; }
                            }
                        }
                        __syncthreads();
                        {
                            const int hh = wave & 3, rh = wave >> 2, fr = lane & 15, fq = lane >> 4;
                            const int nmt = nrows == 128 ? 4 : (rh == 0 ? 2 : 0);
                            for (int mi = 0; mi < nmt; ++mi) {
                                const int mt = rh * 4 + mi, nks = (mt * 16 + 15) / 32 + 1;
                                f32x4 acc[4];
#pragma unroll
                                for (int n = 0; n < 4; ++n) acc[n] = (f32x4){0.f, 0.f, 0.f, 0.f};
                                for (int ks = 0; ks < nks; ++ks) {
                                    const bf16x8 a = *(const bf16x8*)(WST + ((size_t)(hh * 128 + mt * 16 + fr) * 128 + ks * 32 + fq * 8));
#pragma unroll
                                    for (int n = 0; n < 4; ++n) { const bf16x8 b = *(const LAS bf16x8*)(vT + (hh * 64 + n * 16 + fr) * VP + ks * 32 + fq * 8);
                                        acc[n] = __builtin_amdgcn_mfma_f32_16x16x32_bf16(b, a, acc[n], 0, 0, 0); }
                                }
                                { const int t = mt * 16 + fr; const float bias = bsp[hh * 128 + t]; const size_t row = (size_t)(rowbase + t);
#pragma unroll
                                    for (int n = 0; n < 4; ++n) { const int c = hh * 64 + n * 16 + fq * 4; const u32x2 uq = *(const u32x2*)(gZ + row * INC + Z_UC + c);
                                        u32x2 w; w.x = pk2(gelu_t(bflo(uq.x)) * (acc[n][0] + bias), gelu_t(bfhi(uq.x)) * (acc[n][1] + bias)); w.y = pk2(gelu_t(bflo(uq.y)) * (acc[n][2] + bias), gelu_t(bfhi(uq.y)) * (acc[n][3] + bias));
                                        *(u32x2*)(gY + row * D + 768 + c) = w; } }
                            }
                        }
                        __syncthreads();
                    }
                }
                {
                    LAS unsigned char* wl = lds + wave * 16384;
                    LAS bf16_t* tile = (LAS bf16_t*)wl;
                    LAS float* pre_r = (LAS float*)(wl + 2560);
                    LAS float* pre_i = (LAS float*)(wl + 2560 + 4096);
                    LAS float* xcf = (LAS float*)(wl + 2560 + 8192);
                    const int fr = lane & 15, fq = lane >> 4;
                    for (int un = gw; un < 64 + 2048; un += NGW) {
                        int b, hd, rowbase, nrows, t0; bool smp = un < 64;
                        if (smp) { b = un >> 3; hd = un & 7; rowbase = MP + b * TS; nrows = TS; t0 = 0; }
                        else { const int v = un - 64; const int ch = v & 31; hd = (v >> 5) & 7; b = v >> 8; t0 = ch * 128; rowbase = b * SEQ + t0; nrows = 128; }
                        const int cidx = l * AW + hd * 64 + lane;
                        const float br = INP(I_BRG)[cidx], bi = INP(I_BIG)[cidx];
                        const float c8sp = 8.0f * log1pf(__expf(-INP(I_LAM)[cidx]));
                        const float* caw = INP(I_CAW) + (size_t)l * 4 * AW + hd * 64 + lane;
                        const float cw0 = caw[0], cw1 = caw[AW], cw2 = caw[2 * AW], cw3 = caw[3 * AW], cb = INP(I_CAB)[cidx];
                        bf16x8 bR[4][2], bI[4][2];
#pragma unroll
                        for (int n = 0; n < 4; ++n)
#pragma unroll
                            for (int ks = 0; ks < 2; ++ks) { const size_t o_ = (size_t)(hd * 64 + n * 16 + fr) * 64 + ks * 32 + fq * 8;
                                bR[n][ks] = *(const bf16x8*)(GT_R + o_); bI[n][ks] = *(const bf16x8*)(GT_I + o_); }
                        float xm3 = 0.f, xm2 = 0.f, xm1 = 0.f;
                        if (smp) { const float* st = INP(I_SCA) + ((size_t)(l * BS + b) * 3) * AW + hd * 64 + lane; xm3 = st[0]; xm2 = st[AW]; xm1 = st[2 * AW]; }
                        else if (t0 > 0) { const bf16_t* zp = gZ + (size_t)(rowbase - 3) * INC + Z_XA + hd * 64 + lane; xm3 = bf2f(zp[0]); xm2 = bf2f(zp[INC]); xm1 = bf2f(zp[2 * INC]); }
                        float h = 0.f, pc = 1.f;
                        const bf16_t* zq = gZ + (size_t)(rowbase + (lane >> 3)) * INC + Z_XA + hd * 64 + (lane & 7) * 8;
                        float* hp = HLOC + (size_t)rowbase * AW + hd * 64 + lane; float* pp = PCUM + (size_t)rowbase * AW + hd * 64 + lane;
                        LAS bf16_t* xraw = (LAS bf16_t*)pre_r;
                        u32x4 xn0 = *(const u32x4*)zq, xn1 = *(const u32x4*)(zq + (size_t)8 * INC);
                        for (int st = 0; st < nrows / 16; ++st) {
                            *(LAS u32x4*)(xraw + (lane >> 3) * 64 + (lane & 7) * 8) = xn0; *(LAS u32x4*)(xraw + ((lane >> 3) + 8) * 64 + (lane & 7) * 8) = xn1;
                            zq += (size_t)16 * INC;
                            if (st + 1 < nrows / 16) { xn0 = *(const u32x4*)zq; xn1 = *(const u32x4*)(zq + (size_t)8 * INC); }
                            LDS_WAIT();
#pragma unroll
                            for (int i = 0; i < 16; ++i) { const float xv = bf2f(xraw[i * 64 + lane]);
                                const float xc = cw0 * xm3 + cw1 * xm2 + cw2 * xm1 + cw3 * xv + cb; xm3 = xm2; xm2 = xm1; xm1 = xv; xcf[i * 64 + lane] = xc; tile[i * 72 + lane] = (bf16_t)f2bf(xc); }
                            LDS_WAIT();
                            const bf16x8 a0 = *(const LAS bf16x8*)(tile + fr * 72 + fq * 8), a1 = *(const LAS bf16x8*)(tile + fr * 72 + 32 + fq * 8);
#pragma unroll
                            for (int n = 0; n < 4; ++n) {
                                f32x4 ar = (f32x4){0.f, 0.f, 0.f, 0.f}, ai = (f32x4){0.f, 0.f, 0.f, 0.f};
                                ar = __builtin_amdgcn_mfma_f32_16x16x32_bf16(a0, bR[n][0], ar, 0, 0, 0); ar = __builtin_amdgcn_mfma_f32_16x16x32_bf16(a1, bR[n][1], ar, 0, 0, 0);
                                ai = __builtin_amdgcn_mfma_f32_16x16x32_bf16(a0, bI[n][0], ai, 0, 0, 0); ai = __builtin_amdgcn_mfma_f32_16x16x32_bf16(a1, bI[n][1], ai, 0, 0, 0);
#pragma unroll
                                for (int j = 0; j < 4; ++j) { pre_r[(fq * 4 + j) * 64 + n * 16 + fr] = ar[j]; pre_i[(fq * 4 + j) * 64 + n * 16 + fr] = ai[j]; }
                            }
                            LDS_WAIT();
#pragma unroll 4
                            for (int i = 0; i < 16; ++i) {
                                const float r = sigm(pre_r[i * 64 + lane] + br), gi = sigm(pre_i[i * 64 + lane] + bi);
                                const float la = -c8sp * r; float a, om;
                                if (la > -0.125f) { const float x = 2.0f * la; om = -x * (1.0f + x * (0.5f + x * (0.16666667f + x * (0.041666668f + x * (0.0083333338f + x * 0.0013888889f))))); a = 1.0f + la * (1.0f + la * (0.5f + la * (0.16666667f + la * (0.041666668f + la * 0.0083333338f)))); }
                                else { a = __expf(la); om = -expm1f(2.0f * la); }
                                const float bm = sqrtf(om);
                                h = a * h + bm * gi * xcf[i * 64 + lane]; pc = pc * a;
                                *hp = h; *pp = pc; hp += AW; pp += AW;
                            }
                            LDS_WAIT();
                        }
                        AGG[(size_t)un * 128 + lane] = pc; AGG[(size_t)un * 128 + 64 + lane] = h;
                    }
                }
                {
                    const float* cbw = INP(I_CBW) + (size_t)l * 3 * BW;
                    for (int it = gt; it < (MT / 16) * 32; it += NGT) {
                        const int rb = it >> 5, c0 = (it & 31) * 8;
                        int b, t0, T, rowbase; bool smp = rb >= MP / 16;
                        if (!smp) { b = rb >> 8; t0 = (rb & 255) * 16; T = SEQ; rowbase = rb * 16; } else { const int sbk = rb - MP / 16; b = sbk >> 1; t0 = (sbk & 1) * 16; T = TS; rowbase = MP + sbk * 16; }
                        float w0[8], w1[8], w2[8], pm2[8], pm1[8];
#pragma unroll
                        for (int k = 0; k < 8; ++k) { w0[k] = cbw[c0 + k]; w1[k] = cbw[BW + c0 + k]; w2[k] = cbw[2 * BW + c0 + k]; pm2[k] = 0.f; pm1[k] = 0.f; }
                        if (t0 == 0) { if (smp) { const float* st = INP(I_SCB) + ((size_t)(l * BS + b) * 2) * BW + c0;
#pragma unroll
                                for (int k = 0; k < 8; ++k) { pm2[k] = st[k]; pm1[k] = st[BW + k]; } } }
                        else {
#pragma unroll
                            for (int rr = 0; rr < 2; ++rr) { const bf16_t* zr = gZ + (size_t)(rowbase - 2 + rr) * INC; const u32x4 xb = *(const u32x4*)(zr + Z_XB + c0), gc = *(const u32x4*)(zr + Z_GC + c0);
                                float pv[8] = {bflo(xb.x) * bflo(gc.x), bfhi(xb.x) * bfhi(gc.x), bflo(xb.y) * bflo(gc.y), bfhi(xb.y) * bfhi(gc.y), bflo(xb.z) * bflo(gc.z), bfhi(xb.z) * bfhi(gc.z), bflo(xb.w) * bflo(gc.w), bfhi(xb.w) * bfhi(gc.w)};
#pragma unroll
                                for (int k = 0; k < 8; ++k) { if (rr == 0) pm2[k] = pv[k]; else pm1[k] = pv[k]; } }
                        }
                        for (int i = 0; i < 16; ++i) {
                            const bf16_t* zr = gZ + (size_t)(rowbase + i) * INC; const u32x4 xb = *(const u32x4*)(zr + Z_XB + c0), gc = *(const u32x4*)(zr + Z_GC + c0), gb = *(const u32x4*)(zr + Z_GB + c0);
                            const float pv[8] = {bflo(xb.x) * bflo(gc.x), bfhi(xb.x) * bfhi(gc.x), bflo(xb.y) * bflo(gc.y), bfhi(xb.y) * bfhi(gc.y), bflo(xb.z) * bflo(gc.z), bfhi(xb.z) * bfhi(gc.z), bflo(xb.w) * bflo(gc.w), bfhi(xb.w) * bfhi(gc.w)};
                            const float gbv[8] = {bflo(gb.x), bfhi(gb.x), bflo(gb.y), bfhi(gb.y), bflo(gb.z), bfhi(gb.z), bflo(gb.w), bfhi(gb.w)};
                            float yv[8];
#pragma unroll
                            for (int k = 0; k < 8; ++k) { yv[k] = gbv[k] * (w0[k] * pm2[k] + w1[k] * pm1[k] + w2[k] * pv[k]); pm2[k] = pm1[k]; pm1[k] = pv[k]; }
                            u32x4 w; w.x = pk2(yv[0], yv[1]); w.y = pk2(yv[2], yv[3]); w.z = pk2(yv[4], yv[5]); w.w = pk2(yv[6], yv[7]);
                            *(u32x4*)(gY + (size_t)(rowbase + i) * D + 512 + c0) = w;
                        }
                        if (t0 + 16 == T) { float* o = out + (smp ? O_CBS : O_CBP) + ((size_t)(l * 8 + b) * 2) * BW + c0;
#pragma unroll
                            for (int k = 0; k < 8; ++k) { o[k] = pm2[k]; o[BW + k] = pm1[k]; } }
                    }
                }
            } else if (rep == 2) {
                LANE_STATE();
                {
                    LAS float* cr = (LAS float*)lds;
                    for (int un = bid; un < 8 + 256; un += G) {
                        int b, ch, rowbase, nrows; const bool smp = un < 8;
                        if (smp) { b = un; ch = 0; rowbase = MP + b * TS; nrows = TS; } else { const int v = un - 8; b = v >> 5; ch = v & 31; rowbase = b * SEQ + ch * 128; nrows = 128; }
                        {
                            const int c = tid, hd = c >> 6, ln = c & 63; float carry = 0.f;
                            if (smp) carry = INP(I_SHA)[(size_t)(l * BS + b) * AW + c];
                            else { const float* ag = AGG + (size_t)(64 + (b << 8) + (hd << 5)) * 128 + ln; for (int k = 0; k < ch; ++k) carry = ag[(size_t)k * 128] * carry + ag[(size_t)k * 128 + 64]; }
                            cr[c] = carry;
                        }
                        __syncthreads();
                        const int c0 = (tid & 63) * 8, rsub = tid >> 6;
                        const f32x4 ca = *(const LAS f32x4*)(cr + c0), cb = *(const LAS f32x4*)(cr + c0 + 4);
                        for (int p = 0; p < nrows / 8; ++p) {
                            const int rloc = p * 8 + rsub; const size_t row = (size_t)(rowbase + rloc);
                            const f32x4 h0 = *(const f32x4*)(HLOC + row * AW + c0), h1 = *(const f32x4*)(HLOC + row * AW + c0 + 4), p0 = *(const f32x4*)(PCUM + row * AW + c0), p1 = *(const f32x4*)(PCUM + row * AW + c0 + 4);
                            const u32x4 gq = *(const u32x4*)(gZ + row * INC + Z_GA + c0);
                            const f32x4 a0 = h0 + p0 * ca, a1 = h1 + p1 * cb;
                            u32x4 w; w.x = pk2(gelu_t(bflo(gq.x)) * a0[0], gelu_t(bfhi(gq.x)) * a0[1]); w.y = pk2(gelu_t(bflo(gq.y)) * a0[2], gelu_t(bfhi(gq.y)) * a0[3]);
                            w.z = pk2(gelu_t(bflo(gq.z)) * a1[0], gelu_t(bfhi(gq.z)) * a1[1]); w.w = pk2(gelu_t(bflo(gq.w)) * a1[2], gelu_t(bfhi(gq.w)) * a1[3]);
                            *(u32x4*)(gY + row * D + c0) = w;
                            if ((smp || ch == 31) && rloc == nrows - 1) { float* o = out + (smp ? O_HAS : O_HAP) + (size_t)(l * 8 + b) * AW + c0; *(f32x4*)o = a0; *(f32x4*)(o + 4) = a1; }
                        }
                        if ((smp || ch == 31) && tid < 192) {
                            const int k = tid >> 6; const u32x4 xq = *(const u32x4*)(gZ + (size_t)(rowbase + nrows - 3 + k) * INC + Z_XA + c0);
                            float* o = out + (smp ? O_CAS : O_CAP) + ((size_t)(l * 8 + b) * 3 + k) * AW + c0;
                            *(f32x4*)o = (f32x4){bflo(xq.x), bfhi(xq.x), bflo(xq.y), bfhi(xq.y)}; *(f32x4*)(o + 4) = (f32x4){bflo(xq.z), bfhi(xq.z), bflo(xq.w), bfhi(xq.w)};
                        }
                        __syncthreads();
                    }
                }
            } else if (rep == 3 || rep == 8 || rep == 12) {
                LANE_STATE();
                GEMM_RES(rep == 3 ? 0 : (rep == 8 ? 1 : 2));
            } else if (rep == 6) {
                LANE_STATE();
                for (int sub = 0; sub < 2; ++sub) {
                    pg8::GSched S; pg8::Gemm g; pg8::EpiSoftmax E;
                    if (sub == 0) { S.init(MP / 256, 4, G, bid); S.aPm = (size_t)256 * D * 2; S.aPn = 512; S.bPn = 512; S.bPm = (size_t)256 * D * 2; S.bShift = 4; g = pg8::Gemm{gQ, KBP, D, D, 256}; E.O = gP; E.ldc = D; E.smp = 0; }
                    else { S.init(1, 32, G, (bid + G - 64) % G); S.mode = 1; g = pg8::Gemm{gQ + (size_t)MP * D, KBS, D, D, 256}; E.O = PS; E.ldc = 8192; E.smp = 1; }
                    pg8::gemm_phase<pg8::EpiSoftmax, pg8::GSched, true>(lds, g, S, E, wave_s);
                }
            } else if (rep == 11) {
                LANE_STATE();
                {
                    const float* cfw = INP(I_CFW) + (size_t)l * 3 * DFF;
                    for (int it = gt; it < (MP / 256) * (DFF / 8); it += NGT) {
                        const int pm = it / (DFF / 8), c0 = (it % (DFF / 8)) * 8, b = pm >> 4;
                        float w0[8], w1[8], w2[8], p2[8], p1[8], g0[8], g1[8], u0[8], u1[8];
#pragma unroll
                        for (int k = 0; k < 8; ++k) { w0[k] = cfw[c0 + k]; w1[k] = cfw[DFF + c0 + k]; w2[k] = cfw[2 * DFF + c0 + k]; p2[k] = 0.f; p1[k] = 0.f; }
                        if ((pm & 15) != 0) {
#pragma unroll
                            for (int k = 0; k < 8; ++k) { p2[k] = SBL[((size_t)(pm - 1) * 2 + 0) * DFF + c0 + k]; p1[k] = SBL[((size_t)(pm - 1) * 2 + 1) * DFF + c0 + k]; } }
#pragma unroll
                        for (int k = 0; k < 8; ++k) { g0[k] = SBG[((size_t)pm * 2 + 0) * DFF + c0 + k]; g1[k] = SBG[((size_t)pm * 2 + 1) * DFF + c0 + k]; u0[k] = SBU[((size_t)pm * 2 + 0) * DFF + c0 + k]; u1[k] = SBU[((size_t)pm * 2 + 1) * DFF + c0 + k]; }
                        float ha[8], hb[8];
#pragma unroll
                        for (int k = 0; k < 8; ++k) { ha[k] = silu(w0[k] * p2[k] + w1[k] * p1[k] + w2[k] * g0[k]) * u0[k]; hb[k] = silu(w0[k] * p1[k] + w1[k] * g0[k] + w2[k] * g1[k]) * u1[k]; }
                        u32x4 w; w.x = pk2(ha[0], ha[1]); w.y = pk2(ha[2], ha[3]); w.z = pk2(ha[4], ha[5]); w.w = pk2(ha[6], ha[7]);
                        *(u32x4*)(GU + (size_t)(pm * 256) * DFF + c0) = w;
                        w.x = pk2(hb[0], hb[1]); w.y = pk2(hb[2], hb[3]); w.z = pk2(hb[4], hb[5]); w.w = pk2(hb[6], hb[7]);
                        *(u32x4*)(GU + (size_t)(pm * 256 + 1) * DFF + c0) = w;
                        if ((pm & 15) == 15) { float* o = out + O_CFP + ((size_t)(l * 8 + b) * 2) * DFF + c0;
#pragma unroll
                            for (int k = 0; k < 8; ++k) { o[k] = SBL[((size_t)pm * 2 + 0) * DFF + c0 + k]; o[DFF + k] = SBL[((size_t)pm * 2 + 1) * DFF + c0 + k]; } }
                    }
                    for (int it = gt; it < (MS / 16) * (DFF / 8); it += NGT) {
                        const int sbk = it / (DFF / 8), c0 = (it % (DFF / 8)) * 8, b = sbk >> 1, t0 = (sbk & 1) * 16, rowl = sbk * 16;
                        float w0[8], w1[8], w2[8], gm2[8], gm1[8];
#pragma unroll
                        for (int k = 0; k < 8; ++k) { w0[k] = cfw[c0 + k]; w1[k] = cfw[DFF + c0 + k]; w2[k] = cfw[2 * DFF + c0 + k]; }
                        if (t0 == 0) { const float* st = INP(I_SCF) + ((size_t)(l * BS + b) * 2) * DFF + c0;
#pragma unroll
                            for (int k = 0; k < 8; ++k) { gm2[k] = st[k]; gm1[k] = st[DFF + k]; } }
                        else {
                            const u32x4 ga = *(const u32x4*)(GUS + (size_t)(rowl - 2) * (2 * DFF) + c0), gb = *(const u32x4*)(GUS + (size_t)(rowl - 1) * (2 * DFF) + c0);
                            const float a_[8] = {bflo(ga.x), bfhi(ga.x), bflo(ga.y), bfhi(ga.y), bflo(ga.z), bfhi(ga.z), bflo(ga.w), bfhi(ga.w)};
                            const float b_[8] = {bflo(gb.x), bfhi(gb.x), bflo(gb.y), bfhi(gb.y), bflo(gb.z), bfhi(gb.z), bflo(gb.w), bfhi(gb.w)};
#pragma unroll
                            for (int k = 0; k < 8; ++k) { gm2[k] = a_[k]; gm1[k] = b_[k]; }
                        }
                        for (int i = 0; i < 16; ++i) {
                            const bf16_t* gr = GUS + (size_t)(rowl + i) * (2 * DFF) + c0;
                            const u32x4 gq = *(const u32x4*)gr, uq = *(const u32x4*)(gr + DFF);
                            const float gv[8] = {bflo(gq.x), bfhi(gq.x), bflo(gq.y), bfhi(gq.y), bflo(gq.z), bfhi(gq.z), bflo(gq.w), bfhi(gq.w)};
                            const float uv[8] = {bflo(uq.x), bfhi(uq.x), bflo(uq.y), bfhi(uq.y), bflo(uq.z), bfhi(uq.z), bflo(uq.w), bfhi(uq.w)};
                            float hv[8];
#pragma unroll
                            for (int k = 0; k < 8; ++k) { const float cv = w0[k] * gm2[k] + w1[k] * gm1[k] + w2[k] * gv[k]; hv[k] = silu(cv) * uv[k]; gm2[k] = gm1[k]; gm1[k] = gv[k]; }
                            u32x4 w; w.x = pk2(hv[0], hv[1]); w.y = pk2(hv[2], hv[3]); w.z = pk2(hv[4], hv[5]); w.w = pk2(hv[6], hv[7]);
                            *(u32x4*)(GU + (size_t)(MP + rowl + i) * DFF + c0) = w;
                        }
                        if (t0 + 16 == TS) { float* o = out + O_CFS + ((size_t)(l * 8 + b) * 2) * DFF + c0;
#pragma unroll
                            for (int k = 0; k < 8; ++k) { o[k] = gm2[k]; o[DFF + k] = gm1[k]; } }
                    }
                }
            }
            GRID_SYNC();
          }
        }
    }
    {
        LANE_STATE();
        const float* gain = INP(I_GFIN);
        f32x4 gv[4];
#pragma unroll
        for (int j = 0; j < 4; ++j) gv[j] = ((const f32x4*)gain)[lane + 64 * j];
        for (int m = gw; m < MT; m += NGW) {
            f32x4* yr = (f32x4*)(out + (size_t)m * D) + lane; const u32x2* xr = (const u32x2*)(XN + (size_t)m * D) + lane;
            const float rstd = ss_rstd(*(const f32x4*)(SSQ(6) + (size_t)m * 4));
#pragma unroll
            for (int j = 0; j < 4; ++j) { const u32x2 p = xr[64 * j]; yr[64 * j] = (f32x4){bflo(p.x), bfhi(p.x), bflo(p.y), bfhi(p.y)} * rstd * gv[j]; }
        }
    }
}

extern "C" void kernel_launch(void* const* d_in, const int* in_sizes, int n_in, void* d_out, int out_size, void* d_ws, size_t ws_size, hipStream_t stream) {
    static int grid = 0;
    if (grid == 0) {
        if (n_in != N_IN || (size_t)out_size != O_END || ws_size < WS_END) { fprintf(stderr, "kernel_launch: unexpected sizes n_in %d out %d ws %zu (need %zu)\n", n_in, out_size, ws_size, (size_t)WS_END); grid = -1; return; }
        int dev = 0, cus = 0, per_cu = 0;
        (void)hipGetDevice(&dev); (void)hipDeviceGetAttribute(&cus, hipDeviceAttributeMultiprocessorCount, dev);
        if (hipFuncSetAttribute((const void*)trunk_fwd, hipFuncAttributeMaxDynamicSharedMemorySize, LDS_BYTES) != hipSuccess) { fprintf(stderr, "kernel_launch: hipFuncSetAttribute failed\n"); grid = -1; return; }
        if (hipOccupancyMaxActiveBlocksPerMultiprocessor(&per_cu, (const void*)trunk_fwd, NTHREADS, LDS_BYTES) != hipSuccess || per_cu < 1) { fprintf(stderr, "kernel_launch: occupancy query gave %d\n", per_cu); per_cu = 1; }
        (void)hipGetLastError();
        grid = cus * 1;
        if (grid != 256) fprintf(stderr, "kernel_launch: note: %d CUs\n", grid);
    }
    if (grid < 0) return;
    Args a{};
    for (int i = 0; i < N_IN; ++i) a.in[i] = (const float*)d_in[i];
    a.out = (float*)d_out; a.ws = (unsigned char*)d_ws;
    void* kargs[] = {&a};
    hipError_t e = hipLaunchCooperativeKernel((const void*)trunk_fwd, dim3(grid), dim3(NTHREADS), kargs, LDS_BYTES, stream);
    if (e != hipSuccess) fprintf(stderr, "kernel_launch: cooperative launch failed: %s (grid %d)\n", hipGetErrorString(e), grid);
}
```

```cpp
#include <hip/hip_runtime.h>
#include <hip/hip_cooperative_groups.h>
#include <cstdio>
#include <cstdint>
namespace cg = cooperative_groups;
#ifndef PROBE
#define PROBE 0
#endif

#define LAS __attribute__((address_space(3)))
typedef unsigned short bf16_t;
typedef short bf16x8 __attribute__((ext_vector_type(8)));
typedef float f32x4 __attribute__((ext_vector_type(4)));
typedef float f32x2 __attribute__((ext_vector_type(2)));
typedef unsigned u32x4 __attribute__((ext_vector_type(4)));
typedef unsigned u32x2 __attribute__((ext_vector_type(2)));

constexpr int D = 1024, BP = 8, SEQ = 4096, BS = 8, TS = 32, DEPTH = 2;
constexpr int MP = BP * SEQ, MS = BS * TS, MT = MP + MS;
constexpr int INC = 2304, DFF = 2816, NMEM = 256, AW = 512, BW = 256, CW = 256;
constexpr int Z_XA = 0, Z_GA = 512, Z_XB = 1024, Z_GB = 1280, Z_GC = 1536, Z_UC = 1792, Z_VC = 2048;
constexpr float EPS = 1e-6f;
constexpr int NWAVES = 8, NTHREADS = 512;

constexpr size_t O_YP = 0, O_YS = O_YP + (size_t)MP * D, O_CAP = O_YS + (size_t)MS * D, O_HAP = O_CAP + DEPTH * BP * 3 * AW,
                 O_CBP = O_HAP + DEPTH * BP * AW, O_CFP = O_CBP + DEPTH * BP * 2 * BW, O_MKP = O_CFP + DEPTH * BP * 2 * DFF,
                 O_MVP = O_MKP + (size_t)DEPTH * BP * NMEM * D, O_CAS = O_MVP + (size_t)DEPTH * BP * NMEM * D, O_HAS = O_CAS + DEPTH * BS * 3 * AW,
                 O_CBS = O_HAS + DEPTH * BS * AW, O_CFS = O_CBS + DEPTH * BS * 2 * BW, O_VCS = O_CFS + DEPTH * BS * 2 * DFF,
                 O_END = O_VCS + DEPTH * BS * TS * CW;

constexpr size_t MiB = 1u << 20;
constexpr size_t WS_WIN = 0, WS_WOUT = 5 * MiB, WS_WQ = 7 * MiB, WS_WK = 9 * MiB, WS_WV = 11 * MiB, WS_WO = 13 * MiB, WS_WUP = 15 * MiB, WS_WDN = 26 * MiB;
constexpr size_t WS_MEMB = 32 * MiB, WS_KBP = 36 * MiB, WS_VTP = 40 * MiB, WS_KBS = 44 * MiB, WS_VTS = 48 * MiB, WS_WST = 52 * MiB, WS_GT = WS_WST + 131072, WS_AGG = 53 * MiB, WS_SS = 54 * MiB + 256 * 1024, WS_BAR = 55 * MiB + 512 * 1024;
constexpr size_t WS_XN = 56 * MiB, WS_BIG = 121 * MiB;
constexpr size_t B_Z = WS_BIG, B_HLOC = WS_BIG + 146 * MiB, B_PCUM = WS_BIG + 211 * MiB, B_Y = WS_BIG + 276 * MiB;
constexpr size_t B_Q = WS_BIG, B_P = WS_BIG + 65 * MiB, B_O = WS_BIG + 130 * MiB, B_PS = WS_BIG + 195 * MiB;
constexpr size_t B_GU = WS_BIG;
constexpr size_t B_GUS = WS_BIG + 200 * MiB;
constexpr size_t B_SBG = WS_BIG + 204 * MiB, B_SBU = WS_BIG + 207 * MiB, B_SBL = WS_BIG + 210 * MiB;
constexpr size_t WS_END = WS_BIG + (size_t)MT * 2 * DFF * 2;
constexpr size_t WS_SSP = 476 * MiB;
static_assert(WS_END <= WS_SSP && WS_SSP + (size_t)7 * MT * 64 <= 512 * MiB, "workspace");
static_assert(WS_XN + (size_t)MT * D * 2 <= WS_BIG, "xn");

constexpr int LDS_RING = 131072, LDS_EX = LDS_RING, LDS_MISC = LDS_EX + 8192, LDS_BYTES = 147456;

enum { I_XP = 0, I_XS, I_MEM, I_CK, I_CV, I_SCA, I_SHA, I_SCB, I_SCF, I_GMIX, I_WIN, I_CAW, I_CAB, I_WRG, I_BRG, I_WIG, I_BIG, I_LAM, I_CBW, I_GV, I_WS, I_BSS,
       I_WOUT, I_GX, I_WQ, I_WK, I_WV, I_WO, I_GFFN, I_WUP, I_CFW, I_WDN, I_GFIN, N_IN };

struct Args { const float* in[N_IN]; float* out; unsigned char* ws; };

__device__ __forceinline__ unsigned f2bf(float f) { unsigned u = __builtin_bit_cast(unsigned, f); return (u + 0x7fffu + ((u >> 16) & 1u)) >> 16; }
__device__ __forceinline__ unsigned pk2(float lo, float hi) { return f2bf(lo) | (f2bf(hi) << 16); }
__device__ __forceinline__ float bf2f(unsigned v) { return __builtin_bit_cast(float, v << 16); }
__device__ __forceinline__ float bflo(unsigned w) { return __builtin_bit_cast(float, w << 16); }
__device__ __forceinline__ float bfhi(unsigned w) { return __builtin_bit_cast(float, w & 0xffff0000u); }
__device__ __forceinline__ unsigned cvt_pk_bf16(float lo, float hi) { unsigned r; asm volatile("v_cvt_pk_bf16_f32 %0, %1, %2" : "=v"(r) : "v"(lo), "v"(hi)); return r; }
__device__ __forceinline__ float fexp(float x) { return __builtin_amdgcn_exp2f(x * 1.4426950408889634f); }
__device__ __forceinline__ float sigm(float x) { return __builtin_amdgcn_rcpf(1.0f + fexp(-x)); }
__device__ __forceinline__ float gelu_t(float x) { const float u = 0.7978845608028654f * (x + 0.044715f * x * x * x); return x * sigm(2.0f * u); }
__device__ __forceinline__ float silu(float x) { return x * sigm(x); }
__device__ __forceinline__ float shx(float v, int m, int lane) { return __builtin_bit_cast(float, __builtin_amdgcn_ds_bpermute((lane ^ m) << 2, __builtin_bit_cast(int, v))); }
__device__ __forceinline__ float wave_sum(float v, int lane) {
#pragma unroll
    for (int o = 1; o < 64; o <<= 1) v += shx(v, o, lane);
    return v;
}
#define LDS_WAIT() asm volatile("s_waitcnt lgkmcnt(0)" ::: "memory")
__device__ __forceinline__ float ss_rstd(f32x4 p) { return 1.0f / sqrtf(((p[0] + p[1]) + (p[2] + p[3])) * (1.f / 1024.f) + 1e-6f); }
__device__ __forceinline__ int opaque_tid(int wave_s) { int l; asm volatile("v_mbcnt_lo_u32_b32 %0, -1, 0\n\tv_mbcnt_hi_u32_b32 %0, -1, %0" : "=v"(l)); return wave_s * 64 + l; }

namespace pg8 {
constexpr int BM = 256, BK = 64, HALF = 128, HTB = HALF * BK * 2, NXCD = 8, WGM = 8;
__device__ __forceinline__ int lds_byte(int r, int c) { const int st = (r >> 4) * 2 + (c >> 5), rr = r & 15, cc = c & 31, ob = rr * 64 + cc * 2; return st * 1024 + (ob ^ (((ob >> 9) & 1) << 5)); }
__device__ __forceinline__ void stage_rc(int b, int& R, int& C) { const int st = b / 1024, sb = b % 1024, swz = sb ^ (((sb >> 9) & 1) << 5); R = (st >> 1) * 16 + swz / 64; C = (st & 1) * 32 + (swz % 64) / 2; }
__device__ __forceinline__ int perm32(int rho) { const int n = rho >> 4, i = rho & 15; return 8 * (i >> 2) + 4 * n + (i & 3); }

struct Unit { int pm, pn; };
struct Gemm { const bf16_t* A; const bf16_t* Bt; int lda, ldb, K; };

struct GSched {
    int nM, nN, nwg, G, c, mode;
    size_t aPm, aPn, bPn, bPm; int bShift;
    __device__ __forceinline__ void init(int nM_, int nN_, int G_, int c_) { nM = nM_; nN = nN_; nwg = nM * nN; G = G_; c = c_; mode = 0; aPm = 0; aPn = 0; bPn = 0; bPm = 0; bShift = 0; }
    __device__ __forceinline__ bool next(int i, Unit& u) const {
        const long L = (long)i * G + c; if (L >= nwg) return false;
        int wgid = (int)L; { const int q = nwg / NXCD, r = nwg % NXCD, xcd = wgid % NXCD, off = wgid / NXCD; wgid = (xcd < r ? xcd * (q + 1) : r * (q + 1) + (xcd - r) * q) + off; }
        const int nig = WGM * nN, gid = wgid / nig, fm = gid * WGM, gsz = (nM - fm) < WGM ? (nM - fm) : WGM;
        u.pm = fm + ((wgid % nig) % gsz); u.pn = (wgid % nig) / gsz; return true;
    }
    __device__ __forceinline__ size_t offA(const Unit& u) const { return mode == 1 ? (size_t)(u.pn & 3) * 512 : (mode == 2 ? (size_t)(u.pn & 3) * 4096 + (size_t)(u.pn >> 2) * 512 : (size_t)u.pm * aPm + (size_t)u.pn * aPn); }
    __device__ __forceinline__ size_t offB(const Unit& u) const { return mode == 1 ? (size_t)(u.pn >> 2) * (256 * 1024 * 2) + (size_t)(u.pn & 3) * 512 : (mode == 2 ? (size_t)(u.pn & 3) * (256 * 2048 * 2) + (size_t)(u.pn >> 2) * 512 : (size_t)u.pn * bPn + (size_t)(u.pm >> bShift) * bPm); }
};

struct EpiBf16 {
    static constexpr bool PERM = true;
    bf16_t* O; int ldc; float scale; const float* ss; int smp;
    __device__ __forceinline__ void operator()(f32x4 (&acc)[2][2][4][2], const Unit& u, int wr, int wc, int fr, int fq, LAS unsigned char*) const {
        asm volatile("" : "+v"(fr), "+v"(fq)); asm volatile("" : "+s"(wr), "+s"(wc));
        const int row0 = u.pm * BM + wr * 64 + fr, col0 = (smp ? (u.pn & 3) : u.pn) * BM + wc * 32 + 8 * fq;
        f32x4 rs[2][4];
#pragma unroll
        for (int ai = 0; ai < 2; ++ai)
#pragma unroll
            for (int m = 0; m < 4; ++m) rs[ai][m] = ss ? *(const f32x4*)(ss + (size_t)(row0 + ai * HALF + m * 16) * 4) : (f32x4){0.f, 0.f, 0.f, 0.f};
#pragma unroll
        for (int ai = 0; ai < 2; ++ai)
#pragma unroll
            for (int m = 0; m < 4; ++m) { bf16_t* rowp = O + (size_t)(row0 + ai * HALF + m * 16) * ldc + col0;
                float sc = scale; if (ss) sc *= ss_rstd(rs[ai][m]);
                if (smp && ((ai * HALF + wr * 64 + m * 16 + fr) >> 5) != (u.pn >> 2)) continue;
#pragma unroll
                for (int bj = 0; bj < 2; ++bj) { const f32x4 v0 = acc[ai][bj][m][0] * sc, v1 = acc[ai][bj][m][1] * sc;
                    u32x4 w; w.x = cvt_pk_bf16(v0[0], v0[1]); w.y = cvt_pk_bf16(v0[2], v0[3]); w.z = cvt_pk_bf16(v1[0], v1[1]); w.w = cvt_pk_bf16(v1[2], v1[3]);
                    *(u32x4*)(rowp + bj * HALF) = w; } }
    }
};
struct EpiResid {
    static constexpr bool PERM = true;
    bf16_t* xb; float* ss;
    __device__ __forceinline__ void operator()(f32x4 (&acc)[2][2][4][2], const Unit& u, int wr, int wc, int fr, int fq, LAS unsigned char* lds) const {
        asm volatile("" : "+v"(fr), "+v"(fq)); asm volatile("" : "+s"(wr), "+s"(wc));
        const int col0 = u.pn * BM + wc * 32 + 8 * fq, lane = fq * 16 + fr;
        LAS float* PS = (LAS float*)(lds + LDS_EX);
        bf16_t* ob = xb + (size_t)u.pm * BM * D;
#pragma unroll
        for (int ai = 0; ai < 2; ++ai) {
            u32x4 pre[4][2];
#pragma unroll
            for (int m = 0; m < 4; ++m)
#pragma unroll
                for (int bj = 0; bj < 2; ++bj) pre[m][bj] = *(const u32x4*)(ob + (size_t)(ai * HALF + wr * 64 + m * 16 + fr) * D + col0 + bj * HALF);
            asm volatile("" ::: "memory");
#pragma unroll
            for (int m = 0; m < 4; ++m) { const int rl = ai * HALF + wr * 64 + m * 16 + fr; const size_t off = (size_t)rl * D + col0; float q = 0.f;
#pragma unroll
                for (int bj = 0; bj < 2; ++bj) { const u32x4 p = pre[m][bj]; const f32x4 a0 = acc[ai][bj][m][0], a1 = acc[ai][bj][m][1];
                    const float v0 = bflo(p.x) + a0[0], v1 = bfhi(p.x) + a0[1], v2 = bflo(p.y) + a0[2], v3 = bfhi(p.y) + a0[3], v4 = bflo(p.z) + a1[0], v5 = bfhi(p.z) + a1[1], v6 = bflo(p.w) + a1[2], v7 = bfhi(p.w) + a1[3];
                    u32x4 w; w.x = cvt_pk_bf16(v0, v1); w.y = cvt_pk_bf16(v2, v3); w.z = cvt_pk_bf16(v4, v5); w.w = cvt_pk_bf16(v6, v7); *(u32x4*)(ob + off + bj * HALF) = w;
                    q += ((v0 * v0 + v1 * v1) + (v2 * v2 + v3 * v3)) + ((v4 * v4 + v5 * v5) + (v6 * v6 + v7 * v7)); }
                q += shx(q, 16, lane); q += shx(q, 32, lane);
                if (fq == 0) PS[rl * 4 + wc] = q; }
            asm volatile("" ::: "memory");
        }
        asm volatile("s_waitcnt lgkmcnt(0)" ::: "memory"); __builtin_amdgcn_s_barrier(); asm volatile("" ::: "memory");
        { const int t = (wr * 4 + wc) * 64 + lane; if (t < 256) { const f32x4 p = *(const LAS f32x4*)(PS + t * 4); ss[(size_t)(u.pm * BM + t) * 4 + u.pn] = (p[0] + p[1]) + (p[2] + p[3]); } }
    }
};
struct EpiKV {
    static constexpr bool PERM = false;
    float* outK; float* outV; bf16_t* KB; bf16_t* VT;
    __device__ __forceinline__ void operator()(f32x4 (&acc)[2][2][4][2], const Unit& u, int wr, int wc, int fr, int fq, LAS unsigned char*) const {
        asm volatile("" : "+v"(fr), "+v"(fq)); asm volatile("" : "+s"(wr), "+s"(wc));
        const int kind = u.pm >> 4, pm = u.pm & 15;
        const int col0 = u.pn * BM + wc * 32 + 4 * fq;
        float* of = kind == 0 ? outK : outV; bf16_t* ob = kind == 0 ? KB : VT; const int ldb_ = kind == 2 ? 2048 : 1024;
#pragma unroll
        for (int ai = 0; ai < 2; ++ai)
#pragma unroll
            for (int m = 0; m < 4; ++m) { const int row = pm * BM + ai * HALF + wr * 64 + m * 16 + fr;
#pragma unroll
                for (int bj = 0; bj < 2; ++bj)
#pragma unroll
                    for (int n = 0; n < 2; ++n) { const f32x4 v = acc[ai][bj][m][n]; const int col = col0 + bj * HALF + n * 16;
                        if (kind != 2) *(f32x4*)(of + (size_t)row * 1024 + col) = v;
                        if (kind != 1) { u32x2 w; w.x = cvt_pk_bf16(v[0], v[1]); w.y = cvt_pk_bf16(v[2], v[3]); *(u32x2*)(ob + (size_t)row * ldb_ + col) = w; } } }
    }
};
struct EpiSoftmax {
    static constexpr bool PERM = true;
    bf16_t* O; int ldc; int smp;
    __device__ __forceinline__ void operator()(f32x4 (&acc)[2][2][4][2], const Unit& u, int wr, int wc, int fr, int fq, LAS unsigned char* lds) const {
        asm volatile("" : "+v"(fr), "+v"(fq)); asm volatile("" : "+s"(wr), "+s"(wc));
        LAS f32x2* EX = (LAS f32x2*)(lds + LDS_EX);
        const int lane = fq * 16 + fr;
        const float L2E = 1.4426950408889634f;
#pragma unroll
        for (int ai = 0; ai < 2; ++ai)
#pragma unroll
            for (int m = 0; m < 4; ++m) {
                float mx = -3.0e38f;
#pragma unroll
                for (int bj = 0; bj < 2; ++bj)
#pragma unroll
                    for (int n = 0; n < 2; ++n) { const f32x4 x = acc[ai][bj][m][n]; mx = fmaxf(mx, fmaxf(fmaxf(x[0], x[1]), fmaxf(x[2], x[3]))); }
                mx = fmaxf(mx, shx(mx, 16, lane)); mx = fmaxf(mx, shx(mx, 32, lane));
                float s = 0.f;
#pragma unroll
                for (int bj = 0; bj < 2; ++bj)
#pragma unroll
                    for (int n = 0; n < 2; ++n) { f32x4 x = acc[ai][bj][m][n];
#pragma unroll
                        for (int j = 0; j < 4; ++j) { x[j] = __builtin_amdgcn_exp2f((x[j] - mx) * L2E); s += x[j]; }
                        acc[ai][bj][m][n] = x; }
                s += shx(s, 16, lane); s += shx(s, 32, lane);
                if (fq == 0) EX[(ai * HALF + wr * 64 + m * 16 + fr) * 4 + wc] = (f32x2){mx, s};
            }
        asm volatile("s_waitcnt lgkmcnt(0)" ::: "memory"); __builtin_amdgcn_s_barrier(); asm volatile("" ::: "memory");
        int colb = u.pn * BM, j_ = 0;
        if (smp) { colb = (u.pn & 3) * 2048 + (u.pn >> 2) * 256; j_ = u.pn >> 2; }
        const int col0 = colb + wc * 32 + 8 * fq;
#pragma unroll
        for (int ai = 0; ai < 2; ++ai)
#pragma unroll
            for (int m = 0; m < 4; ++m) {
                const int rl = ai * HALF + wr * 64 + m * 16 + fr;
                const f32x2 e0 = EX[rl * 4 + 0], e1 = EX[rl * 4 + 1], e2 = EX[rl * 4 + 2], e3 = EX[rl * 4 + 3];
                const float M = fmaxf(fmaxf(e0.x, e1.x), fmaxf(e2.x, e3.x));
                const float tot = e0.y * __builtin_amdgcn_exp2f((e0.x - M) * L2E) + e1.y * __builtin_amdgcn_exp2f((e1.x - M) * L2E) + e2.y * __builtin_amdgcn_exp2f((e2.x - M) * L2E) + e3.y * __builtin_amdgcn_exp2f((e3.x - M) * L2E);
                const float own = wc == 0 ? e0.x : (wc == 1 ? e1.x : (wc == 2 ? e2.x : e3.x));
                float f = __builtin_amdgcn_exp2f((own - M) * L2E) / tot;
                if (smp && (rl >> 5) != j_) f = 0.f;
                bf16_t* rowp = O + (size_t)(u.pm * BM + rl) * ldc + col0;
#pragma unroll
                for (int bj = 0; bj < 2; ++bj) { const f32x4 v0 = acc[ai][bj][m][0] * f, v1 = acc[ai][bj][m][1] * f;
                    u32x4 w; w.x = cvt_pk_bf16(v0[0], v0[1]); w.y = cvt_pk_bf16(v0[2], v0[3]); w.z = cvt_pk_bf16(v1[0], v1[1]); w.w = cvt_pk_bf16(v1[2], v1[3]);
                    *(u32x4*)(rowp + bj * HALF) = w; } }
    }
};


__device__ __forceinline__ float dpp_ror1(float v) { return __builtin_bit_cast(float, __builtin_amdgcn_update_dpp(0, __builtin_bit_cast(int, v), 0x121, 0xf, 0xf, false)); }
__device__ __forceinline__ float dpp_ror2(float v) { return __builtin_bit_cast(float, __builtin_amdgcn_update_dpp(0, __builtin_bit_cast(int, v), 0x122, 0xf, 0xf, false)); }
struct EpiAct {
    static constexpr bool PERM = true;
    bf16_t* H; const float* scf; float* ocf; float* sbg; float* sbu; float* sbl; const float* cfw; const float* ss;
    __device__ __forceinline__ void operator()(f32x4 (&acc)[2][2][4][2], const Unit& u, int wr, int wc, int fr, int fq, LAS unsigned char* lds) const {
        asm volatile("" : "+s"(wr), "+s"(wc));
        int lane; asm volatile("v_mbcnt_lo_u32_b32 %0, -1, 0\n\tv_mbcnt_hi_u32_b32 %0, -1, %0" : "=v"(lane));
        fr = lane & 15; fq = lane >> 4;
        const int fl = wc * 32 + 8 * fq, f0 = u.pn * 128 + fl; int rowt = wr * 64 + fr;
        {
            float rst[2][4];
            f32x4 rsl[2][4];
#pragma unroll
            for (int ai = 0; ai < 2; ++ai)
#pragma unroll
                for (int m = 0; m < 4; ++m) rsl[ai][m] = *(const f32x4*)(ss + (size_t)(u.pm * BM + ai * HALF + rowt + m * 16) * 4);
#pragma unroll
            for (int ai = 0; ai < 2; ++ai)
#pragma unroll
                for (int m = 0; m < 4; ++m) { rst[ai][m] = ss_rstd(rsl[ai][m]); }
#pragma unroll
            for (int ai = 0; ai < 2; ++ai)
#pragma unroll
                for (int m = 0; m < 4; ++m) { acc[ai][0][m][0] = acc[ai][0][m][0] * rst[ai][m]; acc[ai][0][m][1] = acc[ai][0][m][1] * rst[ai][m]; acc[ai][1][m][0] = acc[ai][1][m][0] * rst[ai][m]; acc[ai][1][m][1] = acc[ai][1][m][1] * rst[ai][m]; }
        }
        const bool smp = (u.pm == 128);
        asm volatile("" : "+v"(rowt));
        LAS float* BND = (LAS float*)(lds + LDS_EX);
        if (fr >= 14) {
#pragma unroll
            for (int ai = 0; ai < 2; ++ai)
#pragma unroll
                for (int n = 0; n < 2; ++n) *(LAS f32x4*)(BND + ((ai * 2 + wr) * 2 + (fr - 14)) * 128 + fl + 4 * n) = acc[ai][0][3][n];
            if (wr == 1) {
#pragma unroll
                for (int n = 0; n < 2; ++n) *(f32x4*)(sbl + ((size_t)u.pm * 2 + (fr - 14)) * DFF + f0 + 4 * n) = acc[1][0][3][n];
            }
        }
        asm volatile("s_waitcnt lgkmcnt(0)" ::: "memory"); __builtin_amdgcn_s_barrier(); asm volatile("" ::: "memory");
#pragma unroll
        for (int ai = 0; ai < 2; ++ai) {
            const int pg = wr == 1 ? ai * 2 : 1;
            u32x2 hp[2][4];
#pragma unroll
            for (int n = 0; n < 2; ++n) {
                const f32x4 w0 = *(const f32x4*)(cfw + f0 + 4 * n), w1 = *(const f32x4*)(cfw + DFF + f0 + 4 * n), w2 = *(const f32x4*)(cfw + 2 * DFF + f0 + 4 * n);
                f32x4 h2 = *(const LAS f32x4*)(BND + (pg * 2 + 0) * 128 + fl + 4 * n), h1 = *(const LAS f32x4*)(BND + (pg * 2 + 1) * 128 + fl + 4 * n);
                f32x4 t2 = h2, t1 = h1;
                if (smp) { const float* sp = scf + (size_t)((ai * 4 + wr * 2) * 2) * DFF + f0 + 4 * n; h2 = *(const f32x4*)sp; h1 = *(const f32x4*)(sp + DFF); t2 = *(const f32x4*)(sp + 2 * DFF); t1 = *(const f32x4*)(sp + 3 * DFF); }
#pragma unroll
                for (int jp = 0; jp < 2; ++jp) {
                    float hv[4][2];
#pragma unroll
                    for (int jj = 0; jj < 2; ++jj) { const int j = jp * 2 + jj;
                        float r1p = h1[j], r2p = fr == 0 ? h2[j] : h1[j];
#pragma unroll
                        for (int m = 0; m < 4; ++m) { const float g = acc[ai][0][m][n][j];
                            if (m == 2 && smp) { r1p = t1[j]; r2p = fr == 0 ? t2[j] : t1[j]; }
                            const float r1 = dpp_ror1(g), r2 = dpp_ror2(g);
                            const float gm1 = fr >= 1 ? r1 : r1p, gm2 = fr >= 2 ? r2 : r2p;
                            r1p = r1; r2p = r2;
                            const float cv = w0[j] * gm2 + w1[j] * gm1 + w2[j] * g;
                            hv[m][jj] = silu(cv) * acc[ai][1][m][n][j]; } }
#pragma unroll
                    for (int m = 0; m < 4; ++m) { const unsigned pk = cvt_pk_bf16(hv[m][0], hv[m][1]); if (jp == 0) hp[n][m].x = pk; else hp[n][m].y = pk; }
                }
            }
#pragma unroll
            for (int m = 0; m < 4; ++m) {
                const int rl = ai * HALF + rowt + m * 16;
                if (smp && (m & 1) && fr >= 14) {
#pragma unroll
                    for (int n = 0; n < 2; ++n) *(f32x4*)(ocf + ((size_t)(ai * 4 + wr * 2 + (m >> 1)) * 2 + (fr - 14)) * DFF + f0 + 4 * n) = acc[ai][0][m][n];
                }
                if (!smp && ai == 0 && m == 0 && wr == 0 && fr < 2) {
#pragma unroll
                    for (int n = 0; n < 2; ++n) { *(f32x4*)(sbg + ((size_t)u.pm * 2 + fr) * DFF + f0 + 4 * n) = acc[0][0][0][n]; *(f32x4*)(sbu + ((size_t)u.pm * 2 + fr) * DFF + f0 + 4 * n) = acc[0][1][0][n]; }
                } else {
                    u32x4 w; w.x = hp[0][m].x; w.y = hp[0][m].y; w.z = hp[1][m].x; w.w = hp[1][m].y;
                    *(u32x4*)(H + (size_t)(u.pm * BM + rl) * DFF + f0) = w;
                }
            }
        }
    }
};

template <class Epi, class Sched, bool ALIGN_EPI>
__device__ __forceinline__ void gemm_phase(LAS unsigned char* lds, const Gemm g, const Sched& S, const Epi& E, const int wave_s) {
    const int tid = opaque_tid(wave_s), wid = __builtin_amdgcn_readfirstlane(tid >> 6), lane = tid & 63, wr = wid >> 2, wc = wid & 3, fr = lane & 15, fq = lane >> 4;
    const int nt = g.K / BK;
    unsigned voffA[2], voffB[2];
#pragma unroll
    for (int i = 0; i < 2; ++i) { int R, C; stage_rc(tid * 16 + i * 8192, R, C); const int Rb = Epi::PERM ? ((R & ~31) + perm32(R & 31)) : R;
        voffA[i] = (unsigned)(R * g.lda + C) * 2u; voffB[i] = (unsigned)(Rb * g.ldb + C) * 2u; }
    const size_t kstep = (size_t)(BK * 2);
    const size_t hstepA = (size_t)HALF * g.lda * 2, hstepB = (size_t)HALF * g.ldb * 2;
    const unsigned ldsw = (unsigned)wid * 1024u;
    const int aoff = lds_byte(wr * 64 + fr, fq * 8), boff = lds_byte(wc * 32 + fr, fq * 8);
#define PG8_SA(b, h) (((b) * 2 + (h)) * HTB)
#define PG8_SB(b, h) ((4 + (b) * 2 + (h)) * HTB)
#define PG8_STAGE(bufoff, gbase, voff) do { _Pragma("unroll") for (int _i = 0; _i < 2; ++_i) \
        __builtin_amdgcn_global_load_lds((const unsigned*)((const char*)(gbase) + (voff)[_i]), (LAS unsigned*)(lds + (bufoff) + ldsw + _i * 8192), 16, 0, 0); } while (0)
#define PG8_LDA(dst, b, h) do { _Pragma("unroll") for (int m = 0; m < 4; ++m) _Pragma("unroll") for (int k = 0; k < 2; ++k) dst[m][k] = *(const LAS bf16x8*)(lds + PG8_SA(b, h) + aoff + m * 2048 + k * 1024); } while (0)
#define PG8_LDB(dst, b, h) do { _Pragma("unroll") for (int n = 0; n < 2; ++n) _Pragma("unroll") for (int k = 0; k < 2; ++k) dst[n][k] = *(const LAS bf16x8*)(lds + PG8_SB(b, h) + boff + n * 2048 + k * 1024); } while (0)
#define PG8_MMA(ai, bj, At, Bt) do { __builtin_amdgcn_s_setprio(1); _Pragma("unroll") for (int m = 0; m < 4; ++m) _Pragma("unroll") for (int n = 0; n < 2; ++n) _Pragma("unroll") for (int k = 0; k < 2; ++k) \
        acc[ai][bj][m][n] = __builtin_amdgcn_mfma_f32_16x16x32_bf16(Bt[n][k], At[m][k], acc[ai][bj][m][n], 0, 0, 0); __builtin_amdgcn_s_setprio(0); } while (0)
#define PG8_WAIT_V(n) asm volatile("s_waitcnt vmcnt(" #n ")" ::: "memory")
#define PG8_WAIT_L(n) asm volatile("s_waitcnt lgkmcnt(" #n ")" ::: "memory")
#define PG8_BAR __builtin_amdgcn_s_barrier()
#define PG8_SCHED __builtin_amdgcn_sched_barrier(0)
    Unit cur, nxt; int ui = 0;
    if (!S.next(0, cur)) return;
    f32x4 acc[2][2][4][2];
#pragma unroll
    for (int a = 0; a < 2; ++a)
#pragma unroll
        for (int b = 0; b < 2; ++b)
#pragma unroll
            for (int m = 0; m < 4; ++m)
#pragma unroll
                for (int n = 0; n < 2; ++n) acc[a][b][m][n] = (f32x4){0.f, 0.f, 0.f, 0.f};
    bf16x8 At[4][2], B0[2][2], B1[2][2];
    const char* cA = (const char*)g.A + S.offA(cur); const char* cB = (const char*)g.Bt + S.offB(cur);
    PG8_STAGE(PG8_SB(0, 0), cB, voffB); PG8_STAGE(PG8_SB(0, 1), cB + hstepB, voffB); PG8_STAGE(PG8_SA(0, 0), cA, voffA); PG8_STAGE(PG8_SA(0, 1), cA + hstepA, voffA);
    if (wr == 1) PG8_BAR;
    PG8_WAIT_V(2); PG8_BAR;
    PG8_STAGE(PG8_SB(1, 0), cB + kstep, voffB); PG8_STAGE(PG8_SA(1, 0), cA + kstep, voffA); PG8_STAGE(PG8_SB(1, 1), cB + hstepB + kstep, voffB);
    PG8_WAIT_V(6); PG8_BAR;
    for (;;) {
        const bool has_next = S.next(ui + 1, nxt);
        const char* nA = has_next ? (const char*)g.A + S.offA(nxt) : cA; const char* nB = has_next ? (const char*)g.Bt + S.offB(nxt) : cB;
        for (int t = 0; t < nt; t += 2) {
            const bool last = (t == nt - 2);
            const char* a1 = cA + (size_t)(t + 1) * kstep;
            const char* a2 = last ? nA : cA + (size_t)(t + 2) * kstep; const char* b2 = last ? nB : cB + (size_t)(t + 2) * kstep;
            const char* a3 = a2 + kstep; const char* b3 = b2 + kstep;
            PG8_LDB(B0, 0, 0); PG8_LDB(B1, 0, 1); PG8_SCHED; PG8_LDA(At, 0, 0); PG8_STAGE(PG8_SA(1, 1), a1 + hstepA, voffA);
            PG8_WAIT_V(8); PG8_WAIT_L(0); PG8_BAR; PG8_MMA(0, 0, At, B0); PG8_MMA(0, 1, At, B1); PG8_BAR; PG8_SCHED;
            PG8_LDA(At, 0, 1); PG8_STAGE(PG8_SB(0, 0), b2, voffB); PG8_STAGE(PG8_SB(0, 1), b2 + hstepB, voffB); PG8_STAGE(PG8_SA(0, 0), a2, voffA);
            PG8_WAIT_V(8); PG8_WAIT_L(0); PG8_BAR; PG8_MMA(1, 0, At, B0); PG8_MMA(1, 1, At, B1); PG8_BAR; PG8_SCHED;
            PG8_LDB(B0, 1, 0); PG8_LDB(B1, 1, 1); PG8_SCHED; PG8_LDA(At, 1, 0); PG8_STAGE(PG8_SA(0, 1), a2 + hstepA, voffA);
            PG8_WAIT_V(8); PG8_WAIT_L(0); PG8_BAR; PG8_MMA(0, 0, At, B0); PG8_MMA(0, 1, At, B1); PG8_BAR; PG8_SCHED;
            PG8_LDA(At, 1, 1); PG8_STAGE(PG8_SB(1, 0), b3, voffB); PG8_STAGE(PG8_SB(1, 1), b3 + hstepB, voffB); PG8_STAGE(PG8_SA(1, 0), a3, voffA);
            PG8_WAIT_V(8); PG8_WAIT_L(0); PG8_BAR; PG8_MMA(1, 0, At, B0); PG8_MMA(1, 1, At, B1); PG8_BAR; PG8_SCHED;
        }
        if constexpr (ALIGN_EPI) { if (wr == 0) PG8_BAR; }
        E(acc, cur, wr, wc, fr, fq, lds);
        if (!has_next) break;
#pragma unroll
        for (int a = 0; a < 2; ++a)
#pragma unroll
            for (int b = 0; b < 2; ++b)
#pragma unroll
                for (int m = 0; m < 4; ++m)
#pragma unroll
                    for (int n = 0; n < 2; ++n) acc[a][b][m][n] = (f32x4){0.f, 0.f, 0.f, 0.f};
        cur = nxt; cA = nA; cB = nB; ++ui;
        if constexpr (ALIGN_EPI) { if (wr == 1) PG8_BAR; }
    }
    PG8_WAIT_V(0);
    if constexpr (!ALIGN_EPI) { if (wr == 0) PG8_BAR; }
    PG8_BAR;
#undef PG8_SA
#undef PG8_SB
#undef PG8_STAGE
#undef PG8_LDA
#undef PG8_LDB
#undef PG8_MMA
#undef PG8_WAIT_V
#undef PG8_WAIT_L
#undef PG8_BAR
#undef PG8_SCHED
}
}

struct KVSched {
    int c, G; const char* ws;
    __device__ __forceinline__ bool next(int i, pg8::Unit& u) const {
        const int L = i * G + c; if (c < 0 || L >= 96) return false;
        const int kind = L >> 5, r = L & 31;
        if (kind < 2) { u.pm = kind * 16 + (r >> 2); u.pn = r & 3; } else { u.pm = 32 + (r >> 3); u.pn = r & 7; }
        return true;
    }
    __device__ __forceinline__ size_t offA(const pg8::Unit& u) const { const int kind = u.pm >> 4, pm = u.pm & 15; int k2 = (kind == 2); asm volatile("" : "+v"(k2));
        return (size_t)ws + WS_MEMB + (size_t)k2 * (WS_WV - WS_MEMB) + (size_t)pm * 256 * 1024 * 2; }
    __device__ __forceinline__ size_t offB(const pg8::Unit& u) const { const int kind = u.pm >> 4; int k1 = (kind == 1), k2 = (kind == 2); asm volatile("" : "+v"(k1), "+v"(k2));
        return (size_t)ws + WS_WK + (size_t)k1 * (WS_WV - WS_WK) + (size_t)k2 * (WS_MEMB - WS_WK) + (size_t)u.pn * 256 * 1024 * 2; }
};


#define XB_TMO      128
#define XB_XCNT(j)  (256  + 64 * (j))
#define XB_XSUB(j)  (1280 + 64 * (j))
#define XB_XGEN(j)  (2304 + 64 * (j))
#define XB_TOP      3328
#define XB_TOPGEN   3392
#define XCD_BAR_WORDS 3456
#define XB_SPIN_CAP (1u << 22)
__device__ __forceinline__ unsigned xb_ld(unsigned* p)              { return __hip_atomic_load(p, __ATOMIC_RELAXED, __HIP_MEMORY_SCOPE_AGENT); }
__device__ __forceinline__ unsigned xb_add(unsigned* p, unsigned v) { return __hip_atomic_fetch_add(p, v, __ATOMIC_RELAXED, __HIP_MEMORY_SCOPE_AGENT); }
__device__ __forceinline__ unsigned xb_xcc_id() { return (unsigned)__builtin_amdgcn_s_getreg((3 << 11) | 20) & 0xFu; }
#define XB_SPIN(cond, bar) do { unsigned _sp = 0; while (cond) { __builtin_amdgcn_s_sleep(1); \
    if ((++_sp & 255u) == 0u) { if (xb_ld(&(bar)[XB_TMO])) break; if (_sp > XB_SPIN_CAP) { atomicAdd(&(bar)[XB_TMO], 1u); break; } } } } while (0)
struct XcdBarrier { unsigned* bar; unsigned x; volatile LAS unsigned* st; };
__device__ __forceinline__ void xcd_barrier_complete(unsigned* bar, unsigned x, unsigned& nloc, unsigned& nx) {
    const unsigned G = gridDim.x * gridDim.y * gridDim.z;
    unsigned sum, cnt, mine, sp = 0u;
    for (;;) {
        sum = 0u; cnt = 0u; mine = 0u;
#pragma unroll
        for (unsigned j = 0; j < 16; ++j) { const unsigned c = xb_ld(&bar[XB_XCNT(j)]); sum += c; cnt += (c > 0u) ? 1u : 0u; mine = (j == x) ? c : mine; }
        if (sum == G) break;
        __builtin_amdgcn_s_sleep(1);
        if ((++sp & 255u) == 0u) { if (xb_ld(&bar[XB_TMO])) break; if (sp > XB_SPIN_CAP) { atomicAdd(&bar[XB_TMO], 1u); break; } }
    }
    nloc = mine > 0u ? mine : 1u; nx = cnt > 0u ? cnt : 1u;
}
__device__ __forceinline__ void xcd_barrier(const XcdBarrier& b) {
    asm volatile("s_waitcnt vmcnt(0)" ::: "memory");
    __syncthreads();
    if (threadIdx.x == 0) {
        unsigned* bar = b.bar;
        __builtin_amdgcn_s_waitcnt(0);
        unsigned nloc = b.st[0], nx = b.st[1];
        if (nloc == 0u) { xcd_barrier_complete(bar, b.x, nloc, nx); b.st[0] = nloc; b.st[1] = nx; }
        const unsigned old = xb_add(&bar[XB_XSUB(b.x)], 1u);
        const unsigned gen = old / nloc;
        if (old + 1u == (gen + 1u) * nloc) {
            __builtin_amdgcn_fence(__ATOMIC_RELEASE, "agent");
            asm volatile("s_waitcnt vmcnt(0)" ::: "memory");
            const unsigned og = xb_add(&bar[XB_TOP], 1u);
            const unsigned tg = og / nx;
            if (og + 1u == (tg + 1u) * nx) xb_add(&bar[XB_TOPGEN], 1u);
            else XB_SPIN(xb_ld(&bar[XB_TOPGEN]) == tg, bar);
            __builtin_amdgcn_fence(__ATOMIC_ACQUIRE, "agent");
            xb_add(&bar[XB_XGEN(b.x)], 1u);
            asm volatile("s_waitcnt vmcnt(0)" ::: "memory");
        } else {
            XB_SPIN(xb_ld(&bar[XB_XGEN(b.x)]) == gen, bar);
            __builtin_amdgcn_fence(__ATOMIC_ACQUIRE, "agent");
            asm volatile("s_waitcnt vmcnt(0)" ::: "memory");
        }
    }
    __syncthreads();
}

__device__ __forceinline__ void transpose_item(const float* W, int K, int N, bf16_t* WT, LAS float* scr, int item, int lane, const float* gain = nullptr, int gu = 0) {
    const int nblk = N / 32, kb = item / nblk, nb = item % nblk, k0 = 64 * kb, n0 = 32 * nb;
    {
        f32x4 v[8];
#pragma unroll
        for (int i = 0; i < 8; ++i) v[i] = *(const f32x4*)(W + (size_t)(k0 + (lane >> 3) + 8 * i) * N + n0 + (lane & 7) * 4);
#pragma unroll
        for (int i = 0; i < 8; ++i) { const int kk = (lane >> 3) + 8 * i; f32x4 w = v[i]; if (gain) w = w * gain[k0 + kk];
            LAS float* d = scr + kk * 33 + (lane & 7) * 4; d[0] = w[0]; d[1] = w[1]; d[2] = w[2]; d[3] = w[3]; }
    }
    LDS_WAIT();
    const int c = lane & 7;
#pragma unroll
    for (int j = 0; j < 4; ++j) { const int n = (lane >> 3) + 8 * j; const LAS float* s = scr + (8 * c) * 33 + n;
        u32x4 o; o.x = pk2(s[0 * 33], s[1 * 33]); o.y = pk2(s[2 * 33], s[3 * 33]); o.z = pk2(s[4 * 33], s[5 * 33]); o.w = pk2(s[6 * 33], s[7 * 33]);
        int drow = n0 + n; if (gu) { const int up = drow >= gu, f = up ? drow - gu : drow; drow = ((f >> 7) << 8) + (up << 7) + (f & 127); }
        *(u32x4*)(WT + (size_t)drow * K + k0 + 8 * c) = o; }
    LDS_WAIT();
}

__device__ __forceinline__ void first_rows(const float* Xp, const float* Xs, bf16_t* XNo, float* ss, int gw, int NGW, int lane) {
    for (int m = gw; m < MT; m += NGW) {
        const f32x4* xr = (const f32x4*)(m < MP ? Xp + (size_t)m * D : Xs + (size_t)(m - MP) * D) + lane;
        f32x4 v[4]; float s = 0.f;
#pragma unroll
        for (int j = 0; j < 4; ++j) { v[j] = xr[64 * j]; s += (v[j].x * v[j].x + v[j].y * v[j].y) + (v[j].z * v[j].z + v[j].w * v[j].w); }
        s = wave_sum(s, lane);
        if (lane < 4) ss[(size_t)m * 4 + lane] = lane == 0 ? s : 0.f;
        u32x2* o8 = (u32x2*)(XNo + (size_t)m * D) + lane;
#pragma unroll
        for (int j = 0; j < 4; ++j) { u32x2 w; w.x = pk2(v[j].x, v[j].y); w.y = pk2(v[j].z, v[j].w); o8[64 * j] = w; }
    }
}

typedef __attribute__((address_space(4))) const unsigned char* kptr_t;
typedef const float* cfp_t; typedef float* fp_t; typedef unsigned char* ucp_t;
#define INP(k) (*(const __attribute__((address_space(4))) cfp_t*)(kp + 8 * (k)))
#define X out
#define WIN_T ((bf16_t*)(ws + WS_WIN))
#define WOUT_T ((bf16_t*)(ws + WS_WOUT))
#define WQ_T ((bf16_t*)(ws + WS_WQ))
#define WK_T ((bf16_t*)(ws + WS_WK))
#define WV_T ((bf16_t*)(ws + WS_WV))
#define WO_T ((bf16_t*)(ws + WS_WO))
#define WUP_T ((bf16_t*)(ws + WS_WUP))
#define WDN_T ((bf16_t*)(ws + WS_WDN))
#define MEMB ((bf16_t*)(ws + WS_MEMB))
#define KBP ((bf16_t*)(ws + WS_KBP))
#define VTP ((bf16_t*)(ws + WS_VTP))
#define KBS ((bf16_t*)(ws + WS_KBS))
#define VTS ((bf16_t*)(ws + WS_VTS))
#define WST ((bf16_t*)(ws + WS_WST))
#define AGG ((float*)(ws + WS_AGG))
#define SSQ(i) ((float*)(ws + WS_SSP) + (size_t)(i) * MT * 4)
#define GT_R ((bf16_t*)(ws + WS_GT))
#define GT_I ((bf16_t*)(ws + WS_GT + 65536))
#define XN ((bf16_t*)(ws + WS_XN))
#define gZ ((bf16_t*)(ws + B_Z))
#define HLOC ((float*)(ws + B_HLOC))
#define PCUM ((float*)(ws + B_PCUM))
#define gY ((bf16_t*)(ws + B_Y))
#define gQ ((bf16_t*)(ws + B_Q))
#define gP ((bf16_t*)(ws + B_P))
#define gO ((bf16_t*)(ws + B_O))
#define PS ((bf16_t*)(ws + B_PS))
#define GU ((bf16_t*)(ws + B_GU))
#define GUS ((bf16_t*)(ws + B_GUS))
#define SBG ((float*)(ws + B_SBG))
#define SBU ((float*)(ws + B_SBU))
#define SBL ((float*)(ws + B_SBL))
__global__ void __launch_bounds__(NTHREADS, 2) trunk_fwd(Args args) {
    extern __shared__ __attribute__((aligned(16))) unsigned char lds_raw[];
    LAS unsigned char* lds = (LAS unsigned char*)lds_raw;
    cg::grid_group grid = cg::this_grid();
    const int wave_s = __builtin_amdgcn_readfirstlane(threadIdx.x >> 6);
#define LANE_STATE() int G = gridDim.x, bid = blockIdx.x; asm volatile("" : "+s"(G), "+s"(bid)); const int NGW = G * NWAVES, NGT = G * NTHREADS; (void)NGW; (void)NGT; \
    const int tid = opaque_tid(wave_s), lane = tid & 63, wave = wave_s; const int gw = bid * NWAVES + wave; const int gt = bid * NTHREADS + tid; (void)lane; (void)gw; (void)gt; \
    kptr_t kp = (kptr_t)__builtin_amdgcn_kernarg_segment_ptr(); asm volatile("" : "+s"(kp)); \
    float* const out = *(const __attribute__((address_space(4))) fp_t*)(kp + 8 * N_IN); unsigned char* const ws = *(const __attribute__((address_space(4))) ucp_t*)(kp + 8 * N_IN + 8); (void)out; (void)ws
    {
        LANE_STATE();
        if (bid == 0) for (int i = tid; i < XCD_BAR_WORDS; i += NTHREADS) __hip_atomic_store((unsigned*)(ws + WS_BAR) + i, 0u, __ATOMIC_RELAXED, __HIP_MEMORY_SCOPE_AGENT);
        if (tid < 32) ((LAS unsigned*)(lds + LDS_MISC))[tid] = 0u;
        __threadfence();
        grid.sync();
        if (tid == 0) (void)xb_add((unsigned*)(ws + WS_BAR) + XB_XCNT(xb_xcc_id()), 1u);
    }
#define GRID_SYNC() do { kptr_t kp_ = (kptr_t)__builtin_amdgcn_kernarg_segment_ptr(); asm volatile("" : "+s"(kp_)); \
        XcdBarrier b_; b_.bar = (unsigned*)(*(const __attribute__((address_space(4))) ucp_t*)(kp_ + 8 * N_IN + 8) + WS_BAR); b_.x = xb_xcc_id(); b_.st = (volatile LAS unsigned*)(lds + LDS_MISC); \
        xcd_barrier(b_); if (PROBE == 3) xcd_barrier(b_); } while (0)

    for (int l = 0; l < DEPTH; ++l) {
        for (int dup0 = 0; dup0 < ((PROBE == 1 || PROBE == 5) ? 2 : 1); ++dup0) {
        {
            LANE_STATE();
            LAS float* scr = (LAS float*)(lds + wave * 16384);
            const float* w_in = INP(I_WIN) + (size_t)l * D * INC; const float* w_out = INP(I_WOUT) + (size_t)l * D * D; const float* w_q = INP(I_WQ) + (size_t)l * D * D;
            const float* w_k = INP(I_WK) + (size_t)l * D * D; const float* w_v = INP(I_WV) + (size_t)l * D * D; const float* w_o = INP(I_WO) + (size_t)l * D * D;
            const float* w_up = INP(I_WUP) + (size_t)l * D * 2 * DFF; const float* w_dn = INP(I_WDN) + (size_t)l * DFF * D; const float* c_v = INP(I_CV) + (size_t)l * BS * NMEM * D;
            constexpr int T_IN = 16 * (INC / 32), T_SQ = 16 * 32, T_UP = 16 * (2 * DFF / 32), T_DN = (DFF / 64) * 32, T_CV = 32 * 32;
            constexpr int T_G = 16;
            constexpr int NIT = T_IN + 5 * T_SQ + T_UP + T_DN + T_CV + 2 * T_G;
            for (int it = gw; it < NIT; it += NGW) {
                int r = it;
                if (r < T_IN) { transpose_item(w_in, D, INC, WIN_T, scr, r, lane, INP(I_GMIX) + l * D); continue; } r -= T_IN;
                if (r < T_SQ) { transpose_item(w_out, D, D, WOUT_T, scr, r, lane); continue; } r -= T_SQ;
                if (r < T_SQ) { transpose_item(w_q, D, D, WQ_T, scr, r, lane, INP(I_GX) + l * D); continue; } r -= T_SQ;
                if (r < T_SQ) { transpose_item(w_k, D, D, WK_T, scr, r, lane); continue; } r -= T_SQ;
                if (r < T_SQ) { transpose_item(w_v, D, D, WV_T, scr, r, lane); continue; } r -= T_SQ;
                if (r < T_SQ) { transpose_item(w_o, D, D, WO_T, scr, r, lane); continue; } r -= T_SQ;
                if (r < T_UP) { transpose_item(w_up, D, 2 * DFF, WUP_T, scr, r, lane, INP(I_GFFN) + l * D, DFF); continue; } r -= T_UP;
                if (r < T_DN) { transpose_item(w_dn, DFF, D, WDN_T, scr, r, lane); continue; } r -= T_DN;
                if (r < T_CV) { transpose_item(c_v, BS * NMEM, D, VTS, scr, r, lane); continue; } r -= T_CV;
                if (r < T_G) { transpose_item(INP(I_WRG) + ((size_t)l * 8 + (r >> 1)) * 4096, 64, 64, GT_R + (r >> 1) * 4096, scr, r & 1, lane); continue; } r -= T_G;
                transpose_item(INP(I_WIG) + ((size_t)l * 8 + (r >> 1)) * 4096, 64, 64, GT_I + (r >> 1) * 4096, scr, r & 1, lane);
            }
            {
                const f32x4* ck = (const f32x4*)(INP(I_CK) + (size_t)l * BS * NMEM * D); u32x2* dk = (u32x2*)KBS;
                for (int i = gt; i < BS * NMEM * D / 4; i += NGT) { const f32x4 v = ck[i]; u32x2 w; w.x = pk2(v.x, v.y); w.y = pk2(v.z, v.w); dk[i] = w; }
                if (l == 0) { const f32x4* mm = (const f32x4*)INP(I_MEM); u32x2* dm = (u32x2*)MEMB;
                    for (int i = gt; i < BP * NMEM * D / 4; i += NGT) { const f32x4 v = mm[i]; u32x2 w; w.x = pk2(v.x, v.y); w.y = pk2(v.z, v.w); dm[i] = w; } }
                const float* wsl = INP(I_WS) + (size_t)l * 4 * 128 * 128;
                for (int i = gt; i < 4 * 128 * 128; i += NGT) { const int s = i & 127, t = (i >> 7) & 127; WST[i] = (bf16_t)f2bf(s <= t ? wsl[i] : 0.f); }
            }
            if (l == 0) first_rows(INP(I_XP), INP(I_XS), XN, SSQ(0), gw, NGW, lane);
        }
        GRID_SYNC();
        }
        {
            LANE_STATE();
            KVSched S; S.G = G; S.c = bid >= 160 ? bid - 160 : -1; S.ws = (const char*)ws;
            pg8::Gemm g{(const bf16_t*)nullptr, (const bf16_t*)nullptr, D, D, D};
            pg8::EpiKV E{out + O_MKP + (size_t)l * BP * NMEM * D, out + O_MVP + (size_t)l * BP * NMEM * D, KBP, VTP};
            pg8::gemm_phase<pg8::EpiKV, KVSched, true>(lds, g, S, E, wave_s);
        }
#define GEMM_BF16(s_) do { const int s = (s_); pg8::GSched S; pg8::Gemm g; pg8::EpiBf16 E; E.scale = 1.f; E.ss = nullptr; E.smp = 0; \
        if (s == 0) { S.init(MT / 256, INC / 256, G, bid); S.aPm = (size_t)256 * D * 2; S.bPn = (size_t)256 * D * 2; g = pg8::Gemm{XN, WIN_T, D, D, D}; E.O = gZ; E.ldc = INC; E.ss = SSQ(3 * l); } \
        else if (s == 1) { S.init(MT / 256, D / 256, G, bid); S.aPm = (size_t)256 * D * 2; S.bPn = (size_t)256 * D * 2; g = pg8::Gemm{XN, WQ_T, D, D, D}; E.O = gQ; E.ldc = D; E.scale = 0.0625f; E.ss = SSQ(3 * l + 1); } \
        else if (s == 2) { S.init(MP / 256, 4, G, bid); S.aPm = (size_t)256 * D * 2; S.aPn = 512; S.bPn = (size_t)256 * 2048 * 2; S.bPm = 512; S.bShift = 4; g = pg8::Gemm{gP, VTP, D, 2048, 256}; E.O = gO; E.ldc = D; } \
        else { S.init(1, 32, G, (bid + G - 64) % G); S.mode = 2; g = pg8::Gemm{PS, VTS, 8192, 2048, 256}; E.O = gO + (size_t)MP * D; E.ldc = D; E.smp = 1; } \
        pg8::gemm_phase<pg8::EpiBf16, pg8::GSched, true>(lds, g, S, E, wave_s); } while (0)
#define GEMM_RES(s_) do { const int s = (s_); pg8::GSched S; S.init(MT / 256, D / 256, G, bid); pg8::Gemm g; \
        if (s == 0) { g = pg8::Gemm{gY, WOUT_T, D, D, D}; S.aPm = (size_t)256 * D * 2; } \
        else if (s == 1) { g = pg8::Gemm{gO, WO_T, D, D, D}; S.aPm = (size_t)256 * D * 2; } \
        else { g = pg8::Gemm{GU, WDN_T, DFF, DFF, DFF}; S.aPm = (size_t)256 * DFF * 2; } \
        S.bPn = (size_t)256 * g.ldb * 2; \
        pg8::EpiResid E{XN, SSQ(3 * l + 1 + s)}; \
        pg8::gemm_phase<pg8::EpiResid, pg8::GSched, true>(lds, g, S, E, wave_s); } while (0)

        for (int rep = 0; rep < 13; ++rep) { if (rep == 4 || rep == 9 || rep == 11) continue;
          const int ndup = ((PROBE == 1 && (rep == 1 || rep == 2)) || (PROBE == 4 && rep == 1) || (PROBE == 6 && rep == 2)) ? 2 : ((PROBE == 2 && (rep == 0 || rep == 5 || rep == 6 || rep == 7 || rep == 10)) ? 2 : 1);
          for (int dup = 0; dup < ndup; ++dup) {
            if (rep == 0 || rep == 5 || rep == 7) {
                LANE_STATE();
                const int s0 = rep == 0 ? 0 : (rep == 5 ? 1 : 2), ns = rep == 7 ? 2 : 1;
                for (int q = 0; q < ns; ++q) GEMM_BF16(s0 + q);
            } else if (rep == 10) {
                LANE_STATE();
                pg8::GSched S; S.init(MT / 256, 2 * DFF / 256, G, bid); S.aPm = (size_t)256 * D * 2; S.bPn = (size_t)256 * D * 2;
                const pg8::Gemm g{XN, WUP_T, D, D, D};
                const pg8::EpiAct E{GU, INP(I_SCF) + (size_t)l * BS * 2 * DFF, out + O_CFS + (size_t)l * BS * 2 * DFF, SBG, SBU, SBL, INP(I_CFW) + (size_t)l * 3 * DFF, SSQ(3 * l + 2)};
                pg8::gemm_phase<pg8::EpiAct, pg8::GSched, true>(lds, g, S, E, wave_s);
            } else if (rep == 1) {
                LANE_STATE();
                {
                    LAS bf16_t* vT = (LAS bf16_t*)lds;
                    constexpr int VP = 136;
                    const float* gvp = INP(I_GV) + l * CW; const float* bsp = INP(I_BSS) + l * 4 * 128;
                    for (int un = bid; un < 8 + 256; un += G) {
                        int rowbase, nrows, sb = -1;
                        if (un < 8) { sb = un; rowbase = MP + un * TS; nrows = TS; } else { rowbase = (un - 8) * 128; nrows = 128; }
                        {
                            const int rl = tid >> 5, cgp = tid & 31;
                            f32x4 g0 = *(const f32x4*)(gvp + cgp * 8), g1 = *(const f32x4*)(gvp + cgp * 8 + 4);
                            for (int p = 0; p < nrows / 16; ++p) {
                                const int r = p * 16 + rl;
                                const u32x4 raw = *(const u32x4*)(gZ + (size_t)(rowbase + r) * INC + Z_VC + cgp * 8);
                                float v[8] = {bflo(raw.x), bfhi(raw.x), bflo(raw.y), bfhi(raw.y), bflo(raw.z), bfhi(raw.z), bflo(raw.w), bfhi(raw.w)};
                                float ss = 0.f;
#pragma unroll
                                for (int k = 0; k < 8; ++k) { v[k] = gelu_t(v[k]); ss += v[k] * v[k]; }
                                ss += shx(ss, 1, lane); ss += shx(ss, 2, lane); ss += shx(ss, 4, lane);
                                const float rstd = 1.0f / sqrtf(ss * (1.f / 64.f) + EPS);
                                const float gg[8] = {g0.x, g0.y, g0.z, g0.w, g1.x, g1.y, g1.z, g1.w};
#pragma unroll
                                for (int k = 0; k < 8; ++k) { v[k] = v[k] * rstd * gg[k]; vT[(cgp * 8 + k) * VP + r] = (bf16_t)f2bf(v[k]); }
                                if (sb >= 0) { float* vo = out + O_VCS + ((size_t)(l * BS + sb) * TS + r) * CW + cgp * 8;
                                    *(f32x4*)vo = (f32x4){v[0], v[1], v[2], v[3]}; *(f32x4*)(vo + 4) = (f32x4){v[4], v[5], v[6], v[7]}; }
                            }
                        }
                        __syncthreads();
                        {
                            const int hh = wave & 3, rh = wave >> 2, fr = lane & 15, fq = lane >> 4;
                            const int nmt = nrows == 128 ? 4 : (rh == 0 ? 2 : 0);
                            for (int mi = 0; mi < nmt; ++mi) {
                                const int mt = rh * 4 + mi, nks = (mt * 16 + 15) / 32 + 1;
                                f32x4 acc[4];
#pragma unroll
                                for (int n = 0; n < 4; ++n) acc[n] = (f32x4){0.f, 0.f, 0.f, 0.f};
                                for (int ks = 0; ks < nks; ++ks) {
                                    const bf16x8 a = *(const bf16x8*)(WST + ((size_t)(hh * 128 + mt * 16 + fr) * 128 + ks * 32 + fq * 8));
#pragma unroll
                                    for (int n = 0; n < 4; ++n) { const bf16x8 b = *(const LAS bf16x8*)(vT + (hh * 64 + n * 16 + fr) * VP + ks * 32 + fq * 8);
                                        acc[n] = __builtin_amdgcn_mfma_f32_16x16x32_bf16(b, a, acc[n], 0, 0, 0); }
                                }
                                { const int t = mt * 16 + fr; const float bias = bsp[hh * 128 + t]; const size_t row = (size_t)(rowbase + t);
#pragma unroll
                                    for (int n = 0; n < 4; ++n) { const int c = hh * 64 + n * 16 + fq * 4; const u32x2 uq = *(const u32x2*)(gZ + row * INC + Z_UC + c);
                                        u32x2 w; w.x = pk2(gelu_t(bflo(uq.x)) * (acc[n][0] + bias), gelu_t(bfhi(uq.x)) * (acc[n][1] + bias)); w.y = pk2(gelu_t(bflo(uq.y)) * (acc[n][2] + bias), gelu_t(bfhi(uq.y)) * (acc[n][3] + bias));
                                        *(u32x2*)(gY + row * D + 768 + c) = w; } }
                            }
                        }
                        __syncthreads();
                    }
                }
                {
                    LAS unsigned char* wl = lds + wave * 16384;
                    LAS bf16_t* tile = (LAS bf16_t*)wl;
                    LAS float* pre_r = (LAS float*)(wl + 2560);
                    LAS float* pre_i = (LAS float*)(wl + 2560 + 4096);
                    LAS float* xcf = (LAS float*)(wl + 2560 + 8192);
                    const int fr = lane & 15, fq = lane >> 4;
                    for (int un = gw; un < 64 + 2048; un += NGW) {
                        int b, hd, rowbase, nrows, t0; bool smp = un < 64;
                        if (smp) { b = un >> 3; hd = un & 7; rowbase = MP + b * TS; nrows = TS; t0 = 0; }
                        else { const int v = un - 64; const int ch = v & 31; hd = (v >> 5) & 7; b = v >> 8; t0 = ch * 128; rowbase = b * SEQ + t0; nrows = 128; }
                        const int cidx = l * AW + hd * 64 + lane;
                        const float br = INP(I_BRG)[cidx], bi = INP(I_BIG)[cidx];
                        const float c8sp = 8.0f * log1pf(__expf(-INP(I_LAM)[cidx]));
                        const float* caw = INP(I_CAW) + (size_t)l * 4 * AW + hd * 64 + lane;
                        const float cw0 = caw[0], cw1 = caw[AW], cw2 = caw[2 * AW], cw3 = caw[3 * AW], cb = INP(I_CAB)[cidx];
                        bf16x8 bR[4][2], bI[4][2];
#pragma unroll
                        for (int n = 0; n < 4; ++n)
#pragma unroll
                            for (int ks = 0; ks < 2; ++ks) { const size_t o_ = (size_t)(hd * 64 + n * 16 + fr) * 64 + ks * 32 + fq * 8;
                                bR[n][ks] = *(const bf16x8*)(GT_R + o_); bI[n][ks] = *(const bf16x8*)(GT_I + o_); }
                        float xm3 = 0.f, xm2 = 0.f, xm1 = 0.f;
                        if (smp) { const float* st = INP(I_SCA) + ((size_t)(l * BS + b) * 3) * AW + hd * 64 + lane; xm3 = st[0]; xm2 = st[AW]; xm1 = st[2 * AW]; }
                        else if (t0 > 0) { const bf16_t* zp = gZ + (size_t)(rowbase - 3) * INC + Z_XA + hd * 64 + lane; xm3 = bf2f(zp[0]); xm2 = bf2f(zp[INC]); xm1 = bf2f(zp[2 * INC]); }
                        float h = 0.f, pc = 1.f;
                        const bf16_t* zq = gZ + (size_t)(rowbase + (lane >> 3)) * INC + Z_XA + hd * 64 + (lane & 7) * 8;
                        float* hp = HLOC + (size_t)rowbase * AW + hd * 64 + lane; float* pp = PCUM + (size_t)rowbase * AW + hd * 64 + lane;
                        LAS bf16_t* xraw = (LAS bf16_t*)pre_r;
                        u32x4 xn0 = *(const u32x4*)zq, xn1 = *(const u32x4*)(zq + (size_t)8 * INC);
                        for (int st = 0; st < nrows / 16; ++st) {
                            *(LAS u32x4*)(xraw + (lane >> 3) * 64 + (lane & 7) * 8) = xn0; *(LAS u32x4*)(xraw + ((lane >> 3) + 8) * 64 + (lane & 7) * 8) = xn1;
                            zq += (size_t)16 * INC;
                            if (st + 1 < nrows / 16) { xn0 = *(const u32x4*)zq; xn1 = *(const u32x4*)(zq + (size_t)8 * INC); }
                            LDS_WAIT();
#pragma unroll
                            for (int i = 0; i < 16; ++i) { const float xv = bf2f(xraw[i * 64 + lane]);
                                const float xc = cw0 * xm3 + cw1 * xm2 + cw2 * xm1 + cw3 * xv + cb; xm3 = xm2; xm2 = xm1; xm1 = xv; xcf[i * 64 + lane] = xc; tile[i * 72 + lane] = (bf16_t)f2bf(xc); }
                            LDS_WAIT();
                            const bf16x8 a0 = *(const LAS bf16x8*)(tile + fr * 72 + fq * 8), a1 = *(const LAS bf16x8*)(tile + fr * 72 + 32 + fq * 8);
#pragma unroll
                            for (int n = 0; n < 4; ++n) {
                                f32x4 ar = (f32x4){0.f, 0.f, 0.f, 0.f}, ai = (f32x4){0.f, 0.f, 0.f, 0.f};
                                ar = __builtin_amdgcn_mfma_f32_16x16x32_bf16(a0, bR[n][0], ar, 0, 0, 0); ar = __builtin_amdgcn_mfma_f32_16x16x32_bf16(a1, bR[n][1], ar, 0, 0, 0);
                                ai = __builtin_amdgcn_mfma_f32_16x16x32_bf16(a0, bI[n][0], ai, 0, 0, 0); ai = __builtin_amdgcn_mfma_f32_16x16x32_bf16(a1, bI[n][1], ai, 0, 0, 0);
#pragma unroll
                                for (int j = 0; j < 4; ++j) { pre_r[(fq * 4 + j) * 64 + n * 16 + fr] = ar[j]; pre_i[(fq * 4 + j) * 64 + n * 16 + fr] = ai[j]; }
                            }
                            LDS_WAIT();
#pragma unroll 4
                            for (int i = 0; i < 16; ++i) {
                                const float r = sigm(pre_r[i * 64 + lane] + br), gi = sigm(pre_i[i * 64 + lane] + bi);
                                const float la = -c8sp * r; float a, om;
                                if (la > -0.125f) { const float x = 2.0f * la; om = -x * (1.0f + x * (0.5f + x * (0.16666667f + x * (0.041666668f + x * (0.0083333338f + x * 0.0013888889f))))); a = 1.0f + la * (1.0f + la * (0.5f + la * (0.16666667f + la * (0.041666668f + la * 0.0083333338f)))); }
                                else { a = __expf(la); om = -expm1f(2.0f * la); }
                                const float bm = sqrtf(om);
                                h = a * h + bm * gi * xcf[i * 64 + lane]; pc = pc * a;
                                *hp = h; *pp = pc; hp += AW; pp += AW;
                            }
                            LDS_WAIT();
                        }
                        AGG[(size_t)un * 128 + lane] = pc; AGG[(size_t)un * 128 + 64 + lane] = h;
                    }
                }
                {
                    const float* cbw = INP(I_CBW) + (size_t)l * 3 * BW;
                    for (int it = gt; it < (MT / 8) * 32; it += NGT) {
                        const int rb = it >> 5, c0 = (it & 31) * 8;
                        int b, t0, T, rowbase; const bool smp = rb >= MP / 8;
                        if (!smp) { b = rb >> 9; t0 = (rb & 511) * 8; T = SEQ; rowbase = rb * 8; } else { const int sbk = rb - MP / 8; b = sbk >> 2; t0 = (sbk & 3) * 8; T = TS; rowbase = MP + sbk * 8; }
                        u32x4 xq[10], cq[10], bq[8];
                        const bf16_t* zr = gZ + (size_t)rowbase * INC + c0;
#pragma unroll
                        for (int i = 0; i < 10; ++i) { if (i >= 2 || t0 > 0) { xq[i] = *(const u32x4*)(zr + (ptrdiff_t)(i - 2) * INC + Z_XB); cq[i] = *(const u32x4*)(zr + (ptrdiff_t)(i - 2) * INC + Z_GC); } else { xq[i] = (u32x4){0u, 0u, 0u, 0u}; cq[i] = (u32x4){0u, 0u, 0u, 0u}; } }
#pragma unroll
                        for (int i = 0; i < 8; ++i) bq[i] = *(const u32x4*)(zr + (size_t)i * INC + Z_GB);
                        float w0[8], w1[8], w2[8], pm2[8], pm1[8];
#pragma unroll
                        for (int k = 0; k < 8; ++k) { w0[k] = cbw[c0 + k]; w1[k] = cbw[BW + c0 + k]; w2[k] = cbw[2 * BW + c0 + k]; }
                        {
                            const float a_[8] = {bflo(xq[0].x) * bflo(cq[0].x), bfhi(xq[0].x) * bfhi(cq[0].x), bflo(xq[0].y) * bflo(cq[0].y), bfhi(xq[0].y) * bfhi(cq[0].y), bflo(xq[0].z) * bflo(cq[0].z), bfhi(xq[0].z) * bfhi(cq[0].z), bflo(xq[0].w) * bflo(cq[0].w), bfhi(xq[0].w) * bfhi(cq[0].w)};
                            const float b_[8] = {bflo(xq[1].x) * bflo(cq[1].x), bfhi(xq[1].x) * bfhi(cq[1].x), bflo(xq[1].y) * bflo(cq[1].y), bfhi(xq[1].y) * bfhi(cq[1].y), bflo(xq[1].z) * bflo(cq[1].z), bfhi(xq[1].z) * bfhi(cq[1].z), bflo(xq[1].w) * bflo(cq[1].w), bfhi(xq[1].w) * bfhi(cq[1].w)};
#pragma unroll
                            for (int k = 0; k < 8; ++k) { pm2[k] = a_[k]; pm1[k] = b_[k]; }
                        }
                        if (t0 == 0 && smp) { const float* st = INP(I_SCB) + ((size_t)(l * BS + b) * 2) * BW + c0;
#pragma unroll
                            for (int k = 0; k < 8; ++k) { pm2[k] = st[k]; pm1[k] = st[BW + k]; } }
#pragma unroll
                        for (int i = 0; i < 8; ++i) {
                            const u32x4 xb = xq[i + 2], gc = cq[i + 2], gb = bq[i];
                            const float pv[8] = {bflo(xb.x) * bflo(gc.x), bfhi(xb.x) * bfhi(gc.x), bflo(xb.y) * bflo(gc.y), bfhi(xb.y) * bfhi(gc.y), bflo(xb.z) * bflo(gc.z), bfhi(xb.z) * bfhi(gc.z), bflo(xb.w) * bflo(gc.w), bfhi(xb.w) * bfhi(gc.w)};
                            const float gbv[8] = {bflo(gb.x), bfhi(gb.x), bflo(gb.y), bfhi(gb.y), bflo(gb.z), bfhi(gb.z), bflo(gb.w), bfhi(gb.w)};
                            float yv[8];
#pragma unroll
                            for (int k = 0; k < 8; ++k) { yv[k] = gbv[k] * (w0[k] * pm2[k] + w1[k] * pm1[k] + w2[k] * pv[k]); pm2[k] = pm1[k]; pm1[k] = pv[k]; }
                            u32x4 w; w.x = pk2(yv[0], yv[1]); w.y = pk2(yv[2], yv[3]); w.z = pk2(yv[4], yv[5]); w.w = pk2(yv[6], yv[7]);
                            *(u32x4*)(gY + (size_t)(rowbase + i) * D + 512 + c0) = w;
                        }
                        if (t0 + 8 == T) { float* o = out + (smp ? O_CBS : O_CBP) + ((size_t)(l * 8 + b) * 2) * BW + c0;
#pragma unroll
                            for (int k = 0; k < 8; ++k) { o[k] = pm2[k]; o[BW + k] = pm1[k]; } }
                    }
                }
            } else if (rep == 2) {
                LANE_STATE();
                {
                    LAS float* cr = (LAS float*)lds;
                    for (int un = bid; un < 8 + 256; un += G) {
                        int b, ch, rowbase, nrows; const bool smp = un < 8;
                        if (smp) { b = un; ch = 0; rowbase = MP + b * TS; nrows = TS; } else { const int v = un - 8; b = v >> 5; ch = v & 31; rowbase = b * SEQ + ch * 128; nrows = 128; }
                        {
                            const int c = tid, hd = c >> 6, ln = c & 63; float carry = 0.f;
                            if (smp) carry = INP(I_SHA)[(size_t)(l * BS + b) * AW + c];
                            else { const float* ag = AGG + (size_t)(64 + (b << 8) + (hd << 5)) * 128 + ln; for (int k = 0; k < ch; ++k) carry = ag[(size_t)k * 128] * carry + ag[(size_t)k * 128 + 64]; }
                            cr[c] = carry;
                        }
                        __syncthreads();
                        const int c0 = (tid & 63) * 8, rsub = tid >> 6;
                        const f32x4 ca = *(const LAS f32x4*)(cr + c0), cb = *(const LAS f32x4*)(cr + c0 + 4);
                        for (int p = 0; p < nrows / 8; ++p) {
                            const int rloc = p * 8 + rsub; const size_t row = (size_t)(rowbase + rloc);
                            const f32x4 h0 = *(const f32x4*)(HLOC + row * AW + c0), h1 = *(const f32x4*)(HLOC + row * AW + c0 + 4), p0 = *(const f32x4*)(PCUM + row * AW + c0), p1 = *(const f32x4*)(PCUM + row * AW + c0 + 4);
                            const u32x4 gq = *(const u32x4*)(gZ + row * INC + Z_GA + c0);
                            const f32x4 a0 = h0 + p0 * ca, a1 = h1 + p1 * cb;
                            u32x4 w; w.x = pk2(gelu_t(bflo(gq.x)) * a0[0], gelu_t(bfhi(gq.x)) * a0[1]); w.y = pk2(gelu_t(bflo(gq.y)) * a0[2], gelu_t(bfhi(gq.y)) * a0[3]);
                            w.z = pk2(gelu_t(bflo(gq.z)) * a1[0], gelu_t(bfhi(gq.z)) * a1[1]); w.w = pk2(gelu_t(bflo(gq.w)) * a1[2], gelu_t(bfhi(gq.w)) * a1[3]);
                            *(u32x4*)(gY + row * D + c0) = w;
                            if ((smp || ch == 31) && rloc == nrows - 1) { float* o = out + (smp ? O_HAS : O_HAP) + (size_t)(l * 8 + b) * AW + c0; *(f32x4*)o = a0; *(f32x4*)(o + 4) = a1; }
                        }
                        if ((smp || ch == 31) && tid < 192) {
                            const int k = tid >> 6; const u32x4 xq = *(const u32x4*)(gZ + (size_t)(rowbase + nrows - 3 + k) * INC + Z_XA + c0);
                            float* o = out + (smp ? O_CAS : O_CAP) + ((size_t)(l * 8 + b) * 3 + k) * AW + c0;
                            *(f32x4*)o = (f32x4){bflo(xq.x), bfhi(xq.x), bflo(xq.y), bfhi(xq.y)}; *(f32x4*)(o + 4) = (f32x4){bflo(xq.z), bfhi(xq.z), bflo(xq.w), bfhi(xq.w)};
                        }
                        __syncthreads();
                    }
                }
            } else if (rep == 3 || rep == 8 || rep == 12) {
                LANE_STATE();
                if (rep == 12) {
                    const float* cfw = INP(I_CFW) + (size_t)l * 3 * DFF;
                    pg8::GSched S0; S0.init(MT / 256, D / 256, G, bid); pg8::Unit u0;
                    for (int i = 0; S0.next(i, u0); ++i) {
                        const int pm = u0.pm; if (pm >= 128 || tid >= DFF / 8) continue;
                        const int c0 = tid * 8, b = pm >> 4;
                        float w0[8], w1[8], w2[8], p2[8], p1[8], g0[8], g1[8], u0_[8], u1_[8];
#pragma unroll
                        for (int k = 0; k < 8; ++k) { w0[k] = cfw[c0 + k]; w1[k] = cfw[DFF + c0 + k]; w2[k] = cfw[2 * DFF + c0 + k]; p2[k] = 0.f; p1[k] = 0.f; }
                        if ((pm & 15) != 0) {
#pragma unroll
                            for (int k = 0; k < 8; ++k) { p2[k] = SBL[((size_t)(pm - 1) * 2 + 0) * DFF + c0 + k]; p1[k] = SBL[((size_t)(pm - 1) * 2 + 1) * DFF + c0 + k]; } }
#pragma unroll
                        for (int k = 0; k < 8; ++k) { g0[k] = SBG[((size_t)pm * 2 + 0) * DFF + c0 + k]; g1[k] = SBG[((size_t)pm * 2 + 1) * DFF + c0 + k]; u0_[k] = SBU[((size_t)pm * 2 + 0) * DFF + c0 + k]; u1_[k] = SBU[((size_t)pm * 2 + 1) * DFF + c0 + k]; }
                        float ha[8], hb[8];
#pragma unroll
                        for (int k = 0; k < 8; ++k) { ha[k] = silu(w0[k] * p2[k] + w1[k] * p1[k] + w2[k] * g0[k]) * u0_[k]; hb[k] = silu(w0[k] * p1[k] + w1[k] * g0[k] + w2[k] * g1[k]) * u1_[k]; }
                        u32x4 w; w.x = pk2(ha[0], ha[1]); w.y = pk2(ha[2], ha[3]); w.z = pk2(ha[4], ha[5]); w.w = pk2(ha[6], ha[7]);
                        *(u32x4*)(GU + (size_t)(pm * 256) * DFF + c0) = w;
                        w.x = pk2(hb[0], hb[1]); w.y = pk2(hb[2], hb[3]); w.z = pk2(hb[4], hb[5]); w.w = pk2(hb[6], hb[7]);
                        *(u32x4*)(GU + (size_t)(pm * 256 + 1) * DFF + c0) = w;
                        if ((pm & 15) == 15 && u0.pn == 0) { float* o = out + O_CFP + ((size_t)(l * 8 + b) * 2) * DFF + c0;
#pragma unroll
                            for (int k = 0; k < 8; ++k) { o[k] = SBL[((size_t)pm * 2 + 0) * DFF + c0 + k]; o[DFF + k] = SBL[((size_t)pm * 2 + 1) * DFF + c0 + k]; } }
                    }
                    asm volatile("s_waitcnt vmcnt(0)" ::: "memory"); __syncthreads();
                }
                GEMM_RES(rep == 3 ? 0 : (rep == 8 ? 1 : 2));
            } else if (rep == 6) {
                LANE_STATE();
                for (int sub = 0; sub < 2; ++sub) {
                    pg8::GSched S; pg8::Gemm g; pg8::EpiSoftmax E;
                    if (sub == 0) { S.init(MP / 256, 4, G, bid); S.aPm = (size_t)256 * D * 2; S.aPn = 512; S.bPn = 512; S.bPm = (size_t)256 * D * 2; S.bShift = 4; g = pg8::Gemm{gQ, KBP, D, D, 256}; E.O = gP; E.ldc = D; E.smp = 0; }
                    else { S.init(1, 32, G, (bid + G - 64) % G); S.mode = 1; g = pg8::Gemm{gQ + (size_t)MP * D, KBS, D, D, 256}; E.O = PS; E.ldc = 8192; E.smp = 1; }
                    pg8::gemm_phase<pg8::EpiSoftmax, pg8::GSched, true>(lds, g, S, E, wave_s);
                }
            }
            GRID_SYNC();
          }
        }
    }
    {
        LANE_STATE();
        const float* gain = INP(I_GFIN);
        f32x4 gv[4];
#pragma unroll
        for (int j = 0; j < 4; ++j) gv[j] = ((const f32x4*)gain)[lane + 64 * j];
        for (int m = gw; m < MT; m += NGW) {
            f32x4* yr = (f32x4*)(out + (size_t)m * D) + lane; const u32x2* xr = (const u32x2*)(XN + (size_t)m * D) + lane;
            const float rstd = ss_rstd(*(const f32x4*)(SSQ(6) + (size_t)m * 4));
#pragma unroll
            for (int j = 0; j < 4; ++j) { const u32x2 p = xr[64 * j]; yr[64 * j] = (f32x4){bflo(p.x), bfhi(p.x), bflo(p.y), bfhi(p.y)} * rstd * gv[j]; }
        }
    }
}

extern "C" void kernel_launch(void* const* d_in, const int* in_sizes, int n_in, void* d_out, int out_size, void* d_ws, size_t ws_size, hipStream_t stream) {
    static int grid = 0;
    if (grid == 0) {
        if (n_in != N_IN || (size_t)out_size != O_END || ws_size < WS_END) { fprintf(stderr, "kernel_launch: unexpected sizes n_in %d out %d ws %zu (need %zu)\n", n_in, out_size, ws_size, (size_t)WS_END); grid = -1; return; }
        int dev = 0, cus = 0, per_cu = 0;
        (void)hipGetDevice(&dev); (void)hipDeviceGetAttribute(&cus, hipDeviceAttributeMultiprocessorCount, dev);
        if (hipFuncSetAttribute((const void*)trunk_fwd, hipFuncAttributeMaxDynamicSharedMemorySize, LDS_BYTES) != hipSuccess) { fprintf(stderr, "kernel_launch: hipFuncSetAttribute failed\n"); grid = -1; return; }
        if (hipOccupancyMaxActiveBlocksPerMultiprocessor(&per_cu, (const void*)trunk_fwd, NTHREADS, LDS_BYTES) != hipSuccess || per_cu < 1) { fprintf(stderr, "kernel_launch: occupancy query gave %d\n", per_cu); per_cu = 1; }
        (void)hipGetLastError();
        grid = cus * 1;
        if (grid != 256) fprintf(stderr, "kernel_launch: note: %d CUs\n", grid);
    }
    if (grid < 0) return;
    Args a{};
    for (int i = 0; i < N_IN; ++i) a.in[i] = (const float*)d_in[i];
    a.out = (float*)d_out; a.ws = (unsigned char*)d_ws;
    void* kargs[] = {&a};
    hipError_t e = hipLaunchCooperativeKernel((const void*)trunk_fwd, dim3(grid), dim3(NTHREADS), kargs, LDS_BYTES, stream);
    if (e != hipSuccess) fprintf(stderr, "kernel_launch: cooperative launch failed: %s (grid %d)\n", hipGetErrorString(e), grid);
}
```

```cpp
#include <hip/hip_runtime.h>
#include <hip/hip_cooperative_groups.h>
#include <cstdio>
#include <cstdint>
namespace cg = cooperative_groups;
#ifndef PROBE
#define PROBE 0
#endif

#define LAS __attribute__((address_space(3)))
typedef unsigned short bf16_t;
typedef short bf16x8 __attribute__((ext_vector_type(8)));
typedef float f32x4 __attribute__((ext_vector_type(4)));
typedef float f32x2 __attribute__((ext_vector_type(2)));
typedef unsigned u32x4 __attribute__((ext_vector_type(4)));
typedef unsigned u32x2 __attribute__((ext_vector_type(2)));

constexpr int D = 1024, BP = 8, SEQ = 4096, BS = 8, TS = 32, DEPTH = 2;
constexpr int MP = BP * SEQ, MS = BS * TS, MT = MP + MS;
constexpr int INC = 2304, DFF = 2816, NMEM = 256, AW = 512, BW = 256, CW = 256;
constexpr int Z_XA = 0, Z_GA = 512, Z_XB = 1024, Z_GB = 1280, Z_GC = 1536, Z_UC = 1792, Z_VC = 2048;
constexpr float EPS = 1e-6f;
constexpr int NWAVES = 8, NTHREADS = 512;

constexpr size_t O_YP = 0, O_YS = O_YP + (size_t)MP * D, O_CAP = O_YS + (size_t)MS * D, O_HAP = O_CAP + DEPTH * BP * 3 * AW,
                 O_CBP = O_HAP + DEPTH * BP * AW, O_CFP = O_CBP + DEPTH * BP * 2 * BW, O_MKP = O_CFP + DEPTH * BP * 2 * DFF,
                 O_MVP = O_MKP + (size_t)DEPTH * BP * NMEM * D, O_CAS = O_MVP + (size_t)DEPTH * BP * NMEM * D, O_HAS = O_CAS + DEPTH * BS * 3 * AW,
                 O_CBS = O_HAS + DEPTH * BS * AW, O_CFS = O_CBS + DEPTH * BS * 2 * BW, O_VCS = O_CFS + DEPTH * BS * 2 * DFF,
                 O_END = O_VCS + DEPTH * BS * TS * CW;

constexpr size_t MiB = 1u << 20;
constexpr size_t WS_WIN = 0, WS_WOUT = 5 * MiB, WS_WQ = 7 * MiB, WS_WK = 9 * MiB, WS_WV = 11 * MiB, WS_WO = 13 * MiB, WS_WUP = 15 * MiB, WS_WDN = 26 * MiB;
constexpr size_t WS_MEMB = 32 * MiB, WS_KBP = 36 * MiB, WS_VTP = 40 * MiB, WS_KBS = 44 * MiB, WS_VTS = 48 * MiB, WS_WST = 52 * MiB, WS_GT = WS_WST + 131072, WS_AGG = 53 * MiB, WS_SS = 54 * MiB + 256 * 1024, WS_BAR = 55 * MiB + 512 * 1024;
constexpr size_t WS_XN = 56 * MiB, WS_BIG = 121 * MiB;
constexpr size_t B_Z = WS_BIG, B_HLOC = WS_BIG + 146 * MiB, B_PCUM = WS_BIG + 211 * MiB, B_Y = WS_BIG + 276 * MiB;
constexpr size_t B_Q = WS_BIG, B_P = WS_BIG + 65 * MiB, B_O = WS_BIG + 130 * MiB, B_PS = WS_BIG + 195 * MiB;
constexpr size_t B_GU = WS_BIG;
constexpr size_t B_GUS = WS_BIG + 200 * MiB;
constexpr size_t B_SBG = WS_BIG + 204 * MiB, B_SBU = WS_BIG + 207 * MiB, B_SBL = WS_BIG + 210 * MiB;
constexpr size_t WS_END = WS_BIG + (size_t)MT * 2 * DFF * 2;
constexpr size_t WS_SSP = 476 * MiB;
static_assert(WS_END <= WS_SSP && WS_SSP + (size_t)7 * MT * 64 <= 512 * MiB, "workspace");
static_assert(WS_XN + (size_t)MT * D * 2 <= WS_BIG, "xn");

constexpr int LDS_RING = 131072, LDS_EX = LDS_RING, LDS_MISC = LDS_EX + 8192, LDS_BYTES = 147456;

enum { I_XP = 0, I_XS, I_MEM, I_CK, I_CV, I_SCA, I_SHA, I_SCB, I_SCF, I_GMIX, I_WIN, I_CAW, I_CAB, I_WRG, I_BRG, I_WIG, I_BIG, I_LAM, I_CBW, I_GV, I_WS, I_BSS,
       I_WOUT, I_GX, I_WQ, I_WK, I_WV, I_WO, I_GFFN, I_WUP, I_CFW, I_WDN, I_GFIN, N_IN };

struct Args { const float* in[N_IN]; float* out; unsigned char* ws; };

__device__ __forceinline__ unsigned f2bf(float f) { unsigned u = __builtin_bit_cast(unsigned, f); return (u + 0x7fffu + ((u >> 16) & 1u)) >> 16; }
__device__ __forceinline__ unsigned pk2(float lo, float hi) { return f2bf(lo) | (f2bf(hi) << 16); }
__device__ __forceinline__ float bf2f(unsigned v) { return __builtin_bit_cast(float, v << 16); }
__device__ __forceinline__ float bflo(unsigned w) { return __builtin_bit_cast(float, w << 16); }
__device__ __forceinline__ float bfhi(unsigned w) { return __builtin_bit_cast(float, w & 0xffff0000u); }
__device__ __forceinline__ unsigned cvt_pk_bf16(float lo, float hi) { unsigned r; asm volatile("v_cvt_pk_bf16_f32 %0, %1, %2" : "=v"(r) : "v"(lo), "v"(hi)); return r; }
__device__ __forceinline__ float fexp(float x) { return __builtin_amdgcn_exp2f(x * 1.4426950408889634f); }
__device__ __forceinline__ float sigm(float x) { return __builtin_amdgcn_rcpf(1.0f + fexp(-x)); }
__device__ __forceinline__ float gelu_t(float x) { const float u = 0.7978845608028654f * (x + 0.044715f * x * x * x); return x * sigm(2.0f * u); }
__device__ __forceinline__ float silu(float x) { return x * sigm(x); }
__device__ __forceinline__ float shx(float v, int m, int lane) { return __builtin_bit_cast(float, __builtin_amdgcn_ds_bpermute((lane ^ m) << 2, __builtin_bit_cast(int, v))); }
__device__ __forceinline__ float wave_sum(float v, int lane) {
#pragma unroll
    for (int o = 1; o < 64; o <<= 1) v += shx(v, o, lane);
    return v;
}
#define LDS_WAIT() asm volatile("s_waitcnt lgkmcnt(0)" ::: "memory")
__device__ __forceinline__ float ss_rstd(f32x4 p) { return 1.0f / sqrtf(((p[0] + p[1]) + (p[2] + p[3])) * (1.f / 1024.f) + 1e-6f); }
__device__ __forceinline__ int opaque_tid(int wave_s) { int l; asm volatile("v_mbcnt_lo_u32_b32 %0, -1, 0\n\tv_mbcnt_hi_u32_b32 %0, -1, %0" : "=v"(l)); return wave_s * 64 + l; }

namespace pg8 {
constexpr int BM = 256, BK = 64, HALF = 128, HTB = HALF * BK * 2, NXCD = 8, WGM = 8;
__device__ __forceinline__ int lds_byte(int r, int c) { const int st = (r >> 4) * 2 + (c >> 5), rr = r & 15, cc = c & 31, ob = rr * 64 + cc * 2; return st * 1024 + (ob ^ (((ob >> 9) & 1) << 5)); }
__device__ __forceinline__ void stage_rc(int b, int& R, int& C) { const int st = b / 1024, sb = b % 1024, swz = sb ^ (((sb >> 9) & 1) << 5); R = (st >> 1) * 16 + swz / 64; C = (st & 1) * 32 + (swz % 64) / 2; }
__device__ __forceinline__ int perm32(int rho) { const int n = rho >> 4, i = rho & 15; return 8 * (i >> 2) + 4 * n + (i & 3); }

struct Unit { int pm, pn; };
struct Gemm { const bf16_t* A; const bf16_t* Bt; int lda, ldb, K; };

struct GSched {
    int nM, nN, nwg, G, c, mode;
    size_t aPm, aPn, bPn, bPm; int bShift;
    __device__ __forceinline__ void init(int nM_, int nN_, int G_, int c_) { nM = nM_; nN = nN_; nwg = nM * nN; G = G_; c = c_; mode = 0; aPm = 0; aPn = 0; bPn = 0; bPm = 0; bShift = 0; }
    __device__ __forceinline__ bool next(int i, Unit& u) const {
        const long L = (long)i * G + c; if (L >= nwg) return false;
        int wgid = (int)L; { const int q = nwg / NXCD, r = nwg % NXCD, xcd = wgid % NXCD, off = wgid / NXCD; wgid = (xcd < r ? xcd * (q + 1) : r * (q + 1) + (xcd - r) * q) + off; }
        const int nig = WGM * nN, gid = wgid / nig, fm = gid * WGM, gsz = (nM - fm) < WGM ? (nM - fm) : WGM;
        u.pm = fm + ((wgid % nig) % gsz); u.pn = (wgid % nig) / gsz; return true;
    }
    __device__ __forceinline__ size_t offA(const Unit& u) const { return mode == 1 ? (size_t)(u.pn & 3) * 512 : (mode == 2 ? (size_t)(u.pn & 3) * 4096 + (size_t)(u.pn >> 2) * 512 : (size_t)u.pm * aPm + (size_t)u.pn * aPn); }
    __device__ __forceinline__ size_t offB(const Unit& u) const { return mode == 1 ? (size_t)(u.pn >> 2) * (256 * 1024 * 2) + (size_t)(u.pn & 3) * 512 : (mode == 2 ? (size_t)(u.pn & 3) * (256 * 2048 * 2) + (size_t)(u.pn >> 2) * 512 : (size_t)u.pn * bPn + (size_t)(u.pm >> bShift) * bPm); }
};

struct EpiBf16 {
    static constexpr bool PERM = true;
    bf16_t* O; int ldc; float scale; const float* ss; int smp;
    __device__ __forceinline__ void operator()(f32x4 (&acc)[2][2][4][2], const Unit& u, int wr, int wc, int fr, int fq, LAS unsigned char*) const {
        asm volatile("" : "+v"(fr), "+v"(fq)); asm volatile("" : "+s"(wr), "+s"(wc));
        const int row0 = u.pm * BM + wr * 64 + fr, col0 = (smp ? (u.pn & 3) : u.pn) * BM + wc * 32 + 8 * fq;
        f32x4 rs[2][4];
#pragma unroll
        for (int ai = 0; ai < 2; ++ai)
#pragma unroll
            for (int m = 0; m < 4; ++m) rs[ai][m] = ss ? *(const f32x4*)(ss + (size_t)(row0 + ai * HALF + m * 16) * 4) : (f32x4){0.f, 0.f, 0.f, 0.f};
#pragma unroll
        for (int ai = 0; ai < 2; ++ai)
#pragma unroll
            for (int m = 0; m < 4; ++m) { bf16_t* rowp = O + (size_t)(row0 + ai * HALF + m * 16) * ldc + col0;
                float sc = scale; if (ss) sc *= ss_rstd(rs[ai][m]);
                if (smp && ((ai * HALF + wr * 64 + m * 16 + fr) >> 5) != (u.pn >> 2)) continue;
#pragma unroll
                for (int bj = 0; bj < 2; ++bj) { const f32x4 v0 = acc[ai][bj][m][0] * sc, v1 = acc[ai][bj][m][1] * sc;
                    u32x4 w; w.x = cvt_pk_bf16(v0[0], v0[1]); w.y = cvt_pk_bf16(v0[2], v0[3]); w.z = cvt_pk_bf16(v1[0], v1[1]); w.w = cvt_pk_bf16(v1[2], v1[3]);
                    *(u32x4*)(rowp + bj * HALF) = w; } }
    }
};
struct EpiResid {
    static constexpr bool PERM = true;
    bf16_t* xb; float* ss;
    __device__ __forceinline__ void operator()(f32x4 (&acc)[2][2][4][2], const Unit& u, int wr, int wc, int fr, int fq, LAS unsigned char* lds) const {
        asm volatile("" : "+v"(fr), "+v"(fq)); asm volatile("" : "+s"(wr), "+s"(wc));
        const int col0 = u.pn * BM + wc * 32 + 8 * fq, lane = fq * 16 + fr;
        LAS float* PS = (LAS float*)(lds + LDS_EX);
        bf16_t* ob = xb + (size_t)u.pm * BM * D;
#pragma unroll
        for (int ai = 0; ai < 2; ++ai) {
            u32x4 pre[4][2];
#pragma unroll
            for (int m = 0; m < 4; ++m)
#pragma unroll
                for (int bj = 0; bj < 2; ++bj) pre[m][bj] = *(const u32x4*)(ob + (size_t)(ai * HALF + wr * 64 + m * 16 + fr) * D + col0 + bj * HALF);
            asm volatile("" ::: "memory");
#pragma unroll
            for (int m = 0; m < 4; ++m) { const int rl = ai * HALF + wr * 64 + m * 16 + fr; const size_t off = (size_t)rl * D + col0; float q = 0.f;
#pragma unroll
                for (int bj = 0; bj < 2; ++bj) { const u32x4 p = pre[m][bj]; const f32x4 a0 = acc[ai][bj][m][0], a1 = acc[ai][bj][m][1];
                    const float v0 = bflo(p.x) + a0[0], v1 = bfhi(p.x) + a0[1], v2 = bflo(p.y) + a0[2], v3 = bfhi(p.y) + a0[3], v4 = bflo(p.z) + a1[0], v5 = bfhi(p.z) + a1[1], v6 = bflo(p.w) + a1[2], v7 = bfhi(p.w) + a1[3];
                    u32x4 w; w.x = cvt_pk_bf16(v0, v1); w.y = cvt_pk_bf16(v2, v3); w.z = cvt_pk_bf16(v4, v5); w.w = cvt_pk_bf16(v6, v7); *(u32x4*)(ob + off + bj * HALF) = w;
                    q += ((v0 * v0 + v1 * v1) + (v2 * v2 + v3 * v3)) + ((v4 * v4 + v5 * v5) + (v6 * v6 + v7 * v7)); }
                q += shx(q, 16, lane); q += shx(q, 32, lane);
                if (fq == 0) PS[rl * 4 + wc] = q; }
            asm volatile("" ::: "memory");
        }
        asm volatile("s_waitcnt lgkmcnt(0)" ::: "memory"); __builtin_amdgcn_s_barrier(); asm volatile("" ::: "memory");
        { const int t = (wr * 4 + wc) * 64 + lane; if (t < 256) { const f32x4 p = *(const LAS f32x4*)(PS + t * 4); ss[(size_t)(u.pm * BM + t) * 4 + u.pn] = (p[0] + p[1]) + (p[2] + p[3]); } }
    }
};
struct EpiKV {
    static constexpr bool PERM = false;
    float* outK; float* outV; bf16_t* KB; bf16_t* VT;
    __device__ __forceinline__ void operator()(f32x4 (&acc)[2][2][4][2], const Unit& u, int wr, int wc, int fr, int fq, LAS unsigned char*) const {
        asm volatile("" : "+v"(fr), "+v"(fq)); asm volatile("" : "+s"(wr), "+s"(wc));
        const int kind = u.pm >> 4, pm = u.pm & 15;
        const int col0 = u.pn * BM + wc * 32 + 4 * fq;
        float* of = kind == 0 ? outK : outV; bf16_t* ob = kind == 0 ? KB : VT; const int ldb_ = kind == 2 ? 2048 : 1024;
#pragma unroll
        for (int ai = 0; ai < 2; ++ai)
#pragma unroll
            for (int m = 0; m < 4; ++m) { const int row = pm * BM + ai * HALF + wr * 64 + m * 16 + fr;
#pragma unroll
                for (int bj = 0; bj < 2; ++bj)
#pragma unroll
                    for (int n = 0; n < 2; ++n) { const f32x4 v = acc[ai][bj][m][n]; const int col = col0 + bj * HALF + n * 16;
                        if (kind != 2) *(f32x4*)(of + (size_t)row * 1024 + col) = v;
                        if (kind != 1) { u32x2 w; w.x = cvt_pk_bf16(v[0], v[1]); w.y = cvt_pk_bf16(v[2], v[3]); *(u32x2*)(ob + (size_t)row * ldb_ + col) = w; } } }
    }
};
struct EpiSoftmax {
    static constexpr bool PERM = true;
    bf16_t* O; int ldc; int smp;
    __device__ __forceinline__ void operator()(f32x4 (&acc)[2][2][4][2], const Unit& u, int wr, int wc, int fr, int fq, LAS unsigned char* lds) const {
        asm volatile("" : "+v"(fr), "+v"(fq)); asm volatile("" : "+s"(wr), "+s"(wc));
        LAS f32x2* EX = (LAS f32x2*)(lds + LDS_EX);
        const int lane = fq * 16 + fr;
        const float L2E = 1.4426950408889634f;
#pragma unroll
        for (int ai = 0; ai < 2; ++ai)
#pragma unroll
            for (int m = 0; m < 4; ++m) {
                float mx = -3.0e38f;
#pragma unroll
                for (int bj = 0; bj < 2; ++bj)
#pragma unroll
                    for (int n = 0; n < 2; ++n) { const f32x4 x = acc[ai][bj][m][n]; mx = fmaxf(mx, fmaxf(fmaxf(x[0], x[1]), fmaxf(x[2], x[3]))); }
                mx = fmaxf(mx, shx(mx, 16, lane)); mx = fmaxf(mx, shx(mx, 32, lane));
                float s = 0.f;
#pragma unroll
                for (int bj = 0; bj < 2; ++bj)
#pragma unroll
                    for (int n = 0; n < 2; ++n) { f32x4 x = acc[ai][bj][m][n];
#pragma unroll
                        for (int j = 0; j < 4; ++j) { x[j] = __builtin_amdgcn_exp2f((x[j] - mx) * L2E); s += x[j]; }
                        acc[ai][bj][m][n] = x; }
                s += shx(s, 16, lane); s += shx(s, 32, lane);
                if (fq == 0) EX[(ai * HALF + wr * 64 + m * 16 + fr) * 4 + wc] = (f32x2){mx, s};
            }
        asm volatile("s_waitcnt lgkmcnt(0)" ::: "memory"); __builtin_amdgcn_s_barrier(); asm volatile("" ::: "memory");
        int colb = u.pn * BM, j_ = 0;
        if (smp) { colb = (u.pn & 3) * 2048 + (u.pn >> 2) * 256; j_ = u.pn >> 2; }
        const int col0 = colb + wc * 32 + 8 * fq;
#pragma unroll
        for (int ai = 0; ai < 2; ++ai)
#pragma unroll
            for (int m = 0; m < 4; ++m) {
                const int rl = ai * HALF + wr * 64 + m * 16 + fr;
                const f32x2 e0 = EX[rl * 4 + 0], e1 = EX[rl * 4 + 1], e2 = EX[rl * 4 + 2], e3 = EX[rl * 4 + 3];
                const float M = fmaxf(fmaxf(e0.x, e1.x), fmaxf(e2.x, e3.x));
                const float tot = e0.y * __builtin_amdgcn_exp2f((e0.x - M) * L2E) + e1.y * __builtin_amdgcn_exp2f((e1.x - M) * L2E) + e2.y * __builtin_amdgcn_exp2f((e2.x - M) * L2E) + e3.y * __builtin_amdgcn_exp2f((e3.x - M) * L2E);
                const float own = wc == 0 ? e0.x : (wc == 1 ? e1.x : (wc == 2 ? e2.x : e3.x));
                float f = __builtin_amdgcn_exp2f((own - M) * L2E) / tot;
                if (smp && (rl >> 5) != j_) f = 0.f;
                bf16_t* rowp = O + (size_t)(u.pm * BM + rl) * ldc + col0;
#pragma unroll
                for (int bj = 0; bj < 2; ++bj) { const f32x4 v0 = acc[ai][bj][m][0] * f, v1 = acc[ai][bj][m][1] * f;
                    u32x4 w; w.x = cvt_pk_bf16(v0[0], v0[1]); w.y = cvt_pk_bf16(v0[2], v0[3]); w.z = cvt_pk_bf16(v1[0], v1[1]); w.w = cvt_pk_bf16(v1[2], v1[3]);
                    *(u32x4*)(rowp + bj * HALF) = w; } }
    }
};


__device__ __forceinline__ float dpp_ror1(float v) { return __builtin_bit_cast(float, __builtin_amdgcn_update_dpp(0, __builtin_bit_cast(int, v), 0x121, 0xf, 0xf, false)); }
__device__ __forceinline__ float dpp_ror2(float v) { return __builtin_bit_cast(float, __builtin_amdgcn_update_dpp(0, __builtin_bit_cast(int, v), 0x122, 0xf, 0xf, false)); }
struct EpiAct {
    static constexpr bool PERM = true;
    bf16_t* H; const float* scf; float* ocf; float* sbg; float* sbu; float* sbl; const float* cfw; const float* ss;
    __device__ __forceinline__ void operator()(f32x4 (&acc)[2][2][4][2], const Unit& u, int wr, int wc, int fr, int fq, LAS unsigned char* lds) const {
        asm volatile("" : "+s"(wr), "+s"(wc));
        int lane; asm volatile("v_mbcnt_lo_u32_b32 %0, -1, 0\n\tv_mbcnt_hi_u32_b32 %0, -1, %0" : "=v"(lane));
        fr = lane & 15; fq = lane >> 4;
        const int fl = wc * 32 + 8 * fq, f0 = u.pn * 128 + fl; int rowt = wr * 64 + fr;
        {
            float rst[2][4];
            f32x4 rsl[2][4];
#pragma unroll
            for (int ai = 0; ai < 2; ++ai)
#pragma unroll
                for (int m = 0; m < 4; ++m) rsl[ai][m] = *(const f32x4*)(ss + (size_t)(u.pm * BM + ai * HALF + rowt + m * 16) * 4);
#pragma unroll
            for (int ai = 0; ai < 2; ++ai)
#pragma unroll
                for (int m = 0; m < 4; ++m) { rst[ai][m] = ss_rstd(rsl[ai][m]); }
#pragma unroll
            for (int ai = 0; ai < 2; ++ai)
#pragma unroll
                for (int m = 0; m < 4; ++m) { acc[ai][0][m][0] = acc[ai][0][m][0] * rst[ai][m]; acc[ai][0][m][1] = acc[ai][0][m][1] * rst[ai][m]; acc[ai][1][m][0] = acc[ai][1][m][0] * rst[ai][m]; acc[ai][1][m][1] = acc[ai][1][m][1] * rst[ai][m]; }
        }
        const bool smp = (u.pm == 128);
        asm volatile("" : "+v"(rowt));
        LAS float* BND = (LAS float*)(lds + LDS_EX);
        if (fr >= 14) {
#pragma unroll
            for (int ai = 0; ai < 2; ++ai)
#pragma unroll
                for (int n = 0; n < 2; ++n) *(LAS f32x4*)(BND + ((ai * 2 + wr) * 2 + (fr - 14)) * 128 + fl + 4 * n) = acc[ai][0][3][n];
            if (wr == 1) {
#pragma unroll
                for (int n = 0; n < 2; ++n) *(f32x4*)(sbl + ((size_t)u.pm * 2 + (fr - 14)) * DFF + f0 + 4 * n) = acc[1][0][3][n];
            }
        }
        asm volatile("s_waitcnt lgkmcnt(0)" ::: "memory"); __builtin_amdgcn_s_barrier(); asm volatile("" ::: "memory");
#pragma unroll
        for (int ai = 0; ai < 2; ++ai) {
            const int pg = wr == 1 ? ai * 2 : 1;
            u32x2 hp[2][4];
#pragma unroll
            for (int n = 0; n < 2; ++n) {
                const f32x4 w0 = *(const f32x4*)(cfw + f0 + 4 * n), w1 = *(const f32x4*)(cfw + DFF + f0 + 4 * n), w2 = *(const f32x4*)(cfw + 2 * DFF + f0 + 4 * n);
                f32x4 h2 = *(const LAS f32x4*)(BND + (pg * 2 + 0) * 128 + fl + 4 * n), h1 = *(const LAS f32x4*)(BND + (pg * 2 + 1) * 128 + fl + 4 * n);
                f32x4 t2 = h2, t1 = h1;
                if (smp) { const float* sp = scf + (size_t)((ai * 4 + wr * 2) * 2) * DFF + f0 + 4 * n; h2 = *(const f32x4*)sp; h1 = *(const f32x4*)(sp + DFF); t2 = *(const f32x4*)(sp + 2 * DFF); t1 = *(const f32x4*)(sp + 3 * DFF); }
#pragma unroll
                for (int jp = 0; jp < 2; ++jp) {
                    float hv[4][2];
#pragma unroll
                    for (int jj = 0; jj < 2; ++jj) { const int j = jp * 2 + jj;
                        float r1p = h1[j], r2p = fr == 0 ? h2[j] : h1[j];
#pragma unroll
                        for (int m = 0; m < 4; ++m) { const float g = acc[ai][0][m][n][j];
                            if (m == 2 && smp) { r1p = t1[j]; r2p = fr == 0 ? t2[j] : t1[j]; }
                            const float r1 = dpp_ror1(g), r2 = dpp_ror2(g);
                            const float gm1 = fr >= 1 ? r1 : r1p, gm2 = fr >= 2 ? r2 : r2p;
                            r1p = r1; r2p = r2;
                            const float cv = w0[j] * gm2 + w1[j] * gm1 + w2[j] * g;
                            hv[m][jj] = silu(cv) * acc[ai][1][m][n][j]; } }
#pragma unroll
                    for (int m = 0; m < 4; ++m) { const unsigned pk = cvt_pk_bf16(hv[m][0], hv[m][1]); if (jp == 0) hp[n][m].x = pk; else hp[n][m].y = pk; }
                }
            }
#pragma unroll
            for (int m = 0; m < 4; ++m) {
                const int rl = ai * HALF + rowt + m * 16;
                if (smp && (m & 1) && fr >= 14) {
#pragma unroll
                    for (int n = 0; n < 2; ++n) *(f32x4*)(ocf + ((size_t)(ai * 4 + wr * 2 + (m >> 1)) * 2 + (fr - 14)) * DFF + f0 + 4 * n) = acc[ai][0][m][n];
                }
                if (!smp && ai == 0 && m == 0 && wr == 0 && fr < 2) {
#pragma unroll
                    for (int n = 0; n < 2; ++n) { *(f32x4*)(sbg + ((size_t)u.pm * 2 + fr) * DFF + f0 + 4 * n) = acc[0][0][0][n]; *(f32x4*)(sbu + ((size_t)u.pm * 2 + fr) * DFF + f0 + 4 * n) = acc[0][1][0][n]; }
                } else {
                    u32x4 w; w.x = hp[0][m].x; w.y = hp[0][m].y; w.z = hp[1][m].x; w.w = hp[1][m].y;
                    *(u32x4*)(H + (size_t)(u.pm * BM + rl) * DFF + f0) = w;
                }
            }
        }
    }
};

template <class Epi, class Sched, bool ALIGN_EPI>
__device__ __forceinline__ void gemm_phase(LAS unsigned char* lds, const Gemm g, const Sched& S, const Epi& E, const int wave_s) {
    const int tid = opaque_tid(wave_s), wid = __builtin_amdgcn_readfirstlane(tid >> 6), lane = tid & 63, wr = wid >> 2, wc = wid & 3, fr = lane & 15, fq = lane >> 4;
    const int nt = g.K / BK;
    unsigned voffA[2], voffB[2];
#pragma unroll
    for (int i = 0; i < 2; ++i) { int R, C; stage_rc(tid * 16 + i * 8192, R, C); const int Rb = Epi::PERM ? ((R & ~31) + perm32(R & 31)) : R;
        voffA[i] = (unsigned)(R * g.lda + C) * 2u; voffB[i] = (unsigned)(Rb * g.ldb + C) * 2u; }
    const size_t kstep = (size_t)(BK * 2);
    const size_t hstepA = (size_t)HALF * g.lda * 2, hstepB = (size_t)HALF * g.ldb * 2;
    const unsigned ldsw = (unsigned)wid * 1024u;
    const int aoff = lds_byte(wr * 64 + fr, fq * 8), boff = lds_byte(wc * 32 + fr, fq * 8);
#define PG8_SA(b, h) (((b) * 2 + (h)) * HTB)
#define PG8_SB(b, h) ((4 + (b) * 2 + (h)) * HTB)
#define PG8_STAGE(bufoff, gbase, voff) do { _Pragma("unroll") for (int _i = 0; _i < 2; ++_i) \
        __builtin_amdgcn_global_load_lds((const unsigned*)((const char*)(gbase) + (voff)[_i]), (LAS unsigned*)(lds + (bufoff) + ldsw + _i * 8192), 16, 0, 0); } while (0)
#define PG8_LDA(dst, b, h) do { _Pragma("unroll") for (int m = 0; m < 4; ++m) _Pragma("unroll") for (int k = 0; k < 2; ++k) dst[m][k] = *(const LAS bf16x8*)(lds + PG8_SA(b, h) + aoff + m * 2048 + k * 1024); } while (0)
#define PG8_LDB(dst, b, h) do { _Pragma("unroll") for (int n = 0; n < 2; ++n) _Pragma("unroll") for (int k = 0; k < 2; ++k) dst[n][k] = *(const LAS bf16x8*)(lds + PG8_SB(b, h) + boff + n * 2048 + k * 1024); } while (0)
#define PG8_MMA(ai, bj, At, Bt) do { __builtin_amdgcn_s_setprio(1); _Pragma("unroll") for (int m = 0; m < 4; ++m) _Pragma("unroll") for (int n = 0; n < 2; ++n) _Pragma("unroll") for (int k = 0; k < 2; ++k) \
        acc[ai][bj][m][n] = __builtin_amdgcn_mfma_f32_16x16x32_bf16(Bt[n][k], At[m][k], acc[ai][bj][m][n], 0, 0, 0); __builtin_amdgcn_s_setprio(0); } while (0)
#define PG8_WAIT_V(n) asm volatile("s_waitcnt vmcnt(" #n ")" ::: "memory")
#define PG8_WAIT_L(n) asm volatile("s_waitcnt lgkmcnt(" #n ")" ::: "memory")
#define PG8_BAR __builtin_amdgcn_s_barrier()
#define PG8_SCHED __builtin_amdgcn_sched_barrier(0)
    Unit cur, nxt; int ui = 0;
    if (!S.next(0, cur)) return;
    f32x4 acc[2][2][4][2];
#pragma unroll
    for (int a = 0; a < 2; ++a)
#pragma unroll
        for (int b = 0; b < 2; ++b)
#pragma unroll
            for (int m = 0; m < 4; ++m)
#pragma unroll
                for (int n = 0; n < 2; ++n) acc[a][b][m][n] = (f32x4){0.f, 0.f, 0.f, 0.f};
    bf16x8 At[4][2], B0[2][2], B1[2][2];
    const char* cA = (const char*)g.A + S.offA(cur); const char* cB = (const char*)g.Bt + S.offB(cur);
    PG8_STAGE(PG8_SB(0, 0), cB, voffB); PG8_STAGE(PG8_SB(0, 1), cB + hstepB, voffB); PG8_STAGE(PG8_SA(0, 0), cA, voffA); PG8_STAGE(PG8_SA(0, 1), cA + hstepA, voffA);
    if (wr == 1) PG8_BAR;
    PG8_WAIT_V(2); PG8_BAR;
    PG8_STAGE(PG8_SB(1, 0), cB + kstep, voffB); PG8_STAGE(PG8_SA(1, 0), cA + kstep, voffA); PG8_STAGE(PG8_SB(1, 1), cB + hstepB + kstep, voffB);
    PG8_WAIT_V(6); PG8_BAR;
    for (;;) {
        const bool has_next = S.next(ui + 1, nxt);
        const char* nA = has_next ? (const char*)g.A + S.offA(nxt) : cA; const char* nB = has_next ? (const char*)g.Bt + S.offB(nxt) : cB;
        for (int t = 0; t < nt; t += 2) {
            const bool last = (t == nt - 2);
            const char* a1 = cA + (size_t)(t + 1) * kstep;
            const char* a2 = last ? nA : cA + (size_t)(t + 2) * kstep; const char* b2 = last ? nB : cB + (size_t)(t + 2) * kstep;
            const char* a3 = a2 + kstep; const char* b3 = b2 + kstep;
            PG8_LDB(B0, 0, 0); PG8_LDB(B1, 0, 1); PG8_SCHED; PG8_LDA(At, 0, 0); PG8_STAGE(PG8_SA(1, 1), a1 + hstepA, voffA);
            PG8_WAIT_V(8); PG8_WAIT_L(0); PG8_BAR; PG8_MMA(0, 0, At, B0); PG8_MMA(0, 1, At, B1); PG8_BAR; PG8_SCHED;
            PG8_LDA(At, 0, 1); PG8_STAGE(PG8_SB(0, 0), b2, voffB); PG8_STAGE(PG8_SB(0, 1), b2 + hstepB, voffB); PG8_STAGE(PG8_SA(0, 0), a2, voffA);
            PG8_WAIT_V(8); PG8_WAIT_L(0); PG8_BAR; PG8_MMA(1, 0, At, B0); PG8_MMA(1, 1, At, B1); PG8_BAR; PG8_SCHED;
            PG8_LDB(B0, 1, 0); PG8_LDB(B1, 1, 1); PG8_SCHED; PG8_LDA(At, 1, 0); PG8_STAGE(PG8_SA(0, 1), a2 + hstepA, voffA);
            PG8_WAIT_V(8); PG8_WAIT_L(0); PG8_BAR; PG8_MMA(0, 0, At, B0); PG8_MMA(0, 1, At, B1); PG8_BAR; PG8_SCHED;
            PG8_LDA(At, 1, 1); PG8_STAGE(PG8_SB(1, 0), b3, voffB); PG8_STAGE(PG8_SB(1, 1), b3 + hstepB, voffB); PG8_STAGE(PG8_SA(1, 0), a3, voffA);
            PG8_WAIT_V(8); PG8_WAIT_L(0); PG8_BAR; PG8_MMA(1, 0, At, B0); PG8_MMA(1, 1, At, B1); PG8_BAR; PG8_SCHED;
        }
        if constexpr (ALIGN_EPI) { if (wr == 0) PG8_BAR; }
        E(acc, cur, wr, wc, fr, fq, lds);
        if (!has_next) break;
#pragma unroll
        for (int a = 0; a < 2; ++a)
#pragma unroll
            for (int b = 0; b < 2; ++b)
#pragma unroll
                for (int m = 0; m < 4; ++m)
#pragma unroll
                    for (int n = 0; n < 2; ++n) acc[a][b][m][n] = (f32x4){0.f, 0.f, 0.f, 0.f};
        cur = nxt; cA = nA; cB = nB; ++ui;
        if constexpr (ALIGN_EPI) { if (wr == 1) PG8_BAR; }
    }
    PG8_WAIT_V(0);
    if constexpr (!ALIGN_EPI) { if (wr == 0) PG8_BAR; }
    PG8_BAR;
#undef PG8_SA
#undef PG8_SB
#undef PG8_STAGE
#undef PG8_LDA
#undef PG8_LDB
#undef PG8_MMA
#undef PG8_WAIT_V
#undef PG8_WAIT_L
#undef PG8_BAR
#undef PG8_SCHED
}
}

struct KVSched {
    int c, G; const char* ws;
    __device__ __forceinline__ bool next(int i, pg8::Unit& u) const {
        const int L = i * G + c; if (c < 0 || L >= 96) return false;
        const int kind = L >> 5, r = L & 31;
        if (kind < 2) { u.pm = kind * 16 + (r >> 2); u.pn = r & 3; } else { u.pm = 32 + (r >> 3); u.pn = r & 7; }
        return true;
    }
    __device__ __forceinline__ size_t offA(const pg8::Unit& u) const { const int kind = u.pm >> 4, pm = u.pm & 15; int k2 = (kind == 2); asm volatile("" : "+v"(k2));
        return (size_t)ws + WS_MEMB + (size_t)k2 * (WS_WV - WS_MEMB) + (size_t)pm * 256 * 1024 * 2; }
    __device__ __forceinline__ size_t offB(const pg8::Unit& u) const { const int kind = u.pm >> 4; int k1 = (kind == 1), k2 = (kind == 2); asm volatile("" : "+v"(k1), "+v"(k2));
        return (size_t)ws + WS_WK + (size_t)k1 * (WS_WV - WS_WK) + (size_t)k2 * (WS_MEMB - WS_WK) + (size_t)u.pn * 256 * 1024 * 2; }
};


#define XB_TMO      128
#define XB_XCNT(j)  (256  + 64 * (j))
#define XB_XSUB(j)  (1280 + 64 * (j))
#define XB_XGEN(j)  (2304 + 64 * (j))
#define XB_TOP      3328
#define XB_TOPGEN   3392
#define XCD_BAR_WORDS 3456
#define XB_SPIN_CAP (1u << 22)
__device__ __forceinline__ unsigned xb_ld(unsigned* p)              { return __hip_atomic_load(p, __ATOMIC_RELAXED, __HIP_MEMORY_SCOPE_AGENT); }
__device__ __forceinline__ unsigned xb_add(unsigned* p, unsigned v) { return __hip_atomic_fetch_add(p, v, __ATOMIC_RELAXED, __HIP_MEMORY_SCOPE_AGENT); }
__device__ __forceinline__ unsigned xb_xcc_id() { return (unsigned)__builtin_amdgcn_s_getreg((3 << 11) | 20) & 0xFu; }
#define XB_SPIN(cond, bar) do { unsigned _sp = 0; while (cond) { __builtin_amdgcn_s_sleep(1); \
    if ((++_sp & 255u) == 0u) { if (xb_ld(&(bar)[XB_TMO])) break; if (_sp > XB_SPIN_CAP) { atomicAdd(&(bar)[XB_TMO], 1u); break; } } } } while (0)
struct XcdBarrier { unsigned* bar; unsigned x; volatile LAS unsigned* st; };
__device__ __forceinline__ void xcd_barrier_complete(unsigned* bar, unsigned x, unsigned& nloc, unsigned& nx) {
    const unsigned G = gridDim.x * gridDim.y * gridDim.z;
    unsigned sum, cnt, mine, sp = 0u;
    for (;;) {
        sum = 0u; cnt = 0u; mine = 0u;
#pragma unroll
        for (unsigned j = 0; j < 16; ++j) { const unsigned c = xb_ld(&bar[XB_XCNT(j)]); sum += c; cnt += (c > 0u) ? 1u : 0u; mine = (j == x) ? c : mine; }
        if (sum == G) break;
        __builtin_amdgcn_s_sleep(1);
        if ((++sp & 255u) == 0u) { if (xb_ld(&bar[XB_TMO])) break; if (sp > XB_SPIN_CAP) { atomicAdd(&bar[XB_TMO], 1u); break; } }
    }
    nloc = mine > 0u ? mine : 1u; nx = cnt > 0u ? cnt : 1u;
}
__device__ __forceinline__ void xcd_barrier(const XcdBarrier& b) {
    asm volatile("s_waitcnt vmcnt(0)" ::: "memory");
    __syncthreads();
    if (threadIdx.x == 0) {
        unsigned* bar = b.bar;
        __builtin_amdgcn_s_waitcnt(0);
        unsigned nloc = b.st[0], nx = b.st[1];
        if (nloc == 0u) { xcd_barrier_complete(bar, b.x, nloc, nx); b.st[0] = nloc; b.st[1] = nx; }
        const unsigned old = xb_add(&bar[XB_XSUB(b.x)], 1u);
        const unsigned gen = old / nloc;
        if (old + 1u == (gen + 1u) * nloc) {
            __builtin_amdgcn_fence(__ATOMIC_RELEASE, "agent");
            asm volatile("s_waitcnt vmcnt(0)" ::: "memory");
            const unsigned og = xb_add(&bar[XB_TOP], 1u);
            const unsigned tg = og / nx;
            if (og + 1u == (tg + 1u) * nx) xb_add(&bar[XB_TOPGEN], 1u);
            else XB_SPIN(xb_ld(&bar[XB_TOPGEN]) == tg, bar);
            __builtin_amdgcn_fence(__ATOMIC_ACQUIRE, "agent");
            xb_add(&bar[XB_XGEN(b.x)], 1u);
            asm volatile("s_waitcnt vmcnt(0)" ::: "memory");
        } else {
            XB_SPIN(xb_ld(&bar[XB_XGEN(b.x)]) == gen, bar);
            __builtin_amdgcn_fence(__ATOMIC_ACQUIRE, "agent");
            asm volatile("s_waitcnt vmcnt(0)" ::: "memory");
        }
    }
    __syncthreads();
}

__device__ __forceinline__ void transpose_item(const float* W, int K, int N, bf16_t* WT, LAS float* scr, int item, int lane, const float* gain = nullptr, int gu = 0) {
    const int nblk = N / 32, kb = item / nblk, nb = item % nblk, k0 = 64 * kb, n0 = 32 * nb;
    {
        f32x4 v[8];
#pragma unroll
        for (int i = 0; i < 8; ++i) v[i] = *(const f32x4*)(W + (size_t)(k0 + (lane >> 3) + 8 * i) * N + n0 + (lane & 7) * 4);
#pragma unroll
        for (int i = 0; i < 8; ++i) { const int kk = (lane >> 3) + 8 * i; f32x4 w = v[i]; if (gain) w = w * gain[k0 + kk];
            LAS float* d = scr + kk * 33 + (lane & 7) * 4; d[0] = w[0]; d[1] = w[1]; d[2] = w[2]; d[3] = w[3]; }
    }
    LDS_WAIT();
    const int c = lane & 7;
#pragma unroll
    for (int j = 0; j < 4; ++j) { const int n = (lane >> 3) + 8 * j; const LAS float* s = scr + (8 * c) * 33 + n;
        u32x4 o; o.x = pk2(s[0 * 33], s[1 * 33]); o.y = pk2(s[2 * 33], s[3 * 33]); o.z = pk2(s[4 * 33], s[5 * 33]); o.w = pk2(s[6 * 33], s[7 * 33]);
        int drow = n0 + n; if (gu) { const int up = drow >= gu, f = up ? drow - gu : drow; drow = ((f >> 7) << 8) + (up << 7) + (f & 127); }
        *(u32x4*)(WT + (size_t)drow * K + k0 + 8 * c) = o; }
    LDS_WAIT();
}

__device__ __forceinline__ void first_rows(const float* Xp, const float* Xs, bf16_t* XNo, float* ss, int gw, int NGW, int lane) {
    for (int m0 = gw; m0 < MT; m0 += 2 * NGW) {
        const int m1 = m0 + NGW; const bool two = m1 < MT; const int mb = two ? m1 : m0;
        const f32x4* xa = (const f32x4*)(m0 < MP ? Xp + (size_t)m0 * D : Xs + (size_t)(m0 - MP) * D) + lane;
        const f32x4* xb = (const f32x4*)(mb < MP ? Xp + (size_t)mb * D : Xs + (size_t)(mb - MP) * D) + lane;
        f32x4 va[4], vb[4]; float sa = 0.f, sb = 0.f;
#pragma unroll
        for (int j = 0; j < 4; ++j) { va[j] = xa[64 * j]; vb[j] = xb[64 * j]; }
#pragma unroll
        for (int j = 0; j < 4; ++j) { sa += (va[j].x * va[j].x + va[j].y * va[j].y) + (va[j].z * va[j].z + va[j].w * va[j].w); sb += (vb[j].x * vb[j].x + vb[j].y * vb[j].y) + (vb[j].z * vb[j].z + vb[j].w * vb[j].w); }
        sa = wave_sum(sa, lane); sb = wave_sum(sb, lane);
        if (lane < 4) { ss[(size_t)m0 * 4 + lane] = lane == 0 ? sa : 0.f; if (two) ss[(size_t)m1 * 4 + lane] = lane == 0 ? sb : 0.f; }
        u32x2* oa = (u32x2*)(XNo + (size_t)m0 * D) + lane; u32x2* ob = (u32x2*)(XNo + (size_t)mb * D) + lane;
#pragma unroll
        for (int j = 0; j < 4; ++j) { u32x2 w; w.x = pk2(va[j].x, va[j].y); w.y = pk2(va[j].z, va[j].w); oa[64 * j] = w; if (two) { w.x = pk2(vb[j].x, vb[j].y); w.y = pk2(vb[j].z, vb[j].w); ob[64 * j] = w; } }
    }
}

typedef __attribute__((address_space(4))) const unsigned char* kptr_t;
typedef const float* cfp_t; typedef float* fp_t; typedef unsigned char* ucp_t;
#define INP(k) (*(const __attribute__((address_space(4))) cfp_t*)(kp + 8 * (k)))
#define X out
#define WIN_T ((bf16_t*)(ws + WS_WIN))
#define WOUT_T ((bf16_t*)(ws + WS_WOUT))
#define WQ_T ((bf16_t*)(ws + WS_WQ))
#define WK_T ((bf16_t*)(ws + WS_WK))
#define WV_T ((bf16_t*)(ws + WS_WV))
#define WO_T ((bf16_t*)(ws + WS_WO))
#define WUP_T ((bf16_t*)(ws + WS_WUP))
#define WDN_T ((bf16_t*)(ws + WS_WDN))
#define MEMB ((bf16_t*)(ws + WS_MEMB))
#define KBP ((bf16_t*)(ws + WS_KBP))
#define VTP ((bf16_t*)(ws + WS_VTP))
#define KBS ((bf16_t*)(ws + WS_KBS))
#define VTS ((bf16_t*)(ws + WS_VTS))
#define WST ((bf16_t*)(ws + WS_WST))
#define AGG ((float*)(ws + WS_AGG))
#define SSQ(i) ((float*)(ws + WS_SSP) + (size_t)(i) * MT * 4)
#define GT_R ((bf16_t*)(ws + WS_GT))
#define GT_I ((bf16_t*)(ws + WS_GT + 65536))
#define XN ((bf16_t*)(ws + WS_XN))
#define gZ ((bf16_t*)(ws + B_Z))
#define HLOC ((float*)(ws + B_HLOC))
#define PCUM ((float*)(ws + B_PCUM))
#define gY ((bf16_t*)(ws + B_Y))
#define gQ ((bf16_t*)(ws + B_Q))
#define gP ((bf16_t*)(ws + B_P))
#define gO ((bf16_t*)(ws + B_O))
#define PS ((bf16_t*)(ws + B_PS))
#define GU ((bf16_t*)(ws + B_GU))
#define GUS ((bf16_t*)(ws + B_GUS))
#define SBG ((float*)(ws + B_SBG))
#define SBU ((float*)(ws + B_SBU))
#define SBL ((float*)(ws + B_SBL))
__global__ void __launch_bounds__(NTHREADS, 2) trunk_fwd(Args args) {
    extern __shared__ __attribute__((aligned(16))) unsigned char lds_raw[];
    LAS unsigned char* lds = (LAS unsigned char*)lds_raw;
    cg::grid_group grid = cg::this_grid();
    const int wave_s = __builtin_amdgcn_readfirstlane(threadIdx.x >> 6);
#define LANE_STATE() int G = gridDim.x, bid = blockIdx.x; asm volatile("" : "+s"(G), "+s"(bid)); const int NGW = G * NWAVES, NGT = G * NTHREADS; (void)NGW; (void)NGT; \
    const int tid = opaque_tid(wave_s), lane = tid & 63, wave = wave_s; const int gw = bid * NWAVES + wave; const int gt = bid * NTHREADS + tid; (void)lane; (void)gw; (void)gt; \
    kptr_t kp = (kptr_t)__builtin_amdgcn_kernarg_segment_ptr(); asm volatile("" : "+s"(kp)); \
    float* const out = *(const __attribute__((address_space(4))) fp_t*)(kp + 8 * N_IN); unsigned char* const ws = *(const __attribute__((address_space(4))) ucp_t*)(kp + 8 * N_IN + 8); (void)out; (void)ws
    {
        LANE_STATE();
        if (bid == 0) for (int i = tid; i < XCD_BAR_WORDS; i += NTHREADS) __hip_atomic_store((unsigned*)(ws + WS_BAR) + i, 0u, __ATOMIC_RELAXED, __HIP_MEMORY_SCOPE_AGENT);
        if (tid < 32) ((LAS unsigned*)(lds + LDS_MISC))[tid] = 0u;
        __threadfence();
        grid.sync();
        if (tid == 0) (void)xb_add((unsigned*)(ws + WS_BAR) + XB_XCNT(xb_xcc_id()), 1u);
    }
#define GRID_SYNC() do { kptr_t kp_ = (kptr_t)__builtin_amdgcn_kernarg_segment_ptr(); asm volatile("" : "+s"(kp_)); \
        XcdBarrier b_; b_.bar = (unsigned*)(*(const __attribute__((address_space(4))) ucp_t*)(kp_ + 8 * N_IN + 8) + WS_BAR); b_.x = xb_xcc_id(); b_.st = (volatile LAS unsigned*)(lds + LDS_MISC); \
        xcd_barrier(b_); if (PROBE == 3) xcd_barrier(b_); } while (0)

    for (int l = 0; l < DEPTH; ++l) {
        for (int dup0 = 0; dup0 < ((PROBE == 1 || PROBE == 5) ? 2 : 1); ++dup0) {
        {
            LANE_STATE();
            LAS float* scr = (LAS float*)(lds + wave * 16384);
            const float* w_in = INP(I_WIN) + (size_t)l * D * INC; const float* w_out = INP(I_WOUT) + (size_t)l * D * D; const float* w_q = INP(I_WQ) + (size_t)l * D * D;
            const float* w_k = INP(I_WK) + (size_t)l * D * D; const float* w_v = INP(I_WV) + (size_t)l * D * D; const float* w_o = INP(I_WO) + (size_t)l * D * D;
            const float* w_up = INP(I_WUP) + (size_t)l * D * 2 * DFF; const float* w_dn = INP(I_WDN) + (size_t)l * DFF * D; const float* c_v = INP(I_CV) + (size_t)l * BS * NMEM * D;
            constexpr int T_IN = 16 * (INC / 32), T_SQ = 16 * 32, T_UP = 16 * (2 * DFF / 32), T_DN = (DFF / 64) * 32, T_CV = 32 * 32;
            constexpr int T_G = 16;
            constexpr int NIT = T_IN + 5 * T_SQ + T_UP + T_DN + T_CV + 2 * T_G;
            for (int it = gw; it < NIT; it += NGW) {
                int r = it;
                if (r < T_IN) { transpose_item(w_in, D, INC, WIN_T, scr, r, lane, INP(I_GMIX) + l * D); continue; } r -= T_IN;
                if (r < T_SQ) { transpose_item(w_out, D, D, WOUT_T, scr, r, lane); continue; } r -= T_SQ;
                if (r < T_SQ) { transpose_item(w_q, D, D, WQ_T, scr, r, lane, INP(I_GX) + l * D); continue; } r -= T_SQ;
                if (r < T_SQ) { transpose_item(w_k, D, D, WK_T, scr, r, lane); continue; } r -= T_SQ;
                if (r < T_SQ) { transpose_item(w_v, D, D, WV_T, scr, r, lane); continue; } r -= T_SQ;
                if (r < T_SQ) { transpose_item(w_o, D, D, WO_T, scr, r, lane); continue; } r -= T_SQ;
                if (r < T_UP) { transpose_item(w_up, D, 2 * DFF, WUP_T, scr, r, lane, INP(I_GFFN) + l * D, DFF); continue; } r -= T_UP;
                if (r < T_DN) { transpose_item(w_dn, DFF, D, WDN_T, scr, r, lane); continue; } r -= T_DN;
                if (r < T_CV) { transpose_item(c_v, BS * NMEM, D, VTS, scr, r, lane); continue; } r -= T_CV;
                if (r < T_G) { transpose_item(INP(I_WRG) + ((size_t)l * 8 + (r >> 1)) * 4096, 64, 64, GT_R + (r >> 1) * 4096, scr, r & 1, lane); continue; } r -= T_G;
                transpose_item(INP(I_WIG) + ((size_t)l * 8 + (r >> 1)) * 4096, 64, 64, GT_I + (r >> 1) * 4096, scr, r & 1, lane);
            }
            {
                const f32x4* ck = (const f32x4*)(INP(I_CK) + (size_t)l * BS * NMEM * D); u32x2* dk = (u32x2*)KBS;
                for (int i = gt; i < BS * NMEM * D / 4; i += NGT) { const f32x4 v = ck[i]; u32x2 w; w.x = pk2(v.x, v.y); w.y = pk2(v.z, v.w); dk[i] = w; }
                if (l == 0) { const f32x4* mm = (const f32x4*)INP(I_MEM); u32x2* dm = (u32x2*)MEMB;
                    for (int i = gt; i < BP * NMEM * D / 4; i += NGT) { const f32x4 v = mm[i]; u32x2 w; w.x = pk2(v.x, v.y); w.y = pk2(v.z, v.w); dm[i] = w; } }
                const float* wsl = INP(I_WS) + (size_t)l * 4 * 128 * 128;
                for (int i = gt; i < 4 * 128 * 128; i += NGT) { const int s = i & 127, t = (i >> 7) & 127; WST[i] = (bf16_t)f2bf(s <= t ? wsl[i] : 0.f); }
            }
            if (l == 0) first_rows(INP(I_XP), INP(I_XS), XN, SSQ(0), gw, NGW, lane);
        }
        GRID_SYNC();
        }
        {
            LANE_STATE();
            KVSched S; S.G = G; S.c = bid >= 160 ? bid - 160 : -1; S.ws = (const char*)ws;
            pg8::Gemm g{(const bf16_t*)nullptr, (const bf16_t*)nullptr, D, D, D};
            pg8::EpiKV E{out + O_MKP + (size_t)l * BP * NMEM * D, out + O_MVP + (size_t)l * BP * NMEM * D, KBP, VTP};
            pg8::gemm_phase<pg8::EpiKV, KVSched, true>(lds, g, S, E, wave_s);
        }
#define GEMM_BF16(s_) do { const int s = (s_); pg8::GSched S; pg8::Gemm g; pg8::EpiBf16 E; E.scale = 1.f; E.ss = nullptr; E.smp = 0; \
        if (s == 0) { S.init(MT / 256, INC / 256, G, bid); S.aPm = (size_t)256 * D * 2; S.bPn = (size_t)256 * D * 2; g = pg8::Gemm{XN, WIN_T, D, D, D}; E.O = gZ; E.ldc = INC; E.ss = SSQ(3 * l); } \
        else if (s == 1) { S.init(MT / 256, D / 256, G, bid); S.aPm = (size_t)256 * D * 2; S.bPn = (size_t)256 * D * 2; g = pg8::Gemm{XN, WQ_T, D, D, D}; E.O = gQ; E.ldc = D; E.scale = 0.0625f; E.ss = SSQ(3 * l + 1); } \
        else if (s == 2) { S.init(MP / 256, 4, G, bid); S.aPm = (size_t)256 * D * 2; S.aPn = 512; S.bPn = (size_t)256 * 2048 * 2; S.bPm = 512; S.bShift = 4; g = pg8::Gemm{gP, VTP, D, 2048, 256}; E.O = gO; E.ldc = D; } \
        else { S.init(1, 32, G, (bid + G - 64) % G); S.mode = 2; g = pg8::Gemm{PS, VTS, 8192, 2048, 256}; E.O = gO + (size_t)MP * D; E.ldc = D; E.smp = 1; } \
        pg8::gemm_phase<pg8::EpiBf16, pg8::GSched, true>(lds, g, S, E, wave_s); } while (0)
#define GEMM_RES(s_) do { const int s = (s_); pg8::GSched S; S.init(MT / 256, D / 256, G, bid); pg8::Gemm g; \
        if (s == 0) { g = pg8::Gemm{gY, WOUT_T, D, D, D}; S.aPm = (size_t)256 * D * 2; } \
        else if (s == 1) { g = pg8::Gemm{gO, WO_T, D, D, D}; S.aPm = (size_t)256 * D * 2; } \
        else { g = pg8::Gemm{GU, WDN_T, DFF, DFF, DFF}; S.aPm = (size_t)256 * DFF * 2; } \
        S.bPn = (size_t)256 * g.ldb * 2; \
        pg8::EpiResid E{XN, SSQ(3 * l + 1 + s)}; \
        pg8::gemm_phase<pg8::EpiResid, pg8::GSched, true>(lds, g, S, E, wave_s); } while (0)

        for (int rep = 0; rep < 13; ++rep) { if (rep == 4 || rep == 9 || rep == 11) continue;
          const int ndup = ((PROBE == 1 && (rep == 1 || rep == 2)) || (PROBE == 4 && rep == 1) || (PROBE == 6 && rep == 2)) ? 2 : ((PROBE == 2 && (rep == 0 || rep == 5 || rep == 6 || rep == 7 || rep == 10)) ? 2 : 1);
          for (int dup = 0; dup < ndup; ++dup) {
            if (rep == 0 || rep == 5 || rep == 7) {
                LANE_STATE();
                const int s0 = rep == 0 ? 0 : (rep == 5 ? 1 : 2), ns = rep == 7 ? 2 : 1;
                for (int q = 0; q < ns; ++q) GEMM_BF16(s0 + q);
            } else if (rep == 10) {
                LANE_STATE();
                pg8::GSched S; S.init(MT / 256, 2 * DFF / 256, G, bid); S.aPm = (size_t)256 * D * 2; S.bPn = (size_t)256 * D * 2;
                const pg8::Gemm g{XN, WUP_T, D, D, D};
                const pg8::EpiAct E{GU, INP(I_SCF) + (size_t)l * BS * 2 * DFF, out + O_CFS + (size_t)l * BS * 2 * DFF, SBG, SBU, SBL, INP(I_CFW) + (size_t)l * 3 * DFF, SSQ(3 * l + 2)};
                pg8::gemm_phase<pg8::EpiAct, pg8::GSched, true>(lds, g, S, E, wave_s);
            } else if (rep == 1) {
                LANE_STATE();
                {
                    LAS bf16_t* vT = (LAS bf16_t*)lds;
                    constexpr int VP = 136;
                    const float* gvp = INP(I_GV) + l * CW; const float* bsp = INP(I_BSS) + l * 4 * 128;
                    for (int un = (bid + G / 2) % G; un < 8 + 256; un += G) {
                        int rowbase, nrows, sb = -1;
                        if (un < 8) { sb = un; rowbase = MP + un * TS; nrows = TS; } else { rowbase = (un - 8) * 128; nrows = 128; }
                        {
                            const int rl = tid >> 5, cgp = tid & 31;
                            f32x4 g0 = *(const f32x4*)(gvp + cgp * 8), g1 = *(const f32x4*)(gvp + cgp * 8 + 4);
                            for (int p = 0; p < nrows / 16; ++p) {
                                const int r = p * 16 + rl;
                                const u32x4 raw = *(const u32x4*)(gZ + (size_t)(rowbase + r) * INC + Z_VC + cgp * 8);
                                float v[8] = {bflo(raw.x), bfhi(raw.x), bflo(raw.y), bfhi(raw.y), bflo(raw.z), bfhi(raw.z), bflo(raw.w), bfhi(raw.w)};
                                float ss = 0.f;
#pragma unroll
                                for (int k = 0; k < 8; ++k) { v[k] = gelu_t(v[k]); ss += v[k] * v[k]; }
                                ss += shx(ss, 1, lane); ss += shx(ss, 2, lane); ss += shx(ss, 4, lane);
                                const float rstd = 1.0f / sqrtf(ss * (1.f / 64.f) + EPS);
                                const float gg[8] = {g0.x, g0.y, g0.z, g0.w, g1.x, g1.y, g1.z, g1.w};
#pragma unroll
                                for (int k = 0; k < 8; ++k) { v[k] = v[k] * rstd * gg[k]; vT[(cgp * 8 + k) * VP + r] = (bf16_t)f2bf(v[k]); }
                                if (sb >= 0) { float* vo = out + O_VCS + ((size_t)(l * BS + sb) * TS + r) * CW + cgp * 8;
                                    *(f32x4*)vo = (f32x4){v[0], v[1], v[2], v[3]}; *(f32x4*)(vo + 4) = (f32x4){v[4], v[5], v[6], v[7]}; }
                            }
                        }
                        __syncthreads();
                        {
                            const int hh = wave & 3, rh = wave >> 2, fr = lane & 15, fq = lane >> 4;
                            const int nmt = nrows == 128 ? 4 : (rh == 0 ? 2 : 0);
                            for (int mi = 0; mi < nmt; ++mi) {
                                const int mt = rh * 4 + mi, nks = (mt * 16 + 15) / 32 + 1;
                                f32x4 acc[4];
#pragma unroll
                                for (int n = 0; n < 4; ++n) acc[n] = (f32x4){0.f, 0.f, 0.f, 0.f};
                                for (int ks = 0; ks < nks; ++ks) {
                                    const bf16x8 a = *(const bf16x8*)(WST + ((size_t)(hh * 128 + mt * 16 + fr) * 128 + ks * 32 + fq * 8));
#pragma unroll
                                    for (int n = 0; n < 4; ++n) { const bf16x8 b = *(const LAS bf16x8*)(vT + (hh * 64 + n * 16 + fr) * VP + ks * 32 + fq * 8);
                                        acc[n] = __builtin_amdgcn_mfma_f32_16x16x32_bf16(b, a, acc[n], 0, 0, 0); }
                                }
                                { const int t = mt * 16 + fr; const float bias = bsp[hh * 128 + t]; const size_t row = (size_t)(rowbase + t);
#pragma unroll
                                    for (int n = 0; n < 4; ++n) { const int c = hh * 64 + n * 16 + fq * 4; const u32x2 uq = *(const u32x2*)(gZ + row * INC + Z_UC + c);
                                        u32x2 w; w.x = pk2(gelu_t(bflo(uq.x)) * (acc[n][0] + bias), gelu_t(bfhi(uq.x)) * (acc[n][1] + bias)); w.y = pk2(gelu_t(bflo(uq.y)) * (acc[n][2] + bias), gelu_t(bfhi(uq.y)) * (acc[n][3] + bias));
                                        *(u32x2*)(gY + row * D + 768 + c) = w; } }
                            }
                        }
                        __syncthreads();
                    }
                }
                {
                    LAS unsigned char* wl = lds + wave * 16384;
                    LAS bf16_t* tile = (LAS bf16_t*)wl;
                    LAS float* pre_r = (LAS float*)(wl + 2560);
                    LAS float* pre_i = (LAS float*)(wl + 2560 + 4096);
                    LAS float* xcf = (LAS float*)(wl + 2560 + 8192);
                    const int fr = lane & 15, fq = lane >> 4;
                    for (int un = gw; un < 64 + 2048; un += NGW) {
                        int b, hd, rowbase, nrows, t0; bool smp = un < 64;
                        if (smp) { b = un >> 3; hd = un & 7; rowbase = MP + b * TS; nrows = TS; t0 = 0; }
                        else { const int v = un - 64; const int ch = v & 31; hd = (v >> 5) & 7; b = v >> 8; t0 = ch * 128; rowbase = b * SEQ + t0; nrows = 128; }
                        const int cidx = l * AW + hd * 64 + lane;
                        const float br = INP(I_BRG)[cidx], bi = INP(I_BIG)[cidx];
                        const float c8sp = 8.0f * log1pf(__expf(-INP(I_LAM)[cidx]));
                        const float* caw = INP(I_CAW) + (size_t)l * 4 * AW + hd * 64 + lane;
                        const float cw0 = caw[0], cw1 = caw[AW], cw2 = caw[2 * AW], cw3 = caw[3 * AW], cb = INP(I_CAB)[cidx];
                        bf16x8 bR[4][2], bI[4][2];
#pragma unroll
                        for (int n = 0; n < 4; ++n)
#pragma unroll
                            for (int ks = 0; ks < 2; ++ks) { const size_t o_ = (size_t)(hd * 64 + n * 16 + fr) * 64 + ks * 32 + fq * 8;
                                bR[n][ks] = *(const bf16x8*)(GT_R + o_); bI[n][ks] = *(const bf16x8*)(GT_I + o_); }
                        float xm3 = 0.f, xm2 = 0.f, xm1 = 0.f;
                        if (smp) { const float* st = INP(I_SCA) + ((size_t)(l * BS + b) * 3) * AW + hd * 64 + lane; xm3 = st[0]; xm2 = st[AW]; xm1 = st[2 * AW]; }
                        else if (t0 > 0) { const bf16_t* zp = gZ + (size_t)(rowbase - 3) * INC + Z_XA + hd * 64 + lane; xm3 = bf2f(zp[0]); xm2 = bf2f(zp[INC]); xm1 = bf2f(zp[2 * INC]); }
                        float h = 0.f, pc = 1.f;
                        const bf16_t* zq = gZ + (size_t)(rowbase + (lane >> 3)) * INC + Z_XA + hd * 64 + (lane & 7) * 8;
                        float* hp = HLOC + (size_t)rowbase * AW + hd * 64 + lane; float* pp = PCUM + (size_t)rowbase * AW + hd * 64 + lane;
                        LAS bf16_t* xraw = (LAS bf16_t*)pre_r;
                        u32x4 xn0 = *(const u32x4*)zq, xn1 = *(const u32x4*)(zq + (size_t)8 * INC);
                        for (int st = 0; st < nrows / 16; ++st) {
                            *(LAS u32x4*)(xraw + (lane >> 3) * 64 + (lane & 7) * 8) = xn0; *(LAS u32x4*)(xraw + ((lane >> 3) + 8) * 64 + (lane & 7) * 8) = xn1;
                            zq += (size_t)16 * INC;
                            if (st + 1 < nrows / 16) { xn0 = *(const u32x4*)zq; xn1 = *(const u32x4*)(zq + (size_t)8 * INC); }
                            LDS_WAIT();
#pragma unroll
                            for (int i = 0; i < 16; ++i) { const float xv = bf2f(xraw[i * 64 + lane]);
                                const float xc = cw0 * xm3 + cw1 * xm2 + cw2 * xm1 + cw3 * xv + cb; xm3 = xm2; xm2 = xm1; xm1 = xv; xcf[i * 64 + lane] = xc; tile[i * 72 + lane] = (bf16_t)f2bf(xc); }
                            LDS_WAIT();
                            const bf16x8 a0 = *(const LAS bf16x8*)(tile + fr * 72 + fq * 8), a1 = *(const LAS bf16x8*)(tile + fr * 72 + 32 + fq * 8);
#pragma unroll
                            for (int n = 0; n < 4; ++n) {
                                f32x4 ar = (f32x4){0.f, 0.f, 0.f, 0.f}, ai = (f32x4){0.f, 0.f, 0.f, 0.f};
                                ar = __builtin_amdgcn_mfma_f32_16x16x32_bf16(a0, bR[n][0], ar, 0, 0, 0); ar = __builtin_amdgcn_mfma_f32_16x16x32_bf16(a1, bR[n][1], ar, 0, 0, 0);
                                ai = __builtin_amdgcn_mfma_f32_16x16x32_bf16(a0, bI[n][0], ai, 0, 0, 0); ai = __builtin_amdgcn_mfma_f32_16x16x32_bf16(a1, bI[n][1], ai, 0, 0, 0);
#pragma unroll
                                for (int j = 0; j < 4; ++j) { pre_r[(fq * 4 + j) * 64 + n * 16 + fr] = ar[j]; pre_i[(fq * 4 + j) * 64 + n * 16 + fr] = ai[j]; }
                            }
                            LDS_WAIT();
#pragma unroll 4
                            for (int i = 0; i < 16; ++i) {
                                const float r = sigm(pre_r[i * 64 + lane] + br), gi = sigm(pre_i[i * 64 + lane] + bi);
                                const float la = -c8sp * r; float a, om;
                                if (la > -0.125f) { const float x = 2.0f * la; om = -x * (1.0f + x * (0.5f + x * (0.16666667f + x * (0.041666668f + x * (0.0083333338f + x * 0.0013888889f))))); a = 1.0f + la * (1.0f + la * (0.5f + la * (0.16666667f + la * (0.041666668f + la * 0.0083333338f)))); }
                                else { a = __expf(la); om = -expm1f(2.0f * la); }
                                const float bm = sqrtf(om);
                                h = a * h + bm * gi * xcf[i * 64 + lane]; pc = pc * a;
                                *hp = h; *pp = pc; hp += AW; pp += AW;
                            }
                            LDS_WAIT();
                        }
                        AGG[(size_t)un * 128 + lane] = pc; AGG[(size_t)un * 128 + 64 + lane] = h;
                    }
                }
                {
                    const float* cbw = INP(I_CBW) + (size_t)l * 3 * BW;
                    for (int it = gt; it < (MT / 8) * 32; it += NGT) {
                        const int rb = it >> 5, c0 = (it & 31) * 8;
                        int b, t0, T, rowbase; const bool smp = rb >= MP / 8;
                        if (!smp) { b = rb >> 9; t0 = (rb & 511) * 8; T = SEQ; rowbase = rb * 8; } else { const int sbk = rb - MP / 8; b = sbk >> 2; t0 = (sbk & 3) * 8; T = TS; rowbase = MP + sbk * 8; }
                        u32x4 xq[10], cq[10], bq[8];
                        const bf16_t* zr = gZ + (size_t)rowbase * INC + c0;
#pragma unroll
                        for (int i = 0; i < 10; ++i) { if (i >= 2 || t0 > 0) { xq[i] = *(const u32x4*)(zr + (ptrdiff_t)(i - 2) * INC + Z_XB); cq[i] = *(const u32x4*)(zr + (ptrdiff_t)(i - 2) * INC + Z_GC); } else { xq[i] = (u32x4){0u, 0u, 0u, 0u}; cq[i] = (u32x4){0u, 0u, 0u, 0u}; } }
#pragma unroll
                        for (int i = 0; i < 8; ++i) bq[i] = *(const u32x4*)(zr + (size_t)i * INC + Z_GB);
                        float w0[8], w1[8], w2[8], pm2[8], pm1[8];
#pragma unroll
                        for (int k = 0; k < 8; ++k) { w0[k] = cbw[c0 + k]; w1[k] = cbw[BW + c0 + k]; w2[k] = cbw[2 * BW + c0 + k]; }
                        {
                            const float a_[8] = {bflo(xq[0].x) * bflo(cq[0].x), bfhi(xq[0].x) * bfhi(cq[0].x), bflo(xq[0].y) * bflo(cq[0].y), bfhi(xq[0].y) * bfhi(cq[0].y), bflo(xq[0].z) * bflo(cq[0].z), bfhi(xq[0].z) * bfhi(cq[0].z), bflo(xq[0].w) * bflo(cq[0].w), bfhi(xq[0].w) * bfhi(cq[0].w)};
                            const float b_[8] = {bflo(xq[1].x) * bflo(cq[1].x), bfhi(xq[1].x) * bfhi(cq[1].x), bflo(xq[1].y) * bflo(cq[1].y), bfhi(xq[1].y) * bfhi(cq[1].y), bflo(xq[1].z) * bflo(cq[1].z), bfhi(xq[1].z) * bfhi(cq[1].z), bflo(xq[1].w) * bflo(cq[1].w), bfhi(xq[1].w) * bfhi(cq[1].w)};
#pragma unroll
                            for (int k = 0; k < 8; ++k) { pm2[k] = a_[k]; pm1[k] = b_[k]; }
                        }
                        if (t0 == 0 && smp) { const float* st = INP(I_SCB) + ((size_t)(l * BS + b) * 2) * BW + c0;
#pragma unroll
                            for (int k = 0; k < 8; ++k) { pm2[k] = st[k]; pm1[k] = st[BW + k]; } }
#pragma unroll
                        for (int i = 0; i < 8; ++i) {
                            const u32x4 xb = xq[i + 2], gc = cq[i + 2], gb = bq[i];
                            const float pv[8] = {bflo(xb.x) * bflo(gc.x), bfhi(xb.x) * bfhi(gc.x), bflo(xb.y) * bflo(gc.y), bfhi(xb.y) * bfhi(gc.y), bflo(xb.z) * bflo(gc.z), bfhi(xb.z) * bfhi(gc.z), bflo(xb.w) * bflo(gc.w), bfhi(xb.w) * bfhi(gc.w)};
                            const float gbv[8] = {bflo(gb.x), bfhi(gb.x), bflo(gb.y), bfhi(gb.y), bflo(gb.z), bfhi(gb.z), bflo(gb.w), bfhi(gb.w)};
                            float yv[8];
#pragma unroll
                            for (int k = 0; k < 8; ++k) { yv[k] = gbv[k] * (w0[k] * pm2[k] + w1[k] * pm1[k] + w2[k] * pv[k]); pm2[k] = pm1[k]; pm1[k] = pv[k]; }
                            u32x4 w; w.x = pk2(yv[0], yv[1]); w.y = pk2(yv[2], yv[3]); w.z = pk2(yv[4], yv[5]); w.w = pk2(yv[6], yv[7]);
                            *(u32x4*)(gY + (size_t)(rowbase + i) * D + 512 + c0) = w;
                        }
                        if (t0 + 8 == T) { float* o = out + (smp ? O_CBS : O_CBP) + ((size_t)(l * 8 + b) * 2) * BW + c0;
#pragma unroll
                            for (int k = 0; k < 8; ++k) { o[k] = pm2[k]; o[BW + k] = pm1[k]; } }
                    }
                }
            } else if (rep == 2) {
                LANE_STATE();
                {
                    LAS float* cr = (LAS float*)lds;
                    for (int un = bid; un < 8 + 256; un += G) {
                        int b, ch, rowbase, nrows; const bool smp = un < 8;
                        if (smp) { b = un; ch = 0; rowbase = MP + b * TS; nrows = TS; } else { const int v = un - 8; b = v >> 5; ch = v & 31; rowbase = b * SEQ + ch * 128; nrows = 128; }
                        {
                            const int c = tid, hd = c >> 6, ln = c & 63; float carry = 0.f;
                            if (smp) carry = INP(I_SHA)[(size_t)(l * BS + b) * AW + c];
                            else { const float* ag = AGG + (size_t)(64 + (b << 8) + (hd << 5)) * 128 + ln; for (int k = 0; k < ch; ++k) carry = ag[(size_t)k * 128] * carry + ag[(size_t)k * 128 + 64]; }
                            cr[c] = carry;
                        }
                        __syncthreads();
                        const int c0 = (tid & 63) * 8, rsub = tid >> 6;
                        const f32x4 ca = *(const LAS f32x4*)(cr + c0), cb = *(const LAS f32x4*)(cr + c0 + 4);
                        for (int p = 0; p < nrows / 8; ++p) {
                            const int rloc = p * 8 + rsub; const size_t row = (size_t)(rowbase + rloc);
                            const f32x4 h0 = *(const f32x4*)(HLOC + row * AW + c0), h1 = *(const f32x4*)(HLOC + row * AW + c0 + 4), p0 = *(const f32x4*)(PCUM + row * AW + c0), p1 = *(const f32x4*)(PCUM + row * AW + c0 + 4);
                            const u32x4 gq = *(const u32x4*)(gZ + row * INC + Z_GA + c0);
                            const f32x4 a0 = h0 + p0 * ca, a1 = h1 + p1 * cb;
                            u32x4 w; w.x = pk2(gelu_t(bflo(gq.x)) * a0[0], gelu_t(bfhi(gq.x)) * a0[1]); w.y = pk2(gelu_t(bflo(gq.y)) * a0[2], gelu_t(bfhi(gq.y)) * a0[3]);
                            w.z = pk2(gelu_t(bflo(gq.z)) * a1[0], gelu_t(bfhi(gq.z)) * a1[1]); w.w = pk2(gelu_t(bflo(gq.w)) * a1[2], gelu_t(bfhi(gq.w)) * a1[3]);
                            *(u32x4*)(gY + row * D + c0) = w;
                            if ((smp || ch == 31) && rloc == nrows - 1) { float* o = out + (smp ? O_HAS : O_HAP) + (size_t)(l * 8 + b) * AW + c0; *(f32x4*)o = a0; *(f32x4*)(o + 4) = a1; }
                        }
                        if ((smp || ch == 31) && tid < 192) {
                            const int k = tid >> 6; const u32x4 xq = *(const u32x4*)(gZ + (size_t)(rowbase + nrows - 3 + k) * INC + Z_XA + c0);
                            float* o = out + (smp ? O_CAS : O_CAP) + ((size_t)(l * 8 + b) * 3 + k) * AW + c0;
                            *(f32x4*)o = (f32x4){bflo(xq.x), bfhi(xq.x), bflo(xq.y), bfhi(xq.y)}; *(f32x4*)(o + 4) = (f32x4){bflo(xq.z), bfhi(xq.z), bflo(xq.w), bfhi(xq.w)};
                        }
                        __syncthreads();
                    }
                }
            } else if (rep == 3 || rep == 8 || rep == 12) {
                LANE_STATE();
                if (rep == 12) {
                    const float* cfw = INP(I_CFW) + (size_t)l * 3 * DFF;
                    pg8::GSched S0; S0.init(MT / 256, D / 256, G, bid); pg8::Unit u0;
                    for (int i = 0; S0.next(i, u0); ++i) {
                        const int pm = u0.pm; if (pm >= 128 || tid >= DFF / 8) continue;
                        const int c0 = tid * 8, b = pm >> 4;
                        float w0[8], w1[8], w2[8], p2[8], p1[8], g0[8], g1[8], u0_[8], u1_[8];
#pragma unroll
                        for (int k = 0; k < 8; ++k) { w0[k] = cfw[c0 + k]; w1[k] = cfw[DFF + c0 + k]; w2[k] = cfw[2 * DFF + c0 + k]; p2[k] = 0.f; p1[k] = 0.f; }
                        if ((pm & 15) != 0) {
#pragma unroll
                            for (int k = 0; k < 8; ++k) { p2[k] = SBL[((size_t)(pm - 1) * 2 + 0) * DFF + c0 + k]; p1[k] = SBL[((size_t)(pm - 1) * 2 + 1) * DFF + c0 + k]; } }
#pragma unroll
                        for (int k = 0; k < 8; ++k) { g0[k] = SBG[((size_t)pm * 2 + 0) * DFF + c0 + k]; g1[k] = SBG[((size_t)pm * 2 + 1) * DFF + c0 + k]; u0_[k] = SBU[((size_t)pm * 2 + 0) * DFF + c0 + k]; u1_[k] = SBU[((size_t)pm * 2 + 1) * DFF + c0 + k]; }
                        float ha[8], hb[8];
#pragma unroll
                        for (int k = 0; k < 8; ++k) { ha[k] = silu(w0[k] * p2[k] + w1[k] * p1[k] + w2[k] * g0[k]) * u0_[k]; hb[k] = silu(w0[k] * p1[k] + w1[k] * g0[k] + w2[k] * g1[k]) * u1_[k]; }
                        u32x4 w; w.x = pk2(ha[0], ha[1]); w.y = pk2(ha[2], ha[3]); w.z = pk2(ha[4], ha[5]); w.w = pk2(ha[6], ha[7]);
                        *(u32x4*)(GU + (size_t)(pm * 256) * DFF + c0) = w;
                        w.x = pk2(hb[0], hb[1]); w.y = pk2(hb[2], hb[3]); w.z = pk2(hb[4], hb[5]); w.w = pk2(hb[6], hb[7]);
                        *(u32x4*)(GU + (size_t)(pm * 256 + 1) * DFF + c0) = w;
                        if ((pm & 15) == 15 && u0.pn == 0) { float* o = out + O_CFP + ((size_t)(l * 8 + b) * 2) * DFF + c0;
#pragma unroll
                            for (int k = 0; k < 8; ++k) { o[k] = SBL[((size_t)pm * 2 + 0) * DFF + c0 + k]; o[DFF + k] = SBL[((size_t)pm * 2 + 1) * DFF + c0 + k]; } }
                    }
                    asm volatile("s_waitcnt vmcnt(0)" ::: "memory"); __syncthreads();
                }
                GEMM_RES(rep == 3 ? 0 : (rep == 8 ? 1 : 2));
            } else if (rep == 6) {
                LANE_STATE();
                for (int sub = 0; sub < 2; ++sub) {
                    pg8::GSched S; pg8::Gemm g; pg8::EpiSoftmax E;
                    if (sub == 0) { S.init(MP / 256, 4, G, bid); S.aPm = (size_t)256 * D * 2; S.aPn = 512; S.bPn = 512; S.bPm = (size_t)256 * D * 2; S.bShift = 4; g = pg8::Gemm{gQ, KBP, D, D, 256}; E.O = gP; E.ldc = D; E.smp = 0; }
                    else { S.init(1, 32, G, (bid + G - 64) % G); S.mode = 1; g = pg8::Gemm{gQ + (size_t)MP * D, KBS, D, D, 256}; E.O = PS; E.ldc = 8192; E.smp = 1; }
                    pg8::gemm_phase<pg8::EpiSoftmax, pg8::GSched, true>(lds, g, S, E, wave_s);
                }
            }
            GRID_SYNC();
          }
        }
    }
    {
        LANE_STATE();
        const float* gain = INP(I_GFIN);
        f32x4 gv[4];
#pragma unroll
        for (int j = 0; j < 4; ++j) gv[j] = ((const f32x4*)gain)[lane + 64 * j];
        for (int m0 = gw; m0 < MT; m0 += 2 * NGW) {
            const int m1 = m0 + NGW; const bool two = m1 < MT; const int mb = two ? m1 : m0;
            const u32x2* xa = (const u32x2*)(XN + (size_t)m0 * D) + lane; const u32x2* xb = (const u32x2*)(XN + (size_t)mb * D) + lane;
            u32x2 pa[4], pb[4];
#pragma unroll
            for (int j = 0; j < 4; ++j) { pa[j] = xa[64 * j]; pb[j] = xb[64 * j]; }
            const float ra = ss_rstd(*(const f32x4*)(SSQ(6) + (size_t)m0 * 4)), rb = ss_rstd(*(const f32x4*)(SSQ(6) + (size_t)mb * 4));
            f32x4* ya = (f32x4*)(out + (size_t)m0 * D) + lane; f32x4* yb = (f32x4*)(out + (size_t)mb * D) + lane;
#pragma unroll
            for (int j = 0; j < 4; ++j) { ya[64 * j] = (f32x4){bflo(pa[j].x), bfhi(pa[j].x), bflo(pa[j].y), bfhi(pa[j].y)} * ra * gv[j]; if (two) yb[64 * j] = (f32x4){bflo(pb[j].x), bfhi(pb[j].x), bflo(pb[j].y), bfhi(pb[j].y)} * rb * gv[j]; }
        }
    }
}

extern "C" void kernel_launch(void* const* d_in, const int* in_sizes, int n_in, void* d_out, int out_size, void* d_ws, size_t ws_size, hipStream_t stream) {
    static int grid = 0;
    if (grid == 0) {
        if (n_in != N_IN || (size_t)out_size != O_END || ws_size < WS_END) { fprintf(stderr, "kernel_launch: unexpected sizes n_in %d out %d ws %zu (need %zu)\n", n_in, out_size, ws_size, (size_t)WS_END); grid = -1; return; }
        int dev = 0, cus = 0, per_cu = 0;
        (void)hipGetDevice(&dev); (void)hipDeviceGetAttribute(&cus, hipDeviceAttributeMultiprocessorCount, dev);
        if (hipFuncSetAttribute((const void*)trunk_fwd, hipFuncAttributeMaxDynamicSharedMemorySize, LDS_BYTES) != hipSuccess) { fprintf(stderr, "kernel_launch: hipFuncSetAttribute failed\n"); grid = -1; return; }
        if (hipOccupancyMaxActiveBlocksPerMultiprocessor(&per_cu, (const void*)trunk_fwd, NTHREADS, LDS_BYTES) != hipSuccess || per_cu < 1) { fprintf(stderr, "kernel_launch: occupancy query gave %d\n", per_cu); per_cu = 1; }
        (void)hipGetLastError();
        grid = cus * 1;
        if (grid != 256) fprintf(stderr, "kernel_launch: note: %d CUs\n", grid);
    }
    if (grid < 0) return;
    Args a{};
    for (int i = 0; i < N_IN; ++i) a.in[i] = (const float*)d_in[i];
    a.out = (float*)d_out; a.ws = (unsigned char*)d_ws;
    void* kargs[] = {&a};
    hipError_t e = hipLaunchCooperativeKernel((const void*)trunk_fwd, dim3(grid), dim3(NTHREADS), kargs, LDS_BYTES, stream);
    if (e != hipSuccess) fprintf(stderr, "kernel_launch: cooperative launch failed: %s (grid %d)\n", hipGetErrorString(e), grid);
}
```

```cpp
#include <hip/hip_runtime.h>
#include <hip/hip_cooperative_groups.h>
#include <cstdio>
#include <cstdint>
namespace cg = cooperative_groups;
#ifndef PROBE
#define PROBE 0
#endif

#define LAS __attribute__((address_space(3)))
typedef unsigned short bf16_t;
typedef short bf16x8 __attribute__((ext_vector_type(8)));
typedef float f32x4 __attribute__((ext_vector_type(4)));
typedef float f32x2 __attribute__((ext_vector_type(2)));
typedef unsigned u32x4 __attribute__((ext_vector_type(4)));
typedef unsigned u32x2 __attribute__((ext_vector_type(2)));

constexpr int D = 1024, BP = 8, SEQ = 4096, BS = 8, TS = 32, DEPTH = 2;
constexpr int MP = BP * SEQ, MS = BS * TS, MT = MP + MS;
constexpr int INC = 2304, DFF = 2816, NMEM = 256, AW = 512, BW = 256, CW = 256;
constexpr int Z_XA = 0, Z_GA = 512, Z_XB = 1024, Z_GB = 1280, Z_GC = 1536, Z_UC = 1792, Z_VC = 2048;
constexpr float EPS = 1e-6f;
constexpr int NWAVES = 8, NTHREADS = 512;

constexpr size_t O_YP = 0, O_YS = O_YP + (size_t)MP * D, O_CAP = O_YS + (size_t)MS * D, O_HAP = O_CAP + DEPTH * BP * 3 * AW,
                 O_CBP = O_HAP + DEPTH * BP * AW, O_CFP = O_CBP + DEPTH * BP * 2 * BW, O_MKP = O_CFP + DEPTH * BP * 2 * DFF,
                 O_MVP = O_MKP + (size_t)DEPTH * BP * NMEM * D, O_CAS = O_MVP + (size_t)DEPTH * BP * NMEM * D, O_HAS = O_CAS + DEPTH * BS * 3 * AW,
                 O_CBS = O_HAS + DEPTH * BS * AW, O_CFS = O_CBS + DEPTH * BS * 2 * BW, O_VCS = O_CFS + DEPTH * BS * 2 * DFF,
                 O_END = O_VCS + DEPTH * BS * TS * CW;

constexpr size_t MiB = 1u << 20;
constexpr size_t WS_WIN = 0, WS_WOUT = 5 * MiB, WS_WQ = 7 * MiB, WS_WK = 9 * MiB, WS_WV = 11 * MiB, WS_WO = 13 * MiB, WS_WUP = 15 * MiB, WS_WDN = 26 * MiB;
constexpr size_t WS_MEMB = 32 * MiB, WS_KBP = 36 * MiB, WS_VTP = 40 * MiB, WS_KBS = 44 * MiB, WS_VTS = 48 * MiB, WS_WST = 52 * MiB, WS_GT = WS_WST + 131072, WS_AGG = 53 * MiB, WS_SS = 54 * MiB + 256 * 1024, WS_BAR = 55 * MiB + 512 * 1024;
constexpr size_t WS_XN = 56 * MiB, WS_BIG = 121 * MiB;
constexpr size_t B_Z = WS_BIG, B_HLOC = WS_BIG + 146 * MiB, B_PCUM = WS_BIG + 211 * MiB, B_Y = WS_BIG + 276 * MiB;
constexpr size_t B_Q = WS_BIG, B_P = WS_BIG + 65 * MiB, B_O = WS_BIG + 130 * MiB, B_PS = WS_BIG + 195 * MiB;
constexpr size_t B_GU = WS_BIG;
constexpr size_t B_GUS = WS_BIG + 200 * MiB;
constexpr size_t B_SBG = WS_BIG + 204 * MiB, B_SBU = WS_BIG + 207 * MiB, B_SBL = WS_BIG + 210 * MiB;
constexpr size_t WS_END = WS_BIG + (size_t)MT * 2 * DFF * 2;
constexpr size_t WS_SSP = 476 * MiB;
static_assert(WS_END <= WS_SSP && WS_SSP + (size_t)7 * MT * 64 <= 512 * MiB, "workspace");
static_assert(WS_XN + (size_t)MT * D * 2 <= WS_BIG, "xn");
constexpr size_t WSEL1 = 480 * MiB, KSEL1 = 418 * MiB;
static_assert(WS_WDN + (size_t)D * DFF * 2 + WSEL1 <= 512 * MiB && WS_KBS + KSEL1 >= WS_BIG + 341 * MiB && WS_GT + 131072 + KSEL1 <= WS_SSP, "second buffer set");

constexpr int LDS_RING = 131072, LDS_EX = LDS_RING, LDS_MISC = LDS_EX + 8192, LDS_BYTES = 147456;

enum { I_XP = 0, I_XS, I_MEM, I_CK, I_CV, I_SCA, I_SHA, I_SCB, I_SCF, I_GMIX, I_WIN, I_CAW, I_CAB, I_WRG, I_BRG, I_WIG, I_BIG, I_LAM, I_CBW, I_GV, I_WS, I_BSS,
       I_WOUT, I_GX, I_WQ, I_WK, I_WV, I_WO, I_GFFN, I_WUP, I_CFW, I_WDN, I_GFIN, N_IN };

struct Args { const float* in[N_IN]; float* out; unsigned char* ws; };

__device__ __forceinline__ unsigned f2bf(float f) { unsigned u = __builtin_bit_cast(unsigned, f); return (u + 0x7fffu + ((u >> 16) & 1u)) >> 16; }
__device__ __forceinline__ unsigned pk2(float lo, float hi) { return f2bf(lo) | (f2bf(hi) << 16); }
__device__ __forceinline__ float bf2f(unsigned v) { return __builtin_bit_cast(float, v << 16); }
__device__ __forceinline__ float bflo(unsigned w) { return __builtin_bit_cast(float, w << 16); }
__device__ __forceinline__ float bfhi(unsigned w) { return __builtin_bit_cast(float, w & 0xffff0000u); }
__device__ __forceinline__ unsigned cvt_pk_bf16(float lo, float hi) { unsigned r; asm volatile("v_cvt_pk_bf16_f32 %0, %1, %2" : "=v"(r) : "v"(lo), "v"(hi)); return r; }
__device__ __forceinline__ float fexp(float x) { return __builtin_amdgcn_exp2f(x * 1.4426950408889634f); }
__device__ __forceinline__ float sigm(float x) { return __builtin_amdgcn_rcpf(1.0f + fexp(-x)); }
__device__ __forceinline__ float gelu_t(float x) { const float u = 0.7978845608028654f * (x + 0.044715f * x * x * x); return x * sigm(2.0f * u); }
__device__ __forceinline__ float silu(float x) { return x * sigm(x); }
__device__ __forceinline__ float shx(float v, int m, int lane) { return __builtin_bit_cast(float, __builtin_amdgcn_ds_bpermute((lane ^ m) << 2, __builtin_bit_cast(int, v))); }
__device__ __forceinline__ float wave_sum(float v, int lane) {
#pragma unroll
    for (int o = 1; o < 64; o <<= 1) v += shx(v, o, lane);
    return v;
}
#define LDS_WAIT() asm volatile("s_waitcnt lgkmcnt(0)" ::: "memory")
__device__ __forceinline__ float ss_rstd(f32x4 p) { return 1.0f / sqrtf(((p[0] + p[1]) + (p[2] + p[3])) * (1.f / 1024.f) + 1e-6f); }
__device__ __forceinline__ int opaque_tid(int wave_s) { int l; asm volatile("v_mbcnt_lo_u32_b32 %0, -1, 0\n\tv_mbcnt_hi_u32_b32 %0, -1, %0" : "=v"(l)); return wave_s * 64 + l; }

namespace pg8 {
constexpr int BM = 256, BK = 64, HALF = 128, HTB = HALF * BK * 2, NXCD = 8, WGM = 8;
__device__ __forceinline__ int lds_byte(int r, int c) { const int st = (r >> 4) * 2 + (c >> 5), rr = r & 15, cc = c & 31, ob = rr * 64 + cc * 2; return st * 1024 + (ob ^ (((ob >> 9) & 1) << 5)); }
__device__ __forceinline__ void stage_rc(int b, int& R, int& C) { const int st = b / 1024, sb = b % 1024, swz = sb ^ (((sb >> 9) & 1) << 5); R = (st >> 1) * 16 + swz / 64; C = (st & 1) * 32 + (swz % 64) / 2; }
__device__ __forceinline__ int perm32(int rho) { const int n = rho >> 4, i = rho & 15; return 8 * (i >> 2) + 4 * n + (i & 3); }

struct Unit { int pm, pn; };
struct Gemm { const bf16_t* A; const bf16_t* Bt; int lda, ldb, K; };

struct GSched {
    int nM, nN, nwg, G, c, mode;
    size_t aPm, aPn, bPn, bPm; int bShift;
    __device__ __forceinline__ void init(int nM_, int nN_, int G_, int c_) { nM = nM_; nN = nN_; nwg = nM * nN; G = G_; c = c_; mode = 0; aPm = 0; aPn = 0; bPn = 0; bPm = 0; bShift = 0; }
    __device__ __forceinline__ bool next(int i, Unit& u) const {
        const long L = (long)i * G + c; if (L >= nwg) return false;
        int wgid = (int)L; { const int q = nwg / NXCD, r = nwg % NXCD, xcd = wgid % NXCD, off = wgid / NXCD; wgid = (xcd < r ? xcd * (q + 1) : r * (q + 1) + (xcd - r) * q) + off; }
        const int nig = WGM * nN, gid = wgid / nig, fm = gid * WGM, gsz = (nM - fm) < WGM ? (nM - fm) : WGM;
        u.pm = fm + ((wgid % nig) % gsz); u.pn = (wgid % nig) / gsz; return true;
    }
    __device__ __forceinline__ size_t offA(const Unit& u) const { return mode == 1 ? (size_t)(u.pn & 3) * 512 : (mode == 2 ? (size_t)(u.pn & 3) * 4096 + (size_t)(u.pn >> 2) * 512 : (size_t)u.pm * aPm + (size_t)u.pn * aPn); }
    __device__ __forceinline__ size_t offB(const Unit& u) const { return mode == 1 ? (size_t)(u.pn >> 2) * (256 * 1024 * 2) + (size_t)(u.pn & 3) * 512 : (mode == 2 ? (size_t)(u.pn & 3) * (256 * 2048 * 2) + (size_t)(u.pn >> 2) * 512 : (size_t)u.pn * bPn + (size_t)(u.pm >> bShift) * bPm); }
};

struct EpiBf16 {
    static constexpr bool PERM = true;
    bf16_t* O; int ldc; float scale; const float* ss; int smp;
    __device__ __forceinline__ void operator()(f32x4 (&acc)[2][2][4][2], const Unit& u, int wr, int wc, int fr, int fq, LAS unsigned char*) const {
        asm volatile("" : "+v"(fr), "+v"(fq)); asm volatile("" : "+s"(wr), "+s"(wc));
        const int row0 = u.pm * BM + wr * 64 + fr, col0 = (smp ? (u.pn & 3) : u.pn) * BM + wc * 32 + 8 * fq;
        f32x4 rs[2][4];
#pragma unroll
        for (int ai = 0; ai < 2; ++ai)
#pragma unroll
            for (int m = 0; m < 4; ++m) rs[ai][m] = ss ? *(const f32x4*)(ss + (size_t)(row0 + ai * HALF + m * 16) * 4) : (f32x4){0.f, 0.f, 0.f, 0.f};
#pragma unroll
        for (int ai = 0; ai < 2; ++ai)
#pragma unroll
            for (int m = 0; m < 4; ++m) { bf16_t* rowp = O + (size_t)(row0 + ai * HALF + m * 16) * ldc + col0;
                float sc = scale; if (ss) sc *= ss_rstd(rs[ai][m]);
                if (smp && ((ai * HALF + wr * 64 + m * 16 + fr) >> 5) != (u.pn >> 2)) continue;
#pragma unroll
                for (int bj = 0; bj < 2; ++bj) { const f32x4 v0 = acc[ai][bj][m][0] * sc, v1 = acc[ai][bj][m][1] * sc;
                    u32x4 w; w.x = cvt_pk_bf16(v0[0], v0[1]); w.y = cvt_pk_bf16(v0[2], v0[3]); w.z = cvt_pk_bf16(v1[0], v1[1]); w.w = cvt_pk_bf16(v1[2], v1[3]);
                    *(u32x4*)(rowp + bj * HALF) = w; } }
    }
};
struct EpiResid {
    static constexpr bool PERM = true;
    bf16_t* xb; float* ss;
    __device__ __forceinline__ void operator()(f32x4 (&acc)[2][2][4][2], const Unit& u, int wr, int wc, int fr, int fq, LAS unsigned char* lds) const {
        asm volatile("" : "+v"(fr), "+v"(fq)); asm volatile("" : "+s"(wr), "+s"(wc));
        const int col0 = u.pn * BM + wc * 32 + 8 * fq, lane = fq * 16 + fr;
        LAS float* PS = (LAS float*)(lds + LDS_EX);
        bf16_t* ob = xb + (size_t)u.pm * BM * D;
#pragma unroll
        for (int ai = 0; ai < 2; ++ai) {
            u32x4 pre[4][2];
#pragma unroll
            for (int m = 0; m < 4; ++m)
#pragma unroll
                for (int bj = 0; bj < 2; ++bj) pre[m][bj] = *(const u32x4*)(ob + (size_t)(ai * HALF + wr * 64 + m * 16 + fr) * D + col0 + bj * HALF);
            asm volatile("" ::: "memory");
#pragma unroll
            for (int m = 0; m < 4; ++m) { const int rl = ai * HALF + wr * 64 + m * 16 + fr; const size_t off = (size_t)rl * D + col0; float q = 0.f;
#pragma unroll
                for (int bj = 0; bj < 2; ++bj) { const u32x4 p = pre[m][bj]; const f32x4 a0 = acc[ai][bj][m][0], a1 = acc[ai][bj][m][1];
                    const float v0 = bflo(p.x) + a0[0], v1 = bfhi(p.x) + a0[1], v2 = bflo(p.y) + a0[2], v3 = bfhi(p.y) + a0[3], v4 = bflo(p.z) + a1[0], v5 = bfhi(p.z) + a1[1], v6 = bflo(p.w) + a1[2], v7 = bfhi(p.w) + a1[3];
                    u32x4 w; w.x = cvt_pk_bf16(v0, v1); w.y = cvt_pk_bf16(v2, v3); w.z = cvt_pk_bf16(v4, v5); w.w = cvt_pk_bf16(v6, v7); *(u32x4*)(ob + off + bj * HALF) = w;
                    q += ((v0 * v0 + v1 * v1) + (v2 * v2 + v3 * v3)) + ((v4 * v4 + v5 * v5) + (v6 * v6 + v7 * v7)); }
                q += shx(q, 16, lane); q += shx(q, 32, lane);
                if (fq == 0) PS[rl * 4 + wc] = q; }
            asm volatile("" ::: "memory");
        }
        asm volatile("s_waitcnt lgkmcnt(0)" ::: "memory"); __builtin_amdgcn_s_barrier(); asm volatile("" ::: "memory");
        { const int t = (wr * 4 + wc) * 64 + lane; if (t < 256) { const f32x4 p = *(const LAS f32x4*)(PS + t * 4); ss[(size_t)(u.pm * BM + t) * 4 + u.pn] = (p[0] + p[1]) + (p[2] + p[3]); } }
    }
};
struct EpiKV {
    static constexpr bool PERM = false;
    float* outK; float* outV; bf16_t* KB; bf16_t* VT;
    __device__ __forceinline__ void operator()(f32x4 (&acc)[2][2][4][2], const Unit& u, int wr, int wc, int fr, int fq, LAS unsigned char*) const {
        asm volatile("" : "+v"(fr), "+v"(fq)); asm volatile("" : "+s"(wr), "+s"(wc));
        const int kind = u.pm >> 4, pm = u.pm & 15;
        const int col0 = u.pn * BM + wc * 32 + 4 * fq;
        float* of = kind == 0 ? outK : outV; bf16_t* ob = kind == 0 ? KB : VT; const int ldb_ = kind == 2 ? 2048 : 1024;
#pragma unroll
        for (int ai = 0; ai < 2; ++ai)
#pragma unroll
            for (int m = 0; m < 4; ++m) { const int row = pm * BM + ai * HALF + wr * 64 + m * 16 + fr;
#pragma unroll
                for (int bj = 0; bj < 2; ++bj)
#pragma unroll
                    for (int n = 0; n < 2; ++n) { const f32x4 v = acc[ai][bj][m][n]; const int col = col0 + bj * HALF + n * 16;
                        if (kind != 2) *(f32x4*)(of + (size_t)row * 1024 + col) = v;
                        if (kind != 1) { u32x2 w; w.x = cvt_pk_bf16(v[0], v[1]); w.y = cvt_pk_bf16(v[2], v[3]); *(u32x2*)(ob + (size_t)row * ldb_ + col) = w; } } }
    }
};
struct EpiSoftmax {
    static constexpr bool PERM = true;
    bf16_t* O; int ldc; int smp;
    __device__ __forceinline__ void operator()(f32x4 (&acc)[2][2][4][2], const Unit& u, int wr, int wc, int fr, int fq, LAS unsigned char* lds) const {
        asm volatile("" : "+v"(fr), "+v"(fq)); asm volatile("" : "+s"(wr), "+s"(wc));
        LAS f32x2* EX = (LAS f32x2*)(lds + LDS_EX);
        const int lane = fq * 16 + fr;
        const float L2E = 1.4426950408889634f;
#pragma unroll
        for (int ai = 0; ai < 2; ++ai)
#pragma unroll
            for (int m = 0; m < 4; ++m) {
                float mx = -3.0e38f;
#pragma unroll
                for (int bj = 0; bj < 2; ++bj)
#pragma unroll
                    for (int n = 0; n < 2; ++n) { const f32x4 x = acc[ai][bj][m][n]; mx = fmaxf(mx, fmaxf(fmaxf(x[0], x[1]), fmaxf(x[2], x[3]))); }
                mx = fmaxf(mx, shx(mx, 16, lane)); mx = fmaxf(mx, shx(mx, 32, lane));
                float s = 0.f;
#pragma unroll
                for (int bj = 0; bj < 2; ++bj)
#pragma unroll
                    for (int n = 0; n < 2; ++n) { f32x4 x = acc[ai][bj][m][n];
#pragma unroll
                        for (int j = 0; j < 4; ++j) { x[j] = __builtin_amdgcn_exp2f((x[j] - mx) * L2E); s += x[j]; }
                        acc[ai][bj][m][n] = x; }
                s += shx(s, 16, lane); s += shx(s, 32, lane);
                if (fq == 0) EX[(ai * HALF + wr * 64 + m * 16 + fr) * 4 + wc] = (f32x2){mx, s};
            }
        asm volatile("s_waitcnt lgkmcnt(0)" ::: "memory"); __builtin_amdgcn_s_barrier(); asm volatile("" ::: "memory");
        int colb = u.pn * BM, j_ = 0;
        if (smp) { colb = (u.pn & 3) * 2048 + (u.pn >> 2) * 256; j_ = u.pn >> 2; }
        const int col0 = colb + wc * 32 + 8 * fq;
#pragma unroll
        for (int ai = 0; ai < 2; ++ai)
#pragma unroll
            for (int m = 0; m < 4; ++m) {
                const int rl = ai * HALF + wr * 64 + m * 16 + fr;
                const f32x2 e0 = EX[rl * 4 + 0], e1 = EX[rl * 4 + 1], e2 = EX[rl * 4 + 2], e3 = EX[rl * 4 + 3];
                const float M = fmaxf(fmaxf(e0.x, e1.x), fmaxf(e2.x, e3.x));
                const float tot = e0.y * __builtin_amdgcn_exp2f((e0.x - M) * L2E) + e1.y * __builtin_amdgcn_exp2f((e1.x - M) * L2E) + e2.y * __builtin_amdgcn_exp2f((e2.x - M) * L2E) + e3.y * __builtin_amdgcn_exp2f((e3.x - M) * L2E);
                const float own = wc == 0 ? e0.x : (wc == 1 ? e1.x : (wc == 2 ? e2.x : e3.x));
                float f = __builtin_amdgcn_exp2f((own - M) * L2E) / tot;
                if (smp && (rl >> 5) != j_) f = 0.f;
                bf16_t* rowp = O + (size_t)(u.pm * BM + rl) * ldc + col0;
#pragma unroll
                for (int bj = 0; bj < 2; ++bj) { const f32x4 v0 = acc[ai][bj][m][0] * f, v1 = acc[ai][bj][m][1] * f;
                    u32x4 w; w.x = cvt_pk_bf16(v0[0], v0[1]); w.y = cvt_pk_bf16(v0[2], v0[3]); w.z = cvt_pk_bf16(v1[0], v1[1]); w.w = cvt_pk_bf16(v1[2], v1[3]);
                    *(u32x4*)(rowp + bj * HALF) = w; } }
    }
};


__device__ __forceinline__ float dpp_ror1(float v) { return __builtin_bit_cast(float, __builtin_amdgcn_update_dpp(0, __builtin_bit_cast(int, v), 0x121, 0xf, 0xf, false)); }
__device__ __forceinline__ float dpp_ror2(float v) { return __builtin_bit_cast(float, __builtin_amdgcn_update_dpp(0, __builtin_bit_cast(int, v), 0x122, 0xf, 0xf, false)); }
struct EpiAct {
    static constexpr bool PERM = true;
    bf16_t* H; const float* scf; float* ocf; float* sbg; float* sbu; float* sbl; const float* cfw; const float* ss;
    __device__ __forceinline__ void operator()(f32x4 (&acc)[2][2][4][2], const Unit& u, int wr, int wc, int fr, int fq, LAS unsigned char* lds) const {
        asm volatile("" : "+s"(wr), "+s"(wc));
        int lane; asm volatile("v_mbcnt_lo_u32_b32 %0, -1, 0\n\tv_mbcnt_hi_u32_b32 %0, -1, %0" : "=v"(lane));
        fr = lane & 15; fq = lane >> 4;
        const int fl = wc * 32 + 8 * fq, f0 = u.pn * 128 + fl; int rowt = wr * 64 + fr;
        {
            float rst[2][4];
            f32x4 rsl[2][4];
#pragma unroll
            for (int ai = 0; ai < 2; ++ai)
#pragma unroll
                for (int m = 0; m < 4; ++m) rsl[ai][m] = *(const f32x4*)(ss + (size_t)(u.pm * BM + ai * HALF + rowt + m * 16) * 4);
#pragma unroll
            for (int ai = 0; ai < 2; ++ai)
#pragma unroll
                for (int m = 0; m < 4; ++m) { rst[ai][m] = ss_rstd(rsl[ai][m]); }
#pragma unroll
            for (int ai = 0; ai < 2; ++ai)
#pragma unroll
                for (int m = 0; m < 4; ++m) { acc[ai][0][m][0] = acc[ai][0][m][0] * rst[ai][m]; acc[ai][0][m][1] = acc[ai][0][m][1] * rst[ai][m]; acc[ai][1][m][0] = acc[ai][1][m][0] * rst[ai][m]; acc[ai][1][m][1] = acc[ai][1][m][1] * rst[ai][m]; }
        }
        const bool smp = (u.pm == 128);
        asm volatile("" : "+v"(rowt));
        LAS float* BND = (LAS float*)(lds + LDS_EX);
        if (fr >= 14) {
#pragma unroll
            for (int ai = 0; ai < 2; ++ai)
#pragma unroll
                for (int n = 0; n < 2; ++n) *(LAS f32x4*)(BND + ((ai * 2 + wr) * 2 + (fr - 14)) * 128 + fl + 4 * n) = acc[ai][0][3][n];
            if (wr == 1) {
#pragma unroll
                for (int n = 0; n < 2; ++n) *(f32x4*)(sbl + ((size_t)u.pm * 2 + (fr - 14)) * DFF + f0 + 4 * n) = acc[1][0][3][n];
            }
        }
        asm volatile("s_waitcnt lgkmcnt(0)" ::: "memory"); __builtin_amdgcn_s_barrier(); asm volatile("" ::: "memory");
#pragma unroll
        for (int ai = 0; ai < 2; ++ai) {
            const int pg = wr == 1 ? ai * 2 : 1;
            u32x2 hp[2][4];
#pragma unroll
            for (int n = 0; n < 2; ++n) {
                const f32x4 w0 = *(const f32x4*)(cfw + f0 + 4 * n), w1 = *(const f32x4*)(cfw + DFF + f0 + 4 * n), w2 = *(const f32x4*)(cfw + 2 * DFF + f0 + 4 * n);
                f32x4 h2 = *(const LAS f32x4*)(BND + (pg * 2 + 0) * 128 + fl + 4 * n), h1 = *(const LAS f32x4*)(BND + (pg * 2 + 1) * 128 + fl + 4 * n);
                f32x4 t2 = h2, t1 = h1;
                if (smp) { const float* sp = scf + (size_t)((ai * 4 + wr * 2) * 2) * DFF + f0 + 4 * n; h2 = *(const f32x4*)sp; h1 = *(const f32x4*)(sp + DFF); t2 = *(const f32x4*)(sp + 2 * DFF); t1 = *(const f32x4*)(sp + 3 * DFF); }
#pragma unroll
                for (int jp = 0; jp < 2; ++jp) {
                    float hv[4][2];
#pragma unroll
                    for (int jj = 0; jj < 2; ++jj) { const int j = jp * 2 + jj;
                        float r1p = h1[j], r2p = fr == 0 ? h2[j] : h1[j];
#pragma unroll
                        for (int m = 0; m < 4; ++m) { const float g = acc[ai][0][m][n][j];
                            if (m == 2 && smp) { r1p = t1[j]; r2p = fr == 0 ? t2[j] : t1[j]; }
                            const float r1 = dpp_ror1(g), r2 = dpp_ror2(g);
                            const float gm1 = fr >= 1 ? r1 : r1p, gm2 = fr >= 2 ? r2 : r2p;
                            r1p = r1; r2p = r2;
                            const float cv = w0[j] * gm2 + w1[j] * gm1 + w2[j] * g;
                            hv[m][jj] = silu(cv) * acc[ai][1][m][n][j]; } }
#pragma unroll
                    for (int m = 0; m < 4; ++m) { const unsigned pk = cvt_pk_bf16(hv[m][0], hv[m][1]); if (jp == 0) hp[n][m].x = pk; else hp[n][m].y = pk; }
                }
            }
#pragma unroll
            for (int m = 0; m < 4; ++m) {
                const int rl = ai * HALF + rowt + m * 16;
                if (smp && (m & 1) && fr >= 14) {
#pragma unroll
                    for (int n = 0; n < 2; ++n) *(f32x4*)(ocf + ((size_t)(ai * 4 + wr * 2 + (m >> 1)) * 2 + (fr - 14)) * DFF + f0 + 4 * n) = acc[ai][0][m][n];
                }
                if (!smp && ai == 0 && m == 0 && wr == 0 && fr < 2) {
#pragma unroll
                    for (int n = 0; n < 2; ++n) { *(f32x4*)(sbg + ((size_t)u.pm * 2 + fr) * DFF + f0 + 4 * n) = acc[0][0][0][n]; *(f32x4*)(sbu + ((size_t)u.pm * 2 + fr) * DFF + f0 + 4 * n) = acc[0][1][0][n]; }
                } else {
                    u32x4 w; w.x = hp[0][m].x; w.y = hp[0][m].y; w.z = hp[1][m].x; w.w = hp[1][m].y;
                    *(u32x4*)(H + (size_t)(u.pm * BM + rl) * DFF + f0) = w;
                }
            }
        }
    }
};

template <class Epi, class Sched, bool ALIGN_EPI>
__device__ __forceinline__ void gemm_phase(LAS unsigned char* lds, const Gemm g, const Sched& S, const Epi& E, const int wave_s) {
    const int tid = opaque_tid(wave_s), wid = __builtin_amdgcn_readfirstlane(tid >> 6), lane = tid & 63, wr = wid >> 2, wc = wid & 3, fr = lane & 15, fq = lane >> 4;
    const int nt = g.K / BK;
    unsigned voffA[2], voffB[2];
#pragma unroll
    for (int i = 0; i < 2; ++i) { int R, C; stage_rc(tid * 16 + i * 8192, R, C); const int Rb = Epi::PERM ? ((R & ~31) + perm32(R & 31)) : R;
        voffA[i] = (unsigned)(R * g.lda + C) * 2u; voffB[i] = (unsigned)(Rb * g.ldb + C) * 2u; }
    const size_t kstep = (size_t)(BK * 2);
    const size_t hstepA = (size_t)HALF * g.lda * 2, hstepB = (size_t)HALF * g.ldb * 2;
    const unsigned ldsw = (unsigned)wid * 1024u;
    const int aoff = lds_byte(wr * 64 + fr, fq * 8), boff = lds_byte(wc * 32 + fr, fq * 8);
#define PG8_SA(b, h) (((b) * 2 + (h)) * HTB)
#define PG8_SB(b, h) ((4 + (b) * 2 + (h)) * HTB)
#define PG8_STAGE(bufoff, gbase, voff) do { _Pragma("unroll") for (int _i = 0; _i < 2; ++_i) \
        __builtin_amdgcn_global_load_lds((const unsigned*)((const char*)(gbase) + (voff)[_i]), (LAS unsigned*)(lds + (bufoff) + ldsw + _i * 8192), 16, 0, 0); } while (0)
#define PG8_LDA(dst, b, h) do { _Pragma("unroll") for (int m = 0; m < 4; ++m) _Pragma("unroll") for (int k = 0; k < 2; ++k) dst[m][k] = *(const LAS bf16x8*)(lds + PG8_SA(b, h) + aoff + m * 2048 + k * 1024); } while (0)
#define PG8_LDB(dst, b, h) do { _Pragma("unroll") for (int n = 0; n < 2; ++n) _Pragma("unroll") for (int k = 0; k < 2; ++k) dst[n][k] = *(const LAS bf16x8*)(lds + PG8_SB(b, h) + boff + n * 2048 + k * 1024); } while (0)
#define PG8_MMA(ai, bj, At, Bt) do { __builtin_amdgcn_s_setprio(1); _Pragma("unroll") for (int m = 0; m < 4; ++m) _Pragma("unroll") for (int n = 0; n < 2; ++n) _Pragma("unroll") for (int k = 0; k < 2; ++k) \
        acc[ai][bj][m][n] = __builtin_amdgcn_mfma_f32_16x16x32_bf16(Bt[n][k], At[m][k], acc[ai][bj][m][n], 0, 0, 0); __builtin_amdgcn_s_setprio(0); } while (0)
#define PG8_WAIT_V(n) asm volatile("s_waitcnt vmcnt(" #n ")" ::: "memory")
#define PG8_WAIT_L(n) asm volatile("s_waitcnt lgkmcnt(" #n ")" ::: "memory")
#define PG8_BAR __builtin_amdgcn_s_barrier()
#define PG8_SCHED __builtin_amdgcn_sched_barrier(0)
    Unit cur, nxt; int ui = 0;
    if (!S.next(0, cur)) return;
    f32x4 acc[2][2][4][2];
#pragma unroll
    for (int a = 0; a < 2; ++a)
#pragma unroll
        for (int b = 0; b < 2; ++b)
#pragma unroll
            for (int m = 0; m < 4; ++m)
#pragma unroll
                for (int n = 0; n < 2; ++n) acc[a][b][m][n] = (f32x4){0.f, 0.f, 0.f, 0.f};
    bf16x8 At[4][2], B0[2][2], B1[2][2];
    const char* cA = (const char*)g.A + S.offA(cur); const char* cB = (const char*)g.Bt + S.offB(cur);
    PG8_STAGE(PG8_SB(0, 0), cB, voffB); PG8_STAGE(PG8_SB(0, 1), cB + hstepB, voffB); PG8_STAGE(PG8_SA(0, 0), cA, voffA); PG8_STAGE(PG8_SA(0, 1), cA + hstepA, voffA);
    if (wr == 1) PG8_BAR;
    PG8_WAIT_V(2); PG8_BAR;
    PG8_STAGE(PG8_SB(1, 0), cB + kstep, voffB); PG8_STAGE(PG8_SA(1, 0), cA + kstep, voffA); PG8_STAGE(PG8_SB(1, 1), cB + hstepB + kstep, voffB);
    PG8_WAIT_V(6); PG8_BAR;
    for (;;) {
        const bool has_next = S.next(ui + 1, nxt);
        const char* nA = has_next ? (const char*)g.A + S.offA(nxt) : cA; const char* nB = has_next ? (const char*)g.Bt + S.offB(nxt) : cB;
        for (int t = 0; t < nt; t += 2) {
            const bool last = (t == nt - 2);
            const char* a1 = cA + (size_t)(t + 1) * kstep;
            const char* a2 = last ? nA : cA + (size_t)(t + 2) * kstep; const char* b2 = last ? nB : cB + (size_t)(t + 2) * kstep;
            const char* a3 = a2 + kstep; const char* b3 = b2 + kstep;
            PG8_LDB(B0, 0, 0); PG8_LDB(B1, 0, 1); PG8_SCHED; PG8_LDA(At, 0, 0); PG8_STAGE(PG8_SA(1, 1), a1 + hstepA, voffA);
            PG8_WAIT_V(8); PG8_WAIT_L(0); PG8_BAR; PG8_MMA(0, 0, At, B0); PG8_MMA(0, 1, At, B1); PG8_BAR; PG8_SCHED;
            PG8_LDA(At, 0, 1); PG8_STAGE(PG8_SB(0, 0), b2, voffB); PG8_STAGE(PG8_SB(0, 1), b2 + hstepB, voffB); PG8_STAGE(PG8_SA(0, 0), a2, voffA);
            PG8_WAIT_V(8); PG8_WAIT_L(0); PG8_BAR; PG8_MMA(1, 0, At, B0); PG8_MMA(1, 1, At, B1); PG8_BAR; PG8_SCHED;
            PG8_LDB(B0, 1, 0); PG8_LDB(B1, 1, 1); PG8_SCHED; PG8_LDA(At, 1, 0); PG8_STAGE(PG8_SA(0, 1), a2 + hstepA, voffA);
            PG8_WAIT_V(8); PG8_WAIT_L(0); PG8_BAR; PG8_MMA(0, 0, At, B0); PG8_MMA(0, 1, At, B1); PG8_BAR; PG8_SCHED;
            PG8_LDA(At, 1, 1); PG8_STAGE(PG8_SB(1, 0), b3, voffB); PG8_STAGE(PG8_SB(1, 1), b3 + hstepB, voffB); PG8_STAGE(PG8_SA(1, 0), a3, voffA);
            PG8_WAIT_V(8); PG8_WAIT_L(0); PG8_BAR; PG8_MMA(1, 0, At, B0); PG8_MMA(1, 1, At, B1); PG8_BAR; PG8_SCHED;
        }
        if constexpr (ALIGN_EPI) { if (wr == 0) PG8_BAR; }
        E(acc, cur, wr, wc, fr, fq, lds);
        if (!has_next) break;
#pragma unroll
        for (int a = 0; a < 2; ++a)
#pragma unroll
            for (int b = 0; b < 2; ++b)
#pragma unroll
                for (int m = 0; m < 4; ++m)
#pragma unroll
                    for (int n = 0; n < 2; ++n) acc[a][b][m][n] = (f32x4){0.f, 0.f, 0.f, 0.f};
        cur = nxt; cA = nA; cB = nB; ++ui;
        if constexpr (ALIGN_EPI) { if (wr == 1) PG8_BAR; }
    }
    PG8_WAIT_V(0);
    if constexpr (!ALIGN_EPI) { if (wr == 0) PG8_BAR; }
    PG8_BAR;
#undef PG8_SA
#undef PG8_SB
#undef PG8_STAGE
#undef PG8_LDA
#undef PG8_LDB
#undef PG8_MMA
#undef PG8_WAIT_V
#undef PG8_WAIT_L
#undef PG8_BAR
#undef PG8_SCHED
}
}

struct KVSched {
    int c, G; const char* ws; size_t wsel;
    __device__ __forceinline__ bool next(int i, pg8::Unit& u) const {
        const int L = i * G + c; if (c < 0 || L >= 96) return false;
        const int kind = L >> 5, r = L & 31;
        if (kind < 2) { u.pm = kind * 16 + (r >> 2); u.pn = r & 3; } else { u.pm = 32 + (r >> 3); u.pn = r & 7; }
        return true;
    }
    __device__ __forceinline__ size_t offA(const pg8::Unit& u) const { const int kind = u.pm >> 4, pm = u.pm & 15; int k2 = (kind == 2); asm volatile("" : "+v"(k2));
        return (size_t)ws + WS_MEMB + (size_t)k2 * (WS_WV + wsel - WS_MEMB) + (size_t)pm * 256 * 1024 * 2; }
    __device__ __forceinline__ size_t offB(const pg8::Unit& u) const { const int kind = u.pm >> 4; int k1 = (kind == 1), k2 = (kind == 2); asm volatile("" : "+v"(k1), "+v"(k2));
        return (size_t)ws + WS_WK + wsel + (size_t)k1 * (WS_WV - WS_WK) + (size_t)k2 * (WS_MEMB - WS_WK - wsel) + (size_t)u.pn * 256 * 1024 * 2; }
};


#define XB_TMO      128
#define XB_XCNT(j)  (256  + 64 * (j))
#define XB_XSUB(j)  (1280 + 64 * (j))
#define XB_XGEN(j)  (2304 + 64 * (j))
#define XB_TOP      3328
#define XB_TOPGEN   3392
#define XCD_BAR_WORDS 3456
#define XB_SPIN_CAP (1u << 22)
__device__ __forceinline__ unsigned xb_ld(unsigned* p)              { return __hip_atomic_load(p, __ATOMIC_RELAXED, __HIP_MEMORY_SCOPE_AGENT); }
__device__ __forceinline__ unsigned xb_add(unsigned* p, unsigned v) { return __hip_atomic_fetch_add(p, v, __ATOMIC_RELAXED, __HIP_MEMORY_SCOPE_AGENT); }
__device__ __forceinline__ unsigned xb_xcc_id() { return (unsigned)__builtin_amdgcn_s_getreg((3 << 11) | 20) & 0xFu; }
#define XB_SPIN(cond, bar) do { unsigned _sp = 0; while (cond) { __builtin_amdgcn_s_sleep(1); \
    if ((++_sp & 255u) == 0u) { if (xb_ld(&(bar)[XB_TMO])) break; if (_sp > XB_SPIN_CAP) { atomicAdd(&(bar)[XB_TMO], 1u); break; } } } } while (0)
struct XcdBarrier { unsigned* bar; unsigned x; volatile LAS unsigned* st; };
__device__ __forceinline__ void xcd_barrier_complete(unsigned* bar, unsigned x, unsigned& nloc, unsigned& nx) {
    const unsigned G = gridDim.x * gridDim.y * gridDim.z;
    unsigned sum, cnt, mine, sp = 0u;
    for (;;) {
        sum = 0u; cnt = 0u; mine = 0u;
#pragma unroll
        for (unsigned j = 0; j < 16; ++j) { const unsigned c = xb_ld(&bar[XB_XCNT(j)]); sum += c; cnt += (c > 0u) ? 1u : 0u; mine = (j == x) ? c : mine; }
        if (sum == G) break;
        __builtin_amdgcn_s_sleep(1);
        if ((++sp & 255u) == 0u) { if (xb_ld(&bar[XB_TMO])) break; if (sp > XB_SPIN_CAP) { atomicAdd(&bar[XB_TMO], 1u); break; } }
    }
    nloc = mine > 0u ? mine : 1u; nx = cnt > 0u ? cnt : 1u;
}
__device__ __forceinline__ void xcd_barrier(const XcdBarrier& b) {
    asm volatile("s_waitcnt vmcnt(0)" ::: "memory");
    __syncthreads();
    if (threadIdx.x == 0) {
        unsigned* bar = b.bar;
        __builtin_amdgcn_s_waitcnt(0);
        unsigned nloc = b.st[0], nx = b.st[1];
        if (nloc == 0u) { xcd_barrier_complete(bar, b.x, nloc, nx); b.st[0] = nloc; b.st[1] = nx; }
        const unsigned old = xb_add(&bar[XB_XSUB(b.x)], 1u);
        const unsigned gen = old / nloc;
        if (old + 1u == (gen + 1u) * nloc) {
            __builtin_amdgcn_fence(__ATOMIC_RELEASE, "agent");
            asm volatile("s_waitcnt vmcnt(0)" ::: "memory");
            const unsigned og = xb_add(&bar[XB_TOP], 1u);
            const unsigned tg = og / nx;
            if (og + 1u == (tg + 1u) * nx) xb_add(&bar[XB_TOPGEN], 1u);
            else XB_SPIN(xb_ld(&bar[XB_TOPGEN]) == tg, bar);
            __builtin_amdgcn_fence(__ATOMIC_ACQUIRE, "agent");
            xb_add(&bar[XB_XGEN(b.x)], 1u);
            asm volatile("s_waitcnt vmcnt(0)" ::: "memory");
        } else {
            XB_SPIN(xb_ld(&bar[XB_XGEN(b.x)]) == gen, bar);
            __builtin_amdgcn_fence(__ATOMIC_ACQUIRE, "agent");
            asm volatile("s_waitcnt vmcnt(0)" ::: "memory");
        }
    }
    __syncthreads();
}

__device__ __forceinline__ void transpose_item(const float* W, int K, int N, bf16_t* WT, LAS float* scr, int item, int lane, const float* gain = nullptr, int gu = 0) {
    const int nblk = N / 32, kb = item / nblk, nb = item % nblk, k0 = 64 * kb, n0 = 32 * nb;
    {
        f32x4 v[8];
#pragma unroll
        for (int i = 0; i < 8; ++i) v[i] = *(const f32x4*)(W + (size_t)(k0 + (lane >> 3) + 8 * i) * N + n0 + (lane & 7) * 4);
#pragma unroll
        for (int i = 0; i < 8; ++i) { const int kk = (lane >> 3) + 8 * i; f32x4 w = v[i]; if (gain) w = w * gain[k0 + kk];
            LAS float* d = scr + kk * 33 + (lane & 7) * 4; d[0] = w[0]; d[1] = w[1]; d[2] = w[2]; d[3] = w[3]; }
    }
    LDS_WAIT();
    const int c = lane & 7;
#pragma unroll
    for (int j = 0; j < 4; ++j) { const int n = (lane >> 3) + 8 * j; const LAS float* s = scr + (8 * c) * 33 + n;
        u32x4 o; o.x = pk2(s[0 * 33], s[1 * 33]); o.y = pk2(s[2 * 33], s[3 * 33]); o.z = pk2(s[4 * 33], s[5 * 33]); o.w = pk2(s[6 * 33], s[7 * 33]);
        int drow = n0 + n; if (gu) { const int up = drow >= gu, f = up ? drow - gu : drow; drow = ((f >> 7) << 8) + (up << 7) + (f & 127); }
        *(u32x4*)(WT + (size_t)drow * K + k0 + 8 * c) = o; }
    LDS_WAIT();
}

__device__ __forceinline__ void first_rows(const float* Xp, const float* Xs, bf16_t* XNo, float* ss, int gw, int NGW, int lane) {
    for (int m0 = gw; m0 < MT; m0 += 2 * NGW) {
        const int m1 = m0 + NGW; const bool two = m1 < MT; const int mb = two ? m1 : m0;
        const f32x4* xa = (const f32x4*)(m0 < MP ? Xp + (size_t)m0 * D : Xs + (size_t)(m0 - MP) * D) + lane;
        const f32x4* xb = (const f32x4*)(mb < MP ? Xp + (size_t)mb * D : Xs + (size_t)(mb - MP) * D) + lane;
        f32x4 va[4], vb[4]; float sa = 0.f, sb = 0.f;
#pragma unroll
        for (int j = 0; j < 4; ++j) { va[j] = xa[64 * j]; vb[j] = xb[64 * j]; }
#pragma unroll
        for (int j = 0; j < 4; ++j) { sa += (va[j].x * va[j].x + va[j].y * va[j].y) + (va[j].z * va[j].z + va[j].w * va[j].w); sb += (vb[j].x * vb[j].x + vb[j].y * vb[j].y) + (vb[j].z * vb[j].z + vb[j].w * vb[j].w); }
        sa = wave_sum(sa, lane); sb = wave_sum(sb, lane);
        if (lane < 4) { ss[(size_t)m0 * 4 + lane] = lane == 0 ? sa : 0.f; if (two) ss[(size_t)m1 * 4 + lane] = lane == 0 ? sb : 0.f; }
        u32x2* oa = (u32x2*)(XNo + (size_t)m0 * D) + lane; u32x2* ob = (u32x2*)(XNo + (size_t)mb * D) + lane;
#pragma unroll
        for (int j = 0; j < 4; ++j) { u32x2 w; w.x = pk2(va[j].x, va[j].y); w.y = pk2(va[j].z, va[j].w); oa[64 * j] = w; if (two) { w.x = pk2(vb[j].x, vb[j].y); w.y = pk2(vb[j].z, vb[j].w); ob[64 * j] = w; } }
    }
}

typedef __attribute__((address_space(4))) const unsigned char* kptr_t;
typedef const float* cfp_t; typedef float* fp_t; typedef unsigned char* ucp_t;
#define INP(k) (*(const __attribute__((address_space(4))) cfp_t*)(kp + 8 * (k)))
#define X out
#define WIN_T ((bf16_t*)(ws + WS_WIN + wsel))
#define WOUT_T ((bf16_t*)(ws + WS_WOUT + wsel))
#define WQ_T ((bf16_t*)(ws + WS_WQ + wsel))
#define WK_T ((bf16_t*)(ws + WS_WK + wsel))
#define WV_T ((bf16_t*)(ws + WS_WV + wsel))
#define WO_T ((bf16_t*)(ws + WS_WO + wsel))
#define WUP_T ((bf16_t*)(ws + WS_WUP + wsel))
#define WDN_T ((bf16_t*)(ws + WS_WDN + wsel))
#define MEMB ((bf16_t*)(ws + WS_MEMB))
#define KBP ((bf16_t*)(ws + WS_KBP))
#define VTP ((bf16_t*)(ws + WS_VTP))
#define KBS ((bf16_t*)(ws + WS_KBS + ksel))
#define VTS ((bf16_t*)(ws + WS_VTS + ksel))
#define WST ((bf16_t*)(ws + WS_WST + ksel))
#define AGG ((float*)(ws + WS_AGG))
#define SSQ(i) ((float*)(ws + WS_SSP) + (size_t)(i) * MT * 4)
#define GT_R ((bf16_t*)(ws + WS_GT + ksel))
#define GT_I ((bf16_t*)(ws + WS_GT + 65536 + ksel))
#define XN ((bf16_t*)(ws + WS_XN))
#define gZ ((bf16_t*)(ws + B_Z))
#define HLOC ((float*)(ws + B_HLOC))
#define PCUM ((float*)(ws + B_PCUM))
#define gY ((bf16_t*)(ws + B_Y))
#define gQ ((bf16_t*)(ws + B_Q))
#define gP ((bf16_t*)(ws + B_P))
#define gO ((bf16_t*)(ws + B_O))
#define PS ((bf16_t*)(ws + B_PS))
#define GU ((bf16_t*)(ws + B_GU))
#define GUS ((bf16_t*)(ws + B_GUS))
#define SBG ((float*)(ws + B_SBG))
#define SBU ((float*)(ws + B_SBU))
#define SBL ((float*)(ws + B_SBL))
__device__ __forceinline__ void convert_layer(kptr_t kp, unsigned char* ws, LAS unsigned char* lds, const int l, const int part, const int nparts, const int gw, const int NGW, const int gt, const int NGT, const int lane, const int wave) {
            const size_t wsel = (size_t)(l & 1) * WSEL1, ksel = (size_t)(l & 1) * KSEL1;
            LAS float* scr = (LAS float*)(lds + wave * 16384);
            const float* w_in = INP(I_WIN) + (size_t)l * D * INC; const float* w_out = INP(I_WOUT) + (size_t)l * D * D; const float* w_q = INP(I_WQ) + (size_t)l * D * D;
            const float* w_k = INP(I_WK) + (size_t)l * D * D; const float* w_v = INP(I_WV) + (size_t)l * D * D; const float* w_o = INP(I_WO) + (size_t)l * D * D;
            const float* w_up = INP(I_WUP) + (size_t)l * D * 2 * DFF; const float* w_dn = INP(I_WDN) + (size_t)l * DFF * D; const float* c_v = INP(I_CV) + (size_t)l * BS * NMEM * D;
            constexpr int T_IN = 16 * (INC / 32), T_SQ = 16 * 32, T_UP = 16 * (2 * DFF / 32), T_DN = (DFF / 64) * 32, T_CV = 32 * 32;
            constexpr int T_G = 16;
            constexpr int NIT = T_IN + 5 * T_SQ + T_UP + T_DN + T_CV + 2 * T_G;
            for (int it = (NIT * part) / nparts + gw; it < (NIT * (part + 1)) / nparts; it += NGW) {
                int r = it;
                if (r < T_IN) { transpose_item(w_in, D, INC, WIN_T, scr, r, lane, INP(I_GMIX) + l * D); continue; } r -= T_IN;
                if (r < T_SQ) { transpose_item(w_out, D, D, WOUT_T, scr, r, lane); continue; } r -= T_SQ;
                if (r < T_SQ) { transpose_item(w_q, D, D, WQ_T, scr, r, lane, INP(I_GX) + l * D); continue; } r -= T_SQ;
                if (r < T_SQ) { transpose_item(w_k, D, D, WK_T, scr, r, lane); continue; } r -= T_SQ;
                if (r < T_SQ) { transpose_item(w_v, D, D, WV_T, scr, r, lane); continue; } r -= T_SQ;
                if (r < T_SQ) { transpose_item(w_o, D, D, WO_T, scr, r, lane); continue; } r -= T_SQ;
                if (r < T_UP) { transpose_item(w_up, D, 2 * DFF, WUP_T, scr, r, lane, INP(I_GFFN) + l * D, DFF); continue; } r -= T_UP;
                if (r < T_DN) { transpose_item(w_dn, DFF, D, WDN_T, scr, r, lane); continue; } r -= T_DN;
                if (r < T_CV) { transpose_item(c_v, BS * NMEM, D, VTS, scr, r, lane); continue; } r -= T_CV;
                if (r < T_G) { transpose_item(INP(I_WRG) + ((size_t)l * 8 + (r >> 1)) * 4096, 64, 64, GT_R + (r >> 1) * 4096, scr, r & 1, lane); continue; } r -= T_G;
                transpose_item(INP(I_WIG) + ((size_t)l * 8 + (r >> 1)) * 4096, 64, 64, GT_I + (r >> 1) * 4096, scr, r & 1, lane);
            }
            if (part == 0) {
                const f32x4* ck = (const f32x4*)(INP(I_CK) + (size_t)l * BS * NMEM * D); u32x2* dk = (u32x2*)KBS;
                for (int i = gt; i < BS * NMEM * D / 4; i += NGT) { const f32x4 v = ck[i]; u32x2 w; w.x = pk2(v.x, v.y); w.y = pk2(v.z, v.w); dk[i] = w; }
                if (l == 0) { const f32x4* mm = (const f32x4*)INP(I_MEM); u32x2* dm = (u32x2*)MEMB;
                    for (int i = gt; i < BP * NMEM * D / 4; i += NGT) { const f32x4 v = mm[i]; u32x2 w; w.x = pk2(v.x, v.y); w.y = pk2(v.z, v.w); dm[i] = w; } }
                const float* wsl = INP(I_WS) + (size_t)l * 4 * 128 * 128;
                for (int i = gt; i < 4 * 128 * 128; i += NGT) { const int s = i & 127, t = (i >> 7) & 127; WST[i] = (bf16_t)f2bf(s <= t ? wsl[i] : 0.f); }
            }
}

__global__ void __launch_bounds__(NTHREADS, 2) trunk_fwd(Args args) {
    extern __shared__ __attribute__((aligned(16))) unsigned char lds_raw[];
    LAS unsigned char* lds = (LAS unsigned char*)lds_raw;
    cg::grid_group grid = cg::this_grid();
    const int wave_s = __builtin_amdgcn_readfirstlane(threadIdx.x >> 6);
#define LANE_STATE() int G = gridDim.x, bid = blockIdx.x; asm volatile("" : "+s"(G), "+s"(bid)); const int NGW = G * NWAVES, NGT = G * NTHREADS; (void)NGW; (void)NGT; \
    const int tid = opaque_tid(wave_s), lane = tid & 63, wave = wave_s; const int gw = bid * NWAVES + wave; const int gt = bid * NTHREADS + tid; (void)lane; (void)gw; (void)gt; \
    kptr_t kp = (kptr_t)__builtin_amdgcn_kernarg_segment_ptr(); asm volatile("" : "+s"(kp)); \
    float* const out = *(const __attribute__((address_space(4))) fp_t*)(kp + 8 * N_IN); unsigned char* const ws = *(const __attribute__((address_space(4))) ucp_t*)(kp + 8 * N_IN + 8); (void)out; (void)ws
    {
        LANE_STATE();
        if (bid == 0) for (int i = tid; i < XCD_BAR_WORDS; i += NTHREADS) __hip_atomic_store((unsigned*)(ws + WS_BAR) + i, 0u, __ATOMIC_RELAXED, __HIP_MEMORY_SCOPE_AGENT);
        if (tid < 32) ((LAS unsigned*)(lds + LDS_MISC))[tid] = 0u;
        __threadfence();
        grid.sync();
        if (tid == 0) (void)xb_add((unsigned*)(ws + WS_BAR) + XB_XCNT(xb_xcc_id()), 1u);
    }
#define GRID_SYNC() do { kptr_t kp_ = (kptr_t)__builtin_amdgcn_kernarg_segment_ptr(); asm volatile("" : "+s"(kp_)); \
        XcdBarrier b_; b_.bar = (unsigned*)(*(const __attribute__((address_space(4))) ucp_t*)(kp_ + 8 * N_IN + 8) + WS_BAR); b_.x = xb_xcc_id(); b_.st = (volatile LAS unsigned*)(lds + LDS_MISC); \
        xcd_barrier(b_); if (PROBE == 3) xcd_barrier(b_); } while (0)

    for (int l = 0; l < DEPTH; ++l) {
        const size_t wsel = (size_t)(l & 1) * WSEL1, ksel = (size_t)(l & 1) * KSEL1;
        if (l == 0)
        for (int dup0 = 0; dup0 < ((PROBE == 1 || PROBE == 5) ? 2 : 1); ++dup0) {
        {
            LANE_STATE();
            convert_layer(kp, ws, lds, l, 0, 1, gw, NGW, gt, NGT, lane, wave);
            if (l == 0) first_rows(INP(I_XP), INP(I_XS), XN, SSQ(0), gw, NGW, lane);
        }
        GRID_SYNC();
        }
        {
            LANE_STATE();
            KVSched S; S.G = G; S.c = bid >= 160 ? bid - 160 : -1; S.ws = (const char*)ws; S.wsel = wsel;
            pg8::Gemm g{(const bf16_t*)nullptr, (const bf16_t*)nullptr, D, D, D};
            pg8::EpiKV E{out + O_MKP + (size_t)l * BP * NMEM * D, out + O_MVP + (size_t)l * BP * NMEM * D, KBP, VTP};
            pg8::gemm_phase<pg8::EpiKV, KVSched, true>(lds, g, S, E, wave_s);
        }
#define GEMM_BF16(s_) do { const int s = (s_); pg8::GSched S; pg8::Gemm g; pg8::EpiBf16 E; E.scale = 1.f; E.ss = nullptr; E.smp = 0; \
        if (s == 0) { S.init(MT / 256, INC / 256, G, bid); S.aPm = (size_t)256 * D * 2; S.bPn = (size_t)256 * D * 2; g = pg8::Gemm{XN, WIN_T, D, D, D}; E.O = gZ; E.ldc = INC; E.ss = SSQ(3 * l); } \
        else if (s == 1) { S.init(MT / 256, D / 256, G, bid); S.aPm = (size_t)256 * D * 2; S.bPn = (size_t)256 * D * 2; g = pg8::Gemm{XN, WQ_T, D, D, D}; E.O = gQ; E.ldc = D; E.scale = 0.0625f; E.ss = SSQ(3 * l + 1); } \
        else if (s == 2) { S.init(MP / 256, 4, G, bid); S.aPm = (size_t)256 * D * 2; S.aPn = 512; S.bPn = (size_t)256 * 2048 * 2; S.bPm = 512; S.bShift = 4; g = pg8::Gemm{gP, VTP, D, 2048, 256}; E.O = gO; E.ldc = D; } \
        else { S.init(1, 32, G, (bid + G - 64) % G); S.mode = 2; g = pg8::Gemm{PS, VTS, 8192, 2048, 256}; E.O = gO + (size_t)MP * D; E.ldc = D; E.smp = 1; } \
        pg8::gemm_phase<pg8::EpiBf16, pg8::GSched, true>(lds, g, S, E, wave_s); } while (0)
#define GEMM_RES(s_) do { const int s = (s_); pg8::GSched S; S.init(MT / 256, D / 256, G, bid); pg8::Gemm g; \
        if (s == 0) { g = pg8::Gemm{gY, WOUT_T, D, D, D}; S.aPm = (size_t)256 * D * 2; } \
        else if (s == 1) { g = pg8::Gemm{gO, WO_T, D, D, D}; S.aPm = (size_t)256 * D * 2; } \
        else { g = pg8::Gemm{GU, WDN_T, DFF, DFF, DFF}; S.aPm = (size_t)256 * DFF * 2; } \
        S.bPn = (size_t)256 * g.ldb * 2; \
        pg8::EpiResid E{XN, SSQ(3 * l + 1 + s)}; \
        pg8::gemm_phase<pg8::EpiResid, pg8::GSched, true>(lds, g, S, E, wave_s); } while (0)

        for (int rep = 0; rep < 13; ++rep) { if (rep == 4 || rep == 9 || rep == 11) continue;
          const int ndup = ((PROBE == 1 && (rep == 1 || rep == 2)) || (PROBE == 4 && rep == 1) || (PROBE == 6 && rep == 2)) ? 2 : ((PROBE == 2 && (rep == 0 || rep == 5 || rep == 6 || rep == 7 || rep == 10)) ? 2 : 1);
          for (int dup = 0; dup < ndup; ++dup) {
            if (rep == 0 || rep == 5 || rep == 7) {
                LANE_STATE();
                const int s0 = rep == 0 ? 0 : (rep == 5 ? 1 : 2), ns = rep == 7 ? 2 : 1;
                for (int q = 0; q < ns; ++q) GEMM_BF16(s0 + q);
                if (rep == 5 && l + 1 < DEPTH) { LANE_STATE(); if (bid >= 4) convert_layer(kp, ws, lds, l + 1, 1, 3, gw - 4 * NWAVES, NGW - 4 * NWAVES, gt - 4 * NTHREADS, NGT - 4 * NTHREADS, lane, wave); }
            } else if (rep == 10) {
                LANE_STATE();
                pg8::GSched S; S.init(MT / 256, 2 * DFF / 256, G, bid); S.aPm = (size_t)256 * D * 2; S.bPn = (size_t)256 * D * 2;
                const pg8::Gemm g{XN, WUP_T, D, D, D};
                const pg8::EpiAct E{GU, INP(I_SCF) + (size_t)l * BS * 2 * DFF, out + O_CFS + (size_t)l * BS * 2 * DFF, SBG, SBU, SBL, INP(I_CFW) + (size_t)l * 3 * DFF, SSQ(3 * l + 2)};
                pg8::gemm_phase<pg8::EpiAct, pg8::GSched, true>(lds, g, S, E, wave_s);
            } else if (rep == 1) {
                LANE_STATE();
                {
                    LAS bf16_t* vT = (LAS bf16_t*)lds;
                    constexpr int VP = 136;
                    const float* gvp = INP(I_GV) + l * CW; const float* bsp = INP(I_BSS) + l * 4 * 128;
                    for (int un = (bid + G / 2) % G; un < 8 + 256; un += G) {
                        int rowbase, nrows, sb = -1;
                        if (un < 8) { sb = un; rowbase = MP + un * TS; nrows = TS; } else { rowbase = (un - 8) * 128; nrows = 128; }
                        {
                            const int rl = tid >> 5, cgp = tid & 31;
                            f32x4 g0 = *(const f32x4*)(gvp + cgp * 8), g1 = *(const f32x4*)(gvp + cgp * 8 + 4);
                            for (int p = 0; p < nrows / 16; ++p) {
                                const int r = p * 16 + rl;
                                const u32x4 raw = *(const u32x4*)(gZ + (size_t)(rowbase + r) * INC + Z_VC + cgp * 8);
                                float v[8] = {bflo(raw.x), bfhi(raw.x), bflo(raw.y), bfhi(raw.y), bflo(raw.z), bfhi(raw.z), bflo(raw.w), bfhi(raw.w)};
                                float ss = 0.f;
#pragma unroll
                                for (int k = 0; k < 8; ++k) { v[k] = gelu_t(v[k]); ss += v[k] * v[k]; }
                                ss += shx(ss, 1, lane); ss += shx(ss, 2, lane); ss += shx(ss, 4, lane);
                                const float rstd = 1.0f / sqrtf(ss * (1.f / 64.f) + EPS);
                                const float gg[8] = {g0.x, g0.y, g0.z, g0.w, g1.x, g1.y, g1.z, g1.w};
#pragma unroll
                                for (int k = 0; k < 8; ++k) { v[k] = v[k] * rstd * gg[k]; vT[(cgp * 8 + k) * VP + r] = (bf16_t)f2bf(v[k]); }
                                if (sb >= 0) { float* vo = out + O_VCS + ((size_t)(l * BS + sb) * TS + r) * CW + cgp * 8;
                                    *(f32x4*)vo = (f32x4){v[0], v[1], v[2], v[3]}; *(f32x4*)(vo + 4) = (f32x4){v[4], v[5], v[6], v[7]}; }
                            }
                        }
                        __syncthreads();
                        {
                            const int hh = wave & 3, rh = wave >> 2, fr = lane & 15, fq = lane >> 4;
                            const int nmt = nrows == 128 ? 4 : (rh == 0 ? 2 : 0);
                            for (int mi = 0; mi < nmt; ++mi) {
                                const int mt = rh * 4 + mi, nks = (mt * 16 + 15) / 32 + 1;
                                f32x4 acc[4];
#pragma unroll
                                for (int n = 0; n < 4; ++n) acc[n] = (f32x4){0.f, 0.f, 0.f, 0.f};
                                for (int ks = 0; ks < nks; ++ks) {
                                    const bf16x8 a = *(const bf16x8*)(WST + ((size_t)(hh * 128 + mt * 16 + fr) * 128 + ks * 32 + fq * 8));
#pragma unroll
                                    for (int n = 0; n < 4; ++n) { const bf16x8 b = *(const LAS bf16x8*)(vT + (hh * 64 + n * 16 + fr) * VP + ks * 32 + fq * 8);
                                        acc[n] = __builtin_amdgcn_mfma_f32_16x16x32_bf16(b, a, acc[n], 0, 0, 0); }
                                }
                                { const int t = mt * 16 + fr; const float bias = bsp[hh * 128 + t]; const size_t row = (size_t)(rowbase + t);
#pragma unroll
                                    for (int n = 0; n < 4; ++n) { const int c = hh * 64 + n * 16 + fq * 4; const u32x2 uq = *(const u32x2*)(gZ + row * INC + Z_UC + c);
                                        u32x2 w; w.x = pk2(gelu_t(bflo(uq.x)) * (acc[n][0] + bias), gelu_t(bfhi(uq.x)) * (acc[n][1] + bias)); w.y = pk2(gelu_t(bflo(uq.y)) * (acc[n][2] + bias), gelu_t(bfhi(uq.y)) * (acc[n][3] + bias));
                                        *(u32x2*)(gY + row * D + 768 + c) = w; } }
                            }
                        }
                        __syncthreads();
                    }
                }
                {
                    LAS unsigned char* wl = lds + wave * 16384;
                    LAS bf16_t* tile = (LAS bf16_t*)wl;
                    LAS float* pre_r = (LAS float*)(wl + 2560);
                    LAS float* pre_i = (LAS float*)(wl + 2560 + 4096);
                    LAS float* xcf = (LAS float*)(wl + 2560 + 8192);
                    const int fr = lane & 15, fq = lane >> 4;
                    for (int un = gw; un < 64 + 2048; un += NGW) {
                        int b, hd, rowbase, nrows, t0; bool smp = un < 64;
                        if (smp) { b = un >> 3; hd = un & 7; rowbase = MP + b * TS; nrows = TS; t0 = 0; }
                        else { const int v = un - 64; const int ch = v & 31; hd = (v >> 5) & 7; b = v >> 8; t0 = ch * 128; rowbase = b * SEQ + t0; nrows = 128; }
                        const int cidx = l * AW + hd * 64 + lane;
                        const float br = INP(I_BRG)[cidx], bi = INP(I_BIG)[cidx];
                        const float c8sp = 8.0f * log1pf(__expf(-INP(I_LAM)[cidx]));
                        const float* caw = INP(I_CAW) + (size_t)l * 4 * AW + hd * 64 + lane;
                        const float cw0 = caw[0], cw1 = caw[AW], cw2 = caw[2 * AW], cw3 = caw[3 * AW], cb = INP(I_CAB)[cidx];
                        bf16x8 bR[4][2], bI[4][2];
#pragma unroll
                        for (int n = 0; n < 4; ++n)
#pragma unroll
                            for (int ks = 0; ks < 2; ++ks) { const size_t o_ = (size_t)(hd * 64 + n * 16 + fr) * 64 + ks * 32 + fq * 8;
                                bR[n][ks] = *(const bf16x8*)(GT_R + o_); bI[n][ks] = *(const bf16x8*)(GT_I + o_); }
                        float xm3 = 0.f, xm2 = 0.f, xm1 = 0.f;
                        if (smp) { const float* st = INP(I_SCA) + ((size_t)(l * BS + b) * 3) * AW + hd * 64 + lane; xm3 = st[0]; xm2 = st[AW]; xm1 = st[2 * AW]; }
                        else if (t0 > 0) { const bf16_t* zp = gZ + (size_t)(rowbase - 3) * INC + Z_XA + hd * 64 + lane; xm3 = bf2f(zp[0]); xm2 = bf2f(zp[INC]); xm1 = bf2f(zp[2 * INC]); }
                        float h = 0.f, pc = 1.f;
                        const bf16_t* zq = gZ + (size_t)(rowbase + (lane >> 3)) * INC + Z_XA + hd * 64 + (lane & 7) * 8;
                        float* hp = HLOC + (size_t)rowbase * AW + hd * 64 + lane; float* pp = PCUM + (size_t)rowbase * AW + hd * 64 + lane;
                        LAS bf16_t* xraw = (LAS bf16_t*)pre_r;
                        u32x4 xn0 = *(const u32x4*)zq, xn1 = *(const u32x4*)(zq + (size_t)8 * INC);
                        for (int st = 0; st < nrows / 16; ++st) {
                            *(LAS u32x4*)(xraw + (lane >> 3) * 64 + (lane & 7) * 8) = xn0; *(LAS u32x4*)(xraw + ((lane >> 3) + 8) * 64 + (lane & 7) * 8) = xn1;
                            zq += (size_t)16 * INC;
                            if (st + 1 < nrows / 16) { xn0 = *(const u32x4*)zq; xn1 = *(const u32x4*)(zq + (size_t)8 * INC); }
                            LDS_WAIT();
#pragma unroll
                            for (int i = 0; i < 16; ++i) { const float xv = bf2f(xraw[i * 64 + lane]);
                                const float xc = cw0 * xm3 + cw1 * xm2 + cw2 * xm1 + cw3 * xv + cb; xm3 = xm2; xm2 = xm1; xm1 = xv; xcf[i * 64 + lane] = xc; tile[i * 72 + lane] = (bf16_t)f2bf(xc); }
                            LDS_WAIT();
                            const bf16x8 a0 = *(const LAS bf16x8*)(tile + fr * 72 + fq * 8), a1 = *(const LAS bf16x8*)(tile + fr * 72 + 32 + fq * 8);
#pragma unroll
                            for (int n = 0; n < 4; ++n) {
                                f32x4 ar = (f32x4){0.f, 0.f, 0.f, 0.f}, ai = (f32x4){0.f, 0.f, 0.f, 0.f};
                                ar = __builtin_amdgcn_mfma_f32_16x16x32_bf16(a0, bR[n][0], ar, 0, 0, 0); ar = __builtin_amdgcn_mfma_f32_16x16x32_bf16(a1, bR[n][1], ar, 0, 0, 0);
                                ai = __builtin_amdgcn_mfma_f32_16x16x32_bf16(a0, bI[n][0], ai, 0, 0, 0); ai = __builtin_amdgcn_mfma_f32_16x16x32_bf16(a1, bI[n][1], ai, 0, 0, 0);
#pragma unroll
                                for (int j = 0; j < 4; ++j) { pre_r[(fq * 4 + j) * 64 + n * 16 + fr] = ar[j]; pre_i[(fq * 4 + j) * 64 + n * 16 + fr] = ai[j]; }
                            }
                            LDS_WAIT();
#pragma unroll 4
                            for (int i = 0; i < 16; ++i) {
                                const float r = sigm(pre_r[i * 64 + lane] + br), gi = sigm(pre_i[i * 64 + lane] + bi);
                                const float la = -c8sp * r; float a, om;
                                if (la > -0.125f) { const float x = 2.0f * la; om = -x * (1.0f + x * (0.5f + x * (0.16666667f + x * (0.041666668f + x * (0.0083333338f + x * 0.0013888889f))))); a = 1.0f + la * (1.0f + la * (0.5f + la * (0.16666667f + la * (0.041666668f + la * 0.0083333338f)))); }
                                else { a = __expf(la); om = -expm1f(2.0f * la); }
                                const float bm = sqrtf(om);
                                h = a * h + bm * gi * xcf[i * 64 + lane]; pc = pc * a;
                                *hp = h; *pp = pc; hp += AW; pp += AW;
                            }
                            LDS_WAIT();
                        }
                        AGG[(size_t)un * 128 + lane] = pc; AGG[(size_t)un * 128 + 64 + lane] = h;
                    }
                }
                {
                    const float* cbw = INP(I_CBW) + (size_t)l * 3 * BW;
                    for (int it = gt; it < (MT / 8) * 32; it += NGT) {
                        const int rb = it >> 5, c0 = (it & 31) * 8;
                        int b, t0, T, rowbase; const bool smp = rb >= MP / 8;
                        if (!smp) { b = rb >> 9; t0 = (rb & 511) * 8; T = SEQ; rowbase = rb * 8; } else { const int sbk = rb - MP / 8; b = sbk >> 2; t0 = (sbk & 3) * 8; T = TS; rowbase = MP + sbk * 8; }
                        u32x4 xq[10], cq[10], bq[8];
                        const bf16_t* zr = gZ + (size_t)rowbase * INC + c0;
#pragma unroll
                        for (int i = 0; i < 10; ++i) { if (i >= 2 || t0 > 0) { xq[i] = *(const u32x4*)(zr + (ptrdiff_t)(i - 2) * INC + Z_XB); cq[i] = *(const u32x4*)(zr + (ptrdiff_t)(i - 2) * INC + Z_GC); } else { xq[i] = (u32x4){0u, 0u, 0u, 0u}; cq[i] = (u32x4){0u, 0u, 0u, 0u}; } }
#pragma unroll
                        for (int i = 0; i < 8; ++i) bq[i] = *(const u32x4*)(zr + (size_t)i * INC + Z_GB);
                        float w0[8], w1[8], w2[8], pm2[8], pm1[8];
#pragma unroll
                        for (int k = 0; k < 8; ++k) { w0[k] = cbw[c0 + k]; w1[k] = cbw[BW + c0 + k]; w2[k] = cbw[2 * BW + c0 + k]; }
                        {
                            const float a_[8] = {bflo(xq[0].x) * bflo(cq[0].x), bfhi(xq[0].x) * bfhi(cq[0].x), bflo(xq[0].y) * bflo(cq[0].y), bfhi(xq[0].y) * bfhi(cq[0].y), bflo(xq[0].z) * bflo(cq[0].z), bfhi(xq[0].z) * bfhi(cq[0].z), bflo(xq[0].w) * bflo(cq[0].w), bfhi(xq[0].w) * bfhi(cq[0].w)};
                            const float b_[8] = {bflo(xq[1].x) * bflo(cq[1].x), bfhi(xq[1].x) * bfhi(cq[1].x), bflo(xq[1].y) * bflo(cq[1].y), bfhi(xq[1].y) * bfhi(cq[1].y), bflo(xq[1].z) * bflo(cq[1].z), bfhi(xq[1].z) * bfhi(cq[1].z), bflo(xq[1].w) * bflo(cq[1].w), bfhi(xq[1].w) * bfhi(cq[1].w)};
#pragma unroll
                            for (int k = 0; k < 8; ++k) { pm2[k] = a_[k]; pm1[k] = b_[k]; }
                        }
                        if (t0 == 0 && smp) { const float* st = INP(I_SCB) + ((size_t)(l * BS + b) * 2) * BW + c0;
#pragma unroll
                            for (int k = 0; k < 8; ++k) { pm2[k] = st[k]; pm1[k] = st[BW + k]; } }
#pragma unroll
                        for (int i = 0; i < 8; ++i) {
                            const u32x4 xb = xq[i + 2], gc = cq[i + 2], gb = bq[i];
                            const float pv[8] = {bflo(xb.x) * bflo(gc.x), bfhi(xb.x) * bfhi(gc.x), bflo(xb.y) * bflo(gc.y), bfhi(xb.y) * bfhi(gc.y), bflo(xb.z) * bflo(gc.z), bfhi(xb.z) * bfhi(gc.z), bflo(xb.w) * bflo(gc.w), bfhi(xb.w) * bfhi(gc.w)};
                            const float gbv[8] = {bflo(gb.x), bfhi(gb.x), bflo(gb.y), bfhi(gb.y), bflo(gb.z), bfhi(gb.z), bflo(gb.w), bfhi(gb.w)};
                            float yv[8];
#pragma unroll
                            for (int k = 0; k < 8; ++k) { yv[k] = gbv[k] * (w0[k] * pm2[k] + w1[k] * pm1[k] + w2[k] * pv[k]); pm2[k] = pm1[k]; pm1[k] = pv[k]; }
                            u32x4 w; w.x = pk2(yv[0], yv[1]); w.y = pk2(yv[2], yv[3]); w.z = pk2(yv[4], yv[5]); w.w = pk2(yv[6], yv[7]);
                            *(u32x4*)(gY + (size_t)(rowbase + i) * D + 512 + c0) = w;
                        }
                        if (t0 + 8 == T) { float* o = out + (smp ? O_CBS : O_CBP) + ((size_t)(l * 8 + b) * 2) * BW + c0;
#pragma unroll
                            for (int k = 0; k < 8; ++k) { o[k] = pm2[k]; o[BW + k] = pm1[k]; } }
                    }
                }
            } else if (rep == 2) {
                LANE_STATE();
                {
                    LAS float* cr = (LAS float*)lds;
                    for (int un = bid; un < 8 + 256; un += G) {
                        int b, ch, rowbase, nrows; const bool smp = un < 8;
                        if (smp) { b = un; ch = 0; rowbase = MP + b * TS; nrows = TS; } else { const int v = un - 8; b = v >> 5; ch = v & 31; rowbase = b * SEQ + ch * 128; nrows = 128; }
                        {
                            const int c = tid, hd = c >> 6, ln = c & 63; float carry = 0.f;
                            if (smp) carry = INP(I_SHA)[(size_t)(l * BS + b) * AW + c];
                            else { const float* ag = AGG + (size_t)(64 + (b << 8) + (hd << 5)) * 128 + ln; for (int k = 0; k < ch; ++k) carry = ag[(size_t)k * 128] * carry + ag[(size_t)k * 128 + 64]; }
                            cr[c] = carry;
                        }
                        __syncthreads();
                        const int c0 = (tid & 63) * 8, rsub = tid >> 6;
                        const f32x4 ca = *(const LAS f32x4*)(cr + c0), cb = *(const LAS f32x4*)(cr + c0 + 4);
                        for (int p = 0; p < nrows / 8; ++p) {
                            const int rloc = p * 8 + rsub; const size_t row = (size_t)(rowbase + rloc);
                            const f32x4 h0 = *(const f32x4*)(HLOC + row * AW + c0), h1 = *(const f32x4*)(HLOC + row * AW + c0 + 4), p0 = *(const f32x4*)(PCUM + row * AW + c0), p1 = *(const f32x4*)(PCUM + row * AW + c0 + 4);
                            const u32x4 gq = *(const u32x4*)(gZ + row * INC + Z_GA + c0);
                            const f32x4 a0 = h0 + p0 * ca, a1 = h1 + p1 * cb;
                            u32x4 w; w.x = pk2(gelu_t(bflo(gq.x)) * a0[0], gelu_t(bfhi(gq.x)) * a0[1]); w.y = pk2(gelu_t(bflo(gq.y)) * a0[2], gelu_t(bfhi(gq.y)) * a0[3]);
                            w.z = pk2(gelu_t(bflo(gq.z)) * a1[0], gelu_t(bfhi(gq.z)) * a1[1]); w.w = pk2(gelu_t(bflo(gq.w)) * a1[2], gelu_t(bfhi(gq.w)) * a1[3]);
                            *(u32x4*)(gY + row * D + c0) = w;
                            if ((smp || ch == 31) && rloc == nrows - 1) { float* o = out + (smp ? O_HAS : O_HAP) + (size_t)(l * 8 + b) * AW + c0; *(f32x4*)o = a0; *(f32x4*)(o + 4) = a1; }
                        }
                        if ((smp || ch == 31) && tid < 192) {
                            const int k = tid >> 6; const u32x4 xq = *(const u32x4*)(gZ + (size_t)(rowbase + nrows - 3 + k) * INC + Z_XA + c0);
                            float* o = out + (smp ? O_CAS : O_CAP) + ((size_t)(l * 8 + b) * 3 + k) * AW + c0;
                            *(f32x4*)o = (f32x4){bflo(xq.x), bfhi(xq.x), bflo(xq.y), bfhi(xq.y)}; *(f32x4*)(o + 4) = (f32x4){bflo(xq.z), bfhi(xq.z), bflo(xq.w), bfhi(xq.w)};
                        }
                        __syncthreads();
                    }
                }
            } else if (rep == 3 || rep == 8 || rep == 12) {
                LANE_STATE();
                if (rep == 12) {
                    const float* cfw = INP(I_CFW) + (size_t)l * 3 * DFF;
                    pg8::GSched S0; S0.init(MT / 256, D / 256, G, bid); pg8::Unit u0;
                    for (int i = 0; S0.next(i, u0); ++i) {
                        const int pm = u0.pm; if (pm >= 128 || tid >= DFF / 8) continue;
                        const int c0 = tid * 8, b = pm >> 4;
                        float w0[8], w1[8], w2[8], p2[8], p1[8], g0[8], g1[8], u0_[8], u1_[8];
#pragma unroll
                        for (int k = 0; k < 8; ++k) { w0[k] = cfw[c0 + k]; w1[k] = cfw[DFF + c0 + k]; w2[k] = cfw[2 * DFF + c0 + k]; p2[k] = 0.f; p1[k] = 0.f; }
                        if ((pm & 15) != 0) {
#pragma unroll
                            for (int k = 0; k < 8; ++k) { p2[k] = SBL[((size_t)(pm - 1) * 2 + 0) * DFF + c0 + k]; p1[k] = SBL[((size_t)(pm - 1) * 2 + 1) * DFF + c0 + k]; } }
#pragma unroll
                        for (int k = 0; k < 8; ++k) { g0[k] = SBG[((size_t)pm * 2 + 0) * DFF + c0 + k]; g1[k] = SBG[((size_t)pm * 2 + 1) * DFF + c0 + k]; u0_[k] = SBU[((size_t)pm * 2 + 0) * DFF + c0 + k]; u1_[k] = SBU[((size_t)pm * 2 + 1) * DFF + c0 + k]; }
                        float ha[8], hb[8];
#pragma unroll
                        for (int k = 0; k < 8; ++k) { ha[k] = silu(w0[k] * p2[k] + w1[k] * p1[k] + w2[k] * g0[k]) * u0_[k]; hb[k] = silu(w0[k] * p1[k] + w1[k] * g0[k] + w2[k] * g1[k]) * u1_[k]; }
                        u32x4 w; w.x = pk2(ha[0], ha[1]); w.y = pk2(ha[2], ha[3]); w.z = pk2(ha[4], ha[5]); w.w = pk2(ha[6], ha[7]);
                        *(u32x4*)(GU + (size_t)(pm * 256) * DFF + c0) = w;
                        w.x = pk2(hb[0], hb[1]); w.y = pk2(hb[2], hb[3]); w.z = pk2(hb[4], hb[5]); w.w = pk2(hb[6], hb[7]);
                        *(u32x4*)(GU + (size_t)(pm * 256 + 1) * DFF + c0) = w;
                        if ((pm & 15) == 15 && u0.pn == 0) { float* o = out + O_CFP + ((size_t)(l * 8 + b) * 2) * DFF + c0;
#pragma unroll
                            for (int k = 0; k < 8; ++k) { o[k] = SBL[((size_t)pm * 2 + 0) * DFF + c0 + k]; o[DFF + k] = SBL[((size_t)pm * 2 + 1) * DFF + c0 + k]; } }
                    }
                    asm volatile("s_waitcnt vmcnt(0)" ::: "memory"); __syncthreads();
                }
                GEMM_RES(rep == 3 ? 0 : (rep == 8 ? 1 : 2));
                if (rep != 12 && l + 1 < DEPTH) { LANE_STATE(); if (bid >= 4) convert_layer(kp, ws, lds, l + 1, rep == 3 ? 0 : 2, 3, gw - 4 * NWAVES, NGW - 4 * NWAVES, gt - 4 * NTHREADS, NGT - 4 * NTHREADS, lane, wave); }
            } else if (rep == 6) {
                LANE_STATE();
                for (int sub = 0; sub < 2; ++sub) {
                    pg8::GSched S; pg8::Gemm g; pg8::EpiSoftmax E;
                    if (sub == 0) { S.init(MP / 256, 4, G, bid); S.aPm = (size_t)256 * D * 2; S.aPn = 512; S.bPn = 512; S.bPm = (size_t)256 * D * 2; S.bShift = 4; g = pg8::Gemm{gQ, KBP, D, D, 256}; E.O = gP; E.ldc = D; E.smp = 0; }
                    else { S.init(1, 32, G, (bid + G - 64) % G); S.mode = 1; g = pg8::Gemm{gQ + (size_t)MP * D, KBS, D, D, 256}; E.O = PS; E.ldc = 8192; E.smp = 1; }
                    pg8::gemm_phase<pg8::EpiSoftmax, pg8::GSched, true>(lds, g, S, E, wave_s);
                }
            }
            GRID_SYNC();
          }
        }
    }
    {
        LANE_STATE();
        const float* gain = INP(I_GFIN);
        f32x4 gv[4];
#pragma unroll
        for (int j = 0; j < 4; ++j) gv[j] = ((const f32x4*)gain)[lane + 64 * j];
        for (int m0 = gw; m0 < MT; m0 += 2 * NGW) {
            const int m1 = m0 + NGW; const bool two = m1 < MT; const int mb = two ? m1 : m0;
            const u32x2* xa = (const u32x2*)(XN + (size_t)m0 * D) + lane; const u32x2* xb = (const u32x2*)(XN + (size_t)mb * D) + lane;
            u32x2 pa[4], pb[4];
#pragma unroll
            for (int j = 0; j < 4; ++j) { pa[j] = xa[64 * j]; pb[j] = xb[64 * j]; }
            const float ra = ss_rstd(*(const f32x4*)(SSQ(6) + (size_t)m0 * 4)), rb = ss_rstd(*(const f32x4*)(SSQ(6) + (size_t)mb * 4));
            f32x4* ya = (f32x4*)(out + (size_t)m0 * D) + lane; f32x4* yb = (f32x4*)(out + (size_t)mb * D) + lane;
#pragma unroll
            for (int j = 0; j < 4; ++j) { ya[64 * j] = (f32x4){bflo(pa[j].x), bfhi(pa[j].x), bflo(pa[j].y), bfhi(pa[j].y)} * ra * gv[j]; if (two) yb[64 * j] = (f32x4){bflo(pb[j].x), bfhi(pb[j].x), bflo(pb[j].y), bfhi(pb[j].y)} * rb * gv[j]; }
        }
    }
}

extern "C" void kernel_launch(void* const* d_in, const int* in_sizes, int n_in, void* d_out, int out_size, void* d_ws, size_t ws_size, hipStream_t stream) {
    static int grid = 0;
    if (grid == 0) {
        if (n_in != N_IN || (size_t)out_size != O_END || ws_size < WS_END) { fprintf(stderr, "kernel_launch: unexpected sizes n_in %d out %d ws %zu (need %zu)\n", n_in, out_size, ws_size, (size_t)WS_END); grid = -1; return; }
        int dev = 0, cus = 0, per_cu = 0;
        (void)hipGetDevice(&dev); (void)hipDeviceGetAttribute(&cus, hipDeviceAttributeMultiprocessorCount, dev);
        if (hipFuncSetAttribute((const void*)trunk_fwd, hipFuncAttributeMaxDynamicSharedMemorySize, LDS_BYTES) != hipSuccess) { fprintf(stderr, "kernel_launch: hipFuncSetAttribute failed\n"); grid = -1; return; }
        if (hipOccupancyMaxActiveBlocksPerMultiprocessor(&per_cu, (const void*)trunk_fwd, NTHREADS, LDS_BYTES) != hipSuccess || per_cu < 1) { fprintf(stderr, "kernel_launch: occupancy query gave %d\n", per_cu); per_cu = 1; }
        (void)hipGetLastError();
        grid = cus * 1;
        if (grid != 256) fprintf(stderr, "kernel_launch: note: %d CUs\n", grid);
    }
    if (grid < 0) return;
    Args a{};
    for (int i = 0; i < N_IN; ++i) a.in[i] = (const float*)d_in[i];
    a.out = (float*)d_out; a.ws = (unsigned char*)d_ws;
    void* kargs[] = {&a};
    hipError_t e = hipLaunchCooperativeKernel((const void*)trunk_fwd, dim3(grid), dim3(NTHREADS), kargs, LDS_BYTES, stream);
    if (e != hipSuccess) fprintf(stderr, "kernel_launch: cooperative launch failed: %s (grid %d)\n", hipGetErrorString(e), grid);
}
```

```cpp
#include <hip/hip_runtime.h>
#include <hip/hip_cooperative_groups.h>
#include <cstdio>
#include <cstdint>
namespace cg = cooperative_groups;
#ifndef PROBE
#define PROBE 0
#endif

#define LAS __attribute__((address_space(3)))
typedef unsigned short bf16_t;
typedef short bf16x8 __attribute__((ext_vector_type(8)));
typedef float f32x4 __attribute__((ext_vector_type(4)));
typedef float f32x2 __attribute__((ext_vector_type(2)));
typedef unsigned u32x4 __attribute__((ext_vector_type(4)));
typedef unsigned u32x2 __attribute__((ext_vector_type(2)));

constexpr int D = 1024, BP = 8, SEQ = 4096, BS = 8, TS = 32, DEPTH = 2;
constexpr int MP = BP * SEQ, MS = BS * TS, MT = MP + MS;
constexpr int INC = 2304, DFF = 2816, NMEM = 256, AW = 512, BW = 256, CW = 256;
constexpr int Z_XA = 0, Z_GA = 512, Z_XB = 1024, Z_GB = 1280, Z_GC = 1536, Z_UC = 1792, Z_VC = 2048;
constexpr float EPS = 1e-6f;
constexpr int NWAVES = 8, NTHREADS = 512;

constexpr size_t O_YP = 0, O_YS = O_YP + (size_t)MP * D, O_CAP = O_YS + (size_t)MS * D, O_HAP = O_CAP + DEPTH * BP * 3 * AW,
                 O_CBP = O_HAP + DEPTH * BP * AW, O_CFP = O_CBP + DEPTH * BP * 2 * BW, O_MKP = O_CFP + DEPTH * BP * 2 * DFF,
                 O_MVP = O_MKP + (size_t)DEPTH * BP * NMEM * D, O_CAS = O_MVP + (size_t)DEPTH * BP * NMEM * D, O_HAS = O_CAS + DEPTH * BS * 3 * AW,
                 O_CBS = O_HAS + DEPTH * BS * AW, O_CFS = O_CBS + DEPTH * BS * 2 * BW, O_VCS = O_CFS + DEPTH * BS * 2 * DFF,
                 O_END = O_VCS + DEPTH * BS * TS * CW;

constexpr size_t MiB = 1u << 20;
constexpr size_t WS_WIN = 0, WS_WOUT = 5 * MiB, WS_WQ = 7 * MiB, WS_WK = 9 * MiB, WS_WV = 11 * MiB, WS_WO = 13 * MiB, WS_WUP = 15 * MiB, WS_WDN = 26 * MiB;
constexpr size_t WS_MEMB = 32 * MiB, WS_KBP = 36 * MiB, WS_VTP = 40 * MiB, WS_KBS = 44 * MiB, WS_VTS = 48 * MiB, WS_WST = 52 * MiB, WS_GT = WS_WST + 131072, WS_AGG = 53 * MiB, WS_SS = 54 * MiB + 256 * 1024, WS_BAR = 55 * MiB + 512 * 1024;
constexpr size_t WS_XN = 56 * MiB, WS_BIG = 121 * MiB;
constexpr size_t B_Z = WS_BIG, B_HLOC = WS_BIG + 146 * MiB, B_PCUM = WS_BIG + 211 * MiB, B_Y = WS_BIG + 276 * MiB;
constexpr size_t B_Q = WS_BIG, B_P = WS_BIG + 65 * MiB, B_O = WS_BIG + 130 * MiB, B_PS = WS_BIG + 195 * MiB;
constexpr size_t B_GU = WS_BIG;
constexpr size_t B_GUS = WS_BIG + 200 * MiB;
constexpr size_t B_SBG = WS_BIG + 204 * MiB, B_SBU = WS_BIG + 207 * MiB, B_SBL = WS_BIG + 210 * MiB;
constexpr size_t WS_END = WS_BIG + (size_t)MT * 2 * DFF * 2;
constexpr size_t WS_SSP = 476 * MiB;
static_assert(WS_END <= WS_SSP && WS_SSP + (size_t)7 * MT * 64 <= 512 * MiB, "workspace");
static_assert(WS_XN + (size_t)MT * D * 2 <= WS_BIG, "xn");
constexpr size_t WS_SSS = WS_SSP + (((size_t)7 * MT * 16 + 4095) / 4096) * 4096;
static_assert(WS_SSS + 7 * 256 * 32 * 4 <= 480 * MiB, "sss");
constexpr size_t WSEL1 = 480 * MiB, KSEL1 = 418 * MiB;
static_assert(WS_WDN + (size_t)D * DFF * 2 + WSEL1 <= 512 * MiB && WS_KBS + KSEL1 >= WS_BIG + 341 * MiB && WS_GT + 131072 + KSEL1 <= WS_SSP, "second buffer set");

constexpr int LDS_RING = 131072, LDS_EX = LDS_RING, LDS_MISC = LDS_EX + 8192, LDS_BYTES = 147456;

enum { I_XP = 0, I_XS, I_MEM, I_CK, I_CV, I_SCA, I_SHA, I_SCB, I_SCF, I_GMIX, I_WIN, I_CAW, I_CAB, I_WRG, I_BRG, I_WIG, I_BIG, I_LAM, I_CBW, I_GV, I_WS, I_BSS,
       I_WOUT, I_GX, I_WQ, I_WK, I_WV, I_WO, I_GFFN, I_WUP, I_CFW, I_WDN, I_GFIN, N_IN };

struct Args { const float* in[N_IN]; float* out; unsigned char* ws; };

__device__ __forceinline__ unsigned f2bf(float f) { unsigned u = __builtin_bit_cast(unsigned, f); return (u + 0x7fffu + ((u >> 16) & 1u)) >> 16; }
__device__ __forceinline__ unsigned pk2(float lo, float hi) { return f2bf(lo) | (f2bf(hi) << 16); }
__device__ __forceinline__ float bf2f(unsigned v) { return __builtin_bit_cast(float, v << 16); }
__device__ __forceinline__ float bflo(unsigned w) { return __builtin_bit_cast(float, w << 16); }
__device__ __forceinline__ float bfhi(unsigned w) { return __builtin_bit_cast(float, w & 0xffff0000u); }
__device__ __forceinline__ unsigned cvt_pk_bf16(float lo, float hi) { unsigned r; asm volatile("v_cvt_pk_bf16_f32 %0, %1, %2" : "=v"(r) : "v"(lo), "v"(hi)); return r; }
__device__ __forceinline__ float fexp(float x) { return __builtin_amdgcn_exp2f(x * 1.4426950408889634f); }
__device__ __forceinline__ float sigm(float x) { return __builtin_amdgcn_rcpf(1.0f + fexp(-x)); }
__device__ __forceinline__ float gelu_t(float x) { const float u = 0.7978845608028654f * (x + 0.044715f * x * x * x); return x * sigm(2.0f * u); }
__device__ __forceinline__ float silu(float x) { return x * sigm(x); }
__device__ __forceinline__ float shx(float v, int m, int lane) { return __builtin_bit_cast(float, __builtin_amdgcn_ds_bpermute((lane ^ m) << 2, __builtin_bit_cast(int, v))); }
__device__ __forceinline__ float wave_sum(float v, int lane) {
#pragma unroll
    for (int o = 1; o < 64; o <<= 1) v += shx(v, o, lane);
    return v;
}
#define LDS_WAIT() asm volatile("s_waitcnt lgkmcnt(0)" ::: "memory")
__device__ __forceinline__ float ss_rstd(f32x4 p) { return 1.0f / sqrtf(((p[0] + p[1]) + (p[2] + p[3])) * (1.f / 1024.f) + 1e-6f); }
__device__ __forceinline__ int opaque_tid(int wave_s) { int l; asm volatile("v_mbcnt_lo_u32_b32 %0, -1, 0\n\tv_mbcnt_hi_u32_b32 %0, -1, %0" : "=v"(l)); return wave_s * 64 + l; }

namespace pg8 {
constexpr int BM = 256, BK = 64, HALF = 128, HTB = HALF * BK * 2, NXCD = 8, WGM = 8;
__device__ __forceinline__ int lds_byte(int r, int c) { const int st = (r >> 4) * 2 + (c >> 5), rr = r & 15, cc = c & 31, ob = rr * 64 + cc * 2; return st * 1024 + (ob ^ (((ob >> 9) & 1) << 5)); }
__device__ __forceinline__ void stage_rc(int b, int& R, int& C) { const int st = b / 1024, sb = b % 1024, swz = sb ^ (((sb >> 9) & 1) << 5); R = (st >> 1) * 16 + swz / 64; C = (st & 1) * 32 + (swz % 64) / 2; }
__device__ __forceinline__ int perm32(int rho) { const int n = rho >> 4, i = rho & 15; return 8 * (i >> 2) + 4 * n + (i & 3); }

struct Unit { int pm, pn; };
struct Gemm { const bf16_t* A; const bf16_t* Bt; int lda, ldb, K; };

struct GSched {
    int nM, nN, nwg, G, c, mode;
    size_t aPm, aPn, bPn, bPm; int bShift;
    __device__ __forceinline__ void init(int nM_, int nN_, int G_, int c_) { nM = nM_; nN = nN_; nwg = nM * nN; G = G_; c = c_; mode = 0; aPm = 0; aPn = 0; bPn = 0; bPm = 0; bShift = 0; }
    __device__ __forceinline__ bool next(int i, Unit& u) const {
        const long L = (long)i * G + c; if (L >= nwg) return false;
        int wgid = (int)L; { const int q = nwg / NXCD, r = nwg % NXCD, xcd = wgid % NXCD, off = wgid / NXCD; wgid = (xcd < r ? xcd * (q + 1) : r * (q + 1) + (xcd - r) * q) + off; }
        const int nig = WGM * nN, gid = wgid / nig, fm = gid * WGM, gsz = (nM - fm) < WGM ? (nM - fm) : WGM;
        u.pm = fm + ((wgid % nig) % gsz); u.pn = (wgid % nig) / gsz; return true;
    }
    __device__ __forceinline__ size_t offA(const Unit& u) const { return mode == 1 ? (size_t)(u.pn & 3) * 512 : (mode == 2 ? (size_t)(u.pn & 3) * 4096 + (size_t)(u.pn >> 2) * 512 : (size_t)u.pm * aPm + (size_t)u.pn * aPn); }
    __device__ __forceinline__ size_t offB(const Unit& u) const { return mode == 1 ? (size_t)(u.pn >> 2) * (256 * 1024 * 2) + (size_t)(u.pn & 3) * 512 : (mode == 2 ? (size_t)(u.pn & 3) * (256 * 2048 * 2) + (size_t)(u.pn >> 2) * 512 : (size_t)u.pn * bPn + (size_t)(u.pm >> bShift) * bPm); }
};

struct EpiBf16 {
    static constexpr bool PERM = true;
    bf16_t* O; int ldc; float scale; const float* ss; int smp;
    __device__ __forceinline__ void operator()(f32x4 (&acc)[2][2][4][2], const Unit& u, int wr, int wc, int fr, int fq, LAS unsigned char*) const {
        asm volatile("" : "+v"(fr), "+v"(fq)); asm volatile("" : "+s"(wr), "+s"(wc));
        const int row0 = u.pm * BM + wr * 64 + fr, col0 = (smp ? (u.pn & 3) : u.pn) * BM + wc * 32 + 8 * fq;
        f32x4 rs[2][4];
#pragma unroll
        for (int ai = 0; ai < 2; ++ai)
#pragma unroll
            for (int m = 0; m < 4; ++m) rs[ai][m] = ss ? *(const f32x4*)(ss + (size_t)(row0 + ai * HALF + m * 16) * 4) : (f32x4){0.f, 0.f, 0.f, 0.f};
#pragma unroll
        for (int ai = 0; ai < 2; ++ai)
#pragma unroll
            for (int m = 0; m < 4; ++m) { bf16_t* rowp = O + (size_t)(row0 + ai * HALF + m * 16) * ldc + col0;
                float sc = scale; if (ss) sc *= ss_rstd(rs[ai][m]);
                if (smp && ((ai * HALF + wr * 64 + m * 16 + fr) >> 5) != (u.pn >> 2)) continue;
#pragma unroll
                for (int bj = 0; bj < 2; ++bj) { const f32x4 v0 = acc[ai][bj][m][0] * sc, v1 = acc[ai][bj][m][1] * sc;
                    u32x4 w; w.x = cvt_pk_bf16(v0[0], v0[1]); w.y = cvt_pk_bf16(v0[2], v0[3]); w.z = cvt_pk_bf16(v1[0], v1[1]); w.w = cvt_pk_bf16(v1[2], v1[3]);
                    *(u32x4*)(rowp + bj * HALF) = w; } }
    }
};
struct EpiResid {
    static constexpr bool PERM = true;
    bf16_t* xb; float* ss;
    __device__ __forceinline__ void operator()(f32x4 (&acc)[2][2][4][2], const Unit& u, int wr, int wc, int fr, int fq, LAS unsigned char* lds) const {
        asm volatile("" : "+v"(fr), "+v"(fq)); asm volatile("" : "+s"(wr), "+s"(wc));
        const int col0 = u.pn * BM + wc * 32 + 8 * fq, lane = fq * 16 + fr;
        LAS float* PS = (LAS float*)(lds + LDS_EX);
        bf16_t* ob = xb + (size_t)u.pm * BM * D;
#pragma unroll
        for (int ai = 0; ai < 2; ++ai) {
            u32x4 pre[4][2];
#pragma unroll
            for (int m = 0; m < 4; ++m)
#pragma unroll
                for (int bj = 0; bj < 2; ++bj) pre[m][bj] = *(const u32x4*)(ob + (size_t)(ai * HALF + wr * 64 + m * 16 + fr) * D + col0 + bj * HALF);
            asm volatile("" ::: "memory");
#pragma unroll
            for (int m = 0; m < 4; ++m) { const int rl = ai * HALF + wr * 64 + m * 16 + fr; const size_t off = (size_t)rl * D + col0; float q = 0.f;
#pragma unroll
                for (int bj = 0; bj < 2; ++bj) { const u32x4 p = pre[m][bj]; const f32x4 a0 = acc[ai][bj][m][0], a1 = acc[ai][bj][m][1];
                    const float v0 = bflo(p.x) + a0[0], v1 = bfhi(p.x) + a0[1], v2 = bflo(p.y) + a0[2], v3 = bfhi(p.y) + a0[3], v4 = bflo(p.z) + a1[0], v5 = bfhi(p.z) + a1[1], v6 = bflo(p.w) + a1[2], v7 = bfhi(p.w) + a1[3];
                    u32x4 w; w.x = cvt_pk_bf16(v0, v1); w.y = cvt_pk_bf16(v2, v3); w.z = cvt_pk_bf16(v4, v5); w.w = cvt_pk_bf16(v6, v7); *(u32x4*)(ob + off + bj * HALF) = w;
                    q += ((v0 * v0 + v1 * v1) + (v2 * v2 + v3 * v3)) + ((v4 * v4 + v5 * v5) + (v6 * v6 + v7 * v7)); }
                q += shx(q, 16, lane); q += shx(q, 32, lane);
                if (fq == 0) PS[rl * 4 + wc] = q; }
            asm volatile("" ::: "memory");
        }
        asm volatile("s_waitcnt lgkmcnt(0)" ::: "memory"); __builtin_amdgcn_s_barrier(); asm volatile("" ::: "memory");
        { const int t = (wr * 4 + wc) * 64 + lane; if (t < 256) { const f32x4 p = *(const LAS f32x4*)(PS + t * 4); ss[(size_t)(u.pm * BM + t) * 4 + u.pn] = (p[0] + p[1]) + (p[2] + p[3]); } }
    }
};
struct EpiKV {
    static constexpr bool PERM = false;
    float* outK; float* outV; bf16_t* KB; bf16_t* VT;
    __device__ __forceinline__ void operator()(f32x4 (&acc)[2][2][4][2], const Unit& u, int wr, int wc, int fr, int fq, LAS unsigned char*) const {
        asm volatile("" : "+v"(fr), "+v"(fq)); asm volatile("" : "+s"(wr), "+s"(wc));
        const int kind = u.pm >> 4, pm = u.pm & 15;
        const int col0 = u.pn * BM + wc * 32 + 4 * fq;
        float* of = kind == 0 ? outK : outV; bf16_t* ob = kind == 0 ? KB : VT; const int ldb_ = kind == 2 ? 2048 : 1024;
#pragma unroll
        for (int ai = 0; ai < 2; ++ai)
#pragma unroll
            for (int m = 0; m < 4; ++m) { const int row = pm * BM + ai * HALF + wr * 64 + m * 16 + fr;
#pragma unroll
                for (int bj = 0; bj < 2; ++bj)
#pragma unroll
                    for (int n = 0; n < 2; ++n) { const f32x4 v = acc[ai][bj][m][n]; const int col = col0 + bj * HALF + n * 16;
                        if (kind != 2) *(f32x4*)(of + (size_t)row * 1024 + col) = v;
                        if (kind != 1) { u32x2 w; w.x = cvt_pk_bf16(v[0], v[1]); w.y = cvt_pk_bf16(v[2], v[3]); *(u32x2*)(ob + (size_t)row * ldb_ + col) = w; } } }
    }
};
struct EpiSoftmax {
    static constexpr bool PERM = true;
    bf16_t* O; int ldc; int smp;
    __device__ __forceinline__ void operator()(f32x4 (&acc)[2][2][4][2], const Unit& u, int wr, int wc, int fr, int fq, LAS unsigned char* lds) const {
        asm volatile("" : "+v"(fr), "+v"(fq)); asm volatile("" : "+s"(wr), "+s"(wc));
        LAS f32x2* EX = (LAS f32x2*)(lds + LDS_EX);
        const int lane = fq * 16 + fr;
        const float L2E = 1.4426950408889634f;
#pragma unroll
        for (int ai = 0; ai < 2; ++ai)
#pragma unroll
            for (int m = 0; m < 4; ++m) {
                float mx = -3.0e38f;
#pragma unroll
                for (int bj = 0; bj < 2; ++bj)
#pragma unroll
                    for (int n = 0; n < 2; ++n) { const f32x4 x = acc[ai][bj][m][n]; mx = fmaxf(mx, fmaxf(fmaxf(x[0], x[1]), fmaxf(x[2], x[3]))); }
                mx = fmaxf(mx, shx(mx, 16, lane)); mx = fmaxf(mx, shx(mx, 32, lane));
                float s = 0.f;
#pragma unroll
                for (int bj = 0; bj < 2; ++bj)
#pragma unroll
                    for (int n = 0; n < 2; ++n) { f32x4 x = acc[ai][bj][m][n];
#pragma unroll
                        for (int j = 0; j < 4; ++j) { x[j] = __builtin_amdgcn_exp2f((x[j] - mx) * L2E); s += x[j]; }
                        acc[ai][bj][m][n] = x; }
                s += shx(s, 16, lane); s += shx(s, 32, lane);
                if (fq == 0) EX[(ai * HALF + wr * 64 + m * 16 + fr) * 4 + wc] = (f32x2){mx, s};
            }
        asm volatile("s_waitcnt lgkmcnt(0)" ::: "memory"); __builtin_amdgcn_s_barrier(); asm volatile("" ::: "memory");
        int colb = u.pn * BM, j_ = 0;
        if (smp) { colb = (u.pn & 3) * 2048 + (u.pn >> 2) * 256; j_ = u.pn >> 2; }
        const int col0 = colb + wc * 32 + 8 * fq;
#pragma unroll
        for (int ai = 0; ai < 2; ++ai)
#pragma unroll
            for (int m = 0; m < 4; ++m) {
                const int rl = ai * HALF + wr * 64 + m * 16 + fr;
                const f32x2 e0 = EX[rl * 4 + 0], e1 = EX[rl * 4 + 1], e2 = EX[rl * 4 + 2], e3 = EX[rl * 4 + 3];
                const float M = fmaxf(fmaxf(e0.x, e1.x), fmaxf(e2.x, e3.x));
                const float tot = e0.y * __builtin_amdgcn_exp2f((e0.x - M) * L2E) + e1.y * __builtin_amdgcn_exp2f((e1.x - M) * L2E) + e2.y * __builtin_amdgcn_exp2f((e2.x - M) * L2E) + e3.y * __builtin_amdgcn_exp2f((e3.x - M) * L2E);
                const float own = wc == 0 ? e0.x : (wc == 1 ? e1.x : (wc == 2 ? e2.x : e3.x));
                float f = __builtin_amdgcn_exp2f((own - M) * L2E) / tot;
                if (smp && (rl >> 5) != j_) f = 0.f;
                bf16_t* rowp = O + (size_t)(u.pm * BM + rl) * ldc + col0;
#pragma unroll
                for (int bj = 0; bj < 2; ++bj) { const f32x4 v0 = acc[ai][bj][m][0] * f, v1 = acc[ai][bj][m][1] * f;
                    u32x4 w; w.x = cvt_pk_bf16(v0[0], v0[1]); w.y = cvt_pk_bf16(v0[2], v0[3]); w.z = cvt_pk_bf16(v1[0], v1[1]); w.w = cvt_pk_bf16(v1[2], v1[3]);
                    *(u32x4*)(rowp + bj * HALF) = w; } }
    }
};


__device__ __forceinline__ float dpp_ror1(float v) { return __builtin_bit_cast(float, __builtin_amdgcn_update_dpp(0, __builtin_bit_cast(int, v), 0x121, 0xf, 0xf, false)); }
__device__ __forceinline__ float dpp_ror2(float v) { return __builtin_bit_cast(float, __builtin_amdgcn_update_dpp(0, __builtin_bit_cast(int, v), 0x122, 0xf, 0xf, false)); }
struct EpiAct {
    static constexpr bool PERM = true;
    bf16_t* H; const float* scf; float* ocf; float* sbg; float* sbu; float* sbl; const float* cfw; const float* ss;
    __device__ __forceinline__ void operator()(f32x4 (&acc)[2][2][4][2], const Unit& u, int wr, int wc, int fr, int fq, LAS unsigned char* lds) const {
        asm volatile("" : "+s"(wr), "+s"(wc));
        int lane; asm volatile("v_mbcnt_lo_u32_b32 %0, -1, 0\n\tv_mbcnt_hi_u32_b32 %0, -1, %0" : "=v"(lane));
        fr = lane & 15; fq = lane >> 4;
        const int fl = wc * 32 + 8 * fq, f0 = u.pn * 128 + fl; int rowt = wr * 64 + fr;
        {
            float rst[2][4];
            f32x4 rsl[2][4];
#pragma unroll
            for (int ai = 0; ai < 2; ++ai)
#pragma unroll
                for (int m = 0; m < 4; ++m) rsl[ai][m] = *(const f32x4*)(ss + (size_t)(u.pm * BM + ai * HALF + rowt + m * 16) * 4);
#pragma unroll
            for (int ai = 0; ai < 2; ++ai)
#pragma unroll
                for (int m = 0; m < 4; ++m) { rst[ai][m] = ss_rstd(rsl[ai][m]); }
#pragma unroll
            for (int ai = 0; ai < 2; ++ai)
#pragma unroll
                for (int m = 0; m < 4; ++m) { acc[ai][0][m][0] = acc[ai][0][m][0] * rst[ai][m]; acc[ai][0][m][1] = acc[ai][0][m][1] * rst[ai][m]; acc[ai][1][m][0] = acc[ai][1][m][0] * rst[ai][m]; acc[ai][1][m][1] = acc[ai][1][m][1] * rst[ai][m]; }
        }
        const bool smp = (u.pm == 128);
        asm volatile("" : "+v"(rowt));
        LAS float* BND = (LAS float*)(lds + LDS_EX);
        if (fr >= 14) {
#pragma unroll
            for (int ai = 0; ai < 2; ++ai)
#pragma unroll
                for (int n = 0; n < 2; ++n) *(LAS f32x4*)(BND + ((ai * 2 + wr) * 2 + (fr - 14)) * 128 + fl + 4 * n) = acc[ai][0][3][n];
            if (wr == 1) {
#pragma unroll
                for (int n = 0; n < 2; ++n) *(f32x4*)(sbl + ((size_t)u.pm * 2 + (fr - 14)) * DFF + f0 + 4 * n) = acc[1][0][3][n];
            }
        }
        asm volatile("s_waitcnt lgkmcnt(0)" ::: "memory"); __builtin_amdgcn_s_barrier(); asm volatile("" ::: "memory");
#pragma unroll
        for (int ai = 0; ai < 2; ++ai) {
            const int pg = wr == 1 ? ai * 2 : 1;
            u32x2 hp[2][4];
#pragma unroll
            for (int n = 0; n < 2; ++n) {
                const f32x4 w0 = *(const f32x4*)(cfw + f0 + 4 * n), w1 = *(const f32x4*)(cfw + DFF + f0 + 4 * n), w2 = *(const f32x4*)(cfw + 2 * DFF + f0 + 4 * n);
                f32x4 h2 = *(const LAS f32x4*)(BND + (pg * 2 + 0) * 128 + fl + 4 * n), h1 = *(const LAS f32x4*)(BND + (pg * 2 + 1) * 128 + fl + 4 * n);
                f32x4 t2 = h2, t1 = h1;
                if (smp) { const float* sp = scf + (size_t)((ai * 4 + wr * 2) * 2) * DFF + f0 + 4 * n; h2 = *(const f32x4*)sp; h1 = *(const f32x4*)(sp + DFF); t2 = *(const f32x4*)(sp + 2 * DFF); t1 = *(const f32x4*)(sp + 3 * DFF); }
#pragma unroll
                for (int jp = 0; jp < 2; ++jp) {
                    float hv[4][2];
#pragma unroll
                    for (int jj = 0; jj < 2; ++jj) { const int j = jp * 2 + jj;
                        float r1p = h1[j], r2p = fr == 0 ? h2[j] : h1[j];
#pragma unroll
                        for (int m = 0; m < 4; ++m) { const float g = acc[ai][0][m][n][j];
                            if (m == 2 && smp) { r1p = t1[j]; r2p = fr == 0 ? t2[j] : t1[j]; }
                            const float r1 = dpp_ror1(g), r2 = dpp_ror2(g);
                            const float gm1 = fr >= 1 ? r1 : r1p, gm2 = fr >= 2 ? r2 : r2p;
                            r1p = r1; r2p = r2;
                            const float cv = w0[j] * gm2 + w1[j] * gm1 + w2[j] * g;
                            hv[m][jj] = silu(cv) * acc[ai][1][m][n][j]; } }
#pragma unroll
                    for (int m = 0; m < 4; ++m) { const unsigned pk = cvt_pk_bf16(hv[m][0], hv[m][1]); if (jp == 0) hp[n][m].x = pk; else hp[n][m].y = pk; }
                }
            }
#pragma unroll
            for (int m = 0; m < 4; ++m) {
                const int rl = ai * HALF + rowt + m * 16;
                if (smp && (m & 1) && fr >= 14) {
#pragma unroll
                    for (int n = 0; n < 2; ++n) *(f32x4*)(ocf + ((size_t)(ai * 4 + wr * 2 + (m >> 1)) * 2 + (fr - 14)) * DFF + f0 + 4 * n) = acc[ai][0][m][n];
                }
                if (!smp && ai == 0 && m == 0 && wr == 0 && fr < 2) {
#pragma unroll
                    for (int n = 0; n < 2; ++n) { *(f32x4*)(sbg + ((size_t)u.pm * 2 + fr) * DFF + f0 + 4 * n) = acc[0][0][0][n]; *(f32x4*)(sbu + ((size_t)u.pm * 2 + fr) * DFF + f0 + 4 * n) = acc[0][1][0][n]; }
                } else {
                    u32x4 w; w.x = hp[0][m].x; w.y = hp[0][m].y; w.z = hp[1][m].x; w.w = hp[1][m].y;
                    *(u32x4*)(H + (size_t)(u.pm * BM + rl) * DFF + f0) = w;
                }
            }
        }
    }
};

template <class Epi, class Sched, bool ALIGN_EPI>
__device__ __forceinline__ void gemm_phase(LAS unsigned char* lds, const Gemm g, const Sched& S, const Epi& E, const int wave_s) {
    const int tid = opaque_tid(wave_s), wid = __builtin_amdgcn_readfirstlane(tid >> 6), lane = tid & 63, wr = wid >> 2, wc = wid & 3, fr = lane & 15, fq = lane >> 4;
    const int nt = g.K / BK;
    unsigned voffA[2], voffB[2];
#pragma unroll
    for (int i = 0; i < 2; ++i) { int R, C; stage_rc(tid * 16 + i * 8192, R, C); const int Rb = Epi::PERM ? ((R & ~31) + perm32(R & 31)) : R;
        voffA[i] = (unsigned)(R * g.lda + C) * 2u; voffB[i] = (unsigned)(Rb * g.ldb + C) * 2u; }
    const size_t kstep = (size_t)(BK * 2);
    const size_t hstepA = (size_t)HALF * g.lda * 2, hstepB = (size_t)HALF * g.ldb * 2;
    const unsigned ldsw = (unsigned)wid * 1024u;
    const int aoff = lds_byte(wr * 64 + fr, fq * 8), boff = lds_byte(wc * 32 + fr, fq * 8);
#define PG8_SA(b, h) (((b) * 2 + (h)) * HTB)
#define PG8_SB(b, h) ((4 + (b) * 2 + (h)) * HTB)
#define PG8_STAGE(bufoff, gbase, voff) do { _Pragma("unroll") for (int _i = 0; _i < 2; ++_i) \
        __builtin_amdgcn_global_load_lds((const unsigned*)((const char*)(gbase) + (voff)[_i]), (LAS unsigned*)(lds + (bufoff) + ldsw + _i * 8192), 16, 0, 0); } while (0)
#define PG8_LDA(dst, b, h) do { _Pragma("unroll") for (int m = 0; m < 4; ++m) _Pragma("unroll") for (int k = 0; k < 2; ++k) dst[m][k] = *(const LAS bf16x8*)(lds + PG8_SA(b, h) + aoff + m * 2048 + k * 1024); } while (0)
#define PG8_LDB(dst, b, h) do { _Pragma("unroll") for (int n = 0; n < 2; ++n) _Pragma("unroll") for (int k = 0; k < 2; ++k) dst[n][k] = *(const LAS bf16x8*)(lds + PG8_SB(b, h) + boff + n * 2048 + k * 1024); } while (0)
#define PG8_MMA(ai, bj, At, Bt) do { __builtin_amdgcn_s_setprio(1); _Pragma("unroll") for (int m = 0; m < 4; ++m) _Pragma("unroll") for (int n = 0; n < 2; ++n) _Pragma("unroll") for (int k = 0; k < 2; ++k) \
        acc[ai][bj][m][n] = __builtin_amdgcn_mfma_f32_16x16x32_bf16(Bt[n][k], At[m][k], acc[ai][bj][m][n], 0, 0, 0); __builtin_amdgcn_s_setprio(0); } while (0)
#define PG8_WAIT_V(n) asm volatile("s_waitcnt vmcnt(" #n ")" ::: "memory")
#define PG8_WAIT_L(n) asm volatile("s_waitcnt lgkmcnt(" #n ")" ::: "memory")
#define PG8_BAR __builtin_amdgcn_s_barrier()
#define PG8_SCHED __builtin_amdgcn_sched_barrier(0)
    Unit cur, nxt; int ui = 0;
    if (!S.next(0, cur)) return;
    f32x4 acc[2][2][4][2];
#pragma unroll
    for (int a = 0; a < 2; ++a)
#pragma unroll
        for (int b = 0; b < 2; ++b)
#pragma unroll
            for (int m = 0; m < 4; ++m)
#pragma unroll
                for (int n = 0; n < 2; ++n) acc[a][b][m][n] = (f32x4){0.f, 0.f, 0.f, 0.f};
    bf16x8 At[4][2], B0[2][2], B1[2][2];
    const char* cA = (const char*)g.A + S.offA(cur); const char* cB = (const char*)g.Bt + S.offB(cur);
    PG8_STAGE(PG8_SB(0, 0), cB, voffB); PG8_STAGE(PG8_SB(0, 1), cB + hstepB, voffB); PG8_STAGE(PG8_SA(0, 0), cA, voffA); PG8_STAGE(PG8_SA(0, 1), cA + hstepA, voffA);
    if (wr == 1) PG8_BAR;
    PG8_WAIT_V(2); PG8_BAR;
    PG8_STAGE(PG8_SB(1, 0), cB + kstep, voffB); PG8_STAGE(PG8_SA(1, 0), cA + kstep, voffA); PG8_STAGE(PG8_SB(1, 1), cB + hstepB + kstep, voffB);
    PG8_WAIT_V(6); PG8_BAR;
    for (;;) {
        const bool has_next = S.next(ui + 1, nxt);
        const char* nA = has_next ? (const char*)g.A + S.offA(nxt) : cA; const char* nB = has_next ? (const char*)g.Bt + S.offB(nxt) : cB;
        for (int t = 0; t < nt; t += 2) {
            const bool last = (t == nt - 2);
            const char* a1 = cA + (size_t)(t + 1) * kstep;
            const char* a2 = last ? nA : cA + (size_t)(t + 2) * kstep; const char* b2 = last ? nB : cB + (size_t)(t + 2) * kstep;
            const char* a3 = a2 + kstep; const char* b3 = b2 + kstep;
            PG8_LDB(B0, 0, 0); PG8_LDB(B1, 0, 1); PG8_SCHED; PG8_LDA(At, 0, 0); PG8_STAGE(PG8_SA(1, 1), a1 + hstepA, voffA);
            PG8_WAIT_V(8); PG8_WAIT_L(0); PG8_BAR; PG8_MMA(0, 0, At, B0); PG8_MMA(0, 1, At, B1); PG8_BAR; PG8_SCHED;
            PG8_LDA(At, 0, 1); PG8_STAGE(PG8_SB(0, 0), b2, voffB); PG8_STAGE(PG8_SB(0, 1), b2 + hstepB, voffB); PG8_STAGE(PG8_SA(0, 0), a2, voffA);
            PG8_WAIT_V(8); PG8_WAIT_L(0); PG8_BAR; PG8_MMA(1, 0, At, B0); PG8_MMA(1, 1, At, B1); PG8_BAR; PG8_SCHED;
            PG8_LDB(B0, 1, 0); PG8_LDB(B1, 1, 1); PG8_SCHED; PG8_LDA(At, 1, 0); PG8_STAGE(PG8_SA(0, 1), a2 + hstepA, voffA);
            PG8_WAIT_V(8); PG8_WAIT_L(0); PG8_BAR; PG8_MMA(0, 0, At, B0); PG8_MMA(0, 1, At, B1); PG8_BAR; PG8_SCHED;
            PG8_LDA(At, 1, 1); PG8_STAGE(PG8_SB(1, 0), b3, voffB); PG8_STAGE(PG8_SB(1, 1), b3 + hstepB, voffB); PG8_STAGE(PG8_SA(1, 0), a3, voffA);
            PG8_WAIT_V(8); PG8_WAIT_L(0); PG8_BAR; PG8_MMA(1, 0, At, B0); PG8_MMA(1, 1, At, B1); PG8_BAR; PG8_SCHED;
        }
        if constexpr (ALIGN_EPI) { if (wr == 0) PG8_BAR; }
        E(acc, cur, wr, wc, fr, fq, lds);
        if (!has_next) break;
#pragma unroll
        for (int a = 0; a < 2; ++a)
#pragma unroll
            for (int b = 0; b < 2; ++b)
#pragma unroll
                for (int m = 0; m < 4; ++m)
#pragma unroll
                    for (int n = 0; n < 2; ++n) acc[a][b][m][n] = (f32x4){0.f, 0.f, 0.f, 0.f};
        cur = nxt; cA = nA; cB = nB; ++ui;
        if constexpr (ALIGN_EPI) { if (wr == 1) PG8_BAR; }
    }
    PG8_WAIT_V(0);
    if constexpr (!ALIGN_EPI) { if (wr == 0) PG8_BAR; }
    PG8_BAR;
#undef PG8_SA
#undef PG8_SB
#undef PG8_STAGE
#undef PG8_LDA
#undef PG8_LDB
#undef PG8_MMA
#undef PG8_WAIT_V
#undef PG8_WAIT_L
#undef PG8_BAR
#undef PG8_SCHED
}
}

struct KVSched {
    int c, G; const char* ws; size_t wsel;
    __device__ __forceinline__ bool next(int i, pg8::Unit& u) const {
        const int L = i * G + c; if (c < 0 || L >= 96) return false;
        const int kind = L >> 5, r = L & 31;
        if (kind < 2) { u.pm = kind * 16 + (r >> 2); u.pn = r & 3; } else { u.pm = 32 + (r >> 3); u.pn = r & 7; }
        return true;
    }
    __device__ __forceinline__ size_t offA(const pg8::Unit& u) const { const int kind = u.pm >> 4, pm = u.pm & 15; int k2 = (kind == 2); asm volatile("" : "+v"(k2));
        return (size_t)ws + WS_MEMB + (size_t)k2 * (WS_WV + wsel - WS_MEMB) + (size_t)pm * 256 * 1024 * 2; }
    __device__ __forceinline__ size_t offB(const pg8::Unit& u) const { const int kind = u.pm >> 4; int k1 = (kind == 1), k2 = (kind == 2); asm volatile("" : "+v"(k1), "+v"(k2));
        return (size_t)ws + WS_WK + wsel + (size_t)k1 * (WS_WV - WS_WK) + (size_t)k2 * (WS_MEMB - WS_WK - wsel) + (size_t)u.pn * 256 * 1024 * 2; }
};


#define XB_TMO      128
#define XB_XCNT(j)  (256  + 64 * (j))
#define XB_XSUB(j)  (1280 + 64 * (j))
#define XB_XGEN(j)  (2304 + 64 * (j))
#define XB_TOP      3328
#define XB_TOPGEN   3392
#define XCD_BAR_WORDS 3456
#define XB_SPIN_CAP (1u << 22)
__device__ __forceinline__ unsigned xb_ld(unsigned* p)              { return __hip_atomic_load(p, __ATOMIC_RELAXED, __HIP_MEMORY_SCOPE_AGENT); }
__device__ __forceinline__ unsigned xb_add(unsigned* p, unsigned v) { return __hip_atomic_fetch_add(p, v, __ATOMIC_RELAXED, __HIP_MEMORY_SCOPE_AGENT); }
__device__ __forceinline__ unsigned xb_xcc_id() { return (unsigned)__builtin_amdgcn_s_getreg((3 << 11) | 20) & 0xFu; }
#define XB_SPIN(cond, bar) do { unsigned _sp = 0; while (cond) { __builtin_amdgcn_s_sleep(1); \
    if ((++_sp & 255u) == 0u) { if (xb_ld(&(bar)[XB_TMO])) break; if (_sp > XB_SPIN_CAP) { atomicAdd(&(bar)[XB_TMO], 1u); break; } } } } while (0)
struct XcdBarrier { unsigned* bar; unsigned x; volatile LAS unsigned* st; };
__device__ __forceinline__ void xcd_barrier_complete(unsigned* bar, unsigned x, unsigned& nloc, unsigned& nx) {
    const unsigned G = gridDim.x * gridDim.y * gridDim.z;
    unsigned sum, cnt, mine, sp = 0u;
    for (;;) {
        sum = 0u; cnt = 0u; mine = 0u;
#pragma unroll
        for (unsigned j = 0; j < 16; ++j) { const unsigned c = xb_ld(&bar[XB_XCNT(j)]); sum += c; cnt += (c > 0u) ? 1u : 0u; mine = (j == x) ? c : mine; }
        if (sum == G) break;
        __builtin_amdgcn_s_sleep(1);
        if ((++sp & 255u) == 0u) { if (xb_ld(&bar[XB_TMO])) break; if (sp > XB_SPIN_CAP) { atomicAdd(&bar[XB_TMO], 1u); break; } }
    }
    nloc = mine > 0u ? mine : 1u; nx = cnt > 0u ? cnt : 1u;
}
__device__ __forceinline__ void xcd_barrier(const XcdBarrier& b) {
    asm volatile("s_waitcnt vmcnt(0)" ::: "memory");
    __syncthreads();
    if (threadIdx.x == 0) {
        unsigned* bar = b.bar;
        __builtin_amdgcn_s_waitcnt(0);
        unsigned nloc = b.st[0], nx = b.st[1];
        if (nloc == 0u) { xcd_barrier_complete(bar, b.x, nloc, nx); b.st[0] = nloc; b.st[1] = nx; }
        const unsigned old = xb_add(&bar[XB_XSUB(b.x)], 1u);
        const unsigned gen = old / nloc;
        if (old + 1u == (gen + 1u) * nloc) {
            __builtin_amdgcn_fence(__ATOMIC_RELEASE, "agent");
            asm volatile("s_waitcnt vmcnt(0)" ::: "memory");
            const unsigned og = xb_add(&bar[XB_TOP], 1u);
            const unsigned tg = og / nx;
            if (og + 1u == (tg + 1u) * nx) xb_add(&bar[XB_TOPGEN], 1u);
            else XB_SPIN(xb_ld(&bar[XB_TOPGEN]) == tg, bar);
            __builtin_amdgcn_fence(__ATOMIC_ACQUIRE, "agent");
            xb_add(&bar[XB_XGEN(b.x)], 1u);
            asm volatile("s_waitcnt vmcnt(0)" ::: "memory");
        } else {
            XB_SPIN(xb_ld(&bar[XB_XGEN(b.x)]) == gen, bar);
            __builtin_amdgcn_fence(__ATOMIC_ACQUIRE, "agent");
            asm volatile("s_waitcnt vmcnt(0)" ::: "memory");
        }
    }
    __syncthreads();
}


struct SG2 { const bf16_t* A; const bf16_t* Bt; int lda, ldb, K, N; bf16_t* O; int ldc; float scale; int mode; float* ssp; };
__device__ __forceinline__ float sq8(bf16x8 a) { float q = 0.f;
#pragma unroll
    for (int i = 0; i < 8; ++i) { const float f = bf2f((unsigned)(unsigned short)a[i]); q += f * f; } return q; }
__device__ __forceinline__ void sgemm2(LAS unsigned char* lds, const SG2 g, int ubase, int G, int wave, int tid) {
    const int lane = tid & 63, fr = lane & 15, fq = lane >> 4, rt = wave & 3, ch = wave >> 2;
    const int nunits = (g.N / 64) * 4, nsl = g.K / 64;
    int R, C; pg8::stage_rc(tid * 16, R, C);
    const unsigned offA = (unsigned)(R * g.lda + C) * 2u, offB = (unsigned)(R * g.ldb + C) * 2u;
    const int aoff = pg8::lds_byte(rt * 16 + fr, fq * 8), boff = pg8::lds_byte(ch * 32 + fr, fq * 8);
    for (int un = ubase; un >= 0 && un < nunits; un += G) {
        const int cgp = un >> 2, rg = un & 3;
        const char* gA = (const char*)(g.A + (size_t)rg * 64 * g.lda) + offA; const char* gB = (const char*)(g.Bt + (size_t)cgp * 64 * g.ldb) + offB;
#define SG2_STAGE(sl) do { LAS unsigned char* d_ = lds + ((sl) & 3) * 16384 + wave * 1024; \
        __builtin_amdgcn_global_load_lds((const unsigned*)(gA + (size_t)(sl) * 128), (LAS unsigned*)d_, 16, 0, 0); \
        __builtin_amdgcn_global_load_lds((const unsigned*)(gB + (size_t)(sl) * 128), (LAS unsigned*)(d_ + 8192), 16, 0, 0); } while (0)
        asm volatile("s_waitcnt vmcnt(0)" ::: "memory");
        SG2_STAGE(0); SG2_STAGE(1);
        f32x4 acc[2] = {(f32x4){0.f, 0.f, 0.f, 0.f}, (f32x4){0.f, 0.f, 0.f, 0.f}}; float q = 0.f;
        for (int sl = 0; sl < nsl; ++sl) {
            if (sl + 1 < nsl) asm volatile("s_waitcnt vmcnt(2)" ::: "memory"); else asm volatile("s_waitcnt vmcnt(0)" ::: "memory");
            __builtin_amdgcn_s_barrier(); asm volatile("" ::: "memory");
            if (sl + 2 < nsl) SG2_STAGE(sl + 2);
            LAS unsigned char* b_ = lds + (sl & 3) * 16384;
#pragma unroll
            for (int ks = 0; ks < 2; ++ks) {
                const bf16x8 a = *(const LAS bf16x8*)(b_ + aoff + ks * 1024);
#pragma unroll
                for (int c = 0; c < 2; ++c) { const bf16x8 b = *(const LAS bf16x8*)(b_ + 8192 + boff + c * 2048 + ks * 1024);
                    acc[c] = __builtin_amdgcn_mfma_f32_16x16x32_bf16(b, a, acc[c], 0, 0, 0); }
                if (g.mode == 1) q += sq8(a);
            }
        }
#undef SG2_STAGE
        const int row = rg * 64 + rt * 16 + fr, col = cgp * 64 + ch * 32 + fq * 4;
        bf16_t* op = g.O + (size_t)row * g.ldc + col;
        if (g.mode == 1) {
            q += shx(q, 16, lane); q += shx(q, 32, lane);
            const float sc = g.scale / sqrtf(q * (1.f / 1024.f) + EPS);
#pragma unroll
            for (int c = 0; c < 2; ++c) { const f32x4 v = acc[c] * sc; u32x2 w; w.x = cvt_pk_bf16(v[0], v[1]); w.y = cvt_pk_bf16(v[2], v[3]); *(u32x2*)(op + c * 16) = w; }
        } else {
            const u32x2 p0 = *(const u32x2*)op, p1 = *(const u32x2*)(op + 16); float qq = 0.f;
            { const float v0 = bflo(p0.x) + acc[0][0], v1 = bfhi(p0.x) + acc[0][1], v2 = bflo(p0.y) + acc[0][2], v3 = bfhi(p0.y) + acc[0][3];
              u32x2 w; w.x = cvt_pk_bf16(v0, v1); w.y = cvt_pk_bf16(v2, v3); *(u32x2*)op = w; qq += (v0 * v0 + v1 * v1) + (v2 * v2 + v3 * v3); }
            { const float v0 = bflo(p1.x) + acc[1][0], v1 = bfhi(p1.x) + acc[1][1], v2 = bflo(p1.y) + acc[1][2], v3 = bfhi(p1.y) + acc[1][3];
              u32x2 w; w.x = cvt_pk_bf16(v0, v1); w.y = cvt_pk_bf16(v2, v3); *(u32x2*)(op + 16) = w; qq += (v0 * v0 + v1 * v1) + (v2 * v2 + v3 * v3); }
            qq += shx(qq, 16, lane); qq += shx(qq, 32, lane);
            if (fq == 0) g.ssp[row * 32 + cgp * 2 + ch] = qq;
        }
        asm volatile("s_waitcnt vmcnt(0) lgkmcnt(0)" ::: "memory"); __builtin_amdgcn_s_barrier(); asm volatile("" ::: "memory");
    }
}
__device__ __forceinline__ void sample_ss_reduce(const float* sss, float* ssq, int tid) {
    if (tid < 256) { const f32x4* p = (const f32x4*)(sss + tid * 32); float t = 0.f;
#pragma unroll
        for (int i = 0; i < 8; ++i) { const f32x4 v = p[i]; t += (v[0] + v[1]) + (v[2] + v[3]); }
        *(f32x4*)(ssq + (size_t)(MP + tid) * 4) = (f32x4){t, 0.f, 0.f, 0.f}; }
    asm volatile("s_waitcnt vmcnt(0)" ::: "memory"); __syncthreads();
}

__device__ __forceinline__ void transpose_item(const float* W, int K, int N, bf16_t* WT, LAS float* scr, int item, int lane, const float* gain = nullptr, int gu = 0) {
    const int nblk = N / 32, kb = item / nblk, nb = item % nblk, k0 = 64 * kb, n0 = 32 * nb;
    {
        f32x4 v[8];
#pragma unroll
        for (int i = 0; i < 8; ++i) v[i] = *(const f32x4*)(W + (size_t)(k0 + (lane >> 3) + 8 * i) * N + n0 + (lane & 7) * 4);
#pragma unroll
        for (int i = 0; i < 8; ++i) { const int kk = (lane >> 3) + 8 * i; f32x4 w = v[i]; if (gain) w = w * gain[k0 + kk];
            LAS float* d = scr + kk * 33 + (lane & 7) * 4; d[0] = w[0]; d[1] = w[1]; d[2] = w[2]; d[3] = w[3]; }
    }
    LDS_WAIT();
    const int c = lane & 7;
#pragma unroll
    for (int j = 0; j < 4; ++j) { const int n = (lane >> 3) + 8 * j; const LAS float* s = scr + (8 * c) * 33 + n;
        u32x4 o; o.x = pk2(s[0 * 33], s[1 * 33]); o.y = pk2(s[2 * 33], s[3 * 33]); o.z = pk2(s[4 * 33], s[5 * 33]); o.w = pk2(s[6 * 33], s[7 * 33]);
        int drow = n0 + n; if (gu) { const int up = drow >= gu, f = up ? drow - gu : drow; drow = ((f >> 7) << 8) + (up << 7) + (f & 127); }
        *(u32x4*)(WT + (size_t)drow * K + k0 + 8 * c) = o; }
    LDS_WAIT();
}

__device__ __forceinline__ void first_rows(const float* Xp, const float* Xs, bf16_t* XNo, float* ss, int gw, int NGW, int lane) {
    for (int m0 = gw; m0 < MT; m0 += 2 * NGW) {
        const int m1 = m0 + NGW; const bool two = m1 < MT; const int mb = two ? m1 : m0;
        const f32x4* xa = (const f32x4*)(m0 < MP ? Xp + (size_t)m0 * D : Xs + (size_t)(m0 - MP) * D) + lane;
        const f32x4* xb = (const f32x4*)(mb < MP ? Xp + (size_t)mb * D : Xs + (size_t)(mb - MP) * D) + lane;
        f32x4 va[4], vb[4]; float sa = 0.f, sb = 0.f;
#pragma unroll
        for (int j = 0; j < 4; ++j) { va[j] = xa[64 * j]; vb[j] = xb[64 * j]; }
#pragma unroll
        for (int j = 0; j < 4; ++j) { sa += (va[j].x * va[j].x + va[j].y * va[j].y) + (va[j].z * va[j].z + va[j].w * va[j].w); sb += (vb[j].x * vb[j].x + vb[j].y * vb[j].y) + (vb[j].z * vb[j].z + vb[j].w * vb[j].w); }
        sa = wave_sum(sa, lane); sb = wave_sum(sb, lane);
        if (lane < 4) { ss[(size_t)m0 * 4 + lane] = lane == 0 ? sa : 0.f; if (two) ss[(size_t)m1 * 4 + lane] = lane == 0 ? sb : 0.f; }
        u32x2* oa = (u32x2*)(XNo + (size_t)m0 * D) + lane; u32x2* ob = (u32x2*)(XNo + (size_t)mb * D) + lane;
#pragma unroll
        for (int j = 0; j < 4; ++j) { u32x2 w; w.x = pk2(va[j].x, va[j].y); w.y = pk2(va[j].z, va[j].w); oa[64 * j] = w; if (two) { w.x = pk2(vb[j].x, vb[j].y); w.y = pk2(vb[j].z, vb[j].w); ob[64 * j] = w; } }
    }
}

typedef __attribute__((address_space(4))) const unsigned char* kptr_t;
typedef const float* cfp_t; typedef float* fp_t; typedef unsigned char* ucp_t;
#define INP(k) (*(const __attribute__((address_space(4))) cfp_t*)(kp + 8 * (k)))
#define X out
#define WIN_T ((bf16_t*)(ws + WS_WIN + wsel))
#define WOUT_T ((bf16_t*)(ws + WS_WOUT + wsel))
#define WQ_T ((bf16_t*)(ws + WS_WQ + wsel))
#define WK_T ((bf16_t*)(ws + WS_WK + wsel))
#define WV_T ((bf16_t*)(ws + WS_WV + wsel))
#define WO_T ((bf16_t*)(ws + WS_WO + wsel))
#define WUP_T ((bf16_t*)(ws + WS_WUP + wsel))
#define WDN_T ((bf16_t*)(ws + WS_WDN + wsel))
#define MEMB ((bf16_t*)(ws + WS_MEMB))
#define KBP ((bf16_t*)(ws + WS_KBP))
#define VTP ((bf16_t*)(ws + WS_VTP))
#define KBS ((bf16_t*)(ws + WS_KBS + ksel))
#define VTS ((bf16_t*)(ws + WS_VTS + ksel))
#define WST ((bf16_t*)(ws + WS_WST + ksel))
#define AGG ((float*)(ws + WS_AGG))
#define SSQ(i) ((float*)(ws + WS_SSP) + (size_t)(i) * MT * 4)
#define SSS(i) ((float*)(ws + WS_SSS) + (size_t)(i) * 256 * 32)
#define GT_R ((bf16_t*)(ws + WS_GT + ksel))
#define GT_I ((bf16_t*)(ws + WS_GT + 65536 + ksel))
#define XN ((bf16_t*)(ws + WS_XN))
#define gZ ((bf16_t*)(ws + B_Z))
#define HLOC ((float*)(ws + B_HLOC))
#define PCUM ((float*)(ws + B_PCUM))
#define gY ((bf16_t*)(ws + B_Y))
#define gQ ((bf16_t*)(ws + B_Q))
#define gP ((bf16_t*)(ws + B_P))
#define gO ((bf16_t*)(ws + B_O))
#define PS ((bf16_t*)(ws + B_PS))
#define GU ((bf16_t*)(ws + B_GU))
#define GUS ((bf16_t*)(ws + B_GUS))
#define SBG ((float*)(ws + B_SBG))
#define SBU ((float*)(ws + B_SBU))
#define SBL ((float*)(ws + B_SBL))
__device__ __forceinline__ void convert_layer(kptr_t kp, unsigned char* ws, LAS unsigned char* lds, const int l, const int part, const int nparts, const int gw, const int NGW, const int gt, const int NGT, const int lane, const int wave) {
            const size_t wsel = (size_t)(l & 1) * WSEL1, ksel = (size_t)(l & 1) * KSEL1;
            LAS float* scr = (LAS float*)(lds + wave * 16384);
            const float* w_in = INP(I_WIN) + (size_t)l * D * INC; const float* w_out = INP(I_WOUT) + (size_t)l * D * D; const float* w_q = INP(I_WQ) + (size_t)l * D * D;
            const float* w_k = INP(I_WK) + (size_t)l * D * D; const float* w_v = INP(I_WV) + (size_t)l * D * D; const float* w_o = INP(I_WO) + (size_t)l * D * D;
            const float* w_up = INP(I_WUP) + (size_t)l * D * 2 * DFF; const float* w_dn = INP(I_WDN) + (size_t)l * DFF * D; const float* c_v = INP(I_CV) + (size_t)l * BS * NMEM * D;
            constexpr int T_IN = 16 * (INC / 32), T_SQ = 16 * 32, T_UP = 16 * (2 * DFF / 32), T_DN = (DFF / 64) * 32, T_CV = 32 * 32;
            constexpr int T_G = 16;
            constexpr int NIT = T_IN + 5 * T_SQ + T_UP + T_DN + T_CV + 2 * T_G;
            for (int it = (NIT * part) / nparts + gw; it < (NIT * (part + 1)) / nparts; it += NGW) {
                int r = it;
                if (r < T_IN) { transpose_item(w_in, D, INC, WIN_T, scr, r, lane, INP(I_GMIX) + l * D); continue; } r -= T_IN;
                if (r < T_SQ) { transpose_item(w_out, D, D, WOUT_T, scr, r, lane); continue; } r -= T_SQ;
                if (r < T_SQ) { transpose_item(w_q, D, D, WQ_T, scr, r, lane, INP(I_GX) + l * D); continue; } r -= T_SQ;
                if (r < T_SQ) { transpose_item(w_k, D, D, WK_T, scr, r, lane); continue; } r -= T_SQ;
                if (r < T_SQ) { transpose_item(w_v, D, D, WV_T, scr, r, lane); continue; } r -= T_SQ;
                if (r < T_SQ) { transpose_item(w_o, D, D, WO_T, scr, r, lane); continue; } r -= T_SQ;
                if (r < T_UP) { transpose_item(w_up, D, 2 * DFF, WUP_T, scr, r, lane, INP(I_GFFN) + l * D, DFF); continue; } r -= T_UP;
                if (r < T_DN) { transpose_item(w_dn, DFF, D, WDN_T, scr, r, lane); continue; } r -= T_DN;
                if (r < T_CV) { transpose_item(c_v, BS * NMEM, D, VTS, scr, r, lane); continue; } r -= T_CV;
                if (r < T_G) { transpose_item(INP(I_WRG) + ((size_t)l * 8 + (r >> 1)) * 4096, 64, 64, GT_R + (r >> 1) * 4096, scr, r & 1, lane); continue; } r -= T_G;
                transpose_item(INP(I_WIG) + ((size_t)l * 8 + (r >> 1)) * 4096, 64, 64, GT_I + (r >> 1) * 4096, scr, r & 1, lane);
            }
            if (part == 0) {
                const f32x4* ck = (const f32x4*)(INP(I_CK) + (size_t)l * BS * NMEM * D); u32x2* dk = (u32x2*)KBS;
                for (int i = gt; i < BS * NMEM * D / 4; i += NGT) { const f32x4 v = ck[i]; u32x2 w; w.x = pk2(v.x, v.y); w.y = pk2(v.z, v.w); dk[i] = w; }
                if (l == 0) { const f32x4* mm = (const f32x4*)INP(I_MEM); u32x2* dm = (u32x2*)MEMB;
                    for (int i = gt; i < BP * NMEM * D / 4; i += NGT) { const f32x4 v = mm[i]; u32x2 w; w.x = pk2(v.x, v.y); w.y = pk2(v.z, v.w); dm[i] = w; } }
                const float* wsl = INP(I_WS) + (size_t)l * 4 * 128 * 128;
                for (int i = gt; i < 4 * 128 * 128; i += NGT) { const int s = i & 127, t = (i >> 7) & 127; WST[i] = (bf16_t)f2bf(s <= t ? wsl[i] : 0.f); }
            }
}

__global__ void __launch_bounds__(NTHREADS, 2) trunk_fwd(Args args) {
    extern __shared__ __attribute__((aligned(16))) unsigned char lds_raw[];
    LAS unsigned char* lds = (LAS unsigned char*)lds_raw;
    cg::grid_group grid = cg::this_grid();
    const int wave_s = __builtin_amdgcn_readfirstlane(threadIdx.x >> 6);
#define LANE_STATE() int G = gridDim.x, bid = blockIdx.x; asm volatile("" : "+s"(G), "+s"(bid)); const int NGW = G * NWAVES, NGT = G * NTHREADS; (void)NGW; (void)NGT; \
    const int tid = opaque_tid(wave_s), lane = tid & 63, wave = wave_s; const int gw = bid * NWAVES + wave; const int gt = bid * NTHREADS + tid; (void)lane; (void)gw; (void)gt; \
    kptr_t kp = (kptr_t)__builtin_amdgcn_kernarg_segment_ptr(); asm volatile("" : "+s"(kp)); \
    float* const out = *(const __attribute__((address_space(4))) fp_t*)(kp + 8 * N_IN); unsigned char* const ws = *(const __attribute__((address_space(4))) ucp_t*)(kp + 8 * N_IN + 8); (void)out; (void)ws
    {
        LANE_STATE();
        if (bid == 0) for (int i = tid; i < XCD_BAR_WORDS; i += NTHREADS) __hip_atomic_store((unsigned*)(ws + WS_BAR) + i, 0u, __ATOMIC_RELAXED, __HIP_MEMORY_SCOPE_AGENT);
        if (tid < 32) ((LAS unsigned*)(lds + LDS_MISC))[tid] = 0u;
        __threadfence();
        grid.sync();
        if (tid == 0) (void)xb_add((unsigned*)(ws + WS_BAR) + XB_XCNT(xb_xcc_id()), 1u);
    }
#define GRID_SYNC() do { kptr_t kp_ = (kptr_t)__builtin_amdgcn_kernarg_segment_ptr(); asm volatile("" : "+s"(kp_)); \
        XcdBarrier b_; b_.bar = (unsigned*)(*(const __attribute__((address_space(4))) ucp_t*)(kp_ + 8 * N_IN + 8) + WS_BAR); b_.x = xb_xcc_id(); b_.st = (volatile LAS unsigned*)(lds + LDS_MISC); \
        xcd_barrier(b_); if (PROBE == 3) xcd_barrier(b_); } while (0)

    for (int l = 0; l < DEPTH; ++l) {
        const size_t wsel = (size_t)(l & 1) * WSEL1, ksel = (size_t)(l & 1) * KSEL1;
        if (l == 0)
        for (int dup0 = 0; dup0 < ((PROBE == 1 || PROBE == 5) ? 2 : 1); ++dup0) {
        {
            LANE_STATE();
            convert_layer(kp, ws, lds, l, 0, 1, gw, NGW, gt, NGT, lane, wave);
            if (l == 0) first_rows(INP(I_XP), INP(I_XS), XN, SSQ(0), gw, NGW, lane);
        }
        GRID_SYNC();
        }
        {
            LANE_STATE();
            KVSched S; S.G = G; S.c = bid >= 160 ? bid - 160 : -1; S.ws = (const char*)ws; S.wsel = wsel;
            pg8::Gemm g{(const bf16_t*)nullptr, (const bf16_t*)nullptr, D, D, D};
            pg8::EpiKV E{out + O_MKP + (size_t)l * BP * NMEM * D, out + O_MVP + (size_t)l * BP * NMEM * D, KBP, VTP};
            pg8::gemm_phase<pg8::EpiKV, KVSched, true>(lds, g, S, E, wave_s);
        }
#define GEMM_BF16(s_) do { const int s = (s_); pg8::GSched S; pg8::Gemm g; pg8::EpiBf16 E; E.scale = 1.f; E.ss = nullptr; E.smp = 0; \
        if (s == 0) { S.init(MT / 256, INC / 256, G, bid); S.aPm = (size_t)256 * D * 2; S.bPn = (size_t)256 * D * 2; g = pg8::Gemm{XN, WIN_T, D, D, D}; E.O = gZ; E.ldc = INC; E.ss = SSQ(3 * l); } \
        else if (s == 1) { S.init(MP / 256, D / 256, G, bid); S.aPm = (size_t)256 * D * 2; S.bPn = (size_t)256 * D * 2; g = pg8::Gemm{XN, WQ_T, D, D, D}; E.O = gQ; E.ldc = D; E.scale = 0.0625f; E.ss = SSQ(3 * l + 1); } \
        else if (s == 2) { S.init(MP / 256, 4, G, bid); S.aPm = (size_t)256 * D * 2; S.aPn = 512; S.bPn = (size_t)256 * 2048 * 2; S.bPm = 512; S.bShift = 4; g = pg8::Gemm{gP, VTP, D, 2048, 256}; E.O = gO; E.ldc = D; } \
        else { S.init(1, 32, G, (bid + G - 64) % G); S.mode = 2; g = pg8::Gemm{PS, VTS, 8192, 2048, 256}; E.O = gO + (size_t)MP * D; E.ldc = D; E.smp = 1; } \
        pg8::gemm_phase<pg8::EpiBf16, pg8::GSched, true>(lds, g, S, E, wave_s); } while (0)
#define GEMM_RES(s_) do { const int s = (s_); pg8::GSched S; S.init(MP / 256, D / 256, G, bid); pg8::Gemm g; \
        if (s == 0) { g = pg8::Gemm{gY, WOUT_T, D, D, D}; S.aPm = (size_t)256 * D * 2; } \
        else if (s == 1) { g = pg8::Gemm{gO, WO_T, D, D, D}; S.aPm = (size_t)256 * D * 2; } \
        else { g = pg8::Gemm{GU, WDN_T, DFF, DFF, DFF}; S.aPm = (size_t)256 * DFF * 2; } \
        S.bPn = (size_t)256 * g.ldb * 2; \
        pg8::EpiResid E{XN, SSQ(3 * l + 1 + s)}; \
        pg8::gemm_phase<pg8::EpiResid, pg8::GSched, true>(lds, g, S, E, wave_s); } while (0)

        for (int rep = 0; rep < 13; ++rep) { if (rep == 4 || rep == 9 || rep == 11) continue;
          const int ndup = ((PROBE == 1 && (rep == 1 || rep == 2)) || (PROBE == 4 && rep == 1) || (PROBE == 6 && rep == 2)) ? 2 : ((PROBE == 2 && (rep == 0 || rep == 5 || rep == 6 || rep == 7 || rep == 10)) ? 2 : 1);
          for (int dup = 0; dup < ndup; ++dup) {
            if (rep == 0 || rep == 5 || rep == 7) {
                LANE_STATE();
                const int s0 = rep == 0 ? 0 : (rep == 5 ? 1 : 2), ns = rep == 7 ? 2 : 1;
                if (rep == 0 && l > 0) {
                    pg8::GSched S0; S0.init(MT / 256, INC / 256, G, bid); pg8::Unit u0; bool own = false;
                    for (int i = 0; S0.next(i, u0); ++i) own = own || (u0.pm == 128);
                    if (own) sample_ss_reduce(SSS(3 * l), SSQ(3 * l), tid);
                }
                for (int q = 0; q < ns; ++q) GEMM_BF16(s0 + q);
                if (rep == 5) { LANE_STATE(); const SG2 sg{XN + (size_t)MP * D, WQ_T, D, D, D, D, gQ + (size_t)MP * D, D, 0.0625f, 1, nullptr}; sgemm2(lds, sg, bid, G, wave, tid); }
                if (rep == 5 && l + 1 < DEPTH) { LANE_STATE(); if (bid >= 4) convert_layer(kp, ws, lds, l + 1, 1, 3, gw - 4 * NWAVES, NGW - 4 * NWAVES, gt - 4 * NTHREADS, NGT - 4 * NTHREADS, lane, wave); }
            } else if (rep == 10) {
                LANE_STATE();
                pg8::GSched S; S.init(MT / 256, 2 * DFF / 256, G, bid); S.aPm = (size_t)256 * D * 2; S.bPn = (size_t)256 * D * 2;
                { pg8::Unit u0; bool own = false; for (int i = 0; S.next(i, u0); ++i) own = own || (u0.pm == 128); if (own) sample_ss_reduce(SSS(3 * l + 2), SSQ(3 * l + 2), tid); }
                const pg8::Gemm g{XN, WUP_T, D, D, D};
                const pg8::EpiAct E{GU, INP(I_SCF) + (size_t)l * BS * 2 * DFF, out + O_CFS + (size_t)l * BS * 2 * DFF, SBG, SBU, SBL, INP(I_CFW) + (size_t)l * 3 * DFF, SSQ(3 * l + 2)};
                pg8::gemm_phase<pg8::EpiAct, pg8::GSched, true>(lds, g, S, E, wave_s);
            } else if (rep == 1) {
                LANE_STATE();
                {
                    LAS bf16_t* vT = (LAS bf16_t*)lds;
                    constexpr int VP = 136;
                    const float* gvp = INP(I_GV) + l * CW; const float* bsp = INP(I_BSS) + l * 4 * 128;
                    for (int un = (bid + G / 2) % G; un < 8 + 256; un += G) {
                        int rowbase, nrows, sb = -1;
                        if (un < 8) { sb = un; rowbase = MP + un * TS; nrows = TS; } else { rowbase = (un - 8) * 128; nrows = 128; }
                        {
                            const int rl = tid >> 5, cgp = tid & 31;
                            f32x4 g0 = *(const f32x4*)(gvp + cgp * 8), g1 = *(const f32x4*)(gvp + cgp * 8 + 4);
                            for (int p = 0; p < nrows / 16; ++p) {
                                const int r = p * 16 + rl;
                                const u32x4 raw = *(const u32x4*)(gZ + (size_t)(rowbase + r) * INC + Z_VC + cgp * 8);
                                float v[8] = {bflo(raw.x), bfhi(raw.x), bflo(raw.y), bfhi(raw.y), bflo(raw.z), bfhi(raw.z), bflo(raw.w), bfhi(raw.w)};
                                float ss = 0.f;
#pragma unroll
                                for (int k = 0; k < 8; ++k) { v[k] = gelu_t(v[k]); ss += v[k] * v[k]; }
                                ss += shx(ss, 1, lane); ss += shx(ss, 2, lane); ss += shx(ss, 4, lane);
                                const float rstd = 1.0f / sqrtf(ss * (1.f / 64.f) + EPS);
                                const float gg[8] = {g0.x, g0.y, g0.z, g0.w, g1.x, g1.y, g1.z, g1.w};
#pragma unroll
                                for (int k = 0; k < 8; ++k) { v[k] = v[k] * rstd * gg[k]; vT[(cgp * 8 + k) * VP + r] = (bf16_t)f2bf(v[k]); }
                                if (sb >= 0) { float* vo = out + O_VCS + ((size_t)(l * BS + sb) * TS + r) * CW + cgp * 8;
                                    *(f32x4*)vo = (f32x4){v[0], v[1], v[2], v[3]}; *(f32x4*)(vo + 4) = (f32x4){v[4], v[5], v[6], v[7]}; }
                            }
                        }
                        __syncthreads();
                        {
                            const int hh = wave & 3, rh = wave >> 2, fr = lane & 15, fq = lane >> 4;
                            const int nmt = nrows == 128 ? 4 : (rh == 0 ? 2 : 0);
                            for (int mi = 0; mi < nmt; ++mi) {
                                const int mt = rh * 4 + mi, nks = (mt * 16 + 15) / 32 + 1;
                                f32x4 acc[4];
#pragma unroll
                                for (int n = 0; n < 4; ++n) acc[n] = (f32x4){0.f, 0.f, 0.f, 0.f};
                                for (int ks = 0; ks < nks; ++ks) {
                                    const bf16x8 a = *(const bf16x8*)(WST + ((size_t)(hh * 128 + mt * 16 + fr) * 128 + ks * 32 + fq * 8));
#pragma unroll
                                    for (int n = 0; n < 4; ++n) { const bf16x8 b = *(const LAS bf16x8*)(vT + (hh * 64 + n * 16 + fr) * VP + ks * 32 + fq * 8);
                                        acc[n] = __builtin_amdgcn_mfma_f32_16x16x32_bf16(b, a, acc[n], 0, 0, 0); }
                                }
                                { const int t = mt * 16 + fr; const float bias = bsp[hh * 128 + t]; const size_t row = (size_t)(rowbase + t);
#pragma unroll
                                    for (int n = 0; n < 4; ++n) { const int c = hh * 64 + n * 16 + fq * 4; const u32x2 uq = *(const u32x2*)(gZ + row * INC + Z_UC + c);
                                        u32x2 w; w.x = pk2(gelu_t(bflo(uq.x)) * (acc[n][0] + bias), gelu_t(bfhi(uq.x)) * (acc[n][1] + bias)); w.y = pk2(gelu_t(bflo(uq.y)) * (acc[n][2] + bias), gelu_t(bfhi(uq.y)) * (acc[n][3] + bias));
                                        *(u32x2*)(gY + row * D + 768 + c) = w; } }
                            }
                        }
                        __syncthreads();
                    }
                }
                {
                    LAS unsigned char* wl = lds + wave * 16384;
                    LAS bf16_t* tile = (LAS bf16_t*)wl;
                    LAS float* pre_r = (LAS float*)(wl + 2560);
                    LAS float* pre_i = (LAS float*)(wl + 2560 + 4096);
                    LAS float* xcf = (LAS float*)(wl + 2560 + 8192);
                    const int fr = lane & 15, fq = lane >> 4;
                    for (int un = gw; un < 64 + 2048; un += NGW) {
                        int b, hd, rowbase, nrows, t0; bool smp = un < 64;
                        if (smp) { b = un >> 3; hd = un & 7; rowbase = MP + b * TS; nrows = TS; t0 = 0; }
                        else { const int v = un - 64; const int ch = v & 31; hd = (v >> 5) & 7; b = v >> 8; t0 = ch * 128; rowbase = b * SEQ + t0; nrows = 128; }
                        const int cidx = l * AW + hd * 64 + lane;
                        const float br = INP(I_BRG)[cidx], bi = INP(I_BIG)[cidx];
                        const float c8sp = 8.0f * log1pf(__expf(-INP(I_LAM)[cidx]));
                        const float* caw = INP(I_CAW) + (size_t)l * 4 * AW + hd * 64 + lane;
                        const float cw0 = caw[0], cw1 = caw[AW], cw2 = caw[2 * AW], cw3 = caw[3 * AW], cb = INP(I_CAB)[cidx];
                        bf16x8 bR[4][2], bI[4][2];
#pragma unroll
                        for (int n = 0; n < 4; ++n)
#pragma unroll
                            for (int ks = 0; ks < 2; ++ks) { const size_t o_ = (size_t)(hd * 64 + n * 16 + fr) * 64 + ks * 32 + fq * 8;
                                bR[n][ks] = *(const bf16x8*)(GT_R + o_); bI[n][ks] = *(const bf16x8*)(GT_I + o_); }
                        float xm3 = 0.f, xm2 = 0.f, xm1 = 0.f;
                        if (smp) { const float* st = INP(I_SCA) + ((size_t)(l * BS + b) * 3) * AW + hd * 64 + lane; xm3 = st[0]; xm2 = st[AW]; xm1 = st[2 * AW]; }
                        else if (t0 > 0) { const bf16_t* zp = gZ + (size_t)(rowbase - 3) * INC + Z_XA + hd * 64 + lane; xm3 = bf2f(zp[0]); xm2 = bf2f(zp[INC]); xm1 = bf2f(zp[2 * INC]); }
                        float h = 0.f, pc = 1.f;
                        const bf16_t* zq = gZ + (size_t)(rowbase + (lane >> 3)) * INC + Z_XA + hd * 64 + (lane & 7) * 8;
                        float* hp = HLOC + (size_t)rowbase * AW + hd * 64 + lane; float* pp = PCUM + (size_t)rowbase * AW + hd * 64 + lane;
                        LAS bf16_t* xraw = (LAS bf16_t*)pre_r;
                        u32x4 xn0 = *(const u32x4*)zq, xn1 = *(const u32x4*)(zq + (size_t)8 * INC);
                        for (int st = 0; st < nrows / 16; ++st) {
                            *(LAS u32x4*)(xraw + (lane >> 3) * 64 + (lane & 7) * 8) = xn0; *(LAS u32x4*)(xraw + ((lane >> 3) + 8) * 64 + (lane & 7) * 8) = xn1;
                            zq += (size_t)16 * INC;
                            if (st + 1 < nrows / 16) { xn0 = *(const u32x4*)zq; xn1 = *(const u32x4*)(zq + (size_t)8 * INC); }
                            LDS_WAIT();
#pragma unroll
                            for (int i = 0; i < 16; ++i) { const float xv = bf2f(xraw[i * 64 + lane]);
                                const float xc = cw0 * xm3 + cw1 * xm2 + cw2 * xm1 + cw3 * xv + cb; xm3 = xm2; xm2 = xm1; xm1 = xv; xcf[i * 64 + lane] = xc; tile[i * 72 + lane] = (bf16_t)f2bf(xc); }
                            LDS_WAIT();
                            const bf16x8 a0 = *(const LAS bf16x8*)(tile + fr * 72 + fq * 8), a1 = *(const LAS bf16x8*)(tile + fr * 72 + 32 + fq * 8);
#pragma unroll
                            for (int n = 0; n < 4; ++n) {
                                f32x4 ar = (f32x4){0.f, 0.f, 0.f, 0.f}, ai = (f32x4){0.f, 0.f, 0.f, 0.f};
                                ar = __builtin_amdgcn_mfma_f32_16x16x32_bf16(a0, bR[n][0], ar, 0, 0, 0); ar = __builtin_amdgcn_mfma_f32_16x16x32_bf16(a1, bR[n][1], ar, 0, 0, 0);
                                ai = __builtin_amdgcn_mfma_f32_16x16x32_bf16(a0, bI[n][0], ai, 0, 0, 0); ai = __builtin_amdgcn_mfma_f32_16x16x32_bf16(a1, bI[n][1], ai, 0, 0, 0);
#pragma unroll
                                for (int j = 0; j < 4; ++j) { pre_r[(fq * 4 + j) * 64 + n * 16 + fr] = ar[j]; pre_i[(fq * 4 + j) * 64 + n * 16 + fr] = ai[j]; }
                            }
                            LDS_WAIT();
#pragma unroll 4
                            for (int i = 0; i < 16; ++i) {
                                const float r = sigm(pre_r[i * 64 + lane] + br), gi = sigm(pre_i[i * 64 + lane] + bi);
                                const float la = -c8sp * r; float a, om;
                                if (la > -0.125f) { const float x = 2.0f * la; om = -x * (1.0f + x * (0.5f + x * (0.16666667f + x * (0.041666668f + x * (0.0083333338f + x * 0.0013888889f))))); a = 1.0f + la * (1.0f + la * (0.5f + la * (0.16666667f + la * (0.041666668f + la * 0.0083333338f)))); }
                                else { a = __expf(la); om = -expm1f(2.0f * la); }
                                const float bm = sqrtf(om);
                                h = a * h + bm * gi * xcf[i * 64 + lane]; pc = pc * a;
                                *hp = h; *pp = pc; hp += AW; pp += AW;
                            }
                            LDS_WAIT();
                        }
                        AGG[(size_t)un * 128 + lane] = pc; AGG[(size_t)un * 128 + 64 + lane] = h;
                    }
                }
                {
                    const float* cbw = INP(I_CBW) + (size_t)l * 3 * BW;
                    for (int it = gt; it < (MT / 8) * 32; it += NGT) {
                        const int rb = it >> 5, c0 = (it & 31) * 8;
                        int b, t0, T, rowbase; const bool smp = rb >= MP / 8;
                        if (!smp) { b = rb >> 9; t0 = (rb & 511) * 8; T = SEQ; rowbase = rb * 8; } else { const int sbk = rb - MP / 8; b = sbk >> 2; t0 = (sbk & 3) * 8; T = TS; rowbase = MP + sbk * 8; }
                        u32x4 xq[10], cq[10], bq[8];
                        const bf16_t* zr = gZ + (size_t)rowbase * INC + c0;
#pragma unroll
                        for (int i = 0; i < 10; ++i) { if (i >= 2 || t0 > 0) { xq[i] = *(const u32x4*)(zr + (ptrdiff_t)(i - 2) * INC + Z_XB); cq[i] = *(const u32x4*)(zr + (ptrdiff_t)(i - 2) * INC + Z_GC); } else { xq[i] = (u32x4){0u, 0u, 0u, 0u}; cq[i] = (u32x4){0u, 0u, 0u, 0u}; } }
#pragma unroll
                        for (int i = 0; i < 8; ++i) bq[i] = *(const u32x4*)(zr + (size_t)i * INC + Z_GB);
                        float w0[8], w1[8], w2[8], pm2[8], pm1[8];
#pragma unroll
                        for (int k = 0; k < 8; ++k) { w0[k] = cbw[c0 + k]; w1[k] = cbw[BW + c0 + k]; w2[k] = cbw[2 * BW + c0 + k]; }
                        {
                            const float a_[8] = {bflo(xq[0].x) * bflo(cq[0].x), bfhi(xq[0].x) * bfhi(cq[0].x), bflo(xq[0].y) * bflo(cq[0].y), bfhi(xq[0].y) * bfhi(cq[0].y), bflo(xq[0].z) * bflo(cq[0].z), bfhi(xq[0].z) * bfhi(cq[0].z), bflo(xq[0].w) * bflo(cq[0].w), bfhi(xq[0].w) * bfhi(cq[0].w)};
                            const float b_[8] = {bflo(xq[1].x) * bflo(cq[1].x), bfhi(xq[1].x) * bfhi(cq[1].x), bflo(xq[1].y) * bflo(cq[1].y), bfhi(xq[1].y) * bfhi(cq[1].y), bflo(xq[1].z) * bflo(cq[1].z), bfhi(xq[1].z) * bfhi(cq[1].z), bflo(xq[1].w) * bflo(cq[1].w), bfhi(xq[1].w) * bfhi(cq[1].w)};
#pragma unroll
                            for (int k = 0; k < 8; ++k) { pm2[k] = a_[k]; pm1[k] = b_[k]; }
                        }
                        if (t0 == 0 && smp) { const float* st = INP(I_SCB) + ((size_t)(l * BS + b) * 2) * BW + c0;
#pragma unroll
                            for (int k = 0; k < 8; ++k) { pm2[k] = st[k]; pm1[k] = st[BW + k]; } }
#pragma unroll
                        for (int i = 0; i < 8; ++i) {
                            const u32x4 xb = xq[i + 2], gc = cq[i + 2], gb = bq[i];
                            const float pv[8] = {bflo(xb.x) * bflo(gc.x), bfhi(xb.x) * bfhi(gc.x), bflo(xb.y) * bflo(gc.y), bfhi(xb.y) * bfhi(gc.y), bflo(xb.z) * bflo(gc.z), bfhi(xb.z) * bfhi(gc.z), bflo(xb.w) * bflo(gc.w), bfhi(xb.w) * bfhi(gc.w)};
                            const float gbv[8] = {bflo(gb.x), bfhi(gb.x), bflo(gb.y), bfhi(gb.y), bflo(gb.z), bfhi(gb.z), bflo(gb.w), bfhi(gb.w)};
                            float yv[8];
#pragma unroll
                            for (int k = 0; k < 8; ++k) { yv[k] = gbv[k] * (w0[k] * pm2[k] + w1[k] * pm1[k] + w2[k] * pv[k]); pm2[k] = pm1[k]; pm1[k] = pv[k]; }
                            u32x4 w; w.x = pk2(yv[0], yv[1]); w.y = pk2(yv[2], yv[3]); w.z = pk2(yv[4], yv[5]); w.w = pk2(yv[6], yv[7]);
                            *(u32x4*)(gY + (size_t)(rowbase + i) * D + 512 + c0) = w;
                        }
                        if (t0 + 8 == T) { float* o = out + (smp ? O_CBS : O_CBP) + ((size_t)(l * 8 + b) * 2) * BW + c0;
#pragma unroll
                            for (int k = 0; k < 8; ++k) { o[k] = pm2[k]; o[BW + k] = pm1[k]; } }
                    }
                }
            } else if (rep == 2) {
                LANE_STATE();
                {
                    LAS float* cr = (LAS float*)lds;
                    for (int un = bid; un < 8 + 256; un += G) {
                        int b, ch, rowbase, nrows; const bool smp = un < 8;
                        if (smp) { b = un; ch = 0; rowbase = MP + b * TS; nrows = TS; } else { const int v = un - 8; b = v >> 5; ch = v & 31; rowbase = b * SEQ + ch * 128; nrows = 128; }
                        {
                            const int c = tid, hd = c >> 6, ln = c & 63; float carry = 0.f;
                            if (smp) carry = INP(I_SHA)[(size_t)(l * BS + b) * AW + c];
                            else { const float* ag = AGG + (size_t)(64 + (b << 8) + (hd << 5)) * 128 + ln; for (int k = 0; k < ch; ++k) carry = ag[(size_t)k * 128] * carry + ag[(size_t)k * 128 + 64]; }
                            cr[c] = carry;
                        }
                        __syncthreads();
                        const int c0 = (tid & 63) * 8, rsub = tid >> 6;
                        const f32x4 ca = *(const LAS f32x4*)(cr + c0), cb = *(const LAS f32x4*)(cr + c0 + 4);
                        for (int p = 0; p < nrows / 8; ++p) {
                            const int rloc = p * 8 + rsub; const size_t row = (size_t)(rowbase + rloc);
                            const f32x4 h0 = *(const f32x4*)(HLOC + row * AW + c0), h1 = *(const f32x4*)(HLOC + row * AW + c0 + 4), p0 = *(const f32x4*)(PCUM + row * AW + c0), p1 = *(const f32x4*)(PCUM + row * AW + c0 + 4);
                            const u32x4 gq = *(const u32x4*)(gZ + row * INC + Z_GA + c0);
                            const f32x4 a0 = h0 + p0 * ca, a1 = h1 + p1 * cb;
                            u32x4 w; w.x = pk2(gelu_t(bflo(gq.x)) * a0[0], gelu_t(bfhi(gq.x)) * a0[1]); w.y = pk2(gelu_t(bflo(gq.y)) * a0[2], gelu_t(bfhi(gq.y)) * a0[3]);
                            w.z = pk2(gelu_t(bflo(gq.z)) * a1[0], gelu_t(bfhi(gq.z)) * a1[1]); w.w = pk2(gelu_t(bflo(gq.w)) * a1[2], gelu_t(bfhi(gq.w)) * a1[3]);
                            *(u32x4*)(gY + row * D + c0) = w;
                            if ((smp || ch == 31) && rloc == nrows - 1) { float* o = out + (smp ? O_HAS : O_HAP) + (size_t)(l * 8 + b) * AW + c0; *(f32x4*)o = a0; *(f32x4*)(o + 4) = a1; }
                        }
                        if ((smp || ch == 31) && tid < 192) {
                            const int k = tid >> 6; const u32x4 xq = *(const u32x4*)(gZ + (size_t)(rowbase + nrows - 3 + k) * INC + Z_XA + c0);
                            float* o = out + (smp ? O_CAS : O_CAP) + ((size_t)(l * 8 + b) * 3 + k) * AW + c0;
                            *(f32x4*)o = (f32x4){bflo(xq.x), bfhi(xq.x), bflo(xq.y), bfhi(xq.y)}; *(f32x4*)(o + 4) = (f32x4){bflo(xq.z), bfhi(xq.z), bflo(xq.w), bfhi(xq.w)};
                        }
                        __syncthreads();
                    }
                }
            } else if (rep == 3 || rep == 8 || rep == 12) {
                LANE_STATE();
                if (rep == 12) {
                    const float* cfw = INP(I_CFW) + (size_t)l * 3 * DFF;
                    pg8::GSched S0; S0.init(MP / 256, D / 256, G, bid); pg8::Unit u0;
                    for (int i = 0; S0.next(i, u0); ++i) {
                        const int pm = u0.pm; if (pm >= 128 || tid >= DFF / 8) continue;
                        const int c0 = tid * 8, b = pm >> 4;
                        float w0[8], w1[8], w2[8], p2[8], p1[8], g0[8], g1[8], u0_[8], u1_[8];
#pragma unroll
                        for (int k = 0; k < 8; ++k) { w0[k] = cfw[c0 + k]; w1[k] = cfw[DFF + c0 + k]; w2[k] = cfw[2 * DFF + c0 + k]; p2[k] = 0.f; p1[k] = 0.f; }
                        if ((pm & 15) != 0) {
#pragma unroll
                            for (int k = 0; k < 8; ++k) { p2[k] = SBL[((size_t)(pm - 1) * 2 + 0) * DFF + c0 + k]; p1[k] = SBL[((size_t)(pm - 1) * 2 + 1) * DFF + c0 + k]; } }
#pragma unroll
                        for (int k = 0; k < 8; ++k) { g0[k] = SBG[((size_t)pm * 2 + 0) * DFF + c0 + k]; g1[k] = SBG[((size_t)pm * 2 + 1) * DFF + c0 + k]; u0_[k] = SBU[((size_t)pm * 2 + 0) * DFF + c0 + k]; u1_[k] = SBU[((size_t)pm * 2 + 1) * DFF + c0 + k]; }
                        float ha[8], hb[8];
#pragma unroll
                        for (int k = 0; k < 8; ++k) { ha[k] = silu(w0[k] * p2[k] + w1[k] * p1[k] + w2[k] * g0[k]) * u0_[k]; hb[k] = silu(w0[k] * p1[k] + w1[k] * g0[k] + w2[k] * g1[k]) * u1_[k]; }
                        u32x4 w; w.x = pk2(ha[0], ha[1]); w.y = pk2(ha[2], ha[3]); w.z = pk2(ha[4], ha[5]); w.w = pk2(ha[6], ha[7]);
                        *(u32x4*)(GU + (size_t)(pm * 256) * DFF + c0) = w;
                        w.x = pk2(hb[0], hb[1]); w.y = pk2(hb[2], hb[3]); w.z = pk2(hb[4], hb[5]); w.w = pk2(hb[6], hb[7]);
                        *(u32x4*)(GU + (size_t)(pm * 256 + 1) * DFF + c0) = w;
                        if ((pm & 15) == 15 && u0.pn == 0) { float* o = out + O_CFP + ((size_t)(l * 8 + b) * 2) * DFF + c0;
#pragma unroll
                            for (int k = 0; k < 8; ++k) { o[k] = SBL[((size_t)pm * 2 + 0) * DFF + c0 + k]; o[DFF + k] = SBL[((size_t)pm * 2 + 1) * DFF + c0 + k]; } }
                    }
                    asm volatile("s_waitcnt vmcnt(0)" ::: "memory"); __syncthreads();
                }
                GEMM_RES(rep == 3 ? 0 : (rep == 8 ? 1 : 2));
                { LANE_STATE();
                  const SG2 sg{rep == 12 ? GU + (size_t)MP * DFF : (rep == 3 ? gY : gO) + (size_t)MP * D, rep == 12 ? WDN_T : (rep == 3 ? WOUT_T : WO_T), rep == 12 ? DFF : D, rep == 12 ? DFF : D, rep == 12 ? DFF : D, D, XN + (size_t)MP * D, D, 1.f, 2, SSS(3 * l + (rep == 3 ? 1 : (rep == 8 ? 2 : 3)))};
                  sgemm2(lds, sg, bid, G, wave, tid); }
                if (rep != 12 && l + 1 < DEPTH) { LANE_STATE(); if (bid >= 4) convert_layer(kp, ws, lds, l + 1, rep == 3 ? 0 : 2, 3, gw - 4 * NWAVES, NGW - 4 * NWAVES, gt - 4 * NTHREADS, NGT - 4 * NTHREADS, lane, wave); }
            } else if (rep == 6) {
                LANE_STATE();
                for (int sub = 0; sub < 2; ++sub) {
                    pg8::GSched S; pg8::Gemm g; pg8::EpiSoftmax E;
                    if (sub == 0) { S.init(MP / 256, 4, G, bid); S.aPm = (size_t)256 * D * 2; S.aPn = 512; S.bPn = 512; S.bPm = (size_t)256 * D * 2; S.bShift = 4; g = pg8::Gemm{gQ, KBP, D, D, 256}; E.O = gP; E.ldc = D; E.smp = 0; }
                    else { S.init(1, 32, G, (bid + G - 64) % G); S.mode = 1; g = pg8::Gemm{gQ + (size_t)MP * D, KBS, D, D, 256}; E.O = PS; E.ldc = 8192; E.smp = 1; }
                    pg8::gemm_phase<pg8::EpiSoftmax, pg8::GSched, true>(lds, g, S, E, wave_s);
                }
            }
            GRID_SYNC();
          }
        }
    }
    {
        LANE_STATE();
        const float* gain = INP(I_GFIN);
        f32x4 gv[4];
#pragma unroll
        for (int j = 0; j < 4; ++j) gv[j] = ((const f32x4*)gain)[lane + 64 * j];
        for (int m0 = gw; m0 < MT; m0 += 2 * NGW) {
            const int m1 = m0 + NGW; const bool two = m1 < MT; const int mb = two ? m1 : m0;
            const u32x2* xa = (const u32x2*)(XN + (size_t)m0 * D) + lane; const u32x2* xb = (const u32x2*)(XN + (size_t)mb * D) + lane;
            u32x2 pa[4], pb[4];
#pragma unroll
            for (int j = 0; j < 4; ++j) { pa[j] = xa[64 * j]; pb[j] = xb[64 * j]; }
            float ra, rb;
            { float qa = 0.f, qb = 0.f;
#pragma unroll
              for (int j = 0; j < 4; ++j) { const float a0 = bflo(pa[j].x), a1 = bfhi(pa[j].x), a2 = bflo(pa[j].y), a3 = bfhi(pa[j].y), b0 = bflo(pb[j].x), b1 = bfhi(pb[j].x), b2 = bflo(pb[j].y), b3 = bfhi(pb[j].y);
                  qa += (a0 * a0 + a1 * a1) + (a2 * a2 + a3 * a3); qb += (b0 * b0 + b1 * b1) + (b2 * b2 + b3 * b3); }
              if (m0 < MP) ra = ss_rstd(*(const f32x4*)(SSQ(6) + (size_t)m0 * 4)); else ra = 1.0f / sqrtf(wave_sum(qa, lane) * (1.f / D) + EPS);
              if (mb < MP) rb = ss_rstd(*(const f32x4*)(SSQ(6) + (size_t)mb * 4)); else rb = 1.0f / sqrtf(wave_sum(qb, lane) * (1.f / D) + EPS); }
            f32x4* ya = (f32x4*)(out + (size_t)m0 * D) + lane; f32x4* yb = (f32x4*)(out + (size_t)mb * D) + lane;
#pragma unroll
            for (int j = 0; j < 4; ++j) { ya[64 * j] = (f32x4){bflo(pa[j].x), bfhi(pa[j].x), bflo(pa[j].y), bfhi(pa[j].y)} * ra * gv[j]; if (two) yb[64 * j] = (f32x4){bflo(pb[j].x), bfhi(pb[j].x), bflo(pb[j].y), bfhi(pb[j].y)} * rb * gv[j]; }
        }
    }
}

extern "C" void kernel_launch(void* const* d_in, const int* in_sizes, int n_in, void* d_out, int out_size, void* d_ws, size_t ws_size, hipStream_t stream) {
    static int grid = 0;
    if (grid == 0) {
        if (n_in != N_IN || (size_t)out_size != O_END || ws_size < WS_END) { fprintf(stderr, "kernel_launch: unexpected sizes n_in %d out %d ws %zu (need %zu)\n", n_in, out_size, ws_size, (size_t)WS_END); grid = -1; return; }
        int dev = 0, cus = 0, per_cu = 0;
        (void)hipGetDevice(&dev); (void)hipDeviceGetAttribute(&cus, hipDeviceAttributeMultiprocessorCount, dev);
        if (hipFuncSetAttribute((const void*)trunk_fwd, hipFuncAttributeMaxDynamicSharedMemorySize, LDS_BYTES) != hipSuccess) { fprintf(stderr, "kernel_launch: hipFuncSetAttribute failed\n"); grid = -1; return; }
        if (hipOccupancyMaxActiveBlocksPerMultiprocessor(&per_cu, (const void*)trunk_fwd, NTHREADS, LDS_BYTES) != hipSuccess || per_cu < 1) { fprintf(stderr, "kernel_launch: occupancy query gave %d\n", per_cu); per_cu = 1; }
        (void)hipGetLastError();
        grid = cus * 1;
        if (grid != 256) fprintf(stderr, "kernel_launch: note: %d CUs\n", grid);
    }
    if (grid < 0) return;
    Args a{};
    for (int i = 0; i < N_IN; ++i) a.in[i] = (const float*)d_in[i];
    a.out = (float*)d_out; a.ws = (unsigned char*)d_ws;
    void* kargs[] = {&a};
    hipError_t e = hipLaunchCooperativeKernel((const void*)trunk_fwd, dim3(grid), dim3(NTHREADS), kargs, LDS_BYTES, stream);
    if (e != hipSuccess) fprintf(stderr, "kernel_launch: cooperative launch failed: %s (grid %d)\n", hipGetErrorString(e), grid);
}
```

```cpp
#include <hip/hip_runtime.h>
#include <hip/hip_cooperative_groups.h>
#include <cstdio>
#include <cstdint>
namespace cg = cooperative_groups;
#ifndef PROBE
#define PROBE 0
#endif

#define LAS __attribute__((address_space(3)))
typedef unsigned short bf16_t;
typedef short bf16x8 __attribute__((ext_vector_type(8)));
typedef float f32x4 __attribute__((ext_vector_type(4)));
typedef float f32x2 __attribute__((ext_vector_type(2)));
typedef unsigned u32x4 __attribute__((ext_vector_type(4)));
typedef unsigned u32x2 __attribute__((ext_vector_type(2)));

constexpr int D = 1024, BP = 8, SEQ = 4096, BS = 8, TS = 32, DEPTH = 2;
constexpr int MP = BP * SEQ, MS = BS * TS, MT = MP + MS;
constexpr int INC = 2304, DFF = 2816, NMEM = 256, AW = 512, BW = 256, CW = 256;
constexpr int Z_XA = 0, Z_GA = 512, Z_XB = 1024, Z_GB = 1280, Z_GC = 1536, Z_UC = 1792, Z_VC = 2048;
constexpr float EPS = 1e-6f;
constexpr int NWAVES = 8, NTHREADS = 512;

constexpr size_t O_YP = 0, O_YS = O_YP + (size_t)MP * D, O_CAP = O_YS + (size_t)MS * D, O_HAP = O_CAP + DEPTH * BP * 3 * AW,
                 O_CBP = O_HAP + DEPTH * BP * AW, O_CFP = O_CBP + DEPTH * BP * 2 * BW, O_MKP = O_CFP + DEPTH * BP * 2 * DFF,
                 O_MVP = O_MKP + (size_t)DEPTH * BP * NMEM * D, O_CAS = O_MVP + (size_t)DEPTH * BP * NMEM * D, O_HAS = O_CAS + DEPTH * BS * 3 * AW,
                 O_CBS = O_HAS + DEPTH * BS * AW, O_CFS = O_CBS + DEPTH * BS * 2 * BW, O_VCS = O_CFS + DEPTH * BS * 2 * DFF,
                 O_END = O_VCS + DEPTH * BS * TS * CW;

constexpr size_t MiB = 1u << 20;
constexpr size_t WS_WIN = 0, WS_WOUT = 5 * MiB, WS_WQ = 7 * MiB, WS_WK = 9 * MiB, WS_WV = 11 * MiB, WS_WO = 13 * MiB, WS_WUP = 15 * MiB, WS_WDN = 26 * MiB;
constexpr size_t WS_MEMB = 32 * MiB, WS_KBP = 36 * MiB, WS_VTP = 40 * MiB, WS_KBS = 44 * MiB, WS_VTS = 48 * MiB, WS_WST = 52 * MiB, WS_GT = WS_WST + 131072, WS_AGG = 53 * MiB, WS_SS = 54 * MiB + 256 * 1024, WS_BAR = 55 * MiB + 512 * 1024;
constexpr size_t WS_XN = 56 * MiB, WS_BIG = 121 * MiB;
constexpr size_t B_Z = WS_BIG, B_HLOC = WS_BIG + 146 * MiB, B_PCUM = WS_BIG + 211 * MiB, B_Y = WS_BIG + 276 * MiB;
constexpr size_t B_Q = WS_BIG, B_P = WS_BIG + 65 * MiB, B_O = WS_BIG + 130 * MiB, B_PS = WS_BIG + 195 * MiB;
constexpr size_t B_GU = WS_BIG;
constexpr size_t B_GUS = WS_BIG + 200 * MiB;
constexpr size_t B_SBG = WS_BIG + 204 * MiB, B_SBU = WS_BIG + 207 * MiB, B_SBL = WS_BIG + 210 * MiB;
constexpr size_t WS_END = WS_BIG + (size_t)MT * 2 * DFF * 2;
constexpr size_t WS_SSP = 476 * MiB;
static_assert(WS_END <= WS_SSP && WS_SSP + (size_t)7 * MT * 64 <= 512 * MiB, "workspace");
static_assert(WS_XN + (size_t)MT * D * 2 <= WS_BIG, "xn");
constexpr size_t WS_SSS = WS_SSP + (((size_t)7 * MT * 16 + 4095) / 4096) * 4096;
static_assert(WS_SSS + 7 * 256 * 32 * 4 <= 480 * MiB, "sss");
constexpr size_t WSEL1 = 480 * MiB, KSEL1 = 418 * MiB;
static_assert(WS_WDN + (size_t)D * DFF * 2 + WSEL1 <= 512 * MiB && WS_KBS + KSEL1 >= WS_BIG + 341 * MiB && WS_GT + 131072 + KSEL1 <= WS_SSP, "second buffer set");

constexpr int LDS_RING = 131072, LDS_EX = LDS_RING, LDS_MISC = LDS_EX + 8192, LDS_BYTES = 147456;

enum { I_XP = 0, I_XS, I_MEM, I_CK, I_CV, I_SCA, I_SHA, I_SCB, I_SCF, I_GMIX, I_WIN, I_CAW, I_CAB, I_WRG, I_BRG, I_WIG, I_BIG, I_LAM, I_CBW, I_GV, I_WS, I_BSS,
       I_WOUT, I_GX, I_WQ, I_WK, I_WV, I_WO, I_GFFN, I_WUP, I_CFW, I_WDN, I_GFIN, N_IN };

struct Args { const float* in[N_IN]; float* out; unsigned char* ws; };

__device__ __forceinline__ unsigned pk2(float lo, float hi) { unsigned r; asm("v_cvt_pk_bf16_f32 %0, %1, %2" : "=v"(r) : "v"(lo), "v"(hi)); return r; }
__device__ __forceinline__ unsigned f2bf(float f) { return pk2(f, f) & 0xffffu; }
__device__ __forceinline__ float bf2f(unsigned v) { return __builtin_bit_cast(float, v << 16); }
__device__ __forceinline__ float bflo(unsigned w) { return __builtin_bit_cast(float, w << 16); }
__device__ __forceinline__ float bfhi(unsigned w) { return __builtin_bit_cast(float, w & 0xffff0000u); }
__device__ __forceinline__ unsigned cvt_pk_bf16(float lo, float hi) { unsigned r; asm volatile("v_cvt_pk_bf16_f32 %0, %1, %2" : "=v"(r) : "v"(lo), "v"(hi)); return r; }
__device__ __forceinline__ float fexp(float x) { return __builtin_amdgcn_exp2f(x * 1.4426950408889634f); }
__device__ __forceinline__ float sigm(float x) { return __builtin_amdgcn_rcpf(1.0f + fexp(-x)); }
__device__ __forceinline__ float gelu_t(float x) { const float u = 0.7978845608028654f * (x + 0.044715f * x * x * x); return x * sigm(2.0f * u); }
__device__ __forceinline__ float silu(float x) { return x * sigm(x); }
__device__ __forceinline__ float shx(float v, int m, int lane) { return __builtin_bit_cast(float, __builtin_amdgcn_ds_bpermute((lane ^ m) << 2, __builtin_bit_cast(int, v))); }
__device__ __forceinline__ float wave_sum(float v, int lane) {
#pragma unroll
    for (int o = 1; o < 64; o <<= 1) v += shx(v, o, lane);
    return v;
}
#define LDS_WAIT() asm volatile("s_waitcnt lgkmcnt(0)" ::: "memory")
__device__ __forceinline__ float ss_rstd(f32x4 p) { return 1.0f / sqrtf(((p[0] + p[1]) + (p[2] + p[3])) * (1.f / 1024.f) + 1e-6f); }
__device__ __forceinline__ int opaque_tid(int wave_s) { int l; asm volatile("v_mbcnt_lo_u32_b32 %0, -1, 0\n\tv_mbcnt_hi_u32_b32 %0, -1, %0" : "=v"(l)); return wave_s * 64 + l; }

namespace pg8 {
constexpr int BM = 256, BK = 64, HALF = 128, HTB = HALF * BK * 2, NXCD = 8, WGM = 8;
__device__ __forceinline__ int lds_byte(int r, int c) { const int st = (r >> 4) * 2 + (c >> 5), rr = r & 15, cc = c & 31, ob = rr * 64 + cc * 2; return st * 1024 + (ob ^ (((ob >> 9) & 1) << 5)); }
__device__ __forceinline__ void stage_rc(int b, int& R, int& C) { const int st = b / 1024, sb = b % 1024, swz = sb ^ (((sb >> 9) & 1) << 5); R = (st >> 1) * 16 + swz / 64; C = (st & 1) * 32 + (swz % 64) / 2; }
__device__ __forceinline__ int perm32(int rho) { const int n = rho >> 4, i = rho & 15; return 8 * (i >> 2) + 4 * n + (i & 3); }

struct Unit { int pm, pn; };
struct Gemm { const bf16_t* A; const bf16_t* Bt; int lda, ldb, K; };

struct GSched {
    int nM, nN, nwg, G, c, mode;
    size_t aPm, aPn, bPn, bPm; int bShift;
    __device__ __forceinline__ void init(int nM_, int nN_, int G_, int c_) { nM = nM_; nN = nN_; nwg = nM * nN; G = G_; c = c_; mode = 0; aPm = 0; aPn = 0; bPn = 0; bPm = 0; bShift = 0; }
    __device__ __forceinline__ bool next(int i, Unit& u) const {
        const long L = (long)i * G + c; if (L >= nwg) return false;
        int wgid = (int)L; { const int q = nwg / NXCD, r = nwg % NXCD, xcd = wgid % NXCD, off = wgid / NXCD; wgid = (xcd < r ? xcd * (q + 1) : r * (q + 1) + (xcd - r) * q) + off; }
        const int nig = WGM * nN, gid = wgid / nig, fm = gid * WGM, gsz = (nM - fm) < WGM ? (nM - fm) : WGM;
        u.pm = fm + ((wgid % nig) % gsz); u.pn = (wgid % nig) / gsz; return true;
    }
    __device__ __forceinline__ size_t offA(const Unit& u) const { return mode == 1 ? (size_t)(u.pn & 3) * 512 : (mode == 2 ? (size_t)(u.pn & 3) * 4096 + (size_t)(u.pn >> 2) * 512 : (size_t)u.pm * aPm + (size_t)u.pn * aPn); }
    __device__ __forceinline__ size_t offB(const Unit& u) const { return mode == 1 ? (size_t)(u.pn >> 2) * (256 * 1024 * 2) + (size_t)(u.pn & 3) * 512 : (mode == 2 ? (size_t)(u.pn & 3) * (256 * 2048 * 2) + (size_t)(u.pn >> 2) * 512 : (size_t)u.pn * bPn + (size_t)(u.pm >> bShift) * bPm); }
};

struct EpiBf16 {
    static constexpr bool PERM = true;
    bf16_t* O; int ldc; float scale; const float* ss; int smp;
    __device__ __forceinline__ void operator()(f32x4 (&acc)[2][2][4][2], const Unit& u, int wr, int wc, int fr, int fq, LAS unsigned char*) const {
        asm volatile("" : "+v"(fr), "+v"(fq)); asm volatile("" : "+s"(wr), "+s"(wc));
        const int row0 = u.pm * BM + wr * 64 + fr, col0 = (smp ? (u.pn & 3) : u.pn) * BM + wc * 32 + 8 * fq;
        f32x4 rs[2][4];
#pragma unroll
        for (int ai = 0; ai < 2; ++ai)
#pragma unroll
            for (int m = 0; m < 4; ++m) rs[ai][m] = ss ? *(const f32x4*)(ss + (size_t)(row0 + ai * HALF + m * 16) * 4) : (f32x4){0.f, 0.f, 0.f, 0.f};
#pragma unroll
        for (int ai = 0; ai < 2; ++ai)
#pragma unroll
            for (int m = 0; m < 4; ++m) { bf16_t* rowp = O + (size_t)(row0 + ai * HALF + m * 16) * ldc + col0;
                float sc = scale; if (ss) sc *= ss_rstd(rs[ai][m]);
                if (smp && ((ai * HALF + wr * 64 + m * 16 + fr) >> 5) != (u.pn >> 2)) continue;
#pragma unroll
                for (int bj = 0; bj < 2; ++bj) { const f32x4 v0 = acc[ai][bj][m][0] * sc, v1 = acc[ai][bj][m][1] * sc;
                    u32x4 w; w.x = cvt_pk_bf16(v0[0], v0[1]); w.y = cvt_pk_bf16(v0[2], v0[3]); w.z = cvt_pk_bf16(v1[0], v1[1]); w.w = cvt_pk_bf16(v1[2], v1[3]);
                    *(u32x4*)(rowp + bj * HALF) = w; } }
    }
};
struct EpiResid {
    static constexpr bool PERM = true;
    bf16_t* xb; float* ss;
    __device__ __forceinline__ void operator()(f32x4 (&acc)[2][2][4][2], const Unit& u, int wr, int wc, int fr, int fq, LAS unsigned char* lds) const {
        asm volatile("" : "+v"(fr), "+v"(fq)); asm volatile("" : "+s"(wr), "+s"(wc));
        const int col0 = u.pn * BM + wc * 32 + 8 * fq, lane = fq * 16 + fr;
        LAS float* PS = (LAS float*)(lds + LDS_EX);
        bf16_t* ob = xb + (size_t)u.pm * BM * D;
#pragma unroll
        for (int ai = 0; ai < 2; ++ai) {
            u32x4 pre[4][2];
#pragma unroll
            for (int m = 0; m < 4; ++m)
#pragma unroll
                for (int bj = 0; bj < 2; ++bj) pre[m][bj] = *(const u32x4*)(ob + (size_t)(ai * HALF + wr * 64 + m * 16 + fr) * D + col0 + bj * HALF);
            asm volatile("" ::: "memory");
#pragma unroll
            for (int m = 0; m < 4; ++m) { const int rl = ai * HALF + wr * 64 + m * 16 + fr; const size_t off = (size_t)rl * D + col0; float q = 0.f;
#pragma unroll
                for (int bj = 0; bj < 2; ++bj) { const u32x4 p = pre[m][bj]; const f32x4 a0 = acc[ai][bj][m][0], a1 = acc[ai][bj][m][1];
                    const float v0 = bflo(p.x) + a0[0], v1 = bfhi(p.x) + a0[1], v2 = bflo(p.y) + a0[2], v3 = bfhi(p.y) + a0[3], v4 = bflo(p.z) + a1[0], v5 = bfhi(p.z) + a1[1], v6 = bflo(p.w) + a1[2], v7 = bfhi(p.w) + a1[3];
                    u32x4 w; w.x = cvt_pk_bf16(v0, v1); w.y = cvt_pk_bf16(v2, v3); w.z = cvt_pk_bf16(v4, v5); w.w = cvt_pk_bf16(v6, v7); *(u32x4*)(ob + off + bj * HALF) = w;
                    q += ((v0 * v0 + v1 * v1) + (v2 * v2 + v3 * v3)) + ((v4 * v4 + v5 * v5) + (v6 * v6 + v7 * v7)); }
                q += shx(q, 16, lane); q += shx(q, 32, lane);
                if (fq == 0) PS[rl * 4 + wc] = q; }
            asm volatile("" ::: "memory");
        }
        asm volatile("s_waitcnt lgkmcnt(0)" ::: "memory"); __builtin_amdgcn_s_barrier(); asm volatile("" ::: "memory");
        { const int t = (wr * 4 + wc) * 64 + lane; if (t < 256) { const f32x4 p = *(const LAS f32x4*)(PS + t * 4); ss[(size_t)(u.pm * BM + t) * 4 + u.pn] = (p[0] + p[1]) + (p[2] + p[3]); } }
    }
};
struct EpiKV {
    static constexpr bool PERM = false;
    float* outK; float* outV; bf16_t* KB; bf16_t* VT;
    __device__ __forceinline__ void operator()(f32x4 (&acc)[2][2][4][2], const Unit& u, int wr, int wc, int fr, int fq, LAS unsigned char*) const {
        asm volatile("" : "+v"(fr), "+v"(fq)); asm volatile("" : "+s"(wr), "+s"(wc));
        const int kind = u.pm >> 4, pm = u.pm & 15;
        const int col0 = u.pn * BM + wc * 32 + 4 * fq;
        float* of = kind == 0 ? outK : outV; bf16_t* ob = kind == 0 ? KB : VT; const int ldb_ = kind == 2 ? 2048 : 1024;
#pragma unroll
        for (int ai = 0; ai < 2; ++ai)
#pragma unroll
            for (int m = 0; m < 4; ++m) { const int row = pm * BM + ai * HALF + wr * 64 + m * 16 + fr;
#pragma unroll
                for (int bj = 0; bj < 2; ++bj)
#pragma unroll
                    for (int n = 0; n < 2; ++n) { const f32x4 v = acc[ai][bj][m][n]; const int col = col0 + bj * HALF + n * 16;
                        if (kind != 2) *(f32x4*)(of + (size_t)row * 1024 + col) = v;
                        if (kind != 1) { u32x2 w; w.x = cvt_pk_bf16(v[0], v[1]); w.y = cvt_pk_bf16(v[2], v[3]); *(u32x2*)(ob + (size_t)row * ldb_ + col) = w; } } }
    }
};
struct EpiSoftmax {
    static constexpr bool PERM = true;
    bf16_t* O; int ldc; int smp;
    __device__ __forceinline__ void operator()(f32x4 (&acc)[2][2][4][2], const Unit& u, int wr, int wc, int fr, int fq, LAS unsigned char* lds) const {
        asm volatile("" : "+v"(fr), "+v"(fq)); asm volatile("" : "+s"(wr), "+s"(wc));
        LAS f32x2* EX = (LAS f32x2*)(lds + LDS_EX);
        const int lane = fq * 16 + fr;
        const float L2E = 1.4426950408889634f;
#pragma unroll
        for (int ai = 0; ai < 2; ++ai)
#pragma unroll
            for (int m = 0; m < 4; ++m) {
                float mx = -3.0e38f;
#pragma unroll
                for (int bj = 0; bj < 2; ++bj)
#pragma unroll
                    for (int n = 0; n < 2; ++n) { const f32x4 x = acc[ai][bj][m][n]; mx = fmaxf(mx, fmaxf(fmaxf(x[0], x[1]), fmaxf(x[2], x[3]))); }
                mx = fmaxf(mx, shx(mx, 16, lane)); mx = fmaxf(mx, shx(mx, 32, lane));
                float s = 0.f;
#pragma unroll
                for (int bj = 0; bj < 2; ++bj)
#pragma unroll
                    for (int n = 0; n < 2; ++n) { f32x4 x = acc[ai][bj][m][n];
#pragma unroll
                        for (int j = 0; j < 4; ++j) { x[j] = __builtin_amdgcn_exp2f((x[j] - mx) * L2E); s += x[j]; }
                        acc[ai][bj][m][n] = x; }
                s += shx(s, 16, lane); s += shx(s, 32, lane);
                if (fq == 0) EX[(ai * HALF + wr * 64 + m * 16 + fr) * 4 + wc] = (f32x2){mx, s};
            }
        asm volatile("s_waitcnt lgkmcnt(0)" ::: "memory"); __builtin_amdgcn_s_barrier(); asm volatile("" ::: "memory");
        int colb = u.pn * BM, j_ = 0;
        if (smp) { colb = (u.pn & 3) * 2048 + (u.pn >> 2) * 256; j_ = u.pn >> 2; }
        const int col0 = colb + wc * 32 + 8 * fq;
#pragma unroll
        for (int ai = 0; ai < 2; ++ai)
#pragma unroll
            for (int m = 0; m < 4; ++m) {
                const int rl = ai * HALF + wr * 64 + m * 16 + fr;
                const f32x2 e0 = EX[rl * 4 + 0], e1 = EX[rl * 4 + 1], e2 = EX[rl * 4 + 2], e3 = EX[rl * 4 + 3];
                const float M = fmaxf(fmaxf(e0.x, e1.x), fmaxf(e2.x, e3.x));
                const float tot = e0.y * __builtin_amdgcn_exp2f((e0.x - M) * L2E) + e1.y * __builtin_amdgcn_exp2f((e1.x - M) * L2E) + e2.y * __builtin_amdgcn_exp2f((e2.x - M) * L2E) + e3.y * __builtin_amdgcn_exp2f((e3.x - M) * L2E);
                const float own = wc == 0 ? e0.x : (wc == 1 ? e1.x : (wc == 2 ? e2.x : e3.x));
                float f = __builtin_amdgcn_exp2f((own - M) * L2E) / tot;
                if (smp && (rl >> 5) != j_) f = 0.f;
                bf16_t* rowp = O + (size_t)(u.pm * BM + rl) * ldc + col0;
#pragma unroll
                for (int bj = 0; bj < 2; ++bj) { const f32x4 v0 = acc[ai][bj][m][0] * f, v1 = acc[ai][bj][m][1] * f;
                    u32x4 w; w.x = cvt_pk_bf16(v0[0], v0[1]); w.y = cvt_pk_bf16(v0[2], v0[3]); w.z = cvt_pk_bf16(v1[0], v1[1]); w.w = cvt_pk_bf16(v1[2], v1[3]);
                    *(u32x4*)(rowp + bj * HALF) = w; } }
    }
};


__device__ __forceinline__ float dpp_ror1(float v) { return __builtin_bit_cast(float, __builtin_amdgcn_update_dpp(0, __builtin_bit_cast(int, v), 0x121, 0xf, 0xf, false)); }
__device__ __forceinline__ float dpp_ror2(float v) { return __builtin_bit_cast(float, __builtin_amdgcn_update_dpp(0, __builtin_bit_cast(int, v), 0x122, 0xf, 0xf, false)); }
struct EpiAct {
    static constexpr bool PERM = true;
    bf16_t* H; const float* scf; float* ocf; float* sbg; float* sbu; float* sbl; const float* cfw; const float* ss;
    __device__ __forceinline__ void operator()(f32x4 (&acc)[2][2][4][2], const Unit& u, int wr, int wc, int fr, int fq, LAS unsigned char* lds) const {
        asm volatile("" : "+s"(wr), "+s"(wc));
        int lane; asm volatile("v_mbcnt_lo_u32_b32 %0, -1, 0\n\tv_mbcnt_hi_u32_b32 %0, -1, %0" : "=v"(lane));
        fr = lane & 15; fq = lane >> 4;
        const int fl = wc * 32 + 8 * fq, f0 = u.pn * 128 + fl; int rowt = wr * 64 + fr;
        {
            float rst[2][4];
            f32x4 rsl[2][4];
#pragma unroll
            for (int ai = 0; ai < 2; ++ai)
#pragma unroll
                for (int m = 0; m < 4; ++m) rsl[ai][m] = *(const f32x4*)(ss + (size_t)(u.pm * BM + ai * HALF + rowt + m * 16) * 4);
#pragma unroll
            for (int ai = 0; ai < 2; ++ai)
#pragma unroll
                for (int m = 0; m < 4; ++m) { rst[ai][m] = ss_rstd(rsl[ai][m]); }
#pragma unroll
            for (int ai = 0; ai < 2; ++ai)
#pragma unroll
                for (int m = 0; m < 4; ++m) { acc[ai][0][m][0] = acc[ai][0][m][0] * rst[ai][m]; acc[ai][0][m][1] = acc[ai][0][m][1] * rst[ai][m]; acc[ai][1][m][0] = acc[ai][1][m][0] * rst[ai][m]; acc[ai][1][m][1] = acc[ai][1][m][1] * rst[ai][m]; }
        }
        const bool smp = (u.pm == 128);
        asm volatile("" : "+v"(rowt));
        LAS float* BND = (LAS float*)(lds + LDS_EX);
        if (fr >= 14) {
#pragma unroll
            for (int ai = 0; ai < 2; ++ai)
#pragma unroll
                for (int n = 0; n < 2; ++n) *(LAS f32x4*)(BND + ((ai * 2 + wr) * 2 + (fr - 14)) * 128 + fl + 4 * n) = acc[ai][0][3][n];
            if (wr == 1) {
#pragma unroll
                for (int n = 0; n < 2; ++n) *(f32x4*)(sbl + ((size_t)u.pm * 2 + (fr - 14)) * DFF + f0 + 4 * n) = acc[1][0][3][n];
            }
        }
        asm volatile("s_waitcnt lgkmcnt(0)" ::: "memory"); __builtin_amdgcn_s_barrier(); asm volatile("" ::: "memory");
#pragma unroll
        for (int ai = 0; ai < 2; ++ai) {
            const int pg = wr == 1 ? ai * 2 : 1;
            u32x2 hp[2][4];
#pragma unroll
            for (int n = 0; n < 2; ++n) {
                const f32x4 w0 = *(const f32x4*)(cfw + f0 + 4 * n), w1 = *(const f32x4*)(cfw + DFF + f0 + 4 * n), w2 = *(const f32x4*)(cfw + 2 * DFF + f0 + 4 * n);
                f32x4 h2 = *(const LAS f32x4*)(BND + (pg * 2 + 0) * 128 + fl + 4 * n), h1 = *(const LAS f32x4*)(BND + (pg * 2 + 1) * 128 + fl + 4 * n);
                f32x4 t2 = h2, t1 = h1;
                if (smp) { const float* sp = scf + (size_t)((ai * 4 + wr * 2) * 2) * DFF + f0 + 4 * n; h2 = *(const f32x4*)sp; h1 = *(const f32x4*)(sp + DFF); t2 = *(const f32x4*)(sp + 2 * DFF); t1 = *(const f32x4*)(sp + 3 * DFF); }
#pragma unroll
                for (int jp = 0; jp < 2; ++jp) {
                    float hv[4][2];
#pragma unroll
                    for (int jj = 0; jj < 2; ++jj) { const int j = jp * 2 + jj;
                        float r1p = h1[j], r2p = fr == 0 ? h2[j] : h1[j];
#pragma unroll
                        for (int m = 0; m < 4; ++m) { const float g = acc[ai][0][m][n][j];
                            if (m == 2 && smp) { r1p = t1[j]; r2p = fr == 0 ? t2[j] : t1[j]; }
                            const float r1 = dpp_ror1(g), r2 = dpp_ror2(g);
                            const float gm1 = fr >= 1 ? r1 : r1p, gm2 = fr >= 2 ? r2 : r2p;
                            r1p = r1; r2p = r2;
                            const float cv = w0[j] * gm2 + w1[j] * gm1 + w2[j] * g;
                            hv[m][jj] = silu(cv) * acc[ai][1][m][n][j]; } }
#pragma unroll
                    for (int m = 0; m < 4; ++m) { const unsigned pk = cvt_pk_bf16(hv[m][0], hv[m][1]); if (jp == 0) hp[n][m].x = pk; else hp[n][m].y = pk; }
                }
            }
#pragma unroll
            for (int m = 0; m < 4; ++m) {
                const int rl = ai * HALF + rowt + m * 16;
                if (smp && (m & 1) && fr >= 14) {
#pragma unroll
                    for (int n = 0; n < 2; ++n) *(f32x4*)(ocf + ((size_t)(ai * 4 + wr * 2 + (m >> 1)) * 2 + (fr - 14)) * DFF + f0 + 4 * n) = acc[ai][0][m][n];
                }
                if (!smp && ai == 0 && m == 0 && wr == 0 && fr < 2) {
#pragma unroll
                    for (int n = 0; n < 2; ++n) { *(f32x4*)(sbg + ((size_t)u.pm * 2 + fr) * DFF + f0 + 4 * n) = acc[0][0][0][n]; *(f32x4*)(sbu + ((size_t)u.pm * 2 + fr) * DFF + f0 + 4 * n) = acc[0][1][0][n]; }
                } else {
                    u32x4 w; w.x = hp[0][m].x; w.y = hp[0][m].y; w.z = hp[1][m].x; w.w = hp[1][m].y;
                    *(u32x4*)(H + (size_t)(u.pm * BM + rl) * DFF + f0) = w;
                }
            }
        }
    }
};

template <class Epi, class Sched, bool ALIGN_EPI>
__device__ __forceinline__ void gemm_phase(LAS unsigned char* lds, const Gemm g, const Sched& S, const Epi& E, const int wave_s) {
    const int tid = opaque_tid(wave_s), wid = __builtin_amdgcn_readfirstlane(tid >> 6), lane = tid & 63, wr = wid >> 2, wc = wid & 3, fr = lane & 15, fq = lane >> 4;
    const int nt = g.K / BK;
    unsigned voffA[2], voffB[2];
#pragma unroll
    for (int i = 0; i < 2; ++i) { int R, C; stage_rc(tid * 16 + i * 8192, R, C); const int Rb = Epi::PERM ? ((R & ~31) + perm32(R & 31)) : R;
        voffA[i] = (unsigned)(R * g.lda + C) * 2u; voffB[i] = (unsigned)(Rb * g.ldb + C) * 2u; }
    const size_t kstep = (size_t)(BK * 2);
    const size_t hstepA = (size_t)HALF * g.lda * 2, hstepB = (size_t)HALF * g.ldb * 2;
    const unsigned ldsw = (unsigned)wid * 1024u;
    const int aoff = lds_byte(wr * 64 + fr, fq * 8), boff = lds_byte(wc * 32 + fr, fq * 8);
#define PG8_SA(b, h) (((b) * 2 + (h)) * HTB)
#define PG8_SB(b, h) ((4 + (b) * 2 + (h)) * HTB)
#define PG8_STAGE(bufoff, gbase, voff) do { _Pragma("unroll") for (int _i = 0; _i < 2; ++_i) \
        __builtin_amdgcn_global_load_lds((const unsigned*)((const char*)(gbase) + (voff)[_i]), (LAS unsigned*)(lds + (bufoff) + ldsw + _i * 8192), 16, 0, 0); } while (0)
#define PG8_LDA(dst, b, h) do { _Pragma("unroll") for (int m = 0; m < 4; ++m) _Pragma("unroll") for (int k = 0; k < 2; ++k) dst[m][k] = *(const LAS bf16x8*)(lds + PG8_SA(b, h) + aoff + m * 2048 + k * 1024); } while (0)
#define PG8_LDB(dst, b, h) do { _Pragma("unroll") for (int n = 0; n < 2; ++n) _Pragma("unroll") for (int k = 0; k < 2; ++k) dst[n][k] = *(const LAS bf16x8*)(lds + PG8_SB(b, h) + boff + n * 2048 + k * 1024); } while (0)
#define PG8_MMA(ai, bj, At, Bt) do { __builtin_amdgcn_s_setprio(1); _Pragma("unroll") for (int m = 0; m < 4; ++m) _Pragma("unroll") for (int n = 0; n < 2; ++n) _Pragma("unroll") for (int k = 0; k < 2; ++k) \
        acc[ai][bj][m][n] = __builtin_amdgcn_mfma_f32_16x16x32_bf16(Bt[n][k], At[m][k], acc[ai][bj][m][n], 0, 0, 0); __builtin_amdgcn_s_setprio(0); } while (0)
#define PG8_WAIT_V(n) asm volatile("s_waitcnt vmcnt(" #n ")" ::: "memory")
#define PG8_WAIT_L(n) asm volatile("s_waitcnt lgkmcnt(" #n ")" ::: "memory")
#define PG8_BAR __builtin_amdgcn_s_barrier()
#define PG8_SCHED __builtin_amdgcn_sched_barrier(0)
    Unit cur, nxt; int ui = 0;
    if (!S.next(0, cur)) return;
    f32x4 acc[2][2][4][2];
#pragma unroll
    for (int a = 0; a < 2; ++a)
#pragma unroll
        for (int b = 0; b < 2; ++b)
#pragma unroll
            for (int m = 0; m < 4; ++m)
#pragma unroll
                for (int n = 0; n < 2; ++n) acc[a][b][m][n] = (f32x4){0.f, 0.f, 0.f, 0.f};
    bf16x8 At[4][2], B0[2][2], B1[2][2];
    const char* cA = (const char*)g.A + S.offA(cur); const char* cB = (const char*)g.Bt + S.offB(cur);
    PG8_STAGE(PG8_SB(0, 0), cB, voffB); PG8_STAGE(PG8_SB(0, 1), cB + hstepB, voffB); PG8_STAGE(PG8_SA(0, 0), cA, voffA); PG8_STAGE(PG8_SA(0, 1), cA + hstepA, voffA);
    if (wr == 1) PG8_BAR;
    PG8_WAIT_V(2); PG8_BAR;
    PG8_STAGE(PG8_SB(1, 0), cB + kstep, voffB); PG8_STAGE(PG8_SA(1, 0), cA + kstep, voffA); PG8_STAGE(PG8_SB(1, 1), cB + hstepB + kstep, voffB);
    PG8_WAIT_V(6); PG8_BAR;
    for (;;) {
        const bool has_next = S.next(ui + 1, nxt);
        const char* nA = has_next ? (const char*)g.A + S.offA(nxt) : cA; const char* nB = has_next ? (const char*)g.Bt + S.offB(nxt) : cB;
        for (int t = 0; t < nt; t += 2) {
            const bool last = (t == nt - 2);
            const char* a1 = cA + (size_t)(t + 1) * kstep;
            const char* a2 = last ? nA : cA + (size_t)(t + 2) * kstep; const char* b2 = last ? nB : cB + (size_t)(t + 2) * kstep;
            const char* a3 = a2 + kstep; const char* b3 = b2 + kstep;
            PG8_LDB(B0, 0, 0); PG8_LDB(B1, 0, 1); PG8_SCHED; PG8_LDA(At, 0, 0); PG8_STAGE(PG8_SA(1, 1), a1 + hstepA, voffA);
            PG8_WAIT_V(8); PG8_WAIT_L(0); PG8_BAR; PG8_MMA(0, 0, At, B0); PG8_MMA(0, 1, At, B1); PG8_BAR; PG8_SCHED;
            PG8_LDA(At, 0, 1); PG8_STAGE(PG8_SB(0, 0), b2, voffB); PG8_STAGE(PG8_SB(0, 1), b2 + hstepB, voffB); PG8_STAGE(PG8_SA(0, 0), a2, voffA);
            PG8_WAIT_V(8); PG8_WAIT_L(0); PG8_BAR; PG8_MMA(1, 0, At, B0); PG8_MMA(1, 1, At, B1); PG8_BAR; PG8_SCHED;
            PG8_LDB(B0, 1, 0); PG8_LDB(B1, 1, 1); PG8_SCHED; PG8_LDA(At, 1, 0); PG8_STAGE(PG8_SA(0, 1), a2 + hstepA, voffA);
            PG8_WAIT_V(8); PG8_WAIT_L(0); PG8_BAR; PG8_MMA(0, 0, At, B0); PG8_MMA(0, 1, At, B1); PG8_BAR; PG8_SCHED;
            PG8_LDA(At, 1, 1); PG8_STAGE(PG8_SB(1, 0), b3, voffB); PG8_STAGE(PG8_SB(1, 1), b3 + hstepB, voffB); PG8_STAGE(PG8_SA(1, 0), a3, voffA);
            PG8_WAIT_V(8); PG8_WAIT_L(0); PG8_BAR; PG8_MMA(1, 0, At, B0); PG8_MMA(1, 1, At, B1); PG8_BAR; PG8_SCHED;
        }
        if constexpr (ALIGN_EPI) { if (wr == 0) PG8_BAR; }
        E(acc, cur, wr, wc, fr, fq, lds);
        if (!has_next) break;
#pragma unroll
        for (int a = 0; a < 2; ++a)
#pragma unroll
            for (int b = 0; b < 2; ++b)
#pragma unroll
                for (int m = 0; m < 4; ++m)
#pragma unroll
                    for (int n = 0; n < 2; ++n) acc[a][b][m][n] = (f32x4){0.f, 0.f, 0.f, 0.f};
        cur = nxt; cA = nA; cB = nB; ++ui;
        if constexpr (ALIGN_EPI) { if (wr == 1) PG8_BAR; }
    }
    PG8_WAIT_V(0);
    if constexpr (!ALIGN_EPI) { if (wr == 0) PG8_BAR; }
    PG8_BAR;
#undef PG8_SA
#undef PG8_SB
#undef PG8_STAGE
#undef PG8_LDA
#undef PG8_LDB
#undef PG8_MMA
#undef PG8_WAIT_V
#undef PG8_WAIT_L
#undef PG8_BAR
#undef PG8_SCHED
}
}

struct KVSched {
    int c, G; const char* ws; size_t wsel;
    __device__ __forceinline__ bool next(int i, pg8::Unit& u) const {
        const int L = i * G + c; if (c < 0 || L >= 96) return false;
        const int kind = L >> 5, r = L & 31;
        if (kind < 2) { u.pm = kind * 16 + (r >> 2); u.pn = r & 3; } else { u.pm = 32 + (r >> 3); u.pn = r & 7; }
        return true;
    }
    __device__ __forceinline__ size_t offA(const pg8::Unit& u) const { const int kind = u.pm >> 4, pm = u.pm & 15; int k2 = (kind == 2); asm volatile("" : "+v"(k2));
        return (size_t)ws + WS_MEMB + (size_t)k2 * (WS_WV + wsel - WS_MEMB) + (size_t)pm * 256 * 1024 * 2; }
    __device__ __forceinline__ size_t offB(const pg8::Unit& u) const { const int kind = u.pm >> 4; int k1 = (kind == 1), k2 = (kind == 2); asm volatile("" : "+v"(k1), "+v"(k2));
        return (size_t)ws + WS_WK + wsel + (size_t)k1 * (WS_WV - WS_WK) + (size_t)k2 * (WS_MEMB - WS_WK - wsel) + (size_t)u.pn * 256 * 1024 * 2; }
};


#define XB_TMO      128
#define XB_XCNT(j)  (256  + 64 * (j))
#define XB_XSUB(j)  (1280 + 64 * (j))
#define XB_XGEN(j)  (2304 + 64 * (j))
#define XB_TOP      3328
#define XB_TOPGEN   3392
#define XCD_BAR_WORDS 3456
#define XB_SPIN_CAP (1u << 22)
__device__ __forceinline__ unsigned xb_ld(unsigned* p)              { return __hip_atomic_load(p, __ATOMIC_RELAXED, __HIP_MEMORY_SCOPE_AGENT); }
__device__ __forceinline__ unsigned xb_add(unsigned* p, unsigned v) { return __hip_atomic_fetch_add(p, v, __ATOMIC_RELAXED, __HIP_MEMORY_SCOPE_AGENT); }
__device__ __forceinline__ unsigned xb_xcc_id() { return (unsigned)__builtin_amdgcn_s_getreg((3 << 11) | 20) & 0xFu; }
#define XB_SPIN(cond, bar) do { unsigned _sp = 0; while (cond) { __builtin_amdgcn_s_sleep(1); \
    if ((++_sp & 255u) == 0u) { if (xb_ld(&(bar)[XB_TMO])) break; if (_sp > XB_SPIN_CAP) { atomicAdd(&(bar)[XB_TMO], 1u); break; } } } } while (0)
struct XcdBarrier { unsigned* bar; unsigned x; volatile LAS unsigned* st; };
__device__ __forceinline__ void xcd_barrier_complete(unsigned* bar, unsigned x, unsigned& nloc, unsigned& nx) {
    const unsigned G = gridDim.x * gridDim.y * gridDim.z;
    unsigned sum, cnt, mine, sp = 0u;
    for (;;) {
        sum = 0u; cnt = 0u; mine = 0u;
#pragma unroll
        for (unsigned j = 0; j < 16; ++j) { const unsigned c = xb_ld(&bar[XB_XCNT(j)]); sum += c; cnt += (c > 0u) ? 1u : 0u; mine = (j == x) ? c : mine; }
        if (sum == G) break;
        __builtin_amdgcn_s_sleep(1);
        if ((++sp & 255u) == 0u) { if (xb_ld(&bar[XB_TMO])) break; if (sp > XB_SPIN_CAP) { atomicAdd(&bar[XB_TMO], 1u); break; } }
    }
    nloc = mine > 0u ? mine : 1u; nx = cnt > 0u ? cnt : 1u;
}
__device__ __forceinline__ void xcd_barrier(const XcdBarrier& b) {
    asm volatile("s_waitcnt vmcnt(0)" ::: "memory");
    __syncthreads();
    if (threadIdx.x == 0) {
        unsigned* bar = b.bar;
        __builtin_amdgcn_s_waitcnt(0);
        unsigned nloc = b.st[0], nx = b.st[1];
        if (nloc == 0u) { xcd_barrier_complete(bar, b.x, nloc, nx); b.st[0] = nloc; b.st[1] = nx; }
        const unsigned old = xb_add(&bar[XB_XSUB(b.x)], 1u);
        const unsigned gen = old / nloc;
        if (old + 1u == (gen + 1u) * nloc) {
            __builtin_amdgcn_fence(__ATOMIC_RELEASE, "agent");
            asm volatile("s_waitcnt vmcnt(0)" ::: "memory");
            const unsigned og = xb_add(&bar[XB_TOP], 1u);
            const unsigned tg = og / nx;
            if (og + 1u == (tg + 1u) * nx) xb_add(&bar[XB_TOPGEN], 1u);
            else XB_SPIN(xb_ld(&bar[XB_TOPGEN]) == tg, bar);
            __builtin_amdgcn_fence(__ATOMIC_ACQUIRE, "agent");
            xb_add(&bar[XB_XGEN(b.x)], 1u);
            asm volatile("s_waitcnt vmcnt(0)" ::: "memory");
        } else {
            XB_SPIN(xb_ld(&bar[XB_XGEN(b.x)]) == gen, bar);
            __builtin_amdgcn_fence(__ATOMIC_ACQUIRE, "agent");
            asm volatile("s_waitcnt vmcnt(0)" ::: "memory");
        }
    }
    __syncthreads();
}


struct SG2 { const bf16_t* A; const bf16_t* Bt; int lda, ldb, K, N; bf16_t* O; int ldc; float scale; int mode; float* ssp; };
__device__ __forceinline__ float sq8(bf16x8 a) { float q = 0.f;
#pragma unroll
    for (int i = 0; i < 8; ++i) { const float f = bf2f((unsigned)(unsigned short)a[i]); q += f * f; } return q; }
__device__ __forceinline__ void sgemm2(LAS unsigned char* lds, const SG2 g, int ubase, int G, int wave, int tid) {
    const int lane = tid & 63, fr = lane & 15, fq = lane >> 4, rt = wave & 3, ch = wave >> 2;
    const int nunits = (g.N / 64) * 4, nsl = g.K / 64;
    int R, C; pg8::stage_rc(tid * 16, R, C);
    const unsigned offA = (unsigned)(R * g.lda + C) * 2u, offB = (unsigned)(R * g.ldb + C) * 2u;
    const int aoff = pg8::lds_byte(rt * 16 + fr, fq * 8), boff = pg8::lds_byte(ch * 32 + fr, fq * 8);
    for (int un = ubase; un >= 0 && un < nunits; un += G) {
        const int cgp = un >> 2, rg = un & 3;
        const char* gA = (const char*)(g.A + (size_t)rg * 64 * g.lda) + offA; const char* gB = (const char*)(g.Bt + (size_t)cgp * 64 * g.ldb) + offB;
#define SG2_STAGE(sl) do { LAS unsigned char* d_ = lds + ((sl) & 3) * 16384 + wave * 1024; \
        __builtin_amdgcn_global_load_lds((const unsigned*)(gA + (size_t)(sl) * 128), (LAS unsigned*)d_, 16, 0, 0); \
        __builtin_amdgcn_global_load_lds((const unsigned*)(gB + (size_t)(sl) * 128), (LAS unsigned*)(d_ + 8192), 16, 0, 0); } while (0)
        asm volatile("s_waitcnt vmcnt(0)" ::: "memory");
        SG2_STAGE(0); SG2_STAGE(1);
        f32x4 acc[2] = {(f32x4){0.f, 0.f, 0.f, 0.f}, (f32x4){0.f, 0.f, 0.f, 0.f}}; float q = 0.f;
        for (int sl = 0; sl < nsl; ++sl) {
            if (sl + 1 < nsl) asm volatile("s_waitcnt vmcnt(2)" ::: "memory"); else asm volatile("s_waitcnt vmcnt(0)" ::: "memory");
            __builtin_amdgcn_s_barrier(); asm volatile("" ::: "memory");
            if (sl + 2 < nsl) SG2_STAGE(sl + 2);
            LAS unsigned char* b_ = lds + (sl & 3) * 16384;
#pragma unroll
            for (int ks = 0; ks < 2; ++ks) {
                const bf16x8 a = *(const LAS bf16x8*)(b_ + aoff + ks * 1024);
#pragma unroll
                for (int c = 0; c < 2; ++c) { const bf16x8 b = *(const LAS bf16x8*)(b_ + 8192 + boff + c * 2048 + ks * 1024);
                    acc[c] = __builtin_amdgcn_mfma_f32_16x16x32_bf16(b, a, acc[c], 0, 0, 0); }
                if (g.mode == 1) q += sq8(a);
            }
        }
#undef SG2_STAGE
        const int row = rg * 64 + rt * 16 + fr, col = cgp * 64 + ch * 32 + fq * 4;
        bf16_t* op = g.O + (size_t)row * g.ldc + col;
        if (g.mode == 1) {
            q += shx(q, 16, lane); q += shx(q, 32, lane);
            const float sc = g.scale / sqrtf(q * (1.f / 1024.f) + EPS);
#pragma unroll
            for (int c = 0; c < 2; ++c) { const f32x4 v = acc[c] * sc; u32x2 w; w.x = cvt_pk_bf16(v[0], v[1]); w.y = cvt_pk_bf16(v[2], v[3]); *(u32x2*)(op + c * 16) = w; }
        } else {
            const u32x2 p0 = *(const u32x2*)op, p1 = *(const u32x2*)(op + 16); float qq = 0.f;
            { const float v0 = bflo(p0.x) + acc[0][0], v1 = bfhi(p0.x) + acc[0][1], v2 = bflo(p0.y) + acc[0][2], v3 = bfhi(p0.y) + acc[0][3];
              u32x2 w; w.x = cvt_pk_bf16(v0, v1); w.y = cvt_pk_bf16(v2, v3); *(u32x2*)op = w; qq += (v0 * v0 + v1 * v1) + (v2 * v2 + v3 * v3); }
            { const float v0 = bflo(p1.x) + acc[1][0], v1 = bfhi(p1.x) + acc[1][1], v2 = bflo(p1.y) + acc[1][2], v3 = bfhi(p1.y) + acc[1][3];
              u32x2 w; w.x = cvt_pk_bf16(v0, v1); w.y = cvt_pk_bf16(v2, v3); *(u32x2*)(op + 16) = w; qq += (v0 * v0 + v1 * v1) + (v2 * v2 + v3 * v3); }
            qq += shx(qq, 16, lane); qq += shx(qq, 32, lane);
            if (fq == 0) g.ssp[row * 32 + cgp * 2 + ch] = qq;
        }
        asm volatile("s_waitcnt vmcnt(0) lgkmcnt(0)" ::: "memory"); __builtin_amdgcn_s_barrier(); asm volatile("" ::: "memory");
    }
}

__device__ __forceinline__ void sgemm_act(LAS unsigned char* lds, const bf16_t* A, const bf16_t* Bt, bf16_t* Hs, const float* cfw, const float* scf, float* ocf, int ubase, int G, int wave, int tid) {
    const int lane = tid & 63, fr = lane & 15, fq = lane >> 4, rt = wave & 3, ch = wave >> 2;
    constexpr int nunits = (DFF / 64) * 4, nsl = D / 64, SLOT = 24576;
    int R, C; pg8::stage_rc(tid * 16, R, C);
    const unsigned off = (unsigned)(R * D + C) * 2u;
    const int aoff = pg8::lds_byte(rt * 16 + fr, fq * 8), boff = pg8::lds_byte(fr, fq * 8) + 8192 + ch * 8192;
    for (int un = ubase; un >= 0 && un < nunits; un += G) {
        const int fg = un >> 2, rg = un & 3, brow = ((fg >> 1) << 8) + ((fg & 1) << 6);
        const char* gA = (const char*)(A + (size_t)rg * 64 * D) + off; const char* gG = (const char*)(Bt + (size_t)brow * D) + off; const char* gU = (const char*)(Bt + (size_t)(brow + 128) * D) + off;
#define SGA_STAGE(sl) do { LAS unsigned char* d_ = lds + ((sl) & 3) * SLOT + wave * 1024; \
        __builtin_amdgcn_global_load_lds((const unsigned*)(gA + (size_t)(sl) * 128), (LAS unsigned*)d_, 16, 0, 0); \
        __builtin_amdgcn_global_load_lds((const unsigned*)(gG + (size_t)(sl) * 128), (LAS unsigned*)(d_ + 8192), 16, 0, 0); \
        __builtin_amdgcn_global_load_lds((const unsigned*)(gU + (size_t)(sl) * 128), (LAS unsigned*)(d_ + 16384), 16, 0, 0); } while (0)
        asm volatile("s_waitcnt vmcnt(0)" ::: "memory");
        SGA_STAGE(0); SGA_STAGE(1);
        f32x4 acc[4]; float q = 0.f;
#pragma unroll
        for (int c = 0; c < 4; ++c) acc[c] = (f32x4){0.f, 0.f, 0.f, 0.f};
        for (int sl = 0; sl < nsl; ++sl) {
            if (sl + 1 < nsl) asm volatile("s_waitcnt vmcnt(3)" ::: "memory"); else asm volatile("s_waitcnt vmcnt(0)" ::: "memory");
            __builtin_amdgcn_s_barrier(); asm volatile("" ::: "memory");
            if (sl + 2 < nsl) SGA_STAGE(sl + 2);
            LAS unsigned char* b_ = lds + (sl & 3) * SLOT;
#pragma unroll
            for (int ks = 0; ks < 2; ++ks) {
                const bf16x8 a = *(const LAS bf16x8*)(b_ + aoff + ks * 1024);
#pragma unroll
                for (int c = 0; c < 4; ++c) { const bf16x8 b = *(const LAS bf16x8*)(b_ + boff + c * 2048 + ks * 1024);
                    acc[c] = __builtin_amdgcn_mfma_f32_16x16x32_bf16(b, a, acc[c], 0, 0, 0); }
                q += sq8(a);
            }
        }
#undef SGA_STAGE
        q += shx(q, 16, lane); q += shx(q, 32, lane);
        const float rstd = 1.0f / sqrtf(q * (1.f / 1024.f) + EPS);
        asm volatile("s_waitcnt lgkmcnt(0)" ::: "memory"); __builtin_amdgcn_s_barrier(); asm volatile("" ::: "memory");
        LAS float* T = (LAS float*)(lds + ch * 20480);
#pragma unroll
        for (int c = 0; c < 4; ++c)
#pragma unroll
            for (int j = 0; j < 4; ++j) T[(rt * 16 + fr) * 65 + c * 16 + fq * 4 + j] = acc[c][j] * rstd;
        asm volatile("s_waitcnt lgkmcnt(0)" ::: "memory"); __builtin_amdgcn_s_barrier(); asm volatile("" ::: "memory");
        {
            const LAS float* Gt = (const LAS float*)lds; const LAS float* Ut = (const LAS float*)(lds + 20480);
            const int r = tid >> 3, f8 = (tid & 7) * 8, b = rg * 2 + (r >> 5), rr = r & 31, f = fg * 64 + f8;
            const float* st = scf + (size_t)(b * 2) * DFF + f;
            float hv[8], gv[8];
#pragma unroll
            for (int k = 0; k < 8; ++k) {
                const float g0 = Gt[r * 65 + f8 + k];
                const float gm1 = rr >= 1 ? Gt[(r - 1) * 65 + f8 + k] : st[DFF + k];
                const float gm2 = rr >= 2 ? Gt[(r - 2) * 65 + f8 + k] : (rr == 1 ? st[DFF + k] : st[k]);
                const float cv = cfw[f + k] * gm2 + cfw[DFF + f + k] * gm1 + cfw[2 * DFF + f + k] * g0;
                hv[k] = silu(cv) * Ut[r * 65 + f8 + k]; gv[k] = g0;
            }
            u32x4 w; w.x = pk2(hv[0], hv[1]); w.y = pk2(hv[2], hv[3]); w.z = pk2(hv[4], hv[5]); w.w = pk2(hv[6], hv[7]);
            *(u32x4*)(Hs + (size_t)(rg * 64 + r) * DFF + f) = w;
            if (rr >= 30) { float* o = ocf + ((size_t)b * 2 + (rr - 30)) * DFF + f; *(f32x4*)o = (f32x4){gv[0], gv[1], gv[2], gv[3]}; *(f32x4*)(o + 4) = (f32x4){gv[4], gv[5], gv[6], gv[7]}; }
        }
        asm volatile("s_waitcnt vmcnt(0) lgkmcnt(0)" ::: "memory"); __builtin_amdgcn_s_barrier(); asm volatile("" ::: "memory");
    }
}
__device__ __forceinline__ void sample_ss_reduce(const float* sss, float* ssq, int tid) {
    if (tid < 256) { const f32x4* p = (const f32x4*)(sss + tid * 32); float t = 0.f;
#pragma unroll
        for (int i = 0; i < 8; ++i) { const f32x4 v = p[i]; t += (v[0] + v[1]) + (v[2] + v[3]); }
        *(f32x4*)(ssq + (size_t)(MP + tid) * 4) = (f32x4){t, 0.f, 0.f, 0.f}; }
    asm volatile("s_waitcnt vmcnt(0)" ::: "memory"); __syncthreads();
}

__device__ __forceinline__ void transpose_item(const float* W, int K, int N, bf16_t* WT, LAS float* scr, int item, int lane, const float* gain = nullptr, int gu = 0) {
    const int nblk = N / 32, kb = item / nblk, nb = item % nblk, k0 = 64 * kb, n0 = 32 * nb;
    {
        f32x4 v[8];
#pragma unroll
        for (int i = 0; i < 8; ++i) v[i] = *(const f32x4*)(W + (size_t)(k0 + (lane >> 3) + 8 * i) * N + n0 + (lane & 7) * 4);
#pragma unroll
        for (int i = 0; i < 8; ++i) { const int kk = (lane >> 3) + 8 * i; f32x4 w = v[i]; if (gain) w = w * gain[k0 + kk];
            LAS float* d = scr + kk * 33 + (lane & 7) * 4; d[0] = w[0]; d[1] = w[1]; d[2] = w[2]; d[3] = w[3]; }
    }
    LDS_WAIT();
    const int c = lane & 7;
#pragma unroll
    for (int j = 0; j < 4; ++j) { const int n = (lane >> 3) + 8 * j; const LAS float* s = scr + (8 * c) * 33 + n;
        u32x4 o; o.x = pk2(s[0 * 33], s[1 * 33]); o.y = pk2(s[2 * 33], s[3 * 33]); o.z = pk2(s[4 * 33], s[5 * 33]); o.w = pk2(s[6 * 33], s[7 * 33]);
        int drow = n0 + n; if (gu) { const int up = drow >= gu, f = up ? drow - gu : drow; drow = ((f >> 7) << 8) + (up << 7) + (f & 127); }
        *(u32x4*)(WT + (size_t)drow * K + k0 + 8 * c) = o; }
    LDS_WAIT();
}

__device__ __forceinline__ void first_rows(const float* Xp, const float* Xs, bf16_t* XNo, float* ss, int gw, int NGW, int lane) {
    for (int m0 = gw; m0 < MT; m0 += 2 * NGW) {
        const int m1 = m0 + NGW; const bool two = m1 < MT; const int mb = two ? m1 : m0;
        const f32x4* xa = (const f32x4*)(m0 < MP ? Xp + (size_t)m0 * D : Xs + (size_t)(m0 - MP) * D) + lane;
        const f32x4* xb = (const f32x4*)(mb < MP ? Xp + (size_t)mb * D : Xs + (size_t)(mb - MP) * D) + lane;
        f32x4 va[4], vb[4]; float sa = 0.f, sb = 0.f;
#pragma unroll
        for (int j = 0; j < 4; ++j) { va[j] = xa[64 * j]; vb[j] = xb[64 * j]; }
#pragma unroll
        for (int j = 0; j < 4; ++j) { sa += (va[j].x * va[j].x + va[j].y * va[j].y) + (va[j].z * va[j].z + va[j].w * va[j].w); sb += (vb[j].x * vb[j].x + vb[j].y * vb[j].y) + (vb[j].z * vb[j].z + vb[j].w * vb[j].w); }
        sa = wave_sum(sa, lane); sb = wave_sum(sb, lane);
        if (lane < 4) { ss[(size_t)m0 * 4 + lane] = lane == 0 ? sa : 0.f; if (two) ss[(size_t)m1 * 4 + lane] = lane == 0 ? sb : 0.f; }
        u32x2* oa = (u32x2*)(XNo + (size_t)m0 * D) + lane; u32x2* ob = (u32x2*)(XNo + (size_t)mb * D) + lane;
#pragma unroll
        for (int j = 0; j < 4; ++j) { u32x2 w; w.x = pk2(va[j].x, va[j].y); w.y = pk2(va[j].z, va[j].w); oa[64 * j] = w; if (two) { w.x = pk2(vb[j].x, vb[j].y); w.y = pk2(vb[j].z, vb[j].w); ob[64 * j] = w; } }
    }
}

typedef __attribute__((address_space(4))) const unsigned char* kptr_t;
typedef const float* cfp_t; typedef float* fp_t; typedef unsigned char* ucp_t;
#define INP(k) (*(const __attribute__((address_space(4))) cfp_t*)(kp + 8 * (k)))
#define X out
#define WIN_T ((bf16_t*)(ws + WS_WIN + wsel))
#define WOUT_T ((bf16_t*)(ws + WS_WOUT + wsel))
#define WQ_T ((bf16_t*)(ws + WS_WQ + wsel))
#define WK_T ((bf16_t*)(ws + WS_WK + wsel))
#define WV_T ((bf16_t*)(ws + WS_WV + wsel))
#define WO_T ((bf16_t*)(ws + WS_WO + wsel))
#define WUP_T ((bf16_t*)(ws + WS_WUP + wsel))
#define WDN_T ((bf16_t*)(ws + WS_WDN + wsel))
#define MEMB ((bf16_t*)(ws + WS_MEMB))
#define KBP ((bf16_t*)(ws + WS_KBP))
#define VTP ((bf16_t*)(ws + WS_VTP))
#define KBS ((bf16_t*)(ws + WS_KBS + ksel))
#define VTS ((bf16_t*)(ws + WS_VTS + ksel))
#define WST ((bf16_t*)(ws + WS_WST + ksel))
#define AGG ((float*)(ws + WS_AGG))
#define SSQ(i) ((float*)(ws + WS_SSP) + (size_t)(i) * MT * 4)
#define SSS(i) ((float*)(ws + WS_SSS) + (size_t)(i) * 256 * 32)
#define GT_R ((bf16_t*)(ws + WS_GT + ksel))
#define GT_I ((bf16_t*)(ws + WS_GT + 65536 + ksel))
#define XN ((bf16_t*)(ws + WS_XN))
#define gZ ((bf16_t*)(ws + B_Z))
#define HLOC ((float*)(ws + B_HLOC))
#define PCUM ((float*)(ws + B_PCUM))
#define gY ((bf16_t*)(ws + B_Y))
#define gQ ((bf16_t*)(ws + B_Q))
#define gP ((bf16_t*)(ws + B_P))
#define gO ((bf16_t*)(ws + B_O))
#define PS ((bf16_t*)(ws + B_PS))
#define GU ((bf16_t*)(ws + B_GU))
#define GUS ((bf16_t*)(ws + B_GUS))
#define SBG ((float*)(ws + B_SBG))
#define SBU ((float*)(ws + B_SBU))
#define SBL ((float*)(ws + B_SBL))
__device__ __forceinline__ void convert_layer(kptr_t kp, unsigned char* ws, LAS unsigned char* lds, const int l, const int part, const int nparts, const int gw, const int NGW, const int gt, const int NGT, const int lane, const int wave) {
            const size_t wsel = (size_t)(l & 1) * WSEL1, ksel = (size_t)(l & 1) * KSEL1;
            LAS float* scr = (LAS float*)(lds + wave * 16384);
            const float* w_in = INP(I_WIN) + (size_t)l * D * INC; const float* w_out = INP(I_WOUT) + (size_t)l * D * D; const float* w_q = INP(I_WQ) + (size_t)l * D * D;
            const float* w_k = INP(I_WK) + (size_t)l * D * D; const float* w_v = INP(I_WV) + (size_t)l * D * D; const float* w_o = INP(I_WO) + (size_t)l * D * D;
            const float* w_up = INP(I_WUP) + (size_t)l * D * 2 * DFF; const float* w_dn = INP(I_WDN) + (size_t)l * DFF * D; const float* c_v = INP(I_CV) + (size_t)l * BS * NMEM * D;
            constexpr int T_IN = 16 * (INC / 32), T_SQ = 16 * 32, T_UP = 16 * (2 * DFF / 32), T_DN = (DFF / 64) * 32, T_CV = 32 * 32;
            constexpr int T_G = 16;
            constexpr int NIT = T_IN + 5 * T_SQ + T_UP + T_DN + T_CV + 2 * T_G;
            for (int it = (NIT * part) / nparts + gw; it < (NIT * (part + 1)) / nparts; it += NGW) {
                int r = it;
                if (r < T_IN) { transpose_item(w_in, D, INC, WIN_T, scr, r, lane, INP(I_GMIX) + l * D); continue; } r -= T_IN;
                if (r < T_SQ) { transpose_item(w_out, D, D, WOUT_T, scr, r, lane); continue; } r -= T_SQ;
                if (r < T_SQ) { transpose_item(w_q, D, D, WQ_T, scr, r, lane, INP(I_GX) + l * D); continue; } r -= T_SQ;
                if (r < T_SQ) { transpose_item(w_k, D, D, WK_T, scr, r, lane); continue; } r -= T_SQ;
                if (r < T_SQ) { transpose_item(w_v, D, D, WV_T, scr, r, lane); continue; } r -= T_SQ;
                if (r < T_SQ) { transpose_item(w_o, D, D, WO_T, scr, r, lane); continue; } r -= T_SQ;
                if (r < T_UP) { transpose_item(w_up, D, 2 * DFF, WUP_T, scr, r, lane, INP(I_GFFN) + l * D, DFF); continue; } r -= T_UP;
                if (r < T_DN) { transpose_item(w_dn, DFF, D, WDN_T, scr, r, lane); continue; } r -= T_DN;
                if (r < T_CV) { transpose_item(c_v, BS * NMEM, D, VTS, scr, r, lane); continue; } r -= T_CV;
                if (r < T_G) { transpose_item(INP(I_WRG) + ((size_t)l * 8 + (r >> 1)) * 4096, 64, 64, GT_R + (r >> 1) * 4096, scr, r & 1, lane); continue; } r -= T_G;
                transpose_item(INP(I_WIG) + ((size_t)l * 8 + (r >> 1)) * 4096, 64, 64, GT_I + (r >> 1) * 4096, scr, r & 1, lane);
            }
            if (part == 0) {
                const f32x4* ck = (const f32x4*)(INP(I_CK) + (size_t)l * BS * NMEM * D); u32x2* dk = (u32x2*)KBS;
                for (int i = gt; i < BS * NMEM * D / 4; i += NGT) { const f32x4 v = ck[i]; u32x2 w; w.x = pk2(v.x, v.y); w.y = pk2(v.z, v.w); dk[i] = w; }
                if (l == 0) { const f32x4* mm = (const f32x4*)INP(I_MEM); u32x2* dm = (u32x2*)MEMB;
                    for (int i = gt; i < BP * NMEM * D / 4; i += NGT) { const f32x4 v = mm[i]; u32x2 w; w.x = pk2(v.x, v.y); w.y = pk2(v.z, v.w); dm[i] = w; } }
                const float* wsl = INP(I_WS) + (size_t)l * 4 * 128 * 128;
                for (int i = gt; i < 4 * 128 * 128; i += NGT) { const int s = i & 127, t = (i >> 7) & 127; WST[i] = (bf16_t)f2bf(s <= t ? wsl[i] : 0.f); }
            }
}

__global__ void __launch_bounds__(NTHREADS, 2) trunk_fwd(Args args) {
    extern __shared__ __attribute__((aligned(16))) unsigned char lds_raw[];
    LAS unsigned char* lds = (LAS unsigned char*)lds_raw;
    cg::grid_group grid = cg::this_grid();
    const int wave_s = __builtin_amdgcn_readfirstlane(threadIdx.x >> 6);
#define LANE_STATE() int G = gridDim.x, bid = blockIdx.x; asm volatile("" : "+s"(G), "+s"(bid)); const int NGW = G * NWAVES, NGT = G * NTHREADS; (void)NGW; (void)NGT; \
    const int tid = opaque_tid(wave_s), lane = tid & 63, wave = wave_s; const int gw = bid * NWAVES + wave; const int gt = bid * NTHREADS + tid; (void)lane; (void)gw; (void)gt; \
    kptr_t kp = (kptr_t)__builtin_amdgcn_kernarg_segment_ptr(); asm volatile("" : "+s"(kp)); \
    float* const out = *(const __attribute__((address_space(4))) fp_t*)(kp + 8 * N_IN); unsigned char* const ws = *(const __attribute__((address_space(4))) ucp_t*)(kp + 8 * N_IN + 8); (void)out; (void)ws
    {
        LANE_STATE();
        if (bid == 0) for (int i = tid; i < XCD_BAR_WORDS; i += NTHREADS) __hip_atomic_store((unsigned*)(ws + WS_BAR) + i, 0u, __ATOMIC_RELAXED, __HIP_MEMORY_SCOPE_AGENT);
        if (tid < 32) ((LAS unsigned*)(lds + LDS_MISC))[tid] = 0u;
        __threadfence();
        grid.sync();
        if (tid == 0) (void)xb_add((unsigned*)(ws + WS_BAR) + XB_XCNT(xb_xcc_id()), 1u);
    }
#define GRID_SYNC() do { kptr_t kp_ = (kptr_t)__builtin_amdgcn_kernarg_segment_ptr(); asm volatile("" : "+s"(kp_)); \
        XcdBarrier b_; b_.bar = (unsigned*)(*(const __attribute__((address_space(4))) ucp_t*)(kp_ + 8 * N_IN + 8) + WS_BAR); b_.x = xb_xcc_id(); b_.st = (volatile LAS unsigned*)(lds + LDS_MISC); \
        xcd_barrier(b_); if (PROBE == 3) xcd_barrier(b_); } while (0)

    for (int l = 0; l < DEPTH; ++l) {
        const size_t wsel = (size_t)(l & 1) * WSEL1, ksel = (size_t)(l & 1) * KSEL1;
        if (l == 0)
        for (int dup0 = 0; dup0 < ((PROBE == 1 || PROBE == 5) ? 2 : 1); ++dup0) {
        {
            LANE_STATE();
            convert_layer(kp, ws, lds, l, 0, 1, gw, NGW, gt, NGT, lane, wave);
            if (l == 0) first_rows(INP(I_XP), INP(I_XS), XN, SSQ(0), gw, NGW, lane);
        }
        GRID_SYNC();
        }
        {
            LANE_STATE();
            KVSched S; S.G = G; S.c = bid >= 160 ? bid - 160 : -1; S.ws = (const char*)ws; S.wsel = wsel;
            pg8::Gemm g{(const bf16_t*)nullptr, (const bf16_t*)nullptr, D, D, D};
            pg8::EpiKV E{out + O_MKP + (size_t)l * BP * NMEM * D, out + O_MVP + (size_t)l * BP * NMEM * D, KBP, VTP};
            pg8::gemm_phase<pg8::EpiKV, KVSched, true>(lds, g, S, E, wave_s);
        }
#define GEMM_BF16(s_) do { const int s = (s_); pg8::GSched S; pg8::Gemm g; pg8::EpiBf16 E; E.scale = 1.f; E.ss = nullptr; E.smp = 0; \
        if (s == 0) { S.init(MT / 256, INC / 256, G, bid); S.aPm = (size_t)256 * D * 2; S.bPn = (size_t)256 * D * 2; g = pg8::Gemm{XN, WIN_T, D, D, D}; E.O = gZ; E.ldc = INC; E.ss = SSQ(3 * l); } \
        else if (s == 1) { S.init(MP / 256, D / 256, G, bid); S.aPm = (size_t)256 * D * 2; S.bPn = (size_t)256 * D * 2; g = pg8::Gemm{XN, WQ_T, D, D, D}; E.O = gQ; E.ldc = D; E.scale = 0.0625f; E.ss = SSQ(3 * l + 1); } \
        else if (s == 2) { S.init(MP / 256, 4, G, bid); S.aPm = (size_t)256 * D * 2; S.aPn = 512; S.bPn = (size_t)256 * 2048 * 2; S.bPm = 512; S.bShift = 4; g = pg8::Gemm{gP, VTP, D, 2048, 256}; E.O = gO; E.ldc = D; } \
        else { S.init(1, 32, G, (bid + G - 64) % G); S.mode = 2; g = pg8::Gemm{PS, VTS, 8192, 2048, 256}; E.O = gO + (size_t)MP * D; E.ldc = D; E.smp = 1; } \
        pg8::gemm_phase<pg8::EpiBf16, pg8::GSched, true>(lds, g, S, E, wave_s); } while (0)
#define GEMM_RES(s_) do { const int s = (s_); pg8::GSched S; S.init(MP / 256, D / 256, G, bid); pg8::Gemm g; \
        if (s == 0) { g = pg8::Gemm{gY, WOUT_T, D, D, D}; S.aPm = (size_t)256 * D * 2; } \
        else if (s == 1) { g = pg8::Gemm{gO, WO_T, D, D, D}; S.aPm = (size_t)256 * D * 2; } \
        else { g = pg8::Gemm{GU, WDN_T, DFF, DFF, DFF}; S.aPm = (size_t)256 * DFF * 2; } \
        S.bPn = (size_t)256 * g.ldb * 2; \
        pg8::EpiResid E{XN, SSQ(3 * l + 1 + s)}; \
        pg8::gemm_phase<pg8::EpiResid, pg8::GSched, true>(lds, g, S, E, wave_s); } while (0)

        for (int rep = 0; rep < 13; ++rep) { if (rep == 4 || rep == 9 || rep == 11) continue;
          const int ndup = ((PROBE == 1 && (rep == 1 || rep == 2)) || (PROBE == 4 && rep == 1) || (PROBE == 6 && rep == 2)) ? 2 : ((PROBE == 2 && (rep == 0 || rep == 5 || rep == 6 || rep == 7 || rep == 10)) ? 2 : 1);
          for (int dup = 0; dup < ndup; ++dup) {
            if (rep == 0 || rep == 5 || rep == 7) {
                LANE_STATE();
                const int s0 = rep == 0 ? 0 : (rep == 5 ? 1 : 2), ns = rep == 7 ? 2 : 1;
                if (rep == 0 && l > 0) {
                    pg8::GSched S0; S0.init(MT / 256, INC / 256, G, bid); pg8::Unit u0; bool own = false;
                    for (int i = 0; S0.next(i, u0); ++i) own = own || (u0.pm == 128);
                    if (own) sample_ss_reduce(SSS(3 * l), SSQ(3 * l), tid);
                }
                for (int q = 0; q < ns; ++q) GEMM_BF16(s0 + q);
                if (rep == 5) { LANE_STATE(); const SG2 sg{XN + (size_t)MP * D, WQ_T, D, D, D, D, gQ + (size_t)MP * D, D, 0.0625f, 1, nullptr}; sgemm2(lds, sg, bid, G, wave, tid); }
                if (rep == 5 && l + 1 < DEPTH) { LANE_STATE(); if (bid >= 4) convert_layer(kp, ws, lds, l + 1, 1, 3, gw - 4 * NWAVES, NGW - 4 * NWAVES, gt - 4 * NTHREADS, NGT - 4 * NTHREADS, lane, wave); }
            } else if (rep == 10) {
                LANE_STATE();
                pg8::GSched S; S.init(MP / 256, 2 * DFF / 256, G, bid); S.aPm = (size_t)256 * D * 2; S.bPn = (size_t)256 * D * 2;
                const pg8::Gemm g{XN, WUP_T, D, D, D};
                const pg8::EpiAct E{GU, INP(I_SCF) + (size_t)l * BS * 2 * DFF, out + O_CFS + (size_t)l * BS * 2 * DFF, SBG, SBU, SBL, INP(I_CFW) + (size_t)l * 3 * DFF, SSQ(3 * l + 2)};
                pg8::gemm_phase<pg8::EpiAct, pg8::GSched, true>(lds, g, S, E, wave_s);
                { LANE_STATE(); sgemm_act(lds, XN + (size_t)MP * D, WUP_T, GU + (size_t)MP * DFF, INP(I_CFW) + (size_t)l * 3 * DFF, INP(I_SCF) + (size_t)l * BS * 2 * DFF, out + O_CFS + (size_t)l * BS * 2 * DFF, bid, G, wave, tid); }
            } else if (rep == 1) {
                LANE_STATE();
                {
                    LAS bf16_t* vT = (LAS bf16_t*)lds;
                    constexpr int VP = 136;
                    const float* gvp = INP(I_GV) + l * CW; const float* bsp = INP(I_BSS) + l * 4 * 128;
                    for (int un = (bid + G / 2) % G; un < 8 + 256; un += G) {
                        int rowbase, nrows, sb = -1;
                        if (un < 8) { sb = un; rowbase = MP + un * TS; nrows = TS; } else { rowbase = (un - 8) * 128; nrows = 128; }
                        {
                            const int rl = tid >> 5, cgp = tid & 31;
                            f32x4 g0 = *(const f32x4*)(gvp + cgp * 8), g1 = *(const f32x4*)(gvp + cgp * 8 + 4);
                            for (int p = 0; p < nrows / 16; ++p) {
                                const int r = p * 16 + rl;
                                const u32x4 raw = *(const u32x4*)(gZ + (size_t)(rowbase + r) * INC + Z_VC + cgp * 8);
                                float v[8] = {bflo(raw.x), bfhi(raw.x), bflo(raw.y), bfhi(raw.y), bflo(raw.z), bfhi(raw.z), bflo(raw.w), bfhi(raw.w)};
                                float ss = 0.f;
#pragma unroll
                                for (int k = 0; k < 8; ++k) { v[k] = gelu_t(v[k]); ss += v[k] * v[k]; }
                                ss += shx(ss, 1, lane); ss += shx(ss, 2, lane); ss += shx(ss, 4, lane);
                                const float rstd = 1.0f / sqrtf(ss * (1.f / 64.f) + EPS);
                                const float gg[8] = {g0.x, g0.y, g0.z, g0.w, g1.x, g1.y, g1.z, g1.w};
#pragma unroll
                                for (int k = 0; k < 8; ++k) { v[k] = v[k] * rstd * gg[k]; vT[(cgp * 8 + k) * VP + r] = (bf16_t)f2bf(v[k]); }
                                if (sb >= 0) { float* vo = out + O_VCS + ((size_t)(l * BS + sb) * TS + r) * CW + cgp * 8;
                                    *(f32x4*)vo = (f32x4){v[0], v[1], v[2], v[3]}; *(f32x4*)(vo + 4) = (f32x4){v[4], v[5], v[6], v[7]}; }
                            }
                        }
                        __syncthreads();
                        {
                            const int hh = wave & 3, rh = wave >> 2, fr = lane & 15, fq = lane >> 4;
                            const int nmt = nrows == 128 ? 4 : (rh == 0 ? 2 : 0);
                            for (int mi = 0; mi < nmt; ++mi) {
                                const int mt = rh * 4 + mi, nks = (mt * 16 + 15) / 32 + 1;
                                f32x4 acc[4];
#pragma unroll
                                for (int n = 0; n < 4; ++n) acc[n] = (f32x4){0.f, 0.f, 0.f, 0.f};
                                for (int ks = 0; ks < nks; ++ks) {
                                    const bf16x8 a = *(const bf16x8*)(WST + ((size_t)(hh * 128 + mt * 16 + fr) * 128 + ks * 32 + fq * 8));
#pragma unroll
                                    for (int n = 0; n < 4; ++n) { const bf16x8 b = *(const LAS bf16x8*)(vT + (hh * 64 + n * 16 + fr) * VP + ks * 32 + fq * 8);
                                        acc[n] = __builtin_amdgcn_mfma_f32_16x16x32_bf16(b, a, acc[n], 0, 0, 0); }
                                }
                                { const int t = mt * 16 + fr; const float bias = bsp[hh * 128 + t]; const size_t row = (size_t)(rowbase + t);
#pragma unroll
                                    for (int n = 0; n < 4; ++n) { const int c = hh * 64 + n * 16 + fq * 4; const u32x2 uq = *(const u32x2*)(gZ + row * INC + Z_UC + c);
                                        u32x2 w; w.x = pk2(gelu_t(bflo(uq.x)) * (acc[n][0] + bias), gelu_t(bfhi(uq.x)) * (acc[n][1] + bias)); w.y = pk2(gelu_t(bflo(uq.y)) * (acc[n][2] + bias), gelu_t(bfhi(uq.y)) * (acc[n][3] + bias));
                                        *(u32x2*)(gY + row * D + 768 + c) = w; } }
                            }
                        }
                        __syncthreads();
                    }
                }
                {
                    LAS unsigned char* wl = lds + wave * 16384;
                    LAS bf16_t* tile = (LAS bf16_t*)wl;
                    LAS float* pre_r = (LAS float*)(wl + 2560);
                    LAS float* pre_i = (LAS float*)(wl + 2560 + 4096);
                    LAS float* xcf = (LAS float*)(wl + 2560 + 8192);
                    const int fr = lane & 15, fq = lane >> 4;
                    for (int un = gw; un < 64 + 2048; un += NGW) {
                        int b, hd, rowbase, nrows, t0; bool smp = un < 64;
                        if (smp) { b = un >> 3; hd = un & 7; rowbase = MP + b * TS; nrows = TS; t0 = 0; }
                        else { const int v = un - 64; const int ch = v & 31; hd = (v >> 5) & 7; b = v >> 8; t0 = ch * 128; rowbase = b * SEQ + t0; nrows = 128; }
                        const int cidx = l * AW + hd * 64 + lane;
                        const float br = INP(I_BRG)[cidx], bi = INP(I_BIG)[cidx];
                        const float c8sp = 8.0f * log1pf(__expf(-INP(I_LAM)[cidx]));
                        const float* caw = INP(I_CAW) + (size_t)l * 4 * AW + hd * 64 + lane;
                        const float cw0 = caw[0], cw1 = caw[AW], cw2 = caw[2 * AW], cw3 = caw[3 * AW], cb = INP(I_CAB)[cidx];
                        bf16x8 bR[4][2], bI[4][2];
#pragma unroll
                        for (int n = 0; n < 4; ++n)
#pragma unroll
                            for (int ks = 0; ks < 2; ++ks) { const size_t o_ = (size_t)(hd * 64 + n * 16 + fr) * 64 + ks * 32 + fq * 8;
                                bR[n][ks] = *(const bf16x8*)(GT_R + o_); bI[n][ks] = *(const bf16x8*)(GT_I + o_); }
                        float xm3 = 0.f, xm2 = 0.f, xm1 = 0.f;
                        if (smp) { const float* st = INP(I_SCA) + ((size_t)(l * BS + b) * 3) * AW + hd * 64 + lane; xm3 = st[0]; xm2 = st[AW]; xm1 = st[2 * AW]; }
                        else if (t0 > 0) { const bf16_t* zp = gZ + (size_t)(rowbase - 3) * INC + Z_XA + hd * 64 + lane; xm3 = bf2f(zp[0]); xm2 = bf2f(zp[INC]); xm1 = bf2f(zp[2 * INC]); }
                        float h = 0.f, pc = 1.f;
                        const bf16_t* zq = gZ + (size_t)(rowbase + (lane >> 3)) * INC + Z_XA + hd * 64 + (lane & 7) * 8;
                        float* hp = HLOC + (size_t)rowbase * AW + hd * 64 + lane; float* pp = PCUM + (size_t)rowbase * AW + hd * 64 + lane;
                        LAS bf16_t* xraw = (LAS bf16_t*)pre_r;
                        u32x4 xn0 = *(const u32x4*)zq, xn1 = *(const u32x4*)(zq + (size_t)8 * INC);
                        for (int st = 0; st < nrows / 16; ++st) {
                            *(LAS u32x4*)(xraw + (lane >> 3) * 64 + (lane & 7) * 8) = xn0; *(LAS u32x4*)(xraw + ((lane >> 3) + 8) * 64 + (lane & 7) * 8) = xn1;
                            zq += (size_t)16 * INC;
                            if (st + 1 < nrows / 16) { xn0 = *(const u32x4*)zq; xn1 = *(const u32x4*)(zq + (size_t)8 * INC); }
                            LDS_WAIT();
#pragma unroll
                            for (int i = 0; i < 16; ++i) { const float xv = bf2f(xraw[i * 64 + lane]);
                                const float xc = cw0 * xm3 + cw1 * xm2 + cw2 * xm1 + cw3 * xv + cb; xm3 = xm2; xm2 = xm1; xm1 = xv; xcf[i * 64 + lane] = xc; tile[i * 72 + lane] = (bf16_t)f2bf(xc); }
                            LDS_WAIT();
                            const bf16x8 a0 = *(const LAS bf16x8*)(tile + fr * 72 + fq * 8), a1 = *(const LAS bf16x8*)(tile + fr * 72 + 32 + fq * 8);
#pragma unroll
                            for (int n = 0; n < 4; ++n) {
                                f32x4 ar = (f32x4){0.f, 0.f, 0.f, 0.f}, ai = (f32x4){0.f, 0.f, 0.f, 0.f};
                                ar = __builtin_amdgcn_mfma_f32_16x16x32_bf16(a0, bR[n][0], ar, 0, 0, 0); ar = __builtin_amdgcn_mfma_f32_16x16x32_bf16(a1, bR[n][1], ar, 0, 0, 0);
                                ai = __builtin_amdgcn_mfma_f32_16x16x32_bf16(a0, bI[n][0], ai, 0, 0, 0); ai = __builtin_amdgcn_mfma_f32_16x16x32_bf16(a1, bI[n][1], ai, 0, 0, 0);
#pragma unroll
                                for (int j = 0; j < 4; ++j) { pre_r[(fq * 4 + j) * 64 + n * 16 + fr] = ar[j]; pre_i[(fq * 4 + j) * 64 + n * 16 + fr] = ai[j]; }
                            }
                            LDS_WAIT();
#pragma unroll 4
                            for (int i = 0; i < 16; ++i) {
                                const float r = sigm(pre_r[i * 64 + lane] + br), gi = sigm(pre_i[i * 64 + lane] + bi);
                                const float la = -c8sp * r; float a, om;
                                if (la > -0.125f) { const float x = 2.0f * la; om = -x * (1.0f + x * (0.5f + x * (0.16666667f + x * (0.041666668f + x * (0.0083333338f + x * 0.0013888889f))))); a = 1.0f + la * (1.0f + la * (0.5f + la * (0.16666667f + la * (0.041666668f + la * 0.0083333338f)))); }
                                else { a = __expf(la); om = -expm1f(2.0f * la); }
                                const float bm = __builtin_amdgcn_sqrtf(om);
                                h = a * h + bm * gi * xcf[i * 64 + lane]; pc = pc * a;
                                *hp = h; *pp = pc; hp += AW; pp += AW;
                            }
                            LDS_WAIT();
                        }
                        AGG[(size_t)un * 128 + lane] = pc; AGG[(size_t)un * 128 + 64 + lane] = h;
                    }
                }
                {
                    const float* cbw = INP(I_CBW) + (size_t)l * 3 * BW;
                    for (int it = gt; it < (MT / 8) * 32; it += NGT) {
                        const int rb = it >> 5, c0 = (it & 31) * 8;
                        int b, t0, T, rowbase; const bool smp = rb >= MP / 8;
                        if (!smp) { b = rb >> 9; t0 = (rb & 511) * 8; T = SEQ; rowbase = rb * 8; } else { const int sbk = rb - MP / 8; b = sbk >> 2; t0 = (sbk & 3) * 8; T = TS; rowbase = MP + sbk * 8; }
                        u32x4 xq[10], cq[10], bq[8];
                        const bf16_t* zr = gZ + (size_t)rowbase * INC + c0;
#pragma unroll
                        for (int i = 0; i < 10; ++i) { if (i >= 2 || t0 > 0) { xq[i] = *(const u32x4*)(zr + (ptrdiff_t)(i - 2) * INC + Z_XB); cq[i] = *(const u32x4*)(zr + (ptrdiff_t)(i - 2) * INC + Z_GC); } else { xq[i] = (u32x4){0u, 0u, 0u, 0u}; cq[i] = (u32x4){0u, 0u, 0u, 0u}; } }
#pragma unroll
                        for (int i = 0; i < 8; ++i) bq[i] = *(const u32x4*)(zr + (size_t)i * INC + Z_GB);
                        float w0[8], w1[8], w2[8], pm2[8], pm1[8];
#pragma unroll
                        for (int k = 0; k < 8; ++k) { w0[k] = cbw[c0 + k]; w1[k] = cbw[BW + c0 + k]; w2[k] = cbw[2 * BW + c0 + k]; }
                        {
                            const float a_[8] = {bflo(xq[0].x) * bflo(cq[0].x), bfhi(xq[0].x) * bfhi(cq[0].x), bflo(xq[0].y) * bflo(cq[0].y), bfhi(xq[0].y) * bfhi(cq[0].y), bflo(xq[0].z) * bflo(cq[0].z), bfhi(xq[0].z) * bfhi(cq[0].z), bflo(xq[0].w) * bflo(cq[0].w), bfhi(xq[0].w) * bfhi(cq[0].w)};
                            const float b_[8] = {bflo(xq[1].x) * bflo(cq[1].x), bfhi(xq[1].x) * bfhi(cq[1].x), bflo(xq[1].y) * bflo(cq[1].y), bfhi(xq[1].y) * bfhi(cq[1].y), bflo(xq[1].z) * bflo(cq[1].z), bfhi(xq[1].z) * bfhi(cq[1].z), bflo(xq[1].w) * bflo(cq[1].w), bfhi(xq[1].w) * bfhi(cq[1].w)};
#pragma unroll
                            for (int k = 0; k < 8; ++k) { pm2[k] = a_[k]; pm1[k] = b_[k]; }
                        }
                        if (t0 == 0 && smp) { const float* st = INP(I_SCB) + ((size_t)(l * BS + b) * 2) * BW + c0;
#pragma unroll
                            for (int k = 0; k < 8; ++k) { pm2[k] = st[k]; pm1[k] = st[BW + k]; } }
#pragma unroll
                        for (int i = 0; i < 8; ++i) {
                            const u32x4 xb = xq[i + 2], gc = cq[i + 2], gb = bq[i];
                            const float pv[8] = {bflo(xb.x) * bflo(gc.x), bfhi(xb.x) * bfhi(gc.x), bflo(xb.y) * bflo(gc.y), bfhi(xb.y) * bfhi(gc.y), bflo(xb.z) * bflo(gc.z), bfhi(xb.z) * bfhi(gc.z), bflo(xb.w) * bflo(gc.w), bfhi(xb.w) * bfhi(gc.w)};
                            const float gbv[8] = {bflo(gb.x), bfhi(gb.x), bflo(gb.y), bfhi(gb.y), bflo(gb.z), bfhi(gb.z), bflo(gb.w), bfhi(gb.w)};
                            float yv[8];
#pragma unroll
                            for (int k = 0; k < 8; ++k) { yv[k] = gbv[k] * (w0[k] * pm2[k] + w1[k] * pm1[k] + w2[k] * pv[k]); pm2[k] = pm1[k]; pm1[k] = pv[k]; }
                            u32x4 w; w.x = pk2(yv[0], yv[1]); w.y = pk2(yv[2], yv[3]); w.z = pk2(yv[4], yv[5]); w.w = pk2(yv[6], yv[7]);
                            *(u32x4*)(gY + (size_t)(rowbase + i) * D + 512 + c0) = w;
                        }
                        if (t0 + 8 == T) { float* o = out + (smp ? O_CBS : O_CBP) + ((size_t)(l * 8 + b) * 2) * BW + c0;
#pragma unroll
                            for (int k = 0; k < 8; ++k) { o[k] = pm2[k]; o[BW + k] = pm1[k]; } }
                    }
                }
            } else if (rep == 2) {
                LANE_STATE();
                {
                    LAS float* cr = (LAS float*)lds;
                    for (int un = bid; un < 8 + 256; un += G) {
                        int b, ch, rowbase, nrows; const bool smp = un < 8;
                        if (smp) { b = un; ch = 0; rowbase = MP + b * TS; nrows = TS; } else { const int v = un - 8; b = v >> 5; ch = v & 31; rowbase = b * SEQ + ch * 128; nrows = 128; }
                        {
                            const int c = tid, hd = c >> 6, ln = c & 63; float carry = 0.f;
                            if (smp) carry = INP(I_SHA)[(size_t)(l * BS + b) * AW + c];
                            else { const float* ag = AGG + (size_t)(64 + (b << 8) + (hd << 5)) * 128 + ln; for (int k = 0; k < ch; ++k) carry = ag[(size_t)k * 128] * carry + ag[(size_t)k * 128 + 64]; }
                            cr[c] = carry;
                        }
                        __syncthreads();
                        const int c0 = (tid & 63) * 8, rsub = tid >> 6;
                        const f32x4 ca = *(const LAS f32x4*)(cr + c0), cb = *(const LAS f32x4*)(cr + c0 + 4);
                        for (int p = 0; p < nrows / 8; ++p) {
                            const int rloc = p * 8 + rsub; const size_t row = (size_t)(rowbase + rloc);
                            const f32x4 h0 = *(const f32x4*)(HLOC + row * AW + c0), h1 = *(const f32x4*)(HLOC + row * AW + c0 + 4), p0 = *(const f32x4*)(PCUM + row * AW + c0), p1 = *(const f32x4*)(PCUM + row * AW + c0 + 4);
                            const u32x4 gq = *(const u32x4*)(gZ + row * INC + Z_GA + c0);
                            const f32x4 a0 = h0 + p0 * ca, a1 = h1 + p1 * cb;
                            u32x4 w; w.x = pk2(gelu_t(bflo(gq.x)) * a0[0], gelu_t(bfhi(gq.x)) * a0[1]); w.y = pk2(gelu_t(bflo(gq.y)) * a0[2], gelu_t(bfhi(gq.y)) * a0[3]);
                            w.z = pk2(gelu_t(bflo(gq.z)) * a1[0], gelu_t(bfhi(gq.z)) * a1[1]); w.w = pk2(gelu_t(bflo(gq.w)) * a1[2], gelu_t(bfhi(gq.w)) * a1[3]);
                            *(u32x4*)(gY + row * D + c0) = w;
                            if ((smp || ch == 31) && rloc == nrows - 1) { float* o = out + (smp ? O_HAS : O_HAP) + (size_t)(l * 8 + b) * AW + c0; *(f32x4*)o = a0; *(f32x4*)(o + 4) = a1; }
                        }
                        if ((smp || ch == 31) && tid < 192) {
                            const int k = tid >> 6; const u32x4 xq = *(const u32x4*)(gZ + (size_t)(rowbase + nrows - 3 + k) * INC + Z_XA + c0);
                            float* o = out + (smp ? O_CAS : O_CAP) + ((size_t)(l * 8 + b) * 3 + k) * AW + c0;
                            *(f32x4*)o = (f32x4){bflo(xq.x), bfhi(xq.x), bflo(xq.y), bfhi(xq.y)}; *(f32x4*)(o + 4) = (f32x4){bflo(xq.z), bfhi(xq.z), bflo(xq.w), bfhi(xq.w)};
                        }
                        __syncthreads();
                    }
                }
            } else if (rep == 3 || rep == 8 || rep == 12) {
                LANE_STATE();
                if (rep == 12) {
                    const float* cfw = INP(I_CFW) + (size_t)l * 3 * DFF;
                    pg8::GSched S0; S0.init(MP / 256, D / 256, G, bid); pg8::Unit u0;
                    for (int i = 0; S0.next(i, u0); ++i) {
                        const int pm = u0.pm; if (pm >= 128 || tid >= DFF / 8) continue;
                        const int c0 = tid * 8, b = pm >> 4;
                        float w0[8], w1[8], w2[8], p2[8], p1[8], g0[8], g1[8], u0_[8], u1_[8];
#pragma unroll
                        for (int k = 0; k < 8; ++k) { w0[k] = cfw[c0 + k]; w1[k] = cfw[DFF + c0 + k]; w2[k] = cfw[2 * DFF + c0 + k]; p2[k] = 0.f; p1[k] = 0.f; }
                        if ((pm & 15) != 0) {
#pragma unroll
                            for (int k = 0; k < 8; ++k) { p2[k] = SBL[((size_t)(pm - 1) * 2 + 0) * DFF + c0 + k]; p1[k] = SBL[((size_t)(pm - 1) * 2 + 1) * DFF + c0 + k]; } }
#pragma unroll
                        for (int k = 0; k < 8; ++k) { g0[k] = SBG[((size_t)pm * 2 + 0) * DFF + c0 + k]; g1[k] = SBG[((size_t)pm * 2 + 1) * DFF + c0 + k]; u0_[k] = SBU[((size_t)pm * 2 + 0) * DFF + c0 + k]; u1_[k] = SBU[((size_t)pm * 2 + 1) * DFF + c0 + k]; }
                        float ha[8], hb[8];
#pragma unroll
                        for (int k = 0; k < 8; ++k) { ha[k] = silu(w0[k] * p2[k] + w1[k] * p1[k] + w2[k] * g0[k]) * u0_[k]; hb[k] = silu(w0[k] * p1[k] + w1[k] * g0[k] + w2[k] * g1[k]) * u1_[k]; }
                        u32x4 w; w.x = pk2(ha[0], ha[1]); w.y = pk2(ha[2], ha[3]); w.z = pk2(ha[4], ha[5]); w.w = pk2(ha[6], ha[7]);
                        *(u32x4*)(GU + (size_t)(pm * 256) * DFF + c0) = w;
                        w.x = pk2(hb[0], hb[1]); w.y = pk2(hb[2], hb[3]); w.z = pk2(hb[4], hb[5]); w.w = pk2(hb[6], hb[7]);
                        *(u32x4*)(GU + (size_t)(pm * 256 + 1) * DFF + c0) = w;
                        if ((pm & 15) == 15 && u0.pn == 0) { float* o = out + O_CFP + ((size_t)(l * 8 + b) * 2) * DFF + c0;
#pragma unroll
                            for (int k = 0; k < 8; ++k) { o[k] = SBL[((size_t)pm * 2 + 0) * DFF + c0 + k]; o[DFF + k] = SBL[((size_t)pm * 2 + 1) * DFF + c0 + k]; } }
                    }
                    asm volatile("s_waitcnt vmcnt(0)" ::: "memory"); __syncthreads();
                }
                GEMM_RES(rep == 3 ? 0 : (rep == 8 ? 1 : 2));
                { LANE_STATE();
                  const SG2 sg{rep == 12 ? GU + (size_t)MP * DFF : (rep == 3 ? gY : gO) + (size_t)MP * D, rep == 12 ? WDN_T : (rep == 3 ? WOUT_T : WO_T), rep == 12 ? DFF : D, rep == 12 ? DFF : D, rep == 12 ? DFF : D, D, XN + (size_t)MP * D, D, 1.f, 2, SSS(3 * l + (rep == 3 ? 1 : (rep == 8 ? 2 : 3)))};
                  sgemm2(lds, sg, bid, G, wave, tid); }
                if (rep != 12 && l + 1 < DEPTH) { LANE_STATE(); if (bid >= 4) convert_layer(kp, ws, lds, l + 1, rep == 3 ? 0 : 2, 3, gw - 4 * NWAVES, NGW - 4 * NWAVES, gt - 4 * NTHREADS, NGT - 4 * NTHREADS, lane, wave); }
            } else if (rep == 6) {
                LANE_STATE();
                for (int sub = 0; sub < 2; ++sub) {
                    pg8::GSched S; pg8::Gemm g; pg8::EpiSoftmax E;
                    if (sub == 0) { S.init(MP / 256, 4, G, bid); S.aPm = (size_t)256 * D * 2; S.aPn = 512; S.bPn = 512; S.bPm = (size_t)256 * D * 2; S.bShift = 4; g = pg8::Gemm{gQ, KBP, D, D, 256}; E.O = gP; E.ldc = D; E.smp = 0; }
                    else { S.init(1, 32, G, (bid + G - 64) % G); S.mode = 1; g = pg8::Gemm{gQ + (size_t)MP * D, KBS, D, D, 256}; E.O = PS; E.ldc = 8192; E.smp = 1; }
                    pg8::gemm_phase<pg8::EpiSoftmax, pg8::GSched, true>(lds, g, S, E, wave_s);
                }
            }
            GRID_SYNC();
          }
        }
    }
    {
        LANE_STATE();
        const float* gain = INP(I_GFIN);
        f32x4 gv[4];
#pragma unroll
        for (int j = 0; j < 4; ++j) gv[j] = ((const f32x4*)gain)[lane + 64 * j];
        for (int m0 = gw; m0 < MT; m0 += 2 * NGW) {
            const int m1 = m0 + NGW; const bool two = m1 < MT; const int mb = two ? m1 : m0;
            const u32x2* xa = (const u32x2*)(XN + (size_t)m0 * D) + lane; const u32x2* xb = (const u32x2*)(XN + (size_t)mb * D) + lane;
            u32x2 pa[4], pb[4];
#pragma unroll
            for (int j = 0; j < 4; ++j) { pa[j] = xa[64 * j]; pb[j] = xb[64 * j]; }
            float ra, rb;
            { float qa = 0.f, qb = 0.f;
#pragma unroll
              for (int j = 0; j < 4; ++j) { const float a0 = bflo(pa[j].x), a1 = bfhi(pa[j].x), a2 = bflo(pa[j].y), a3 = bfhi(pa[j].y), b0 = bflo(pb[j].x), b1 = bfhi(pb[j].x), b2 = bflo(pb[j].y), b3 = bfhi(pb[j].y);
                  qa += (a0 * a0 + a1 * a1) + (a2 * a2 + a3 * a3); qb += (b0 * b0 + b1 * b1) + (b2 * b2 + b3 * b3); }
              if (m0 < MP) ra = ss_rstd(*(const f32x4*)(SSQ(6) + (size_t)m0 * 4)); else ra = 1.0f / sqrtf(wave_sum(qa, lane) * (1.f / D) + EPS);
              if (mb < MP) rb = ss_rstd(*(const f32x4*)(SSQ(6) + (size_t)mb * 4)); else rb = 1.0f / sqrtf(wave_sum(qb, lane) * (1.f / D) + EPS); }
            f32x4* ya = (f32x4*)(out + (size_t)m0 * D) + lane; f32x4* yb = (f32x4*)(out + (size_t)mb * D) + lane;
#pragma unroll
            for (int j = 0; j < 4; ++j) { ya[64 * j] = (f32x4){bflo(pa[j].x), bfhi(pa[j].x), bflo(pa[j].y), bfhi(pa[j].y)} * ra * gv[j]; if (two) yb[64 * j] = (f32x4){bflo(pb[j].x), bfhi(pb[j].x), bflo(pb[j].y), bfhi(pb[j].y)} * rb * gv[j]; }
        }
    }
}

extern "C" void kernel_launch(void* const* d_in, const int* in_sizes, int n_in, void* d_out, int out_size, void* d_ws, size_t ws_size, hipStream_t stream) {
    static int grid = 0;
    if (grid == 0) {
        if (n_in != N_IN || (size_t)out_size != O_END || ws_size < WS_END) { fprintf(stderr, "kernel_launch: unexpected sizes n_in %d out %d ws %zu (need %zu)\n", n_in, out_size, ws_size, (size_t)WS_END); grid = -1; return; }
        int dev = 0, cus = 0, per_cu = 0;
        (void)hipGetDevice(&dev); (void)hipDeviceGetAttribute(&cus, hipDeviceAttributeMultiprocessorCount, dev);
        if (hipFuncSetAttribute((const void*)trunk_fwd, hipFuncAttributeMaxDynamicSharedMemorySize, LDS_BYTES) != hipSuccess) { fprintf(stderr, "kernel_launch: hipFuncSetAttribute failed\n"); grid = -1; return; }
        if (hipOccupancyMaxActiveBlocksPerMultiprocessor(&per_cu, (const void*)trunk_fwd, NTHREADS, LDS_BYTES) != hipSuccess || per_cu < 1) { fprintf(stderr, "kernel_launch: occupancy query gave %d\n", per_cu); per_cu = 1; }
        (void)hipGetLastError();
        grid = cus * 1;
        if (grid != 256) fprintf(stderr, "kernel_launch: note: %d CUs\n", grid);
    }
    if (grid < 0) return;
    Args a{};
    for (int i = 0; i < N_IN; ++i) a.in[i] = (const float*)d_in[i];
    a.out = (float*)d_out; a.ws = (unsigned char*)d_ws;
    void* kargs[] = {&a};
    hipError_t e = hipLaunchCooperativeKernel((const void*)trunk_fwd, dim3(grid), dim3(NTHREADS), kargs, LDS_BYTES, stream);
    if (e != hipSuccess) fprintf(stderr, "kernel_launch: cooperative launch failed: %s (grid %d)\n", hipGetErrorString(e), grid);
}
```

```cpp
#include <hip/hip_runtime.h>
#include <hip/hip_cooperative_groups.h>
#include <cstdio>
#include <cstdint>
namespace cg = cooperative_groups;
#ifndef PROBE
#define PROBE 0
#endif

#define LAS __attribute__((address_space(3)))
typedef unsigned short bf16_t;
typedef short bf16x8 __attribute__((ext_vector_type(8)));
typedef float f32x4 __attribute__((ext_vector_type(4)));
typedef float f32x2 __attribute__((ext_vector_type(2)));
typedef unsigned u32x4 __attribute__((ext_vector_type(4)));
typedef unsigned u32x2 __attribute__((ext_vector_type(2)));

constexpr int D = 1024, BP = 8, SEQ = 4096, BS = 8, TS = 32, DEPTH = 2;
constexpr int MP = BP * SEQ, MS = BS * TS, MT = MP + MS;
constexpr int INC = 2304, DFF = 2816, NMEM = 256, AW = 512, BW = 256, CW = 256;
constexpr int Z_XA = 0, Z_GA = 512, Z_XB = 1024, Z_GB = 1280, Z_GC = 1536, Z_UC = 1792, Z_VC = 2048;
constexpr float EPS = 1e-6f;
constexpr int NWAVES = 8, NTHREADS = 512;

constexpr size_t O_YP = 0, O_YS = O_YP + (size_t)MP * D, O_CAP = O_YS + (size_t)MS * D, O_HAP = O_CAP + DEPTH * BP * 3 * AW,
                 O_CBP = O_HAP + DEPTH * BP * AW, O_CFP = O_CBP + DEPTH * BP * 2 * BW, O_MKP = O_CFP + DEPTH * BP * 2 * DFF,
                 O_MVP = O_MKP + (size_t)DEPTH * BP * NMEM * D, O_CAS = O_MVP + (size_t)DEPTH * BP * NMEM * D, O_HAS = O_CAS + DEPTH * BS * 3 * AW,
                 O_CBS = O_HAS + DEPTH * BS * AW, O_CFS = O_CBS + DEPTH * BS * 2 * BW, O_VCS = O_CFS + DEPTH * BS * 2 * DFF,
                 O_END = O_VCS + DEPTH * BS * TS * CW;

constexpr size_t MiB = 1u << 20;
constexpr size_t WS_WIN = 0, WS_WOUT = 5 * MiB, WS_WQ = 7 * MiB, WS_WK = 9 * MiB, WS_WV = 11 * MiB, WS_WO = 13 * MiB, WS_WUP = 15 * MiB, WS_WDN = 26 * MiB;
constexpr size_t WS_MEMB = 32 * MiB, WS_KBP = 36 * MiB, WS_VTP = 40 * MiB, WS_KBS = 44 * MiB, WS_VTS = 48 * MiB, WS_WST = 52 * MiB, WS_GT = WS_WST + 131072, WS_AGG = 53 * MiB, WS_SS = 54 * MiB + 256 * 1024, WS_BAR = 55 * MiB + 512 * 1024;
constexpr size_t WS_XN = 56 * MiB, WS_BIG = 121 * MiB;
constexpr size_t B_Z = WS_BIG, B_HLOC = WS_BIG + 146 * MiB, B_PCUM = WS_BIG + 211 * MiB, B_Y = WS_BIG + 276 * MiB;
constexpr size_t B_Q = WS_BIG, B_P = WS_BIG + 65 * MiB, B_O = WS_BIG + 130 * MiB, B_PS = WS_BIG + 195 * MiB;
constexpr size_t B_GU = WS_BIG;
constexpr size_t B_GUS = WS_BIG + 200 * MiB;
constexpr size_t B_SBG = WS_BIG + 204 * MiB, B_SBU = WS_BIG + 207 * MiB, B_SBL = WS_BIG + 210 * MiB;
constexpr size_t WS_END = WS_BIG + (size_t)MT * 2 * DFF * 2;
constexpr size_t WS_SSP = 476 * MiB;
static_assert(WS_END <= WS_SSP && WS_SSP + (size_t)7 * MT * 64 <= 512 * MiB, "workspace");
static_assert(WS_XN + (size_t)MT * D * 2 <= WS_BIG, "xn");
constexpr size_t WS_SSS = WS_SSP + (((size_t)7 * MT * 16 + 4095) / 4096) * 4096;
static_assert(WS_SSS + 7 * 256 * 32 * 4 <= 480 * MiB, "sss");
constexpr size_t WSEL1 = 480 * MiB, KSEL1 = 418 * MiB;
static_assert(WS_WDN + (size_t)D * DFF * 2 + WSEL1 <= 512 * MiB && WS_KBS + KSEL1 >= WS_BIG + 341 * MiB && WS_GT + 131072 + KSEL1 <= WS_SSP, "second buffer set");

constexpr int LDS_RING = 131072, LDS_EX = LDS_RING, LDS_MISC = LDS_EX + 8192, LDS_BYTES = 147456;

enum { I_XP = 0, I_XS, I_MEM, I_CK, I_CV, I_SCA, I_SHA, I_SCB, I_SCF, I_GMIX, I_WIN, I_CAW, I_CAB, I_WRG, I_BRG, I_WIG, I_BIG, I_LAM, I_CBW, I_GV, I_WS, I_BSS,
       I_WOUT, I_GX, I_WQ, I_WK, I_WV, I_WO, I_GFFN, I_WUP, I_CFW, I_WDN, I_GFIN, N_IN };

struct Args { const float* in[N_IN]; float* out; unsigned char* ws; };

__device__ __forceinline__ unsigned pk2(float lo, float hi) { unsigned r; asm("v_cvt_pk_bf16_f32 %0, %1, %2" : "=v"(r) : "v"(lo), "v"(hi)); return r; }
__device__ __forceinline__ unsigned f2bf(float f) { return pk2(f, f) & 0xffffu; }
__device__ __forceinline__ float bf2f(unsigned v) { return __builtin_bit_cast(float, v << 16); }
__device__ __forceinline__ float bflo(unsigned w) { return __builtin_bit_cast(float, w << 16); }
__device__ __forceinline__ float bfhi(unsigned w) { return __builtin_bit_cast(float, w & 0xffff0000u); }
__device__ __forceinline__ unsigned cvt_pk_bf16(float lo, float hi) { unsigned r; asm volatile("v_cvt_pk_bf16_f32 %0, %1, %2" : "=v"(r) : "v"(lo), "v"(hi)); return r; }
__device__ __forceinline__ float fexp(float x) { return __builtin_amdgcn_exp2f(x * 1.4426950408889634f); }
__device__ __forceinline__ float sigm(float x) { return __builtin_amdgcn_rcpf(1.0f + fexp(-x)); }
__device__ __forceinline__ float gelu_t(float x) { const float u = 0.7978845608028654f * (x + 0.044715f * x * x * x); return x * sigm(2.0f * u); }
__device__ __forceinline__ float silu(float x) { return x * sigm(x); }
__device__ __forceinline__ float shx(float v, int m, int lane) { return __builtin_bit_cast(float, __builtin_amdgcn_ds_bpermute((lane ^ m) << 2, __builtin_bit_cast(int, v))); }
__device__ __forceinline__ float wave_sum(float v, int lane) {
#pragma unroll
    for (int o = 1; o < 64; o <<= 1) v += shx(v, o, lane);
    return v;
}
#define LDS_WAIT() asm volatile("s_waitcnt lgkmcnt(0)" ::: "memory")
__device__ __forceinline__ float ss_rstd(f32x4 p) { return 1.0f / sqrtf(((p[0] + p[1]) + (p[2] + p[3])) * (1.f / 1024.f) + 1e-6f); }
__device__ __forceinline__ int opaque_tid(int wave_s) { int l; asm volatile("v_mbcnt_lo_u32_b32 %0, -1, 0\n\tv_mbcnt_hi_u32_b32 %0, -1, %0" : "=v"(l)); return wave_s * 64 + l; }

namespace pg8 {
constexpr int BM = 256, BK = 64, HALF = 128, HTB = HALF * BK * 2, NXCD = 8, WGM = 8;
__device__ __forceinline__ int lds_byte(int r, int c) { const int st = (r >> 4) * 2 + (c >> 5), rr = r & 15, cc = c & 31, ob = rr * 64 + cc * 2; return st * 1024 + (ob ^ (((ob >> 9) & 1) << 5)); }
__device__ __forceinline__ void stage_rc(int b, int& R, int& C) { const int st = b / 1024, sb = b % 1024, swz = sb ^ (((sb >> 9) & 1) << 5); R = (st >> 1) * 16 + swz / 64; C = (st & 1) * 32 + (swz % 64) / 2; }
__device__ __forceinline__ int perm32(int rho) { const int n = rho >> 4, i = rho & 15; return 8 * (i >> 2) + 4 * n + (i & 3); }

struct Unit { int pm, pn; };
struct Gemm { const bf16_t* A; const bf16_t* Bt; int lda, ldb, K; };

struct GSched {
    int nM, nN, nwg, G, c, mode;
    size_t aPm, aPn, bPn, bPm; int bShift;
    __device__ __forceinline__ void init(int nM_, int nN_, int G_, int c_) { nM = nM_; nN = nN_; nwg = nM * nN; G = G_; c = c_; mode = 0; aPm = 0; aPn = 0; bPn = 0; bPm = 0; bShift = 0; }
    __device__ __forceinline__ bool next(int i, Unit& u) const {
        const long L = (long)i * G + c; if (L >= nwg) return false;
        int wgid = (int)L; { const int q = nwg / NXCD, r = nwg % NXCD, xcd = wgid % NXCD, off = wgid / NXCD; wgid = (xcd < r ? xcd * (q + 1) : r * (q + 1) + (xcd - r) * q) + off; }
        const int nig = WGM * nN, gid = wgid / nig, fm = gid * WGM, gsz = (nM - fm) < WGM ? (nM - fm) : WGM;
        u.pm = fm + ((wgid % nig) % gsz); u.pn = (wgid % nig) / gsz; return true;
    }
    __device__ __forceinline__ size_t offA(const Unit& u) const { return mode == 1 ? (size_t)(u.pn & 3) * 512 : (mode == 2 ? (size_t)(u.pn & 3) * 4096 + (size_t)(u.pn >> 2) * 512 : (size_t)u.pm * aPm + (size_t)u.pn * aPn); }
    __device__ __forceinline__ size_t offB(const Unit& u) const { return mode == 1 ? (size_t)(u.pn >> 2) * (256 * 1024 * 2) + (size_t)(u.pn & 3) * 512 : (mode == 2 ? (size_t)(u.pn & 3) * (256 * 2048 * 2) + (size_t)(u.pn >> 2) * 512 : (size_t)u.pn * bPn + (size_t)(u.pm >> bShift) * bPm); }
};

struct EpiBf16 {
    static constexpr bool PERM = true;
    bf16_t* O; int ldc; float scale; const float* ss; int smp;
    __device__ __forceinline__ void operator()(f32x4 (&acc)[2][2][4][2], const Unit& u, int wr, int wc, int fr, int fq, LAS unsigned char*) const {
        asm volatile("" : "+v"(fr), "+v"(fq)); asm volatile("" : "+s"(wr), "+s"(wc));
        const int row0 = u.pm * BM + wr * 64 + fr, col0 = (smp ? (u.pn & 3) : u.pn) * BM + wc * 32 + 8 * fq;
        f32x4 rs[2][4];
#pragma unroll
        for (int ai = 0; ai < 2; ++ai)
#pragma unroll
            for (int m = 0; m < 4; ++m) rs[ai][m] = ss ? *(const f32x4*)(ss + (size_t)(row0 + ai * HALF + m * 16) * 4) : (f32x4){0.f, 0.f, 0.f, 0.f};
#pragma unroll
        for (int ai = 0; ai < 2; ++ai)
#pragma unroll
            for (int m = 0; m < 4; ++m) { bf16_t* rowp = O + (size_t)(row0 + ai * HALF + m * 16) * ldc + col0;
                float sc = scale; if (ss) sc *= ss_rstd(rs[ai][m]);
                if (smp && ((ai * HALF + wr * 64 + m * 16 + fr) >> 5) != (u.pn >> 2)) continue;
#pragma unroll
                for (int bj = 0; bj < 2; ++bj) { const f32x4 v0 = acc[ai][bj][m][0] * sc, v1 = acc[ai][bj][m][1] * sc;
                    u32x4 w; w.x = cvt_pk_bf16(v0[0], v0[1]); w.y = cvt_pk_bf16(v0[2], v0[3]); w.z = cvt_pk_bf16(v1[0], v1[1]); w.w = cvt_pk_bf16(v1[2], v1[3]);
                    *(u32x4*)(rowp + bj * HALF) = w; } }
    }
};
struct EpiResid {
    static constexpr bool PERM = true;
    bf16_t* xb; float* ss;
    __device__ __forceinline__ void operator()(f32x4 (&acc)[2][2][4][2], const Unit& u, int wr, int wc, int fr, int fq, LAS unsigned char* lds) const {
        asm volatile("" : "+v"(fr), "+v"(fq)); asm volatile("" : "+s"(wr), "+s"(wc));
        const int col0 = u.pn * BM + wc * 32 + 8 * fq, lane = fq * 16 + fr;
        LAS float* PS = (LAS float*)(lds + LDS_EX);
        bf16_t* ob = xb + (size_t)u.pm * BM * D;
#pragma unroll
        for (int ai = 0; ai < 2; ++ai) {
            u32x4 pre[4][2];
#pragma unroll
            for (int m = 0; m < 4; ++m)
#pragma unroll
                for (int bj = 0; bj < 2; ++bj) pre[m][bj] = *(const u32x4*)(ob + (size_t)(ai * HALF + wr * 64 + m * 16 + fr) * D + col0 + bj * HALF);
            asm volatile("" ::: "memory");
#pragma unroll
            for (int m = 0; m < 4; ++m) { const int rl = ai * HALF + wr * 64 + m * 16 + fr; const size_t off = (size_t)rl * D + col0; float q = 0.f;
#pragma unroll
                for (int bj = 0; bj < 2; ++bj) { const u32x4 p = pre[m][bj]; const f32x4 a0 = acc[ai][bj][m][0], a1 = acc[ai][bj][m][1];
                    const float v0 = bflo(p.x) + a0[0], v1 = bfhi(p.x) + a0[1], v2 = bflo(p.y) + a0[2], v3 = bfhi(p.y) + a0[3], v4 = bflo(p.z) + a1[0], v5 = bfhi(p.z) + a1[1], v6 = bflo(p.w) + a1[2], v7 = bfhi(p.w) + a1[3];
                    u32x4 w; w.x = cvt_pk_bf16(v0, v1); w.y = cvt_pk_bf16(v2, v3); w.z = cvt_pk_bf16(v4, v5); w.w = cvt_pk_bf16(v6, v7); *(u32x4*)(ob + off + bj * HALF) = w;
                    q += ((v0 * v0 + v1 * v1) + (v2 * v2 + v3 * v3)) + ((v4 * v4 + v5 * v5) + (v6 * v6 + v7 * v7)); }
                q += shx(q, 16, lane); q += shx(q, 32, lane);
                if (fq == 0) PS[rl * 4 + wc] = q; }
            asm volatile("" ::: "memory");
        }
        asm volatile("s_waitcnt lgkmcnt(0)" ::: "memory"); __builtin_amdgcn_s_barrier(); asm volatile("" ::: "memory");
        { const int t = (wr * 4 + wc) * 64 + lane; if (t < 256) { const f32x4 p = *(const LAS f32x4*)(PS + t * 4); ss[(size_t)(u.pm * BM + t) * 4 + u.pn] = (p[0] + p[1]) + (p[2] + p[3]); } }
    }
};
struct EpiKV {
    static constexpr bool PERM = false;
    float* outK; float* outV; bf16_t* KB; bf16_t* VT;
    __device__ __forceinline__ void operator()(f32x4 (&acc)[2][2][4][2], const Unit& u, int wr, int wc, int fr, int fq, LAS unsigned char*) const {
        asm volatile("" : "+v"(fr), "+v"(fq)); asm volatile("" : "+s"(wr), "+s"(wc));
        const int kind = u.pm >> 4, pm = u.pm & 15;
        const int col0 = u.pn * BM + wc * 32 + 4 * fq;
        float* of = kind == 0 ? outK : outV; bf16_t* ob = kind == 0 ? KB : VT; const int ldb_ = kind == 2 ? 2048 : 1024;
#pragma unroll
        for (int ai = 0; ai < 2; ++ai)
#pragma unroll
            for (int m = 0; m < 4; ++m) { const int row = pm * BM + ai * HALF + wr * 64 + m * 16 + fr;
#pragma unroll
                for (int bj = 0; bj < 2; ++bj)
#pragma unroll
                    for (int n = 0; n < 2; ++n) { const f32x4 v = acc[ai][bj][m][n]; const int col = col0 + bj * HALF + n * 16;
                        if (kind != 2) *(f32x4*)(of + (size_t)row * 1024 + col) = v;
                        if (kind != 1) { u32x2 w; w.x = cvt_pk_bf16(v[0], v[1]); w.y = cvt_pk_bf16(v[2], v[3]); *(u32x2*)(ob + (size_t)row * ldb_ + col) = w; } } }
    }
};
struct EpiSoftmax {
    static constexpr bool PERM = true;
    bf16_t* O; int ldc; int smp;
    __device__ __forceinline__ void operator()(f32x4 (&acc)[2][2][4][2], const Unit& u, int wr, int wc, int fr, int fq, LAS unsigned char* lds) const {
        asm volatile("" : "+v"(fr), "+v"(fq)); asm volatile("" : "+s"(wr), "+s"(wc));
        LAS f32x2* EX = (LAS f32x2*)(lds + LDS_EX);
        const int lane = fq * 16 + fr;
        const float L2E = 1.4426950408889634f;
#pragma unroll
        for (int ai = 0; ai < 2; ++ai)
#pragma unroll
            for (int m = 0; m < 4; ++m) {
                float mx = -3.0e38f;
#pragma unroll
                for (int bj = 0; bj < 2; ++bj)
#pragma unroll
                    for (int n = 0; n < 2; ++n) { const f32x4 x = acc[ai][bj][m][n]; mx = fmaxf(mx, fmaxf(fmaxf(x[0], x[1]), fmaxf(x[2], x[3]))); }
                mx = fmaxf(mx, shx(mx, 16, lane)); mx = fmaxf(mx, shx(mx, 32, lane));
                float s = 0.f;
#pragma unroll
                for (int bj = 0; bj < 2; ++bj)
#pragma unroll
                    for (int n = 0; n < 2; ++n) { f32x4 x = acc[ai][bj][m][n];
#pragma unroll
                        for (int j = 0; j < 4; ++j) { x[j] = __builtin_amdgcn_exp2f((x[j] - mx) * L2E); s += x[j]; }
                        acc[ai][bj][m][n] = x; }
                s += shx(s, 16, lane); s += shx(s, 32, lane);
                if (fq == 0) EX[(ai * HALF + wr * 64 + m * 16 + fr) * 4 + wc] = (f32x2){mx, s};
            }
        asm volatile("s_waitcnt lgkmcnt(0)" ::: "memory"); __builtin_amdgcn_s_barrier(); asm volatile("" ::: "memory");
        int colb = u.pn * BM, j_ = 0;
        if (smp) { colb = (u.pn & 3) * 2048 + (u.pn >> 2) * 256; j_ = u.pn >> 2; }
        const int col0 = colb + wc * 32 + 8 * fq;
#pragma unroll
        for (int ai = 0; ai < 2; ++ai)
#pragma unroll
            for (int m = 0; m < 4; ++m) {
                const int rl = ai * HALF + wr * 64 + m * 16 + fr;
                const f32x2 e0 = EX[rl * 4 + 0], e1 = EX[rl * 4 + 1], e2 = EX[rl * 4 + 2], e3 = EX[rl * 4 + 3];
                const float M = fmaxf(fmaxf(e0.x, e1.x), fmaxf(e2.x, e3.x));
                const float tot = e0.y * __builtin_amdgcn_exp2f((e0.x - M) * L2E) + e1.y * __builtin_amdgcn_exp2f((e1.x - M) * L2E) + e2.y * __builtin_amdgcn_exp2f((e2.x - M) * L2E) + e3.y * __builtin_amdgcn_exp2f((e3.x - M) * L2E);
                const float own = wc == 0 ? e0.x : (wc == 1 ? e1.x : (wc == 2 ? e2.x : e3.x));
                float f = __builtin_amdgcn_exp2f((own - M) * L2E) / tot;
                if (smp && (rl >> 5) != j_) f = 0.f;
                bf16_t* rowp = O + (size_t)(u.pm * BM + rl) * ldc + col0;
#pragma unroll
                for (int bj = 0; bj < 2; ++bj) { const f32x4 v0 = acc[ai][bj][m][0] * f, v1 = acc[ai][bj][m][1] * f;
                    u32x4 w; w.x = cvt_pk_bf16(v0[0], v0[1]); w.y = cvt_pk_bf16(v0[2], v0[3]); w.z = cvt_pk_bf16(v1[0], v1[1]); w.w = cvt_pk_bf16(v1[2], v1[3]);
                    *(u32x4*)(rowp + bj * HALF) = w; } }
    }
};


__device__ __forceinline__ float dpp_ror1(float v) { return __builtin_bit_cast(float, __builtin_amdgcn_update_dpp(0, __builtin_bit_cast(int, v), 0x121, 0xf, 0xf, false)); }
__device__ __forceinline__ float dpp_ror2(float v) { return __builtin_bit_cast(float, __builtin_amdgcn_update_dpp(0, __builtin_bit_cast(int, v), 0x122, 0xf, 0xf, false)); }
struct EpiAct {
    static constexpr bool PERM = true;
    bf16_t* H; const float* scf; float* ocf; float* sbg; float* sbu; float* sbl; const float* cfw; const float* ss;
    __device__ __forceinline__ void operator()(f32x4 (&acc)[2][2][4][2], const Unit& u, int wr, int wc, int fr, int fq, LAS unsigned char* lds) const {
        asm volatile("" : "+s"(wr), "+s"(wc));
        int lane; asm volatile("v_mbcnt_lo_u32_b32 %0, -1, 0\n\tv_mbcnt_hi_u32_b32 %0, -1, %0" : "=v"(lane));
        fr = lane & 15; fq = lane >> 4;
        const int fl = wc * 32 + 8 * fq, f0 = u.pn * 128 + fl; int rowt = wr * 64 + fr;
        {
            float rst[2][4];
            f32x4 rsl[2][4];
#pragma unroll
            for (int ai = 0; ai < 2; ++ai)
#pragma unroll
                for (int m = 0; m < 4; ++m) rsl[ai][m] = *(const f32x4*)(ss + (size_t)(u.pm * BM + ai * HALF + rowt + m * 16) * 4);
#pragma unroll
            for (int ai = 0; ai < 2; ++ai)
#pragma unroll
                for (int m = 0; m < 4; ++m) { rst[ai][m] = ss_rstd(rsl[ai][m]); }
#pragma unroll
            for (int ai = 0; ai < 2; ++ai)
#pragma unroll
                for (int m = 0; m < 4; ++m) { acc[ai][0][m][0] = acc[ai][0][m][0] * rst[ai][m]; acc[ai][0][m][1] = acc[ai][0][m][1] * rst[ai][m]; acc[ai][1][m][0] = acc[ai][1][m][0] * rst[ai][m]; acc[ai][1][m][1] = acc[ai][1][m][1] * rst[ai][m]; }
        }
        const bool smp = (u.pm == 128);
        asm volatile("" : "+v"(rowt));
        LAS float* BND = (LAS float*)(lds + LDS_EX);
        if (fr >= 14) {
#pragma unroll
            for (int ai = 0; ai < 2; ++ai)
#pragma unroll
                for (int n = 0; n < 2; ++n) *(LAS f32x4*)(BND + ((ai * 2 + wr) * 2 + (fr - 14)) * 128 + fl + 4 * n) = acc[ai][0][3][n];
            if (wr == 1) {
#pragma unroll
                for (int n = 0; n < 2; ++n) *(f32x4*)(sbl + ((size_t)u.pm * 2 + (fr - 14)) * DFF + f0 + 4 * n) = acc[1][0][3][n];
            }
        }
        asm volatile("s_waitcnt lgkmcnt(0)" ::: "memory"); __builtin_amdgcn_s_barrier(); asm volatile("" ::: "memory");
#pragma unroll
        for (int ai = 0; ai < 2; ++ai) {
            const int pg = wr == 1 ? ai * 2 : 1;
            u32x2 hp[2][4];
#pragma unroll
            for (int n = 0; n < 2; ++n) {
                const f32x4 w0 = *(const f32x4*)(cfw + f0 + 4 * n), w1 = *(const f32x4*)(cfw + DFF + f0 + 4 * n), w2 = *(const f32x4*)(cfw + 2 * DFF + f0 + 4 * n);
                f32x4 h2 = *(const LAS f32x4*)(BND + (pg * 2 + 0) * 128 + fl + 4 * n), h1 = *(const LAS f32x4*)(BND + (pg * 2 + 1) * 128 + fl + 4 * n);
                f32x4 t2 = h2, t1 = h1;
                if (smp) { const float* sp = scf + (size_t)((ai * 4 + wr * 2) * 2) * DFF + f0 + 4 * n; h2 = *(const f32x4*)sp; h1 = *(const f32x4*)(sp + DFF); t2 = *(const f32x4*)(sp + 2 * DFF); t1 = *(const f32x4*)(sp + 3 * DFF); }
#pragma unroll
                for (int jp = 0; jp < 2; ++jp) {
                    float hv[4][2];
#pragma unroll
                    for (int jj = 0; jj < 2; ++jj) { const int j = jp * 2 + jj;
                        float r1p = h1[j], r2p = fr == 0 ? h2[j] : h1[j];
#pragma unroll
                        for (int m = 0; m < 4; ++m) { const float g = acc[ai][0][m][n][j];
                            if (m == 2 && smp) { r1p = t1[j]; r2p = fr == 0 ? t2[j] : t1[j]; }
                            const float r1 = dpp_ror1(g), r2 = dpp_ror2(g);
                            const float gm1 = fr >= 1 ? r1 : r1p, gm2 = fr >= 2 ? r2 : r2p;
                            r1p = r1; r2p = r2;
                            const float cv = w0[j] * gm2 + w1[j] * gm1 + w2[j] * g;
                            hv[m][jj] = silu(cv) * acc[ai][1][m][n][j]; } }
#pragma unroll
                    for (int m = 0; m < 4; ++m) { const unsigned pk = cvt_pk_bf16(hv[m][0], hv[m][1]); if (jp == 0) hp[n][m].x = pk; else hp[n][m].y = pk; }
                }
            }
#pragma unroll
            for (int m = 0; m < 4; ++m) {
                const int rl = ai * HALF + rowt + m * 16;
                if (smp && (m & 1) && fr >= 14) {
#pragma unroll
                    for (int n = 0; n < 2; ++n) *(f32x4*)(ocf + ((size_t)(ai * 4 + wr * 2 + (m >> 1)) * 2 + (fr - 14)) * DFF + f0 + 4 * n) = acc[ai][0][m][n];
                }
                if (!smp && ai == 0 && m == 0 && wr == 0 && fr < 2) {
#pragma unroll
                    for (int n = 0; n < 2; ++n) { *(f32x4*)(sbg + ((size_t)u.pm * 2 + fr) * DFF + f0 + 4 * n) = acc[0][0][0][n]; *(f32x4*)(sbu + ((size_t)u.pm * 2 + fr) * DFF + f0 + 4 * n) = acc[0][1][0][n]; }
                } else {
                    u32x4 w; w.x = hp[0][m].x; w.y = hp[0][m].y; w.z = hp[1][m].x; w.w = hp[1][m].y;
                    *(u32x4*)(H + (size_t)(u.pm * BM + rl) * DFF + f0) = w;
                }
            }
        }
    }
};

template <class Epi, class Sched, bool ALIGN_EPI>
__device__ __forceinline__ void gemm_phase(LAS unsigned char* lds, const Gemm g, const Sched& S, const Epi& E, const int wave_s) {
    const int tid = opaque_tid(wave_s), wid = __builtin_amdgcn_readfirstlane(tid >> 6), lane = tid & 63, wr = wid >> 2, wc = wid & 3, fr = lane & 15, fq = lane >> 4;
    const int nt = g.K / BK;
    unsigned voffA[2], voffB[2];
#pragma unroll
    for (int i = 0; i < 2; ++i) { int R, C; stage_rc(tid * 16 + i * 8192, R, C); const int Rb = Epi::PERM ? ((R & ~31) + perm32(R & 31)) : R;
        voffA[i] = (unsigned)(R * g.lda + C) * 2u; voffB[i] = (unsigned)(Rb * g.ldb + C) * 2u; }
    const size_t kstep = (size_t)(BK * 2);
    const size_t hstepA = (size_t)HALF * g.lda * 2, hstepB = (size_t)HALF * g.ldb * 2;
    const unsigned ldsw = (unsigned)wid * 1024u;
    const int aoff = lds_byte(wr * 64 + fr, fq * 8), boff = lds_byte(wc * 32 + fr, fq * 8);
#define PG8_SA(b, h) (((b) * 2 + (h)) * HTB)
#define PG8_SB(b, h) ((4 + (b) * 2 + (h)) * HTB)
#define PG8_STAGE(bufoff, gbase, voff) do { _Pragma("unroll") for (int _i = 0; _i < 2; ++_i) \
        __builtin_amdgcn_global_load_lds((const unsigned*)((const char*)(gbase) + (voff)[_i]), (LAS unsigned*)(lds + (bufoff) + ldsw + _i * 8192), 16, 0, 0); } while (0)
#define PG8_LDA(dst, b, h) do { _Pragma("unroll") for (int m = 0; m < 4; ++m) _Pragma("unroll") for (int k = 0; k < 2; ++k) dst[m][k] = *(const LAS bf16x8*)(lds + PG8_SA(b, h) + aoff + m * 2048 + k * 1024); } while (0)
#define PG8_LDB(dst, b, h) do { _Pragma("unroll") for (int n = 0; n < 2; ++n) _Pragma("unroll") for (int k = 0; k < 2; ++k) dst[n][k] = *(const LAS bf16x8*)(lds + PG8_SB(b, h) + boff + n * 2048 + k * 1024); } while (0)
#define PG8_MMA(ai, bj, At, Bt) do { __builtin_amdgcn_s_setprio(1); _Pragma("unroll") for (int m = 0; m < 4; ++m) _Pragma("unroll") for (int n = 0; n < 2; ++n) _Pragma("unroll") for (int k = 0; k < 2; ++k) \
        acc[ai][bj][m][n] = __builtin_amdgcn_mfma_f32_16x16x32_bf16(Bt[n][k], At[m][k], acc[ai][bj][m][n], 0, 0, 0); __builtin_amdgcn_s_setprio(0); } while (0)
#define PG8_WAIT_V(n) asm volatile("s_waitcnt vmcnt(" #n ")" ::: "memory")
#define PG8_WAIT_L(n) asm volatile("s_waitcnt lgkmcnt(" #n ")" ::: "memory")
#define PG8_BAR __builtin_amdgcn_s_barrier()
#define PG8_SCHED __builtin_amdgcn_sched_barrier(0)
    Unit cur, nxt; int ui = 0;
    if (!S.next(0, cur)) return;
    f32x4 acc[2][2][4][2];
#pragma unroll
    for (int a = 0; a < 2; ++a)
#pragma unroll
        for (int b = 0; b < 2; ++b)
#pragma unroll
            for (int m = 0; m < 4; ++m)
#pragma unroll
                for (int n = 0; n < 2; ++n) acc[a][b][m][n] = (f32x4){0.f, 0.f, 0.f, 0.f};
    bf16x8 At[4][2], B0[2][2], B1[2][2];
    const char* cA = (const char*)g.A + S.offA(cur); const char* cB = (const char*)g.Bt + S.offB(cur);
    PG8_STAGE(PG8_SB(0, 0), cB, voffB); PG8_STAGE(PG8_SB(0, 1), cB + hstepB, voffB); PG8_STAGE(PG8_SA(0, 0), cA, voffA); PG8_STAGE(PG8_SA(0, 1), cA + hstepA, voffA);
    if (wr == 1) PG8_BAR;
    PG8_WAIT_V(2); PG8_BAR;
    PG8_STAGE(PG8_SB(1, 0), cB + kstep, voffB); PG8_STAGE(PG8_SA(1, 0), cA + kstep, voffA); PG8_STAGE(PG8_SB(1, 1), cB + hstepB + kstep, voffB);
    PG8_WAIT_V(6); PG8_BAR;
    for (;;) {
        const bool has_next = S.next(ui + 1, nxt);
        const char* nA = has_next ? (const char*)g.A + S.offA(nxt) : cA; const char* nB = has_next ? (const char*)g.Bt + S.offB(nxt) : cB;
        for (int t = 0; t < nt; t += 2) {
            const bool last = (t == nt - 2);
            const char* a1 = cA + (size_t)(t + 1) * kstep;
            const char* a2 = last ? nA : cA + (size_t)(t + 2) * kstep; const char* b2 = last ? nB : cB + (size_t)(t + 2) * kstep;
            const char* a3 = a2 + kstep; const char* b3 = b2 + kstep;
            PG8_LDB(B0, 0, 0); PG8_LDB(B1, 0, 1); PG8_SCHED; PG8_LDA(At, 0, 0); PG8_STAGE(PG8_SA(1, 1), a1 + hstepA, voffA);
            PG8_WAIT_V(8); PG8_WAIT_L(0); PG8_BAR; PG8_MMA(0, 0, At, B0); PG8_MMA(0, 1, At, B1); PG8_BAR; PG8_SCHED;
            PG8_LDA(At, 0, 1); PG8_STAGE(PG8_SB(0, 0), b2, voffB); PG8_STAGE(PG8_SB(0, 1), b2 + hstepB, voffB); PG8_STAGE(PG8_SA(0, 0), a2, voffA);
            PG8_WAIT_V(8); PG8_WAIT_L(0); PG8_BAR; PG8_MMA(1, 0, At, B0); PG8_MMA(1, 1, At, B1); PG8_BAR; PG8_SCHED;
            PG8_LDB(B0, 1, 0); PG8_LDB(B1, 1, 1); PG8_SCHED; PG8_LDA(At, 1, 0); PG8_STAGE(PG8_SA(0, 1), a2 + hstepA, voffA);
            PG8_WAIT_V(8); PG8_WAIT_L(0); PG8_BAR; PG8_MMA(0, 0, At, B0); PG8_MMA(0, 1, At, B1); PG8_BAR; PG8_SCHED;
            PG8_LDA(At, 1, 1); PG8_STAGE(PG8_SB(1, 0), b3, voffB); PG8_STAGE(PG8_SB(1, 1), b3 + hstepB, voffB); PG8_STAGE(PG8_SA(1, 0), a3, voffA);
            PG8_WAIT_V(8); PG8_WAIT_L(0); PG8_BAR; PG8_MMA(1, 0, At, B0); PG8_MMA(1, 1, At, B1); PG8_BAR; PG8_SCHED;
        }
        if constexpr (ALIGN_EPI) { if (wr == 0) PG8_BAR; }
        E(acc, cur, wr, wc, fr, fq, lds);
        if (!has_next) break;
#pragma unroll
        for (int a = 0; a < 2; ++a)
#pragma unroll
            for (int b = 0; b < 2; ++b)
#pragma unroll
                for (int m = 0; m < 4; ++m)
#pragma unroll
                    for (int n = 0; n < 2; ++n) acc[a][b][m][n] = (f32x4){0.f, 0.f, 0.f, 0.f};
        cur = nxt; cA = nA; cB = nB; ++ui;
        if constexpr (ALIGN_EPI) { if (wr == 1) PG8_BAR; }
    }
    PG8_WAIT_V(0);
    if constexpr (!ALIGN_EPI) { if (wr == 0) PG8_BAR; }
    PG8_BAR;
#undef PG8_SA
#undef PG8_SB
#undef PG8_STAGE
#undef PG8_LDA
#undef PG8_LDB
#undef PG8_MMA
#undef PG8_WAIT_V
#undef PG8_WAIT_L
#undef PG8_BAR
#undef PG8_SCHED
}
}

struct KVSched {
    int c, G; const char* ws; size_t wsel;
    __device__ __forceinline__ bool next(int i, pg8::Unit& u) const {
        const int L = i * G + c; if (c < 0 || L >= 96) return false;
        const int kind = L >> 5, r = L & 31;
        if (kind < 2) { u.pm = kind * 16 + (r >> 2); u.pn = r & 3; } else { u.pm = 32 + (r >> 3); u.pn = r & 7; }
        return true;
    }
    __device__ __forceinline__ size_t offA(const pg8::Unit& u) const { const int kind = u.pm >> 4, pm = u.pm & 15; int k2 = (kind == 2); asm volatile("" : "+v"(k2));
        return (size_t)ws + WS_MEMB + (size_t)k2 * (WS_WV + wsel - WS_MEMB) + (size_t)pm * 256 * 1024 * 2; }
    __device__ __forceinline__ size_t offB(const pg8::Unit& u) const { const int kind = u.pm >> 4; int k1 = (kind == 1), k2 = (kind == 2); asm volatile("" : "+v"(k1), "+v"(k2));
        return (size_t)ws + WS_WK + wsel + (size_t)k1 * (WS_WV - WS_WK) + (size_t)k2 * (WS_MEMB - WS_WK - wsel) + (size_t)u.pn * 256 * 1024 * 2; }
};


#define XB_TMO      128
#define XB_XCNT(j)  (256  + 64 * (j))
#define XB_XSUB(j)  (1280 + 64 * (j))
#define XB_XGEN(j)  (2304 + 64 * (j))
#define XB_TOP      3328
#define XB_TOPGEN   3392
#define XCD_BAR_WORDS 3456
#define XB_SPIN_CAP (1u << 22)
__device__ __forceinline__ unsigned xb_ld(unsigned* p)              { return __hip_atomic_load(p, __ATOMIC_RELAXED, __HIP_MEMORY_SCOPE_AGENT); }
__device__ __forceinline__ unsigned xb_add(unsigned* p, unsigned v) { return __hip_atomic_fetch_add(p, v, __ATOMIC_RELAXED, __HIP_MEMORY_SCOPE_AGENT); }
__device__ __forceinline__ unsigned xb_xcc_id() { return (unsigned)__builtin_amdgcn_s_getreg((3 << 11) | 20) & 0xFu; }
#define XB_SPIN(cond, bar) do { unsigned _sp = 0; while (cond) { __builtin_amdgcn_s_sleep(1); \
    if ((++_sp & 255u) == 0u) { if (xb_ld(&(bar)[XB_TMO])) break; if (_sp > XB_SPIN_CAP) { atomicAdd(&(bar)[XB_TMO], 1u); break; } } } } while (0)
struct XcdBarrier { unsigned* bar; unsigned x; volatile LAS unsigned* st; };
__device__ __forceinline__ void xcd_barrier_complete(unsigned* bar, unsigned x, unsigned& nloc, unsigned& nx) {
    const unsigned G = gridDim.x * gridDim.y * gridDim.z;
    unsigned sum, cnt, mine, sp = 0u;
    for (;;) {
        sum = 0u; cnt = 0u; mine = 0u;
#pragma unroll
        for (unsigned j = 0; j < 16; ++j) { const unsigned c = xb_ld(&bar[XB_XCNT(j)]); sum += c; cnt += (c > 0u) ? 1u : 0u; mine = (j == x) ? c : mine; }
        if (sum == G) break;
        __builtin_amdgcn_s_sleep(1);
        if ((++sp & 255u) == 0u) { if (xb_ld(&bar[XB_TMO])) break; if (sp > XB_SPIN_CAP) { atomicAdd(&bar[XB_TMO], 1u); break; } }
    }
    nloc = mine > 0u ? mine : 1u; nx = cnt > 0u ? cnt : 1u;
}
__device__ __forceinline__ void xcd_barrier(const XcdBarrier& b) {
    asm volatile("s_waitcnt vmcnt(0)" ::: "memory");
    __syncthreads();
    if (threadIdx.x == 0) {
        unsigned* bar = b.bar;
        __builtin_amdgcn_s_waitcnt(0);
        unsigned nloc = b.st[0], nx = b.st[1];
        if (nloc == 0u) { xcd_barrier_complete(bar, b.x, nloc, nx); b.st[0] = nloc; b.st[1] = nx; }
        const unsigned old = xb_add(&bar[XB_XSUB(b.x)], 1u);
        const unsigned gen = old / nloc;
        if (old + 1u == (gen + 1u) * nloc) {
            __builtin_amdgcn_fence(__ATOMIC_RELEASE, "agent");
            asm volatile("s_waitcnt vmcnt(0)" ::: "memory");
            const unsigned og = xb_add(&bar[XB_TOP], 1u);
            const unsigned tg = og / nx;
            if (og + 1u == (tg + 1u) * nx) xb_add(&bar[XB_TOPGEN], 1u);
            else XB_SPIN(xb_ld(&bar[XB_TOPGEN]) == tg, bar);
            __builtin_amdgcn_fence(__ATOMIC_ACQUIRE, "agent");
            xb_add(&bar[XB_XGEN(b.x)], 1u);
            asm volatile("s_waitcnt vmcnt(0)" ::: "memory");
        } else {
            XB_SPIN(xb_ld(&bar[XB_XGEN(b.x)]) == gen, bar);
            __builtin_amdgcn_fence(__ATOMIC_ACQUIRE, "agent");
            asm volatile("s_waitcnt vmcnt(0)" ::: "memory");
        }
    }
    __syncthreads();
}


struct SG2 { const bf16_t* A; const bf16_t* Bt; int lda, ldb, K, N; bf16_t* O; int ldc; float scale; int mode; float* ssp; };
__device__ __forceinline__ float sq8(bf16x8 a) { float q = 0.f;
#pragma unroll
    for (int i = 0; i < 8; ++i) { const float f = bf2f((unsigned)(unsigned short)a[i]); q += f * f; } return q; }
__device__ __forceinline__ void sgemm2(LAS unsigned char* lds, const SG2 g, int ubase, int G, int wave, int tid) {
    const int lane = tid & 63, fr = lane & 15, fq = lane >> 4, rt = wave & 3, ch = wave >> 2;
    const int nunits = (g.N / 64) * 4, nsl = g.K / 64;
    int R, C; pg8::stage_rc(tid * 16, R, C);
    const unsigned offA = (unsigned)(R * g.lda + C) * 2u, offB = (unsigned)(R * g.ldb + C) * 2u;
    const int aoff = pg8::lds_byte(rt * 16 + fr, fq * 8), boff = pg8::lds_byte(ch * 32 + fr, fq * 8);
    for (int un = ubase; un >= 0 && un < nunits; un += G) {
        const int cgp = un >> 2, rg = un & 3;
        const char* gA = (const char*)(g.A + (size_t)rg * 64 * g.lda) + offA; const char* gB = (const char*)(g.Bt + (size_t)cgp * 64 * g.ldb) + offB;
#define SG2_STAGE(sl) do { LAS unsigned char* d_ = lds + ((sl) & 3) * 16384 + wave * 1024; \
        __builtin_amdgcn_global_load_lds((const unsigned*)(gA + (size_t)(sl) * 128), (LAS unsigned*)d_, 16, 0, 0); \
        __builtin_amdgcn_global_load_lds((const unsigned*)(gB + (size_t)(sl) * 128), (LAS unsigned*)(d_ + 8192), 16, 0, 0); } while (0)
        asm volatile("s_waitcnt vmcnt(0)" ::: "memory");
        SG2_STAGE(0); SG2_STAGE(1);
        f32x4 acc[2] = {(f32x4){0.f, 0.f, 0.f, 0.f}, (f32x4){0.f, 0.f, 0.f, 0.f}}; float q = 0.f;
        for (int sl = 0; sl < nsl; ++sl) {
            if (sl + 1 < nsl) asm volatile("s_waitcnt vmcnt(2)" ::: "memory"); else asm volatile("s_waitcnt vmcnt(0)" ::: "memory");
            __builtin_amdgcn_s_barrier(); asm volatile("" ::: "memory");
            if (sl + 2 < nsl) SG2_STAGE(sl + 2);
            LAS unsigned char* b_ = lds + (sl & 3) * 16384;
#pragma unroll
            for (int ks = 0; ks < 2; ++ks) {
                const bf16x8 a = *(const LAS bf16x8*)(b_ + aoff + ks * 1024);
#pragma unroll
                for (int c = 0; c < 2; ++c) { const bf16x8 b = *(const LAS bf16x8*)(b_ + 8192 + boff + c * 2048 + ks * 1024);
                    acc[c] = __builtin_amdgcn_mfma_f32_16x16x32_bf16(b, a, acc[c], 0, 0, 0); }
                if (g.mode == 1) q += sq8(a);
            }
        }
#undef SG2_STAGE
        const int row = rg * 64 + rt * 16 + fr, col = cgp * 64 + ch * 32 + fq * 4;
        bf16_t* op = g.O + (size_t)row * g.ldc + col;
        if (g.mode == 1) {
            q += shx(q, 16, lane); q += shx(q, 32, lane);
            const float sc = g.scale / sqrtf(q * (1.f / 1024.f) + EPS);
#pragma unroll
            for (int c = 0; c < 2; ++c) { const f32x4 v = acc[c] * sc; u32x2 w; w.x = cvt_pk_bf16(v[0], v[1]); w.y = cvt_pk_bf16(v[2], v[3]); *(u32x2*)(op + c * 16) = w; }
        } else {
            const u32x2 p0 = *(const u32x2*)op, p1 = *(const u32x2*)(op + 16); float qq = 0.f;
            { const float v0 = bflo(p0.x) + acc[0][0], v1 = bfhi(p0.x) + acc[0][1], v2 = bflo(p0.y) + acc[0][2], v3 = bfhi(p0.y) + acc[0][3];
              u32x2 w; w.x = cvt_pk_bf16(v0, v1); w.y = cvt_pk_bf16(v2, v3); *(u32x2*)op = w; qq += (v0 * v0 + v1 * v1) + (v2 * v2 + v3 * v3); }
            { const float v0 = bflo(p1.x) + acc[1][0], v1 = bfhi(p1.x) + acc[1][1], v2 = bflo(p1.y) + acc[1][2], v3 = bfhi(p1.y) + acc[1][3];
              u32x2 w; w.x = cvt_pk_bf16(v0, v1); w.y = cvt_pk_bf16(v2, v3); *(u32x2*)(op + 16) = w; qq += (v0 * v0 + v1 * v1) + (v2 * v2 + v3 * v3); }
            qq += shx(qq, 16, lane); qq += shx(qq, 32, lane);
            if (fq == 0) g.ssp[row * 32 + cgp * 2 + ch] = qq;
        }
        asm volatile("s_waitcnt vmcnt(0) lgkmcnt(0)" ::: "memory"); __builtin_amdgcn_s_barrier(); asm volatile("" ::: "memory");
    }
}

__device__ __forceinline__ void sgemm_act(LAS unsigned char* lds, const bf16_t* A, const bf16_t* Bt, bf16_t* Hs, const float* cfw, const float* scf, float* ocf, int ubase, int G, int wave, int tid) {
    const int lane = tid & 63, fr = lane & 15, fq = lane >> 4, rt = wave & 3, ch = wave >> 2;
    constexpr int nunits = (DFF / 64) * 4, nsl = D / 64, SLOT = 24576;
    int R, C; pg8::stage_rc(tid * 16, R, C);
    const unsigned off = (unsigned)(R * D + C) * 2u;
    const int aoff = pg8::lds_byte(rt * 16 + fr, fq * 8), boff = pg8::lds_byte(fr, fq * 8) + 8192 + ch * 8192;
    for (int un = ubase; un >= 0 && un < nunits; un += G) {
        const int fg = un >> 2, rg = un & 3, brow = ((fg >> 1) << 8) + ((fg & 1) << 6);
        const char* gA = (const char*)(A + (size_t)rg * 64 * D) + off; const char* gG = (const char*)(Bt + (size_t)brow * D) + off; const char* gU = (const char*)(Bt + (size_t)(brow + 128) * D) + off;
#define SGA_STAGE(sl) do { LAS unsigned char* d_ = lds + ((sl) & 3) * SLOT + wave * 1024; \
        __builtin_amdgcn_global_load_lds((const unsigned*)(gA + (size_t)(sl) * 128), (LAS unsigned*)d_, 16, 0, 0); \
        __builtin_amdgcn_global_load_lds((const unsigned*)(gG + (size_t)(sl) * 128), (LAS unsigned*)(d_ + 8192), 16, 0, 0); \
        __builtin_amdgcn_global_load_lds((const unsigned*)(gU + (size_t)(sl) * 128), (LAS unsigned*)(d_ + 16384), 16, 0, 0); } while (0)
        asm volatile("s_waitcnt vmcnt(0)" ::: "memory");
        SGA_STAGE(0); SGA_STAGE(1);
        f32x4 acc[4]; float q = 0.f;
#pragma unroll
        for (int c = 0; c < 4; ++c) acc[c] = (f32x4){0.f, 0.f, 0.f, 0.f};
        for (int sl = 0; sl < nsl; ++sl) {
            if (sl + 1 < nsl) asm volatile("s_waitcnt vmcnt(3)" ::: "memory"); else asm volatile("s_waitcnt vmcnt(0)" ::: "memory");
            __builtin_amdgcn_s_barrier(); asm volatile("" ::: "memory");
            if (sl + 2 < nsl) SGA_STAGE(sl + 2);
            LAS unsigned char* b_ = lds + (sl & 3) * SLOT;
#pragma unroll
            for (int ks = 0; ks < 2; ++ks) {
                const bf16x8 a = *(const LAS bf16x8*)(b_ + aoff + ks * 1024);
#pragma unroll
                for (int c = 0; c < 4; ++c) { const bf16x8 b = *(const LAS bf16x8*)(b_ + boff + c * 2048 + ks * 1024);
                    acc[c] = __builtin_amdgcn_mfma_f32_16x16x32_bf16(b, a, acc[c], 0, 0, 0); }
                q += sq8(a);
            }
        }
#undef SGA_STAGE
        q += shx(q, 16, lane); q += shx(q, 32, lane);
        const float rstd = 1.0f / sqrtf(q * (1.f / 1024.f) + EPS);
        asm volatile("s_waitcnt lgkmcnt(0)" ::: "memory"); __builtin_amdgcn_s_barrier(); asm volatile("" ::: "memory");
        LAS float* T = (LAS float*)(lds + ch * 20480);
#pragma unroll
        for (int c = 0; c < 4; ++c)
#pragma unroll
            for (int j = 0; j < 4; ++j) T[(rt * 16 + fr) * 65 + c * 16 + fq * 4 + j] = acc[c][j] * rstd;
        asm volatile("s_waitcnt lgkmcnt(0)" ::: "memory"); __builtin_amdgcn_s_barrier(); asm volatile("" ::: "memory");
        {
            const LAS float* Gt = (const LAS float*)lds; const LAS float* Ut = (const LAS float*)(lds + 20480);
            const int r = tid >> 3, f8 = (tid & 7) * 8, b = rg * 2 + (r >> 5), rr = r & 31, f = fg * 64 + f8;
            const float* st = scf + (size_t)(b * 2) * DFF + f;
            float hv[8], gv[8];
#pragma unroll
            for (int k = 0; k < 8; ++k) {
                const float g0 = Gt[r * 65 + f8 + k];
                const float gm1 = rr >= 1 ? Gt[(r - 1) * 65 + f8 + k] : st[DFF + k];
                const float gm2 = rr >= 2 ? Gt[(r - 2) * 65 + f8 + k] : (rr == 1 ? st[DFF + k] : st[k]);
                const float cv = cfw[f + k] * gm2 + cfw[DFF + f + k] * gm1 + cfw[2 * DFF + f + k] * g0;
                hv[k] = silu(cv) * Ut[r * 65 + f8 + k]; gv[k] = g0;
            }
            u32x4 w; w.x = pk2(hv[0], hv[1]); w.y = pk2(hv[2], hv[3]); w.z = pk2(hv[4], hv[5]); w.w = pk2(hv[6], hv[7]);
            *(u32x4*)(Hs + (size_t)(rg * 64 + r) * DFF + f) = w;
            if (rr >= 30) { float* o = ocf + ((size_t)b * 2 + (rr - 30)) * DFF + f; *(f32x4*)o = (f32x4){gv[0], gv[1], gv[2], gv[3]}; *(f32x4*)(o + 4) = (f32x4){gv[4], gv[5], gv[6], gv[7]}; }
        }
        asm volatile("s_waitcnt vmcnt(0) lgkmcnt(0)" ::: "memory"); __builtin_amdgcn_s_barrier(); asm volatile("" ::: "memory");
    }
}
__device__ __forceinline__ void sample_ss_reduce(const float* sss, float* ssq, int tid) {
    if (tid < 256) { const f32x4* p = (const f32x4*)(sss + tid * 32); float t = 0.f;
#pragma unroll
        for (int i = 0; i < 8; ++i) { const f32x4 v = p[i]; t += (v[0] + v[1]) + (v[2] + v[3]); }
        *(f32x4*)(ssq + (size_t)(MP + tid) * 4) = (f32x4){t, 0.f, 0.f, 0.f}; }
    asm volatile("s_waitcnt vmcnt(0)" ::: "memory"); __syncthreads();
}

__device__ __forceinline__ void transpose_item(const float* W, int K, int N, bf16_t* WT, LAS float* scr, int item, int lane, const float* gain = nullptr, int gu = 0) {
    const int nblk = N / 32, kb = item / nblk, nb = item % nblk, k0 = 64 * kb, n0 = 32 * nb;
    {
        f32x4 v[8];
#pragma unroll
        for (int i = 0; i < 8; ++i) v[i] = *(const f32x4*)(W + (size_t)(k0 + (lane >> 3) + 8 * i) * N + n0 + (lane & 7) * 4);
#pragma unroll
        for (int i = 0; i < 8; ++i) { const int kk = (lane >> 3) + 8 * i; f32x4 w = v[i]; if (gain) w = w * gain[k0 + kk];
            LAS float* d = scr + kk * 33 + (lane & 7) * 4; d[0] = w[0]; d[1] = w[1]; d[2] = w[2]; d[3] = w[3]; }
    }
    LDS_WAIT();
    const int c = lane & 7;
#pragma unroll
    for (int j = 0; j < 4; ++j) { const int n = (lane >> 3) + 8 * j; const LAS float* s = scr + (8 * c) * 33 + n;
        u32x4 o; o.x = pk2(s[0 * 33], s[1 * 33]); o.y = pk2(s[2 * 33], s[3 * 33]); o.z = pk2(s[4 * 33], s[5 * 33]); o.w = pk2(s[6 * 33], s[7 * 33]);
        int drow = n0 + n; if (gu) { const int up = drow >= gu, f = up ? drow - gu : drow; drow = ((f >> 7) << 8) + (up << 7) + (f & 127); }
        *(u32x4*)(WT + (size_t)drow * K + k0 + 8 * c) = o; }
    LDS_WAIT();
}

__device__ __forceinline__ void first_rows(const float* Xp, const float* Xs, bf16_t* XNo, float* ss, int gw, int NGW, int lane) {
    for (int m0 = gw; m0 < MT; m0 += 2 * NGW) {
        const int m1 = m0 + NGW; const bool two = m1 < MT; const int mb = two ? m1 : m0;
        const f32x4* xa = (const f32x4*)(m0 < MP ? Xp + (size_t)m0 * D : Xs + (size_t)(m0 - MP) * D) + lane;
        const f32x4* xb = (const f32x4*)(mb < MP ? Xp + (size_t)mb * D : Xs + (size_t)(mb - MP) * D) + lane;
        f32x4 va[4], vb[4]; float sa = 0.f, sb = 0.f;
#pragma unroll
        for (int j = 0; j < 4; ++j) { va[j] = xa[64 * j]; vb[j] = xb[64 * j]; }
#pragma unroll
        for (int j = 0; j < 4; ++j) { sa += (va[j].x * va[j].x + va[j].y * va[j].y) + (va[j].z * va[j].z + va[j].w * va[j].w); sb += (vb[j].x * vb[j].x + vb[j].y * vb[j].y) + (vb[j].z * vb[j].z + vb[j].w * vb[j].w); }
        sa = wave_sum(sa, lane); sb = wave_sum(sb, lane);
        if (lane < 4) { ss[(size_t)m0 * 4 + lane] = lane == 0 ? sa : 0.f; if (two) ss[(size_t)m1 * 4 + lane] = lane == 0 ? sb : 0.f; }
        u32x2* oa = (u32x2*)(XNo + (size_t)m0 * D) + lane; u32x2* ob = (u32x2*)(XNo + (size_t)mb * D) + lane;
#pragma unroll
        for (int j = 0; j < 4; ++j) { u32x2 w; w.x = pk2(va[j].x, va[j].y); w.y = pk2(va[j].z, va[j].w); oa[64 * j] = w; if (two) { w.x = pk2(vb[j].x, vb[j].y); w.y = pk2(vb[j].z, vb[j].w); ob[64 * j] = w; } }
    }
}

typedef __attribute__((address_space(4))) const unsigned char* kptr_t;
typedef const float* cfp_t; typedef float* fp_t; typedef unsigned char* ucp_t;
#define INP(k) (*(const __attribute__((address_space(4))) cfp_t*)(kp + 8 * (k)))
#define X out
#define WIN_T ((bf16_t*)(ws + WS_WIN + wsel))
#define WOUT_T ((bf16_t*)(ws + WS_WOUT + wsel))
#define WQ_T ((bf16_t*)(ws + WS_WQ + wsel))
#define WK_T ((bf16_t*)(ws + WS_WK + wsel))
#define WV_T ((bf16_t*)(ws + WS_WV + wsel))
#define WO_T ((bf16_t*)(ws + WS_WO + wsel))
#define WUP_T ((bf16_t*)(ws + WS_WUP + wsel))
#define WDN_T ((bf16_t*)(ws + WS_WDN + wsel))
#define MEMB ((bf16_t*)(ws + WS_MEMB))
#define KBP ((bf16_t*)(ws + WS_KBP))
#define VTP ((bf16_t*)(ws + WS_VTP))
#define KBS ((bf16_t*)(ws + WS_KBS + ksel))
#define VTS ((bf16_t*)(ws + WS_VTS + ksel))
#define WST ((bf16_t*)(ws + WS_WST + ksel))
#define AGG ((float*)(ws + WS_AGG))
#define SSQ(i) ((float*)(ws + WS_SSP) + (size_t)(i) * MT * 4)
#define SSS(i) ((float*)(ws + WS_SSS) + (size_t)(i) * 256 * 32)
#define GT_R ((bf16_t*)(ws + WS_GT + ksel))
#define GT_I ((bf16_t*)(ws + WS_GT + 65536 + ksel))
#define XN ((bf16_t*)(ws + WS_XN))
#define gZ ((bf16_t*)(ws + B_Z))
#define HLOC ((float*)(ws + B_HLOC))
#define PCUM ((float*)(ws + B_PCUM))
#define gY ((bf16_t*)(ws + B_Y))
#define gQ ((bf16_t*)(ws + B_Q))
#define gP ((bf16_t*)(ws + B_P))
#define gO ((bf16_t*)(ws + B_O))
#define PS ((bf16_t*)(ws + B_PS))
#define GU ((bf16_t*)(ws + B_GU))
#define GUS ((bf16_t*)(ws + B_GUS))
#define SBG ((float*)(ws + B_SBG))
#define SBU ((float*)(ws + B_SBU))
#define SBL ((float*)(ws + B_SBL))
__device__ __forceinline__ void convert_layer(kptr_t kp, unsigned char* ws, LAS unsigned char* lds, const int l, const int part, const int nparts, const int gw, const int NGW, const int gt, const int NGT, const int lane, const int wave) {
            const size_t wsel = (size_t)(l & 1) * WSEL1, ksel = (size_t)(l & 1) * KSEL1;
            LAS float* scr = (LAS float*)(lds + wave * 16384);
            const float* w_in = INP(I_WIN) + (size_t)l * D * INC; const float* w_out = INP(I_WOUT) + (size_t)l * D * D; const float* w_q = INP(I_WQ) + (size_t)l * D * D;
            const float* w_k = INP(I_WK) + (size_t)l * D * D; const float* w_v = INP(I_WV) + (size_t)l * D * D; const float* w_o = INP(I_WO) + (size_t)l * D * D;
            const float* w_up = INP(I_WUP) + (size_t)l * D * 2 * DFF; const float* w_dn = INP(I_WDN) + (size_t)l * DFF * D; const float* c_v = INP(I_CV) + (size_t)l * BS * NMEM * D;
            constexpr int T_IN = 16 * (INC / 32), T_SQ = 16 * 32, T_UP = 16 * (2 * DFF / 32), T_DN = (DFF / 64) * 32, T_CV = 32 * 32;
            constexpr int T_G = 16;
            constexpr int NIT = T_IN + 5 * T_SQ + T_UP + T_DN + T_CV + 2 * T_G;
            for (int it = (NIT * part) / nparts + gw; it < (NIT * (part + 1)) / nparts; it += NGW) {
                int r = it;
                if (r < T_IN) { transpose_item(w_in, D, INC, WIN_T, scr, r, lane, INP(I_GMIX) + l * D); continue; } r -= T_IN;
                if (r < T_SQ) { transpose_item(w_out, D, D, WOUT_T, scr, r, lane); continue; } r -= T_SQ;
                if (r < T_SQ) { transpose_item(w_q, D, D, WQ_T, scr, r, lane, INP(I_GX) + l * D); continue; } r -= T_SQ;
                if (r < T_SQ) { transpose_item(w_k, D, D, WK_T, scr, r, lane); continue; } r -= T_SQ;
                if (r < T_SQ) { transpose_item(w_v, D, D, WV_T, scr, r, lane); continue; } r -= T_SQ;
                if (r < T_SQ) { transpose_item(w_o, D, D, WO_T, scr, r, lane); continue; } r -= T_SQ;
                if (r < T_UP) { transpose_item(w_up, D, 2 * DFF, WUP_T, scr, r, lane, INP(I_GFFN) + l * D, DFF); continue; } r -= T_UP;
                if (r < T_DN) { transpose_item(w_dn, DFF, D, WDN_T, scr, r, lane); continue; } r -= T_DN;
                if (r < T_CV) { transpose_item(c_v, BS * NMEM, D, VTS, scr, r, lane); continue; } r -= T_CV;
                if (r < T_G) { transpose_item(INP(I_WRG) + ((size_t)l * 8 + (r >> 1)) * 4096, 64, 64, GT_R + (r >> 1) * 4096, scr, r & 1, lane); continue; } r -= T_G;
                transpose_item(INP(I_WIG) + ((size_t)l * 8 + (r >> 1)) * 4096, 64, 64, GT_I + (r >> 1) * 4096, scr, r & 1, lane);
            }
            if (part == 0) {
                const f32x4* ck = (const f32x4*)(INP(I_CK) + (size_t)l * BS * NMEM * D); u32x2* dk = (u32x2*)KBS;
                for (int i = gt; i < BS * NMEM * D / 4; i += NGT) { const f32x4 v = ck[i]; u32x2 w; w.x = pk2(v.x, v.y); w.y = pk2(v.z, v.w); dk[i] = w; }
                if (l == 0) { const f32x4* mm = (const f32x4*)INP(I_MEM); u32x2* dm = (u32x2*)MEMB;
                    for (int i = gt; i < BP * NMEM * D / 4; i += NGT) { const f32x4 v = mm[i]; u32x2 w; w.x = pk2(v.x, v.y); w.y = pk2(v.z, v.w); dm[i] = w; } }
                const float* wsl = INP(I_WS) + (size_t)l * 4 * 128 * 128;
                for (int i = gt; i < 4 * 128 * 128; i += NGT) { const int s = i & 127, t = (i >> 7) & 127; WST[i] = (bf16_t)f2bf(s <= t ? wsl[i] : 0.f); }
            }
}

__global__ void __launch_bounds__(NTHREADS, 2) trunk_fwd(Args args) {
    extern __shared__ __attribute__((aligned(16))) unsigned char lds_raw[];
    LAS unsigned char* lds = (LAS unsigned char*)lds_raw;
    cg::grid_group grid = cg::this_grid();
    const int wave_s = __builtin_amdgcn_readfirstlane(threadIdx.x >> 6);
#define LANE_STATE() int G = gridDim.x, bid = blockIdx.x; asm volatile("" : "+s"(G), "+s"(bid)); const int NGW = G * NWAVES, NGT = G * NTHREADS; (void)NGW; (void)NGT; \
    const int tid = opaque_tid(wave_s), lane = tid & 63, wave = wave_s; const int gw = bid * NWAVES + wave; const int gt = bid * NTHREADS + tid; (void)lane; (void)gw; (void)gt; \
    kptr_t kp = (kptr_t)__builtin_amdgcn_kernarg_segment_ptr(); asm volatile("" : "+s"(kp)); \
    float* const out = *(const __attribute__((address_space(4))) fp_t*)(kp + 8 * N_IN); unsigned char* const ws = *(const __attribute__((address_space(4))) ucp_t*)(kp + 8 * N_IN + 8); (void)out; (void)ws
    {
        LANE_STATE();
        if (bid == 0) for (int i = tid; i < XCD_BAR_WORDS; i += NTHREADS) __hip_atomic_store((unsigned*)(ws + WS_BAR) + i, 0u, __ATOMIC_RELAXED, __HIP_MEMORY_SCOPE_AGENT);
        if (tid < 32) ((LAS unsigned*)(lds + LDS_MISC))[tid] = 0u;
        __threadfence();
        grid.sync();
        if (tid == 0) (void)xb_add((unsigned*)(ws + WS_BAR) + XB_XCNT(xb_xcc_id()), 1u);
    }
#define GRID_SYNC() do { kptr_t kp_ = (kptr_t)__builtin_amdgcn_kernarg_segment_ptr(); asm volatile("" : "+s"(kp_)); \
        XcdBarrier b_; b_.bar = (unsigned*)(*(const __attribute__((address_space(4))) ucp_t*)(kp_ + 8 * N_IN + 8) + WS_BAR); b_.x = xb_xcc_id(); b_.st = (volatile LAS unsigned*)(lds + LDS_MISC); \
        xcd_barrier(b_); if (PROBE == 3) xcd_barrier(b_); } while (0)

    for (int l = 0; l < DEPTH; ++l) {
        const size_t wsel = (size_t)(l & 1) * WSEL1, ksel = (size_t)(l & 1) * KSEL1;
        if (l == 0)
        for (int dup0 = 0; dup0 < ((PROBE == 1 || PROBE == 5) ? 2 : 1); ++dup0) {
        {
            LANE_STATE();
            convert_layer(kp, ws, lds, l, 0, 1, gw, NGW, gt, NGT, lane, wave);
            if (l == 0) first_rows(INP(I_XP), INP(I_XS), XN, SSQ(0), gw, NGW, lane);
        }
        GRID_SYNC();
        }
        {
            LANE_STATE();
            KVSched S; S.G = G; S.c = bid >= 160 ? bid - 160 : -1; S.ws = (const char*)ws; S.wsel = wsel;
            pg8::Gemm g{(const bf16_t*)nullptr, (const bf16_t*)nullptr, D, D, D};
            pg8::EpiKV E{out + O_MKP + (size_t)l * BP * NMEM * D, out + O_MVP + (size_t)l * BP * NMEM * D, KBP, VTP};
            pg8::gemm_phase<pg8::EpiKV, KVSched, true>(lds, g, S, E, wave_s);
        }
#define GEMM_BF16(s_) do { const int s = (s_); pg8::GSched S; pg8::Gemm g; pg8::EpiBf16 E; E.scale = 1.f; E.ss = nullptr; E.smp = 0; \
        if (s == 0) { S.init(MT / 256, INC / 256, G, bid); S.aPm = (size_t)256 * D * 2; S.bPn = (size_t)256 * D * 2; g = pg8::Gemm{XN, WIN_T, D, D, D}; E.O = gZ; E.ldc = INC; E.ss = SSQ(3 * l); } \
        else if (s == 1) { S.init(MP / 256, D / 256, G, bid); S.aPm = (size_t)256 * D * 2; S.bPn = (size_t)256 * D * 2; g = pg8::Gemm{XN, WQ_T, D, D, D}; E.O = gQ; E.ldc = D; E.scale = 0.0625f; E.ss = SSQ(3 * l + 1); } \
        else if (s == 2) { S.init(MP / 256, 4, G, bid); S.aPm = (size_t)256 * D * 2; S.aPn = 512; S.bPn = (size_t)256 * 2048 * 2; S.bPm = 512; S.bShift = 4; g = pg8::Gemm{gP, VTP, D, 2048, 256}; E.O = gO; E.ldc = D; } \
        else { S.init(1, 32, G, (bid + G - 64) % G); S.mode = 2; g = pg8::Gemm{PS, VTS, 8192, 2048, 256}; E.O = gO + (size_t)MP * D; E.ldc = D; E.smp = 1; } \
        pg8::gemm_phase<pg8::EpiBf16, pg8::GSched, true>(lds, g, S, E, wave_s); } while (0)
#define GEMM_RES(s_) do { const int s = (s_); pg8::GSched S; S.init(MP / 256, D / 256, G, bid); pg8::Gemm g; \
        if (s == 0) { g = pg8::Gemm{gY, WOUT_T, D, D, D}; S.aPm = (size_t)256 * D * 2; } \
        else if (s == 1) { g = pg8::Gemm{gO, WO_T, D, D, D}; S.aPm = (size_t)256 * D * 2; } \
        else { g = pg8::Gemm{GU, WDN_T, DFF, DFF, DFF}; S.aPm = (size_t)256 * DFF * 2; } \
        S.bPn = (size_t)256 * g.ldb * 2; \
        pg8::EpiResid E{XN, SSQ(3 * l + 1 + s)}; \
        pg8::gemm_phase<pg8::EpiResid, pg8::GSched, true>(lds, g, S, E, wave_s); } while (0)

        for (int rep = 0; rep < 13; ++rep) { if (rep == 4 || rep == 9 || rep == 11) continue;
          const int ndup = ((PROBE == 1 && (rep == 1 || rep == 2)) || (PROBE == 4 && rep == 1) || (PROBE == 6 && rep == 2)) ? 2 : ((PROBE == 2 && (rep == 0 || rep == 5 || rep == 6 || rep == 7 || rep == 10)) ? 2 : 1);
          for (int dup = 0; dup < ndup; ++dup) {
            if (rep == 0 || rep == 5 || rep == 7) {
                LANE_STATE();
                const int s0 = rep == 0 ? 0 : (rep == 5 ? 1 : 2), ns = rep == 7 ? 2 : 1;
                if (rep == 0 && l > 0) {
                    pg8::GSched S0; S0.init(MT / 256, INC / 256, G, bid); pg8::Unit u0; bool own = false;
                    for (int i = 0; S0.next(i, u0); ++i) own = own || (u0.pm == 128);
                    if (own) sample_ss_reduce(SSS(3 * l), SSQ(3 * l), tid);
                }
                for (int q = 0; q < ns; ++q) GEMM_BF16(s0 + q);
                if (rep == 5) { LANE_STATE(); const SG2 sg{XN + (size_t)MP * D, WQ_T, D, D, D, D, gQ + (size_t)MP * D, D, 0.0625f, 1, nullptr}; sgemm2(lds, sg, bid, G, wave, tid); }
                if (rep == 5 && l + 1 < DEPTH) { LANE_STATE(); if (bid >= 4) convert_layer(kp, ws, lds, l + 1, 1, 3, gw - 4 * NWAVES, NGW - 4 * NWAVES, gt - 4 * NTHREADS, NGT - 4 * NTHREADS, lane, wave); }
            } else if (rep == 10) {
                LANE_STATE();
                pg8::GSched S; S.init(MP / 256, 2 * DFF / 256, G, bid); S.aPm = (size_t)256 * D * 2; S.bPn = (size_t)256 * D * 2;
                const pg8::Gemm g{XN, WUP_T, D, D, D};
                const pg8::EpiAct E{GU, INP(I_SCF) + (size_t)l * BS * 2 * DFF, out + O_CFS + (size_t)l * BS * 2 * DFF, SBG, SBU, SBL, INP(I_CFW) + (size_t)l * 3 * DFF, SSQ(3 * l + 2)};
                pg8::gemm_phase<pg8::EpiAct, pg8::GSched, true>(lds, g, S, E, wave_s);
                { LANE_STATE(); sgemm_act(lds, XN + (size_t)MP * D, WUP_T, GU + (size_t)MP * DFF, INP(I_CFW) + (size_t)l * 3 * DFF, INP(I_SCF) + (size_t)l * BS * 2 * DFF, out + O_CFS + (size_t)l * BS * 2 * DFF, bid, G, wave, tid); }
            } else if (rep == 1) {
                LANE_STATE();
                {
                    LAS bf16_t* vT = (LAS bf16_t*)lds;
                    constexpr int VP = 136;
                    const float* gvp = INP(I_GV) + l * CW; const float* bsp = INP(I_BSS) + l * 4 * 128;
                    for (int un = (bid + G / 2) % G; un < 8 + 256; un += G) {
                        int rowbase, nrows, sb = -1;
                        if (un < 8) { sb = un; rowbase = MP + un * TS; nrows = TS; } else { rowbase = (un - 8) * 128; nrows = 128; }
                        {
                            const int rl = tid >> 5, cgp = tid & 31;
                            f32x4 g0 = *(const f32x4*)(gvp + cgp * 8), g1 = *(const f32x4*)(gvp + cgp * 8 + 4);
                            for (int p = 0; p < nrows / 16; ++p) {
                                const int r = p * 16 + rl;
                                const u32x4 raw = *(const u32x4*)(gZ + (size_t)(rowbase + r) * INC + Z_VC + cgp * 8);
                                float v[8] = {bflo(raw.x), bfhi(raw.x), bflo(raw.y), bfhi(raw.y), bflo(raw.z), bfhi(raw.z), bflo(raw.w), bfhi(raw.w)};
                                float ss = 0.f;
#pragma unroll
                                for (int k = 0; k < 8; ++k) { v[k] = gelu_t(v[k]); ss += v[k] * v[k]; }
                                ss += shx(ss, 1, lane); ss += shx(ss, 2, lane); ss += shx(ss, 4, lane);
                                const float rstd = 1.0f / sqrtf(ss * (1.f / 64.f) + EPS);
                                const float gg[8] = {g0.x, g0.y, g0.z, g0.w, g1.x, g1.y, g1.z, g1.w};
#pragma unroll
                                for (int k = 0; k < 8; ++k) { v[k] = v[k] * rstd * gg[k]; vT[(cgp * 8 + k) * VP + r] = (bf16_t)f2bf(v[k]); }
                                if (sb >= 0) { float* vo = out + O_VCS + ((size_t)(l * BS + sb) * TS + r) * CW + cgp * 8;
                                    *(f32x4*)vo = (f32x4){v[0], v[1], v[2], v[3]}; *(f32x4*)(vo + 4) = (f32x4){v[4], v[5], v[6], v[7]}; }
                            }
                        }
                        __syncthreads();
                        {
                            const int hh = wave & 3, rh = wave >> 2, fr = lane & 15, fq = lane >> 4;
                            const int nmt = nrows == 128 ? 4 : (rh == 0 ? 2 : 0);
                            for (int mi = 0; mi < nmt; ++mi) {
                                const int mt = rh * 4 + mi, nks = (mt * 16 + 15) / 32 + 1;
                                f32x4 acc[4];
#pragma unroll
                                for (int n = 0; n < 4; ++n) acc[n] = (f32x4){0.f, 0.f, 0.f, 0.f};
                                for (int ks = 0; ks < nks; ++ks) {
                                    const bf16x8 a = *(const bf16x8*)(WST + ((size_t)(hh * 128 + mt * 16 + fr) * 128 + ks * 32 + fq * 8));
#pragma unroll
                                    for (int n = 0; n < 4; ++n) { const bf16x8 b = *(const LAS bf16x8*)(vT + (hh * 64 + n * 16 + fr) * VP + ks * 32 + fq * 8);
                                        acc[n] = __builtin_amdgcn_mfma_f32_16x16x32_bf16(b, a, acc[n], 0, 0, 0); }
                                }
                                { const int t = mt * 16 + fr; const float bias = bsp[hh * 128 + t]; const size_t row = (size_t)(rowbase + t);
#pragma unroll
                                    for (int n = 0; n < 4; ++n) { const int c = hh * 64 + n * 16 + fq * 4; const u32x2 uq = *(const u32x2*)(gZ + row * INC + Z_UC + c);
                                        u32x2 w; w.x = pk2(gelu_t(bflo(uq.x)) * (acc[n][0] + bias), gelu_t(bfhi(uq.x)) * (acc[n][1] + bias)); w.y = pk2(gelu_t(bflo(uq.y)) * (acc[n][2] + bias), gelu_t(bfhi(uq.y)) * (acc[n][3] + bias));
                                        *(u32x2*)(gY + row * D + 768 + c) = w; } }
                            }
                        }
                        __syncthreads();
                    }
                }
                {
                    LAS unsigned char* wl = lds + wave * 16384;
                    LAS bf16_t* tile = (LAS bf16_t*)wl;
                    LAS float* pre_r = (LAS float*)(wl + 2560);
                    LAS float* pre_i = (LAS float*)(wl + 2560 + 4096);
                    LAS float* xcf = (LAS float*)(wl + 2560 + 8192);
                    const int fr = lane & 15, fq = lane >> 4;
                    for (int un = gw; un < 64 + 2048; un += NGW) {
                        int b, hd, rowbase, nrows, t0; bool smp = un < 64;
                        if (smp) { b = un >> 3; hd = un & 7; rowbase = MP + b * TS; nrows = TS; t0 = 0; }
                        else { const int v = un - 64; const int ch = v & 31; hd = (v >> 5) & 7; b = v >> 8; t0 = ch * 128; rowbase = b * SEQ + t0; nrows = 128; }
                        const int cidx = l * AW + hd * 64 + lane;
                        const float br = INP(I_BRG)[cidx], bi = INP(I_BIG)[cidx];
                        const float c8sp = 8.0f * log1pf(__expf(-INP(I_LAM)[cidx]));
                        const float* caw = INP(I_CAW) + (size_t)l * 4 * AW + hd * 64 + lane;
                        const float cw0 = caw[0], cw1 = caw[AW], cw2 = caw[2 * AW], cw3 = caw[3 * AW], cb = INP(I_CAB)[cidx];
                        bf16x8 bR[4][2], bI[4][2];
#pragma unroll
                        for (int n = 0; n < 4; ++n)
#pragma unroll
                            for (int ks = 0; ks < 2; ++ks) { const size_t o_ = (size_t)(hd * 64 + n * 16 + fr) * 64 + ks * 32 + fq * 8;
                                bR[n][ks] = *(const bf16x8*)(GT_R + o_); bI[n][ks] = *(const bf16x8*)(GT_I + o_); }
                        float xm3 = 0.f, xm2 = 0.f, xm1 = 0.f;
                        if (smp) { const float* st = INP(I_SCA) + ((size_t)(l * BS + b) * 3) * AW + hd * 64 + lane; xm3 = st[0]; xm2 = st[AW]; xm1 = st[2 * AW]; }
                        else if (t0 > 0) { const bf16_t* zp = gZ + (size_t)(rowbase - 3) * INC + Z_XA + hd * 64 + lane; xm3 = bf2f(zp[0]); xm2 = bf2f(zp[INC]); xm1 = bf2f(zp[2 * INC]); }
                        float h = 0.f, pc = 1.f;
                        const bf16_t* zq = gZ + (size_t)(rowbase + (lane >> 3)) * INC + Z_XA + hd * 64 + (lane & 7) * 8;
                        float* hp = HLOC + (size_t)rowbase * AW + hd * 64 + lane; float* pp = PCUM + (size_t)rowbase * AW + hd * 64 + lane;
                        LAS bf16_t* xraw = (LAS bf16_t*)pre_r;
                        u32x4 xn0 = *(const u32x4*)zq, xn1 = *(const u32x4*)(zq + (size_t)8 * INC);
                        for (int st = 0; st < nrows / 16; ++st) {
                            *(LAS u32x4*)(xraw + (lane >> 3) * 64 + (lane & 7) * 8) = xn0; *(LAS u32x4*)(xraw + ((lane >> 3) + 8) * 64 + (lane & 7) * 8) = xn1;
                            zq += (size_t)16 * INC;
                            if (st + 1 < nrows / 16) { xn0 = *(const u32x4*)zq; xn1 = *(const u32x4*)(zq + (size_t)8 * INC); }
                            LDS_WAIT();
#pragma unroll
                            for (int i = 0; i < 16; ++i) { const float xv = bf2f(xraw[i * 64 + lane]);
                                const float xc = cw0 * xm3 + cw1 * xm2 + cw2 * xm1 + cw3 * xv + cb; xm3 = xm2; xm2 = xm1; xm1 = xv; xcf[i * 64 + lane] = xc; tile[i * 72 + lane] = (bf16_t)f2bf(xc); }
                            LDS_WAIT();
                            const bf16x8 a0 = *(const LAS bf16x8*)(tile + fr * 72 + fq * 8), a1 = *(const LAS bf16x8*)(tile + fr * 72 + 32 + fq * 8);
#pragma unroll
                            for (int n = 0; n < 4; ++n) {
                                f32x4 ar = (f32x4){0.f, 0.f, 0.f, 0.f}, ai = (f32x4){0.f, 0.f, 0.f, 0.f};
                                ar = __builtin_amdgcn_mfma_f32_16x16x32_bf16(a0, bR[n][0], ar, 0, 0, 0); ar = __builtin_amdgcn_mfma_f32_16x16x32_bf16(a1, bR[n][1], ar, 0, 0, 0);
                                ai = __builtin_amdgcn_mfma_f32_16x16x32_bf16(a0, bI[n][0], ai, 0, 0, 0); ai = __builtin_amdgcn_mfma_f32_16x16x32_bf16(a1, bI[n][1], ai, 0, 0, 0);
#pragma unroll
                                for (int j = 0; j < 4; ++j) { pre_r[(fq * 4 + j) * 64 + n * 16 + fr] = ar[j]; pre_i[(fq * 4 + j) * 64 + n * 16 + fr] = ai[j]; }
                            }
                            LDS_WAIT();
#pragma unroll 4
                            for (int i = 0; i < 16; ++i) {
                                const float r = sigm(pre_r[i * 64 + lane] + br), gi = sigm(pre_i[i * 64 + lane] + bi);
                                const float la = -c8sp * r; float a, om;
                                if (la > -0.125f) { const float x = 2.0f * la; om = -x * (1.0f + x * (0.5f + x * (0.16666667f + x * (0.041666668f + x * (0.0083333338f + x * 0.0013888889f))))); a = 1.0f + la * (1.0f + la * (0.5f + la * (0.16666667f + la * (0.041666668f + la * 0.0083333338f)))); }
                                else { a = __expf(la); om = -expm1f(2.0f * la); }
                                const float bm = __builtin_amdgcn_sqrtf(om);
                                h = a * h + bm * gi * xcf[i * 64 + lane]; pc = pc * a;
                                *hp = h; *pp = pc; hp += AW; pp += AW;
                            }
                            LDS_WAIT();
                        }
                        AGG[(size_t)un * 128 + lane] = pc; AGG[(size_t)un * 128 + 64 + lane] = h;
                    }
                }
                {
                    const float* cbw = INP(I_CBW) + (size_t)l * 3 * BW;
                    for (int it = gt; it < (MT / 8) * 32; it += NGT) {
                        const int rb = it >> 5, c0 = (it & 31) * 8;
                        int b, t0, T, rowbase; const bool smp = rb >= MP / 8;
                        if (!smp) { b = rb >> 9; t0 = (rb & 511) * 8; T = SEQ; rowbase = rb * 8; } else { const int sbk = rb - MP / 8; b = sbk >> 2; t0 = (sbk & 3) * 8; T = TS; rowbase = MP + sbk * 8; }
                        u32x4 xq[10], cq[10], bq[8];
                        const bf16_t* zr = gZ + (size_t)rowbase * INC + c0;
#pragma unroll
                        for (int i = 0; i < 10; ++i) { if (i >= 2 || t0 > 0) { xq[i] = *(const u32x4*)(zr + (ptrdiff_t)(i - 2) * INC + Z_XB); cq[i] = *(const u32x4*)(zr + (ptrdiff_t)(i - 2) * INC + Z_GC); } else { xq[i] = (u32x4){0u, 0u, 0u, 0u}; cq[i] = (u32x4){0u, 0u, 0u, 0u}; } }
#pragma unroll
                        for (int i = 0; i < 8; ++i) bq[i] = *(const u32x4*)(zr + (size_t)i * INC + Z_GB);
                        float w0[8], w1[8], w2[8], pm2[8], pm1[8];
#pragma unroll
                        for (int k = 0; k < 8; ++k) { w0[k] = cbw[c0 + k]; w1[k] = cbw[BW + c0 + k]; w2[k] = cbw[2 * BW + c0 + k]; }
                        {
                            const float a_[8] = {bflo(xq[0].x) * bflo(cq[0].x), bfhi(xq[0].x) * bfhi(cq[0].x), bflo(xq[0].y) * bflo(cq[0].y), bfhi(xq[0].y) * bfhi(cq[0].y), bflo(xq[0].z) * bflo(cq[0].z), bfhi(xq[0].z) * bfhi(cq[0].z), bflo(xq[0].w) * bflo(cq[0].w), bfhi(xq[0].w) * bfhi(cq[0].w)};
                            const float b_[8] = {bflo(xq[1].x) * bflo(cq[1].x), bfhi(xq[1].x) * bfhi(cq[1].x), bflo(xq[1].y) * bflo(cq[1].y), bfhi(xq[1].y) * bfhi(cq[1].y), bflo(xq[1].z) * bflo(cq[1].z), bfhi(xq[1].z) * bfhi(cq[1].z), bflo(xq[1].w) * bflo(cq[1].w), bfhi(xq[1].w) * bfhi(cq[1].w)};
#pragma unroll
                            for (int k = 0; k < 8; ++k) { pm2[k] = a_[k]; pm1[k] = b_[k]; }
                        }
                        if (t0 == 0 && smp) { const float* st = INP(I_SCB) + ((size_t)(l * BS + b) * 2) * BW + c0;
#pragma unroll
                            for (int k = 0; k < 8; ++k) { pm2[k] = st[k]; pm1[k] = st[BW + k]; } }
#pragma unroll
                        for (int i = 0; i < 8; ++i) {
                            const u32x4 xb = xq[i + 2], gc = cq[i + 2], gb = bq[i];
                            const float pv[8] = {bflo(xb.x) * bflo(gc.x), bfhi(xb.x) * bfhi(gc.x), bflo(xb.y) * bflo(gc.y), bfhi(xb.y) * bfhi(gc.y), bflo(xb.z) * bflo(gc.z), bfhi(xb.z) * bfhi(gc.z), bflo(xb.w) * bflo(gc.w), bfhi(xb.w) * bfhi(gc.w)};
                            const float gbv[8] = {bflo(gb.x), bfhi(gb.x), bflo(gb.y), bfhi(gb.y), bflo(gb.z), bfhi(gb.z), bflo(gb.w), bfhi(gb.w)};
                            float yv[8];
#pragma unroll
                            for (int k = 0; k < 8; ++k) { yv[k] = gbv[k] * (w0[k] * pm2[k] + w1[k] * pm1[k] + w2[k] * pv[k]); pm2[k] = pm1[k]; pm1[k] = pv[k]; }
                            u32x4 w; w.x = pk2(yv[0], yv[1]); w.y = pk2(yv[2], yv[3]); w.z = pk2(yv[4], yv[5]); w.w = pk2(yv[6], yv[7]);
                            *(u32x4*)(gY + (size_t)(rowbase + i) * D + 512 + c0) = w;
                        }
                        if (t0 + 8 == T) { float* o = out + (smp ? O_CBS : O_CBP) + ((size_t)(l * 8 + b) * 2) * BW + c0;
#pragma unroll
                            for (int k = 0; k < 8; ++k) { o[k] = pm2[k]; o[BW + k] = pm1[k]; } }
                    }
                }
            } else if (rep == 2) {
                LANE_STATE();
                {
                    LAS float* cr = (LAS float*)lds;
                    for (int un = bid; un < 8 + 256; un += G) {
                        int b, ch, rowbase, nrows; const bool smp = un < 8;
                        if (smp) { b = un; ch = 0; rowbase = MP + b * TS; nrows = TS; } else { const int v = un - 8; b = v >> 5; ch = v & 31; rowbase = b * SEQ + ch * 128; nrows = 128; }
                        {
                            const int c = tid, hd = c >> 6, ln = c & 63; float carry = 0.f;
                            if (smp) carry = INP(I_SHA)[(size_t)(l * BS + b) * AW + c];
                            else { const float* ag = AGG + (size_t)(64 + (b << 8) + (hd << 5)) * 128 + ln; for (int k = 0; k < ch; ++k) carry = ag[(size_t)k * 128] * carry + ag[(size_t)k * 128 + 64]; }
                            cr[c] = carry;
                        }
                        __syncthreads();
                        const int c0 = (tid & 63) * 8, rsub = tid >> 6;
                        const f32x4 ca = *(const LAS f32x4*)(cr + c0), cb = *(const LAS f32x4*)(cr + c0 + 4);
                        for (int p = 0; p < nrows / 8; ++p) {
                            const int rloc = p * 8 + rsub; const size_t row = (size_t)(rowbase + rloc);
                            const f32x4 h0 = *(const f32x4*)(HLOC + row * AW + c0), h1 = *(const f32x4*)(HLOC + row * AW + c0 + 4), p0 = *(const f32x4*)(PCUM + row * AW + c0), p1 = *(const f32x4*)(PCUM + row * AW + c0 + 4);
                            const u32x4 gq = *(const u32x4*)(gZ + row * INC + Z_GA + c0);
                            const f32x4 a0 = h0 + p0 * ca, a1 = h1 + p1 * cb;
                            u32x4 w; w.x = pk2(gelu_t(bflo(gq.x)) * a0[0], gelu_t(bfhi(gq.x)) * a0[1]); w.y = pk2(gelu_t(bflo(gq.y)) * a0[2], gelu_t(bfhi(gq.y)) * a0[3]);
                            w.z = pk2(gelu_t(bflo(gq.z)) * a1[0], gelu_t(bfhi(gq.z)) * a1[1]); w.w = pk2(gelu_t(bflo(gq.w)) * a1[2], gelu_t(bfhi(gq.w)) * a1[3]);
                            *(u32x4*)(gY + row * D + c0) = w;
                            if ((smp || ch == 31) && rloc == nrows - 1) { float* o = out + (smp ? O_HAS : O_HAP) + (size_t)(l * 8 + b) * AW + c0; *(f32x4*)o = a0; *(f32x4*)(o + 4) = a1; }
                        }
                        if ((smp || ch == 31) && tid < 192) {
                            const int k = tid >> 6; const u32x4 xq = *(const u32x4*)(gZ + (size_t)(rowbase + nrows - 3 + k) * INC + Z_XA + c0);
                            float* o = out + (smp ? O_CAS : O_CAP) + ((size_t)(l * 8 + b) * 3 + k) * AW + c0;
                            *(f32x4*)o = (f32x4){bflo(xq.x), bfhi(xq.x), bflo(xq.y), bfhi(xq.y)}; *(f32x4*)(o + 4) = (f32x4){bflo(xq.z), bfhi(xq.z), bflo(xq.w), bfhi(xq.w)};
                        }
                        __syncthreads();
                    }
                }
            } else if (rep == 3 || rep == 8 || rep == 12) {
                LANE_STATE();
                if (rep == 12) {
                    const float* cfw = INP(I_CFW) + (size_t)l * 3 * DFF;
                    pg8::GSched S0; S0.init(MP / 256, D / 256, G, bid); pg8::Unit u0;
                    for (int i = 0; S0.next(i, u0); ++i) {
                        const int pm = u0.pm; if (pm >= 128 || tid >= DFF / 8) continue;
                        const int c0 = tid * 8, b = pm >> 4;
                        float w0[8], w1[8], w2[8], p2[8], p1[8], g0[8], g1[8], u0_[8], u1_[8];
#pragma unroll
                        for (int k = 0; k < 8; ++k) { w0[k] = cfw[c0 + k]; w1[k] = cfw[DFF + c0 + k]; w2[k] = cfw[2 * DFF + c0 + k]; p2[k] = 0.f; p1[k] = 0.f; }
                        if ((pm & 15) != 0) {
#pragma unroll
                            for (int k = 0; k < 8; ++k) { p2[k] = SBL[((size_t)(pm - 1) * 2 + 0) * DFF + c0 + k]; p1[k] = SBL[((size_t)(pm - 1) * 2 + 1) * DFF + c0 + k]; } }
#pragma unroll
                        for (int k = 0; k < 8; ++k) { g0[k] = SBG[((size_t)pm * 2 + 0) * DFF + c0 + k]; g1[k] = SBG[((size_t)pm * 2 + 1) * DFF + c0 + k]; u0_[k] = SBU[((size_t)pm * 2 + 0) * DFF + c0 + k]; u1_[k] = SBU[((size_t)pm * 2 + 1) * DFF + c0 + k]; }
                        float ha[8], hb[8];
#pragma unroll
                        for (int k = 0; k < 8; ++k) { ha[k] = silu(w0[k] * p2[k] + w1[k] * p1[k] + w2[k] * g0[k]) * u0_[k]; hb[k] = silu(w0[k] * p1[k] + w1[k] * g0[k] + w2[k] * g1[k]) * u1_[k]; }
                        u32x4 w; w.x = pk2(ha[0], ha[1]); w.y = pk2(ha[2], ha[3]); w.z = pk2(ha[4], ha[5]); w.w = pk2(ha[6], ha[7]);
                        *(u32x4*)(GU + (size_t)(pm * 256) * DFF + c0) = w;
                        w.x = pk2(hb[0], hb[1]); w.y = pk2(hb[2], hb[3]); w.z = pk2(hb[4], hb[5]); w.w = pk2(hb[6], hb[7]);
                        *(u32x4*)(GU + (size_t)(pm * 256 + 1) * DFF + c0) = w;
                        if ((pm & 15) == 15 && u0.pn == 0) { float* o = out + O_CFP + ((size_t)(l * 8 + b) * 2) * DFF + c0;
#pragma unroll
                            for (int k = 0; k < 8; ++k) { o[k] = SBL[((size_t)pm * 2 + 0) * DFF + c0 + k]; o[DFF + k] = SBL[((size_t)pm * 2 + 1) * DFF + c0 + k]; } }
                    }
                    asm volatile("s_waitcnt vmcnt(0)" ::: "memory"); __syncthreads();
                }
                GEMM_RES(rep == 3 ? 0 : (rep == 8 ? 1 : 2));
                { LANE_STATE();
                  const SG2 sg{rep == 12 ? GU + (size_t)MP * DFF : (rep == 3 ? gY : gO) + (size_t)MP * D, rep == 12 ? WDN_T : (rep == 3 ? WOUT_T : WO_T), rep == 12 ? DFF : D, rep == 12 ? DFF : D, rep == 12 ? DFF : D, D, XN + (size_t)MP * D, D, 1.f, 2, SSS(3 * l + (rep == 3 ? 1 : (rep == 8 ? 2 : 3)))};
                  sgemm2(lds, sg, bid, G, wave, tid); }
                if (rep != 12 && l + 1 < DEPTH) { LANE_STATE(); if (bid >= 4) convert_layer(kp, ws, lds, l + 1, rep == 3 ? 0 : 2, 3, gw - 4 * NWAVES, NGW - 4 * NWAVES, gt - 4 * NTHREADS, NGT - 4 * NTHREADS, lane, wave); }
            } else if (rep == 6) {
                LANE_STATE();
                for (int sub = 0; sub < 2; ++sub) {
                    pg8::GSched S; pg8::Gemm g; pg8::EpiSoftmax E;
                    if (sub == 0) { S.init(MP / 256, 4, G, bid); S.aPm = (size_t)256 * D * 2; S.aPn = 512; S.bPn = 512; S.bPm = (size_t)256 * D * 2; S.bShift = 4; g = pg8::Gemm{gQ, KBP, D, D, 256}; E.O = gP; E.ldc = D; E.smp = 0; }
                    else { S.init(1, 32, G, (bid + G - 64) % G); S.mode = 1; g = pg8::Gemm{gQ + (size_t)MP * D, KBS, D, D, 256}; E.O = PS; E.ldc = 8192; E.smp = 1; }
                    pg8::gemm_phase<pg8::EpiSoftmax, pg8::GSched, true>(lds, g, S, E, wave_s);
                }
            }
            if (rep == 6) { asm volatile("s_waitcnt vmcnt(0)" ::: "memory"); __syncthreads(); }
            else GRID_SYNC();
          }
        }
    }
    {
        LANE_STATE();
        const float* gain = INP(I_GFIN);
        f32x4 gv[4];
#pragma unroll
        for (int j = 0; j < 4; ++j) gv[j] = ((const f32x4*)gain)[lane + 64 * j];
        for (int m0 = gw; m0 < MT; m0 += 2 * NGW) {
            const int m1 = m0 + NGW; const bool two = m1 < MT; const int mb = two ? m1 : m0;
            const u32x2* xa = (const u32x2*)(XN + (size_t)m0 * D) + lane; const u32x2* xb = (const u32x2*)(XN + (size_t)mb * D) + lane;
            u32x2 pa[4], pb[4];
#pragma unroll
            for (int j = 0; j < 4; ++j) { pa[j] = xa[64 * j]; pb[j] = xb[64 * j]; }
            float ra, rb;
            { float qa = 0.f, qb = 0.f;
#pragma unroll
              for (int j = 0; j < 4; ++j) { const float a0 = bflo(pa[j].x), a1 = bfhi(pa[j].x), a2 = bflo(pa[j].y), a3 = bfhi(pa[j].y), b0 = bflo(pb[j].x), b1 = bfhi(pb[j].x), b2 = bflo(pb[j].y), b3 = bfhi(pb[j].y);
                  qa += (a0 * a0 + a1 * a1) + (a2 * a2 + a3 * a3); qb += (b0 * b0 + b1 * b1) + (b2 * b2 + b3 * b3); }
              if (m0 < MP) ra = ss_rstd(*(const f32x4*)(SSQ(6) + (size_t)m0 * 4)); else ra = 1.0f / sqrtf(wave_sum(qa, lane) * (1.f / D) + EPS);
              if (mb < MP) rb = ss_rstd(*(const f32x4*)(SSQ(6) + (size_t)mb * 4)); else rb = 1.0f / sqrtf(wave_sum(qb, lane) * (1.f / D) + EPS); }
            f32x4* ya = (f32x4*)(out + (size_t)m0 * D) + lane; f32x4* yb = (f32x4*)(out + (size_t)mb * D) + lane;
#pragma unroll
            for (int j = 0; j < 4; ++j) { ya[64 * j] = (f32x4){bflo(pa[j].x), bfhi(pa[j].x), bflo(pa[j].y), bfhi(pa[j].y)} * ra * gv[j]; if (two) yb[64 * j] = (f32x4){bflo(pb[j].x), bfhi(pb[j].x), bflo(pb[j].y), bfhi(pb[j].y)} * rb * gv[j]; }
        }
    }
}

extern "C" void kernel_launch(void* const* d_in, const int* in_sizes, int n_in, void* d_out, int out_size, void* d_ws, size_t ws_size, hipStream_t stream) {
    static int grid = 0;
    if (grid == 0) {
        if (n_in != N_IN || (size_t)out_size != O_END || ws_size < WS_END) { fprintf(stderr, "kernel_launch: unexpected sizes n_in %d out %d ws %zu (need %zu)\n", n_in, out_size, ws_size, (size_t)WS_END); grid = -1; return; }
        int dev = 0, cus = 0, per_cu = 0;
        (void)hipGetDevice(&dev); (void)hipDeviceGetAttribute(&cus, hipDeviceAttributeMultiprocessorCount, dev);
        if (hipFuncSetAttribute((const void*)trunk_fwd, hipFuncAttributeMaxDynamicSharedMemorySize, LDS_BYTES) != hipSuccess) { fprintf(stderr, "kernel_launch: hipFuncSetAttribute failed\n"); grid = -1; return; }
        if (hipOccupancyMaxActiveBlocksPerMultiprocessor(&per_cu, (const void*)trunk_fwd, NTHREADS, LDS_BYTES) != hipSuccess || per_cu < 1) { fprintf(stderr, "kernel_launch: occupancy query gave %d\n", per_cu); per_cu = 1; }
        (void)hipGetLastError();
        grid = cus * 1;
        if (grid != 256) fprintf(stderr, "kernel_launch: note: %d CUs\n", grid);
    }
    if (grid < 0) return;
    Args a{};
    for (int i = 0; i < N_IN; ++i) a.in[i] = (const float*)d_in[i];
    a.out = (float*)d_out; a.ws = (unsigned char*)d_ws;
    void* kargs[] = {&a};
    hipError_t e = hipLaunchCooperativeKernel((const void*)trunk_fwd, dim3(grid), dim3(NTHREADS), kargs, LDS_BYTES, stream);
    if (e != hipSuccess) fprintf(stderr, "kernel_launch: cooperative launch failed: %s (grid %d)\n", hipGetErrorString(e), grid);
}
```

```cpp
#include <hip/hip_runtime.h>
#include <hip/hip_cooperative_groups.h>
#include <cstdio>
#include <cstdint>
namespace cg = cooperative_groups;
#ifndef PROBE
#define PROBE 0
#endif

#define LAS __attribute__((address_space(3)))
typedef unsigned short bf16_t;
typedef short bf16x8 __attribute__((ext_vector_type(8)));
typedef float f32x4 __attribute__((ext_vector_type(4)));
typedef float f32x2 __attribute__((ext_vector_type(2)));
typedef unsigned u32x4 __attribute__((ext_vector_type(4)));
typedef unsigned u32x2 __attribute__((ext_vector_type(2)));

constexpr int D = 1024, BP = 8, SEQ = 4096, BS = 8, TS = 32, DEPTH = 2;
constexpr int MP = BP * SEQ, MS = BS * TS, MT = MP + MS;
constexpr int INC = 2304, DFF = 2816, NMEM = 256, AW = 512, BW = 256, CW = 256;
constexpr int Z_XA = 0, Z_GA = 512, Z_XB = 1024, Z_GB = 1280, Z_GC = 1536, Z_UC = 1792, Z_VC = 2048;
constexpr float EPS = 1e-6f;
constexpr int NWAVES = 8, NTHREADS = 512;

constexpr size_t O_YP = 0, O_YS = O_YP + (size_t)MP * D, O_CAP = O_YS + (size_t)MS * D, O_HAP = O_CAP + DEPTH * BP * 3 * AW,
                 O_CBP = O_HAP + DEPTH * BP * AW, O_CFP = O_CBP + DEPTH * BP * 2 * BW, O_MKP = O_CFP + DEPTH * BP * 2 * DFF,
                 O_MVP = O_MKP + (size_t)DEPTH * BP * NMEM * D, O_CAS = O_MVP + (size_t)DEPTH * BP * NMEM * D, O_HAS = O_CAS + DEPTH * BS * 3 * AW,
                 O_CBS = O_HAS + DEPTH * BS * AW, O_CFS = O_CBS + DEPTH * BS * 2 * BW, O_VCS = O_CFS + DEPTH * BS * 2 * DFF,
                 O_END = O_VCS + DEPTH * BS * TS * CW;

constexpr size_t MiB = 1u << 20;
constexpr size_t WS_WIN = 0, WS_WOUT = 5 * MiB, WS_WQ = 7 * MiB, WS_WK = 9 * MiB, WS_WV = 11 * MiB, WS_WO = 13 * MiB, WS_WUP = 15 * MiB, WS_WDN = 26 * MiB;
constexpr size_t WS_MEMB = 32 * MiB, WS_KBP = 36 * MiB, WS_VTP = 40 * MiB, WS_KBS = 44 * MiB, WS_VTS = 48 * MiB, WS_WST = 52 * MiB, WS_GT = WS_WST + 131072, WS_AGG = 53 * MiB, WS_SS = 54 * MiB + 256 * 1024, WS_BAR = 55 * MiB + 512 * 1024;
constexpr size_t WS_XN = 56 * MiB, WS_BIG = 121 * MiB;
constexpr size_t B_Z = WS_BIG, B_HLOC = WS_BIG + 146 * MiB, B_PCUM = WS_BIG + 211 * MiB, B_Y = WS_BIG + 276 * MiB;
constexpr size_t B_Q = WS_BIG, B_P = WS_BIG + 65 * MiB, B_O = WS_BIG + 130 * MiB, B_PS = WS_BIG + 195 * MiB;
constexpr size_t B_GU = WS_BIG;
constexpr size_t B_GUS = WS_BIG + 200 * MiB;
constexpr size_t B_SBG = WS_BIG + 204 * MiB, B_SBU = WS_BIG + 207 * MiB, B_SBL = WS_BIG + 210 * MiB;
constexpr size_t WS_END = WS_BIG + (size_t)MT * 2 * DFF * 2;
constexpr size_t WS_SSP = 476 * MiB;
static_assert(WS_END <= WS_SSP && WS_SSP + (size_t)7 * MT * 64 <= 512 * MiB, "workspace");
static_assert(WS_XN + (size_t)MT * D * 2 <= WS_BIG, "xn");
constexpr size_t WS_SSS = WS_SSP + (((size_t)7 * MT * 16 + 4095) / 4096) * 4096;
static_assert(WS_SSS + 7 * 256 * 32 * 4 <= 480 * MiB, "sss");
constexpr size_t WSEL1 = 480 * MiB, KSEL1 = 418 * MiB;
static_assert(WS_WDN + (size_t)D * DFF * 2 + WSEL1 <= 512 * MiB && WS_KBS + KSEL1 >= WS_BIG + 341 * MiB && WS_GT + 131072 + KSEL1 <= WS_SSP, "second buffer set");

constexpr int LDS_RING = 131072, LDS_EX = LDS_RING, LDS_MISC = LDS_EX + 8192, LDS_BYTES = 147456;

enum { I_XP = 0, I_XS, I_MEM, I_CK, I_CV, I_SCA, I_SHA, I_SCB, I_SCF, I_GMIX, I_WIN, I_CAW, I_CAB, I_WRG, I_BRG, I_WIG, I_BIG, I_LAM, I_CBW, I_GV, I_WS, I_BSS,
       I_WOUT, I_GX, I_WQ, I_WK, I_WV, I_WO, I_GFFN, I_WUP, I_CFW, I_WDN, I_GFIN, N_IN };

struct Args { const float* in[N_IN]; float* out; unsigned char* ws; };

__device__ __forceinline__ unsigned pk2(float lo, float hi) { unsigned r; asm("v_cvt_pk_bf16_f32 %0, %1, %2" : "=v"(r) : "v"(lo), "v"(hi)); return r; }
__device__ __forceinline__ unsigned f2bf(float f) { return pk2(f, f) & 0xffffu; }
__device__ __forceinline__ float bf2f(unsigned v) { return __builtin_bit_cast(float, v << 16); }
__device__ __forceinline__ float bflo(unsigned w) { return __builtin_bit_cast(float, w << 16); }
__device__ __forceinline__ float bfhi(unsigned w) { return __builtin_bit_cast(float, w & 0xffff0000u); }
__device__ __forceinline__ unsigned cvt_pk_bf16(float lo, float hi) { unsigned r; asm volatile("v_cvt_pk_bf16_f32 %0, %1, %2" : "=v"(r) : "v"(lo), "v"(hi)); return r; }
__device__ __forceinline__ float fexp(float x) { return __builtin_amdgcn_exp2f(x * 1.4426950408889634f); }
__device__ __forceinline__ float sigm(float x) { return __builtin_amdgcn_rcpf(1.0f + fexp(-x)); }
__device__ __forceinline__ float gelu_t(float x) { const float u = 0.7978845608028654f * (x + 0.044715f * x * x * x); return x * sigm(2.0f * u); }
__device__ __forceinline__ float silu(float x) { return x * sigm(x); }
__device__ __forceinline__ float shx(float v, int m, int lane) { return __builtin_bit_cast(float, __builtin_amdgcn_ds_bpermute((lane ^ m) << 2, __builtin_bit_cast(int, v))); }
__device__ __forceinline__ float wave_sum(float v, int lane) {
#pragma unroll
    for (int o = 1; o < 64; o <<= 1) v += shx(v, o, lane);
    return v;
}
#define LDS_WAIT() asm volatile("s_waitcnt lgkmcnt(0)" ::: "memory")
__device__ __forceinline__ float ss_rstd(f32x4 p) { return 1.0f / sqrtf(((p[0] + p[1]) + (p[2] + p[3])) * (1.f / 1024.f) + 1e-6f); }
__device__ __forceinline__ int opaque_tid(int wave_s) { int l; asm volatile("v_mbcnt_lo_u32_b32 %0, -1, 0\n\tv_mbcnt_hi_u32_b32 %0, -1, %0" : "=v"(l)); return wave_s * 64 + l; }

namespace pg8 {
constexpr int BM = 256, BK = 64, HALF = 128, HTB = HALF * BK * 2, NXCD = 8, WGM = 8;
__device__ __forceinline__ int lds_byte(int r, int c) { const int st = (r >> 4) * 2 + (c >> 5), rr = r & 15, cc = c & 31, ob = rr * 64 + cc * 2; return st * 1024 + (ob ^ (((ob >> 9) & 1) << 5)); }
__device__ __forceinline__ void stage_rc(int b, int& R, int& C) { const int st = b / 1024, sb = b % 1024, swz = sb ^ (((sb >> 9) & 1) << 5); R = (st >> 1) * 16 + swz / 64; C = (st & 1) * 32 + (swz % 64) / 2; }
__device__ __forceinline__ int perm32(int rho) { const int n = rho >> 4, i = rho & 15; return 8 * (i >> 2) + 4 * n + (i & 3); }

struct Unit { int pm, pn; };
struct Gemm { const bf16_t* A; const bf16_t* Bt; int lda, ldb, K; };

struct GSched {
    int nM, nN, nwg, G, c, mode;
    size_t aPm, aPn, bPn, bPm; int bShift;
    __device__ __forceinline__ void init(int nM_, int nN_, int G_, int c_) { nM = nM_; nN = nN_; nwg = nM * nN; G = G_; c = c_; mode = 0; aPm = 0; aPn = 0; bPn = 0; bPm = 0; bShift = 0; }
    __device__ __forceinline__ bool next(int i, Unit& u) const {
        const long L = (long)i * G + c; if (L >= nwg) return false;
        int wgid = (int)L; { const int q = nwg / NXCD, r = nwg % NXCD, xcd = wgid % NXCD, off = wgid / NXCD; wgid = (xcd < r ? xcd * (q + 1) : r * (q + 1) + (xcd - r) * q) + off; }
        const int nig = WGM * nN, gid = wgid / nig, fm = gid * WGM, gsz = (nM - fm) < WGM ? (nM - fm) : WGM;
        u.pm = fm + ((wgid % nig) % gsz); u.pn = (wgid % nig) / gsz; return true;
    }
    __device__ __forceinline__ size_t offA(const Unit& u) const { return mode == 1 ? (size_t)(u.pn & 3) * 512 : (mode == 2 ? (size_t)(u.pn & 3) * 4096 + (size_t)(u.pn >> 2) * 512 : (size_t)u.pm * aPm + (size_t)u.pn * aPn); }
    __device__ __forceinline__ size_t offB(const Unit& u) const { return mode == 1 ? (size_t)(u.pn >> 2) * (256 * 1024 * 2) + (size_t)(u.pn & 3) * 512 : (mode == 2 ? (size_t)(u.pn & 3) * (256 * 2048 * 2) + (size_t)(u.pn >> 2) * 512 : (size_t)u.pn * bPn + (size_t)(u.pm >> bShift) * bPm); }
};

struct EpiBf16 {
    static constexpr bool PERM = true;
    bf16_t* O; int ldc; float scale; const float* ss; int smp;
    __device__ __forceinline__ void operator()(f32x4 (&acc)[2][2][4][2], const Unit& u, int wr, int wc, int fr, int fq, LAS unsigned char*) const {
        asm volatile("" : "+v"(fr), "+v"(fq)); asm volatile("" : "+s"(wr), "+s"(wc));
        const int row0 = u.pm * BM + wr * 64 + fr, col0 = (smp ? (u.pn & 3) : u.pn) * BM + wc * 32 + 8 * fq;
        f32x4 rs[2][4];
#pragma unroll
        for (int ai = 0; ai < 2; ++ai)
#pragma unroll
            for (int m = 0; m < 4; ++m) rs[ai][m] = ss ? *(const f32x4*)(ss + (size_t)(row0 + ai * HALF + m * 16) * 4) : (f32x4){0.f, 0.f, 0.f, 0.f};
#pragma unroll
        for (int ai = 0; ai < 2; ++ai)
#pragma unroll
            for (int m = 0; m < 4; ++m) { bf16_t* rowp = O + (size_t)(row0 + ai * HALF + m * 16) * ldc + col0;
                float sc = scale; if (ss) sc *= ss_rstd(rs[ai][m]);
                if (smp && ((ai * HALF + wr * 64 + m * 16 + fr) >> 5) != (u.pn >> 2)) continue;
#pragma unroll
                for (int bj = 0; bj < 2; ++bj) { const f32x4 v0 = acc[ai][bj][m][0] * sc, v1 = acc[ai][bj][m][1] * sc;
                    u32x4 w; w.x = cvt_pk_bf16(v0[0], v0[1]); w.y = cvt_pk_bf16(v0[2], v0[3]); w.z = cvt_pk_bf16(v1[0], v1[1]); w.w = cvt_pk_bf16(v1[2], v1[3]);
                    *(u32x4*)(rowp + bj * HALF) = w; } }
    }
};
struct EpiResid {
    static constexpr bool PERM = true;
    bf16_t* xb; float* ss;
    __device__ __forceinline__ void operator()(f32x4 (&acc)[2][2][4][2], const Unit& u, int wr, int wc, int fr, int fq, LAS unsigned char* lds) const {
        asm volatile("" : "+v"(fr), "+v"(fq)); asm volatile("" : "+s"(wr), "+s"(wc));
        const int col0 = u.pn * BM + wc * 32 + 8 * fq, lane = fq * 16 + fr;
        LAS float* PS = (LAS float*)(lds + LDS_EX);
        bf16_t* ob = xb + (size_t)u.pm * BM * D;
#pragma unroll
        for (int ai = 0; ai < 2; ++ai) {
            u32x4 pre[4][2];
#pragma unroll
            for (int m = 0; m < 4; ++m)
#pragma unroll
                for (int bj = 0; bj < 2; ++bj) pre[m][bj] = *(const u32x4*)(ob + (size_t)(ai * HALF + wr * 64 + m * 16 + fr) * D + col0 + bj * HALF);
            asm volatile("" ::: "memory");
#pragma unroll
            for (int m = 0; m < 4; ++m) { const int rl = ai * HALF + wr * 64 + m * 16 + fr; const size_t off = (size_t)rl * D + col0; float q = 0.f;
#pragma unroll
                for (int bj = 0; bj < 2; ++bj) { const u32x4 p = pre[m][bj]; const f32x4 a0 = acc[ai][bj][m][0], a1 = acc[ai][bj][m][1];
                    const float v0 = bflo(p.x) + a0[0], v1 = bfhi(p.x) + a0[1], v2 = bflo(p.y) + a0[2], v3 = bfhi(p.y) + a0[3], v4 = bflo(p.z) + a1[0], v5 = bfhi(p.z) + a1[1], v6 = bflo(p.w) + a1[2], v7 = bfhi(p.w) + a1[3];
                    u32x4 w; w.x = cvt_pk_bf16(v0, v1); w.y = cvt_pk_bf16(v2, v3); w.z = cvt_pk_bf16(v4, v5); w.w = cvt_pk_bf16(v6, v7); *(u32x4*)(ob + off + bj * HALF) = w;
                    q += ((v0 * v0 + v1 * v1) + (v2 * v2 + v3 * v3)) + ((v4 * v4 + v5 * v5) + (v6 * v6 + v7 * v7)); }
                q += shx(q, 16, lane); q += shx(q, 32, lane);
                if (fq == 0) PS[rl * 4 + wc] = q; }
            asm volatile("" ::: "memory");
        }
        asm volatile("s_waitcnt lgkmcnt(0)" ::: "memory"); __builtin_amdgcn_s_barrier(); asm volatile("" ::: "memory");
        { const int t = (wr * 4 + wc) * 64 + lane; if (t < 256) { const f32x4 p = *(const LAS f32x4*)(PS + t * 4); ss[(size_t)(u.pm * BM + t) * 4 + u.pn] = (p[0] + p[1]) + (p[2] + p[3]); } }
    }
};
struct EpiKV {
    static constexpr bool PERM = false;
    float* outK; float* outV; bf16_t* KB; bf16_t* VT;
    __device__ __forceinline__ void operator()(f32x4 (&acc)[2][2][4][2], const Unit& u, int wr, int wc, int fr, int fq, LAS unsigned char*) const {
        asm volatile("" : "+v"(fr), "+v"(fq)); asm volatile("" : "+s"(wr), "+s"(wc));
        const int kind = u.pm >> 4, pm = u.pm & 15;
        const int col0 = u.pn * BM + wc * 32 + 4 * fq;
        float* of = kind == 0 ? outK : outV; bf16_t* ob = kind == 0 ? KB : VT; const int ldb_ = kind == 2 ? 2048 : 1024;
#pragma unroll
        for (int ai = 0; ai < 2; ++ai)
#pragma unroll
            for (int m = 0; m < 4; ++m) { const int row = pm * BM + ai * HALF + wr * 64 + m * 16 + fr;
#pragma unroll
                for (int bj = 0; bj < 2; ++bj)
#pragma unroll
                    for (int n = 0; n < 2; ++n) { const f32x4 v = acc[ai][bj][m][n]; const int col = col0 + bj * HALF + n * 16;
                        if (kind != 2) *(f32x4*)(of + (size_t)row * 1024 + col) = v;
                        if (kind != 1) { u32x2 w; w.x = cvt_pk_bf16(v[0], v[1]); w.y = cvt_pk_bf16(v[2], v[3]); *(u32x2*)(ob + (size_t)row * ldb_ + col) = w; } } }
    }
};
struct EpiSoftmax {
    static constexpr bool PERM = true;
    bf16_t* O; int ldc; int smp;
    __device__ __forceinline__ void operator()(f32x4 (&acc)[2][2][4][2], const Unit& u, int wr, int wc, int fr, int fq, LAS unsigned char* lds) const {
        asm volatile("" : "+v"(fr), "+v"(fq)); asm volatile("" : "+s"(wr), "+s"(wc));
        LAS f32x2* EX = (LAS f32x2*)(lds + LDS_EX);
        const int lane = fq * 16 + fr;
        const float L2E = 1.4426950408889634f;
#pragma unroll
        for (int ai = 0; ai < 2; ++ai)
#pragma unroll
            for (int m = 0; m < 4; ++m) {
                float mx = -3.0e38f;
#pragma unroll
                for (int bj = 0; bj < 2; ++bj)
#pragma unroll
                    for (int n = 0; n < 2; ++n) { const f32x4 x = acc[ai][bj][m][n]; mx = fmaxf(mx, fmaxf(fmaxf(x[0], x[1]), fmaxf(x[2], x[3]))); }
                mx = fmaxf(mx, shx(mx, 16, lane)); mx = fmaxf(mx, shx(mx, 32, lane));
                float s = 0.f;
#pragma unroll
                for (int bj = 0; bj < 2; ++bj)
#pragma unroll
                    for (int n = 0; n < 2; ++n) { f32x4 x = acc[ai][bj][m][n];
#pragma unroll
                        for (int j = 0; j < 4; ++j) { x[j] = __builtin_amdgcn_exp2f((x[j] - mx) * L2E); s += x[j]; }
                        acc[ai][bj][m][n] = x; }
                s += shx(s, 16, lane); s += shx(s, 32, lane);
                if (fq == 0) EX[(ai * HALF + wr * 64 + m * 16 + fr) * 4 + wc] = (f32x2){mx, s};
            }
        asm volatile("s_waitcnt lgkmcnt(0)" ::: "memory"); __builtin_amdgcn_s_barrier(); asm volatile("" ::: "memory");
        int colb = u.pn * BM, j_ = 0;
        if (smp) { colb = (u.pn & 3) * 2048 + (u.pn >> 2) * 256; j_ = u.pn >> 2; }
        const int col0 = colb + wc * 32 + 8 * fq;
#pragma unroll
        for (int ai = 0; ai < 2; ++ai)
#pragma unroll
            for (int m = 0; m < 4; ++m) {
                const int rl = ai * HALF + wr * 64 + m * 16 + fr;
                const f32x2 e0 = EX[rl * 4 + 0], e1 = EX[rl * 4 + 1], e2 = EX[rl * 4 + 2], e3 = EX[rl * 4 + 3];
                const float M = fmaxf(fmaxf(e0.x, e1.x), fmaxf(e2.x, e3.x));
                const float tot = e0.y * __builtin_amdgcn_exp2f((e0.x - M) * L2E) + e1.y * __builtin_amdgcn_exp2f((e1.x - M) * L2E) + e2.y * __builtin_amdgcn_exp2f((e2.x - M) * L2E) + e3.y * __builtin_amdgcn_exp2f((e3.x - M) * L2E);
                const float own = wc == 0 ? e0.x : (wc == 1 ? e1.x : (wc == 2 ? e2.x : e3.x));
                float f = __builtin_amdgcn_exp2f((own - M) * L2E) / tot;
                if (smp && (rl >> 5) != j_) f = 0.f;
                bf16_t* rowp = O + (size_t)(u.pm * BM + rl) * ldc + col0;
#pragma unroll
                for (int bj = 0; bj < 2; ++bj) { const f32x4 v0 = acc[ai][bj][m][0] * f, v1 = acc[ai][bj][m][1] * f;
                    u32x4 w; w.x = cvt_pk_bf16(v0[0], v0[1]); w.y = cvt_pk_bf16(v0[2], v0[3]); w.z = cvt_pk_bf16(v1[0], v1[1]); w.w = cvt_pk_bf16(v1[2], v1[3]);
                    *(u32x4*)(rowp + bj * HALF) = w; } }
    }
};


__device__ __forceinline__ float dpp_ror1(float v) { return __builtin_bit_cast(float, __builtin_amdgcn_update_dpp(0, __builtin_bit_cast(int, v), 0x121, 0xf, 0xf, false)); }
__device__ __forceinline__ float dpp_ror2(float v) { return __builtin_bit_cast(float, __builtin_amdgcn_update_dpp(0, __builtin_bit_cast(int, v), 0x122, 0xf, 0xf, false)); }
struct EpiAct {
    static constexpr bool PERM = true;
    bf16_t* H; const float* scf; float* ocf; float* sbg; float* sbu; float* sbl; const float* cfw; const float* ss;
    __device__ __forceinline__ void operator()(f32x4 (&acc)[2][2][4][2], const Unit& u, int wr, int wc, int fr, int fq, LAS unsigned char* lds) const {
        asm volatile("" : "+s"(wr), "+s"(wc));
        int lane; asm volatile("v_mbcnt_lo_u32_b32 %0, -1, 0\n\tv_mbcnt_hi_u32_b32 %0, -1, %0" : "=v"(lane));
        fr = lane & 15; fq = lane >> 4;
        const int fl = wc * 32 + 8 * fq, f0 = u.pn * 128 + fl; int rowt = wr * 64 + fr;
        {
            float rst[2][4];
            f32x4 rsl[2][4];
#pragma unroll
            for (int ai = 0; ai < 2; ++ai)
#pragma unroll
                for (int m = 0; m < 4; ++m) rsl[ai][m] = *(const f32x4*)(ss + (size_t)(u.pm * BM + ai * HALF + rowt + m * 16) * 4);
#pragma unroll
            for (int ai = 0; ai < 2; ++ai)
#pragma unroll
                for (int m = 0; m < 4; ++m) { rst[ai][m] = ss_rstd(rsl[ai][m]); }
#pragma unroll
            for (int ai = 0; ai < 2; ++ai)
#pragma unroll
                for (int m = 0; m < 4; ++m) { acc[ai][0][m][0] = acc[ai][0][m][0] * rst[ai][m]; acc[ai][0][m][1] = acc[ai][0][m][1] * rst[ai][m]; acc[ai][1][m][0] = acc[ai][1][m][0] * rst[ai][m]; acc[ai][1][m][1] = acc[ai][1][m][1] * rst[ai][m]; }
        }
        const bool smp = (u.pm == 128);
        asm volatile("" : "+v"(rowt));
        LAS float* BND = (LAS float*)(lds + LDS_EX);
        if (fr >= 14) {
#pragma unroll
            for (int ai = 0; ai < 2; ++ai)
#pragma unroll
                for (int n = 0; n < 2; ++n) *(LAS f32x4*)(BND + ((ai * 2 + wr) * 2 + (fr - 14)) * 128 + fl + 4 * n) = acc[ai][0][3][n];
            if (wr == 1) {
#pragma unroll
                for (int n = 0; n < 2; ++n) *(f32x4*)(sbl + ((size_t)u.pm * 2 + (fr - 14)) * DFF + f0 + 4 * n) = acc[1][0][3][n];
            }
        }
        asm volatile("s_waitcnt lgkmcnt(0)" ::: "memory"); __builtin_amdgcn_s_barrier(); asm volatile("" ::: "memory");
#pragma unroll
        for (int ai = 0; ai < 2; ++ai) {
            const int pg = wr == 1 ? ai * 2 : 1;
            u32x2 hp[2][4];
#pragma unroll
            for (int n = 0; n < 2; ++n) {
                const f32x4 w0 = *(const f32x4*)(cfw + f0 + 4 * n), w1 = *(const f32x4*)(cfw + DFF + f0 + 4 * n), w2 = *(const f32x4*)(cfw + 2 * DFF + f0 + 4 * n);
                f32x4 h2 = *(const LAS f32x4*)(BND + (pg * 2 + 0) * 128 + fl + 4 * n), h1 = *(const LAS f32x4*)(BND + (pg * 2 + 1) * 128 + fl + 4 * n);
                f32x4 t2 = h2, t1 = h1;
                if (smp) { const float* sp = scf + (size_t)((ai * 4 + wr * 2) * 2) * DFF + f0 + 4 * n; h2 = *(const f32x4*)sp; h1 = *(const f32x4*)(sp + DFF); t2 = *(const f32x4*)(sp + 2 * DFF); t1 = *(const f32x4*)(sp + 3 * DFF); }
#pragma unroll
                for (int jp = 0; jp < 2; ++jp) {
                    float hv[4][2];
#pragma unroll
                    for (int jj = 0; jj < 2; ++jj) { const int j = jp * 2 + jj;
                        float r1p = h1[j], r2p = fr == 0 ? h2[j] : h1[j];
#pragma unroll
                        for (int m = 0; m < 4; ++m) { const float g = acc[ai][0][m][n][j];
                            if (m == 2 && smp) { r1p = t1[j]; r2p = fr == 0 ? t2[j] : t1[j]; }
                            const float r1 = dpp_ror1(g), r2 = dpp_ror2(g);
                            const float gm1 = fr >= 1 ? r1 : r1p, gm2 = fr >= 2 ? r2 : r2p;
                            r1p = r1; r2p = r2;
                            const float cv = w0[j] * gm2 + w1[j] * gm1 + w2[j] * g;
                            hv[m][jj] = silu(cv) * acc[ai][1][m][n][j]; } }
#pragma unroll
                    for (int m = 0; m < 4; ++m) { const unsigned pk = cvt_pk_bf16(hv[m][0], hv[m][1]); if (jp == 0) hp[n][m].x = pk; else hp[n][m].y = pk; }
                }
            }
#pragma unroll
            for (int m = 0; m < 4; ++m) {
                const int rl = ai * HALF + rowt + m * 16;
                if (smp && (m & 1) && fr >= 14) {
#pragma unroll
                    for (int n = 0; n < 2; ++n) *(f32x4*)(ocf + ((size_t)(ai * 4 + wr * 2 + (m >> 1)) * 2 + (fr - 14)) * DFF + f0 + 4 * n) = acc[ai][0][m][n];
                }
                if (!smp && ai == 0 && m == 0 && wr == 0 && fr < 2) {
#pragma unroll
                    for (int n = 0; n < 2; ++n) { *(f32x4*)(sbg + ((size_t)u.pm * 2 + fr) * DFF + f0 + 4 * n) = acc[0][0][0][n]; *(f32x4*)(sbu + ((size_t)u.pm * 2 + fr) * DFF + f0 + 4 * n) = acc[0][1][0][n]; }
                } else {
                    u32x4 w; w.x = hp[0][m].x; w.y = hp[0][m].y; w.z = hp[1][m].x; w.w = hp[1][m].y;
                    *(u32x4*)(H + (size_t)(u.pm * BM + rl) * DFF + f0) = w;
                }
            }
        }
    }
};

template <class Epi, class Sched, bool ALIGN_EPI>
__device__ __forceinline__ void gemm_phase(LAS unsigned char* lds, const Gemm g, const Sched& S, const Epi& E, const int wave_s) {
    const int tid = opaque_tid(wave_s), wid = __builtin_amdgcn_readfirstlane(tid >> 6), lane = tid & 63, wr = wid >> 2, wc = wid & 3, fr = lane & 15, fq = lane >> 4;
    const int nt = g.K / BK;
    unsigned voffA[2], voffB[2];
#pragma unroll
    for (int i = 0; i < 2; ++i) { int R, C; stage_rc(tid * 16 + i * 8192, R, C); const int Rb = Epi::PERM ? ((R & ~31) + perm32(R & 31)) : R;
        voffA[i] = (unsigned)(R * g.lda + C) * 2u; voffB[i] = (unsigned)(Rb * g.ldb + C) * 2u; }
    const size_t kstep = (size_t)(BK * 2);
    const size_t hstepA = (size_t)HALF * g.lda * 2, hstepB = (size_t)HALF * g.ldb * 2;
    const unsigned ldsw = (unsigned)wid * 1024u;
    const int aoff = lds_byte(wr * 64 + fr, fq * 8), boff = lds_byte(wc * 32 + fr, fq * 8);
#define PG8_SA(b, h) (((b) * 2 + (h)) * HTB)
#define PG8_SB(b, h) ((4 + (b) * 2 + (h)) * HTB)
#define PG8_STAGE(bufoff, gbase, voff) do { _Pragma("unroll") for (int _i = 0; _i < 2; ++_i) \
        __builtin_amdgcn_global_load_lds((const unsigned*)((const char*)(gbase) + (voff)[_i]), (LAS unsigned*)(lds + (bufoff) + ldsw + _i * 8192), 16, 0, 0); } while (0)
#define PG8_LDA(dst, b, h) do { _Pragma("unroll") for (int m = 0; m < 4; ++m) _Pragma("unroll") for (int k = 0; k < 2; ++k) dst[m][k] = *(const LAS bf16x8*)(lds + PG8_SA(b, h) + aoff + m * 2048 + k * 1024); } while (0)
#define PG8_LDB(dst, b, h) do { _Pragma("unroll") for (int n = 0; n < 2; ++n) _Pragma("unroll") for (int k = 0; k < 2; ++k) dst[n][k] = *(const LAS bf16x8*)(lds + PG8_SB(b, h) + boff + n * 2048 + k * 1024); } while (0)
#define PG8_MMA(ai, bj, At, Bt) do { __builtin_amdgcn_s_setprio(1); _Pragma("unroll") for (int m = 0; m < 4; ++m) _Pragma("unroll") for (int n = 0; n < 2; ++n) _Pragma("unroll") for (int k = 0; k < 2; ++k) \
        acc[ai][bj][m][n] = __builtin_amdgcn_mfma_f32_16x16x32_bf16(Bt[n][k], At[m][k], acc[ai][bj][m][n], 0, 0, 0); __builtin_amdgcn_s_setprio(0); } while (0)
#define PG8_WAIT_V(n) asm volatile("s_waitcnt vmcnt(" #n ")" ::: "memory")
#define PG8_WAIT_L(n) asm volatile("s_waitcnt lgkmcnt(" #n ")" ::: "memory")
#define PG8_BAR __builtin_amdgcn_s_barrier()
#define PG8_SCHED __builtin_amdgcn_sched_barrier(0)
    Unit cur, nxt; int ui = 0;
    if (!S.next(0, cur)) return;
    f32x4 acc[2][2][4][2];
#pragma unroll
    for (int a = 0; a < 2; ++a)
#pragma unroll
        for (int b = 0; b < 2; ++b)
#pragma unroll
            for (int m = 0; m < 4; ++m)
#pragma unroll
                for (int n = 0; n < 2; ++n) acc[a][b][m][n] = (f32x4){0.f, 0.f, 0.f, 0.f};
    bf16x8 At[4][2], B0[2][2], B1[2][2];
    const char* cA = (const char*)g.A + S.offA(cur); const char* cB = (const char*)g.Bt + S.offB(cur);
    PG8_STAGE(PG8_SB(0, 0), cB, voffB); PG8_STAGE(PG8_SB(0, 1), cB + hstepB, voffB); PG8_STAGE(PG8_SA(0, 0), cA, voffA); PG8_STAGE(PG8_SA(0, 1), cA + hstepA, voffA);
    if (wr == 1) PG8_BAR;
    PG8_WAIT_V(2); PG8_BAR;
    PG8_STAGE(PG8_SB(1, 0), cB + kstep, voffB); PG8_STAGE(PG8_SA(1, 0), cA + kstep, voffA); PG8_STAGE(PG8_SB(1, 1), cB + hstepB + kstep, voffB);
    PG8_WAIT_V(6); PG8_BAR;
    for (;;) {
        const bool has_next = S.next(ui + 1, nxt);
        const char* nA = has_next ? (const char*)g.A + S.offA(nxt) : cA; const char* nB = has_next ? (const char*)g.Bt + S.offB(nxt) : cB;
        for (int t = 0; t < nt; t += 2) {
            const bool last = (t == nt - 2);
            const char* a1 = cA + (size_t)(t + 1) * kstep;
            const char* a2 = last ? nA : cA + (size_t)(t + 2) * kstep; const char* b2 = last ? nB : cB + (size_t)(t + 2) * kstep;
            const char* a3 = a2 + kstep; const char* b3 = b2 + kstep;
            PG8_LDB(B0, 0, 0); PG8_LDB(B1, 0, 1); PG8_SCHED; PG8_LDA(At, 0, 0); PG8_STAGE(PG8_SA(1, 1), a1 + hstepA, voffA);
            PG8_WAIT_V(8); PG8_WAIT_L(0); PG8_BAR; PG8_MMA(0, 0, At, B0); PG8_MMA(0, 1, At, B1); PG8_BAR; PG8_SCHED;
            PG8_LDA(At, 0, 1); PG8_STAGE(PG8_SB(0, 0), b2, voffB); PG8_STAGE(PG8_SB(0, 1), b2 + hstepB, voffB); PG8_STAGE(PG8_SA(0, 0), a2, voffA);
            PG8_WAIT_V(8); PG8_WAIT_L(0); PG8_BAR; PG8_MMA(1, 0, At, B0); PG8_MMA(1, 1, At, B1); PG8_BAR; PG8_SCHED;
            PG8_LDB(B0, 1, 0); PG8_LDB(B1, 1, 1); PG8_SCHED; PG8_LDA(At, 1, 0); PG8_STAGE(PG8_SA(0, 1), a2 + hstepA, voffA);
            PG8_WAIT_V(8); PG8_WAIT_L(0); PG8_BAR; PG8_MMA(0, 0, At, B0); PG8_MMA(0, 1, At, B1); PG8_BAR; PG8_SCHED;
            PG8_LDA(At, 1, 1); PG8_STAGE(PG8_SB(1, 0), b3, voffB); PG8_STAGE(PG8_SB(1, 1), b3 + hstepB, voffB); PG8_STAGE(PG8_SA(1, 0), a3, voffA);
            PG8_WAIT_V(8); PG8_WAIT_L(0); PG8_BAR; PG8_MMA(1, 0, At, B0); PG8_MMA(1, 1, At, B1); PG8_BAR; PG8_SCHED;
        }
        if constexpr (ALIGN_EPI) { if (wr == 0) PG8_BAR; }
        E(acc, cur, wr, wc, fr, fq, lds);
        if (!has_next) break;
#pragma unroll
        for (int a = 0; a < 2; ++a)
#pragma unroll
            for (int b = 0; b < 2; ++b)
#pragma unroll
                for (int m = 0; m < 4; ++m)
#pragma unroll
                    for (int n = 0; n < 2; ++n) acc[a][b][m][n] = (f32x4){0.f, 0.f, 0.f, 0.f};
        cur = nxt; cA = nA; cB = nB; ++ui;
        if constexpr (ALIGN_EPI) { if (wr == 1) PG8_BAR; }
    }
    PG8_WAIT_V(0);
    if constexpr (!ALIGN_EPI) { if (wr == 0) PG8_BAR; }
    PG8_BAR;
#undef PG8_SA
#undef PG8_SB
#undef PG8_STAGE
#undef PG8_LDA
#undef PG8_LDB
#undef PG8_MMA
#undef PG8_WAIT_V
#undef PG8_WAIT_L
#undef PG8_BAR
#undef PG8_SCHED
}
}

struct KVSched {
    int c, G; const char* ws; size_t wsel;
    __device__ __forceinline__ bool next(int i, pg8::Unit& u) const {
        const int L = i * G + c; if (c < 0 || L >= 96) return false;
        const int kind = L >> 5, r = L & 31;
        if (kind < 2) { u.pm = kind * 16 + (r >> 2); u.pn = r & 3; } else { u.pm = 32 + (r >> 3); u.pn = r & 7; }
        return true;
    }
    __device__ __forceinline__ size_t offA(const pg8::Unit& u) const { const int kind = u.pm >> 4, pm = u.pm & 15; int k2 = (kind == 2); asm volatile("" : "+v"(k2));
        return (size_t)ws + WS_MEMB + (size_t)k2 * (WS_WV + wsel - WS_MEMB) + (size_t)pm * 256 * 1024 * 2; }
    __device__ __forceinline__ size_t offB(const pg8::Unit& u) const { const int kind = u.pm >> 4; int k1 = (kind == 1), k2 = (kind == 2); asm volatile("" : "+v"(k1), "+v"(k2));
        return (size_t)ws + WS_WK + wsel + (size_t)k1 * (WS_WV - WS_WK) + (size_t)k2 * (WS_MEMB - WS_WK - wsel) + (size_t)u.pn * 256 * 1024 * 2; }
};


#define XB_TMO      128
#define XB_XCNT(j)  (256  + 64 * (j))
#define XB_XSUB(j)  (1280 + 64 * (j))
#define XB_XGEN(j)  (2304 + 64 * (j))
#define XB_TOP      3328
#define XB_TOPGEN   3392
#define XCD_BAR_WORDS 3456
#define XB_SPIN_CAP (1u << 22)
__device__ __forceinline__ unsigned xb_ld(unsigned* p)              { return __hip_atomic_load(p, __ATOMIC_RELAXED, __HIP_MEMORY_SCOPE_AGENT); }
__device__ __forceinline__ unsigned xb_add(unsigned* p, unsigned v) { return __hip_atomic_fetch_add(p, v, __ATOMIC_RELAXED, __HIP_MEMORY_SCOPE_AGENT); }
__device__ __forceinline__ unsigned xb_xcc_id() { return (unsigned)__builtin_amdgcn_s_getreg((3 << 11) | 20) & 0xFu; }
#define XB_SPIN(cond, bar) do { unsigned _sp = 0; while (cond) { __builtin_amdgcn_s_sleep(1); \
    if ((++_sp & 255u) == 0u) { if (xb_ld(&(bar)[XB_TMO])) break; if (_sp > XB_SPIN_CAP) { atomicAdd(&(bar)[XB_TMO], 1u); break; } } } } while (0)
struct XcdBarrier { unsigned* bar; unsigned x; volatile LAS unsigned* st; };
__device__ __forceinline__ void xcd_barrier_complete(unsigned* bar, unsigned x, unsigned& nloc, unsigned& nx) {
    const unsigned G = gridDim.x * gridDim.y * gridDim.z;
    unsigned sum, cnt, mine, sp = 0u;
    for (;;) {
        sum = 0u; cnt = 0u; mine = 0u;
#pragma unroll
        for (unsigned j = 0; j < 16; ++j) { const unsigned c = xb_ld(&bar[XB_XCNT(j)]); sum += c; cnt += (c > 0u) ? 1u : 0u; mine = (j == x) ? c : mine; }
        if (sum == G) break;
        __builtin_amdgcn_s_sleep(1);
        if ((++sp & 255u) == 0u) { if (xb_ld(&bar[XB_TMO])) break; if (sp > XB_SPIN_CAP) { atomicAdd(&bar[XB_TMO], 1u); break; } }
    }
    nloc = mine > 0u ? mine : 1u; nx = cnt > 0u ? cnt : 1u;
}
__device__ __forceinline__ void xcd_barrier(const XcdBarrier& b) {
    asm volatile("s_waitcnt vmcnt(0)" ::: "memory");
    __syncthreads();
    if (threadIdx.x == 0) {
        unsigned* bar = b.bar;
        __builtin_amdgcn_s_waitcnt(0);
        unsigned nloc = b.st[0], nx = b.st[1];
        if (nloc == 0u) { xcd_barrier_complete(bar, b.x, nloc, nx); b.st[0] = nloc; b.st[1] = nx; }
        const unsigned old = xb_add(&bar[XB_XSUB(b.x)], 1u);
        const unsigned gen = old / nloc;
        if (old + 1u == (gen + 1u) * nloc) {
            __builtin_amdgcn_fence(__ATOMIC_RELEASE, "agent");
            asm volatile("s_waitcnt vmcnt(0)" ::: "memory");
            const unsigned og = xb_add(&bar[XB_TOP], 1u);
            const unsigned tg = og / nx;
            if (og + 1u == (tg + 1u) * nx) xb_add(&bar[XB_TOPGEN], 1u);
            else XB_SPIN(xb_ld(&bar[XB_TOPGEN]) == tg, bar);
            __builtin_amdgcn_fence(__ATOMIC_ACQUIRE, "agent");
            xb_add(&bar[XB_XGEN(b.x)], 1u);
            asm volatile("s_waitcnt vmcnt(0)" ::: "memory");
        } else {
            XB_SPIN(xb_ld(&bar[XB_XGEN(b.x)]) == gen, bar);
            __builtin_amdgcn_fence(__ATOMIC_ACQUIRE, "agent");
            asm volatile("s_waitcnt vmcnt(0)" ::: "memory");
        }
    }
    __syncthreads();
}


struct SG2 { const bf16_t* A; const bf16_t* Bt; int lda, ldb, K, N; bf16_t* O; int ldc; float scale; int mode; float* ssp; };
__device__ __forceinline__ float sq8(bf16x8 a) { float q = 0.f;
#pragma unroll
    for (int i = 0; i < 8; ++i) { const float f = bf2f((unsigned)(unsigned short)a[i]); q += f * f; } return q; }
__device__ __forceinline__ void sgemm2(LAS unsigned char* lds, const SG2 g, int ubase, int G, int wave, int tid) {
    const int lane = tid & 63, fr = lane & 15, fq = lane >> 4, rt = wave & 3, ch = wave >> 2;
    const int nunits = (g.N / 64) * 4, nsl = g.K / 64;
    int R, C; pg8::stage_rc(tid * 16, R, C);
    const unsigned offA = (unsigned)(R * g.lda + C) * 2u, offB = (unsigned)(R * g.ldb + C) * 2u;
    const int aoff = pg8::lds_byte(rt * 16 + fr, fq * 8), boff = pg8::lds_byte(ch * 32 + fr, fq * 8);
    for (int un = ubase; un >= 0 && un < nunits; un += G) {
        const int cgp = un >> 2, rg = un & 3;
        const char* gA = (const char*)(g.A + (size_t)rg * 64 * g.lda) + offA; const char* gB = (const char*)(g.Bt + (size_t)cgp * 64 * g.ldb) + offB;
#define SG2_STAGE(sl) do { LAS unsigned char* d_ = lds + ((sl) & 3) * 16384 + wave * 1024; \
        __builtin_amdgcn_global_load_lds((const unsigned*)(gA + (size_t)(sl) * 128), (LAS unsigned*)d_, 16, 0, 0); \
        __builtin_amdgcn_global_load_lds((const unsigned*)(gB + (size_t)(sl) * 128), (LAS unsigned*)(d_ + 8192), 16, 0, 0); } while (0)
        asm volatile("s_waitcnt vmcnt(0)" ::: "memory");
        SG2_STAGE(0); SG2_STAGE(1);
        f32x4 acc[2] = {(f32x4){0.f, 0.f, 0.f, 0.f}, (f32x4){0.f, 0.f, 0.f, 0.f}}; float q = 0.f;
        for (int sl = 0; sl < nsl; ++sl) {
            if (sl + 1 < nsl) asm volatile("s_waitcnt vmcnt(2)" ::: "memory"); else asm volatile("s_waitcnt vmcnt(0)" ::: "memory");
            __builtin_amdgcn_s_barrier(); asm volatile("" ::: "memory");
            if (sl + 2 < nsl) SG2_STAGE(sl + 2);
            LAS unsigned char* b_ = lds + (sl & 3) * 16384;
#pragma unroll
            for (int ks = 0; ks < 2; ++ks) {
                const bf16x8 a = *(const LAS bf16x8*)(b_ + aoff + ks * 1024);
#pragma unroll
                for (int c = 0; c < 2; ++c) { const bf16x8 b = *(const LAS bf16x8*)(b_ + 8192 + boff + c * 2048 + ks * 1024);
                    acc[c] = __builtin_amdgcn_mfma_f32_16x16x32_bf16(b, a, acc[c], 0, 0, 0); }
                if (g.mode == 1) q += sq8(a);
            }
        }
#undef SG2_STAGE
        const int row = rg * 64 + rt * 16 + fr, col = cgp * 64 + ch * 32 + fq * 4;
        bf16_t* op = g.O + (size_t)row * g.ldc + col;
        if (g.mode == 1) {
            q += shx(q, 16, lane); q += shx(q, 32, lane);
            const float sc = g.scale / sqrtf(q * (1.f / 1024.f) + EPS);
#pragma unroll
            for (int c = 0; c < 2; ++c) { const f32x4 v = acc[c] * sc; u32x2 w; w.x = cvt_pk_bf16(v[0], v[1]); w.y = cvt_pk_bf16(v[2], v[3]); *(u32x2*)(op + c * 16) = w; }
        } else {
            const u32x2 p0 = *(const u32x2*)op, p1 = *(const u32x2*)(op + 16); float qq = 0.f;
            { const float v0 = bflo(p0.x) + acc[0][0], v1 = bfhi(p0.x) + acc[0][1], v2 = bflo(p0.y) + acc[0][2], v3 = bfhi(p0.y) + acc[0][3];
              u32x2 w; w.x = cvt_pk_bf16(v0, v1); w.y = cvt_pk_bf16(v2, v3); *(u32x2*)op = w; qq += (v0 * v0 + v1 * v1) + (v2 * v2 + v3 * v3); }
            { const float v0 = bflo(p1.x) + acc[1][0], v1 = bfhi(p1.x) + acc[1][1], v2 = bflo(p1.y) + acc[1][2], v3 = bfhi(p1.y) + acc[1][3];
              u32x2 w; w.x = cvt_pk_bf16(v0, v1); w.y = cvt_pk_bf16(v2, v3); *(u32x2*)(op + 16) = w; qq += (v0 * v0 + v1 * v1) + (v2 * v2 + v3 * v3); }
            qq += shx(qq, 16, lane); qq += shx(qq, 32, lane);
            if (fq == 0) g.ssp[row * 32 + cgp * 2 + ch] = qq;
        }
        asm volatile("s_waitcnt vmcnt(0) lgkmcnt(0)" ::: "memory"); __builtin_amdgcn_s_barrier(); asm volatile("" ::: "memory");
    }
}

__device__ __forceinline__ void sgemm_act(LAS unsigned char* lds, const bf16_t* A, const bf16_t* Bt, bf16_t* Hs, const float* cfw, const float* scf, float* ocf, int ubase, int G, int wave, int tid) {
    const int lane = tid & 63, fr = lane & 15, fq = lane >> 4, rt = wave & 3, ch = wave >> 2;
    constexpr int nunits = (DFF / 64) * 4, nsl = D / 64, SLOT = 24576;
    int R, C; pg8::stage_rc(tid * 16, R, C);
    const unsigned off = (unsigned)(R * D + C) * 2u;
    const int aoff = pg8::lds_byte(rt * 16 + fr, fq * 8), boff = pg8::lds_byte(fr, fq * 8) + 8192 + ch * 8192;
    for (int un = ubase; un >= 0 && un < nunits; un += G) {
        const int fg = un >> 2, rg = un & 3, brow = ((fg >> 1) << 8) + ((fg & 1) << 6);
        const char* gA = (const char*)(A + (size_t)rg * 64 * D) + off; const char* gG = (const char*)(Bt + (size_t)brow * D) + off; const char* gU = (const char*)(Bt + (size_t)(brow + 128) * D) + off;
#define SGA_STAGE(sl) do { LAS unsigned char* d_ = lds + ((sl) & 3) * SLOT + wave * 1024; \
        __builtin_amdgcn_global_load_lds((const unsigned*)(gA + (size_t)(sl) * 128), (LAS unsigned*)d_, 16, 0, 0); \
        __builtin_amdgcn_global_load_lds((const unsigned*)(gG + (size_t)(sl) * 128), (LAS unsigned*)(d_ + 8192), 16, 0, 0); \
        __builtin_amdgcn_global_load_lds((const unsigned*)(gU + (size_t)(sl) * 128), (LAS unsigned*)(d_ + 16384), 16, 0, 0); } while (0)
        asm volatile("s_waitcnt vmcnt(0)" ::: "memory");
        SGA_STAGE(0); SGA_STAGE(1);
        f32x4 acc[4]; float q = 0.f;
#pragma unroll
        for (int c = 0; c < 4; ++c) acc[c] = (f32x4){0.f, 0.f, 0.f, 0.f};
        for (int sl = 0; sl < nsl; ++sl) {
            if (sl + 1 < nsl) asm volatile("s_waitcnt vmcnt(3)" ::: "memory"); else asm volatile("s_waitcnt vmcnt(0)" ::: "memory");
            __builtin_amdgcn_s_barrier(); asm volatile("" ::: "memory");
            if (sl + 2 < nsl) SGA_STAGE(sl + 2);
            LAS unsigned char* b_ = lds + (sl & 3) * SLOT;
#pragma unroll
            for (int ks = 0; ks < 2; ++ks) {
                const bf16x8 a = *(const LAS bf16x8*)(b_ + aoff + ks * 1024);
#pragma unroll
                for (int c = 0; c < 4; ++c) { const bf16x8 b = *(const LAS bf16x8*)(b_ + boff + c * 2048 + ks * 1024);
                    acc[c] = __builtin_amdgcn_mfma_f32_16x16x32_bf16(b, a, acc[c], 0, 0, 0); }
                q += sq8(a);
            }
        }
#undef SGA_STAGE
        q += shx(q, 16, lane); q += shx(q, 32, lane);
        const float rstd = 1.0f / sqrtf(q * (1.f / 1024.f) + EPS);
        asm volatile("s_waitcnt lgkmcnt(0)" ::: "memory"); __builtin_amdgcn_s_barrier(); asm volatile("" ::: "memory");
        LAS float* T = (LAS float*)(lds + ch * 20480);
#pragma unroll
        for (int c = 0; c < 4; ++c)
#pragma unroll
            for (int j = 0; j < 4; ++j) T[(rt * 16 + fr) * 65 + c * 16 + fq * 4 + j] = acc[c][j] * rstd;
        asm volatile("s_waitcnt lgkmcnt(0)" ::: "memory"); __builtin_amdgcn_s_barrier(); asm volatile("" ::: "memory");
        {
            const LAS float* Gt = (const LAS float*)lds; const LAS float* Ut = (const LAS float*)(lds + 20480);
            const int r = tid >> 3, f8 = (tid & 7) * 8, b = rg * 2 + (r >> 5), rr = r & 31, f = fg * 64 + f8;
            const float* st = scf + (size_t)(b * 2) * DFF + f;
            float hv[8], gv[8];
#pragma unroll
            for (int k = 0; k < 8; ++k) {
                const float g0 = Gt[r * 65 + f8 + k];
                const float gm1 = rr >= 1 ? Gt[(r - 1) * 65 + f8 + k] : st[DFF + k];
                const float gm2 = rr >= 2 ? Gt[(r - 2) * 65 + f8 + k] : (rr == 1 ? st[DFF + k] : st[k]);
                const float cv = cfw[f + k] * gm2 + cfw[DFF + f + k] * gm1 + cfw[2 * DFF + f + k] * g0;
                hv[k] = silu(cv) * Ut[r * 65 + f8 + k]; gv[k] = g0;
            }
            u32x4 w; w.x = pk2(hv[0], hv[1]); w.y = pk2(hv[2], hv[3]); w.z = pk2(hv[4], hv[5]); w.w = pk2(hv[6], hv[7]);
            *(u32x4*)(Hs + (size_t)(rg * 64 + r) * DFF + f) = w;
            if (rr >= 30) { float* o = ocf + ((size_t)b * 2 + (rr - 30)) * DFF + f; *(f32x4*)o = (f32x4){gv[0], gv[1], gv[2], gv[3]}; *(f32x4*)(o + 4) = (f32x4){gv[4], gv[5], gv[6], gv[7]}; }
        }
        asm volatile("s_waitcnt vmcnt(0) lgkmcnt(0)" ::: "memory"); __builtin_amdgcn_s_barrier(); asm volatile("" ::: "memory");
    }
}
__device__ __forceinline__ void sample_ss_reduce(const float* sss, float* ssq, int tid) {
    if (tid < 256) { const f32x4* p = (const f32x4*)(sss + tid * 32); float t = 0.f;
#pragma unroll
        for (int i = 0; i < 8; ++i) { const f32x4 v = p[i]; t += (v[0] + v[1]) + (v[2] + v[3]); }
        *(f32x4*)(ssq + (size_t)(MP + tid) * 4) = (f32x4){t, 0.f, 0.f, 0.f}; }
    asm volatile("s_waitcnt vmcnt(0)" ::: "memory"); __syncthreads();
}

__device__ __forceinline__ void transpose_item(const float* W, int K, int N, bf16_t* WT, LAS float* scr, int item, int lane, const float* gain = nullptr, int gu = 0) {
    const int nblk = N / 32, kb = item / nblk, nb = item % nblk, k0 = 64 * kb, n0 = 32 * nb;
    {
        f32x4 v[8];
#pragma unroll
        for (int i = 0; i < 8; ++i) v[i] = *(const f32x4*)(W + (size_t)(k0 + (lane >> 3) + 8 * i) * N + n0 + (lane & 7) * 4);
#pragma unroll
        for (int i = 0; i < 8; ++i) { const int kk = (lane >> 3) + 8 * i; f32x4 w = v[i]; if (gain) w = w * gain[k0 + kk];
            LAS float* d = scr + kk * 33 + (lane & 7) * 4; d[0] = w[0]; d[1] = w[1]; d[2] = w[2]; d[3] = w[3]; }
    }
    LDS_WAIT();
    const int c = lane & 7;
#pragma unroll
    for (int j = 0; j < 4; ++j) { const int n = (lane >> 3) + 8 * j; const LAS float* s = scr + (8 * c) * 33 + n;
        u32x4 o; o.x = pk2(s[0 * 33], s[1 * 33]); o.y = pk2(s[2 * 33], s[3 * 33]); o.z = pk2(s[4 * 33], s[5 * 33]); o.w = pk2(s[6 * 33], s[7 * 33]);
        int drow = n0 + n; if (gu) { const int up = drow >= gu, f = up ? drow - gu : drow; drow = ((f >> 7) << 8) + (up << 7) + (f & 127); }
        *(u32x4*)(WT + (size_t)drow * K + k0 + 8 * c) = o; }
    LDS_WAIT();
}

__device__ __forceinline__ void first_rows(const float* Xp, const float* Xs, bf16_t* XNo, float* ss, int gw, int NGW, int lane) {
    for (int m0 = gw; m0 < MT; m0 += 2 * NGW) {
        const int m1 = m0 + NGW; const bool two = m1 < MT; const int mb = two ? m1 : m0;
        const f32x4* xa = (const f32x4*)(m0 < MP ? Xp + (size_t)m0 * D : Xs + (size_t)(m0 - MP) * D) + lane;
        const f32x4* xb = (const f32x4*)(mb < MP ? Xp + (size_t)mb * D : Xs + (size_t)(mb - MP) * D) + lane;
        f32x4 va[4], vb[4]; float sa = 0.f, sb = 0.f;
#pragma unroll
        for (int j = 0; j < 4; ++j) { va[j] = xa[64 * j]; vb[j] = xb[64 * j]; }
#pragma unroll
        for (int j = 0; j < 4; ++j) { sa += (va[j].x * va[j].x + va[j].y * va[j].y) + (va[j].z * va[j].z + va[j].w * va[j].w); sb += (vb[j].x * vb[j].x + vb[j].y * vb[j].y) + (vb[j].z * vb[j].z + vb[j].w * vb[j].w); }
        sa = wave_sum(sa, lane); sb = wave_sum(sb, lane);
        if (lane < 4) { ss[(size_t)m0 * 4 + lane] = lane == 0 ? sa : 0.f; if (two) ss[(size_t)m1 * 4 + lane] = lane == 0 ? sb : 0.f; }
        u32x2* oa = (u32x2*)(XNo + (size_t)m0 * D) + lane; u32x2* ob = (u32x2*)(XNo + (size_t)mb * D) + lane;
#pragma unroll
        for (int j = 0; j < 4; ++j) { u32x2 w; w.x = pk2(va[j].x, va[j].y); w.y = pk2(va[j].z, va[j].w); oa[64 * j] = w; if (two) { w.x = pk2(vb[j].x, vb[j].y); w.y = pk2(vb[j].z, vb[j].w); ob[64 * j] = w; } }
    }
}

typedef __attribute__((address_space(4))) const unsigned char* kptr_t;
typedef const float* cfp_t; typedef float* fp_t; typedef unsigned char* ucp_t;
#define INP(k) (*(const __attribute__((address_space(4))) cfp_t*)(kp + 8 * (k)))
#define X out
#define WIN_T ((bf16_t*)(ws + WS_WIN + wsel))
#define WOUT_T ((bf16_t*)(ws + WS_WOUT + wsel))
#define WQ_T ((bf16_t*)(ws + WS_WQ + wsel))
#define WK_T ((bf16_t*)(ws + WS_WK + wsel))
#define WV_T ((bf16_t*)(ws + WS_WV + wsel))
#define WO_T ((bf16_t*)(ws + WS_WO + wsel))
#define WUP_T ((bf16_t*)(ws + WS_WUP + wsel))
#define WDN_T ((bf16_t*)(ws + WS_WDN + wsel))
#define MEMB ((bf16_t*)(ws + WS_MEMB))
#define KBP ((bf16_t*)(ws + WS_KBP))
#define VTP ((bf16_t*)(ws + WS_VTP))
#define KBS ((bf16_t*)(ws + WS_KBS + ksel))
#define VTS ((bf16_t*)(ws + WS_VTS + ksel))
#define WST ((bf16_t*)(ws + WS_WST + ksel))
#define AGG ((float*)(ws + WS_AGG))
#define SSQ(i) ((float*)(ws + WS_SSP) + (size_t)(i) * MT * 4)
#define SSS(i) ((float*)(ws + WS_SSS) + (size_t)(i) * 256 * 32)
#define GT_R ((bf16_t*)(ws + WS_GT + ksel))
#define GT_I ((bf16_t*)(ws + WS_GT + 65536 + ksel))
#define XN ((bf16_t*)(ws + WS_XN))
#define gZ ((bf16_t*)(ws + B_Z))
#define HLOC ((float*)(ws + B_HLOC))
#define PCUM ((float*)(ws + B_PCUM))
#define gY ((bf16_t*)(ws + B_Y))
#define gQ ((bf16_t*)(ws + B_Q))
#define gP ((bf16_t*)(ws + B_P))
#define gO ((bf16_t*)(ws + B_O))
#define PS ((bf16_t*)(ws + B_PS))
#define GU ((bf16_t*)(ws + B_GU))
#define GUS ((bf16_t*)(ws + B_GUS))
#define SBG ((float*)(ws + B_SBG))
#define SBU ((float*)(ws + B_SBU))
#define SBL ((float*)(ws + B_SBL))
__device__ __forceinline__ void convert_layer(kptr_t kp, unsigned char* ws, LAS unsigned char* lds, const int l, const int part, const int nparts, const int gw, const int NGW, const int gt, const int NGT, const int lane, const int wave) {
            const size_t wsel = (size_t)(l & 1) * WSEL1, ksel = (size_t)(l & 1) * KSEL1;
            LAS float* scr = (LAS float*)(lds + wave * 16384);
            const float* w_in = INP(I_WIN) + (size_t)l * D * INC; const float* w_out = INP(I_WOUT) + (size_t)l * D * D; const float* w_q = INP(I_WQ) + (size_t)l * D * D;
            const float* w_k = INP(I_WK) + (size_t)l * D * D; const float* w_v = INP(I_WV) + (size_t)l * D * D; const float* w_o = INP(I_WO) + (size_t)l * D * D;
            const float* w_up = INP(I_WUP) + (size_t)l * D * 2 * DFF; const float* w_dn = INP(I_WDN) + (size_t)l * DFF * D; const float* c_v = INP(I_CV) + (size_t)l * BS * NMEM * D;
            constexpr int T_IN = 16 * (INC / 32), T_SQ = 16 * 32, T_UP = 16 * (2 * DFF / 32), T_DN = (DFF / 64) * 32, T_CV = 32 * 32;
            constexpr int T_G = 16;
            constexpr int NIT = T_IN + 5 * T_SQ + T_UP + T_DN + T_CV + 2 * T_G;
            for (int it = (NIT * part) / nparts + gw; it < (NIT * (part + 1)) / nparts; it += NGW) {
                int r = it;
                if (r < T_IN) { transpose_item(w_in, D, INC, WIN_T, scr, r, lane, INP(I_GMIX) + l * D); continue; } r -= T_IN;
                if (r < T_SQ) { transpose_item(w_out, D, D, WOUT_T, scr, r, lane); continue; } r -= T_SQ;
                if (r < T_SQ) { transpose_item(w_q, D, D, WQ_T, scr, r, lane, INP(I_GX) + l * D); continue; } r -= T_SQ;
                if (r < T_SQ) { transpose_item(w_k, D, D, WK_T, scr, r, lane); continue; } r -= T_SQ;
                if (r < T_SQ) { transpose_item(w_v, D, D, WV_T, scr, r, lane); continue; } r -= T_SQ;
                if (r < T_SQ) { transpose_item(w_o, D, D, WO_T, scr, r, lane); continue; } r -= T_SQ;
                if (r < T_UP) { transpose_item(w_up, D, 2 * DFF, WUP_T, scr, r, lane, INP(I_GFFN) + l * D, DFF); continue; } r -= T_UP;
                if (r < T_DN) { transpose_item(w_dn, DFF, D, WDN_T, scr, r, lane); continue; } r -= T_DN;
                if (r < T_CV) { transpose_item(c_v, BS * NMEM, D, VTS, scr, r, lane); continue; } r -= T_CV;
                if (r < T_G) { transpose_item(INP(I_WRG) + ((size_t)l * 8 + (r >> 1)) * 4096, 64, 64, GT_R + (r >> 1) * 4096, scr, r & 1, lane); continue; } r -= T_G;
                transpose_item(INP(I_WIG) + ((size_t)l * 8 + (r >> 1)) * 4096, 64, 64, GT_I + (r >> 1) * 4096, scr, r & 1, lane);
            }
            if (part == 0) {
                const f32x4* ck = (const f32x4*)(INP(I_CK) + (size_t)l * BS * NMEM * D); u32x2* dk = (u32x2*)KBS;
                for (int i = gt; i < BS * NMEM * D / 4; i += NGT) { const f32x4 v = ck[i]; u32x2 w; w.x = pk2(v.x, v.y); w.y = pk2(v.z, v.w); dk[i] = w; }
                if (l == 0) { const f32x4* mm = (const f32x4*)INP(I_MEM); u32x2* dm = (u32x2*)MEMB;
                    for (int i = gt; i < BP * NMEM * D / 4; i += NGT) { const f32x4 v = mm[i]; u32x2 w; w.x = pk2(v.x, v.y); w.y = pk2(v.z, v.w); dm[i] = w; } }
                const float* wsl = INP(I_WS) + (size_t)l * 4 * 128 * 128;
                for (int i = gt; i < 4 * 128 * 128; i += NGT) { const int s = i & 127, t = (i >> 7) & 127; WST[i] = (bf16_t)f2bf(s <= t ? wsl[i] : 0.f); }
            }
}

__global__ void __launch_bounds__(NTHREADS, 2) trunk_fwd(Args args) {
    extern __shared__ __attribute__((aligned(16))) unsigned char lds_raw[];
    LAS unsigned char* lds = (LAS unsigned char*)lds_raw;
    cg::grid_group grid = cg::this_grid();
    const int wave_s = __builtin_amdgcn_readfirstlane(threadIdx.x >> 6);
#define LANE_STATE() int G = gridDim.x, bid = blockIdx.x; asm volatile("" : "+s"(G), "+s"(bid)); const int NGW = G * NWAVES, NGT = G * NTHREADS; (void)NGW; (void)NGT; \
    const int tid = opaque_tid(wave_s), lane = tid & 63, wave = wave_s; const int gw = bid * NWAVES + wave; const int gt = bid * NTHREADS + tid; (void)lane; (void)gw; (void)gt; \
    kptr_t kp = (kptr_t)__builtin_amdgcn_kernarg_segment_ptr(); asm volatile("" : "+s"(kp)); \
    float* const out = *(const __attribute__((address_space(4))) fp_t*)(kp + 8 * N_IN); unsigned char* const ws = *(const __attribute__((address_space(4))) ucp_t*)(kp + 8 * N_IN + 8); (void)out; (void)ws
    {
        LANE_STATE();
        if (bid == 0) for (int i = tid; i < XCD_BAR_WORDS; i += NTHREADS) __hip_atomic_store((unsigned*)(ws + WS_BAR) + i, 0u, __ATOMIC_RELAXED, __HIP_MEMORY_SCOPE_AGENT);
        if (tid < 32) ((LAS unsigned*)(lds + LDS_MISC))[tid] = 0u;
        __threadfence();
        grid.sync();
        if (tid == 0) (void)xb_add((unsigned*)(ws + WS_BAR) + XB_XCNT(xb_xcc_id()), 1u);
    }
#define GRID_SYNC() do { kptr_t kp_ = (kptr_t)__builtin_amdgcn_kernarg_segment_ptr(); asm volatile("" : "+s"(kp_)); \
        XcdBarrier b_; b_.bar = (unsigned*)(*(const __attribute__((address_space(4))) ucp_t*)(kp_ + 8 * N_IN + 8) + WS_BAR); b_.x = xb_xcc_id(); b_.st = (volatile LAS unsigned*)(lds + LDS_MISC); \
        xcd_barrier(b_); if (PROBE == 3) xcd_barrier(b_); } while (0)

    for (int l = 0; l < DEPTH; ++l) {
        const size_t wsel = (size_t)(l & 1) * WSEL1, ksel = (size_t)(l & 1) * KSEL1;
        if (l == 0)
        for (int dup0 = 0; dup0 < ((PROBE == 1 || PROBE == 5) ? 2 : 1); ++dup0) {
        {
            LANE_STATE();
            convert_layer(kp, ws, lds, l, 0, 1, gw, NGW, gt, NGT, lane, wave);
            if (l == 0) first_rows(INP(I_XP), INP(I_XS), XN, SSQ(0), gw, NGW, lane);
        }
        GRID_SYNC();
        }
        {
            LANE_STATE();
            KVSched S; S.G = G; S.c = bid >= 160 ? bid - 160 : -1; S.ws = (const char*)ws; S.wsel = wsel;
            pg8::Gemm g{(const bf16_t*)nullptr, (const bf16_t*)nullptr, D, D, D};
            pg8::EpiKV E{out + O_MKP + (size_t)l * BP * NMEM * D, out + O_MVP + (size_t)l * BP * NMEM * D, KBP, VTP};
            pg8::gemm_phase<pg8::EpiKV, KVSched, true>(lds, g, S, E, wave_s);
        }
#define GEMM_BF16(s_) do { const int s = (s_); pg8::GSched S; pg8::Gemm g; pg8::EpiBf16 E; E.scale = 1.f; E.ss = nullptr; E.smp = 0; \
        if (s == 0) { S.init(MT / 256, INC / 256, G, bid); S.aPm = (size_t)256 * D * 2; S.bPn = (size_t)256 * D * 2; g = pg8::Gemm{XN, WIN_T, D, D, D}; E.O = gZ; E.ldc = INC; E.ss = SSQ(3 * l); } \
        else if (s == 1) { S.init(MP / 256, D / 256, G, bid); S.aPm = (size_t)256 * D * 2; S.bPn = (size_t)256 * D * 2; g = pg8::Gemm{XN, WQ_T, D, D, D}; E.O = gQ; E.ldc = D; E.scale = 0.0625f; E.ss = SSQ(3 * l + 1); } \
        else if (s == 2) { S.init(MP / 256, 4, G, bid); S.aPm = (size_t)256 * D * 2; S.aPn = 512; S.bPn = (size_t)256 * 2048 * 2; S.bPm = 512; S.bShift = 4; g = pg8::Gemm{gP, VTP, D, 2048, 256}; E.O = gO; E.ldc = D; } \
        else { S.init(1, 32, G, (bid + G - 64) % G); S.mode = 2; g = pg8::Gemm{PS, VTS, 8192, 2048, 256}; E.O = gO + (size_t)MP * D; E.ldc = D; E.smp = 1; } \
        pg8::gemm_phase<pg8::EpiBf16, pg8::GSched, true>(lds, g, S, E, wave_s); } while (0)
#define GEMM_RES(s_) do { const int s = (s_); pg8::GSched S; S.init(MP / 256, D / 256, G, bid); pg8::Gemm g; \
        if (s == 0) { g = pg8::Gemm{gY, WOUT_T, D, D, D}; S.aPm = (size_t)256 * D * 2; } \
        else if (s == 1) { g = pg8::Gemm{gO, WO_T, D, D, D}; S.aPm = (size_t)256 * D * 2; } \
        else { g = pg8::Gemm{GU, WDN_T, DFF, DFF, DFF}; S.aPm = (size_t)256 * DFF * 2; } \
        S.bPn = (size_t)256 * g.ldb * 2; \
        pg8::EpiResid E{XN, SSQ(3 * l + 1 + s)}; \
        pg8::gemm_phase<pg8::EpiResid, pg8::GSched, true>(lds, g, S, E, wave_s); } while (0)

        for (int rep = 0; rep < 13; ++rep) { if (rep == 4 || rep == 9 || rep == 11) continue;
          const int ndup = ((PROBE == 1 && (rep == 1 || rep == 2)) || (PROBE == 4 && rep == 1) || (PROBE == 6 && rep == 2)) ? 2 : ((PROBE == 2 && (rep == 0 || rep == 5 || rep == 6 || rep == 7 || rep == 10)) ? 2 : 1);
          for (int dup = 0; dup < ndup; ++dup) {
            if (rep == 0 || rep == 5 || rep == 7) {
                LANE_STATE();
                const int s0 = rep == 0 ? 0 : (rep == 5 ? 1 : 2), ns = rep == 7 ? 2 : 1;
                if (rep == 0 && l > 0) {
                    pg8::GSched S0; S0.init(MT / 256, INC / 256, G, bid); pg8::Unit u0; bool own = false;
                    for (int i = 0; S0.next(i, u0); ++i) own = own || (u0.pm == 128);
                    if (own) sample_ss_reduce(SSS(3 * l), SSQ(3 * l), tid);
                }
                for (int q = 0; q < ns; ++q) GEMM_BF16(s0 + q);
                if (rep == 5) { LANE_STATE(); const SG2 sg{XN + (size_t)MP * D, WQ_T, D, D, D, D, gQ + (size_t)MP * D, D, 0.0625f, 1, nullptr}; sgemm2(lds, sg, bid, G, wave, tid); }
                if (rep == 5 && l + 1 < DEPTH) { LANE_STATE(); if (bid >= 4) convert_layer(kp, ws, lds, l + 1, 1, 3, gw - 4 * NWAVES, NGW - 4 * NWAVES, gt - 4 * NTHREADS, NGT - 4 * NTHREADS, lane, wave); }
            } else if (rep == 10) {
                LANE_STATE();
                pg8::GSched S; S.init(MP / 256, 2 * DFF / 256, G, bid); S.aPm = (size_t)256 * D * 2; S.bPn = (size_t)256 * D * 2;
                const pg8::Gemm g{XN, WUP_T, D, D, D};
                const pg8::EpiAct E{GU, INP(I_SCF) + (size_t)l * BS * 2 * DFF, out + O_CFS + (size_t)l * BS * 2 * DFF, SBG, SBU, SBL, INP(I_CFW) + (size_t)l * 3 * DFF, SSQ(3 * l + 2)};
                pg8::gemm_phase<pg8::EpiAct, pg8::GSched, true>(lds, g, S, E, wave_s);
                { LANE_STATE(); sgemm_act(lds, XN + (size_t)MP * D, WUP_T, GU + (size_t)MP * DFF, INP(I_CFW) + (size_t)l * 3 * DFF, INP(I_SCF) + (size_t)l * BS * 2 * DFF, out + O_CFS + (size_t)l * BS * 2 * DFF, bid, G, wave, tid); }
            } else if (rep == 1) {
                LANE_STATE();
                {
                    LAS bf16_t* vT = (LAS bf16_t*)lds;
                    constexpr int VP = 136;
                    const float* gvp = INP(I_GV) + l * CW; const float* bsp = INP(I_BSS) + l * 4 * 128;
                    for (int un = (bid + G / 2) % G; un < 8 + 256; un += G) {
                        int rowbase, nrows, sb = -1;
                        if (un < 8) { sb = un; rowbase = MP + un * TS; nrows = TS; } else { rowbase = (un - 8) * 128; nrows = 128; }
                        {
                            const int rl = tid >> 5, cgp = tid & 31;
                            f32x4 g0 = *(const f32x4*)(gvp + cgp * 8), g1 = *(const f32x4*)(gvp + cgp * 8 + 4);
                            for (int p = 0; p < nrows / 16; ++p) {
                                const int r = p * 16 + rl;
                                const u32x4 raw = *(const u32x4*)(gZ + (size_t)(rowbase + r) * INC + Z_VC + cgp * 8);
                                float v[8] = {bflo(raw.x), bfhi(raw.x), bflo(raw.y), bfhi(raw.y), bflo(raw.z), bfhi(raw.z), bflo(raw.w), bfhi(raw.w)};
                                float ss = 0.f;
#pragma unroll
                                for (int k = 0; k < 8; ++k) { v[k] = gelu_t(v[k]); ss += v[k] * v[k]; }
                                ss += shx(ss, 1, lane); ss += shx(ss, 2, lane); ss += shx(ss, 4, lane);
                                const float rstd = 1.0f / sqrtf(ss * (1.f / 64.f) + EPS);
                                const float gg[8] = {g0.x, g0.y, g0.z, g0.w, g1.x, g1.y, g1.z, g1.w};
#pragma unroll
                                for (int k = 0; k < 8; ++k) { v[k] = v[k] * rstd * gg[k]; vT[(cgp * 8 + k) * VP + r] = (bf16_t)f2bf(v[k]); }
                                if (sb >= 0) { float* vo = out + O_VCS + ((size_t)(l * BS + sb) * TS + r) * CW + cgp * 8;
                                    *(f32x4*)vo = (f32x4){v[0], v[1], v[2], v[3]}; *(f32x4*)(vo + 4) = (f32x4){v[4], v[5], v[6], v[7]}; }
                            }
                        }
                        __syncthreads();
                        {
                            const int hh = wave & 3, rh = wave >> 2, fr = lane & 15, fq = lane >> 4;
                            const int nmt = nrows == 128 ? 4 : (rh == 0 ? 2 : 0);
                            for (int mi = 0; mi < nmt; ++mi) {
                                const int mt = rh * 4 + mi, nks = (mt * 16 + 15) / 32 + 1;
                                f32x4 acc[4];
#pragma unroll
                                for (int n = 0; n < 4; ++n) acc[n] = (f32x4){0.f, 0.f, 0.f, 0.f};
                                for (int ks = 0; ks < nks; ++ks) {
                                    const bf16x8 a = *(const bf16x8*)(WST + ((size_t)(hh * 128 + mt * 16 + fr) * 128 + ks * 32 + fq * 8));
#pragma unroll
                                    for (int n = 0; n < 4; ++n) { const bf16x8 b = *(const LAS bf16x8*)(vT + (hh * 64 + n * 16 + fr) * VP + ks * 32 + fq * 8);
                                        acc[n] = __builtin_amdgcn_mfma_f32_16x16x32_bf16(b, a, acc[n], 0, 0, 0); }
                                }
                                { const int t = mt * 16 + fr; const float bias = bsp[hh * 128 + t]; const size_t row = (size_t)(rowbase + t);
#pragma unroll
                                    for (int n = 0; n < 4; ++n) { const int c = hh * 64 + n * 16 + fq * 4; const u32x2 uq = *(const u32x2*)(gZ + row * INC + Z_UC + c);
                                        u32x2 w; w.x = pk2(gelu_t(bflo(uq.x)) * (acc[n][0] + bias), gelu_t(bfhi(uq.x)) * (acc[n][1] + bias)); w.y = pk2(gelu_t(bflo(uq.y)) * (acc[n][2] + bias), gelu_t(bfhi(uq.y)) * (acc[n][3] + bias));
                                        *(u32x2*)(gY + row * D + 768 + c) = w; } }
                            }
                        }
                        __syncthreads();
                    }
                }
                {
                    LAS unsigned char* wl = lds + wave * 16384;
                    LAS bf16_t* tile = (LAS bf16_t*)wl;
                    LAS float* pre_r = (LAS float*)(wl + 2560);
                    LAS float* pre_i = (LAS float*)(wl + 2560 + 4096);
                    LAS float* xcf = (LAS float*)(wl + 2560 + 8192);
                    const int fr = lane & 15, fq = lane >> 4;
                    for (int un = gw; un < 64 + 2048; un += NGW) {
                        int b, hd, rowbase, nrows, t0; bool smp = un < 64;
                        if (smp) { b = un >> 3; hd = un & 7; rowbase = MP + b * TS; nrows = TS; t0 = 0; }
                        else { const int v = un - 64; const int ch = v & 31; hd = (v >> 5) & 7; b = v >> 8; t0 = ch * 128; rowbase = b * SEQ + t0; nrows = 128; }
                        const int cidx = l * AW + hd * 64 + lane;
                        const float br = INP(I_BRG)[cidx], bi = INP(I_BIG)[cidx];
                        const float c8sp = 8.0f * log1pf(__expf(-INP(I_LAM)[cidx]));
                        const float* caw = INP(I_CAW) + (size_t)l * 4 * AW + hd * 64 + lane;
                        const float cw0 = caw[0], cw1 = caw[AW], cw2 = caw[2 * AW], cw3 = caw[3 * AW], cb = INP(I_CAB)[cidx];
                        bf16x8 bR[4][2], bI[4][2];
#pragma unroll
                        for (int n = 0; n < 4; ++n)
#pragma unroll
                            for (int ks = 0; ks < 2; ++ks) { const size_t o_ = (size_t)(hd * 64 + n * 16 + fr) * 64 + ks * 32 + fq * 8;
                                bR[n][ks] = *(const bf16x8*)(GT_R + o_); bI[n][ks] = *(const bf16x8*)(GT_I + o_); }
                        float xm3 = 0.f, xm2 = 0.f, xm1 = 0.f;
                        if (smp) { const float* st = INP(I_SCA) + ((size_t)(l * BS + b) * 3) * AW + hd * 64 + lane; xm3 = st[0]; xm2 = st[AW]; xm1 = st[2 * AW]; }
                        else if (t0 > 0) { const bf16_t* zp = gZ + (size_t)(rowbase - 3) * INC + Z_XA + hd * 64 + lane; xm3 = bf2f(zp[0]); xm2 = bf2f(zp[INC]); xm1 = bf2f(zp[2 * INC]); }
                        float h = 0.f, pc = 1.f;
                        const bf16_t* zq = gZ + (size_t)(rowbase + (lane >> 3)) * INC + Z_XA + hd * 64 + (lane & 7) * 8;
                        float* hp = HLOC + (size_t)rowbase * AW + hd * 64 + lane; float* pp = PCUM + (size_t)rowbase * AW + hd * 64 + lane;
                        LAS bf16_t* xraw = (LAS bf16_t*)pre_r;
                        u32x4 xn0 = *(const u32x4*)zq, xn1 = *(const u32x4*)(zq + (size_t)8 * INC);
                        for (int st = 0; st < nrows / 16; ++st) {
                            *(LAS u32x4*)(xraw + (lane >> 3) * 64 + (lane & 7) * 8) = xn0; *(LAS u32x4*)(xraw + ((lane >> 3) + 8) * 64 + (lane & 7) * 8) = xn1;
                            zq += (size_t)16 * INC;
                            if (st + 1 < nrows / 16) { xn0 = *(const u32x4*)zq; xn1 = *(const u32x4*)(zq + (size_t)8 * INC); }
                            LDS_WAIT();
#pragma unroll
                            for (int i = 0; i < 16; ++i) { const float xv = bf2f(xraw[i * 64 + lane]);
                                const float xc = cw0 * xm3 + cw1 * xm2 + cw2 * xm1 + cw3 * xv + cb; xm3 = xm2; xm2 = xm1; xm1 = xv; xcf[i * 64 + lane] = xc; tile[i * 72 + lane] = (bf16_t)f2bf(xc); }
                            LDS_WAIT();
                            const bf16x8 a0 = *(const LAS bf16x8*)(tile + fr * 72 + fq * 8), a1 = *(const LAS bf16x8*)(tile + fr * 72 + 32 + fq * 8);
#pragma unroll
                            for (int n = 0; n < 4; ++n) {
                                f32x4 ar = (f32x4){0.f, 0.f, 0.f, 0.f}, ai = (f32x4){0.f, 0.f, 0.f, 0.f};
                                ar = __builtin_amdgcn_mfma_f32_16x16x32_bf16(a0, bR[n][0], ar, 0, 0, 0); ar = __builtin_amdgcn_mfma_f32_16x16x32_bf16(a1, bR[n][1], ar, 0, 0, 0);
                                ai = __builtin_amdgcn_mfma_f32_16x16x32_bf16(a0, bI[n][0], ai, 0, 0, 0); ai = __builtin_amdgcn_mfma_f32_16x16x32_bf16(a1, bI[n][1], ai, 0, 0, 0);
#pragma unroll
                                for (int j = 0; j < 4; ++j) { pre_r[(fq * 4 + j) * 64 + n * 16 + fr] = ar[j]; pre_i[(fq * 4 + j) * 64 + n * 16 + fr] = ai[j]; }
                            }
                            LDS_WAIT();
#pragma unroll 4
                            for (int i = 0; i < 16; ++i) {
                                const float r = sigm(pre_r[i * 64 + lane] + br), gi = sigm(pre_i[i * 64 + lane] + bi);
                                const float la = -c8sp * r; float a, om;
                                if (la > -0.125f) { const float x = 2.0f * la; om = -x * (1.0f + x * (0.5f + x * (0.16666667f + x * (0.041666668f + x * (0.0083333338f + x * 0.0013888889f))))); a = 1.0f + la * (1.0f + la * (0.5f + la * (0.16666667f + la * (0.041666668f + la * 0.0083333338f)))); }
                                else { a = __expf(la); om = -expm1f(2.0f * la); }
                                const float bm = __builtin_amdgcn_sqrtf(om);
                                h = a * h + bm * gi * xcf[i * 64 + lane]; pc = pc * a;
                                *hp = h; *pp = pc; hp += AW; pp += AW;
                            }
                            LDS_WAIT();
                        }
                        AGG[(size_t)un * 128 + lane] = pc; AGG[(size_t)un * 128 + 64 + lane] = h;
                    }
                }
                {
                    const float* cbw = INP(I_CBW) + (size_t)l * 3 * BW;
                    for (int it = gt; it < (MT / 8) * 32; it += NGT) {
                        const int rb = it >> 5, c0 = (it & 31) * 8;
                        int b, t0, T, rowbase; const bool smp = rb >= MP / 8;
                        if (!smp) { b = rb >> 9; t0 = (rb & 511) * 8; T = SEQ; rowbase = rb * 8; } else { const int sbk = rb - MP / 8; b = sbk >> 2; t0 = (sbk & 3) * 8; T = TS; rowbase = MP + sbk * 8; }
                        u32x4 xq[10], cq[10], bq[8];
                        const bf16_t* zr = gZ + (size_t)rowbase * INC + c0;
#pragma unroll
                        for (int i = 0; i < 10; ++i) { if (i >= 2 || t0 > 0) { xq[i] = *(const u32x4*)(zr + (ptrdiff_t)(i - 2) * INC + Z_XB); cq[i] = *(const u32x4*)(zr + (ptrdiff_t)(i - 2) * INC + Z_GC); } else { xq[i] = (u32x4){0u, 0u, 0u, 0u}; cq[i] = (u32x4){0u, 0u, 0u, 0u}; } }
#pragma unroll
                        for (int i = 0; i < 8; ++i) bq[i] = *(const u32x4*)(zr + (size_t)i * INC + Z_GB);
                        float w0[8], w1[8], w2[8], pm2[8], pm1[8];
#pragma unroll
                        for (int k = 0; k < 8; ++k) { w0[k] = cbw[c0 + k]; w1[k] = cbw[BW + c0 + k]; w2[k] = cbw[2 * BW + c0 + k]; }
                        {
                            const float a_[8] = {bflo(xq[0].x) * bflo(cq[0].x), bfhi(xq[0].x) * bfhi(cq[0].x), bflo(xq[0].y) * bflo(cq[0].y), bfhi(xq[0].y) * bfhi(cq[0].y), bflo(xq[0].z) * bflo(cq[0].z), bfhi(xq[0].z) * bfhi(cq[0].z), bflo(xq[0].w) * bflo(cq[0].w), bfhi(xq[0].w) * bfhi(cq[0].w)};
                            const float b_[8] = {bflo(xq[1].x) * bflo(cq[1].x), bfhi(xq[1].x) * bfhi(cq[1].x), bflo(xq[1].y) * bflo(cq[1].y), bfhi(xq[1].y) * bfhi(cq[1].y), bflo(xq[1].z) * bflo(cq[1].z), bfhi(xq[1].z) * bfhi(cq[1].z), bflo(xq[1].w) * bflo(cq[1].w), bfhi(xq[1].w) * bfhi(cq[1].w)};
#pragma unroll
                            for (int k = 0; k < 8; ++k) { pm2[k] = a_[k]; pm1[k] = b_[k]; }
                        }
                        if (t0 == 0 && smp) { const float* st = INP(I_SCB) + ((size_t)(l * BS + b) * 2) * BW + c0;
#pragma unroll
                            for (int k = 0; k < 8; ++k) { pm2[k] = st[k]; pm1[k] = st[BW + k]; } }
#pragma unroll
                        for (int i = 0; i < 8; ++i) {
                            const u32x4 xb = xq[i + 2], gc = cq[i + 2], gb = bq[i];
                            const float pv[8] = {bflo(xb.x) * bflo(gc.x), bfhi(xb.x) * bfhi(gc.x), bflo(xb.y) * bflo(gc.y), bfhi(xb.y) * bfhi(gc.y), bflo(xb.z) * bflo(gc.z), bfhi(xb.z) * bfhi(gc.z), bflo(xb.w) * bflo(gc.w), bfhi(xb.w) * bfhi(gc.w)};
                            const float gbv[8] = {bflo(gb.x), bfhi(gb.x), bflo(gb.y), bfhi(gb.y), bflo(gb.z), bfhi(gb.z), bflo(gb.w), bfhi(gb.w)};
                            float yv[8];
#pragma unroll
                            for (int k = 0; k < 8; ++k) { yv[k] = gbv[k] * (w0[k] * pm2[k] + w1[k] * pm1[k] + w2[k] * pv[k]); pm2[k] = pm1[k]; pm1[k] = pv[k]; }
                            u32x4 w; w.x = pk2(yv[0], yv[1]); w.y = pk2(yv[2], yv[3]); w.z = pk2(yv[4], yv[5]); w.w = pk2(yv[6], yv[7]);
                            *(u32x4*)(gY + (size_t)(rowbase + i) * D + 512 + c0) = w;
                        }
                        if (t0 + 8 == T) { float* o = out + (smp ? O_CBS : O_CBP) + ((size_t)(l * 8 + b) * 2) * BW + c0;
#pragma unroll
                            for (int k = 0; k < 8; ++k) { o[k] = pm2[k]; o[BW + k] = pm1[k]; } }
                    }
                }
            } else if (rep == 2) {
                LANE_STATE();
                {
                    LAS float* cr = (LAS float*)lds;
                    for (int un = bid; un < 8 + 256; un += G) {
                        int b, ch, rowbase, nrows; const bool smp = un < 8;
                        if (smp) { b = un; ch = 0; rowbase = MP + b * TS; nrows = TS; } else { const int v = un - 8; b = v >> 5; ch = v & 31; rowbase = b * SEQ + ch * 128; nrows = 128; }
                        {
                            const int c = tid, hd = c >> 6, ln = c & 63; float carry = 0.f;
                            if (smp) carry = INP(I_SHA)[(size_t)(l * BS + b) * AW + c];
                            else { const float* ag = AGG + (size_t)(64 + (b << 8) + (hd << 5)) * 128 + ln; for (int k = 0; k < ch; ++k) carry = ag[(size_t)k * 128] * carry + ag[(size_t)k * 128 + 64]; }
                            cr[c] = carry;
                        }
                        __syncthreads();
                        const int c0 = (tid & 63) * 8, rsub = tid >> 6;
                        const f32x4 ca = *(const LAS f32x4*)(cr + c0), cb = *(const LAS f32x4*)(cr + c0 + 4);
                        for (int p = 0; p < nrows / 8; ++p) {
                            const int rloc = p * 8 + rsub; const size_t row = (size_t)(rowbase + rloc);
                            const f32x4 h0 = *(const f32x4*)(HLOC + row * AW + c0), h1 = *(const f32x4*)(HLOC + row * AW + c0 + 4), p0 = *(const f32x4*)(PCUM + row * AW + c0), p1 = *(const f32x4*)(PCUM + row * AW + c0 + 4);
                            const u32x4 gq = *(const u32x4*)(gZ + row * INC + Z_GA + c0);
                            const f32x4 a0 = h0 + p0 * ca, a1 = h1 + p1 * cb;
                            u32x4 w; w.x = pk2(gelu_t(bflo(gq.x)) * a0[0], gelu_t(bfhi(gq.x)) * a0[1]); w.y = pk2(gelu_t(bflo(gq.y)) * a0[2], gelu_t(bfhi(gq.y)) * a0[3]);
                            w.z = pk2(gelu_t(bflo(gq.z)) * a1[0], gelu_t(bfhi(gq.z)) * a1[1]); w.w = pk2(gelu_t(bflo(gq.w)) * a1[2], gelu_t(bfhi(gq.w)) * a1[3]);
                            *(u32x4*)(gY + row * D + c0) = w;
                            if ((smp || ch == 31) && rloc == nrows - 1) { float* o = out + (smp ? O_HAS : O_HAP) + (size_t)(l * 8 + b) * AW + c0; *(f32x4*)o = a0; *(f32x4*)(o + 4) = a1; }
                        }
                        if ((smp || ch == 31) && tid < 192) {
                            const int k = tid >> 6; const u32x4 xq = *(const u32x4*)(gZ + (size_t)(rowbase + nrows - 3 + k) * INC + Z_XA + c0);
                            float* o = out + (smp ? O_CAS : O_CAP) + ((size_t)(l * 8 + b) * 3 + k) * AW + c0;
                            *(f32x4*)o = (f32x4){bflo(xq.x), bfhi(xq.x), bflo(xq.y), bfhi(xq.y)}; *(f32x4*)(o + 4) = (f32x4){bflo(xq.z), bfhi(xq.z), bflo(xq.w), bfhi(xq.w)};
                        }
                        __syncthreads();
                    }
                }
            } else if (rep == 3 || rep == 8 || rep == 12) {
                LANE_STATE();
                if (rep == 12) {
                    const float* cfw = INP(I_CFW) + (size_t)l * 3 * DFF;
                    pg8::GSched S0; S0.init(MP / 256, D / 256, G, bid); pg8::Unit u0;
                    for (int i = 0; S0.next(i, u0); ++i) {
                        const int pm = u0.pm; if (pm >= 128 || tid >= DFF / 8) continue;
                        const int c0 = tid * 8, b = pm >> 4;
                        float w0[8], w1[8], w2[8], p2[8], p1[8], g0[8], g1[8], u0_[8], u1_[8];
#pragma unroll
                        for (int k = 0; k < 8; ++k) { w0[k] = cfw[c0 + k]; w1[k] = cfw[DFF + c0 + k]; w2[k] = cfw[2 * DFF + c0 + k]; p2[k] = 0.f; p1[k] = 0.f; }
                        if ((pm & 15) != 0) {
#pragma unroll
                            for (int k = 0; k < 8; ++k) { p2[k] = SBL[((size_t)(pm - 1) * 2 + 0) * DFF + c0 + k]; p1[k] = SBL[((size_t)(pm - 1) * 2 + 1) * DFF + c0 + k]; } }
#pragma unroll
                        for (int k = 0; k < 8; ++k) { g0[k] = SBG[((size_t)pm * 2 + 0) * DFF + c0 + k]; g1[k] = SBG[((size_t)pm * 2 + 1) * DFF + c0 + k]; u0_[k] = SBU[((size_t)pm * 2 + 0) * DFF + c0 + k]; u1_[k] = SBU[((size_t)pm * 2 + 1) * DFF + c0 + k]; }
                        float ha[8], hb[8];
#pragma unroll
                        for (int k = 0; k < 8; ++k) { ha[k] = silu(w0[k] * p2[k] + w1[k] * p1[k] + w2[k] * g0[k]) * u0_[k]; hb[k] = silu(w0[k] * p1[k] + w1[k] * g0[k] + w2[k] * g1[k]) * u1_[k]; }
                        u32x4 w; w.x = pk2(ha[0], ha[1]); w.y = pk2(ha[2], ha[3]); w.z = pk2(ha[4], ha[5]); w.w = pk2(ha[6], ha[7]);
                        *(u32x4*)(GU + (size_t)(pm * 256) * DFF + c0) = w;
                        w.x = pk2(hb[0], hb[1]); w.y = pk2(hb[2], hb[3]); w.z = pk2(hb[4], hb[5]); w.w = pk2(hb[6], hb[7]);
                        *(u32x4*)(GU + (size_t)(pm * 256 + 1) * DFF + c0) = w;
                        if ((pm & 15) == 15 && u0.pn == 0) { float* o = out + O_CFP + ((size_t)(l * 8 + b) * 2) * DFF + c0;
#pragma unroll
                            for (int k = 0; k < 8; ++k) { o[k] = SBL[((size_t)pm * 2 + 0) * DFF + c0 + k]; o[DFF + k] = SBL[((size_t)pm * 2 + 1) * DFF + c0 + k]; } }
                    }
                    asm volatile("s_waitcnt vmcnt(0)" ::: "memory"); __syncthreads();
                }
                GEMM_RES(rep == 3 ? 0 : (rep == 8 ? 1 : 2));
                { LANE_STATE();
                  const SG2 sg{rep == 12 ? GU + (size_t)MP * DFF : (rep == 3 ? gY : gO) + (size_t)MP * D, rep == 12 ? WDN_T : (rep == 3 ? WOUT_T : WO_T), rep == 12 ? DFF : D, rep == 12 ? DFF : D, rep == 12 ? DFF : D, D, XN + (size_t)MP * D, D, 1.f, 2, SSS(3 * l + (rep == 3 ? 1 : (rep == 8 ? 2 : 3)))};
                  sgemm2(lds, sg, bid, G, wave, tid); }
                if (rep != 12 && l + 1 < DEPTH) { LANE_STATE(); if (bid >= 4) convert_layer(kp, ws, lds, l + 1, rep == 3 ? 0 : 2, 3, gw - 4 * NWAVES, NGW - 4 * NWAVES, gt - 4 * NTHREADS, NGT - 4 * NTHREADS, lane, wave); }
            } else if (rep == 6) {
                LANE_STATE();
                for (int sub = 0; sub < 2; ++sub) {
                    pg8::GSched S; pg8::Gemm g; pg8::EpiSoftmax E;
                    if (sub == 0) { S.init(MP / 256, 4, G, bid); S.aPm = (size_t)256 * D * 2; S.aPn = 512; S.bPn = 512; S.bPm = (size_t)256 * D * 2; S.bShift = 4; g = pg8::Gemm{gQ, KBP, D, D, 256}; E.O = gP; E.ldc = D; E.smp = 0; }
                    else { S.init(1, 32, G, (bid + G - 64) % G); S.mode = 1; g = pg8::Gemm{gQ + (size_t)MP * D, KBS, D, D, 256}; E.O = PS; E.ldc = 8192; E.smp = 1; }
                    pg8::gemm_phase<pg8::EpiSoftmax, pg8::GSched, true>(lds, g, S, E, wave_s);
                }
            }
            if (rep == 6) { asm volatile("s_waitcnt vmcnt(0)" ::: "memory"); __syncthreads(); }
            else GRID_SYNC();
          }
        }
    }
    {
        LANE_STATE();
        const float* gain = INP(I_GFIN);
        f32x4 gv[4];
#pragma unroll
        for (int j = 0; j < 4; ++j) gv[j] = ((const f32x4*)gain)[lane + 64 * j];
        for (int m0 = gw; m0 < MT; m0 += 2 * NGW) {
            const int m1 = m0 + NGW; const bool two = m1 < MT; const int mb = two ? m1 : m0;
            const u32x2* xa = (const u32x2*)(XN + (size_t)m0 * D) + lane; const u32x2* xb = (const u32x2*)(XN + (size_t)mb * D) + lane;
            u32x2 pa[4], pb[4];
#pragma unroll
            for (int j = 0; j < 4; ++j) { pa[j] = xa[64 * j]; pb[j] = xb[64 * j]; }
            float ra, rb;
            { float qa = 0.f, qb = 0.f;
#pragma unroll
              for (int j = 0; j < 4; ++j) { const float a0 = bflo(pa[j].x), a1 = bfhi(pa[j].x), a2 = bflo(pa[j].y), a3 = bfhi(pa[j].y), b0 = bflo(pb[j].x), b1 = bfhi(pb[j].x), b2 = bflo(pb[j].y), b3 = bfhi(pb[j].y);
                  qa += (a0 * a0 + a1 * a1) + (a2 * a2 + a3 * a3); qb += (b0 * b0 + b1 * b1) + (b2 * b2 + b3 * b3); }
              if (m0 < MP) ra = ss_rstd(*(const f32x4*)(SSQ(6) + (size_t)m0 * 4)); else ra = 1.0f / sqrtf(wave_sum(qa, lane) * (1.f / D) + EPS);
              if (mb < MP) rb = ss_rstd(*(const f32x4*)(SSQ(6) + (size_t)mb * 4)); else rb = 1.0f / sqrtf(wave_sum(qb, lane) * (1.f / D) + EPS); }
            f32x4* ya = (f32x4*)(out + (size_t)m0 * D) + lane; f32x4* yb = (f32x4*)(out + (size_t)mb * D) + lane;
#pragma unroll
            for (int j = 0; j < 4; ++j) { ya[64 * j] = (f32x4){bflo(pa[j].x), bfhi(pa[j].x), bflo(pa[j].y), bfhi(pa[j].y)} * ra * gv[j]; if (two) yb[64 * j] = (f32x4){bflo(pb[j].x), bfhi(pb[j].x), bflo(pb[j].y), bfhi(pb[j].y)} * rb * gv[j]; }
        }
    }
}

extern "C" void kernel_launch(void* const* d_in, const int* in_sizes, int n_in, void* d_out, int out_size, void* d_ws, size_t ws_size, hipStream_t stream) {
    static int grid = 0;
    if (grid == 0) {
        if (n_in != N_IN || (size_t)out_size != O_END || ws_size < 512 * MiB) { fprintf(stderr, "kernel_launch: unexpected sizes n_in %d out %d ws %zu (need %zu)\n", n_in, out_size, ws_size, (size_t)(512 * MiB)); grid = -1; return; }
        int dev = 0, cus = 0, per_cu = 0;
        (void)hipGetDevice(&dev); (void)hipDeviceGetAttribute(&cus, hipDeviceAttributeMultiprocessorCount, dev);
        if (hipFuncSetAttribute((const void*)trunk_fwd, hipFuncAttributeMaxDynamicSharedMemorySize, LDS_BYTES) != hipSuccess) { fprintf(stderr, "kernel_launch: hipFuncSetAttribute failed\n"); grid = -1; return; }
        if (hipOccupancyMaxActiveBlocksPerMultiprocessor(&per_cu, (const void*)trunk_fwd, NTHREADS, LDS_BYTES) != hipSuccess || per_cu < 1) { fprintf(stderr, "kernel_launch: occupancy query gave %d\n", per_cu); per_cu = 1; }
        (void)hipGetLastError();
        grid = cus * 1;
        if (grid != 256) fprintf(stderr, "kernel_launch: note: %d CUs\n", grid);
    }
    if (grid < 0) return;
    Args a{};
    for (int i = 0; i < N_IN; ++i) a.in[i] = (const float*)d_in[i];
    a.out = (float*)d_out; a.ws = (unsigned char*)d_ws;
    void* kargs[] = {&a};
    hipError_t e = hipLaunchCooperativeKernel((const void*)trunk_fwd, dim3(grid), dim3(NTHREADS), kargs, LDS_BYTES, stream);
    if (e != hipSuccess) fprintf(stderr, "kernel_launch: cooperative launch failed: %s (grid %d)\n", hipGetErrorString(e), grid);
}
```

```cpp
#include <hip/hip_runtime.h>
#include <hip/hip_cooperative_groups.h>
#include <cstdio>
#include <cstdint>
namespace cg = cooperative_groups;
#ifndef PROBE
#define PROBE 0
#endif

#define LAS __attribute__((address_space(3)))
typedef unsigned short bf16_t;
typedef short bf16x8 __attribute__((ext_vector_type(8)));
typedef float f32x4 __attribute__((ext_vector_type(4)));
typedef float f32x2 __attribute__((ext_vector_type(2)));
typedef unsigned u32x4 __attribute__((ext_vector_type(4)));
typedef unsigned u32x2 __attribute__((ext_vector_type(2)));

constexpr int D = 1024, BP = 8, SEQ = 4096, BS = 8, TS = 32, DEPTH = 2;
constexpr int MP = BP * SEQ, MS = BS * TS, MT = MP + MS;
constexpr int INC = 2304, DFF = 2816, NMEM = 256, AW = 512, BW = 256, CW = 256;
constexpr int Z_XA = 0, Z_GA = 512, Z_XB = 1024, Z_GB = 1280, Z_GC = 1536, Z_UC = 1792, Z_VC = 2048;
constexpr float EPS = 1e-6f;
constexpr int NWAVES = 8, NTHREADS = 512;

constexpr size_t O_YP = 0, O_YS = O_YP + (size_t)MP * D, O_CAP = O_YS + (size_t)MS * D, O_HAP = O_CAP + DEPTH * BP * 3 * AW,
                 O_CBP = O_HAP + DEPTH * BP * AW, O_CFP = O_CBP + DEPTH * BP * 2 * BW, O_MKP = O_CFP + DEPTH * BP * 2 * DFF,
                 O_MVP = O_MKP + (size_t)DEPTH * BP * NMEM * D, O_CAS = O_MVP + (size_t)DEPTH * BP * NMEM * D, O_HAS = O_CAS + DEPTH * BS * 3 * AW,
                 O_CBS = O_HAS + DEPTH * BS * AW, O_CFS = O_CBS + DEPTH * BS * 2 * BW, O_VCS = O_CFS + DEPTH * BS * 2 * DFF,
                 O_END = O_VCS + DEPTH * BS * TS * CW;

constexpr size_t MiB = 1u << 20;
constexpr size_t WS_WIN = 0, WS_WOUT = 5 * MiB, WS_WQ = 7 * MiB, WS_WK = 9 * MiB, WS_WV = 11 * MiB, WS_WO = 13 * MiB, WS_WUP = 15 * MiB, WS_WDN = 26 * MiB;
constexpr size_t WS_MEMB = 32 * MiB, WS_KBP = 36 * MiB, WS_VTP = 40 * MiB, WS_KBS = 44 * MiB, WS_VTS = 48 * MiB, WS_WST = 52 * MiB, WS_GT = WS_WST + 131072, WS_AGG = 53 * MiB, WS_SS = 54 * MiB + 256 * 1024, WS_BAR = 55 * MiB + 512 * 1024;
constexpr size_t WS_XN = 56 * MiB, WS_BIG = 121 * MiB;
constexpr size_t B_Z = WS_BIG, B_HLOC = WS_BIG + 146 * MiB, B_PCUM = WS_BIG + 211 * MiB, B_Y = WS_BIG + 276 * MiB;
constexpr size_t B_Q = WS_BIG, B_P = WS_BIG + 65 * MiB, B_O = WS_BIG + 130 * MiB, B_PS = WS_BIG + 195 * MiB;
constexpr size_t B_GU = WS_BIG;
constexpr size_t B_GUS = WS_BIG + 200 * MiB;
constexpr size_t B_SBG = WS_BIG + 204 * MiB, B_SBU = WS_BIG + 207 * MiB, B_SBL = WS_BIG + 210 * MiB;
constexpr size_t WS_END = WS_BIG + (size_t)MT * 2 * DFF * 2;
constexpr size_t WS_SSP = 476 * MiB;
static_assert(WS_END <= WS_SSP && WS_SSP + (size_t)7 * MT * 64 <= 512 * MiB, "workspace");
static_assert(WS_XN + (size_t)MT * D * 2 <= WS_BIG, "xn");
constexpr size_t WS_SSS = WS_SSP + (((size_t)7 * MT * 16 + 4095) / 4096) * 4096;
static_assert(WS_SSS + 7 * 256 * 32 * 4 <= 480 * MiB, "sss");
constexpr size_t WSEL1 = 480 * MiB, KSEL1 = 418 * MiB;
static_assert(WS_WDN + (size_t)D * DFF * 2 + WSEL1 <= 512 * MiB && WS_KBS + KSEL1 >= WS_BIG + 341 * MiB && WS_GT + 131072 + KSEL1 <= WS_SSP, "second buffer set");

constexpr int LDS_RING = 131072, LDS_EX = LDS_RING, LDS_MISC = LDS_EX + 8192, LDS_BYTES = 147456;

enum { I_XP = 0, I_XS, I_MEM, I_CK, I_CV, I_SCA, I_SHA, I_SCB, I_SCF, I_GMIX, I_WIN, I_CAW, I_CAB, I_WRG, I_BRG, I_WIG, I_BIG, I_LAM, I_CBW, I_GV, I_WS, I_BSS,
       I_WOUT, I_GX, I_WQ, I_WK, I_WV, I_WO, I_GFFN, I_WUP, I_CFW, I_WDN, I_GFIN, N_IN };

struct Args { const float* in[N_IN]; float* out; unsigned char* ws; };

__device__ __forceinline__ unsigned pk2(float lo, float hi) { unsigned r; asm("v_cvt_pk_bf16_f32 %0, %1, %2" : "=v"(r) : "v"(lo), "v"(hi)); return r; }
__device__ __forceinline__ unsigned f2bf(float f) { return pk2(f, f) & 0xffffu; }
__device__ __forceinline__ float bf2f(unsigned v) { return __builtin_bit_cast(float, v << 16); }
__device__ __forceinline__ float bflo(unsigned w) { return __builtin_bit_cast(float, w << 16); }
__device__ __forceinline__ float bfhi(unsigned w) { return __builtin_bit_cast(float, w & 0xffff0000u); }
__device__ __forceinline__ unsigned cvt_pk_bf16(float lo, float hi) { unsigned r; asm volatile("v_cvt_pk_bf16_f32 %0, %1, %2" : "=v"(r) : "v"(lo), "v"(hi)); return r; }
__device__ __forceinline__ float fexp(float x) { return __builtin_amdgcn_exp2f(x * 1.4426950408889634f); }
__device__ __forceinline__ float sigm(float x) { return __builtin_amdgcn_rcpf(1.0f + fexp(-x)); }
__device__ __forceinline__ float gelu_t(float x) { const float u = 0.7978845608028654f * (x + 0.044715f * x * x * x); return x * sigm(2.0f * u); }
__device__ __forceinline__ float silu(float x) { return x * sigm(x); }
__device__ __forceinline__ float shx(float v, int m, int lane) { return __builtin_bit_cast(float, __builtin_amdgcn_ds_bpermute((lane ^ m) << 2, __builtin_bit_cast(int, v))); }
__device__ __forceinline__ float wave_sum(float v, int lane) {
#pragma unroll
    for (int o = 1; o < 64; o <<= 1) v += shx(v, o, lane);
    return v;
}
#define LDS_WAIT() asm volatile("s_waitcnt lgkmcnt(0)" ::: "memory")
__device__ __forceinline__ float ss_rstd(f32x4 p) { return 1.0f / sqrtf(((p[0] + p[1]) + (p[2] + p[3])) * (1.f / 1024.f) + 1e-6f); }
__device__ __forceinline__ int opaque_tid(int wave_s) { int l; asm volatile("v_mbcnt_lo_u32_b32 %0, -1, 0\n\tv_mbcnt_hi_u32_b32 %0, -1, %0" : "=v"(l)); return wave_s * 64 + l; }

namespace pg8 {
constexpr int BM = 256, BK = 64, HALF = 128, HTB = HALF * BK * 2, NXCD = 8, WGM = 8;
__device__ __forceinline__ int lds_byte(int r, int c) { const int st = (r >> 4) * 2 + (c >> 5), rr = r & 15, cc = c & 31, ob = rr * 64 + cc * 2; return st * 1024 + (ob ^ (((ob >> 9) & 1) << 5)); }
__device__ __forceinline__ void stage_rc(int b, int& R, int& C) { const int st = b / 1024, sb = b % 1024, swz = sb ^ (((sb >> 9) & 1) << 5); R = (st >> 1) * 16 + swz / 64; C = (st & 1) * 32 + (swz % 64) / 2; }
__device__ __forceinline__ int perm32(int rho) { const int n = rho >> 4, i = rho & 15; return 8 * (i >> 2) + 4 * n + (i & 3); }

struct Unit { int pm, pn; };
struct Gemm { const bf16_t* A; const bf16_t* Bt; int lda, ldb, K; };

struct GSched {
    int nM, nN, nwg, G, c, mode;
    size_t aPm, aPn, bPn, bPm; int bShift;
    __device__ __forceinline__ void init(int nM_, int nN_, int G_, int c_) { nM = nM_; nN = nN_; nwg = nM * nN; G = G_; c = c_; mode = 0; aPm = 0; aPn = 0; bPn = 0; bPm = 0; bShift = 0; }
    __device__ __forceinline__ bool next(int i, Unit& u) const {
        const long L = (long)i * G + c; if (L >= nwg) return false;
        int wgid = (int)L; { const int q = nwg / NXCD, r = nwg % NXCD, xcd = wgid % NXCD, off = wgid / NXCD; wgid = (xcd < r ? xcd * (q + 1) : r * (q + 1) + (xcd - r) * q) + off; }
        const int nig = WGM * nN, gid = wgid / nig, fm = gid * WGM, gsz = (nM - fm) < WGM ? (nM - fm) : WGM;
        u.pm = fm + ((wgid % nig) % gsz); u.pn = (wgid % nig) / gsz; return true;
    }
    __device__ __forceinline__ size_t offA(const Unit& u) const { return mode == 1 ? (size_t)(u.pn & 3) * 512 : (mode == 2 ? (size_t)(u.pn & 3) * 4096 + (size_t)(u.pn >> 2) * 512 : (size_t)u.pm * aPm + (size_t)u.pn * aPn); }
    __device__ __forceinline__ size_t offB(const Unit& u) const { return mode == 1 ? (size_t)(u.pn >> 2) * (256 * 1024 * 2) + (size_t)(u.pn & 3) * 512 : (mode == 2 ? (size_t)(u.pn & 3) * (256 * 2048 * 2) + (size_t)(u.pn >> 2) * 512 : (size_t)u.pn * bPn + (size_t)(u.pm >> bShift) * bPm); }
};

struct EpiBf16 {
    static constexpr bool PERM = true;
    bf16_t* O; int ldc; float scale; const float* ss; int smp;
    __device__ __forceinline__ void operator()(f32x4 (&acc)[2][2][4][2], const Unit& u, int wr, int wc, int fr, int fq, LAS unsigned char*) const {
        asm volatile("" : "+v"(fr), "+v"(fq)); asm volatile("" : "+s"(wr), "+s"(wc));
        const int row0 = u.pm * BM + wr * 64 + fr, col0 = (smp ? (u.pn & 3) : u.pn) * BM + wc * 32 + 8 * fq;
        f32x4 rs[2][4];
#pragma unroll
        for (int ai = 0; ai < 2; ++ai)
#pragma unroll
            for (int m = 0; m < 4; ++m) rs[ai][m] = ss ? *(const f32x4*)(ss + (size_t)(row0 + ai * HALF + m * 16) * 4) : (f32x4){0.f, 0.f, 0.f, 0.f};
#pragma unroll
        for (int ai = 0; ai < 2; ++ai)
#pragma unroll
            for (int m = 0; m < 4; ++m) { bf16_t* rowp = O + (size_t)(row0 + ai * HALF + m * 16) * ldc + col0;
                float sc = scale; if (ss) sc *= ss_rstd(rs[ai][m]);
                if (smp && ((ai * HALF + wr * 64 + m * 16 + fr) >> 5) != (u.pn >> 2)) continue;
#pragma unroll
                for (int bj = 0; bj < 2; ++bj) { const f32x4 v0 = acc[ai][bj][m][0] * sc, v1 = acc[ai][bj][m][1] * sc;
                    u32x4 w; w.x = cvt_pk_bf16(v0[0], v0[1]); w.y = cvt_pk_bf16(v0[2], v0[3]); w.z = cvt_pk_bf16(v1[0], v1[1]); w.w = cvt_pk_bf16(v1[2], v1[3]);
                    *(u32x4*)(rowp + bj * HALF) = w; } }
    }
};
struct EpiResid {
    static constexpr bool PERM = true;
    bf16_t* xb; float* ss;
    __device__ __forceinline__ void operator()(f32x4 (&acc)[2][2][4][2], const Unit& u, int wr, int wc, int fr, int fq, LAS unsigned char* lds) const {
        asm volatile("" : "+v"(fr), "+v"(fq)); asm volatile("" : "+s"(wr), "+s"(wc));
        const int col0 = u.pn * BM + wc * 32 + 8 * fq, lane = fq * 16 + fr;
        LAS float* PS = (LAS float*)(lds + LDS_EX);
        bf16_t* ob = xb + (size_t)u.pm * BM * D;
#pragma unroll
        for (int ai = 0; ai < 2; ++ai) {
            u32x4 pre[4][2];
#pragma unroll
            for (int m = 0; m < 4; ++m)
#pragma unroll
                for (int bj = 0; bj < 2; ++bj) pre[m][bj] = *(const u32x4*)(ob + (size_t)(ai * HALF + wr * 64 + m * 16 + fr) * D + col0 + bj * HALF);
            asm volatile("" ::: "memory");
#pragma unroll
            for (int m = 0; m < 4; ++m) { const int rl = ai * HALF + wr * 64 + m * 16 + fr; const size_t off = (size_t)rl * D + col0; float q = 0.f;
#pragma unroll
                for (int bj = 0; bj < 2; ++bj) { const u32x4 p = pre[m][bj]; const f32x4 a0 = acc[ai][bj][m][0], a1 = acc[ai][bj][m][1];
                    const float v0 = bflo(p.x) + a0[0], v1 = bfhi(p.x) + a0[1], v2 = bflo(p.y) + a0[2], v3 = bfhi(p.y) + a0[3], v4 = bflo(p.z) + a1[0], v5 = bfhi(p.z) + a1[1], v6 = bflo(p.w) + a1[2], v7 = bfhi(p.w) + a1[3];
                    u32x4 w; w.x = cvt_pk_bf16(v0, v1); w.y = cvt_pk_bf16(v2, v3); w.z = cvt_pk_bf16(v4, v5); w.w = cvt_pk_bf16(v6, v7); *(u32x4*)(ob + off + bj * HALF) = w;
                    q += ((v0 * v0 + v1 * v1) + (v2 * v2 + v3 * v3)) + ((v4 * v4 + v5 * v5) + (v6 * v6 + v7 * v7)); }
                q += shx(q, 16, lane); q += shx(q, 32, lane);
                if (fq == 0) PS[rl * 4 + wc] = q; }
            asm volatile("" ::: "memory");
        }
        asm volatile("s_waitcnt lgkmcnt(0)" ::: "memory"); __builtin_amdgcn_s_barrier(); asm volatile("" ::: "memory");
        { const int t = (wr * 4 + wc) * 64 + lane; if (t < 256) { const f32x4 p = *(const LAS f32x4*)(PS + t * 4); ss[(size_t)(u.pm * BM + t) * 4 + u.pn] = (p[0] + p[1]) + (p[2] + p[3]); } }
    }
};
struct EpiKV {
    static constexpr bool PERM = false;
    float* outK; float* outV; bf16_t* KB; bf16_t* VT;
    __device__ __forceinline__ void operator()(f32x4 (&acc)[2][2][4][2], const Unit& u, int wr, int wc, int fr, int fq, LAS unsigned char*) const {
        asm volatile("" : "+v"(fr), "+v"(fq)); asm volatile("" : "+s"(wr), "+s"(wc));
        const int kind = u.pm >> 4, pm = u.pm & 15;
        const int col0 = u.pn * BM + wc * 32 + 4 * fq;
        float* of = kind == 0 ? outK : outV; bf16_t* ob = kind == 0 ? KB : VT; const int ldb_ = kind == 2 ? 2048 : 1024;
#pragma unroll
        for (int ai = 0; ai < 2; ++ai)
#pragma unroll
            for (int m = 0; m < 4; ++m) { const int row = pm * BM + ai * HALF + wr * 64 + m * 16 + fr;
#pragma unroll
                for (int bj = 0; bj < 2; ++bj)
#pragma unroll
                    for (int n = 0; n < 2; ++n) { const f32x4 v = acc[ai][bj][m][n]; const int col = col0 + bj * HALF + n * 16;
                        if (kind != 2) *(f32x4*)(of + (size_t)row * 1024 + col) = v;
                        if (kind != 1) { u32x2 w; w.x = cvt_pk_bf16(v[0], v[1]); w.y = cvt_pk_bf16(v[2], v[3]); *(u32x2*)(ob + (size_t)row * ldb_ + col) = w; } } }
    }
};
struct EpiSoftmax {
    static constexpr bool PERM = true;
    bf16_t* O; int ldc; int smp;
    __device__ __forceinline__ void operator()(f32x4 (&acc)[2][2][4][2], const Unit& u, int wr, int wc, int fr, int fq, LAS unsigned char* lds) const {
        asm volatile("" : "+v"(fr), "+v"(fq)); asm volatile("" : "+s"(wr), "+s"(wc));
        LAS f32x2* EX = (LAS f32x2*)(lds + LDS_EX);
        const int lane = fq * 16 + fr;
        const float L2E = 1.4426950408889634f;
#pragma unroll
        for (int ai = 0; ai < 2; ++ai)
#pragma unroll
            for (int m = 0; m < 4; ++m) {
                float mx = -3.0e38f;
#pragma unroll
                for (int bj = 0; bj < 2; ++bj)
#pragma unroll
                    for (int n = 0; n < 2; ++n) { const f32x4 x = acc[ai][bj][m][n]; mx = fmaxf(mx, fmaxf(fmaxf(x[0], x[1]), fmaxf(x[2], x[3]))); }
                mx = fmaxf(mx, shx(mx, 16, lane)); mx = fmaxf(mx, shx(mx, 32, lane));
                float s = 0.f;
#pragma unroll
                for (int bj = 0; bj < 2; ++bj)
#pragma unroll
                    for (int n = 0; n < 2; ++n) { f32x4 x = acc[ai][bj][m][n];
#pragma unroll
                        for (int j = 0; j < 4; ++j) { x[j] = __builtin_amdgcn_exp2f((x[j] - mx) * L2E); s += x[j]; }
                        acc[ai][bj][m][n] = x; }
                s += shx(s, 16, lane); s += shx(s, 32, lane);
                if (fq == 0) EX[(ai * HALF + wr * 64 + m * 16 + fr) * 4 + wc] = (f32x2){mx, s};
            }
        asm volatile("s_waitcnt lgkmcnt(0)" ::: "memory"); __builtin_amdgcn_s_barrier(); asm volatile("" ::: "memory");
        int colb = u.pn * BM, j_ = 0;
        if (smp) { colb = (u.pn & 3) * 2048 + (u.pn >> 2) * 256; j_ = u.pn >> 2; }
        const int col0 = colb + wc * 32 + 8 * fq;
#pragma unroll
        for (int ai = 0; ai < 2; ++ai)
#pragma unroll
            for (int m = 0; m < 4; ++m) {
                const int rl = ai * HALF + wr * 64 + m * 16 + fr;
                const f32x2 e0 = EX[rl * 4 + 0], e1 = EX[rl * 4 + 1], e2 = EX[rl * 4 + 2], e3 = EX[rl * 4 + 3];
                const float M = fmaxf(fmaxf(e0.x, e1.x), fmaxf(e2.x, e3.x));
                const float tot = e0.y * __builtin_amdgcn_exp2f((e0.x - M) * L2E) + e1.y * __builtin_amdgcn_exp2f((e1.x - M) * L2E) + e2.y * __builtin_amdgcn_exp2f((e2.x - M) * L2E) + e3.y * __builtin_amdgcn_exp2f((e3.x - M) * L2E);
                const float own = wc == 0 ? e0.x : (wc == 1 ? e1.x : (wc == 2 ? e2.x : e3.x));
                float f = __builtin_amdgcn_exp2f((own - M) * L2E) / tot;
                if (smp && (rl >> 5) != j_) f = 0.f;
                bf16_t* rowp = O + (size_t)(u.pm * BM + rl) * ldc + col0;
#pragma unroll
                for (int bj = 0; bj < 2; ++bj) { const f32x4 v0 = acc[ai][bj][m][0] * f, v1 = acc[ai][bj][m][1] * f;
                    u32x4 w; w.x = cvt_pk_bf16(v0[0], v0[1]); w.y = cvt_pk_bf16(v0[2], v0[3]); w.z = cvt_pk_bf16(v1[0], v1[1]); w.w = cvt_pk_bf16(v1[2], v1[3]);
                    *(u32x4*)(rowp + bj * HALF) = w; } }
    }
};


__device__ __forceinline__ float dpp_ror1(float v) { return __builtin_bit_cast(float, __builtin_amdgcn_update_dpp(0, __builtin_bit_cast(int, v), 0x121, 0xf, 0xf, false)); }
__device__ __forceinline__ float dpp_ror2(float v) { return __builtin_bit_cast(float, __builtin_amdgcn_update_dpp(0, __builtin_bit_cast(int, v), 0x122, 0xf, 0xf, false)); }
struct EpiAct {
    static constexpr bool PERM = true;
    bf16_t* H; const float* scf; float* ocf; float* sbg; float* sbu; float* sbl; const float* cfw; const float* ss;
    __device__ __forceinline__ void operator()(f32x4 (&acc)[2][2][4][2], const Unit& u, int wr, int wc, int fr, int fq, LAS unsigned char* lds) const {
        asm volatile("" : "+s"(wr), "+s"(wc));
        int lane; asm volatile("v_mbcnt_lo_u32_b32 %0, -1, 0\n\tv_mbcnt_hi_u32_b32 %0, -1, %0" : "=v"(lane));
        fr = lane & 15; fq = lane >> 4;
        const int fl = wc * 32 + 8 * fq, f0 = u.pn * 128 + fl; int rowt = wr * 64 + fr;
        {
            float rst[2][4];
            f32x4 rsl[2][4];
#pragma unroll
            for (int ai = 0; ai < 2; ++ai)
#pragma unroll
                for (int m = 0; m < 4; ++m) rsl[ai][m] = *(const f32x4*)(ss + (size_t)(u.pm * BM + ai * HALF + rowt + m * 16) * 4);
#pragma unroll
            for (int ai = 0; ai < 2; ++ai)
#pragma unroll
                for (int m = 0; m < 4; ++m) { rst[ai][m] = ss_rstd(rsl[ai][m]); }
#pragma unroll
            for (int ai = 0; ai < 2; ++ai)
#pragma unroll
                for (int m = 0; m < 4; ++m) { acc[ai][0][m][0] = acc[ai][0][m][0] * rst[ai][m]; acc[ai][0][m][1] = acc[ai][0][m][1] * rst[ai][m]; acc[ai][1][m][0] = acc[ai][1][m][0] * rst[ai][m]; acc[ai][1][m][1] = acc[ai][1][m][1] * rst[ai][m]; }
        }
        const bool smp = (u.pm == 128);
        asm volatile("" : "+v"(rowt));
        LAS float* BND = (LAS float*)(lds + LDS_EX);
        if (fr >= 14) {
#pragma unroll
            for (int ai = 0; ai < 2; ++ai)
#pragma unroll
                for (int n = 0; n < 2; ++n) *(LAS f32x4*)(BND + ((ai * 2 + wr) * 2 + (fr - 14)) * 128 + fl + 4 * n) = acc[ai][0][3][n];
            if (wr == 1) {
#pragma unroll
                for (int n = 0; n < 2; ++n) *(f32x4*)(sbl + ((size_t)u.pm * 2 + (fr - 14)) * DFF + f0 + 4 * n) = acc[1][0][3][n];
            }
        }
        asm volatile("s_waitcnt lgkmcnt(0)" ::: "memory"); __builtin_amdgcn_s_barrier(); asm volatile("" ::: "memory");
#pragma unroll
        for (int ai = 0; ai < 2; ++ai) {
            const int pg = wr == 1 ? ai * 2 : 1;
            u32x2 hp[2][4];
#pragma unroll
            for (int n = 0; n < 2; ++n) {
                const f32x4 w0 = *(const f32x4*)(cfw + f0 + 4 * n), w1 = *(const f32x4*)(cfw + DFF + f0 + 4 * n), w2 = *(const f32x4*)(cfw + 2 * DFF + f0 + 4 * n);
                f32x4 h2 = *(const LAS f32x4*)(BND + (pg * 2 + 0) * 128 + fl + 4 * n), h1 = *(const LAS f32x4*)(BND + (pg * 2 + 1) * 128 + fl + 4 * n);
                f32x4 t2 = h2, t1 = h1;
                if (smp) { const float* sp = scf + (size_t)((ai * 4 + wr * 2) * 2) * DFF + f0 + 4 * n; h2 = *(const f32x4*)sp; h1 = *(const f32x4*)(sp + DFF); t2 = *(const f32x4*)(sp + 2 * DFF); t1 = *(const f32x4*)(sp + 3 * DFF); }
#pragma unroll
                for (int jp = 0; jp < 2; ++jp) {
                    float hv[4][2];
#pragma unroll
                    for (int jj = 0; jj < 2; ++jj) { const int j = jp * 2 + jj;
                        float r1p = h1[j], r2p = fr == 0 ? h2[j] : h1[j];
#pragma unroll
                        for (int m = 0; m < 4; ++m) { const float g = acc[ai][0][m][n][j];
                            if (m == 2 && smp) { r1p = t1[j]; r2p = fr == 0 ? t2[j] : t1[j]; }
                            const float r1 = dpp_ror1(g), r2 = dpp_ror2(g);
                            const float gm1 = fr >= 1 ? r1 : r1p, gm2 = fr >= 2 ? r2 : r2p;
                            r1p = r1; r2p = r2;
                            const float cv = w0[j] * gm2 + w1[j] * gm1 + w2[j] * g;
                            hv[m][jj] = silu(cv) * acc[ai][1][m][n][j]; } }
#pragma unroll
                    for (int m = 0; m < 4; ++m) { const unsigned pk = cvt_pk_bf16(hv[m][0], hv[m][1]); if (jp == 0) hp[n][m].x = pk; else hp[n][m].y = pk; }
                }
            }
#pragma unroll
            for (int m = 0; m < 4; ++m) {
                const int rl = ai * HALF + rowt + m * 16;
                if (smp && (m & 1) && fr >= 14) {
#pragma unroll
                    for (int n = 0; n < 2; ++n) *(f32x4*)(ocf + ((size_t)(ai * 4 + wr * 2 + (m >> 1)) * 2 + (fr - 14)) * DFF + f0 + 4 * n) = acc[ai][0][m][n];
                }
                if (!smp && ai == 0 && m == 0 && wr == 0 && fr < 2) {
#pragma unroll
                    for (int n = 0; n < 2; ++n) { *(f32x4*)(sbg + ((size_t)u.pm * 2 + fr) * DFF + f0 + 4 * n) = acc[0][0][0][n]; *(f32x4*)(sbu + ((size_t)u.pm * 2 + fr) * DFF + f0 + 4 * n) = acc[0][1][0][n]; }
                } else {
                    u32x4 w; w.x = hp[0][m].x; w.y = hp[0][m].y; w.z = hp[1][m].x; w.w = hp[1][m].y;
                    *(u32x4*)(H + (size_t)(u.pm * BM + rl) * DFF + f0) = w;
                }
            }
        }
    }
};

template <class Epi, class Sched, bool ALIGN_EPI>
__device__ __forceinline__ void gemm_phase(LAS unsigned char* lds, const Gemm g, const Sched& S, const Epi& E, const int wave_s) {
    const int tid = opaque_tid(wave_s), wid = __builtin_amdgcn_readfirstlane(tid >> 6), lane = tid & 63, wr = wid >> 2, wc = wid & 3, fr = lane & 15, fq = lane >> 4;
    const int nt = g.K / BK;
    unsigned voffA[2], voffB[2];
#pragma unroll
    for (int i = 0; i < 2; ++i) { int R, C; stage_rc(tid * 16 + i * 8192, R, C); const int Rb = Epi::PERM ? ((R & ~31) + perm32(R & 31)) : R;
        voffA[i] = (unsigned)(R * g.lda + C) * 2u; voffB[i] = (unsigned)(Rb * g.ldb + C) * 2u; }
    const size_t kstep = (size_t)(BK * 2);
    const size_t hstepA = (size_t)HALF * g.lda * 2, hstepB = (size_t)HALF * g.ldb * 2;
    const unsigned ldsw = (unsigned)wid * 1024u;
    const int aoff = lds_byte(wr * 64 + fr, fq * 8), boff = lds_byte(wc * 32 + fr, fq * 8);
#define PG8_SA(b, h) (((b) * 2 + (h)) * HTB)
#define PG8_SB(b, h) ((4 + (b) * 2 + (h)) * HTB)
#define PG8_STAGE(bufoff, gbase, voff) do { _Pragma("unroll") for (int _i = 0; _i < 2; ++_i) \
        __builtin_amdgcn_global_load_lds((const unsigned*)((const char*)(gbase) + (voff)[_i]), (LAS unsigned*)(lds + (bufoff) + ldsw + _i * 8192), 16, 0, 0); } while (0)
#define PG8_LDA(dst, b, h) do { _Pragma("unroll") for (int m = 0; m < 4; ++m) _Pragma("unroll") for (int k = 0; k < 2; ++k) dst[m][k] = *(const LAS bf16x8*)(lds + PG8_SA(b, h) + aoff + m * 2048 + k * 1024); } while (0)
#define PG8_LDB(dst, b, h) do { _Pragma("unroll") for (int n = 0; n < 2; ++n) _Pragma("unroll") for (int k = 0; k < 2; ++k) dst[n][k] = *(const LAS bf16x8*)(lds + PG8_SB(b, h) + boff + n * 2048 + k * 1024); } while (0)
#define PG8_MMA(ai, bj, At, Bt) do { __builtin_amdgcn_s_setprio(1); _Pragma("unroll") for (int m = 0; m < 4; ++m) _Pragma("unroll") for (int n = 0; n < 2; ++n) _Pragma("unroll") for (int k = 0; k < 2; ++k) \
        acc[ai][bj][m][n] = __builtin_amdgcn_mfma_f32_16x16x32_bf16(Bt[n][k], At[m][k], acc[ai][bj][m][n], 0, 0, 0); __builtin_amdgcn_s_setprio(0); } while (0)
#define PG8_WAIT_V(n) asm volatile("s_waitcnt vmcnt(" #n ")" ::: "memory")
#define PG8_WAIT_L(n) asm volatile("s_waitcnt lgkmcnt(" #n ")" ::: "memory")
#define PG8_BAR __builtin_amdgcn_s_barrier()
#define PG8_SCHED __builtin_amdgcn_sched_barrier(0)
    Unit cur, nxt; int ui = 0;
    if (!S.next(0, cur)) return;
    f32x4 acc[2][2][4][2];
#pragma unroll
    for (int a = 0; a < 2; ++a)
#pragma unroll
        for (int b = 0; b < 2; ++b)
#pragma unroll
            for (int m = 0; m < 4; ++m)
#pragma unroll
                for (int n = 0; n < 2; ++n) acc[a][b][m][n] = (f32x4){0.f, 0.f, 0.f, 0.f};
    bf16x8 At[4][2], B0[2][2], B1[2][2];
    const char* cA = (const char*)g.A + S.offA(cur); const char* cB = (const char*)g.Bt + S.offB(cur);
    PG8_STAGE(PG8_SB(0, 0), cB, voffB); PG8_STAGE(PG8_SB(0, 1), cB + hstepB, voffB); PG8_STAGE(PG8_SA(0, 0), cA, voffA); PG8_STAGE(PG8_SA(0, 1), cA + hstepA, voffA);
    if (wr == 1) PG8_BAR;
    PG8_WAIT_V(2); PG8_BAR;
    PG8_STAGE(PG8_SB(1, 0), cB + kstep, voffB); PG8_STAGE(PG8_SA(1, 0), cA + kstep, voffA); PG8_STAGE(PG8_SB(1, 1), cB + hstepB + kstep, voffB);
    PG8_WAIT_V(6); PG8_BAR;
    for (;;) {
        const bool has_next = S.next(ui + 1, nxt);
        const char* nA = has_next ? (const char*)g.A + S.offA(nxt) : cA; const char* nB = has_next ? (const char*)g.Bt + S.offB(nxt) : cB;
        for (int t = 0; t < nt; t += 2) {
            const bool last = (t == nt - 2);
            const char* a1 = cA + (size_t)(t + 1) * kstep;
            const char* a2 = last ? nA : cA + (size_t)(t + 2) * kstep; const char* b2 = last ? nB : cB + (size_t)(t + 2) * kstep;
            const char* a3 = a2 + kstep; const char* b3 = b2 + kstep;
            PG8_LDB(B0, 0, 0); PG8_LDB(B1, 0, 1); PG8_SCHED; PG8_LDA(At, 0, 0); PG8_STAGE(PG8_SA(1, 1), a1 + hstepA, voffA);
            PG8_WAIT_V(8); PG8_WAIT_L(0); PG8_BAR; PG8_MMA(0, 0, At, B0); PG8_MMA(0, 1, At, B1); PG8_BAR; PG8_SCHED;
            PG8_LDA(At, 0, 1); PG8_STAGE(PG8_SB(0, 0), b2, voffB); PG8_STAGE(PG8_SB(0, 1), b2 + hstepB, voffB); PG8_STAGE(PG8_SA(0, 0), a2, voffA);
            PG8_WAIT_V(8); PG8_WAIT_L(0); PG8_BAR; PG8_MMA(1, 0, At, B0); PG8_MMA(1, 1, At, B1); PG8_BAR; PG8_SCHED;
            PG8_LDB(B0, 1, 0); PG8_LDB(B1, 1, 1); PG8_SCHED; PG8_LDA(At, 1, 0); PG8_STAGE(PG8_SA(0, 1), a2 + hstepA, voffA);
            PG8_WAIT_V(8); PG8_WAIT_L(0); PG8_BAR; PG8_MMA(0, 0, At, B0); PG8_MMA(0, 1, At, B1); PG8_BAR; PG8_SCHED;
            PG8_LDA(At, 1, 1); PG8_STAGE(PG8_SB(1, 0), b3, voffB); PG8_STAGE(PG8_SB(1, 1), b3 + hstepB, voffB); PG8_STAGE(PG8_SA(1, 0), a3, voffA);
            PG8_WAIT_V(8); PG8_WAIT_L(0); PG8_BAR; PG8_MMA(1, 0, At, B0); PG8_MMA(1, 1, At, B1); PG8_BAR; PG8_SCHED;
        }
        if constexpr (ALIGN_EPI) { if (wr == 0) PG8_BAR; }
        E(acc, cur, wr, wc, fr, fq, lds);
        if (!has_next) break;
#pragma unroll
        for (int a = 0; a < 2; ++a)
#pragma unroll
            for (int b = 0; b < 2; ++b)
#pragma unroll
                for (int m = 0; m < 4; ++m)
#pragma unroll
                    for (int n = 0; n < 2; ++n) acc[a][b][m][n] = (f32x4){0.f, 0.f, 0.f, 0.f};
        cur = nxt; cA = nA; cB = nB; ++ui;
        if constexpr (ALIGN_EPI) { if (wr == 1) PG8_BAR; }
    }
    PG8_WAIT_V(0);
    if constexpr (!ALIGN_EPI) { if (wr == 0) PG8_BAR; }
    PG8_BAR;
#undef PG8_SA
#undef PG8_SB
#undef PG8_STAGE
#undef PG8_LDA
#undef PG8_LDB
#undef PG8_MMA
#undef PG8_WAIT_V
#undef PG8_WAIT_L
#undef PG8_BAR
#undef PG8_SCHED
}
}

struct KVSched {
    int c, G; const char* ws; size_t wsel;
    __device__ __forceinline__ bool next(int i, pg8::Unit& u) const {
        const int L = i * G + c; if (c < 0 || L >= 96) return false;
        const int kind = L >> 5, r = L & 31;
        if (kind < 2) { u.pm = kind * 16 + (r >> 2); u.pn = r & 3; } else { u.pm = 32 + (r >> 3); u.pn = r & 7; }
        return true;
    }
    __device__ __forceinline__ size_t offA(const pg8::Unit& u) const { const int kind = u.pm >> 4, pm = u.pm & 15; int k2 = (kind == 2); asm volatile("" : "+v"(k2));
        return (size_t)ws + WS_MEMB + (size_t)k2 * (WS_WV + wsel - WS_MEMB) + (size_t)pm * 256 * 1024 * 2; }
    __device__ __forceinline__ size_t offB(const pg8::Unit& u) const { const int kind = u.pm >> 4; int k1 = (kind == 1), k2 = (kind == 2); asm volatile("" : "+v"(k1), "+v"(k2));
        return (size_t)ws + WS_WK + wsel + (size_t)k1 * (WS_WV - WS_WK) + (size_t)k2 * (WS_MEMB - WS_WK - wsel) + (size_t)u.pn * 256 * 1024 * 2; }
};


#define XB_TMO      128
#define XB_XCNT(j)  (256  + 64 * (j))
#define XB_XSUB(j)  (1280 + 64 * (j))
#define XB_XGEN(j)  (2304 + 64 * (j))
#define XB_TOP      3328
#define XB_TOPGEN   3392
#define XCD_BAR_WORDS 3456
#define XB_SPIN_CAP (1u << 22)
__device__ __forceinline__ unsigned xb_ld(unsigned* p)              { return __hip_atomic_load(p, __ATOMIC_RELAXED, __HIP_MEMORY_SCOPE_AGENT); }
__device__ __forceinline__ unsigned xb_add(unsigned* p, unsigned v) { return __hip_atomic_fetch_add(p, v, __ATOMIC_RELAXED, __HIP_MEMORY_SCOPE_AGENT); }
__device__ __forceinline__ unsigned xb_xcc_id() { return (unsigned)__builtin_amdgcn_s_getreg((3 << 11) | 20) & 0xFu; }
#define XB_SPIN(cond, bar) do { unsigned _sp = 0; while (cond) { __builtin_amdgcn_s_sleep(1); \
    if ((++_sp & 255u) == 0u) { if (xb_ld(&(bar)[XB_TMO])) break; if (_sp > XB_SPIN_CAP) { atomicAdd(&(bar)[XB_TMO], 1u); break; } } } } while (0)
struct XcdBarrier { unsigned* bar; unsigned x; volatile LAS unsigned* st; };
__device__ __forceinline__ void xcd_barrier_complete(unsigned* bar, unsigned x, unsigned& nloc, unsigned& nx) {
    const unsigned G = gridDim.x * gridDim.y * gridDim.z;
    unsigned sum, cnt, mine, sp = 0u;
    for (;;) {
        sum = 0u; cnt = 0u; mine = 0u;
#pragma unroll
        for (unsigned j = 0; j < 16; ++j) { const unsigned c = xb_ld(&bar[XB_XCNT(j)]); sum += c; cnt += (c > 0u) ? 1u : 0u; mine = (j == x) ? c : mine; }
        if (sum == G) break;
        __builtin_amdgcn_s_sleep(1);
        if ((++sp & 255u) == 0u) { if (xb_ld(&bar[XB_TMO])) break; if (sp > XB_SPIN_CAP) { atomicAdd(&bar[XB_TMO], 1u); break; } }
    }
    nloc = mine > 0u ? mine : 1u; nx = cnt > 0u ? cnt : 1u;
}
__device__ __forceinline__ void xcd_barrier(const XcdBarrier& b) {
    asm volatile("s_waitcnt vmcnt(0)" ::: "memory");
    __syncthreads();
    if (threadIdx.x == 0) {
        unsigned* bar = b.bar;
        __builtin_amdgcn_s_waitcnt(0);
        unsigned nloc = b.st[0], nx = b.st[1];
        if (nloc == 0u) { xcd_barrier_complete(bar, b.x, nloc, nx); b.st[0] = nloc; b.st[1] = nx; }
        const unsigned old = xb_add(&bar[XB_XSUB(b.x)], 1u);
        const unsigned gen = old / nloc;
        if (old + 1u == (gen + 1u) * nloc) {
            __builtin_amdgcn_fence(__ATOMIC_RELEASE, "agent");
            asm volatile("s_waitcnt vmcnt(0)" ::: "memory");
            const unsigned og = xb_add(&bar[XB_TOP], 1u);
            const unsigned tg = og / nx;
            if (og + 1u == (tg + 1u) * nx) xb_add(&bar[XB_TOPGEN], 1u);
            else XB_SPIN(xb_ld(&bar[XB_TOPGEN]) == tg, bar);
            __builtin_amdgcn_fence(__ATOMIC_ACQUIRE, "agent");
            xb_add(&bar[XB_XGEN(b.x)], 1u);
            asm volatile("s_waitcnt vmcnt(0)" ::: "memory");
        } else {
            XB_SPIN(xb_ld(&bar[XB_XGEN(b.x)]) == gen, bar);
            __builtin_amdgcn_fence(__ATOMIC_ACQUIRE, "agent");
            asm volatile("s_waitcnt vmcnt(0)" ::: "memory");
        }
    }
    __syncthreads();
}


struct SG2 { const bf16_t* A; const bf16_t* Bt; int lda, ldb, K, N; bf16_t* O; int ldc; float scale; int mode; float* ssp; };
__device__ __forceinline__ float sq8(bf16x8 a) { float q = 0.f;
#pragma unroll
    for (int i = 0; i < 8; ++i) { const float f = bf2f((unsigned)(unsigned short)a[i]); q += f * f; } return q; }
__device__ __forceinline__ void sgemm2(LAS unsigned char* lds, const SG2 g, int ubase, int G, int wave, int tid) {
    const int lane = tid & 63, fr = lane & 15, fq = lane >> 4, rt = wave & 3, ch = wave >> 2;
    const int nunits = (g.N / 64) * 4, nsl = g.K / 64;
    int R, C; pg8::stage_rc(tid * 16, R, C);
    const unsigned offA = (unsigned)(R * g.lda + C) * 2u, offB = (unsigned)(R * g.ldb + C) * 2u;
    const int aoff = pg8::lds_byte(rt * 16 + fr, fq * 8), boff = pg8::lds_byte(ch * 32 + fr, fq * 8);
    for (int un = ubase; un >= 0 && un < nunits; un += G) {
        const int cgp = un >> 2, rg = un & 3;
        const char* gA = (const char*)(g.A + (size_t)rg * 64 * g.lda) + offA; const char* gB = (const char*)(g.Bt + (size_t)cgp * 64 * g.ldb) + offB;
#define SG2_STAGE(sl) do { LAS unsigned char* d_ = lds + ((sl) & 3) * 16384 + wave * 1024; \
        __builtin_amdgcn_global_load_lds((const unsigned*)(gA + (size_t)(sl) * 128), (LAS unsigned*)d_, 16, 0, 0); \
        __builtin_amdgcn_global_load_lds((const unsigned*)(gB + (size_t)(sl) * 128), (LAS unsigned*)(d_ + 8192), 16, 0, 0); } while (0)
        asm volatile("s_waitcnt vmcnt(0)" ::: "memory");
        SG2_STAGE(0); SG2_STAGE(1);
        f32x4 acc[2] = {(f32x4){0.f, 0.f, 0.f, 0.f}, (f32x4){0.f, 0.f, 0.f, 0.f}}; float q = 0.f;
        for (int sl = 0; sl < nsl; ++sl) {
            if (sl + 1 < nsl) asm volatile("s_waitcnt vmcnt(2)" ::: "memory"); else asm volatile("s_waitcnt vmcnt(0)" ::: "memory");
            __builtin_amdgcn_s_barrier(); asm volatile("" ::: "memory");
            if (sl + 2 < nsl) SG2_STAGE(sl + 2);
            LAS unsigned char* b_ = lds + (sl & 3) * 16384;
#pragma unroll
            for (int ks = 0; ks < 2; ++ks) {
                const bf16x8 a = *(const LAS bf16x8*)(b_ + aoff + ks * 1024);
#pragma unroll
                for (int c = 0; c < 2; ++c) { const bf16x8 b = *(const LAS bf16x8*)(b_ + 8192 + boff + c * 2048 + ks * 1024);
                    acc[c] = __builtin_amdgcn_mfma_f32_16x16x32_bf16(b, a, acc[c], 0, 0, 0); }
                if (g.mode == 1) q += sq8(a);
            }
        }
#undef SG2_STAGE
        const int row = rg * 64 + rt * 16 + fr, col = cgp * 64 + ch * 32 + fq * 4;
        bf16_t* op = g.O + (size_t)row * g.ldc + col;
        if (g.mode == 1) {
            q += shx(q, 16, lane); q += shx(q, 32, lane);
            const float sc = g.scale / sqrtf(q * (1.f / 1024.f) + EPS);
#pragma unroll
            for (int c = 0; c < 2; ++c) { const f32x4 v = acc[c] * sc; u32x2 w; w.x = cvt_pk_bf16(v[0], v[1]); w.y = cvt_pk_bf16(v[2], v[3]); *(u32x2*)(op + c * 16) = w; }
        } else {
            const u32x2 p0 = *(const u32x2*)op, p1 = *(const u32x2*)(op + 16); float qq = 0.f;
            { const float v0 = bflo(p0.x) + acc[0][0], v1 = bfhi(p0.x) + acc[0][1], v2 = bflo(p0.y) + acc[0][2], v3 = bfhi(p0.y) + acc[0][3];
              u32x2 w; w.x = cvt_pk_bf16(v0, v1); w.y = cvt_pk_bf16(v2, v3); *(u32x2*)op = w; qq += (v0 * v0 + v1 * v1) + (v2 * v2 + v3 * v3); }
            { const float v0 = bflo(p1.x) + acc[1][0], v1 = bfhi(p1.x) + acc[1][1], v2 = bflo(p1.y) + acc[1][2], v3 = bfhi(p1.y) + acc[1][3];
              u32x2 w; w.x = cvt_pk_bf16(v0, v1); w.y = cvt_pk_bf16(v2, v3); *(u32x2*)(op + 16) = w; qq += (v0 * v0 + v1 * v1) + (v2 * v2 + v3 * v3); }
            qq += shx(qq, 16, lane); qq += shx(qq, 32, lane);
            if (fq == 0) g.ssp[row * 32 + cgp * 2 + ch] = qq;
        }
        asm volatile("s_waitcnt vmcnt(0) lgkmcnt(0)" ::: "memory"); __builtin_amdgcn_s_barrier(); asm volatile("" ::: "memory");
    }
}

__device__ __forceinline__ void sgemm_act(LAS unsigned char* lds, const bf16_t* A, const bf16_t* Bt, bf16_t* Hs, const float* cfw, const float* scf, float* ocf, int ubase, int G, int wave, int tid) {
    const int lane = tid & 63, fr = lane & 15, fq = lane >> 4, rt = wave & 3, ch = wave >> 2;
    constexpr int nunits = (DFF / 64) * 4, nsl = D / 64, SLOT = 24576;
    int R, C; pg8::stage_rc(tid * 16, R, C);
    const unsigned off = (unsigned)(R * D + C) * 2u;
    const int aoff = pg8::lds_byte(rt * 16 + fr, fq * 8), boff = pg8::lds_byte(fr, fq * 8) + 8192 + ch * 8192;
    for (int un = ubase; un >= 0 && un < nunits; un += G) {
        const int fg = un >> 2, rg = un & 3, brow = ((fg >> 1) << 8) + ((fg & 1) << 6);
        const char* gA = (const char*)(A + (size_t)rg * 64 * D) + off; const char* gG = (const char*)(Bt + (size_t)brow * D) + off; const char* gU = (const char*)(Bt + (size_t)(brow + 128) * D) + off;
#define SGA_STAGE(sl) do { LAS unsigned char* d_ = lds + ((sl) & 3) * SLOT + wave * 1024; \
        __builtin_amdgcn_global_load_lds((const unsigned*)(gA + (size_t)(sl) * 128), (LAS unsigned*)d_, 16, 0, 0); \
        __builtin_amdgcn_global_load_lds((const unsigned*)(gG + (size_t)(sl) * 128), (LAS unsigned*)(d_ + 8192), 16, 0, 0); \
        __builtin_amdgcn_global_load_lds((const unsigned*)(gU + (size_t)(sl) * 128), (LAS unsigned*)(d_ + 16384), 16, 0, 0); } while (0)
        asm volatile("s_waitcnt vmcnt(0)" ::: "memory");
        SGA_STAGE(0); SGA_STAGE(1);
        f32x4 acc[4]; float q = 0.f;
#pragma unroll
        for (int c = 0; c < 4; ++c) acc[c] = (f32x4){0.f, 0.f, 0.f, 0.f};
        for (int sl = 0; sl < nsl; ++sl) {
            if (sl + 1 < nsl) asm volatile("s_waitcnt vmcnt(3)" ::: "memory"); else asm volatile("s_waitcnt vmcnt(0)" ::: "memory");
            __builtin_amdgcn_s_barrier(); asm volatile("" ::: "memory");
            if (sl + 2 < nsl) SGA_STAGE(sl + 2);
            LAS unsigned char* b_ = lds + (sl & 3) * SLOT;
#pragma unroll
            for (int ks = 0; ks < 2; ++ks) {
                const bf16x8 a = *(const LAS bf16x8*)(b_ + aoff + ks * 1024);
#pragma unroll
                for (int c = 0; c < 4; ++c) { const bf16x8 b = *(const LAS bf16x8*)(b_ + boff + c * 2048 + ks * 1024);
                    acc[c] = __builtin_amdgcn_mfma_f32_16x16x32_bf16(b, a, acc[c], 0, 0, 0); }
                q += sq8(a);
            }
        }
#undef SGA_STAGE
        q += shx(q, 16, lane); q += shx(q, 32, lane);
        const float rstd = 1.0f / sqrtf(q * (1.f / 1024.f) + EPS);
        asm volatile("s_waitcnt lgkmcnt(0)" ::: "memory"); __builtin_amdgcn_s_barrier(); asm volatile("" ::: "memory");
        LAS float* T = (LAS float*)(lds + ch * 20480);
#pragma unroll
        for (int c = 0; c < 4; ++c)
#pragma unroll
            for (int j = 0; j < 4; ++j) T[(rt * 16 + fr) * 65 + c * 16 + fq * 4 + j] = acc[c][j] * rstd;
        asm volatile("s_waitcnt lgkmcnt(0)" ::: "memory"); __builtin_amdgcn_s_barrier(); asm volatile("" ::: "memory");
        {
            const LAS float* Gt = (const LAS float*)lds; const LAS float* Ut = (const LAS float*)(lds + 20480);
            const int r = tid >> 3, f8 = (tid & 7) * 8, b = rg * 2 + (r >> 5), rr = r & 31, f = fg * 64 + f8;
            const float* st = scf + (size_t)(b * 2) * DFF + f;
            float hv[8], gv[8];
#pragma unroll
            for (int k = 0; k < 8; ++k) {
                const float g0 = Gt[r * 65 + f8 + k];
                const float gm1 = rr >= 1 ? Gt[(r - 1) * 65 + f8 + k] : st[DFF + k];
                const float gm2 = rr >= 2 ? Gt[(r - 2) * 65 + f8 + k] : (rr == 1 ? st[DFF + k] : st[k]);
                const float cv = cfw[f + k] * gm2 + cfw[DFF + f + k] * gm1 + cfw[2 * DFF + f + k] * g0;
                hv[k] = silu(cv) * Ut[r * 65 + f8 + k]; gv[k] = g0;
            }
            u32x4 w; w.x = pk2(hv[0], hv[1]); w.y = pk2(hv[2], hv[3]); w.z = pk2(hv[4], hv[5]); w.w = pk2(hv[6], hv[7]);
            *(u32x4*)(Hs + (size_t)(rg * 64 + r) * DFF + f) = w;
            if (rr >= 30) { float* o = ocf + ((size_t)b * 2 + (rr - 30)) * DFF + f; *(f32x4*)o = (f32x4){gv[0], gv[1], gv[2], gv[3]}; *(f32x4*)(o + 4) = (f32x4){gv[4], gv[5], gv[6], gv[7]}; }
        }
        asm volatile("s_waitcnt vmcnt(0) lgkmcnt(0)" ::: "memory"); __builtin_amdgcn_s_barrier(); asm volatile("" ::: "memory");
    }
}
__device__ __forceinline__ void sample_ss_reduce(const float* sss, float* ssq, int tid) {
    if (tid < 256) { const f32x4* p = (const f32x4*)(sss + tid * 32); float t = 0.f;
#pragma unroll
        for (int i = 0; i < 8; ++i) { const f32x4 v = p[i]; t += (v[0] + v[1]) + (v[2] + v[3]); }
        *(f32x4*)(ssq + (size_t)(MP + tid) * 4) = (f32x4){t, 0.f, 0.f, 0.f}; }
    asm volatile("s_waitcnt vmcnt(0)" ::: "memory"); __syncthreads();
}

__device__ __forceinline__ void transpose_item(const float* W, int K, int N, bf16_t* WT, LAS float* scr, int item, int lane, const float* gain = nullptr, int gu = 0) {
    const int nblk = N / 32, kb = item / nblk, nb = item % nblk, k0 = 64 * kb, n0 = 32 * nb;
    {
        f32x4 v[8];
#pragma unroll
        for (int i = 0; i < 8; ++i) v[i] = *(const f32x4*)(W + (size_t)(k0 + (lane >> 3) + 8 * i) * N + n0 + (lane & 7) * 4);
#pragma unroll
        for (int i = 0; i < 8; ++i) { const int kk = (lane >> 3) + 8 * i; f32x4 w = v[i]; if (gain) w = w * gain[k0 + kk];
            LAS float* d = scr + kk * 33 + (lane & 7) * 4; d[0] = w[0]; d[1] = w[1]; d[2] = w[2]; d[3] = w[3]; }
    }
    LDS_WAIT();
    const int c = lane & 7;
#pragma unroll
    for (int j = 0; j < 4; ++j) { const int n = (lane >> 3) + 8 * j; const LAS float* s = scr + (8 * c) * 33 + n;
        u32x4 o; o.x = pk2(s[0 * 33], s[1 * 33]); o.y = pk2(s[2 * 33], s[3 * 33]); o.z = pk2(s[4 * 33], s[5 * 33]); o.w = pk2(s[6 * 33], s[7 * 33]);
        int drow = n0 + n; if (gu) { const int up = drow >= gu, f = up ? drow - gu : drow; drow = ((f >> 7) << 8) + (up << 7) + (f & 127); }
        *(u32x4*)(WT + (size_t)drow * K + k0 + 8 * c) = o; }
    LDS_WAIT();
}

__device__ __forceinline__ void first_rows(const float* Xp, const float* Xs, bf16_t* XNo, float* ss, int gw, int NGW, int lane) {
    for (int m0 = gw; m0 < MT; m0 += 2 * NGW) {
        const int m1 = m0 + NGW; const bool two = m1 < MT; const int mb = two ? m1 : m0;
        const f32x4* xa = (const f32x4*)(m0 < MP ? Xp + (size_t)m0 * D : Xs + (size_t)(m0 - MP) * D) + lane;
        const f32x4* xb = (const f32x4*)(mb < MP ? Xp + (size_t)mb * D : Xs + (size_t)(mb - MP) * D) + lane;
        f32x4 va[4], vb[4]; float sa = 0.f, sb = 0.f;
#pragma unroll
        for (int j = 0; j < 4; ++j) { va[j] = xa[64 * j]; vb[j] = xb[64 * j]; }
#pragma unroll
        for (int j = 0; j < 4; ++j) { sa += (va[j].x * va[j].x + va[j].y * va[j].y) + (va[j].z * va[j].z + va[j].w * va[j].w); sb += (vb[j].x * vb[j].x + vb[j].y * vb[j].y) + (vb[j].z * vb[j].z + vb[j].w * vb[j].w); }
        sa = wave_sum(sa, lane); sb = wave_sum(sb, lane);
        if (lane < 4) { ss[(size_t)m0 * 4 + lane] = lane == 0 ? sa : 0.f; if (two) ss[(size_t)m1 * 4 + lane] = lane == 0 ? sb : 0.f; }
        u32x2* oa = (u32x2*)(XNo + (size_t)m0 * D) + lane; u32x2* ob = (u32x2*)(XNo + (size_t)mb * D) + lane;
#pragma unroll
        for (int j = 0; j < 4; ++j) { u32x2 w; w.x = pk2(va[j].x, va[j].y); w.y = pk2(va[j].z, va[j].w); oa[64 * j] = w; if (two) { w.x = pk2(vb[j].x, vb[j].y); w.y = pk2(vb[j].z, vb[j].w); ob[64 * j] = w; } }
    }
}

typedef __attribute__((address_space(4))) const unsigned char* kptr_t;
typedef const float* cfp_t; typedef float* fp_t; typedef unsigned char* ucp_t;
#define INP(k) (*(const __attribute__((address_space(4))) cfp_t*)(kp + 8 * (k)))
#define X out
#define WIN_T ((bf16_t*)(ws + WS_WIN + wsel))
#define WOUT_T ((bf16_t*)(ws + WS_WOUT + wsel))
#define WQ_T ((bf16_t*)(ws + WS_WQ + wsel))
#define WK_T ((bf16_t*)(ws + WS_WK + wsel))
#define WV_T ((bf16_t*)(ws + WS_WV + wsel))
#define WO_T ((bf16_t*)(ws + WS_WO + wsel))
#define WUP_T ((bf16_t*)(ws + WS_WUP + wsel))
#define WDN_T ((bf16_t*)(ws + WS_WDN + wsel))
#define MEMB ((bf16_t*)(ws + WS_MEMB))
#define KBP ((bf16_t*)(ws + WS_KBP))
#define VTP ((bf16_t*)(ws + WS_VTP))
#define KBS ((bf16_t*)(ws + WS_KBS + ksel))
#define VTS ((bf16_t*)(ws + WS_VTS + ksel))
#define WST ((bf16_t*)(ws + WS_WST + ksel))
#define AGG ((float*)(ws + WS_AGG))
#define SSQ(i) ((float*)(ws + WS_SSP) + (size_t)(i) * MT * 4)
#define SSS(i) ((float*)(ws + WS_SSS) + (size_t)(i) * 256 * 32)
#define GT_R ((bf16_t*)(ws + WS_GT + ksel))
#define GT_I ((bf16_t*)(ws + WS_GT + 65536 + ksel))
#define XN ((bf16_t*)(ws + WS_XN))
#define gZ ((bf16_t*)(ws + B_Z))
#define HLOC ((float*)(ws + B_HLOC))
#define PCUM ((float*)(ws + B_PCUM))
#define gY ((bf16_t*)(ws + B_Y))
#define gQ ((bf16_t*)(ws + B_Q))
#define gP ((bf16_t*)(ws + B_P))
#define gO ((bf16_t*)(ws + B_O))
#define PS ((bf16_t*)(ws + B_PS))
#define GU ((bf16_t*)(ws + B_GU))
#define GUS ((bf16_t*)(ws + B_GUS))
#define SBG ((float*)(ws + B_SBG))
#define SBU ((float*)(ws + B_SBU))
#define SBL ((float*)(ws + B_SBL))
__device__ __forceinline__ void convert_layer(kptr_t kp, unsigned char* ws, LAS unsigned char* lds, const int l, const int part, const int nparts, const int gw, const int NGW, const int gt, const int NGT, const int lane, const int wave) {
            const size_t wsel = (size_t)(l & 1) * WSEL1, ksel = (size_t)(l & 1) * KSEL1;
            LAS float* scr = (LAS float*)(lds + wave * 16384);
            const float* w_in = INP(I_WIN) + (size_t)l * D * INC; const float* w_out = INP(I_WOUT) + (size_t)l * D * D; const float* w_q = INP(I_WQ) + (size_t)l * D * D;
            const float* w_k = INP(I_WK) + (size_t)l * D * D; const float* w_v = INP(I_WV) + (size_t)l * D * D; const float* w_o = INP(I_WO) + (size_t)l * D * D;
            const float* w_up = INP(I_WUP) + (size_t)l * D * 2 * DFF; const float* w_dn = INP(I_WDN) + (size_t)l * DFF * D; const float* c_v = INP(I_CV) + (size_t)l * BS * NMEM * D;
            constexpr int T_IN = 16 * (INC / 32), T_SQ = 16 * 32, T_UP = 16 * (2 * DFF / 32), T_DN = (DFF / 64) * 32, T_CV = 32 * 32;
            constexpr int T_G = 16;
            constexpr int NIT = T_IN + 5 * T_SQ + T_UP + T_DN + T_CV + 2 * T_G;
            for (int it = (NIT * part) / nparts + gw; it < (NIT * (part + 1)) / nparts; it += NGW) {
                int r = it;
                if (r < T_IN) { transpose_item(w_in, D, INC, WIN_T, scr, r, lane, INP(I_GMIX) + l * D); continue; } r -= T_IN;
                if (r < T_SQ) { transpose_item(w_out, D, D, WOUT_T, scr, r, lane); continue; } r -= T_SQ;
                if (r < T_SQ) { transpose_item(w_q, D, D, WQ_T, scr, r, lane, INP(I_GX) + l * D); continue; } r -= T_SQ;
                if (r < T_SQ) { transpose_item(w_k, D, D, WK_T, scr, r, lane); continue; } r -= T_SQ;
                if (r < T_SQ) { transpose_item(w_v, D, D, WV_T, scr, r, lane); continue; } r -= T_SQ;
                if (r < T_SQ) { transpose_item(w_o, D, D, WO_T, scr, r, lane); continue; } r -= T_SQ;
                if (r < T_UP) { transpose_item(w_up, D, 2 * DFF, WUP_T, scr, r, lane, INP(I_GFFN) + l * D, DFF); continue; } r -= T_UP;
                if (r < T_DN) { transpose_item(w_dn, DFF, D, WDN_T, scr, r, lane); continue; } r -= T_DN;
                if (r < T_CV) { transpose_item(c_v, BS * NMEM, D, VTS, scr, r, lane); continue; } r -= T_CV;
                if (r < T_G) { transpose_item(INP(I_WRG) + ((size_t)l * 8 + (r >> 1)) * 4096, 64, 64, GT_R + (r >> 1) * 4096, scr, r & 1, lane); continue; } r -= T_G;
                transpose_item(INP(I_WIG) + ((size_t)l * 8 + (r >> 1)) * 4096, 64, 64, GT_I + (r >> 1) * 4096, scr, r & 1, lane);
            }
            if (part == 0) {
                const f32x4* ck = (const f32x4*)(INP(I_CK) + (size_t)l * BS * NMEM * D); u32x2* dk = (u32x2*)KBS;
                for (int i = gt; i < BS * NMEM * D / 4; i += NGT) { const f32x4 v = ck[i]; u32x2 w; w.x = pk2(v.x, v.y); w.y = pk2(v.z, v.w); dk[i] = w; }
                if (l == 0) { const f32x4* mm = (const f32x4*)INP(I_MEM); u32x2* dm = (u32x2*)MEMB;
                    for (int i = gt; i < BP * NMEM * D / 4; i += NGT) { const f32x4 v = mm[i]; u32x2 w; w.x = pk2(v.x, v.y); w.y = pk2(v.z, v.w); dm[i] = w; } }
                const float* wsl = INP(I_WS) + (size_t)l * 4 * 128 * 128;
                for (int i = gt; i < 4 * 128 * 128; i += NGT) { const int s = i & 127, t = (i >> 7) & 127; WST[i] = (bf16_t)f2bf(s <= t ? wsl[i] : 0.f); }
            }
}

__global__ void __launch_bounds__(NTHREADS, 2) trunk_fwd(Args args) {
    extern __shared__ __attribute__((aligned(16))) unsigned char lds_raw[];
    LAS unsigned char* lds = (LAS unsigned char*)lds_raw;
    cg::grid_group grid = cg::this_grid();
    const int wave_s = __builtin_amdgcn_readfirstlane(threadIdx.x >> 6);
#define LANE_STATE() int G = gridDim.x, bid = blockIdx.x; asm volatile("" : "+s"(G), "+s"(bid)); const int NGW = G * NWAVES, NGT = G * NTHREADS; (void)NGW; (void)NGT; \
    const int tid = opaque_tid(wave_s), lane = tid & 63, wave = wave_s; const int gw = bid * NWAVES + wave; const int gt = bid * NTHREADS + tid; (void)lane; (void)gw; (void)gt; \
    kptr_t kp = (kptr_t)__builtin_amdgcn_kernarg_segment_ptr(); asm volatile("" : "+s"(kp)); \
    float* const out = *(const __attribute__((address_space(4))) fp_t*)(kp + 8 * N_IN); unsigned char* const ws = *(const __attribute__((address_space(4))) ucp_t*)(kp + 8 * N_IN + 8); (void)out; (void)ws
    {
        LANE_STATE();
        if (bid == 0) for (int i = tid; i < XCD_BAR_WORDS; i += NTHREADS) __hip_atomic_store((unsigned*)(ws + WS_BAR) + i, 0u, __ATOMIC_RELAXED, __HIP_MEMORY_SCOPE_AGENT);
        if (tid < 32) ((LAS unsigned*)(lds + LDS_MISC))[tid] = 0u;
        __threadfence();
        grid.sync();
        if (tid == 0) (void)xb_add((unsigned*)(ws + WS_BAR) + XB_XCNT(xb_xcc_id()), 1u);
    }
#define GRID_SYNC() do { kptr_t kp_ = (kptr_t)__builtin_amdgcn_kernarg_segment_ptr(); asm volatile("" : "+s"(kp_)); \
        XcdBarrier b_; b_.bar = (unsigned*)(*(const __attribute__((address_space(4))) ucp_t*)(kp_ + 8 * N_IN + 8) + WS_BAR); b_.x = xb_xcc_id(); b_.st = (volatile LAS unsigned*)(lds + LDS_MISC); \
        xcd_barrier(b_); if (PROBE == 3) xcd_barrier(b_); } while (0)

    for (int l = 0; l < DEPTH; ++l) {
        const size_t wsel = (size_t)(l & 1) * WSEL1, ksel = (size_t)(l & 1) * KSEL1;
        if (l == 0)
        for (int dup0 = 0; dup0 < ((PROBE == 1 || PROBE == 5) ? 2 : 1); ++dup0) {
        {
            LANE_STATE();
            convert_layer(kp, ws, lds, l, 0, 1, gw, NGW, gt, NGT, lane, wave);
            if (l == 0) first_rows(INP(I_XP), INP(I_XS), XN, SSQ(0), gw, NGW, lane);
        }
        GRID_SYNC();
        }
        {
            LANE_STATE();
            KVSched S; S.G = G; S.c = bid >= 160 ? bid - 160 : -1; S.ws = (const char*)ws; S.wsel = wsel;
            pg8::Gemm g{(const bf16_t*)nullptr, (const bf16_t*)nullptr, D, D, D};
            pg8::EpiKV E{out + O_MKP + (size_t)l * BP * NMEM * D, out + O_MVP + (size_t)l * BP * NMEM * D, KBP, VTP};
            pg8::gemm_phase<pg8::EpiKV, KVSched, true>(lds, g, S, E, wave_s);
        }
#define GEMM_BF16(s_) do { const int s = (s_); pg8::GSched S; pg8::Gemm g; pg8::EpiBf16 E; E.scale = 1.f; E.ss = nullptr; E.smp = 0; \
        if (s == 0) { S.init(MT / 256, INC / 256, G, bid); S.aPm = (size_t)256 * D * 2; S.bPn = (size_t)256 * D * 2; g = pg8::Gemm{XN, WIN_T, D, D, D}; E.O = gZ; E.ldc = INC; E.ss = SSQ(3 * l); } \
        else if (s == 1) { S.init(MP / 256, D / 256, G, bid); S.aPm = (size_t)256 * D * 2; S.bPn = (size_t)256 * D * 2; g = pg8::Gemm{XN, WQ_T, D, D, D}; E.O = gQ; E.ldc = D; E.scale = 0.0625f; E.ss = SSQ(3 * l + 1); } \
        else if (s == 2) { S.init(MP / 256, 4, G, bid); S.aPm = (size_t)256 * D * 2; S.aPn = 512; S.bPn = (size_t)256 * 2048 * 2; S.bPm = 512; S.bShift = 4; g = pg8::Gemm{gP, VTP, D, 2048, 256}; E.O = gO; E.ldc = D; } \
        else { S.init(1, 32, G, (bid + G - 64) % G); S.mode = 2; g = pg8::Gemm{PS, VTS, 8192, 2048, 256}; E.O = gO + (size_t)MP * D; E.ldc = D; E.smp = 1; } \
        pg8::gemm_phase<pg8::EpiBf16, pg8::GSched, true>(lds, g, S, E, wave_s); } while (0)
#define GEMM_RES(s_) do { const int s = (s_); pg8::GSched S; S.init(MP / 256, D / 256, G, bid); pg8::Gemm g; \
        if (s == 0) { g = pg8::Gemm{gY, WOUT_T, D, D, D}; S.aPm = (size_t)256 * D * 2; } \
        else if (s == 1) { g = pg8::Gemm{gO, WO_T, D, D, D}; S.aPm = (size_t)256 * D * 2; } \
        else { g = pg8::Gemm{GU, WDN_T, DFF, DFF, DFF}; S.aPm = (size_t)256 * DFF * 2; } \
        S.bPn = (size_t)256 * g.ldb * 2; \
        pg8::EpiResid E{XN, SSQ(3 * l + 1 + s)}; \
        pg8::gemm_phase<pg8::EpiResid, pg8::GSched, true>(lds, g, S, E, wave_s); } while (0)

        for (int rep = 0; rep < 13; ++rep) { if (rep == 4 || rep == 9 || rep == 11) continue;
          const int ndup = ((PROBE == 1 && (rep == 1 || rep == 2)) || (PROBE == 4 && rep == 1) || (PROBE == 6 && rep == 2)) ? 2 : ((PROBE == 2 && (rep == 0 || rep == 5 || rep == 6 || rep == 7 || rep == 10)) ? 2 : 1);
          for (int dup = 0; dup < ndup; ++dup) {
            if (rep == 0 || rep == 5 || rep == 7) {
                LANE_STATE();
                const int s0 = rep == 0 ? 0 : (rep == 5 ? 1 : 2), ns = rep == 7 ? 2 : 1;
                if (rep == 0 && l > 0) {
                    pg8::GSched S0; S0.init(MT / 256, INC / 256, G, bid); pg8::Unit u0; bool own = false;
                    for (int i = 0; S0.next(i, u0); ++i) own = own || (u0.pm == 128);
                    if (own) sample_ss_reduce(SSS(3 * l), SSQ(3 * l), tid);
                }
                for (int q = 0; q < ns; ++q) GEMM_BF16(s0 + q);
                if (rep == 5) { LANE_STATE(); const SG2 sg{XN + (size_t)MP * D, WQ_T, D, D, D, D, gQ + (size_t)MP * D, D, 0.0625f, 1, nullptr}; sgemm2(lds, sg, bid, G, wave, tid); }
                if (rep == 5 && l + 1 < DEPTH) { LANE_STATE(); if (bid >= 64) convert_layer(kp, ws, lds, l + 1, 1, 3, gw - 64 * NWAVES, NGW - 64 * NWAVES, gt - 64 * NTHREADS, NGT - 64 * NTHREADS, lane, wave); }
            } else if (rep == 10) {
                LANE_STATE();
                pg8::GSched S; S.init(MP / 256, 2 * DFF / 256, G, bid); S.aPm = (size_t)256 * D * 2; S.bPn = (size_t)256 * D * 2;
                const pg8::Gemm g{XN, WUP_T, D, D, D};
                const pg8::EpiAct E{GU, INP(I_SCF) + (size_t)l * BS * 2 * DFF, out + O_CFS + (size_t)l * BS * 2 * DFF, SBG, SBU, SBL, INP(I_CFW) + (size_t)l * 3 * DFF, SSQ(3 * l + 2)};
                pg8::gemm_phase<pg8::EpiAct, pg8::GSched, true>(lds, g, S, E, wave_s);
                { LANE_STATE(); sgemm_act(lds, XN + (size_t)MP * D, WUP_T, GU + (size_t)MP * DFF, INP(I_CFW) + (size_t)l * 3 * DFF, INP(I_SCF) + (size_t)l * BS * 2 * DFF, out + O_CFS + (size_t)l * BS * 2 * DFF, bid, G, wave, tid); }
            } else if (rep == 1) {
                LANE_STATE();
                {
                    LAS bf16_t* vT = (LAS bf16_t*)lds;
                    constexpr int VP = 136;
                    const float* gvp = INP(I_GV) + l * CW; const float* bsp = INP(I_BSS) + l * 4 * 128;
                    for (int un = (bid + G / 2) % G; un < 8 + 256; un += G) {
                        int rowbase, nrows, sb = -1;
                        if (un < 8) { sb = un; rowbase = MP + un * TS; nrows = TS; } else { rowbase = (un - 8) * 128; nrows = 128; }
                        {
                            const int rl = tid >> 5, cgp = tid & 31;
                            f32x4 g0 = *(const f32x4*)(gvp + cgp * 8), g1 = *(const f32x4*)(gvp + cgp * 8 + 4);
                            for (int p = 0; p < nrows / 16; ++p) {
                                const int r = p * 16 + rl;
                                const u32x4 raw = *(const u32x4*)(gZ + (size_t)(rowbase + r) * INC + Z_VC + cgp * 8);
                                float v[8] = {bflo(raw.x), bfhi(raw.x), bflo(raw.y), bfhi(raw.y), bflo(raw.z), bfhi(raw.z), bflo(raw.w), bfhi(raw.w)};
                                float ss = 0.f;
#pragma unroll
                                for (int k = 0; k < 8; ++k) { v[k] = gelu_t(v[k]); ss += v[k] * v[k]; }
                                ss += shx(ss, 1, lane); ss += shx(ss, 2, lane); ss += shx(ss, 4, lane);
                                const float rstd = 1.0f / sqrtf(ss * (1.f / 64.f) + EPS);
                                const float gg[8] = {g0.x, g0.y, g0.z, g0.w, g1.x, g1.y, g1.z, g1.w};
#pragma unroll
                                for (int k = 0; k < 8; ++k) { v[k] = v[k] * rstd * gg[k]; vT[(cgp * 8 + k) * VP + r] = (bf16_t)f2bf(v[k]); }
                                if (sb >= 0) { float* vo = out + O_VCS + ((size_t)(l * BS + sb) * TS + r) * CW + cgp * 8;
                                    *(f32x4*)vo = (f32x4){v[0], v[1], v[2], v[3]}; *(f32x4*)(vo + 4) = (f32x4){v[4], v[5], v[6], v[7]}; }
                            }
                        }
                        __syncthreads();
                        {
                            const int hh = wave & 3, rh = wave >> 2, fr = lane & 15, fq = lane >> 4;
                            const int nmt = nrows == 128 ? 4 : (rh == 0 ? 2 : 0);
                            for (int mi = 0; mi < nmt; ++mi) {
                                const int mt = rh * 4 + mi, nks = (mt * 16 + 15) / 32 + 1;
                                f32x4 acc[4];
#pragma unroll
                                for (int n = 0; n < 4; ++n) acc[n] = (f32x4){0.f, 0.f, 0.f, 0.f};
                                for (int ks = 0; ks < nks; ++ks) {
                                    const bf16x8 a = *(const bf16x8*)(WST + ((size_t)(hh * 128 + mt * 16 + fr) * 128 + ks * 32 + fq * 8));
#pragma unroll
                                    for (int n = 0; n < 4; ++n) { const bf16x8 b = *(const LAS bf16x8*)(vT + (hh * 64 + n * 16 + fr) * VP + ks * 32 + fq * 8);
                                        acc[n] = __builtin_amdgcn_mfma_f32_16x16x32_bf16(b, a, acc[n], 0, 0, 0); }
                                }
                                { const int t = mt * 16 + fr; const float bias = bsp[hh * 128 + t]; const size_t row = (size_t)(rowbase + t);
#pragma unroll
                                    for (int n = 0; n < 4; ++n) { const int c = hh * 64 + n * 16 + fq * 4; const u32x2 uq = *(const u32x2*)(gZ + row * INC + Z_UC + c);
                                        u32x2 w; w.x = pk2(gelu_t(bflo(uq.x)) * (acc[n][0] + bias), gelu_t(bfhi(uq.x)) * (acc[n][1] + bias)); w.y = pk2(gelu_t(bflo(uq.y)) * (acc[n][2] + bias), gelu_t(bfhi(uq.y)) * (acc[n][3] + bias));
                                        *(u32x2*)(gY + row * D + 768 + c) = w; } }
                            }
                        }
                        __syncthreads();
                    }
                }
                {
                    LAS unsigned char* wl = lds + wave * 16384;
                    LAS bf16_t* tile = (LAS bf16_t*)wl;
                    LAS float* pre_r = (LAS float*)(wl + 2560);
                    LAS float* pre_i = (LAS float*)(wl + 2560 + 4096);
                    LAS float* xcf = (LAS float*)(wl + 2560 + 8192);
                    const int fr = lane & 15, fq = lane >> 4;
                    for (int un = gw; un < 64 + 2048; un += NGW) {
                        int b, hd, rowbase, nrows, t0; bool smp = un < 64;
                        if (smp) { b = un >> 3; hd = un & 7; rowbase = MP + b * TS; nrows = TS; t0 = 0; }
                        else { const int v = un - 64; const int ch = v & 31; hd = (v >> 5) & 7; b = v >> 8; t0 = ch * 128; rowbase = b * SEQ + t0; nrows = 128; }
                        const int cidx = l * AW + hd * 64 + lane;
                        const float br = INP(I_BRG)[cidx], bi = INP(I_BIG)[cidx];
                        const float c8sp = 8.0f * log1pf(__expf(-INP(I_LAM)[cidx]));
                        const float* caw = INP(I_CAW) + (size_t)l * 4 * AW + hd * 64 + lane;
                        const float cw0 = caw[0], cw1 = caw[AW], cw2 = caw[2 * AW], cw3 = caw[3 * AW], cb = INP(I_CAB)[cidx];
                        bf16x8 bR[4][2], bI[4][2];
#pragma unroll
                        for (int n = 0; n < 4; ++n)
#pragma unroll
                            for (int ks = 0; ks < 2; ++ks) { const size_t o_ = (size_t)(hd * 64 + n * 16 + fr) * 64 + ks * 32 + fq * 8;
                                bR[n][ks] = *(const bf16x8*)(GT_R + o_); bI[n][ks] = *(const bf16x8*)(GT_I + o_); }
                        float xm3 = 0.f, xm2 = 0.f, xm1 = 0.f;
                        if (smp) { const float* st = INP(I_SCA) + ((size_t)(l * BS + b) * 3) * AW + hd * 64 + lane; xm3 = st[0]; xm2 = st[AW]; xm1 = st[2 * AW]; }
                        else if (t0 > 0) { const bf16_t* zp = gZ + (size_t)(rowbase - 3) * INC + Z_XA + hd * 64 + lane; xm3 = bf2f(zp[0]); xm2 = bf2f(zp[INC]); xm1 = bf2f(zp[2 * INC]); }
                        float h = 0.f, pc = 1.f;
                        const bf16_t* zq = gZ + (size_t)(rowbase + (lane >> 3)) * INC + Z_XA + hd * 64 + (lane & 7) * 8;
                        float* hp = HLOC + (size_t)rowbase * AW + hd * 64 + lane; float* pp = PCUM + (size_t)rowbase * AW + hd * 64 + lane;
                        LAS bf16_t* xraw = (LAS bf16_t*)pre_r;
                        u32x4 xn0 = *(const u32x4*)zq, xn1 = *(const u32x4*)(zq + (size_t)8 * INC);
                        for (int st = 0; st < nrows / 16; ++st) {
                            *(LAS u32x4*)(xraw + (lane >> 3) * 64 + (lane & 7) * 8) = xn0; *(LAS u32x4*)(xraw + ((lane >> 3) + 8) * 64 + (lane & 7) * 8) = xn1;
                            zq += (size_t)16 * INC;
                            if (st + 1 < nrows / 16) { xn0 = *(const u32x4*)zq; xn1 = *(const u32x4*)(zq + (size_t)8 * INC); }
                            LDS_WAIT();
#pragma unroll
                            for (int i = 0; i < 16; ++i) { const float xv = bf2f(xraw[i * 64 + lane]);
                                const float xc = cw0 * xm3 + cw1 * xm2 + cw2 * xm1 + cw3 * xv + cb; xm3 = xm2; xm2 = xm1; xm1 = xv; xcf[i * 64 + lane] = xc; tile[i * 72 + lane] = (bf16_t)f2bf(xc); }
                            LDS_WAIT();
                            const bf16x8 a0 = *(const LAS bf16x8*)(tile + fr * 72 + fq * 8), a1 = *(const LAS bf16x8*)(tile + fr * 72 + 32 + fq * 8);
#pragma unroll
                            for (int n = 0; n < 4; ++n) {
                                f32x4 ar = (f32x4){0.f, 0.f, 0.f, 0.f}, ai = (f32x4){0.f, 0.f, 0.f, 0.f};
                                ar = __builtin_amdgcn_mfma_f32_16x16x32_bf16(a0, bR[n][0], ar, 0, 0, 0); ar = __builtin_amdgcn_mfma_f32_16x16x32_bf16(a1, bR[n][1], ar, 0, 0, 0);
                                ai = __builtin_amdgcn_mfma_f32_16x16x32_bf16(a0, bI[n][0], ai, 0, 0, 0); ai = __builtin_amdgcn_mfma_f32_16x16x32_bf16(a1, bI[n][1], ai, 0, 0, 0);
#pragma unroll
                                for (int j = 0; j < 4; ++j) { pre_r[(fq * 4 + j) * 64 + n * 16 + fr] = ar[j]; pre_i[(fq * 4 + j) * 64 + n * 16 + fr] = ai[j]; }
                            }
                            LDS_WAIT();
#pragma unroll 4
                            for (int i = 0; i < 16; ++i) {
                                const float r = sigm(pre_r[i * 64 + lane] + br), gi = sigm(pre_i[i * 64 + lane] + bi);
                                const float la = -c8sp * r; float a, om;
                                if (la > -0.125f) { const float x = 2.0f * la; om = -x * (1.0f + x * (0.5f + x * (0.16666667f + x * (0.041666668f + x * (0.0083333338f + x * 0.0013888889f))))); a = 1.0f + la * (1.0f + la * (0.5f + la * (0.16666667f + la * (0.041666668f + la * 0.0083333338f)))); }
                                else { a = __expf(la); om = -expm1f(2.0f * la); }
                                const float bm = __builtin_amdgcn_sqrtf(om);
                                h = a * h + bm * gi * xcf[i * 64 + lane]; pc = pc * a;
                                *hp = h; *pp = pc; hp += AW; pp += AW;
                            }
                            LDS_WAIT();
                        }
                        AGG[(size_t)un * 128 + lane] = pc; AGG[(size_t)un * 128 + 64 + lane] = h;
                    }
                }
                {
                    const float* cbw = INP(I_CBW) + (size_t)l * 3 * BW;
                    for (int it = gt; it < (MT / 8) * 32; it += NGT) {
                        const int rb = it >> 5, c0 = (it & 31) * 8;
                        int b, t0, T, rowbase; const bool smp = rb >= MP / 8;
                        if (!smp) { b = rb >> 9; t0 = (rb & 511) * 8; T = SEQ; rowbase = rb * 8; } else { const int sbk = rb - MP / 8; b = sbk >> 2; t0 = (sbk & 3) * 8; T = TS; rowbase = MP + sbk * 8; }
                        u32x4 xq[10], cq[10], bq[8];
                        const bf16_t* zr = gZ + (size_t)rowbase * INC + c0;
#pragma unroll
                        for (int i = 0; i < 10; ++i) { if (i >= 2 || t0 > 0) { xq[i] = *(const u32x4*)(zr + (ptrdiff_t)(i - 2) * INC + Z_XB); cq[i] = *(const u32x4*)(zr + (ptrdiff_t)(i - 2) * INC + Z_GC); } else { xq[i] = (u32x4){0u, 0u, 0u, 0u}; cq[i] = (u32x4){0u, 0u, 0u, 0u}; } }
#pragma unroll
                        for (int i = 0; i < 8; ++i) bq[i] = *(const u32x4*)(zr + (size_t)i * INC + Z_GB);
                        float w0[8], w1[8], w2[8], pm2[8], pm1[8];
#pragma unroll
                        for (int k = 0; k < 8; ++k) { w0[k] = cbw[c0 + k]; w1[k] = cbw[BW + c0 + k]; w2[k] = cbw[2 * BW + c0 + k]; }
                        {
                            const float a_[8] = {bflo(xq[0].x) * bflo(cq[0].x), bfhi(xq[0].x) * bfhi(cq[0].x), bflo(xq[0].y) * bflo(cq[0].y), bfhi(xq[0].y) * bfhi(cq[0].y), bflo(xq[0].z) * bflo(cq[0].z), bfhi(xq[0].z) * bfhi(cq[0].z), bflo(xq[0].w) * bflo(cq[0].w), bfhi(xq[0].w) * bfhi(cq[0].w)};
                            const float b_[8] = {bflo(xq[1].x) * bflo(cq[1].x), bfhi(xq[1].x) * bfhi(cq[1].x), bflo(xq[1].y) * bflo(cq[1].y), bfhi(xq[1].y) * bfhi(cq[1].y), bflo(xq[1].z) * bflo(cq[1].z), bfhi(xq[1].z) * bfhi(cq[1].z), bflo(xq[1].w) * bflo(cq[1].w), bfhi(xq[1].w) * bfhi(cq[1].w)};
#pragma unroll
                            for (int k = 0; k < 8; ++k) { pm2[k] = a_[k]; pm1[k] = b_[k]; }
                        }
                        if (t0 == 0 && smp) { const float* st = INP(I_SCB) + ((size_t)(l * BS + b) * 2) * BW + c0;
#pragma unroll
                            for (int k = 0; k < 8; ++k) { pm2[k] = st[k]; pm1[k] = st[BW + k]; } }
#pragma unroll
                        for (int i = 0; i < 8; ++i) {
                            const u32x4 xb = xq[i + 2], gc = cq[i + 2], gb = bq[i];
                            const float pv[8] = {bflo(xb.x) * bflo(gc.x), bfhi(xb.x) * bfhi(gc.x), bflo(xb.y) * bflo(gc.y), bfhi(xb.y) * bfhi(gc.y), bflo(xb.z) * bflo(gc.z), bfhi(xb.z) * bfhi(gc.z), bflo(xb.w) * bflo(gc.w), bfhi(xb.w) * bfhi(gc.w)};
                            const float gbv[8] = {bflo(gb.x), bfhi(gb.x), bflo(gb.y), bfhi(gb.y), bflo(gb.z), bfhi(gb.z), bflo(gb.w), bfhi(gb.w)};
                            float yv[8];
#pragma unroll
                            for (int k = 0; k < 8; ++k) { yv[k] = gbv[k] * (w0[k] * pm2[k] + w1[k] * pm1[k] + w2[k] * pv[k]); pm2[k] = pm1[k]; pm1[k] = pv[k]; }
                            u32x4 w; w.x = pk2(yv[0], yv[1]); w.y = pk2(yv[2], yv[3]); w.z = pk2(yv[4], yv[5]); w.w = pk2(yv[6], yv[7]);
                            *(u32x4*)(gY + (size_t)(rowbase + i) * D + 512 + c0) = w;
                        }
                        if (t0 + 8 == T) { float* o = out + (smp ? O_CBS : O_CBP) + ((size_t)(l * 8 + b) * 2) * BW + c0;
#pragma unroll
                            for (int k = 0; k < 8; ++k) { o[k] = pm2[k]; o[BW + k] = pm1[k]; } }
                    }
                }
            } else if (rep == 2) {
                LANE_STATE();
                {
                    LAS float* cr = (LAS float*)lds;
                    for (int un = bid; un < 8 + 256; un += G) {
                        int b, ch, rowbase, nrows; const bool smp = un < 8;
                        if (smp) { b = un; ch = 0; rowbase = MP + b * TS; nrows = TS; } else { const int v = un - 8; b = v >> 5; ch = v & 31; rowbase = b * SEQ + ch * 128; nrows = 128; }
                        {
                            const int c = tid, hd = c >> 6, ln = c & 63; float carry = 0.f;
                            if (smp) carry = INP(I_SHA)[(size_t)(l * BS + b) * AW + c];
                            else { const float* ag = AGG + (size_t)(64 + (b << 8) + (hd << 5)) * 128 + ln; for (int k = 0; k < ch; ++k) carry = ag[(size_t)k * 128] * carry + ag[(size_t)k * 128 + 64]; }
                            cr[c] = carry;
                        }
                        __syncthreads();
                        const int c0 = (tid & 63) * 8, rsub = tid >> 6;
                        const f32x4 ca = *(const LAS f32x4*)(cr + c0), cb = *(const LAS f32x4*)(cr + c0 + 4);
                        for (int p = 0; p < nrows / 8; ++p) {
                            const int rloc = p * 8 + rsub; const size_t row = (size_t)(rowbase + rloc);
                            const f32x4 h0 = *(const f32x4*)(HLOC + row * AW + c0), h1 = *(const f32x4*)(HLOC + row * AW + c0 + 4), p0 = *(const f32x4*)(PCUM + row * AW + c0), p1 = *(const f32x4*)(PCUM + row * AW + c0 + 4);
                            const u32x4 gq = *(const u32x4*)(gZ + row * INC + Z_GA + c0);
                            const f32x4 a0 = h0 + p0 * ca, a1 = h1 + p1 * cb;
                            u32x4 w; w.x = pk2(gelu_t(bflo(gq.x)) * a0[0], gelu_t(bfhi(gq.x)) * a0[1]); w.y = pk2(gelu_t(bflo(gq.y)) * a0[2], gelu_t(bfhi(gq.y)) * a0[3]);
                            w.z = pk2(gelu_t(bflo(gq.z)) * a1[0], gelu_t(bfhi(gq.z)) * a1[1]); w.w = pk2(gelu_t(bflo(gq.w)) * a1[2], gelu_t(bfhi(gq.w)) * a1[3]);
                            *(u32x4*)(gY + row * D + c0) = w;
                            if ((smp || ch == 31) && rloc == nrows - 1) { float* o = out + (smp ? O_HAS : O_HAP) + (size_t)(l * 8 + b) * AW + c0; *(f32x4*)o = a0; *(f32x4*)(o + 4) = a1; }
                        }
                        if ((smp || ch == 31) && tid < 192) {
                            const int k = tid >> 6; const u32x4 xq = *(const u32x4*)(gZ + (size_t)(rowbase + nrows - 3 + k) * INC + Z_XA + c0);
                            float* o = out + (smp ? O_CAS : O_CAP) + ((size_t)(l * 8 + b) * 3 + k) * AW + c0;
                            *(f32x4*)o = (f32x4){bflo(xq.x), bfhi(xq.x), bflo(xq.y), bfhi(xq.y)}; *(f32x4*)(o + 4) = (f32x4){bflo(xq.z), bfhi(xq.z), bflo(xq.w), bfhi(xq.w)};
                        }
                        __syncthreads();
                    }
                }
            } else if (rep == 3 || rep == 8 || rep == 12) {
                LANE_STATE();
                if (rep == 12) {
                    const float* cfw = INP(I_CFW) + (size_t)l * 3 * DFF;
                    pg8::GSched S0; S0.init(MP / 256, D / 256, G, bid); pg8::Unit u0;
                    for (int i = 0; S0.next(i, u0); ++i) {
                        const int pm = u0.pm; if (pm >= 128 || tid >= DFF / 8) continue;
                        const int c0 = tid * 8, b = pm >> 4;
                        float w0[8], w1[8], w2[8], p2[8], p1[8], g0[8], g1[8], u0_[8], u1_[8];
#pragma unroll
                        for (int k = 0; k < 8; ++k) { w0[k] = cfw[c0 + k]; w1[k] = cfw[DFF + c0 + k]; w2[k] = cfw[2 * DFF + c0 + k]; p2[k] = 0.f; p1[k] = 0.f; }
                        if ((pm & 15) != 0) {
#pragma unroll
                            for (int k = 0; k < 8; ++k) { p2[k] = SBL[((size_t)(pm - 1) * 2 + 0) * DFF + c0 + k]; p1[k] = SBL[((size_t)(pm - 1) * 2 + 1) * DFF + c0 + k]; } }
#pragma unroll
                        for (int k = 0; k < 8; ++k) { g0[k] = SBG[((size_t)pm * 2 + 0) * DFF + c0 + k]; g1[k] = SBG[((size_t)pm * 2 + 1) * DFF + c0 + k]; u0_[k] = SBU[((size_t)pm * 2 + 0) * DFF + c0 + k]; u1_[k] = SBU[((size_t)pm * 2 + 1) * DFF + c0 + k]; }
                        float ha[8], hb[8];
#pragma unroll
                        for (int k = 0; k < 8; ++k) { ha[k] = silu(w0[k] * p2[k] + w1[k] * p1[k] + w2[k] * g0[k]) * u0_[k]; hb[k] = silu(w0[k] * p1[k] + w1[k] * g0[k] + w2[k] * g1[k]) * u1_[k]; }
                        u32x4 w; w.x = pk2(ha[0], ha[1]); w.y = pk2(ha[2], ha[3]); w.z = pk2(ha[4], ha[5]); w.w = pk2(ha[6], ha[7]);
                        *(u32x4*)(GU + (size_t)(pm * 256) * DFF + c0) = w;
                        w.x = pk2(hb[0], hb[1]); w.y = pk2(hb[2], hb[3]); w.z = pk2(hb[4], hb[5]); w.w = pk2(hb[6], hb[7]);
                        *(u32x4*)(GU + (size_t)(pm * 256 + 1) * DFF + c0) = w;
                        if ((pm & 15) == 15 && u0.pn == 0) { float* o = out + O_CFP + ((size_t)(l * 8 + b) * 2) * DFF + c0;
#pragma unroll
                            for (int k = 0; k < 8; ++k) { o[k] = SBL[((size_t)pm * 2 + 0) * DFF + c0 + k]; o[DFF + k] = SBL[((size_t)pm * 2 + 1) * DFF + c0 + k]; } }
                    }
                    asm volatile("s_waitcnt vmcnt(0)" ::: "memory"); __syncthreads();
                }
                GEMM_RES(rep == 3 ? 0 : (rep == 8 ? 1 : 2));
                { LANE_STATE();
                  const SG2 sg{rep == 12 ? GU + (size_t)MP * DFF : (rep == 3 ? gY : gO) + (size_t)MP * D, rep == 12 ? WDN_T : (rep == 3 ? WOUT_T : WO_T), rep == 12 ? DFF : D, rep == 12 ? DFF : D, rep == 12 ? DFF : D, D, XN + (size_t)MP * D, D, 1.f, 2, SSS(3 * l + (rep == 3 ? 1 : (rep == 8 ? 2 : 3)))};
                  sgemm2(lds, sg, bid, G, wave, tid); }
                if (rep != 12 && l + 1 < DEPTH) { LANE_STATE(); if (bid >= 64) convert_layer(kp, ws, lds, l + 1, rep == 3 ? 0 : 2, 3, gw - 64 * NWAVES, NGW - 64 * NWAVES, gt - 64 * NTHREADS, NGT - 64 * NTHREADS, lane, wave); }
            } else if (rep == 6) {
                LANE_STATE();
                for (int sub = 0; sub < 2; ++sub) {
                    pg8::GSched S; pg8::Gemm g; pg8::EpiSoftmax E;
                    if (sub == 0) { S.init(MP / 256, 4, G, bid); S.aPm = (size_t)256 * D * 2; S.aPn = 512; S.bPn = 512; S.bPm = (size_t)256 * D * 2; S.bShift = 4; g = pg8::Gemm{gQ, KBP, D, D, 256}; E.O = gP; E.ldc = D; E.smp = 0; }
                    else { S.init(1, 32, G, (bid + G - 64) % G); S.mode = 1; g = pg8::Gemm{gQ + (size_t)MP * D, KBS, D, D, 256}; E.O = PS; E.ldc = 8192; E.smp = 1; }
                    pg8::gemm_phase<pg8::EpiSoftmax, pg8::GSched, true>(lds, g, S, E, wave_s);
                }
            }
            if (rep == 6) { asm volatile("s_waitcnt vmcnt(0)" ::: "memory"); __syncthreads(); }
            else GRID_SYNC();
          }
        }
    }
    {
        LANE_STATE();
        const float* gain = INP(I_GFIN);
        f32x4 gv[4];
#pragma unroll
        for (int j = 0; j < 4; ++j) gv[j] = ((const f32x4*)gain)[lane + 64 * j];
        for (int m0 = gw; m0 < MT; m0 += 2 * NGW) {
            const int m1 = m0 + NGW; const bool two = m1 < MT; const int mb = two ? m1 : m0;
            const u32x2* xa = (const u32x2*)(XN + (size_t)m0 * D) + lane; const u32x2* xb = (const u32x2*)(XN + (size_t)mb * D) + lane;
            u32x2 pa[4], pb[4];
#pragma unroll
            for (int j = 0; j < 4; ++j) { pa[j] = xa[64 * j]; pb[j] = xb[64 * j]; }
            float ra, rb;
            { float qa = 0.f, qb = 0.f;
#pragma unroll
              for (int j = 0; j < 4; ++j) { const float a0 = bflo(pa[j].x), a1 = bfhi(pa[j].x), a2 = bflo(pa[j].y), a3 = bfhi(pa[j].y), b0 = bflo(pb[j].x), b1 = bfhi(pb[j].x), b2 = bflo(pb[j].y), b3 = bfhi(pb[j].y);
                  qa += (a0 * a0 + a1 * a1) + (a2 * a2 + a3 * a3); qb += (b0 * b0 + b1 * b1) + (b2 * b2 + b3 * b3); }
              if (m0 < MP) ra = ss_rstd(*(const f32x4*)(SSQ(6) + (size_t)m0 * 4)); else ra = 1.0f / sqrtf(wave_sum(qa, lane) * (1.f / D) + EPS);
              if (mb < MP) rb = ss_rstd(*(const f32x4*)(SSQ(6) + (size_t)mb * 4)); else rb = 1.0f / sqrtf(wave_sum(qb, lane) * (1.f / D) + EPS); }
            f32x4* ya = (f32x4*)(out + (size_t)m0 * D) + lane; f32x4* yb = (f32x4*)(out + (size_t)mb * D) + lane;
#pragma unroll
            for (int j = 0; j < 4; ++j) { ya[64 * j] = (f32x4){bflo(pa[j].x), bfhi(pa[j].x), bflo(pa[j].y), bfhi(pa[j].y)} * ra * gv[j]; if (two) yb[64 * j] = (f32x4){bflo(pb[j].x), bfhi(pb[j].x), bflo(pb[j].y), bfhi(pb[j].y)} * rb * gv[j]; }
        }
    }
}

extern "C" void kernel_launch(void* const* d_in, const int* in_sizes, int n_in, void* d_out, int out_size, void* d_ws, size_t ws_size, hipStream_t stream) {
    static int grid = 0;
    if (grid == 0) {
        if (n_in != N_IN || (size_t)out_size != O_END || ws_size < 512 * MiB) { fprintf(stderr, "kernel_launch: unexpected sizes n_in %d out %d ws %zu (need %zu)\n", n_in, out_size, ws_size, (size_t)(512 * MiB)); grid = -1; return; }
        int dev = 0, cus = 0, per_cu = 0;
        (void)hipGetDevice(&dev); (void)hipDeviceGetAttribute(&cus, hipDeviceAttributeMultiprocessorCount, dev);
        if (hipFuncSetAttribute((const void*)trunk_fwd, hipFuncAttributeMaxDynamicSharedMemorySize, LDS_BYTES) != hipSuccess) { fprintf(stderr, "kernel_launch: hipFuncSetAttribute failed\n"); grid = -1; return; }
        if (hipOccupancyMaxActiveBlocksPerMultiprocessor(&per_cu, (const void*)trunk_fwd, NTHREADS, LDS_BYTES) != hipSuccess || per_cu < 1) { fprintf(stderr, "kernel_launch: occupancy query gave %d\n", per_cu); per_cu = 1; }
        (void)hipGetLastError();
        grid = cus * 1;
        if (grid != 256) fprintf(stderr, "kernel_launch: note: %d CUs\n", grid);
    }
    if (grid < 0) return;
    Args a{};
    for (int i = 0; i < N_IN; ++i) a.in[i] = (const float*)d_in[i];
    a.out = (float*)d_out; a.ws = (unsigned char*)d_ws;
    void* kargs[] = {&a};
    hipError_t e = hipLaunchCooperativeKernel((const void*)trunk_fwd, dim3(grid), dim3(NTHREADS), kargs, LDS_BYTES, stream);
    if (e != hipSuccess) fprintf(stderr, "kernel_launch: cooperative launch failed: %s (grid %d)\n", hipGetErrorString(e), grid);
}
```

```cpp
#include <hip/hip_runtime.h>
#include <hip/hip_cooperative_groups.h>
#include <cstdio>
#include <cstdint>
namespace cg = cooperative_groups;
#ifndef PROBE
#define PROBE 0
#endif

#define LAS __attribute__((address_space(3)))
typedef unsigned short bf16_t;
typedef short bf16x8 __attribute__((ext_vector_type(8)));
typedef float f32x4 __attribute__((ext_vector_type(4)));
typedef float f32x2 __attribute__((ext_vector_type(2)));
typedef unsigned u32x4 __attribute__((ext_vector_type(4)));
typedef unsigned u32x2 __attribute__((ext_vector_type(2)));

constexpr int D = 1024, BP = 8, SEQ = 4096, BS = 8, TS = 32, DEPTH = 2;
constexpr int MP = BP * SEQ, MS = BS * TS, MT = MP + MS;
constexpr int INC = 2304, DFF = 2816, NMEM = 256, AW = 512, BW = 256, CW = 256;
constexpr int Z_XA = 0, Z_GA = 512, Z_XB = 1024, Z_GB = 1280, Z_GC = 1536, Z_UC = 1792, Z_VC = 2048;
constexpr float EPS = 1e-6f;
constexpr int NWAVES = 8, NTHREADS = 512;

constexpr size_t O_YP = 0, O_YS = O_YP + (size_t)MP * D, O_CAP = O_YS + (size_t)MS * D, O_HAP = O_CAP + DEPTH * BP * 3 * AW,
                 O_CBP = O_HAP + DEPTH * BP * AW, O_CFP = O_CBP + DEPTH * BP * 2 * BW, O_MKP = O_CFP + DEPTH * BP * 2 * DFF,
                 O_MVP = O_MKP + (size_t)DEPTH * BP * NMEM * D, O_CAS = O_MVP + (size_t)DEPTH * BP * NMEM * D, O_HAS = O_CAS + DEPTH * BS * 3 * AW,
                 O_CBS = O_HAS + DEPTH * BS * AW, O_CFS = O_CBS + DEPTH * BS * 2 * BW, O_VCS = O_CFS + DEPTH * BS * 2 * DFF,
                 O_END = O_VCS + DEPTH * BS * TS * CW;

constexpr size_t MiB = 1u << 20;
constexpr size_t WS_WIN = 0, WS_WOUT = 5 * MiB, WS_WQ = 7 * MiB, WS_WK = 9 * MiB, WS_WV = 11 * MiB, WS_WO = 13 * MiB, WS_WUP = 15 * MiB, WS_WDN = 26 * MiB;
constexpr size_t WS_MEMB = 32 * MiB, WS_KBP = 36 * MiB, WS_VTP = 40 * MiB, WS_KBS = 44 * MiB, WS_VTS = 48 * MiB, WS_WST = 52 * MiB, WS_GT = WS_WST + 131072, WS_AGG = 53 * MiB, WS_SS = 54 * MiB + 256 * 1024, WS_BAR = 55 * MiB + 512 * 1024;
constexpr size_t WS_XN = 56 * MiB, WS_BIG = 121 * MiB;
constexpr size_t B_Z = WS_BIG, B_HLOC = WS_BIG + 146 * MiB, B_PCUM = WS_BIG + 211 * MiB, B_Y = WS_BIG + 276 * MiB;
constexpr size_t B_Q = WS_BIG, B_P = WS_BIG + 65 * MiB, B_O = WS_BIG + 130 * MiB, B_PS = WS_BIG + 195 * MiB;
constexpr size_t B_GU = WS_BIG;
constexpr size_t B_GUS = WS_BIG + 200 * MiB;
constexpr size_t B_SBG = WS_BIG + 204 * MiB, B_SBU = WS_BIG + 207 * MiB, B_SBL = WS_BIG + 210 * MiB;
constexpr size_t WS_END = WS_BIG + (size_t)MT * 2 * DFF * 2;
constexpr size_t WS_SSP = 476 * MiB;
static_assert(WS_END <= WS_SSP && WS_SSP + (size_t)7 * MT * 64 <= 512 * MiB, "workspace");
static_assert(WS_XN + (size_t)MT * D * 2 <= WS_BIG, "xn");
constexpr size_t WS_SSS = WS_SSP + (((size_t)7 * MT * 16 + 4095) / 4096) * 4096;
static_assert(WS_SSS + 7 * 256 * 32 * 4 <= 480 * MiB, "sss");
constexpr size_t WSEL1 = 480 * MiB, KSEL1 = 418 * MiB;
static_assert(WS_WDN + (size_t)D * DFF * 2 + WSEL1 <= 512 * MiB && WS_KBS + KSEL1 >= WS_BIG + 341 * MiB && WS_GT + 131072 + KSEL1 <= WS_SSP, "second buffer set");

constexpr int LDS_RING = 131072, LDS_EX = LDS_RING, LDS_MISC = LDS_EX + 8192, LDS_BYTES = 147456;

enum { I_XP = 0, I_XS, I_MEM, I_CK, I_CV, I_SCA, I_SHA, I_SCB, I_SCF, I_GMIX, I_WIN, I_CAW, I_CAB, I_WRG, I_BRG, I_WIG, I_BIG, I_LAM, I_CBW, I_GV, I_WS, I_BSS,
       I_WOUT, I_GX, I_WQ, I_WK, I_WV, I_WO, I_GFFN, I_WUP, I_CFW, I_WDN, I_GFIN, N_IN };

struct Args { const float* in[N_IN]; float* out; unsigned char* ws; };

__device__ __forceinline__ unsigned pk2(float lo, float hi) { unsigned r; asm("v_cvt_pk_bf16_f32 %0, %1, %2" : "=v"(r) : "v"(lo), "v"(hi)); return r; }
__device__ __forceinline__ unsigned f2bf(float f) { return pk2(f, f) & 0xffffu; }
__device__ __forceinline__ float bf2f(unsigned v) { return __builtin_bit_cast(float, v << 16); }
__device__ __forceinline__ float bflo(unsigned w) { return __builtin_bit_cast(float, w << 16); }
__device__ __forceinline__ float bfhi(unsigned w) { return __builtin_bit_cast(float, w & 0xffff0000u); }
__device__ __forceinline__ unsigned cvt_pk_bf16(float lo, float hi) { unsigned r; asm volatile("v_cvt_pk_bf16_f32 %0, %1, %2" : "=v"(r) : "v"(lo), "v"(hi)); return r; }
__device__ __forceinline__ float fexp(float x) { return __builtin_amdgcn_exp2f(x * 1.4426950408889634f); }
__device__ __forceinline__ float sigm(float x) { return __builtin_amdgcn_rcpf(1.0f + fexp(-x)); }
__device__ __forceinline__ float gelu_t(float x) { const float u = 0.7978845608028654f * (x + 0.044715f * x * x * x); return x * sigm(2.0f * u); }
__device__ __forceinline__ float silu(float x) { return x * sigm(x); }
__device__ __forceinline__ float shx(float v, int m, int lane) { return __builtin_bit_cast(float, __builtin_amdgcn_ds_bpermute((lane ^ m) << 2, __builtin_bit_cast(int, v))); }
__device__ __forceinline__ float wave_sum(float v, int lane) {
#pragma unroll
    for (int o = 1; o < 64; o <<= 1) v += shx(v, o, lane);
    return v;
}
#define LDS_WAIT() asm volatile("s_waitcnt lgkmcnt(0)" ::: "memory")
__device__ __forceinline__ float ss_rstd(f32x4 p) { return 1.0f / sqrtf(((p[0] + p[1]) + (p[2] + p[3])) * (1.f / 1024.f) + 1e-6f); }
__device__ __forceinline__ int opaque_tid(int wave_s) { int l; asm volatile("v_mbcnt_lo_u32_b32 %0, -1, 0\n\tv_mbcnt_hi_u32_b32 %0, -1, %0" : "=v"(l)); return wave_s * 64 + l; }

namespace pg8 {
constexpr int BM = 256, BK = 64, HALF = 128, HTB = HALF * BK * 2, NXCD = 8, WGM = 8;
__device__ __forceinline__ int lds_byte(int r, int c) { const int st = (r >> 4) * 2 + (c >> 5), rr = r & 15, cc = c & 31, ob = rr * 64 + cc * 2; return st * 1024 + (ob ^ (((ob >> 9) & 1) << 5)); }
__device__ __forceinline__ void stage_rc(int b, int& R, int& C) { const int st = b / 1024, sb = b % 1024, swz = sb ^ (((sb >> 9) & 1) << 5); R = (st >> 1) * 16 + swz / 64; C = (st & 1) * 32 + (swz % 64) / 2; }
__device__ __forceinline__ int perm32(int rho) { const int n = rho >> 4, i = rho & 15; return 8 * (i >> 2) + 4 * n + (i & 3); }

struct Unit { int pm, pn; };
struct Gemm { const bf16_t* A; const bf16_t* Bt; int lda, ldb, K; };

struct GSched {
    int nM, nN, nwg, G, c, mode;
    size_t aPm, aPn, bPn, bPm; int bShift;
    __device__ __forceinline__ void init(int nM_, int nN_, int G_, int c_) { nM = nM_; nN = nN_; nwg = nM * nN; G = G_; c = c_; mode = 0; aPm = 0; aPn = 0; bPn = 0; bPm = 0; bShift = 0; }
    __device__ __forceinline__ bool next(int i, Unit& u) const {
        const long L = (long)i * G + c; if (L >= nwg) return false;
        int wgid = (int)L; { const int q = nwg / NXCD, r = nwg % NXCD, xcd = wgid % NXCD, off = wgid / NXCD; wgid = (xcd < r ? xcd * (q + 1) : r * (q + 1) + (xcd - r) * q) + off; }
        const int nig = WGM * nN, gid = wgid / nig, fm = gid * WGM, gsz = (nM - fm) < WGM ? (nM - fm) : WGM;
        u.pm = fm + ((wgid % nig) % gsz); u.pn = (wgid % nig) / gsz; return true;
    }
    __device__ __forceinline__ size_t offA(const Unit& u) const { return mode == 1 ? (size_t)(u.pn & 3) * 512 : (mode == 2 ? (size_t)(u.pn & 3) * 4096 + (size_t)(u.pn >> 2) * 512 : (size_t)u.pm * aPm + (size_t)u.pn * aPn); }
    __device__ __forceinline__ size_t offB(const Unit& u) const { return mode == 1 ? (size_t)(u.pn >> 2) * (256 * 1024 * 2) + (size_t)(u.pn & 3) * 512 : (mode == 2 ? (size_t)(u.pn & 3) * (256 * 2048 * 2) + (size_t)(u.pn >> 2) * 512 : (size_t)u.pn * bPn + (size_t)(u.pm >> bShift) * bPm); }
};

struct EpiBf16 {
    static constexpr bool PERM = true;
    bf16_t* O; int ldc; float scale; const float* ss; int smp;
    __device__ __forceinline__ void operator()(f32x4 (&acc)[2][2][4][2], const Unit& u, int wr, int wc, int fr, int fq, LAS unsigned char*) const {
        asm volatile("" : "+v"(fr), "+v"(fq)); asm volatile("" : "+s"(wr), "+s"(wc));
        const int row0 = u.pm * BM + wr * 64 + fr, col0 = (smp ? (u.pn & 3) : u.pn) * BM + wc * 32 + 8 * fq;
        f32x4 rs[2][4];
#pragma unroll
        for (int ai = 0; ai < 2; ++ai)
#pragma unroll
            for (int m = 0; m < 4; ++m) rs[ai][m] = ss ? *(const f32x4*)(ss + (size_t)(row0 + ai * HALF + m * 16) * 4) : (f32x4){0.f, 0.f, 0.f, 0.f};
#pragma unroll
        for (int ai = 0; ai < 2; ++ai)
#pragma unroll
            for (int m = 0; m < 4; ++m) { bf16_t* rowp = O + (size_t)(row0 + ai * HALF + m * 16) * ldc + col0;
                float sc = scale; if (ss) sc *= ss_rstd(rs[ai][m]);
                if (smp && ((ai * HALF + wr * 64 + m * 16 + fr) >> 5) != (u.pn >> 2)) continue;
#pragma unroll
                for (int bj = 0; bj < 2; ++bj) { const f32x4 v0 = acc[ai][bj][m][0] * sc, v1 = acc[ai][bj][m][1] * sc;
                    u32x4 w; w.x = cvt_pk_bf16(v0[0], v0[1]); w.y = cvt_pk_bf16(v0[2], v0[3]); w.z = cvt_pk_bf16(v1[0], v1[1]); w.w = cvt_pk_bf16(v1[2], v1[3]);
                    *(u32x4*)(rowp + bj * HALF) = w; } }
    }
};
struct EpiResid {
    static constexpr bool PERM = true;
    bf16_t* xb; float* ss;
    __device__ __forceinline__ void operator()(f32x4 (&acc)[2][2][4][2], const Unit& u, int wr, int wc, int fr, int fq, LAS unsigned char* lds) const {
        asm volatile("" : "+v"(fr), "+v"(fq)); asm volatile("" : "+s"(wr), "+s"(wc));
        const int col0 = u.pn * BM + wc * 32 + 8 * fq, lane = fq * 16 + fr;
        LAS float* PS = (LAS float*)(lds + LDS_EX);
        bf16_t* ob = xb + (size_t)u.pm * BM * D;
#pragma unroll
        for (int ai = 0; ai < 2; ++ai) {
            u32x4 pre[4][2];
#pragma unroll
            for (int m = 0; m < 4; ++m)
#pragma unroll
                for (int bj = 0; bj < 2; ++bj) pre[m][bj] = *(const u32x4*)(ob + (size_t)(ai * HALF + wr * 64 + m * 16 + fr) * D + col0 + bj * HALF);
            asm volatile("" ::: "memory");
#pragma unroll
            for (int m = 0; m < 4; ++m) { const int rl = ai * HALF + wr * 64 + m * 16 + fr; const size_t off = (size_t)rl * D + col0; float q = 0.f;
#pragma unroll
                for (int bj = 0; bj < 2; ++bj) { const u32x4 p = pre[m][bj]; const f32x4 a0 = acc[ai][bj][m][0], a1 = acc[ai][bj][m][1];
                    const float v0 = bflo(p.x) + a0[0], v1 = bfhi(p.x) + a0[1], v2 = bflo(p.y) + a0[2], v3 = bfhi(p.y) + a0[3], v4 = bflo(p.z) + a1[0], v5 = bfhi(p.z) + a1[1], v6 = bflo(p.w) + a1[2], v7 = bfhi(p.w) + a1[3];
                    u32x4 w; w.x = cvt_pk_bf16(v0, v1); w.y = cvt_pk_bf16(v2, v3); w.z = cvt_pk_bf16(v4, v5); w.w = cvt_pk_bf16(v6, v7); *(u32x4*)(ob + off + bj * HALF) = w;
                    q += ((v0 * v0 + v1 * v1) + (v2 * v2 + v3 * v3)) + ((v4 * v4 + v5 * v5) + (v6 * v6 + v7 * v7)); }
                q += shx(q, 16, lane); q += shx(q, 32, lane);
                if (fq == 0) PS[rl * 4 + wc] = q; }
            asm volatile("" ::: "memory");
        }
        asm volatile("s_waitcnt lgkmcnt(0)" ::: "memory"); __builtin_amdgcn_s_barrier(); asm volatile("" ::: "memory");
        { const int t = (wr * 4 + wc) * 64 + lane; if (t < 256) { const f32x4 p = *(const LAS f32x4*)(PS + t * 4); ss[(size_t)(u.pm * BM + t) * 4 + u.pn] = (p[0] + p[1]) + (p[2] + p[3]); } }
    }
};
struct EpiKV {
    static constexpr bool PERM = false;
    float* outK; float* outV; bf16_t* KB; bf16_t* VT;
    __device__ __forceinline__ void operator()(f32x4 (&acc)[2][2][4][2], const Unit& u, int wr, int wc, int fr, int fq, LAS unsigned char*) const {
        asm volatile("" : "+v"(fr), "+v"(fq)); asm volatile("" : "+s"(wr), "+s"(wc));
        const int kind = u.pm >> 4, pm = u.pm & 15;
        const int col0 = u.pn * BM + wc * 32 + 4 * fq;
        float* of = kind == 0 ? outK : outV; bf16_t* ob = kind == 0 ? KB : VT; const int ldb_ = kind == 2 ? 2048 : 1024;
#pragma unroll
        for (int ai = 0; ai < 2; ++ai)
#pragma unroll
            for (int m = 0; m < 4; ++m) { const int row = pm * BM + ai * HALF + wr * 64 + m * 16 + fr;
#pragma unroll
                for (int bj = 0; bj < 2; ++bj)
#pragma unroll
                    for (int n = 0; n < 2; ++n) { const f32x4 v = acc[ai][bj][m][n]; const int col = col0 + bj * HALF + n * 16;
                        if (kind != 2) *(f32x4*)(of + (size_t)row * 1024 + col) = v;
                        if (kind != 1) { u32x2 w; w.x = cvt_pk_bf16(v[0], v[1]); w.y = cvt_pk_bf16(v[2], v[3]); *(u32x2*)(ob + (size_t)row * ldb_ + col) = w; } } }
    }
};
struct EpiSoftmax {
    static constexpr bool PERM = true;
    bf16_t* O; int ldc; int smp;
    __device__ __forceinline__ void operator()(f32x4 (&acc)[2][2][4][2], const Unit& u, int wr, int wc, int fr, int fq, LAS unsigned char* lds) const {
        asm volatile("" : "+v"(fr), "+v"(fq)); asm volatile("" : "+s"(wr), "+s"(wc));
        LAS f32x2* EX = (LAS f32x2*)(lds + LDS_EX);
        const int lane = fq * 16 + fr;
        const float L2E = 1.4426950408889634f;
#pragma unroll
        for (int ai = 0; ai < 2; ++ai)
#pragma unroll
            for (int m = 0; m < 4; ++m) {
                float mx = -3.0e38f;
#pragma unroll
                for (int bj = 0; bj < 2; ++bj)
#pragma unroll
                    for (int n = 0; n < 2; ++n) { const f32x4 x = acc[ai][bj][m][n]; mx = fmaxf(mx, fmaxf(fmaxf(x[0], x[1]), fmaxf(x[2], x[3]))); }
                mx = fmaxf(mx, shx(mx, 16, lane)); mx = fmaxf(mx, shx(mx, 32, lane));
                float s = 0.f;
#pragma unroll
                for (int bj = 0; bj < 2; ++bj)
#pragma unroll
                    for (int n = 0; n < 2; ++n) { f32x4 x = acc[ai][bj][m][n];
#pragma unroll
                        for (int j = 0; j < 4; ++j) { x[j] = __builtin_amdgcn_exp2f((x[j] - mx) * L2E); s += x[j]; }
                        acc[ai][bj][m][n] = x; }
                s += shx(s, 16, lane); s += shx(s, 32, lane);
                if (fq == 0) EX[(ai * HALF + wr * 64 + m * 16 + fr) * 4 + wc] = (f32x2){mx, s};
            }
        asm volatile("s_waitcnt lgkmcnt(0)" ::: "memory"); __builtin_amdgcn_s_barrier(); asm volatile("" ::: "memory");
        int colb = u.pn * BM, j_ = 0;
        if (smp) { colb = (u.pn & 3) * 2048 + (u.pn >> 2) * 256; j_ = u.pn >> 2; }
        const int col0 = colb + wc * 32 + 8 * fq;
#pragma unroll
        for (int ai = 0; ai < 2; ++ai)
#pragma unroll
            for (int m = 0; m < 4; ++m) {
                const int rl = ai * HALF + wr * 64 + m * 16 + fr;
                const f32x2 e0 = EX[rl * 4 + 0], e1 = EX[rl * 4 + 1], e2 = EX[rl * 4 + 2], e3 = EX[rl * 4 + 3];
                const float M = fmaxf(fmaxf(e0.x, e1.x), fmaxf(e2.x, e3.x));
                const float tot = e0.y * __builtin_amdgcn_exp2f((e0.x - M) * L2E) + e1.y * __builtin_amdgcn_exp2f((e1.x - M) * L2E) + e2.y * __builtin_amdgcn_exp2f((e2.x - M) * L2E) + e3.y * __builtin_amdgcn_exp2f((e3.x - M) * L2E);
                const float own = wc == 0 ? e0.x : (wc == 1 ? e1.x : (wc == 2 ? e2.x : e3.x));
                float f = __builtin_amdgcn_exp2f((own - M) * L2E) / tot;
                if (smp && (rl >> 5) != j_) f = 0.f;
                bf16_t* rowp = O + (size_t)(u.pm * BM + rl) * ldc + col0;
#pragma unroll
                for (int bj = 0; bj < 2; ++bj) { const f32x4 v0 = acc[ai][bj][m][0] * f, v1 = acc[ai][bj][m][1] * f;
                    u32x4 w; w.x = cvt_pk_bf16(v0[0], v0[1]); w.y = cvt_pk_bf16(v0[2], v0[3]); w.z = cvt_pk_bf16(v1[0], v1[1]); w.w = cvt_pk_bf16(v1[2], v1[3]);
                    *(u32x4*)(rowp + bj * HALF) = w; } }
    }
};


__device__ __forceinline__ float dpp_ror1(float v) { return __builtin_bit_cast(float, __builtin_amdgcn_update_dpp(0, __builtin_bit_cast(int, v), 0x121, 0xf, 0xf, false)); }
__device__ __forceinline__ float dpp_ror2(float v) { return __builtin_bit_cast(float, __builtin_amdgcn_update_dpp(0, __builtin_bit_cast(int, v), 0x122, 0xf, 0xf, false)); }
struct EpiAct {
    static constexpr bool PERM = true;
    bf16_t* H; const float* scf; float* ocf; float* sbg; float* sbu; float* sbl; const float* cfw; const float* ss;
    __device__ __forceinline__ void operator()(f32x4 (&acc)[2][2][4][2], const Unit& u, int wr, int wc, int fr, int fq, LAS unsigned char* lds) const {
        asm volatile("" : "+s"(wr), "+s"(wc));
        int lane; asm volatile("v_mbcnt_lo_u32_b32 %0, -1, 0\n\tv_mbcnt_hi_u32_b32 %0, -1, %0" : "=v"(lane));
        fr = lane & 15; fq = lane >> 4;
        const int fl = wc * 32 + 8 * fq, f0 = u.pn * 128 + fl; int rowt = wr * 64 + fr;
        {
            float rst[2][4];
            f32x4 rsl[2][4];
#pragma unroll
            for (int ai = 0; ai < 2; ++ai)
#pragma unroll
                for (int m = 0; m < 4; ++m) rsl[ai][m] = *(const f32x4*)(ss + (size_t)(u.pm * BM + ai * HALF + rowt + m * 16) * 4);
#pragma unroll
            for (int ai = 0; ai < 2; ++ai)
#pragma unroll
                for (int m = 0; m < 4; ++m) { rst[ai][m] = ss_rstd(rsl[ai][m]); }
#pragma unroll
            for (int ai = 0; ai < 2; ++ai)
#pragma unroll
                for (int m = 0; m < 4; ++m) { acc[ai][0][m][0] = acc[ai][0][m][0] * rst[ai][m]; acc[ai][0][m][1] = acc[ai][0][m][1] * rst[ai][m]; acc[ai][1][m][0] = acc[ai][1][m][0] * rst[ai][m]; acc[ai][1][m][1] = acc[ai][1][m][1] * rst[ai][m]; }
        }
        const bool smp = (u.pm == 128);
        asm volatile("" : "+v"(rowt));
        LAS float* BND = (LAS float*)(lds + LDS_EX);
        if (fr >= 14) {
#pragma unroll
            for (int ai = 0; ai < 2; ++ai)
#pragma unroll
                for (int n = 0; n < 2; ++n) *(LAS f32x4*)(BND + ((ai * 2 + wr) * 2 + (fr - 14)) * 128 + fl + 4 * n) = acc[ai][0][3][n];
            if (wr == 1) {
#pragma unroll
                for (int n = 0; n < 2; ++n) *(f32x4*)(sbl + ((size_t)u.pm * 2 + (fr - 14)) * DFF + f0 + 4 * n) = acc[1][0][3][n];
            }
        }
        asm volatile("s_waitcnt lgkmcnt(0)" ::: "memory"); __builtin_amdgcn_s_barrier(); asm volatile("" ::: "memory");
#pragma unroll
        for (int ai = 0; ai < 2; ++ai) {
            const int pg = wr == 1 ? ai * 2 : 1;
            u32x2 hp[2][4];
#pragma unroll
            for (int n = 0; n < 2; ++n) {
                const f32x4 w0 = *(const f32x4*)(cfw + f0 + 4 * n), w1 = *(const f32x4*)(cfw + DFF + f0 + 4 * n), w2 = *(const f32x4*)(cfw + 2 * DFF + f0 + 4 * n);
                f32x4 h2 = *(const LAS f32x4*)(BND + (pg * 2 + 0) * 128 + fl + 4 * n), h1 = *(const LAS f32x4*)(BND + (pg * 2 + 1) * 128 + fl + 4 * n);
                f32x4 t2 = h2, t1 = h1;
                if (smp) { const float* sp = scf + (size_t)((ai * 4 + wr * 2) * 2) * DFF + f0 + 4 * n; h2 = *(const f32x4*)sp; h1 = *(const f32x4*)(sp + DFF); t2 = *(const f32x4*)(sp + 2 * DFF); t1 = *(const f32x4*)(sp + 3 * DFF); }
#pragma unroll
                for (int jp = 0; jp < 2; ++jp) {
                    float hv[4][2];
#pragma unroll
                    for (int jj = 0; jj < 2; ++jj) { const int j = jp * 2 + jj;
                        float r1p = h1[j], r2p = fr == 0 ? h2[j] : h1[j];
#pragma unroll
                        for (int m = 0; m < 4; ++m) { const float g = acc[ai][0][m][n][j];
                            if (m == 2 && smp) { r1p = t1[j]; r2p = fr == 0 ? t2[j] : t1[j]; }
                            const float r1 = dpp_ror1(g), r2 = dpp_ror2(g);
                            const float gm1 = fr >= 1 ? r1 : r1p, gm2 = fr >= 2 ? r2 : r2p;
                            r1p = r1; r2p = r2;
                            const float cv = w0[j] * gm2 + w1[j] * gm1 + w2[j] * g;
                            hv[m][jj] = silu(cv) * acc[ai][1][m][n][j]; } }
#pragma unroll
                    for (int m = 0; m < 4; ++m) { const unsigned pk = cvt_pk_bf16(hv[m][0], hv[m][1]); if (jp == 0) hp[n][m].x = pk; else hp[n][m].y = pk; }
                }
            }
#pragma unroll
            for (int m = 0; m < 4; ++m) {
                const int rl = ai * HALF + rowt + m * 16;
                if (smp && (m & 1) && fr >= 14) {
#pragma unroll
                    for (int n = 0; n < 2; ++n) *(f32x4*)(ocf + ((size_t)(ai * 4 + wr * 2 + (m >> 1)) * 2 + (fr - 14)) * DFF + f0 + 4 * n) = acc[ai][0][m][n];
                }
                if (!smp && ai == 0 && m == 0 && wr == 0 && fr < 2) {
#pragma unroll
                    for (int n = 0; n < 2; ++n) { *(f32x4*)(sbg + ((size_t)u.pm * 2 + fr) * DFF + f0 + 4 * n) = acc[0][0][0][n]; *(f32x4*)(sbu + ((size_t)u.pm * 2 + fr) * DFF + f0 + 4 * n) = acc[0][1][0][n]; }
                } else {
                    u32x4 w; w.x = hp[0][m].x; w.y = hp[0][m].y; w.z = hp[1][m].x; w.w = hp[1][m].y;
                    *(u32x4*)(H + (size_t)(u.pm * BM + rl) * DFF + f0) = w;
                }
            }
        }
    }
};

template <class Epi, class Sched, bool ALIGN_EPI>
__device__ __forceinline__ void gemm_phase(LAS unsigned char* lds, const Gemm g, const Sched& S, const Epi& E, const int wave_s) {
    const int tid = opaque_tid(wave_s), wid = __builtin_amdgcn_readfirstlane(tid >> 6), lane = tid & 63, wr = wid >> 2, wc = wid & 3, fr = lane & 15, fq = lane >> 4;
    const int nt = g.K / BK;
    unsigned voffA[2], voffB[2];
#pragma unroll
    for (int i = 0; i < 2; ++i) { int R, C; stage_rc(tid * 16 + i * 8192, R, C); const int Rb = Epi::PERM ? ((R & ~31) + perm32(R & 31)) : R;
        voffA[i] = (unsigned)(R * g.lda + C) * 2u; voffB[i] = (unsigned)(Rb * g.ldb + C) * 2u; }
    const size_t kstep = (size_t)(BK * 2);
    const size_t hstepA = (size_t)HALF * g.lda * 2, hstepB = (size_t)HALF * g.ldb * 2;
    const unsigned ldsw = (unsigned)wid * 1024u;
    const int aoff = lds_byte(wr * 64 + fr, fq * 8), boff = lds_byte(wc * 32 + fr, fq * 8);
#define PG8_SA(b, h) (((b) * 2 + (h)) * HTB)
#define PG8_SB(b, h) ((4 + (b) * 2 + (h)) * HTB)
#define PG8_STAGE(bufoff, gbase, voff) do { _Pragma("unroll") for (int _i = 0; _i < 2; ++_i) \
        __builtin_amdgcn_global_load_lds((const unsigned*)((const char*)(gbase) + (voff)[_i]), (LAS unsigned*)(lds + (bufoff) + ldsw + _i * 8192), 16, 0, 0); } while (0)
#define PG8_LDA(dst, b, h) do { _Pragma("unroll") for (int m = 0; m < 4; ++m) _Pragma("unroll") for (int k = 0; k < 2; ++k) dst[m][k] = *(const LAS bf16x8*)(lds + PG8_SA(b, h) + aoff + m * 2048 + k * 1024); } while (0)
#define PG8_LDB(dst, b, h) do { _Pragma("unroll") for (int n = 0; n < 2; ++n) _Pragma("unroll") for (int k = 0; k < 2; ++k) dst[n][k] = *(const LAS bf16x8*)(lds + PG8_SB(b, h) + boff + n * 2048 + k * 1024); } while (0)
#define PG8_MMA(ai, bj, At, Bt) do { __builtin_amdgcn_s_setprio(1); _Pragma("unroll") for (int m = 0; m < 4; ++m) _Pragma("unroll") for (int n = 0; n < 2; ++n) _Pragma("unroll") for (int k = 0; k < 2; ++k) \
        acc[ai][bj][m][n] = __builtin_amdgcn_mfma_f32_16x16x32_bf16(Bt[n][k], At[m][k], acc[ai][bj][m][n], 0, 0, 0); __builtin_amdgcn_s_setprio(0); } while (0)
#define PG8_WAIT_V(n) asm volatile("s_waitcnt vmcnt(" #n ")" ::: "memory")
#define PG8_WAIT_L(n) asm volatile("s_waitcnt lgkmcnt(" #n ")" ::: "memory")
#define PG8_BAR __builtin_amdgcn_s_barrier()
#define PG8_SCHED __builtin_amdgcn_sched_barrier(0)
    Unit cur, nxt; int ui = 0;
    if (!S.next(0, cur)) return;
    f32x4 acc[2][2][4][2];
#pragma unroll
    for (int a = 0; a < 2; ++a)
#pragma unroll
        for (int b = 0; b < 2; ++b)
#pragma unroll
            for (int m = 0; m < 4; ++m)
#pragma unroll
                for (int n = 0; n < 2; ++n) acc[a][b][m][n] = (f32x4){0.f, 0.f, 0.f, 0.f};
    bf16x8 At[4][2], B0[2][2], B1[2][2];
    const char* cA = (const char*)g.A + S.offA(cur); const char* cB = (const char*)g.Bt + S.offB(cur);
    PG8_STAGE(PG8_SB(0, 0), cB, voffB); PG8_STAGE(PG8_SB(0, 1), cB + hstepB, voffB); PG8_STAGE(PG8_SA(0, 0), cA, voffA); PG8_STAGE(PG8_SA(0, 1), cA + hstepA, voffA);
    if (wr == 1) PG8_BAR;
    PG8_WAIT_V(2); PG8_BAR;
    PG8_STAGE(PG8_SB(1, 0), cB + kstep, voffB); PG8_STAGE(PG8_SA(1, 0), cA + kstep, voffA); PG8_STAGE(PG8_SB(1, 1), cB + hstepB + kstep, voffB);
    PG8_WAIT_V(6); PG8_BAR;
    for (;;) {
        const bool has_next = S.next(ui + 1, nxt);
        const char* nA = has_next ? (const char*)g.A + S.offA(nxt) : cA; const char* nB = has_next ? (const char*)g.Bt + S.offB(nxt) : cB;
        for (int t = 0; t < nt; t += 2) {
            const bool last = (t == nt - 2);
            const char* a1 = cA + (size_t)(t + 1) * kstep;
            const char* a2 = last ? nA : cA + (size_t)(t + 2) * kstep; const char* b2 = last ? nB : cB + (size_t)(t + 2) * kstep;
            const char* a3 = a2 + kstep; const char* b3 = b2 + kstep;
            PG8_LDB(B0, 0, 0); PG8_LDB(B1, 0, 1); PG8_SCHED; PG8_LDA(At, 0, 0); PG8_STAGE(PG8_SA(1, 1), a1 + hstepA, voffA);
            PG8_WAIT_V(8); PG8_WAIT_L(0); PG8_BAR; PG8_MMA(0, 0, At, B0); PG8_MMA(0, 1, At, B1); PG8_BAR; PG8_SCHED;
            PG8_LDA(At, 0, 1); PG8_STAGE(PG8_SB(0, 0), b2, voffB); PG8_STAGE(PG8_SB(0, 1), b2 + hstepB, voffB); PG8_STAGE(PG8_SA(0, 0), a2, voffA);
            PG8_WAIT_V(8); PG8_WAIT_L(0); PG8_BAR; PG8_MMA(1, 0, At, B0); PG8_MMA(1, 1, At, B1); PG8_BAR; PG8_SCHED;
            PG8_LDB(B0, 1, 0); PG8_LDB(B1, 1, 1); PG8_SCHED; PG8_LDA(At, 1, 0); PG8_STAGE(PG8_SA(0, 1), a2 + hstepA, voffA);
            PG8_WAIT_V(8); PG8_WAIT_L(0); PG8_BAR; PG8_MMA(0, 0, At, B0); PG8_MMA(0, 1, At, B1); PG8_BAR; PG8_SCHED;
            PG8_LDA(At, 1, 1); PG8_STAGE(PG8_SB(1, 0), b3, voffB); PG8_STAGE(PG8_SB(1, 1), b3 + hstepB, voffB); PG8_STAGE(PG8_SA(1, 0), a3, voffA);
            PG8_WAIT_V(8); PG8_WAIT_L(0); PG8_BAR; PG8_MMA(1, 0, At, B0); PG8_MMA(1, 1, At, B1); PG8_BAR; PG8_SCHED;
        }
        if constexpr (ALIGN_EPI) { if (wr == 0) PG8_BAR; }
        E(acc, cur, wr, wc, fr, fq, lds);
        if (!has_next) break;
#pragma unroll
        for (int a = 0; a < 2; ++a)
#pragma unroll
            for (int b = 0; b < 2; ++b)
#pragma unroll
                for (int m = 0; m < 4; ++m)
#pragma unroll
                    for (int n = 0; n < 2; ++n) acc[a][b][m][n] = (f32x4){0.f, 0.f, 0.f, 0.f};
        cur = nxt; cA = nA; cB = nB; ++ui;
        if constexpr (ALIGN_EPI) { if (wr == 1) PG8_BAR; }
    }
    PG8_WAIT_V(0);
    if constexpr (!ALIGN_EPI) { if (wr == 0) PG8_BAR; }
    PG8_BAR;
#undef PG8_SA
#undef PG8_SB
#undef PG8_STAGE
#undef PG8_LDA
#undef PG8_LDB
#undef PG8_MMA
#undef PG8_WAIT_V
#undef PG8_WAIT_L
#undef PG8_BAR
#undef PG8_SCHED
}
}

struct KVSched {
    int c, G; const char* ws; size_t wsel;
    __device__ __forceinline__ bool next(int i, pg8::Unit& u) const {
        const int L = i * G + c; if (c < 0 || L >= 96) return false;
        const int kind = L >> 5, r = L & 31;
        if (kind < 2) { u.pm = kind * 16 + (r >> 2); u.pn = r & 3; } else { u.pm = 32 + (r >> 3); u.pn = r & 7; }
        return true;
    }
    __device__ __forceinline__ size_t offA(const pg8::Unit& u) const { const int kind = u.pm >> 4, pm = u.pm & 15; int k2 = (kind == 2); asm volatile("" : "+v"(k2));
        return (size_t)ws + WS_MEMB + (size_t)k2 * (WS_WV + wsel - WS_MEMB) + (size_t)pm * 256 * 1024 * 2; }
    __device__ __forceinline__ size_t offB(const pg8::Unit& u) const { const int kind = u.pm >> 4; int k1 = (kind == 1), k2 = (kind == 2); asm volatile("" : "+v"(k1), "+v"(k2));
        return (size_t)ws + WS_WK + wsel + (size_t)k1 * (WS_WV - WS_WK) + (size_t)k2 * (WS_MEMB - WS_WK - wsel) + (size_t)u.pn * 256 * 1024 * 2; }
};


#define XB_TMO      128
#define XB_XCNT(j)  (256  + 64 * (j))
#define XB_XSUB(j)  (1280 + 64 * (j))
#define XB_XGEN(j)  (2304 + 64 * (j))
#define XB_TOP      3328
#define XB_TOPGEN   3392
#define XCD_BAR_WORDS 3456
#define XB_SPIN_CAP (1u << 22)
__device__ __forceinline__ unsigned xb_ld(unsigned* p)              { return __hip_atomic_load(p, __ATOMIC_RELAXED, __HIP_MEMORY_SCOPE_AGENT); }
__device__ __forceinline__ unsigned xb_add(unsigned* p, unsigned v) { return __hip_atomic_fetch_add(p, v, __ATOMIC_RELAXED, __HIP_MEMORY_SCOPE_AGENT); }
__device__ __forceinline__ unsigned xb_xcc_id() { return (unsigned)__builtin_amdgcn_s_getreg((3 << 11) | 20) & 0xFu; }
#define XB_SPIN(cond, bar) do { unsigned _sp = 0; while (cond) { __builtin_amdgcn_s_sleep(1); \
    if ((++_sp & 255u) == 0u) { if (xb_ld(&(bar)[XB_TMO])) break; if (_sp > XB_SPIN_CAP) { atomicAdd(&(bar)[XB_TMO], 1u); break; } } } } while (0)
struct XcdBarrier { unsigned* bar; unsigned x; volatile LAS unsigned* st; };
__device__ __forceinline__ void xcd_barrier_complete(unsigned* bar, unsigned x, unsigned& nloc, unsigned& nx) {
    const unsigned G = gridDim.x * gridDim.y * gridDim.z;
    unsigned sum, cnt, mine, sp = 0u;
    for (;;) {
        sum = 0u; cnt = 0u; mine = 0u;
#pragma unroll
        for (unsigned j = 0; j < 16; ++j) { const unsigned c = xb_ld(&bar[XB_XCNT(j)]); sum += c; cnt += (c > 0u) ? 1u : 0u; mine = (j == x) ? c : mine; }
        if (sum == G) break;
        __builtin_amdgcn_s_sleep(1);
        if ((++sp & 255u) == 0u) { if (xb_ld(&bar[XB_TMO])) break; if (sp > XB_SPIN_CAP) { atomicAdd(&bar[XB_TMO], 1u); break; } }
    }
    nloc = mine > 0u ? mine : 1u; nx = cnt > 0u ? cnt : 1u;
}
__device__ __forceinline__ void xcd_barrier(const XcdBarrier& b) {
    asm volatile("s_waitcnt vmcnt(0)" ::: "memory");
    __syncthreads();
    if (threadIdx.x == 0) {
        unsigned* bar = b.bar;
        __builtin_amdgcn_s_waitcnt(0);
        unsigned nloc = b.st[0], nx = b.st[1];
        if (nloc == 0u) { xcd_barrier_complete(bar, b.x, nloc, nx); b.st[0] = nloc; b.st[1] = nx; }
        const unsigned old = xb_add(&bar[XB_XSUB(b.x)], 1u);
        const unsigned gen = old / nloc;
        if (old + 1u == (gen + 1u) * nloc) {
            __builtin_amdgcn_fence(__ATOMIC_RELEASE, "agent");
            asm volatile("s_waitcnt vmcnt(0)" ::: "memory");
            const unsigned og = xb_add(&bar[XB_TOP], 1u);
            const unsigned tg = og / nx;
            if (og + 1u == (tg + 1u) * nx) xb_add(&bar[XB_TOPGEN], 1u);
            else XB_SPIN(xb_ld(&bar[XB_TOPGEN]) == tg, bar);
            __builtin_amdgcn_fence(__ATOMIC_ACQUIRE, "agent");
            xb_add(&bar[XB_XGEN(b.x)], 1u);
            asm volatile("s_waitcnt vmcnt(0)" ::: "memory");
        } else {
            XB_SPIN(xb_ld(&bar[XB_XGEN(b.x)]) == gen, bar);
            __builtin_amdgcn_fence(__ATOMIC_ACQUIRE, "agent");
            asm volatile("s_waitcnt vmcnt(0)" ::: "memory");
        }
    }
    __syncthreads();
}


struct SG2 { const bf16_t* A; const bf16_t* Bt; int lda, ldb, K, N; bf16_t* O; int ldc; float scale; int mode; float* ssp; };
__device__ __forceinline__ float sq8(bf16x8 a) { float q = 0.f;
#pragma unroll
    for (int i = 0; i < 8; ++i) { const float f = bf2f((unsigned)(unsigned short)a[i]); q += f * f; } return q; }
__device__ __forceinline__ void sgemm2(LAS unsigned char* lds, const SG2 g, int ubase, int G, int wave, int tid) {
    const int lane = tid & 63, fr = lane & 15, fq = lane >> 4, rt = wave & 3, ch = wave >> 2;
    const int nunits = (g.N / 64) * 4, nsl = g.K / 64;
    int R, C; pg8::stage_rc(tid * 16, R, C);
    const unsigned offA = (unsigned)(R * g.lda + C) * 2u, offB = (unsigned)(R * g.ldb + C) * 2u;
    const int aoff = pg8::lds_byte(rt * 16 + fr, fq * 8), boff = pg8::lds_byte(ch * 32 + fr, fq * 8);
    for (int un = ubase; un >= 0 && un < nunits; un += G) {
        const int cgp = un >> 2, rg = un & 3;
        const char* gA = (const char*)(g.A + (size_t)rg * 64 * g.lda) + offA; const char* gB = (const char*)(g.Bt + (size_t)cgp * 64 * g.ldb) + offB;
#define SG2_STAGE(sl) do { LAS unsigned char* d_ = lds + ((sl) & 3) * 16384 + wave * 1024; \
        __builtin_amdgcn_global_load_lds((const unsigned*)(gA + (size_t)(sl) * 128), (LAS unsigned*)d_, 16, 0, 0); \
        __builtin_amdgcn_global_load_lds((const unsigned*)(gB + (size_t)(sl) * 128), (LAS unsigned*)(d_ + 8192), 16, 0, 0); } while (0)
        asm volatile("s_waitcnt vmcnt(0)" ::: "memory");
        SG2_STAGE(0); SG2_STAGE(1);
        f32x4 acc[2] = {(f32x4){0.f, 0.f, 0.f, 0.f}, (f32x4){0.f, 0.f, 0.f, 0.f}}; float q = 0.f;
        for (int sl = 0; sl < nsl; ++sl) {
            if (sl + 1 < nsl) asm volatile("s_waitcnt vmcnt(2)" ::: "memory"); else asm volatile("s_waitcnt vmcnt(0)" ::: "memory");
            __builtin_amdgcn_s_barrier(); asm volatile("" ::: "memory");
            if (sl + 2 < nsl) SG2_STAGE(sl + 2);
            LAS unsigned char* b_ = lds + (sl & 3) * 16384;
#pragma unroll
            for (int ks = 0; ks < 2; ++ks) {
                const bf16x8 a = *(const LAS bf16x8*)(b_ + aoff + ks * 1024);
#pragma unroll
                for (int c = 0; c < 2; ++c) { const bf16x8 b = *(const LAS bf16x8*)(b_ + 8192 + boff + c * 2048 + ks * 1024);
                    acc[c] = __builtin_amdgcn_mfma_f32_16x16x32_bf16(b, a, acc[c], 0, 0, 0); }
                if (g.mode == 1) q += sq8(a);
            }
        }
#undef SG2_STAGE
        const int row = rg * 64 + rt * 16 + fr, col = cgp * 64 + ch * 32 + fq * 4;
        bf16_t* op = g.O + (size_t)row * g.ldc + col;
        if (g.mode == 1) {
            q += shx(q, 16, lane); q += shx(q, 32, lane);
            const float sc = g.scale / sqrtf(q * (1.f / 1024.f) + EPS);
#pragma unroll
            for (int c = 0; c < 2; ++c) { const f32x4 v = acc[c] * sc; u32x2 w; w.x = cvt_pk_bf16(v[0], v[1]); w.y = cvt_pk_bf16(v[2], v[3]); *(u32x2*)(op + c * 16) = w; }
        } else {
            const u32x2 p0 = *(const u32x2*)op, p1 = *(const u32x2*)(op + 16); float qq = 0.f;
            { const float v0 = bflo(p0.x) + acc[0][0], v1 = bfhi(p0.x) + acc[0][1], v2 = bflo(p0.y) + acc[0][2], v3 = bfhi(p0.y) + acc[0][3];
              u32x2 w; w.x = cvt_pk_bf16(v0, v1); w.y = cvt_pk_bf16(v2, v3); *(u32x2*)op = w; qq += (v0 * v0 + v1 * v1) + (v2 * v2 + v3 * v3); }
            { const float v0 = bflo(p1.x) + acc[1][0], v1 = bfhi(p1.x) + acc[1][1], v2 = bflo(p1.y) + acc[1][2], v3 = bfhi(p1.y) + acc[1][3];
              u32x2 w; w.x = cvt_pk_bf16(v0, v1); w.y = cvt_pk_bf16(v2, v3); *(u32x2*)(op + 16) = w; qq += (v0 * v0 + v1 * v1) + (v2 * v2 + v3 * v3); }
            qq += shx(qq, 16, lane); qq += shx(qq, 32, lane);
            if (fq == 0) g.ssp[row * 32 + cgp * 2 + ch] = qq;
        }
        asm volatile("s_waitcnt vmcnt(0) lgkmcnt(0)" ::: "memory"); __builtin_amdgcn_s_barrier(); asm volatile("" ::: "memory");
    }
}

__device__ __forceinline__ void sgemm_act(LAS unsigned char* lds, const bf16_t* A, const bf16_t* Bt, bf16_t* Hs, const float* cfw, const float* scf, float* ocf, int ubase, int G, int wave, int tid) {
    const int lane = tid & 63, fr = lane & 15, fq = lane >> 4, rt = wave & 3, ch = wave >> 2;
    constexpr int nunits = (DFF / 64) * 4, nsl = D / 64, SLOT = 24576;
    int R, C; pg8::stage_rc(tid * 16, R, C);
    const unsigned off = (unsigned)(R * D + C) * 2u;
    const int aoff = pg8::lds_byte(rt * 16 + fr, fq * 8), boff = pg8::lds_byte(fr, fq * 8) + 8192 + ch * 8192;
    for (int un = ubase; un >= 0 && un < nunits; un += G) {
        const int fg = un >> 2, rg = un & 3, brow = ((fg >> 1) << 8) + ((fg & 1) << 6);
        const char* gA = (const char*)(A + (size_t)rg * 64 * D) + off; const char* gG = (const char*)(Bt + (size_t)brow * D) + off; const char* gU = (const char*)(Bt + (size_t)(brow + 128) * D) + off;
#define SGA_STAGE(sl) do { LAS unsigned char* d_ = lds + ((sl) & 3) * SLOT + wave * 1024; \
        __builtin_amdgcn_global_load_lds((const unsigned*)(gA + (size_t)(sl) * 128), (LAS unsigned*)d_, 16, 0, 0); \
        __builtin_amdgcn_global_load_lds((const unsigned*)(gG + (size_t)(sl) * 128), (LAS unsigned*)(d_ + 8192), 16, 0, 0); \
        __builtin_amdgcn_global_load_lds((const unsigned*)(gU + (size_t)(sl) * 128), (LAS unsigned*)(d_ + 16384), 16, 0, 0); } while (0)
        asm volatile("s_waitcnt vmcnt(0)" ::: "memory");
        SGA_STAGE(0); SGA_STAGE(1);
        f32x4 acc[4]; float q = 0.f;
#pragma unroll
        for (int c = 0; c < 4; ++c) acc[c] = (f32x4){0.f, 0.f, 0.f, 0.f};
        for (int sl = 0; sl < nsl; ++sl) {
            if (sl + 1 < nsl) asm volatile("s_waitcnt vmcnt(3)" ::: "memory"); else asm volatile("s_waitcnt vmcnt(0)" ::: "memory");
            __builtin_amdgcn_s_barrier(); asm volatile("" ::: "memory");
            if (sl + 2 < nsl) SGA_STAGE(sl + 2);
            LAS unsigned char* b_ = lds + (sl & 3) * SLOT;
#pragma unroll
            for (int ks = 0; ks < 2; ++ks) {
                const bf16x8 a = *(const LAS bf16x8*)(b_ + aoff + ks * 1024);
#pragma unroll
                for (int c = 0; c < 4; ++c) { const bf16x8 b = *(const LAS bf16x8*)(b_ + boff + c * 2048 + ks * 1024);
                    acc[c] = __builtin_amdgcn_mfma_f32_16x16x32_bf16(b, a, acc[c], 0, 0, 0); }
                q += sq8(a);
            }
        }
#undef SGA_STAGE
        q += shx(q, 16, lane); q += shx(q, 32, lane);
        const float rstd = 1.0f / sqrtf(q * (1.f / 1024.f) + EPS);
        asm volatile("s_waitcnt lgkmcnt(0)" ::: "memory"); __builtin_amdgcn_s_barrier(); asm volatile("" ::: "memory");
        LAS float* T = (LAS float*)(lds + ch * 20480);
#pragma unroll
        for (int c = 0; c < 4; ++c)
#pragma unroll
            for (int j = 0; j < 4; ++j) T[(rt * 16 + fr) * 65 + c * 16 + fq * 4 + j] = acc[c][j] * rstd;
        asm volatile("s_waitcnt lgkmcnt(0)" ::: "memory"); __builtin_amdgcn_s_barrier(); asm volatile("" ::: "memory");
        {
            const LAS float* Gt = (const LAS float*)lds; const LAS float* Ut = (const LAS float*)(lds + 20480);
            const int r = tid >> 3, f8 = (tid & 7) * 8, b = rg * 2 + (r >> 5), rr = r & 31, f = fg * 64 + f8;
            const float* st = scf + (size_t)(b * 2) * DFF + f;
            float hv[8], gv[8];
#pragma unroll
            for (int k = 0; k < 8; ++k) {
                const float g0 = Gt[r * 65 + f8 + k];
                const float gm1 = rr >= 1 ? Gt[(r - 1) * 65 + f8 + k] : st[DFF + k];
                const float gm2 = rr >= 2 ? Gt[(r - 2) * 65 + f8 + k] : (rr == 1 ? st[DFF + k] : st[k]);
                const float cv = cfw[f + k] * gm2 + cfw[DFF + f + k] * gm1 + cfw[2 * DFF + f + k] * g0;
                hv[k] = silu(cv) * Ut[r * 65 + f8 + k]; gv[k] = g0;
            }
            u32x4 w; w.x = pk2(hv[0], hv[1]); w.y = pk2(hv[2], hv[3]); w.z = pk2(hv[4], hv[5]); w.w = pk2(hv[6], hv[7]);
            *(u32x4*)(Hs + (size_t)(rg * 64 + r) * DFF + f) = w;
            if (rr >= 30) { float* o = ocf + ((size_t)b * 2 + (rr - 30)) * DFF + f; *(f32x4*)o = (f32x4){gv[0], gv[1], gv[2], gv[3]}; *(f32x4*)(o + 4) = (f32x4){gv[4], gv[5], gv[6], gv[7]}; }
        }
        asm volatile("s_waitcnt vmcnt(0) lgkmcnt(0)" ::: "memory"); __builtin_amdgcn_s_barrier(); asm volatile("" ::: "memory");
    }
}
__device__ __forceinline__ void sample_ss_reduce(const float* sss, float* ssq, int tid) {
    if (tid < 256) { const f32x4* p = (const f32x4*)(sss + tid * 32); float t = 0.f;
#pragma unroll
        for (int i = 0; i < 8; ++i) { const f32x4 v = p[i]; t += (v[0] + v[1]) + (v[2] + v[3]); }
        *(f32x4*)(ssq + (size_t)(MP + tid) * 4) = (f32x4){t, 0.f, 0.f, 0.f}; }
    asm volatile("s_waitcnt vmcnt(0)" ::: "memory"); __syncthreads();
}

__device__ __forceinline__ void transpose_item(const float* W, int K, int N, bf16_t* WT, LAS float* scr, int item, int lane, const float* gain = nullptr, int gu = 0) {
    const int nblk = N / 32, kb = item / nblk, nb = item % nblk, k0 = 64 * kb, n0 = 32 * nb;
    {
        f32x4 v[8];
#pragma unroll
        for (int i = 0; i < 8; ++i) v[i] = *(const f32x4*)(W + (size_t)(k0 + (lane >> 3) + 8 * i) * N + n0 + (lane & 7) * 4);
#pragma unroll
        for (int i = 0; i < 8; ++i) { const int kk = (lane >> 3) + 8 * i; f32x4 w = v[i]; if (gain) w = w * gain[k0 + kk];
            LAS float* d = scr + kk * 33 + (lane & 7) * 4; d[0] = w[0]; d[1] = w[1]; d[2] = w[2]; d[3] = w[3]; }
    }
    LDS_WAIT();
    const int c = lane & 7;
#pragma unroll
    for (int j = 0; j < 4; ++j) { const int n = (lane >> 3) + 8 * j; const LAS float* s = scr + (8 * c) * 33 + n;
        u32x4 o; o.x = pk2(s[0 * 33], s[1 * 33]); o.y = pk2(s[2 * 33], s[3 * 33]); o.z = pk2(s[4 * 33], s[5 * 33]); o.w = pk2(s[6 * 33], s[7 * 33]);
        int drow = n0 + n; if (gu) { const int up = drow >= gu, f = up ? drow - gu : drow; drow = ((f >> 7) << 8) + (up << 7) + (f & 127); }
        *(u32x4*)(WT + (size_t)drow * K + k0 + 8 * c) = o; }
    LDS_WAIT();
}

__device__ __forceinline__ void first_rows(const float* Xp, const float* Xs, bf16_t* XNo, float* ss, int gw, int NGW, int lane) {
    for (int m0 = gw; m0 < MT; m0 += 2 * NGW) {
        const int m1 = m0 + NGW; const bool two = m1 < MT; const int mb = two ? m1 : m0;
        const f32x4* xa = (const f32x4*)(m0 < MP ? Xp + (size_t)m0 * D : Xs + (size_t)(m0 - MP) * D) + lane;
        const f32x4* xb = (const f32x4*)(mb < MP ? Xp + (size_t)mb * D : Xs + (size_t)(mb - MP) * D) + lane;
        f32x4 va[4], vb[4]; float sa = 0.f, sb = 0.f;
#pragma unroll
        for (int j = 0; j < 4; ++j) { va[j] = xa[64 * j]; vb[j] = xb[64 * j]; }
#pragma unroll
        for (int j = 0; j < 4; ++j) { sa += (va[j].x * va[j].x + va[j].y * va[j].y) + (va[j].z * va[j].z + va[j].w * va[j].w); sb += (vb[j].x * vb[j].x + vb[j].y * vb[j].y) + (vb[j].z * vb[j].z + vb[j].w * vb[j].w); }
        sa = wave_sum(sa, lane); sb = wave_sum(sb, lane);
        if (lane < 4) { ss[(size_t)m0 * 4 + lane] = lane == 0 ? sa : 0.f; if (two) ss[(size_t)m1 * 4 + lane] = lane == 0 ? sb : 0.f; }
        u32x2* oa = (u32x2*)(XNo + (size_t)m0 * D) + lane; u32x2* ob = (u32x2*)(XNo + (size_t)mb * D) + lane;
#pragma unroll
        for (int j = 0; j < 4; ++j) { u32x2 w; w.x = pk2(va[j].x, va[j].y); w.y = pk2(va[j].z, va[j].w); oa[64 * j] = w; if (two) { w.x = pk2(vb[j].x, vb[j].y); w.y = pk2(vb[j].z, vb[j].w); ob[64 * j] = w; } }
    }
}

typedef __attribute__((address_space(4))) const unsigned char* kptr_t;
typedef const float* cfp_t; typedef float* fp_t; typedef unsigned char* ucp_t;
#define INP(k) (*(const __attribute__((address_space(4))) cfp_t*)(kp + 8 * (k)))
#define X out
#define WIN_T ((bf16_t*)(ws + WS_WIN + wsel))
#define WOUT_T ((bf16_t*)(ws + WS_WOUT + wsel))
#define WQ_T ((bf16_t*)(ws + WS_WQ + wsel))
#define WK_T ((bf16_t*)(ws + WS_WK + wsel))
#define WV_T ((bf16_t*)(ws + WS_WV + wsel))
#define WO_T ((bf16_t*)(ws + WS_WO + wsel))
#define WUP_T ((bf16_t*)(ws + WS_WUP + wsel))
#define WDN_T ((bf16_t*)(ws + WS_WDN + wsel))
#define MEMB ((bf16_t*)(ws + WS_MEMB))
#define KBP ((bf16_t*)(ws + WS_KBP))
#define VTP ((bf16_t*)(ws + WS_VTP))
#define KBS ((bf16_t*)(ws + WS_KBS + ksel))
#define VTS ((bf16_t*)(ws + WS_VTS + ksel))
#define WST ((bf16_t*)(ws + WS_WST + ksel))
#define AGG ((float*)(ws + WS_AGG))
#define SSQ(i) ((float*)(ws + WS_SSP) + (size_t)(i) * MT * 4)
#define SSS(i) ((float*)(ws + WS_SSS) + (size_t)(i) * 256 * 32)
#define GT_R ((bf16_t*)(ws + WS_GT + ksel))
#define GT_I ((bf16_t*)(ws + WS_GT + 65536 + ksel))
#define XN ((bf16_t*)(ws + WS_XN))
#define gZ ((bf16_t*)(ws + B_Z))
#define HLOC ((bf16_t*)(ws + B_HLOC))
#define PCUM ((bf16_t*)(ws + B_PCUM))
#define gY ((bf16_t*)(ws + B_Y))
#define gQ ((bf16_t*)(ws + B_Q))
#define gP ((bf16_t*)(ws + B_P))
#define gO ((bf16_t*)(ws + B_O))
#define PS ((bf16_t*)(ws + B_PS))
#define GU ((bf16_t*)(ws + B_GU))
#define GUS ((bf16_t*)(ws + B_GUS))
#define SBG ((float*)(ws + B_SBG))
#define SBU ((float*)(ws + B_SBU))
#define SBL ((float*)(ws + B_SBL))
__device__ __forceinline__ void convert_layer(kptr_t kp, unsigned char* ws, LAS unsigned char* lds, const int l, const int part, const int nparts, const int gw, const int NGW, const int gt, const int NGT, const int lane, const int wave) {
            const size_t wsel = (size_t)(l & 1) * WSEL1, ksel = (size_t)(l & 1) * KSEL1;
            LAS float* scr = (LAS float*)(lds + wave * 16384);
            const float* w_in = INP(I_WIN) + (size_t)l * D * INC; const float* w_out = INP(I_WOUT) + (size_t)l * D * D; const float* w_q = INP(I_WQ) + (size_t)l * D * D;
            const float* w_k = INP(I_WK) + (size_t)l * D * D; const float* w_v = INP(I_WV) + (size_t)l * D * D; const float* w_o = INP(I_WO) + (size_t)l * D * D;
            const float* w_up = INP(I_WUP) + (size_t)l * D * 2 * DFF; const float* w_dn = INP(I_WDN) + (size_t)l * DFF * D; const float* c_v = INP(I_CV) + (size_t)l * BS * NMEM * D;
            constexpr int T_IN = 16 * (INC / 32), T_SQ = 16 * 32, T_UP = 16 * (2 * DFF / 32), T_DN = (DFF / 64) * 32, T_CV = 32 * 32;
            constexpr int T_G = 16;
            constexpr int NIT = T_IN + 5 * T_SQ + T_UP + T_DN + T_CV + 2 * T_G;
            for (int it = (NIT * part) / nparts + gw; it < (NIT * (part + 1)) / nparts; it += NGW) {
                int r = it;
                if (r < T_IN) { transpose_item(w_in, D, INC, WIN_T, scr, r, lane, INP(I_GMIX) + l * D); continue; } r -= T_IN;
                if (r < T_SQ) { transpose_item(w_out, D, D, WOUT_T, scr, r, lane); continue; } r -= T_SQ;
                if (r < T_SQ) { transpose_item(w_q, D, D, WQ_T, scr, r, lane, INP(I_GX) + l * D); continue; } r -= T_SQ;
                if (r < T_SQ) { transpose_item(w_k, D, D, WK_T, scr, r, lane); continue; } r -= T_SQ;
                if (r < T_SQ) { transpose_item(w_v, D, D, WV_T, scr, r, lane); continue; } r -= T_SQ;
                if (r < T_SQ) { transpose_item(w_o, D, D, WO_T, scr, r, lane); continue; } r -= T_SQ;
                if (r < T_UP) { transpose_item(w_up, D, 2 * DFF, WUP_T, scr, r, lane, INP(I_GFFN) + l * D, DFF); continue; } r -= T_UP;
                if (r < T_DN) { transpose_item(w_dn, DFF, D, WDN_T, scr, r, lane); continue; } r -= T_DN;
                if (r < T_CV) { transpose_item(c_v, BS * NMEM, D, VTS, scr, r, lane); continue; } r -= T_CV;
                if (r < T_G) { transpose_item(INP(I_WRG) + ((size_t)l * 8 + (r >> 1)) * 4096, 64, 64, GT_R + (r >> 1) * 4096, scr, r & 1, lane); continue; } r -= T_G;
                transpose_item(INP(I_WIG) + ((size_t)l * 8 + (r >> 1)) * 4096, 64, 64, GT_I + (r >> 1) * 4096, scr, r & 1, lane);
            }
            if (part == 0) {
                const f32x4* ck = (const f32x4*)(INP(I_CK) + (size_t)l * BS * NMEM * D); u32x2* dk = (u32x2*)KBS;
                for (int i = gt; i < BS * NMEM * D / 4; i += NGT) { const f32x4 v = ck[i]; u32x2 w; w.x = pk2(v.x, v.y); w.y = pk2(v.z, v.w); dk[i] = w; }
                if (l == 0) { const f32x4* mm = (const f32x4*)INP(I_MEM); u32x2* dm = (u32x2*)MEMB;
                    for (int i = gt; i < BP * NMEM * D / 4; i += NGT) { const f32x4 v = mm[i]; u32x2 w; w.x = pk2(v.x, v.y); w.y = pk2(v.z, v.w); dm[i] = w; } }
                const float* wsl = INP(I_WS) + (size_t)l * 4 * 128 * 128;
                for (int i = gt; i < 4 * 128 * 128; i += NGT) { const int s = i & 127, t = (i >> 7) & 127; WST[i] = (bf16_t)f2bf(s <= t ? wsl[i] : 0.f); }
            }
}

__global__ void __launch_bounds__(NTHREADS, 2) trunk_fwd(Args args) {
    extern __shared__ __attribute__((aligned(16))) unsigned char lds_raw[];
    LAS unsigned char* lds = (LAS unsigned char*)lds_raw;
    cg::grid_group grid = cg::this_grid();
    const int wave_s = __builtin_amdgcn_readfirstlane(threadIdx.x >> 6);
#define LANE_STATE() int G = gridDim.x, bid = blockIdx.x; asm volatile("" : "+s"(G), "+s"(bid)); const int NGW = G * NWAVES, NGT = G * NTHREADS; (void)NGW; (void)NGT; \
    const int tid = opaque_tid(wave_s), lane = tid & 63, wave = wave_s; const int gw = bid * NWAVES + wave; const int gt = bid * NTHREADS + tid; (void)lane; (void)gw; (void)gt; \
    kptr_t kp = (kptr_t)__builtin_amdgcn_kernarg_segment_ptr(); asm volatile("" : "+s"(kp)); \
    float* const out = *(const __attribute__((address_space(4))) fp_t*)(kp + 8 * N_IN); unsigned char* const ws = *(const __attribute__((address_space(4))) ucp_t*)(kp + 8 * N_IN + 8); (void)out; (void)ws
    {
        LANE_STATE();
        if (bid == 0) for (int i = tid; i < XCD_BAR_WORDS; i += NTHREADS) __hip_atomic_store((unsigned*)(ws + WS_BAR) + i, 0u, __ATOMIC_RELAXED, __HIP_MEMORY_SCOPE_AGENT);
        if (tid < 32) ((LAS unsigned*)(lds + LDS_MISC))[tid] = 0u;
        __threadfence();
        grid.sync();
        if (tid == 0) (void)xb_add((unsigned*)(ws + WS_BAR) + XB_XCNT(xb_xcc_id()), 1u);
    }
#define GRID_SYNC() do { kptr_t kp_ = (kptr_t)__builtin_amdgcn_kernarg_segment_ptr(); asm volatile("" : "+s"(kp_)); \
        XcdBarrier b_; b_.bar = (unsigned*)(*(const __attribute__((address_space(4))) ucp_t*)(kp_ + 8 * N_IN + 8) + WS_BAR); b_.x = xb_xcc_id(); b_.st = (volatile LAS unsigned*)(lds + LDS_MISC); \
        xcd_barrier(b_); if (PROBE == 3) xcd_barrier(b_); } while (0)

    for (int l = 0; l < DEPTH; ++l) {
        const size_t wsel = (size_t)(l & 1) * WSEL1, ksel = (size_t)(l & 1) * KSEL1;
        if (l == 0)
        for (int dup0 = 0; dup0 < ((PROBE == 1 || PROBE == 5) ? 2 : 1); ++dup0) {
        {
            LANE_STATE();
            convert_layer(kp, ws, lds, l, 0, 1, gw, NGW, gt, NGT, lane, wave);
            if (l == 0) first_rows(INP(I_XP), INP(I_XS), XN, SSQ(0), gw, NGW, lane);
        }
        GRID_SYNC();
        }
        {
            LANE_STATE();
            KVSched S; S.G = G; S.c = bid >= 160 ? bid - 160 : -1; S.ws = (const char*)ws; S.wsel = wsel;
            pg8::Gemm g{(const bf16_t*)nullptr, (const bf16_t*)nullptr, D, D, D};
            pg8::EpiKV E{out + O_MKP + (size_t)l * BP * NMEM * D, out + O_MVP + (size_t)l * BP * NMEM * D, KBP, VTP};
            pg8::gemm_phase<pg8::EpiKV, KVSched, true>(lds, g, S, E, wave_s);
        }
#define GEMM_BF16(s_) do { const int s = (s_); pg8::GSched S; pg8::Gemm g; pg8::EpiBf16 E; E.scale = 1.f; E.ss = nullptr; E.smp = 0; \
        if (s == 0) { S.init(MT / 256, INC / 256, G, bid); S.aPm = (size_t)256 * D * 2; S.bPn = (size_t)256 * D * 2; g = pg8::Gemm{XN, WIN_T, D, D, D}; E.O = gZ; E.ldc = INC; E.ss = SSQ(3 * l); } \
        else if (s == 1) { S.init(MP / 256, D / 256, G, bid); S.aPm = (size_t)256 * D * 2; S.bPn = (size_t)256 * D * 2; g = pg8::Gemm{XN, WQ_T, D, D, D}; E.O = gQ; E.ldc = D; E.scale = 0.0625f; E.ss = SSQ(3 * l + 1); } \
        else if (s == 2) { S.init(MP / 256, 4, G, bid); S.aPm = (size_t)256 * D * 2; S.aPn = 512; S.bPn = (size_t)256 * 2048 * 2; S.bPm = 512; S.bShift = 4; g = pg8::Gemm{gP, VTP, D, 2048, 256}; E.O = gO; E.ldc = D; } \
        else { S.init(1, 32, G, (bid + G - 64) % G); S.mode = 2; g = pg8::Gemm{PS, VTS, 8192, 2048, 256}; E.O = gO + (size_t)MP * D; E.ldc = D; E.smp = 1; } \
        pg8::gemm_phase<pg8::EpiBf16, pg8::GSched, true>(lds, g, S, E, wave_s); } while (0)
#define GEMM_RES(s_) do { const int s = (s_); pg8::GSched S; S.init(MP / 256, D / 256, G, bid); pg8::Gemm g; \
        if (s == 0) { g = pg8::Gemm{gY, WOUT_T, D, D, D}; S.aPm = (size_t)256 * D * 2; } \
        else if (s == 1) { g = pg8::Gemm{gO, WO_T, D, D, D}; S.aPm = (size_t)256 * D * 2; } \
        else { g = pg8::Gemm{GU, WDN_T, DFF, DFF, DFF}; S.aPm = (size_t)256 * DFF * 2; } \
        S.bPn = (size_t)256 * g.ldb * 2; \
        pg8::EpiResid E{XN, SSQ(3 * l + 1 + s)}; \
        pg8::gemm_phase<pg8::EpiResid, pg8::GSched, true>(lds, g, S, E, wave_s); } while (0)

        for (int rep = 0; rep < 13; ++rep) { if (rep == 4 || rep == 9 || rep == 11) continue;
          const int ndup = ((PROBE == 1 && (rep == 1 || rep == 2)) || (PROBE == 4 && rep == 1) || (PROBE == 6 && rep == 2)) ? 2 : ((PROBE == 2 && (rep == 0 || rep == 5 || rep == 6 || rep == 7 || rep == 10)) ? 2 : 1);
          for (int dup = 0; dup < ndup; ++dup) {
            if (rep == 0 || rep == 5 || rep == 7) {
                LANE_STATE();
                const int s0 = rep == 0 ? 0 : (rep == 5 ? 1 : 2), ns = rep == 7 ? 2 : 1;
                if (rep == 0 && l > 0) {
                    pg8::GSched S0; S0.init(MT / 256, INC / 256, G, bid); pg8::Unit u0; bool own = false;
                    for (int i = 0; S0.next(i, u0); ++i) own = own || (u0.pm == 128);
                    if (own) sample_ss_reduce(SSS(3 * l), SSQ(3 * l), tid);
                }
                for (int q = 0; q < ns; ++q) GEMM_BF16(s0 + q);
                if (rep == 5) { LANE_STATE(); const SG2 sg{XN + (size_t)MP * D, WQ_T, D, D, D, D, gQ + (size_t)MP * D, D, 0.0625f, 1, nullptr}; sgemm2(lds, sg, bid, G, wave, tid); }
                if (rep == 5 && l + 1 < DEPTH) { LANE_STATE(); if (bid >= 64) convert_layer(kp, ws, lds, l + 1, 1, 3, gw - 64 * NWAVES, NGW - 64 * NWAVES, gt - 64 * NTHREADS, NGT - 64 * NTHREADS, lane, wave); }
            } else if (rep == 10) {
                LANE_STATE();
                pg8::GSched S; S.init(MP / 256, 2 * DFF / 256, G, bid); S.aPm = (size_t)256 * D * 2; S.bPn = (size_t)256 * D * 2;
                const pg8::Gemm g{XN, WUP_T, D, D, D};
                const pg8::EpiAct E{GU, INP(I_SCF) + (size_t)l * BS * 2 * DFF, out + O_CFS + (size_t)l * BS * 2 * DFF, SBG, SBU, SBL, INP(I_CFW) + (size_t)l * 3 * DFF, SSQ(3 * l + 2)};
                pg8::gemm_phase<pg8::EpiAct, pg8::GSched, true>(lds, g, S, E, wave_s);
                { LANE_STATE(); sgemm_act(lds, XN + (size_t)MP * D, WUP_T, GU + (size_t)MP * DFF, INP(I_CFW) + (size_t)l * 3 * DFF, INP(I_SCF) + (size_t)l * BS * 2 * DFF, out + O_CFS + (size_t)l * BS * 2 * DFF, bid, G, wave, tid); }
            } else if (rep == 1) {
                LANE_STATE();
                {
                    LAS bf16_t* vT = (LAS bf16_t*)lds;
                    constexpr int VP = 136;
                    const float* gvp = INP(I_GV) + l * CW; const float* bsp = INP(I_BSS) + l * 4 * 128;
                    for (int un = (bid + G / 2) % G; un < 8 + 256; un += G) {
                        int rowbase, nrows, sb = -1;
                        if (un < 8) { sb = un; rowbase = MP + un * TS; nrows = TS; } else { rowbase = (un - 8) * 128; nrows = 128; }
                        {
                            const int rl = tid >> 5, cgp = tid & 31;
                            f32x4 g0 = *(const f32x4*)(gvp + cgp * 8), g1 = *(const f32x4*)(gvp + cgp * 8 + 4);
                            for (int p = 0; p < nrows / 16; ++p) {
                                const int r = p * 16 + rl;
                                const u32x4 raw = *(const u32x4*)(gZ + (size_t)(rowbase + r) * INC + Z_VC + cgp * 8);
                                float v[8] = {bflo(raw.x), bfhi(raw.x), bflo(raw.y), bfhi(raw.y), bflo(raw.z), bfhi(raw.z), bflo(raw.w), bfhi(raw.w)};
                                float ss = 0.f;
#pragma unroll
                                for (int k = 0; k < 8; ++k) { v[k] = gelu_t(v[k]); ss += v[k] * v[k]; }
                                ss += shx(ss, 1, lane); ss += shx(ss, 2, lane); ss += shx(ss, 4, lane);
                                const float rstd = 1.0f / sqrtf(ss * (1.f / 64.f) + EPS);
                                const float gg[8] = {g0.x, g0.y, g0.z, g0.w, g1.x, g1.y, g1.z, g1.w};
#pragma unroll
                                for (int k = 0; k < 8; ++k) { v[k] = v[k] * rstd * gg[k]; vT[(cgp * 8 + k) * VP + r] = (bf16_t)f2bf(v[k]); }
                                if (sb >= 0) { float* vo = out + O_VCS + ((size_t)(l * BS + sb) * TS + r) * CW + cgp * 8;
                                    *(f32x4*)vo = (f32x4){v[0], v[1], v[2], v[3]}; *(f32x4*)(vo + 4) = (f32x4){v[4], v[5], v[6], v[7]}; }
                            }
                        }
                        __syncthreads();
                        {
                            const int hh = wave & 3, rh = wave >> 2, fr = lane & 15, fq = lane >> 4;
                            const int nmt = nrows == 128 ? 4 : (rh == 0 ? 2 : 0);
                            for (int mi = 0; mi < nmt; ++mi) {
                                const int mt = rh * 4 + mi, nks = (mt * 16 + 15) / 32 + 1;
                                f32x4 acc[4];
#pragma unroll
                                for (int n = 0; n < 4; ++n) acc[n] = (f32x4){0.f, 0.f, 0.f, 0.f};
                                for (int ks = 0; ks < nks; ++ks) {
                                    const bf16x8 a = *(const bf16x8*)(WST + ((size_t)(hh * 128 + mt * 16 + fr) * 128 + ks * 32 + fq * 8));
#pragma unroll
                                    for (int n = 0; n < 4; ++n) { const bf16x8 b = *(const LAS bf16x8*)(vT + (hh * 64 + n * 16 + fr) * VP + ks * 32 + fq * 8);
                                        acc[n] = __builtin_amdgcn_mfma_f32_16x16x32_bf16(b, a, acc[n], 0, 0, 0); }
                                }
                                { const int t = mt * 16 + fr; const float bias = bsp[hh * 128 + t]; const size_t row = (size_t)(rowbase + t);
#pragma unroll
                                    for (int n = 0; n < 4; ++n) { const int c = hh * 64 + n * 16 + fq * 4; const u32x2 uq = *(const u32x2*)(gZ + row * INC + Z_UC + c);
                                        u32x2 w; w.x = pk2(gelu_t(bflo(uq.x)) * (acc[n][0] + bias), gelu_t(bfhi(uq.x)) * (acc[n][1] + bias)); w.y = pk2(gelu_t(bflo(uq.y)) * (acc[n][2] + bias), gelu_t(bfhi(uq.y)) * (acc[n][3] + bias));
                                        *(u32x2*)(gY + row * D + 768 + c) = w; } }
                            }
                        }
                        __syncthreads();
                    }
                }
                {
                    LAS unsigned char* wl = lds + wave * 16384;
                    LAS bf16_t* tile = (LAS bf16_t*)wl;
                    LAS float* pre_r = (LAS float*)(wl + 2560);
                    LAS float* pre_i = (LAS float*)(wl + 2560 + 4096);
                    LAS float* xcf = (LAS float*)(wl + 2560 + 8192);
                    const int fr = lane & 15, fq = lane >> 4;
                    for (int un = gw; un < 64 + 2048; un += NGW) {
                        int b, hd, rowbase, nrows, t0; bool smp = un < 64;
                        if (smp) { b = un >> 3; hd = un & 7; rowbase = MP + b * TS; nrows = TS; t0 = 0; }
                        else { const int v = un - 64; const int ch = v & 31; hd = (v >> 5) & 7; b = v >> 8; t0 = ch * 128; rowbase = b * SEQ + t0; nrows = 128; }
                        const int cidx = l * AW + hd * 64 + lane;
                        const float br = INP(I_BRG)[cidx], bi = INP(I_BIG)[cidx];
                        const float c8sp = 8.0f * log1pf(__expf(-INP(I_LAM)[cidx]));
                        const float* caw = INP(I_CAW) + (size_t)l * 4 * AW + hd * 64 + lane;
                        const float cw0 = caw[0], cw1 = caw[AW], cw2 = caw[2 * AW], cw3 = caw[3 * AW], cb = INP(I_CAB)[cidx];
                        bf16x8 bR[4][2], bI[4][2];
#pragma unroll
                        for (int n = 0; n < 4; ++n)
#pragma unroll
                            for (int ks = 0; ks < 2; ++ks) { const size_t o_ = (size_t)(hd * 64 + n * 16 + fr) * 64 + ks * 32 + fq * 8;
                                bR[n][ks] = *(const bf16x8*)(GT_R + o_); bI[n][ks] = *(const bf16x8*)(GT_I + o_); }
                        float xm3 = 0.f, xm2 = 0.f, xm1 = 0.f;
                        if (smp) { const float* st = INP(I_SCA) + ((size_t)(l * BS + b) * 3) * AW + hd * 64 + lane; xm3 = st[0]; xm2 = st[AW]; xm1 = st[2 * AW]; }
                        else if (t0 > 0) { const bf16_t* zp = gZ + (size_t)(rowbase - 3) * INC + Z_XA + hd * 64 + lane; xm3 = bf2f(zp[0]); xm2 = bf2f(zp[INC]); xm1 = bf2f(zp[2 * INC]); }
                        float h = 0.f, pc = 1.f;
                        const bf16_t* zq = gZ + (size_t)(rowbase + (lane >> 3)) * INC + Z_XA + hd * 64 + (lane & 7) * 8;
                        unsigned* hp = (unsigned*)(HLOC + (size_t)rowbase * AW + hd * 64 + (lane & ~1)); unsigned* pp = (unsigned*)(PCUM + (size_t)rowbase * AW + hd * 64 + (lane & ~1));
                        LAS bf16_t* xraw = (LAS bf16_t*)pre_r;
                        u32x4 xn0 = *(const u32x4*)zq, xn1 = *(const u32x4*)(zq + (size_t)8 * INC);
                        for (int st = 0; st < nrows / 16; ++st) {
                            *(LAS u32x4*)(xraw + (lane >> 3) * 64 + (lane & 7) * 8) = xn0; *(LAS u32x4*)(xraw + ((lane >> 3) + 8) * 64 + (lane & 7) * 8) = xn1;
                            zq += (size_t)16 * INC;
                            if (st + 1 < nrows / 16) { xn0 = *(const u32x4*)zq; xn1 = *(const u32x4*)(zq + (size_t)8 * INC); }
                            LDS_WAIT();
#pragma unroll
                            for (int i = 0; i < 16; ++i) { const float xv = bf2f(xraw[i * 64 + lane]);
                                const float xc = cw0 * xm3 + cw1 * xm2 + cw2 * xm1 + cw3 * xv + cb; xm3 = xm2; xm2 = xm1; xm1 = xv; xcf[i * 64 + lane] = xc; tile[i * 72 + lane] = (bf16_t)f2bf(xc); }
                            LDS_WAIT();
                            const bf16x8 a0 = *(const LAS bf16x8*)(tile + fr * 72 + fq * 8), a1 = *(const LAS bf16x8*)(tile + fr * 72 + 32 + fq * 8);
#pragma unroll
                            for (int n = 0; n < 4; ++n) {
                                f32x4 ar = (f32x4){0.f, 0.f, 0.f, 0.f}, ai = (f32x4){0.f, 0.f, 0.f, 0.f};
                                ar = __builtin_amdgcn_mfma_f32_16x16x32_bf16(a0, bR[n][0], ar, 0, 0, 0); ar = __builtin_amdgcn_mfma_f32_16x16x32_bf16(a1, bR[n][1], ar, 0, 0, 0);
                                ai = __builtin_amdgcn_mfma_f32_16x16x32_bf16(a0, bI[n][0], ai, 0, 0, 0); ai = __builtin_amdgcn_mfma_f32_16x16x32_bf16(a1, bI[n][1], ai, 0, 0, 0);
#pragma unroll
                                for (int j = 0; j < 4; ++j) { pre_r[(fq * 4 + j) * 64 + n * 16 + fr] = ar[j]; pre_i[(fq * 4 + j) * 64 + n * 16 + fr] = ai[j]; }
                            }
                            LDS_WAIT();
#pragma unroll 4
                            for (int i = 0; i < 16; ++i) {
                                const float r = sigm(pre_r[i * 64 + lane] + br), gi = sigm(pre_i[i * 64 + lane] + bi);
                                const float la = -c8sp * r; float a, om;
                                if (la > -0.125f) { const float x = 2.0f * la; om = -x * (1.0f + x * (0.5f + x * (0.16666667f + x * (0.041666668f + x * (0.0083333338f + x * 0.0013888889f))))); a = 1.0f + la * (1.0f + la * (0.5f + la * (0.16666667f + la * (0.041666668f + la * 0.0083333338f)))); }
                                else { a = __expf(la); om = -expm1f(2.0f * la); }
                                const float bm = __builtin_amdgcn_sqrtf(om);
                                h = a * h + bm * gi * xcf[i * 64 + lane]; pc = pc * a;
                                { const float hn = __builtin_bit_cast(float, __builtin_amdgcn_mov_dpp(__builtin_bit_cast(int, h), 0xB1, 0xf, 0xf, true)), pn = __builtin_bit_cast(float, __builtin_amdgcn_mov_dpp(__builtin_bit_cast(int, pc), 0xB1, 0xf, 0xf, true));
                                  if ((lane & 1) == 0) { *hp = pk2(h, hn); *pp = pk2(pc, pn); } hp += AW / 2; pp += AW / 2; }
                            }
                            LDS_WAIT();
                        }
                        AGG[(size_t)un * 128 + lane] = pc; AGG[(size_t)un * 128 + 64 + lane] = h;
                    }
                }
                {
                    const float* cbw = INP(I_CBW) + (size_t)l * 3 * BW;
                    for (int it = gt; it < (MT / 8) * 32; it += NGT) {
                        const int rb = it >> 5, c0 = (it & 31) * 8;
                        int b, t0, T, rowbase; const bool smp = rb >= MP / 8;
                        if (!smp) { b = rb >> 9; t0 = (rb & 511) * 8; T = SEQ; rowbase = rb * 8; } else { const int sbk = rb - MP / 8; b = sbk >> 2; t0 = (sbk & 3) * 8; T = TS; rowbase = MP + sbk * 8; }
                        u32x4 xq[10], cq[10], bq[8];
                        const bf16_t* zr = gZ + (size_t)rowbase * INC + c0;
#pragma unroll
                        for (int i = 0; i < 10; ++i) { if (i >= 2 || t0 > 0) { xq[i] = *(const u32x4*)(zr + (ptrdiff_t)(i - 2) * INC + Z_XB); cq[i] = *(const u32x4*)(zr + (ptrdiff_t)(i - 2) * INC + Z_GC); } else { xq[i] = (u32x4){0u, 0u, 0u, 0u}; cq[i] = (u32x4){0u, 0u, 0u, 0u}; } }
#pragma unroll
                        for (int i = 0; i < 8; ++i) bq[i] = *(const u32x4*)(zr + (size_t)i * INC + Z_GB);
                        float w0[8], w1[8], w2[8], pm2[8], pm1[8];
#pragma unroll
                        for (int k = 0; k < 8; ++k) { w0[k] = cbw[c0 + k]; w1[k] = cbw[BW + c0 + k]; w2[k] = cbw[2 * BW + c0 + k]; }
                        {
                            const float a_[8] = {bflo(xq[0].x) * bflo(cq[0].x), bfhi(xq[0].x) * bfhi(cq[0].x), bflo(xq[0].y) * bflo(cq[0].y), bfhi(xq[0].y) * bfhi(cq[0].y), bflo(xq[0].z) * bflo(cq[0].z), bfhi(xq[0].z) * bfhi(cq[0].z), bflo(xq[0].w) * bflo(cq[0].w), bfhi(xq[0].w) * bfhi(cq[0].w)};
                            const float b_[8] = {bflo(xq[1].x) * bflo(cq[1].x), bfhi(xq[1].x) * bfhi(cq[1].x), bflo(xq[1].y) * bflo(cq[1].y), bfhi(xq[1].y) * bfhi(cq[1].y), bflo(xq[1].z) * bflo(cq[1].z), bfhi(xq[1].z) * bfhi(cq[1].z), bflo(xq[1].w) * bflo(cq[1].w), bfhi(xq[1].w) * bfhi(cq[1].w)};
#pragma unroll
                            for (int k = 0; k < 8; ++k) { pm2[k] = a_[k]; pm1[k] = b_[k]; }
                        }
                        if (t0 == 0 && smp) { const float* st = INP(I_SCB) + ((size_t)(l * BS + b) * 2) * BW + c0;
#pragma unroll
                            for (int k = 0; k < 8; ++k) { pm2[k] = st[k]; pm1[k] = st[BW + k]; } }
#pragma unroll
                        for (int i = 0; i < 8; ++i) {
                            const u32x4 xb = xq[i + 2], gc = cq[i + 2], gb = bq[i];
                            const float pv[8] = {bflo(xb.x) * bflo(gc.x), bfhi(xb.x) * bfhi(gc.x), bflo(xb.y) * bflo(gc.y), bfhi(xb.y) * bfhi(gc.y), bflo(xb.z) * bflo(gc.z), bfhi(xb.z) * bfhi(gc.z), bflo(xb.w) * bflo(gc.w), bfhi(xb.w) * bfhi(gc.w)};
                            const float gbv[8] = {bflo(gb.x), bfhi(gb.x), bflo(gb.y), bfhi(gb.y), bflo(gb.z), bfhi(gb.z), bflo(gb.w), bfhi(gb.w)};
                            float yv[8];
#pragma unroll
                            for (int k = 0; k < 8; ++k) { yv[k] = gbv[k] * (w0[k] * pm2[k] + w1[k] * pm1[k] + w2[k] * pv[k]); pm2[k] = pm1[k]; pm1[k] = pv[k]; }
                            u32x4 w; w.x = pk2(yv[0], yv[1]); w.y = pk2(yv[2], yv[3]); w.z = pk2(yv[4], yv[5]); w.w = pk2(yv[6], yv[7]);
                            *(u32x4*)(gY + (size_t)(rowbase + i) * D + 512 + c0) = w;
                        }
                        if (t0 + 8 == T) { float* o = out + (smp ? O_CBS : O_CBP) + ((size_t)(l * 8 + b) * 2) * BW + c0;
#pragma unroll
                            for (int k = 0; k < 8; ++k) { o[k] = pm2[k]; o[BW + k] = pm1[k]; } }
                    }
                }
            } else if (rep == 2) {
                LANE_STATE();
                {
                    LAS float* cr = (LAS float*)lds;
                    for (int un = bid; un < 8 + 256; un += G) {
                        int b, ch, rowbase, nrows; const bool smp = un < 8;
                        if (smp) { b = un; ch = 0; rowbase = MP + b * TS; nrows = TS; } else { const int v = un - 8; b = v >> 5; ch = v & 31; rowbase = b * SEQ + ch * 128; nrows = 128; }
                        {
                            const int c = tid, hd = c >> 6, ln = c & 63; float carry = 0.f;
                            if (smp) carry = INP(I_SHA)[(size_t)(l * BS + b) * AW + c];
                            else { const float* ag = AGG + (size_t)(64 + (b << 8) + (hd << 5)) * 128 + ln; for (int k = 0; k < ch; ++k) carry = ag[(size_t)k * 128] * carry + ag[(size_t)k * 128 + 64]; }
                            cr[c] = carry;
                        }
                        __syncthreads();
                        const int c0 = (tid & 63) * 8, rsub = tid >> 6;
                        const f32x4 ca = *(const LAS f32x4*)(cr + c0), cb = *(const LAS f32x4*)(cr + c0 + 4);
                        for (int p = 0; p < nrows / 8; ++p) {
                            const int rloc = p * 8 + rsub; const size_t row = (size_t)(rowbase + rloc);
                            const u32x4 hq = *(const u32x4*)(HLOC + row * AW + c0), pq = *(const u32x4*)(PCUM + row * AW + c0);
                            const f32x4 h0 = (f32x4){bflo(hq.x), bfhi(hq.x), bflo(hq.y), bfhi(hq.y)}, h1 = (f32x4){bflo(hq.z), bfhi(hq.z), bflo(hq.w), bfhi(hq.w)}, p0 = (f32x4){bflo(pq.x), bfhi(pq.x), bflo(pq.y), bfhi(pq.y)}, p1 = (f32x4){bflo(pq.z), bfhi(pq.z), bflo(pq.w), bfhi(pq.w)};
                            const u32x4 gq = *(const u32x4*)(gZ + row * INC + Z_GA + c0);
                            const f32x4 a0 = h0 + p0 * ca, a1 = h1 + p1 * cb;
                            u32x4 w; w.x = pk2(gelu_t(bflo(gq.x)) * a0[0], gelu_t(bfhi(gq.x)) * a0[1]); w.y = pk2(gelu_t(bflo(gq.y)) * a0[2], gelu_t(bfhi(gq.y)) * a0[3]);
                            w.z = pk2(gelu_t(bflo(gq.z)) * a1[0], gelu_t(bfhi(gq.z)) * a1[1]); w.w = pk2(gelu_t(bflo(gq.w)) * a1[2], gelu_t(bfhi(gq.w)) * a1[3]);
                            *(u32x4*)(gY + row * D + c0) = w;
                            if ((smp || ch == 31) && rloc == nrows - 1) { float* o = out + (smp ? O_HAS : O_HAP) + (size_t)(l * 8 + b) * AW + c0; *(f32x4*)o = a0; *(f32x4*)(o + 4) = a1; }
                        }
                        if ((smp || ch == 31) && tid < 192) {
                            const int k = tid >> 6; const u32x4 xq = *(const u32x4*)(gZ + (size_t)(rowbase + nrows - 3 + k) * INC + Z_XA + c0);
                            float* o = out + (smp ? O_CAS : O_CAP) + ((size_t)(l * 8 + b) * 3 + k) * AW + c0;
                            *(f32x4*)o = (f32x4){bflo(xq.x), bfhi(xq.x), bflo(xq.y), bfhi(xq.y)}; *(f32x4*)(o + 4) = (f32x4){bflo(xq.z), bfhi(xq.z), bflo(xq.w), bfhi(xq.w)};
                        }
                        __syncthreads();
                    }
                }
            } else if (rep == 3 || rep == 8 || rep == 12) {
                LANE_STATE();
                if (rep == 12) {
                    const float* cfw = INP(I_CFW) + (size_t)l * 3 * DFF;
                    pg8::GSched S0; S0.init(MP / 256, D / 256, G, bid); pg8::Unit u0;
                    for (int i = 0; S0.next(i, u0); ++i) {
                        const int pm = u0.pm; if (pm >= 128 || tid >= DFF / 8) continue;
                        const int c0 = tid * 8, b = pm >> 4;
                        float w0[8], w1[8], w2[8], p2[8], p1[8], g0[8], g1[8], u0_[8], u1_[8];
#pragma unroll
                        for (int k = 0; k < 8; ++k) { w0[k] = cfw[c0 + k]; w1[k] = cfw[DFF + c0 + k]; w2[k] = cfw[2 * DFF + c0 + k]; p2[k] = 0.f; p1[k] = 0.f; }
                        if ((pm & 15) != 0) {
#pragma unroll
                            for (int k = 0; k < 8; ++k) { p2[k] = SBL[((size_t)(pm - 1) * 2 + 0) * DFF + c0 + k]; p1[k] = SBL[((size_t)(pm - 1) * 2 + 1) * DFF + c0 + k]; } }
#pragma unroll
                        for (int k = 0; k < 8; ++k) { g0[k] = SBG[((size_t)pm * 2 + 0) * DFF + c0 + k]; g1[k] = SBG[((size_t)pm * 2 + 1) * DFF + c0 + k]; u0_[k] = SBU[((size_t)pm * 2 + 0) * DFF + c0 + k]; u1_[k] = SBU[((size_t)pm * 2 + 1) * DFF + c0 + k]; }
                        float ha[8], hb[8];
#pragma unroll
                        for (int k = 0; k < 8; ++k) { ha[k] = silu(w0[k] * p2[k] + w1[k] * p1[k] + w2[k] * g0[k]) * u0_[k]; hb[k] = silu(w0[k] * p1[k] + w1[k] * g0[k] + w2[k] * g1[k]) * u1_[k]; }
                        u32x4 w; w.x = pk2(ha[0], ha[1]); w.y = pk2(ha[2], ha[3]); w.z = pk2(ha[4], ha[5]); w.w = pk2(ha[6], ha[7]);
                        *(u32x4*)(GU + (size_t)(pm * 256) * DFF + c0) = w;
                        w.x = pk2(hb[0], hb[1]); w.y = pk2(hb[2], hb[3]); w.z = pk2(hb[4], hb[5]); w.w = pk2(hb[6], hb[7]);
                        *(u32x4*)(GU + (size_t)(pm * 256 + 1) * DFF + c0) = w;
                        if ((pm & 15) == 15 && u0.pn == 0) { float* o = out + O_CFP + ((size_t)(l * 8 + b) * 2) * DFF + c0;
#pragma unroll
                            for (int k = 0; k < 8; ++k) { o[k] = SBL[((size_t)pm * 2 + 0) * DFF + c0 + k]; o[DFF + k] = SBL[((size_t)pm * 2 + 1) * DFF + c0 + k]; } }
                    }
                    asm volatile("s_waitcnt vmcnt(0)" ::: "memory"); __syncthreads();
                }
                GEMM_RES(rep == 3 ? 0 : (rep == 8 ? 1 : 2));
                { LANE_STATE();
                  const SG2 sg{rep == 12 ? GU + (size_t)MP * DFF : (rep == 3 ? gY : gO) + (size_t)MP * D, rep == 12 ? WDN_T : (rep == 3 ? WOUT_T : WO_T), rep == 12 ? DFF : D, rep == 12 ? DFF : D, rep == 12 ? DFF : D, D, XN + (size_t)MP * D, D, 1.f, 2, SSS(3 * l + (rep == 3 ? 1 : (rep == 8 ? 2 : 3)))};
                  sgemm2(lds, sg, bid, G, wave, tid); }
                if (rep != 12 && l + 1 < DEPTH) { LANE_STATE(); if (bid >= 64) convert_layer(kp, ws, lds, l + 1, rep == 3 ? 0 : 2, 3, gw - 64 * NWAVES, NGW - 64 * NWAVES, gt - 64 * NTHREADS, NGT - 64 * NTHREADS, lane, wave); }
            } else if (rep == 6) {
                LANE_STATE();
                for (int sub = 0; sub < 2; ++sub) {
                    pg8::GSched S; pg8::Gemm g; pg8::EpiSoftmax E;
                    if (sub == 0) { S.init(MP / 256, 4, G, bid); S.aPm = (size_t)256 * D * 2; S.aPn = 512; S.bPn = 512; S.bPm = (size_t)256 * D * 2; S.bShift = 4; g = pg8::Gemm{gQ, KBP, D, D, 256}; E.O = gP; E.ldc = D; E.smp = 0; }
                    else { S.init(1, 32, G, (bid + G - 64) % G); S.mode = 1; g = pg8::Gemm{gQ + (size_t)MP * D, KBS, D, D, 256}; E.O = PS; E.ldc = 8192; E.smp = 1; }
                    pg8::gemm_phase<pg8::EpiSoftmax, pg8::GSched, true>(lds, g, S, E, wave_s);
                }
            }
            if (rep == 6) { asm volatile("s_waitcnt vmcnt(0)" ::: "memory"); __syncthreads(); }
            else GRID_SYNC();
          }
        }
    }
    {
        LANE_STATE();
        const float* gain = INP(I_GFIN);
        f32x4 gv[4];
#pragma unroll
        for (int j = 0; j < 4; ++j) gv[j] = ((const f32x4*)gain)[lane + 64 * j];
        for (int m0 = gw; m0 < MT; m0 += 2 * NGW) {
            const int m1 = m0 + NGW; const bool two = m1 < MT; const int mb = two ? m1 : m0;
            const u32x2* xa = (const u32x2*)(XN + (size_t)m0 * D) + lane; const u32x2* xb = (const u32x2*)(XN + (size_t)mb * D) + lane;
            u32x2 pa[4], pb[4];
#pragma unroll
            for (int j = 0; j < 4; ++j) { pa[j] = xa[64 * j]; pb[j] = xb[64 * j]; }
            float ra, rb;
            { float qa = 0.f, qb = 0.f;
#pragma unroll
              for (int j = 0; j < 4; ++j) { const float a0 = bflo(pa[j].x), a1 = bfhi(pa[j].x), a2 = bflo(pa[j].y), a3 = bfhi(pa[j].y), b0 = bflo(pb[j].x), b1 = bfhi(pb[j].x), b2 = bflo(pb[j].y), b3 = bfhi(pb[j].y);
                  qa += (a0 * a0 + a1 * a1) + (a2 * a2 + a3 * a3); qb += (b0 * b0 + b1 * b1) + (b2 * b2 + b3 * b3); }
              if (m0 < MP) ra = ss_rstd(*(const f32x4*)(SSQ(6) + (size_t)m0 * 4)); else ra = 1.0f / sqrtf(wave_sum(qa, lane) * (1.f / D) + EPS);
              if (mb < MP) rb = ss_rstd(*(const f32x4*)(SSQ(6) + (size_t)mb * 4)); else rb = 1.0f / sqrtf(wave_sum(qb, lane) * (1.f / D) + EPS); }
            f32x4* ya = (f32x4*)(out + (size_t)m0 * D) + lane; f32x4* yb = (f32x4*)(out + (size_t)mb * D) + lane;
#pragma unroll
            for (int j = 0; j < 4; ++j) { ya[64 * j] = (f32x4){bflo(pa[j].x), bfhi(pa[j].x), bflo(pa[j].y), bfhi(pa[j].y)} * ra * gv[j]; if (two) yb[64 * j] = (f32x4){bflo(pb[j].x), bfhi(pb[j].x), bflo(pb[j].y), bfhi(pb[j].y)} * rb * gv[j]; }
        }
    }
}

extern "C" void kernel_launch(void* const* d_in, const int* in_sizes, int n_in, void* d_out, int out_size, void* d_ws, size_t ws_size, hipStream_t stream) {
    static int grid = 0;
    if (grid == 0) {
        if (n_in != N_IN || (size_t)out_size != O_END || ws_size < 512 * MiB) { fprintf(stderr, "kernel_launch: unexpected sizes n_in %d out %d ws %zu (need %zu)\n", n_in, out_size, ws_size, (size_t)(512 * MiB)); grid = -1; return; }
        int dev = 0, cus = 0, per_cu = 0;
        (void)hipGetDevice(&dev); (void)hipDeviceGetAttribute(&cus, hipDeviceAttributeMultiprocessorCount, dev);
        if (hipFuncSetAttribute((const void*)trunk_fwd, hipFuncAttributeMaxDynamicSharedMemorySize, LDS_BYTES) != hipSuccess) { fprintf(stderr, "kernel_launch: hipFuncSetAttribute failed\n"); grid = -1; return; }
        if (hipOccupancyMaxActiveBlocksPerMultiprocessor(&per_cu, (const void*)trunk_fwd, NTHREADS, LDS_BYTES) != hipSuccess || per_cu < 1) { fprintf(stderr, "kernel_launch: occupancy query gave %d\n", per_cu); per_cu = 1; }
        (void)hipGetLastError();
        grid = cus * 1;
        if (grid != 256) fprintf(stderr, "kernel_launch: note: %d CUs\n", grid);
    }
    if (grid < 0) return;
    Args a{};
    for (int i = 0; i < N_IN; ++i) a.in[i] = (const float*)d_in[i];
    a.out = (float*)d_out; a.ws = (unsigned char*)d_ws;
    void* kargs[] = {&a};
    hipError_t e = hipLaunchCooperativeKernel((const void*)trunk_fwd, dim3(grid), dim3(NTHREADS), kargs, LDS_BYTES, stream);
    if (e != hipSuccess) fprintf(stderr, "kernel_launch: cooperative launch failed: %s (grid %d)\n", hipGetErrorString(e), grid);
}
```

```cpp
#include <hip/hip_runtime.h>
#include <hip/hip_cooperative_groups.h>
#include <cstdio>
#include <cstdint>
namespace cg = cooperative_groups;
#ifndef PROBE
#define PROBE 0
#endif

#define LAS __attribute__((address_space(3)))
typedef unsigned short bf16_t;
typedef short bf16x8 __attribute__((ext_vector_type(8)));
typedef float f32x4 __attribute__((ext_vector_type(4)));
typedef float f32x2 __attribute__((ext_vector_type(2)));
typedef unsigned u32x4 __attribute__((ext_vector_type(4)));
typedef unsigned u32x2 __attribute__((ext_vector_type(2)));

constexpr int D = 1024, BP = 8, SEQ = 4096, BS = 8, TS = 32, DEPTH = 2;
constexpr int MP = BP * SEQ, MS = BS * TS, MT = MP + MS;
constexpr int INC = 2304, DFF = 2816, NMEM = 256, AW = 512, BW = 256, CW = 256;
constexpr int Z_XA = 0, Z_GA = 512, Z_XB = 1024, Z_GB = 1280, Z_GC = 1536, Z_UC = 1792, Z_VC = 2048;
constexpr float EPS = 1e-6f;
constexpr int NWAVES = 8, NTHREADS = 512;

constexpr size_t O_YP = 0, O_YS = O_YP + (size_t)MP * D, O_CAP = O_YS + (size_t)MS * D, O_HAP = O_CAP + DEPTH * BP * 3 * AW,
                 O_CBP = O_HAP + DEPTH * BP * AW, O_CFP = O_CBP + DEPTH * BP * 2 * BW, O_MKP = O_CFP + DEPTH * BP * 2 * DFF,
                 O_MVP = O_MKP + (size_t)DEPTH * BP * NMEM * D, O_CAS = O_MVP + (size_t)DEPTH * BP * NMEM * D, O_HAS = O_CAS + DEPTH * BS * 3 * AW,
                 O_CBS = O_HAS + DEPTH * BS * AW, O_CFS = O_CBS + DEPTH * BS * 2 * BW, O_VCS = O_CFS + DEPTH * BS * 2 * DFF,
                 O_END = O_VCS + DEPTH * BS * TS * CW;

constexpr size_t MiB = 1u << 20;
constexpr size_t WS_WIN = 0, WS_WOUT = 5 * MiB, WS_WQ = 7 * MiB, WS_WK = 9 * MiB, WS_WV = 11 * MiB, WS_WO = 13 * MiB, WS_WUP = 15 * MiB, WS_WDN = 26 * MiB;
constexpr size_t WS_MEMB = 32 * MiB, WS_KBP = 36 * MiB, WS_VTP = 40 * MiB, WS_KBS = 44 * MiB, WS_VTS = 48 * MiB, WS_WST = 52 * MiB, WS_GT = WS_WST + 131072, WS_AGG = 53 * MiB, WS_SS = 54 * MiB + 256 * 1024, WS_BAR = 55 * MiB + 512 * 1024;
constexpr size_t WS_XN = 56 * MiB, WS_BIG = 121 * MiB;
constexpr size_t B_Z = WS_BIG, B_HLOC = WS_BIG + 146 * MiB, B_PCUM = WS_BIG + 211 * MiB, B_Y = WS_BIG + 276 * MiB;
constexpr size_t B_Q = WS_BIG, B_P = WS_BIG + 65 * MiB, B_O = WS_BIG + 130 * MiB, B_PS = WS_BIG + 195 * MiB;
constexpr size_t B_GU = WS_BIG;
constexpr size_t B_GUS = WS_BIG + 200 * MiB;
constexpr size_t B_SBG = WS_BIG + 204 * MiB, B_SBU = WS_BIG + 207 * MiB, B_SBL = WS_BIG + 210 * MiB;
constexpr size_t WS_END = WS_BIG + (size_t)MT * 2 * DFF * 2;
constexpr size_t WS_SSP = 476 * MiB;
static_assert(WS_END <= WS_SSP && WS_SSP + (size_t)7 * MT * 64 <= 512 * MiB, "workspace");
static_assert(WS_XN + (size_t)MT * D * 2 <= WS_BIG, "xn");
constexpr size_t WS_SSS = WS_SSP + (((size_t)7 * MT * 16 + 4095) / 4096) * 4096;
static_assert(WS_SSS + 7 * 256 * 32 * 4 <= 480 * MiB, "sss");
constexpr size_t WSEL1 = 480 * MiB, KSEL1 = 418 * MiB;
static_assert(WS_WDN + (size_t)D * DFF * 2 + WSEL1 <= 512 * MiB && WS_KBS + KSEL1 >= WS_BIG + 341 * MiB && WS_GT + 131072 + KSEL1 <= WS_SSP, "second buffer set");

constexpr int LDS_RING = 131072, LDS_EX = LDS_RING, LDS_MISC = LDS_EX + 8192, LDS_BYTES = 147456;

enum { I_XP = 0, I_XS, I_MEM, I_CK, I_CV, I_SCA, I_SHA, I_SCB, I_SCF, I_GMIX, I_WIN, I_CAW, I_CAB, I_WRG, I_BRG, I_WIG, I_BIG, I_LAM, I_CBW, I_GV, I_WS, I_BSS,
       I_WOUT, I_GX, I_WQ, I_WK, I_WV, I_WO, I_GFFN, I_WUP, I_CFW, I_WDN, I_GFIN, N_IN };

struct Args { const float* in[N_IN]; float* out; unsigned char* ws; };

__device__ __forceinline__ unsigned pk2(float lo, float hi) { unsigned r; asm("v_cvt_pk_bf16_f32 %0, %1, %2" : "=v"(r) : "v"(lo), "v"(hi)); return r; }
__device__ __forceinline__ unsigned f2bf(float f) { return pk2(f, f) & 0xffffu; }
__device__ __forceinline__ float bf2f(unsigned v) { return __builtin_bit_cast(float, v << 16); }
__device__ __forceinline__ float bflo(unsigned w) { return __builtin_bit_cast(float, w << 16); }
__device__ __forceinline__ float bfhi(unsigned w) { return __builtin_bit_cast(float, w & 0xffff0000u); }
__device__ __forceinline__ unsigned cvt_pk_bf16(float lo, float hi) { unsigned r; asm volatile("v_cvt_pk_bf16_f32 %0, %1, %2" : "=v"(r) : "v"(lo), "v"(hi)); return r; }
__device__ __forceinline__ float fexp(float x) { return __builtin_amdgcn_exp2f(x * 1.4426950408889634f); }
__device__ __forceinline__ float sigm(float x) { return __builtin_amdgcn_rcpf(1.0f + fexp(-x)); }
__device__ __forceinline__ float gelu_t(float x) { const float u = 0.7978845608028654f * (x + 0.044715f * x * x * x); return x * sigm(2.0f * u); }
__device__ __forceinline__ float silu(float x) { return x * sigm(x); }
__device__ __forceinline__ float shx(float v, int m, int lane) { return __builtin_bit_cast(float, __builtin_amdgcn_ds_bpermute((lane ^ m) << 2, __builtin_bit_cast(int, v))); }
__device__ __forceinline__ float wave_sum(float v, int lane) {
#pragma unroll
    for (int o = 1; o < 64; o <<= 1) v += shx(v, o, lane);
    return v;
}
#define LDS_WAIT() asm volatile("s_waitcnt lgkmcnt(0)" ::: "memory")
__device__ __forceinline__ float ss_rstd(f32x4 p) { return __builtin_amdgcn_rsqf(((p[0] + p[1]) + (p[2] + p[3])) * (1.f / 1024.f) + 1e-6f); }
__device__ __forceinline__ int opaque_tid(int wave_s) { int l; asm volatile("v_mbcnt_lo_u32_b32 %0, -1, 0\n\tv_mbcnt_hi_u32_b32 %0, -1, %0" : "=v"(l)); return wave_s * 64 + l; }

namespace pg8 {
constexpr int BM = 256, BK = 64, HALF = 128, HTB = HALF * BK * 2, NXCD = 8, WGM = 8;
__device__ __forceinline__ int lds_byte(int r, int c) { const int st = (r >> 4) * 2 + (c >> 5), rr = r & 15, cc = c & 31, ob = rr * 64 + cc * 2; return st * 1024 + (ob ^ (((ob >> 9) & 1) << 5)); }
__device__ __forceinline__ void stage_rc(int b, int& R, int& C) { const int st = b / 1024, sb = b % 1024, swz = sb ^ (((sb >> 9) & 1) << 5); R = (st >> 1) * 16 + swz / 64; C = (st & 1) * 32 + (swz % 64) / 2; }
__device__ __forceinline__ int perm32(int rho) { const int n = rho >> 4, i = rho & 15; return 8 * (i >> 2) + 4 * n + (i & 3); }

struct Unit { int pm, pn; };
struct Gemm { const bf16_t* A; const bf16_t* Bt; int lda, ldb, K; };

struct GSched {
    int nM, nN, nwg, G, c, mode;
    size_t aPm, aPn, bPn, bPm; int bShift;
    __device__ __forceinline__ void init(int nM_, int nN_, int G_, int c_) { nM = nM_; nN = nN_; nwg = nM * nN; G = G_; c = c_; mode = 0; aPm = 0; aPn = 0; bPn = 0; bPm = 0; bShift = 0; }
    __device__ __forceinline__ bool next(int i, Unit& u) const {
        const long L = (long)i * G + c; if (L >= nwg) return false;
        int wgid = (int)L; { const int q = nwg / NXCD, r = nwg % NXCD, xcd = wgid % NXCD, off = wgid / NXCD; wgid = (xcd < r ? xcd * (q + 1) : r * (q + 1) + (xcd - r) * q) + off; }
        const int nig = WGM * nN, gid = wgid / nig, fm = gid * WGM, gsz = (nM - fm) < WGM ? (nM - fm) : WGM;
        u.pm = fm + ((wgid % nig) % gsz); u.pn = (wgid % nig) / gsz; return true;
    }
    __device__ __forceinline__ size_t offA(const Unit& u) const { return mode == 1 ? (size_t)(u.pn & 3) * 512 : (mode == 2 ? (size_t)(u.pn & 3) * 4096 + (size_t)(u.pn >> 2) * 512 : (size_t)u.pm * aPm + (size_t)u.pn * aPn); }
    __device__ __forceinline__ size_t offB(const Unit& u) const { return mode == 1 ? (size_t)(u.pn >> 2) * (256 * 1024 * 2) + (size_t)(u.pn & 3) * 512 : (mode == 2 ? (size_t)(u.pn & 3) * (256 * 2048 * 2) + (size_t)(u.pn >> 2) * 512 : (size_t)u.pn * bPn + (size_t)(u.pm >> bShift) * bPm); }
};

struct EpiBf16 {
    static constexpr bool PERM = true;
    bf16_t* O; int ldc; float scale; const float* ss; int smp;
    __device__ __forceinline__ void operator()(f32x4 (&acc)[2][2][4][2], const Unit& u, int wr, int wc, int fr, int fq, LAS unsigned char*) const {
        asm volatile("" : "+v"(fr), "+v"(fq)); asm volatile("" : "+s"(wr), "+s"(wc));
        const int row0 = u.pm * BM + wr * 64 + fr, col0 = (smp ? (u.pn & 3) : u.pn) * BM + wc * 32 + 8 * fq;
        f32x4 rs[2][4];
#pragma unroll
        for (int ai = 0; ai < 2; ++ai)
#pragma unroll
            for (int m = 0; m < 4; ++m) rs[ai][m] = ss ? *(const f32x4*)(ss + (size_t)(row0 + ai * HALF + m * 16) * 4) : (f32x4){0.f, 0.f, 0.f, 0.f};
#pragma unroll
        for (int ai = 0; ai < 2; ++ai)
#pragma unroll
            for (int m = 0; m < 4; ++m) { bf16_t* rowp = O + (size_t)(row0 + ai * HALF + m * 16) * ldc + col0;
                float sc = scale; if (ss) sc *= ss_rstd(rs[ai][m]);
                if (smp && ((ai * HALF + wr * 64 + m * 16 + fr) >> 5) != (u.pn >> 2)) continue;
#pragma unroll
                for (int bj = 0; bj < 2; ++bj) { const f32x4 v0 = acc[ai][bj][m][0] * sc, v1 = acc[ai][bj][m][1] * sc;
                    u32x4 w; w.x = cvt_pk_bf16(v0[0], v0[1]); w.y = cvt_pk_bf16(v0[2], v0[3]); w.z = cvt_pk_bf16(v1[0], v1[1]); w.w = cvt_pk_bf16(v1[2], v1[3]);
                    *(u32x4*)(rowp + bj * HALF) = w; } }
    }
};
struct EpiResid {
    static constexpr bool PERM = true;
    bf16_t* xb; float* ss;
    __device__ __forceinline__ void operator()(f32x4 (&acc)[2][2][4][2], const Unit& u, int wr, int wc, int fr, int fq, LAS unsigned char* lds) const {
        asm volatile("" : "+v"(fr), "+v"(fq)); asm volatile("" : "+s"(wr), "+s"(wc));
        const int col0 = u.pn * BM + wc * 32 + 8 * fq, lane = fq * 16 + fr;
        LAS float* PS = (LAS float*)(lds + LDS_EX);
        bf16_t* ob = xb + (size_t)u.pm * BM * D;
#pragma unroll
        for (int ai = 0; ai < 2; ++ai) {
            u32x4 pre[4][2];
#pragma unroll
            for (int m = 0; m < 4; ++m)
#pragma unroll
                for (int bj = 0; bj < 2; ++bj) pre[m][bj] = *(const u32x4*)(ob + (size_t)(ai * HALF + wr * 64 + m * 16 + fr) * D + col0 + bj * HALF);
            asm volatile("" ::: "memory");
#pragma unroll
            for (int m = 0; m < 4; ++m) { const int rl = ai * HALF + wr * 64 + m * 16 + fr; const size_t off = (size_t)rl * D + col0; float q = 0.f;
#pragma unroll
                for (int bj = 0; bj < 2; ++bj) { const u32x4 p = pre[m][bj]; const f32x4 a0 = acc[ai][bj][m][0], a1 = acc[ai][bj][m][1];
                    const float v0 = bflo(p.x) + a0[0], v1 = bfhi(p.x) + a0[1], v2 = bflo(p.y) + a0[2], v3 = bfhi(p.y) + a0[3], v4 = bflo(p.z) + a1[0], v5 = bfhi(p.z) + a1[1], v6 = bflo(p.w) + a1[2], v7 = bfhi(p.w) + a1[3];
                    u32x4 w; w.x = cvt_pk_bf16(v0, v1); w.y = cvt_pk_bf16(v2, v3); w.z = cvt_pk_bf16(v4, v5); w.w = cvt_pk_bf16(v6, v7); *(u32x4*)(ob + off + bj * HALF) = w;
                    q += ((v0 * v0 + v1 * v1) + (v2 * v2 + v3 * v3)) + ((v4 * v4 + v5 * v5) + (v6 * v6 + v7 * v7)); }
                q += shx(q, 16, lane); q += shx(q, 32, lane);
                if (fq == 0) PS[rl * 4 + wc] = q; }
            asm volatile("" ::: "memory");
        }
        asm volatile("s_waitcnt lgkmcnt(0)" ::: "memory"); __builtin_amdgcn_s_barrier(); asm volatile("" ::: "memory");
        { const int t = (wr * 4 + wc) * 64 + lane; if (t < 256) { const f32x4 p = *(const LAS f32x4*)(PS + t * 4); ss[(size_t)(u.pm * BM + t) * 4 + u.pn] = (p[0] + p[1]) + (p[2] + p[3]); } }
    }
};
struct EpiKV {
    static constexpr bool PERM = false;
    float* outK; float* outV; bf16_t* KB; bf16_t* VT;
    __device__ __forceinline__ void operator()(f32x4 (&acc)[2][2][4][2], const Unit& u, int wr, int wc, int fr, int fq, LAS unsigned char*) const {
        asm volatile("" : "+v"(fr), "+v"(fq)); asm volatile("" : "+s"(wr), "+s"(wc));
        const int kind = u.pm >> 4, pm = u.pm & 15;
        const int col0 = u.pn * BM + wc * 32 + 4 * fq;
        float* of = kind == 0 ? outK : outV; bf16_t* ob = kind == 0 ? KB : VT; const int ldb_ = kind == 2 ? 2048 : 1024;
#pragma unroll
        for (int ai = 0; ai < 2; ++ai)
#pragma unroll
            for (int m = 0; m < 4; ++m) { const int row = pm * BM + ai * HALF + wr * 64 + m * 16 + fr;
#pragma unroll
                for (int bj = 0; bj < 2; ++bj)
#pragma unroll
                    for (int n = 0; n < 2; ++n) { const f32x4 v = acc[ai][bj][m][n]; const int col = col0 + bj * HALF + n * 16;
                        if (kind != 2) *(f32x4*)(of + (size_t)row * 1024 + col) = v;
                        if (kind != 1) { u32x2 w; w.x = cvt_pk_bf16(v[0], v[1]); w.y = cvt_pk_bf16(v[2], v[3]); *(u32x2*)(ob + (size_t)row * ldb_ + col) = w; } } }
    }
};
struct EpiSoftmax {
    static constexpr bool PERM = true;
    bf16_t* O; int ldc; int smp;
    __device__ __forceinline__ void operator()(f32x4 (&acc)[2][2][4][2], const Unit& u, int wr, int wc, int fr, int fq, LAS unsigned char* lds) const {
        asm volatile("" : "+v"(fr), "+v"(fq)); asm volatile("" : "+s"(wr), "+s"(wc));
        LAS f32x2* EX = (LAS f32x2*)(lds + LDS_EX);
        const int lane = fq * 16 + fr;
        const float L2E = 1.4426950408889634f;
#pragma unroll
        for (int ai = 0; ai < 2; ++ai)
#pragma unroll
            for (int m = 0; m < 4; ++m) {
                float mx = -3.0e38f;
#pragma unroll
                for (int bj = 0; bj < 2; ++bj)
#pragma unroll
                    for (int n = 0; n < 2; ++n) { const f32x4 x = acc[ai][bj][m][n]; mx = fmaxf(mx, fmaxf(fmaxf(x[0], x[1]), fmaxf(x[2], x[3]))); }
                mx = fmaxf(mx, shx(mx, 16, lane)); mx = fmaxf(mx, shx(mx, 32, lane));
                float s = 0.f;
#pragma unroll
                for (int bj = 0; bj < 2; ++bj)
#pragma unroll
                    for (int n = 0; n < 2; ++n) { f32x4 x = acc[ai][bj][m][n];
#pragma unroll
                        for (int j = 0; j < 4; ++j) { x[j] = __builtin_amdgcn_exp2f((x[j] - mx) * L2E); s += x[j]; }
                        acc[ai][bj][m][n] = x; }
                s += shx(s, 16, lane); s += shx(s, 32, lane);
                if (fq == 0) EX[(ai * HALF + wr * 64 + m * 16 + fr) * 4 + wc] = (f32x2){mx, s};
            }
        asm volatile("s_waitcnt lgkmcnt(0)" ::: "memory"); __builtin_amdgcn_s_barrier(); asm volatile("" ::: "memory");
        int colb = u.pn * BM, j_ = 0;
        if (smp) { colb = (u.pn & 3) * 2048 + (u.pn >> 2) * 256; j_ = u.pn >> 2; }
        const int col0 = colb + wc * 32 + 8 * fq;
#pragma unroll
        for (int ai = 0; ai < 2; ++ai)
#pragma unroll
            for (int m = 0; m < 4; ++m) {
                const int rl = ai * HALF + wr * 64 + m * 16 + fr;
                const f32x2 e0 = EX[rl * 4 + 0], e1 = EX[rl * 4 + 1], e2 = EX[rl * 4 + 2], e3 = EX[rl * 4 + 3];
                const float M = fmaxf(fmaxf(e0.x, e1.x), fmaxf(e2.x, e3.x));
                const float tot = e0.y * __builtin_amdgcn_exp2f((e0.x - M) * L2E) + e1.y * __builtin_amdgcn_exp2f((e1.x - M) * L2E) + e2.y * __builtin_amdgcn_exp2f((e2.x - M) * L2E) + e3.y * __builtin_amdgcn_exp2f((e3.x - M) * L2E);
                const float own = wc == 0 ? e0.x : (wc == 1 ? e1.x : (wc == 2 ? e2.x : e3.x));
                float f = __builtin_amdgcn_exp2f((own - M) * L2E) * __builtin_amdgcn_rcpf(tot);
                if (smp && (rl >> 5) != j_) f = 0.f;
                bf16_t* rowp = O + (size_t)(u.pm * BM + rl) * ldc + col0;
#pragma unroll
                for (int bj = 0; bj < 2; ++bj) { const f32x4 v0 = acc[ai][bj][m][0] * f, v1 = acc[ai][bj][m][1] * f;
                    u32x4 w; w.x = cvt_pk_bf16(v0[0], v0[1]); w.y = cvt_pk_bf16(v0[2], v0[3]); w.z = cvt_pk_bf16(v1[0], v1[1]); w.w = cvt_pk_bf16(v1[2], v1[3]);
                    *(u32x4*)(rowp + bj * HALF) = w; } }
    }
};


__device__ __forceinline__ float dpp_ror1(float v) { return __builtin_bit_cast(float, __builtin_amdgcn_update_dpp(0, __builtin_bit_cast(int, v), 0x121, 0xf, 0xf, false)); }
__device__ __forceinline__ float dpp_ror2(float v) { return __builtin_bit_cast(float, __builtin_amdgcn_update_dpp(0, __builtin_bit_cast(int, v), 0x122, 0xf, 0xf, false)); }
struct EpiAct {
    static constexpr bool PERM = true;
    bf16_t* H; const float* scf; float* ocf; float* sbg; float* sbu; float* sbl; const float* cfw; const float* ss;
    __device__ __forceinline__ void operator()(f32x4 (&acc)[2][2][4][2], const Unit& u, int wr, int wc, int fr, int fq, LAS unsigned char* lds) const {
        asm volatile("" : "+s"(wr), "+s"(wc));
        int lane; asm volatile("v_mbcnt_lo_u32_b32 %0, -1, 0\n\tv_mbcnt_hi_u32_b32 %0, -1, %0" : "=v"(lane));
        fr = lane & 15; fq = lane >> 4;
        const int fl = wc * 32 + 8 * fq, f0 = u.pn * 128 + fl; int rowt = wr * 64 + fr;
        {
            float rst[2][4];
            f32x4 rsl[2][4];
#pragma unroll
            for (int ai = 0; ai < 2; ++ai)
#pragma unroll
                for (int m = 0; m < 4; ++m) rsl[ai][m] = *(const f32x4*)(ss + (size_t)(u.pm * BM + ai * HALF + rowt + m * 16) * 4);
#pragma unroll
            for (int ai = 0; ai < 2; ++ai)
#pragma unroll
                for (int m = 0; m < 4; ++m) { rst[ai][m] = ss_rstd(rsl[ai][m]); }
#pragma unroll
            for (int ai = 0; ai < 2; ++ai)
#pragma unroll
                for (int m = 0; m < 4; ++m) { acc[ai][0][m][0] = acc[ai][0][m][0] * rst[ai][m]; acc[ai][0][m][1] = acc[ai][0][m][1] * rst[ai][m]; acc[ai][1][m][0] = acc[ai][1][m][0] * rst[ai][m]; acc[ai][1][m][1] = acc[ai][1][m][1] * rst[ai][m]; }
        }
        const bool smp = (u.pm == 128);
        asm volatile("" : "+v"(rowt));
        LAS float* BND = (LAS float*)(lds + LDS_EX);
        if (fr >= 14) {
#pragma unroll
            for (int ai = 0; ai < 2; ++ai)
#pragma unroll
                for (int n = 0; n < 2; ++n) *(LAS f32x4*)(BND + ((ai * 2 + wr) * 2 + (fr - 14)) * 128 + fl + 4 * n) = acc[ai][0][3][n];
            if (wr == 1) {
#pragma unroll
                for (int n = 0; n < 2; ++n) *(f32x4*)(sbl + ((size_t)u.pm * 2 + (fr - 14)) * DFF + f0 + 4 * n) = acc[1][0][3][n];
            }
        }
        asm volatile("s_waitcnt lgkmcnt(0)" ::: "memory"); __builtin_amdgcn_s_barrier(); asm volatile("" ::: "memory");
#pragma unroll
        for (int ai = 0; ai < 2; ++ai) {
            const int pg = wr == 1 ? ai * 2 : 1;
            u32x2 hp[2][4];
#pragma unroll
            for (int n = 0; n < 2; ++n) {
                const f32x4 w0 = *(const f32x4*)(cfw + f0 + 4 * n), w1 = *(const f32x4*)(cfw + DFF + f0 + 4 * n), w2 = *(const f32x4*)(cfw + 2 * DFF + f0 + 4 * n);
                f32x4 h2 = *(const LAS f32x4*)(BND + (pg * 2 + 0) * 128 + fl + 4 * n), h1 = *(const LAS f32x4*)(BND + (pg * 2 + 1) * 128 + fl + 4 * n);
                f32x4 t2 = h2, t1 = h1;
                if (smp) { const float* sp = scf + (size_t)((ai * 4 + wr * 2) * 2) * DFF + f0 + 4 * n; h2 = *(const f32x4*)sp; h1 = *(const f32x4*)(sp + DFF); t2 = *(const f32x4*)(sp + 2 * DFF); t1 = *(const f32x4*)(sp + 3 * DFF); }
#pragma unroll
                for (int jp = 0; jp < 2; ++jp) {
                    float hv[4][2];
#pragma unroll
                    for (int jj = 0; jj < 2; ++jj) { const int j = jp * 2 + jj;
                        float r1p = h1[j], r2p = fr == 0 ? h2[j] : h1[j];
#pragma unroll
                        for (int m = 0; m < 4; ++m) { const float g = acc[ai][0][m][n][j];
                            if (m == 2 && smp) { r1p = t1[j]; r2p = fr == 0 ? t2[j] : t1[j]; }
                            const float r1 = dpp_ror1(g), r2 = dpp_ror2(g);
                            const float gm1 = fr >= 1 ? r1 : r1p, gm2 = fr >= 2 ? r2 : r2p;
                            r1p = r1; r2p = r2;
                            const float cv = w0[j] * gm2 + w1[j] * gm1 + w2[j] * g;
                            hv[m][jj] = silu(cv) * acc[ai][1][m][n][j]; } }
#pragma unroll
                    for (int m = 0; m < 4; ++m) { const unsigned pk = cvt_pk_bf16(hv[m][0], hv[m][1]); if (jp == 0) hp[n][m].x = pk; else hp[n][m].y = pk; }
                }
            }
#pragma unroll
            for (int m = 0; m < 4; ++m) {
                const int rl = ai * HALF + rowt + m * 16;
                if (smp && (m & 1) && fr >= 14) {
#pragma unroll
                    for (int n = 0; n < 2; ++n) *(f32x4*)(ocf + ((size_t)(ai * 4 + wr * 2 + (m >> 1)) * 2 + (fr - 14)) * DFF + f0 + 4 * n) = acc[ai][0][m][n];
                }
                if (!smp && ai == 0 && m == 0 && wr == 0 && fr < 2) {
#pragma unroll
                    for (int n = 0; n < 2; ++n) { *(f32x4*)(sbg + ((size_t)u.pm * 2 + fr) * DFF + f0 + 4 * n) = acc[0][0][0][n]; *(f32x4*)(sbu + ((size_t)u.pm * 2 + fr) * DFF + f0 + 4 * n) = acc[0][1][0][n]; }
                } else {
                    u32x4 w; w.x = hp[0][m].x; w.y = hp[0][m].y; w.z = hp[1][m].x; w.w = hp[1][m].y;
                    *(u32x4*)(H + (size_t)(u.pm * BM + rl) * DFF + f0) = w;
                }
            }
        }
    }
};

template <class Epi, class Sched, bool ALIGN_EPI>
__device__ __forceinline__ void gemm_phase(LAS unsigned char* lds, const Gemm g, const Sched& S, const Epi& E, const int wave_s) {
    const int tid = opaque_tid(wave_s), wid = __builtin_amdgcn_readfirstlane(tid >> 6), lane = tid & 63, wr = wid >> 2, wc = wid & 3, fr = lane & 15, fq = lane >> 4;
    const int nt = g.K / BK;
    unsigned voffA[2], voffB[2];
#pragma unroll
    for (int i = 0; i < 2; ++i) { int R, C; stage_rc(tid * 16 + i * 8192, R, C); const int Rb = Epi::PERM ? ((R & ~31) + perm32(R & 31)) : R;
        voffA[i] = (unsigned)(R * g.lda + C) * 2u; voffB[i] = (unsigned)(Rb * g.ldb + C) * 2u; }
    const size_t kstep = (size_t)(BK * 2);
    const size_t hstepA = (size_t)HALF * g.lda * 2, hstepB = (size_t)HALF * g.ldb * 2;
    const unsigned ldsw = (unsigned)wid * 1024u;
    const int aoff = lds_byte(wr * 64 + fr, fq * 8), boff = lds_byte(wc * 32 + fr, fq * 8);
#define PG8_SA(b, h) (((b) * 2 + (h)) * HTB)
#define PG8_SB(b, h) ((4 + (b) * 2 + (h)) * HTB)
#define PG8_STAGE(bufoff, gbase, voff) do { _Pragma("unroll") for (int _i = 0; _i < 2; ++_i) \
        __builtin_amdgcn_global_load_lds((const unsigned*)((const char*)(gbase) + (voff)[_i]), (LAS unsigned*)(lds + (bufoff) + ldsw + _i * 8192), 16, 0, 0); } while (0)
#define PG8_LDA(dst, b, h) do { _Pragma("unroll") for (int m = 0; m < 4; ++m) _Pragma("unroll") for (int k = 0; k < 2; ++k) dst[m][k] = *(const LAS bf16x8*)(lds + PG8_SA(b, h) + aoff + m * 2048 + k * 1024); } while (0)
#define PG8_LDB(dst, b, h) do { _Pragma("unroll") for (int n = 0; n < 2; ++n) _Pragma("unroll") for (int k = 0; k < 2; ++k) dst[n][k] = *(const LAS bf16x8*)(lds + PG8_SB(b, h) + boff + n * 2048 + k * 1024); } while (0)
#define PG8_MMA(ai, bj, At, Bt) do { __builtin_amdgcn_s_setprio(1); _Pragma("unroll") for (int m = 0; m < 4; ++m) _Pragma("unroll") for (int n = 0; n < 2; ++n) _Pragma("unroll") for (int k = 0; k < 2; ++k) \
        acc[ai][bj][m][n] = __builtin_amdgcn_mfma_f32_16x16x32_bf16(Bt[n][k], At[m][k], acc[ai][bj][m][n], 0, 0, 0); __builtin_amdgcn_s_setprio(0); } while (0)
#define PG8_WAIT_V(n) asm volatile("s_waitcnt vmcnt(" #n ")" ::: "memory")
#define PG8_WAIT_L(n) asm volatile("s_waitcnt lgkmcnt(" #n ")" ::: "memory")
#define PG8_BAR __builtin_amdgcn_s_barrier()
#define PG8_SCHED __builtin_amdgcn_sched_barrier(0)
    Unit cur, nxt; int ui = 0;
    if (!S.next(0, cur)) return;
    f32x4 acc[2][2][4][2];
#pragma unroll
    for (int a = 0; a < 2; ++a)
#pragma unroll
        for (int b = 0; b < 2; ++b)
#pragma unroll
            for (int m = 0; m < 4; ++m)
#pragma unroll
                for (int n = 0; n < 2; ++n) acc[a][b][m][n] = (f32x4){0.f, 0.f, 0.f, 0.f};
    bf16x8 At[4][2], B0[2][2], B1[2][2];
    const char* cA = (const char*)g.A + S.offA(cur); const char* cB = (const char*)g.Bt + S.offB(cur);
    PG8_STAGE(PG8_SB(0, 0), cB, voffB); PG8_STAGE(PG8_SB(0, 1), cB + hstepB, voffB); PG8_STAGE(PG8_SA(0, 0), cA, voffA); PG8_STAGE(PG8_SA(0, 1), cA + hstepA, voffA);
    if (wr == 1) PG8_BAR;
    PG8_WAIT_V(2); PG8_BAR;
    PG8_STAGE(PG8_SB(1, 0), cB + kstep, voffB); PG8_STAGE(PG8_SA(1, 0), cA + kstep, voffA); PG8_STAGE(PG8_SB(1, 1), cB + hstepB + kstep, voffB);
    PG8_WAIT_V(6); PG8_BAR;
    for (;;) {
        const bool has_next = S.next(ui + 1, nxt);
        const char* nA = has_next ? (const char*)g.A + S.offA(nxt) : cA; const char* nB = has_next ? (const char*)g.Bt + S.offB(nxt) : cB;
        for (int t = 0; t < nt; t += 2) {
            const bool last = (t == nt - 2);
            const char* a1 = cA + (size_t)(t + 1) * kstep;
            const char* a2 = last ? nA : cA + (size_t)(t + 2) * kstep; const char* b2 = last ? nB : cB + (size_t)(t + 2) * kstep;
            const char* a3 = a2 + kstep; const char* b3 = b2 + kstep;
            PG8_LDB(B0, 0, 0); PG8_LDB(B1, 0, 1); PG8_SCHED; PG8_LDA(At, 0, 0); PG8_STAGE(PG8_SA(1, 1), a1 + hstepA, voffA);
            PG8_WAIT_V(8); PG8_WAIT_L(0); PG8_BAR; PG8_MMA(0, 0, At, B0); PG8_MMA(0, 1, At, B1); PG8_BAR; PG8_SCHED;
            PG8_LDA(At, 0, 1); PG8_STAGE(PG8_SB(0, 0), b2, voffB); PG8_STAGE(PG8_SB(0, 1), b2 + hstepB, voffB); PG8_STAGE(PG8_SA(0, 0), a2, voffA);
            PG8_WAIT_V(8); PG8_WAIT_L(0); PG8_BAR; PG8_MMA(1, 0, At, B0); PG8_MMA(1, 1, At, B1); PG8_BAR; PG8_SCHED;
            PG8_LDB(B0, 1, 0); PG8_LDB(B1, 1, 1); PG8_SCHED; PG8_LDA(At, 1, 0); PG8_STAGE(PG8_SA(0, 1), a2 + hstepA, voffA);
            PG8_WAIT_V(8); PG8_WAIT_L(0); PG8_BAR; PG8_MMA(0, 0, At, B0); PG8_MMA(0, 1, At, B1); PG8_BAR; PG8_SCHED;
            PG8_LDA(At, 1, 1); PG8_STAGE(PG8_SB(1, 0), b3, voffB); PG8_STAGE(PG8_SB(1, 1), b3 + hstepB, voffB); PG8_STAGE(PG8_SA(1, 0), a3, voffA);
            PG8_WAIT_V(8); PG8_WAIT_L(0); PG8_BAR; PG8_MMA(1, 0, At, B0); PG8_MMA(1, 1, At, B1); PG8_BAR; PG8_SCHED;
        }
        if constexpr (ALIGN_EPI) { if (wr == 0) PG8_BAR; }
        E(acc, cur, wr, wc, fr, fq, lds);
        if (!has_next) break;
#pragma unroll
        for (int a = 0; a < 2; ++a)
#pragma unroll
            for (int b = 0; b < 2; ++b)
#pragma unroll
                for (int m = 0; m < 4; ++m)
#pragma unroll
                    for (int n = 0; n < 2; ++n) acc[a][b][m][n] = (f32x4){0.f, 0.f, 0.f, 0.f};
        cur = nxt; cA = nA; cB = nB; ++ui;
        if constexpr (ALIGN_EPI) { if (wr == 1) PG8_BAR; }
    }
    PG8_WAIT_V(0);
    if constexpr (!ALIGN_EPI) { if (wr == 0) PG8_BAR; }
    PG8_BAR;
#undef PG8_SA
#undef PG8_SB
#undef PG8_STAGE
#undef PG8_LDA
#undef PG8_LDB
#undef PG8_MMA
#undef PG8_WAIT_V
#undef PG8_WAIT_L
#undef PG8_BAR
#undef PG8_SCHED
}
}

struct KVSched {
    int c, G; const char* ws; size_t wsel;
    __device__ __forceinline__ bool next(int i, pg8::Unit& u) const {
        const int L = i * G + c; if (c < 0 || L >= 96) return false;
        const int kind = L >> 5, r = L & 31;
        if (kind < 2) { u.pm = kind * 16 + (r >> 2); u.pn = r & 3; } else { u.pm = 32 + (r >> 3); u.pn = r & 7; }
        return true;
    }
    __device__ __forceinline__ size_t offA(const pg8::Unit& u) const { const int kind = u.pm >> 4, pm = u.pm & 15; int k2 = (kind == 2); asm volatile("" : "+v"(k2));
        return (size_t)ws + WS_MEMB + (size_t)k2 * (WS_WV + wsel - WS_MEMB) + (size_t)pm * 256 * 1024 * 2; }
    __device__ __forceinline__ size_t offB(const pg8::Unit& u) const { const int kind = u.pm >> 4; int k1 = (kind == 1), k2 = (kind == 2); asm volatile("" : "+v"(k1), "+v"(k2));
        return (size_t)ws + WS_WK + wsel + (size_t)k1 * (WS_WV - WS_WK) + (size_t)k2 * (WS_MEMB - WS_WK - wsel) + (size_t)u.pn * 256 * 1024 * 2; }
};


#define XB_TMO      128
#define XB_XCNT(j)  (256  + 64 * (j))
#define XB_XSUB(j)  (1280 + 64 * (j))
#define XB_XGEN(j)  (2304 + 64 * (j))
#define XB_TOP      3328
#define XB_TOPGEN   3392
#define XCD_BAR_WORDS 3456
#define XB_SPIN_CAP (1u << 22)
__device__ __forceinline__ unsigned xb_ld(unsigned* p)              { return __hip_atomic_load(p, __ATOMIC_RELAXED, __HIP_MEMORY_SCOPE_AGENT); }
__device__ __forceinline__ unsigned xb_add(unsigned* p, unsigned v) { return __hip_atomic_fetch_add(p, v, __ATOMIC_RELAXED, __HIP_MEMORY_SCOPE_AGENT); }
__device__ __forceinline__ unsigned xb_xcc_id() { return (unsigned)__builtin_amdgcn_s_getreg((3 << 11) | 20) & 0xFu; }
#define XB_SPIN(cond, bar) do { unsigned _sp = 0; while (cond) { __builtin_amdgcn_s_sleep(1); \
    if ((++_sp & 255u) == 0u) { if (xb_ld(&(bar)[XB_TMO])) break; if (_sp > XB_SPIN_CAP) { atomicAdd(&(bar)[XB_TMO], 1u); break; } } } } while (0)
struct XcdBarrier { unsigned* bar; unsigned x; volatile LAS unsigned* st; };
__device__ __forceinline__ void xcd_barrier_complete(unsigned* bar, unsigned x, unsigned& nloc, unsigned& nx) {
    const unsigned G = gridDim.x * gridDim.y * gridDim.z;
    unsigned sum, cnt, mine, sp = 0u;
    for (;;) {
        sum = 0u; cnt = 0u; mine = 0u;
#pragma unroll
        for (unsigned j = 0; j < 16; ++j) { const unsigned c = xb_ld(&bar[XB_XCNT(j)]); sum += c; cnt += (c > 0u) ? 1u : 0u; mine = (j == x) ? c : mine; }
        if (sum == G) break;
        __builtin_amdgcn_s_sleep(1);
        if ((++sp & 255u) == 0u) { if (xb_ld(&bar[XB_TMO])) break; if (sp > XB_SPIN_CAP) { atomicAdd(&bar[XB_TMO], 1u); break; } }
    }
    nloc = mine > 0u ? mine : 1u; nx = cnt > 0u ? cnt : 1u;
}
__device__ __forceinline__ void xcd_barrier(const XcdBarrier& b) {
    asm volatile("s_waitcnt vmcnt(0)" ::: "memory");
    __syncthreads();
    if (threadIdx.x == 0) {
        unsigned* bar = b.bar;
        __builtin_amdgcn_s_waitcnt(0);
        unsigned nloc = b.st[0], nx = b.st[1];
        if (nloc == 0u) { xcd_barrier_complete(bar, b.x, nloc, nx); b.st[0] = nloc; b.st[1] = nx; }
        const unsigned old = xb_add(&bar[XB_XSUB(b.x)], 1u);
        const unsigned gen = old / nloc;
        if (old + 1u == (gen + 1u) * nloc) {
            __builtin_amdgcn_fence(__ATOMIC_RELEASE, "agent");
            asm volatile("s_waitcnt vmcnt(0)" ::: "memory");
            const unsigned og = xb_add(&bar[XB_TOP], 1u);
            const unsigned tg = og / nx;
            if (og + 1u == (tg + 1u) * nx) xb_add(&bar[XB_TOPGEN], 1u);
            else XB_SPIN(xb_ld(&bar[XB_TOPGEN]) == tg, bar);
            __builtin_amdgcn_fence(__ATOMIC_ACQUIRE, "agent");
            xb_add(&bar[XB_XGEN(b.x)], 1u);
            asm volatile("s_waitcnt vmcnt(0)" ::: "memory");
        } else {
            XB_SPIN(xb_ld(&bar[XB_XGEN(b.x)]) == gen, bar);
            __builtin_amdgcn_fence(__ATOMIC_ACQUIRE, "agent");
            asm volatile("s_waitcnt vmcnt(0)" ::: "memory");
        }
    }
    __syncthreads();
}


struct SG2 { const bf16_t* A; const bf16_t* Bt; int lda, ldb, K, N; bf16_t* O; int ldc; float scale; int mode; float* ssp; };
__device__ __forceinline__ float sq8(bf16x8 a) { float q = 0.f;
#pragma unroll
    for (int i = 0; i < 8; ++i) { const float f = bf2f((unsigned)(unsigned short)a[i]); q += f * f; } return q; }
__device__ __forceinline__ void sgemm2(LAS unsigned char* lds, const SG2 g, int ubase, int G, int wave, int tid) {
    const int lane = tid & 63, fr = lane & 15, fq = lane >> 4, rt = wave & 3, ch = wave >> 2;
    const int nunits = (g.N / 64) * 4, nsl = g.K / 64;
    int R, C; pg8::stage_rc(tid * 16, R, C);
    const unsigned offA = (unsigned)(R * g.lda + C) * 2u, offB = (unsigned)(R * g.ldb + C) * 2u;
    const int aoff = pg8::lds_byte(rt * 16 + fr, fq * 8), boff = pg8::lds_byte(ch * 32 + fr, fq * 8);
    for (int un = ubase; un >= 0 && un < nunits; un += G) {
        const int cgp = un >> 2, rg = un & 3;
        const char* gA = (const char*)(g.A + (size_t)rg * 64 * g.lda) + offA; const char* gB = (const char*)(g.Bt + (size_t)cgp * 64 * g.ldb) + offB;
#define SG2_STAGE(sl) do { LAS unsigned char* d_ = lds + ((sl) & 3) * 16384 + wave * 1024; \
        __builtin_amdgcn_global_load_lds((const unsigned*)(gA + (size_t)(sl) * 128), (LAS unsigned*)d_, 16, 0, 0); \
        __builtin_amdgcn_global_load_lds((const unsigned*)(gB + (size_t)(sl) * 128), (LAS unsigned*)(d_ + 8192), 16, 0, 0); } while (0)
        asm volatile("s_waitcnt vmcnt(0)" ::: "memory");
        SG2_STAGE(0); SG2_STAGE(1);
        f32x4 acc[2] = {(f32x4){0.f, 0.f, 0.f, 0.f}, (f32x4){0.f, 0.f, 0.f, 0.f}}; float q = 0.f;
        for (int sl = 0; sl < nsl; ++sl) {
            if (sl + 1 < nsl) asm volatile("s_waitcnt vmcnt(2)" ::: "memory"); else asm volatile("s_waitcnt vmcnt(0)" ::: "memory");
            __builtin_amdgcn_s_barrier(); asm volatile("" ::: "memory");
            if (sl + 2 < nsl) SG2_STAGE(sl + 2);
            LAS unsigned char* b_ = lds + (sl & 3) * 16384;
#pragma unroll
            for (int ks = 0; ks < 2; ++ks) {
                const bf16x8 a = *(const LAS bf16x8*)(b_ + aoff + ks * 1024);
#pragma unroll
                for (int c = 0; c < 2; ++c) { const bf16x8 b = *(const LAS bf16x8*)(b_ + 8192 + boff + c * 2048 + ks * 1024);
                    acc[c] = __builtin_amdgcn_mfma_f32_16x16x32_bf16(b, a, acc[c], 0, 0, 0); }
                if (g.mode == 1) q += sq8(a);
            }
        }
#undef SG2_STAGE
        const int row = rg * 64 + rt * 16 + fr, col = cgp * 64 + ch * 32 + fq * 4;
        bf16_t* op = g.O + (size_t)row * g.ldc + col;
        if (g.mode == 1) {
            q += shx(q, 16, lane); q += shx(q, 32, lane);
            const float sc = g.scale / sqrtf(q * (1.f / 1024.f) + EPS);
#pragma unroll
            for (int c = 0; c < 2; ++c) { const f32x4 v = acc[c] * sc; u32x2 w; w.x = cvt_pk_bf16(v[0], v[1]); w.y = cvt_pk_bf16(v[2], v[3]); *(u32x2*)(op + c * 16) = w; }
        } else {
            const u32x2 p0 = *(const u32x2*)op, p1 = *(const u32x2*)(op + 16); float qq = 0.f;
            { const float v0 = bflo(p0.x) + acc[0][0], v1 = bfhi(p0.x) + acc[0][1], v2 = bflo(p0.y) + acc[0][2], v3 = bfhi(p0.y) + acc[0][3];
              u32x2 w; w.x = cvt_pk_bf16(v0, v1); w.y = cvt_pk_bf16(v2, v3); *(u32x2*)op = w; qq += (v0 * v0 + v1 * v1) + (v2 * v2 + v3 * v3); }
            { const float v0 = bflo(p1.x) + acc[1][0], v1 = bfhi(p1.x) + acc[1][1], v2 = bflo(p1.y) + acc[1][2], v3 = bfhi(p1.y) + acc[1][3];
              u32x2 w; w.x = cvt_pk_bf16(v0, v1); w.y = cvt_pk_bf16(v2, v3); *(u32x2*)(op + 16) = w; qq += (v0 * v0 + v1 * v1) + (v2 * v2 + v3 * v3); }
            qq += shx(qq, 16, lane); qq += shx(qq, 32, lane);
            if (fq == 0) g.ssp[row * 32 + cgp * 2 + ch] = qq;
        }
        asm volatile("s_waitcnt vmcnt(0) lgkmcnt(0)" ::: "memory"); __builtin_amdgcn_s_barrier(); asm volatile("" ::: "memory");
    }
}

__device__ __forceinline__ void sgemm_act(LAS unsigned char* lds, const bf16_t* A, const bf16_t* Bt, bf16_t* Hs, const float* cfw, const float* scf, float* ocf, int ubase, int G, int wave, int tid) {
    const int lane = tid & 63, fr = lane & 15, fq = lane >> 4, rt = wave & 3, ch = wave >> 2;
    constexpr int nunits = (DFF / 64) * 4, nsl = D / 64, SLOT = 24576;
    int R, C; pg8::stage_rc(tid * 16, R, C);
    const unsigned off = (unsigned)(R * D + C) * 2u;
    const int aoff = pg8::lds_byte(rt * 16 + fr, fq * 8), boff = pg8::lds_byte(fr, fq * 8) + 8192 + ch * 8192;
    for (int un = ubase; un >= 0 && un < nunits; un += G) {
        const int fg = un >> 2, rg = un & 3, brow = ((fg >> 1) << 8) + ((fg & 1) << 6);
        const char* gA = (const char*)(A + (size_t)rg * 64 * D) + off; const char* gG = (const char*)(Bt + (size_t)brow * D) + off; const char* gU = (const char*)(Bt + (size_t)(brow + 128) * D) + off;
#define SGA_STAGE(sl) do { LAS unsigned char* d_ = lds + ((sl) & 3) * SLOT + wave * 1024; \
        __builtin_amdgcn_global_load_lds((const unsigned*)(gA + (size_t)(sl) * 128), (LAS unsigned*)d_, 16, 0, 0); \
        __builtin_amdgcn_global_load_lds((const unsigned*)(gG + (size_t)(sl) * 128), (LAS unsigned*)(d_ + 8192), 16, 0, 0); \
        __builtin_amdgcn_global_load_lds((const unsigned*)(gU + (size_t)(sl) * 128), (LAS unsigned*)(d_ + 16384), 16, 0, 0); } while (0)
        asm volatile("s_waitcnt vmcnt(0)" ::: "memory");
        SGA_STAGE(0); SGA_STAGE(1);
        f32x4 acc[4]; float q = 0.f;
#pragma unroll
        for (int c = 0; c < 4; ++c) acc[c] = (f32x4){0.f, 0.f, 0.f, 0.f};
        for (int sl = 0; sl < nsl; ++sl) {
            if (sl + 1 < nsl) asm volatile("s_waitcnt vmcnt(3)" ::: "memory"); else asm volatile("s_waitcnt vmcnt(0)" ::: "memory");
            __builtin_amdgcn_s_barrier(); asm volatile("" ::: "memory");
            if (sl + 2 < nsl) SGA_STAGE(sl + 2);
            LAS unsigned char* b_ = lds + (sl & 3) * SLOT;
#pragma unroll
            for (int ks = 0; ks < 2; ++ks) {
                const bf16x8 a = *(const LAS bf16x8*)(b_ + aoff + ks * 1024);
#pragma unroll
                for (int c = 0; c < 4; ++c) { const bf16x8 b = *(const LAS bf16x8*)(b_ + boff + c * 2048 + ks * 1024);
                    acc[c] = __builtin_amdgcn_mfma_f32_16x16x32_bf16(b, a, acc[c], 0, 0, 0); }
                q += sq8(a);
            }
        }
#undef SGA_STAGE
        q += shx(q, 16, lane); q += shx(q, 32, lane);
        const float rstd = 1.0f / sqrtf(q * (1.f / 1024.f) + EPS);
        asm volatile("s_waitcnt lgkmcnt(0)" ::: "memory"); __builtin_amdgcn_s_barrier(); asm volatile("" ::: "memory");
        LAS float* T = (LAS float*)(lds + ch * 20480);
#pragma unroll
        for (int c = 0; c < 4; ++c)
#pragma unroll
            for (int j = 0; j < 4; ++j) T[(rt * 16 + fr) * 65 + c * 16 + fq * 4 + j] = acc[c][j] * rstd;
        asm volatile("s_waitcnt lgkmcnt(0)" ::: "memory"); __builtin_amdgcn_s_barrier(); asm volatile("" ::: "memory");
        {
            const LAS float* Gt = (const LAS float*)lds; const LAS float* Ut = (const LAS float*)(lds + 20480);
            const int r = tid >> 3, f8 = (tid & 7) * 8, b = rg * 2 + (r >> 5), rr = r & 31, f = fg * 64 + f8;
            const float* st = scf + (size_t)(b * 2) * DFF + f;
            float hv[8], gv[8];
#pragma unroll
            for (int k = 0; k < 8; ++k) {
                const float g0 = Gt[r * 65 + f8 + k];
                const float gm1 = rr >= 1 ? Gt[(r - 1) * 65 + f8 + k] : st[DFF + k];
                const float gm2 = rr >= 2 ? Gt[(r - 2) * 65 + f8 + k] : (rr == 1 ? st[DFF + k] : st[k]);
                const float cv = cfw[f + k] * gm2 + cfw[DFF + f + k] * gm1 + cfw[2 * DFF + f + k] * g0;
                hv[k] = silu(cv) * Ut[r * 65 + f8 + k]; gv[k] = g0;
            }
            u32x4 w; w.x = pk2(hv[0], hv[1]); w.y = pk2(hv[2], hv[3]); w.z = pk2(hv[4], hv[5]); w.w = pk2(hv[6], hv[7]);
            *(u32x4*)(Hs + (size_t)(rg * 64 + r) * DFF + f) = w;
            if (rr >= 30) { float* o = ocf + ((size_t)b * 2 + (rr - 30)) * DFF + f; *(f32x4*)o = (f32x4){gv[0], gv[1], gv[2], gv[3]}; *(f32x4*)(o + 4) = (f32x4){gv[4], gv[5], gv[6], gv[7]}; }
        }
        asm volatile("s_waitcnt vmcnt(0) lgkmcnt(0)" ::: "memory"); __builtin_amdgcn_s_barrier(); asm volatile("" ::: "memory");
    }
}
__device__ __forceinline__ void sample_ss_reduce(const float* sss, float* ssq, int tid) {
    if (tid < 256) { const f32x4* p = (const f32x4*)(sss + tid * 32); float t = 0.f;
#pragma unroll
        for (int i = 0; i < 8; ++i) { const f32x4 v = p[i]; t += (v[0] + v[1]) + (v[2] + v[3]); }
        *(f32x4*)(ssq + (size_t)(MP + tid) * 4) = (f32x4){t, 0.f, 0.f, 0.f}; }
    asm volatile("s_waitcnt vmcnt(0)" ::: "memory"); __syncthreads();
}

__device__ __forceinline__ void transpose_item(const float* W, int K, int N, bf16_t* WT, LAS float* scr, int item, int lane, const float* gain = nullptr, int gu = 0) {
    const int nblk = N / 32, kb = item / nblk, nb = item % nblk, k0 = 64 * kb, n0 = 32 * nb;
    {
        f32x4 v[8];
#pragma unroll
        for (int i = 0; i < 8; ++i) v[i] = *(const f32x4*)(W + (size_t)(k0 + (lane >> 3) + 8 * i) * N + n0 + (lane & 7) * 4);
#pragma unroll
        for (int i = 0; i < 8; ++i) { const int kk = (lane >> 3) + 8 * i; f32x4 w = v[i]; if (gain) w = w * gain[k0 + kk];
            LAS float* d = scr + kk * 33 + (lane & 7) * 4; d[0] = w[0]; d[1] = w[1]; d[2] = w[2]; d[3] = w[3]; }
    }
    LDS_WAIT();
    const int c = lane & 7;
#pragma unroll
    for (int j = 0; j < 4; ++j) { const int n = (lane >> 3) + 8 * j; const LAS float* s = scr + (8 * c) * 33 + n;
        u32x4 o; o.x = pk2(s[0 * 33], s[1 * 33]); o.y = pk2(s[2 * 33], s[3 * 33]); o.z = pk2(s[4 * 33], s[5 * 33]); o.w = pk2(s[6 * 33], s[7 * 33]);
        int drow = n0 + n; if (gu) { const int up = drow >= gu, f = up ? drow - gu : drow; drow = ((f >> 7) << 8) + (up << 7) + (f & 127); }
        *(u32x4*)(WT + (size_t)drow * K + k0 + 8 * c) = o; }
    LDS_WAIT();
}

__device__ __forceinline__ void first_rows(const float* Xp, const float* Xs, bf16_t* XNo, float* ss, int gw, int NGW, int lane) {
    for (int m0 = gw; m0 < MT; m0 += 2 * NGW) {
        const int m1 = m0 + NGW; const bool two = m1 < MT; const int mb = two ? m1 : m0;
        const f32x4* xa = (const f32x4*)(m0 < MP ? Xp + (size_t)m0 * D : Xs + (size_t)(m0 - MP) * D) + lane;
        const f32x4* xb = (const f32x4*)(mb < MP ? Xp + (size_t)mb * D : Xs + (size_t)(mb - MP) * D) + lane;
        f32x4 va[4], vb[4]; float sa = 0.f, sb = 0.f;
#pragma unroll
        for (int j = 0; j < 4; ++j) { va[j] = xa[64 * j]; vb[j] = xb[64 * j]; }
#pragma unroll
        for (int j = 0; j < 4; ++j) { sa += (va[j].x * va[j].x + va[j].y * va[j].y) + (va[j].z * va[j].z + va[j].w * va[j].w); sb += (vb[j].x * vb[j].x + vb[j].y * vb[j].y) + (vb[j].z * vb[j].z + vb[j].w * vb[j].w); }
        sa = wave_sum(sa, lane); sb = wave_sum(sb, lane);
        if (lane < 4) { ss[(size_t)m0 * 4 + lane] = lane == 0 ? sa : 0.f; if (two) ss[(size_t)m1 * 4 + lane] = lane == 0 ? sb : 0.f; }
        u32x2* oa = (u32x2*)(XNo + (size_t)m0 * D) + lane; u32x2* ob = (u32x2*)(XNo + (size_t)mb * D) + lane;
#pragma unroll
        for (int j = 0; j < 4; ++j) { u32x2 w; w.x = pk2(va[j].x, va[j].y); w.y = pk2(va[j].z, va[j].w); oa[64 * j] = w; if (two) { w.x = pk2(vb[j].x, vb[j].y); w.y = pk2(vb[j].z, vb[j].w); ob[64 * j] = w; } }
    }
}

typedef __attribute__((address_space(4))) const unsigned char* kptr_t;
typedef const float* cfp_t; typedef float* fp_t; typedef unsigned char* ucp_t;
#define INP(k) (*(const __attribute__((address_space(4))) cfp_t*)(kp + 8 * (k)))
#define X out
#define WIN_T ((bf16_t*)(ws + WS_WIN + wsel))
#define WOUT_T ((bf16_t*)(ws + WS_WOUT + wsel))
#define WQ_T ((bf16_t*)(ws + WS_WQ + wsel))
#define WK_T ((bf16_t*)(ws + WS_WK + wsel))
#define WV_T ((bf16_t*)(ws + WS_WV + wsel))
#define WO_T ((bf16_t*)(ws + WS_WO + wsel))
#define WUP_T ((bf16_t*)(ws + WS_WUP + wsel))
#define WDN_T ((bf16_t*)(ws + WS_WDN + wsel))
#define MEMB ((bf16_t*)(ws + WS_MEMB))
#define KBP ((bf16_t*)(ws + WS_KBP))
#define VTP ((bf16_t*)(ws + WS_VTP))
#define KBS ((bf16_t*)(ws + WS_KBS + ksel))
#define VTS ((bf16_t*)(ws + WS_VTS + ksel))
#define WST ((bf16_t*)(ws + WS_WST + ksel))
#define AGG ((float*)(ws + WS_AGG))
#define SSQ(i) ((float*)(ws + WS_SSP) + (size_t)(i) * MT * 4)
#define SSS(i) ((float*)(ws + WS_SSS) + (size_t)(i) * 256 * 32)
#define GT_R ((bf16_t*)(ws + WS_GT + ksel))
#define GT_I ((bf16_t*)(ws + WS_GT + 65536 + ksel))
#define XN ((bf16_t*)(ws + WS_XN))
#define gZ ((bf16_t*)(ws + B_Z))
#define HLOC ((bf16_t*)(ws + B_HLOC))
#define PCUM ((bf16_t*)(ws + B_PCUM))
#define gY ((bf16_t*)(ws + B_Y))
#define gQ ((bf16_t*)(ws + B_Q))
#define gP ((bf16_t*)(ws + B_P))
#define gO ((bf16_t*)(ws + B_O))
#define PS ((bf16_t*)(ws + B_PS))
#define GU ((bf16_t*)(ws + B_GU))
#define GUS ((bf16_t*)(ws + B_GUS))
#define SBG ((float*)(ws + B_SBG))
#define SBU ((float*)(ws + B_SBU))
#define SBL ((float*)(ws + B_SBL))
__device__ __forceinline__ void convert_layer(kptr_t kp, unsigned char* ws, LAS unsigned char* lds, const int l, const int part, const int nparts, const int gw, const int NGW, const int gt, const int NGT, const int lane, const int wave) {
            const size_t wsel = (size_t)(l & 1) * WSEL1, ksel = (size_t)(l & 1) * KSEL1;
            LAS float* scr = (LAS float*)(lds + wave * 16384);
            const float* w_in = INP(I_WIN) + (size_t)l * D * INC; const float* w_out = INP(I_WOUT) + (size_t)l * D * D; const float* w_q = INP(I_WQ) + (size_t)l * D * D;
            const float* w_k = INP(I_WK) + (size_t)l * D * D; const float* w_v = INP(I_WV) + (size_t)l * D * D; const float* w_o = INP(I_WO) + (size_t)l * D * D;
            const float* w_up = INP(I_WUP) + (size_t)l * D * 2 * DFF; const float* w_dn = INP(I_WDN) + (size_t)l * DFF * D; const float* c_v = INP(I_CV) + (size_t)l * BS * NMEM * D;
            constexpr int T_IN = 16 * (INC / 32), T_SQ = 16 * 32, T_UP = 16 * (2 * DFF / 32), T_DN = (DFF / 64) * 32, T_CV = 32 * 32;
            constexpr int T_G = 16;
            constexpr int NIT = T_IN + 5 * T_SQ + T_UP + T_DN + T_CV + 2 * T_G;
            for (int it = (NIT * part) / nparts + gw; it < (NIT * (part + 1)) / nparts; it += NGW) {
                int r = it;
                if (r < T_IN) { transpose_item(w_in, D, INC, WIN_T, scr, r, lane, INP(I_GMIX) + l * D); continue; } r -= T_IN;
                if (r < T_SQ) { transpose_item(w_out, D, D, WOUT_T, scr, r, lane); continue; } r -= T_SQ;
                if (r < T_SQ) { transpose_item(w_q, D, D, WQ_T, scr, r, lane, INP(I_GX) + l * D); continue; } r -= T_SQ;
                if (r < T_SQ) { transpose_item(w_k, D, D, WK_T, scr, r, lane); continue; } r -= T_SQ;
                if (r < T_SQ) { transpose_item(w_v, D, D, WV_T, scr, r, lane); continue; } r -= T_SQ;
                if (r < T_SQ) { transpose_item(w_o, D, D, WO_T, scr, r, lane); continue; } r -= T_SQ;
                if (r < T_UP) { transpose_item(w_up, D, 2 * DFF, WUP_T, scr, r, lane, INP(I_GFFN) + l * D, DFF); continue; } r -= T_UP;
                if (r < T_DN) { transpose_item(w_dn, DFF, D, WDN_T, scr, r, lane); continue; } r -= T_DN;
                if (r < T_CV) { transpose_item(c_v, BS * NMEM, D, VTS, scr, r, lane); continue; } r -= T_CV;
                if (r < T_G) { transpose_item(INP(I_WRG) + ((size_t)l * 8 + (r >> 1)) * 4096, 64, 64, GT_R + (r >> 1) * 4096, scr, r & 1, lane); continue; } r -= T_G;
                transpose_item(INP(I_WIG) + ((size_t)l * 8 + (r >> 1)) * 4096, 64, 64, GT_I + (r >> 1) * 4096, scr, r & 1, lane);
            }
            if (part == 0) {
                const f32x4* ck = (const f32x4*)(INP(I_CK) + (size_t)l * BS * NMEM * D); u32x2* dk = (u32x2*)KBS;
                for (int i = gt; i < BS * NMEM * D / 4; i += NGT) { const f32x4 v = ck[i]; u32x2 w; w.x = pk2(v.x, v.y); w.y = pk2(v.z, v.w); dk[i] = w; }
                if (l == 0) { const f32x4* mm = (const f32x4*)INP(I_MEM); u32x2* dm = (u32x2*)MEMB;
                    for (int i = gt; i < BP * NMEM * D / 4; i += NGT) { const f32x4 v = mm[i]; u32x2 w; w.x = pk2(v.x, v.y); w.y = pk2(v.z, v.w); dm[i] = w; } }
                const float* wsl = INP(I_WS) + (size_t)l * 4 * 128 * 128;
                for (int i = gt; i < 4 * 128 * 128; i += NGT) { const int s = i & 127, t = (i >> 7) & 127; WST[i] = (bf16_t)f2bf(s <= t ? wsl[i] : 0.f); }
            }
}

__global__ void __launch_bounds__(NTHREADS, 2) trunk_fwd(Args args) {
    extern __shared__ __attribute__((aligned(16))) unsigned char lds_raw[];
    LAS unsigned char* lds = (LAS unsigned char*)lds_raw;
    cg::grid_group grid = cg::this_grid();
    const int wave_s = __builtin_amdgcn_readfirstlane(threadIdx.x >> 6);
#define LANE_STATE() int G = gridDim.x, bid = blockIdx.x; asm volatile("" : "+s"(G), "+s"(bid)); const int NGW = G * NWAVES, NGT = G * NTHREADS; (void)NGW; (void)NGT; \
    const int tid = opaque_tid(wave_s), lane = tid & 63, wave = wave_s; const int gw = bid * NWAVES + wave; const int gt = bid * NTHREADS + tid; (void)lane; (void)gw; (void)gt; \
    kptr_t kp = (kptr_t)__builtin_amdgcn_kernarg_segment_ptr(); asm volatile("" : "+s"(kp)); \
    float* const out = *(const __attribute__((address_space(4))) fp_t*)(kp + 8 * N_IN); unsigned char* const ws = *(const __attribute__((address_space(4))) ucp_t*)(kp + 8 * N_IN + 8); (void)out; (void)ws
    {
        LANE_STATE();
        if (bid == 0) for (int i = tid; i < XCD_BAR_WORDS; i += NTHREADS) __hip_atomic_store((unsigned*)(ws + WS_BAR) + i, 0u, __ATOMIC_RELAXED, __HIP_MEMORY_SCOPE_AGENT);
        if (tid < 32) ((LAS unsigned*)(lds + LDS_MISC))[tid] = 0u;
        __threadfence();
        grid.sync();
        if (tid == 0) (void)xb_add((unsigned*)(ws + WS_BAR) + XB_XCNT(xb_xcc_id()), 1u);
    }
#define GRID_SYNC() do { kptr_t kp_ = (kptr_t)__builtin_amdgcn_kernarg_segment_ptr(); asm volatile("" : "+s"(kp_)); \
        XcdBarrier b_; b_.bar = (unsigned*)(*(const __attribute__((address_space(4))) ucp_t*)(kp_ + 8 * N_IN + 8) + WS_BAR); b_.x = xb_xcc_id(); b_.st = (volatile LAS unsigned*)(lds + LDS_MISC); \
        xcd_barrier(b_); if (PROBE == 3) xcd_barrier(b_); } while (0)

    for (int l = 0; l < DEPTH; ++l) {
        const size_t wsel = (size_t)(l & 1) * WSEL1, ksel = (size_t)(l & 1) * KSEL1;
        if (l == 0)
        for (int dup0 = 0; dup0 < ((PROBE == 1 || PROBE == 5) ? 2 : 1); ++dup0) {
        {
            LANE_STATE();
            convert_layer(kp, ws, lds, l, 0, 1, gw, NGW, gt, NGT, lane, wave);
            if (l == 0) first_rows(INP(I_XP), INP(I_XS), XN, SSQ(0), gw, NGW, lane);
        }
        GRID_SYNC();
        }
        {
            LANE_STATE();
            KVSched S; S.G = G; S.c = bid >= 160 ? bid - 160 : -1; S.ws = (const char*)ws; S.wsel = wsel;
            pg8::Gemm g{(const bf16_t*)nullptr, (const bf16_t*)nullptr, D, D, D};
            pg8::EpiKV E{out + O_MKP + (size_t)l * BP * NMEM * D, out + O_MVP + (size_t)l * BP * NMEM * D, KBP, VTP};
            pg8::gemm_phase<pg8::EpiKV, KVSched, true>(lds, g, S, E, wave_s);
        }
#define GEMM_BF16(s_) do { const int s = (s_); pg8::GSched S; pg8::Gemm g; pg8::EpiBf16 E; E.scale = 1.f; E.ss = nullptr; E.smp = 0; \
        if (s == 0) { S.init(MT / 256, INC / 256, G, bid); S.aPm = (size_t)256 * D * 2; S.bPn = (size_t)256 * D * 2; g = pg8::Gemm{XN, WIN_T, D, D, D}; E.O = gZ; E.ldc = INC; E.ss = SSQ(3 * l); } \
        else if (s == 1) { S.init(MP / 256, D / 256, G, bid); S.aPm = (size_t)256 * D * 2; S.bPn = (size_t)256 * D * 2; g = pg8::Gemm{XN, WQ_T, D, D, D}; E.O = gQ; E.ldc = D; E.scale = 0.0625f; E.ss = SSQ(3 * l + 1); } \
        else if (s == 2) { S.init(MP / 256, 4, G, bid); S.aPm = (size_t)256 * D * 2; S.aPn = 512; S.bPn = (size_t)256 * 2048 * 2; S.bPm = 512; S.bShift = 4; g = pg8::Gemm{gP, VTP, D, 2048, 256}; E.O = gO; E.ldc = D; } \
        else { S.init(1, 32, G, (bid + G - 64) % G); S.mode = 2; g = pg8::Gemm{PS, VTS, 8192, 2048, 256}; E.O = gO + (size_t)MP * D; E.ldc = D; E.smp = 1; } \
        pg8::gemm_phase<pg8::EpiBf16, pg8::GSched, true>(lds, g, S, E, wave_s); } while (0)
#define GEMM_RES(s_) do { const int s = (s_); pg8::GSched S; S.init(MP / 256, D / 256, G, bid); pg8::Gemm g; \
        if (s == 0) { g = pg8::Gemm{gY, WOUT_T, D, D, D}; S.aPm = (size_t)256 * D * 2; } \
        else if (s == 1) { g = pg8::Gemm{gO, WO_T, D, D, D}; S.aPm = (size_t)256 * D * 2; } \
        else { g = pg8::Gemm{GU, WDN_T, DFF, DFF, DFF}; S.aPm = (size_t)256 * DFF * 2; } \
        S.bPn = (size_t)256 * g.ldb * 2; \
        pg8::EpiResid E{XN, SSQ(3 * l + 1 + s)}; \
        pg8::gemm_phase<pg8::EpiResid, pg8::GSched, true>(lds, g, S, E, wave_s); } while (0)

        for (int rep = 0; rep < 13; ++rep) { if (rep == 4 || rep == 9 || rep == 11) continue;
          const int ndup = ((PROBE == 1 && (rep == 1 || rep == 2)) || (PROBE == 4 && rep == 1) || (PROBE == 6 && rep == 2)) ? 2 : ((PROBE == 2 && (rep == 0 || rep == 5 || rep == 6 || rep == 7 || rep == 10)) ? 2 : 1);
          for (int dup = 0; dup < ndup; ++dup) {
            if (rep == 0 || rep == 5 || rep == 7) {
                LANE_STATE();
                const int s0 = rep == 0 ? 0 : (rep == 5 ? 1 : 2), ns = rep == 7 ? 2 : 1;
                if (rep == 0 && l > 0) {
                    pg8::GSched S0; S0.init(MT / 256, INC / 256, G, bid); pg8::Unit u0; bool own = false;
                    for (int i = 0; S0.next(i, u0); ++i) own = own || (u0.pm == 128);
                    if (own) sample_ss_reduce(SSS(3 * l), SSQ(3 * l), tid);
                }
                for (int q = 0; q < ns; ++q) GEMM_BF16(s0 + q);
                if (rep == 5) { LANE_STATE(); const SG2 sg{XN + (size_t)MP * D, WQ_T, D, D, D, D, gQ + (size_t)MP * D, D, 0.0625f, 1, nullptr}; sgemm2(lds, sg, bid, G, wave, tid); }
                if (rep == 5 && l + 1 < DEPTH) { LANE_STATE(); if (bid >= 64) convert_layer(kp, ws, lds, l + 1, 1, 3, gw - 64 * NWAVES, NGW - 64 * NWAVES, gt - 64 * NTHREADS, NGT - 64 * NTHREADS, lane, wave); }
            } else if (rep == 10) {
                LANE_STATE();
                pg8::GSched S; S.init(MP / 256, 2 * DFF / 256, G, bid); S.aPm = (size_t)256 * D * 2; S.bPn = (size_t)256 * D * 2;
                const pg8::Gemm g{XN, WUP_T, D, D, D};
                const pg8::EpiAct E{GU, INP(I_SCF) + (size_t)l * BS * 2 * DFF, out + O_CFS + (size_t)l * BS * 2 * DFF, SBG, SBU, SBL, INP(I_CFW) + (size_t)l * 3 * DFF, SSQ(3 * l + 2)};
                pg8::gemm_phase<pg8::EpiAct, pg8::GSched, true>(lds, g, S, E, wave_s);
                { LANE_STATE(); sgemm_act(lds, XN + (size_t)MP * D, WUP_T, GU + (size_t)MP * DFF, INP(I_CFW) + (size_t)l * 3 * DFF, INP(I_SCF) + (size_t)l * BS * 2 * DFF, out + O_CFS + (size_t)l * BS * 2 * DFF, bid, G, wave, tid); }
            } else if (rep == 1) {
                LANE_STATE();
                {
                    LAS bf16_t* vT = (LAS bf16_t*)lds;
                    constexpr int VP = 136;
                    const float* gvp = INP(I_GV) + l * CW; const float* bsp = INP(I_BSS) + l * 4 * 128;
                    for (int un = (bid + G / 2) % G; un < 8 + 256; un += G) {
                        int rowbase, nrows, sb = -1;
                        if (un < 8) { sb = un; rowbase = MP + un * TS; nrows = TS; } else { rowbase = (un - 8) * 128; nrows = 128; }
                        {
                            const int rl = tid >> 5, cgp = tid & 31;
                            f32x4 g0 = *(const f32x4*)(gvp + cgp * 8), g1 = *(const f32x4*)(gvp + cgp * 8 + 4);
                            for (int p = 0; p < nrows / 16; ++p) {
                                const int r = p * 16 + rl;
                                const u32x4 raw = *(const u32x4*)(gZ + (size_t)(rowbase + r) * INC + Z_VC + cgp * 8);
                                float v[8] = {bflo(raw.x), bfhi(raw.x), bflo(raw.y), bfhi(raw.y), bflo(raw.z), bfhi(raw.z), bflo(raw.w), bfhi(raw.w)};
                                float ss = 0.f;
#pragma unroll
                                for (int k = 0; k < 8; ++k) { v[k] = gelu_t(v[k]); ss += v[k] * v[k]; }
                                ss += shx(ss, 1, lane); ss += shx(ss, 2, lane); ss += shx(ss, 4, lane);
                                const float rstd = __builtin_amdgcn_rsqf(ss * (1.f / 64.f) + EPS);
                                const float gg[8] = {g0.x, g0.y, g0.z, g0.w, g1.x, g1.y, g1.z, g1.w};
#pragma unroll
                                for (int k = 0; k < 8; ++k) { v[k] = v[k] * rstd * gg[k]; vT[(cgp * 8 + k) * VP + r] = (bf16_t)f2bf(v[k]); }
                                if (sb >= 0) { float* vo = out + O_VCS + ((size_t)(l * BS + sb) * TS + r) * CW + cgp * 8;
                                    *(f32x4*)vo = (f32x4){v[0], v[1], v[2], v[3]}; *(f32x4*)(vo + 4) = (f32x4){v[4], v[5], v[6], v[7]}; }
                            }
                        }
                        __syncthreads();
                        {
                            const int hh = wave & 3, rh = wave >> 2, fr = lane & 15, fq = lane >> 4;
                            const int nmt = nrows == 128 ? 4 : (rh == 0 ? 2 : 0);
                            for (int mi = 0; mi < nmt; ++mi) {
                                const int mt = rh * 4 + mi, nks = (mt * 16 + 15) / 32 + 1;
                                f32x4 acc[4];
#pragma unroll
                                for (int n = 0; n < 4; ++n) acc[n] = (f32x4){0.f, 0.f, 0.f, 0.f};
                                for (int ks = 0; ks < nks; ++ks) {
                                    const bf16x8 a = *(const bf16x8*)(WST + ((size_t)(hh * 128 + mt * 16 + fr) * 128 + ks * 32 + fq * 8));
#pragma unroll
                                    for (int n = 0; n < 4; ++n) { const bf16x8 b = *(const LAS bf16x8*)(vT + (hh * 64 + n * 16 + fr) * VP + ks * 32 + fq * 8);
                                        acc[n] = __builtin_amdgcn_mfma_f32_16x16x32_bf16(b, a, acc[n], 0, 0, 0); }
                                }
                                { const int t = mt * 16 + fr; const float bias = bsp[hh * 128 + t]; const size_t row = (size_t)(rowbase + t);
#pragma unroll
                                    for (int n = 0; n < 4; ++n) { const int c = hh * 64 + n * 16 + fq * 4; const u32x2 uq = *(const u32x2*)(gZ + row * INC + Z_UC + c);
                                        u32x2 w; w.x = pk2(gelu_t(bflo(uq.x)) * (acc[n][0] + bias), gelu_t(bfhi(uq.x)) * (acc[n][1] + bias)); w.y = pk2(gelu_t(bflo(uq.y)) * (acc[n][2] + bias), gelu_t(bfhi(uq.y)) * (acc[n][3] + bias));
                                        *(u32x2*)(gY + row * D + 768 + c) = w; } }
                            }
                        }
                        __syncthreads();
                    }
                }
                {
                    LAS unsigned char* wl = lds + wave * 16384;
                    LAS bf16_t* tile = (LAS bf16_t*)wl;
                    LAS float* pre_r = (LAS float*)(wl + 2560);
                    LAS float* pre_i = (LAS float*)(wl + 2560 + 4096);
                    LAS float* xcf = (LAS float*)(wl + 2560 + 8192);
                    const int fr = lane & 15, fq = lane >> 4;
                    for (int un = gw; un < 64 + 2048; un += NGW) {
                        int b, hd, rowbase, nrows, t0; bool smp = un < 64;
                        if (smp) { b = un >> 3; hd = un & 7; rowbase = MP + b * TS; nrows = TS; t0 = 0; }
                        else { const int v = un - 64; const int ch = v & 31; hd = (v >> 5) & 7; b = v >> 8; t0 = ch * 128; rowbase = b * SEQ + t0; nrows = 128; }
                        const int cidx = l * AW + hd * 64 + lane;
                        const float br = INP(I_BRG)[cidx], bi = INP(I_BIG)[cidx];
                        const float c8sp = 8.0f * log1pf(__expf(-INP(I_LAM)[cidx]));
                        const float* caw = INP(I_CAW) + (size_t)l * 4 * AW + hd * 64 + lane;
                        const float cw0 = caw[0], cw1 = caw[AW], cw2 = caw[2 * AW], cw3 = caw[3 * AW], cb = INP(I_CAB)[cidx];
                        bf16x8 bR[4][2], bI[4][2];
#pragma unroll
                        for (int n = 0; n < 4; ++n)
#pragma unroll
                            for (int ks = 0; ks < 2; ++ks) { const size_t o_ = (size_t)(hd * 64 + n * 16 + fr) * 64 + ks * 32 + fq * 8;
                                bR[n][ks] = *(const bf16x8*)(GT_R + o_); bI[n][ks] = *(const bf16x8*)(GT_I + o_); }
                        float xm3 = 0.f, xm2 = 0.f, xm1 = 0.f;
                        if (smp) { const float* st = INP(I_SCA) + ((size_t)(l * BS + b) * 3) * AW + hd * 64 + lane; xm3 = st[0]; xm2 = st[AW]; xm1 = st[2 * AW]; }
                        else if (t0 > 0) { const bf16_t* zp = gZ + (size_t)(rowbase - 3) * INC + Z_XA + hd * 64 + lane; xm3 = bf2f(zp[0]); xm2 = bf2f(zp[INC]); xm1 = bf2f(zp[2 * INC]); }
                        float h = 0.f, pc = 1.f;
                        const bf16_t* zq = gZ + (size_t)(rowbase + (lane >> 3)) * INC + Z_XA + hd * 64 + (lane & 7) * 8;
                        unsigned* hp = (unsigned*)(HLOC + (size_t)rowbase * AW + hd * 64 + (lane & ~1)); unsigned* pp = (unsigned*)(PCUM + (size_t)rowbase * AW + hd * 64 + (lane & ~1));
                        LAS bf16_t* xraw = (LAS bf16_t*)pre_r;
                        u32x4 xn0 = *(const u32x4*)zq, xn1 = *(const u32x4*)(zq + (size_t)8 * INC);
                        for (int st = 0; st < nrows / 16; ++st) {
                            *(LAS u32x4*)(xraw + (lane >> 3) * 64 + (lane & 7) * 8) = xn0; *(LAS u32x4*)(xraw + ((lane >> 3) + 8) * 64 + (lane & 7) * 8) = xn1;
                            zq += (size_t)16 * INC;
                            if (st + 1 < nrows / 16) { xn0 = *(const u32x4*)zq; xn1 = *(const u32x4*)(zq + (size_t)8 * INC); }
                            LDS_WAIT();
#pragma unroll
                            for (int i = 0; i < 16; ++i) { const float xv = bf2f(xraw[i * 64 + lane]);
                                const float xc = cw0 * xm3 + cw1 * xm2 + cw2 * xm1 + cw3 * xv + cb; xm3 = xm2; xm2 = xm1; xm1 = xv; xcf[i * 64 + lane] = xc; tile[i * 72 + lane] = (bf16_t)f2bf(xc); }
                            LDS_WAIT();
                            const bf16x8 a0 = *(const LAS bf16x8*)(tile + fr * 72 + fq * 8), a1 = *(const LAS bf16x8*)(tile + fr * 72 + 32 + fq * 8);
#pragma unroll
                            for (int n = 0; n < 4; ++n) {
                                f32x4 ar = (f32x4){0.f, 0.f, 0.f, 0.f}, ai = (f32x4){0.f, 0.f, 0.f, 0.f};
                                ar = __builtin_amdgcn_mfma_f32_16x16x32_bf16(a0, bR[n][0], ar, 0, 0, 0); ar = __builtin_amdgcn_mfma_f32_16x16x32_bf16(a1, bR[n][1], ar, 0, 0, 0);
                                ai = __builtin_amdgcn_mfma_f32_16x16x32_bf16(a0, bI[n][0], ai, 0, 0, 0); ai = __builtin_amdgcn_mfma_f32_16x16x32_bf16(a1, bI[n][1], ai, 0, 0, 0);
#pragma unroll
                                for (int j = 0; j < 4; ++j) { pre_r[(fq * 4 + j) * 64 + n * 16 + fr] = ar[j]; pre_i[(fq * 4 + j) * 64 + n * 16 + fr] = ai[j]; }
                            }
                            LDS_WAIT();
#pragma unroll 4
                            for (int i = 0; i < 16; ++i) {
                                const float r = sigm(pre_r[i * 64 + lane] + br), gi = sigm(pre_i[i * 64 + lane] + bi);
                                const float la = -c8sp * r; float a, om;
                                if (la > -0.125f) { const float x = 2.0f * la; om = -x * (1.0f + x * (0.5f + x * (0.16666667f + x * (0.041666668f + x * (0.0083333338f + x * 0.0013888889f))))); a = 1.0f + la * (1.0f + la * (0.5f + la * (0.16666667f + la * (0.041666668f + la * 0.0083333338f)))); }
                                else { a = __expf(la); om = -expm1f(2.0f * la); }
                                const float bm = __builtin_amdgcn_sqrtf(om);
                                h = a * h + bm * gi * xcf[i * 64 + lane]; pc = pc * a;
                                { const float hn = __builtin_bit_cast(float, __builtin_amdgcn_mov_dpp(__builtin_bit_cast(int, h), 0xB1, 0xf, 0xf, true)), pn = __builtin_bit_cast(float, __builtin_amdgcn_mov_dpp(__builtin_bit_cast(int, pc), 0xB1, 0xf, 0xf, true));
                                  if ((lane & 1) == 0) { *hp = pk2(h, hn); *pp = pk2(pc, pn); } hp += AW / 2; pp += AW / 2; }
                            }
                            LDS_WAIT();
                        }
                        AGG[(size_t)un * 128 + lane] = pc; AGG[(size_t)un * 128 + 64 + lane] = h;
                    }
                }
                {
                    const float* cbw = INP(I_CBW) + (size_t)l * 3 * BW;
                    for (int it = gt; it < (MT / 8) * 32; it += NGT) {
                        const int rb = it >> 5, c0 = (it & 31) * 8;
                        int b, t0, T, rowbase; const bool smp = rb >= MP / 8;
                        if (!smp) { b = rb >> 9; t0 = (rb & 511) * 8; T = SEQ; rowbase = rb * 8; } else { const int sbk = rb - MP / 8; b = sbk >> 2; t0 = (sbk & 3) * 8; T = TS; rowbase = MP + sbk * 8; }
                        u32x4 xq[10], cq[10], bq[8];
                        const bf16_t* zr = gZ + (size_t)rowbase * INC + c0;
#pragma unroll
                        for (int i = 0; i < 10; ++i) { if (i >= 2 || t0 > 0) { xq[i] = *(const u32x4*)(zr + (ptrdiff_t)(i - 2) * INC + Z_XB); cq[i] = *(const u32x4*)(zr + (ptrdiff_t)(i - 2) * INC + Z_GC); } else { xq[i] = (u32x4){0u, 0u, 0u, 0u}; cq[i] = (u32x4){0u, 0u, 0u, 0u}; } }
#pragma unroll
                        for (int i = 0; i < 8; ++i) bq[i] = *(const u32x4*)(zr + (size_t)i * INC + Z_GB);
                        float w0[8], w1[8], w2[8], pm2[8], pm1[8];
#pragma unroll
                        for (int k = 0; k < 8; ++k) { w0[k] = cbw[c0 + k]; w1[k] = cbw[BW + c0 + k]; w2[k] = cbw[2 * BW + c0 + k]; }
                        {
                            const float a_[8] = {bflo(xq[0].x) * bflo(cq[0].x), bfhi(xq[0].x) * bfhi(cq[0].x), bflo(xq[0].y) * bflo(cq[0].y), bfhi(xq[0].y) * bfhi(cq[0].y), bflo(xq[0].z) * bflo(cq[0].z), bfhi(xq[0].z) * bfhi(cq[0].z), bflo(xq[0].w) * bflo(cq[0].w), bfhi(xq[0].w) * bfhi(cq[0].w)};
                            const float b_[8] = {bflo(xq[1].x) * bflo(cq[1].x), bfhi(xq[1].x) * bfhi(cq[1].x), bflo(xq[1].y) * bflo(cq[1].y), bfhi(xq[1].y) * bfhi(cq[1].y), bflo(xq[1].z) * bflo(cq[1].z), bfhi(xq[1].z) * bfhi(cq[1].z), bflo(xq[1].w) * bflo(cq[1].w), bfhi(xq[1].w) * bfhi(cq[1].w)};
#pragma unroll
                            for (int k = 0; k < 8; ++k) { pm2[k] = a_[k]; pm1[k] = b_[k]; }
                        }
                        if (t0 == 0 && smp) { const float* st = INP(I_SCB) + ((size_t)(l * BS + b) * 2) * BW + c0;
#pragma unroll
                            for (int k = 0; k < 8; ++k) { pm2[k] = st[k]; pm1[k] = st[BW + k]; } }
#pragma unroll
                        for (int i = 0; i < 8; ++i) {
                            const u32x4 xb = xq[i + 2], gc = cq[i + 2], gb = bq[i];
                            const float pv[8] = {bflo(xb.x) * bflo(gc.x), bfhi(xb.x) * bfhi(gc.x), bflo(xb.y) * bflo(gc.y), bfhi(xb.y) * bfhi(gc.y), bflo(xb.z) * bflo(gc.z), bfhi(xb.z) * bfhi(gc.z), bflo(xb.w) * bflo(gc.w), bfhi(xb.w) * bfhi(gc.w)};
                            const float gbv[8] = {bflo(gb.x), bfhi(gb.x), bflo(gb.y), bfhi(gb.y), bflo(gb.z), bfhi(gb.z), bflo(gb.w), bfhi(gb.w)};
                            float yv[8];
#pragma unroll
                            for (int k = 0; k < 8; ++k) { yv[k] = gbv[k] * (w0[k] * pm2[k] + w1[k] * pm1[k] + w2[k] * pv[k]); pm2[k] = pm1[k]; pm1[k] = pv[k]; }
                            u32x4 w; w.x = pk2(yv[0], yv[1]); w.y = pk2(yv[2], yv[3]); w.z = pk2(yv[4], yv[5]); w.w = pk2(yv[6], yv[7]);
                            *(u32x4*)(gY + (size_t)(rowbase + i) * D + 512 + c0) = w;
                        }
                        if (t0 + 8 == T) { float* o = out + (smp ? O_CBS : O_CBP) + ((size_t)(l * 8 + b) * 2) * BW + c0;
#pragma unroll
                            for (int k = 0; k < 8; ++k) { o[k] = pm2[k]; o[BW + k] = pm1[k]; } }
                    }
                }
            } else if (rep == 2) {
                LANE_STATE();
                {
                    LAS float* cr = (LAS float*)lds;
                    for (int un = bid; un < 8 + 256; un += G) {
                        int b, ch, rowbase, nrows; const bool smp = un < 8;
                        if (smp) { b = un; ch = 0; rowbase = MP + b * TS; nrows = TS; } else { const int v = un - 8; b = v >> 5; ch = v & 31; rowbase = b * SEQ + ch * 128; nrows = 128; }
                        {
                            const int c = tid, hd = c >> 6, ln = c & 63; float carry = 0.f;
                            if (smp) carry = INP(I_SHA)[(size_t)(l * BS + b) * AW + c];
                            else { const float* ag = AGG + (size_t)(64 + (b << 8) + (hd << 5)) * 128 + ln; for (int k = 0; k < ch; ++k) carry = ag[(size_t)k * 128] * carry + ag[(size_t)k * 128 + 64]; }
                            cr[c] = carry;
                        }
                        __syncthreads();
                        const int c0 = (tid & 63) * 8, rsub = tid >> 6;
                        const f32x4 ca = *(const LAS f32x4*)(cr + c0), cb = *(const LAS f32x4*)(cr + c0 + 4);
                        for (int p = 0; p < nrows / 8; ++p) {
                            const int rloc = p * 8 + rsub; const size_t row = (size_t)(rowbase + rloc);
                            const u32x4 hq = *(const u32x4*)(HLOC + row * AW + c0), pq = *(const u32x4*)(PCUM + row * AW + c0);
                            const f32x4 h0 = (f32x4){bflo(hq.x), bfhi(hq.x), bflo(hq.y), bfhi(hq.y)}, h1 = (f32x4){bflo(hq.z), bfhi(hq.z), bflo(hq.w), bfhi(hq.w)}, p0 = (f32x4){bflo(pq.x), bfhi(pq.x), bflo(pq.y), bfhi(pq.y)}, p1 = (f32x4){bflo(pq.z), bfhi(pq.z), bflo(pq.w), bfhi(pq.w)};
                            const u32x4 gq = *(const u32x4*)(gZ + row * INC + Z_GA + c0);
                            const f32x4 a0 = h0 + p0 * ca, a1 = h1 + p1 * cb;
                            u32x4 w; w.x = pk2(gelu_t(bflo(gq.x)) * a0[0], gelu_t(bfhi(gq.x)) * a0[1]); w.y = pk2(gelu_t(bflo(gq.y)) * a0[2], gelu_t(bfhi(gq.y)) * a0[3]);
                            w.z = pk2(gelu_t(bflo(gq.z)) * a1[0], gelu_t(bfhi(gq.z)) * a1[1]); w.w = pk2(gelu_t(bflo(gq.w)) * a1[2], gelu_t(bfhi(gq.w)) * a1[3]);
                            *(u32x4*)(gY + row * D + c0) = w;
                            if ((smp || ch == 31) && rloc == nrows - 1) { float* o = out + (smp ? O_HAS : O_HAP) + (size_t)(l * 8 + b) * AW + c0; *(f32x4*)o = a0; *(f32x4*)(o + 4) = a1; }
                        }
                        if ((smp || ch == 31) && tid < 192) {
                            const int k = tid >> 6; const u32x4 xq = *(const u32x4*)(gZ + (size_t)(rowbase + nrows - 3 + k) * INC + Z_XA + c0);
                            float* o = out + (smp ? O_CAS : O_CAP) + ((size_t)(l * 8 + b) * 3 + k) * AW + c0;
                            *(f32x4*)o = (f32x4){bflo(xq.x), bfhi(xq.x), bflo(xq.y), bfhi(xq.y)}; *(f32x4*)(o + 4) = (f32x4){bflo(xq.z), bfhi(xq.z), bflo(xq.w), bfhi(xq.w)};
                        }
                        __syncthreads();
                    }
                }
            } else if (rep == 3 || rep == 8 || rep == 12) {
                LANE_STATE();
                if (rep == 12) {
                    const float* cfw = INP(I_CFW) + (size_t)l * 3 * DFF;
                    pg8::GSched S0; S0.init(MP / 256, D / 256, G, bid); pg8::Unit u0;
                    for (int i = 0; S0.next(i, u0); ++i) {
                        const int pm = u0.pm; if (pm >= 128 || tid >= DFF / 8) continue;
                        const int c0 = tid * 8, b = pm >> 4;
                        float w0[8], w1[8], w2[8], p2[8], p1[8], g0[8], g1[8], u0_[8], u1_[8];
#pragma unroll
                        for (int k = 0; k < 8; ++k) { w0[k] = cfw[c0 + k]; w1[k] = cfw[DFF + c0 + k]; w2[k] = cfw[2 * DFF + c0 + k]; p2[k] = 0.f; p1[k] = 0.f; }
                        if ((pm & 15) != 0) {
#pragma unroll
                            for (int k = 0; k < 8; ++k) { p2[k] = SBL[((size_t)(pm - 1) * 2 + 0) * DFF + c0 + k]; p1[k] = SBL[((size_t)(pm - 1) * 2 + 1) * DFF + c0 + k]; } }
#pragma unroll
                        for (int k = 0; k < 8; ++k) { g0[k] = SBG[((size_t)pm * 2 + 0) * DFF + c0 + k]; g1[k] = SBG[((size_t)pm * 2 + 1) * DFF + c0 + k]; u0_[k] = SBU[((size_t)pm * 2 + 0) * DFF + c0 + k]; u1_[k] = SBU[((size_t)pm * 2 + 1) * DFF + c0 + k]; }
                        float ha[8], hb[8];
#pragma unroll
                        for (int k = 0; k < 8; ++k) { ha[k] = silu(w0[k] * p2[k] + w1[k] * p1[k] + w2[k] * g0[k]) * u0_[k]; hb[k] = silu(w0[k] * p1[k] + w1[k] * g0[k] + w2[k] * g1[k]) * u1_[k]; }
                        u32x4 w; w.x = pk2(ha[0], ha[1]); w.y = pk2(ha[2], ha[3]); w.z = pk2(ha[4], ha[5]); w.w = pk2(ha[6], ha[7]);
                        *(u32x4*)(GU + (size_t)(pm * 256) * DFF + c0) = w;
                        w.x = pk2(hb[0], hb[1]); w.y = pk2(hb[2], hb[3]); w.z = pk2(hb[4], hb[5]); w.w = pk2(hb[6], hb[7]);
                        *(u32x4*)(GU + (size_t)(pm * 256 + 1) * DFF + c0) = w;
                        if ((pm & 15) == 15 && u0.pn == 0) { float* o = out + O_CFP + ((size_t)(l * 8 + b) * 2) * DFF + c0;
#pragma unroll
                            for (int k = 0; k < 8; ++k) { o[k] = SBL[((size_t)pm * 2 + 0) * DFF + c0 + k]; o[DFF + k] = SBL[((size_t)pm * 2 + 1) * DFF + c0 + k]; } }
                    }
                    asm volatile("s_waitcnt vmcnt(0)" ::: "memory"); __syncthreads();
                }
                GEMM_RES(rep == 3 ? 0 : (rep == 8 ? 1 : 2));
                { LANE_STATE();
                  const SG2 sg{rep == 12 ? GU + (size_t)MP * DFF : (rep == 3 ? gY : gO) + (size_t)MP * D, rep == 12 ? WDN_T : (rep == 3 ? WOUT_T : WO_T), rep == 12 ? DFF : D, rep == 12 ? DFF : D, rep == 12 ? DFF : D, D, XN + (size_t)MP * D, D, 1.f, 2, SSS(3 * l + (rep == 3 ? 1 : (rep == 8 ? 2 : 3)))};
                  sgemm2(lds, sg, bid, G, wave, tid); }
                if (rep != 12 && l + 1 < DEPTH) { LANE_STATE(); if (bid >= 64) convert_layer(kp, ws, lds, l + 1, rep == 3 ? 0 : 2, 3, gw - 64 * NWAVES, NGW - 64 * NWAVES, gt - 64 * NTHREADS, NGT - 64 * NTHREADS, lane, wave); }
            } else if (rep == 6) {
                LANE_STATE();
                for (int sub = 0; sub < 2; ++sub) {
                    pg8::GSched S; pg8::Gemm g; pg8::EpiSoftmax E;
                    if (sub == 0) { S.init(MP / 256, 4, G, bid); S.aPm = (size_t)256 * D * 2; S.aPn = 512; S.bPn = 512; S.bPm = (size_t)256 * D * 2; S.bShift = 4; g = pg8::Gemm{gQ, KBP, D, D, 256}; E.O = gP; E.ldc = D; E.smp = 0; }
                    else { S.init(1, 32, G, (bid + G - 64) % G); S.mode = 1; g = pg8::Gemm{gQ + (size_t)MP * D, KBS, D, D, 256}; E.O = PS; E.ldc = 8192; E.smp = 1; }
                    pg8::gemm_phase<pg8::EpiSoftmax, pg8::GSched, true>(lds, g, S, E, wave_s);
                }
            }
            if (rep == 6) { asm volatile("s_waitcnt vmcnt(0)" ::: "memory"); __syncthreads(); }
            else GRID_SYNC();
          }
        }
    }
    {
        LANE_STATE();
        const float* gain = INP(I_GFIN);
        f32x4 gv[4];
#pragma unroll
        for (int j = 0; j < 4; ++j) gv[j] = ((const f32x4*)gain)[lane + 64 * j];
        for (int m0 = gw; m0 < MT; m0 += 2 * NGW) {
            const int m1 = m0 + NGW; const bool two = m1 < MT; const int mb = two ? m1 : m0;
            const u32x2* xa = (const u32x2*)(XN + (size_t)m0 * D) + lane; const u32x2* xb = (const u32x2*)(XN + (size_t)mb * D) + lane;
            u32x2 pa[4], pb[4];
#pragma unroll
            for (int j = 0; j < 4; ++j) { pa[j] = xa[64 * j]; pb[j] = xb[64 * j]; }
            float ra, rb;
            { float qa = 0.f, qb = 0.f;
#pragma unroll
              for (int j = 0; j < 4; ++j) { const float a0 = bflo(pa[j].x), a1 = bfhi(pa[j].x), a2 = bflo(pa[j].y), a3 = bfhi(pa[j].y), b0 = bflo(pb[j].x), b1 = bfhi(pb[j].x), b2 = bflo(pb[j].y), b3 = bfhi(pb[j].y);
                  qa += (a0 * a0 + a1 * a1) + (a2 * a2 + a3 * a3); qb += (b0 * b0 + b1 * b1) + (b2 * b2 + b3 * b3); }
              if (m0 < MP) ra = ss_rstd(*(const f32x4*)(SSQ(6) + (size_t)m0 * 4)); else ra = 1.0f / sqrtf(wave_sum(qa, lane) * (1.f / D) + EPS);
              if (mb < MP) rb = ss_rstd(*(const f32x4*)(SSQ(6) + (size_t)mb * 4)); else rb = 1.0f / sqrtf(wave_sum(qb, lane) * (1.f / D) + EPS); }
            f32x4* ya = (f32x4*)(out + (size_t)m0 * D) + lane; f32x4* yb = (f32x4*)(out + (size_t)mb * D) + lane;
#pragma unroll
            for (int j = 0; j < 4; ++j) { ya[64 * j] = (f32x4){bflo(pa[j].x), bfhi(pa[j].x), bflo(pa[j].y), bfhi(pa[j].y)} * ra * gv[j]; if (two) yb[64 * j] = (f32x4){bflo(pb[j].x), bfhi(pb[j].x), bflo(pb[j].y), bfhi(pb[j].y)} * rb * gv[j]; }
        }
    }
}

extern "C" void kernel_launch(void* const* d_in, const int* in_sizes, int n_in, void* d_out, int out_size, void* d_ws, size_t ws_size, hipStream_t stream) {
    static int grid = 0;
    if (grid == 0) {
        if (n_in != N_IN || (size_t)out_size != O_END || ws_size < 512 * MiB) { fprintf(stderr, "kernel_launch: unexpected sizes n_in %d out %d ws %zu (need %zu)\n", n_in, out_size, ws_size, (size_t)(512 * MiB)); grid = -1; return; }
        int dev = 0, cus = 0, per_cu = 0;
        (void)hipGetDevice(&dev); (void)hipDeviceGetAttribute(&cus, hipDeviceAttributeMultiprocessorCount, dev);
        if (hipFuncSetAttribute((const void*)trunk_fwd, hipFuncAttributeMaxDynamicSharedMemorySize, LDS_BYTES) != hipSuccess) { fprintf(stderr, "kernel_launch: hipFuncSetAttribute failed\n"); grid = -1; return; }
        if (hipOccupancyMaxActiveBlocksPerMultiprocessor(&per_cu, (const void*)trunk_fwd, NTHREADS, LDS_BYTES) != hipSuccess || per_cu < 1) { fprintf(stderr, "kernel_launch: occupancy query gave %d\n", per_cu); per_cu = 1; }
        (void)hipGetLastError();
        grid = cus * 1;
        if (grid != 256) fprintf(stderr, "kernel_launch: note: %d CUs\n", grid);
    }
    if (grid < 0) return;
    Args a{};
    for (int i = 0; i < N_IN; ++i) a.in[i] = (const float*)d_in[i];
    a.out = (float*)d_out; a.ws = (unsigned char*)d_ws;
    void* kargs[] = {&a};
    hipError_t e = hipLaunchCooperativeKernel((const void*)trunk_fwd, dim3(grid), dim3(NTHREADS), kargs, LDS_BYTES, stream);
    if (e != hipSuccess) fprintf(stderr, "kernel_launch: cooperative launch failed: %s (grid %d)\n", hipGetErrorString(e), grid);
}
```

```cpp
#include <hip/hip_runtime.h>
#include <hip/hip_cooperative_groups.h>
#include <cstdio>
#include <cstdint>
namespace cg = cooperative_groups;
#ifndef PROBE
#define PROBE 0
#endif

#define LAS __attribute__((address_space(3)))
typedef unsigned short bf16_t;
typedef short bf16x8 __attribute__((ext_vector_type(8)));
typedef float f32x4 __attribute__((ext_vector_type(4)));
typedef float f32x2 __attribute__((ext_vector_type(2)));
typedef unsigned u32x4 __attribute__((ext_vector_type(4)));
typedef unsigned u32x2 __attribute__((ext_vector_type(2)));

constexpr int D = 1024, BP = 8, SEQ = 4096, BS = 8, TS = 32, DEPTH = 2;
constexpr int MP = BP * SEQ, MS = BS * TS, MT = MP + MS;
constexpr int INC = 2304, DFF = 2816, NMEM = 256, AW = 512, BW = 256, CW = 256;
constexpr int Z_XA = 0, Z_GA = 512, Z_XB = 1024, Z_GB = 1280, Z_GC = 1536, Z_UC = 1792, Z_VC = 2048;
constexpr float EPS = 1e-6f;
constexpr int NWAVES = 8, NTHREADS = 512;

constexpr size_t O_YP = 0, O_YS = O_YP + (size_t)MP * D, O_CAP = O_YS + (size_t)MS * D, O_HAP = O_CAP + DEPTH * BP * 3 * AW,
                 O_CBP = O_HAP + DEPTH * BP * AW, O_CFP = O_CBP + DEPTH * BP * 2 * BW, O_MKP = O_CFP + DEPTH * BP * 2 * DFF,
                 O_MVP = O_MKP + (size_t)DEPTH * BP * NMEM * D, O_CAS = O_MVP + (size_t)DEPTH * BP * NMEM * D, O_HAS = O_CAS + DEPTH * BS * 3 * AW,
                 O_CBS = O_HAS + DEPTH * BS * AW, O_CFS = O_CBS + DEPTH * BS * 2 * BW, O_VCS = O_CFS + DEPTH * BS * 2 * DFF,
                 O_END = O_VCS + DEPTH * BS * TS * CW;

constexpr size_t MiB = 1u << 20;
constexpr size_t WS_WIN = 0, WS_WOUT = 5 * MiB, WS_WQ = 7 * MiB, WS_WK = 9 * MiB, WS_WV = 11 * MiB, WS_WO = 13 * MiB, WS_WUP = 15 * MiB, WS_WDN = 26 * MiB;
constexpr size_t WS_MEMB = 32 * MiB, WS_KBP = 36 * MiB, WS_VTP = 40 * MiB, WS_KBS = 44 * MiB, WS_VTS = 48 * MiB, WS_WST = 52 * MiB, WS_GT = WS_WST + 131072, WS_AGG = 53 * MiB, WS_SS = 54 * MiB + 256 * 1024, WS_BAR = 55 * MiB + 512 * 1024;
constexpr size_t WS_XN = 56 * MiB, WS_BIG = 121 * MiB;
constexpr size_t B_Z = WS_BIG, B_HLOC = WS_BIG + 146 * MiB, B_PCUM = WS_BIG + 211 * MiB, B_Y = WS_BIG + 276 * MiB;
constexpr size_t B_Q = WS_BIG, B_P = WS_BIG + 65 * MiB, B_O = WS_BIG + 130 * MiB, B_PS = WS_BIG + 195 * MiB;
constexpr size_t B_GU = WS_BIG;
constexpr size_t B_GUS = WS_BIG + 200 * MiB;
constexpr size_t B_SBG = WS_BIG + 204 * MiB, B_SBU = WS_BIG + 207 * MiB, B_SBL = WS_BIG + 210 * MiB;
constexpr size_t WS_END = WS_BIG + (size_t)MT * 2 * DFF * 2;
constexpr size_t WS_SSP = 476 * MiB;
static_assert(WS_END <= WS_SSP && WS_SSP + (size_t)7 * MT * 64 <= 512 * MiB, "workspace");
static_assert(WS_XN + (size_t)MT * D * 2 <= WS_BIG, "xn");
constexpr size_t WS_SSS = WS_SSP + (((size_t)7 * MT * 16 + 4095) / 4096) * 4096;
static_assert(WS_SSS + 7 * 256 * 32 * 4 <= 480 * MiB, "sss");
constexpr size_t WSEL1 = 480 * MiB, KSEL1 = 418 * MiB;
static_assert(WS_WDN + (size_t)D * DFF * 2 + WSEL1 <= 512 * MiB && WS_KBS + KSEL1 >= WS_BIG + 341 * MiB && WS_GT + 131072 + KSEL1 <= WS_SSP, "second buffer set");

constexpr int LDS_RING = 131072, LDS_EX = LDS_RING, LDS_MISC = LDS_EX + 8192, LDS_BYTES = 147456;

enum { I_XP = 0, I_XS, I_MEM, I_CK, I_CV, I_SCA, I_SHA, I_SCB, I_SCF, I_GMIX, I_WIN, I_CAW, I_CAB, I_WRG, I_BRG, I_WIG, I_BIG, I_LAM, I_CBW, I_GV, I_WS, I_BSS,
       I_WOUT, I_GX, I_WQ, I_WK, I_WV, I_WO, I_GFFN, I_WUP, I_CFW, I_WDN, I_GFIN, N_IN };

struct Args { const float* in[N_IN]; float* out; unsigned char* ws; };

__device__ __forceinline__ unsigned pk2(float lo, float hi) { unsigned r; asm("v_cvt_pk_bf16_f32 %0, %1, %2" : "=v"(r) : "v"(lo), "v"(hi)); return r; }
__device__ __forceinline__ unsigned f2bf(float f) { return pk2(f, f) & 0xffffu; }
__device__ __forceinline__ float bf2f(unsigned v) { return __builtin_bit_cast(float, v << 16); }
__device__ __forceinline__ float bflo(unsigned w) { return __builtin_bit_cast(float, w << 16); }
__device__ __forceinline__ float bfhi(unsigned w) { return __builtin_bit_cast(float, w & 0xffff0000u); }
__device__ __forceinline__ unsigned cvt_pk_bf16(float lo, float hi) { unsigned r; asm volatile("v_cvt_pk_bf16_f32 %0, %1, %2" : "=v"(r) : "v"(lo), "v"(hi)); return r; }
__device__ __forceinline__ float fexp(float x) { return __builtin_amdgcn_exp2f(x * 1.4426950408889634f); }
__device__ __forceinline__ float sigm(float x) { return __builtin_amdgcn_rcpf(1.0f + fexp(-x)); }
__device__ __forceinline__ float gelu_t(float x) { const float u = 0.7978845608028654f * (x + 0.044715f * x * x * x); return x * sigm(2.0f * u); }
__device__ __forceinline__ float silu(float x) { return x * sigm(x); }
__device__ __forceinline__ float shx(float v, int m, int lane) { return __builtin_bit_cast(float, __builtin_amdgcn_ds_bpermute((lane ^ m) << 2, __builtin_bit_cast(int, v))); }
__device__ __forceinline__ float wave_sum(float v, int lane) {
#pragma unroll
    for (int o = 1; o < 64; o <<= 1) v += shx(v, o, lane);
    return v;
}
#define LDS_WAIT() asm volatile("s_waitcnt lgkmcnt(0)" ::: "memory")
__device__ __forceinline__ float ss_rstd(f32x4 p) { return __builtin_amdgcn_rsqf(((p[0] + p[1]) + (p[2] + p[3])) * (1.f / 1024.f) + 1e-6f); }
__device__ __forceinline__ int opaque_tid(int wave_s) { int l; asm volatile("v_mbcnt_lo_u32_b32 %0, -1, 0\n\tv_mbcnt_hi_u32_b32 %0, -1, %0" : "=v"(l)); return wave_s * 64 + l; }

namespace pg8 {
constexpr int BM = 256, BK = 64, HALF = 128, HTB = HALF * BK * 2, NXCD = 8, WGM = 8;
__device__ __forceinline__ int lds_byte(int r, int c) { const int st = (r >> 4) * 2 + (c >> 5), rr = r & 15, cc = c & 31, ob = rr * 64 + cc * 2; return st * 1024 + (ob ^ (((ob >> 9) & 1) << 5)); }
__device__ __forceinline__ void stage_rc(int b, int& R, int& C) { const int st = b / 1024, sb = b % 1024, swz = sb ^ (((sb >> 9) & 1) << 5); R = (st >> 1) * 16 + swz / 64; C = (st & 1) * 32 + (swz % 64) / 2; }
__device__ __forceinline__ int perm32(int rho) { const int n = rho >> 4, i = rho & 15; return 8 * (i >> 2) + 4 * n + (i & 3); }

struct Unit { int pm, pn; };
struct Gemm { const bf16_t* A; const bf16_t* Bt; int lda, ldb, K; };

struct GSched {
    int nM, nN, nwg, G, c, mode;
    size_t aPm, aPn, bPn, bPm; int bShift;
    __device__ __forceinline__ void init(int nM_, int nN_, int G_, int c_) { nM = nM_; nN = nN_; nwg = nM * nN; G = G_; c = c_; mode = 0; aPm = 0; aPn = 0; bPn = 0; bPm = 0; bShift = 0; }
    __device__ __forceinline__ bool next(int i, Unit& u) const {
        const long L = (long)i * G + c; if (L >= nwg) return false;
        int wgid = (int)L; { const int q = nwg / NXCD, r = nwg % NXCD, xcd = wgid % NXCD, off = wgid / NXCD; wgid = (xcd < r ? xcd * (q + 1) : r * (q + 1) + (xcd - r) * q) + off; }
        const int nig = WGM * nN, gid = wgid / nig, fm = gid * WGM, gsz = (nM - fm) < WGM ? (nM - fm) : WGM;
        u.pm = fm + ((wgid % nig) % gsz); u.pn = (wgid % nig) / gsz; return true;
    }
    __device__ __forceinline__ size_t offA(const Unit& u) const { return mode == 1 ? (size_t)(u.pn & 3) * 512 : (mode == 2 ? (size_t)(u.pn & 3) * 4096 + (size_t)(u.pn >> 2) * 512 : (size_t)u.pm * aPm + (size_t)u.pn * aPn); }
    __device__ __forceinline__ size_t offB(const Unit& u) const { return mode == 1 ? (size_t)(u.pn >> 2) * (256 * 1024 * 2) + (size_t)(u.pn & 3) * 512 : (mode == 2 ? (size_t)(u.pn & 3) * (256 * 2048 * 2) + (size_t)(u.pn >> 2) * 512 : (size_t)u.pn * bPn + (size_t)(u.pm >> bShift) * bPm); }
};

struct EpiBf16 {
    static constexpr bool PERM = true;
    bf16_t* O; int ldc; float scale; const float* ss; int smp;
    __device__ __forceinline__ void operator()(f32x4 (&acc)[2][2][4][2], const Unit& u, int wr, int wc, int fr, int fq, LAS unsigned char*) const {
        asm volatile("" : "+v"(fr), "+v"(fq)); asm volatile("" : "+s"(wr), "+s"(wc));
        const int row0 = u.pm * BM + wr * 64 + fr, col0 = (smp ? (u.pn & 3) : u.pn) * BM + wc * 32 + 8 * fq;
        f32x4 rs[2][4];
#pragma unroll
        for (int ai = 0; ai < 2; ++ai)
#pragma unroll
            for (int m = 0; m < 4; ++m) rs[ai][m] = ss ? *(const f32x4*)(ss + (size_t)(row0 + ai * HALF + m * 16) * 4) : (f32x4){0.f, 0.f, 0.f, 0.f};
#pragma unroll
        for (int ai = 0; ai < 2; ++ai)
#pragma unroll
            for (int m = 0; m < 4; ++m) { bf16_t* rowp = O + (size_t)(row0 + ai * HALF + m * 16) * ldc + col0;
                float sc = scale; if (ss) sc *= ss_rstd(rs[ai][m]);
                if (smp && ((ai * HALF + wr * 64 + m * 16 + fr) >> 5) != (u.pn >> 2)) continue;
#pragma unroll
                for (int bj = 0; bj < 2; ++bj) { const f32x4 v0 = acc[ai][bj][m][0] * sc, v1 = acc[ai][bj][m][1] * sc;
                    u32x4 w; w.x = cvt_pk_bf16(v0[0], v0[1]); w.y = cvt_pk_bf16(v0[2], v0[3]); w.z = cvt_pk_bf16(v1[0], v1[1]); w.w = cvt_pk_bf16(v1[2], v1[3]);
                    *(u32x4*)(rowp + bj * HALF) = w; } }
    }
};
struct EpiResid {
    static constexpr bool PERM = true;
    bf16_t* xb; float* ss;
    __device__ __forceinline__ void operator()(f32x4 (&acc)[2][2][4][2], const Unit& u, int wr, int wc, int fr, int fq, LAS unsigned char* lds) const {
        asm volatile("" : "+v"(fr), "+v"(fq)); asm volatile("" : "+s"(wr), "+s"(wc));
        const int col0 = u.pn * BM + wc * 32 + 8 * fq, lane = fq * 16 + fr;
        LAS float* PS = (LAS float*)(lds + LDS_EX);
        bf16_t* ob = xb + (size_t)u.pm * BM * D;
#pragma unroll
        for (int ai = 0; ai < 2; ++ai) {
            u32x4 pre[4][2];
#pragma unroll
            for (int m = 0; m < 4; ++m)
#pragma unroll
                for (int bj = 0; bj < 2; ++bj) pre[m][bj] = *(const u32x4*)(ob + (size_t)(ai * HALF + wr * 64 + m * 16 + fr) * D + col0 + bj * HALF);
            asm volatile("" ::: "memory");
#pragma unroll
            for (int m = 0; m < 4; ++m) { const int rl = ai * HALF + wr * 64 + m * 16 + fr; const size_t off = (size_t)rl * D + col0; float q = 0.f;
#pragma unroll
                for (int bj = 0; bj < 2; ++bj) { const u32x4 p = pre[m][bj]; const f32x4 a0 = acc[ai][bj][m][0], a1 = acc[ai][bj][m][1];
                    const float v0 = bflo(p.x) + a0[0], v1 = bfhi(p.x) + a0[1], v2 = bflo(p.y) + a0[2], v3 = bfhi(p.y) + a0[3], v4 = bflo(p.z) + a1[0], v5 = bfhi(p.z) + a1[1], v6 = bflo(p.w) + a1[2], v7 = bfhi(p.w) + a1[3];
                    u32x4 w; w.x = cvt_pk_bf16(v0, v1); w.y = cvt_pk_bf16(v2, v3); w.z = cvt_pk_bf16(v4, v5); w.w = cvt_pk_bf16(v6, v7); *(u32x4*)(ob + off + bj * HALF) = w;
                    q += ((v0 * v0 + v1 * v1) + (v2 * v2 + v3 * v3)) + ((v4 * v4 + v5 * v5) + (v6 * v6 + v7 * v7)); }
                q += shx(q, 16, lane); q += shx(q, 32, lane);
                if (fq == 0) PS[rl * 4 + wc] = q; }
            asm volatile("" ::: "memory");
        }
        asm volatile("s_waitcnt lgkmcnt(0)" ::: "memory"); __builtin_amdgcn_s_barrier(); asm volatile("" ::: "memory");
        { const int t = (wr * 4 + wc) * 64 + lane; if (t < 256) { const f32x4 p = *(const LAS f32x4*)(PS + t * 4); ss[(size_t)(u.pm * BM + t) * 4 + u.pn] = (p[0] + p[1]) + (p[2] + p[3]); } }
    }
};
struct EpiKV {
    static constexpr bool PERM = false;
    float* outK; float* outV; bf16_t* KB; bf16_t* VT;
    __device__ __forceinline__ void operator()(f32x4 (&acc)[2][2][4][2], const Unit& u, int wr, int wc, int fr, int fq, LAS unsigned char*) const {
        asm volatile("" : "+v"(fr), "+v"(fq)); asm volatile("" : "+s"(wr), "+s"(wc));
        const int kind = u.pm >> 4, pm = u.pm & 15;
        const int col0 = u.pn * BM + wc * 32 + 4 * fq;
        float* of = kind == 0 ? outK : outV; bf16_t* ob = kind == 0 ? KB : VT; const int ldb_ = kind == 2 ? 2048 : 1024;
#pragma unroll
        for (int ai = 0; ai < 2; ++ai)
#pragma unroll
            for (int m = 0; m < 4; ++m) { const int row = pm * BM + ai * HALF + wr * 64 + m * 16 + fr;
#pragma unroll
                for (int bj = 0; bj < 2; ++bj)
#pragma unroll
                    for (int n = 0; n < 2; ++n) { const f32x4 v = acc[ai][bj][m][n]; const int col = col0 + bj * HALF + n * 16;
                        if (kind != 2) *(f32x4*)(of + (size_t)row * 1024 + col) = v;
                        if (kind != 1) { u32x2 w; w.x = cvt_pk_bf16(v[0], v[1]); w.y = cvt_pk_bf16(v[2], v[3]); *(u32x2*)(ob + (size_t)row * ldb_ + col) = w; } } }
    }
};
struct EpiSoftmax {
    static constexpr bool PERM = true;
    bf16_t* O; int ldc; int smp;
    __device__ __forceinline__ void operator()(f32x4 (&acc)[2][2][4][2], const Unit& u, int wr, int wc, int fr, int fq, LAS unsigned char* lds) const {
        asm volatile("" : "+v"(fr), "+v"(fq)); asm volatile("" : "+s"(wr), "+s"(wc));
        LAS f32x2* EX = (LAS f32x2*)(lds + LDS_EX);
        const int lane = fq * 16 + fr;
        const float L2E = 1.4426950408889634f;
#pragma unroll
        for (int ai = 0; ai < 2; ++ai)
#pragma unroll
            for (int m = 0; m < 4; ++m) {
                float mx = -3.0e38f;
#pragma unroll
                for (int bj = 0; bj < 2; ++bj)
#pragma unroll
                    for (int n = 0; n < 2; ++n) { const f32x4 x = acc[ai][bj][m][n]; mx = fmaxf(mx, fmaxf(fmaxf(x[0], x[1]), fmaxf(x[2], x[3]))); }
                mx = fmaxf(mx, shx(mx, 16, lane)); mx = fmaxf(mx, shx(mx, 32, lane));
                float s = 0.f;
#pragma unroll
                for (int bj = 0; bj < 2; ++bj)
#pragma unroll
                    for (int n = 0; n < 2; ++n) { f32x4 x = acc[ai][bj][m][n];
#pragma unroll
                        for (int j = 0; j < 4; ++j) { x[j] = __builtin_amdgcn_exp2f((x[j] - mx) * L2E); s += x[j]; }
                        acc[ai][bj][m][n] = x; }
                s += shx(s, 16, lane); s += shx(s, 32, lane);
                if (fq == 0) EX[(ai * HALF + wr * 64 + m * 16 + fr) * 4 + wc] = (f32x2){mx, s};
            }
        asm volatile("s_waitcnt lgkmcnt(0)" ::: "memory"); __builtin_amdgcn_s_barrier(); asm volatile("" ::: "memory");
        int colb = u.pn * BM, j_ = 0;
        if (smp) { colb = (u.pn & 3) * 2048 + (u.pn >> 2) * 256; j_ = u.pn >> 2; }
        const int col0 = colb + wc * 32 + 8 * fq;
#pragma unroll
        for (int ai = 0; ai < 2; ++ai)
#pragma unroll
            for (int m = 0; m < 4; ++m) {
                const int rl = ai * HALF + wr * 64 + m * 16 + fr;
                const f32x2 e0 = EX[rl * 4 + 0], e1 = EX[rl * 4 + 1], e2 = EX[rl * 4 + 2], e3 = EX[rl * 4 + 3];
                const float M = fmaxf(fmaxf(e0.x, e1.x), fmaxf(e2.x, e3.x));
                const float tot = e0.y * __builtin_amdgcn_exp2f((e0.x - M) * L2E) + e1.y * __builtin_amdgcn_exp2f((e1.x - M) * L2E) + e2.y * __builtin_amdgcn_exp2f((e2.x - M) * L2E) + e3.y * __builtin_amdgcn_exp2f((e3.x - M) * L2E);
                const float own = wc == 0 ? e0.x : (wc == 1 ? e1.x : (wc == 2 ? e2.x : e3.x));
                float f = __builtin_amdgcn_exp2f((own - M) * L2E) * __builtin_amdgcn_rcpf(tot);
                if (smp && (rl >> 5) != j_) f = 0.f;
                bf16_t* rowp = O + (size_t)(u.pm * BM + rl) * ldc + col0;
#pragma unroll
                for (int bj = 0; bj < 2; ++bj) { const f32x4 v0 = acc[ai][bj][m][0] * f, v1 = acc[ai][bj][m][1] * f;
                    u32x4 w; w.x = cvt_pk_bf16(v0[0], v0[1]); w.y = cvt_pk_bf16(v0[2], v0[3]); w.z = cvt_pk_bf16(v1[0], v1[1]); w.w = cvt_pk_bf16(v1[2], v1[3]);
                    *(u32x4*)(rowp + bj * HALF) = w; } }
    }
};


__device__ __forceinline__ float dpp_ror1(float v) { return __builtin_bit_cast(float, __builtin_amdgcn_update_dpp(0, __builtin_bit_cast(int, v), 0x121, 0xf, 0xf, false)); }
__device__ __forceinline__ float dpp_ror2(float v) { return __builtin_bit_cast(float, __builtin_amdgcn_update_dpp(0, __builtin_bit_cast(int, v), 0x122, 0xf, 0xf, false)); }
struct EpiAct {
    static constexpr bool PERM = true;
    bf16_t* H; const float* scf; float* ocf; float* sbg; float* sbu; float* sbl; const float* cfw; const float* ss;
    __device__ __forceinline__ void operator()(f32x4 (&acc)[2][2][4][2], const Unit& u, int wr, int wc, int fr, int fq, LAS unsigned char* lds) const {
        asm volatile("" : "+s"(wr), "+s"(wc));
        int lane; asm volatile("v_mbcnt_lo_u32_b32 %0, -1, 0\n\tv_mbcnt_hi_u32_b32 %0, -1, %0" : "=v"(lane));
        fr = lane & 15; fq = lane >> 4;
        const int fl = wc * 32 + 8 * fq, f0 = u.pn * 128 + fl; int rowt = wr * 64 + fr;
        {
            float rst[2][4];
            f32x4 rsl[2][4];
#pragma unroll
            for (int ai = 0; ai < 2; ++ai)
#pragma unroll
                for (int m = 0; m < 4; ++m) rsl[ai][m] = *(const f32x4*)(ss + (size_t)(u.pm * BM + ai * HALF + rowt + m * 16) * 4);
#pragma unroll
            for (int ai = 0; ai < 2; ++ai)
#pragma unroll
                for (int m = 0; m < 4; ++m) { rst[ai][m] = ss_rstd(rsl[ai][m]); }
#pragma unroll
            for (int ai = 0; ai < 2; ++ai)
#pragma unroll
                for (int m = 0; m < 4; ++m) { acc[ai][0][m][0] = acc[ai][0][m][0] * rst[ai][m]; acc[ai][0][m][1] = acc[ai][0][m][1] * rst[ai][m]; acc[ai][1][m][0] = acc[ai][1][m][0] * rst[ai][m]; acc[ai][1][m][1] = acc[ai][1][m][1] * rst[ai][m]; }
        }
        const bool smp = (u.pm == 128);
        asm volatile("" : "+v"(rowt));
        LAS float* BND = (LAS float*)(lds + LDS_EX);
        if (fr >= 14) {
#pragma unroll
            for (int ai = 0; ai < 2; ++ai)
#pragma unroll
                for (int n = 0; n < 2; ++n) *(LAS f32x4*)(BND + ((ai * 2 + wr) * 2 + (fr - 14)) * 128 + fl + 4 * n) = acc[ai][0][3][n];
            if (wr == 1) {
#pragma unroll
                for (int n = 0; n < 2; ++n) *(f32x4*)(sbl + ((size_t)u.pm * 2 + (fr - 14)) * DFF + f0 + 4 * n) = acc[1][0][3][n];
            }
        }
        asm volatile("s_waitcnt lgkmcnt(0)" ::: "memory"); __builtin_amdgcn_s_barrier(); asm volatile("" ::: "memory");
#pragma unroll
        for (int ai = 0; ai < 2; ++ai) {
            const int pg = wr == 1 ? ai * 2 : 1;
            u32x2 hp[2][4];
#pragma unroll
            for (int n = 0; n < 2; ++n) {
                const f32x4 w0 = *(const f32x4*)(cfw + f0 + 4 * n), w1 = *(const f32x4*)(cfw + DFF + f0 + 4 * n), w2 = *(const f32x4*)(cfw + 2 * DFF + f0 + 4 * n);
                f32x4 h2 = *(const LAS f32x4*)(BND + (pg * 2 + 0) * 128 + fl + 4 * n), h1 = *(const LAS f32x4*)(BND + (pg * 2 + 1) * 128 + fl + 4 * n);
                f32x4 t2 = h2, t1 = h1;
                if (smp) { const float* sp = scf + (size_t)((ai * 4 + wr * 2) * 2) * DFF + f0 + 4 * n; h2 = *(const f32x4*)sp; h1 = *(const f32x4*)(sp + DFF); t2 = *(const f32x4*)(sp + 2 * DFF); t1 = *(const f32x4*)(sp + 3 * DFF); }
#pragma unroll
                for (int jp = 0; jp < 2; ++jp) {
                    float hv[4][2];
#pragma unroll
                    for (int jj = 0; jj < 2; ++jj) { const int j = jp * 2 + jj;
                        float r1p = h1[j], r2p = fr == 0 ? h2[j] : h1[j];
#pragma unroll
                        for (int m = 0; m < 4; ++m) { const float g = acc[ai][0][m][n][j];
                            if (m == 2 && smp) { r1p = t1[j]; r2p = fr == 0 ? t2[j] : t1[j]; }
                            const float r1 = dpp_ror1(g), r2 = dpp_ror2(g);
                            const float gm1 = fr >= 1 ? r1 : r1p, gm2 = fr >= 2 ? r2 : r2p;
                            r1p = r1; r2p = r2;
                            const float cv = w0[j] * gm2 + w1[j] * gm1 + w2[j] * g;
                            hv[m][jj] = silu(cv) * acc[ai][1][m][n][j]; } }
#pragma unroll
                    for (int m = 0; m < 4; ++m) { const unsigned pk = cvt_pk_bf16(hv[m][0], hv[m][1]); if (jp == 0) hp[n][m].x = pk; else hp[n][m].y = pk; }
                }
            }
#pragma unroll
            for (int m = 0; m < 4; ++m) {
                const int rl = ai * HALF + rowt + m * 16;
                if (smp && (m & 1) && fr >= 14) {
#pragma unroll
                    for (int n = 0; n < 2; ++n) *(f32x4*)(ocf + ((size_t)(ai * 4 + wr * 2 + (m >> 1)) * 2 + (fr - 14)) * DFF + f0 + 4 * n) = acc[ai][0][m][n];
                }
                if (!smp && ai == 0 && m == 0 && wr == 0 && fr < 2) {
#pragma unroll
                    for (int n = 0; n < 2; ++n) { *(f32x4*)(sbg + ((size_t)u.pm * 2 + fr) * DFF + f0 + 4 * n) = acc[0][0][0][n]; *(f32x4*)(sbu + ((size_t)u.pm * 2 + fr) * DFF + f0 + 4 * n) = acc[0][1][0][n]; }
                } else {
                    u32x4 w; w.x = hp[0][m].x; w.y = hp[0][m].y; w.z = hp[1][m].x; w.w = hp[1][m].y;
                    *(u32x4*)(H + (size_t)(u.pm * BM + rl) * DFF + f0) = w;
                }
            }
        }
    }
};

template <class Epi, class Sched, bool ALIGN_EPI>
__device__ __forceinline__ void gemm_phase(LAS unsigned char* lds, const Gemm g, const Sched& S, const Epi& E, const int wave_s) {
    const int tid = opaque_tid(wave_s), wid = __builtin_amdgcn_readfirstlane(tid >> 6), lane = tid & 63, wr = wid >> 2, wc = wid & 3, fr = lane & 15, fq = lane >> 4;
    const int nt = g.K / BK;
    unsigned voffA[2], voffB[2];
#pragma unroll
    for (int i = 0; i < 2; ++i) { int R, C; stage_rc(tid * 16 + i * 8192, R, C); const int Rb = Epi::PERM ? ((R & ~31) + perm32(R & 31)) : R;
        voffA[i] = (unsigned)(R * g.lda + C) * 2u; voffB[i] = (unsigned)(Rb * g.ldb + C) * 2u; }
    const size_t kstep = (size_t)(BK * 2);
    const size_t hstepA = (size_t)HALF * g.lda * 2, hstepB = (size_t)HALF * g.ldb * 2;
    const unsigned ldsw = (unsigned)wid * 1024u;
    const int aoff = lds_byte(wr * 64 + fr, fq * 8), boff = lds_byte(wc * 32 + fr, fq * 8);
#define PG8_SA(b, h) (((b) * 2 + (h)) * HTB)
#define PG8_SB(b, h) ((4 + (b) * 2 + (h)) * HTB)
#define PG8_STAGE(bufoff, gbase, voff) do { _Pragma("unroll") for (int _i = 0; _i < 2; ++_i) \
        __builtin_amdgcn_global_load_lds((const unsigned*)((const char*)(gbase) + (voff)[_i]), (LAS unsigned*)(lds + (bufoff) + ldsw + _i * 8192), 16, 0, 0); } while (0)
#define PG8_LDA(dst, b, h) do { _Pragma("unroll") for (int m = 0; m < 4; ++m) _Pragma("unroll") for (int k = 0; k < 2; ++k) dst[m][k] = *(const LAS bf16x8*)(lds + PG8_SA(b, h) + aoff + m * 2048 + k * 1024); } while (0)
#define PG8_LDB(dst, b, h) do { _Pragma("unroll") for (int n = 0; n < 2; ++n) _Pragma("unroll") for (int k = 0; k < 2; ++k) dst[n][k] = *(const LAS bf16x8*)(lds + PG8_SB(b, h) + boff + n * 2048 + k * 1024); } while (0)
#define PG8_MMA(ai, bj, At, Bt) do { __builtin_amdgcn_s_setprio(1); _Pragma("unroll") for (int m = 0; m < 4; ++m) _Pragma("unroll") for (int n = 0; n < 2; ++n) _Pragma("unroll") for (int k = 0; k < 2; ++k) \
        acc[ai][bj][m][n] = __builtin_amdgcn_mfma_f32_16x16x32_bf16(Bt[n][k], At[m][k], acc[ai][bj][m][n], 0, 0, 0); __builtin_amdgcn_s_setprio(0); } while (0)
#define PG8_WAIT_V(n) asm volatile("s_waitcnt vmcnt(" #n ")" ::: "memory")
#define PG8_WAIT_L(n) asm volatile("s_waitcnt lgkmcnt(" #n ")" ::: "memory")
#define PG8_BAR __builtin_amdgcn_s_barrier()
#define PG8_SCHED __builtin_amdgcn_sched_barrier(0)
    Unit cur, nxt; int ui = 0;
    if (!S.next(0, cur)) return;
    f32x4 acc[2][2][4][2];
#pragma unroll
    for (int a = 0; a < 2; ++a)
#pragma unroll
        for (int b = 0; b < 2; ++b)
#pragma unroll
            for (int m = 0; m < 4; ++m)
#pragma unroll
                for (int n = 0; n < 2; ++n) acc[a][b][m][n] = (f32x4){0.f, 0.f, 0.f, 0.f};
    bf16x8 At[4][2], B0[2][2], B1[2][2];
    const char* cA = (const char*)g.A + S.offA(cur); const char* cB = (const char*)g.Bt + S.offB(cur);
    PG8_STAGE(PG8_SB(0, 0), cB, voffB); PG8_STAGE(PG8_SB(0, 1), cB + hstepB, voffB); PG8_STAGE(PG8_SA(0, 0), cA, voffA); PG8_STAGE(PG8_SA(0, 1), cA + hstepA, voffA);
    if (wr == 1) PG8_BAR;
    PG8_WAIT_V(2); PG8_BAR;
    PG8_STAGE(PG8_SB(1, 0), cB + kstep, voffB); PG8_STAGE(PG8_SA(1, 0), cA + kstep, voffA); PG8_STAGE(PG8_SB(1, 1), cB + hstepB + kstep, voffB);
    PG8_WAIT_V(6); PG8_BAR;
    for (;;) {
        const bool has_next = S.next(ui + 1, nxt);
        const char* nA = has_next ? (const char*)g.A + S.offA(nxt) : cA; const char* nB = has_next ? (const char*)g.Bt + S.offB(nxt) : cB;
        for (int t = 0; t < nt; t += 2) {
            const bool last = (t == nt - 2);
            const char* a1 = cA + (size_t)(t + 1) * kstep;
            const char* a2 = last ? nA : cA + (size_t)(t + 2) * kstep; const char* b2 = last ? nB : cB + (size_t)(t + 2) * kstep;
            const char* a3 = a2 + kstep; const char* b3 = b2 + kstep;
            PG8_LDB(B0, 0, 0); PG8_LDB(B1, 0, 1); PG8_SCHED; PG8_LDA(At, 0, 0); PG8_STAGE(PG8_SA(1, 1), a1 + hstepA, voffA);
            PG8_WAIT_V(8); PG8_WAIT_L(0); PG8_BAR; PG8_MMA(0, 0, At, B0); PG8_MMA(0, 1, At, B1); PG8_BAR; PG8_SCHED;
            PG8_LDA(At, 0, 1); PG8_STAGE(PG8_SB(0, 0), b2, voffB); PG8_STAGE(PG8_SB(0, 1), b2 + hstepB, voffB); PG8_STAGE(PG8_SA(0, 0), a2, voffA);
            PG8_WAIT_V(8); PG8_WAIT_L(0); PG8_BAR; PG8_MMA(1, 0, At, B0); PG8_MMA(1, 1, At, B1); PG8_BAR; PG8_SCHED;
            PG8_LDB(B0, 1, 0); PG8_LDB(B1, 1, 1); PG8_SCHED; PG8_LDA(At, 1, 0); PG8_STAGE(PG8_SA(0, 1), a2 + hstepA, voffA);
            PG8_WAIT_V(8); PG8_WAIT_L(0); PG8_BAR; PG8_MMA(0, 0, At, B0); PG8_MMA(0, 1, At, B1); PG8_BAR; PG8_SCHED;
            PG8_LDA(At, 1, 1); PG8_STAGE(PG8_SB(1, 0), b3, voffB); PG8_STAGE(PG8_SB(1, 1), b3 + hstepB, voffB); PG8_STAGE(PG8_SA(1, 0), a3, voffA);
            PG8_WAIT_V(8); PG8_WAIT_L(0); PG8_BAR; PG8_MMA(1, 0, At, B0); PG8_MMA(1, 1, At, B1); PG8_BAR; PG8_SCHED;
        }
        if constexpr (ALIGN_EPI) { if (wr == 0) PG8_BAR; }
        E(acc, cur, wr, wc, fr, fq, lds);
        if (!has_next) break;
#pragma unroll
        for (int a = 0; a < 2; ++a)
#pragma unroll
            for (int b = 0; b < 2; ++b)
#pragma unroll
                for (int m = 0; m < 4; ++m)
#pragma unroll
                    for (int n = 0; n < 2; ++n) acc[a][b][m][n] = (f32x4){0.f, 0.f, 0.f, 0.f};
        cur = nxt; cA = nA; cB = nB; ++ui;
        if constexpr (ALIGN_EPI) { if (wr == 1) PG8_BAR; }
    }
    PG8_WAIT_V(0);
    if constexpr (!ALIGN_EPI) { if (wr == 0) PG8_BAR; }
    PG8_BAR;
#undef PG8_SA
#undef PG8_SB
#undef PG8_STAGE
#undef PG8_LDA
#undef PG8_LDB
#undef PG8_MMA
#undef PG8_WAIT_V
#undef PG8_WAIT_L
#undef PG8_BAR
#undef PG8_SCHED
}
}

struct KVSched {
    int c, G; const char* ws; size_t wsel;
    __device__ __forceinline__ bool next(int i, pg8::Unit& u) const {
        const int L = i * G + c; if (c < 0 || L >= 96) return false;
        const int kind = L >> 5, r = L & 31;
        if (kind < 2) { u.pm = kind * 16 + (r >> 2); u.pn = r & 3; } else { u.pm = 32 + (r >> 3); u.pn = r & 7; }
        return true;
    }
    __device__ __forceinline__ size_t offA(const pg8::Unit& u) const { const int kind = u.pm >> 4, pm = u.pm & 15; int k2 = (kind == 2); asm volatile("" : "+v"(k2));
        return (size_t)ws + WS_MEMB + (size_t)k2 * (WS_WV + wsel - WS_MEMB) + (size_t)pm * 256 * 1024 * 2; }
    __device__ __forceinline__ size_t offB(const pg8::Unit& u) const { const int kind = u.pm >> 4; int k1 = (kind == 1), k2 = (kind == 2); asm volatile("" : "+v"(k1), "+v"(k2));
        return (size_t)ws + WS_WK + wsel + (size_t)k1 * (WS_WV - WS_WK) + (size_t)k2 * (WS_MEMB - WS_WK - wsel) + (size_t)u.pn * 256 * 1024 * 2; }
};


#define XB_TMO      128
#define XB_XCNT(j)  (256  + 64 * (j))
#define XB_XSUB(j)  (1280 + 64 * (j))
#define XB_XGEN(j)  (2304 + 64 * (j))
#define XB_TOP      3328
#define XB_TOPGEN   3392
#define XCD_BAR_WORDS 3456
#define XB_SPIN_CAP (1u << 22)
__device__ __forceinline__ unsigned xb_ld(unsigned* p)              { return __hip_atomic_load(p, __ATOMIC_RELAXED, __HIP_MEMORY_SCOPE_AGENT); }
__device__ __forceinline__ unsigned xb_add(unsigned* p, unsigned v) { return __hip_atomic_fetch_add(p, v, __ATOMIC_RELAXED, __HIP_MEMORY_SCOPE_AGENT); }
__device__ __forceinline__ unsigned xb_xcc_id() { return (unsigned)__builtin_amdgcn_s_getreg((3 << 11) | 20) & 0xFu; }
#define XB_SPIN(cond, bar) do { unsigned _sp = 0; while (cond) { __builtin_amdgcn_s_sleep(1); \
    if ((++_sp & 255u) == 0u) { if (xb_ld(&(bar)[XB_TMO])) break; if (_sp > XB_SPIN_CAP) { atomicAdd(&(bar)[XB_TMO], 1u); break; } } } } while (0)
struct XcdBarrier { unsigned* bar; unsigned x; volatile LAS unsigned* st; };
__device__ __forceinline__ void xcd_barrier_complete(unsigned* bar, unsigned x, unsigned& nloc, unsigned& nx) {
    const unsigned G = gridDim.x * gridDim.y * gridDim.z;
    unsigned sum, cnt, mine, sp = 0u;
    for (;;) {
        sum = 0u; cnt = 0u; mine = 0u;
#pragma unroll
        for (unsigned j = 0; j < 16; ++j) { const unsigned c = xb_ld(&bar[XB_XCNT(j)]); sum += c; cnt += (c > 0u) ? 1u : 0u; mine = (j == x) ? c : mine; }
        if (sum == G) break;
        __builtin_amdgcn_s_sleep(1);
        if ((++sp & 255u) == 0u) { if (xb_ld(&bar[XB_TMO])) break; if (sp > XB_SPIN_CAP) { atomicAdd(&bar[XB_TMO], 1u); break; } }
    }
    nloc = mine > 0u ? mine : 1u; nx = cnt > 0u ? cnt : 1u;
}
__device__ __forceinline__ void xcd_barrier(const XcdBarrier& b) {
    asm volatile("s_waitcnt vmcnt(0)" ::: "memory");
    __syncthreads();
    if (threadIdx.x == 0) {
        unsigned* bar = b.bar;
        __builtin_amdgcn_s_waitcnt(0);
        unsigned nloc = b.st[0], nx = b.st[1];
        if (nloc == 0u) { xcd_barrier_complete(bar, b.x, nloc, nx); b.st[0] = nloc; b.st[1] = nx; }
        const unsigned old = xb_add(&bar[XB_XSUB(b.x)], 1u);
        const unsigned gen = old / nloc;
        if (old + 1u == (gen + 1u) * nloc) {
            __builtin_amdgcn_fence(__ATOMIC_RELEASE, "agent");
            asm volatile("s_waitcnt vmcnt(0)" ::: "memory");
            const unsigned og = xb_add(&bar[XB_TOP], 1u);
            const unsigned tg = og / nx;
            if (og + 1u == (tg + 1u) * nx) xb_add(&bar[XB_TOPGEN], 1u);
            else XB_SPIN(xb_ld(&bar[XB_TOPGEN]) == tg, bar);
            __builtin_amdgcn_fence(__ATOMIC_ACQUIRE, "agent");
            xb_add(&bar[XB_XGEN(b.x)], 1u);
            asm volatile("s_waitcnt vmcnt(0)" ::: "memory");
        } else {
            XB_SPIN(xb_ld(&bar[XB_XGEN(b.x)]) == gen, bar);
            __builtin_amdgcn_fence(__ATOMIC_ACQUIRE, "agent");
            asm volatile("s_waitcnt vmcnt(0)" ::: "memory");
        }
    }
    __syncthreads();
}


struct SG2 { const bf16_t* A; const bf16_t* Bt; int lda, ldb, K, N; bf16_t* O; int ldc; float scale; int mode; float* ssp; };
__device__ __forceinline__ float sq8(bf16x8 a) { float q = 0.f;
#pragma unroll
    for (int i = 0; i < 8; ++i) { const float f = bf2f((unsigned)(unsigned short)a[i]); q += f * f; } return q; }
__device__ __forceinline__ void sgemm2(LAS unsigned char* lds, const SG2 g, int ubase, int G, int wave, int tid) {
    const int lane = tid & 63, fr = lane & 15, fq = lane >> 4, rt = wave & 3, ch = wave >> 2;
    const int nunits = (g.N / 64) * 4, nsl = g.K / 64;
    int R, C; pg8::stage_rc(tid * 16, R, C);
    const unsigned offA = (unsigned)(R * g.lda + C) * 2u, offB = (unsigned)(R * g.ldb + C) * 2u;
    const int aoff = pg8::lds_byte(rt * 16 + fr, fq * 8), boff = pg8::lds_byte(ch * 32 + fr, fq * 8);
    for (int un = ubase; un >= 0 && un < nunits; un += G) {
        const int cgp = un >> 2, rg = un & 3;
        const char* gA = (const char*)(g.A + (size_t)rg * 64 * g.lda) + offA; const char* gB = (const char*)(g.Bt + (size_t)cgp * 64 * g.ldb) + offB;
#define SG2_STAGE(sl) do { LAS unsigned char* d_ = lds + ((sl) & 3) * 16384 + wave * 1024; \
        __builtin_amdgcn_global_load_lds((const unsigned*)(gA + (size_t)(sl) * 128), (LAS unsigned*)d_, 16, 0, 0); \
        __builtin_amdgcn_global_load_lds((const unsigned*)(gB + (size_t)(sl) * 128), (LAS unsigned*)(d_ + 8192), 16, 0, 0); } while (0)
        asm volatile("s_waitcnt vmcnt(0)" ::: "memory");
        SG2_STAGE(0); SG2_STAGE(1);
        f32x4 acc[2] = {(f32x4){0.f, 0.f, 0.f, 0.f}, (f32x4){0.f, 0.f, 0.f, 0.f}}; float q = 0.f;
        for (int sl = 0; sl < nsl; ++sl) {
            if (sl + 1 < nsl) asm volatile("s_waitcnt vmcnt(2)" ::: "memory"); else asm volatile("s_waitcnt vmcnt(0)" ::: "memory");
            __builtin_amdgcn_s_barrier(); asm volatile("" ::: "memory");
            if (sl + 2 < nsl) SG2_STAGE(sl + 2);
            LAS unsigned char* b_ = lds + (sl & 3) * 16384;
#pragma unroll
            for (int ks = 0; ks < 2; ++ks) {
                const bf16x8 a = *(const LAS bf16x8*)(b_ + aoff + ks * 1024);
#pragma unroll
                for (int c = 0; c < 2; ++c) { const bf16x8 b = *(const LAS bf16x8*)(b_ + 8192 + boff + c * 2048 + ks * 1024);
                    acc[c] = __builtin_amdgcn_mfma_f32_16x16x32_bf16(b, a, acc[c], 0, 0, 0); }
                if (g.mode == 1) q += sq8(a);
            }
        }
#undef SG2_STAGE
        const int row = rg * 64 + rt * 16 + fr, col = cgp * 64 + ch * 32 + fq * 4;
        bf16_t* op = g.O + (size_t)row * g.ldc + col;
        if (g.mode == 1) {
            q += shx(q, 16, lane); q += shx(q, 32, lane);
            const float sc = g.scale / sqrtf(q * (1.f / 1024.f) + EPS);
#pragma unroll
            for (int c = 0; c < 2; ++c) { const f32x4 v = acc[c] * sc; u32x2 w; w.x = cvt_pk_bf16(v[0], v[1]); w.y = cvt_pk_bf16(v[2], v[3]); *(u32x2*)(op + c * 16) = w; }
        } else {
            const u32x2 p0 = *(const u32x2*)op, p1 = *(const u32x2*)(op + 16); float qq = 0.f;
            { const float v0 = bflo(p0.x) + acc[0][0], v1 = bfhi(p0.x) + acc[0][1], v2 = bflo(p0.y) + acc[0][2], v3 = bfhi(p0.y) + acc[0][3];
              u32x2 w; w.x = cvt_pk_bf16(v0, v1); w.y = cvt_pk_bf16(v2, v3); *(u32x2*)op = w; qq += (v0 * v0 + v1 * v1) + (v2 * v2 + v3 * v3); }
            { const float v0 = bflo(p1.x) + acc[1][0], v1 = bfhi(p1.x) + acc[1][1], v2 = bflo(p1.y) + acc[1][2], v3 = bfhi(p1.y) + acc[1][3];
              u32x2 w; w.x = cvt_pk_bf16(v0, v1); w.y = cvt_pk_bf16(v2, v3); *(u32x2*)(op + 16) = w; qq += (v0 * v0 + v1 * v1) + (v2 * v2 + v3 * v3); }
            qq += shx(qq, 16, lane); qq += shx(qq, 32, lane);
            if (fq == 0) g.ssp[row * 32 + cgp * 2 + ch] = qq;
        }
        asm volatile("s_waitcnt vmcnt(0) lgkmcnt(0)" ::: "memory"); __builtin_amdgcn_s_barrier(); asm volatile("" ::: "memory");
    }
}

__device__ __forceinline__ void sgemm_act(LAS unsigned char* lds, const bf16_t* A, const bf16_t* Bt, bf16_t* Hs, const float* cfw, const float* scf, float* ocf, int ubase, int G, int wave, int tid) {
    const int lane = tid & 63, fr = lane & 15, fq = lane >> 4, rt = wave & 3, ch = wave >> 2;
    constexpr int nunits = (DFF / 64) * 4, nsl = D / 64, SLOT = 24576;
    int R, C; pg8::stage_rc(tid * 16, R, C);
    const unsigned off = (unsigned)(R * D + C) * 2u;
    const int aoff = pg8::lds_byte(rt * 16 + fr, fq * 8), boff = pg8::lds_byte(fr, fq * 8) + 8192 + ch * 8192;
    for (int un = ubase; un >= 0 && un < nunits; un += G) {
        const int fg = un >> 2, rg = un & 3, brow = ((fg >> 1) << 8) + ((fg & 1) << 6);
        const char* gA = (const char*)(A + (size_t)rg * 64 * D) + off; const char* gG = (const char*)(Bt + (size_t)brow * D) + off; const char* gU = (const char*)(Bt + (size_t)(brow + 128) * D) + off;
#define SGA_STAGE(sl) do { LAS unsigned char* d_ = lds + ((sl) & 3) * SLOT + wave * 1024; \
        __builtin_amdgcn_global_load_lds((const unsigned*)(gA + (size_t)(sl) * 128), (LAS unsigned*)d_, 16, 0, 0); \
        __builtin_amdgcn_global_load_lds((const unsigned*)(gG + (size_t)(sl) * 128), (LAS unsigned*)(d_ + 8192), 16, 0, 0); \
        __builtin_amdgcn_global_load_lds((const unsigned*)(gU + (size_t)(sl) * 128), (LAS unsigned*)(d_ + 16384), 16, 0, 0); } while (0)
        asm volatile("s_waitcnt vmcnt(0)" ::: "memory");
        SGA_STAGE(0); SGA_STAGE(1);
        f32x4 acc[4]; float q = 0.f;
#pragma unroll
        for (int c = 0; c < 4; ++c) acc[c] = (f32x4){0.f, 0.f, 0.f, 0.f};
        for (int sl = 0; sl < nsl; ++sl) {
            if (sl + 1 < nsl) asm volatile("s_waitcnt vmcnt(3)" ::: "memory"); else asm volatile("s_waitcnt vmcnt(0)" ::: "memory");
            __builtin_amdgcn_s_barrier(); asm volatile("" ::: "memory");
            if (sl + 2 < nsl) SGA_STAGE(sl + 2);
            LAS unsigned char* b_ = lds + (sl & 3) * SLOT;
#pragma unroll
            for (int ks = 0; ks < 2; ++ks) {
                const bf16x8 a = *(const LAS bf16x8*)(b_ + aoff + ks * 1024);
#pragma unroll
                for (int c = 0; c < 4; ++c) { const bf16x8 b = *(const LAS bf16x8*)(b_ + boff + c * 2048 + ks * 1024);
                    acc[c] = __builtin_amdgcn_mfma_f32_16x16x32_bf16(b, a, acc[c], 0, 0, 0); }
                q += sq8(a);
            }
        }
#undef SGA_STAGE
        q += shx(q, 16, lane); q += shx(q, 32, lane);
        const float rstd = 1.0f / sqrtf(q * (1.f / 1024.f) + EPS);
        asm volatile("s_waitcnt lgkmcnt(0)" ::: "memory"); __builtin_amdgcn_s_barrier(); asm volatile("" ::: "memory");
        LAS float* T = (LAS float*)(lds + ch * 20480);
#pragma unroll
        for (int c = 0; c < 4; ++c)
#pragma unroll
            for (int j = 0; j < 4; ++j) T[(rt * 16 + fr) * 65 + c * 16 + fq * 4 + j] = acc[c][j] * rstd;
        asm volatile("s_waitcnt lgkmcnt(0)" ::: "memory"); __builtin_amdgcn_s_barrier(); asm volatile("" ::: "memory");
        {
            const LAS float* Gt = (const LAS float*)lds; const LAS float* Ut = (const LAS float*)(lds + 20480);
            const int r = tid >> 3, f8 = (tid & 7) * 8, b = rg * 2 + (r >> 5), rr = r & 31, f = fg * 64 + f8;
            const float* st = scf + (size_t)(b * 2) * DFF + f;
            float hv[8], gv[8];
#pragma unroll
            for (int k = 0; k < 8; ++k) {
                const float g0 = Gt[r * 65 + f8 + k];
                const float gm1 = rr >= 1 ? Gt[(r - 1) * 65 + f8 + k] : st[DFF + k];
                const float gm2 = rr >= 2 ? Gt[(r - 2) * 65 + f8 + k] : (rr == 1 ? st[DFF + k] : st[k]);
                const float cv = cfw[f + k] * gm2 + cfw[DFF + f + k] * gm1 + cfw[2 * DFF + f + k] * g0;
                hv[k] = silu(cv) * Ut[r * 65 + f8 + k]; gv[k] = g0;
            }
            u32x4 w; w.x = pk2(hv[0], hv[1]); w.y = pk2(hv[2], hv[3]); w.z = pk2(hv[4], hv[5]); w.w = pk2(hv[6], hv[7]);
            *(u32x4*)(Hs + (size_t)(rg * 64 + r) * DFF + f) = w;
            if (rr >= 30) { float* o = ocf + ((size_t)b * 2 + (rr - 30)) * DFF + f; *(f32x4*)o = (f32x4){gv[0], gv[1], gv[2], gv[3]}; *(f32x4*)(o + 4) = (f32x4){gv[4], gv[5], gv[6], gv[7]}; }
        }
        asm volatile("s_waitcnt vmcnt(0) lgkmcnt(0)" ::: "memory"); __builtin_amdgcn_s_barrier(); asm volatile("" ::: "memory");
    }
}
__device__ __forceinline__ void sample_ss_reduce(const float* sss, float* ssq, int tid) {
    if (tid < 256) { const f32x4* p = (const f32x4*)(sss + tid * 32); float t = 0.f;
#pragma unroll
        for (int i = 0; i < 8; ++i) { const f32x4 v = p[i]; t += (v[0] + v[1]) + (v[2] + v[3]); }
        *(f32x4*)(ssq + (size_t)(MP + tid) * 4) = (f32x4){t, 0.f, 0.f, 0.f}; }
    asm volatile("s_waitcnt vmcnt(0)" ::: "memory"); __syncthreads();
}

__device__ __forceinline__ void transpose_item(const float* W, int K, int N, bf16_t* WT, LAS float* scr, int item, int lane, const float* gain = nullptr, int gu = 0) {
    const int nblk = N / 32, kb = item / nblk, nb = item % nblk, k0 = 64 * kb, n0 = 32 * nb;
    {
        f32x4 v[8];
#pragma unroll
        for (int i = 0; i < 8; ++i) v[i] = *(const f32x4*)(W + (size_t)(k0 + (lane >> 3) + 8 * i) * N + n0 + (lane & 7) * 4);
#pragma unroll
        for (int i = 0; i < 8; ++i) { const int kk = (lane >> 3) + 8 * i; f32x4 w = v[i]; if (gain) w = w * gain[k0 + kk];
            LAS float* d = scr + kk * 33 + (lane & 7) * 4; d[0] = w[0]; d[1] = w[1]; d[2] = w[2]; d[3] = w[3]; }
    }
    LDS_WAIT();
    const int c = lane & 7;
#pragma unroll
    for (int j = 0; j < 4; ++j) { const int n = (lane >> 3) + 8 * j; const LAS float* s = scr + (8 * c) * 33 + n;
        u32x4 o; o.x = pk2(s[0 * 33], s[1 * 33]); o.y = pk2(s[2 * 33], s[3 * 33]); o.z = pk2(s[4 * 33], s[5 * 33]); o.w = pk2(s[6 * 33], s[7 * 33]);
        int drow = n0 + n; if (gu) { const int up = drow >= gu, f = up ? drow - gu : drow; drow = ((f >> 7) << 8) + (up << 7) + (f & 127); }
        *(u32x4*)(WT + (size_t)drow * K + k0 + 8 * c) = o; }
    LDS_WAIT();
}

__device__ __forceinline__ void first_rows(const float* Xp, const float* Xs, bf16_t* XNo, float* ss, int gw, int NGW, int lane) {
    for (int m0 = gw; m0 < MT; m0 += 2 * NGW) {
        const int m1 = m0 + NGW; const bool two = m1 < MT; const int mb = two ? m1 : m0;
        const f32x4* xa = (const f32x4*)(m0 < MP ? Xp + (size_t)m0 * D : Xs + (size_t)(m0 - MP) * D) + lane;
        const f32x4* xb = (const f32x4*)(mb < MP ? Xp + (size_t)mb * D : Xs + (size_t)(mb - MP) * D) + lane;
        f32x4 va[4], vb[4]; float sa = 0.f, sb = 0.f;
#pragma unroll
        for (int j = 0; j < 4; ++j) { va[j] = xa[64 * j]; vb[j] = xb[64 * j]; }
#pragma unroll
        for (int j = 0; j < 4; ++j) { sa += (va[j].x * va[j].x + va[j].y * va[j].y) + (va[j].z * va[j].z + va[j].w * va[j].w); sb += (vb[j].x * vb[j].x + vb[j].y * vb[j].y) + (vb[j].z * vb[j].z + vb[j].w * vb[j].w); }
        sa = wave_sum(sa, lane); sb = wave_sum(sb, lane);
        if (lane < 4) { ss[(size_t)m0 * 4 + lane] = lane == 0 ? sa : 0.f; if (two) ss[(size_t)m1 * 4 + lane] = lane == 0 ? sb : 0.f; }
        u32x2* oa = (u32x2*)(XNo + (size_t)m0 * D) + lane; u32x2* ob = (u32x2*)(XNo + (size_t)mb * D) + lane;
#pragma unroll
        for (int j = 0; j < 4; ++j) { u32x2 w; w.x = pk2(va[j].x, va[j].y); w.y = pk2(va[j].z, va[j].w); oa[64 * j] = w; if (two) { w.x = pk2(vb[j].x, vb[j].y); w.y = pk2(vb[j].z, vb[j].w); ob[64 * j] = w; } }
    }
}

typedef __attribute__((address_space(4))) const unsigned char* kptr_t;
typedef const float* cfp_t; typedef float* fp_t; typedef unsigned char* ucp_t;
#define INP(k) (*(const __attribute__((address_space(4))) cfp_t*)(kp + 8 * (k)))
#define X out
#define WIN_T ((bf16_t*)(ws + WS_WIN + wsel))
#define WOUT_T ((bf16_t*)(ws + WS_WOUT + wsel))
#define WQ_T ((bf16_t*)(ws + WS_WQ + wsel))
#define WK_T ((bf16_t*)(ws + WS_WK + wsel))
#define WV_T ((bf16_t*)(ws + WS_WV + wsel))
#define WO_T ((bf16_t*)(ws + WS_WO + wsel))
#define WUP_T ((bf16_t*)(ws + WS_WUP + wsel))
#define WDN_T ((bf16_t*)(ws + WS_WDN + wsel))
#define MEMB ((bf16_t*)(ws + WS_MEMB))
#define KBP ((bf16_t*)(ws + WS_KBP))
#define VTP ((bf16_t*)(ws + WS_VTP))
#define KBS ((bf16_t*)(ws + WS_KBS + ksel))
#define VTS ((bf16_t*)(ws + WS_VTS + ksel))
#define WST ((bf16_t*)(ws + WS_WST + ksel))
#define AGG ((float*)(ws + WS_AGG))
#define SSQ(i) ((float*)(ws + WS_SSP) + (size_t)(i) * MT * 4)
#define SSS(i) ((float*)(ws + WS_SSS) + (size_t)(i) * 256 * 32)
#define GT_R ((bf16_t*)(ws + WS_GT + ksel))
#define GT_I ((bf16_t*)(ws + WS_GT + 65536 + ksel))
#define XN ((bf16_t*)(ws + WS_XN))
#define gZ ((bf16_t*)(ws + B_Z))
#define HLOC ((bf16_t*)(ws + B_HLOC))
#define PCUM ((bf16_t*)(ws + B_PCUM))
#define gY ((bf16_t*)(ws + B_Y))
#define gQ ((bf16_t*)(ws + B_Q))
#define gP ((bf16_t*)(ws + B_P))
#define gO ((bf16_t*)(ws + B_O))
#define PS ((bf16_t*)(ws + B_PS))
#define GU ((bf16_t*)(ws + B_GU))
#define GUS ((bf16_t*)(ws + B_GUS))
#define SBG ((float*)(ws + B_SBG))
#define SBU ((float*)(ws + B_SBU))
#define SBL ((float*)(ws + B_SBL))
__device__ __forceinline__ void convert_layer(kptr_t kp, unsigned char* ws, LAS unsigned char* lds, const int l, const int part, const int nparts, const int gw, const int NGW, const int gt, const int NGT, const int lane, const int wave) {
            const size_t wsel = (size_t)(l & 1) * WSEL1, ksel = (size_t)(l & 1) * KSEL1;
            LAS float* scr = (LAS float*)(lds + wave * 16384);
            const float* w_in = INP(I_WIN) + (size_t)l * D * INC; const float* w_out = INP(I_WOUT) + (size_t)l * D * D; const float* w_q = INP(I_WQ) + (size_t)l * D * D;
            const float* w_k = INP(I_WK) + (size_t)l * D * D; const float* w_v = INP(I_WV) + (size_t)l * D * D; const float* w_o = INP(I_WO) + (size_t)l * D * D;
            const float* w_up = INP(I_WUP) + (size_t)l * D * 2 * DFF; const float* w_dn = INP(I_WDN) + (size_t)l * DFF * D; const float* c_v = INP(I_CV) + (size_t)l * BS * NMEM * D;
            constexpr int T_IN = 16 * (INC / 32), T_SQ = 16 * 32, T_UP = 16 * (2 * DFF / 32), T_DN = (DFF / 64) * 32, T_CV = 32 * 32;
            constexpr int T_G = 16;
            constexpr int NIT = T_IN + 5 * T_SQ + T_UP + T_DN + T_CV + 2 * T_G;
            for (int it = (NIT * part) / nparts + gw; it < (NIT * (part + 1)) / nparts; it += NGW) {
                int r = it;
                if (r < T_IN) { transpose_item(w_in, D, INC, WIN_T, scr, r, lane, INP(I_GMIX) + l * D); continue; } r -= T_IN;
                if (r < T_SQ) { transpose_item(w_out, D, D, WOUT_T, scr, r, lane); continue; } r -= T_SQ;
                if (r < T_SQ) { transpose_item(w_q, D, D, WQ_T, scr, r, lane, INP(I_GX) + l * D); continue; } r -= T_SQ;
                if (r < T_SQ) { transpose_item(w_k, D, D, WK_T, scr, r, lane); continue; } r -= T_SQ;
                if (r < T_SQ) { transpose_item(w_v, D, D, WV_T, scr, r, lane); continue; } r -= T_SQ;
                if (r < T_SQ) { transpose_item(w_o, D, D, WO_T, scr, r, lane); continue; } r -= T_SQ;
                if (r < T_UP) { transpose_item(w_up, D, 2 * DFF, WUP_T, scr, r, lane, INP(I_GFFN) + l * D, DFF); continue; } r -= T_UP;
                if (r < T_DN) { transpose_item(w_dn, DFF, D, WDN_T, scr, r, lane); continue; } r -= T_DN;
                if (r < T_CV) { transpose_item(c_v, BS * NMEM, D, VTS, scr, r, lane); continue; } r -= T_CV;
                if (r < T_G) { transpose_item(INP(I_WRG) + ((size_t)l * 8 + (r >> 1)) * 4096, 64, 64, GT_R + (r >> 1) * 4096, scr, r & 1, lane); continue; } r -= T_G;
                transpose_item(INP(I_WIG) + ((size_t)l * 8 + (r >> 1)) * 4096, 64, 64, GT_I + (r >> 1) * 4096, scr, r & 1, lane);
            }
            if (part == 0) {
                const f32x4* ck = (const f32x4*)(INP(I_CK) + (size_t)l * BS * NMEM * D); u32x2* dk = (u32x2*)KBS;
                for (int i = gt; i < BS * NMEM * D / 4; i += NGT) { const f32x4 v = ck[i]; u32x2 w; w.x = pk2(v.x, v.y); w.y = pk2(v.z, v.w); dk[i] = w; }
                if (l == 0) { const f32x4* mm = (const f32x4*)INP(I_MEM); u32x2* dm = (u32x2*)MEMB;
                    for (int i = gt; i < BP * NMEM * D / 4; i += NGT) { const f32x4 v = mm[i]; u32x2 w; w.x = pk2(v.x, v.y); w.y = pk2(v.z, v.w); dm[i] = w; } }
                const float* wsl = INP(I_WS) + (size_t)l * 4 * 128 * 128;
                for (int i = gt; i < 4 * 128 * 128; i += NGT) { const int s = i & 127, t = (i >> 7) & 127; WST[i] = (bf16_t)f2bf(s <= t ? wsl[i] : 0.f); }
            }
}

__global__ void __launch_bounds__(NTHREADS, 2) trunk_fwd(Args args) {
    extern __shared__ __attribute__((aligned(16))) unsigned char lds_raw[];
    LAS unsigned char* lds = (LAS unsigned char*)lds_raw;
    cg::grid_group grid = cg::this_grid();
    const int wave_s = __builtin_amdgcn_readfirstlane(threadIdx.x >> 6);
#define LANE_STATE() int G = gridDim.x, bid = blockIdx.x; asm volatile("" : "+s"(G), "+s"(bid)); const int NGW = G * NWAVES, NGT = G * NTHREADS; (void)NGW; (void)NGT; \
    const int tid = opaque_tid(wave_s), lane = tid & 63, wave = wave_s; const int gw = bid * NWAVES + wave; const int gt = bid * NTHREADS + tid; (void)lane; (void)gw; (void)gt; \
    kptr_t kp = (kptr_t)__builtin_amdgcn_kernarg_segment_ptr(); asm volatile("" : "+s"(kp)); \
    float* const out = *(const __attribute__((address_space(4))) fp_t*)(kp + 8 * N_IN); unsigned char* const ws = *(const __attribute__((address_space(4))) ucp_t*)(kp + 8 * N_IN + 8); (void)out; (void)ws
    {
        LANE_STATE();
        if (bid == 0) for (int i = tid; i < XCD_BAR_WORDS; i += NTHREADS) __hip_atomic_store((unsigned*)(ws + WS_BAR) + i, 0u, __ATOMIC_RELAXED, __HIP_MEMORY_SCOPE_AGENT);
        if (tid < 32) ((LAS unsigned*)(lds + LDS_MISC))[tid] = 0u;
        __threadfence();
        grid.sync();
        if (tid == 0) (void)xb_add((unsigned*)(ws + WS_BAR) + XB_XCNT(xb_xcc_id()), 1u);
    }
#define GRID_SYNC() do { kptr_t kp_ = (kptr_t)__builtin_amdgcn_kernarg_segment_ptr(); asm volatile("" : "+s"(kp_)); \
        XcdBarrier b_; b_.bar = (unsigned*)(*(const __attribute__((address_space(4))) ucp_t*)(kp_ + 8 * N_IN + 8) + WS_BAR); b_.x = xb_xcc_id(); b_.st = (volatile LAS unsigned*)(lds + LDS_MISC); \
        xcd_barrier(b_); if (PROBE == 3) xcd_barrier(b_); } while (0)

    for (int l = 0; l < DEPTH; ++l) {
        const size_t wsel = (size_t)(l & 1) * WSEL1, ksel = (size_t)(l & 1) * KSEL1;
        if (l == 0)
        for (int dup0 = 0; dup0 < ((PROBE == 1 || PROBE == 5) ? 2 : 1); ++dup0) {
        {
            LANE_STATE();
            convert_layer(kp, ws, lds, l, 0, 1, gw, NGW, gt, NGT, lane, wave);
            if (l == 0) first_rows(INP(I_XP), INP(I_XS), XN, SSQ(0), gw, NGW, lane);
        }
        GRID_SYNC();
        }
        {
            LANE_STATE();
            KVSched S; S.G = G; S.c = bid >= 160 ? bid - 160 : -1; S.ws = (const char*)ws; S.wsel = wsel;
            pg8::Gemm g{(const bf16_t*)nullptr, (const bf16_t*)nullptr, D, D, D};
            pg8::EpiKV E{out + O_MKP + (size_t)l * BP * NMEM * D, out + O_MVP + (size_t)l * BP * NMEM * D, KBP, VTP};
            pg8::gemm_phase<pg8::EpiKV, KVSched, true>(lds, g, S, E, wave_s);
        }
#define GEMM_BF16(s_) do { const int s = (s_); pg8::GSched S; pg8::Gemm g; pg8::EpiBf16 E; E.scale = 1.f; E.ss = nullptr; E.smp = 0; \
        if (s == 0) { S.init(MT / 256, INC / 256, G, bid); S.aPm = (size_t)256 * D * 2; S.bPn = (size_t)256 * D * 2; g = pg8::Gemm{XN, WIN_T, D, D, D}; E.O = gZ; E.ldc = INC; E.ss = SSQ(3 * l); } \
        else if (s == 1) { S.init(MP / 256, D / 256, G, bid); S.aPm = (size_t)256 * D * 2; S.bPn = (size_t)256 * D * 2; g = pg8::Gemm{XN, WQ_T, D, D, D}; E.O = gQ; E.ldc = D; E.scale = 0.0625f; E.ss = SSQ(3 * l + 1); } \
        else if (s == 2) { S.init(MP / 256, 4, G, bid); S.aPm = (size_t)256 * D * 2; S.aPn = 512; S.bPn = (size_t)256 * 2048 * 2; S.bPm = 512; S.bShift = 4; g = pg8::Gemm{gP, VTP, D, 2048, 256}; E.O = gO; E.ldc = D; } \
        else { S.init(1, 32, G, (bid + G - 64) % G); S.mode = 2; g = pg8::Gemm{PS, VTS, 8192, 2048, 256}; E.O = gO + (size_t)MP * D; E.ldc = D; E.smp = 1; } \
        pg8::gemm_phase<pg8::EpiBf16, pg8::GSched, true>(lds, g, S, E, wave_s); } while (0)
#define GEMM_RES(s_) do { const int s = (s_); pg8::GSched S; S.init(MP / 256, D / 256, G, bid); pg8::Gemm g; \
        if (s == 0) { g = pg8::Gemm{gY, WOUT_T, D, D, D}; S.aPm = (size_t)256 * D * 2; } \
        else if (s == 1) { g = pg8::Gemm{gO, WO_T, D, D, D}; S.aPm = (size_t)256 * D * 2; } \
        else { g = pg8::Gemm{GU, WDN_T, DFF, DFF, DFF}; S.aPm = (size_t)256 * DFF * 2; } \
        S.bPn = (size_t)256 * g.ldb * 2; \
        pg8::EpiResid E{XN, SSQ(3 * l + 1 + s)}; \
        pg8::gemm_phase<pg8::EpiResid, pg8::GSched, true>(lds, g, S, E, wave_s); } while (0)

        for (int rep = 0; rep < 13; ++rep) { if (rep == 4 || rep == 9 || rep == 11) continue;
          const int ndup = ((PROBE == 1 && (rep == 1 || rep == 2)) || (PROBE == 4 && rep == 1) || (PROBE == 6 && rep == 2)) ? 2 : ((PROBE == 2 && (rep == 0 || rep == 5 || rep == 6 || rep == 7 || rep == 10)) ? 2 : 1);
          for (int dup = 0; dup < ndup; ++dup) {
            if (rep == 0 || rep == 5 || rep == 7) {
                LANE_STATE();
                const int s0 = rep == 0 ? 0 : (rep == 5 ? 1 : 2), ns = rep == 7 ? 2 : 1;
                if (rep == 0 && l > 0) {
                    pg8::GSched S0; S0.init(MT / 256, INC / 256, G, bid); pg8::Unit u0; bool own = false;
                    for (int i = 0; S0.next(i, u0); ++i) own = own || (u0.pm == 128);
                    if (own) sample_ss_reduce(SSS(3 * l), SSQ(3 * l), tid);
                }
                for (int q = 0; q < ns; ++q) GEMM_BF16(s0 + q);
                if (rep == 5) { LANE_STATE(); const SG2 sg{XN + (size_t)MP * D, WQ_T, D, D, D, D, gQ + (size_t)MP * D, D, 0.0625f, 1, nullptr}; sgemm2(lds, sg, bid, G, wave, tid); }
                if (rep == 5 && l + 1 < DEPTH) { LANE_STATE(); if (bid >= 64) convert_layer(kp, ws, lds, l + 1, 1, 4, gw - 64 * NWAVES, NGW - 64 * NWAVES, gt - 64 * NTHREADS, NGT - 64 * NTHREADS, lane, wave); }
            } else if (rep == 10) {
                LANE_STATE();
                pg8::GSched S; S.init(MP / 256, 2 * DFF / 256, G, bid); S.aPm = (size_t)256 * D * 2; S.bPn = (size_t)256 * D * 2;
                const pg8::Gemm g{XN, WUP_T, D, D, D};
                const pg8::EpiAct E{GU, INP(I_SCF) + (size_t)l * BS * 2 * DFF, out + O_CFS + (size_t)l * BS * 2 * DFF, SBG, SBU, SBL, INP(I_CFW) + (size_t)l * 3 * DFF, SSQ(3 * l + 2)};
                pg8::gemm_phase<pg8::EpiAct, pg8::GSched, true>(lds, g, S, E, wave_s);
                { LANE_STATE(); sgemm_act(lds, XN + (size_t)MP * D, WUP_T, GU + (size_t)MP * DFF, INP(I_CFW) + (size_t)l * 3 * DFF, INP(I_SCF) + (size_t)l * BS * 2 * DFF, out + O_CFS + (size_t)l * BS * 2 * DFF, bid, G, wave, tid); }
            } else if (rep == 1) {
                LANE_STATE();
                {
                    LAS bf16_t* vT = (LAS bf16_t*)lds;
                    constexpr int VP = 136;
                    const float* gvp = INP(I_GV) + l * CW; const float* bsp = INP(I_BSS) + l * 4 * 128;
                    for (int un = (bid + G / 2) % G; un < 8 + 256; un += G) {
                        int rowbase, nrows, sb = -1;
                        if (un < 8) { sb = un; rowbase = MP + un * TS; nrows = TS; } else { rowbase = (un - 8) * 128; nrows = 128; }
                        {
                            const int rl = tid >> 5, cgp = tid & 31;
                            f32x4 g0 = *(const f32x4*)(gvp + cgp * 8), g1 = *(const f32x4*)(gvp + cgp * 8 + 4);
                            for (int p = 0; p < nrows / 16; ++p) {
                                const int r = p * 16 + rl;
                                const u32x4 raw = *(const u32x4*)(gZ + (size_t)(rowbase + r) * INC + Z_VC + cgp * 8);
                                float v[8] = {bflo(raw.x), bfhi(raw.x), bflo(raw.y), bfhi(raw.y), bflo(raw.z), bfhi(raw.z), bflo(raw.w), bfhi(raw.w)};
                                float ss = 0.f;
#pragma unroll
                                for (int k = 0; k < 8; ++k) { v[k] = gelu_t(v[k]); ss += v[k] * v[k]; }
                                ss += shx(ss, 1, lane); ss += shx(ss, 2, lane); ss += shx(ss, 4, lane);
                                const float rstd = __builtin_amdgcn_rsqf(ss * (1.f / 64.f) + EPS);
                                const float gg[8] = {g0.x, g0.y, g0.z, g0.w, g1.x, g1.y, g1.z, g1.w};
#pragma unroll
                                for (int k = 0; k < 8; ++k) { v[k] = v[k] * rstd * gg[k]; vT[(cgp * 8 + k) * VP + r] = (bf16_t)f2bf(v[k]); }
                                if (sb >= 0) { float* vo = out + O_VCS + ((size_t)(l * BS + sb) * TS + r) * CW + cgp * 8;
                                    *(f32x4*)vo = (f32x4){v[0], v[1], v[2], v[3]}; *(f32x4*)(vo + 4) = (f32x4){v[4], v[5], v[6], v[7]}; }
                            }
                        }
                        __syncthreads();
                        {
                            const int hh = wave & 3, rh = wave >> 2, fr = lane & 15, fq = lane >> 4;
                            const int nmt = nrows == 128 ? 4 : (rh == 0 ? 2 : 0);
                            for (int mi = 0; mi < nmt; ++mi) {
                                const int mt = rh * 4 + mi, nks = (mt * 16 + 15) / 32 + 1;
                                f32x4 acc[4];
#pragma unroll
                                for (int n = 0; n < 4; ++n) acc[n] = (f32x4){0.f, 0.f, 0.f, 0.f};
                                for (int ks = 0; ks < nks; ++ks) {
                                    const bf16x8 a = *(const bf16x8*)(WST + ((size_t)(hh * 128 + mt * 16 + fr) * 128 + ks * 32 + fq * 8));
#pragma unroll
                                    for (int n = 0; n < 4; ++n) { const bf16x8 b = *(const LAS bf16x8*)(vT + (hh * 64 + n * 16 + fr) * VP + ks * 32 + fq * 8);
                                        acc[n] = __builtin_amdgcn_mfma_f32_16x16x32_bf16(b, a, acc[n], 0, 0, 0); }
                                }
                                { const int t = mt * 16 + fr; const float bias = bsp[hh * 128 + t]; const size_t row = (size_t)(rowbase + t);
#pragma unroll
                                    for (int n = 0; n < 4; ++n) { const int c = hh * 64 + n * 16 + fq * 4; const u32x2 uq = *(const u32x2*)(gZ + row * INC + Z_UC + c);
                                        u32x2 w; w.x = pk2(gelu_t(bflo(uq.x)) * (acc[n][0] + bias), gelu_t(bfhi(uq.x)) * (acc[n][1] + bias)); w.y = pk2(gelu_t(bflo(uq.y)) * (acc[n][2] + bias), gelu_t(bfhi(uq.y)) * (acc[n][3] + bias));
                                        *(u32x2*)(gY + row * D + 768 + c) = w; } }
                            }
                        }
                        __syncthreads();
                    }
                }
                {
                    LAS unsigned char* wl = lds + wave * 16384;
                    LAS bf16_t* tile = (LAS bf16_t*)wl;
                    LAS float* pre_r = (LAS float*)(wl + 2560);
                    LAS float* pre_i = (LAS float*)(wl + 2560 + 4096);
                    LAS float* xcf = (LAS float*)(wl + 2560 + 8192);
                    const int fr = lane & 15, fq = lane >> 4;
                    for (int un = gw; un < 64 + 2048; un += NGW) {
                        int b, hd, rowbase, nrows, t0; bool smp = un < 64;
                        if (smp) { b = un >> 3; hd = un & 7; rowbase = MP + b * TS; nrows = TS; t0 = 0; }
                        else { const int v = un - 64; const int ch = v & 31; hd = (v >> 5) & 7; b = v >> 8; t0 = ch * 128; rowbase = b * SEQ + t0; nrows = 128; }
                        const int cidx = l * AW + hd * 64 + lane;
                        const float br = INP(I_BRG)[cidx], bi = INP(I_BIG)[cidx];
                        const float c8sp = 8.0f * log1pf(__expf(-INP(I_LAM)[cidx]));
                        const float* caw = INP(I_CAW) + (size_t)l * 4 * AW + hd * 64 + lane;
                        const float cw0 = caw[0], cw1 = caw[AW], cw2 = caw[2 * AW], cw3 = caw[3 * AW], cb = INP(I_CAB)[cidx];
                        bf16x8 bR[4][2], bI[4][2];
#pragma unroll
                        for (int n = 0; n < 4; ++n)
#pragma unroll
                            for (int ks = 0; ks < 2; ++ks) { const size_t o_ = (size_t)(hd * 64 + n * 16 + fr) * 64 + ks * 32 + fq * 8;
                                bR[n][ks] = *(const bf16x8*)(GT_R + o_); bI[n][ks] = *(const bf16x8*)(GT_I + o_); }
                        float xm3 = 0.f, xm2 = 0.f, xm1 = 0.f;
                        if (smp) { const float* st = INP(I_SCA) + ((size_t)(l * BS + b) * 3) * AW + hd * 64 + lane; xm3 = st[0]; xm2 = st[AW]; xm1 = st[2 * AW]; }
                        else if (t0 > 0) { const bf16_t* zp = gZ + (size_t)(rowbase - 3) * INC + Z_XA + hd * 64 + lane; xm3 = bf2f(zp[0]); xm2 = bf2f(zp[INC]); xm1 = bf2f(zp[2 * INC]); }
                        float h = 0.f, pc = 1.f;
                        const bf16_t* zq = gZ + (size_t)(rowbase + (lane >> 3)) * INC + Z_XA + hd * 64 + (lane & 7) * 8;
                        unsigned* hp = (unsigned*)(HLOC + (size_t)rowbase * AW + hd * 64 + (lane & ~1)); unsigned* pp = (unsigned*)(PCUM + (size_t)rowbase * AW + hd * 64 + (lane & ~1));
                        LAS bf16_t* xraw = (LAS bf16_t*)pre_r;
                        u32x4 xn0 = *(const u32x4*)zq, xn1 = *(const u32x4*)(zq + (size_t)8 * INC);
                        for (int st = 0; st < nrows / 16; ++st) {
                            *(LAS u32x4*)(xraw + (lane >> 3) * 64 + (lane & 7) * 8) = xn0; *(LAS u32x4*)(xraw + ((lane >> 3) + 8) * 64 + (lane & 7) * 8) = xn1;
                            zq += (size_t)16 * INC;
                            if (st + 1 < nrows / 16) { xn0 = *(const u32x4*)zq; xn1 = *(const u32x4*)(zq + (size_t)8 * INC); }
                            LDS_WAIT();
#pragma unroll
                            for (int i = 0; i < 16; ++i) { const float xv = bf2f(xraw[i * 64 + lane]);
                                const float xc = cw0 * xm3 + cw1 * xm2 + cw2 * xm1 + cw3 * xv + cb; xm3 = xm2; xm2 = xm1; xm1 = xv; xcf[i * 64 + lane] = xc; tile[i * 72 + lane] = (bf16_t)f2bf(xc); }
                            LDS_WAIT();
                            const bf16x8 a0 = *(const LAS bf16x8*)(tile + fr * 72 + fq * 8), a1 = *(const LAS bf16x8*)(tile + fr * 72 + 32 + fq * 8);
#pragma unroll
                            for (int n = 0; n < 4; ++n) {
                                f32x4 ar = (f32x4){0.f, 0.f, 0.f, 0.f}, ai = (f32x4){0.f, 0.f, 0.f, 0.f};
                                ar = __builtin_amdgcn_mfma_f32_16x16x32_bf16(a0, bR[n][0], ar, 0, 0, 0); ar = __builtin_amdgcn_mfma_f32_16x16x32_bf16(a1, bR[n][1], ar, 0, 0, 0);
                                ai = __builtin_amdgcn_mfma_f32_16x16x32_bf16(a0, bI[n][0], ai, 0, 0, 0); ai = __builtin_amdgcn_mfma_f32_16x16x32_bf16(a1, bI[n][1], ai, 0, 0, 0);
#pragma unroll
                                for (int j = 0; j < 4; ++j) { pre_r[(fq * 4 + j) * 64 + n * 16 + fr] = ar[j]; pre_i[(fq * 4 + j) * 64 + n * 16 + fr] = ai[j]; }
                            }
                            LDS_WAIT();
#pragma unroll 4
                            for (int i = 0; i < 16; ++i) {
                                const float r = sigm(pre_r[i * 64 + lane] + br), gi = sigm(pre_i[i * 64 + lane] + bi);
                                const float la = -c8sp * r; float a, om;
                                if (la > -0.125f) { const float x = 2.0f * la; om = -x * (1.0f + x * (0.5f + x * (0.16666667f + x * (0.041666668f + x * (0.0083333338f + x * 0.0013888889f))))); a = 1.0f + la * (1.0f + la * (0.5f + la * (0.16666667f + la * (0.041666668f + la * 0.0083333338f)))); }
                                else { a = __expf(la); om = -expm1f(2.0f * la); }
                                const float bm = __builtin_amdgcn_sqrtf(om);
                                h = a * h + bm * gi * xcf[i * 64 + lane]; pc = pc * a;
                                { const float hn = __builtin_bit_cast(float, __builtin_amdgcn_mov_dpp(__builtin_bit_cast(int, h), 0xB1, 0xf, 0xf, true)), pn = __builtin_bit_cast(float, __builtin_amdgcn_mov_dpp(__builtin_bit_cast(int, pc), 0xB1, 0xf, 0xf, true));
                                  if ((lane & 1) == 0) { *hp = pk2(h, hn); *pp = pk2(pc, pn); } hp += AW / 2; pp += AW / 2; }
                            }
                            LDS_WAIT();
                        }
                        AGG[(size_t)un * 128 + lane] = pc; AGG[(size_t)un * 128 + 64 + lane] = h;
                    }
                }
                {
                    const float* cbw = INP(I_CBW) + (size_t)l * 3 * BW;
                    if (bid >= 8) for (int it = gt - 8 * NTHREADS; it < (MT / 8) * 32; it += NGT - 8 * NTHREADS) {
                        const int rb = it >> 5, c0 = (it & 31) * 8;
                        int b, t0, T, rowbase; const bool smp = rb >= MP / 8;
                        if (!smp) { b = rb >> 9; t0 = (rb & 511) * 8; T = SEQ; rowbase = rb * 8; } else { const int sbk = rb - MP / 8; b = sbk >> 2; t0 = (sbk & 3) * 8; T = TS; rowbase = MP + sbk * 8; }
                        u32x4 xq[10], cq[10], bq[8];
                        const bf16_t* zr = gZ + (size_t)rowbase * INC + c0;
#pragma unroll
                        for (int i = 0; i < 10; ++i) { if (i >= 2 || t0 > 0) { xq[i] = *(const u32x4*)(zr + (ptrdiff_t)(i - 2) * INC + Z_XB); cq[i] = *(const u32x4*)(zr + (ptrdiff_t)(i - 2) * INC + Z_GC); } else { xq[i] = (u32x4){0u, 0u, 0u, 0u}; cq[i] = (u32x4){0u, 0u, 0u, 0u}; } }
#pragma unroll
                        for (int i = 0; i < 8; ++i) bq[i] = *(const u32x4*)(zr + (size_t)i * INC + Z_GB);
                        float w0[8], w1[8], w2[8], pm2[8], pm1[8];
#pragma unroll
                        for (int k = 0; k < 8; ++k) { w0[k] = cbw[c0 + k]; w1[k] = cbw[BW + c0 + k]; w2[k] = cbw[2 * BW + c0 + k]; }
                        {
                            const float a_[8] = {bflo(xq[0].x) * bflo(cq[0].x), bfhi(xq[0].x) * bfhi(cq[0].x), bflo(xq[0].y) * bflo(cq[0].y), bfhi(xq[0].y) * bfhi(cq[0].y), bflo(xq[0].z) * bflo(cq[0].z), bfhi(xq[0].z) * bfhi(cq[0].z), bflo(xq[0].w) * bflo(cq[0].w), bfhi(xq[0].w) * bfhi(cq[0].w)};
                            const float b_[8] = {bflo(xq[1].x) * bflo(cq[1].x), bfhi(xq[1].x) * bfhi(cq[1].x), bflo(xq[1].y) * bflo(cq[1].y), bfhi(xq[1].y) * bfhi(cq[1].y), bflo(xq[1].z) * bflo(cq[1].z), bfhi(xq[1].z) * bfhi(cq[1].z), bflo(xq[1].w) * bflo(cq[1].w), bfhi(xq[1].w) * bfhi(cq[1].w)};
#pragma unroll
                            for (int k = 0; k < 8; ++k) { pm2[k] = a_[k]; pm1[k] = b_[k]; }
                        }
                        if (t0 == 0 && smp) { const float* st = INP(I_SCB) + ((size_t)(l * BS + b) * 2) * BW + c0;
#pragma unroll
                            for (int k = 0; k < 8; ++k) { pm2[k] = st[k]; pm1[k] = st[BW + k]; } }
#pragma unroll
                        for (int i = 0; i < 8; ++i) {
                            const u32x4 xb = xq[i + 2], gc = cq[i + 2], gb = bq[i];
                            const float pv[8] = {bflo(xb.x) * bflo(gc.x), bfhi(xb.x) * bfhi(gc.x), bflo(xb.y) * bflo(gc.y), bfhi(xb.y) * bfhi(gc.y), bflo(xb.z) * bflo(gc.z), bfhi(xb.z) * bfhi(gc.z), bflo(xb.w) * bflo(gc.w), bfhi(xb.w) * bfhi(gc.w)};
                            const float gbv[8] = {bflo(gb.x), bfhi(gb.x), bflo(gb.y), bfhi(gb.y), bflo(gb.z), bfhi(gb.z), bflo(gb.w), bfhi(gb.w)};
                            float yv[8];
#pragma unroll
                            for (int k = 0; k < 8; ++k) { yv[k] = gbv[k] * (w0[k] * pm2[k] + w1[k] * pm1[k] + w2[k] * pv[k]); pm2[k] = pm1[k]; pm1[k] = pv[k]; }
                            u32x4 w; w.x = pk2(yv[0], yv[1]); w.y = pk2(yv[2], yv[3]); w.z = pk2(yv[4], yv[5]); w.w = pk2(yv[6], yv[7]);
                            *(u32x4*)(gY + (size_t)(rowbase + i) * D + 512 + c0) = w;
                        }
                        if (t0 + 8 == T) { float* o = out + (smp ? O_CBS : O_CBP) + ((size_t)(l * 8 + b) * 2) * BW + c0;
#pragma unroll
                            for (int k = 0; k < 8; ++k) { o[k] = pm2[k]; o[BW + k] = pm1[k]; } }
                    }
                }
            } else if (rep == 2) {
                LANE_STATE();
                {
                    LAS float* cr = (LAS float*)lds;
                    for (int un = bid; un < 8 + 256; un += G) {
                        int b, ch, rowbase, nrows; const bool smp = un < 8;
                        if (smp) { b = un; ch = 0; rowbase = MP + b * TS; nrows = TS; } else { const int v = un - 8; b = v >> 5; ch = v & 31; rowbase = b * SEQ + ch * 128; nrows = 128; }
                        {
                            const int c = tid, hd = c >> 6, ln = c & 63; float carry = 0.f;
                            if (smp) carry = INP(I_SHA)[(size_t)(l * BS + b) * AW + c];
                            else { const float* ag = AGG + (size_t)(64 + (b << 8) + (hd << 5)) * 128 + ln; for (int k = 0; k < ch; ++k) carry = ag[(size_t)k * 128] * carry + ag[(size_t)k * 128 + 64]; }
                            cr[c] = carry;
                        }
                        __syncthreads();
                        const int c0 = (tid & 63) * 8, rsub = tid >> 6;
                        const f32x4 ca = *(const LAS f32x4*)(cr + c0), cb = *(const LAS f32x4*)(cr + c0 + 4);
                        for (int p = 0; p < nrows / 8; ++p) {
                            const int rloc = p * 8 + rsub; const size_t row = (size_t)(rowbase + rloc);
                            const u32x4 hq = *(const u32x4*)(HLOC + row * AW + c0), pq = *(const u32x4*)(PCUM + row * AW + c0);
                            const f32x4 h0 = (f32x4){bflo(hq.x), bfhi(hq.x), bflo(hq.y), bfhi(hq.y)}, h1 = (f32x4){bflo(hq.z), bfhi(hq.z), bflo(hq.w), bfhi(hq.w)}, p0 = (f32x4){bflo(pq.x), bfhi(pq.x), bflo(pq.y), bfhi(pq.y)}, p1 = (f32x4){bflo(pq.z), bfhi(pq.z), bflo(pq.w), bfhi(pq.w)};
                            const u32x4 gq = *(const u32x4*)(gZ + row * INC + Z_GA + c0);
                            const f32x4 a0 = h0 + p0 * ca, a1 = h1 + p1 * cb;
                            u32x4 w; w.x = pk2(gelu_t(bflo(gq.x)) * a0[0], gelu_t(bfhi(gq.x)) * a0[1]); w.y = pk2(gelu_t(bflo(gq.y)) * a0[2], gelu_t(bfhi(gq.y)) * a0[3]);
                            w.z = pk2(gelu_t(bflo(gq.z)) * a1[0], gelu_t(bfhi(gq.z)) * a1[1]); w.w = pk2(gelu_t(bflo(gq.w)) * a1[2], gelu_t(bfhi(gq.w)) * a1[3]);
                            *(u32x4*)(gY + row * D + c0) = w;
                            if ((smp || ch == 31) && rloc == nrows - 1) { float* o = out + (smp ? O_HAS : O_HAP) + (size_t)(l * 8 + b) * AW + c0; *(f32x4*)o = a0; *(f32x4*)(o + 4) = a1; }
                        }
                        if ((smp || ch == 31) && tid < 192) {
                            const int k = tid >> 6; const u32x4 xq = *(const u32x4*)(gZ + (size_t)(rowbase + nrows - 3 + k) * INC + Z_XA + c0);
                            float* o = out + (smp ? O_CAS : O_CAP) + ((size_t)(l * 8 + b) * 3 + k) * AW + c0;
                            *(f32x4*)o = (f32x4){bflo(xq.x), bfhi(xq.x), bflo(xq.y), bfhi(xq.y)}; *(f32x4*)(o + 4) = (f32x4){bflo(xq.z), bfhi(xq.z), bflo(xq.w), bfhi(xq.w)};
                        }
                        __syncthreads();
                    }
                }
            } else if (rep == 3 || rep == 8 || rep == 12) {
                LANE_STATE();
                if (rep == 12) {
                    const float* cfw = INP(I_CFW) + (size_t)l * 3 * DFF;
                    pg8::GSched S0; S0.init(MP / 256, D / 256, G, bid); pg8::Unit u0;
                    for (int i = 0; S0.next(i, u0); ++i) {
                        const int pm = u0.pm; if (pm >= 128 || tid >= DFF / 8) continue;
                        const int c0 = tid * 8, b = pm >> 4;
                        float w0[8], w1[8], w2[8], p2[8], p1[8], g0[8], g1[8], u0_[8], u1_[8];
#pragma unroll
                        for (int k = 0; k < 8; ++k) { w0[k] = cfw[c0 + k]; w1[k] = cfw[DFF + c0 + k]; w2[k] = cfw[2 * DFF + c0 + k]; p2[k] = 0.f; p1[k] = 0.f; }
                        if ((pm & 15) != 0) {
#pragma unroll
                            for (int k = 0; k < 8; ++k) { p2[k] = SBL[((size_t)(pm - 1) * 2 + 0) * DFF + c0 + k]; p1[k] = SBL[((size_t)(pm - 1) * 2 + 1) * DFF + c0 + k]; } }
#pragma unroll
                        for (int k = 0; k < 8; ++k) { g0[k] = SBG[((size_t)pm * 2 + 0) * DFF + c0 + k]; g1[k] = SBG[((size_t)pm * 2 + 1) * DFF + c0 + k]; u0_[k] = SBU[((size_t)pm * 2 + 0) * DFF + c0 + k]; u1_[k] = SBU[((size_t)pm * 2 + 1) * DFF + c0 + k]; }
                        float ha[8], hb[8];
#pragma unroll
                        for (int k = 0; k < 8; ++k) { ha[k] = silu(w0[k] * p2[k] + w1[k] * p1[k] + w2[k] * g0[k]) * u0_[k]; hb[k] = silu(w0[k] * p1[k] + w1[k] * g0[k] + w2[k] * g1[k]) * u1_[k]; }
                        u32x4 w; w.x = pk2(ha[0], ha[1]); w.y = pk2(ha[2], ha[3]); w.z = pk2(ha[4], ha[5]); w.w = pk2(ha[6], ha[7]);
                        *(u32x4*)(GU + (size_t)(pm * 256) * DFF + c0) = w;
                        w.x = pk2(hb[0], hb[1]); w.y = pk2(hb[2], hb[3]); w.z = pk2(hb[4], hb[5]); w.w = pk2(hb[6], hb[7]);
                        *(u32x4*)(GU + (size_t)(pm * 256 + 1) * DFF + c0) = w;
                        if ((pm & 15) == 15 && u0.pn == 0) { float* o = out + O_CFP + ((size_t)(l * 8 + b) * 2) * DFF + c0;
#pragma unroll
                            for (int k = 0; k < 8; ++k) { o[k] = SBL[((size_t)pm * 2 + 0) * DFF + c0 + k]; o[DFF + k] = SBL[((size_t)pm * 2 + 1) * DFF + c0 + k]; } }
                    }
                    asm volatile("s_waitcnt vmcnt(0)" ::: "memory"); __syncthreads();
                }
                GEMM_RES(rep == 3 ? 0 : (rep == 8 ? 1 : 2));
                { LANE_STATE();
                  const SG2 sg{rep == 12 ? GU + (size_t)MP * DFF : (rep == 3 ? gY : gO) + (size_t)MP * D, rep == 12 ? WDN_T : (rep == 3 ? WOUT_T : WO_T), rep == 12 ? DFF : D, rep == 12 ? DFF : D, rep == 12 ? DFF : D, D, XN + (size_t)MP * D, D, 1.f, 2, SSS(3 * l + (rep == 3 ? 1 : (rep == 8 ? 2 : 3)))};
                  sgemm2(lds, sg, bid, G, wave, tid); }
                if (l + 1 < DEPTH) { LANE_STATE(); if (bid >= 64) convert_layer(kp, ws, lds, l + 1, rep == 3 ? 0 : (rep == 8 ? 2 : 3), 4, gw - 64 * NWAVES, NGW - 64 * NWAVES, gt - 64 * NTHREADS, NGT - 64 * NTHREADS, lane, wave); }
            } else if (rep == 6) {
                LANE_STATE();
                for (int sub = 0; sub < 2; ++sub) {
                    pg8::GSched S; pg8::Gemm g; pg8::EpiSoftmax E;
                    if (sub == 0) { S.init(MP / 256, 4, G, bid); S.aPm = (size_t)256 * D * 2; S.aPn = 512; S.bPn = 512; S.bPm = (size_t)256 * D * 2; S.bShift = 4; g = pg8::Gemm{gQ, KBP, D, D, 256}; E.O = gP; E.ldc = D; E.smp = 0; }
                    else { S.init(1, 32, G, (bid + G - 64) % G); S.mode = 1; g = pg8::Gemm{gQ + (size_t)MP * D, KBS, D, D, 256}; E.O = PS; E.ldc = 8192; E.smp = 1; }
                    pg8::gemm_phase<pg8::EpiSoftmax, pg8::GSched, true>(lds, g, S, E, wave_s);
                }
            }
            if (rep == 6) { asm volatile("s_waitcnt vmcnt(0)" ::: "memory"); __syncthreads(); }
            else GRID_SYNC();
          }
        }
    }
    {
        LANE_STATE();
        const float* gain = INP(I_GFIN);
        f32x4 gv[4];
#pragma unroll
        for (int j = 0; j < 4; ++j) gv[j] = ((const f32x4*)gain)[lane + 64 * j];
        for (int m0 = gw; m0 < MT; m0 += 2 * NGW) {
            const int m1 = m0 + NGW; const bool two = m1 < MT; const int mb = two ? m1 : m0;
            const u32x2* xa = (const u32x2*)(XN + (size_t)m0 * D) + lane; const u32x2* xb = (const u32x2*)(XN + (size_t)mb * D) + lane;
            u32x2 pa[4], pb[4];
#pragma unroll
            for (int j = 0; j < 4; ++j) { pa[j] = xa[64 * j]; pb[j] = xb[64 * j]; }
            float ra, rb;
            { float qa = 0.f, qb = 0.f;
#pragma unroll
              for (int j = 0; j < 4; ++j) { const float a0 = bflo(pa[j].x), a1 = bfhi(pa[j].x), a2 = bflo(pa[j].y), a3 = bfhi(pa[j].y), b0 = bflo(pb[j].x), b1 = bfhi(pb[j].x), b2 = bflo(pb[j].y), b3 = bfhi(pb[j].y);
                  qa += (a0 * a0 + a1 * a1) + (a2 * a2 + a3 * a3); qb += (b0 * b0 + b1 * b1) + (b2 * b2 + b3 * b3); }
              if (m0 < MP) ra = ss_rstd(*(const f32x4*)(SSQ(6) + (size_t)m0 * 4)); else ra = 1.0f / sqrtf(wave_sum(qa, lane) * (1.f / D) + EPS);
              if (mb < MP) rb = ss_rstd(*(const f32x4*)(SSQ(6) + (size_t)mb * 4)); else rb = 1.0f / sqrtf(wave_sum(qb, lane) * (1.f / D) + EPS); }
            f32x4* ya = (f32x4*)(out + (size_t)m0 * D) + lane; f32x4* yb = (f32x4*)(out + (size_t)mb * D) + lane;
#pragma unroll
            for (int j = 0; j < 4; ++j) { ya[64 * j] = (f32x4){bflo(pa[j].x), bfhi(pa[j].x), bflo(pa[j].y), bfhi(pa[j].y)} * ra * gv[j]; if (two) yb[64 * j] = (f32x4){bflo(pb[j].x), bfhi(pb[j].x), bflo(pb[j].y), bfhi(pb[j].y)} * rb * gv[j]; }
        }
    }
}

extern "C" void kernel_launch(void* const* d_in, const int* in_sizes, int n_in, void* d_out, int out_size, void* d_ws, size_t ws_size, hipStream_t stream) {
    static int grid = 0;
    if (grid == 0) {
        if (n_in != N_IN || (size_t)out_size != O_END || ws_size < 512 * MiB) { fprintf(stderr, "kernel_launch: unexpected sizes n_in %d out %d ws %zu (need %zu)\n", n_in, out_size, ws_size, (size_t)(512 * MiB)); grid = -1; return; }
        int dev = 0, cus = 0, per_cu = 0;
        (void)hipGetDevice(&dev); (void)hipDeviceGetAttribute(&cus, hipDeviceAttributeMultiprocessorCount, dev);
        if (hipFuncSetAttribute((const void*)trunk_fwd, hipFuncAttributeMaxDynamicSharedMemorySize, LDS_BYTES) != hipSuccess) { fprintf(stderr, "kernel_launch: hipFuncSetAttribute failed\n"); grid = -1; return; }
        if (hipOccupancyMaxActiveBlocksPerMultiprocessor(&per_cu, (const void*)trunk_fwd, NTHREADS, LDS_BYTES) != hipSuccess || per_cu < 1) { fprintf(stderr, "kernel_launch: occupancy query gave %d\n", per_cu); per_cu = 1; }
        (void)hipGetLastError();
        grid = cus * 1;
        if (grid != 256) fprintf(stderr, "kernel_launch: note: %d CUs\n", grid);
    }
    if (grid < 0) return;
    Args a{};
    for (int i = 0; i < N_IN; ++i) a.in[i] = (const float*)d_in[i];
    a.out = (float*)d_out; a.ws = (unsigned char*)d_ws;
    void* kargs[] = {&a};
    hipError_t e = hipLaunchCooperativeKernel((const void*)trunk_fwd, dim3(grid), dim3(NTHREADS), kargs, LDS_BYTES, stream);
    if (e != hipSuccess) fprintf(stderr, "kernel_launch: cooperative launch failed: %s (grid %d)\n", hipGetErrorString(e), grid);
}
```

```cpp
#include <hip/hip_runtime.h>
#include <hip/hip_cooperative_groups.h>
#include <cstdio>
#include <cstdint>
namespace cg = cooperative_groups;
#ifndef PROBE
#define PROBE 0
#endif

#define LAS __attribute__((address_space(3)))
typedef unsigned short bf16_t;
typedef short bf16x8 __attribute__((ext_vector_type(8)));
typedef float f32x4 __attribute__((ext_vector_type(4)));
typedef float f32x2 __attribute__((ext_vector_type(2)));
typedef unsigned u32x4 __attribute__((ext_vector_type(4)));
typedef unsigned u32x2 __attribute__((ext_vector_type(2)));

constexpr int D = 1024, BP = 8, SEQ = 4096, BS = 8, TS = 32, DEPTH = 2;
constexpr int MP = BP * SEQ, MS = BS * TS, MT = MP + MS;
constexpr int INC = 2304, DFF = 2816, NMEM = 256, AW = 512, BW = 256, CW = 256;
constexpr int Z_XA = 0, Z_GA = 512, Z_XB = 1024, Z_GB = 1280, Z_GC = 1536, Z_UC = 1792, Z_VC = 2048;
constexpr float EPS = 1e-6f;
constexpr int NWAVES = 8, NTHREADS = 512;

constexpr size_t O_YP = 0, O_YS = O_YP + (size_t)MP * D, O_CAP = O_YS + (size_t)MS * D, O_HAP = O_CAP + DEPTH * BP * 3 * AW,
                 O_CBP = O_HAP + DEPTH * BP * AW, O_CFP = O_CBP + DEPTH * BP * 2 * BW, O_MKP = O_CFP + DEPTH * BP * 2 * DFF,
                 O_MVP = O_MKP + (size_t)DEPTH * BP * NMEM * D, O_CAS = O_MVP + (size_t)DEPTH * BP * NMEM * D, O_HAS = O_CAS + DEPTH * BS * 3 * AW,
                 O_CBS = O_HAS + DEPTH * BS * AW, O_CFS = O_CBS + DEPTH * BS * 2 * BW, O_VCS = O_CFS + DEPTH * BS * 2 * DFF,
                 O_END = O_VCS + DEPTH * BS * TS * CW;

constexpr size_t MiB = 1u << 20;
constexpr size_t WS_WIN = 0, WS_WOUT = 5 * MiB, WS_WQ = 7 * MiB, WS_WK = 9 * MiB, WS_WV = 11 * MiB, WS_WO = 13 * MiB, WS_WUP = 15 * MiB, WS_WDN = 26 * MiB;
constexpr size_t WS_MEMB = 32 * MiB, WS_KBP = 36 * MiB, WS_VTP = 40 * MiB, WS_KBS = 44 * MiB, WS_VTS = 48 * MiB, WS_WST = 52 * MiB, WS_GT = WS_WST + 131072, WS_AGG = 53 * MiB, WS_SS = 54 * MiB + 256 * 1024, WS_BAR = 55 * MiB + 512 * 1024;
constexpr size_t WS_XN = 56 * MiB, WS_BIG = 121 * MiB;
constexpr size_t B_Z = WS_BIG, B_HLOC = WS_BIG + 146 * MiB, B_PCUM = WS_BIG + 211 * MiB, B_Y = WS_BIG + 276 * MiB;
constexpr size_t B_Q = WS_BIG, B_P = WS_BIG + 65 * MiB, B_O = WS_BIG + 130 * MiB, B_PS = WS_BIG + 195 * MiB;
constexpr size_t B_GU = WS_BIG;
constexpr size_t B_GUS = WS_BIG + 200 * MiB;
constexpr size_t B_SBG = WS_BIG + 204 * MiB, B_SBU = WS_BIG + 207 * MiB, B_SBL = WS_BIG + 210 * MiB;
constexpr size_t WS_END = WS_BIG + (size_t)MT * 2 * DFF * 2;
constexpr size_t WS_SSP = 476 * MiB;
static_assert(WS_END <= WS_SSP && WS_SSP + (size_t)7 * MT * 64 <= 512 * MiB, "workspace");
static_assert(WS_XN + (size_t)MT * D * 2 <= WS_BIG, "xn");
constexpr size_t WS_SSS = WS_SSP + (((size_t)7 * MT * 16 + 4095) / 4096) * 4096;
static_assert(WS_SSS + 7 * 256 * 32 * 4 <= 480 * MiB, "sss");
constexpr size_t WSEL1 = 480 * MiB, KSEL1 = 418 * MiB;
static_assert(WS_WDN + (size_t)D * DFF * 2 + WSEL1 <= 512 * MiB && WS_KBS + KSEL1 >= WS_BIG + 341 * MiB && WS_GT + 131072 + KSEL1 <= WS_SSP, "second buffer set");

constexpr int LDS_RING = 131072, LDS_EX = LDS_RING, LDS_MISC = LDS_EX + 8192, LDS_BYTES = 147456;

enum { I_XP = 0, I_XS, I_MEM, I_CK, I_CV, I_SCA, I_SHA, I_SCB, I_SCF, I_GMIX, I_WIN, I_CAW, I_CAB, I_WRG, I_BRG, I_WIG, I_BIG, I_LAM, I_CBW, I_GV, I_WS, I_BSS,
       I_WOUT, I_GX, I_WQ, I_WK, I_WV, I_WO, I_GFFN, I_WUP, I_CFW, I_WDN, I_GFIN, N_IN };

struct Args { const float* in[N_IN]; float* out; unsigned char* ws; };

__device__ __forceinline__ unsigned pk2(float lo, float hi) { unsigned r; asm("v_cvt_pk_bf16_f32 %0, %1, %2" : "=v"(r) : "v"(lo), "v"(hi)); return r; }
__device__ __forceinline__ unsigned f2bf(float f) { return pk2(f, f) & 0xffffu; }
__device__ __forceinline__ float bf2f(unsigned v) { return __builtin_bit_cast(float, v << 16); }
__device__ __forceinline__ float bflo(unsigned w) { return __builtin_bit_cast(float, w << 16); }
__device__ __forceinline__ float bfhi(unsigned w) { return __builtin_bit_cast(float, w & 0xffff0000u); }
__device__ __forceinline__ unsigned cvt_pk_bf16(float lo, float hi) { unsigned r; asm volatile("v_cvt_pk_bf16_f32 %0, %1, %2" : "=v"(r) : "v"(lo), "v"(hi)); return r; }
__device__ __forceinline__ float fexp(float x) { return __builtin_amdgcn_exp2f(x * 1.4426950408889634f); }
__device__ __forceinline__ float sigm(float x) { return __builtin_amdgcn_rcpf(1.0f + fexp(-x)); }
__device__ __forceinline__ float gelu_t(float x) { const float u = 0.7978845608028654f * (x + 0.044715f * x * x * x); return x * sigm(2.0f * u); }
__device__ __forceinline__ float silu(float x) { return x * sigm(x); }
__device__ __forceinline__ float shx(float v, int m, int lane) { return __builtin_bit_cast(float, __builtin_amdgcn_ds_bpermute((lane ^ m) << 2, __builtin_bit_cast(int, v))); }
__device__ __forceinline__ float wave_sum(float v, int lane) {
#pragma unroll
    for (int o = 1; o < 64; o <<= 1) v += shx(v, o, lane);
    return v;
}
#define LDS_WAIT() asm volatile("s_waitcnt lgkmcnt(0)" ::: "memory")
__device__ __forceinline__ float ss_rstd(f32x4 p) { return __builtin_amdgcn_rsqf(((p[0] + p[1]) + (p[2] + p[3])) * (1.f / 1024.f) + 1e-6f); }
__device__ __forceinline__ int opaque_tid(int wave_s) { int l; asm volatile("v_mbcnt_lo_u32_b32 %0, -1, 0\n\tv_mbcnt_hi_u32_b32 %0, -1, %0" : "=v"(l)); return wave_s * 64 + l; }

namespace pg8 {
constexpr int BM = 256, BK = 64, HALF = 128, HTB = HALF * BK * 2, NXCD = 8, WGM = 8;
__device__ __forceinline__ int lds_byte(int r, int c) { const int st = (r >> 4) * 2 + (c >> 5), rr = r & 15, cc = c & 31, ob = rr * 64 + cc * 2; return st * 1024 + (ob ^ (((ob >> 9) & 1) << 5)); }
__device__ __forceinline__ void stage_rc(int b, int& R, int& C) { const int st = b / 1024, sb = b % 1024, swz = sb ^ (((sb >> 9) & 1) << 5); R = (st >> 1) * 16 + swz / 64; C = (st & 1) * 32 + (swz % 64) / 2; }
__device__ __forceinline__ int perm32(int rho) { const int n = rho >> 4, i = rho & 15; return 8 * (i >> 2) + 4 * n + (i & 3); }

struct Unit { int pm, pn; };
struct Gemm { const bf16_t* A; const bf16_t* Bt; int lda, ldb, K; };

struct GSched {
    int nM, nN, nwg, G, c, mode;
    size_t aPm, aPn, bPn, bPm; int bShift;
    __device__ __forceinline__ void init(int nM_, int nN_, int G_, int c_) { nM = nM_; nN = nN_; nwg = nM * nN; G = G_; c = c_; mode = 0; aPm = 0; aPn = 0; bPn = 0; bPm = 0; bShift = 0; }
    __device__ __forceinline__ bool next(int i, Unit& u) const {
        const long L = (long)i * G + c; if (L >= nwg) return false;
        int wgid = (int)L; { const int q = nwg / NXCD, r = nwg % NXCD, xcd = wgid % NXCD, off = wgid / NXCD; wgid = (xcd < r ? xcd * (q + 1) : r * (q + 1) + (xcd - r) * q) + off; }
        const int nig = WGM * nN, gid = wgid / nig, fm = gid * WGM, gsz = (nM - fm) < WGM ? (nM - fm) : WGM;
        u.pm = fm + ((wgid % nig) % gsz); u.pn = (wgid % nig) / gsz; return true;
    }
    __device__ __forceinline__ size_t offA(const Unit& u) const { return mode == 1 ? (size_t)(u.pn & 3) * 512 : (mode == 2 ? (size_t)(u.pn & 3) * 4096 + (size_t)(u.pn >> 2) * 512 : (size_t)u.pm * aPm + (size_t)u.pn * aPn); }
    __device__ __forceinline__ size_t offB(const Unit& u) const { return mode == 1 ? (size_t)(u.pn >> 2) * (256 * 1024 * 2) + (size_t)(u.pn & 3) * 512 : (mode == 2 ? (size_t)(u.pn & 3) * (256 * 2048 * 2) + (size_t)(u.pn >> 2) * 512 : (size_t)u.pn * bPn + (size_t)(u.pm >> bShift) * bPm); }
};

struct EpiBf16 {
    static constexpr bool PERM = true;
    bf16_t* O; int ldc; float scale; const float* ss; int smp;
    __device__ __forceinline__ void operator()(f32x4 (&acc)[2][2][4][2], const Unit& u, int wr, int wc, int fr, int fq, LAS unsigned char*) const {
        asm volatile("" : "+v"(fr), "+v"(fq)); asm volatile("" : "+s"(wr), "+s"(wc));
        const int row0 = u.pm * BM + wr * 64 + fr, col0 = (smp ? (u.pn & 3) : u.pn) * BM + wc * 32 + 8 * fq;
        f32x4 rs[2][4];
#pragma unroll
        for (int ai = 0; ai < 2; ++ai)
#pragma unroll
            for (int m = 0; m < 4; ++m) rs[ai][m] = ss ? *(const f32x4*)(ss + (size_t)(row0 + ai * HALF + m * 16) * 4) : (f32x4){0.f, 0.f, 0.f, 0.f};
#pragma unroll
        for (int ai = 0; ai < 2; ++ai)
#pragma unroll
            for (int m = 0; m < 4; ++m) { bf16_t* rowp = O + (size_t)(row0 + ai * HALF + m * 16) * ldc + col0;
                float sc = scale; if (ss) sc *= ss_rstd(rs[ai][m]);
                if (smp && ((ai * HALF + wr * 64 + m * 16 + fr) >> 5) != (u.pn >> 2)) continue;
#pragma unroll
                for (int bj = 0; bj < 2; ++bj) { const f32x4 v0 = acc[ai][bj][m][0] * sc, v1 = acc[ai][bj][m][1] * sc;
                    u32x4 w; w.x = cvt_pk_bf16(v0[0], v0[1]); w.y = cvt_pk_bf16(v0[2], v0[3]); w.z = cvt_pk_bf16(v1[0], v1[1]); w.w = cvt_pk_bf16(v1[2], v1[3]);
                    *(u32x4*)(rowp + bj * HALF) = w; } }
    }
};
struct EpiResid {
    static constexpr bool PERM = true;
    bf16_t* xb; float* ss;
    __device__ __forceinline__ void operator()(f32x4 (&acc)[2][2][4][2], const Unit& u, int wr, int wc, int fr, int fq, LAS unsigned char* lds) const {
        asm volatile("" : "+v"(fr), "+v"(fq)); asm volatile("" : "+s"(wr), "+s"(wc));
        const int col0 = u.pn * BM + wc * 32 + 8 * fq, lane = fq * 16 + fr;
        LAS float* PS = (LAS float*)(lds + LDS_EX);
        bf16_t* ob = xb + (size_t)u.pm * BM * D;
#pragma unroll
        for (int ai = 0; ai < 2; ++ai) {
            u32x4 pre[4][2];
#pragma unroll
            for (int m = 0; m < 4; ++m)
#pragma unroll
                for (int bj = 0; bj < 2; ++bj) pre[m][bj] = *(const u32x4*)(ob + (size_t)(ai * HALF + wr * 64 + m * 16 + fr) * D + col0 + bj * HALF);
            asm volatile("" ::: "memory");
#pragma unroll
            for (int m = 0; m < 4; ++m) { const int rl = ai * HALF + wr * 64 + m * 16 + fr; const size_t off = (size_t)rl * D + col0; float q = 0.f;
#pragma unroll
                for (int bj = 0; bj < 2; ++bj) { const u32x4 p = pre[m][bj]; const f32x4 a0 = acc[ai][bj][m][0], a1 = acc[ai][bj][m][1];
                    const float v0 = bflo(p.x) + a0[0], v1 = bfhi(p.x) + a0[1], v2 = bflo(p.y) + a0[2], v3 = bfhi(p.y) + a0[3], v4 = bflo(p.z) + a1[0], v5 = bfhi(p.z) + a1[1], v6 = bflo(p.w) + a1[2], v7 = bfhi(p.w) + a1[3];
                    u32x4 w; w.x = cvt_pk_bf16(v0, v1); w.y = cvt_pk_bf16(v2, v3); w.z = cvt_pk_bf16(v4, v5); w.w = cvt_pk_bf16(v6, v7); *(u32x4*)(ob + off + bj * HALF) = w;
                    q += ((v0 * v0 + v1 * v1) + (v2 * v2 + v3 * v3)) + ((v4 * v4 + v5 * v5) + (v6 * v6 + v7 * v7)); }
                q += shx(q, 16, lane); q += shx(q, 32, lane);
                if (fq == 0) PS[rl * 4 + wc] = q; }
            asm volatile("" ::: "memory");
        }
        asm volatile("s_waitcnt lgkmcnt(0)" ::: "memory"); __builtin_amdgcn_s_barrier(); asm volatile("" ::: "memory");
        { const int t = (wr * 4 + wc) * 64 + lane; if (t < 256) { const f32x4 p = *(const LAS f32x4*)(PS + t * 4); ss[(size_t)(u.pm * BM + t) * 4 + u.pn] = (p[0] + p[1]) + (p[2] + p[3]); } }
    }
};
struct EpiKV {
    static constexpr bool PERM = false;
    float* outK; float* outV; bf16_t* KB; bf16_t* VT;
    __device__ __forceinline__ void operator()(f32x4 (&acc)[2][2][4][2], const Unit& u, int wr, int wc, int fr, int fq, LAS unsigned char*) const {
        asm volatile("" : "+v"(fr), "+v"(fq)); asm volatile("" : "+s"(wr), "+s"(wc));
        const int kind = u.pm >> 4, pm = u.pm & 15;
        const int col0 = u.pn * BM + wc * 32 + 4 * fq;
        float* of = kind == 0 ? outK : outV; bf16_t* ob = kind == 0 ? KB : VT; const int ldb_ = kind == 2 ? 2048 : 1024;
#pragma unroll
        for (int ai = 0; ai < 2; ++ai)
#pragma unroll
            for (int m = 0; m < 4; ++m) { const int row = pm * BM + ai * HALF + wr * 64 + m * 16 + fr;
#pragma unroll
                for (int bj = 0; bj < 2; ++bj)
#pragma unroll
                    for (int n = 0; n < 2; ++n) { const f32x4 v = acc[ai][bj][m][n]; const int col = col0 + bj * HALF + n * 16;
                        if (kind != 2) *(f32x4*)(of + (size_t)row * 1024 + col) = v;
                        if (kind != 1) { u32x2 w; w.x = cvt_pk_bf16(v[0], v[1]); w.y = cvt_pk_bf16(v[2], v[3]); *(u32x2*)(ob + (size_t)row * ldb_ + col) = w; } } }
    }
};
struct EpiSoftmax {
    static constexpr bool PERM = true;
    bf16_t* O; int ldc; int smp;
    __device__ __forceinline__ void operator()(f32x4 (&acc)[2][2][4][2], const Unit& u, int wr, int wc, int fr, int fq, LAS unsigned char* lds) const {
        asm volatile("" : "+v"(fr), "+v"(fq)); asm volatile("" : "+s"(wr), "+s"(wc));
        LAS f32x2* EX = (LAS f32x2*)(lds + LDS_EX);
        const int lane = fq * 16 + fr;
        const float L2E = 1.4426950408889634f;
#pragma unroll
        for (int ai = 0; ai < 2; ++ai)
#pragma unroll
            for (int m = 0; m < 4; ++m) {
                float mx = -3.0e38f;
#pragma unroll
                for (int bj = 0; bj < 2; ++bj)
#pragma unroll
                    for (int n = 0; n < 2; ++n) { const f32x4 x = acc[ai][bj][m][n]; mx = fmaxf(mx, fmaxf(fmaxf(x[0], x[1]), fmaxf(x[2], x[3]))); }
                mx = fmaxf(mx, shx(mx, 16, lane)); mx = fmaxf(mx, shx(mx, 32, lane));
                float s = 0.f;
#pragma unroll
                for (int bj = 0; bj < 2; ++bj)
#pragma unroll
                    for (int n = 0; n < 2; ++n) { f32x4 x = acc[ai][bj][m][n];
#pragma unroll
                        for (int j = 0; j < 4; ++j) { x[j] = __builtin_amdgcn_exp2f((x[j] - mx) * L2E); s += x[j]; }
                        acc[ai][bj][m][n] = x; }
                s += shx(s, 16, lane); s += shx(s, 32, lane);
                if (fq == 0) EX[(ai * HALF + wr * 64 + m * 16 + fr) * 4 + wc] = (f32x2){mx, s};
            }
        asm volatile("s_waitcnt lgkmcnt(0)" ::: "memory"); __builtin_amdgcn_s_barrier(); asm volatile("" ::: "memory");
        int colb = u.pn * BM, j_ = 0;
        if (smp) { colb = (u.pn & 3) * 2048 + (u.pn >> 2) * 256; j_ = u.pn >> 2; }
        const int col0 = colb + wc * 32 + 8 * fq;
#pragma unroll
        for (int ai = 0; ai < 2; ++ai)
#pragma unroll
            for (int m = 0; m < 4; ++m) {
                const int rl = ai * HALF + wr * 64 + m * 16 + fr;
                const f32x2 e0 = EX[rl * 4 + 0], e1 = EX[rl * 4 + 1], e2 = EX[rl * 4 + 2], e3 = EX[rl * 4 + 3];
                const float M = fmaxf(fmaxf(e0.x, e1.x), fmaxf(e2.x, e3.x));
                const float tot = e0.y * __builtin_amdgcn_exp2f((e0.x - M) * L2E) + e1.y * __builtin_amdgcn_exp2f((e1.x - M) * L2E) + e2.y * __builtin_amdgcn_exp2f((e2.x - M) * L2E) + e3.y * __builtin_amdgcn_exp2f((e3.x - M) * L2E);
                const float own = wc == 0 ? e0.x : (wc == 1 ? e1.x : (wc == 2 ? e2.x : e3.x));
                float f = __builtin_amdgcn_exp2f((own - M) * L2E) * __builtin_amdgcn_rcpf(tot);
                if (smp && (rl >> 5) != j_) f = 0.f;
                bf16_t* rowp = O + (size_t)(u.pm * BM + rl) * ldc + col0;
#pragma unroll
                for (int bj = 0; bj < 2; ++bj) { const f32x4 v0 = acc[ai][bj][m][0] * f, v1 = acc[ai][bj][m][1] * f;
                    u32x4 w; w.x = cvt_pk_bf16(v0[0], v0[1]); w.y = cvt_pk_bf16(v0[2], v0[3]); w.z = cvt_pk_bf16(v1[0], v1[1]); w.w = cvt_pk_bf16(v1[2], v1[3]);
                    *(u32x4*)(rowp + bj * HALF) = w; } }
    }
};


__device__ __forceinline__ float dpp_ror1(float v) { return __builtin_bit_cast(float, __builtin_amdgcn_update_dpp(0, __builtin_bit_cast(int, v), 0x121, 0xf, 0xf, false)); }
__device__ __forceinline__ float dpp_ror2(float v) { return __builtin_bit_cast(float, __builtin_amdgcn_update_dpp(0, __builtin_bit_cast(int, v), 0x122, 0xf, 0xf, false)); }
struct EpiAct {
    static constexpr bool PERM = true;
    bf16_t* H; const float* scf; float* ocf; float* sbg; float* sbu; float* sbl; const float* cfw; const float* ss;
    __device__ __forceinline__ void operator()(f32x4 (&acc)[2][2][4][2], const Unit& u, int wr, int wc, int fr, int fq, LAS unsigned char* lds) const {
        asm volatile("" : "+s"(wr), "+s"(wc));
        int lane; asm volatile("v_mbcnt_lo_u32_b32 %0, -1, 0\n\tv_mbcnt_hi_u32_b32 %0, -1, %0" : "=v"(lane));
        fr = lane & 15; fq = lane >> 4;
        const int fl = wc * 32 + 8 * fq, f0 = u.pn * 128 + fl; int rowt = wr * 64 + fr;
        {
            float rst[2][4];
            f32x4 rsl[2][4];
#pragma unroll
            for (int ai = 0; ai < 2; ++ai)
#pragma unroll
                for (int m = 0; m < 4; ++m) rsl[ai][m] = *(const f32x4*)(ss + (size_t)(u.pm * BM + ai * HALF + rowt + m * 16) * 4);
#pragma unroll
            for (int ai = 0; ai < 2; ++ai)
#pragma unroll
                for (int m = 0; m < 4; ++m) { rst[ai][m] = ss_rstd(rsl[ai][m]); }
#pragma unroll
            for (int ai = 0; ai < 2; ++ai)
#pragma unroll
                for (int m = 0; m < 4; ++m) { acc[ai][0][m][0] = acc[ai][0][m][0] * rst[ai][m]; acc[ai][0][m][1] = acc[ai][0][m][1] * rst[ai][m]; acc[ai][1][m][0] = acc[ai][1][m][0] * rst[ai][m]; acc[ai][1][m][1] = acc[ai][1][m][1] * rst[ai][m]; }
        }
        const bool smp = (u.pm == 128);
        asm volatile("" : "+v"(rowt));
        LAS float* BND = (LAS float*)(lds + LDS_EX);
        if (fr >= 14) {
#pragma unroll
            for (int ai = 0; ai < 2; ++ai)
#pragma unroll
                for (int n = 0; n < 2; ++n) *(LAS f32x4*)(BND + ((ai * 2 + wr) * 2 + (fr - 14)) * 128 + fl + 4 * n) = acc[ai][0][3][n];
            if (wr == 1) {
#pragma unroll
                for (int n = 0; n < 2; ++n) *(f32x4*)(sbl + ((size_t)u.pm * 2 + (fr - 14)) * DFF + f0 + 4 * n) = acc[1][0][3][n];
            }
        }
        asm volatile("s_waitcnt lgkmcnt(0)" ::: "memory"); __builtin_amdgcn_s_barrier(); asm volatile("" ::: "memory");
#pragma unroll
        for (int ai = 0; ai < 2; ++ai) {
            const int pg = wr == 1 ? ai * 2 : 1;
            u32x2 hp[2][4];
#pragma unroll
            for (int n = 0; n < 2; ++n) {
                const f32x4 w0 = *(const f32x4*)(cfw + f0 + 4 * n), w1 = *(const f32x4*)(cfw + DFF + f0 + 4 * n), w2 = *(const f32x4*)(cfw + 2 * DFF + f0 + 4 * n);
                f32x4 h2 = *(const LAS f32x4*)(BND + (pg * 2 + 0) * 128 + fl + 4 * n), h1 = *(const LAS f32x4*)(BND + (pg * 2 + 1) * 128 + fl + 4 * n);
                f32x4 t2 = h2, t1 = h1;
                if (smp) { const float* sp = scf + (size_t)((ai * 4 + wr * 2) * 2) * DFF + f0 + 4 * n; h2 = *(const f32x4*)sp; h1 = *(const f32x4*)(sp + DFF); t2 = *(const f32x4*)(sp + 2 * DFF); t1 = *(const f32x4*)(sp + 3 * DFF); }
#pragma unroll
                for (int jp = 0; jp < 2; ++jp) {
                    const int j0 = jp * 2, j1 = jp * 2 + 1;
                    const f32x2 w0p = {w0[j0], w0[j1]}, w1p = {w1[j0], w1[j1]}, w2p = {w2[j0], w2[j1]};
                    f32x2 r1p = {h1[j0], h1[j1]}, r2p = fr == 0 ? (f32x2){h2[j0], h2[j1]} : (f32x2){h1[j0], h1[j1]};
#pragma unroll
                    for (int m = 0; m < 4; ++m) {
                        const f32x2 g = {acc[ai][0][m][n][j0], acc[ai][0][m][n][j1]}, uu = {acc[ai][1][m][n][j0], acc[ai][1][m][n][j1]};
                        if (m == 2 && smp) { r1p = (f32x2){t1[j0], t1[j1]}; r2p = fr == 0 ? (f32x2){t2[j0], t2[j1]} : (f32x2){t1[j0], t1[j1]}; }
                        const f32x2 r1 = {dpp_ror1(g.x), dpp_ror1(g.y)}, r2 = {dpp_ror2(g.x), dpp_ror2(g.y)};
                        const f32x2 gm1 = fr >= 1 ? r1 : r1p, gm2 = fr >= 2 ? r2 : r2p;
                        r1p = r1; r2p = r2;
                        const f32x2 cv = w0p * gm2 + w1p * gm1 + w2p * g;
                        const f32x2 ex = cv * (-1.4426950408889634f);
                        f32x2 den; den.x = __builtin_amdgcn_exp2f(ex.x); den.y = __builtin_amdgcn_exp2f(ex.y); den = den + 1.0f;
                        f32x2 rc; rc.x = __builtin_amdgcn_rcpf(den.x); rc.y = __builtin_amdgcn_rcpf(den.y);
                        const f32x2 hv = (cv * rc) * uu;
                        const unsigned pk = cvt_pk_bf16(hv.x, hv.y); if (jp == 0) hp[n][m].x = pk; else hp[n][m].y = pk;
                    }
                }
            }
#pragma unroll
            for (int m = 0; m < 4; ++m) {
                const int rl = ai * HALF + rowt + m * 16;
                if (smp && (m & 1) && fr >= 14) {
#pragma unroll
                    for (int n = 0; n < 2; ++n) *(f32x4*)(ocf + ((size_t)(ai * 4 + wr * 2 + (m >> 1)) * 2 + (fr - 14)) * DFF + f0 + 4 * n) = acc[ai][0][m][n];
                }
                if (!smp && ai == 0 && m == 0 && wr == 0 && fr < 2) {
#pragma unroll
                    for (int n = 0; n < 2; ++n) { *(f32x4*)(sbg + ((size_t)u.pm * 2 + fr) * DFF + f0 + 4 * n) = acc[0][0][0][n]; *(f32x4*)(sbu + ((size_t)u.pm * 2 + fr) * DFF + f0 + 4 * n) = acc[0][1][0][n]; }
                } else {
                    u32x4 w; w.x = hp[0][m].x; w.y = hp[0][m].y; w.z = hp[1][m].x; w.w = hp[1][m].y;
                    *(u32x4*)(H + (size_t)(u.pm * BM + rl) * DFF + f0) = w;
                }
            }
        }
    }
};

template <class Epi, class Sched, bool ALIGN_EPI>
__device__ __forceinline__ void gemm_phase(LAS unsigned char* lds, const Gemm g, const Sched& S, const Epi& E, const int wave_s) {
    const int tid = opaque_tid(wave_s), wid = __builtin_amdgcn_readfirstlane(tid >> 6), lane = tid & 63, wr = wid >> 2, wc = wid & 3, fr = lane & 15, fq = lane >> 4;
    const int nt = g.K / BK;
    unsigned voffA[2], voffB[2];
#pragma unroll
    for (int i = 0; i < 2; ++i) { int R, C; stage_rc(tid * 16 + i * 8192, R, C); const int Rb = Epi::PERM ? ((R & ~31) + perm32(R & 31)) : R;
        voffA[i] = (unsigned)(R * g.lda + C) * 2u; voffB[i] = (unsigned)(Rb * g.ldb + C) * 2u; }
    const size_t kstep = (size_t)(BK * 2);
    const size_t hstepA = (size_t)HALF * g.lda * 2, hstepB = (size_t)HALF * g.ldb * 2;
    const unsigned ldsw = (unsigned)wid * 1024u;
    const int aoff = lds_byte(wr * 64 + fr, fq * 8), boff = lds_byte(wc * 32 + fr, fq * 8);
#define PG8_SA(b, h) (((b) * 2 + (h)) * HTB)
#define PG8_SB(b, h) ((4 + (b) * 2 + (h)) * HTB)
#define PG8_STAGE(bufoff, gbase, voff) do { _Pragma("unroll") for (int _i = 0; _i < 2; ++_i) \
        __builtin_amdgcn_global_load_lds((const unsigned*)((const char*)(gbase) + (voff)[_i]), (LAS unsigned*)(lds + (bufoff) + ldsw + _i * 8192), 16, 0, 0); } while (0)
#define PG8_LDA(dst, b, h) do { _Pragma("unroll") for (int m = 0; m < 4; ++m) _Pragma("unroll") for (int k = 0; k < 2; ++k) dst[m][k] = *(const LAS bf16x8*)(lds + PG8_SA(b, h) + aoff + m * 2048 + k * 1024); } while (0)
#define PG8_LDB(dst, b, h) do { _Pragma("unroll") for (int n = 0; n < 2; ++n) _Pragma("unroll") for (int k = 0; k < 2; ++k) dst[n][k] = *(const LAS bf16x8*)(lds + PG8_SB(b, h) + boff + n * 2048 + k * 1024); } while (0)
#define PG8_MMA(ai, bj, At, Bt) do { __builtin_amdgcn_s_setprio(1); _Pragma("unroll") for (int m = 0; m < 4; ++m) _Pragma("unroll") for (int n = 0; n < 2; ++n) _Pragma("unroll") for (int k = 0; k < 2; ++k) \
        acc[ai][bj][m][n] = __builtin_amdgcn_mfma_f32_16x16x32_bf16(Bt[n][k], At[m][k], acc[ai][bj][m][n], 0, 0, 0); __builtin_amdgcn_s_setprio(0); } while (0)
#define PG8_WAIT_V(n) asm volatile("s_waitcnt vmcnt(" #n ")" ::: "memory")
#define PG8_WAIT_L(n) asm volatile("s_waitcnt lgkmcnt(" #n ")" ::: "memory")
#define PG8_BAR __builtin_amdgcn_s_barrier()
#define PG8_SCHED __builtin_amdgcn_sched_barrier(0)
    Unit cur, nxt; int ui = 0;
    if (!S.next(0, cur)) return;
    f32x4 acc[2][2][4][2];
#pragma unroll
    for (int a = 0; a < 2; ++a)
#pragma unroll
        for (int b = 0; b < 2; ++b)
#pragma unroll
            for (int m = 0; m < 4; ++m)
#pragma unroll
                for (int n = 0; n < 2; ++n) acc[a][b][m][n] = (f32x4){0.f, 0.f, 0.f, 0.f};
    bf16x8 At[4][2], B0[2][2], B1[2][2];
    const char* cA = (const char*)g.A + S.offA(cur); const char* cB = (const char*)g.Bt + S.offB(cur);
    PG8_STAGE(PG8_SB(0, 0), cB, voffB); PG8_STAGE(PG8_SB(0, 1), cB + hstepB, voffB); PG8_STAGE(PG8_SA(0, 0), cA, voffA); PG8_STAGE(PG8_SA(0, 1), cA + hstepA, voffA);
    if (wr == 1) PG8_BAR;
    PG8_WAIT_V(2); PG8_BAR;
    PG8_STAGE(PG8_SB(1, 0), cB + kstep, voffB); PG8_STAGE(PG8_SA(1, 0), cA + kstep, voffA); PG8_STAGE(PG8_SB(1, 1), cB + hstepB + kstep, voffB);
    PG8_WAIT_V(6); PG8_BAR;
    for (;;) {
        const bool has_next = S.next(ui + 1, nxt);
        const char* nA = has_next ? (const char*)g.A + S.offA(nxt) : cA; const char* nB = has_next ? (const char*)g.Bt + S.offB(nxt) : cB;
        for (int t = 0; t < nt; t += 2) {
            const bool last = (t == nt - 2);
            const char* a1 = cA + (size_t)(t + 1) * kstep;
            const char* a2 = last ? nA : cA + (size_t)(t + 2) * kstep; const char* b2 = last ? nB : cB + (size_t)(t + 2) * kstep;
            const char* a3 = a2 + kstep; const char* b3 = b2 + kstep;
            PG8_LDB(B0, 0, 0); PG8_LDB(B1, 0, 1); PG8_SCHED; PG8_LDA(At, 0, 0); PG8_STAGE(PG8_SA(1, 1), a1 + hstepA, voffA);
            PG8_WAIT_V(8); PG8_WAIT_L(0); PG8_BAR; PG8_MMA(0, 0, At, B0); PG8_MMA(0, 1, At, B1); PG8_BAR; PG8_SCHED;
            PG8_LDA(At, 0, 1); PG8_STAGE(PG8_SB(0, 0), b2, voffB); PG8_STAGE(PG8_SB(0, 1), b2 + hstepB, voffB); PG8_STAGE(PG8_SA(0, 0), a2, voffA);
            PG8_WAIT_V(8); PG8_WAIT_L(0); PG8_BAR; PG8_MMA(1, 0, At, B0); PG8_MMA(1, 1, At, B1); PG8_BAR; PG8_SCHED;
            PG8_LDB(B0, 1, 0); PG8_LDB(B1, 1, 1); PG8_SCHED; PG8_LDA(At, 1, 0); PG8_STAGE(PG8_SA(0, 1), a2 + hstepA, voffA);
            PG8_WAIT_V(8); PG8_WAIT_L(0); PG8_BAR; PG8_MMA(0, 0, At, B0); PG8_MMA(0, 1, At, B1); PG8_BAR; PG8_SCHED;
            PG8_LDA(At, 1, 1); PG8_STAGE(PG8_SB(1, 0), b3, voffB); PG8_STAGE(PG8_SB(1, 1), b3 + hstepB, voffB); PG8_STAGE(PG8_SA(1, 0), a3, voffA);
            PG8_WAIT_V(8); PG8_WAIT_L(0); PG8_BAR; PG8_MMA(1, 0, At, B0); PG8_MMA(1, 1, At, B1); PG8_BAR; PG8_SCHED;
        }
        if constexpr (ALIGN_EPI) { if (wr == 0) PG8_BAR; }
        E(acc, cur, wr, wc, fr, fq, lds);
        if (!has_next) break;
#pragma unroll
        for (int a = 0; a < 2; ++a)
#pragma unroll
            for (int b = 0; b < 2; ++b)
#pragma unroll
                for (int m = 0; m < 4; ++m)
#pragma unroll
                    for (int n = 0; n < 2; ++n) acc[a][b][m][n] = (f32x4){0.f, 0.f, 0.f, 0.f};
        cur = nxt; cA = nA; cB = nB; ++ui;
        if constexpr (ALIGN_EPI) { if (wr == 1) PG8_BAR; }
    }
    PG8_WAIT_V(0);
    if constexpr (!ALIGN_EPI) { if (wr == 0) PG8_BAR; }
    PG8_BAR;
#undef PG8_SA
#undef PG8_SB
#undef PG8_STAGE
#undef PG8_LDA
#undef PG8_LDB
#undef PG8_MMA
#undef PG8_WAIT_V
#undef PG8_WAIT_L
#undef PG8_BAR
#undef PG8_SCHED
}
}

struct KVSched {
    int c, G; const char* ws; size_t wsel;
    __device__ __forceinline__ bool next(int i, pg8::Unit& u) const {
        const int L = i * G + c; if (c < 0 || L >= 96) return false;
        const int kind = L >> 5, r = L & 31;
        if (kind < 2) { u.pm = kind * 16 + (r >> 2); u.pn = r & 3; } else { u.pm = 32 + (r >> 3); u.pn = r & 7; }
        return true;
    }
    __device__ __forceinline__ size_t offA(const pg8::Unit& u) const { const int kind = u.pm >> 4, pm = u.pm & 15; int k2 = (kind == 2); asm volatile("" : "+v"(k2));
        return (size_t)ws + WS_MEMB + (size_t)k2 * (WS_WV + wsel - WS_MEMB) + (size_t)pm * 256 * 1024 * 2; }
    __device__ __forceinline__ size_t offB(const pg8::Unit& u) const { const int kind = u.pm >> 4; int k1 = (kind == 1), k2 = (kind == 2); asm volatile("" : "+v"(k1), "+v"(k2));
        return (size_t)ws + WS_WK + wsel + (size_t)k1 * (WS_WV - WS_WK) + (size_t)k2 * (WS_MEMB - WS_WK - wsel) + (size_t)u.pn * 256 * 1024 * 2; }
};


#define XB_TMO      128
#define XB_XCNT(j)  (256  + 64 * (j))
#define XB_XSUB(j)  (1280 + 64 * (j))
#define XB_XGEN(j)  (2304 + 64 * (j))
#define XB_TOP      3328
#define XB_TOPGEN   3392
#define XCD_BAR_WORDS 3456
#define XB_SPIN_CAP (1u << 22)
__device__ __forceinline__ unsigned xb_ld(unsigned* p)              { return __hip_atomic_load(p, __ATOMIC_RELAXED, __HIP_MEMORY_SCOPE_AGENT); }
__device__ __forceinline__ unsigned xb_add(unsigned* p, unsigned v) { return __hip_atomic_fetch_add(p, v, __ATOMIC_RELAXED, __HIP_MEMORY_SCOPE_AGENT); }
__device__ __forceinline__ unsigned xb_xcc_id() { return (unsigned)__builtin_amdgcn_s_getreg((3 << 11) | 20) & 0xFu; }
#define XB_SPIN(cond, bar) do { unsigned _sp = 0; while (cond) { __builtin_amdgcn_s_sleep(1); \
    if ((++_sp & 255u) == 0u) { if (xb_ld(&(bar)[XB_TMO])) break; if (_sp > XB_SPIN_CAP) { atomicAdd(&(bar)[XB_TMO], 1u); break; } } } } while (0)
struct XcdBarrier { unsigned* bar; unsigned x; volatile LAS unsigned* st; };
__device__ __forceinline__ void xcd_barrier_complete(unsigned* bar, unsigned x, unsigned& nloc, unsigned& nx) {
    const unsigned G = gridDim.x * gridDim.y * gridDim.z;
    unsigned sum, cnt, mine, sp = 0u;
    for (;;) {
        sum = 0u; cnt = 0u; mine = 0u;
#pragma unroll
        for (unsigned j = 0; j < 16; ++j) { const unsigned c = xb_ld(&bar[XB_XCNT(j)]); sum += c; cnt += (c > 0u) ? 1u : 0u; mine = (j == x) ? c : mine; }
        if (sum == G) break;
        __builtin_amdgcn_s_sleep(1);
        if ((++sp & 255u) == 0u) { if (xb_ld(&bar[XB_TMO])) break; if (sp > XB_SPIN_CAP) { atomicAdd(&bar[XB_TMO], 1u); break; } }
    }
    nloc = mine > 0u ? mine : 1u; nx = cnt > 0u ? cnt : 1u;
}
__device__ __forceinline__ void xcd_barrier(const XcdBarrier& b) {
    asm volatile("s_waitcnt vmcnt(0)" ::: "memory");
    __syncthreads();
    if (threadIdx.x == 0) {
        unsigned* bar = b.bar;
        __builtin_amdgcn_s_waitcnt(0);
        unsigned nloc = b.st[0], nx = b.st[1];
        if (nloc == 0u) { xcd_barrier_complete(bar, b.x, nloc, nx); b.st[0] = nloc; b.st[1] = nx; }
        const unsigned old = xb_add(&bar[XB_XSUB(b.x)], 1u);
        const unsigned gen = old / nloc;
        if (old + 1u == (gen + 1u) * nloc) {
            __builtin_amdgcn_fence(__ATOMIC_RELEASE, "agent");
            asm volatile("s_waitcnt vmcnt(0)" ::: "memory");
            const unsigned og = xb_add(&bar[XB_TOP], 1u);
            const unsigned tg = og / nx;
            if (og + 1u == (tg + 1u) * nx) xb_add(&bar[XB_TOPGEN], 1u);
            else XB_SPIN(xb_ld(&bar[XB_TOPGEN]) == tg, bar);
            __builtin_amdgcn_fence(__ATOMIC_ACQUIRE, "agent");
            xb_add(&bar[XB_XGEN(b.x)], 1u);
            asm volatile("s_waitcnt vmcnt(0)" ::: "memory");
        } else {
            XB_SPIN(xb_ld(&bar[XB_XGEN(b.x)]) == gen, bar);
            __builtin_amdgcn_fence(__ATOMIC_ACQUIRE, "agent");
            asm volatile("s_waitcnt vmcnt(0)" ::: "memory");
        }
    }
    __syncthreads();
}


struct SG2 { const bf16_t* A; const bf16_t* Bt; int lda, ldb, K, N; bf16_t* O; int ldc; float scale; int mode; float* ssp; };
__device__ __forceinline__ float sq8(bf16x8 a) { float q = 0.f;
#pragma unroll
    for (int i = 0; i < 8; ++i) { const float f = bf2f((unsigned)(unsigned short)a[i]); q += f * f; } return q; }
__device__ __forceinline__ void sgemm2(LAS unsigned char* lds, const SG2 g, int ubase, int G, int wave, int tid) {
    const int lane = tid & 63, fr = lane & 15, fq = lane >> 4, rt = wave & 3, ch = wave >> 2;
    const int nunits = (g.N / 64) * 4, nsl = g.K / 64;
    int R, C; pg8::stage_rc(tid * 16, R, C);
    const unsigned offA = (unsigned)(R * g.lda + C) * 2u, offB = (unsigned)(R * g.ldb + C) * 2u;
    const int aoff = pg8::lds_byte(rt * 16 + fr, fq * 8), boff = pg8::lds_byte(ch * 32 + fr, fq * 8);
    for (int un = ubase; un >= 0 && un < nunits; un += G) {
        const int cgp = un >> 2, rg = un & 3;
        const char* gA = (const char*)(g.A + (size_t)rg * 64 * g.lda) + offA; const char* gB = (const char*)(g.Bt + (size_t)cgp * 64 * g.ldb) + offB;
#define SG2_STAGE(sl) do { LAS unsigned char* d_ = lds + ((sl) & 3) * 16384 + wave * 1024; \
        __builtin_amdgcn_global_load_lds((const unsigned*)(gA + (size_t)(sl) * 128), (LAS unsigned*)d_, 16, 0, 0); \
        __builtin_amdgcn_global_load_lds((const unsigned*)(gB + (size_t)(sl) * 128), (LAS unsigned*)(d_ + 8192), 16, 0, 0); } while (0)
        asm volatile("s_waitcnt vmcnt(0)" ::: "memory");
        SG2_STAGE(0); SG2_STAGE(1);
        f32x4 acc[2] = {(f32x4){0.f, 0.f, 0.f, 0.f}, (f32x4){0.f, 0.f, 0.f, 0.f}}; float q = 0.f;
        for (int sl = 0; sl < nsl; ++sl) {
            if (sl + 1 < nsl) asm volatile("s_waitcnt vmcnt(2)" ::: "memory"); else asm volatile("s_waitcnt vmcnt(0)" ::: "memory");
            __builtin_amdgcn_s_barrier(); asm volatile("" ::: "memory");
            if (sl + 2 < nsl) SG2_STAGE(sl + 2);
            LAS unsigned char* b_ = lds + (sl & 3) * 16384;
#pragma unroll
            for (int ks = 0; ks < 2; ++ks) {
                const bf16x8 a = *(const LAS bf16x8*)(b_ + aoff + ks * 1024);
#pragma unroll
                for (int c = 0; c < 2; ++c) { const bf16x8 b = *(const LAS bf16x8*)(b_ + 8192 + boff + c * 2048 + ks * 1024);
                    acc[c] = __builtin_amdgcn_mfma_f32_16x16x32_bf16(b, a, acc[c], 0, 0, 0); }
                if (g.mode == 1) q += sq8(a);
            }
        }
#undef SG2_STAGE
        const int row = rg * 64 + rt * 16 + fr, col = cgp * 64 + ch * 32 + fq * 4;
        bf16_t* op = g.O + (size_t)row * g.ldc + col;
        if (g.mode == 1) {
            q += shx(q, 16, lane); q += shx(q, 32, lane);
            const float sc = g.scale / sqrtf(q * (1.f / 1024.f) + EPS);
#pragma unroll
            for (int c = 0; c < 2; ++c) { const f32x4 v = acc[c] * sc; u32x2 w; w.x = cvt_pk_bf16(v[0], v[1]); w.y = cvt_pk_bf16(v[2], v[3]); *(u32x2*)(op + c * 16) = w; }
        } else {
            const u32x2 p0 = *(const u32x2*)op, p1 = *(const u32x2*)(op + 16); float qq = 0.f;
            { const float v0 = bflo(p0.x) + acc[0][0], v1 = bfhi(p0.x) + acc[0][1], v2 = bflo(p0.y) + acc[0][2], v3 = bfhi(p0.y) + acc[0][3];
              u32x2 w; w.x = cvt_pk_bf16(v0, v1); w.y = cvt_pk_bf16(v2, v3); *(u32x2*)op = w; qq += (v0 * v0 + v1 * v1) + (v2 * v2 + v3 * v3); }
            { const float v0 = bflo(p1.x) + acc[1][0], v1 = bfhi(p1.x) + acc[1][1], v2 = bflo(p1.y) + acc[1][2], v3 = bfhi(p1.y) + acc[1][3];
              u32x2 w; w.x = cvt_pk_bf16(v0, v1); w.y = cvt_pk_bf16(v2, v3); *(u32x2*)(op + 16) = w; qq += (v0 * v0 + v1 * v1) + (v2 * v2 + v3 * v3); }
            qq += shx(qq, 16, lane); qq += shx(qq, 32, lane);
            if (fq == 0) g.ssp[row * 32 + cgp * 2 + ch] = qq;
        }
        asm volatile("s_waitcnt vmcnt(0) lgkmcnt(0)" ::: "memory"); __builtin_amdgcn_s_barrier(); asm volatile("" ::: "memory");
    }
}

__device__ __forceinline__ void sgemm_act(LAS unsigned char* lds, const bf16_t* A, const bf16_t* Bt, bf16_t* Hs, const float* cfw, const float* scf, float* ocf, int ubase, int G, int wave, int tid) {
    const int lane = tid & 63, fr = lane & 15, fq = lane >> 4, rt = wave & 3, ch = wave >> 2;
    constexpr int nunits = (DFF / 64) * 4, nsl = D / 64, SLOT = 24576;
    int R, C; pg8::stage_rc(tid * 16, R, C);
    const unsigned off = (unsigned)(R * D + C) * 2u;
    const int aoff = pg8::lds_byte(rt * 16 + fr, fq * 8), boff = pg8::lds_byte(fr, fq * 8) + 8192 + ch * 8192;
    for (int un = ubase; un >= 0 && un < nunits; un += G) {
        const int fg = un >> 2, rg = un & 3, brow = ((fg >> 1) << 8) + ((fg & 1) << 6);
        const char* gA = (const char*)(A + (size_t)rg * 64 * D) + off; const char* gG = (const char*)(Bt + (size_t)brow * D) + off; const char* gU = (const char*)(Bt + (size_t)(brow + 128) * D) + off;
#define SGA_STAGE(sl) do { LAS unsigned char* d_ = lds + ((sl) & 3) * SLOT + wave * 1024; \
        __builtin_amdgcn_global_load_lds((const unsigned*)(gA + (size_t)(sl) * 128), (LAS unsigned*)d_, 16, 0, 0); \
        __builtin_amdgcn_global_load_lds((const unsigned*)(gG + (size_t)(sl) * 128), (LAS unsigned*)(d_ + 8192), 16, 0, 0); \
        __builtin_amdgcn_global_load_lds((const unsigned*)(gU + (size_t)(sl) * 128), (LAS unsigned*)(d_ + 16384), 16, 0, 0); } while (0)
        asm volatile("s_waitcnt vmcnt(0)" ::: "memory");
        SGA_STAGE(0); SGA_STAGE(1);
        f32x4 acc[4]; float q = 0.f;
#pragma unroll
        for (int c = 0; c < 4; ++c) acc[c] = (f32x4){0.f, 0.f, 0.f, 0.f};
        for (int sl = 0; sl < nsl; ++sl) {
            if (sl + 1 < nsl) asm volatile("s_waitcnt vmcnt(3)" ::: "memory"); else asm volatile("s_waitcnt vmcnt(0)" ::: "memory");
            __builtin_amdgcn_s_barrier(); asm volatile("" ::: "memory");
            if (sl + 2 < nsl) SGA_STAGE(sl + 2);
            LAS unsigned char* b_ = lds + (sl & 3) * SLOT;
#pragma unroll
            for (int ks = 0; ks < 2; ++ks) {
                const bf16x8 a = *(const LAS bf16x8*)(b_ + aoff + ks * 1024);
#pragma unroll
                for (int c = 0; c < 4; ++c) { const bf16x8 b = *(const LAS bf16x8*)(b_ + boff + c * 2048 + ks * 1024);
                    acc[c] = __builtin_amdgcn_mfma_f32_16x16x32_bf16(b, a, acc[c], 0, 0, 0); }
                q += sq8(a);
            }
        }
#undef SGA_STAGE
        q += shx(q, 16, lane); q += shx(q, 32, lane);
        const float rstd = 1.0f / sqrtf(q * (1.f / 1024.f) + EPS);
        asm volatile("s_waitcnt lgkmcnt(0)" ::: "memory"); __builtin_amdgcn_s_barrier(); asm volatile("" ::: "memory");
        LAS float* T = (LAS float*)(lds + ch * 20480);
#pragma unroll
        for (int c = 0; c < 4; ++c)
#pragma unroll
            for (int j = 0; j < 4; ++j) T[(rt * 16 + fr) * 65 + c * 16 + fq * 4 + j] = acc[c][j] * rstd;
        asm volatile("s_waitcnt lgkmcnt(0)" ::: "memory"); __builtin_amdgcn_s_barrier(); asm volatile("" ::: "memory");
        {
            const LAS float* Gt = (const LAS float*)lds; const LAS float* Ut = (const LAS float*)(lds + 20480);
            const int r = tid >> 3, f8 = (tid & 7) * 8, b = rg * 2 + (r >> 5), rr = r & 31, f = fg * 64 + f8;
            const float* st = scf + (size_t)(b * 2) * DFF + f;
            float hv[8], gv[8];
#pragma unroll
            for (int k = 0; k < 8; ++k) {
                const float g0 = Gt[r * 65 + f8 + k];
                const float gm1 = rr >= 1 ? Gt[(r - 1) * 65 + f8 + k] : st[DFF + k];
                const float gm2 = rr >= 2 ? Gt[(r - 2) * 65 + f8 + k] : (rr == 1 ? st[DFF + k] : st[k]);
                const float cv = cfw[f + k] * gm2 + cfw[DFF + f + k] * gm1 + cfw[2 * DFF + f + k] * g0;
                hv[k] = silu(cv) * Ut[r * 65 + f8 + k]; gv[k] = g0;
            }
            u32x4 w; w.x = pk2(hv[0], hv[1]); w.y = pk2(hv[2], hv[3]); w.z = pk2(hv[4], hv[5]); w.w = pk2(hv[6], hv[7]);
            *(u32x4*)(Hs + (size_t)(rg * 64 + r) * DFF + f) = w;
            if (rr >= 30) { float* o = ocf + ((size_t)b * 2 + (rr - 30)) * DFF + f; *(f32x4*)o = (f32x4){gv[0], gv[1], gv[2], gv[3]}; *(f32x4*)(o + 4) = (f32x4){gv[4], gv[5], gv[6], gv[7]}; }
        }
        asm volatile("s_waitcnt vmcnt(0) lgkmcnt(0)" ::: "memory"); __builtin_amdgcn_s_barrier(); asm volatile("" ::: "memory");
    }
}
__device__ __forceinline__ void sample_ss_reduce(const float* sss, float* ssq, int tid) {
    if (tid < 256) { const f32x4* p = (const f32x4*)(sss + tid * 32); float t = 0.f;
#pragma unroll
        for (int i = 0; i < 8; ++i) { const f32x4 v = p[i]; t += (v[0] + v[1]) + (v[2] + v[3]); }
        *(f32x4*)(ssq + (size_t)(MP + tid) * 4) = (f32x4){t, 0.f, 0.f, 0.f}; }
    asm volatile("s_waitcnt vmcnt(0)" ::: "memory"); __syncthreads();
}

__device__ __forceinline__ void transpose_item(const float* W, int K, int N, bf16_t* WT, LAS float* scr, int item, int lane, const float* gain = nullptr, int gu = 0) {
    const int nblk = N / 32, kb = item / nblk, nb = item % nblk, k0 = 64 * kb, n0 = 32 * nb;
    {
        f32x4 v[8];
#pragma unroll
        for (int i = 0; i < 8; ++i) v[i] = *(const f32x4*)(W + (size_t)(k0 + (lane >> 3) + 8 * i) * N + n0 + (lane & 7) * 4);
#pragma unroll
        for (int i = 0; i < 8; ++i) { const int kk = (lane >> 3) + 8 * i; f32x4 w = v[i]; if (gain) w = w * gain[k0 + kk];
            LAS float* d = scr + kk * 33 + (lane & 7) * 4; d[0] = w[0]; d[1] = w[1]; d[2] = w[2]; d[3] = w[3]; }
    }
    LDS_WAIT();
    const int c = lane & 7;
#pragma unroll
    for (int j = 0; j < 4; ++j) { const int n = (lane >> 3) + 8 * j; const LAS float* s = scr + (8 * c) * 33 + n;
        u32x4 o; o.x = pk2(s[0 * 33], s[1 * 33]); o.y = pk2(s[2 * 33], s[3 * 33]); o.z = pk2(s[4 * 33], s[5 * 33]); o.w = pk2(s[6 * 33], s[7 * 33]);
        int drow = n0 + n; if (gu) { const int up = drow >= gu, f = up ? drow - gu : drow; drow = ((f >> 7) << 8) + (up << 7) + (f & 127); }
        *(u32x4*)(WT + (size_t)drow * K + k0 + 8 * c) = o; }
    LDS_WAIT();
}

__device__ __forceinline__ void first_rows(const float* Xp, const float* Xs, bf16_t* XNo, float* ss, int gw, int NGW, int lane) {
    for (int m0 = gw; m0 < MT; m0 += 2 * NGW) {
        const int m1 = m0 + NGW; const bool two = m1 < MT; const int mb = two ? m1 : m0;
        const f32x4* xa = (const f32x4*)(m0 < MP ? Xp + (size_t)m0 * D : Xs + (size_t)(m0 - MP) * D) + lane;
        const f32x4* xb = (const f32x4*)(mb < MP ? Xp + (size_t)mb * D : Xs + (size_t)(mb - MP) * D) + lane;
        f32x4 va[4], vb[4]; float sa = 0.f, sb = 0.f;
#pragma unroll
        for (int j = 0; j < 4; ++j) { va[j] = xa[64 * j]; vb[j] = xb[64 * j]; }
#pragma unroll
        for (int j = 0; j < 4; ++j) { sa += (va[j].x * va[j].x + va[j].y * va[j].y) + (va[j].z * va[j].z + va[j].w * va[j].w); sb += (vb[j].x * vb[j].x + vb[j].y * vb[j].y) + (vb[j].z * vb[j].z + vb[j].w * vb[j].w); }
        sa = wave_sum(sa, lane); sb = wave_sum(sb, lane);
        if (lane < 4) { ss[(size_t)m0 * 4 + lane] = lane == 0 ? sa : 0.f; if (two) ss[(size_t)m1 * 4 + lane] = lane == 0 ? sb : 0.f; }
        u32x2* oa = (u32x2*)(XNo + (size_t)m0 * D) + lane; u32x2* ob = (u32x2*)(XNo + (size_t)mb * D) + lane;
#pragma unroll
        for (int j = 0; j < 4; ++j) { u32x2 w; w.x = pk2(va[j].x, va[j].y); w.y = pk2(va[j].z, va[j].w); oa[64 * j] = w; if (two) { w.x = pk2(vb[j].x, vb[j].y); w.y = pk2(vb[j].z, vb[j].w); ob[64 * j] = w; } }
    }
}

typedef __attribute__((address_space(4))) const unsigned char* kptr_t;
typedef const float* cfp_t; typedef float* fp_t; typedef unsigned char* ucp_t;
#define INP(k) (*(const __attribute__((address_space(4))) cfp_t*)(kp + 8 * (k)))
#define X out
#define WIN_T ((bf16_t*)(ws + WS_WIN + wsel))
#define WOUT_T ((bf16_t*)(ws + WS_WOUT + wsel))
#define WQ_T ((bf16_t*)(ws + WS_WQ + wsel))
#define WK_T ((bf16_t*)(ws + WS_WK + wsel))
#define WV_T ((bf16_t*)(ws + WS_WV + wsel))
#define WO_T ((bf16_t*)(ws + WS_WO + wsel))
#define WUP_T ((bf16_t*)(ws + WS_WUP + wsel))
#define WDN_T ((bf16_t*)(ws + WS_WDN + wsel))
#define MEMB ((bf16_t*)(ws + WS_MEMB))
#define KBP ((bf16_t*)(ws + WS_KBP))
#define VTP ((bf16_t*)(ws + WS_VTP))
#define KBS ((bf16_t*)(ws + WS_KBS + ksel))
#define VTS ((bf16_t*)(ws + WS_VTS + ksel))
#define WST ((bf16_t*)(ws + WS_WST + ksel))
#define AGG ((float*)(ws + WS_AGG))
#define SSQ(i) ((float*)(ws + WS_SSP) + (size_t)(i) * MT * 4)
#define SSS(i) ((float*)(ws + WS_SSS) + (size_t)(i) * 256 * 32)
#define GT_R ((bf16_t*)(ws + WS_GT + ksel))
#define GT_I ((bf16_t*)(ws + WS_GT + 65536 + ksel))
#define XN ((bf16_t*)(ws + WS_XN))
#define gZ ((bf16_t*)(ws + B_Z))
#define HLOC ((bf16_t*)(ws + B_HLOC))
#define PCUM ((bf16_t*)(ws + B_PCUM))
#define gY ((bf16_t*)(ws + B_Y))
#define gQ ((bf16_t*)(ws + B_Q))
#define gP ((bf16_t*)(ws + B_P))
#define gO ((bf16_t*)(ws + B_O))
#define PS ((bf16_t*)(ws + B_PS))
#define GU ((bf16_t*)(ws + B_GU))
#define GUS ((bf16_t*)(ws + B_GUS))
#define SBG ((float*)(ws + B_SBG))
#define SBU ((float*)(ws + B_SBU))
#define SBL ((float*)(ws + B_SBL))
__device__ __forceinline__ void convert_layer(kptr_t kp, unsigned char* ws, LAS unsigned char* lds, const int l, const int part, const int nparts, const int gw, const int NGW, const int gt, const int NGT, const int lane, const int wave) {
            const size_t wsel = (size_t)(l & 1) * WSEL1, ksel = (size_t)(l & 1) * KSEL1;
            LAS float* scr = (LAS float*)(lds + wave * 16384);
            const float* w_in = INP(I_WIN) + (size_t)l * D * INC; const float* w_out = INP(I_WOUT) + (size_t)l * D * D; const float* w_q = INP(I_WQ) + (size_t)l * D * D;
            const float* w_k = INP(I_WK) + (size_t)l * D * D; const float* w_v = INP(I_WV) + (size_t)l * D * D; const float* w_o = INP(I_WO) + (size_t)l * D * D;
            const float* w_up = INP(I_WUP) + (size_t)l * D * 2 * DFF; const float* w_dn = INP(I_WDN) + (size_t)l * DFF * D; const float* c_v = INP(I_CV) + (size_t)l * BS * NMEM * D;
            constexpr int T_IN = 16 * (INC / 32), T_SQ = 16 * 32, T_UP = 16 * (2 * DFF / 32), T_DN = (DFF / 64) * 32, T_CV = 32 * 32;
            constexpr int T_G = 16;
            constexpr int NIT = T_IN + 5 * T_SQ + T_UP + T_DN + T_CV + 2 * T_G;
            for (int it = (NIT * part) / nparts + gw; it < (NIT * (part + 1)) / nparts; it += NGW) {
                int r = it;
                if (r < T_IN) { transpose_item(w_in, D, INC, WIN_T, scr, r, lane, INP(I_GMIX) + l * D); continue; } r -= T_IN;
                if (r < T_SQ) { transpose_item(w_out, D, D, WOUT_T, scr, r, lane); continue; } r -= T_SQ;
                if (r < T_SQ) { transpose_item(w_q, D, D, WQ_T, scr, r, lane, INP(I_GX) + l * D); continue; } r -= T_SQ;
                if (r < T_SQ) { transpose_item(w_k, D, D, WK_T, scr, r, lane); continue; } r -= T_SQ;
                if (r < T_SQ) { transpose_item(w_v, D, D, WV_T, scr, r, lane); continue; } r -= T_SQ;
                if (r < T_SQ) { transpose_item(w_o, D, D, WO_T, scr, r, lane); continue; } r -= T_SQ;
                if (r < T_UP) { transpose_item(w_up, D, 2 * DFF, WUP_T, scr, r, lane, INP(I_GFFN) + l * D, DFF); continue; } r -= T_UP;
                if (r < T_DN) { transpose_item(w_dn, DFF, D, WDN_T, scr, r, lane); continue; } r -= T_DN;
                if (r < T_CV) { transpose_item(c_v, BS * NMEM, D, VTS, scr, r, lane); continue; } r -= T_CV;
                if (r < T_G) { transpose_item(INP(I_WRG) + ((size_t)l * 8 + (r >> 1)) * 4096, 64, 64, GT_R + (r >> 1) * 4096, scr, r & 1, lane); continue; } r -= T_G;
                transpose_item(INP(I_WIG) + ((size_t)l * 8 + (r >> 1)) * 4096, 64, 64, GT_I + (r >> 1) * 4096, scr, r & 1, lane);
            }
            if (part == 0) {
                const f32x4* ck = (const f32x4*)(INP(I_CK) + (size_t)l * BS * NMEM * D); u32x2* dk = (u32x2*)KBS;
                for (int i = gt; i < BS * NMEM * D / 4; i += NGT) { const f32x4 v = ck[i]; u32x2 w; w.x = pk2(v.x, v.y); w.y = pk2(v.z, v.w); dk[i] = w; }
                if (l == 0) { const f32x4* mm = (const f32x4*)INP(I_MEM); u32x2* dm = (u32x2*)MEMB;
                    for (int i = gt; i < BP * NMEM * D / 4; i += NGT) { const f32x4 v = mm[i]; u32x2 w; w.x = pk2(v.x, v.y); w.y = pk2(v.z, v.w); dm[i] = w; } }
                const float* wsl = INP(I_WS) + (size_t)l * 4 * 128 * 128;
                for (int i = gt; i < 4 * 128 * 128; i += NGT) { const int s = i & 127, t = (i >> 7) & 127; WST[i] = (bf16_t)f2bf(s <= t ? wsl[i] : 0.f); }
            }
}

__global__ void __launch_bounds__(NTHREADS, 2) trunk_fwd(Args args) {
    extern __shared__ __attribute__((aligned(16))) unsigned char lds_raw[];
    LAS unsigned char* lds = (LAS unsigned char*)lds_raw;
    cg::grid_group grid = cg::this_grid();
    const int wave_s = __builtin_amdgcn_readfirstlane(threadIdx.x >> 6);
#define LANE_STATE() int G = gridDim.x, bid = blockIdx.x; asm volatile("" : "+s"(G), "+s"(bid)); const int NGW = G * NWAVES, NGT = G * NTHREADS; (void)NGW; (void)NGT; \
    const int tid = opaque_tid(wave_s), lane = tid & 63, wave = wave_s; const int gw = bid * NWAVES + wave; const int gt = bid * NTHREADS + tid; (void)lane; (void)gw; (void)gt; \
    kptr_t kp = (kptr_t)__builtin_amdgcn_kernarg_segment_ptr(); asm volatile("" : "+s"(kp)); \
    float* const out = *(const __attribute__((address_space(4))) fp_t*)(kp + 8 * N_IN); unsigned char* const ws = *(const __attribute__((address_space(4))) ucp_t*)(kp + 8 * N_IN + 8); (void)out; (void)ws
    {
        LANE_STATE();
        if (bid == 0) for (int i = tid; i < XCD_BAR_WORDS; i += NTHREADS) __hip_atomic_store((unsigned*)(ws + WS_BAR) + i, 0u, __ATOMIC_RELAXED, __HIP_MEMORY_SCOPE_AGENT);
        if (tid < 32) ((LAS unsigned*)(lds + LDS_MISC))[tid] = 0u;
        __threadfence();
        grid.sync();
        if (tid == 0) (void)xb_add((unsigned*)(ws + WS_BAR) + XB_XCNT(xb_xcc_id()), 1u);
    }
#define GRID_SYNC() do { kptr_t kp_ = (kptr_t)__builtin_amdgcn_kernarg_segment_ptr(); asm volatile("" : "+s"(kp_)); \
        XcdBarrier b_; b_.bar = (unsigned*)(*(const __attribute__((address_space(4))) ucp_t*)(kp_ + 8 * N_IN + 8) + WS_BAR); b_.x = xb_xcc_id(); b_.st = (volatile LAS unsigned*)(lds + LDS_MISC); \
        xcd_barrier(b_); if (PROBE == 3) xcd_barrier(b_); } while (0)

    for (int l = 0; l < DEPTH; ++l) {
        const size_t wsel = (size_t)(l & 1) * WSEL1, ksel = (size_t)(l & 1) * KSEL1;
        if (l == 0)
        for (int dup0 = 0; dup0 < ((PROBE == 1 || PROBE == 5) ? 2 : 1); ++dup0) {
        {
            LANE_STATE();
            convert_layer(kp, ws, lds, l, 0, 1, gw, NGW, gt, NGT, lane, wave);
            if (l == 0) first_rows(INP(I_XP), INP(I_XS), XN, SSQ(0), gw, NGW, lane);
        }
        GRID_SYNC();
        }
        {
            LANE_STATE();
            KVSched S; S.G = G; S.c = bid >= 160 ? bid - 160 : -1; S.ws = (const char*)ws; S.wsel = wsel;
            pg8::Gemm g{(const bf16_t*)nullptr, (const bf16_t*)nullptr, D, D, D};
            pg8::EpiKV E{out + O_MKP + (size_t)l * BP * NMEM * D, out + O_MVP + (size_t)l * BP * NMEM * D, KBP, VTP};
            pg8::gemm_phase<pg8::EpiKV, KVSched, true>(lds, g, S, E, wave_s);
        }
#define GEMM_BF16(s_) do { const int s = (s_); pg8::GSched S; pg8::Gemm g; pg8::EpiBf16 E; E.scale = 1.f; E.ss = nullptr; E.smp = 0; \
        if (s == 0) { S.init(MT / 256, INC / 256, G, bid); S.aPm = (size_t)256 * D * 2; S.bPn = (size_t)256 * D * 2; g = pg8::Gemm{XN, WIN_T, D, D, D}; E.O = gZ; E.ldc = INC; E.ss = SSQ(3 * l); } \
        else if (s == 1) { S.init(MP / 256, D / 256, G, bid); S.aPm = (size_t)256 * D * 2; S.bPn = (size_t)256 * D * 2; g = pg8::Gemm{XN, WQ_T, D, D, D}; E.O = gQ; E.ldc = D; E.scale = 0.0625f; E.ss = SSQ(3 * l + 1); } \
        else if (s == 2) { S.init(MP / 256, 4, G, bid); S.aPm = (size_t)256 * D * 2; S.aPn = 512; S.bPn = (size_t)256 * 2048 * 2; S.bPm = 512; S.bShift = 4; g = pg8::Gemm{gP, VTP, D, 2048, 256}; E.O = gO; E.ldc = D; } \
        else { S.init(1, 32, G, (bid + G - 64) % G); S.mode = 2; g = pg8::Gemm{PS, VTS, 8192, 2048, 256}; E.O = gO + (size_t)MP * D; E.ldc = D; E.smp = 1; } \
        pg8::gemm_phase<pg8::EpiBf16, pg8::GSched, true>(lds, g, S, E, wave_s); } while (0)
#define GEMM_RES(s_) do { const int s = (s_); pg8::GSched S; S.init(MP / 256, D / 256, G, bid); pg8::Gemm g; \
        if (s == 0) { g = pg8::Gemm{gY, WOUT_T, D, D, D}; S.aPm = (size_t)256 * D * 2; } \
        else if (s == 1) { g = pg8::Gemm{gO, WO_T, D, D, D}; S.aPm = (size_t)256 * D * 2; } \
        else { g = pg8::Gemm{GU, WDN_T, DFF, DFF, DFF}; S.aPm = (size_t)256 * DFF * 2; } \
        S.bPn = (size_t)256 * g.ldb * 2; \
        pg8::EpiResid E{XN, SSQ(3 * l + 1 + s)}; \
        pg8::gemm_phase<pg8::EpiResid, pg8::GSched, true>(lds, g, S, E, wave_s); } while (0)

        for (int rep = 0; rep < 13; ++rep) { if (rep == 4 || rep == 9 || rep == 11) continue;
          const int ndup = ((PROBE == 1 && (rep == 1 || rep == 2)) || (PROBE == 4 && rep == 1) || (PROBE == 6 && rep == 2)) ? 2 : ((PROBE == 2 && (rep == 0 || rep == 5 || rep == 6 || rep == 7 || rep == 10)) ? 2 : 1);
          for (int dup = 0; dup < ndup; ++dup) {
            if (rep == 0 || rep == 5 || rep == 7) {
                LANE_STATE();
                const int s0 = rep == 0 ? 0 : (rep == 5 ? 1 : 2), ns = rep == 7 ? 2 : 1;
                if (rep == 0 && l > 0) {
                    pg8::GSched S0; S0.init(MT / 256, INC / 256, G, bid); pg8::Unit u0; bool own = false;
                    for (int i = 0; S0.next(i, u0); ++i) own = own || (u0.pm == 128);
                    if (own) sample_ss_reduce(SSS(3 * l), SSQ(3 * l), tid);
                }
                for (int q = 0; q < ns; ++q) GEMM_BF16(s0 + q);
                if (rep == 5) { LANE_STATE(); const SG2 sg{XN + (size_t)MP * D, WQ_T, D, D, D, D, gQ + (size_t)MP * D, D, 0.0625f, 1, nullptr}; sgemm2(lds, sg, bid, G, wave, tid); }
                if (rep == 5 && l + 1 < DEPTH) { LANE_STATE(); if (bid >= 64) convert_layer(kp, ws, lds, l + 1, 1, 4, gw - 64 * NWAVES, NGW - 64 * NWAVES, gt - 64 * NTHREADS, NGT - 64 * NTHREADS, lane, wave); }
            } else if (rep == 10) {
                LANE_STATE();
                pg8::GSched S; S.init(MP / 256, 2 * DFF / 256, G, bid); S.aPm = (size_t)256 * D * 2; S.bPn = (size_t)256 * D * 2;
                const pg8::Gemm g{XN, WUP_T, D, D, D};
                const pg8::EpiAct E{GU, INP(I_SCF) + (size_t)l * BS * 2 * DFF, out + O_CFS + (size_t)l * BS * 2 * DFF, SBG, SBU, SBL, INP(I_CFW) + (size_t)l * 3 * DFF, SSQ(3 * l + 2)};
                pg8::gemm_phase<pg8::EpiAct, pg8::GSched, true>(lds, g, S, E, wave_s);
                { LANE_STATE(); sgemm_act(lds, XN + (size_t)MP * D, WUP_T, GU + (size_t)MP * DFF, INP(I_CFW) + (size_t)l * 3 * DFF, INP(I_SCF) + (size_t)l * BS * 2 * DFF, out + O_CFS + (size_t)l * BS * 2 * DFF, bid, G, wave, tid); }
            } else if (rep == 1) {
                LANE_STATE();
                {
                    LAS bf16_t* vT = (LAS bf16_t*)lds;
                    constexpr int VP = 136;
                    const float* gvp = INP(I_GV) + l * CW; const float* bsp = INP(I_BSS) + l * 4 * 128;
                    for (int un = (bid + G / 2) % G; un < 8 + 256; un += G) {
                        int rowbase, nrows, sb = -1;
                        if (un < 8) { sb = un; rowbase = MP + un * TS; nrows = TS; } else { rowbase = (un - 8) * 128; nrows = 128; }
                        {
                            const int rl = tid >> 5, cgp = tid & 31;
                            f32x4 g0 = *(const f32x4*)(gvp + cgp * 8), g1 = *(const f32x4*)(gvp + cgp * 8 + 4);
                            for (int p = 0; p < nrows / 16; ++p) {
                                const int r = p * 16 + rl;
                                const u32x4 raw = *(const u32x4*)(gZ + (size_t)(rowbase + r) * INC + Z_VC + cgp * 8);
                                float v[8] = {bflo(raw.x), bfhi(raw.x), bflo(raw.y), bfhi(raw.y), bflo(raw.z), bfhi(raw.z), bflo(raw.w), bfhi(raw.w)};
                                float ss = 0.f;
#pragma unroll
                                for (int k = 0; k < 8; ++k) { v[k] = gelu_t(v[k]); ss += v[k] * v[k]; }
                                ss += shx(ss, 1, lane); ss += shx(ss, 2, lane); ss += shx(ss, 4, lane);
                                const float rstd = __builtin_amdgcn_rsqf(ss * (1.f / 64.f) + EPS);
                                const float gg[8] = {g0.x, g0.y, g0.z, g0.w, g1.x, g1.y, g1.z, g1.w};
#pragma unroll
                                for (int k = 0; k < 8; ++k) { v[k] = v[k] * rstd * gg[k]; vT[(cgp * 8 + k) * VP + r] = (bf16_t)f2bf(v[k]); }
                                if (sb >= 0) { float* vo = out + O_VCS + ((size_t)(l * BS + sb) * TS + r) * CW + cgp * 8;
                                    *(f32x4*)vo = (f32x4){v[0], v[1], v[2], v[3]}; *(f32x4*)(vo + 4) = (f32x4){v[4], v[5], v[6], v[7]}; }
                            }
                        }
                        __syncthreads();
                        {
                            const int hh = wave & 3, rh = wave >> 2, fr = lane & 15, fq = lane >> 4;
                            const int nmt = nrows == 128 ? 4 : (rh == 0 ? 2 : 0);
                            for (int mi = 0; mi < nmt; ++mi) {
                                const int mt = rh * 4 + mi, nks = (mt * 16 + 15) / 32 + 1;
                                f32x4 acc[4];
#pragma unroll
                                for (int n = 0; n < 4; ++n) acc[n] = (f32x4){0.f, 0.f, 0.f, 0.f};
                                for (int ks = 0; ks < nks; ++ks) {
                                    const bf16x8 a = *(const bf16x8*)(WST + ((size_t)(hh * 128 + mt * 16 + fr) * 128 + ks * 32 + fq * 8));
#pragma unroll
                                    for (int n = 0; n < 4; ++n) { const bf16x8 b = *(const LAS bf16x8*)(vT + (hh * 64 + n * 16 + fr) * VP + ks * 32 + fq * 8);
                                        acc[n] = __builtin_amdgcn_mfma_f32_16x16x32_bf16(b, a, acc[n], 0, 0, 0); }
                                }
                                { const int t = mt * 16 + fr; const float bias = bsp[hh * 128 + t]; const size_t row = (size_t)(rowbase + t);
#pragma unroll
                                    for (int n = 0; n < 4; ++n) { const int c = hh * 64 + n * 16 + fq * 4; const u32x2 uq = *(const u32x2*)(gZ + row * INC + Z_UC + c);
                                        u32x2 w; w.x = pk2(gelu_t(bflo(uq.x)) * (acc[n][0] + bias), gelu_t(bfhi(uq.x)) * (acc[n][1] + bias)); w.y = pk2(gelu_t(bflo(uq.y)) * (acc[n][2] + bias), gelu_t(bfhi(uq.y)) * (acc[n][3] + bias));
                                        *(u32x2*)(gY + row * D + 768 + c) = w; } }
                            }
                        }
                        __syncthreads();
                    }
                }
                {
                    LAS unsigned char* wl = lds + wave * 16384;
                    LAS bf16_t* tile = (LAS bf16_t*)wl;
                    LAS float* pre_r = (LAS float*)(wl + 2560);
                    LAS float* pre_i = (LAS float*)(wl + 2560 + 4096);
                    LAS float* xcf = (LAS float*)(wl + 2560 + 8192);
                    const int fr = lane & 15, fq = lane >> 4;
                    for (int un = gw; un < 64 + 2048; un += NGW) {
                        int b, hd, rowbase, nrows, t0; bool smp = un < 64;
                        if (smp) { b = un >> 3; hd = un & 7; rowbase = MP + b * TS; nrows = TS; t0 = 0; }
                        else { const int v = un - 64; const int ch = v & 31; hd = (v >> 5) & 7; b = v >> 8; t0 = ch * 128; rowbase = b * SEQ + t0; nrows = 128; }
                        const int cidx = l * AW + hd * 64 + lane;
                        const float br = INP(I_BRG)[cidx], bi = INP(I_BIG)[cidx];
                        const float c8sp = 8.0f * log1pf(__expf(-INP(I_LAM)[cidx]));
                        const float* caw = INP(I_CAW) + (size_t)l * 4 * AW + hd * 64 + lane;
                        const float cw0 = caw[0], cw1 = caw[AW], cw2 = caw[2 * AW], cw3 = caw[3 * AW], cb = INP(I_CAB)[cidx];
                        bf16x8 bR[4][2], bI[4][2];
#pragma unroll
                        for (int n = 0; n < 4; ++n)
#pragma unroll
                            for (int ks = 0; ks < 2; ++ks) { const size_t o_ = (size_t)(hd * 64 + n * 16 + fr) * 64 + ks * 32 + fq * 8;
                                bR[n][ks] = *(const bf16x8*)(GT_R + o_); bI[n][ks] = *(const bf16x8*)(GT_I + o_); }
                        float xm3 = 0.f, xm2 = 0.f, xm1 = 0.f;
                        if (smp) { const float* st = INP(I_SCA) + ((size_t)(l * BS + b) * 3) * AW + hd * 64 + lane; xm3 = st[0]; xm2 = st[AW]; xm1 = st[2 * AW]; }
                        else if (t0 > 0) { const bf16_t* zp = gZ + (size_t)(rowbase - 3) * INC + Z_XA + hd * 64 + lane; xm3 = bf2f(zp[0]); xm2 = bf2f(zp[INC]); xm1 = bf2f(zp[2 * INC]); }
                        float h = 0.f, pc = 1.f;
                        const bf16_t* zq = gZ + (size_t)(rowbase + (lane >> 3)) * INC + Z_XA + hd * 64 + (lane & 7) * 8;
                        unsigned* hp = (unsigned*)(HLOC + (size_t)rowbase * AW + hd * 64 + (lane & ~1)); unsigned* pp = (unsigned*)(PCUM + (size_t)rowbase * AW + hd * 64 + (lane & ~1));
                        LAS bf16_t* xraw = (LAS bf16_t*)pre_r;
                        u32x4 xn0 = *(const u32x4*)zq, xn1 = *(const u32x4*)(zq + (size_t)8 * INC);
                        for (int st = 0; st < nrows / 16; ++st) {
                            *(LAS u32x4*)(xraw + (lane >> 3) * 64 + (lane & 7) * 8) = xn0; *(LAS u32x4*)(xraw + ((lane >> 3) + 8) * 64 + (lane & 7) * 8) = xn1;
                            zq += (size_t)16 * INC;
                            if (st + 1 < nrows / 16) { xn0 = *(const u32x4*)zq; xn1 = *(const u32x4*)(zq + (size_t)8 * INC); }
                            LDS_WAIT();
#pragma unroll
                            for (int i = 0; i < 16; ++i) { const float xv = bf2f(xraw[i * 64 + lane]);
                                const float xc = cw0 * xm3 + cw1 * xm2 + cw2 * xm1 + cw3 * xv + cb; xm3 = xm2; xm2 = xm1; xm1 = xv; xcf[i * 64 + lane] = xc; tile[i * 72 + lane] = (bf16_t)f2bf(xc); }
                            LDS_WAIT();
                            const bf16x8 a0 = *(const LAS bf16x8*)(tile + fr * 72 + fq * 8), a1 = *(const LAS bf16x8*)(tile + fr * 72 + 32 + fq * 8);
#pragma unroll
                            for (int n = 0; n < 4; ++n) {
                                f32x4 ar = (f32x4){0.f, 0.f, 0.f, 0.f}, ai = (f32x4){0.f, 0.f, 0.f, 0.f};
                                ar = __builtin_amdgcn_mfma_f32_16x16x32_bf16(a0, bR[n][0], ar, 0, 0, 0); ar = __builtin_amdgcn_mfma_f32_16x16x32_bf16(a1, bR[n][1], ar, 0, 0, 0);
                                ai = __builtin_amdgcn_mfma_f32_16x16x32_bf16(a0, bI[n][0], ai, 0, 0, 0); ai = __builtin_amdgcn_mfma_f32_16x16x32_bf16(a1, bI[n][1], ai, 0, 0, 0);
#pragma unroll
                                for (int j = 0; j < 4; ++j) { pre_r[(fq * 4 + j) * 64 + n * 16 + fr] = ar[j]; pre_i[(fq * 4 + j) * 64 + n * 16 + fr] = ai[j]; }
                            }
                            LDS_WAIT();
#pragma unroll 4
                            for (int i = 0; i < 16; ++i) {
                                const float r = sigm(pre_r[i * 64 + lane] + br), gi = sigm(pre_i[i * 64 + lane] + bi);
                                const float la = -c8sp * r; float a, om;
                                if (la > -0.125f) { const float x = 2.0f * la; om = -x * (1.0f + x * (0.5f + x * (0.16666667f + x * (0.041666668f + x * (0.0083333338f + x * 0.0013888889f))))); a = 1.0f + la * (1.0f + la * (0.5f + la * (0.16666667f + la * (0.041666668f + la * 0.0083333338f)))); }
                                else { a = __expf(la); om = -expm1f(2.0f * la); }
                                const float bm = __builtin_amdgcn_sqrtf(om);
                                h = a * h + bm * gi * xcf[i * 64 + lane]; pc = pc * a;
                                { const float hn = __builtin_bit_cast(float, __builtin_amdgcn_mov_dpp(__builtin_bit_cast(int, h), 0xB1, 0xf, 0xf, true)), pn = __builtin_bit_cast(float, __builtin_amdgcn_mov_dpp(__builtin_bit_cast(int, pc), 0xB1, 0xf, 0xf, true));
                                  if ((lane & 1) == 0) { *hp = pk2(h, hn); *pp = pk2(pc, pn); } hp += AW / 2; pp += AW / 2; }
                            }
                            LDS_WAIT();
                        }
                        AGG[(size_t)un * 128 + lane] = pc; AGG[(size_t)un * 128 + 64 + lane] = h;
                    }
                }
                {
                    const float* cbw = INP(I_CBW) + (size_t)l * 3 * BW;
                    if (bid >= 8) for (int it = gt - 8 * NTHREADS; it < (MT / 8) * 32; it += NGT - 8 * NTHREADS) {
                        const int rb = it >> 5, c0 = (it & 31) * 8;
                        int b, t0, T, rowbase; const bool smp = rb >= MP / 8;
                        if (!smp) { b = rb >> 9; t0 = (rb & 511) * 8; T = SEQ; rowbase = rb * 8; } else { const int sbk = rb - MP / 8; b = sbk >> 2; t0 = (sbk & 3) * 8; T = TS; rowbase = MP + sbk * 8; }
                        u32x4 xq[10], cq[10], bq[8];
                        const bf16_t* zr = gZ + (size_t)rowbase * INC + c0;
#pragma unroll
                        for (int i = 0; i < 10; ++i) { if (i >= 2 || t0 > 0) { xq[i] = *(const u32x4*)(zr + (ptrdiff_t)(i - 2) * INC + Z_XB); cq[i] = *(const u32x4*)(zr + (ptrdiff_t)(i - 2) * INC + Z_GC); } else { xq[i] = (u32x4){0u, 0u, 0u, 0u}; cq[i] = (u32x4){0u, 0u, 0u, 0u}; } }
#pragma unroll
                        for (int i = 0; i < 8; ++i) bq[i] = *(const u32x4*)(zr + (size_t)i * INC + Z_GB);
                        float w0[8], w1[8], w2[8], pm2[8], pm1[8];
#pragma unroll
                        for (int k = 0; k < 8; ++k) { w0[k] = cbw[c0 + k]; w1[k] = cbw[BW + c0 + k]; w2[k] = cbw[2 * BW + c0 + k]; }
                        {
                            const float a_[8] = {bflo(xq[0].x) * bflo(cq[0].x), bfhi(xq[0].x) * bfhi(cq[0].x), bflo(xq[0].y) * bflo(cq[0].y), bfhi(xq[0].y) * bfhi(cq[0].y), bflo(xq[0].z) * bflo(cq[0].z), bfhi(xq[0].z) * bfhi(cq[0].z), bflo(xq[0].w) * bflo(cq[0].w), bfhi(xq[0].w) * bfhi(cq[0].w)};
                            const float b_[8] = {bflo(xq[1].x) * bflo(cq[1].x), bfhi(xq[1].x) * bfhi(cq[1].x), bflo(xq[1].y) * bflo(cq[1].y), bfhi(xq[1].y) * bfhi(cq[1].y), bflo(xq[1].z) * bflo(cq[1].z), bfhi(xq[1].z) * bfhi(cq[1].z), bflo(xq[1].w) * bflo(cq[1].w), bfhi(xq[1].w) * bfhi(cq[1].w)};
#pragma unroll
                            for (int k = 0; k < 8; ++k) { pm2[k] = a_[k]; pm1[k] = b_[k]; }
                        }
                        if (t0 == 0 && smp) { const float* st = INP(I_SCB) + ((size_t)(l * BS + b) * 2) * BW + c0;
#pragma unroll
                            for (int k = 0; k < 8; ++k) { pm2[k] = st[k]; pm1[k] = st[BW + k]; } }
#pragma unroll
                        for (int i = 0; i < 8; ++i) {
                            const u32x4 xb = xq[i + 2], gc = cq[i + 2], gb = bq[i];
                            const float pv[8] = {bflo(xb.x) * bflo(gc.x), bfhi(xb.x) * bfhi(gc.x), bflo(xb.y) * bflo(gc.y), bfhi(xb.y) * bfhi(gc.y), bflo(xb.z) * bflo(gc.z), bfhi(xb.z) * bfhi(gc.z), bflo(xb.w) * bflo(gc.w), bfhi(xb.w) * bfhi(gc.w)};
                            const float gbv[8] = {bflo(gb.x), bfhi(gb.x), bflo(gb.y), bfhi(gb.y), bflo(gb.z), bfhi(gb.z), bflo(gb.w), bfhi(gb.w)};
                            float yv[8];
#pragma unroll
                            for (int k = 0; k < 8; ++k) { yv[k] = gbv[k] * (w0[k] * pm2[k] + w1[k] * pm1[k] + w2[k] * pv[k]); pm2[k] = pm1[k]; pm1[k] = pv[k]; }
                            u32x4 w; w.x = pk2(yv[0], yv[1]); w.y = pk2(yv[2], yv[3]); w.z = pk2(yv[4], yv[5]); w.w = pk2(yv[6], yv[7]);
                            *(u32x4*)(gY + (size_t)(rowbase + i) * D + 512 + c0) = w;
                        }
                        if (t0 + 8 == T) { float* o = out + (smp ? O_CBS : O_CBP) + ((size_t)(l * 8 + b) * 2) * BW + c0;
#pragma unroll
                            for (int k = 0; k < 8; ++k) { o[k] = pm2[k]; o[BW + k] = pm1[k]; } }
                    }
                }
            } else if (rep == 2) {
                LANE_STATE();
                {
                    LAS float* cr = (LAS float*)lds;
                    for (int un = bid; un < 8 + 256; un += G) {
                        int b, ch, rowbase, nrows; const bool smp = un < 8;
                        if (smp) { b = un; ch = 0; rowbase = MP + b * TS; nrows = TS; } else { const int v = un - 8; b = v >> 5; ch = v & 31; rowbase = b * SEQ + ch * 128; nrows = 128; }
                        {
                            const int c = tid, hd = c >> 6, ln = c & 63; float carry = 0.f;
                            if (smp) carry = INP(I_SHA)[(size_t)(l * BS + b) * AW + c];
                            else { const float* ag = AGG + (size_t)(64 + (b << 8) + (hd << 5)) * 128 + ln; for (int k = 0; k < ch; ++k) carry = ag[(size_t)k * 128] * carry + ag[(size_t)k * 128 + 64]; }
                            cr[c] = carry;
                        }
                        __syncthreads();
                        const int c0 = (tid & 63) * 8, rsub = tid >> 6;
                        const f32x4 ca = *(const LAS f32x4*)(cr + c0), cb = *(const LAS f32x4*)(cr + c0 + 4);
                        for (int p = 0; p < nrows / 8; ++p) {
                            const int rloc = p * 8 + rsub; const size_t row = (size_t)(rowbase + rloc);
                            const u32x4 hq = *(const u32x4*)(HLOC + row * AW + c0), pq = *(const u32x4*)(PCUM + row * AW + c0);
                            const f32x4 h0 = (f32x4){bflo(hq.x), bfhi(hq.x), bflo(hq.y), bfhi(hq.y)}, h1 = (f32x4){bflo(hq.z), bfhi(hq.z), bflo(hq.w), bfhi(hq.w)}, p0 = (f32x4){bflo(pq.x), bfhi(pq.x), bflo(pq.y), bfhi(pq.y)}, p1 = (f32x4){bflo(pq.z), bfhi(pq.z), bflo(pq.w), bfhi(pq.w)};
                            const u32x4 gq = *(const u32x4*)(gZ + row * INC + Z_GA + c0);
                            const f32x4 a0 = h0 + p0 * ca, a1 = h1 + p1 * cb;
                            u32x4 w; w.x = pk2(gelu_t(bflo(gq.x)) * a0[0], gelu_t(bfhi(gq.x)) * a0[1]); w.y = pk2(gelu_t(bflo(gq.y)) * a0[2], gelu_t(bfhi(gq.y)) * a0[3]);
                            w.z = pk2(gelu_t(bflo(gq.z)) * a1[0], gelu_t(bfhi(gq.z)) * a1[1]); w.w = pk2(gelu_t(bflo(gq.w)) * a1[2], gelu_t(bfhi(gq.w)) * a1[3]);
                            *(u32x4*)(gY + row * D + c0) = w;
                            if ((smp || ch == 31) && rloc == nrows - 1) { float* o = out + (smp ? O_HAS : O_HAP) + (size_t)(l * 8 + b) * AW + c0; *(f32x4*)o = a0; *(f32x4*)(o + 4) = a1; }
                        }
                        if ((smp || ch == 31) && tid < 192) {
                            const int k = tid >> 6; const u32x4 xq = *(const u32x4*)(gZ + (size_t)(rowbase + nrows - 3 + k) * INC + Z_XA + c0);
                            float* o = out + (smp ? O_CAS : O_CAP) + ((size_t)(l * 8 + b) * 3 + k) * AW + c0;
                            *(f32x4*)o = (f32x4){bflo(xq.x), bfhi(xq.x), bflo(xq.y), bfhi(xq.y)}; *(f32x4*)(o + 4) = (f32x4){bflo(xq.z), bfhi(xq.z), bflo(xq.w), bfhi(xq.w)};
                        }
                        __syncthreads();
                    }
                }
            } else if (rep == 3 || rep == 8 || rep == 12) {
                LANE_STATE();
                if (rep == 12) {
                    const float* cfw = INP(I_CFW) + (size_t)l * 3 * DFF;
                    pg8::GSched S0; S0.init(MP / 256, D / 256, G, bid); pg8::Unit u0;
                    for (int i = 0; S0.next(i, u0); ++i) {
                        const int pm = u0.pm; if (pm >= 128 || tid >= DFF / 8) continue;
                        const int c0 = tid * 8, b = pm >> 4;
                        float w0[8], w1[8], w2[8], p2[8], p1[8], g0[8], g1[8], u0_[8], u1_[8];
#pragma unroll
                        for (int k = 0; k < 8; ++k) { w0[k] = cfw[c0 + k]; w1[k] = cfw[DFF + c0 + k]; w2[k] = cfw[2 * DFF + c0 + k]; p2[k] = 0.f; p1[k] = 0.f; }
                        if ((pm & 15) != 0) {
#pragma unroll
                            for (int k = 0; k < 8; ++k) { p2[k] = SBL[((size_t)(pm - 1) * 2 + 0) * DFF + c0 + k]; p1[k] = SBL[((size_t)(pm - 1) * 2 + 1) * DFF + c0 + k]; } }
#pragma unroll
                        for (int k = 0; k < 8; ++k) { g0[k] = SBG[((size_t)pm * 2 + 0) * DFF + c0 + k]; g1[k] = SBG[((size_t)pm * 2 + 1) * DFF + c0 + k]; u0_[k] = SBU[((size_t)pm * 2 + 0) * DFF + c0 + k]; u1_[k] = SBU[((size_t)pm * 2 + 1) * DFF + c0 + k]; }
                        float ha[8], hb[8];
#pragma unroll
                        for (int k = 0; k < 8; ++k) { ha[k] = silu(w0[k] * p2[k] + w1[k] * p1[k] + w2[k] * g0[k]) * u0_[k]; hb[k] = silu(w0[k] * p1[k] + w1[k] * g0[k] + w2[k] * g1[k]) * u1_[k]; }
                        u32x4 w; w.x = pk2(ha[0], ha[1]); w.y = pk2(ha[2], ha[3]); w.z = pk2(ha[4], ha[5]); w.w = pk2(ha[6], ha[7]);
                        *(u32x4*)(GU + (size_t)(pm * 256) * DFF + c0) = w;
                        w.x = pk2(hb[0], hb[1]); w.y = pk2(hb[2], hb[3]); w.z = pk2(hb[4], hb[5]); w.w = pk2(hb[6], hb[7]);
                        *(u32x4*)(GU + (size_t)(pm * 256 + 1) * DFF + c0) = w;
                        if ((pm & 15) == 15 && u0.pn == 0) { float* o = out + O_CFP + ((size_t)(l * 8 + b) * 2) * DFF + c0;
#pragma unroll
                            for (int k = 0; k < 8; ++k) { o[k] = SBL[((size_t)pm * 2 + 0) * DFF + c0 + k]; o[DFF + k] = SBL[((size_t)pm * 2 + 1) * DFF + c0 + k]; } }
                    }
                    asm volatile("s_waitcnt vmcnt(0)" ::: "memory"); __syncthreads();
                }
                GEMM_RES(rep == 3 ? 0 : (rep == 8 ? 1 : 2));
                { LANE_STATE();
                  const SG2 sg{rep == 12 ? GU + (size_t)MP * DFF : (rep == 3 ? gY : gO) + (size_t)MP * D, rep == 12 ? WDN_T : (rep == 3 ? WOUT_T : WO_T), rep == 12 ? DFF : D, rep == 12 ? DFF : D, rep == 12 ? DFF : D, D, XN + (size_t)MP * D, D, 1.f, 2, SSS(3 * l + (rep == 3 ? 1 : (rep == 8 ? 2 : 3)))};
                  sgemm2(lds, sg, bid, G, wave, tid); }
                if (l + 1 < DEPTH) { LANE_STATE(); if (bid >= 64) convert_layer(kp, ws, lds, l + 1, rep == 3 ? 0 : (rep == 8 ? 2 : 3), 4, gw - 64 * NWAVES, NGW - 64 * NWAVES, gt - 64 * NTHREADS, NGT - 64 * NTHREADS, lane, wave); }
            } else if (rep == 6) {
                LANE_STATE();
                for (int sub = 0; sub < 2; ++sub) {
                    pg8::GSched S; pg8::Gemm g; pg8::EpiSoftmax E;
                    if (sub == 0) { S.init(MP / 256, 4, G, bid); S.aPm = (size_t)256 * D * 2; S.aPn = 512; S.bPn = 512; S.bPm = (size_t)256 * D * 2; S.bShift = 4; g = pg8::Gemm{gQ, KBP, D, D, 256}; E.O = gP; E.ldc = D; E.smp = 0; }
                    else { S.init(1, 32, G, (bid + G - 64) % G); S.mode = 1; g = pg8::Gemm{gQ + (size_t)MP * D, KBS, D, D, 256}; E.O = PS; E.ldc = 8192; E.smp = 1; }
                    pg8::gemm_phase<pg8::EpiSoftmax, pg8::GSched, true>(lds, g, S, E, wave_s);
                }
            }
            if (rep == 6) { asm volatile("s_waitcnt vmcnt(0)" ::: "memory"); __syncthreads(); }
            else GRID_SYNC();
          }
        }
    }
    {
        LANE_STATE();
        const float* gain = INP(I_GFIN);
        f32x4 gv[4];
#pragma unroll
        for (int j = 0; j < 4; ++j) gv[j] = ((const f32x4*)gain)[lane + 64 * j];
        for (int m0 = gw; m0 < MT; m0 += 2 * NGW) {
            const int m1 = m0 + NGW; const bool two = m1 < MT; const int mb = two ? m1 : m0;
            const u32x2* xa = (const u32x2*)(XN + (size_t)m0 * D) + lane; const u32x2* xb = (const u32x2*)(XN + (size_t)mb * D) + lane;
            u32x2 pa[4], pb[4];
#pragma unroll
            for (int j = 0; j < 4; ++j) { pa[j] = xa[64 * j]; pb[j] = xb[64 * j]; }
            float ra, rb;
            { float qa = 0.f, qb = 0.f;
#pragma unroll
              for (int j = 0; j < 4; ++j) { const float a0 = bflo(pa[j].x), a1 = bfhi(pa[j].x), a2 = bflo(pa[j].y), a3 = bfhi(pa[j].y), b0 = bflo(pb[j].x), b1 = bfhi(pb[j].x), b2 = bflo(pb[j].y), b3 = bfhi(pb[j].y);
                  qa += (a0 * a0 + a1 * a1) + (a2 * a2 + a3 * a3); qb += (b0 * b0 + b1 * b1) + (b2 * b2 + b3 * b3); }
              if (m0 < MP) ra = ss_rstd(*(const f32x4*)(SSQ(6) + (size_t)m0 * 4)); else ra = 1.0f / sqrtf(wave_sum(qa, lane) * (1.f / D) + EPS);
              if (mb < MP) rb = ss_rstd(*(const f32x4*)(SSQ(6) + (size_t)mb * 4)); else rb = 1.0f / sqrtf(wave_sum(qb, lane) * (1.f / D) + EPS); }
            f32x4* ya = (f32x4*)(out + (size_t)m0 * D) + lane; f32x4* yb = (f32x4*)(out + (size_t)mb * D) + lane;
#pragma unroll
            for (int j = 0; j < 4; ++j) { ya[64 * j] = (f32x4){bflo(pa[j].x), bfhi(pa[j].x), bflo(pa[j].y), bfhi(pa[j].y)} * ra * gv[j]; if (two) yb[64 * j] = (f32x4){bflo(pb[j].x), bfhi(pb[j].x), bflo(pb[j].y), bfhi(pb[j].y)} * rb * gv[j]; }
        }
    }
}

extern "C" void kernel_launch(void* const* d_in, const int* in_sizes, int n_in, void* d_out, int out_size, void* d_ws, size_t ws_size, hipStream_t stream) {
    static int grid = 0;
    if (grid == 0) {
        if (n_in != N_IN || (size_t)out_size != O_END || ws_size < 512 * MiB) { fprintf(stderr, "kernel_launch: unexpected sizes n_in %d out %d ws %zu (need %zu)\n", n_in, out_size, ws_size, (size_t)(512 * MiB)); grid = -1; return; }
        int dev = 0, cus = 0, per_cu = 0;
        (void)hipGetDevice(&dev); (void)hipDeviceGetAttribute(&cus, hipDeviceAttributeMultiprocessorCount, dev);
        if (hipFuncSetAttribute((const void*)trunk_fwd, hipFuncAttributeMaxDynamicSharedMemorySize, LDS_BYTES) != hipSuccess) { fprintf(stderr, "kernel_launch: hipFuncSetAttribute failed\n"); grid = -1; return; }
        if (hipOccupancyMaxActiveBlocksPerMultiprocessor(&per_cu, (const void*)trunk_fwd, NTHREADS, LDS_BYTES) != hipSuccess || per_cu < 1) { fprintf(stderr, "kernel_launch: occupancy query gave %d\n", per_cu); per_cu = 1; }
        (void)hipGetLastError();
        grid = cus * 1;
        if (grid != 256) fprintf(stderr, "kernel_launch: note: %d CUs\n", grid);
    }
    if (grid < 0) return;
    Args a{};
    for (int i = 0; i < N_IN; ++i) a.in[i] = (const float*)d_in[i];
    a.out = (float*)d_out; a.ws = (unsigned char*)d_ws;
    void* kargs[] = {&a};
    hipError_t e = hipLaunchCooperativeKernel((const void*)trunk_fwd, dim3(grid), dim3(NTHREADS), kargs, LDS_BYTES, stream);
    if (e != hipSuccess) fprintf(stderr, "kernel_launch: cooperative launch failed: %s (grid %d)\n", hipGetErrorString(e), grid);
}
```

```cpp
#include <hip/hip_runtime.h>
#include <hip/hip_cooperative_groups.h>
#include <cstdio>
#include <cstdint>
namespace cg = cooperative_groups;
#ifndef PROBE
#define PROBE 0
#endif

#define LAS __attribute__((address_space(3)))
typedef unsigned short bf16_t;
typedef short bf16x8 __attribute__((ext_vector_type(8)));
typedef float f32x4 __attribute__((ext_vector_type(4)));
typedef float f32x2 __attribute__((ext_vector_type(2)));
typedef unsigned u32x4 __attribute__((ext_vector_type(4)));
typedef unsigned u32x2 __attribute__((ext_vector_type(2)));

constexpr int D = 1024, BP = 8, SEQ = 4096, BS = 8, TS = 32, DEPTH = 2;
constexpr int MP = BP * SEQ, MS = BS * TS, MT = MP + MS;
constexpr int INC = 2304, DFF = 2816, NMEM = 256, AW = 512, BW = 256, CW = 256;
constexpr int Z_XA = 0, Z_GA = 512, Z_XB = 1024, Z_GB = 1280, Z_GC = 1536, Z_UC = 1792, Z_VC = 2048;
constexpr float EPS = 1e-6f;
constexpr int NWAVES = 8, NTHREADS = 512;

constexpr size_t O_YP = 0, O_YS = O_YP + (size_t)MP * D, O_CAP = O_YS + (size_t)MS * D, O_HAP = O_CAP + DEPTH * BP * 3 * AW,
                 O_CBP = O_HAP + DEPTH * BP * AW, O_CFP = O_CBP + DEPTH * BP * 2 * BW, O_MKP = O_CFP + DEPTH * BP * 2 * DFF,
                 O_MVP = O_MKP + (size_t)DEPTH * BP * NMEM * D, O_CAS = O_MVP + (size_t)DEPTH * BP * NMEM * D, O_HAS = O_CAS + DEPTH * BS * 3 * AW,
                 O_CBS = O_HAS + DEPTH * BS * AW, O_CFS = O_CBS + DEPTH * BS * 2 * BW, O_VCS = O_CFS + DEPTH * BS * 2 * DFF,
                 O_END = O_VCS + DEPTH * BS * TS * CW;

constexpr size_t MiB = 1u << 20;
constexpr size_t WS_WIN = 0, WS_WOUT = 5 * MiB, WS_WQ = 7 * MiB, WS_WK = 9 * MiB, WS_WV = 11 * MiB, WS_WO = 13 * MiB, WS_WUP = 15 * MiB, WS_WDN = 26 * MiB;
constexpr size_t WS_MEMB = 32 * MiB, WS_KBP = 36 * MiB, WS_VTP = 40 * MiB, WS_KBS = 44 * MiB, WS_VTS = 48 * MiB, WS_WST = 52 * MiB, WS_GT = WS_WST + 131072, WS_AGG = 53 * MiB, WS_SS = 54 * MiB + 256 * 1024, WS_BAR = 55 * MiB + 512 * 1024;
constexpr size_t WS_XN = 56 * MiB, WS_BIG = 121 * MiB;
constexpr size_t B_Z = WS_BIG, B_HLOC = WS_BIG + 146 * MiB, B_PCUM = WS_BIG + 211 * MiB, B_Y = WS_BIG + 276 * MiB;
constexpr size_t B_Q = WS_BIG, B_P = WS_BIG + 65 * MiB, B_O = WS_BIG + 130 * MiB, B_PS = WS_BIG + 195 * MiB;
constexpr size_t B_GU = WS_BIG;
constexpr size_t B_GUS = WS_BIG + 200 * MiB;
constexpr size_t B_SBG = WS_BIG + 204 * MiB, B_SBU = WS_BIG + 207 * MiB, B_SBL = WS_BIG + 210 * MiB;
constexpr size_t WS_END = WS_BIG + (size_t)MT * 2 * DFF * 2;
constexpr size_t WS_SSP = 476 * MiB;
static_assert(WS_END <= WS_SSP && WS_SSP + (size_t)7 * MT * 64 <= 512 * MiB, "workspace");
static_assert(WS_XN + (size_t)MT * D * 2 <= WS_BIG, "xn");
constexpr size_t WS_SSS = WS_SSP + (((size_t)7 * MT * 16 + 4095) / 4096) * 4096;
static_assert(WS_SSS + 7 * 256 * 32 * 4 <= 480 * MiB, "sss");
constexpr size_t WSEL1 = 480 * MiB, KSEL1 = 418 * MiB;
static_assert(WS_WDN + (size_t)D * DFF * 2 + WSEL1 <= 512 * MiB && WS_KBS + KSEL1 >= WS_BIG + 341 * MiB && WS_GT + 131072 + KSEL1 <= WS_SSP, "second buffer set");

constexpr int LDS_RING = 131072, LDS_EX = LDS_RING, LDS_MISC = LDS_EX + 8192, LDS_BYTES = 147456;

enum { I_XP = 0, I_XS, I_MEM, I_CK, I_CV, I_SCA, I_SHA, I_SCB, I_SCF, I_GMIX, I_WIN, I_CAW, I_CAB, I_WRG, I_BRG, I_WIG, I_BIG, I_LAM, I_CBW, I_GV, I_WS, I_BSS,
       I_WOUT, I_GX, I_WQ, I_WK, I_WV, I_WO, I_GFFN, I_WUP, I_CFW, I_WDN, I_GFIN, N_IN };

struct Args { const float* in[N_IN]; float* out; unsigned char* ws; };

__device__ __forceinline__ unsigned pk2(float lo, float hi) { unsigned r; asm("v_cvt_pk_bf16_f32 %0, %1, %2" : "=v"(r) : "v"(lo), "v"(hi)); return r; }
__device__ __forceinline__ unsigned f2bf(float f) { return pk2(f, f) & 0xffffu; }
__device__ __forceinline__ float bf2f(unsigned v) { return __builtin_bit_cast(float, v << 16); }
__device__ __forceinline__ float bflo(unsigned w) { return __builtin_bit_cast(float, w << 16); }
__device__ __forceinline__ float bfhi(unsigned w) { return __builtin_bit_cast(float, w & 0xffff0000u); }
__device__ __forceinline__ unsigned cvt_pk_bf16(float lo, float hi) { unsigned r; asm volatile("v_cvt_pk_bf16_f32 %0, %1, %2" : "=v"(r) : "v"(lo), "v"(hi)); return r; }
__device__ __forceinline__ float fexp(float x) { return __builtin_amdgcn_exp2f(x * 1.4426950408889634f); }
__device__ __forceinline__ float sigm(float x) { return __builtin_amdgcn_rcpf(1.0f + fexp(-x)); }
__device__ __forceinline__ float gelu_t(float x) { const float u = 0.7978845608028654f * (x + 0.044715f * x * x * x); return x * sigm(2.0f * u); }
__device__ __forceinline__ float silu(float x) { return x * sigm(x); }
__device__ __forceinline__ float shx(float v, int m, int lane) { return __builtin_bit_cast(float, __builtin_amdgcn_ds_bpermute((lane ^ m) << 2, __builtin_bit_cast(int, v))); }
__device__ __forceinline__ float wave_sum(float v, int lane) {
#pragma unroll
    for (int o = 1; o < 64; o <<= 1) v += shx(v, o, lane);
    return v;
}
#define LDS_WAIT() asm volatile("s_waitcnt lgkmcnt(0)" ::: "memory")
__device__ __forceinline__ float ss_rstd(f32x4 p) { return __builtin_amdgcn_rsqf(((p[0] + p[1]) + (p[2] + p[3])) * (1.f / 1024.f) + 1e-6f); }
__device__ __forceinline__ int opaque_tid(int wave_s) { int l; asm volatile("v_mbcnt_lo_u32_b32 %0, -1, 0\n\tv_mbcnt_hi_u32_b32 %0, -1, %0" : "=v"(l)); return wave_s * 64 + l; }

namespace pg8 {
constexpr int BM = 256, BK = 64, HALF = 128, HTB = HALF * BK * 2, NXCD = 8, WGM = 8;
__device__ __forceinline__ int lds_byte(int r, int c) { const int st = (r >> 4) * 2 + (c >> 5), rr = r & 15, cc = c & 31, ob = rr * 64 + cc * 2; return st * 1024 + (ob ^ (((ob >> 9) & 1) << 5)); }
__device__ __forceinline__ void stage_rc(int b, int& R, int& C) { const int st = b / 1024, sb = b % 1024, swz = sb ^ (((sb >> 9) & 1) << 5); R = (st >> 1) * 16 + swz / 64; C = (st & 1) * 32 + (swz % 64) / 2; }
__device__ __forceinline__ int perm32(int rho) { const int n = rho >> 4, i = rho & 15; return 8 * (i >> 2) + 4 * n + (i & 3); }

struct Unit { int pm, pn; };
struct Gemm { const bf16_t* A; const bf16_t* Bt; int lda, ldb, K; };

struct GSched {
    int nM, nN, nwg, G, c, mode;
    size_t aPm, aPn, bPn, bPm; int bShift;
    __device__ __forceinline__ void init(int nM_, int nN_, int G_, int c_) { nM = nM_; nN = nN_; nwg = nM * nN; G = G_; c = c_; mode = 0; aPm = 0; aPn = 0; bPn = 0; bPm = 0; bShift = 0; }
    __device__ __forceinline__ bool next(int i, Unit& u) const {
        const long L = (long)i * G + c; if (L >= nwg) return false;
        int wgid = (int)L; { const int q = nwg / NXCD, r = nwg % NXCD, xcd = wgid % NXCD, off = wgid / NXCD; wgid = (xcd < r ? xcd * (q + 1) : r * (q + 1) + (xcd - r) * q) + off; }
        const int nig = WGM * nN, gid = wgid / nig, fm = gid * WGM, gsz = (nM - fm) < WGM ? (nM - fm) : WGM;
        u.pm = fm + ((wgid % nig) % gsz); u.pn = (wgid % nig) / gsz; return true;
    }
    __device__ __forceinline__ size_t offA(const Unit& u) const { return mode == 1 ? (size_t)(u.pn & 3) * 512 : (mode == 2 ? (size_t)(u.pn & 3) * 4096 + (size_t)(u.pn >> 2) * 512 : (size_t)u.pm * aPm + (size_t)u.pn * aPn); }
    __device__ __forceinline__ size_t offB(const Unit& u) const { return mode == 1 ? (size_t)(u.pn >> 2) * (256 * 1024 * 2) + (size_t)(u.pn & 3) * 512 : (mode == 2 ? (size_t)(u.pn & 3) * (256 * 2048 * 2) + (size_t)(u.pn >> 2) * 512 : (size_t)u.pn * bPn + (size_t)(u.pm >> bShift) * bPm); }
};

struct EpiBf16 {
    static constexpr bool PERM = true;
    bf16_t* O; int ldc; float scale; const float* ss; int smp;
    __device__ __forceinline__ void operator()(f32x4 (&acc)[2][2][4][2], const Unit& u, int wr, int wc, int fr, int fq, LAS unsigned char*) const {
        asm volatile("" : "+v"(fr), "+v"(fq)); asm volatile("" : "+s"(wr), "+s"(wc));
        const int row0 = u.pm * BM + wr * 64 + fr, col0 = (smp ? (u.pn & 3) : u.pn) * BM + wc * 32 + 8 * fq;
        f32x4 rs[2][4];
#pragma unroll
        for (int ai = 0; ai < 2; ++ai)
#pragma unroll
            for (int m = 0; m < 4; ++m) rs[ai][m] = ss ? *(const f32x4*)(ss + (size_t)(row0 + ai * HALF + m * 16) * 4) : (f32x4){0.f, 0.f, 0.f, 0.f};
#pragma unroll
        for (int ai = 0; ai < 2; ++ai)
#pragma unroll
            for (int m = 0; m < 4; ++m) { bf16_t* rowp = O + (size_t)(row0 + ai * HALF + m * 16) * ldc + col0;
                float sc = scale; if (ss) sc *= ss_rstd(rs[ai][m]);
                if (smp && ((ai * HALF + wr * 64 + m * 16 + fr) >> 5) != (u.pn >> 2)) continue;
#pragma unroll
                for (int bj = 0; bj < 2; ++bj) { const f32x4 v0 = acc[ai][bj][m][0] * sc, v1 = acc[ai][bj][m][1] * sc;
                    u32x4 w; w.x = cvt_pk_bf16(v0[0], v0[1]); w.y = cvt_pk_bf16(v0[2], v0[3]); w.z = cvt_pk_bf16(v1[0], v1[1]); w.w = cvt_pk_bf16(v1[2], v1[3]);
                    *(u32x4*)(rowp + bj * HALF) = w; } }
    }
};
struct EpiResid {
    static constexpr bool PERM = true;
    bf16_t* xb; float* ss;
    __device__ __forceinline__ void operator()(f32x4 (&acc)[2][2][4][2], const Unit& u, int wr, int wc, int fr, int fq, LAS unsigned char* lds) const {
        asm volatile("" : "+v"(fr), "+v"(fq)); asm volatile("" : "+s"(wr), "+s"(wc));
        const int col0 = u.pn * BM + wc * 32 + 8 * fq, lane = fq * 16 + fr;
        LAS float* PS = (LAS float*)(lds + LDS_EX);
        bf16_t* ob = xb + (size_t)u.pm * BM * D;
#pragma unroll
        for (int ai = 0; ai < 2; ++ai) {
            u32x4 pre[4][2];
#pragma unroll
            for (int m = 0; m < 4; ++m)
#pragma unroll
                for (int bj = 0; bj < 2; ++bj) pre[m][bj] = *(const u32x4*)(ob + (size_t)(ai * HALF + wr * 64 + m * 16 + fr) * D + col0 + bj * HALF);
            asm volatile("" ::: "memory");
#pragma unroll
            for (int m = 0; m < 4; ++m) { const int rl = ai * HALF + wr * 64 + m * 16 + fr; const size_t off = (size_t)rl * D + col0; float q = 0.f;
#pragma unroll
                for (int bj = 0; bj < 2; ++bj) { const u32x4 p = pre[m][bj]; const f32x4 a0 = acc[ai][bj][m][0], a1 = acc[ai][bj][m][1];
                    const float v0 = bflo(p.x) + a0[0], v1 = bfhi(p.x) + a0[1], v2 = bflo(p.y) + a0[2], v3 = bfhi(p.y) + a0[3], v4 = bflo(p.z) + a1[0], v5 = bfhi(p.z) + a1[1], v6 = bflo(p.w) + a1[2], v7 = bfhi(p.w) + a1[3];
                    u32x4 w; w.x = cvt_pk_bf16(v0, v1); w.y = cvt_pk_bf16(v2, v3); w.z = cvt_pk_bf16(v4, v5); w.w = cvt_pk_bf16(v6, v7); *(u32x4*)(ob + off + bj * HALF) = w;
                    q += ((v0 * v0 + v1 * v1) + (v2 * v2 + v3 * v3)) + ((v4 * v4 + v5 * v5) + (v6 * v6 + v7 * v7)); }
                q += shx(q, 16, lane); q += shx(q, 32, lane);
                if (fq == 0) PS[rl * 4 + wc] = q; }
            asm volatile("" ::: "memory");
        }
        asm volatile("s_waitcnt lgkmcnt(0)" ::: "memory"); __builtin_amdgcn_s_barrier(); asm volatile("" ::: "memory");
        { const int t = (wr * 4 + wc) * 64 + lane; if (t < 256) { const f32x4 p = *(const LAS f32x4*)(PS + t * 4); ss[(size_t)(u.pm * BM + t) * 4 + u.pn] = (p[0] + p[1]) + (p[2] + p[3]); } }
    }
};
struct EpiKV {
    static constexpr bool PERM = false;
    float* outK; float* outV; bf16_t* KB; bf16_t* VT;
    __device__ __forceinline__ void operator()(f32x4 (&acc)[2][2][4][2], const Unit& u, int wr, int wc, int fr, int fq, LAS unsigned char*) const {
        asm volatile("" : "+v"(fr), "+v"(fq)); asm volatile("" : "+s"(wr), "+s"(wc));
        const int kind = u.pm >> 4, pm = u.pm & 15;
        const int col0 = u.pn * BM + wc * 32 + 4 * fq;
        float* of = kind == 0 ? outK : outV; bf16_t* ob = kind == 0 ? KB : VT; const int ldb_ = kind == 2 ? 2048 : 1024;
#pragma unroll
        for (int ai = 0; ai < 2; ++ai)
#pragma unroll
            for (int m = 0; m < 4; ++m) { const int row = pm * BM + ai * HALF + wr * 64 + m * 16 + fr;
#pragma unroll
                for (int bj = 0; bj < 2; ++bj)
#pragma unroll
                    for (int n = 0; n < 2; ++n) { const f32x4 v = acc[ai][bj][m][n]; const int col = col0 + bj * HALF + n * 16;
                        if (kind != 2) __builtin_nontemporal_store(v, (f32x4*)(of + (size_t)row * 1024 + col));
                        if (kind != 1) { u32x2 w; w.x = cvt_pk_bf16(v[0], v[1]); w.y = cvt_pk_bf16(v[2], v[3]); *(u32x2*)(ob + (size_t)row * ldb_ + col) = w; } } }
    }
};
struct EpiSoftmax {
    static constexpr bool PERM = true;
    bf16_t* O; int ldc; int smp;
    __device__ __forceinline__ void operator()(f32x4 (&acc)[2][2][4][2], const Unit& u, int wr, int wc, int fr, int fq, LAS unsigned char* lds) const {
        asm volatile("" : "+v"(fr), "+v"(fq)); asm volatile("" : "+s"(wr), "+s"(wc));
        LAS f32x2* EX = (LAS f32x2*)(lds + LDS_EX);
        const int lane = fq * 16 + fr;
        const float L2E = 1.4426950408889634f;
#pragma unroll
        for (int ai = 0; ai < 2; ++ai)
#pragma unroll
            for (int m = 0; m < 4; ++m) {
                float mx = -3.0e38f;
#pragma unroll
                for (int bj = 0; bj < 2; ++bj)
#pragma unroll
                    for (int n = 0; n < 2; ++n) { const f32x4 x = acc[ai][bj][m][n]; mx = fmaxf(mx, fmaxf(fmaxf(x[0], x[1]), fmaxf(x[2], x[3]))); }
                mx = fmaxf(mx, shx(mx, 16, lane)); mx = fmaxf(mx, shx(mx, 32, lane));
                float s = 0.f;
#pragma unroll
                for (int bj = 0; bj < 2; ++bj)
#pragma unroll
                    for (int n = 0; n < 2; ++n) { f32x4 x = acc[ai][bj][m][n];
#pragma unroll
                        for (int j = 0; j < 4; ++j) { x[j] = __builtin_amdgcn_exp2f((x[j] - mx) * L2E); s += x[j]; }
                        acc[ai][bj][m][n] = x; }
                s += shx(s, 16, lane); s += shx(s, 32, lane);
                if (fq == 0) EX[(ai * HALF + wr * 64 + m * 16 + fr) * 4 + wc] = (f32x2){mx, s};
            }
        asm volatile("s_waitcnt lgkmcnt(0)" ::: "memory"); __builtin_amdgcn_s_barrier(); asm volatile("" ::: "memory");
        int colb = u.pn * BM, j_ = 0;
        if (smp) { colb = (u.pn & 3) * 2048 + (u.pn >> 2) * 256; j_ = u.pn >> 2; }
        const int col0 = colb + wc * 32 + 8 * fq;
#pragma unroll
        for (int ai = 0; ai < 2; ++ai)
#pragma unroll
            for (int m = 0; m < 4; ++m) {
                const int rl = ai * HALF + wr * 64 + m * 16 + fr;
                const f32x2 e0 = EX[rl * 4 + 0], e1 = EX[rl * 4 + 1], e2 = EX[rl * 4 + 2], e3 = EX[rl * 4 + 3];
                const float M = fmaxf(fmaxf(e0.x, e1.x), fmaxf(e2.x, e3.x));
                const float tot = e0.y * __builtin_amdgcn_exp2f((e0.x - M) * L2E) + e1.y * __builtin_amdgcn_exp2f((e1.x - M) * L2E) + e2.y * __builtin_amdgcn_exp2f((e2.x - M) * L2E) + e3.y * __builtin_amdgcn_exp2f((e3.x - M) * L2E);
                const float own = wc == 0 ? e0.x : (wc == 1 ? e1.x : (wc == 2 ? e2.x : e3.x));
                float f = __builtin_amdgcn_exp2f((own - M) * L2E) * __builtin_amdgcn_rcpf(tot);
                if (smp && (rl >> 5) != j_) f = 0.f;
                bf16_t* rowp = O + (size_t)(u.pm * BM + rl) * ldc + col0;
#pragma unroll
                for (int bj = 0; bj < 2; ++bj) { const f32x4 v0 = acc[ai][bj][m][0] * f, v1 = acc[ai][bj][m][1] * f;
                    u32x4 w; w.x = cvt_pk_bf16(v0[0], v0[1]); w.y = cvt_pk_bf16(v0[2], v0[3]); w.z = cvt_pk_bf16(v1[0], v1[1]); w.w = cvt_pk_bf16(v1[2], v1[3]);
                    *(u32x4*)(rowp + bj * HALF) = w; } }
    }
};


__device__ __forceinline__ float dpp_ror1(float v) { return __builtin_bit_cast(float, __builtin_amdgcn_update_dpp(0, __builtin_bit_cast(int, v), 0x121, 0xf, 0xf, false)); }
__device__ __forceinline__ float dpp_ror2(float v) { return __builtin_bit_cast(float, __builtin_amdgcn_update_dpp(0, __builtin_bit_cast(int, v), 0x122, 0xf, 0xf, false)); }
struct EpiAct {
    static constexpr bool PERM = true;
    bf16_t* H; const float* scf; float* ocf; float* sbg; float* sbu; float* sbl; const float* cfw; const float* ss;
    __device__ __forceinline__ void operator()(f32x4 (&acc)[2][2][4][2], const Unit& u, int wr, int wc, int fr, int fq, LAS unsigned char* lds) const {
        asm volatile("" : "+s"(wr), "+s"(wc));
        int lane; asm volatile("v_mbcnt_lo_u32_b32 %0, -1, 0\n\tv_mbcnt_hi_u32_b32 %0, -1, %0" : "=v"(lane));
        fr = lane & 15; fq = lane >> 4;
        const int fl = wc * 32 + 8 * fq, f0 = u.pn * 128 + fl; int rowt = wr * 64 + fr;
        {
            float rst[2][4];
            f32x4 rsl[2][4];
#pragma unroll
            for (int ai = 0; ai < 2; ++ai)
#pragma unroll
                for (int m = 0; m < 4; ++m) rsl[ai][m] = *(const f32x4*)(ss + (size_t)(u.pm * BM + ai * HALF + rowt + m * 16) * 4);
#pragma unroll
            for (int ai = 0; ai < 2; ++ai)
#pragma unroll
                for (int m = 0; m < 4; ++m) { rst[ai][m] = ss_rstd(rsl[ai][m]); }
#pragma unroll
            for (int ai = 0; ai < 2; ++ai)
#pragma unroll
                for (int m = 0; m < 4; ++m) { acc[ai][0][m][0] = acc[ai][0][m][0] * rst[ai][m]; acc[ai][0][m][1] = acc[ai][0][m][1] * rst[ai][m]; acc[ai][1][m][0] = acc[ai][1][m][0] * rst[ai][m]; acc[ai][1][m][1] = acc[ai][1][m][1] * rst[ai][m]; }
        }
        const bool smp = (u.pm == 128);
        asm volatile("" : "+v"(rowt));
        LAS float* BND = (LAS float*)(lds + LDS_EX);
        if (fr >= 14) {
#pragma unroll
            for (int ai = 0; ai < 2; ++ai)
#pragma unroll
                for (int n = 0; n < 2; ++n) *(LAS f32x4*)(BND + ((ai * 2 + wr) * 2 + (fr - 14)) * 128 + fl + 4 * n) = acc[ai][0][3][n];
            if (wr == 1) {
#pragma unroll
                for (int n = 0; n < 2; ++n) *(f32x4*)(sbl + ((size_t)u.pm * 2 + (fr - 14)) * DFF + f0 + 4 * n) = acc[1][0][3][n];
            }
        }
        asm volatile("s_waitcnt lgkmcnt(0)" ::: "memory"); __builtin_amdgcn_s_barrier(); asm volatile("" ::: "memory");
#pragma unroll
        for (int ai = 0; ai < 2; ++ai) {
            const int pg = wr == 1 ? ai * 2 : 1;
            u32x2 hp[2][4];
#pragma unroll
            for (int n = 0; n < 2; ++n) {
                const f32x4 w0 = *(const f32x4*)(cfw + f0 + 4 * n), w1 = *(const f32x4*)(cfw + DFF + f0 + 4 * n), w2 = *(const f32x4*)(cfw + 2 * DFF + f0 + 4 * n);
                f32x4 h2 = *(const LAS f32x4*)(BND + (pg * 2 + 0) * 128 + fl + 4 * n), h1 = *(const LAS f32x4*)(BND + (pg * 2 + 1) * 128 + fl + 4 * n);
                f32x4 t2 = h2, t1 = h1;
                if (smp) { const float* sp = scf + (size_t)((ai * 4 + wr * 2) * 2) * DFF + f0 + 4 * n; h2 = *(const f32x4*)sp; h1 = *(const f32x4*)(sp + DFF); t2 = *(const f32x4*)(sp + 2 * DFF); t1 = *(const f32x4*)(sp + 3 * DFF); }
#pragma unroll
                for (int jp = 0; jp < 2; ++jp) {
                    const int j0 = jp * 2, j1 = jp * 2 + 1;
                    const f32x2 w0p = {w0[j0], w0[j1]}, w1p = {w1[j0], w1[j1]}, w2p = {w2[j0], w2[j1]};
                    f32x2 r1p = {h1[j0], h1[j1]}, r2p = fr == 0 ? (f32x2){h2[j0], h2[j1]} : (f32x2){h1[j0], h1[j1]};
#pragma unroll
                    for (int m = 0; m < 4; ++m) {
                        const f32x2 g = {acc[ai][0][m][n][j0], acc[ai][0][m][n][j1]}, uu = {acc[ai][1][m][n][j0], acc[ai][1][m][n][j1]};
                        if (m == 2 && smp) { r1p = (f32x2){t1[j0], t1[j1]}; r2p = fr == 0 ? (f32x2){t2[j0], t2[j1]} : (f32x2){t1[j0], t1[j1]}; }
                        const f32x2 r1 = {dpp_ror1(g.x), dpp_ror1(g.y)}, r2 = {dpp_ror2(g.x), dpp_ror2(g.y)};
                        const f32x2 gm1 = fr >= 1 ? r1 : r1p, gm2 = fr >= 2 ? r2 : r2p;
                        r1p = r1; r2p = r2;
                        const f32x2 cv = w0p * gm2 + w1p * gm1 + w2p * g;
                        const f32x2 ex = cv * (-1.4426950408889634f);
                        f32x2 den; den.x = __builtin_amdgcn_exp2f(ex.x); den.y = __builtin_amdgcn_exp2f(ex.y); den = den + 1.0f;
                        f32x2 rc; rc.x = __builtin_amdgcn_rcpf(den.x); rc.y = __builtin_amdgcn_rcpf(den.y);
                        const f32x2 hv = (cv * rc) * uu;
                        const unsigned pk = cvt_pk_bf16(hv.x, hv.y); if (jp == 0) hp[n][m].x = pk; else hp[n][m].y = pk;
                    }
                }
            }
#pragma unroll
            for (int m = 0; m < 4; ++m) {
                const int rl = ai * HALF + rowt + m * 16;
                if (smp && (m & 1) && fr >= 14) {
#pragma unroll
                    for (int n = 0; n < 2; ++n) *(f32x4*)(ocf + ((size_t)(ai * 4 + wr * 2 + (m >> 1)) * 2 + (fr - 14)) * DFF + f0 + 4 * n) = acc[ai][0][m][n];
                }
                if (!smp && ai == 0 && m == 0 && wr == 0 && fr < 2) {
#pragma unroll
                    for (int n = 0; n < 2; ++n) { *(f32x4*)(sbg + ((size_t)u.pm * 2 + fr) * DFF + f0 + 4 * n) = acc[0][0][0][n]; *(f32x4*)(sbu + ((size_t)u.pm * 2 + fr) * DFF + f0 + 4 * n) = acc[0][1][0][n]; }
                } else {
                    u32x4 w; w.x = hp[0][m].x; w.y = hp[0][m].y; w.z = hp[1][m].x; w.w = hp[1][m].y;
                    *(u32x4*)(H + (size_t)(u.pm * BM + rl) * DFF + f0) = w;
                }
            }
        }
    }
};

template <class Epi, class Sched, bool ALIGN_EPI>
__device__ __forceinline__ void gemm_phase(LAS unsigned char* lds, const Gemm g, const Sched& S, const Epi& E, const int wave_s) {
    const int tid = opaque_tid(wave_s), wid = __builtin_amdgcn_readfirstlane(tid >> 6), lane = tid & 63, wr = wid >> 2, wc = wid & 3, fr = lane & 15, fq = lane >> 4;
    const int nt = g.K / BK;
    unsigned voffA[2], voffB[2];
#pragma unroll
    for (int i = 0; i < 2; ++i) { int R, C; stage_rc(tid * 16 + i * 8192, R, C); const int Rb = Epi::PERM ? ((R & ~31) + perm32(R & 31)) : R;
        voffA[i] = (unsigned)(R * g.lda + C) * 2u; voffB[i] = (unsigned)(Rb * g.ldb + C) * 2u; }
    const size_t kstep = (size_t)(BK * 2);
    const size_t hstepA = (size_t)HALF * g.lda * 2, hstepB = (size_t)HALF * g.ldb * 2;
    const unsigned ldsw = (unsigned)wid * 1024u;
    const int aoff = lds_byte(wr * 64 + fr, fq * 8), boff = lds_byte(wc * 32 + fr, fq * 8);
#define PG8_SA(b, h) (((b) * 2 + (h)) * HTB)
#define PG8_SB(b, h) ((4 + (b) * 2 + (h)) * HTB)
#define PG8_STAGE(bufoff, gbase, voff) do { _Pragma("unroll") for (int _i = 0; _i < 2; ++_i) \
        __builtin_amdgcn_global_load_lds((const unsigned*)((const char*)(gbase) + (voff)[_i]), (LAS unsigned*)(lds + (bufoff) + ldsw + _i * 8192), 16, 0, 0); } while (0)
#define PG8_LDA(dst, b, h) do { _Pragma("unroll") for (int m = 0; m < 4; ++m) _Pragma("unroll") for (int k = 0; k < 2; ++k) dst[m][k] = *(const LAS bf16x8*)(lds + PG8_SA(b, h) + aoff + m * 2048 + k * 1024); } while (0)
#define PG8_LDB(dst, b, h) do { _Pragma("unroll") for (int n = 0; n < 2; ++n) _Pragma("unroll") for (int k = 0; k < 2; ++k) dst[n][k] = *(const LAS bf16x8*)(lds + PG8_SB(b, h) + boff + n * 2048 + k * 1024); } while (0)
#define PG8_MMA(ai, bj, At, Bt) do { __builtin_amdgcn_s_setprio(1); _Pragma("unroll") for (int m = 0; m < 4; ++m) _Pragma("unroll") for (int n = 0; n < 2; ++n) _Pragma("unroll") for (int k = 0; k < 2; ++k) \
        acc[ai][bj][m][n] = __builtin_amdgcn_mfma_f32_16x16x32_bf16(Bt[n][k], At[m][k], acc[ai][bj][m][n], 0, 0, 0); __builtin_amdgcn_s_setprio(0); } while (0)
#define PG8_WAIT_V(n) asm volatile("s_waitcnt vmcnt(" #n ")" ::: "memory")
#define PG8_WAIT_L(n) asm volatile("s_waitcnt lgkmcnt(" #n ")" ::: "memory")
#define PG8_BAR __builtin_amdgcn_s_barrier()
#define PG8_SCHED __builtin_amdgcn_sched_barrier(0)
    Unit cur, nxt; int ui = 0;
    if (!S.next(0, cur)) return;
    f32x4 acc[2][2][4][2];
#pragma unroll
    for (int a = 0; a < 2; ++a)
#pragma unroll
        for (int b = 0; b < 2; ++b)
#pragma unroll
            for (int m = 0; m < 4; ++m)
#pragma unroll
                for (int n = 0; n < 2; ++n) acc[a][b][m][n] = (f32x4){0.f, 0.f, 0.f, 0.f};
    bf16x8 At[4][2], B0[2][2], B1[2][2];
    const char* cA = (const char*)g.A + S.offA(cur); const char* cB = (const char*)g.Bt + S.offB(cur);
    PG8_STAGE(PG8_SB(0, 0), cB, voffB); PG8_STAGE(PG8_SB(0, 1), cB + hstepB, voffB); PG8_STAGE(PG8_SA(0, 0), cA, voffA); PG8_STAGE(PG8_SA(0, 1), cA + hstepA, voffA);
    if (wr == 1) PG8_BAR;
    PG8_WAIT_V(2); PG8_BAR;
    PG8_STAGE(PG8_SB(1, 0), cB + kstep, voffB); PG8_STAGE(PG8_SA(1, 0), cA + kstep, voffA); PG8_STAGE(PG8_SB(1, 1), cB + hstepB + kstep, voffB);
    PG8_WAIT_V(6); PG8_BAR;
    for (;;) {
        const bool has_next = S.next(ui + 1, nxt);
        const char* nA = has_next ? (const char*)g.A + S.offA(nxt) : cA; const char* nB = has_next ? (const char*)g.Bt + S.offB(nxt) : cB;
        for (int t = 0; t < nt; t += 2) {
            const bool last = (t == nt - 2);
            const char* a1 = cA + (size_t)(t + 1) * kstep;
            const char* a2 = last ? nA : cA + (size_t)(t + 2) * kstep; const char* b2 = last ? nB : cB + (size_t)(t + 2) * kstep;
            const char* a3 = a2 + kstep; const char* b3 = b2 + kstep;
            PG8_LDB(B0, 0, 0); PG8_LDB(B1, 0, 1); PG8_SCHED; PG8_LDA(At, 0, 0); PG8_STAGE(PG8_SA(1, 1), a1 + hstepA, voffA);
            PG8_WAIT_V(8); PG8_WAIT_L(0); PG8_BAR; PG8_MMA(0, 0, At, B0); PG8_MMA(0, 1, At, B1); PG8_BAR; PG8_SCHED;
            PG8_LDA(At, 0, 1); PG8_STAGE(PG8_SB(0, 0), b2, voffB); PG8_STAGE(PG8_SB(0, 1), b2 + hstepB, voffB); PG8_STAGE(PG8_SA(0, 0), a2, voffA);
            PG8_WAIT_V(8); PG8_WAIT_L(0); PG8_BAR; PG8_MMA(1, 0, At, B0); PG8_MMA(1, 1, At, B1); PG8_BAR; PG8_SCHED;
            PG8_LDB(B0, 1, 0); PG8_LDB(B1, 1, 1); PG8_SCHED; PG8_LDA(At, 1, 0); PG8_STAGE(PG8_SA(0, 1), a2 + hstepA, voffA);
            PG8_WAIT_V(8); PG8_WAIT_L(0); PG8_BAR; PG8_MMA(0, 0, At, B0); PG8_MMA(0, 1, At, B1); PG8_BAR; PG8_SCHED;
            PG8_LDA(At, 1, 1); PG8_STAGE(PG8_SB(1, 0), b3, voffB); PG8_STAGE(PG8_SB(1, 1), b3 + hstepB, voffB); PG8_STAGE(PG8_SA(1, 0), a3, voffA);
            PG8_WAIT_V(8); PG8_WAIT_L(0); PG8_BAR; PG8_MMA(1, 0, At, B0); PG8_MMA(1, 1, At, B1); PG8_BAR; PG8_SCHED;
        }
        if constexpr (ALIGN_EPI) { if (wr == 0) PG8_BAR; }
        E(acc, cur, wr, wc, fr, fq, lds);
        if (!has_next) break;
#pragma unroll
        for (int a = 0; a < 2; ++a)
#pragma unroll
            for (int b = 0; b < 2; ++b)
#pragma unroll
                for (int m = 0; m < 4; ++m)
#pragma unroll
                    for (int n = 0; n < 2; ++n) acc[a][b][m][n] = (f32x4){0.f, 0.f, 0.f, 0.f};
        cur = nxt; cA = nA; cB = nB; ++ui;
        if constexpr (ALIGN_EPI) { if (wr == 1) PG8_BAR; }
    }
    PG8_WAIT_V(0);
    if constexpr (!ALIGN_EPI) { if (wr == 0) PG8_BAR; }
    PG8_BAR;
#undef PG8_SA
#undef PG8_SB
#undef PG8_STAGE
#undef PG8_LDA
#undef PG8_LDB
#undef PG8_MMA
#undef PG8_WAIT_V
#undef PG8_WAIT_L
#undef PG8_BAR
#undef PG8_SCHED
}
}

struct KVSched {
    int c, G; const char* ws; size_t wsel;
    __device__ __forceinline__ bool next(int i, pg8::Unit& u) const {
        const int L = i * G + c; if (c < 0 || L >= 96) return false;
        const int kind = L >> 5, r = L & 31;
        if (kind < 2) { u.pm = kind * 16 + (r >> 2); u.pn = r & 3; } else { u.pm = 32 + (r >> 3); u.pn = r & 7; }
        return true;
    }
    __device__ __forceinline__ size_t offA(const pg8::Unit& u) const { const int kind = u.pm >> 4, pm = u.pm & 15; int k2 = (kind == 2); asm volatile("" : "+v"(k2));
        return (size_t)ws + WS_MEMB + (size_t)k2 * (WS_WV + wsel - WS_MEMB) + (size_t)pm * 256 * 1024 * 2; }
    __device__ __forceinline__ size_t offB(const pg8::Unit& u) const { const int kind = u.pm >> 4; int k1 = (kind == 1), k2 = (kind == 2); asm volatile("" : "+v"(k1), "+v"(k2));
        return (size_t)ws + WS_WK + wsel + (size_t)k1 * (WS_WV - WS_WK) + (size_t)k2 * (WS_MEMB - WS_WK - wsel) + (size_t)u.pn * 256 * 1024 * 2; }
};


#define XB_TMO      128
#define XB_XCNT(j)  (256  + 64 * (j))
#define XB_XSUB(j)  (1280 + 64 * (j))
#define XB_XGEN(j)  (2304 + 64 * (j))
#define XB_TOP      3328
#define XB_TOPGEN   3392
#define XCD_BAR_WORDS 3456
#define XB_SPIN_CAP (1u << 22)
__device__ __forceinline__ unsigned xb_ld(unsigned* p)              { return __hip_atomic_load(p, __ATOMIC_RELAXED, __HIP_MEMORY_SCOPE_AGENT); }
__device__ __forceinline__ unsigned xb_add(unsigned* p, unsigned v) { return __hip_atomic_fetch_add(p, v, __ATOMIC_RELAXED, __HIP_MEMORY_SCOPE_AGENT); }
__device__ __forceinline__ unsigned xb_xcc_id() { return (unsigned)__builtin_amdgcn_s_getreg((3 << 11) | 20) & 0xFu; }
#define XB_SPIN(cond, bar) do { unsigned _sp = 0; while (cond) { __builtin_amdgcn_s_sleep(1); \
    if ((++_sp & 255u) == 0u) { if (xb_ld(&(bar)[XB_TMO])) break; if (_sp > XB_SPIN_CAP) { atomicAdd(&(bar)[XB_TMO], 1u); break; } } } } while (0)
struct XcdBarrier { unsigned* bar; unsigned x; volatile LAS unsigned* st; };
__device__ __forceinline__ void xcd_barrier_complete(unsigned* bar, unsigned x, unsigned& nloc, unsigned& nx) {
    const unsigned G = gridDim.x * gridDim.y * gridDim.z;
    unsigned sum, cnt, mine, sp = 0u;
    for (;;) {
        sum = 0u; cnt = 0u; mine = 0u;
#pragma unroll
        for (unsigned j = 0; j < 16; ++j) { const unsigned c = xb_ld(&bar[XB_XCNT(j)]); sum += c; cnt += (c > 0u) ? 1u : 0u; mine = (j == x) ? c : mine; }
        if (sum == G) break;
        __builtin_amdgcn_s_sleep(1);
        if ((++sp & 255u) == 0u) { if (xb_ld(&bar[XB_TMO])) break; if (sp > XB_SPIN_CAP) { atomicAdd(&bar[XB_TMO], 1u); break; } }
    }
    nloc = mine > 0u ? mine : 1u; nx = cnt > 0u ? cnt : 1u;
}
__device__ __forceinline__ void xcd_barrier(const XcdBarrier& b) {
    asm volatile("s_waitcnt vmcnt(0)" ::: "memory");
    __syncthreads();
    if (threadIdx.x == 0) {
        unsigned* bar = b.bar;
        __builtin_amdgcn_s_waitcnt(0);
        unsigned nloc = b.st[0], nx = b.st[1];
        if (nloc == 0u) { xcd_barrier_complete(bar, b.x, nloc, nx); b.st[0] = nloc; b.st[1] = nx; }
        const unsigned old = xb_add(&bar[XB_XSUB(b.x)], 1u);
        const unsigned gen = old / nloc;
        if (old + 1u == (gen + 1u) * nloc) {
            __builtin_amdgcn_fence(__ATOMIC_RELEASE, "agent");
            asm volatile("s_waitcnt vmcnt(0)" ::: "memory");
            const unsigned og = xb_add(&bar[XB_TOP], 1u);
            const unsigned tg = og / nx;
            if (og + 1u == (tg + 1u) * nx) xb_add(&bar[XB_TOPGEN], 1u);
            else XB_SPIN(xb_ld(&bar[XB_TOPGEN]) == tg, bar);
            __builtin_amdgcn_fence(__ATOMIC_ACQUIRE, "agent");
            xb_add(&bar[XB_XGEN(b.x)], 1u);
            asm volatile("s_waitcnt vmcnt(0)" ::: "memory");
        } else {
            XB_SPIN(xb_ld(&bar[XB_XGEN(b.x)]) == gen, bar);
            __builtin_amdgcn_fence(__ATOMIC_ACQUIRE, "agent");
            asm volatile("s_waitcnt vmcnt(0)" ::: "memory");
        }
    }
    __syncthreads();
}


struct SG2 { const bf16_t* A; const bf16_t* Bt; int lda, ldb, K, N; bf16_t* O; int ldc; float scale; int mode; float* ssp; };
__device__ __forceinline__ float sq8(bf16x8 a) { float q = 0.f;
#pragma unroll
    for (int i = 0; i < 8; ++i) { const float f = bf2f((unsigned)(unsigned short)a[i]); q += f * f; } return q; }
__device__ __forceinline__ void sgemm2(LAS unsigned char* lds, const SG2 g, int ubase, int G, int wave, int tid) {
    const int lane = tid & 63, fr = lane & 15, fq = lane >> 4, rt = wave & 3, ch = wave >> 2;
    const int nunits = (g.N / 64) * 4, nsl = g.K / 64;
    int R, C; pg8::stage_rc(tid * 16, R, C);
    const unsigned offA = (unsigned)(R * g.lda + C) * 2u, offB = (unsigned)(R * g.ldb + C) * 2u;
    const int aoff = pg8::lds_byte(rt * 16 + fr, fq * 8), boff = pg8::lds_byte(ch * 32 + fr, fq * 8);
    for (int un = ubase; un >= 0 && un < nunits; un += G) {
        const int cgp = un >> 2, rg = un & 3;
        const char* gA = (const char*)(g.A + (size_t)rg * 64 * g.lda) + offA; const char* gB = (const char*)(g.Bt + (size_t)cgp * 64 * g.ldb) + offB;
#define SG2_STAGE(sl) do { LAS unsigned char* d_ = lds + ((sl) & 3) * 16384 + wave * 1024; \
        __builtin_amdgcn_global_load_lds((const unsigned*)(gA + (size_t)(sl) * 128), (LAS unsigned*)d_, 16, 0, 0); \
        __builtin_amdgcn_global_load_lds((const unsigned*)(gB + (size_t)(sl) * 128), (LAS unsigned*)(d_ + 8192), 16, 0, 0); } while (0)
        asm volatile("s_waitcnt vmcnt(0)" ::: "memory");
        SG2_STAGE(0); SG2_STAGE(1);
        f32x4 acc[2] = {(f32x4){0.f, 0.f, 0.f, 0.f}, (f32x4){0.f, 0.f, 0.f, 0.f}}; float q = 0.f;
        for (int sl = 0; sl < nsl; ++sl) {
            if (sl + 1 < nsl) asm volatile("s_waitcnt vmcnt(2)" ::: "memory"); else asm volatile("s_waitcnt vmcnt(0)" ::: "memory");
            __builtin_amdgcn_s_barrier(); asm volatile("" ::: "memory");
            if (sl + 2 < nsl) SG2_STAGE(sl + 2);
            LAS unsigned char* b_ = lds + (sl & 3) * 16384;
#pragma unroll
            for (int ks = 0; ks < 2; ++ks) {
                const bf16x8 a = *(const LAS bf16x8*)(b_ + aoff + ks * 1024);
#pragma unroll
                for (int c = 0; c < 2; ++c) { const bf16x8 b = *(const LAS bf16x8*)(b_ + 8192 + boff + c * 2048 + ks * 1024);
                    acc[c] = __builtin_amdgcn_mfma_f32_16x16x32_bf16(b, a, acc[c], 0, 0, 0); }
                if (g.mode == 1) q += sq8(a);
            }
        }
#undef SG2_STAGE
        const int row = rg * 64 + rt * 16 + fr, col = cgp * 64 + ch * 32 + fq * 4;
        bf16_t* op = g.O + (size_t)row * g.ldc + col;
        if (g.mode == 1) {
            q += shx(q, 16, lane); q += shx(q, 32, lane);
            const float sc = g.scale / sqrtf(q * (1.f / 1024.f) + EPS);
#pragma unroll
            for (int c = 0; c < 2; ++c) { const f32x4 v = acc[c] * sc; u32x2 w; w.x = cvt_pk_bf16(v[0], v[1]); w.y = cvt_pk_bf16(v[2], v[3]); *(u32x2*)(op + c * 16) = w; }
        } else {
            const u32x2 p0 = *(const u32x2*)op, p1 = *(const u32x2*)(op + 16); float qq = 0.f;
            { const float v0 = bflo(p0.x) + acc[0][0], v1 = bfhi(p0.x) + acc[0][1], v2 = bflo(p0.y) + acc[0][2], v3 = bfhi(p0.y) + acc[0][3];
              u32x2 w; w.x = cvt_pk_bf16(v0, v1); w.y = cvt_pk_bf16(v2, v3); *(u32x2*)op = w; qq += (v0 * v0 + v1 * v1) + (v2 * v2 + v3 * v3); }
            { const float v0 = bflo(p1.x) + acc[1][0], v1 = bfhi(p1.x) + acc[1][1], v2 = bflo(p1.y) + acc[1][2], v3 = bfhi(p1.y) + acc[1][3];
              u32x2 w; w.x = cvt_pk_bf16(v0, v1); w.y = cvt_pk_bf16(v2, v3); *(u32x2*)(op + 16) = w; qq += (v0 * v0 + v1 * v1) + (v2 * v2 + v3 * v3); }
            qq += shx(qq, 16, lane); qq += shx(qq, 32, lane);
            if (fq == 0) g.ssp[row * 32 + cgp * 2 + ch] = qq;
        }
        asm volatile("s_waitcnt vmcnt(0) lgkmcnt(0)" ::: "memory"); __builtin_amdgcn_s_barrier(); asm volatile("" ::: "memory");
    }
}

__device__ __forceinline__ void sgemm_act(LAS unsigned char* lds, const bf16_t* A, const bf16_t* Bt, bf16_t* Hs, const float* cfw, const float* scf, float* ocf, int ubase, int G, int wave, int tid) {
    const int lane = tid & 63, fr = lane & 15, fq = lane >> 4, rt = wave & 3, ch = wave >> 2;
    constexpr int nunits = (DFF / 64) * 4, nsl = D / 64, SLOT = 24576;
    int R, C; pg8::stage_rc(tid * 16, R, C);
    const unsigned off = (unsigned)(R * D + C) * 2u;
    const int aoff = pg8::lds_byte(rt * 16 + fr, fq * 8), boff = pg8::lds_byte(fr, fq * 8) + 8192 + ch * 8192;
    for (int un = ubase; un >= 0 && un < nunits; un += G) {
        const int fg = un >> 2, rg = un & 3, brow = ((fg >> 1) << 8) + ((fg & 1) << 6);
        const char* gA = (const char*)(A + (size_t)rg * 64 * D) + off; const char* gG = (const char*)(Bt + (size_t)brow * D) + off; const char* gU = (const char*)(Bt + (size_t)(brow + 128) * D) + off;
#define SGA_STAGE(sl) do { LAS unsigned char* d_ = lds + ((sl) & 3) * SLOT + wave * 1024; \
        __builtin_amdgcn_global_load_lds((const unsigned*)(gA + (size_t)(sl) * 128), (LAS unsigned*)d_, 16, 0, 0); \
        __builtin_amdgcn_global_load_lds((const unsigned*)(gG + (size_t)(sl) * 128), (LAS unsigned*)(d_ + 8192), 16, 0, 0); \
        __builtin_amdgcn_global_load_lds((const unsigned*)(gU + (size_t)(sl) * 128), (LAS unsigned*)(d_ + 16384), 16, 0, 0); } while (0)
        asm volatile("s_waitcnt vmcnt(0)" ::: "memory");
        SGA_STAGE(0); SGA_STAGE(1);
        f32x4 acc[4]; float q = 0.f;
#pragma unroll
        for (int c = 0; c < 4; ++c) acc[c] = (f32x4){0.f, 0.f, 0.f, 0.f};
        for (int sl = 0; sl < nsl; ++sl) {
            if (sl + 1 < nsl) asm volatile("s_waitcnt vmcnt(3)" ::: "memory"); else asm volatile("s_waitcnt vmcnt(0)" ::: "memory");
            __builtin_amdgcn_s_barrier(); asm volatile("" ::: "memory");
            if (sl + 2 < nsl) SGA_STAGE(sl + 2);
            LAS unsigned char* b_ = lds + (sl & 3) * SLOT;
#pragma unroll
            for (int ks = 0; ks < 2; ++ks) {
                const bf16x8 a = *(const LAS bf16x8*)(b_ + aoff + ks * 1024);
#pragma unroll
                for (int c = 0; c < 4; ++c) { const bf16x8 b = *(const LAS bf16x8*)(b_ + boff + c * 2048 + ks * 1024);
                    acc[c] = __builtin_amdgcn_mfma_f32_16x16x32_bf16(b, a, acc[c], 0, 0, 0); }
                q += sq8(a);
            }
        }
#undef SGA_STAGE
        q += shx(q, 16, lane); q += shx(q, 32, lane);
        const float rstd = 1.0f / sqrtf(q * (1.f / 1024.f) + EPS);
        asm volatile("s_waitcnt lgkmcnt(0)" ::: "memory"); __builtin_amdgcn_s_barrier(); asm volatile("" ::: "memory");
        LAS float* T = (LAS float*)(lds + ch * 20480);
#pragma unroll
        for (int c = 0; c < 4; ++c)
#pragma unroll
            for (int j = 0; j < 4; ++j) T[(rt * 16 + fr) * 65 + c * 16 + fq * 4 + j] = acc[c][j] * rstd;
        asm volatile("s_waitcnt lgkmcnt(0)" ::: "memory"); __builtin_amdgcn_s_barrier(); asm volatile("" ::: "memory");
        {
            const LAS float* Gt = (const LAS float*)lds; const LAS float* Ut = (const LAS float*)(lds + 20480);
            const int r = tid >> 3, f8 = (tid & 7) * 8, b = rg * 2 + (r >> 5), rr = r & 31, f = fg * 64 + f8;
            const float* st = scf + (size_t)(b * 2) * DFF + f;
            float hv[8], gv[8];
#pragma unroll
            for (int k = 0; k < 8; ++k) {
                const float g0 = Gt[r * 65 + f8 + k];
                const float gm1 = rr >= 1 ? Gt[(r - 1) * 65 + f8 + k] : st[DFF + k];
                const float gm2 = rr >= 2 ? Gt[(r - 2) * 65 + f8 + k] : (rr == 1 ? st[DFF + k] : st[k]);
                const float cv = cfw[f + k] * gm2 + cfw[DFF + f + k] * gm1 + cfw[2 * DFF + f + k] * g0;
                hv[k] = silu(cv) * Ut[r * 65 + f8 + k]; gv[k] = g0;
            }
            u32x4 w; w.x = pk2(hv[0], hv[1]); w.y = pk2(hv[2], hv[3]); w.z = pk2(hv[4], hv[5]); w.w = pk2(hv[6], hv[7]);
            *(u32x4*)(Hs + (size_t)(rg * 64 + r) * DFF + f) = w;
            if (rr >= 30) { float* o = ocf + ((size_t)b * 2 + (rr - 30)) * DFF + f; *(f32x4*)o = (f32x4){gv[0], gv[1], gv[2], gv[3]}; *(f32x4*)(o + 4) = (f32x4){gv[4], gv[5], gv[6], gv[7]}; }
        }
        asm volatile("s_waitcnt vmcnt(0) lgkmcnt(0)" ::: "memory"); __builtin_amdgcn_s_barrier(); asm volatile("" ::: "memory");
    }
}
__device__ __forceinline__ void sample_ss_reduce(const float* sss, float* ssq, int tid) {
    if (tid < 256) { const f32x4* p = (const f32x4*)(sss + tid * 32); float t = 0.f;
#pragma unroll
        for (int i = 0; i < 8; ++i) { const f32x4 v = p[i]; t += (v[0] + v[1]) + (v[2] + v[3]); }
        *(f32x4*)(ssq + (size_t)(MP + tid) * 4) = (f32x4){t, 0.f, 0.f, 0.f}; }
    asm volatile("s_waitcnt vmcnt(0)" ::: "memory"); __syncthreads();
}

__device__ __forceinline__ void transpose_item(const float* W, int K, int N, bf16_t* WT, LAS float* scr, int item, int lane, const float* gain = nullptr, int gu = 0) {
    const int nblk = N / 32, kb = item / nblk, nb = item % nblk, k0 = 64 * kb, n0 = 32 * nb;
    {
        f32x4 v[8];
#pragma unroll
        for (int i = 0; i < 8; ++i) v[i] = *(const f32x4*)(W + (size_t)(k0 + (lane >> 3) + 8 * i) * N + n0 + (lane & 7) * 4);
#pragma unroll
        for (int i = 0; i < 8; ++i) { const int kk = (lane >> 3) + 8 * i; f32x4 w = v[i]; if (gain) w = w * gain[k0 + kk];
            LAS float* d = scr + kk * 33 + (lane & 7) * 4; d[0] = w[0]; d[1] = w[1]; d[2] = w[2]; d[3] = w[3]; }
    }
    LDS_WAIT();
    const int c = lane & 7;
#pragma unroll
    for (int j = 0; j < 4; ++j) { const int n = (lane >> 3) + 8 * j; const LAS float* s = scr + (8 * c) * 33 + n;
        u32x4 o; o.x = pk2(s[0 * 33], s[1 * 33]); o.y = pk2(s[2 * 33], s[3 * 33]); o.z = pk2(s[4 * 33], s[5 * 33]); o.w = pk2(s[6 * 33], s[7 * 33]);
        int drow = n0 + n; if (gu) { const int up = drow >= gu, f = up ? drow - gu : drow; drow = ((f >> 7) << 8) + (up << 7) + (f & 127); }
        *(u32x4*)(WT + (size_t)drow * K + k0 + 8 * c) = o; }
    LDS_WAIT();
}

__device__ __forceinline__ void first_rows(const float* Xp, const float* Xs, bf16_t* XNo, float* ss, int gw, int NGW, int lane) {
    for (int m0 = gw; m0 < MT; m0 += 2 * NGW) {
        const int m1 = m0 + NGW; const bool two = m1 < MT; const int mb = two ? m1 : m0;
        const f32x4* xa = (const f32x4*)(m0 < MP ? Xp + (size_t)m0 * D : Xs + (size_t)(m0 - MP) * D) + lane;
        const f32x4* xb = (const f32x4*)(mb < MP ? Xp + (size_t)mb * D : Xs + (size_t)(mb - MP) * D) + lane;
        f32x4 va[4], vb[4]; float sa = 0.f, sb = 0.f;
#pragma unroll
        for (int j = 0; j < 4; ++j) { va[j] = __builtin_nontemporal_load(xa + 64 * j); vb[j] = __builtin_nontemporal_load(xb + 64 * j); }
#pragma unroll
        for (int j = 0; j < 4; ++j) { sa += (va[j].x * va[j].x + va[j].y * va[j].y) + (va[j].z * va[j].z + va[j].w * va[j].w); sb += (vb[j].x * vb[j].x + vb[j].y * vb[j].y) + (vb[j].z * vb[j].z + vb[j].w * vb[j].w); }
        sa = wave_sum(sa, lane); sb = wave_sum(sb, lane);
        if (lane < 4) { ss[(size_t)m0 * 4 + lane] = lane == 0 ? sa : 0.f; if (two) ss[(size_t)m1 * 4 + lane] = lane == 0 ? sb : 0.f; }
        u32x2* oa = (u32x2*)(XNo + (size_t)m0 * D) + lane; u32x2* ob = (u32x2*)(XNo + (size_t)mb * D) + lane;
#pragma unroll
        for (int j = 0; j < 4; ++j) { u32x2 w; w.x = pk2(va[j].x, va[j].y); w.y = pk2(va[j].z, va[j].w); oa[64 * j] = w; if (two) { w.x = pk2(vb[j].x, vb[j].y); w.y = pk2(vb[j].z, vb[j].w); ob[64 * j] = w; } }
    }
}

typedef __attribute__((address_space(4))) const unsigned char* kptr_t;
typedef const float* cfp_t; typedef float* fp_t; typedef unsigned char* ucp_t;
#define INP(k) (*(const __attribute__((address_space(4))) cfp_t*)(kp + 8 * (k)))
#define X out
#define WIN_T ((bf16_t*)(ws + WS_WIN + wsel))
#define WOUT_T ((bf16_t*)(ws + WS_WOUT + wsel))
#define WQ_T ((bf16_t*)(ws + WS_WQ + wsel))
#define WK_T ((bf16_t*)(ws + WS_WK + wsel))
#define WV_T ((bf16_t*)(ws + WS_WV + wsel))
#define WO_T ((bf16_t*)(ws + WS_WO + wsel))
#define WUP_T ((bf16_t*)(ws + WS_WUP + wsel))
#define WDN_T ((bf16_t*)(ws + WS_WDN + wsel))
#define MEMB ((bf16_t*)(ws + WS_MEMB))
#define KBP ((bf16_t*)(ws + WS_KBP))
#define VTP ((bf16_t*)(ws + WS_VTP))
#define KBS ((bf16_t*)(ws + WS_KBS + ksel))
#define VTS ((bf16_t*)(ws + WS_VTS + ksel))
#define WST ((bf16_t*)(ws + WS_WST + ksel))
#define AGG ((float*)(ws + WS_AGG))
#define SSQ(i) ((float*)(ws + WS_SSP) + (size_t)(i) * MT * 4)
#define SSS(i) ((float*)(ws + WS_SSS) + (size_t)(i) * 256 * 32)
#define GT_R ((bf16_t*)(ws + WS_GT + ksel))
#define GT_I ((bf16_t*)(ws + WS_GT + 65536 + ksel))
#define XN ((bf16_t*)(ws + WS_XN))
#define gZ ((bf16_t*)(ws + B_Z))
#define HLOC ((bf16_t*)(ws + B_HLOC))
#define PCUM ((bf16_t*)(ws + B_PCUM))
#define gY ((bf16_t*)(ws + B_Y))
#define gQ ((bf16_t*)(ws + B_Q))
#define gP ((bf16_t*)(ws + B_P))
#define gO ((bf16_t*)(ws + B_O))
#define PS ((bf16_t*)(ws + B_PS))
#define GU ((bf16_t*)(ws + B_GU))
#define GUS ((bf16_t*)(ws + B_GUS))
#define SBG ((float*)(ws + B_SBG))
#define SBU ((float*)(ws + B_SBU))
#define SBL ((float*)(ws + B_SBL))
__device__ __forceinline__ void convert_layer(kptr_t kp, unsigned char* ws, LAS unsigned char* lds, const int l, const int part, const int nparts, const int gw, const int NGW, const int gt, const int NGT, const int lane, const int wave) {
            const size_t wsel = (size_t)(l & 1) * WSEL1, ksel = (size_t)(l & 1) * KSEL1;
            LAS float* scr = (LAS float*)(lds + wave * 16384);
            const float* w_in = INP(I_WIN) + (size_t)l * D * INC; const float* w_out = INP(I_WOUT) + (size_t)l * D * D; const float* w_q = INP(I_WQ) + (size_t)l * D * D;
            const float* w_k = INP(I_WK) + (size_t)l * D * D; const float* w_v = INP(I_WV) + (size_t)l * D * D; const float* w_o = INP(I_WO) + (size_t)l * D * D;
            const float* w_up = INP(I_WUP) + (size_t)l * D * 2 * DFF; const float* w_dn = INP(I_WDN) + (size_t)l * DFF * D; const float* c_v = INP(I_CV) + (size_t)l * BS * NMEM * D;
            constexpr int T_IN = 16 * (INC / 32), T_SQ = 16 * 32, T_UP = 16 * (2 * DFF / 32), T_DN = (DFF / 64) * 32, T_CV = 32 * 32;
            constexpr int T_G = 16;
            constexpr int NIT = T_IN + 5 * T_SQ + T_UP + T_DN + T_CV + 2 * T_G;
            for (int it = (NIT * part) / nparts + gw; it < (NIT * (part + 1)) / nparts; it += NGW) {
                int r = it;
                if (r < T_IN) { transpose_item(w_in, D, INC, WIN_T, scr, r, lane, INP(I_GMIX) + l * D); continue; } r -= T_IN;
                if (r < T_SQ) { transpose_item(w_out, D, D, WOUT_T, scr, r, lane); continue; } r -= T_SQ;
                if (r < T_SQ) { transpose_item(w_q, D, D, WQ_T, scr, r, lane, INP(I_GX) + l * D); continue; } r -= T_SQ;
                if (r < T_SQ) { transpose_item(w_k, D, D, WK_T, scr, r, lane); continue; } r -= T_SQ;
                if (r < T_SQ) { transpose_item(w_v, D, D, WV_T, scr, r, lane); continue; } r -= T_SQ;
                if (r < T_SQ) { transpose_item(w_o, D, D, WO_T, scr, r, lane); continue; } r -= T_SQ;
                if (r < T_UP) { transpose_item(w_up, D, 2 * DFF, WUP_T, scr, r, lane, INP(I_GFFN) + l * D, DFF); continue; } r -= T_UP;
                if (r < T_DN) { transpose_item(w_dn, DFF, D, WDN_T, scr, r, lane); continue; } r -= T_DN;
                if (r < T_CV) { transpose_item(c_v, BS * NMEM, D, VTS, scr, r, lane); continue; } r -= T_CV;
                if (r < T_G) { transpose_item(INP(I_WRG) + ((size_t)l * 8 + (r >> 1)) * 4096, 64, 64, GT_R + (r >> 1) * 4096, scr, r & 1, lane); continue; } r -= T_G;
                transpose_item(INP(I_WIG) + ((size_t)l * 8 + (r >> 1)) * 4096, 64, 64, GT_I + (r >> 1) * 4096, scr, r & 1, lane);
            }
            if (part == 0) {
                const f32x4* ck = (const f32x4*)(INP(I_CK) + (size_t)l * BS * NMEM * D); u32x2* dk = (u32x2*)KBS;
                for (int i = gt; i < BS * NMEM * D / 4; i += NGT) { const f32x4 v = ck[i]; u32x2 w; w.x = pk2(v.x, v.y); w.y = pk2(v.z, v.w); dk[i] = w; }
                if (l == 0) { const f32x4* mm = (const f32x4*)INP(I_MEM); u32x2* dm = (u32x2*)MEMB;
                    for (int i = gt; i < BP * NMEM * D / 4; i += NGT) { const f32x4 v = mm[i]; u32x2 w; w.x = pk2(v.x, v.y); w.y = pk2(v.z, v.w); dm[i] = w; } }
                const float* wsl = INP(I_WS) + (size_t)l * 4 * 128 * 128;
                for (int i = gt; i < 4 * 128 * 128; i += NGT) { const int s = i & 127, t = (i >> 7) & 127; WST[i] = (bf16_t)f2bf(s <= t ? wsl[i] : 0.f); }
            }
}

__global__ void __launch_bounds__(NTHREADS, 2) trunk_fwd(Args args) {
    extern __shared__ __attribute__((aligned(16))) unsigned char lds_raw[];
    LAS unsigned char* lds = (LAS unsigned char*)lds_raw;
    cg::grid_group grid = cg::this_grid();
    const int wave_s = __builtin_amdgcn_readfirstlane(threadIdx.x >> 6);
#define LANE_STATE() int G = gridDim.x, bid = blockIdx.x; asm volatile("" : "+s"(G), "+s"(bid)); const int NGW = G * NWAVES, NGT = G * NTHREADS; (void)NGW; (void)NGT; \
    const int tid = opaque_tid(wave_s), lane = tid & 63, wave = wave_s; const int gw = bid * NWAVES + wave; const int gt = bid * NTHREADS + tid; (void)lane; (void)gw; (void)gt; \
    kptr_t kp = (kptr_t)__builtin_amdgcn_kernarg_segment_ptr(); asm volatile("" : "+s"(kp)); \
    float* const out = *(const __attribute__((address_space(4))) fp_t*)(kp + 8 * N_IN); unsigned char* const ws = *(const __attribute__((address_space(4))) ucp_t*)(kp + 8 * N_IN + 8); (void)out; (void)ws
    {
        LANE_STATE();
        if (bid == 0) for (int i = tid; i < XCD_BAR_WORDS; i += NTHREADS) __hip_atomic_store((unsigned*)(ws + WS_BAR) + i, 0u, __ATOMIC_RELAXED, __HIP_MEMORY_SCOPE_AGENT);
        if (tid < 32) ((LAS unsigned*)(lds + LDS_MISC))[tid] = 0u;
        __threadfence();
        grid.sync();
        if (tid == 0) (void)xb_add((unsigned*)(ws + WS_BAR) + XB_XCNT(xb_xcc_id()), 1u);
    }
#define GRID_SYNC() do { kptr_t kp_ = (kptr_t)__builtin_amdgcn_kernarg_segment_ptr(); asm volatile("" : "+s"(kp_)); \
        XcdBarrier b_; b_.bar = (unsigned*)(*(const __attribute__((address_space(4))) ucp_t*)(kp_ + 8 * N_IN + 8) + WS_BAR); b_.x = xb_xcc_id(); b_.st = (volatile LAS unsigned*)(lds + LDS_MISC); \
        xcd_barrier(b_); if (PROBE == 3) xcd_barrier(b_); } while (0)

    for (int l = 0; l < DEPTH; ++l) {
        const size_t wsel = (size_t)(l & 1) * WSEL1, ksel = (size_t)(l & 1) * KSEL1;
        if (l == 0)
        for (int dup0 = 0; dup0 < ((PROBE == 1 || PROBE == 5) ? 2 : 1); ++dup0) {
        {
            LANE_STATE();
            convert_layer(kp, ws, lds, l, 0, 1, gw, NGW, gt, NGT, lane, wave);
            if (l == 0) first_rows(INP(I_XP), INP(I_XS), XN, SSQ(0), gw, NGW, lane);
        }
        GRID_SYNC();
        }
        {
            LANE_STATE();
            KVSched S; S.G = G; S.c = bid >= 160 ? bid - 160 : -1; S.ws = (const char*)ws; S.wsel = wsel;
            pg8::Gemm g{(const bf16_t*)nullptr, (const bf16_t*)nullptr, D, D, D};
            pg8::EpiKV E{out + O_MKP + (size_t)l * BP * NMEM * D, out + O_MVP + (size_t)l * BP * NMEM * D, KBP, VTP};
            pg8::gemm_phase<pg8::EpiKV, KVSched, true>(lds, g, S, E, wave_s);
        }
#define GEMM_BF16(s_) do { const int s = (s_); pg8::GSched S; pg8::Gemm g; pg8::EpiBf16 E; E.scale = 1.f; E.ss = nullptr; E.smp = 0; \
        if (s == 0) { S.init(MT / 256, INC / 256, G, bid); S.aPm = (size_t)256 * D * 2; S.bPn = (size_t)256 * D * 2; g = pg8::Gemm{XN, WIN_T, D, D, D}; E.O = gZ; E.ldc = INC; E.ss = SSQ(3 * l); } \
        else if (s == 1) { S.init(MP / 256, D / 256, G, bid); S.aPm = (size_t)256 * D * 2; S.bPn = (size_t)256 * D * 2; g = pg8::Gemm{XN, WQ_T, D, D, D}; E.O = gQ; E.ldc = D; E.scale = 0.0625f; E.ss = SSQ(3 * l + 1); } \
        else if (s == 2) { S.init(MP / 256, 4, G, bid); S.aPm = (size_t)256 * D * 2; S.aPn = 512; S.bPn = (size_t)256 * 2048 * 2; S.bPm = 512; S.bShift = 4; g = pg8::Gemm{gP, VTP, D, 2048, 256}; E.O = gO; E.ldc = D; } \
        else { S.init(1, 32, G, (bid + G - 64) % G); S.mode = 2; g = pg8::Gemm{PS, VTS, 8192, 2048, 256}; E.O = gO + (size_t)MP * D; E.ldc = D; E.smp = 1; } \
        pg8::gemm_phase<pg8::EpiBf16, pg8::GSched, true>(lds, g, S, E, wave_s); } while (0)
#define GEMM_RES(s_) do { const int s = (s_); pg8::GSched S; S.init(MP / 256, D / 256, G, bid); pg8::Gemm g; \
        if (s == 0) { g = pg8::Gemm{gY, WOUT_T, D, D, D}; S.aPm = (size_t)256 * D * 2; } \
        else if (s == 1) { g = pg8::Gemm{gO, WO_T, D, D, D}; S.aPm = (size_t)256 * D * 2; } \
        else { g = pg8::Gemm{GU, WDN_T, DFF, DFF, DFF}; S.aPm = (size_t)256 * DFF * 2; } \
        S.bPn = (size_t)256 * g.ldb * 2; \
        pg8::EpiResid E{XN, SSQ(3 * l + 1 + s)}; \
        pg8::gemm_phase<pg8::EpiResid, pg8::GSched, true>(lds, g, S, E, wave_s); } while (0)

        for (int rep = 0; rep < 13; ++rep) { if (rep == 4 || rep == 9 || rep == 11) continue;
          const int ndup = ((PROBE == 1 && (rep == 1 || rep == 2)) || (PROBE == 4 && rep == 1) || (PROBE == 6 && rep == 2)) ? 2 : ((PROBE == 2 && (rep == 0 || rep == 5 || rep == 6 || rep == 7 || rep == 10)) ? 2 : 1);
          for (int dup = 0; dup < ndup; ++dup) {
            if (rep == 0 || rep == 5 || rep == 7) {
                LANE_STATE();
                const int s0 = rep == 0 ? 0 : (rep == 5 ? 1 : 2), ns = rep == 7 ? 2 : 1;
                if (rep == 0 && l > 0) {
                    pg8::GSched S0; S0.init(MT / 256, INC / 256, G, bid); pg8::Unit u0; bool own = false;
                    for (int i = 0; S0.next(i, u0); ++i) own = own || (u0.pm == 128);
                    if (own) sample_ss_reduce(SSS(3 * l), SSQ(3 * l), tid);
                }
                for (int q = 0; q < ns; ++q) GEMM_BF16(s0 + q);
                if (rep == 5) { LANE_STATE(); const SG2 sg{XN + (size_t)MP * D, WQ_T, D, D, D, D, gQ + (size_t)MP * D, D, 0.0625f, 1, nullptr}; sgemm2(lds, sg, bid, G, wave, tid); }
                if (rep == 5 && l + 1 < DEPTH) { LANE_STATE(); if (bid >= 64) convert_layer(kp, ws, lds, l + 1, 1, 4, gw - 64 * NWAVES, NGW - 64 * NWAVES, gt - 64 * NTHREADS, NGT - 64 * NTHREADS, lane, wave); }
            } else if (rep == 10) {
                LANE_STATE();
                pg8::GSched S; S.init(MP / 256, 2 * DFF / 256, G, bid); S.aPm = (size_t)256 * D * 2; S.bPn = (size_t)256 * D * 2;
                const pg8::Gemm g{XN, WUP_T, D, D, D};
                const pg8::EpiAct E{GU, INP(I_SCF) + (size_t)l * BS * 2 * DFF, out + O_CFS + (size_t)l * BS * 2 * DFF, SBG, SBU, SBL, INP(I_CFW) + (size_t)l * 3 * DFF, SSQ(3 * l + 2)};
                pg8::gemm_phase<pg8::EpiAct, pg8::GSched, true>(lds, g, S, E, wave_s);
                { LANE_STATE(); sgemm_act(lds, XN + (size_t)MP * D, WUP_T, GU + (size_t)MP * DFF, INP(I_CFW) + (size_t)l * 3 * DFF, INP(I_SCF) + (size_t)l * BS * 2 * DFF, out + O_CFS + (size_t)l * BS * 2 * DFF, bid, G, wave, tid); }
            } else if (rep == 1) {
                LANE_STATE();
                {
                    LAS bf16_t* vT = (LAS bf16_t*)lds;
                    constexpr int VP = 136;
                    const float* gvp = INP(I_GV) + l * CW; const float* bsp = INP(I_BSS) + l * 4 * 128;
                    for (int un = (bid + G / 2) % G; un < 8 + 256; un += G) {
                        int rowbase, nrows, sb = -1;
                        if (un < 8) { sb = un; rowbase = MP + un * TS; nrows = TS; } else { rowbase = (un - 8) * 128; nrows = 128; }
                        {
                            const int rl = tid >> 5, cgp = tid & 31;
                            f32x4 g0 = *(const f32x4*)(gvp + cgp * 8), g1 = *(const f32x4*)(gvp + cgp * 8 + 4);
                            for (int p = 0; p < nrows / 16; ++p) {
                                const int r = p * 16 + rl;
                                const u32x4 raw = *(const u32x4*)(gZ + (size_t)(rowbase + r) * INC + Z_VC + cgp * 8);
                                float v[8] = {bflo(raw.x), bfhi(raw.x), bflo(raw.y), bfhi(raw.y), bflo(raw.z), bfhi(raw.z), bflo(raw.w), bfhi(raw.w)};
                                float ss = 0.f;
#pragma unroll
                                for (int k = 0; k < 8; ++k) { v[k] = gelu_t(v[k]); ss += v[k] * v[k]; }
                                ss += shx(ss, 1, lane); ss += shx(ss, 2, lane); ss += shx(ss, 4, lane);
                                const float rstd = __builtin_amdgcn_rsqf(ss * (1.f / 64.f) + EPS);
                                const float gg[8] = {g0.x, g0.y, g0.z, g0.w, g1.x, g1.y, g1.z, g1.w};
#pragma unroll
                                for (int k = 0; k < 8; ++k) { v[k] = v[k] * rstd * gg[k]; vT[(cgp * 8 + k) * VP + r] = (bf16_t)f2bf(v[k]); }
                                if (sb >= 0) { float* vo = out + O_VCS + ((size_t)(l * BS + sb) * TS + r) * CW + cgp * 8;
                                    *(f32x4*)vo = (f32x4){v[0], v[1], v[2], v[3]}; *(f32x4*)(vo + 4) = (f32x4){v[4], v[5], v[6], v[7]}; }
                            }
                        }
                        __syncthreads();
                        {
                            const int hh = wave & 3, rh = wave >> 2, fr = lane & 15, fq = lane >> 4;
                            const int nmt = nrows == 128 ? 4 : (rh == 0 ? 2 : 0);
                            for (int mi = 0; mi < nmt; ++mi) {
                                const int mt = rh * 4 + mi, nks = (mt * 16 + 15) / 32 + 1;
                                f32x4 acc[4];
#pragma unroll
                                for (int n = 0; n < 4; ++n) acc[n] = (f32x4){0.f, 0.f, 0.f, 0.f};
                                for (int ks = 0; ks < nks; ++ks) {
                                    const bf16x8 a = *(const bf16x8*)(WST + ((size_t)(hh * 128 + mt * 16 + fr) * 128 + ks * 32 + fq * 8));
#pragma unroll
                                    for (int n = 0; n < 4; ++n) { const bf16x8 b = *(const LAS bf16x8*)(vT + (hh * 64 + n * 16 + fr) * VP + ks * 32 + fq * 8);
                                        acc[n] = __builtin_amdgcn_mfma_f32_16x16x32_bf16(b, a, acc[n], 0, 0, 0); }
                                }
                                { const int t = mt * 16 + fr; const float bias = bsp[hh * 128 + t]; const size_t row = (size_t)(rowbase + t);
#pragma unroll
                                    for (int n = 0; n < 4; ++n) { const int c = hh * 64 + n * 16 + fq * 4; const u32x2 uq = *(const u32x2*)(gZ + row * INC + Z_UC + c);
                                        u32x2 w; w.x = pk2(gelu_t(bflo(uq.x)) * (acc[n][0] + bias), gelu_t(bfhi(uq.x)) * (acc[n][1] + bias)); w.y = pk2(gelu_t(bflo(uq.y)) * (acc[n][2] + bias), gelu_t(bfhi(uq.y)) * (acc[n][3] + bias));
                                        *(u32x2*)(gY + row * D + 768 + c) = w; } }
                            }
                        }
                        __syncthreads();
                    }
                }
                {
                    LAS unsigned char* wl = lds + wave * 16384;
                    LAS bf16_t* tile = (LAS bf16_t*)wl;
                    LAS float* pre_r = (LAS float*)(wl + 2560);
                    LAS float* pre_i = (LAS float*)(wl + 2560 + 4096);
                    LAS float* xcf = (LAS float*)(wl + 2560 + 8192);
                    const int fr = lane & 15, fq = lane >> 4;
                    for (int un = gw; un < 64 + 2048; un += NGW) {
                        int b, hd, rowbase, nrows, t0; bool smp = un < 64;
                        if (smp) { b = un >> 3; hd = un & 7; rowbase = MP + b * TS; nrows = TS; t0 = 0; }
                        else { const int v = un - 64; const int ch = v & 31; hd = (v >> 5) & 7; b = v >> 8; t0 = ch * 128; rowbase = b * SEQ + t0; nrows = 128; }
                        const int cidx = l * AW + hd * 64 + lane;
                        const float br = INP(I_BRG)[cidx], bi = INP(I_BIG)[cidx];
                        const float c8sp = 8.0f * log1pf(__expf(-INP(I_LAM)[cidx]));
                        const float* caw = INP(I_CAW) + (size_t)l * 4 * AW + hd * 64 + lane;
                        const float cw0 = caw[0], cw1 = caw[AW], cw2 = caw[2 * AW], cw3 = caw[3 * AW], cb = INP(I_CAB)[cidx];
                        bf16x8 bR[4][2], bI[4][2];
#pragma unroll
                        for (int n = 0; n < 4; ++n)
#pragma unroll
                            for (int ks = 0; ks < 2; ++ks) { const size_t o_ = (size_t)(hd * 64 + n * 16 + fr) * 64 + ks * 32 + fq * 8;
                                bR[n][ks] = *(const bf16x8*)(GT_R + o_); bI[n][ks] = *(const bf16x8*)(GT_I + o_); }
                        float xm3 = 0.f, xm2 = 0.f, xm1 = 0.f;
                        if (smp) { const float* st = INP(I_SCA) + ((size_t)(l * BS + b) * 3) * AW + hd * 64 + lane; xm3 = st[0]; xm2 = st[AW]; xm1 = st[2 * AW]; }
                        else if (t0 > 0) { const bf16_t* zp = gZ + (size_t)(rowbase - 3) * INC + Z_XA + hd * 64 + lane; xm3 = bf2f(zp[0]); xm2 = bf2f(zp[INC]); xm1 = bf2f(zp[2 * INC]); }
                        float h = 0.f, pc = 1.f;
                        const bf16_t* zq = gZ + (size_t)(rowbase + (lane >> 3)) * INC + Z_XA + hd * 64 + (lane & 7) * 8;
                        unsigned* hp = (unsigned*)(HLOC + (size_t)rowbase * AW + hd * 64 + (lane & ~1)); unsigned* pp = (unsigned*)(PCUM + (size_t)rowbase * AW + hd * 64 + (lane & ~1));
                        LAS bf16_t* xraw = (LAS bf16_t*)pre_r;
                        u32x4 xn0 = *(const u32x4*)zq, xn1 = *(const u32x4*)(zq + (size_t)8 * INC);
                        for (int st = 0; st < nrows / 16; ++st) {
                            *(LAS u32x4*)(xraw + (lane >> 3) * 64 + (lane & 7) * 8) = xn0; *(LAS u32x4*)(xraw + ((lane >> 3) + 8) * 64 + (lane & 7) * 8) = xn1;
                            zq += (size_t)16 * INC;
                            if (st + 1 < nrows / 16) { xn0 = *(const u32x4*)zq; xn1 = *(const u32x4*)(zq + (size_t)8 * INC); }
                            LDS_WAIT();
#pragma unroll
                            for (int i = 0; i < 16; ++i) { const float xv = bf2f(xraw[i * 64 + lane]);
                                const float xc = cw0 * xm3 + cw1 * xm2 + cw2 * xm1 + cw3 * xv + cb; xm3 = xm2; xm2 = xm1; xm1 = xv; xcf[i * 64 + lane] = xc; tile[i * 72 + lane] = (bf16_t)f2bf(xc); }
                            LDS_WAIT();
                            const bf16x8 a0 = *(const LAS bf16x8*)(tile + fr * 72 + fq * 8), a1 = *(const LAS bf16x8*)(tile + fr * 72 + 32 + fq * 8);
#pragma unroll
                            for (int n = 0; n < 4; ++n) {
                                f32x4 ar = (f32x4){0.f, 0.f, 0.f, 0.f}, ai = (f32x4){0.f, 0.f, 0.f, 0.f};
                                ar = __builtin_amdgcn_mfma_f32_16x16x32_bf16(a0, bR[n][0], ar, 0, 0, 0); ar = __builtin_amdgcn_mfma_f32_16x16x32_bf16(a1, bR[n][1], ar, 0, 0, 0);
                                ai = __builtin_amdgcn_mfma_f32_16x16x32_bf16(a0, bI[n][0], ai, 0, 0, 0); ai = __builtin_amdgcn_mfma_f32_16x16x32_bf16(a1, bI[n][1], ai, 0, 0, 0);
#pragma unroll
                                for (int j = 0; j < 4; ++j) { pre_r[(fq * 4 + j) * 64 + n * 16 + fr] = ar[j]; pre_i[(fq * 4 + j) * 64 + n * 16 + fr] = ai[j]; }
                            }
                            LDS_WAIT();
#pragma unroll 4
                            for (int i = 0; i < 16; ++i) {
                                const float r = sigm(pre_r[i * 64 + lane] + br), gi = sigm(pre_i[i * 64 + lane] + bi);
                                const float la = -c8sp * r; float a, om;
                                if (la > -0.125f) { const float x = 2.0f * la; om = -x * (1.0f + x * (0.5f + x * (0.16666667f + x * (0.041666668f + x * (0.0083333338f + x * 0.0013888889f))))); a = 1.0f + la * (1.0f + la * (0.5f + la * (0.16666667f + la * (0.041666668f + la * 0.0083333338f)))); }
                                else { a = __expf(la); om = -expm1f(2.0f * la); }
                                const float bm = __builtin_amdgcn_sqrtf(om);
                                h = a * h + bm * gi * xcf[i * 64 + lane]; pc = pc * a;
                                { const float hn = __builtin_bit_cast(float, __builtin_amdgcn_mov_dpp(__builtin_bit_cast(int, h), 0xB1, 0xf, 0xf, true)), pn = __builtin_bit_cast(float, __builtin_amdgcn_mov_dpp(__builtin_bit_cast(int, pc), 0xB1, 0xf, 0xf, true));
                                  if ((lane & 1) == 0) { *hp = pk2(h, hn); *pp = pk2(pc, pn); } hp += AW / 2; pp += AW / 2; }
                            }
                            LDS_WAIT();
                        }
                        AGG[(size_t)un * 128 + lane] = pc; AGG[(size_t)un * 128 + 64 + lane] = h;
                    }
                }
                {
                    const float* cbw = INP(I_CBW) + (size_t)l * 3 * BW;
                    if (bid >= 8) for (int it = gt - 8 * NTHREADS; it < (MT / 8) * 32; it += NGT - 8 * NTHREADS) {
                        const int rb = it >> 5, c0 = (it & 31) * 8;
                        int b, t0, T, rowbase; const bool smp = rb >= MP / 8;
                        if (!smp) { b = rb >> 9; t0 = (rb & 511) * 8; T = SEQ; rowbase = rb * 8; } else { const int sbk = rb - MP / 8; b = sbk >> 2; t0 = (sbk & 3) * 8; T = TS; rowbase = MP + sbk * 8; }
                        u32x4 xq[10], cq[10], bq[8];
                        const bf16_t* zr = gZ + (size_t)rowbase * INC + c0;
#pragma unroll
                        for (int i = 0; i < 10; ++i) { if (i >= 2 || t0 > 0) { xq[i] = *(const u32x4*)(zr + (ptrdiff_t)(i - 2) * INC + Z_XB); cq[i] = *(const u32x4*)(zr + (ptrdiff_t)(i - 2) * INC + Z_GC); } else { xq[i] = (u32x4){0u, 0u, 0u, 0u}; cq[i] = (u32x4){0u, 0u, 0u, 0u}; } }
#pragma unroll
                        for (int i = 0; i < 8; ++i) bq[i] = *(const u32x4*)(zr + (size_t)i * INC + Z_GB);
                        float w0[8], w1[8], w2[8], pm2[8], pm1[8];
#pragma unroll
                        for (int k = 0; k < 8; ++k) { w0[k] = cbw[c0 + k]; w1[k] = cbw[BW + c0 + k]; w2[k] = cbw[2 * BW + c0 + k]; }
                        {
                            const float a_[8] = {bflo(xq[0].x) * bflo(cq[0].x), bfhi(xq[0].x) * bfhi(cq[0].x), bflo(xq[0].y) * bflo(cq[0].y), bfhi(xq[0].y) * bfhi(cq[0].y), bflo(xq[0].z) * bflo(cq[0].z), bfhi(xq[0].z) * bfhi(cq[0].z), bflo(xq[0].w) * bflo(cq[0].w), bfhi(xq[0].w) * bfhi(cq[0].w)};
                            const float b_[8] = {bflo(xq[1].x) * bflo(cq[1].x), bfhi(xq[1].x) * bfhi(cq[1].x), bflo(xq[1].y) * bflo(cq[1].y), bfhi(xq[1].y) * bfhi(cq[1].y), bflo(xq[1].z) * bflo(cq[1].z), bfhi(xq[1].z) * bfhi(cq[1].z), bflo(xq[1].w) * bflo(cq[1].w), bfhi(xq[1].w) * bfhi(cq[1].w)};
#pragma unroll
                            for (int k = 0; k < 8; ++k) { pm2[k] = a_[k]; pm1[k] = b_[k]; }
                        }
                        if (t0 == 0 && smp) { const float* st = INP(I_SCB) + ((size_t)(l * BS + b) * 2) * BW + c0;
#pragma unroll
                            for (int k = 0; k < 8; ++k) { pm2[k] = st[k]; pm1[k] = st[BW + k]; } }
#pragma unroll
                        for (int i = 0; i < 8; ++i) {
                            const u32x4 xb = xq[i + 2], gc = cq[i + 2], gb = bq[i];
                            const float pv[8] = {bflo(xb.x) * bflo(gc.x), bfhi(xb.x) * bfhi(gc.x), bflo(xb.y) * bflo(gc.y), bfhi(xb.y) * bfhi(gc.y), bflo(xb.z) * bflo(gc.z), bfhi(xb.z) * bfhi(gc.z), bflo(xb.w) * bflo(gc.w), bfhi(xb.w) * bfhi(gc.w)};
                            const float gbv[8] = {bflo(gb.x), bfhi(gb.x), bflo(gb.y), bfhi(gb.y), bflo(gb.z), bfhi(gb.z), bflo(gb.w), bfhi(gb.w)};
                            float yv[8];
#pragma unroll
                            for (int k = 0; k < 8; ++k) { yv[k] = gbv[k] * (w0[k] * pm2[k] + w1[k] * pm1[k] + w2[k] * pv[k]); pm2[k] = pm1[k]; pm1[k] = pv[k]; }
                            u32x4 w; w.x = pk2(yv[0], yv[1]); w.y = pk2(yv[2], yv[3]); w.z = pk2(yv[4], yv[5]); w.w = pk2(yv[6], yv[7]);
                            *(u32x4*)(gY + (size_t)(rowbase + i) * D + 512 + c0) = w;
                        }
                        if (t0 + 8 == T) { float* o = out + (smp ? O_CBS : O_CBP) + ((size_t)(l * 8 + b) * 2) * BW + c0;
#pragma unroll
                            for (int k = 0; k < 8; ++k) { o[k] = pm2[k]; o[BW + k] = pm1[k]; } }
                    }
                }
            } else if (rep == 2) {
                LANE_STATE();
                {
                    LAS float* cr = (LAS float*)lds;
                    for (int un = bid; un < 8 + 256; un += G) {
                        int b, ch, rowbase, nrows; const bool smp = un < 8;
                        if (smp) { b = un; ch = 0; rowbase = MP + b * TS; nrows = TS; } else { const int v = un - 8; b = v >> 5; ch = v & 31; rowbase = b * SEQ + ch * 128; nrows = 128; }
                        {
                            const int c = tid, hd = c >> 6, ln = c & 63; float carry = 0.f;
                            if (smp) carry = INP(I_SHA)[(size_t)(l * BS + b) * AW + c];
                            else { const float* ag = AGG + (size_t)(64 + (b << 8) + (hd << 5)) * 128 + ln; for (int k = 0; k < ch; ++k) carry = ag[(size_t)k * 128] * carry + ag[(size_t)k * 128 + 64]; }
                            cr[c] = carry;
                        }
                        __syncthreads();
                        const int c0 = (tid & 63) * 8, rsub = tid >> 6;
                        const f32x4 ca = *(const LAS f32x4*)(cr + c0), cb = *(const LAS f32x4*)(cr + c0 + 4);
                        for (int p4 = 0; p4 < nrows / 8; p4 += 4) {
                            u32x4 hqv[4], pqv[4], gqv[4];
#pragma unroll
                            for (int q = 0; q < 4; ++q) { const size_t row = (size_t)(rowbase + (p4 + q) * 8 + rsub); hqv[q] = *(const u32x4*)(HLOC + row * AW + c0); pqv[q] = *(const u32x4*)(PCUM + row * AW + c0); gqv[q] = *(const u32x4*)(gZ + row * INC + Z_GA + c0); }
#pragma unroll
                            for (int q = 0; q < 4; ++q) {
                                const int rloc = (p4 + q) * 8 + rsub; const size_t row = (size_t)(rowbase + rloc);
                                const u32x4 hq = hqv[q], pq = pqv[q], gq = gqv[q];
                                const f32x4 h0 = (f32x4){bflo(hq.x), bfhi(hq.x), bflo(hq.y), bfhi(hq.y)}, h1 = (f32x4){bflo(hq.z), bfhi(hq.z), bflo(hq.w), bfhi(hq.w)}, p0 = (f32x4){bflo(pq.x), bfhi(pq.x), bflo(pq.y), bfhi(pq.y)}, p1 = (f32x4){bflo(pq.z), bfhi(pq.z), bflo(pq.w), bfhi(pq.w)};
                                const f32x4 a0 = h0 + p0 * ca, a1 = h1 + p1 * cb;
                                u32x4 w; w.x = pk2(gelu_t(bflo(gq.x)) * a0[0], gelu_t(bfhi(gq.x)) * a0[1]); w.y = pk2(gelu_t(bflo(gq.y)) * a0[2], gelu_t(bfhi(gq.y)) * a0[3]);
                                w.z = pk2(gelu_t(bflo(gq.z)) * a1[0], gelu_t(bfhi(gq.z)) * a1[1]); w.w = pk2(gelu_t(bflo(gq.w)) * a1[2], gelu_t(bfhi(gq.w)) * a1[3]);
                                *(u32x4*)(gY + row * D + c0) = w;
                                if ((smp || ch == 31) && rloc == nrows - 1) { float* o = out + (smp ? O_HAS : O_HAP) + (size_t)(l * 8 + b) * AW + c0; *(f32x4*)o = a0; *(f32x4*)(o + 4) = a1; }
                            }
                        }
                        if ((smp || ch == 31) && tid < 192) {
                            const int k = tid >> 6; const u32x4 xq = *(const u32x4*)(gZ + (size_t)(rowbase + nrows - 3 + k) * INC + Z_XA + c0);
                            float* o = out + (smp ? O_CAS : O_CAP) + ((size_t)(l * 8 + b) * 3 + k) * AW + c0;
                            *(f32x4*)o = (f32x4){bflo(xq.x), bfhi(xq.x), bflo(xq.y), bfhi(xq.y)}; *(f32x4*)(o + 4) = (f32x4){bflo(xq.z), bfhi(xq.z), bflo(xq.w), bfhi(xq.w)};
                        }
                        __syncthreads();
                    }
                }
            } else if (rep == 3 || rep == 8 || rep == 12) {
                LANE_STATE();
                if (rep == 12) {
                    const float* cfw = INP(I_CFW) + (size_t)l * 3 * DFF;
                    pg8::GSched S0; S0.init(MP / 256, D / 256, G, bid); pg8::Unit u0;
                    for (int i = 0; S0.next(i, u0); ++i) {
                        const int pm = u0.pm; if (pm >= 128 || tid >= DFF / 8) continue;
                        const int c0 = tid * 8, b = pm >> 4;
                        float w0[8], w1[8], w2[8], p2[8], p1[8], g0[8], g1[8], u0_[8], u1_[8];
#pragma unroll
                        for (int k = 0; k < 8; ++k) { w0[k] = cfw[c0 + k]; w1[k] = cfw[DFF + c0 + k]; w2[k] = cfw[2 * DFF + c0 + k]; p2[k] = 0.f; p1[k] = 0.f; }
                        if ((pm & 15) != 0) {
#pragma unroll
                            for (int k = 0; k < 8; ++k) { p2[k] = SBL[((size_t)(pm - 1) * 2 + 0) * DFF + c0 + k]; p1[k] = SBL[((size_t)(pm - 1) * 2 + 1) * DFF + c0 + k]; } }
#pragma unroll
                        for (int k = 0; k < 8; ++k) { g0[k] = SBG[((size_t)pm * 2 + 0) * DFF + c0 + k]; g1[k] = SBG[((size_t)pm * 2 + 1) * DFF + c0 + k]; u0_[k] = SBU[((size_t)pm * 2 + 0) * DFF + c0 + k]; u1_[k] = SBU[((size_t)pm * 2 + 1) * DFF + c0 + k]; }
                        float ha[8], hb[8];
#pragma unroll
                        for (int k = 0; k < 8; ++k) { ha[k] = silu(w0[k] * p2[k] + w1[k] * p1[k] + w2[k] * g0[k]) * u0_[k]; hb[k] = silu(w0[k] * p1[k] + w1[k] * g0[k] + w2[k] * g1[k]) * u1_[k]; }
                        u32x4 w; w.x = pk2(ha[0], ha[1]); w.y = pk2(ha[2], ha[3]); w.z = pk2(ha[4], ha[5]); w.w = pk2(ha[6], ha[7]);
                        *(u32x4*)(GU + (size_t)(pm * 256) * DFF + c0) = w;
                        w.x = pk2(hb[0], hb[1]); w.y = pk2(hb[2], hb[3]); w.z = pk2(hb[4], hb[5]); w.w = pk2(hb[6], hb[7]);
                        *(u32x4*)(GU + (size_t)(pm * 256 + 1) * DFF + c0) = w;
                        if ((pm & 15) == 15 && u0.pn == 0) { float* o = out + O_CFP + ((size_t)(l * 8 + b) * 2) * DFF + c0;
#pragma unroll
                            for (int k = 0; k < 8; ++k) { o[k] = SBL[((size_t)pm * 2 + 0) * DFF + c0 + k]; o[DFF + k] = SBL[((size_t)pm * 2 + 1) * DFF + c0 + k]; } }
                    }
                    asm volatile("s_waitcnt vmcnt(0)" ::: "memory"); __syncthreads();
                }
                GEMM_RES(rep == 3 ? 0 : (rep == 8 ? 1 : 2));
                { LANE_STATE();
                  const SG2 sg{rep == 12 ? GU + (size_t)MP * DFF : (rep == 3 ? gY : gO) + (size_t)MP * D, rep == 12 ? WDN_T : (rep == 3 ? WOUT_T : WO_T), rep == 12 ? DFF : D, rep == 12 ? DFF : D, rep == 12 ? DFF : D, D, XN + (size_t)MP * D, D, 1.f, 2, SSS(3 * l + (rep == 3 ? 1 : (rep == 8 ? 2 : 3)))};
                  sgemm2(lds, sg, bid, G, wave, tid); }
                if (l + 1 < DEPTH) { LANE_STATE(); if (bid >= 64) convert_layer(kp, ws, lds, l + 1, rep == 3 ? 0 : (rep == 8 ? 2 : 3), 4, gw - 64 * NWAVES, NGW - 64 * NWAVES, gt - 64 * NTHREADS, NGT - 64 * NTHREADS, lane, wave); }
            } else if (rep == 6) {
                LANE_STATE();
                for (int sub = 0; sub < 2; ++sub) {
                    pg8::GSched S; pg8::Gemm g; pg8::EpiSoftmax E;
                    if (sub == 0) { S.init(MP / 256, 4, G, bid); S.aPm = (size_t)256 * D * 2; S.aPn = 512; S.bPn = 512; S.bPm = (size_t)256 * D * 2; S.bShift = 4; g = pg8::Gemm{gQ, KBP, D, D, 256}; E.O = gP; E.ldc = D; E.smp = 0; }
                    else { S.init(1, 32, G, (bid + G - 64) % G); S.mode = 1; g = pg8::Gemm{gQ + (size_t)MP * D, KBS, D, D, 256}; E.O = PS; E.ldc = 8192; E.smp = 1; }
                    pg8::gemm_phase<pg8::EpiSoftmax, pg8::GSched, true>(lds, g, S, E, wave_s);
                }
            }
            if (rep == 6) { asm volatile("s_waitcnt vmcnt(0)" ::: "memory"); __syncthreads(); }
            else GRID_SYNC();
          }
        }
    }
    {
        LANE_STATE();
        const float* gain = INP(I_GFIN);
        f32x4 gv[4];
#pragma unroll
        for (int j = 0; j < 4; ++j) gv[j] = ((const f32x4*)gain)[lane + 64 * j];
        for (int m0 = gw; m0 < MT; m0 += 2 * NGW) {
            const int m1 = m0 + NGW; const bool two = m1 < MT; const int mb = two ? m1 : m0;
            const u32x2* xa = (const u32x2*)(XN + (size_t)m0 * D) + lane; const u32x2* xb = (const u32x2*)(XN + (size_t)mb * D) + lane;
            u32x2 pa[4], pb[4];
#pragma unroll
            for (int j = 0; j < 4; ++j) { pa[j] = xa[64 * j]; pb[j] = xb[64 * j]; }
            float ra, rb;
            { float qa = 0.f, qb = 0.f;
#pragma unroll
              for (int j = 0; j < 4; ++j) { const float a0 = bflo(pa[j].x), a1 = bfhi(pa[j].x), a2 = bflo(pa[j].y), a3 = bfhi(pa[j].y), b0 = bflo(pb[j].x), b1 = bfhi(pb[j].x), b2 = bflo(pb[j].y), b3 = bfhi(pb[j].y);
                  qa += (a0 * a0 + a1 * a1) + (a2 * a2 + a3 * a3); qb += (b0 * b0 + b1 * b1) + (b2 * b2 + b3 * b3); }
              if (m0 < MP) ra = ss_rstd(*(const f32x4*)(SSQ(6) + (size_t)m0 * 4)); else ra = 1.0f / sqrtf(wave_sum(qa, lane) * (1.f / D) + EPS);
              if (mb < MP) rb = ss_rstd(*(const f32x4*)(SSQ(6) + (size_t)mb * 4)); else rb = 1.0f / sqrtf(wave_sum(qb, lane) * (1.f / D) + EPS); }
            f32x4* ya = (f32x4*)(out + (size_t)m0 * D) + lane; f32x4* yb = (f32x4*)(out + (size_t)mb * D) + lane;
#pragma unroll
            for (int j = 0; j < 4; ++j) { __builtin_nontemporal_store((f32x4){bflo(pa[j].x), bfhi(pa[j].x), bflo(pa[j].y), bfhi(pa[j].y)} * ra * gv[j], ya + 64 * j); if (two) __builtin_nontemporal_store((f32x4){bflo(pb[j].x), bfhi(pb[j].x), bflo(pb[j].y), bfhi(pb[j].y)} * rb * gv[j], yb + 64 * j); }
        }
    }
}

extern "C" void kernel_launch(void* const* d_in, const int* in_sizes, int n_in, void* d_out, int out_size, void* d_ws, size_t ws_size, hipStream_t stream) {
    static int grid = 0;
    if (grid == 0) {
        if (n_in != N_IN || (size_t)out_size != O_END || ws_size < 512 * MiB) { fprintf(stderr, "kernel_launch: unexpected sizes n_in %d out %d ws %zu (need %zu)\n", n_in, out_size, ws_size, (size_t)(512 * MiB)); grid = -1; return; }
        int dev = 0, cus = 0, per_cu = 0;
        (void)hipGetDevice(&dev); (void)hipDeviceGetAttribute(&cus, hipDeviceAttributeMultiprocessorCount, dev);
        if (hipFuncSetAttribute((const void*)trunk_fwd, hipFuncAttributeMaxDynamicSharedMemorySize, LDS_BYTES) != hipSuccess) { fprintf(stderr, "kernel_launch: hipFuncSetAttribute failed\n"); grid = -1; return; }
        if (hipOccupancyMaxActiveBlocksPerMultiprocessor(&per_cu, (const void*)trunk_fwd, NTHREADS, LDS_BYTES) != hipSuccess || per_cu < 1) { fprintf(stderr, "kernel_launch: occupancy query gave %d\n", per_cu); per_cu = 1; }
        (void)hipGetLastError();
        grid = cus * 1;
        if (grid != 256) fprintf(stderr, "kernel_launch: note: %d CUs\n", grid);
    }
    if (grid < 0) return;
    Args a{};
    for (int i = 0; i < N_IN; ++i) a.in[i] = (const float*)d_in[i];
    a.out = (float*)d_out; a.ws = (unsigned char*)d_ws;
    void* kargs[] = {&a};
    hipError_t e = hipLaunchCooperativeKernel((const void*)trunk_fwd, dim3(grid), dim3(NTHREADS), kargs, LDS_BYTES, stream);
    if (e != hipSuccess) fprintf(stderr, "kernel_launch: cooperative launch failed: %s (grid %d)\n", hipGetErrorString(e), grid);
}
```

```cpp
#include <hip/hip_runtime.h>
#include <hip/hip_cooperative_groups.h>
#include <cstdio>
#include <cstdint>
namespace cg = cooperative_groups;
#ifndef PROBE
#define PROBE 0
#endif

#define LAS __attribute__((address_space(3)))
typedef unsigned short bf16_t;
typedef short bf16x8 __attribute__((ext_vector_type(8)));
typedef float f32x4 __attribute__((ext_vector_type(4)));
typedef float f32x2 __attribute__((ext_vector_type(2)));
typedef unsigned u32x4 __attribute__((ext_vector_type(4)));
typedef unsigned u32x2 __attribute__((ext_vector_type(2)));

constexpr int D = 1024, BP = 8, SEQ = 4096, BS = 8, TS = 32, DEPTH = 2;
constexpr int MP = BP * SEQ, MS = BS * TS, MT = MP + MS;
constexpr int INC = 2304, DFF = 2816, NMEM = 256, AW = 512, BW = 256, CW = 256;
constexpr int Z_XA = 0, Z_GA = 512, Z_XB = 1024, Z_GB = 1280, Z_GC = 1536, Z_UC = 1792, Z_VC = 2048;
constexpr float EPS = 1e-6f;
constexpr int NWAVES = 8, NTHREADS = 512;

constexpr size_t O_YP = 0, O_YS = O_YP + (size_t)MP * D, O_CAP = O_YS + (size_t)MS * D, O_HAP = O_CAP + DEPTH * BP * 3 * AW,
                 O_CBP = O_HAP + DEPTH * BP * AW, O_CFP = O_CBP + DEPTH * BP * 2 * BW, O_MKP = O_CFP + DEPTH * BP * 2 * DFF,
                 O_MVP = O_MKP + (size_t)DEPTH * BP * NMEM * D, O_CAS = O_MVP + (size_t)DEPTH * BP * NMEM * D, O_HAS = O_CAS + DEPTH * BS * 3 * AW,
                 O_CBS = O_HAS + DEPTH * BS * AW, O_CFS = O_CBS + DEPTH * BS * 2 * BW, O_VCS = O_CFS + DEPTH * BS * 2 * DFF,
                 O_END = O_VCS + DEPTH * BS * TS * CW;

constexpr size_t MiB = 1u << 20;
constexpr size_t WS_WIN = 0, WS_WOUT = 5 * MiB, WS_WQ = 7 * MiB, WS_WK = 9 * MiB, WS_WV = 11 * MiB, WS_WO = 13 * MiB, WS_WUP = 15 * MiB, WS_WDN = 26 * MiB;
constexpr size_t WS_MEMB = 32 * MiB, WS_KBP = 36 * MiB, WS_VTP = 40 * MiB, WS_KBS = 44 * MiB, WS_VTS = 48 * MiB, WS_WST = 52 * MiB, WS_GT = WS_WST + 131072, WS_AGG = 53 * MiB, WS_SS = 54 * MiB + 256 * 1024, WS_BAR = 55 * MiB + 512 * 1024;
constexpr size_t WS_XN = 56 * MiB, WS_BIG = 121 * MiB;
constexpr size_t B_Z = WS_BIG, B_HLOC = WS_BIG + 146 * MiB, B_PCUM = WS_BIG + 211 * MiB, B_Y = WS_BIG + 276 * MiB;
constexpr size_t B_Q = WS_BIG, B_P = WS_BIG + 65 * MiB, B_O = WS_BIG + 130 * MiB, B_PS = WS_BIG + 195 * MiB;
constexpr size_t B_GU = WS_BIG;
constexpr size_t B_GUS = WS_BIG + 200 * MiB;
constexpr size_t B_SBG = WS_BIG + 204 * MiB, B_SBU = WS_BIG + 207 * MiB, B_SBL = WS_BIG + 210 * MiB;
constexpr size_t WS_END = WS_BIG + (size_t)MT * 2 * DFF * 2;
constexpr size_t WS_SSP = 476 * MiB;
static_assert(WS_END <= WS_SSP && WS_SSP + (size_t)7 * MT * 64 <= 512 * MiB, "workspace");
static_assert(WS_XN + (size_t)MT * D * 2 <= WS_BIG, "xn");
constexpr size_t WS_SSS = WS_SSP + (((size_t)7 * MT * 16 + 4095) / 4096) * 4096;
static_assert(WS_SSS + 7 * 256 * 32 * 4 <= 480 * MiB, "sss");
constexpr size_t WSEL1 = 480 * MiB, KSEL1 = 418 * MiB;
static_assert(WS_WDN + (size_t)D * DFF * 2 + WSEL1 <= 512 * MiB && WS_KBS + KSEL1 >= WS_BIG + 341 * MiB && WS_GT + 131072 + KSEL1 <= WS_SSP, "second buffer set");

constexpr int LDS_RING = 131072, LDS_EX = LDS_RING, LDS_MISC = LDS_EX + 8192, LDS_BYTES = 147456;

enum { I_XP = 0, I_XS, I_MEM, I_CK, I_CV, I_SCA, I_SHA, I_SCB, I_SCF, I_GMIX, I_WIN, I_CAW, I_CAB, I_WRG, I_BRG, I_WIG, I_BIG, I_LAM, I_CBW, I_GV, I_WS, I_BSS,
       I_WOUT, I_GX, I_WQ, I_WK, I_WV, I_WO, I_GFFN, I_WUP, I_CFW, I_WDN, I_GFIN, N_IN };

struct Args { const float* in[N_IN]; float* out; unsigned char* ws; };

__device__ __forceinline__ unsigned pk2(float lo, float hi) { unsigned r; asm("v_cvt_pk_bf16_f32 %0, %1, %2" : "=v"(r) : "v"(lo), "v"(hi)); return r; }
__device__ __forceinline__ unsigned f2bf(float f) { return pk2(f, f) & 0xffffu; }
__device__ __forceinline__ float bf2f(unsigned v) { return __builtin_bit_cast(float, v << 16); }
__device__ __forceinline__ float bflo(unsigned w) { return __builtin_bit_cast(float, w << 16); }
__device__ __forceinline__ float bfhi(unsigned w) { return __builtin_bit_cast(float, w & 0xffff0000u); }
__device__ __forceinline__ unsigned cvt_pk_bf16(float lo, float hi) { unsigned r; asm volatile("v_cvt_pk_bf16_f32 %0, %1, %2" : "=v"(r) : "v"(lo), "v"(hi)); return r; }
__device__ __forceinline__ float fexp(float x) { return __builtin_amdgcn_exp2f(x * 1.4426950408889634f); }
__device__ __forceinline__ float sigm(float x) { return __builtin_amdgcn_rcpf(1.0f + fexp(-x)); }
__device__ __forceinline__ float gelu_t(float x) { const float u = 0.7978845608028654f * (x + 0.044715f * x * x * x); return x * sigm(2.0f * u); }
__device__ __forceinline__ float silu(float x) { return x * sigm(x); }
__device__ __forceinline__ float shx(float v, int m, int lane) { return __builtin_bit_cast(float, __builtin_amdgcn_ds_bpermute((lane ^ m) << 2, __builtin_bit_cast(int, v))); }
__device__ __forceinline__ float wave_sum(float v, int lane) {
#pragma unroll
    for (int o = 1; o < 64; o <<= 1) v += shx(v, o, lane);
    return v;
}
#define LDS_WAIT() asm volatile("s_waitcnt lgkmcnt(0)" ::: "memory")
__device__ __forceinline__ float ss_rstd(f32x4 p) { return __builtin_amdgcn_rsqf(((p[0] + p[1]) + (p[2] + p[3])) * (1.f / 1024.f) + 1e-6f); }
__device__ __forceinline__ int opaque_tid(int wave_s) { int l; asm volatile("v_mbcnt_lo_u32_b32 %0, -1, 0\n\tv_mbcnt_hi_u32_b32 %0, -1, %0" : "=v"(l)); return wave_s * 64 + l; }

namespace pg8 {
constexpr int BM = 256, BK = 64, HALF = 128, HTB = HALF * BK * 2, NXCD = 8, WGM = 8;
__device__ __forceinline__ int lds_byte(int r, int c) { const int st = (r >> 4) * 2 + (c >> 5), rr = r & 15, cc = c & 31, ob = rr * 64 + cc * 2; return st * 1024 + (ob ^ (((ob >> 9) & 1) << 5)); }
__device__ __forceinline__ void stage_rc(int b, int& R, int& C) { const int st = b / 1024, sb = b % 1024, swz = sb ^ (((sb >> 9) & 1) << 5); R = (st >> 1) * 16 + swz / 64; C = (st & 1) * 32 + (swz % 64) / 2; }
__device__ __forceinline__ int perm32(int rho) { const int n = rho >> 4, i = rho & 15; return 8 * (i >> 2) + 4 * n + (i & 3); }

struct Unit { int pm, pn; };
struct Gemm { const bf16_t* A; const bf16_t* Bt; int lda, ldb, K; };

struct GSched {
    int nM, nN, nwg, G, c, mode;
    size_t aPm, aPn, bPn, bPm; int bShift;
    __device__ __forceinline__ void init(int nM_, int nN_, int G_, int c_) { nM = nM_; nN = nN_; nwg = nM * nN; G = G_; c = c_; mode = 0; aPm = 0; aPn = 0; bPn = 0; bPm = 0; bShift = 0; }
    __device__ __forceinline__ bool next(int i, Unit& u) const {
        const long L = (long)i * G + c; if (L >= nwg) return false;
        int wgid = (int)L; { const int q = nwg / NXCD, r = nwg % NXCD, xcd = wgid % NXCD, off = wgid / NXCD; wgid = (xcd < r ? xcd * (q + 1) : r * (q + 1) + (xcd - r) * q) + off; }
        const int nig = WGM * nN, gid = wgid / nig, fm = gid * WGM, gsz = (nM - fm) < WGM ? (nM - fm) : WGM;
        u.pm = fm + ((wgid % nig) % gsz); u.pn = (wgid % nig) / gsz; return true;
    }
    __device__ __forceinline__ size_t offA(const Unit& u) const { return mode == 1 ? (size_t)(u.pn & 3) * 512 : (mode == 2 ? (size_t)(u.pn & 3) * 4096 + (size_t)(u.pn >> 2) * 512 : (size_t)u.pm * aPm + (size_t)u.pn * aPn); }
    __device__ __forceinline__ size_t offB(const Unit& u) const { return mode == 1 ? (size_t)(u.pn >> 2) * (256 * 1024 * 2) + (size_t)(u.pn & 3) * 512 : (mode == 2 ? (size_t)(u.pn & 3) * (256 * 2048 * 2) + (size_t)(u.pn >> 2) * 512 : (size_t)u.pn * bPn + (size_t)(u.pm >> bShift) * bPm); }
};

struct EpiBf16 {
    static constexpr bool PERM = true;
    bf16_t* O; int ldc; float scale; const float* ss; int smp;
    __device__ __forceinline__ void operator()(f32x4 (&acc)[2][2][4][2], const Unit& u, int wr, int wc, int fr, int fq, LAS unsigned char*) const {
        asm volatile("" : "+v"(fr), "+v"(fq)); asm volatile("" : "+s"(wr), "+s"(wc));
        const int row0 = u.pm * BM + wr * 64 + fr, col0 = (smp ? (u.pn & 3) : u.pn) * BM + wc * 32 + 8 * fq;
        f32x4 rs[2][4];
#pragma unroll
        for (int ai = 0; ai < 2; ++ai)
#pragma unroll
            for (int m = 0; m < 4; ++m) rs[ai][m] = ss ? *(const f32x4*)(ss + (size_t)(row0 + ai * HALF + m * 16) * 4) : (f32x4){0.f, 0.f, 0.f, 0.f};
#pragma unroll
        for (int ai = 0; ai < 2; ++ai)
#pragma unroll
            for (int m = 0; m < 4; ++m) { bf16_t* rowp = O + (size_t)(row0 + ai * HALF + m * 16) * ldc + col0;
                float sc = scale; if (ss) sc *= ss_rstd(rs[ai][m]);
                if (smp && ((ai * HALF + wr * 64 + m * 16 + fr) >> 5) != (u.pn >> 2)) continue;
#pragma unroll
                for (int bj = 0; bj < 2; ++bj) { const f32x4 v0 = acc[ai][bj][m][0] * sc, v1 = acc[ai][bj][m][1] * sc;
                    u32x4 w; w.x = cvt_pk_bf16(v0[0], v0[1]); w.y = cvt_pk_bf16(v0[2], v0[3]); w.z = cvt_pk_bf16(v1[0], v1[1]); w.w = cvt_pk_bf16(v1[2], v1[3]);
                    *(u32x4*)(rowp + bj * HALF) = w; } }
    }
};
struct EpiResid {
    static constexpr bool PERM = true;
    bf16_t* xb; float* ss;
    __device__ __forceinline__ void operator()(f32x4 (&acc)[2][2][4][2], const Unit& u, int wr, int wc, int fr, int fq, LAS unsigned char* lds) const {
        asm volatile("" : "+v"(fr), "+v"(fq)); asm volatile("" : "+s"(wr), "+s"(wc));
        const int col0 = u.pn * BM + wc * 32 + 8 * fq, lane = fq * 16 + fr;
        LAS float* PS = (LAS float*)(lds + LDS_EX);
        bf16_t* ob = xb + (size_t)u.pm * BM * D;
#pragma unroll
        for (int ai = 0; ai < 2; ++ai) {
            u32x4 pre[4][2];
#pragma unroll
            for (int m = 0; m < 4; ++m)
#pragma unroll
                for (int bj = 0; bj < 2; ++bj) pre[m][bj] = *(const u32x4*)(ob + (size_t)(ai * HALF + wr * 64 + m * 16 + fr) * D + col0 + bj * HALF);
            asm volatile("" ::: "memory");
#pragma unroll
            for (int m = 0; m < 4; ++m) { const int rl = ai * HALF + wr * 64 + m * 16 + fr; const size_t off = (size_t)rl * D + col0; float q = 0.f;
#pragma unroll
                for (int bj = 0; bj < 2; ++bj) { const u32x4 p = pre[m][bj]; const f32x4 a0 = acc[ai][bj][m][0], a1 = acc[ai][bj][m][1];
                    const float v0 = bflo(p.x) + a0[0], v1 = bfhi(p.x) + a0[1], v2 = bflo(p.y) + a0[2], v3 = bfhi(p.y) + a0[3], v4 = bflo(p.z) + a1[0], v5 = bfhi(p.z) + a1[1], v6 = bflo(p.w) + a1[2], v7 = bfhi(p.w) + a1[3];
                    u32x4 w; w.x = cvt_pk_bf16(v0, v1); w.y = cvt_pk_bf16(v2, v3); w.z = cvt_pk_bf16(v4, v5); w.w = cvt_pk_bf16(v6, v7); *(u32x4*)(ob + off + bj * HALF) = w;
                    q += ((v0 * v0 + v1 * v1) + (v2 * v2 + v3 * v3)) + ((v4 * v4 + v5 * v5) + (v6 * v6 + v7 * v7)); }
                q += shx(q, 16, lane); q += shx(q, 32, lane);
                if (fq == 0) PS[rl * 4 + wc] = q; }
            asm volatile("" ::: "memory");
        }
        asm volatile("s_waitcnt lgkmcnt(0)" ::: "memory"); __builtin_amdgcn_s_barrier(); asm volatile("" ::: "memory");
        { const int t = (wr * 4 + wc) * 64 + lane; if (t < 256) { const f32x4 p = *(const LAS f32x4*)(PS + t * 4); ss[(size_t)(u.pm * BM + t) * 4 + u.pn] = (p[0] + p[1]) + (p[2] + p[3]); } }
    }
};
struct EpiKV {
    static constexpr bool PERM = false;
    float* outK; float* outV; bf16_t* KB; bf16_t* VT;
    __device__ __forceinline__ void operator()(f32x4 (&acc)[2][2][4][2], const Unit& u, int wr, int wc, int fr, int fq, LAS unsigned char*) const {
        asm volatile("" : "+v"(fr), "+v"(fq)); asm volatile("" : "+s"(wr), "+s"(wc));
        const int kind = u.pm >> 4, pm = u.pm & 15;
        const int col0 = u.pn * BM + wc * 32 + 4 * fq;
        float* of = kind == 0 ? outK : outV; bf16_t* ob = kind == 0 ? KB : VT; const int ldb_ = kind == 2 ? 2048 : 1024;
#pragma unroll
        for (int ai = 0; ai < 2; ++ai)
#pragma unroll
            for (int m = 0; m < 4; ++m) { const int row = pm * BM + ai * HALF + wr * 64 + m * 16 + fr;
#pragma unroll
                for (int bj = 0; bj < 2; ++bj)
#pragma unroll
                    for (int n = 0; n < 2; ++n) { const f32x4 v = acc[ai][bj][m][n]; const int col = col0 + bj * HALF + n * 16;
                        if (kind != 2) __builtin_nontemporal_store(v, (f32x4*)(of + (size_t)row * 1024 + col));
                        if (kind != 1) { u32x2 w; w.x = cvt_pk_bf16(v[0], v[1]); w.y = cvt_pk_bf16(v[2], v[3]); *(u32x2*)(ob + (size_t)row * ldb_ + col) = w; } } }
    }
};
struct EpiSoftmax {
    static constexpr bool PERM = true;
    bf16_t* O; int ldc; int smp;
    __device__ __forceinline__ void operator()(f32x4 (&acc)[2][2][4][2], const Unit& u, int wr, int wc, int fr, int fq, LAS unsigned char* lds) const {
        asm volatile("" : "+v"(fr), "+v"(fq)); asm volatile("" : "+s"(wr), "+s"(wc));
        LAS f32x2* EX = (LAS f32x2*)(lds + LDS_EX);
        const int lane = fq * 16 + fr;
        const float L2E = 1.4426950408889634f;
#pragma unroll
        for (int ai = 0; ai < 2; ++ai)
#pragma unroll
            for (int m = 0; m < 4; ++m) {
                float mx = -3.0e38f;
#pragma unroll
                for (int bj = 0; bj < 2; ++bj)
#pragma unroll
                    for (int n = 0; n < 2; ++n) { const f32x4 x = acc[ai][bj][m][n]; mx = fmaxf(mx, fmaxf(fmaxf(x[0], x[1]), fmaxf(x[2], x[3]))); }
                mx = fmaxf(mx, shx(mx, 16, lane)); mx = fmaxf(mx, shx(mx, 32, lane));
                float s = 0.f;
#pragma unroll
                for (int bj = 0; bj < 2; ++bj)
#pragma unroll
                    for (int n = 0; n < 2; ++n) { f32x4 x = acc[ai][bj][m][n];
#pragma unroll
                        for (int j = 0; j < 4; ++j) { x[j] = __builtin_amdgcn_exp2f((x[j] - mx) * L2E); s += x[j]; }
                        acc[ai][bj][m][n] = x; }
                s += shx(s, 16, lane); s += shx(s, 32, lane);
                if (fq == 0) EX[(ai * HALF + wr * 64 + m * 16 + fr) * 4 + wc] = (f32x2){mx, s};
            }
        asm volatile("s_waitcnt lgkmcnt(0)" ::: "memory"); __builtin_amdgcn_s_barrier(); asm volatile("" ::: "memory");
        int colb = u.pn * BM, j_ = 0;
        if (smp) { colb = (u.pn & 3) * 2048 + (u.pn >> 2) * 256; j_ = u.pn >> 2; }
        const int col0 = colb + wc * 32 + 8 * fq;
#pragma unroll
        for (int ai = 0; ai < 2; ++ai)
#pragma unroll
            for (int m = 0; m < 4; ++m) {
                const int rl = ai * HALF + wr * 64 + m * 16 + fr;
                const f32x2 e0 = EX[rl * 4 + 0], e1 = EX[rl * 4 + 1], e2 = EX[rl * 4 + 2], e3 = EX[rl * 4 + 3];
                const float M = fmaxf(fmaxf(e0.x, e1.x), fmaxf(e2.x, e3.x));
                const float tot = e0.y * __builtin_amdgcn_exp2f((e0.x - M) * L2E) + e1.y * __builtin_amdgcn_exp2f((e1.x - M) * L2E) + e2.y * __builtin_amdgcn_exp2f((e2.x - M) * L2E) + e3.y * __builtin_amdgcn_exp2f((e3.x - M) * L2E);
                const float own = wc == 0 ? e0.x : (wc == 1 ? e1.x : (wc == 2 ? e2.x : e3.x));
                float f = __builtin_amdgcn_exp2f((own - M) * L2E) * __builtin_amdgcn_rcpf(tot);
                if (smp && (rl >> 5) != j_) f = 0.f;
                bf16_t* rowp = O + (size_t)(u.pm * BM + rl) * ldc + col0;
#pragma unroll
                for (int bj = 0; bj < 2; ++bj) { const f32x4 v0 = acc[ai][bj][m][0] * f, v1 = acc[ai][bj][m][1] * f;
                    u32x4 w; w.x = cvt_pk_bf16(v0[0], v0[1]); w.y = cvt_pk_bf16(v0[2], v0[3]); w.z = cvt_pk_bf16(v1[0], v1[1]); w.w = cvt_pk_bf16(v1[2], v1[3]);
                    *(u32x4*)(rowp + bj * HALF) = w; } }
    }
};


__device__ __forceinline__ float dpp_ror1(float v) { return __builtin_bit_cast(float, __builtin_amdgcn_update_dpp(0, __builtin_bit_cast(int, v), 0x121, 0xf, 0xf, false)); }
__device__ __forceinline__ float dpp_ror2(float v) { return __builtin_bit_cast(float, __builtin_amdgcn_update_dpp(0, __builtin_bit_cast(int, v), 0x122, 0xf, 0xf, false)); }
struct EpiAct {
    static constexpr bool PERM = true;
    bf16_t* H; const float* scf; float* ocf; float* sbg; float* sbu; float* sbl; const float* cfw; const float* ss;
    __device__ __forceinline__ void operator()(f32x4 (&acc)[2][2][4][2], const Unit& u, int wr, int wc, int fr, int fq, LAS unsigned char* lds) const {
        asm volatile("" : "+s"(wr), "+s"(wc));
        int lane; asm volatile("v_mbcnt_lo_u32_b32 %0, -1, 0\n\tv_mbcnt_hi_u32_b32 %0, -1, %0" : "=v"(lane));
        fr = lane & 15; fq = lane >> 4;
        const int fl = wc * 32 + 8 * fq, f0 = u.pn * 128 + fl; int rowt = wr * 64 + fr;
        {
            float rst[2][4];
            f32x4 rsl[2][4];
#pragma unroll
            for (int ai = 0; ai < 2; ++ai)
#pragma unroll
                for (int m = 0; m < 4; ++m) rsl[ai][m] = *(const f32x4*)(ss + (size_t)(u.pm * BM + ai * HALF + rowt + m * 16) * 4);
#pragma unroll
            for (int ai = 0; ai < 2; ++ai)
#pragma unroll
                for (int m = 0; m < 4; ++m) { rst[ai][m] = ss_rstd(rsl[ai][m]); }
#pragma unroll
            for (int ai = 0; ai < 2; ++ai)
#pragma unroll
                for (int m = 0; m < 4; ++m) { acc[ai][0][m][0] = acc[ai][0][m][0] * rst[ai][m]; acc[ai][0][m][1] = acc[ai][0][m][1] * rst[ai][m]; acc[ai][1][m][0] = acc[ai][1][m][0] * rst[ai][m]; acc[ai][1][m][1] = acc[ai][1][m][1] * rst[ai][m]; }
        }
        const bool smp = (u.pm == 128);
        asm volatile("" : "+v"(rowt));
        LAS float* BND = (LAS float*)(lds + LDS_EX);
        if (fr >= 14) {
#pragma unroll
            for (int ai = 0; ai < 2; ++ai)
#pragma unroll
                for (int n = 0; n < 2; ++n) *(LAS f32x4*)(BND + ((ai * 2 + wr) * 2 + (fr - 14)) * 128 + fl + 4 * n) = acc[ai][0][3][n];
            if (wr == 1) {
#pragma unroll
                for (int n = 0; n < 2; ++n) *(f32x4*)(sbl + ((size_t)u.pm * 2 + (fr - 14)) * DFF + f0 + 4 * n) = acc[1][0][3][n];
            }
        }
        asm volatile("s_waitcnt lgkmcnt(0)" ::: "memory"); __builtin_amdgcn_s_barrier(); asm volatile("" ::: "memory");
#pragma unroll
        for (int ai = 0; ai < 2; ++ai) {
            const int pg = wr == 1 ? ai * 2 : 1;
            u32x2 hp[2][4];
#pragma unroll
            for (int n = 0; n < 2; ++n) {
                const f32x4 w0 = *(const f32x4*)(cfw + f0 + 4 * n), w1 = *(const f32x4*)(cfw + DFF + f0 + 4 * n), w2 = *(const f32x4*)(cfw + 2 * DFF + f0 + 4 * n);
                f32x4 h2 = *(const LAS f32x4*)(BND + (pg * 2 + 0) * 128 + fl + 4 * n), h1 = *(const LAS f32x4*)(BND + (pg * 2 + 1) * 128 + fl + 4 * n);
                f32x4 t2 = h2, t1 = h1;
                if (smp) { const float* sp = scf + (size_t)((ai * 4 + wr * 2) * 2) * DFF + f0 + 4 * n; h2 = *(const f32x4*)sp; h1 = *(const f32x4*)(sp + DFF); t2 = *(const f32x4*)(sp + 2 * DFF); t1 = *(const f32x4*)(sp + 3 * DFF); }
#pragma unroll
                for (int jp = 0; jp < 2; ++jp) {
                    const int j0 = jp * 2, j1 = jp * 2 + 1;
                    const f32x2 w0p = {w0[j0], w0[j1]}, w1p = {w1[j0], w1[j1]}, w2p = {w2[j0], w2[j1]};
                    f32x2 r1p = {h1[j0], h1[j1]}, r2p = fr == 0 ? (f32x2){h2[j0], h2[j1]} : (f32x2){h1[j0], h1[j1]};
#pragma unroll
                    for (int m = 0; m < 4; ++m) {
                        const f32x2 g = {acc[ai][0][m][n][j0], acc[ai][0][m][n][j1]}, uu = {acc[ai][1][m][n][j0], acc[ai][1][m][n][j1]};
                        if (m == 2 && smp) { r1p = (f32x2){t1[j0], t1[j1]}; r2p = fr == 0 ? (f32x2){t2[j0], t2[j1]} : (f32x2){t1[j0], t1[j1]}; }
                        const f32x2 r1 = {dpp_ror1(g.x), dpp_ror1(g.y)}, r2 = {dpp_ror2(g.x), dpp_ror2(g.y)};
                        const f32x2 gm1 = fr >= 1 ? r1 : r1p, gm2 = fr >= 2 ? r2 : r2p;
                        r1p = r1; r2p = r2;
                        const f32x2 cv = w0p * gm2 + w1p * gm1 + w2p * g;
                        const f32x2 ex = cv * (-1.4426950408889634f);
                        f32x2 den; den.x = __builtin_amdgcn_exp2f(ex.x); den.y = __builtin_amdgcn_exp2f(ex.y); den = den + 1.0f;
                        f32x2 rc; rc.x = __builtin_amdgcn_rcpf(den.x); rc.y = __builtin_amdgcn_rcpf(den.y);
                        const f32x2 hv = (cv * rc) * uu;
                        const unsigned pk = cvt_pk_bf16(hv.x, hv.y); if (jp == 0) hp[n][m].x = pk; else hp[n][m].y = pk;
                    }
                }
            }
#pragma unroll
            for (int m = 0; m < 4; ++m) {
                const int rl = ai * HALF + rowt + m * 16;
                if (smp && (m & 1) && fr >= 14) {
#pragma unroll
                    for (int n = 0; n < 2; ++n) *(f32x4*)(ocf + ((size_t)(ai * 4 + wr * 2 + (m >> 1)) * 2 + (fr - 14)) * DFF + f0 + 4 * n) = acc[ai][0][m][n];
                }
                if (!smp && ai == 0 && m == 0 && wr == 0 && fr < 2) {
#pragma unroll
                    for (int n = 0; n < 2; ++n) { *(f32x4*)(sbg + ((size_t)u.pm * 2 + fr) * DFF + f0 + 4 * n) = acc[0][0][0][n]; *(f32x4*)(sbu + ((size_t)u.pm * 2 + fr) * DFF + f0 + 4 * n) = acc[0][1][0][n]; }
                } else {
                    u32x4 w; w.x = hp[0][m].x; w.y = hp[0][m].y; w.z = hp[1][m].x; w.w = hp[1][m].y;
                    *(u32x4*)(H + (size_t)(u.pm * BM + rl) * DFF + f0) = w;
                }
            }
        }
    }
};

template <class Epi, class Sched, bool ALIGN_EPI>
__device__ __forceinline__ void gemm_phase(LAS unsigned char* lds, const Gemm g, const Sched& S, const Epi& E, const int wave_s) {
    const int tid = opaque_tid(wave_s), wid = __builtin_amdgcn_readfirstlane(tid >> 6), lane = tid & 63, wr = wid >> 2, wc = wid & 3, fr = lane & 15, fq = lane >> 4;
    const int nt = g.K / BK;
    unsigned voffA[2], voffB[2];
#pragma unroll
    for (int i = 0; i < 2; ++i) { int R, C; stage_rc(tid * 16 + i * 8192, R, C); const int Rb = Epi::PERM ? ((R & ~31) + perm32(R & 31)) : R;
        voffA[i] = (unsigned)(R * g.lda + C) * 2u; voffB[i] = (unsigned)(Rb * g.ldb + C) * 2u; }
    const size_t kstep = (size_t)(BK * 2);
    const size_t hstepA = (size_t)HALF * g.lda * 2, hstepB = (size_t)HALF * g.ldb * 2;
    const unsigned ldsw = (unsigned)wid * 1024u;
    const int aoff = lds_byte(wr * 64 + fr, fq * 8), boff = lds_byte(wc * 32 + fr, fq * 8);
#define PG8_SA(b, h) (((b) * 2 + (h)) * HTB)
#define PG8_SB(b, h) ((4 + (b) * 2 + (h)) * HTB)
#define PG8_STAGE(bufoff, gbase, voff) do { _Pragma("unroll") for (int _i = 0; _i < 2; ++_i) \
        __builtin_amdgcn_global_load_lds((const unsigned*)((const char*)(gbase) + (voff)[_i]), (LAS unsigned*)(lds + (bufoff) + ldsw + _i * 8192), 16, 0, 0); } while (0)
#define PG8_LDA(dst, b, h) do { _Pragma("unroll") for (int m = 0; m < 4; ++m) _Pragma("unroll") for (int k = 0; k < 2; ++k) dst[m][k] = *(const LAS bf16x8*)(lds + PG8_SA(b, h) + aoff + m * 2048 + k * 1024); } while (0)
#define PG8_LDB(dst, b, h) do { _Pragma("unroll") for (int n = 0; n < 2; ++n) _Pragma("unroll") for (int k = 0; k < 2; ++k) dst[n][k] = *(const LAS bf16x8*)(lds + PG8_SB(b, h) + boff + n * 2048 + k * 1024); } while (0)
#define PG8_MMA(ai, bj, At, Bt) do { __builtin_amdgcn_s_setprio(1); _Pragma("unroll") for (int m = 0; m < 4; ++m) _Pragma("unroll") for (int n = 0; n < 2; ++n) _Pragma("unroll") for (int k = 0; k < 2; ++k) \
        acc[ai][bj][m][n] = __builtin_amdgcn_mfma_f32_16x16x32_bf16(Bt[n][k], At[m][k], acc[ai][bj][m][n], 0, 0, 0); __builtin_amdgcn_s_setprio(0); } while (0)
#define PG8_WAIT_V(n) asm volatile("s_waitcnt vmcnt(" #n ")" ::: "memory")
#define PG8_WAIT_L(n) asm volatile("s_waitcnt lgkmcnt(" #n ")" ::: "memory")
#define PG8_BAR __builtin_amdgcn_s_barrier()
#define PG8_SCHED __builtin_amdgcn_sched_barrier(0)
    Unit cur, nxt; int ui = 0;
    if (!S.next(0, cur)) return;
    f32x4 acc[2][2][4][2];
#pragma unroll
    for (int a = 0; a < 2; ++a)
#pragma unroll
        for (int b = 0; b < 2; ++b)
#pragma unroll
            for (int m = 0; m < 4; ++m)
#pragma unroll
                for (int n = 0; n < 2; ++n) acc[a][b][m][n] = (f32x4){0.f, 0.f, 0.f, 0.f};
    bf16x8 At[4][2], B0[2][2], B1[2][2];
    const char* cA = (const char*)g.A + S.offA(cur); const char* cB = (const char*)g.Bt + S.offB(cur);
    PG8_STAGE(PG8_SB(0, 0), cB, voffB); PG8_STAGE(PG8_SB(0, 1), cB + hstepB, voffB); PG8_STAGE(PG8_SA(0, 0), cA, voffA); PG8_STAGE(PG8_SA(0, 1), cA + hstepA, voffA);
    if (wr == 1) PG8_BAR;
    PG8_WAIT_V(2); PG8_BAR;
    PG8_STAGE(PG8_SB(1, 0), cB + kstep, voffB); PG8_STAGE(PG8_SA(1, 0), cA + kstep, voffA); PG8_STAGE(PG8_SB(1, 1), cB + hstepB + kstep, voffB);
    PG8_WAIT_V(6); PG8_BAR;
    for (;;) {
        const bool has_next = S.next(ui + 1, nxt);
        const char* nA = has_next ? (const char*)g.A + S.offA(nxt) : cA; const char* nB = has_next ? (const char*)g.Bt + S.offB(nxt) : cB;
        for (int t = 0; t < nt; t += 2) {
            const bool last = (t == nt - 2);
            const char* a1 = cA + (size_t)(t + 1) * kstep;
            const char* a2 = last ? nA : cA + (size_t)(t + 2) * kstep; const char* b2 = last ? nB : cB + (size_t)(t + 2) * kstep;
            const char* a3 = a2 + kstep; const char* b3 = b2 + kstep;
            PG8_LDB(B0, 0, 0); PG8_LDB(B1, 0, 1); PG8_SCHED; PG8_LDA(At, 0, 0); PG8_STAGE(PG8_SA(1, 1), a1 + hstepA, voffA);
            PG8_WAIT_V(8); PG8_WAIT_L(0); PG8_BAR; PG8_MMA(0, 0, At, B0); PG8_MMA(0, 1, At, B1); PG8_BAR; PG8_SCHED;
            PG8_LDA(At, 0, 1); PG8_STAGE(PG8_SB(0, 0), b2, voffB); PG8_STAGE(PG8_SB(0, 1), b2 + hstepB, voffB); PG8_STAGE(PG8_SA(0, 0), a2, voffA);
            PG8_WAIT_V(8); PG8_WAIT_L(0); PG8_BAR; PG8_MMA(1, 0, At, B0); PG8_MMA(1, 1, At, B1); PG8_BAR; PG8_SCHED;
            PG8_LDB(B0, 1, 0); PG8_LDB(B1, 1, 1); PG8_SCHED; PG8_LDA(At, 1, 0); PG8_STAGE(PG8_SA(0, 1), a2 + hstepA, voffA);
            PG8_WAIT_V(8); PG8_WAIT_L(0); PG8_BAR; PG8_MMA(0, 0, At, B0); PG8_MMA(0, 1, At, B1); PG8_BAR; PG8_SCHED;
            PG8_LDA(At, 1, 1); PG8_STAGE(PG8_SB(1, 0), b3, voffB); PG8_STAGE(PG8_SB(1, 1), b3 + hstepB, voffB); PG8_STAGE(PG8_SA(1, 0), a3, voffA);
            PG8_WAIT_V(8); PG8_WAIT_L(0); PG8_BAR; PG8_MMA(1, 0, At, B0); PG8_MMA(1, 1, At, B1); PG8_BAR; PG8_SCHED;
        }
        if constexpr (ALIGN_EPI) { if (wr == 0) PG8_BAR; }
        E(acc, cur, wr, wc, fr, fq, lds);
        if (!has_next) break;
#pragma unroll
        for (int a = 0; a < 2; ++a)
#pragma unroll
            for (int b = 0; b < 2; ++b)
#pragma unroll
                for (int m = 0; m < 4; ++m)
#pragma unroll
                    for (int n = 0; n < 2; ++n) acc[a][b][m][n] = (f32x4){0.f, 0.f, 0.f, 0.f};
        cur = nxt; cA = nA; cB = nB; ++ui;
        if constexpr (ALIGN_EPI) { if (wr == 1) PG8_BAR; }
    }
    PG8_WAIT_V(0);
    if constexpr (!ALIGN_EPI) { if (wr == 0) PG8_BAR; }
    PG8_BAR;
#undef PG8_SA
#undef PG8_SB
#undef PG8_STAGE
#undef PG8_LDA
#undef PG8_LDB
#undef PG8_MMA
#undef PG8_WAIT_V
#undef PG8_WAIT_L
#undef PG8_BAR
#undef PG8_SCHED
}
}

struct KVSched {
    int c, G; const char* ws; size_t wsel;
    __device__ __forceinline__ bool next(int i, pg8::Unit& u) const {
        const int L = i * G + c; if (c < 0 || L >= 96) return false;
        const int kind = L >> 5, r = L & 31;
        if (kind < 2) { u.pm = kind * 16 + (r >> 2); u.pn = r & 3; } else { u.pm = 32 + (r >> 3); u.pn = r & 7; }
        return true;
    }
    __device__ __forceinline__ size_t offA(const pg8::Unit& u) const { const int kind = u.pm >> 4, pm = u.pm & 15; int k2 = (kind == 2); asm volatile("" : "+v"(k2));
        return (size_t)ws + WS_MEMB + (size_t)k2 * (WS_WV + wsel - WS_MEMB) + (size_t)pm * 256 * 1024 * 2; }
    __device__ __forceinline__ size_t offB(const pg8::Unit& u) const { const int kind = u.pm >> 4; int k1 = (kind == 1), k2 = (kind == 2); asm volatile("" : "+v"(k1), "+v"(k2));
        return (size_t)ws + WS_WK + wsel + (size_t)k1 * (WS_WV - WS_WK) + (size_t)k2 * (WS_MEMB - WS_WK - wsel) + (size_t)u.pn * 256 * 1024 * 2; }
};


#define XB_TMO      128
#define XB_XCNT(j)  (256  + 64 * (j))
#define XB_XSUB(j)  (1280 + 64 * (j))
#define XB_XGEN(j)  (2304 + 64 * (j))
#define XB_TOP      3328
#define XB_TOPGEN   3392
#define XCD_BAR_WORDS 3456
#define XB_SPIN_CAP (1u << 22)
__device__ __forceinline__ unsigned xb_ld(unsigned* p)              { return __hip_atomic_load(p, __ATOMIC_RELAXED, __HIP_MEMORY_SCOPE_AGENT); }
__device__ __forceinline__ unsigned xb_add(unsigned* p, unsigned v) { return __hip_atomic_fetch_add(p, v, __ATOMIC_RELAXED, __HIP_MEMORY_SCOPE_AGENT); }
__device__ __forceinline__ unsigned xb_xcc_id() { return (unsigned)__builtin_amdgcn_s_getreg((3 << 11) | 20) & 0xFu; }
#define XB_SPIN(cond, bar) do { unsigned _sp = 0; while (cond) { __builtin_amdgcn_s_sleep(1); \
    if ((++_sp & 255u) == 0u) { if (xb_ld(&(bar)[XB_TMO])) break; if (_sp > XB_SPIN_CAP) { atomicAdd(&(bar)[XB_TMO], 1u); break; } } } } while (0)
struct XcdBarrier { unsigned* bar; unsigned x; volatile LAS unsigned* st; };
__device__ __forceinline__ void xcd_barrier_complete(unsigned* bar, unsigned x, unsigned& nloc, unsigned& nx) {
    const unsigned G = gridDim.x * gridDim.y * gridDim.z;
    unsigned sum, cnt, mine, sp = 0u;
    for (;;) {
        sum = 0u; cnt = 0u; mine = 0u;
#pragma unroll
        for (unsigned j = 0; j < 16; ++j) { const unsigned c = xb_ld(&bar[XB_XCNT(j)]); sum += c; cnt += (c > 0u) ? 1u : 0u; mine = (j == x) ? c : mine; }
        if (sum == G) break;
        __builtin_amdgcn_s_sleep(1);
        if ((++sp & 255u) == 0u) { if (xb_ld(&bar[XB_TMO])) break; if (sp > XB_SPIN_CAP) { atomicAdd(&bar[XB_TMO], 1u); break; } }
    }
    nloc = mine > 0u ? mine : 1u; nx = cnt > 0u ? cnt : 1u;
}
__device__ __forceinline__ void xcd_barrier(const XcdBarrier& b) {
    asm volatile("s_waitcnt vmcnt(0)" ::: "memory");
    __syncthreads();
    if (threadIdx.x == 0) {
        unsigned* bar = b.bar;
        __builtin_amdgcn_s_waitcnt(0);
        unsigned nloc = b.st[0], nx = b.st[1];
        if (nloc == 0u) { xcd_barrier_complete(bar, b.x, nloc, nx); b.st[0] = nloc; b.st[1] = nx; }
        const unsigned old = xb_add(&bar[XB_XSUB(b.x)], 1u);
        const unsigned gen = old / nloc;
        if (old + 1u == (gen + 1u) * nloc) {
            __builtin_amdgcn_fence(__ATOMIC_RELEASE, "agent");
            asm volatile("s_waitcnt vmcnt(0)" ::: "memory");
            const unsigned og = xb_add(&bar[XB_TOP], 1u);
            const unsigned tg = og / nx;
            if (og + 1u == (tg + 1u) * nx) xb_add(&bar[XB_TOPGEN], 1u);
            else XB_SPIN(xb_ld(&bar[XB_TOPGEN]) == tg, bar);
            __builtin_amdgcn_fence(__ATOMIC_ACQUIRE, "agent");
            xb_add(&bar[XB_XGEN(b.x)], 1u);
            asm volatile("s_waitcnt vmcnt(0)" ::: "memory");
        } else {
            XB_SPIN(xb_ld(&bar[XB_XGEN(b.x)]) == gen, bar);
            __builtin_amdgcn_fence(__ATOMIC_ACQUIRE, "agent");
            asm volatile("s_waitcnt vmcnt(0)" ::: "memory");
        }
    }
    __syncthreads();
}


struct SG2 { const bf16_t* A; const bf16_t* Bt; int lda, ldb, K, N; bf16_t* O; int ldc; float scale; int mode; float* ssp; };
__device__ __forceinline__ float sq8(bf16x8 a) { float q = 0.f;
#pragma unroll
    for (int i = 0; i < 8; ++i) { const float f = bf2f((unsigned)(unsigned short)a[i]); q += f * f; } return q; }
__device__ __forceinline__ void sgemm2(LAS unsigned char* lds, const SG2 g, int ubase, int G, int wave, int tid) {
    const int lane = tid & 63, fr = lane & 15, fq = lane >> 4, rt = wave & 3, ch = wave >> 2;
    const int nunits = (g.N / 64) * 4, nsl = g.K / 64;
    int R, C; pg8::stage_rc(tid * 16, R, C);
    const unsigned offA = (unsigned)(R * g.lda + C) * 2u, offB = (unsigned)(R * g.ldb + C) * 2u;
    const int aoff = pg8::lds_byte(rt * 16 + fr, fq * 8), boff = pg8::lds_byte(ch * 32 + fr, fq * 8);
    for (int un = ubase; un >= 0 && un < nunits; un += G) {
        const int cgp = un >> 2, rg = un & 3;
        const char* gA = (const char*)(g.A + (size_t)rg * 64 * g.lda) + offA; const char* gB = (const char*)(g.Bt + (size_t)cgp * 64 * g.ldb) + offB;
#define SG2_STAGE(sl) do { LAS unsigned char* d_ = lds + ((sl) & 3) * 16384 + wave * 1024; \
        __builtin_amdgcn_global_load_lds((const unsigned*)(gA + (size_t)(sl) * 128), (LAS unsigned*)d_, 16, 0, 0); \
        __builtin_amdgcn_global_load_lds((const unsigned*)(gB + (size_t)(sl) * 128), (LAS unsigned*)(d_ + 8192), 16, 0, 0); } while (0)
        asm volatile("s_waitcnt vmcnt(0)" ::: "memory");
        SG2_STAGE(0); SG2_STAGE(1);
        f32x4 acc[2] = {(f32x4){0.f, 0.f, 0.f, 0.f}, (f32x4){0.f, 0.f, 0.f, 0.f}}; float q = 0.f;
        for (int sl = 0; sl < nsl; ++sl) {
            if (sl + 1 < nsl) asm volatile("s_waitcnt vmcnt(2)" ::: "memory"); else asm volatile("s_waitcnt vmcnt(0)" ::: "memory");
            __builtin_amdgcn_s_barrier(); asm volatile("" ::: "memory");
            if (sl + 2 < nsl) SG2_STAGE(sl + 2);
            LAS unsigned char* b_ = lds + (sl & 3) * 16384;
#pragma unroll
            for (int ks = 0; ks < 2; ++ks) {
                const bf16x8 a = *(const LAS bf16x8*)(b_ + aoff + ks * 1024);
#pragma unroll
                for (int c = 0; c < 2; ++c) { const bf16x8 b = *(const LAS bf16x8*)(b_ + 8192 + boff + c * 2048 + ks * 1024);
                    acc[c] = __builtin_amdgcn_mfma_f32_16x16x32_bf16(b, a, acc[c], 0, 0, 0); }
                if (g.mode == 1) q += sq8(a);
            }
        }
#undef SG2_STAGE
        const int row = rg * 64 + rt * 16 + fr, col = cgp * 64 + ch * 32 + fq * 4;
        bf16_t* op = g.O + (size_t)row * g.ldc + col;
        if (g.mode == 1) {
            q += shx(q, 16, lane); q += shx(q, 32, lane);
            const float sc = g.scale / sqrtf(q * (1.f / 1024.f) + EPS);
#pragma unroll
            for (int c = 0; c < 2; ++c) { const f32x4 v = acc[c] * sc; u32x2 w; w.x = cvt_pk_bf16(v[0], v[1]); w.y = cvt_pk_bf16(v[2], v[3]); *(u32x2*)(op + c * 16) = w; }
        } else {
            const u32x2 p0 = *(const u32x2*)op, p1 = *(const u32x2*)(op + 16); float qq = 0.f;
            { const float v0 = bflo(p0.x) + acc[0][0], v1 = bfhi(p0.x) + acc[0][1], v2 = bflo(p0.y) + acc[0][2], v3 = bfhi(p0.y) + acc[0][3];
              u32x2 w; w.x = cvt_pk_bf16(v0, v1); w.y = cvt_pk_bf16(v2, v3); *(u32x2*)op = w; qq += (v0 * v0 + v1 * v1) + (v2 * v2 + v3 * v3); }
            { const float v0 = bflo(p1.x) + acc[1][0], v1 = bfhi(p1.x) + acc[1][1], v2 = bflo(p1.y) + acc[1][2], v3 = bfhi(p1.y) + acc[1][3];
              u32x2 w; w.x = cvt_pk_bf16(v0, v1); w.y = cvt_pk_bf16(v2, v3); *(u32x2*)(op + 16) = w; qq += (v0 * v0 + v1 * v1) + (v2 * v2 + v3 * v3); }
            qq += shx(qq, 16, lane); qq += shx(qq, 32, lane);
            if (fq == 0) g.ssp[row * 32 + cgp * 2 + ch] = qq;
        }
        asm volatile("s_waitcnt vmcnt(0) lgkmcnt(0)" ::: "memory"); __builtin_amdgcn_s_barrier(); asm volatile("" ::: "memory");
    }
}

__device__ __forceinline__ void sgemm_act(LAS unsigned char* lds, const bf16_t* A, const bf16_t* Bt, bf16_t* Hs, const float* cfw, const float* scf, float* ocf, int ubase, int G, int wave, int tid) {
    const int lane = tid & 63, fr = lane & 15, fq = lane >> 4, rt = wave & 3, ch = wave >> 2;
    constexpr int nunits = (DFF / 64) * 4, nsl = D / 64, SLOT = 24576;
    int R, C; pg8::stage_rc(tid * 16, R, C);
    const unsigned off = (unsigned)(R * D + C) * 2u;
    const int aoff = pg8::lds_byte(rt * 16 + fr, fq * 8), boff = pg8::lds_byte(fr, fq * 8) + 8192 + ch * 8192;
    for (int un = ubase; un >= 0 && un < nunits; un += G) {
        const int fg = un >> 2, rg = un & 3, brow = ((fg >> 1) << 8) + ((fg & 1) << 6);
        const char* gA = (const char*)(A + (size_t)rg * 64 * D) + off; const char* gG = (const char*)(Bt + (size_t)brow * D) + off; const char* gU = (const char*)(Bt + (size_t)(brow + 128) * D) + off;
#define SGA_STAGE(sl) do { LAS unsigned char* d_ = lds + ((sl) & 3) * SLOT + wave * 1024; \
        __builtin_amdgcn_global_load_lds((const unsigned*)(gA + (size_t)(sl) * 128), (LAS unsigned*)d_, 16, 0, 0); \
        __builtin_amdgcn_global_load_lds((const unsigned*)(gG + (size_t)(sl) * 128), (LAS unsigned*)(d_ + 8192), 16, 0, 0); \
        __builtin_amdgcn_global_load_lds((const unsigned*)(gU + (size_t)(sl) * 128), (LAS unsigned*)(d_ + 16384), 16, 0, 0); } while (0)
        asm volatile("s_waitcnt vmcnt(0)" ::: "memory");
        SGA_STAGE(0); SGA_STAGE(1);
        f32x4 acc[4]; float q = 0.f;
#pragma unroll
        for (int c = 0; c < 4; ++c) acc[c] = (f32x4){0.f, 0.f, 0.f, 0.f};
        for (int sl = 0; sl < nsl; ++sl) {
            if (sl + 1 < nsl) asm volatile("s_waitcnt vmcnt(3)" ::: "memory"); else asm volatile("s_waitcnt vmcnt(0)" ::: "memory");
            __builtin_amdgcn_s_barrier(); asm volatile("" ::: "memory");
            if (sl + 2 < nsl) SGA_STAGE(sl + 2);
            LAS unsigned char* b_ = lds + (sl & 3) * SLOT;
#pragma unroll
            for (int ks = 0; ks < 2; ++ks) {
                const bf16x8 a = *(const LAS bf16x8*)(b_ + aoff + ks * 1024);
#pragma unroll
                for (int c = 0; c < 4; ++c) { const bf16x8 b = *(const LAS bf16x8*)(b_ + boff + c * 2048 + ks * 1024);
                    acc[c] = __builtin_amdgcn_mfma_f32_16x16x32_bf16(b, a, acc[c], 0, 0, 0); }
                q += sq8(a);
            }
        }
#undef SGA_STAGE
        q += shx(q, 16, lane); q += shx(q, 32, lane);
        const float rstd = 1.0f / sqrtf(q * (1.f / 1024.f) + EPS);
        asm volatile("s_waitcnt lgkmcnt(0)" ::: "memory"); __builtin_amdgcn_s_barrier(); asm volatile("" ::: "memory");
        LAS float* T = (LAS float*)(lds + ch * 20480);
#pragma unroll
        for (int c = 0; c < 4; ++c)
#pragma unroll
            for (int j = 0; j < 4; ++j) T[(rt * 16 + fr) * 65 + c * 16 + fq * 4 + j] = acc[c][j] * rstd;
        asm volatile("s_waitcnt lgkmcnt(0)" ::: "memory"); __builtin_amdgcn_s_barrier(); asm volatile("" ::: "memory");
        {
            const LAS float* Gt = (const LAS float*)lds; const LAS float* Ut = (const LAS float*)(lds + 20480);
            const int r = tid >> 3, f8 = (tid & 7) * 8, b = rg * 2 + (r >> 5), rr = r & 31, f = fg * 64 + f8;
            const float* st = scf + (size_t)(b * 2) * DFF + f;
            float hv[8], gv[8];
#pragma unroll
            for (int k = 0; k < 8; ++k) {
                const float g0 = Gt[r * 65 + f8 + k];
                const float gm1 = rr >= 1 ? Gt[(r - 1) * 65 + f8 + k] : st[DFF + k];
                const float gm2 = rr >= 2 ? Gt[(r - 2) * 65 + f8 + k] : (rr == 1 ? st[DFF + k] : st[k]);
                const float cv = cfw[f + k] * gm2 + cfw[DFF + f + k] * gm1 + cfw[2 * DFF + f + k] * g0;
                hv[k] = silu(cv) * Ut[r * 65 + f8 + k]; gv[k] = g0;
            }
            u32x4 w; w.x = pk2(hv[0], hv[1]); w.y = pk2(hv[2], hv[3]); w.z = pk2(hv[4], hv[5]); w.w = pk2(hv[6], hv[7]);
            *(u32x4*)(Hs + (size_t)(rg * 64 + r) * DFF + f) = w;
            if (rr >= 30) { float* o = ocf + ((size_t)b * 2 + (rr - 30)) * DFF + f; *(f32x4*)o = (f32x4){gv[0], gv[1], gv[2], gv[3]}; *(f32x4*)(o + 4) = (f32x4){gv[4], gv[5], gv[6], gv[7]}; }
        }
        asm volatile("s_waitcnt vmcnt(0) lgkmcnt(0)" ::: "memory"); __builtin_amdgcn_s_barrier(); asm volatile("" ::: "memory");
    }
}
__device__ __forceinline__ void sample_ss_reduce(const float* sss, float* ssq, int tid) {
    if (tid < 256) { const f32x4* p = (const f32x4*)(sss + tid * 32); float t = 0.f;
#pragma unroll
        for (int i = 0; i < 8; ++i) { const f32x4 v = p[i]; t += (v[0] + v[1]) + (v[2] + v[3]); }
        *(f32x4*)(ssq + (size_t)(MP + tid) * 4) = (f32x4){t, 0.f, 0.f, 0.f}; }
    asm volatile("s_waitcnt vmcnt(0)" ::: "memory"); __syncthreads();
}

__device__ __forceinline__ void transpose_item(const float* W, int K, int N, bf16_t* WT, LAS float* scr, int item, int lane, const float* gain = nullptr, int gu = 0) {
    const int nblk = N / 32, kb = item / nblk, nb = item % nblk, k0 = 64 * kb, n0 = 32 * nb;
    {
        f32x4 v[8];
#pragma unroll
        for (int i = 0; i < 8; ++i) v[i] = __builtin_nontemporal_load((const f32x4*)(W + (size_t)(k0 + (lane >> 3) + 8 * i) * N + n0 + (lane & 7) * 4));
#pragma unroll
        for (int i = 0; i < 8; ++i) { const int kk = (lane >> 3) + 8 * i; f32x4 w = v[i]; if (gain) w = w * gain[k0 + kk];
            LAS float* d = scr + kk * 33 + (lane & 7) * 4; d[0] = w[0]; d[1] = w[1]; d[2] = w[2]; d[3] = w[3]; }
    }
    LDS_WAIT();
    const int c = lane & 7;
#pragma unroll
    for (int j = 0; j < 4; ++j) { const int n = (lane >> 3) + 8 * j; const LAS float* s = scr + (8 * c) * 33 + n;
        u32x4 o; o.x = pk2(s[0 * 33], s[1 * 33]); o.y = pk2(s[2 * 33], s[3 * 33]); o.z = pk2(s[4 * 33], s[5 * 33]); o.w = pk2(s[6 * 33], s[7 * 33]);
        int drow = n0 + n; if (gu) { const int up = drow >= gu, f = up ? drow - gu : drow; drow = ((f >> 7) << 8) + (up << 7) + (f & 127); }
        *(u32x4*)(WT + (size_t)drow * K + k0 + 8 * c) = o; }
    LDS_WAIT();
}

__device__ __forceinline__ void first_rows(const float* Xp, const float* Xs, bf16_t* XNo, float* ss, int gw, int NGW, int lane) {
    for (int m0 = gw; m0 < MT; m0 += 2 * NGW) {
        const int m1 = m0 + NGW; const bool two = m1 < MT; const int mb = two ? m1 : m0;
        const f32x4* xa = (const f32x4*)(m0 < MP ? Xp + (size_t)m0 * D : Xs + (size_t)(m0 - MP) * D) + lane;
        const f32x4* xb = (const f32x4*)(mb < MP ? Xp + (size_t)mb * D : Xs + (size_t)(mb - MP) * D) + lane;
        f32x4 va[4], vb[4]; float sa = 0.f, sb = 0.f;
#pragma unroll
        for (int j = 0; j < 4; ++j) { va[j] = __builtin_nontemporal_load(xa + 64 * j); vb[j] = __builtin_nontemporal_load(xb + 64 * j); }
#pragma unroll
        for (int j = 0; j < 4; ++j) { sa += (va[j].x * va[j].x + va[j].y * va[j].y) + (va[j].z * va[j].z + va[j].w * va[j].w); sb += (vb[j].x * vb[j].x + vb[j].y * vb[j].y) + (vb[j].z * vb[j].z + vb[j].w * vb[j].w); }
        sa = wave_sum(sa, lane); sb = wave_sum(sb, lane);
        if (lane < 4) { ss[(size_t)m0 * 4 + lane] = lane == 0 ? sa : 0.f; if (two) ss[(size_t)m1 * 4 + lane] = lane == 0 ? sb : 0.f; }
        u32x2* oa = (u32x2*)(XNo + (size_t)m0 * D) + lane; u32x2* ob = (u32x2*)(XNo + (size_t)mb * D) + lane;
#pragma unroll
        for (int j = 0; j < 4; ++j) { u32x2 w; w.x = pk2(va[j].x, va[j].y); w.y = pk2(va[j].z, va[j].w); oa[64 * j] = w; if (two) { w.x = pk2(vb[j].x, vb[j].y); w.y = pk2(vb[j].z, vb[j].w); ob[64 * j] = w; } }
    }
}

typedef __attribute__((address_space(4))) const unsigned char* kptr_t;
typedef const float* cfp_t; typedef float* fp_t; typedef unsigned char* ucp_t;
#define INP(k) (*(const __attribute__((address_space(4))) cfp_t*)(kp + 8 * (k)))
#define X out
#define WIN_T ((bf16_t*)(ws + WS_WIN + wsel))
#define WOUT_T ((bf16_t*)(ws + WS_WOUT + wsel))
#define WQ_T ((bf16_t*)(ws + WS_WQ + wsel))
#define WK_T ((bf16_t*)(ws + WS_WK + wsel))
#define WV_T ((bf16_t*)(ws + WS_WV + wsel))
#define WO_T ((bf16_t*)(ws + WS_WO + wsel))
#define WUP_T ((bf16_t*)(ws + WS_WUP + wsel))
#define WDN_T ((bf16_t*)(ws + WS_WDN + wsel))
#define MEMB ((bf16_t*)(ws + WS_MEMB))
#define KBP ((bf16_t*)(ws + WS_KBP))
#define VTP ((bf16_t*)(ws + WS_VTP))
#define KBS ((bf16_t*)(ws + WS_KBS + ksel))
#define VTS ((bf16_t*)(ws + WS_VTS + ksel))
#define WST ((bf16_t*)(ws + WS_WST + ksel))
#define AGG ((float*)(ws + WS_AGG))
#define SSQ(i) ((float*)(ws + WS_SSP) + (size_t)(i) * MT * 4)
#define SSS(i) ((float*)(ws + WS_SSS) + (size_t)(i) * 256 * 32)
#define GT_R ((bf16_t*)(ws + WS_GT + ksel))
#define GT_I ((bf16_t*)(ws + WS_GT + 65536 + ksel))
#define XN ((bf16_t*)(ws + WS_XN))
#define gZ ((bf16_t*)(ws + B_Z))
#define HLOC ((bf16_t*)(ws + B_HLOC))
#define PCUM ((bf16_t*)(ws + B_PCUM))
#define gY ((bf16_t*)(ws + B_Y))
#define gQ ((bf16_t*)(ws + B_Q))
#define gP ((bf16_t*)(ws + B_P))
#define gO ((bf16_t*)(ws + B_O))
#define PS ((bf16_t*)(ws + B_PS))
#define GU ((bf16_t*)(ws + B_GU))
#define GUS ((bf16_t*)(ws + B_GUS))
#define SBG ((float*)(ws + B_SBG))
#define SBU ((float*)(ws + B_SBU))
#define SBL ((float*)(ws + B_SBL))
__device__ __forceinline__ void convert_layer(kptr_t kp, unsigned char* ws, LAS unsigned char* lds, const int l, const int part, const int nparts, const int gw, const int NGW, const int gt, const int NGT, const int lane, const int wave) {
            const size_t wsel = (size_t)(l & 1) * WSEL1, ksel = (size_t)(l & 1) * KSEL1;
            LAS float* scr = (LAS float*)(lds + wave * 16384);
            const float* w_in = INP(I_WIN) + (size_t)l * D * INC; const float* w_out = INP(I_WOUT) + (size_t)l * D * D; const float* w_q = INP(I_WQ) + (size_t)l * D * D;
            const float* w_k = INP(I_WK) + (size_t)l * D * D; const float* w_v = INP(I_WV) + (size_t)l * D * D; const float* w_o = INP(I_WO) + (size_t)l * D * D;
            const float* w_up = INP(I_WUP) + (size_t)l * D * 2 * DFF; const float* w_dn = INP(I_WDN) + (size_t)l * DFF * D; const float* c_v = INP(I_CV) + (size_t)l * BS * NMEM * D;
            constexpr int T_IN = 16 * (INC / 32), T_SQ = 16 * 32, T_UP = 16 * (2 * DFF / 32), T_DN = (DFF / 64) * 32, T_CV = 32 * 32;
            constexpr int T_G = 16;
            constexpr int NIT = T_IN + 5 * T_SQ + T_UP + T_DN + T_CV + 2 * T_G;
            for (int it = (NIT * part) / nparts + gw; it < (NIT * (part + 1)) / nparts; it += NGW) {
                int r = it;
                if (r < T_IN) { transpose_item(w_in, D, INC, WIN_T, scr, r, lane, INP(I_GMIX) + l * D); continue; } r -= T_IN;
                if (r < T_SQ) { transpose_item(w_out, D, D, WOUT_T, scr, r, lane); continue; } r -= T_SQ;
                if (r < T_SQ) { transpose_item(w_q, D, D, WQ_T, scr, r, lane, INP(I_GX) + l * D); continue; } r -= T_SQ;
                if (r < T_SQ) { transpose_item(w_k, D, D, WK_T, scr, r, lane); continue; } r -= T_SQ;
                if (r < T_SQ) { transpose_item(w_v, D, D, WV_T, scr, r, lane); continue; } r -= T_SQ;
                if (r < T_SQ) { transpose_item(w_o, D, D, WO_T, scr, r, lane); continue; } r -= T_SQ;
                if (r < T_UP) { transpose_item(w_up, D, 2 * DFF, WUP_T, scr, r, lane, INP(I_GFFN) + l * D, DFF); continue; } r -= T_UP;
                if (r < T_DN) { transpose_item(w_dn, DFF, D, WDN_T, scr, r, lane); continue; } r -= T_DN;
                if (r < T_CV) { transpose_item(c_v, BS * NMEM, D, VTS, scr, r, lane); continue; } r -= T_CV;
                if (r < T_G) { transpose_item(INP(I_WRG) + ((size_t)l * 8 + (r >> 1)) * 4096, 64, 64, GT_R + (r >> 1) * 4096, scr, r & 1, lane); continue; } r -= T_G;
                transpose_item(INP(I_WIG) + ((size_t)l * 8 + (r >> 1)) * 4096, 64, 64, GT_I + (r >> 1) * 4096, scr, r & 1, lane);
            }
            if (part == 0) {
                const f32x4* ck = (const f32x4*)(INP(I_CK) + (size_t)l * BS * NMEM * D); u32x2* dk = (u32x2*)KBS;
                for (int i = gt; i < BS * NMEM * D / 4; i += NGT) { const f32x4 v = ck[i]; u32x2 w; w.x = pk2(v.x, v.y); w.y = pk2(v.z, v.w); dk[i] = w; }
                if (l == 0) { const f32x4* mm = (const f32x4*)INP(I_MEM); u32x2* dm = (u32x2*)MEMB;
                    for (int i = gt; i < BP * NMEM * D / 4; i += NGT) { const f32x4 v = mm[i]; u32x2 w; w.x = pk2(v.x, v.y); w.y = pk2(v.z, v.w); dm[i] = w; } }
                const float* wsl = INP(I_WS) + (size_t)l * 4 * 128 * 128;
                for (int i = gt; i < 4 * 128 * 128; i += NGT) { const int s = i & 127, t = (i >> 7) & 127; WST[i] = (bf16_t)f2bf(s <= t ? wsl[i] : 0.f); }
            }
}

__global__ void __launch_bounds__(NTHREADS, 2) trunk_fwd(Args args) {
    extern __shared__ __attribute__((aligned(16))) unsigned char lds_raw[];
    LAS unsigned char* lds = (LAS unsigned char*)lds_raw;
    cg::grid_group grid = cg::this_grid();
    const int wave_s = __builtin_amdgcn_readfirstlane(threadIdx.x >> 6);
#define LANE_STATE() int G = gridDim.x, bid = blockIdx.x; asm volatile("" : "+s"(G), "+s"(bid)); const int NGW = G * NWAVES, NGT = G * NTHREADS; (void)NGW; (void)NGT; \
    const int tid = opaque_tid(wave_s), lane = tid & 63, wave = wave_s; const int gw = bid * NWAVES + wave; const int gt = bid * NTHREADS + tid; (void)lane; (void)gw; (void)gt; \
    kptr_t kp = (kptr_t)__builtin_amdgcn_kernarg_segment_ptr(); asm volatile("" : "+s"(kp)); \
    float* const out = *(const __attribute__((address_space(4))) fp_t*)(kp + 8 * N_IN); unsigned char* const ws = *(const __attribute__((address_space(4))) ucp_t*)(kp + 8 * N_IN + 8); (void)out; (void)ws
    {
        LANE_STATE();
        if (bid == 0) for (int i = tid; i < XCD_BAR_WORDS; i += NTHREADS) __hip_atomic_store((unsigned*)(ws + WS_BAR) + i, 0u, __ATOMIC_RELAXED, __HIP_MEMORY_SCOPE_AGENT);
        if (tid < 32) ((LAS unsigned*)(lds + LDS_MISC))[tid] = 0u;
        __threadfence();
        grid.sync();
        if (tid == 0) (void)xb_add((unsigned*)(ws + WS_BAR) + XB_XCNT(xb_xcc_id()), 1u);
    }
#define GRID_SYNC() do { kptr_t kp_ = (kptr_t)__builtin_amdgcn_kernarg_segment_ptr(); asm volatile("" : "+s"(kp_)); \
        XcdBarrier b_; b_.bar = (unsigned*)(*(const __attribute__((address_space(4))) ucp_t*)(kp_ + 8 * N_IN + 8) + WS_BAR); b_.x = xb_xcc_id(); b_.st = (volatile LAS unsigned*)(lds + LDS_MISC); \
        xcd_barrier(b_); if (PROBE == 3) xcd_barrier(b_); } while (0)

    for (int l = 0; l < DEPTH; ++l) {
        const size_t wsel = (size_t)(l & 1) * WSEL1, ksel = (size_t)(l & 1) * KSEL1;
        if (l == 0)
        for (int dup0 = 0; dup0 < ((PROBE == 1 || PROBE == 5) ? 2 : 1); ++dup0) {
        {
            LANE_STATE();
            convert_layer(kp, ws, lds, l, 0, 1, gw, NGW, gt, NGT, lane, wave);
            if (l == 0) first_rows(INP(I_XP), INP(I_XS), XN, SSQ(0), gw, NGW, lane);
        }
        GRID_SYNC();
        }
        {
            LANE_STATE();
            KVSched S; S.G = G; S.c = bid >= 160 ? bid - 160 : -1; S.ws = (const char*)ws; S.wsel = wsel;
            pg8::Gemm g{(const bf16_t*)nullptr, (const bf16_t*)nullptr, D, D, D};
            pg8::EpiKV E{out + O_MKP + (size_t)l * BP * NMEM * D, out + O_MVP + (size_t)l * BP * NMEM * D, KBP, VTP};
            pg8::gemm_phase<pg8::EpiKV, KVSched, true>(lds, g, S, E, wave_s);
        }
#define GEMM_BF16(s_) do { const int s = (s_); pg8::GSched S; pg8::Gemm g; pg8::EpiBf16 E; E.scale = 1.f; E.ss = nullptr; E.smp = 0; \
        if (s == 0) { S.init(MT / 256, INC / 256, G, bid); S.aPm = (size_t)256 * D * 2; S.bPn = (size_t)256 * D * 2; g = pg8::Gemm{XN, WIN_T, D, D, D}; E.O = gZ; E.ldc = INC; E.ss = SSQ(3 * l); } \
        else if (s == 1) { S.init(MP / 256, D / 256, G, bid); S.aPm = (size_t)256 * D * 2; S.bPn = (size_t)256 * D * 2; g = pg8::Gemm{XN, WQ_T, D, D, D}; E.O = gQ; E.ldc = D; E.scale = 0.0625f; E.ss = SSQ(3 * l + 1); } \
        else if (s == 2) { S.init(MP / 256, 4, G, bid); S.aPm = (size_t)256 * D * 2; S.aPn = 512; S.bPn = (size_t)256 * 2048 * 2; S.bPm = 512; S.bShift = 4; g = pg8::Gemm{gP, VTP, D, 2048, 256}; E.O = gO; E.ldc = D; } \
        else { S.init(1, 32, G, (bid + G - 64) % G); S.mode = 2; g = pg8::Gemm{PS, VTS, 8192, 2048, 256}; E.O = gO + (size_t)MP * D; E.ldc = D; E.smp = 1; } \
        pg8::gemm_phase<pg8::EpiBf16, pg8::GSched, true>(lds, g, S, E, wave_s); } while (0)
#define GEMM_RES(s_) do { const int s = (s_); pg8::GSched S; S.init(MP / 256, D / 256, G, bid); pg8::Gemm g; \
        if (s == 0) { g = pg8::Gemm{gY, WOUT_T, D, D, D}; S.aPm = (size_t)256 * D * 2; } \
        else if (s == 1) { g = pg8::Gemm{gO, WO_T, D, D, D}; S.aPm = (size_t)256 * D * 2; } \
        else { g = pg8::Gemm{GU, WDN_T, DFF, DFF, DFF}; S.aPm = (size_t)256 * DFF * 2; } \
        S.bPn = (size_t)256 * g.ldb * 2; \
        pg8::EpiResid E{XN, SSQ(3 * l + 1 + s)}; \
        pg8::gemm_phase<pg8::EpiResid, pg8::GSched, true>(lds, g, S, E, wave_s); } while (0)

        for (int rep = 0; rep < 13; ++rep) { if (rep == 4 || rep == 9 || rep == 11) continue;
          const int ndup = ((PROBE == 1 && (rep == 1 || rep == 2)) || (PROBE == 4 && rep == 1) || (PROBE == 6 && rep == 2)) ? 2 : ((PROBE == 2 && (rep == 0 || rep == 5 || rep == 6 || rep == 7 || rep == 10)) ? 2 : 1);
          for (int dup = 0; dup < ndup; ++dup) {
            if (rep == 0 || rep == 5 || rep == 7) {
                LANE_STATE();
                const int s0 = rep == 0 ? 0 : (rep == 5 ? 1 : 2), ns = rep == 7 ? 2 : 1;
                if (rep == 0 && l > 0) {
                    pg8::GSched S0; S0.init(MT / 256, INC / 256, G, bid); pg8::Unit u0; bool own = false;
                    for (int i = 0; S0.next(i, u0); ++i) own = own || (u0.pm == 128);
                    if (own) sample_ss_reduce(SSS(3 * l), SSQ(3 * l), tid);
                }
                for (int q = 0; q < ns; ++q) GEMM_BF16(s0 + q);
                if (rep == 5) { LANE_STATE(); const SG2 sg{XN + (size_t)MP * D, WQ_T, D, D, D, D, gQ + (size_t)MP * D, D, 0.0625f, 1, nullptr}; sgemm2(lds, sg, bid, G, wave, tid); }
                if (rep == 5 && l + 1 < DEPTH) { LANE_STATE(); if (bid >= 64) convert_layer(kp, ws, lds, l + 1, 1, 4, gw - 64 * NWAVES, NGW - 64 * NWAVES, gt - 64 * NTHREADS, NGT - 64 * NTHREADS, lane, wave); }
            } else if (rep == 10) {
                LANE_STATE();
                pg8::GSched S; S.init(MP / 256, 2 * DFF / 256, G, bid); S.aPm = (size_t)256 * D * 2; S.bPn = (size_t)256 * D * 2;
                const pg8::Gemm g{XN, WUP_T, D, D, D};
                const pg8::EpiAct E{GU, INP(I_SCF) + (size_t)l * BS * 2 * DFF, out + O_CFS + (size_t)l * BS * 2 * DFF, SBG, SBU, SBL, INP(I_CFW) + (size_t)l * 3 * DFF, SSQ(3 * l + 2)};
                pg8::gemm_phase<pg8::EpiAct, pg8::GSched, true>(lds, g, S, E, wave_s);
                { LANE_STATE(); sgemm_act(lds, XN + (size_t)MP * D, WUP_T, GU + (size_t)MP * DFF, INP(I_CFW) + (size_t)l * 3 * DFF, INP(I_SCF) + (size_t)l * BS * 2 * DFF, out + O_CFS + (size_t)l * BS * 2 * DFF, bid, G, wave, tid); }
            } else if (rep == 1) {
                LANE_STATE();
                {
                    LAS bf16_t* vT = (LAS bf16_t*)lds;
                    constexpr int VP = 136;
                    const float* gvp = INP(I_GV) + l * CW; const float* bsp = INP(I_BSS) + l * 4 * 128;
                    for (int un = (bid + G / 2) % G; un < 8 + 256; un += G) {
                        int rowbase, nrows, sb = -1;
                        if (un < 8) { sb = un; rowbase = MP + un * TS; nrows = TS; } else { rowbase = (un - 8) * 128; nrows = 128; }
                        {
                            const int rl = tid >> 5, cgp = tid & 31;
                            f32x4 g0 = *(const f32x4*)(gvp + cgp * 8), g1 = *(const f32x4*)(gvp + cgp * 8 + 4);
                            for (int p = 0; p < nrows / 16; ++p) {
                                const int r = p * 16 + rl;
                                const u32x4 raw = *(const u32x4*)(gZ + (size_t)(rowbase + r) * INC + Z_VC + cgp * 8);
                                float v[8] = {bflo(raw.x), bfhi(raw.x), bflo(raw.y), bfhi(raw.y), bflo(raw.z), bfhi(raw.z), bflo(raw.w), bfhi(raw.w)};
                                float ss = 0.f;
#pragma unroll
                                for (int k = 0; k < 8; ++k) { v[k] = gelu_t(v[k]); ss += v[k] * v[k]; }
                                ss += shx(ss, 1, lane); ss += shx(ss, 2, lane); ss += shx(ss, 4, lane);
                                const float rstd = __builtin_amdgcn_rsqf(ss * (1.f / 64.f) + EPS);
                                const float gg[8] = {g0.x, g0.y, g0.z, g0.w, g1.x, g1.y, g1.z, g1.w};
#pragma unroll
                                for (int k = 0; k < 8; ++k) { v[k] = v[k] * rstd * gg[k]; vT[(cgp * 8 + k) * VP + r] = (bf16_t)f2bf(v[k]); }
                                if (sb >= 0) { float* vo = out + O_VCS + ((size_t)(l * BS + sb) * TS + r) * CW + cgp * 8;
                                    *(f32x4*)vo = (f32x4){v[0], v[1], v[2], v[3]}; *(f32x4*)(vo + 4) = (f32x4){v[4], v[5], v[6], v[7]}; }
                            }
                        }
                        __syncthreads();
                        {
                            const int hh = wave & 3, rh = wave >> 2, fr = lane & 15, fq = lane >> 4;
                            const int nmt = nrows == 128 ? 4 : (rh == 0 ? 2 : 0);
                            for (int mi = 0; mi < nmt; ++mi) {
                                const int mt = rh * 4 + mi, nks = (mt * 16 + 15) / 32 + 1;
                                f32x4 acc[4];
#pragma unroll
                                for (int n = 0; n < 4; ++n) acc[n] = (f32x4){0.f, 0.f, 0.f, 0.f};
                                for (int ks = 0; ks < nks; ++ks) {
                                    const bf16x8 a = *(const bf16x8*)(WST + ((size_t)(hh * 128 + mt * 16 + fr) * 128 + ks * 32 + fq * 8));
#pragma unroll
                                    for (int n = 0; n < 4; ++n) { const bf16x8 b = *(const LAS bf16x8*)(vT + (hh * 64 + n * 16 + fr) * VP + ks * 32 + fq * 8);
                                        acc[n] = __builtin_amdgcn_mfma_f32_16x16x32_bf16(b, a, acc[n], 0, 0, 0); }
                                }
                                { const int t = mt * 16 + fr; const float bias = bsp[hh * 128 + t]; const size_t row = (size_t)(rowbase + t);
#pragma unroll
                                    for (int n = 0; n < 4; ++n) { const int c = hh * 64 + n * 16 + fq * 4; const u32x2 uq = *(const u32x2*)(gZ + row * INC + Z_UC + c);
                                        u32x2 w; w.x = pk2(gelu_t(bflo(uq.x)) * (acc[n][0] + bias), gelu_t(bfhi(uq.x)) * (acc[n][1] + bias)); w.y = pk2(gelu_t(bflo(uq.y)) * (acc[n][2] + bias), gelu_t(bfhi(uq.y)) * (acc[n][3] + bias));
                                        *(u32x2*)(gY + row * D + 768 + c) = w; } }
                            }
                        }
                        __syncthreads();
                    }
                }
                {
                    LAS unsigned char* wl = lds + wave * 16384;
                    LAS bf16_t* tile = (LAS bf16_t*)wl;
                    LAS float* pre_r = (LAS float*)(wl + 2560);
                    LAS float* pre_i = (LAS float*)(wl + 2560 + 4096);
                    LAS float* xcf = (LAS float*)(wl + 2560 + 8192);
                    const int fr = lane & 15, fq = lane >> 4;
                    for (int un = gw; un < 64 + 2048; un += NGW) {
                        int b, hd, rowbase, nrows, t0; bool smp = un < 64;
                        if (smp) { b = un >> 3; hd = un & 7; rowbase = MP + b * TS; nrows = TS; t0 = 0; }
                        else { const int v = un - 64; const int ch = v & 31; hd = (v >> 5) & 7; b = v >> 8; t0 = ch * 128; rowbase = b * SEQ + t0; nrows = 128; }
                        const int cidx = l * AW + hd * 64 + lane;
                        const float br = INP(I_BRG)[cidx], bi = INP(I_BIG)[cidx];
                        const float c8sp = 8.0f * log1pf(__expf(-INP(I_LAM)[cidx]));
                        const float* caw = INP(I_CAW) + (size_t)l * 4 * AW + hd * 64 + lane;
                        const float cw0 = caw[0], cw1 = caw[AW], cw2 = caw[2 * AW], cw3 = caw[3 * AW], cb = INP(I_CAB)[cidx];
                        bf16x8 bR[4][2], bI[4][2];
#pragma unroll
                        for (int n = 0; n < 4; ++n)
#pragma unroll
                            for (int ks = 0; ks < 2; ++ks) { const size_t o_ = (size_t)(hd * 64 + n * 16 + fr) * 64 + ks * 32 + fq * 8;
                                bR[n][ks] = *(const bf16x8*)(GT_R + o_); bI[n][ks] = *(const bf16x8*)(GT_I + o_); }
                        float xm3 = 0.f, xm2 = 0.f, xm1 = 0.f;
                        if (smp) { const float* st = INP(I_SCA) + ((size_t)(l * BS + b) * 3) * AW + hd * 64 + lane; xm3 = st[0]; xm2 = st[AW]; xm1 = st[2 * AW]; }
                        else if (t0 > 0) { const bf16_t* zp = gZ + (size_t)(rowbase - 3) * INC + Z_XA + hd * 64 + lane; xm3 = bf2f(zp[0]); xm2 = bf2f(zp[INC]); xm1 = bf2f(zp[2 * INC]); }
                        float h = 0.f, pc = 1.f;
                        const bf16_t* zq = gZ + (size_t)(rowbase + (lane >> 3)) * INC + Z_XA + hd * 64 + (lane & 7) * 8;
                        unsigned* hp = (unsigned*)(HLOC + (size_t)rowbase * AW + hd * 64 + (lane & ~1)); unsigned* pp = (unsigned*)(PCUM + (size_t)rowbase * AW + hd * 64 + (lane & ~1));
                        LAS bf16_t* xraw = (LAS bf16_t*)pre_r;
                        u32x4 xn0 = *(const u32x4*)zq, xn1 = *(const u32x4*)(zq + (size_t)8 * INC);
                        for (int st = 0; st < nrows / 16; ++st) {
                            *(LAS u32x4*)(xraw + (lane >> 3) * 64 + (lane & 7) * 8) = xn0; *(LAS u32x4*)(xraw + ((lane >> 3) + 8) * 64 + (lane & 7) * 8) = xn1;
                            zq += (size_t)16 * INC;
                            if (st + 1 < nrows / 16) { xn0 = *(const u32x4*)zq; xn1 = *(const u32x4*)(zq + (size_t)8 * INC); }
                            LDS_WAIT();
#pragma unroll
                            for (int i = 0; i < 16; ++i) { const float xv = bf2f(xraw[i * 64 + lane]);
                                const float xc = cw0 * xm3 + cw1 * xm2 + cw2 * xm1 + cw3 * xv + cb; xm3 = xm2; xm2 = xm1; xm1 = xv; xcf[i * 64 + lane] = xc; tile[i * 72 + lane] = (bf16_t)f2bf(xc); }
                            LDS_WAIT();
                            const bf16x8 a0 = *(const LAS bf16x8*)(tile + fr * 72 + fq * 8), a1 = *(const LAS bf16x8*)(tile + fr * 72 + 32 + fq * 8);
#pragma unroll
                            for (int n = 0; n < 4; ++n) {
                                f32x4 ar = (f32x4){0.f, 0.f, 0.f, 0.f}, ai = (f32x4){0.f, 0.f, 0.f, 0.f};
                                ar = __builtin_amdgcn_mfma_f32_16x16x32_bf16(a0, bR[n][0], ar, 0, 0, 0); ar = __builtin_amdgcn_mfma_f32_16x16x32_bf16(a1, bR[n][1], ar, 0, 0, 0);
                                ai = __builtin_amdgcn_mfma_f32_16x16x32_bf16(a0, bI[n][0], ai, 0, 0, 0); ai = __builtin_amdgcn_mfma_f32_16x16x32_bf16(a1, bI[n][1], ai, 0, 0, 0);
#pragma unroll
                                for (int j = 0; j < 4; ++j) { pre_r[(fq * 4 + j) * 64 + n * 16 + fr] = ar[j]; pre_i[(fq * 4 + j) * 64 + n * 16 + fr] = ai[j]; }
                            }
                            LDS_WAIT();
#pragma unroll 4
                            for (int i = 0; i < 16; ++i) {
                                const float r = sigm(pre_r[i * 64 + lane] + br), gi = sigm(pre_i[i * 64 + lane] + bi);
                                const float la = -c8sp * r; float a, om;
                                if (la > -0.125f) { const float x = 2.0f * la; om = -x * (1.0f + x * (0.5f + x * (0.16666667f + x * (0.041666668f + x * (0.0083333338f + x * 0.0013888889f))))); a = 1.0f + la * (1.0f + la * (0.5f + la * (0.16666667f + la * (0.041666668f + la * 0.0083333338f)))); }
                                else { a = __expf(la); om = -expm1f(2.0f * la); }
                                const float bm = __builtin_amdgcn_sqrtf(om);
                                h = a * h + bm * gi * xcf[i * 64 + lane]; pc = pc * a;
                                { const float hn = __builtin_bit_cast(float, __builtin_amdgcn_mov_dpp(__builtin_bit_cast(int, h), 0xB1, 0xf, 0xf, true)), pn = __builtin_bit_cast(float, __builtin_amdgcn_mov_dpp(__builtin_bit_cast(int, pc), 0xB1, 0xf, 0xf, true));
                                  if ((lane & 1) == 0) { *hp = pk2(h, hn); *pp = pk2(pc, pn); } hp += AW / 2; pp += AW / 2; }
                            }
                            LDS_WAIT();
                        }
                        AGG[(size_t)un * 128 + lane] = pc; AGG[(size_t)un * 128 + 64 + lane] = h;
                    }
                }
                {
                    const float* cbw = INP(I_CBW) + (size_t)l * 3 * BW;
                    if (bid >= 8) for (int it = gt - 8 * NTHREADS; it < (MT / 8) * 32; it += NGT - 8 * NTHREADS) {
                        const int rb = it >> 5, c0 = (it & 31) * 8;
                        int b, t0, T, rowbase; const bool smp = rb >= MP / 8;
                        if (!smp) { b = rb >> 9; t0 = (rb & 511) * 8; T = SEQ; rowbase = rb * 8; } else { const int sbk = rb - MP / 8; b = sbk >> 2; t0 = (sbk & 3) * 8; T = TS; rowbase = MP + sbk * 8; }
                        u32x4 xq[10], cq[10], bq[8];
                        const bf16_t* zr = gZ + (size_t)rowbase * INC + c0;
#pragma unroll
                        for (int i = 0; i < 10; ++i) { if (i >= 2 || t0 > 0) { xq[i] = __builtin_nontemporal_load((const u32x4*)(zr + (ptrdiff_t)(i - 2) * INC + Z_XB)); cq[i] = __builtin_nontemporal_load((const u32x4*)(zr + (ptrdiff_t)(i - 2) * INC + Z_GC)); } else { xq[i] = (u32x4){0u, 0u, 0u, 0u}; cq[i] = (u32x4){0u, 0u, 0u, 0u}; } }
#pragma unroll
                        for (int i = 0; i < 8; ++i) bq[i] = __builtin_nontemporal_load((const u32x4*)(zr + (size_t)i * INC + Z_GB));
                        float w0[8], w1[8], w2[8], pm2[8], pm1[8];
#pragma unroll
                        for (int k = 0; k < 8; ++k) { w0[k] = cbw[c0 + k]; w1[k] = cbw[BW + c0 + k]; w2[k] = cbw[2 * BW + c0 + k]; }
                        {
                            const float a_[8] = {bflo(xq[0].x) * bflo(cq[0].x), bfhi(xq[0].x) * bfhi(cq[0].x), bflo(xq[0].y) * bflo(cq[0].y), bfhi(xq[0].y) * bfhi(cq[0].y), bflo(xq[0].z) * bflo(cq[0].z), bfhi(xq[0].z) * bfhi(cq[0].z), bflo(xq[0].w) * bflo(cq[0].w), bfhi(xq[0].w) * bfhi(cq[0].w)};
                            const float b_[8] = {bflo(xq[1].x) * bflo(cq[1].x), bfhi(xq[1].x) * bfhi(cq[1].x), bflo(xq[1].y) * bflo(cq[1].y), bfhi(xq[1].y) * bfhi(cq[1].y), bflo(xq[1].z) * bflo(cq[1].z), bfhi(xq[1].z) * bfhi(cq[1].z), bflo(xq[1].w) * bflo(cq[1].w), bfhi(xq[1].w) * bfhi(cq[1].w)};
#pragma unroll
                            for (int k = 0; k < 8; ++k) { pm2[k] = a_[k]; pm1[k] = b_[k]; }
                        }
                        if (t0 == 0 && smp) { const float* st = INP(I_SCB) + ((size_t)(l * BS + b) * 2) * BW + c0;
#pragma unroll
                            for (int k = 0; k < 8; ++k) { pm2[k] = st[k]; pm1[k] = st[BW + k]; } }
#pragma unroll
                        for (int i = 0; i < 8; ++i) {
                            const u32x4 xb = xq[i + 2], gc = cq[i + 2], gb = bq[i];
                            const float pv[8] = {bflo(xb.x) * bflo(gc.x), bfhi(xb.x) * bfhi(gc.x), bflo(xb.y) * bflo(gc.y), bfhi(xb.y) * bfhi(gc.y), bflo(xb.z) * bflo(gc.z), bfhi(xb.z) * bfhi(gc.z), bflo(xb.w) * bflo(gc.w), bfhi(xb.w) * bfhi(gc.w)};
                            const float gbv[8] = {bflo(gb.x), bfhi(gb.x), bflo(gb.y), bfhi(gb.y), bflo(gb.z), bfhi(gb.z), bflo(gb.w), bfhi(gb.w)};
                            float yv[8];
#pragma unroll
                            for (int k = 0; k < 8; ++k) { yv[k] = gbv[k] * (w0[k] * pm2[k] + w1[k] * pm1[k] + w2[k] * pv[k]); pm2[k] = pm1[k]; pm1[k] = pv[k]; }
                            u32x4 w; w.x = pk2(yv[0], yv[1]); w.y = pk2(yv[2], yv[3]); w.z = pk2(yv[4], yv[5]); w.w = pk2(yv[6], yv[7]);
                            *(u32x4*)(gY + (size_t)(rowbase + i) * D + 512 + c0) = w;
                        }
                        if (t0 + 8 == T) { float* o = out + (smp ? O_CBS : O_CBP) + ((size_t)(l * 8 + b) * 2) * BW + c0;
#pragma unroll
                            for (int k = 0; k < 8; ++k) { o[k] = pm2[k]; o[BW + k] = pm1[k]; } }
                    }
                }
            } else if (rep == 2) {
                LANE_STATE();
                {
                    LAS float* cr = (LAS float*)lds;
                    for (int un = bid; un < 8 + 256; un += G) {
                        int b, ch, rowbase, nrows; const bool smp = un < 8;
                        if (smp) { b = un; ch = 0; rowbase = MP + b * TS; nrows = TS; } else { const int v = un - 8; b = v >> 5; ch = v & 31; rowbase = b * SEQ + ch * 128; nrows = 128; }
                        {
                            const int c = tid, hd = c >> 6, ln = c & 63; float carry = 0.f;
                            if (smp) carry = INP(I_SHA)[(size_t)(l * BS + b) * AW + c];
                            else { const float* ag = AGG + (size_t)(64 + (b << 8) + (hd << 5)) * 128 + ln; for (int k = 0; k < ch; ++k) carry = ag[(size_t)k * 128] * carry + ag[(size_t)k * 128 + 64]; }
                            cr[c] = carry;
                        }
                        __syncthreads();
                        const int c0 = (tid & 63) * 8, rsub = tid >> 6;
                        const f32x4 ca = *(const LAS f32x4*)(cr + c0), cb = *(const LAS f32x4*)(cr + c0 + 4);
                        for (int p4 = 0; p4 < nrows / 8; p4 += 4) {
                            u32x4 hqv[4], pqv[4], gqv[4];
#pragma unroll
                            for (int q = 0; q < 4; ++q) { const size_t row = (size_t)(rowbase + (p4 + q) * 8 + rsub); hqv[q] = __builtin_nontemporal_load((const u32x4*)(HLOC + row * AW + c0)); pqv[q] = __builtin_nontemporal_load((const u32x4*)(PCUM + row * AW + c0)); gqv[q] = __builtin_nontemporal_load((const u32x4*)(gZ + row * INC + Z_GA + c0)); }
#pragma unroll
                            for (int q = 0; q < 4; ++q) {
                                const int rloc = (p4 + q) * 8 + rsub; const size_t row = (size_t)(rowbase + rloc);
                                const u32x4 hq = hqv[q], pq = pqv[q], gq = gqv[q];
                                const f32x4 h0 = (f32x4){bflo(hq.x), bfhi(hq.x), bflo(hq.y), bfhi(hq.y)}, h1 = (f32x4){bflo(hq.z), bfhi(hq.z), bflo(hq.w), bfhi(hq.w)}, p0 = (f32x4){bflo(pq.x), bfhi(pq.x), bflo(pq.y), bfhi(pq.y)}, p1 = (f32x4){bflo(pq.z), bfhi(pq.z), bflo(pq.w), bfhi(pq.w)};
                                const f32x4 a0 = h0 + p0 * ca, a1 = h1 + p1 * cb;
                                u32x4 w; w.x = pk2(gelu_t(bflo(gq.x)) * a0[0], gelu_t(bfhi(gq.x)) * a0[1]); w.y = pk2(gelu_t(bflo(gq.y)) * a0[2], gelu_t(bfhi(gq.y)) * a0[3]);
                                w.z = pk2(gelu_t(bflo(gq.z)) * a1[0], gelu_t(bfhi(gq.z)) * a1[1]); w.w = pk2(gelu_t(bflo(gq.w)) * a1[2], gelu_t(bfhi(gq.w)) * a1[3]);
                                *(u32x4*)(gY + row * D + c0) = w;
                                if ((smp || ch == 31) && rloc == nrows - 1) { float* o = out + (smp ? O_HAS : O_HAP) + (size_t)(l * 8 + b) * AW + c0; *(f32x4*)o = a0; *(f32x4*)(o + 4) = a1; }
                            }
                        }
                        if ((smp || ch == 31) && tid < 192) {
                            const int k = tid >> 6; const u32x4 xq = *(const u32x4*)(gZ + (size_t)(rowbase + nrows - 3 + k) * INC + Z_XA + c0);
                            float* o = out + (smp ? O_CAS : O_CAP) + ((size_t)(l * 8 + b) * 3 + k) * AW + c0;
                            *(f32x4*)o = (f32x4){bflo(xq.x), bfhi(xq.x), bflo(xq.y), bfhi(xq.y)}; *(f32x4*)(o + 4) = (f32x4){bflo(xq.z), bfhi(xq.z), bflo(xq.w), bfhi(xq.w)};
                        }
                        __syncthreads();
                    }
                }
            } else if (rep == 3 || rep == 8 || rep == 12) {
                LANE_STATE();
                if (rep == 12) {
                    const float* cfw = INP(I_CFW) + (size_t)l * 3 * DFF;
                    pg8::GSched S0; S0.init(MP / 256, D / 256, G, bid); pg8::Unit u0;
                    for (int i = 0; S0.next(i, u0); ++i) {
                        const int pm = u0.pm; if (pm >= 128 || tid >= DFF / 8) continue;
                        const int c0 = tid * 8, b = pm >> 4;
                        float w0[8], w1[8], w2[8], p2[8], p1[8], g0[8], g1[8], u0_[8], u1_[8];
#pragma unroll
                        for (int k = 0; k < 8; ++k) { w0[k] = cfw[c0 + k]; w1[k] = cfw[DFF + c0 + k]; w2[k] = cfw[2 * DFF + c0 + k]; p2[k] = 0.f; p1[k] = 0.f; }
                        if ((pm & 15) != 0) {
#pragma unroll
                            for (int k = 0; k < 8; ++k) { p2[k] = SBL[((size_t)(pm - 1) * 2 + 0) * DFF + c0 + k]; p1[k] = SBL[((size_t)(pm - 1) * 2 + 1) * DFF + c0 + k]; } }
#pragma unroll
                        for (int k = 0; k < 8; ++k) { g0[k] = SBG[((size_t)pm * 2 + 0) * DFF + c0 + k]; g1[k] = SBG[((size_t)pm * 2 + 1) * DFF + c0 + k]; u0_[k] = SBU[((size_t)pm * 2 + 0) * DFF + c0 + k]; u1_[k] = SBU[((size_t)pm * 2 + 1) * DFF + c0 + k]; }
                        float ha[8], hb[8];
#pragma unroll
                        for (int k = 0; k < 8; ++k) { ha[k] = silu(w0[k] * p2[k] + w1[k] * p1[k] + w2[k] * g0[k]) * u0_[k]; hb[k] = silu(w0[k] * p1[k] + w1[k] * g0[k] + w2[k] * g1[k]) * u1_[k]; }
                        u32x4 w; w.x = pk2(ha[0], ha[1]); w.y = pk2(ha[2], ha[3]); w.z = pk2(ha[4], ha[5]); w.w = pk2(ha[6], ha[7]);
                        *(u32x4*)(GU + (size_t)(pm * 256) * DFF + c0) = w;
                        w.x = pk2(hb[0], hb[1]); w.y = pk2(hb[2], hb[3]); w.z = pk2(hb[4], hb[5]); w.w = pk2(hb[6], hb[7]);
                        *(u32x4*)(GU + (size_t)(pm * 256 + 1) * DFF + c0) = w;
                        if ((pm & 15) == 15 && u0.pn == 0) { float* o = out + O_CFP + ((size_t)(l * 8 + b) * 2) * DFF + c0;
#pragma unroll
                            for (int k = 0; k < 8; ++k) { o[k] = SBL[((size_t)pm * 2 + 0) * DFF + c0 + k]; o[DFF + k] = SBL[((size_t)pm * 2 + 1) * DFF + c0 + k]; } }
                    }
                    asm volatile("s_waitcnt vmcnt(0)" ::: "memory"); __syncthreads();
                }
                GEMM_RES(rep == 3 ? 0 : (rep == 8 ? 1 : 2));
                { LANE_STATE();
                  const SG2 sg{rep == 12 ? GU + (size_t)MP * DFF : (rep == 3 ? gY : gO) + (size_t)MP * D, rep == 12 ? WDN_T : (rep == 3 ? WOUT_T : WO_T), rep == 12 ? DFF : D, rep == 12 ? DFF : D, rep == 12 ? DFF : D, D, XN + (size_t)MP * D, D, 1.f, 2, SSS(3 * l + (rep == 3 ? 1 : (rep == 8 ? 2 : 3)))};
                  sgemm2(lds, sg, bid, G, wave, tid); }
                if (l + 1 < DEPTH) { LANE_STATE(); if (bid >= 64) convert_layer(kp, ws, lds, l + 1, rep == 3 ? 0 : (rep == 8 ? 2 : 3), 4, gw - 64 * NWAVES, NGW - 64 * NWAVES, gt - 64 * NTHREADS, NGT - 64 * NTHREADS, lane, wave); }
            } else if (rep == 6) {
                LANE_STATE();
                for (int sub = 0; sub < 2; ++sub) {
                    pg8::GSched S; pg8::Gemm g; pg8::EpiSoftmax E;
                    if (sub == 0) { S.init(MP / 256, 4, G, bid); S.aPm = (size_t)256 * D * 2; S.aPn = 512; S.bPn = 512; S.bPm = (size_t)256 * D * 2; S.bShift = 4; g = pg8::Gemm{gQ, KBP, D, D, 256}; E.O = gP; E.ldc = D; E.smp = 0; }
                    else { S.init(1, 32, G, (bid + G - 64) % G); S.mode = 1; g = pg8::Gemm{gQ + (size_t)MP * D, KBS, D, D, 256}; E.O = PS; E.ldc = 8192; E.smp = 1; }
                    pg8::gemm_phase<pg8::EpiSoftmax, pg8::GSched, true>(lds, g, S, E, wave_s);
                }
            }
            if (rep == 6) { asm volatile("s_waitcnt vmcnt(0)" ::: "memory"); __syncthreads(); }
            else GRID_SYNC();
          }
        }
    }
    {
        LANE_STATE();
        const float* gain = INP(I_GFIN);
        f32x4 gv[4];
#pragma unroll
        for (int j = 0; j < 4; ++j) gv[j] = ((const f32x4*)gain)[lane + 64 * j];
        for (int m0 = gw; m0 < MT; m0 += 2 * NGW) {
            const int m1 = m0 + NGW; const bool two = m1 < MT; const int mb = two ? m1 : m0;
            const u32x2* xa = (const u32x2*)(XN + (size_t)m0 * D) + lane; const u32x2* xb = (const u32x2*)(XN + (size_t)mb * D) + lane;
            u32x2 pa[4], pb[4];
#pragma unroll
            for (int j = 0; j < 4; ++j) { pa[j] = __builtin_nontemporal_load(xa + 64 * j); pb[j] = __builtin_nontemporal_load(xb + 64 * j); }
            float ra, rb;
            { float qa = 0.f, qb = 0.f;
#pragma unroll
              for (int j = 0; j < 4; ++j) { const float a0 = bflo(pa[j].x), a1 = bfhi(pa[j].x), a2 = bflo(pa[j].y), a3 = bfhi(pa[j].y), b0 = bflo(pb[j].x), b1 = bfhi(pb[j].x), b2 = bflo(pb[j].y), b3 = bfhi(pb[j].y);
                  qa += (a0 * a0 + a1 * a1) + (a2 * a2 + a3 * a3); qb += (b0 * b0 + b1 * b1) + (b2 * b2 + b3 * b3); }
              if (m0 < MP) ra = ss_rstd(*(const f32x4*)(SSQ(6) + (size_t)m0 * 4)); else ra = 1.0f / sqrtf(wave_sum(qa, lane) * (1.f / D) + EPS);
              if (mb < MP) rb = ss_rstd(*(const f32x4*)(SSQ(6) + (size_t)mb * 4)); else rb = 1.0f / sqrtf(wave_sum(qb, lane) * (1.f / D) + EPS); }
            f32x4* ya = (f32x4*)(out + (size_t)m0 * D) + lane; f32x4* yb = (f32x4*)(out + (size_t)mb * D) + lane;
#pragma unroll
            for (int j = 0; j < 4; ++j) { __builtin_nontemporal_store((f32x4){bflo(pa[j].x), bfhi(pa[j].x), bflo(pa[j].y), bfhi(pa[j].y)} * ra * gv[j], ya + 64 * j); if (two) __builtin_nontemporal_store((f32x4){bflo(pb[j].x), bfhi(pb[j].x), bflo(pb[j].y), bfhi(pb[j].y)} * rb * gv[j], yb + 64 * j); }
        }
    }
}

extern "C" void kernel_launch(void* const* d_in, const int* in_sizes, int n_in, void* d_out, int out_size, void* d_ws, size_t ws_size, hipStream_t stream) {
    static int grid = 0;
    if (grid == 0) {
        if (n_in != N_IN || (size_t)out_size != O_END || ws_size < 512 * MiB) { fprintf(stderr, "kernel_launch: unexpected sizes n_in %d out %d ws %zu (need %zu)\n", n_in, out_size, ws_size, (size_t)(512 * MiB)); grid = -1; return; }
        int dev = 0, cus = 0, per_cu = 0;
        (void)hipGetDevice(&dev); (void)hipDeviceGetAttribute(&cus, hipDeviceAttributeMultiprocessorCount, dev);
        if (hipFuncSetAttribute((const void*)trunk_fwd, hipFuncAttributeMaxDynamicSharedMemorySize, LDS_BYTES) != hipSuccess) { fprintf(stderr, "kernel_launch: hipFuncSetAttribute failed\n"); grid = -1; return; }
        if (hipOccupancyMaxActiveBlocksPerMultiprocessor(&per_cu, (const void*)trunk_fwd, NTHREADS, LDS_BYTES) != hipSuccess || per_cu < 1) { fprintf(stderr, "kernel_launch: occupancy query gave %d\n", per_cu); per_cu = 1; }
        (void)hipGetLastError();
        grid = cus * 1;
        if (grid != 256) fprintf(stderr, "kernel_launch: note: %d CUs\n", grid);
    }
    if (grid < 0) return;
    Args a{};
    for (int i = 0; i < N_IN; ++i) a.in[i] = (const float*)d_in[i];
    a.out = (float*)d_out; a.ws = (unsigned char*)d_ws;
    void* kargs[] = {&a};
    hipError_t e = hipLaunchCooperativeKernel((const void*)trunk_fwd, dim3(grid), dim3(NTHREADS), kargs, LDS_BYTES, stream);
    if (e != hipSuccess) fprintf(stderr, "kernel_launch: cooperative launch failed: %s (grid %d)\n", hipGetErrorString(e), grid);
}
```

```cpp
#include <hip/hip_runtime.h>
#include <hip/hip_cooperative_groups.h>
#include <cstdio>
#include <cstdint>
namespace cg = cooperative_groups;
#ifndef PROBE
#define PROBE 0
#endif

#define LAS __attribute__((address_space(3)))
typedef unsigned short bf16_t;
typedef short bf16x8 __attribute__((ext_vector_type(8)));
typedef float f32x4 __attribute__((ext_vector_type(4)));
typedef float f32x2 __attribute__((ext_vector_type(2)));
typedef unsigned u32x4 __attribute__((ext_vector_type(4)));
typedef unsigned u32x2 __attribute__((ext_vector_type(2)));

constexpr int D = 1024, BP = 8, SEQ = 4096, BS = 8, TS = 32, DEPTH = 2;
constexpr int MP = BP * SEQ, MS = BS * TS, MT = MP + MS;
constexpr int INC = 2304, DFF = 2816, NMEM = 256, AW = 512, BW = 256, CW = 256;
constexpr int Z_XA = 0, Z_GA = 512, Z_XB = 1024, Z_GB = 1280, Z_GC = 1536, Z_UC = 1792, Z_VC = 2048;
constexpr float EPS = 1e-6f;
constexpr int NWAVES = 8, NTHREADS = 512;

constexpr size_t O_YP = 0, O_YS = O_YP + (size_t)MP * D, O_CAP = O_YS + (size_t)MS * D, O_HAP = O_CAP + DEPTH * BP * 3 * AW,
                 O_CBP = O_HAP + DEPTH * BP * AW, O_CFP = O_CBP + DEPTH * BP * 2 * BW, O_MKP = O_CFP + DEPTH * BP * 2 * DFF,
                 O_MVP = O_MKP + (size_t)DEPTH * BP * NMEM * D, O_CAS = O_MVP + (size_t)DEPTH * BP * NMEM * D, O_HAS = O_CAS + DEPTH * BS * 3 * AW,
                 O_CBS = O_HAS + DEPTH * BS * AW, O_CFS = O_CBS + DEPTH * BS * 2 * BW, O_VCS = O_CFS + DEPTH * BS * 2 * DFF,
                 O_END = O_VCS + DEPTH * BS * TS * CW;

constexpr size_t MiB = 1u << 20;
constexpr size_t WS_WIN = 0, WS_WOUT = 5 * MiB, WS_WQ = 7 * MiB, WS_WK = 9 * MiB, WS_WV = 11 * MiB, WS_WO = 13 * MiB, WS_WUP = 15 * MiB, WS_WDN = 26 * MiB;
constexpr size_t WS_MEMB = 32 * MiB, WS_KBP = 36 * MiB, WS_VTP = 40 * MiB, WS_KBS = 44 * MiB, WS_VTS = 48 * MiB, WS_WST = 52 * MiB, WS_GT = WS_WST + 131072, WS_AGG = 53 * MiB, WS_SS = 54 * MiB + 256 * 1024, WS_BAR = 55 * MiB + 512 * 1024;
constexpr size_t WS_XN = 56 * MiB, WS_BIG = 121 * MiB;
constexpr size_t B_Z = WS_BIG, B_HLOC = WS_BIG + 146 * MiB, B_PCUM = WS_BIG + 211 * MiB, B_Y = WS_BIG + 276 * MiB;
constexpr size_t B_Q = WS_BIG, B_P = WS_BIG + 65 * MiB, B_O = WS_BIG + 130 * MiB, B_PS = WS_BIG + 195 * MiB;
constexpr size_t B_GU = WS_BIG;
constexpr size_t B_GUS = WS_BIG + 200 * MiB;
constexpr size_t B_SBG = WS_BIG + 204 * MiB, B_SBU = WS_BIG + 207 * MiB, B_SBL = WS_BIG + 210 * MiB;
constexpr size_t WS_END = WS_BIG + (size_t)MT * 2 * DFF * 2;
constexpr size_t WS_SSP = 476 * MiB;
static_assert(WS_END <= WS_SSP && WS_SSP + (size_t)7 * MT * 64 <= 512 * MiB, "workspace");
static_assert(WS_XN + (size_t)MT * D * 2 <= WS_BIG, "xn");
constexpr size_t WS_SSS = WS_SSP + (((size_t)7 * MT * 16 + 4095) / 4096) * 4096;
static_assert(WS_SSS + 7 * 256 * 32 * 4 <= 480 * MiB, "sss");
constexpr size_t WSEL1 = 480 * MiB, KSEL1 = 418 * MiB;
static_assert(WS_WDN + (size_t)D * DFF * 2 + WSEL1 <= 512 * MiB && WS_KBS + KSEL1 >= WS_BIG + 341 * MiB && WS_GT + 131072 + KSEL1 <= WS_SSP, "second buffer set");

constexpr int LDS_RING = 131072, LDS_EX = LDS_RING, LDS_MISC = LDS_EX + 8192, LDS_BYTES = 147456;

enum { I_XP = 0, I_XS, I_MEM, I_CK, I_CV, I_SCA, I_SHA, I_SCB, I_SCF, I_GMIX, I_WIN, I_CAW, I_CAB, I_WRG, I_BRG, I_WIG, I_BIG, I_LAM, I_CBW, I_GV, I_WS, I_BSS,
       I_WOUT, I_GX, I_WQ, I_WK, I_WV, I_WO, I_GFFN, I_WUP, I_CFW, I_WDN, I_GFIN, N_IN };

struct Args { const float* in[N_IN]; float* out; unsigned char* ws; };

__device__ __forceinline__ unsigned pk2(float lo, float hi) { unsigned r; asm("v_cvt_pk_bf16_f32 %0, %1, %2" : "=v"(r) : "v"(lo), "v"(hi)); return r; }
__device__ __forceinline__ unsigned f2bf(float f) { return pk2(f, f) & 0xffffu; }
__device__ __forceinline__ float bf2f(unsigned v) { return __builtin_bit_cast(float, v << 16); }
__device__ __forceinline__ float bflo(unsigned w) { return __builtin_bit_cast(float, w << 16); }
__device__ __forceinline__ float bfhi(unsigned w) { return __builtin_bit_cast(float, w & 0xffff0000u); }
__device__ __forceinline__ unsigned cvt_pk_bf16(float lo, float hi) { unsigned r; asm volatile("v_cvt_pk_bf16_f32 %0, %1, %2" : "=v"(r) : "v"(lo), "v"(hi)); return r; }
__device__ __forceinline__ float fexp(float x) { return __builtin_amdgcn_exp2f(x * 1.4426950408889634f); }
__device__ __forceinline__ float sigm(float x) { return __builtin_amdgcn_rcpf(1.0f + fexp(-x)); }
__device__ __forceinline__ float gelu_t(float x) { const float u = 0.7978845608028654f * (x + 0.044715f * x * x * x); return x * sigm(2.0f * u); }
__device__ __forceinline__ float silu(float x) { return x * sigm(x); }
__device__ __forceinline__ float shx(float v, int m, int lane) { return __builtin_bit_cast(float, __builtin_amdgcn_ds_bpermute((lane ^ m) << 2, __builtin_bit_cast(int, v))); }
__device__ __forceinline__ float wave_sum(float v, int lane) {
#pragma unroll
    for (int o = 1; o < 64; o <<= 1) v += shx(v, o, lane);
    return v;
}
#define LDS_WAIT() asm volatile("s_waitcnt lgkmcnt(0)" ::: "memory")
__device__ __forceinline__ float ss_rstd(f32x4 p) { return __builtin_amdgcn_rsqf(((p[0] + p[1]) + (p[2] + p[3])) * (1.f / 1024.f) + 1e-6f); }
__device__ __forceinline__ int opaque_tid(int wave_s) { int l; asm volatile("v_mbcnt_lo_u32_b32 %0, -1, 0\n\tv_mbcnt_hi_u32_b32 %0, -1, %0" : "=v"(l)); return wave_s * 64 + l; }

namespace pg8 {
constexpr int BM = 256, BK = 64, HALF = 128, HTB = HALF * BK * 2, NXCD = 8, WGM = 8;
__device__ __forceinline__ int lds_byte(int r, int c) { const int st = (r >> 4) * 2 + (c >> 5), rr = r & 15, cc = c & 31, ob = rr * 64 + cc * 2; return st * 1024 + (ob ^ (((ob >> 9) & 1) << 5)); }
__device__ __forceinline__ void stage_rc(int b, int& R, int& C) { const int st = b / 1024, sb = b % 1024, swz = sb ^ (((sb >> 9) & 1) << 5); R = (st >> 1) * 16 + swz / 64; C = (st & 1) * 32 + (swz % 64) / 2; }
__device__ __forceinline__ int perm32(int rho) { const int n = rho >> 4, i = rho & 15; return 8 * (i >> 2) + 4 * n + (i & 3); }

struct Unit { int pm, pn; };
struct Gemm { const bf16_t* A; const bf16_t* Bt; int lda, ldb, K; };

struct GSched {
    int nM, nN, nwg, G, c, mode;
    size_t aPm, aPn, bPn, bPm; int bShift;
    __device__ __forceinline__ void init(int nM_, int nN_, int G_, int c_) { nM = nM_; nN = nN_; nwg = nM * nN; G = G_; c = c_; mode = 0; aPm = 0; aPn = 0; bPn = 0; bPm = 0; bShift = 0; }
    __device__ __forceinline__ bool next(int i, Unit& u) const {
        const long L = (long)i * G + c; if (L >= nwg) return false;
        int wgid = (int)L; { const int q = nwg / NXCD, r = nwg % NXCD, xcd = wgid % NXCD, off = wgid / NXCD; wgid = (xcd < r ? xcd * (q + 1) : r * (q + 1) + (xcd - r) * q) + off; }
        const int nig = WGM * nN, gid = wgid / nig, fm = gid * WGM, gsz = (nM - fm) < WGM ? (nM - fm) : WGM;
        u.pm = fm + ((wgid % nig) % gsz); u.pn = (wgid % nig) / gsz; return true;
    }
    __device__ __forceinline__ size_t offA(const Unit& u) const { return mode == 1 ? (size_t)(u.pn & 3) * 512 : (mode == 2 ? (size_t)(u.pn & 3) * 4096 + (size_t)(u.pn >> 2) * 512 : (size_t)u.pm * aPm + (size_t)u.pn * aPn); }
    __device__ __forceinline__ size_t offB(const Unit& u) const { return mode == 1 ? (size_t)(u.pn >> 2) * (256 * 1024 * 2) + (size_t)(u.pn & 3) * 512 : (mode == 2 ? (size_t)(u.pn & 3) * (256 * 2048 * 2) + (size_t)(u.pn >> 2) * 512 : (size_t)u.pn * bPn + (size_t)(u.pm >> bShift) * bPm); }
};

struct EpiBf16 {
    static constexpr bool PERM = true;
    bf16_t* O; int ldc; float scale; const float* ss; int smp;
    __device__ __forceinline__ void operator()(f32x4 (&acc)[2][2][4][2], const Unit& u, int wr, int wc, int fr, int fq, LAS unsigned char*) const {
        asm volatile("" : "+v"(fr), "+v"(fq)); asm volatile("" : "+s"(wr), "+s"(wc));
        const int row0 = u.pm * BM + wr * 64 + fr, col0 = (smp ? (u.pn & 3) : u.pn) * BM + wc * 32 + 8 * fq;
        f32x4 rs[2][4];
#pragma unroll
        for (int ai = 0; ai < 2; ++ai)
#pragma unroll
            for (int m = 0; m < 4; ++m) rs[ai][m] = ss ? *(const f32x4*)(ss + (size_t)(row0 + ai * HALF + m * 16) * 4) : (f32x4){0.f, 0.f, 0.f, 0.f};
#pragma unroll
        for (int ai = 0; ai < 2; ++ai)
#pragma unroll
            for (int m = 0; m < 4; ++m) { bf16_t* rowp = O + (size_t)(row0 + ai * HALF + m * 16) * ldc + col0;
                float sc = scale; if (ss) sc *= ss_rstd(rs[ai][m]);
                if (smp && ((ai * HALF + wr * 64 + m * 16 + fr) >> 5) != (u.pn >> 2)) continue;
#pragma unroll
                for (int bj = 0; bj < 2; ++bj) { const f32x4 v0 = acc[ai][bj][m][0] * sc, v1 = acc[ai][bj][m][1] * sc;
                    u32x4 w; w.x = cvt_pk_bf16(v0[0], v0[1]); w.y = cvt_pk_bf16(v0[2], v0[3]); w.z = cvt_pk_bf16(v1[0], v1[1]); w.w = cvt_pk_bf16(v1[2], v1[3]);
                    *(u32x4*)(rowp + bj * HALF) = w; } }
    }
};
struct EpiResid {
    static constexpr bool PERM = true;
    bf16_t* xb; float* ss;
    __device__ __forceinline__ void operator()(f32x4 (&acc)[2][2][4][2], const Unit& u, int wr, int wc, int fr, int fq, LAS unsigned char* lds) const {
        asm volatile("" : "+v"(fr), "+v"(fq)); asm volatile("" : "+s"(wr), "+s"(wc));
        const int col0 = u.pn * BM + wc * 32 + 8 * fq, lane = fq * 16 + fr;
        LAS float* PS = (LAS float*)(lds + LDS_EX);
        bf16_t* ob = xb + (size_t)u.pm * BM * D;
#pragma unroll
        for (int ai = 0; ai < 2; ++ai) {
            u32x4 pre[4][2];
#pragma unroll
            for (int m = 0; m < 4; ++m)
#pragma unroll
                for (int bj = 0; bj < 2; ++bj) pre[m][bj] = *(const u32x4*)(ob + (size_t)(ai * HALF + wr * 64 + m * 16 + fr) * D + col0 + bj * HALF);
            asm volatile("" ::: "memory");
#pragma unroll
            for (int m = 0; m < 4; ++m) { const int rl = ai * HALF + wr * 64 + m * 16 + fr; const size_t off = (size_t)rl * D + col0; float q = 0.f;
#pragma unroll
                for (int bj = 0; bj < 2; ++bj) { const u32x4 p = pre[m][bj]; const f32x4 a0 = acc[ai][bj][m][0], a1 = acc[ai][bj][m][1];
                    const float v0 = bflo(p.x) + a0[0], v1 = bfhi(p.x) + a0[1], v2 = bflo(p.y) + a0[2], v3 = bfhi(p.y) + a0[3], v4 = bflo(p.z) + a1[0], v5 = bfhi(p.z) + a1[1], v6 = bflo(p.w) + a1[2], v7 = bfhi(p.w) + a1[3];
                    u32x4 w; w.x = cvt_pk_bf16(v0, v1); w.y = cvt_pk_bf16(v2, v3); w.z = cvt_pk_bf16(v4, v5); w.w = cvt_pk_bf16(v6, v7); *(u32x4*)(ob + off + bj * HALF) = w;
                    q += ((v0 * v0 + v1 * v1) + (v2 * v2 + v3 * v3)) + ((v4 * v4 + v5 * v5) + (v6 * v6 + v7 * v7)); }
                q += shx(q, 16, lane); q += shx(q, 32, lane);
                if (fq == 0) PS[rl * 4 + wc] = q; }
            asm volatile("" ::: "memory");
        }
        asm volatile("s_waitcnt lgkmcnt(0)" ::: "memory"); __builtin_amdgcn_s_barrier(); asm volatile("" ::: "memory");
        { const int t = (wr * 4 + wc) * 64 + lane; if (t < 256) { const f32x4 p = *(const LAS f32x4*)(PS + t * 4); ss[(size_t)(u.pm * BM + t) * 4 + u.pn] = (p[0] + p[1]) + (p[2] + p[3]); } }
    }
};
struct EpiKV {
    static constexpr bool PERM = false;
    float* outK; float* outV; bf16_t* KB; bf16_t* VT;
    __device__ __forceinline__ void operator()(f32x4 (&acc)[2][2][4][2], const Unit& u, int wr, int wc, int fr, int fq, LAS unsigned char*) const {
        asm volatile("" : "+v"(fr), "+v"(fq)); asm volatile("" : "+s"(wr), "+s"(wc));
        const int kind = u.pm >> 4, pm = u.pm & 15;
        const int col0 = u.pn * BM + wc * 32 + 4 * fq;
        float* of = kind == 0 ? outK : outV; bf16_t* ob = kind == 0 ? KB : VT; const int ldb_ = kind == 2 ? 2048 : 1024;
#pragma unroll
        for (int ai = 0; ai < 2; ++ai)
#pragma unroll
            for (int m = 0; m < 4; ++m) { const int row = pm * BM + ai * HALF + wr * 64 + m * 16 + fr;
#pragma unroll
                for (int bj = 0; bj < 2; ++bj)
#pragma unroll
                    for (int n = 0; n < 2; ++n) { const f32x4 v = acc[ai][bj][m][n]; const int col = col0 + bj * HALF + n * 16;
                        if (kind != 2) __builtin_nontemporal_store(v, (f32x4*)(of + (size_t)row * 1024 + col));
                        if (kind != 1) { u32x2 w; w.x = cvt_pk_bf16(v[0], v[1]); w.y = cvt_pk_bf16(v[2], v[3]); *(u32x2*)(ob + (size_t)row * ldb_ + col) = w; } } }
    }
};
struct EpiSoftmax {
    static constexpr bool PERM = true;
    bf16_t* O; int ldc; int smp;
    __device__ __forceinline__ void operator()(f32x4 (&acc)[2][2][4][2], const Unit& u, int wr, int wc, int fr, int fq, LAS unsigned char* lds) const {
        asm volatile("" : "+v"(fr), "+v"(fq)); asm volatile("" : "+s"(wr), "+s"(wc));
        LAS f32x2* EX = (LAS f32x2*)(lds + LDS_EX);
        const int lane = fq * 16 + fr;
        const float L2E = 1.4426950408889634f;
#pragma unroll
        for (int ai = 0; ai < 2; ++ai)
#pragma unroll
            for (int m = 0; m < 4; ++m) {
                float mx = -3.0e38f;
#pragma unroll
                for (int bj = 0; bj < 2; ++bj)
#pragma unroll
                    for (int n = 0; n < 2; ++n) { const f32x4 x = acc[ai][bj][m][n]; mx = fmaxf(mx, fmaxf(fmaxf(x[0], x[1]), fmaxf(x[2], x[3]))); }
                mx = fmaxf(mx, shx(mx, 16, lane)); mx = fmaxf(mx, shx(mx, 32, lane));
                float s = 0.f;
#pragma unroll
                for (int bj = 0; bj < 2; ++bj)
#pragma unroll
                    for (int n = 0; n < 2; ++n) { f32x4 x = acc[ai][bj][m][n];
#pragma unroll
                        for (int j = 0; j < 4; ++j) { x[j] = __builtin_amdgcn_exp2f((x[j] - mx) * L2E); s += x[j]; }
                        acc[ai][bj][m][n] = x; }
                s += shx(s, 16, lane); s += shx(s, 32, lane);
                if (fq == 0) EX[(ai * HALF + wr * 64 + m * 16 + fr) * 4 + wc] = (f32x2){mx, s};
            }
        asm volatile("s_waitcnt lgkmcnt(0)" ::: "memory"); __builtin_amdgcn_s_barrier(); asm volatile("" ::: "memory");
        int colb = u.pn * BM, j_ = 0;
        if (smp) { colb = (u.pn & 3) * 2048 + (u.pn >> 2) * 256; j_ = u.pn >> 2; }
        const int col0 = colb + wc * 32 + 8 * fq;
#pragma unroll
        for (int ai = 0; ai < 2; ++ai)
#pragma unroll
            for (int m = 0; m < 4; ++m) {
                const int rl = ai * HALF + wr * 64 + m * 16 + fr;
                const f32x2 e0 = EX[rl * 4 + 0], e1 = EX[rl * 4 + 1], e2 = EX[rl * 4 + 2], e3 = EX[rl * 4 + 3];
                const float M = fmaxf(fmaxf(e0.x, e1.x), fmaxf(e2.x, e3.x));
                const float tot = e0.y * __builtin_amdgcn_exp2f((e0.x - M) * L2E) + e1.y * __builtin_amdgcn_exp2f((e1.x - M) * L2E) + e2.y * __builtin_amdgcn_exp2f((e2.x - M) * L2E) + e3.y * __builtin_amdgcn_exp2f((e3.x - M) * L2E);
                const float own = wc == 0 ? e0.x : (wc == 1 ? e1.x : (wc == 2 ? e2.x : e3.x));
                float f = __builtin_amdgcn_exp2f((own - M) * L2E) * __builtin_amdgcn_rcpf(tot);
                if (smp && (rl >> 5) != j_) f = 0.f;
                bf16_t* rowp = O + (size_t)(u.pm * BM + rl) * ldc + col0;
#pragma unroll
                for (int bj = 0; bj < 2; ++bj) { const f32x4 v0 = acc[ai][bj][m][0] * f, v1 = acc[ai][bj][m][1] * f;
                    u32x4 w; w.x = cvt_pk_bf16(v0[0], v0[1]); w.y = cvt_pk_bf16(v0[2], v0[3]); w.z = cvt_pk_bf16(v1[0], v1[1]); w.w = cvt_pk_bf16(v1[2], v1[3]);
                    *(u32x4*)(rowp + bj * HALF) = w; } }
    }
};


__device__ __forceinline__ float dpp_ror1(float v) { return __builtin_bit_cast(float, __builtin_amdgcn_update_dpp(0, __builtin_bit_cast(int, v), 0x121, 0xf, 0xf, false)); }
__device__ __forceinline__ float dpp_ror2(float v) { return __builtin_bit_cast(float, __builtin_amdgcn_update_dpp(0, __builtin_bit_cast(int, v), 0x122, 0xf, 0xf, false)); }
struct EpiAct {
    static constexpr bool PERM = true;
    bf16_t* H; const float* scf; float* ocf; float* sbg; float* sbu; float* sbl; const float* cfw; const float* ss;
    __device__ __forceinline__ void operator()(f32x4 (&acc)[2][2][4][2], const Unit& u, int wr, int wc, int fr, int fq, LAS unsigned char* lds) const {
        asm volatile("" : "+s"(wr), "+s"(wc));
        int lane; asm volatile("v_mbcnt_lo_u32_b32 %0, -1, 0\n\tv_mbcnt_hi_u32_b32 %0, -1, %0" : "=v"(lane));
        fr = lane & 15; fq = lane >> 4;
        const int fl = wc * 32 + 8 * fq, f0 = u.pn * 128 + fl; int rowt = wr * 64 + fr;
        {
            float rst[2][4];
            f32x4 rsl[2][4];
#pragma unroll
            for (int ai = 0; ai < 2; ++ai)
#pragma unroll
                for (int m = 0; m < 4; ++m) rsl[ai][m] = *(const f32x4*)(ss + (size_t)(u.pm * BM + ai * HALF + rowt + m * 16) * 4);
#pragma unroll
            for (int ai = 0; ai < 2; ++ai)
#pragma unroll
                for (int m = 0; m < 4; ++m) { rst[ai][m] = ss_rstd(rsl[ai][m]); }
#pragma unroll
            for (int ai = 0; ai < 2; ++ai)
#pragma unroll
                for (int m = 0; m < 4; ++m) { acc[ai][0][m][0] = acc[ai][0][m][0] * rst[ai][m]; acc[ai][0][m][1] = acc[ai][0][m][1] * rst[ai][m]; acc[ai][1][m][0] = acc[ai][1][m][0] * rst[ai][m]; acc[ai][1][m][1] = acc[ai][1][m][1] * rst[ai][m]; }
        }
        const bool smp = (u.pm == 128);
        asm volatile("" : "+v"(rowt));
        LAS float* BND = (LAS float*)(lds + LDS_EX);
        if (fr >= 14) {
#pragma unroll
            for (int ai = 0; ai < 2; ++ai)
#pragma unroll
                for (int n = 0; n < 2; ++n) *(LAS f32x4*)(BND + ((ai * 2 + wr) * 2 + (fr - 14)) * 128 + fl + 4 * n) = acc[ai][0][3][n];
            if (wr == 1) {
#pragma unroll
                for (int n = 0; n < 2; ++n) *(f32x4*)(sbl + ((size_t)u.pm * 2 + (fr - 14)) * DFF + f0 + 4 * n) = acc[1][0][3][n];
            }
        }
        asm volatile("s_waitcnt lgkmcnt(0)" ::: "memory"); __builtin_amdgcn_s_barrier(); asm volatile("" ::: "memory");
#pragma unroll
        for (int ai = 0; ai < 2; ++ai) {
            const int pg = wr == 1 ? ai * 2 : 1;
            u32x2 hp[2][4];
#pragma unroll
            for (int n = 0; n < 2; ++n) {
                const f32x4 w0 = *(const f32x4*)(cfw + f0 + 4 * n), w1 = *(const f32x4*)(cfw + DFF + f0 + 4 * n), w2 = *(const f32x4*)(cfw + 2 * DFF + f0 + 4 * n);
                f32x4 h2 = *(const LAS f32x4*)(BND + (pg * 2 + 0) * 128 + fl + 4 * n), h1 = *(const LAS f32x4*)(BND + (pg * 2 + 1) * 128 + fl + 4 * n);
                f32x4 t2 = h2, t1 = h1;
                if (smp) { const float* sp = scf + (size_t)((ai * 4 + wr * 2) * 2) * DFF + f0 + 4 * n; h2 = *(const f32x4*)sp; h1 = *(const f32x4*)(sp + DFF); t2 = *(const f32x4*)(sp + 2 * DFF); t1 = *(const f32x4*)(sp + 3 * DFF); }
#pragma unroll
                for (int jp = 0; jp < 2; ++jp) {
                    const int j0 = jp * 2, j1 = jp * 2 + 1;
                    const f32x2 w0p = {w0[j0], w0[j1]}, w1p = {w1[j0], w1[j1]}, w2p = {w2[j0], w2[j1]};
                    f32x2 r1p = {h1[j0], h1[j1]}, r2p = fr == 0 ? (f32x2){h2[j0], h2[j1]} : (f32x2){h1[j0], h1[j1]};
#pragma unroll
                    for (int m = 0; m < 4; ++m) {
                        const f32x2 g = {acc[ai][0][m][n][j0], acc[ai][0][m][n][j1]}, uu = {acc[ai][1][m][n][j0], acc[ai][1][m][n][j1]};
                        if (m == 2 && smp) { r1p = (f32x2){t1[j0], t1[j1]}; r2p = fr == 0 ? (f32x2){t2[j0], t2[j1]} : (f32x2){t1[j0], t1[j1]}; }
                        const f32x2 r1 = {dpp_ror1(g.x), dpp_ror1(g.y)}, r2 = {dpp_ror2(g.x), dpp_ror2(g.y)};
                        const f32x2 gm1 = fr >= 1 ? r1 : r1p, gm2 = fr >= 2 ? r2 : r2p;
                        r1p = r1; r2p = r2;
                        const f32x2 cv = w0p * gm2 + w1p * gm1 + w2p * g;
                        const f32x2 ex = cv * (-1.4426950408889634f);
                        f32x2 den; den.x = __builtin_amdgcn_exp2f(ex.x); den.y = __builtin_amdgcn_exp2f(ex.y); den = den + 1.0f;
                        f32x2 rc; rc.x = __builtin_amdgcn_rcpf(den.x); rc.y = __builtin_amdgcn_rcpf(den.y);
                        const f32x2 hv = (cv * rc) * uu;
                        const unsigned pk = cvt_pk_bf16(hv.x, hv.y); if (jp == 0) hp[n][m].x = pk; else hp[n][m].y = pk;
                    }
                }
            }
#pragma unroll
            for (int m = 0; m < 4; ++m) {
                const int rl = ai * HALF + rowt + m * 16;
                if (smp && (m & 1) && fr >= 14) {
#pragma unroll
                    for (int n = 0; n < 2; ++n) *(f32x4*)(ocf + ((size_t)(ai * 4 + wr * 2 + (m >> 1)) * 2 + (fr - 14)) * DFF + f0 + 4 * n) = acc[ai][0][m][n];
                }
                if (!smp && ai == 0 && m == 0 && wr == 0 && fr < 2) {
#pragma unroll
                    for (int n = 0; n < 2; ++n) { *(f32x4*)(sbg + ((size_t)u.pm * 2 + fr) * DFF + f0 + 4 * n) = acc[0][0][0][n]; *(f32x4*)(sbu + ((size_t)u.pm * 2 + fr) * DFF + f0 + 4 * n) = acc[0][1][0][n]; }
                } else {
                    u32x4 w; w.x = hp[0][m].x; w.y = hp[0][m].y; w.z = hp[1][m].x; w.w = hp[1][m].y;
                    __builtin_nontemporal_store(w, (u32x4*)(H + (size_t)(u.pm * BM + rl) * DFF + f0));
                }
            }
        }
    }
};

template <class Epi, class Sched, bool ALIGN_EPI>
__device__ __forceinline__ void gemm_phase(LAS unsigned char* lds, const Gemm g, const Sched& S, const Epi& E, const int wave_s) {
    const int tid = opaque_tid(wave_s), wid = __builtin_amdgcn_readfirstlane(tid >> 6), lane = tid & 63, wr = wid >> 2, wc = wid & 3, fr = lane & 15, fq = lane >> 4;
    const int nt = g.K / BK;
    unsigned voffA[2], voffB[2];
#pragma unroll
    for (int i = 0; i < 2; ++i) { int R, C; stage_rc(tid * 16 + i * 8192, R, C); const int Rb = Epi::PERM ? ((R & ~31) + perm32(R & 31)) : R;
        voffA[i] = (unsigned)(R * g.lda + C) * 2u; voffB[i] = (unsigned)(Rb * g.ldb + C) * 2u; }
    const size_t kstep = (size_t)(BK * 2);
    const size_t hstepA = (size_t)HALF * g.lda * 2, hstepB = (size_t)HALF * g.ldb * 2;
    const unsigned ldsw = (unsigned)wid * 1024u;
    const int aoff = lds_byte(wr * 64 + fr, fq * 8), boff = lds_byte(wc * 32 + fr, fq * 8);
#define PG8_SA(b, h) (((b) * 2 + (h)) * HTB)
#define PG8_SB(b, h) ((4 + (b) * 2 + (h)) * HTB)
#define PG8_STAGE(bufoff, gbase, voff) do { _Pragma("unroll") for (int _i = 0; _i < 2; ++_i) \
        __builtin_amdgcn_global_load_lds((const unsigned*)((const char*)(gbase) + (voff)[_i]), (LAS unsigned*)(lds + (bufoff) + ldsw + _i * 8192), 16, 0, 0); } while (0)
#define PG8_LDA(dst, b, h) do { _Pragma("unroll") for (int m = 0; m < 4; ++m) _Pragma("unroll") for (int k = 0; k < 2; ++k) dst[m][k] = *(const LAS bf16x8*)(lds + PG8_SA(b, h) + aoff + m * 2048 + k * 1024); } while (0)
#define PG8_LDB(dst, b, h) do { _Pragma("unroll") for (int n = 0; n < 2; ++n) _Pragma("unroll") for (int k = 0; k < 2; ++k) dst[n][k] = *(const LAS bf16x8*)(lds + PG8_SB(b, h) + boff + n * 2048 + k * 1024); } while (0)
#define PG8_MMA(ai, bj, At, Bt) do { __builtin_amdgcn_s_setprio(1); _Pragma("unroll") for (int m = 0; m < 4; ++m) _Pragma("unroll") for (int n = 0; n < 2; ++n) _Pragma("unroll") for (int k = 0; k < 2; ++k) \
        acc[ai][bj][m][n] = __builtin_amdgcn_mfma_f32_16x16x32_bf16(Bt[n][k], At[m][k], acc[ai][bj][m][n], 0, 0, 0); __builtin_amdgcn_s_setprio(0); } while (0)
#define PG8_WAIT_V(n) asm volatile("s_waitcnt vmcnt(" #n ")" ::: "memory")
#define PG8_WAIT_L(n) asm volatile("s_waitcnt lgkmcnt(" #n ")" ::: "memory")
#define PG8_BAR __builtin_amdgcn_s_barrier()
#define PG8_SCHED __builtin_amdgcn_sched_barrier(0)
    Unit cur, nxt; int ui = 0;
    if (!S.next(0, cur)) return;
    f32x4 acc[2][2][4][2];
#pragma unroll
    for (int a = 0; a < 2; ++a)
#pragma unroll
        for (int b = 0; b < 2; ++b)
#pragma unroll
            for (int m = 0; m < 4; ++m)
#pragma unroll
                for (int n = 0; n < 2; ++n) acc[a][b][m][n] = (f32x4){0.f, 0.f, 0.f, 0.f};
    bf16x8 At[4][2], B0[2][2], B1[2][2];
    const char* cA = (const char*)g.A + S.offA(cur); const char* cB = (const char*)g.Bt + S.offB(cur);
    PG8_STAGE(PG8_SB(0, 0), cB, voffB); PG8_STAGE(PG8_SB(0, 1), cB + hstepB, voffB); PG8_STAGE(PG8_SA(0, 0), cA, voffA); PG8_STAGE(PG8_SA(0, 1), cA + hstepA, voffA);
    if (wr == 1) PG8_BAR;
    PG8_WAIT_V(2); PG8_BAR;
    PG8_STAGE(PG8_SB(1, 0), cB + kstep, voffB); PG8_STAGE(PG8_SA(1, 0), cA + kstep, voffA); PG8_STAGE(PG8_SB(1, 1), cB + hstepB + kstep, voffB);
    PG8_WAIT_V(6); PG8_BAR;
    for (;;) {
        const bool has_next = S.next(ui + 1, nxt);
        const char* nA = has_next ? (const char*)g.A + S.offA(nxt) : cA; const char* nB = has_next ? (const char*)g.Bt + S.offB(nxt) : cB;
        for (int t = 0; t < nt; t += 2) {
            const bool last = (t == nt - 2);
            const char* a1 = cA + (size_t)(t + 1) * kstep;
            const char* a2 = last ? nA : cA + (size_t)(t + 2) * kstep; const char* b2 = last ? nB : cB + (size_t)(t + 2) * kstep;
            const char* a3 = a2 + kstep; const char* b3 = b2 + kstep;
            PG8_LDB(B0, 0, 0); PG8_LDB(B1, 0, 1); PG8_SCHED; PG8_LDA(At, 0, 0); PG8_STAGE(PG8_SA(1, 1), a1 + hstepA, voffA);
            PG8_WAIT_V(8); PG8_WAIT_L(0); PG8_BAR; PG8_MMA(0, 0, At, B0); PG8_MMA(0, 1, At, B1); PG8_BAR; PG8_SCHED;
            PG8_LDA(At, 0, 1); PG8_STAGE(PG8_SB(0, 0), b2, voffB); PG8_STAGE(PG8_SB(0, 1), b2 + hstepB, voffB); PG8_STAGE(PG8_SA(0, 0), a2, voffA);
            PG8_WAIT_V(8); PG8_WAIT_L(0); PG8_BAR; PG8_MMA(1, 0, At, B0); PG8_MMA(1, 1, At, B1); PG8_BAR; PG8_SCHED;
            PG8_LDB(B0, 1, 0); PG8_LDB(B1, 1, 1); PG8_SCHED; PG8_LDA(At, 1, 0); PG8_STAGE(PG8_SA(0, 1), a2 + hstepA, voffA);
            PG8_WAIT_V(8); PG8_WAIT_L(0); PG8_BAR; PG8_MMA(0, 0, At, B0); PG8_MMA(0, 1, At, B1); PG8_BAR; PG8_SCHED;
            PG8_LDA(At, 1, 1); PG8_STAGE(PG8_SB(1, 0), b3, voffB); PG8_STAGE(PG8_SB(1, 1), b3 + hstepB, voffB); PG8_STAGE(PG8_SA(1, 0), a3, voffA);
            PG8_WAIT_V(8); PG8_WAIT_L(0); PG8_BAR; PG8_MMA(1, 0, At, B0); PG8_MMA(1, 1, At, B1); PG8_BAR; PG8_SCHED;
        }
        if constexpr (ALIGN_EPI) { if (wr == 0) PG8_BAR; }
        E(acc, cur, wr, wc, fr, fq, lds);
        if (!has_next) break;
#pragma unroll
        for (int a = 0; a < 2; ++a)
#pragma unroll
            for (int b = 0; b < 2; ++b)
#pragma unroll
                for (int m = 0; m < 4; ++m)
#pragma unroll
                    for (int n = 0; n < 2; ++n) acc[a][b][m][n] = (f32x4){0.f, 0.f, 0.f, 0.f};
        cur = nxt; cA = nA; cB = nB; ++ui;
        if constexpr (ALIGN_EPI) { if (wr == 1) PG8_BAR; }
    }
    PG8_WAIT_V(0);
    if constexpr (!ALIGN_EPI) { if (wr == 0) PG8_BAR; }
    PG8_BAR;
#undef PG8_SA
#undef PG8_SB
#undef PG8_STAGE
#undef PG8_LDA
#undef PG8_LDB
#undef PG8_MMA
#undef PG8_WAIT_V
#undef PG8_WAIT_L
#undef PG8_BAR
#undef PG8_SCHED
}
}

struct KVSched {
    int c, G; const char* ws; size_t wsel;
    __device__ __forceinline__ bool next(int i, pg8::Unit& u) const {
        const int L = i * G + c; if (c < 0 || L >= 96) return false;
        const int kind = L >> 5, r = L & 31;
        if (kind < 2) { u.pm = kind * 16 + (r >> 2); u.pn = r & 3; } else { u.pm = 32 + (r >> 3); u.pn = r & 7; }
        return true;
    }
    __device__ __forceinline__ size_t offA(const pg8::Unit& u) const { const int kind = u.pm >> 4, pm = u.pm & 15; int k2 = (kind == 2); asm volatile("" : "+v"(k2));
        return (size_t)ws + WS_MEMB + (size_t)k2 * (WS_WV + wsel - WS_MEMB) + (size_t)pm * 256 * 1024 * 2; }
    __device__ __forceinline__ size_t offB(const pg8::Unit& u) const { const int kind = u.pm >> 4; int k1 = (kind == 1), k2 = (kind == 2); asm volatile("" : "+v"(k1), "+v"(k2));
        return (size_t)ws + WS_WK + wsel + (size_t)k1 * (WS_WV - WS_WK) + (size_t)k2 * (WS_MEMB - WS_WK - wsel) + (size_t)u.pn * 256 * 1024 * 2; }
};


#define XB_TMO      128
#define XB_XCNT(j)  (256  + 64 * (j))
#define XB_XSUB(j)  (1280 + 64 * (j))
#define XB_XGEN(j)  (2304 + 64 * (j))
#define XB_TOP      3328
#define XB_TOPGEN   3392
#define XCD_BAR_WORDS 3456
#define XB_SPIN_CAP (1u << 22)
__device__ __forceinline__ unsigned xb_ld(unsigned* p)              { return __hip_atomic_load(p, __ATOMIC_RELAXED, __HIP_MEMORY_SCOPE_AGENT); }
__device__ __forceinline__ unsigned xb_add(unsigned* p, unsigned v) { return __hip_atomic_fetch_add(p, v, __ATOMIC_RELAXED, __HIP_MEMORY_SCOPE_AGENT); }
__device__ __forceinline__ unsigned xb_xcc_id() { return (unsigned)__builtin_amdgcn_s_getreg((3 << 11) | 20) & 0xFu; }
#define XB_SPIN(cond, bar) do { unsigned _sp = 0; while (cond) { __builtin_amdgcn_s_sleep(1); \
    if ((++_sp & 255u) == 0u) { if (xb_ld(&(bar)[XB_TMO])) break; if (_sp > XB_SPIN_CAP) { atomicAdd(&(bar)[XB_TMO], 1u); break; } } } } while (0)
struct XcdBarrier { unsigned* bar; unsigned x; volatile LAS unsigned* st; };
__device__ __forceinline__ void xcd_barrier_complete(unsigned* bar, unsigned x, unsigned& nloc, unsigned& nx) {
    const unsigned G = gridDim.x * gridDim.y * gridDim.z;
    unsigned sum, cnt, mine, sp = 0u;
    for (;;) {
        sum = 0u; cnt = 0u; mine = 0u;
#pragma unroll
        for (unsigned j = 0; j < 16; ++j) { const unsigned c = xb_ld(&bar[XB_XCNT(j)]); sum += c; cnt += (c > 0u) ? 1u : 0u; mine = (j == x) ? c : mine; }
        if (sum == G) break;
        __builtin_amdgcn_s_sleep(1);
        if ((++sp & 255u) == 0u) { if (xb_ld(&bar[XB_TMO])) break; if (sp > XB_SPIN_CAP) { atomicAdd(&bar[XB_TMO], 1u); break; } }
    }
    nloc = mine > 0u ? mine : 1u; nx = cnt > 0u ? cnt : 1u;
}
__device__ __forceinline__ void xcd_barrier(const XcdBarrier& b) {
    asm volatile("s_waitcnt vmcnt(0)" ::: "memory");
    __syncthreads();
    if (threadIdx.x == 0) {
        unsigned* bar = b.bar;
        __builtin_amdgcn_s_waitcnt(0);
        unsigned nloc = b.st[0], nx = b.st[1];
        if (nloc == 0u) { xcd_barrier_complete(bar, b.x, nloc, nx); b.st[0] = nloc; b.st[1] = nx; }
        const unsigned old = xb_add(&bar[XB_XSUB(b.x)], 1u);
        const unsigned gen = old / nloc;
        if (old + 1u == (gen + 1u) * nloc) {
            __builtin_amdgcn_fence(__ATOMIC_RELEASE, "agent");
            asm volatile("s_waitcnt vmcnt(0)" ::: "memory");
            const unsigned og = xb_add(&bar[XB_TOP], 1u);
            const unsigned tg = og / nx;
            if (og + 1u == (tg + 1u) * nx) xb_add(&bar[XB_TOPGEN], 1u);
            else XB_SPIN(xb_ld(&bar[XB_TOPGEN]) == tg, bar);
            __builtin_amdgcn_fence(__ATOMIC_ACQUIRE, "agent");
            xb_add(&bar[XB_XGEN(b.x)], 1u);
            asm volatile("s_waitcnt vmcnt(0)" ::: "memory");
        } else {
            XB_SPIN(xb_ld(&bar[XB_XGEN(b.x)]) == gen, bar);
            __builtin_amdgcn_fence(__ATOMIC_ACQUIRE, "agent");
            asm volatile("s_waitcnt vmcnt(0)" ::: "memory");
        }
    }
    __syncthreads();
}


struct SG2 { const bf16_t* A; const bf16_t* Bt; int lda, ldb, K, N; bf16_t* O; int ldc; float scale; int mode; float* ssp; };
__device__ __forceinline__ float sq8(bf16x8 a) { float q = 0.f;
#pragma unroll
    for (int i = 0; i < 8; ++i) { const float f = bf2f((unsigned)(unsigned short)a[i]); q += f * f; } return q; }
__device__ __forceinline__ void sgemm2(LAS unsigned char* lds, const SG2 g, int ubase, int G, int wave, int tid) {
    const int lane = tid & 63, fr = lane & 15, fq = lane >> 4, rt = wave & 3, ch = wave >> 2;
    const int nunits = (g.N / 64) * 4, nsl = g.K / 64;
    int R, C; pg8::stage_rc(tid * 16, R, C);
    const unsigned offA = (unsigned)(R * g.lda + C) * 2u, offB = (unsigned)(R * g.ldb + C) * 2u;
    const int aoff = pg8::lds_byte(rt * 16 + fr, fq * 8), boff = pg8::lds_byte(ch * 32 + fr, fq * 8);
    for (int un = ubase; un >= 0 && un < nunits; un += G) {
        const int cgp = un >> 2, rg = un & 3;
        const char* gA = (const char*)(g.A + (size_t)rg * 64 * g.lda) + offA; const char* gB = (const char*)(g.Bt + (size_t)cgp * 64 * g.ldb) + offB;
#define SG2_STAGE(sl) do { LAS unsigned char* d_ = lds + ((sl) & 3) * 16384 + wave * 1024; \
        __builtin_amdgcn_global_load_lds((const unsigned*)(gA + (size_t)(sl) * 128), (LAS unsigned*)d_, 16, 0, 0); \
        __builtin_amdgcn_global_load_lds((const unsigned*)(gB + (size_t)(sl) * 128), (LAS unsigned*)(d_ + 8192), 16, 0, 0); } while (0)
        asm volatile("s_waitcnt vmcnt(0)" ::: "memory");
        SG2_STAGE(0); SG2_STAGE(1);
        f32x4 acc[2] = {(f32x4){0.f, 0.f, 0.f, 0.f}, (f32x4){0.f, 0.f, 0.f, 0.f}}; float q = 0.f;
        for (int sl = 0; sl < nsl; ++sl) {
            if (sl + 1 < nsl) asm volatile("s_waitcnt vmcnt(2)" ::: "memory"); else asm volatile("s_waitcnt vmcnt(0)" ::: "memory");
            __builtin_amdgcn_s_barrier(); asm volatile("" ::: "memory");
            if (sl + 2 < nsl) SG2_STAGE(sl + 2);
            LAS unsigned char* b_ = lds + (sl & 3) * 16384;
#pragma unroll
            for (int ks = 0; ks < 2; ++ks) {
                const bf16x8 a = *(const LAS bf16x8*)(b_ + aoff + ks * 1024);
#pragma unroll
                for (int c = 0; c < 2; ++c) { const bf16x8 b = *(const LAS bf16x8*)(b_ + 8192 + boff + c * 2048 + ks * 1024);
                    acc[c] = __builtin_amdgcn_mfma_f32_16x16x32_bf16(b, a, acc[c], 0, 0, 0); }
                if (g.mode == 1) q += sq8(a);
            }
        }
#undef SG2_STAGE
        const int row = rg * 64 + rt * 16 + fr, col = cgp * 64 + ch * 32 + fq * 4;
        bf16_t* op = g.O + (size_t)row * g.ldc + col;
        if (g.mode == 1) {
            q += shx(q, 16, lane); q += shx(q, 32, lane);
            const float sc = g.scale / sqrtf(q * (1.f / 1024.f) + EPS);
#pragma unroll
            for (int c = 0; c < 2; ++c) { const f32x4 v = acc[c] * sc; u32x2 w; w.x = cvt_pk_bf16(v[0], v[1]); w.y = cvt_pk_bf16(v[2], v[3]); *(u32x2*)(op + c * 16) = w; }
        } else {
            const u32x2 p0 = *(const u32x2*)op, p1 = *(const u32x2*)(op + 16); float qq = 0.f;
            { const float v0 = bflo(p0.x) + acc[0][0], v1 = bfhi(p0.x) + acc[0][1], v2 = bflo(p0.y) + acc[0][2], v3 = bfhi(p0.y) + acc[0][3];
              u32x2 w; w.x = cvt_pk_bf16(v0, v1); w.y = cvt_pk_bf16(v2, v3); *(u32x2*)op = w; qq += (v0 * v0 + v1 * v1) + (v2 * v2 + v3 * v3); }
            { const float v0 = bflo(p1.x) + acc[1][0], v1 = bfhi(p1.x) + acc[1][1], v2 = bflo(p1.y) + acc[1][2], v3 = bfhi(p1.y) + acc[1][3];
              u32x2 w; w.x = cvt_pk_bf16(v0, v1); w.y = cvt_pk_bf16(v2, v3); *(u32x2*)(op + 16) = w; qq += (v0 * v0 + v1 * v1) + (v2 * v2 + v3 * v3); }
            qq += shx(qq, 16, lane); qq += shx(qq, 32, lane);
            if (fq == 0) g.ssp[row * 32 + cgp * 2 + ch] = qq;
        }
        asm volatile("s_waitcnt vmcnt(0) lgkmcnt(0)" ::: "memory"); __builtin_amdgcn_s_barrier(); asm volatile("" ::: "memory");
    }
}

__device__ __forceinline__ void sgemm_act(LAS unsigned char* lds, const bf16_t* A, const bf16_t* Bt, bf16_t* Hs, const float* cfw, const float* scf, float* ocf, int ubase, int G, int wave, int tid) {
    const int lane = tid & 63, fr = lane & 15, fq = lane >> 4, rt = wave & 3, ch = wave >> 2;
    constexpr int nunits = (DFF / 64) * 4, nsl = D / 64, SLOT = 24576;
    int R, C; pg8::stage_rc(tid * 16, R, C);
    const unsigned off = (unsigned)(R * D + C) * 2u;
    const int aoff = pg8::lds_byte(rt * 16 + fr, fq * 8), boff = pg8::lds_byte(fr, fq * 8) + 8192 + ch * 8192;
    for (int un = ubase; un >= 0 && un < nunits; un += G) {
        const int fg = un >> 2, rg = un & 3, brow = ((fg >> 1) << 8) + ((fg & 1) << 6);
        const char* gA = (const char*)(A + (size_t)rg * 64 * D) + off; const char* gG = (const char*)(Bt + (size_t)brow * D) + off; const char* gU = (const char*)(Bt + (size_t)(brow + 128) * D) + off;
#define SGA_STAGE(sl) do { LAS unsigned char* d_ = lds + ((sl) & 3) * SLOT + wave * 1024; \
        __builtin_amdgcn_global_load_lds((const unsigned*)(gA + (size_t)(sl) * 128), (LAS unsigned*)d_, 16, 0, 0); \
        __builtin_amdgcn_global_load_lds((const unsigned*)(gG + (size_t)(sl) * 128), (LAS unsigned*)(d_ + 8192), 16, 0, 0); \
        __builtin_amdgcn_global_load_lds((const unsigned*)(gU + (size_t)(sl) * 128), (LAS unsigned*)(d_ + 16384), 16, 0, 0); } while (0)
        asm volatile("s_waitcnt vmcnt(0)" ::: "memory");
        SGA_STAGE(0); SGA_STAGE(1);
        f32x4 acc[4]; float q = 0.f;
#pragma unroll
        for (int c = 0; c < 4; ++c) acc[c] = (f32x4){0.f, 0.f, 0.f, 0.f};
        for (int sl = 0; sl < nsl; ++sl) {
            if (sl + 1 < nsl) asm volatile("s_waitcnt vmcnt(3)" ::: "memory"); else asm volatile("s_waitcnt vmcnt(0)" ::: "memory");
            __builtin_amdgcn_s_barrier(); asm volatile("" ::: "memory");
            if (sl + 2 < nsl) SGA_STAGE(sl + 2);
            LAS unsigned char* b_ = lds + (sl & 3) * SLOT;
#pragma unroll
            for (int ks = 0; ks < 2; ++ks) {
                const bf16x8 a = *(const LAS bf16x8*)(b_ + aoff + ks * 1024);
#pragma unroll
                for (int c = 0; c < 4; ++c) { const bf16x8 b = *(const LAS bf16x8*)(b_ + boff + c * 2048 + ks * 1024);
                    acc[c] = __builtin_amdgcn_mfma_f32_16x16x32_bf16(b, a, acc[c], 0, 0, 0); }
                q += sq8(a);
            }
        }
#undef SGA_STAGE
        q += shx(q, 16, lane); q += shx(q, 32, lane);
        const float rstd = 1.0f / sqrtf(q * (1.f / 1024.f) + EPS);
        asm volatile("s_waitcnt lgkmcnt(0)" ::: "memory"); __builtin_amdgcn_s_barrier(); asm volatile("" ::: "memory");
        LAS float* T = (LAS float*)(lds + ch * 20480);
#pragma unroll
        for (int c = 0; c < 4; ++c)
#pragma unroll
            for (int j = 0; j < 4; ++j) T[(rt * 16 + fr) * 65 + c * 16 + fq * 4 + j] = acc[c][j] * rstd;
        asm volatile("s_waitcnt lgkmcnt(0)" ::: "memory"); __builtin_amdgcn_s_barrier(); asm volatile("" ::: "memory");
        {
            const LAS float* Gt = (const LAS float*)lds; const LAS float* Ut = (const LAS float*)(lds + 20480);
            const int r = tid >> 3, f8 = (tid & 7) * 8, b = rg * 2 + (r >> 5), rr = r & 31, f = fg * 64 + f8;
            const float* st = scf + (size_t)(b * 2) * DFF + f;
            float hv[8], gv[8];
#pragma unroll
            for (int k = 0; k < 8; ++k) {
                const float g0 = Gt[r * 65 + f8 + k];
                const float gm1 = rr >= 1 ? Gt[(r - 1) * 65 + f8 + k] : st[DFF + k];
                const float gm2 = rr >= 2 ? Gt[(r - 2) * 65 + f8 + k] : (rr == 1 ? st[DFF + k] : st[k]);
                const float cv = cfw[f + k] * gm2 + cfw[DFF + f + k] * gm1 + cfw[2 * DFF + f + k] * g0;
                hv[k] = silu(cv) * Ut[r * 65 + f8 + k]; gv[k] = g0;
            }
            u32x4 w; w.x = pk2(hv[0], hv[1]); w.y = pk2(hv[2], hv[3]); w.z = pk2(hv[4], hv[5]); w.w = pk2(hv[6], hv[7]);
            *(u32x4*)(Hs + (size_t)(rg * 64 + r) * DFF + f) = w;
            if (rr >= 30) { float* o = ocf + ((size_t)b * 2 + (rr - 30)) * DFF + f; *(f32x4*)o = (f32x4){gv[0], gv[1], gv[2], gv[3]}; *(f32x4*)(o + 4) = (f32x4){gv[4], gv[5], gv[6], gv[7]}; }
        }
        asm volatile("s_waitcnt vmcnt(0) lgkmcnt(0)" ::: "memory"); __builtin_amdgcn_s_barrier(); asm volatile("" ::: "memory");
    }
}
__device__ __forceinline__ void sample_ss_reduce(const float* sss, float* ssq, int tid) {
    if (tid < 256) { const f32x4* p = (const f32x4*)(sss + tid * 32); float t = 0.f;
#pragma unroll
        for (int i = 0; i < 8; ++i) { const f32x4 v = p[i]; t += (v[0] + v[1]) + (v[2] + v[3]); }
        *(f32x4*)(ssq + (size_t)(MP + tid) * 4) = (f32x4){t, 0.f, 0.f, 0.f}; }
    asm volatile("s_waitcnt vmcnt(0)" ::: "memory"); __syncthreads();
}

__device__ __forceinline__ void transpose_item(const float* W, int K, int N, bf16_t* WT, LAS float* scr, int item, int lane, const float* gain = nullptr, int gu = 0) {
    const int nblk = N / 32, kb = item / nblk, nb = item % nblk, k0 = 64 * kb, n0 = 32 * nb;
    {
        f32x4 v[8];
#pragma unroll
        for (int i = 0; i < 8; ++i) v[i] = __builtin_nontemporal_load((const f32x4*)(W + (size_t)(k0 + (lane >> 3) + 8 * i) * N + n0 + (lane & 7) * 4));
#pragma unroll
        for (int i = 0; i < 8; ++i) { const int kk = (lane >> 3) + 8 * i; f32x4 w = v[i]; if (gain) w = w * gain[k0 + kk];
            LAS float* d = scr + kk * 33 + (lane & 7) * 4; d[0] = w[0]; d[1] = w[1]; d[2] = w[2]; d[3] = w[3]; }
    }
    LDS_WAIT();
    const int c = lane & 7;
#pragma unroll
    for (int j = 0; j < 4; ++j) { const int n = (lane >> 3) + 8 * j; const LAS float* s = scr + (8 * c) * 33 + n;
        u32x4 o; o.x = pk2(s[0 * 33], s[1 * 33]); o.y = pk2(s[2 * 33], s[3 * 33]); o.z = pk2(s[4 * 33], s[5 * 33]); o.w = pk2(s[6 * 33], s[7 * 33]);
        int drow = n0 + n; if (gu) { const int up = drow >= gu, f = up ? drow - gu : drow; drow = ((f >> 7) << 8) + (up << 7) + (f & 127); }
        *(u32x4*)(WT + (size_t)drow * K + k0 + 8 * c) = o; }
    LDS_WAIT();
}

__device__ __forceinline__ void first_rows(const float* Xp, const float* Xs, bf16_t* XNo, float* ss, int gw, int NGW, int lane) {
    for (int m0 = gw; m0 < MT; m0 += 2 * NGW) {
        const int m1 = m0 + NGW; const bool two = m1 < MT; const int mb = two ? m1 : m0;
        const f32x4* xa = (const f32x4*)(m0 < MP ? Xp + (size_t)m0 * D : Xs + (size_t)(m0 - MP) * D) + lane;
        const f32x4* xb = (const f32x4*)(mb < MP ? Xp + (size_t)mb * D : Xs + (size_t)(mb - MP) * D) + lane;
        f32x4 va[4], vb[4]; float sa = 0.f, sb = 0.f;
#pragma unroll
        for (int j = 0; j < 4; ++j) { va[j] = __builtin_nontemporal_load(xa + 64 * j); vb[j] = __builtin_nontemporal_load(xb + 64 * j); }
#pragma unroll
        for (int j = 0; j < 4; ++j) { sa += (va[j].x * va[j].x + va[j].y * va[j].y) + (va[j].z * va[j].z + va[j].w * va[j].w); sb += (vb[j].x * vb[j].x + vb[j].y * vb[j].y) + (vb[j].z * vb[j].z + vb[j].w * vb[j].w); }
        sa = wave_sum(sa, lane); sb = wave_sum(sb, lane);
        if (lane < 4) { ss[(size_t)m0 * 4 + lane] = lane == 0 ? sa : 0.f; if (two) ss[(size_t)m1 * 4 + lane] = lane == 0 ? sb : 0.f; }
        u32x2* oa = (u32x2*)(XNo + (size_t)m0 * D) + lane; u32x2* ob = (u32x2*)(XNo + (size_t)mb * D) + lane;
#pragma unroll
        for (int j = 0; j < 4; ++j) { u32x2 w; w.x = pk2(va[j].x, va[j].y); w.y = pk2(va[j].z, va[j].w); oa[64 * j] = w; if (two) { w.x = pk2(vb[j].x, vb[j].y); w.y = pk2(vb[j].z, vb[j].w); ob[64 * j] = w; } }
    }
}

typedef __attribute__((address_space(4))) const unsigned char* kptr_t;
typedef const float* cfp_t; typedef float* fp_t; typedef unsigned char* ucp_t;
#define INP(k) (*(const __attribute__((address_space(4))) cfp_t*)(kp + 8 * (k)))
#define X out
#define WIN_T ((bf16_t*)(ws + WS_WIN + wsel))
#define WOUT_T ((bf16_t*)(ws + WS_WOUT + wsel))
#define WQ_T ((bf16_t*)(ws + WS_WQ + wsel))
#define WK_T ((bf16_t*)(ws + WS_WK + wsel))
#define WV_T ((bf16_t*)(ws + WS_WV + wsel))
#define WO_T ((bf16_t*)(ws + WS_WO + wsel))
#define WUP_T ((bf16_t*)(ws + WS_WUP + wsel))
#define WDN_T ((bf16_t*)(ws + WS_WDN + wsel))
#define MEMB ((bf16_t*)(ws + WS_MEMB))
#define KBP ((bf16_t*)(ws + WS_KBP))
#define VTP ((bf16_t*)(ws + WS_VTP))
#define KBS ((bf16_t*)(ws + WS_KBS + ksel))
#define VTS ((bf16_t*)(ws + WS_VTS + ksel))
#define WST ((bf16_t*)(ws + WS_WST + ksel))
#define AGG ((float*)(ws + WS_AGG))
#define SSQ(i) ((float*)(ws + WS_SSP) + (size_t)(i) * MT * 4)
#define SSS(i) ((float*)(ws + WS_SSS) + (size_t)(i) * 256 * 32)
#define GT_R ((bf16_t*)(ws + WS_GT + ksel))
#define GT_I ((bf16_t*)(ws + WS_GT + 65536 + ksel))
#define XN ((bf16_t*)(ws + WS_XN))
#define gZ ((bf16_t*)(ws + B_Z))
#define HLOC ((bf16_t*)(ws + B_HLOC))
#define PCUM ((bf16_t*)(ws + B_PCUM))
#define gY ((bf16_t*)(ws + B_Y))
#define gQ ((bf16_t*)(ws + B_Q))
#define gP ((bf16_t*)(ws + B_P))
#define gO ((bf16_t*)(ws + B_O))
#define PS ((bf16_t*)(ws + B_PS))
#define GU ((bf16_t*)(ws + B_GU))
#define GUS ((bf16_t*)(ws + B_GUS))
#define SBG ((float*)(ws + B_SBG))
#define SBU ((float*)(ws + B_SBU))
#define SBL ((float*)(ws + B_SBL))
__device__ __forceinline__ void convert_layer(kptr_t kp, unsigned char* ws, LAS unsigned char* lds, const int l, const int part, const int nparts, const int gw, const int NGW, const int gt, const int NGT, const int lane, const int wave) {
            const size_t wsel = (size_t)(l & 1) * WSEL1, ksel = (size_t)(l & 1) * KSEL1;
            LAS float* scr = (LAS float*)(lds + wave * 16384);
            const float* w_in = INP(I_WIN) + (size_t)l * D * INC; const float* w_out = INP(I_WOUT) + (size_t)l * D * D; const float* w_q = INP(I_WQ) + (size_t)l * D * D;
            const float* w_k = INP(I_WK) + (size_t)l * D * D; const float* w_v = INP(I_WV) + (size_t)l * D * D; const float* w_o = INP(I_WO) + (size_t)l * D * D;
            const float* w_up = INP(I_WUP) + (size_t)l * D * 2 * DFF; const float* w_dn = INP(I_WDN) + (size_t)l * DFF * D; const float* c_v = INP(I_CV) + (size_t)l * BS * NMEM * D;
            constexpr int T_IN = 16 * (INC / 32), T_SQ = 16 * 32, T_UP = 16 * (2 * DFF / 32), T_DN = (DFF / 64) * 32, T_CV = 32 * 32;
            constexpr int T_G = 16;
            constexpr int NIT = T_IN + 5 * T_SQ + T_UP + T_DN + T_CV + 2 * T_G;
            for (int it = (NIT * part) / nparts + gw; it < (NIT * (part + 1)) / nparts; it += NGW) {
                int r = it;
                if (r < T_IN) { transpose_item(w_in, D, INC, WIN_T, scr, r, lane, INP(I_GMIX) + l * D); continue; } r -= T_IN;
                if (r < T_SQ) { transpose_item(w_out, D, D, WOUT_T, scr, r, lane); continue; } r -= T_SQ;
                if (r < T_SQ) { transpose_item(w_q, D, D, WQ_T, scr, r, lane, INP(I_GX) + l * D); continue; } r -= T_SQ;
                if (r < T_SQ) { transpose_item(w_k, D, D, WK_T, scr, r, lane); continue; } r -= T_SQ;
                if (r < T_SQ) { transpose_item(w_v, D, D, WV_T, scr, r, lane); continue; } r -= T_SQ;
                if (r < T_SQ) { transpose_item(w_o, D, D, WO_T, scr, r, lane); continue; } r -= T_SQ;
                if (r < T_UP) { transpose_item(w_up, D, 2 * DFF, WUP_T, scr, r, lane, INP(I_GFFN) + l * D, DFF); continue; } r -= T_UP;
                if (r < T_DN) { transpose_item(w_dn, DFF, D, WDN_T, scr, r, lane); continue; } r -= T_DN;
                if (r < T_CV) { transpose_item(c_v, BS * NMEM, D, VTS, scr, r, lane); continue; } r -= T_CV;
                if (r < T_G) { transpose_item(INP(I_WRG) + ((size_t)l * 8 + (r >> 1)) * 4096, 64, 64, GT_R + (r >> 1) * 4096, scr, r & 1, lane); continue; } r -= T_G;
                transpose_item(INP(I_WIG) + ((size_t)l * 8 + (r >> 1)) * 4096, 64, 64, GT_I + (r >> 1) * 4096, scr, r & 1, lane);
            }
            if (part == 0) {
                const f32x4* ck = (const f32x4*)(INP(I_CK) + (size_t)l * BS * NMEM * D); u32x2* dk = (u32x2*)KBS;
                for (int i = gt; i < BS * NMEM * D / 4; i += NGT) { const f32x4 v = ck[i]; u32x2 w; w.x = pk2(v.x, v.y); w.y = pk2(v.z, v.w); dk[i] = w; }
                if (l == 0) { const f32x4* mm = (const f32x4*)INP(I_MEM); u32x2* dm = (u32x2*)MEMB;
                    for (int i = gt; i < BP * NMEM * D / 4; i += NGT) { const f32x4 v = mm[i]; u32x2 w; w.x = pk2(v.x, v.y); w.y = pk2(v.z, v.w); dm[i] = w; } }
                const float* wsl = INP(I_WS) + (size_t)l * 4 * 128 * 128;
                for (int i = gt; i < 4 * 128 * 128; i += NGT) { const int s = i & 127, t = (i >> 7) & 127; WST[i] = (bf16_t)f2bf(s <= t ? wsl[i] : 0.f); }
            }
}

__global__ void __launch_bounds__(NTHREADS, 2) trunk_fwd(Args args) {
    extern __shared__ __attribute__((aligned(16))) unsigned char lds_raw[];
    LAS unsigned char* lds = (LAS unsigned char*)lds_raw;
    cg::grid_group grid = cg::this_grid();
    const int wave_s = __builtin_amdgcn_readfirstlane(threadIdx.x >> 6);
#define LANE_STATE() int G = gridDim.x, bid = blockIdx.x; asm volatile("" : "+s"(G), "+s"(bid)); const int NGW = G * NWAVES, NGT = G * NTHREADS; (void)NGW; (void)NGT; \
    const int tid = opaque_tid(wave_s), lane = tid & 63, wave = wave_s; const int gw = bid * NWAVES + wave; const int gt = bid * NTHREADS + tid; (void)lane; (void)gw; (void)gt; \
    kptr_t kp = (kptr_t)__builtin_amdgcn_kernarg_segment_ptr(); asm volatile("" : "+s"(kp)); \
    float* const out = *(const __attribute__((address_space(4))) fp_t*)(kp + 8 * N_IN); unsigned char* const ws = *(const __attribute__((address_space(4))) ucp_t*)(kp + 8 * N_IN + 8); (void)out; (void)ws
    {
        LANE_STATE();
        if (bid == 0) for (int i = tid; i < XCD_BAR_WORDS; i += NTHREADS) __hip_atomic_store((unsigned*)(ws + WS_BAR) + i, 0u, __ATOMIC_RELAXED, __HIP_MEMORY_SCOPE_AGENT);
        if (tid < 32) ((LAS unsigned*)(lds + LDS_MISC))[tid] = 0u;
        __threadfence();
        grid.sync();
        if (tid == 0) (void)xb_add((unsigned*)(ws + WS_BAR) + XB_XCNT(xb_xcc_id()), 1u);
    }
#define GRID_SYNC() do { kptr_t kp_ = (kptr_t)__builtin_amdgcn_kernarg_segment_ptr(); asm volatile("" : "+s"(kp_)); \
        XcdBarrier b_; b_.bar = (unsigned*)(*(const __attribute__((address_space(4))) ucp_t*)(kp_ + 8 * N_IN + 8) + WS_BAR); b_.x = xb_xcc_id(); b_.st = (volatile LAS unsigned*)(lds + LDS_MISC); \
        xcd_barrier(b_); if (PROBE == 3) xcd_barrier(b_); } while (0)

    for (int l = 0; l < DEPTH; ++l) {
        const size_t wsel = (size_t)(l & 1) * WSEL1, ksel = (size_t)(l & 1) * KSEL1;
        if (l == 0)
        for (int dup0 = 0; dup0 < ((PROBE == 1 || PROBE == 5) ? 2 : 1); ++dup0) {
        {
            LANE_STATE();
            convert_layer(kp, ws, lds, l, 0, 1, gw, NGW, gt, NGT, lane, wave);
            if (l == 0) first_rows(INP(I_XP), INP(I_XS), XN, SSQ(0), gw, NGW, lane);
        }
        GRID_SYNC();
        }
        {
            LANE_STATE();
            KVSched S; S.G = G; S.c = bid >= 160 ? bid - 160 : -1; S.ws = (const char*)ws; S.wsel = wsel;
            pg8::Gemm g{(const bf16_t*)nullptr, (const bf16_t*)nullptr, D, D, D};
            pg8::EpiKV E{out + O_MKP + (size_t)l * BP * NMEM * D, out + O_MVP + (size_t)l * BP * NMEM * D, KBP, VTP};
            pg8::gemm_phase<pg8::EpiKV, KVSched, true>(lds, g, S, E, wave_s);
        }
#define GEMM_BF16(s_) do { const int s = (s_); pg8::GSched S; pg8::Gemm g; pg8::EpiBf16 E; E.scale = 1.f; E.ss = nullptr; E.smp = 0; \
        if (s == 0) { S.init(MT / 256, INC / 256, G, bid); S.aPm = (size_t)256 * D * 2; S.bPn = (size_t)256 * D * 2; g = pg8::Gemm{XN, WIN_T, D, D, D}; E.O = gZ; E.ldc = INC; E.ss = SSQ(3 * l); } \
        else if (s == 1) { S.init(MP / 256, D / 256, G, bid); S.aPm = (size_t)256 * D * 2; S.bPn = (size_t)256 * D * 2; g = pg8::Gemm{XN, WQ_T, D, D, D}; E.O = gQ; E.ldc = D; E.scale = 0.0625f; E.ss = SSQ(3 * l + 1); } \
        else if (s == 2) { S.init(MP / 256, 4, G, bid); S.aPm = (size_t)256 * D * 2; S.aPn = 512; S.bPn = (size_t)256 * 2048 * 2; S.bPm = 512; S.bShift = 4; g = pg8::Gemm{gP, VTP, D, 2048, 256}; E.O = gO; E.ldc = D; } \
        else { S.init(1, 32, G, (bid + G - 64) % G); S.mode = 2; g = pg8::Gemm{PS, VTS, 8192, 2048, 256}; E.O = gO + (size_t)MP * D; E.ldc = D; E.smp = 1; } \
        pg8::gemm_phase<pg8::EpiBf16, pg8::GSched, true>(lds, g, S, E, wave_s); } while (0)
#define GEMM_RES(s_) do { const int s = (s_); pg8::GSched S; S.init(MP / 256, D / 256, G, bid); pg8::Gemm g; \
        if (s == 0) { g = pg8::Gemm{gY, WOUT_T, D, D, D}; S.aPm = (size_t)256 * D * 2; } \
        else if (s == 1) { g = pg8::Gemm{gO, WO_T, D, D, D}; S.aPm = (size_t)256 * D * 2; } \
        else { g = pg8::Gemm{GU, WDN_T, DFF, DFF, DFF}; S.aPm = (size_t)256 * DFF * 2; } \
        S.bPn = (size_t)256 * g.ldb * 2; \
        pg8::EpiResid E{XN, SSQ(3 * l + 1 + s)}; \
        pg8::gemm_phase<pg8::EpiResid, pg8::GSched, true>(lds, g, S, E, wave_s); } while (0)

        for (int rep = 0; rep < 13; ++rep) { if (rep == 4 || rep == 9 || rep == 11) continue;
          const int ndup = ((PROBE == 1 && (rep == 1 || rep == 2)) || (PROBE == 4 && rep == 1) || (PROBE == 6 && rep == 2)) ? 2 : ((PROBE == 2 && (rep == 0 || rep == 5 || rep == 6 || rep == 7 || rep == 10)) ? 2 : 1);
          for (int dup = 0; dup < ndup; ++dup) {
            if (rep == 0 || rep == 5 || rep == 7) {
                LANE_STATE();
                const int s0 = rep == 0 ? 0 : (rep == 5 ? 1 : 2), ns = rep == 7 ? 2 : 1;
                if (rep == 0 && l > 0) {
                    pg8::GSched S0; S0.init(MT / 256, INC / 256, G, bid); pg8::Unit u0; bool own = false;
                    for (int i = 0; S0.next(i, u0); ++i) own = own || (u0.pm == 128);
                    if (own) sample_ss_reduce(SSS(3 * l), SSQ(3 * l), tid);
                }
                for (int q = 0; q < ns; ++q) GEMM_BF16(s0 + q);
                if (rep == 5) { LANE_STATE(); const SG2 sg{XN + (size_t)MP * D, WQ_T, D, D, D, D, gQ + (size_t)MP * D, D, 0.0625f, 1, nullptr}; sgemm2(lds, sg, bid, G, wave, tid); }
                if (rep == 5 && l + 1 < DEPTH) { LANE_STATE(); if (bid >= 64) convert_layer(kp, ws, lds, l + 1, 1, 4, gw - 64 * NWAVES, NGW - 64 * NWAVES, gt - 64 * NTHREADS, NGT - 64 * NTHREADS, lane, wave); }
            } else if (rep == 10) {
                LANE_STATE();
                pg8::GSched S; S.init(MP / 256, 2 * DFF / 256, G, bid); S.aPm = (size_t)256 * D * 2; S.bPn = (size_t)256 * D * 2;
                const pg8::Gemm g{XN, WUP_T, D, D, D};
                const pg8::EpiAct E{GU, INP(I_SCF) + (size_t)l * BS * 2 * DFF, out + O_CFS + (size_t)l * BS * 2 * DFF, SBG, SBU, SBL, INP(I_CFW) + (size_t)l * 3 * DFF, SSQ(3 * l + 2)};
                pg8::gemm_phase<pg8::EpiAct, pg8::GSched, true>(lds, g, S, E, wave_s);
                { LANE_STATE(); sgemm_act(lds, XN + (size_t)MP * D, WUP_T, GU + (size_t)MP * DFF, INP(I_CFW) + (size_t)l * 3 * DFF, INP(I_SCF) + (size_t)l * BS * 2 * DFF, out + O_CFS + (size_t)l * BS * 2 * DFF, bid, G, wave, tid); }
            } else if (rep == 1) {
                LANE_STATE();
                {
                    LAS bf16_t* vT = (LAS bf16_t*)lds;
                    constexpr int VP = 136;
                    const float* gvp = INP(I_GV) + l * CW; const float* bsp = INP(I_BSS) + l * 4 * 128;
                    for (int un = (bid + G / 2) % G; un < 8 + 256; un += G) {
                        int rowbase, nrows, sb = -1;
                        if (un < 8) { sb = un; rowbase = MP + un * TS; nrows = TS; } else { rowbase = (un - 8) * 128; nrows = 128; }
                        {
                            const int rl = tid >> 5, cgp = tid & 31;
                            f32x4 g0 = *(const f32x4*)(gvp + cgp * 8), g1 = *(const f32x4*)(gvp + cgp * 8 + 4);
                            for (int p = 0; p < nrows / 16; ++p) {
                                const int r = p * 16 + rl;
                                const u32x4 raw = *(const u32x4*)(gZ + (size_t)(rowbase + r) * INC + Z_VC + cgp * 8);
                                float v[8] = {bflo(raw.x), bfhi(raw.x), bflo(raw.y), bfhi(raw.y), bflo(raw.z), bfhi(raw.z), bflo(raw.w), bfhi(raw.w)};
                                float ss = 0.f;
#pragma unroll
                                for (int k = 0; k < 8; ++k) { v[k] = gelu_t(v[k]); ss += v[k] * v[k]; }
                                ss += shx(ss, 1, lane); ss += shx(ss, 2, lane); ss += shx(ss, 4, lane);
                                const float rstd = __builtin_amdgcn_rsqf(ss * (1.f / 64.f) + EPS);
                                const float gg[8] = {g0.x, g0.y, g0.z, g0.w, g1.x, g1.y, g1.z, g1.w};
#pragma unroll
                                for (int k = 0; k < 8; ++k) { v[k] = v[k] * rstd * gg[k]; vT[(cgp * 8 + k) * VP + r] = (bf16_t)f2bf(v[k]); }
                                if (sb >= 0) { float* vo = out + O_VCS + ((size_t)(l * BS + sb) * TS + r) * CW + cgp * 8;
                                    *(f32x4*)vo = (f32x4){v[0], v[1], v[2], v[3]}; *(f32x4*)(vo + 4) = (f32x4){v[4], v[5], v[6], v[7]}; }
                            }
                        }
                        __syncthreads();
                        {
                            const int hh = wave & 3, rh = wave >> 2, fr = lane & 15, fq = lane >> 4;
                            const int nmt = nrows == 128 ? 4 : (rh == 0 ? 2 : 0);
                            for (int mi = 0; mi < nmt; ++mi) {
                                const int mt = rh * 4 + mi, nks = (mt * 16 + 15) / 32 + 1;
                                f32x4 acc[4];
#pragma unroll
                                for (int n = 0; n < 4; ++n) acc[n] = (f32x4){0.f, 0.f, 0.f, 0.f};
                                for (int ks = 0; ks < nks; ++ks) {
                                    const bf16x8 a = *(const bf16x8*)(WST + ((size_t)(hh * 128 + mt * 16 + fr) * 128 + ks * 32 + fq * 8));
#pragma unroll
                                    for (int n = 0; n < 4; ++n) { const bf16x8 b = *(const LAS bf16x8*)(vT + (hh * 64 + n * 16 + fr) * VP + ks * 32 + fq * 8);
                                        acc[n] = __builtin_amdgcn_mfma_f32_16x16x32_bf16(b, a, acc[n], 0, 0, 0); }
                                }
                                { const int t = mt * 16 + fr; const float bias = bsp[hh * 128 + t]; const size_t row = (size_t)(rowbase + t);
#pragma unroll
                                    for (int n = 0; n < 4; ++n) { const int c = hh * 64 + n * 16 + fq * 4; const u32x2 uq = *(const u32x2*)(gZ + row * INC + Z_UC + c);
                                        u32x2 w; w.x = pk2(gelu_t(bflo(uq.x)) * (acc[n][0] + bias), gelu_t(bfhi(uq.x)) * (acc[n][1] + bias)); w.y = pk2(gelu_t(bflo(uq.y)) * (acc[n][2] + bias), gelu_t(bfhi(uq.y)) * (acc[n][3] + bias));
                                        *(u32x2*)(gY + row * D + 768 + c) = w; } }
                            }
                        }
                        __syncthreads();
                    }
                }
                {
                    LAS unsigned char* wl = lds + wave * 16384;
                    LAS bf16_t* tile = (LAS bf16_t*)wl;
                    LAS float* pre_r = (LAS float*)(wl + 2560);
                    LAS float* pre_i = (LAS float*)(wl + 2560 + 4096);
                    LAS float* xcf = (LAS float*)(wl + 2560 + 8192);
                    const int fr = lane & 15, fq = lane >> 4;
                    for (int un = gw; un < 64 + 2048; un += NGW) {
                        int b, hd, rowbase, nrows, t0; bool smp = un < 64;
                        if (smp) { b = un >> 3; hd = un & 7; rowbase = MP + b * TS; nrows = TS; t0 = 0; }
                        else { const int v = un - 64; const int ch = v & 31; hd = (v >> 5) & 7; b = v >> 8; t0 = ch * 128; rowbase = b * SEQ + t0; nrows = 128; }
                        const int cidx = l * AW + hd * 64 + lane;
                        const float br = INP(I_BRG)[cidx], bi = INP(I_BIG)[cidx];
                        const float c8sp = 8.0f * log1pf(__expf(-INP(I_LAM)[cidx]));
                        const float* caw = INP(I_CAW) + (size_t)l * 4 * AW + hd * 64 + lane;
                        const float cw0 = caw[0], cw1 = caw[AW], cw2 = caw[2 * AW], cw3 = caw[3 * AW], cb = INP(I_CAB)[cidx];
                        bf16x8 bR[4][2], bI[4][2];
#pragma unroll
                        for (int n = 0; n < 4; ++n)
#pragma unroll
                            for (int ks = 0; ks < 2; ++ks) { const size_t o_ = (size_t)(hd * 64 + n * 16 + fr) * 64 + ks * 32 + fq * 8;
                                bR[n][ks] = *(const bf16x8*)(GT_R + o_); bI[n][ks] = *(const bf16x8*)(GT_I + o_); }
                        float xm3 = 0.f, xm2 = 0.f, xm1 = 0.f;
                        if (smp) { const float* st = INP(I_SCA) + ((size_t)(l * BS + b) * 3) * AW + hd * 64 + lane; xm3 = st[0]; xm2 = st[AW]; xm1 = st[2 * AW]; }
                        else if (t0 > 0) { const bf16_t* zp = gZ + (size_t)(rowbase - 3) * INC + Z_XA + hd * 64 + lane; xm3 = bf2f(zp[0]); xm2 = bf2f(zp[INC]); xm1 = bf2f(zp[2 * INC]); }
                        float h = 0.f, pc = 1.f;
                        const bf16_t* zq = gZ + (size_t)(rowbase + (lane >> 3)) * INC + Z_XA + hd * 64 + (lane & 7) * 8;
                        unsigned* hp = (unsigned*)(HLOC + (size_t)rowbase * AW + hd * 64 + (lane & ~1)); unsigned* pp = (unsigned*)(PCUM + (size_t)rowbase * AW + hd * 64 + (lane & ~1));
                        LAS bf16_t* xraw = (LAS bf16_t*)pre_r;
                        u32x4 xn0 = *(const u32x4*)zq, xn1 = *(const u32x4*)(zq + (size_t)8 * INC);
                        for (int st = 0; st < nrows / 16; ++st) {
                            *(LAS u32x4*)(xraw + (lane >> 3) * 64 + (lane & 7) * 8) = xn0; *(LAS u32x4*)(xraw + ((lane >> 3) + 8) * 64 + (lane & 7) * 8) = xn1;
                            zq += (size_t)16 * INC;
                            if (st + 1 < nrows / 16) { xn0 = *(const u32x4*)zq; xn1 = *(const u32x4*)(zq + (size_t)8 * INC); }
                            LDS_WAIT();
#pragma unroll
                            for (int i = 0; i < 16; ++i) { const float xv = bf2f(xraw[i * 64 + lane]);
                                const float xc = cw0 * xm3 + cw1 * xm2 + cw2 * xm1 + cw3 * xv + cb; xm3 = xm2; xm2 = xm1; xm1 = xv; xcf[i * 64 + lane] = xc; tile[i * 72 + lane] = (bf16_t)f2bf(xc); }
                            LDS_WAIT();
                            const bf16x8 a0 = *(const LAS bf16x8*)(tile + fr * 72 + fq * 8), a1 = *(const LAS bf16x8*)(tile + fr * 72 + 32 + fq * 8);
#pragma unroll
                            for (int n = 0; n < 4; ++n) {
                                f32x4 ar = (f32x4){0.f, 0.f, 0.f, 0.f}, ai = (f32x4){0.f, 0.f, 0.f, 0.f};
                                ar = __builtin_amdgcn_mfma_f32_16x16x32_bf16(a0, bR[n][0], ar, 0, 0, 0); ar = __builtin_amdgcn_mfma_f32_16x16x32_bf16(a1, bR[n][1], ar, 0, 0, 0);
                                ai = __builtin_amdgcn_mfma_f32_16x16x32_bf16(a0, bI[n][0], ai, 0, 0, 0); ai = __builtin_amdgcn_mfma_f32_16x16x32_bf16(a1, bI[n][1], ai, 0, 0, 0);
#pragma unroll
                                for (int j = 0; j < 4; ++j) { pre_r[(fq * 4 + j) * 64 + n * 16 + fr] = ar[j]; pre_i[(fq * 4 + j) * 64 + n * 16 + fr] = ai[j]; }
                            }
                            LDS_WAIT();
#pragma unroll 4
                            for (int i = 0; i < 16; ++i) {
                                const float r = sigm(pre_r[i * 64 + lane] + br), gi = sigm(pre_i[i * 64 + lane] + bi);
                                const float la = -c8sp * r; float a, om;
                                if (la > -0.125f) { const float x = 2.0f * la; om = -x * (1.0f + x * (0.5f + x * (0.16666667f + x * (0.041666668f + x * (0.0083333338f + x * 0.0013888889f))))); a = 1.0f + la * (1.0f + la * (0.5f + la * (0.16666667f + la * (0.041666668f + la * 0.0083333338f)))); }
                                else { a = __expf(la); om = -expm1f(2.0f * la); }
                                const float bm = __builtin_amdgcn_sqrtf(om);
                                h = a * h + bm * gi * xcf[i * 64 + lane]; pc = pc * a;
                                { const float hn = __builtin_bit_cast(float, __builtin_amdgcn_mov_dpp(__builtin_bit_cast(int, h), 0xB1, 0xf, 0xf, true)), pn = __builtin_bit_cast(float, __builtin_amdgcn_mov_dpp(__builtin_bit_cast(int, pc), 0xB1, 0xf, 0xf, true));
                                  if ((lane & 1) == 0) { *hp = pk2(h, hn); *pp = pk2(pc, pn); } hp += AW / 2; pp += AW / 2; }
                            }
                            LDS_WAIT();
                        }
                        AGG[(size_t)un * 128 + lane] = pc; AGG[(size_t)un * 128 + 64 + lane] = h;
                    }
                }
                {
                    const float* cbw = INP(I_CBW) + (size_t)l * 3 * BW;
                    if (bid >= 8) for (int it = gt - 8 * NTHREADS; it < (MT / 8) * 32; it += NGT - 8 * NTHREADS) {
                        const int rb = it >> 5, c0 = (it & 31) * 8;
                        int b, t0, T, rowbase; const bool smp = rb >= MP / 8;
                        if (!smp) { b = rb >> 9; t0 = (rb & 511) * 8; T = SEQ; rowbase = rb * 8; } else { const int sbk = rb - MP / 8; b = sbk >> 2; t0 = (sbk & 3) * 8; T = TS; rowbase = MP + sbk * 8; }
                        u32x4 xq[10], cq[10], bq[8];
                        const bf16_t* zr = gZ + (size_t)rowbase * INC + c0;
#pragma unroll
                        for (int i = 0; i < 10; ++i) { if (i >= 2 || t0 > 0) { xq[i] = __builtin_nontemporal_load((const u32x4*)(zr + (ptrdiff_t)(i - 2) * INC + Z_XB)); cq[i] = __builtin_nontemporal_load((const u32x4*)(zr + (ptrdiff_t)(i - 2) * INC + Z_GC)); } else { xq[i] = (u32x4){0u, 0u, 0u, 0u}; cq[i] = (u32x4){0u, 0u, 0u, 0u}; } }
#pragma unroll
                        for (int i = 0; i < 8; ++i) bq[i] = __builtin_nontemporal_load((const u32x4*)(zr + (size_t)i * INC + Z_GB));
                        float w0[8], w1[8], w2[8], pm2[8], pm1[8];
#pragma unroll
                        for (int k = 0; k < 8; ++k) { w0[k] = cbw[c0 + k]; w1[k] = cbw[BW + c0 + k]; w2[k] = cbw[2 * BW + c0 + k]; }
                        {
                            const float a_[8] = {bflo(xq[0].x) * bflo(cq[0].x), bfhi(xq[0].x) * bfhi(cq[0].x), bflo(xq[0].y) * bflo(cq[0].y), bfhi(xq[0].y) * bfhi(cq[0].y), bflo(xq[0].z) * bflo(cq[0].z), bfhi(xq[0].z) * bfhi(cq[0].z), bflo(xq[0].w) * bflo(cq[0].w), bfhi(xq[0].w) * bfhi(cq[0].w)};
                            const float b_[8] = {bflo(xq[1].x) * bflo(cq[1].x), bfhi(xq[1].x) * bfhi(cq[1].x), bflo(xq[1].y) * bflo(cq[1].y), bfhi(xq[1].y) * bfhi(cq[1].y), bflo(xq[1].z) * bflo(cq[1].z), bfhi(xq[1].z) * bfhi(cq[1].z), bflo(xq[1].w) * bflo(cq[1].w), bfhi(xq[1].w) * bfhi(cq[1].w)};
#pragma unroll
                            for (int k = 0; k < 8; ++k) { pm2[k] = a_[k]; pm1[k] = b_[k]; }
                        }
                        if (t0 == 0 && smp) { const float* st = INP(I_SCB) + ((size_t)(l * BS + b) * 2) * BW + c0;
#pragma unroll
                            for (int k = 0; k < 8; ++k) { pm2[k] = st[k]; pm1[k] = st[BW + k]; } }
#pragma unroll
                        for (int i = 0; i < 8; ++i) {
                            const u32x4 xb = xq[i + 2], gc = cq[i + 2], gb = bq[i];
                            const float pv[8] = {bflo(xb.x) * bflo(gc.x), bfhi(xb.x) * bfhi(gc.x), bflo(xb.y) * bflo(gc.y), bfhi(xb.y) * bfhi(gc.y), bflo(xb.z) * bflo(gc.z), bfhi(xb.z) * bfhi(gc.z), bflo(xb.w) * bflo(gc.w), bfhi(xb.w) * bfhi(gc.w)};
                            const float gbv[8] = {bflo(gb.x), bfhi(gb.x), bflo(gb.y), bfhi(gb.y), bflo(gb.z), bfhi(gb.z), bflo(gb.w), bfhi(gb.w)};
                            float yv[8];
#pragma unroll
                            for (int k = 0; k < 8; ++k) { yv[k] = gbv[k] * (w0[k] * pm2[k] + w1[k] * pm1[k] + w2[k] * pv[k]); pm2[k] = pm1[k]; pm1[k] = pv[k]; }
                            u32x4 w; w.x = pk2(yv[0], yv[1]); w.y = pk2(yv[2], yv[3]); w.z = pk2(yv[4], yv[5]); w.w = pk2(yv[6], yv[7]);
                            *(u32x4*)(gY + (size_t)(rowbase + i) * D + 512 + c0) = w;
                        }
                        if (t0 + 8 == T) { float* o = out + (smp ? O_CBS : O_CBP) + ((size_t)(l * 8 + b) * 2) * BW + c0;
#pragma unroll
                            for (int k = 0; k < 8; ++k) { o[k] = pm2[k]; o[BW + k] = pm1[k]; } }
                    }
                }
            } else if (rep == 2) {
                LANE_STATE();
                {
                    LAS float* cr = (LAS float*)lds;
                    for (int un = bid; un < 8 + 256; un += G) {
                        int b, ch, rowbase, nrows; const bool smp = un < 8;
                        if (smp) { b = un; ch = 0; rowbase = MP + b * TS; nrows = TS; } else { const int v = un - 8; b = v >> 5; ch = v & 31; rowbase = b * SEQ + ch * 128; nrows = 128; }
                        {
                            const int c = tid, hd = c >> 6, ln = c & 63; float carry = 0.f;
                            if (smp) carry = INP(I_SHA)[(size_t)(l * BS + b) * AW + c];
                            else { const float* ag = AGG + (size_t)(64 + (b << 8) + (hd << 5)) * 128 + ln; for (int k = 0; k < ch; ++k) carry = ag[(size_t)k * 128] * carry + ag[(size_t)k * 128 + 64]; }
                            cr[c] = carry;
                        }
                        __syncthreads();
                        const int c0 = (tid & 63) * 8, rsub = tid >> 6;
                        const f32x4 ca = *(const LAS f32x4*)(cr + c0), cb = *(const LAS f32x4*)(cr + c0 + 4);
                        for (int p4 = 0; p4 < nrows / 8; p4 += 4) {
                            u32x4 hqv[4], pqv[4], gqv[4];
#pragma unroll
                            for (int q = 0; q < 4; ++q) { const size_t row = (size_t)(rowbase + (p4 + q) * 8 + rsub); hqv[q] = __builtin_nontemporal_load((const u32x4*)(HLOC + row * AW + c0)); pqv[q] = __builtin_nontemporal_load((const u32x4*)(PCUM + row * AW + c0)); gqv[q] = __builtin_nontemporal_load((const u32x4*)(gZ + row * INC + Z_GA + c0)); }
#pragma unroll
                            for (int q = 0; q < 4; ++q) {
                                const int rloc = (p4 + q) * 8 + rsub; const size_t row = (size_t)(rowbase + rloc);
                                const u32x4 hq = hqv[q], pq = pqv[q], gq = gqv[q];
                                const f32x4 h0 = (f32x4){bflo(hq.x), bfhi(hq.x), bflo(hq.y), bfhi(hq.y)}, h1 = (f32x4){bflo(hq.z), bfhi(hq.z), bflo(hq.w), bfhi(hq.w)}, p0 = (f32x4){bflo(pq.x), bfhi(pq.x), bflo(pq.y), bfhi(pq.y)}, p1 = (f32x4){bflo(pq.z), bfhi(pq.z), bflo(pq.w), bfhi(pq.w)};
                                const f32x4 a0 = h0 + p0 * ca, a1 = h1 + p1 * cb;
                                u32x4 w; w.x = pk2(gelu_t(bflo(gq.x)) * a0[0], gelu_t(bfhi(gq.x)) * a0[1]); w.y = pk2(gelu_t(bflo(gq.y)) * a0[2], gelu_t(bfhi(gq.y)) * a0[3]);
                                w.z = pk2(gelu_t(bflo(gq.z)) * a1[0], gelu_t(bfhi(gq.z)) * a1[1]); w.w = pk2(gelu_t(bflo(gq.w)) * a1[2], gelu_t(bfhi(gq.w)) * a1[3]);
                                *(u32x4*)(gY + row * D + c0) = w;
                                if ((smp || ch == 31) && rloc == nrows - 1) { float* o = out + (smp ? O_HAS : O_HAP) + (size_t)(l * 8 + b) * AW + c0; *(f32x4*)o = a0; *(f32x4*)(o + 4) = a1; }
                            }
                        }
                        if ((smp || ch == 31) && tid < 192) {
                            const int k = tid >> 6; const u32x4 xq = *(const u32x4*)(gZ + (size_t)(rowbase + nrows - 3 + k) * INC + Z_XA + c0);
                            float* o = out + (smp ? O_CAS : O_CAP) + ((size_t)(l * 8 + b) * 3 + k) * AW + c0;
                            *(f32x4*)o = (f32x4){bflo(xq.x), bfhi(xq.x), bflo(xq.y), bfhi(xq.y)}; *(f32x4*)(o + 4) = (f32x4){bflo(xq.z), bfhi(xq.z), bflo(xq.w), bfhi(xq.w)};
                        }
                        __syncthreads();
                    }
                }
            } else if (rep == 3 || rep == 8 || rep == 12) {
                LANE_STATE();
                if (rep == 12) {
                    const float* cfw = INP(I_CFW) + (size_t)l * 3 * DFF;
                    pg8::GSched S0; S0.init(MP / 256, D / 256, G, bid); pg8::Unit u0;
                    for (int i = 0; S0.next(i, u0); ++i) {
                        const int pm = u0.pm; if (pm >= 128 || tid >= DFF / 8) continue;
                        const int c0 = tid * 8, b = pm >> 4;
                        float w0[8], w1[8], w2[8], p2[8], p1[8], g0[8], g1[8], u0_[8], u1_[8];
#pragma unroll
                        for (int k = 0; k < 8; ++k) { w0[k] = cfw[c0 + k]; w1[k] = cfw[DFF + c0 + k]; w2[k] = cfw[2 * DFF + c0 + k]; p2[k] = 0.f; p1[k] = 0.f; }
                        if ((pm & 15) != 0) {
#pragma unroll
                            for (int k = 0; k < 8; ++k) { p2[k] = SBL[((size_t)(pm - 1) * 2 + 0) * DFF + c0 + k]; p1[k] = SBL[((size_t)(pm - 1) * 2 + 1) * DFF + c0 + k]; } }
#pragma unroll
                        for (int k = 0; k < 8; ++k) { g0[k] = SBG[((size_t)pm * 2 + 0) * DFF + c0 + k]; g1[k] = SBG[((size_t)pm * 2 + 1) * DFF + c0 + k]; u0_[k] = SBU[((size_t)pm * 2 + 0) * DFF + c0 + k]; u1_[k] = SBU[((size_t)pm * 2 + 1) * DFF + c0 + k]; }
                        float ha[8], hb[8];
#pragma unroll
                        for (int k = 0; k < 8; ++k) { ha[k] = silu(w0[k] * p2[k] + w1[k] * p1[k] + w2[k] * g0[k]) * u0_[k]; hb[k] = silu(w0[k] * p1[k] + w1[k] * g0[k] + w2[k] * g1[k]) * u1_[k]; }
                        u32x4 w; w.x = pk2(ha[0], ha[1]); w.y = pk2(ha[2], ha[3]); w.z = pk2(ha[4], ha[5]); w.w = pk2(ha[6], ha[7]);
                        *(u32x4*)(GU + (size_t)(pm * 256) * DFF + c0) = w;
                        w.x = pk2(hb[0], hb[1]); w.y = pk2(hb[2], hb[3]); w.z = pk2(hb[4], hb[5]); w.w = pk2(hb[6], hb[7]);
                        *(u32x4*)(GU + (size_t)(pm * 256 + 1) * DFF + c0) = w;
                        if ((pm & 15) == 15 && u0.pn == 0) { float* o = out + O_CFP + ((size_t)(l * 8 + b) * 2) * DFF + c0;
#pragma unroll
                            for (int k = 0; k < 8; ++k) { o[k] = SBL[((size_t)pm * 2 + 0) * DFF + c0 + k]; o[DFF + k] = SBL[((size_t)pm * 2 + 1) * DFF + c0 + k]; } }
                    }
                    asm volatile("s_waitcnt vmcnt(0)" ::: "memory"); __syncthreads();
                }
                GEMM_RES(rep == 3 ? 0 : (rep == 8 ? 1 : 2));
                { LANE_STATE();
                  const SG2 sg{rep == 12 ? GU + (size_t)MP * DFF : (rep == 3 ? gY : gO) + (size_t)MP * D, rep == 12 ? WDN_T : (rep == 3 ? WOUT_T : WO_T), rep == 12 ? DFF : D, rep == 12 ? DFF : D, rep == 12 ? DFF : D, D, XN + (size_t)MP * D, D, 1.f, 2, SSS(3 * l + (rep == 3 ? 1 : (rep == 8 ? 2 : 3)))};
                  sgemm2(lds, sg, bid, G, wave, tid); }
                if (l + 1 < DEPTH) { LANE_STATE(); if (bid >= 64) convert_layer(kp, ws, lds, l + 1, rep == 3 ? 0 : (rep == 8 ? 2 : 3), 4, gw - 64 * NWAVES, NGW - 64 * NWAVES, gt - 64 * NTHREADS, NGT - 64 * NTHREADS, lane, wave); }
            } else if (rep == 6) {
                LANE_STATE();
                for (int sub = 0; sub < 2; ++sub) {
                    pg8::GSched S; pg8::Gemm g; pg8::EpiSoftmax E;
                    if (sub == 0) { S.init(MP / 256, 4, G, bid); S.aPm = (size_t)256 * D * 2; S.aPn = 512; S.bPn = 512; S.bPm = (size_t)256 * D * 2; S.bShift = 4; g = pg8::Gemm{gQ, KBP, D, D, 256}; E.O = gP; E.ldc = D; E.smp = 0; }
                    else { S.init(1, 32, G, (bid + G - 64) % G); S.mode = 1; g = pg8::Gemm{gQ + (size_t)MP * D, KBS, D, D, 256}; E.O = PS; E.ldc = 8192; E.smp = 1; }
                    pg8::gemm_phase<pg8::EpiSoftmax, pg8::GSched, true>(lds, g, S, E, wave_s);
                }
            }
            if (rep == 6) { asm volatile("s_waitcnt vmcnt(0)" ::: "memory"); __syncthreads(); }
            else GRID_SYNC();
          }
        }
    }
    {
        LANE_STATE();
        const float* gain = INP(I_GFIN);
        f32x4 gv[4];
#pragma unroll
        for (int j = 0; j < 4; ++j) gv[j] = ((const f32x4*)gain)[lane + 64 * j];
        for (int m0 = gw; m0 < MT; m0 += 2 * NGW) {
            const int m1 = m0 + NGW; const bool two = m1 < MT; const int mb = two ? m1 : m0;
            const u32x2* xa = (const u32x2*)(XN + (size_t)m0 * D) + lane; const u32x2* xb = (const u32x2*)(XN + (size_t)mb * D) + lane;
            u32x2 pa[4], pb[4];
#pragma unroll
            for (int j = 0; j < 4; ++j) { pa[j] = __builtin_nontemporal_load(xa + 64 * j); pb[j] = __builtin_nontemporal_load(xb + 64 * j); }
            float ra, rb;
            { float qa = 0.f, qb = 0.f;
#pragma unroll
              for (int j = 0; j < 4; ++j) { const float a0 = bflo(pa[j].x), a1 = bfhi(pa[j].x), a2 = bflo(pa[j].y), a3 = bfhi(pa[j].y), b0 = bflo(pb[j].x), b1 = bfhi(pb[j].x), b2 = bflo(pb[j].y), b3 = bfhi(pb[j].y);
                  qa += (a0 * a0 + a1 * a1) + (a2 * a2 + a3 * a3); qb += (b0 * b0 + b1 * b1) + (b2 * b2 + b3 * b3); }
              if (m0 < MP) ra = ss_rstd(*(const f32x4*)(SSQ(6) + (size_t)m0 * 4)); else ra = 1.0f / sqrtf(wave_sum(qa, lane) * (1.f / D) + EPS);
              if (mb < MP) rb = ss_rstd(*(const f32x4*)(SSQ(6) + (size_t)mb * 4)); else rb = 1.0f / sqrtf(wave_sum(qb, lane) * (1.f / D) + EPS); }
            f32x4* ya = (f32x4*)(out + (size_t)m0 * D) + lane; f32x4* yb = (f32x4*)(out + (size_t)mb * D) + lane;
#pragma unroll
            for (int j = 0; j < 4; ++j) { __builtin_nontemporal_store((f32x4){bflo(pa[j].x), bfhi(pa[j].x), bflo(pa[j].y), bfhi(pa[j].y)} * ra * gv[j], ya + 64 * j); if (two) __builtin_nontemporal_store((f32x4){bflo(pb[j].x), bfhi(pb[j].x), bflo(pb[j].y), bfhi(pb[j].y)} * rb * gv[j], yb + 64 * j); }
        }
    }
}

extern "C" void kernel_launch(void* const* d_in, const int* in_sizes, int n_in, void* d_out, int out_size, void* d_ws, size_t ws_size, hipStream_t stream) {
    static int grid = 0;
    if (grid == 0) {
        if (n_in != N_IN || (size_t)out_size != O_END || ws_size < 512 * MiB) { fprintf(stderr, "kernel_launch: unexpected sizes n_in %d out %d ws %zu (need %zu)\n", n_in, out_size, ws_size, (size_t)(512 * MiB)); grid = -1; return; }
        int dev = 0, cus = 0, per_cu = 0;
        (void)hipGetDevice(&dev); (void)hipDeviceGetAttribute(&cus, hipDeviceAttributeMultiprocessorCount, dev);
        if (hipFuncSetAttribute((const void*)trunk_fwd, hipFuncAttributeMaxDynamicSharedMemorySize, LDS_BYTES) != hipSuccess) { fprintf(stderr, "kernel_launch: hipFuncSetAttribute failed\n"); grid = -1; return; }
        if (hipOccupancyMaxActiveBlocksPerMultiprocessor(&per_cu, (const void*)trunk_fwd, NTHREADS, LDS_BYTES) != hipSuccess || per_cu < 1) { fprintf(stderr, "kernel_launch: occupancy query gave %d\n", per_cu); per_cu = 1; }
        (void)hipGetLastError();
        grid = cus * 1;
        if (grid != 256) fprintf(stderr, "kernel_launch: note: %d CUs\n", grid);
    }
    if (grid < 0) return;
    Args a{};
    for (int i = 0; i < N_IN; ++i) a.in[i] = (const float*)d_in[i];
    a.out = (float*)d_out; a.ws = (unsigned char*)d_ws;
    void* kargs[] = {&a};
    hipError_t e = hipLaunchCooperativeKernel((const void*)trunk_fwd, dim3(grid), dim3(NTHREADS), kargs, LDS_BYTES, stream);
    if (e != hipSuccess) fprintf(stderr, "kernel_launch: cooperative launch failed: %s (grid %d)\n", hipGetErrorString(e), grid);
}
```

```cpp
#include <hip/hip_runtime.h>
#include <hip/hip_cooperative_groups.h>
#include <cstdio>
#include <cstdint>
namespace cg = cooperative_groups;
#ifndef PROBE
#define PROBE 0
#endif

#define LAS __attribute__((address_space(3)))
typedef unsigned short bf16_t;
typedef short bf16x8 __attribute__((ext_vector_type(8)));
typedef float f32x4 __attribute__((ext_vector_type(4)));
typedef float f32x2 __attribute__((ext_vector_type(2)));
typedef unsigned u32x4 __attribute__((ext_vector_type(4)));
typedef unsigned u32x2 __attribute__((ext_vector_type(2)));

constexpr int D = 1024, BP = 8, SEQ = 4096, BS = 8, TS = 32, DEPTH = 2;
constexpr int MP = BP * SEQ, MS = BS * TS, MT = MP + MS;
constexpr int INC = 2304, DFF = 2816, NMEM = 256, AW = 512, BW = 256, CW = 256;
constexpr int Z_XA = 0, Z_GA = 512, Z_XB = 1024, Z_GB = 1280, Z_GC = 1536, Z_UC = 1792, Z_VC = 2048;
constexpr float EPS = 1e-6f;
constexpr int NWAVES = 8, NTHREADS = 512;

constexpr size_t O_YP = 0, O_YS = O_YP + (size_t)MP * D, O_CAP = O_YS + (size_t)MS * D, O_HAP = O_CAP + DEPTH * BP * 3 * AW,
                 O_CBP = O_HAP + DEPTH * BP * AW, O_CFP = O_CBP + DEPTH * BP * 2 * BW, O_MKP = O_CFP + DEPTH * BP * 2 * DFF,
                 O_MVP = O_MKP + (size_t)DEPTH * BP * NMEM * D, O_CAS = O_MVP + (size_t)DEPTH * BP * NMEM * D, O_HAS = O_CAS + DEPTH * BS * 3 * AW,
                 O_CBS = O_HAS + DEPTH * BS * AW, O_CFS = O_CBS + DEPTH * BS * 2 * BW, O_VCS = O_CFS + DEPTH * BS * 2 * DFF,
                 O_END = O_VCS + DEPTH * BS * TS * CW;

constexpr size_t MiB = 1u << 20;
constexpr size_t WS_WIN = 0, WS_WOUT = 5 * MiB, WS_WQ = 7 * MiB, WS_WK = 9 * MiB, WS_WV = 11 * MiB, WS_WO = 13 * MiB, WS_WUP = 15 * MiB, WS_WDN = 26 * MiB;
constexpr size_t WS_MEMB = 32 * MiB, WS_KBP = 36 * MiB, WS_VTP = 40 * MiB, WS_KBS = 44 * MiB, WS_VTS = 48 * MiB, WS_WST = 52 * MiB, WS_GT = WS_WST + 131072, WS_AGG = 53 * MiB, WS_SS = 54 * MiB + 256 * 1024, WS_BAR = 55 * MiB + 512 * 1024;
constexpr size_t WS_XN = 56 * MiB, WS_BIG = 121 * MiB;
constexpr size_t B_Z = WS_BIG, B_HLOC = WS_BIG + 146 * MiB, B_PCUM = WS_BIG + 211 * MiB, B_Y = WS_BIG + 276 * MiB;
constexpr size_t B_Q = WS_BIG, B_P = WS_BIG + 65 * MiB, B_O = WS_BIG + 130 * MiB, B_PS = WS_BIG + 195 * MiB;
constexpr size_t B_GU = WS_BIG;
constexpr size_t B_GUS = WS_BIG + 200 * MiB;
constexpr size_t B_SBG = WS_BIG + 204 * MiB, B_SBU = WS_BIG + 207 * MiB, B_SBL = WS_BIG + 210 * MiB;
constexpr size_t WS_END = WS_BIG + (size_t)MT * 2 * DFF * 2;
constexpr size_t WS_SSP = 476 * MiB;
static_assert(WS_END <= WS_SSP && WS_SSP + (size_t)7 * MT * 64 <= 512 * MiB, "workspace");
static_assert(WS_XN + (size_t)MT * D * 2 <= WS_BIG, "xn");
constexpr size_t WS_SSS = WS_SSP + (((size_t)7 * MT * 16 + 4095) / 4096) * 4096;
static_assert(WS_SSS + 7 * 256 * 32 * 4 <= 480 * MiB, "sss");
constexpr size_t WSEL1 = 480 * MiB, KSEL1 = 418 * MiB;
static_assert(WS_WDN + (size_t)D * DFF * 2 + WSEL1 <= 512 * MiB && WS_KBS + KSEL1 >= WS_BIG + 341 * MiB && WS_GT + 131072 + KSEL1 <= WS_SSP, "second buffer set");

constexpr int LDS_RING = 131072, LDS_EX = LDS_RING, LDS_MISC = LDS_EX + 8192, LDS_BYTES = 147456;

enum { I_XP = 0, I_XS, I_MEM, I_CK, I_CV, I_SCA, I_SHA, I_SCB, I_SCF, I_GMIX, I_WIN, I_CAW, I_CAB, I_WRG, I_BRG, I_WIG, I_BIG, I_LAM, I_CBW, I_GV, I_WS, I_BSS,
       I_WOUT, I_GX, I_WQ, I_WK, I_WV, I_WO, I_GFFN, I_WUP, I_CFW, I_WDN, I_GFIN, N_IN };

struct Args { const float* in[N_IN]; float* out; unsigned char* ws; };

__device__ __forceinline__ unsigned pk2(float lo, float hi) { unsigned r; asm("v_cvt_pk_bf16_f32 %0, %1, %2" : "=v"(r) : "v"(lo), "v"(hi)); return r; }
__device__ __forceinline__ unsigned f2bf(float f) { return pk2(f, f) & 0xffffu; }
__device__ __forceinline__ float bf2f(unsigned v) { return __builtin_bit_cast(float, v << 16); }
__device__ __forceinline__ float bflo(unsigned w) { return __builtin_bit_cast(float, w << 16); }
__device__ __forceinline__ float bfhi(unsigned w) { return __builtin_bit_cast(float, w & 0xffff0000u); }
__device__ __forceinline__ unsigned cvt_pk_bf16(float lo, float hi) { unsigned r; asm volatile("v_cvt_pk_bf16_f32 %0, %1, %2" : "=v"(r) : "v"(lo), "v"(hi)); return r; }
__device__ __forceinline__ float fexp(float x) { return __builtin_amdgcn_exp2f(x * 1.4426950408889634f); }
__device__ __forceinline__ float sigm(float x) { return __builtin_amdgcn_rcpf(1.0f + fexp(-x)); }
__device__ __forceinline__ float gelu_t(float x) { const float u = 0.7978845608028654f * (x + 0.044715f * x * x * x); return x * sigm(2.0f * u); }
__device__ __forceinline__ float silu(float x) { return x * sigm(x); }
__device__ __forceinline__ float shx(float v, int m, int lane) { return __builtin_bit_cast(float, __builtin_amdgcn_ds_bpermute((lane ^ m) << 2, __builtin_bit_cast(int, v))); }
__device__ __forceinline__ float wave_sum(float v, int lane) {
#pragma unroll
    for (int o = 1; o < 64; o <<= 1) v += shx(v, o, lane);
    return v;
}
#define LDS_WAIT() asm volatile("s_waitcnt lgkmcnt(0)" ::: "memory")
__device__ __forceinline__ float ss_rstd(f32x4 p) { return __builtin_amdgcn_rsqf(((p[0] + p[1]) + (p[2] + p[3])) * (1.f / 1024.f) + 1e-6f); }
__device__ __forceinline__ int opaque_tid(int wave_s) { int l; asm volatile("v_mbcnt_lo_u32_b32 %0, -1, 0\n\tv_mbcnt_hi_u32_b32 %0, -1, %0" : "=v"(l)); return wave_s * 64 + l; }

namespace pg8 {
constexpr int BM = 256, BK = 64, HALF = 128, HTB = HALF * BK * 2, NXCD = 8, WGM = 8;
__device__ __forceinline__ int lds_byte(int r, int c) { const int st = (r >> 4) * 2 + (c >> 5), rr = r & 15, cc = c & 31, ob = rr * 64 + cc * 2; return st * 1024 + (ob ^ (((ob >> 9) & 1) << 5)); }
__device__ __forceinline__ void stage_rc(int b, int& R, int& C) { const int st = b / 1024, sb = b % 1024, swz = sb ^ (((sb >> 9) & 1) << 5); R = (st >> 1) * 16 + swz / 64; C = (st & 1) * 32 + (swz % 64) / 2; }
__device__ __forceinline__ int perm32(int rho) { const int n = rho >> 4, i = rho & 15; return 8 * (i >> 2) + 4 * n + (i & 3); }

struct Unit { int pm, pn; };
struct Gemm { const bf16_t* A; const bf16_t* Bt; int lda, ldb, K; };

struct GSched {
    int nM, nN, nwg, G, c, mode;
    size_t aPm, aPn, bPn, bPm; int bShift;
    __device__ __forceinline__ void init(int nM_, int nN_, int G_, int c_) { nM = nM_; nN = nN_; nwg = nM * nN; G = G_; c = c_; mode = 0; aPm = 0; aPn = 0; bPn = 0; bPm = 0; bShift = 0; }
    __device__ __forceinline__ bool next(int i, Unit& u) const {
        const long L = (long)i * G + c; if (L >= nwg) return false;
        int wgid = (int)L; { const int q = nwg / NXCD, r = nwg % NXCD, xcd = wgid % NXCD, off = wgid / NXCD; wgid = (xcd < r ? xcd * (q + 1) : r * (q + 1) + (xcd - r) * q) + off; }
        const int nig = WGM * nN, gid = wgid / nig, fm = gid * WGM, gsz = (nM - fm) < WGM ? (nM - fm) : WGM;
        u.pm = fm + ((wgid % nig) % gsz); u.pn = (wgid % nig) / gsz; return true;
    }
    __device__ __forceinline__ size_t offA(const Unit& u) const { return mode == 1 ? (size_t)(u.pn & 3) * 512 : (mode == 2 ? (size_t)(u.pn & 3) * 4096 + (size_t)(u.pn >> 2) * 512 : (size_t)u.pm * aPm + (size_t)u.pn * aPn); }
    __device__ __forceinline__ size_t offB(const Unit& u) const { return mode == 1 ? (size_t)(u.pn >> 2) * (256 * 1024 * 2) + (size_t)(u.pn & 3) * 512 : (mode == 2 ? (size_t)(u.pn & 3) * (256 * 2048 * 2) + (size_t)(u.pn >> 2) * 512 : (size_t)u.pn * bPn + (size_t)(u.pm >> bShift) * bPm); }
};

struct EpiBf16 {
    static constexpr bool PERM = true;
    bf16_t* O; int ldc; float scale; const float* ss; int smp;
    __device__ __forceinline__ void operator()(f32x4 (&acc)[2][2][4][2], const Unit& u, int wr, int wc, int fr, int fq, LAS unsigned char*) const {
        asm volatile("" : "+v"(fr), "+v"(fq)); asm volatile("" : "+s"(wr), "+s"(wc));
        const int row0 = u.pm * BM + wr * 64 + fr, col0 = (smp ? (u.pn & 3) : u.pn) * BM + wc * 32 + 8 * fq;
        f32x4 rs[2][4];
#pragma unroll
        for (int ai = 0; ai < 2; ++ai)
#pragma unroll
            for (int m = 0; m < 4; ++m) rs[ai][m] = ss ? *(const f32x4*)(ss + (size_t)(row0 + ai * HALF + m * 16) * 4) : (f32x4){0.f, 0.f, 0.f, 0.f};
#pragma unroll
        for (int ai = 0; ai < 2; ++ai)
#pragma unroll
            for (int m = 0; m < 4; ++m) { bf16_t* rowp = O + (size_t)(row0 + ai * HALF + m * 16) * ldc + col0;
                float sc = scale; if (ss) sc *= ss_rstd(rs[ai][m]);
                if (smp && ((ai * HALF + wr * 64 + m * 16 + fr) >> 5) != (u.pn >> 2)) continue;
#pragma unroll
                for (int bj = 0; bj < 2; ++bj) { const f32x4 v0 = acc[ai][bj][m][0] * sc, v1 = acc[ai][bj][m][1] * sc;
                    u32x4 w; w.x = cvt_pk_bf16(v0[0], v0[1]); w.y = cvt_pk_bf16(v0[2], v0[3]); w.z = cvt_pk_bf16(v1[0], v1[1]); w.w = cvt_pk_bf16(v1[2], v1[3]);
                    *(u32x4*)(rowp + bj * HALF) = w; } }
    }
};
struct EpiResid {
    static constexpr bool PERM = true;
    bf16_t* xb; float* ss;
    __device__ __forceinline__ void operator()(f32x4 (&acc)[2][2][4][2], const Unit& u, int wr, int wc, int fr, int fq, LAS unsigned char* lds) const {
        asm volatile("" : "+v"(fr), "+v"(fq)); asm volatile("" : "+s"(wr), "+s"(wc));
        const int col0 = u.pn * BM + wc * 32 + 8 * fq, lane = fq * 16 + fr;
        LAS float* PS = (LAS float*)(lds + LDS_EX);
        bf16_t* ob = xb + (size_t)u.pm * BM * D;
#pragma unroll
        for (int ai = 0; ai < 2; ++ai) {
            u32x4 pre[4][2];
#pragma unroll
            for (int m = 0; m < 4; ++m)
#pragma unroll
                for (int bj = 0; bj < 2; ++bj) pre[m][bj] = *(const u32x4*)(ob + (size_t)(ai * HALF + wr * 64 + m * 16 + fr) * D + col0 + bj * HALF);
            asm volatile("" ::: "memory");
#pragma unroll
            for (int m = 0; m < 4; ++m) { const int rl = ai * HALF + wr * 64 + m * 16 + fr; const size_t off = (size_t)rl * D + col0; float q = 0.f;
#pragma unroll
                for (int bj = 0; bj < 2; ++bj) { const u32x4 p = pre[m][bj]; const f32x4 a0 = acc[ai][bj][m][0], a1 = acc[ai][bj][m][1];
                    const float v0 = bflo(p.x) + a0[0], v1 = bfhi(p.x) + a0[1], v2 = bflo(p.y) + a0[2], v3 = bfhi(p.y) + a0[3], v4 = bflo(p.z) + a1[0], v5 = bfhi(p.z) + a1[1], v6 = bflo(p.w) + a1[2], v7 = bfhi(p.w) + a1[3];
                    u32x4 w; w.x = cvt_pk_bf16(v0, v1); w.y = cvt_pk_bf16(v2, v3); w.z = cvt_pk_bf16(v4, v5); w.w = cvt_pk_bf16(v6, v7); *(u32x4*)(ob + off + bj * HALF) = w;
                    q += ((v0 * v0 + v1 * v1) + (v2 * v2 + v3 * v3)) + ((v4 * v4 + v5 * v5) + (v6 * v6 + v7 * v7)); }
                q += shx(q, 16, lane); q += shx(q, 32, lane);
                if (fq == 0) PS[rl * 4 + wc] = q; }
            asm volatile("" ::: "memory");
        }
        asm volatile("s_waitcnt lgkmcnt(0)" ::: "memory"); __builtin_amdgcn_s_barrier(); asm volatile("" ::: "memory");
        { const int t = (wr * 4 + wc) * 64 + lane; if (t < 256) { const f32x4 p = *(const LAS f32x4*)(PS + t * 4); ss[(size_t)(u.pm * BM + t) * 4 + u.pn] = (p[0] + p[1]) + (p[2] + p[3]); } }
    }
};
struct EpiKV {
    static constexpr bool PERM = false;
    float* outK; float* outV; bf16_t* KB; bf16_t* VT;
    __device__ __forceinline__ void operator()(f32x4 (&acc)[2][2][4][2], const Unit& u, int wr, int wc, int fr, int fq, LAS unsigned char*) const {
        asm volatile("" : "+v"(fr), "+v"(fq)); asm volatile("" : "+s"(wr), "+s"(wc));
        const int kind = u.pm >> 4, pm = u.pm & 15;
        const int col0 = u.pn * BM + wc * 32 + 4 * fq;
        float* of = kind == 0 ? outK : outV; bf16_t* ob = kind == 0 ? KB : VT; const int ldb_ = kind == 2 ? 2048 : 1024;
#pragma unroll
        for (int ai = 0; ai < 2; ++ai)
#pragma unroll
            for (int m = 0; m < 4; ++m) { const int row = pm * BM + ai * HALF + wr * 64 + m * 16 + fr;
#pragma unroll
                for (int bj = 0; bj < 2; ++bj)
#pragma unroll
                    for (int n = 0; n < 2; ++n) { const f32x4 v = acc[ai][bj][m][n]; const int col = col0 + bj * HALF + n * 16;
                        if (kind != 2) __builtin_nontemporal_store(v, (f32x4*)(of + (size_t)row * 1024 + col));
                        if (kind != 1) { u32x2 w; w.x = cvt_pk_bf16(v[0], v[1]); w.y = cvt_pk_bf16(v[2], v[3]); *(u32x2*)(ob + (size_t)row * ldb_ + col) = w; } } }
    }
};
struct EpiSoftmax {
    static constexpr bool PERM = true;
    bf16_t* O; int ldc; int smp;
    __device__ __forceinline__ void operator()(f32x4 (&acc)[2][2][4][2], const Unit& u, int wr, int wc, int fr, int fq, LAS unsigned char* lds) const {
        asm volatile("" : "+v"(fr), "+v"(fq)); asm volatile("" : "+s"(wr), "+s"(wc));
        LAS f32x2* EX = (LAS f32x2*)(lds + LDS_EX);
        const int lane = fq * 16 + fr;
        const float L2E = 1.4426950408889634f;
#pragma unroll
        for (int ai = 0; ai < 2; ++ai)
#pragma unroll
            for (int m = 0; m < 4; ++m) {
                float mx = -3.0e38f;
#pragma unroll
                for (int bj = 0; bj < 2; ++bj)
#pragma unroll
                    for (int n = 0; n < 2; ++n) { const f32x4 x = acc[ai][bj][m][n]; mx = fmaxf(mx, fmaxf(fmaxf(x[0], x[1]), fmaxf(x[2], x[3]))); }
                mx = fmaxf(mx, shx(mx, 16, lane)); mx = fmaxf(mx, shx(mx, 32, lane));
                float s = 0.f;
#pragma unroll
                for (int bj = 0; bj < 2; ++bj)
#pragma unroll
                    for (int n = 0; n < 2; ++n) { f32x4 x = acc[ai][bj][m][n];
#pragma unroll
                        for (int j = 0; j < 4; ++j) { x[j] = __builtin_amdgcn_exp2f((x[j] - mx) * L2E); s += x[j]; }
                        acc[ai][bj][m][n] = x; }
                s += shx(s, 16, lane); s += shx(s, 32, lane);
                if (fq == 0) EX[(ai * HALF + wr * 64 + m * 16 + fr) * 4 + wc] = (f32x2){mx, s};
            }
        asm volatile("s_waitcnt lgkmcnt(0)" ::: "memory"); __builtin_amdgcn_s_barrier(); asm volatile("" ::: "memory");
        int colb = u.pn * BM, j_ = 0;
        if (smp) { colb = (u.pn & 3) * 2048 + (u.pn >> 2) * 256; j_ = u.pn >> 2; }
        const int col0 = colb + wc * 32 + 8 * fq;
#pragma unroll
        for (int ai = 0; ai < 2; ++ai)
#pragma unroll
            for (int m = 0; m < 4; ++m) {
                const int rl = ai * HALF + wr * 64 + m * 16 + fr;
                const f32x2 e0 = EX[rl * 4 + 0], e1 = EX[rl * 4 + 1], e2 = EX[rl * 4 + 2], e3 = EX[rl * 4 + 3];
                const float M = fmaxf(fmaxf(e0.x, e1.x), fmaxf(e2.x, e3.x));
                const float tot = e0.y * __builtin_amdgcn_exp2f((e0.x - M) * L2E) + e1.y * __builtin_amdgcn_exp2f((e1.x - M) * L2E) + e2.y * __builtin_amdgcn_exp2f((e2.x - M) * L2E) + e3.y * __builtin_amdgcn_exp2f((e3.x - M) * L2E);
                const float own = wc == 0 ? e0.x : (wc == 1 ? e1.x : (wc == 2 ? e2.x : e3.x));
                float f = __builtin_amdgcn_exp2f((own - M) * L2E) * __builtin_amdgcn_rcpf(tot);
                if (smp && (rl >> 5) != j_) f = 0.f;
                bf16_t* rowp = O + (size_t)(u.pm * BM + rl) * ldc + col0;
#pragma unroll
                for (int bj = 0; bj < 2; ++bj) { const f32x4 v0 = acc[ai][bj][m][0] * f, v1 = acc[ai][bj][m][1] * f;
                    u32x4 w; w.x = cvt_pk_bf16(v0[0], v0[1]); w.y = cvt_pk_bf16(v0[2], v0[3]); w.z = cvt_pk_bf16(v1[0], v1[1]); w.w = cvt_pk_bf16(v1[2], v1[3]);
                    *(u32x4*)(rowp + bj * HALF) = w; } }
    }
};


__device__ __forceinline__ float dpp_ror1(float v) { return __builtin_bit_cast(float, __builtin_amdgcn_update_dpp(0, __builtin_bit_cast(int, v), 0x121, 0xf, 0xf, false)); }
__device__ __forceinline__ float dpp_ror2(float v) { return __builtin_bit_cast(float, __builtin_amdgcn_update_dpp(0, __builtin_bit_cast(int, v), 0x122, 0xf, 0xf, false)); }
struct EpiAct {
    static constexpr bool PERM = true;
    bf16_t* H; const float* scf; float* ocf; float* sbg; float* sbu; float* sbl; const float* cfw; const float* ss;
    __device__ __forceinline__ void operator()(f32x4 (&acc)[2][2][4][2], const Unit& u, int wr, int wc, int fr, int fq, LAS unsigned char* lds) const {
        asm volatile("" : "+s"(wr), "+s"(wc));
        int lane; asm volatile("v_mbcnt_lo_u32_b32 %0, -1, 0\n\tv_mbcnt_hi_u32_b32 %0, -1, %0" : "=v"(lane));
        fr = lane & 15; fq = lane >> 4;
        const int fl = wc * 32 + 8 * fq, f0 = u.pn * 128 + fl; int rowt = wr * 64 + fr;
        {
            float rst[2][4];
            f32x4 rsl[2][4];
#pragma unroll
            for (int ai = 0; ai < 2; ++ai)
#pragma unroll
                for (int m = 0; m < 4; ++m) rsl[ai][m] = *(const f32x4*)(ss + (size_t)(u.pm * BM + ai * HALF + rowt + m * 16) * 4);
#pragma unroll
            for (int ai = 0; ai < 2; ++ai)
#pragma unroll
                for (int m = 0; m < 4; ++m) { rst[ai][m] = ss_rstd(rsl[ai][m]); }
#pragma unroll
            for (int ai = 0; ai < 2; ++ai)
#pragma unroll
                for (int m = 0; m < 4; ++m) { acc[ai][0][m][0] = acc[ai][0][m][0] * rst[ai][m]; acc[ai][0][m][1] = acc[ai][0][m][1] * rst[ai][m]; acc[ai][1][m][0] = acc[ai][1][m][0] * rst[ai][m]; acc[ai][1][m][1] = acc[ai][1][m][1] * rst[ai][m]; }
        }
        const bool smp = (u.pm == 128);
        asm volatile("" : "+v"(rowt));
        LAS float* BND = (LAS float*)(lds + LDS_EX);
        if (fr >= 14) {
#pragma unroll
            for (int ai = 0; ai < 2; ++ai)
#pragma unroll
                for (int n = 0; n < 2; ++n) *(LAS f32x4*)(BND + ((ai * 2 + wr) * 2 + (fr - 14)) * 128 + fl + 4 * n) = acc[ai][0][3][n];
            if (wr == 1) {
#pragma unroll
                for (int n = 0; n < 2; ++n) *(f32x4*)(sbl + ((size_t)u.pm * 2 + (fr - 14)) * DFF + f0 + 4 * n) = acc[1][0][3][n];
            }
        }
        asm volatile("s_waitcnt lgkmcnt(0)" ::: "memory"); __builtin_amdgcn_s_barrier(); asm volatile("" ::: "memory");
#pragma unroll
        for (int ai = 0; ai < 2; ++ai) {
            const int pg = wr == 1 ? ai * 2 : 1;
            u32x2 hp[2][4];
#pragma unroll
            for (int n = 0; n < 2; ++n) {
                const f32x4 w0 = *(const f32x4*)(cfw + f0 + 4 * n), w1 = *(const f32x4*)(cfw + DFF + f0 + 4 * n), w2 = *(const f32x4*)(cfw + 2 * DFF + f0 + 4 * n);
                f32x4 h2 = *(const LAS f32x4*)(BND + (pg * 2 + 0) * 128 + fl + 4 * n), h1 = *(const LAS f32x4*)(BND + (pg * 2 + 1) * 128 + fl + 4 * n);
                f32x4 t2 = h2, t1 = h1;
                if (smp) { const float* sp = scf + (size_t)((ai * 4 + wr * 2) * 2) * DFF + f0 + 4 * n; h2 = *(const f32x4*)sp; h1 = *(const f32x4*)(sp + DFF); t2 = *(const f32x4*)(sp + 2 * DFF); t1 = *(const f32x4*)(sp + 3 * DFF); }
#pragma unroll
                for (int jp = 0; jp < 2; ++jp) {
                    const int j0 = jp * 2, j1 = jp * 2 + 1;
                    const f32x2 w0p = {w0[j0], w0[j1]}, w1p = {w1[j0], w1[j1]}, w2p = {w2[j0], w2[j1]};
                    f32x2 r1p = {h1[j0], h1[j1]}, r2p = fr == 0 ? (f32x2){h2[j0], h2[j1]} : (f32x2){h1[j0], h1[j1]};
#pragma unroll
                    for (int m = 0; m < 4; ++m) {
                        const f32x2 g = {acc[ai][0][m][n][j0], acc[ai][0][m][n][j1]}, uu = {acc[ai][1][m][n][j0], acc[ai][1][m][n][j1]};
                        if (m == 2 && smp) { r1p = (f32x2){t1[j0], t1[j1]}; r2p = fr == 0 ? (f32x2){t2[j0], t2[j1]} : (f32x2){t1[j0], t1[j1]}; }
                        const f32x2 r1 = {dpp_ror1(g.x), dpp_ror1(g.y)}, r2 = {dpp_ror2(g.x), dpp_ror2(g.y)};
                        const f32x2 gm1 = fr >= 1 ? r1 : r1p, gm2 = fr >= 2 ? r2 : r2p;
                        r1p = r1; r2p = r2;
                        const f32x2 cv = w0p * gm2 + w1p * gm1 + w2p * g;
                        const f32x2 ex = cv * (-1.4426950408889634f);
                        f32x2 den; den.x = __builtin_amdgcn_exp2f(ex.x); den.y = __builtin_amdgcn_exp2f(ex.y); den = den + 1.0f;
                        f32x2 rc; rc.x = __builtin_amdgcn_rcpf(den.x); rc.y = __builtin_amdgcn_rcpf(den.y);
                        const f32x2 hv = (cv * rc) * uu;
                        const unsigned pk = cvt_pk_bf16(hv.x, hv.y); if (jp == 0) hp[n][m].x = pk; else hp[n][m].y = pk;
                    }
                }
            }
#pragma unroll
            for (int m = 0; m < 4; ++m) {
                const int rl = ai * HALF + rowt + m * 16;
                if (smp && (m & 1) && fr >= 14) {
#pragma unroll
                    for (int n = 0; n < 2; ++n) *(f32x4*)(ocf + ((size_t)(ai * 4 + wr * 2 + (m >> 1)) * 2 + (fr - 14)) * DFF + f0 + 4 * n) = acc[ai][0][m][n];
                }
                if (!smp && ai == 0 && m == 0 && wr == 0 && fr < 2) {
#pragma unroll
                    for (int n = 0; n < 2; ++n) { *(f32x4*)(sbg + ((size_t)u.pm * 2 + fr) * DFF + f0 + 4 * n) = acc[0][0][0][n]; *(f32x4*)(sbu + ((size_t)u.pm * 2 + fr) * DFF + f0 + 4 * n) = acc[0][1][0][n]; }
                } else {
                    u32x4 w; w.x = hp[0][m].x; w.y = hp[0][m].y; w.z = hp[1][m].x; w.w = hp[1][m].y;
                    __builtin_nontemporal_store(w, (u32x4*)(H + (size_t)(u.pm * BM + rl) * DFF + f0));
                }
            }
        }
    }
};

template <class Epi, class Sched, bool ALIGN_EPI>
__device__ __forceinline__ void gemm_phase(LAS unsigned char* lds, const Gemm g, const Sched& S, const Epi& E, const int wave_s) {
    const int tid = opaque_tid(wave_s), wid = __builtin_amdgcn_readfirstlane(tid >> 6), lane = tid & 63, wr = wid >> 2, wc = wid & 3, fr = lane & 15, fq = lane >> 4;
    const int nt = g.K / BK;
    unsigned voffA[2], voffB[2];
#pragma unroll
    for (int i = 0; i < 2; ++i) { int R, C; stage_rc(tid * 16 + i * 8192, R, C); const int Rb = Epi::PERM ? ((R & ~31) + perm32(R & 31)) : R;
        voffA[i] = (unsigned)(R * g.lda + C) * 2u; voffB[i] = (unsigned)(Rb * g.ldb + C) * 2u; }
    const size_t kstep = (size_t)(BK * 2);
    const size_t hstepA = (size_t)HALF * g.lda * 2, hstepB = (size_t)HALF * g.ldb * 2;
    const unsigned ldsw = (unsigned)wid * 1024u;
    const int aoff = lds_byte(wr * 64 + fr, fq * 8), boff = lds_byte(wc * 32 + fr, fq * 8);
#define PG8_SA(b, h) (((b) * 2 + (h)) * HTB)
#define PG8_SB(b, h) ((4 + (b) * 2 + (h)) * HTB)
#define PG8_STAGE(bufoff, gbase, voff) do { _Pragma("unroll") for (int _i = 0; _i < 2; ++_i) \
        __builtin_amdgcn_global_load_lds((const unsigned*)((const char*)(gbase) + (voff)[_i]), (LAS unsigned*)(lds + (bufoff) + ldsw + _i * 8192), 16, 0, 0); } while (0)
#define PG8_LDA(dst, b, h) do { _Pragma("unroll") for (int m = 0; m < 4; ++m) _Pragma("unroll") for (int k = 0; k < 2; ++k) dst[m][k] = *(const LAS bf16x8*)(lds + PG8_SA(b, h) + aoff + m * 2048 + k * 1024); } while (0)
#define PG8_LDB(dst, b, h) do { _Pragma("unroll") for (int n = 0; n < 2; ++n) _Pragma("unroll") for (int k = 0; k < 2; ++k) dst[n][k] = *(const LAS bf16x8*)(lds + PG8_SB(b, h) + boff + n * 2048 + k * 1024); } while (0)
#define PG8_MMA(ai, bj, At, Bt) do { __builtin_amdgcn_s_setprio(1); _Pragma("unroll") for (int m = 0; m < 4; ++m) _Pragma("unroll") for (int n = 0; n < 2; ++n) _Pragma("unroll") for (int k = 0; k < 2; ++k) \
        acc[ai][bj][m][n] = __builtin_amdgcn_mfma_f32_16x16x32_bf16(Bt[n][k], At[m][k], acc[ai][bj][m][n], 0, 0, 0); __builtin_amdgcn_s_setprio(0); } while (0)
#define PG8_WAIT_V(n) asm volatile("s_waitcnt vmcnt(" #n ")" ::: "memory")
#define PG8_WAIT_L(n) asm volatile("s_waitcnt lgkmcnt(" #n ")" ::: "memory")
#define PG8_BAR __builtin_amdgcn_s_barrier()
#define PG8_SCHED __builtin_amdgcn_sched_barrier(0)
    Unit cur, nxt; int ui = 0;
    if (!S.next(0, cur)) return;
    f32x4 acc[2][2][4][2];
#pragma unroll
    for (int a = 0; a < 2; ++a)
#pragma unroll
        for (int b = 0; b < 2; ++b)
#pragma unroll
            for (int m = 0; m < 4; ++m)
#pragma unroll
                for (int n = 0; n < 2; ++n) acc[a][b][m][n] = (f32x4){0.f, 0.f, 0.f, 0.f};
    bf16x8 At[4][2], B0[2][2], B1[2][2];
    const char* cA = (const char*)g.A + S.offA(cur); const char* cB = (const char*)g.Bt + S.offB(cur);
    PG8_STAGE(PG8_SB(0, 0), cB, voffB); PG8_STAGE(PG8_SB(0, 1), cB + hstepB, voffB); PG8_STAGE(PG8_SA(0, 0), cA, voffA); PG8_STAGE(PG8_SA(0, 1), cA + hstepA, voffA);
    if (wr == 1) PG8_BAR;
    PG8_WAIT_V(2); PG8_BAR;
    PG8_STAGE(PG8_SB(1, 0), cB + kstep, voffB); PG8_STAGE(PG8_SA(1, 0), cA + kstep, voffA); PG8_STAGE(PG8_SB(1, 1), cB + hstepB + kstep, voffB);
    PG8_WAIT_V(6); PG8_BAR;
    for (;;) {
        const bool has_next = S.next(ui + 1, nxt);
        const char* nA = has_next ? (const char*)g.A + S.offA(nxt) : cA; const char* nB = has_next ? (const char*)g.Bt + S.offB(nxt) : cB;
        for (int t = 0; t < nt; t += 2) {
            const bool last = (t == nt - 2);
            const char* a1 = cA + (size_t)(t + 1) * kstep;
            const char* a2 = last ? nA : cA + (size_t)(t + 2) * kstep; const char* b2 = last ? nB : cB + (size_t)(t + 2) * kstep;
            const char* a3 = a2 + kstep; const char* b3 = b2 + kstep;
            PG8_LDB(B0, 0, 0); PG8_LDB(B1, 0, 1); PG8_SCHED; PG8_LDA(At, 0, 0); PG8_STAGE(PG8_SA(1, 1), a1 + hstepA, voffA);
            PG8_WAIT_V(8); PG8_WAIT_L(0); PG8_BAR; PG8_MMA(0, 0, At, B0); PG8_MMA(0, 1, At, B1); PG8_BAR; PG8_SCHED;
            PG8_LDA(At, 0, 1); PG8_STAGE(PG8_SB(0, 0), b2, voffB); PG8_STAGE(PG8_SB(0, 1), b2 + hstepB, voffB); PG8_STAGE(PG8_SA(0, 0), a2, voffA);
            PG8_WAIT_V(8); PG8_WAIT_L(0); PG8_BAR; PG8_MMA(1, 0, At, B0); PG8_MMA(1, 1, At, B1); PG8_BAR; PG8_SCHED;
            PG8_LDB(B0, 1, 0); PG8_LDB(B1, 1, 1); PG8_SCHED; PG8_LDA(At, 1, 0); PG8_STAGE(PG8_SA(0, 1), a2 + hstepA, voffA);
            PG8_WAIT_V(8); PG8_WAIT_L(0); PG8_BAR; PG8_MMA(0, 0, At, B0); PG8_MMA(0, 1, At, B1); PG8_BAR; PG8_SCHED;
            PG8_LDA(At, 1, 1); PG8_STAGE(PG8_SB(1, 0), b3, voffB); PG8_STAGE(PG8_SB(1, 1), b3 + hstepB, voffB); PG8_STAGE(PG8_SA(1, 0), a3, voffA);
            PG8_WAIT_V(8); PG8_WAIT_L(0); PG8_BAR; PG8_MMA(1, 0, At, B0); PG8_MMA(1, 1, At, B1); PG8_BAR; PG8_SCHED;
        }
        if constexpr (ALIGN_EPI) { if (wr == 0) PG8_BAR; }
        E(acc, cur, wr, wc, fr, fq, lds);
        if (!has_next) break;
#pragma unroll
        for (int a = 0; a < 2; ++a)
#pragma unroll
            for (int b = 0; b < 2; ++b)
#pragma unroll
                for (int m = 0; m < 4; ++m)
#pragma unroll
                    for (int n = 0; n < 2; ++n) acc[a][b][m][n] = (f32x4){0.f, 0.f, 0.f, 0.f};
        cur = nxt; cA = nA; cB = nB; ++ui;
        if constexpr (ALIGN_EPI) { if (wr == 1) PG8_BAR; }
    }
    PG8_WAIT_V(0);
    if constexpr (!ALIGN_EPI) { if (wr == 0) PG8_BAR; }
    PG8_BAR;
#undef PG8_SA
#undef PG8_SB
#undef PG8_STAGE
#undef PG8_LDA
#undef PG8_LDB
#undef PG8_MMA
#undef PG8_WAIT_V
#undef PG8_WAIT_L
#undef PG8_BAR
#undef PG8_SCHED
}
}

struct KVSched {
    int c, G; const char* ws; size_t wsel;
    __device__ __forceinline__ bool next(int i, pg8::Unit& u) const {
        const int L = i * G + c; if (c < 0 || L >= 96) return false;
        const int kind = L >> 5, r = L & 31;
        if (kind < 2) { u.pm = kind * 16 + (r >> 2); u.pn = r & 3; } else { u.pm = 32 + (r >> 3); u.pn = r & 7; }
        return true;
    }
    __device__ __forceinline__ size_t offA(const pg8::Unit& u) const { const int kind = u.pm >> 4, pm = u.pm & 15; int k2 = (kind == 2); asm volatile("" : "+v"(k2));
        return (size_t)ws + WS_MEMB + (size_t)k2 * (WS_WV + wsel - WS_MEMB) + (size_t)pm * 256 * 1024 * 2; }
    __device__ __forceinline__ size_t offB(const pg8::Unit& u) const { const int kind = u.pm >> 4; int k1 = (kind == 1), k2 = (kind == 2); asm volatile("" : "+v"(k1), "+v"(k2));
        return (size_t)ws + WS_WK + wsel + (size_t)k1 * (WS_WV - WS_WK) + (size_t)k2 * (WS_MEMB - WS_WK - wsel) + (size_t)u.pn * 256 * 1024 * 2; }
};


#define XB_TMO      128
#define XB_XCNT(j)  (256  + 64 * (j))
#define XB_XSUB(j)  (1280 + 64 * (j))
#define XB_XGEN(j)  (2304 + 64 * (j))
#define XB_TOP      3328
#define XB_TOPGEN   3392
#define XCD_BAR_WORDS 3456
#define XB_SPIN_CAP (1u << 22)
__device__ __forceinline__ unsigned xb_ld(unsigned* p)              { return __hip_atomic_load(p, __ATOMIC_RELAXED, __HIP_MEMORY_SCOPE_AGENT); }
__device__ __forceinline__ unsigned xb_add(unsigned* p, unsigned v) { return __hip_atomic_fetch_add(p, v, __ATOMIC_RELAXED, __HIP_MEMORY_SCOPE_AGENT); }
__device__ __forceinline__ unsigned xb_xcc_id() { return (unsigned)__builtin_amdgcn_s_getreg((3 << 11) | 20) & 0xFu; }
#define XB_SPIN(cond, bar) do { unsigned _sp = 0; while (cond) { __builtin_amdgcn_s_sleep(1); \
    if ((++_sp & 255u) == 0u) { if (xb_ld(&(bar)[XB_TMO])) break; if (_sp > XB_SPIN_CAP) { atomicAdd(&(bar)[XB_TMO], 1u); break; } } } } while (0)
struct XcdBarrier { unsigned* bar; unsigned x; volatile LAS unsigned* st; };
__device__ __forceinline__ void xcd_barrier_complete(unsigned* bar, unsigned x, unsigned& nloc, unsigned& nx) {
    const unsigned G = gridDim.x * gridDim.y * gridDim.z;
    unsigned sum, cnt, mine, sp = 0u;
    for (;;) {
        sum = 0u; cnt = 0u; mine = 0u;
#pragma unroll
        for (unsigned j = 0; j < 16; ++j) { const unsigned c = xb_ld(&bar[XB_XCNT(j)]); sum += c; cnt += (c > 0u) ? 1u : 0u; mine = (j == x) ? c : mine; }
        if (sum == G) break;
        __builtin_amdgcn_s_sleep(1);
        if ((++sp & 255u) == 0u) { if (xb_ld(&bar[XB_TMO])) break; if (sp > XB_SPIN_CAP) { atomicAdd(&bar[XB_TMO], 1u); break; } }
    }
    nloc = mine > 0u ? mine : 1u; nx = cnt > 0u ? cnt : 1u;
}
__device__ __forceinline__ void xcd_barrier(const XcdBarrier& b) {
    asm volatile("s_waitcnt vmcnt(0)" ::: "memory");
    __syncthreads();
    if (threadIdx.x == 0) {
        unsigned* bar = b.bar;
        __builtin_amdgcn_s_waitcnt(0);
        unsigned nloc = b.st[0], nx = b.st[1];
        if (nloc == 0u) { xcd_barrier_complete(bar, b.x, nloc, nx); b.st[0] = nloc; b.st[1] = nx; }
        const unsigned old = xb_add(&bar[XB_XSUB(b.x)], 1u);
        const unsigned gen = old / nloc;
        if (old + 1u == (gen + 1u) * nloc) {
            __builtin_amdgcn_fence(__ATOMIC_RELEASE, "agent");
            asm volatile("s_waitcnt vmcnt(0)" ::: "memory");
            const unsigned og = xb_add(&bar[XB_TOP], 1u);
            const unsigned tg = og / nx;
            if (og + 1u == (tg + 1u) * nx) xb_add(&bar[XB_TOPGEN], 1u);
            else XB_SPIN(xb_ld(&bar[XB_TOPGEN]) == tg, bar);
            __builtin_amdgcn_fence(__ATOMIC_ACQUIRE, "agent");
            xb_add(&bar[XB_XGEN(b.x)], 1u);
            asm volatile("s_waitcnt vmcnt(0)" ::: "memory");
        } else {
            XB_SPIN(xb_ld(&bar[XB_XGEN(b.x)]) == gen, bar);
            __builtin_amdgcn_fence(__ATOMIC_ACQUIRE, "agent");
            asm volatile("s_waitcnt vmcnt(0)" ::: "memory");
        }
    }
    __syncthreads();
}


struct SG2 { const bf16_t* A; const bf16_t* Bt; int lda, ldb, K, N; bf16_t* O; int ldc; float scale; int mode; float* ssp; };
__device__ __forceinline__ float sq8(bf16x8 a) { float q = 0.f;
#pragma unroll
    for (int i = 0; i < 8; ++i) { const float f = bf2f((unsigned)(unsigned short)a[i]); q += f * f; } return q; }
__device__ __forceinline__ void sgemm2(LAS unsigned char* lds, const SG2 g, int ubase, int G, int wave, int tid) {
    const int lane = tid & 63, fr = lane & 15, fq = lane >> 4, rt = wave & 3, ch = wave >> 2;
    const int nunits = (g.N / 64) * 4, nsl = g.K / 64;
    int R, C; pg8::stage_rc(tid * 16, R, C);
    const unsigned offA = (unsigned)(R * g.lda + C) * 2u, offB = (unsigned)(R * g.ldb + C) * 2u;
    const int aoff = pg8::lds_byte(rt * 16 + fr, fq * 8), boff = pg8::lds_byte(ch * 32 + fr, fq * 8);
    for (int un = ubase; un >= 0 && un < nunits; un += G) {
        const int cgp = un >> 2, rg = un & 3;
        const char* gA = (const char*)(g.A + (size_t)rg * 64 * g.lda) + offA; const char* gB = (const char*)(g.Bt + (size_t)cgp * 64 * g.ldb) + offB;
#define SG2_STAGE(sl) do { LAS unsigned char* d_ = lds + ((sl) & 3) * 16384 + wave * 1024; \
        __builtin_amdgcn_global_load_lds((const unsigned*)(gA + (size_t)(sl) * 128), (LAS unsigned*)d_, 16, 0, 0); \
        __builtin_amdgcn_global_load_lds((const unsigned*)(gB + (size_t)(sl) * 128), (LAS unsigned*)(d_ + 8192), 16, 0, 0); } while (0)
        asm volatile("s_waitcnt vmcnt(0)" ::: "memory");
        SG2_STAGE(0); SG2_STAGE(1);
        f32x4 acc[2] = {(f32x4){0.f, 0.f, 0.f, 0.f}, (f32x4){0.f, 0.f, 0.f, 0.f}}; float q = 0.f;
        for (int sl = 0; sl < nsl; ++sl) {
            if (sl + 1 < nsl) asm volatile("s_waitcnt vmcnt(2)" ::: "memory"); else asm volatile("s_waitcnt vmcnt(0)" ::: "memory");
            __builtin_amdgcn_s_barrier(); asm volatile("" ::: "memory");
            if (sl + 2 < nsl) SG2_STAGE(sl + 2);
            LAS unsigned char* b_ = lds + (sl & 3) * 16384;
#pragma unroll
            for (int ks = 0; ks < 2; ++ks) {
                const bf16x8 a = *(const LAS bf16x8*)(b_ + aoff + ks * 1024);
#pragma unroll
                for (int c = 0; c < 2; ++c) { const bf16x8 b = *(const LAS bf16x8*)(b_ + 8192 + boff + c * 2048 + ks * 1024);
                    acc[c] = __builtin_amdgcn_mfma_f32_16x16x32_bf16(b, a, acc[c], 0, 0, 0); }
                if (g.mode == 1) q += sq8(a);
            }
        }
#undef SG2_STAGE
        const int row = rg * 64 + rt * 16 + fr, col = cgp * 64 + ch * 32 + fq * 4;
        bf16_t* op = g.O + (size_t)row * g.ldc + col;
        if (g.mode == 1) {
            q += shx(q, 16, lane); q += shx(q, 32, lane);
            const float sc = g.scale / sqrtf(q * (1.f / 1024.f) + EPS);
#pragma unroll
            for (int c = 0; c < 2; ++c) { const f32x4 v = acc[c] * sc; u32x2 w; w.x = cvt_pk_bf16(v[0], v[1]); w.y = cvt_pk_bf16(v[2], v[3]); *(u32x2*)(op + c * 16) = w; }
        } else {
            const u32x2 p0 = *(const u32x2*)op, p1 = *(const u32x2*)(op + 16); float qq = 0.f;
            { const float v0 = bflo(p0.x) + acc[0][0], v1 = bfhi(p0.x) + acc[0][1], v2 = bflo(p0.y) + acc[0][2], v3 = bfhi(p0.y) + acc[0][3];
              u32x2 w; w.x = cvt_pk_bf16(v0, v1); w.y = cvt_pk_bf16(v2, v3); *(u32x2*)op = w; qq += (v0 * v0 + v1 * v1) + (v2 * v2 + v3 * v3); }
            { const float v0 = bflo(p1.x) + acc[1][0], v1 = bfhi(p1.x) + acc[1][1], v2 = bflo(p1.y) + acc[1][2], v3 = bfhi(p1.y) + acc[1][3];
              u32x2 w; w.x = cvt_pk_bf16(v0, v1); w.y = cvt_pk_bf16(v2, v3); *(u32x2*)(op + 16) = w; qq += (v0 * v0 + v1 * v1) + (v2 * v2 + v3 * v3); }
            qq += shx(qq, 16, lane); qq += shx(qq, 32, lane);
            if (fq == 0) g.ssp[row * 32 + cgp * 2 + ch] = qq;
        }
        asm volatile("s_waitcnt vmcnt(0) lgkmcnt(0)" ::: "memory"); __builtin_amdgcn_s_barrier(); asm volatile("" ::: "memory");
    }
}

__device__ __forceinline__ void sgemm_act(LAS unsigned char* lds, const bf16_t* A, const bf16_t* Bt, bf16_t* Hs, const float* cfw, const float* scf, float* ocf, int ubase, int G, int wave, int tid) {
    const int lane = tid & 63, fr = lane & 15, fq = lane >> 4, rt = wave & 3, ch = wave >> 2;
    constexpr int nunits = (DFF / 64) * 4, nsl = D / 64, SLOT = 24576;
    int R, C; pg8::stage_rc(tid * 16, R, C);
    const unsigned off = (unsigned)(R * D + C) * 2u;
    const int aoff = pg8::lds_byte(rt * 16 + fr, fq * 8), boff = pg8::lds_byte(fr, fq * 8) + 8192 + ch * 8192;
    for (int un = ubase; un >= 0 && un < nunits; un += G) {
        const int fg = un >> 2, rg = un & 3, brow = ((fg >> 1) << 8) + ((fg & 1) << 6);
        const char* gA = (const char*)(A + (size_t)rg * 64 * D) + off; const char* gG = (const char*)(Bt + (size_t)brow * D) + off; const char* gU = (const char*)(Bt + (size_t)(brow + 128) * D) + off;
#define SGA_STAGE(sl) do { LAS unsigned char* d_ = lds + ((sl) & 3) * SLOT + wave * 1024; \
        __builtin_amdgcn_global_load_lds((const unsigned*)(gA + (size_t)(sl) * 128), (LAS unsigned*)d_, 16, 0, 0); \
        __builtin_amdgcn_global_load_lds((const unsigned*)(gG + (size_t)(sl) * 128), (LAS unsigned*)(d_ + 8192), 16, 0, 0); \
        __builtin_amdgcn_global_load_lds((const unsigned*)(gU + (size_t)(sl) * 128), (LAS unsigned*)(d_ + 16384), 16, 0, 0); } while (0)
        asm volatile("s_waitcnt vmcnt(0)" ::: "memory");
        SGA_STAGE(0); SGA_STAGE(1);
        f32x4 acc[4]; float q = 0.f;
#pragma unroll
        for (int c = 0; c < 4; ++c) acc[c] = (f32x4){0.f, 0.f, 0.f, 0.f};
        for (int sl = 0; sl < nsl; ++sl) {
            if (sl + 1 < nsl) asm volatile("s_waitcnt vmcnt(3)" ::: "memory"); else asm volatile("s_waitcnt vmcnt(0)" ::: "memory");
            __builtin_amdgcn_s_barrier(); asm volatile("" ::: "memory");
            if (sl + 2 < nsl) SGA_STAGE(sl + 2);
            LAS unsigned char* b_ = lds + (sl & 3) * SLOT;
#pragma unroll
            for (int ks = 0; ks < 2; ++ks) {
                const bf16x8 a = *(const LAS bf16x8*)(b_ + aoff + ks * 1024);
#pragma unroll
                for (int c = 0; c < 4; ++c) { const bf16x8 b = *(const LAS bf16x8*)(b_ + boff + c * 2048 + ks * 1024);
                    acc[c] = __builtin_amdgcn_mfma_f32_16x16x32_bf16(b, a, acc[c], 0, 0, 0); }
                q += sq8(a);
            }
        }
#undef SGA_STAGE
        q += shx(q, 16, lane); q += shx(q, 32, lane);
        const float rstd = 1.0f / sqrtf(q * (1.f / 1024.f) + EPS);
        asm volatile("s_waitcnt lgkmcnt(0)" ::: "memory"); __builtin_amdgcn_s_barrier(); asm volatile("" ::: "memory");
        LAS float* T = (LAS float*)(lds + ch * 20480);
#pragma unroll
        for (int c = 0; c < 4; ++c)
#pragma unroll
            for (int j = 0; j < 4; ++j) T[(rt * 16 + fr) * 65 + c * 16 + fq * 4 + j] = acc[c][j] * rstd;
        asm volatile("s_waitcnt lgkmcnt(0)" ::: "memory"); __builtin_amdgcn_s_barrier(); asm volatile("" ::: "memory");
        {
            const LAS float* Gt = (const LAS float*)lds; const LAS float* Ut = (const LAS float*)(lds + 20480);
            const int r = tid >> 3, f8 = (tid & 7) * 8, b = rg * 2 + (r >> 5), rr = r & 31, f = fg * 64 + f8;
            const float* st = scf + (size_t)(b * 2) * DFF + f;
            float hv[8], gv[8];
#pragma unroll
            for (int k = 0; k < 8; ++k) {
                const float g0 = Gt[r * 65 + f8 + k];
                const float gm1 = rr >= 1 ? Gt[(r - 1) * 65 + f8 + k] : st[DFF + k];
                const float gm2 = rr >= 2 ? Gt[(r - 2) * 65 + f8 + k] : (rr == 1 ? st[DFF + k] : st[k]);
                const float cv = cfw[f + k] * gm2 + cfw[DFF + f + k] * gm1 + cfw[2 * DFF + f + k] * g0;
                hv[k] = silu(cv) * Ut[r * 65 + f8 + k]; gv[k] = g0;
            }
            u32x4 w; w.x = pk2(hv[0], hv[1]); w.y = pk2(hv[2], hv[3]); w.z = pk2(hv[4], hv[5]); w.w = pk2(hv[6], hv[7]);
            *(u32x4*)(Hs + (size_t)(rg * 64 + r) * DFF + f) = w;
            if (rr >= 30) { float* o = ocf + ((size_t)b * 2 + (rr - 30)) * DFF + f; *(f32x4*)o = (f32x4){gv[0], gv[1], gv[2], gv[3]}; *(f32x4*)(o + 4) = (f32x4){gv[4], gv[5], gv[6], gv[7]}; }
        }
        asm volatile("s_waitcnt vmcnt(0) lgkmcnt(0)" ::: "memory"); __builtin_amdgcn_s_barrier(); asm volatile("" ::: "memory");
    }
}
__device__ __forceinline__ void sample_ss_reduce(const float* sss, float* ssq, int tid) {
    if (tid < 256) { const f32x4* p = (const f32x4*)(sss + tid * 32); float t = 0.f;
#pragma unroll
        for (int i = 0; i < 8; ++i) { const f32x4 v = p[i]; t += (v[0] + v[1]) + (v[2] + v[3]); }
        *(f32x4*)(ssq + (size_t)(MP + tid) * 4) = (f32x4){t, 0.f, 0.f, 0.f}; }
    asm volatile("s_waitcnt vmcnt(0)" ::: "memory"); __syncthreads();
}

__device__ __forceinline__ void transpose_item(const float* W, int K, int N, bf16_t* WT, LAS float* scr, int item, int lane, const float* gain = nullptr, int gu = 0) {
    const int nblk = N / 32, kb = item / nblk, nb = item % nblk, k0 = 64 * kb, n0 = 32 * nb;
    {
        f32x4 v[8];
#pragma unroll
        for (int i = 0; i < 8; ++i) v[i] = __builtin_nontemporal_load((const f32x4*)(W + (size_t)(k0 + (lane >> 3) + 8 * i) * N + n0 + (lane & 7) * 4));
#pragma unroll
        for (int i = 0; i < 8; ++i) { const int kk = (lane >> 3) + 8 * i; f32x4 w = v[i]; if (gain) w = w * gain[k0 + kk];
            LAS float* d = scr + kk * 33 + (lane & 7) * 4; d[0] = w[0]; d[1] = w[1]; d[2] = w[2]; d[3] = w[3]; }
    }
    LDS_WAIT();
    const int c = lane & 7;
#pragma unroll
    for (int j = 0; j < 4; ++j) { const int n = (lane >> 3) + 8 * j; const LAS float* s = scr + (8 * c) * 33 + n;
        u32x4 o; o.x = pk2(s[0 * 33], s[1 * 33]); o.y = pk2(s[2 * 33], s[3 * 33]); o.z = pk2(s[4 * 33], s[5 * 33]); o.w = pk2(s[6 * 33], s[7 * 33]);
        int drow = n0 + n; if (gu) { const int up = drow >= gu, f = up ? drow - gu : drow; drow = ((f >> 7) << 8) + (up << 7) + (f & 127); }
        *(u32x4*)(WT + (size_t)drow * K + k0 + 8 * c) = o; }
    LDS_WAIT();
}

__device__ __forceinline__ void first_rows(const float* Xp, const float* Xs, bf16_t* XNo, float* ss, int gw, int NGW, int lane) {
    for (int m0 = gw; m0 < MT; m0 += 2 * NGW) {
        const int m1 = m0 + NGW; const bool two = m1 < MT; const int mb = two ? m1 : m0;
        const f32x4* xa = (const f32x4*)(m0 < MP ? Xp + (size_t)m0 * D : Xs + (size_t)(m0 - MP) * D) + lane;
        const f32x4* xb = (const f32x4*)(mb < MP ? Xp + (size_t)mb * D : Xs + (size_t)(mb - MP) * D) + lane;
        f32x4 va[4], vb[4]; float sa = 0.f, sb = 0.f;
#pragma unroll
        for (int j = 0; j < 4; ++j) { va[j] = __builtin_nontemporal_load(xa + 64 * j); vb[j] = __builtin_nontemporal_load(xb + 64 * j); }
#pragma unroll
        for (int j = 0; j < 4; ++j) { sa += (va[j].x * va[j].x + va[j].y * va[j].y) + (va[j].z * va[j].z + va[j].w * va[j].w); sb += (vb[j].x * vb[j].x + vb[j].y * vb[j].y) + (vb[j].z * vb[j].z + vb[j].w * vb[j].w); }
        sa = wave_sum(sa, lane); sb = wave_sum(sb, lane);
        if (lane < 4) { ss[(size_t)m0 * 4 + lane] = lane == 0 ? sa : 0.f; if (two) ss[(size_t)m1 * 4 + lane] = lane == 0 ? sb : 0.f; }
        u32x2* oa = (u32x2*)(XNo + (size_t)m0 * D) + lane; u32x2* ob = (u32x2*)(XNo + (size_t)mb * D) + lane;
#pragma unroll
        for (int j = 0; j < 4; ++j) { u32x2 w; w.x = pk2(va[j].x, va[j].y); w.y = pk2(va[j].z, va[j].w); oa[64 * j] = w; if (two) { w.x = pk2(vb[j].x, vb[j].y); w.y = pk2(vb[j].z, vb[j].w); ob[64 * j] = w; } }
    }
}

typedef __attribute__((address_space(4))) const unsigned char* kptr_t;
typedef const float* cfp_t; typedef float* fp_t; typedef unsigned char* ucp_t;
#define INP(k) (*(const __attribute__((address_space(4))) cfp_t*)(kp + 8 * (k)))
#define X out
#define WIN_T ((bf16_t*)(ws + WS_WIN + wsel))
#define WOUT_T ((bf16_t*)(ws + WS_WOUT + wsel))
#define WQ_T ((bf16_t*)(ws + WS_WQ + wsel))
#define WK_T ((bf16_t*)(ws + WS_WK + wsel))
#define WV_T ((bf16_t*)(ws + WS_WV + wsel))
#define WO_T ((bf16_t*)(ws + WS_WO + wsel))
#define WUP_T ((bf16_t*)(ws + WS_WUP + wsel))
#define WDN_T ((bf16_t*)(ws + WS_WDN + wsel))
#define MEMB ((bf16_t*)(ws + WS_MEMB))
#define KBP ((bf16_t*)(ws + WS_KBP))
#define VTP ((bf16_t*)(ws + WS_VTP))
#define KBS ((bf16_t*)(ws + WS_KBS + ksel))
#define VTS ((bf16_t*)(ws + WS_VTS + ksel))
#define WST ((bf16_t*)(ws + WS_WST + ksel))
#define AGG ((float*)(ws + WS_AGG))
#define SSQ(i) ((float*)(ws + WS_SSP) + (size_t)(i) * MT * 4)
#define SSS(i) ((float*)(ws + WS_SSS) + (size_t)(i) * 256 * 32)
#define GT_R ((bf16_t*)(ws + WS_GT + ksel))
#define GT_I ((bf16_t*)(ws + WS_GT + 65536 + ksel))
#define XN ((bf16_t*)(ws + WS_XN))
#define gZ ((bf16_t*)(ws + B_Z))
#define HLOC ((bf16_t*)(ws + B_HLOC))
#define PCUM ((bf16_t*)(ws + B_PCUM))
#define gY ((bf16_t*)(ws + B_Y))
#define gQ ((bf16_t*)(ws + B_Q))
#define gP ((bf16_t*)(ws + B_P))
#define gO ((bf16_t*)(ws + B_O))
#define PS ((bf16_t*)(ws + B_PS))
#define GU ((bf16_t*)(ws + B_GU))
#define GUS ((bf16_t*)(ws + B_GUS))
#define SBG ((float*)(ws + B_SBG))
#define SBU ((float*)(ws + B_SBU))
#define SBL ((float*)(ws + B_SBL))
__device__ __forceinline__ void convert_layer(kptr_t kp, unsigned char* ws, LAS unsigned char* lds, const int l, const int part, const int nparts, const int gw, const int NGW, const int gt, const int NGT, const int lane, const int wave) {
            const size_t wsel = (size_t)(l & 1) * WSEL1, ksel = (size_t)(l & 1) * KSEL1;
            LAS float* scr = (LAS float*)(lds + wave * 16384);
            const float* w_in = INP(I_WIN) + (size_t)l * D * INC; const float* w_out = INP(I_WOUT) + (size_t)l * D * D; const float* w_q = INP(I_WQ) + (size_t)l * D * D;
            const float* w_k = INP(I_WK) + (size_t)l * D * D; const float* w_v = INP(I_WV) + (size_t)l * D * D; const float* w_o = INP(I_WO) + (size_t)l * D * D;
            const float* w_up = INP(I_WUP) + (size_t)l * D * 2 * DFF; const float* w_dn = INP(I_WDN) + (size_t)l * DFF * D; const float* c_v = INP(I_CV) + (size_t)l * BS * NMEM * D;
            constexpr int T_IN = 16 * (INC / 32), T_SQ = 16 * 32, T_UP = 16 * (2 * DFF / 32), T_DN = (DFF / 64) * 32, T_CV = 32 * 32;
            constexpr int T_G = 16;
            constexpr int NIT = T_IN + 5 * T_SQ + T_UP + T_DN + T_CV + 2 * T_G;
            for (int it = (NIT * part) / nparts + gw; it < (NIT * (part + 1)) / nparts; it += NGW) {
                int r = it;
                if (r < T_IN) { transpose_item(w_in, D, INC, WIN_T, scr, r, lane, INP(I_GMIX) + l * D); continue; } r -= T_IN;
                if (r < T_SQ) { transpose_item(w_out, D, D, WOUT_T, scr, r, lane); continue; } r -= T_SQ;
                if (r < T_SQ) { transpose_item(w_q, D, D, WQ_T, scr, r, lane, INP(I_GX) + l * D); continue; } r -= T_SQ;
                if (r < T_SQ) { transpose_item(w_k, D, D, WK_T, scr, r, lane); continue; } r -= T_SQ;
                if (r < T_SQ) { transpose_item(w_v, D, D, WV_T, scr, r, lane); continue; } r -= T_SQ;
                if (r < T_SQ) { transpose_item(w_o, D, D, WO_T, scr, r, lane); continue; } r -= T_SQ;
                if (r < T_UP) { transpose_item(w_up, D, 2 * DFF, WUP_T, scr, r, lane, INP(I_GFFN) + l * D, DFF); continue; } r -= T_UP;
                if (r < T_DN) { transpose_item(w_dn, DFF, D, WDN_T, scr, r, lane); continue; } r -= T_DN;
                if (r < T_CV) { transpose_item(c_v, BS * NMEM, D, VTS, scr, r, lane); continue; } r -= T_CV;
                if (r < T_G) { transpose_item(INP(I_WRG) + ((size_t)l * 8 + (r >> 1)) * 4096, 64, 64, GT_R + (r >> 1) * 4096, scr, r & 1, lane); continue; } r -= T_G;
                transpose_item(INP(I_WIG) + ((size_t)l * 8 + (r >> 1)) * 4096, 64, 64, GT_I + (r >> 1) * 4096, scr, r & 1, lane);
            }
            if (part == 0) {
                const f32x4* ck = (const f32x4*)(INP(I_CK) + (size_t)l * BS * NMEM * D); u32x2* dk = (u32x2*)KBS;
                for (int i = gt; i < BS * NMEM * D / 4; i += NGT) { const f32x4 v = ck[i]; u32x2 w; w.x = pk2(v.x, v.y); w.y = pk2(v.z, v.w); dk[i] = w; }
                if (l == 0) { const f32x4* mm = (const f32x4*)INP(I_MEM); u32x2* dm = (u32x2*)MEMB;
                    for (int i = gt; i < BP * NMEM * D / 4; i += NGT) { const f32x4 v = mm[i]; u32x2 w; w.x = pk2(v.x, v.y); w.y = pk2(v.z, v.w); dm[i] = w; } }
                const float* wsl = INP(I_WS) + (size_t)l * 4 * 128 * 128;
                for (int i = gt; i < 4 * 128 * 128; i += NGT) { const int s = i & 127, t = (i >> 7) & 127; WST[i] = (bf16_t)f2bf(s <= t ? wsl[i] : 0.f); }
            }
}

__global__ void __launch_bounds__(NTHREADS, 2) trunk_fwd(Args args) {
    extern __shared__ __attribute__((aligned(16))) unsigned char lds_raw[];
    LAS unsigned char* lds = (LAS unsigned char*)lds_raw;
    cg::grid_group grid = cg::this_grid();
    const int wave_s = __builtin_amdgcn_readfirstlane(threadIdx.x >> 6);
#define LANE_STATE() int G = gridDim.x, bid = blockIdx.x; asm volatile("" : "+s"(G), "+s"(bid)); const int NGW = G * NWAVES, NGT = G * NTHREADS; (void)NGW; (void)NGT; \
    const int tid = opaque_tid(wave_s), lane = tid & 63, wave = wave_s; const int gw = bid * NWAVES + wave; const int gt = bid * NTHREADS + tid; (void)lane; (void)gw; (void)gt; \
    kptr_t kp = (kptr_t)__builtin_amdgcn_kernarg_segment_ptr(); asm volatile("" : "+s"(kp)); \
    float* const out = *(const __attribute__((address_space(4))) fp_t*)(kp + 8 * N_IN); unsigned char* const ws = *(const __attribute__((address_space(4))) ucp_t*)(kp + 8 * N_IN + 8); (void)out; (void)ws
    {
        LANE_STATE();
        if (bid == 0) for (int i = tid; i < XCD_BAR_WORDS; i += NTHREADS) __hip_atomic_store((unsigned*)(ws + WS_BAR) + i, 0u, __ATOMIC_RELAXED, __HIP_MEMORY_SCOPE_AGENT);
        if (tid < 32) ((LAS unsigned*)(lds + LDS_MISC))[tid] = 0u;
        __threadfence();
        grid.sync();
        if (tid == 0) (void)xb_add((unsigned*)(ws + WS_BAR) + XB_XCNT(xb_xcc_id()), 1u);
    }
#define GRID_SYNC() do { kptr_t kp_ = (kptr_t)__builtin_amdgcn_kernarg_segment_ptr(); asm volatile("" : "+s"(kp_)); \
        XcdBarrier b_; b_.bar = (unsigned*)(*(const __attribute__((address_space(4))) ucp_t*)(kp_ + 8 * N_IN + 8) + WS_BAR); b_.x = xb_xcc_id(); b_.st = (volatile LAS unsigned*)(lds + LDS_MISC); \
        xcd_barrier(b_); if (PROBE == 3) xcd_barrier(b_); } while (0)

    for (int l = 0; l < DEPTH; ++l) {
        const size_t wsel = (size_t)(l & 1) * WSEL1, ksel = (size_t)(l & 1) * KSEL1;
        if (l == 0)
        for (int dup0 = 0; dup0 < ((PROBE == 1 || PROBE == 5) ? 2 : 1); ++dup0) {
        {
            LANE_STATE();
            convert_layer(kp, ws, lds, l, 0, 1, gw, NGW, gt, NGT, lane, wave);
            if (l == 0) first_rows(INP(I_XP), INP(I_XS), XN, SSQ(0), gw, NGW, lane);
        }
        GRID_SYNC();
        }
        {
            LANE_STATE();
            KVSched S; S.G = G; S.c = bid >= 160 ? bid - 160 : -1; S.ws = (const char*)ws; S.wsel = wsel;
            pg8::Gemm g{(const bf16_t*)nullptr, (const bf16_t*)nullptr, D, D, D};
            pg8::EpiKV E{out + O_MKP + (size_t)l * BP * NMEM * D, out + O_MVP + (size_t)l * BP * NMEM * D, KBP, VTP};
            pg8::gemm_phase<pg8::EpiKV, KVSched, true>(lds, g, S, E, wave_s);
        }
#define GEMM_BF16(s_) do { const int s = (s_); pg8::GSched S; pg8::Gemm g; pg8::EpiBf16 E; E.scale = 1.f; E.ss = nullptr; E.smp = 0; \
        if (s == 0) { S.init(MT / 256, INC / 256, G, bid); S.aPm = (size_t)256 * D * 2; S.bPn = (size_t)256 * D * 2; g = pg8::Gemm{XN, WIN_T, D, D, D}; E.O = gZ; E.ldc = INC; E.ss = SSQ(3 * l); } \
        else if (s == 1) { S.init(MP / 256, D / 256, G, bid); S.aPm = (size_t)256 * D * 2; S.bPn = (size_t)256 * D * 2; g = pg8::Gemm{XN, WQ_T, D, D, D}; E.O = gQ; E.ldc = D; E.scale = 0.0625f; E.ss = SSQ(3 * l + 1); } \
        else if (s == 2) { S.init(MP / 256, 4, G, bid); S.aPm = (size_t)256 * D * 2; S.aPn = 512; S.bPn = (size_t)256 * 2048 * 2; S.bPm = 512; S.bShift = 4; g = pg8::Gemm{gP, VTP, D, 2048, 256}; E.O = gO; E.ldc = D; } \
        else { S.init(1, 32, G, (bid + G - 64) % G); S.mode = 2; g = pg8::Gemm{PS, VTS, 8192, 2048, 256}; E.O = gO + (size_t)MP * D; E.ldc = D; E.smp = 1; } \
        pg8::gemm_phase<pg8::EpiBf16, pg8::GSched, true>(lds, g, S, E, wave_s); } while (0)
#define GEMM_RES(s_) do { const int s = (s_); pg8::GSched S; S.init(MP / 256, D / 256, G, bid); pg8::Gemm g; \
        if (s == 0) { g = pg8::Gemm{gY, WOUT_T, D, D, D}; S.aPm = (size_t)256 * D * 2; } \
        else if (s == 1) { g = pg8::Gemm{gO, WO_T, D, D, D}; S.aPm = (size_t)256 * D * 2; } \
        else { g = pg8::Gemm{GU, WDN_T, DFF, DFF, DFF}; S.aPm = (size_t)256 * DFF * 2; } \
        S.bPn = (size_t)256 * g.ldb * 2; \
        pg8::EpiResid E{XN, SSQ(3 * l + 1 + s)}; \
        pg8::gemm_phase<pg8::EpiResid, pg8::GSched, true>(lds, g, S, E, wave_s); } while (0)

        for (int rep = 0; rep < 13; ++rep) { if (rep == 4 || rep == 9 || rep == 11) continue;
          const int ndup = ((PROBE == 1 && (rep == 1 || rep == 2)) || (PROBE == 4 && rep == 1) || (PROBE == 6 && rep == 2)) ? 2 : ((PROBE == 2 && (rep == 0 || rep == 5 || rep == 6 || rep == 7 || rep == 10)) ? 2 : 1);
          for (int dup = 0; dup < ndup; ++dup) {
            if (rep == 0 || rep == 5 || rep == 7) {
                LANE_STATE();
                const int s0 = rep == 0 ? 0 : (rep == 5 ? 1 : 2), ns = rep == 7 ? 2 : 1;
                if (rep == 0 && l > 0) {
                    pg8::GSched S0; S0.init(MT / 256, INC / 256, G, bid); pg8::Unit u0; bool own = false;
                    for (int i = 0; S0.next(i, u0); ++i) own = own || (u0.pm == 128);
                    if (own) sample_ss_reduce(SSS(3 * l), SSQ(3 * l), tid);
                }
                for (int q = 0; q < ns; ++q) GEMM_BF16(s0 + q);
                if (rep == 5) { LANE_STATE(); const SG2 sg{XN + (size_t)MP * D, WQ_T, D, D, D, D, gQ + (size_t)MP * D, D, 0.0625f, 1, nullptr}; sgemm2(lds, sg, bid, G, wave, tid); }
                if (rep == 5 && l + 1 < DEPTH) { LANE_STATE(); if (bid >= 64) convert_layer(kp, ws, lds, l + 1, 1, 4, gw - 64 * NWAVES, NGW - 64 * NWAVES, gt - 64 * NTHREADS, NGT - 64 * NTHREADS, lane, wave); }
            } else if (rep == 10) {
                LANE_STATE();
                pg8::GSched S; S.init(MP / 256, 2 * DFF / 256, G, bid); S.aPm = (size_t)256 * D * 2; S.bPn = (size_t)256 * D * 2;
                const pg8::Gemm g{XN, WUP_T, D, D, D};
                const pg8::EpiAct E{GU, INP(I_SCF) + (size_t)l * BS * 2 * DFF, out + O_CFS + (size_t)l * BS * 2 * DFF, SBG, SBU, SBL, INP(I_CFW) + (size_t)l * 3 * DFF, SSQ(3 * l + 2)};
                pg8::gemm_phase<pg8::EpiAct, pg8::GSched, true>(lds, g, S, E, wave_s);
                { LANE_STATE(); sgemm_act(lds, XN + (size_t)MP * D, WUP_T, GU + (size_t)MP * DFF, INP(I_CFW) + (size_t)l * 3 * DFF, INP(I_SCF) + (size_t)l * BS * 2 * DFF, out + O_CFS + (size_t)l * BS * 2 * DFF, bid, G, wave, tid); }
            } else if (rep == 1) {
                LANE_STATE();
                {
                    LAS bf16_t* vT = (LAS bf16_t*)lds;
                    constexpr int VP = 136;
                    const float* gvp = INP(I_GV) + l * CW; const float* bsp = INP(I_BSS) + l * 4 * 128;
                    for (int un = (bid + G / 2) % G; un < 8 + 256; un += G) {
                        int rowbase, nrows, sb = -1;
                        if (un < 8) { sb = un; rowbase = MP + un * TS; nrows = TS; } else { rowbase = (un - 8) * 128; nrows = 128; }
                        {
                            const int rl = tid >> 5, cgp = tid & 31;
                            f32x4 g0 = *(const f32x4*)(gvp + cgp * 8), g1 = *(const f32x4*)(gvp + cgp * 8 + 4);
                            for (int p = 0; p < nrows / 16; ++p) {
                                const int r = p * 16 + rl;
                                const u32x4 raw = *(const u32x4*)(gZ + (size_t)(rowbase + r) * INC + Z_VC + cgp * 8);
                                float v[8] = {bflo(raw.x), bfhi(raw.x), bflo(raw.y), bfhi(raw.y), bflo(raw.z), bfhi(raw.z), bflo(raw.w), bfhi(raw.w)};
                                float ss = 0.f;
#pragma unroll
                                for (int k = 0; k < 8; ++k) { v[k] = gelu_t(v[k]); ss += v[k] * v[k]; }
                                ss += shx(ss, 1, lane); ss += shx(ss, 2, lane); ss += shx(ss, 4, lane);
                                const float rstd = __builtin_amdgcn_rsqf(ss * (1.f / 64.f) + EPS);
                                const float gg[8] = {g0.x, g0.y, g0.z, g0.w, g1.x, g1.y, g1.z, g1.w};
#pragma unroll
                                for (int k = 0; k < 8; ++k) { v[k] = v[k] * rstd * gg[k]; vT[(cgp * 8 + k) * VP + r] = (bf16_t)f2bf(v[k]); }
                                if (sb >= 0) { float* vo = out + O_VCS + ((size_t)(l * BS + sb) * TS + r) * CW + cgp * 8;
                                    *(f32x4*)vo = (f32x4){v[0], v[1], v[2], v[3]}; *(f32x4*)(vo + 4) = (f32x4){v[4], v[5], v[6], v[7]}; }
                            }
                        }
                        __syncthreads();
                        {
                            const int hh = wave & 3, rh = wave >> 2, fr = lane & 15, fq = lane >> 4;
                            const int nmt = nrows == 128 ? 4 : (rh == 0 ? 2 : 0);
                            for (int mi = 0; mi < nmt; ++mi) {
                                const int mt = rh * 4 + mi, nks = (mt * 16 + 15) / 32 + 1;
                                f32x4 acc[4];
#pragma unroll
                                for (int n = 0; n < 4; ++n) acc[n] = (f32x4){0.f, 0.f, 0.f, 0.f};
                                for (int ks = 0; ks < nks; ++ks) {
                                    const bf16x8 a = *(const bf16x8*)(WST + ((size_t)(hh * 128 + mt * 16 + fr) * 128 + ks * 32 + fq * 8));
#pragma unroll
                                    for (int n = 0; n < 4; ++n) { const bf16x8 b = *(const LAS bf16x8*)(vT + (hh * 64 + n * 16 + fr) * VP + ks * 32 + fq * 8);
                                        acc[n] = __builtin_amdgcn_mfma_f32_16x16x32_bf16(b, a, acc[n], 0, 0, 0); }
                                }
                                { const int t = mt * 16 + fr; const float bias = bsp[hh * 128 + t]; const size_t row = (size_t)(rowbase + t);
#pragma unroll
                                    for (int n = 0; n < 4; ++n) { const int c = hh * 64 + n * 16 + fq * 4; const u32x2 uq = *(const u32x2*)(gZ + row * INC + Z_UC + c);
                                        u32x2 w; w.x = pk2(gelu_t(bflo(uq.x)) * (acc[n][0] + bias), gelu_t(bfhi(uq.x)) * (acc[n][1] + bias)); w.y = pk2(gelu_t(bflo(uq.y)) * (acc[n][2] + bias), gelu_t(bfhi(uq.y)) * (acc[n][3] + bias));
                                        *(u32x2*)(gY + row * D + 768 + c) = w; } }
                            }
                        }
                        __syncthreads();
                    }
                }
                {
                    LAS unsigned char* wl = lds + wave * 16384;
                    LAS bf16_t* tile = (LAS bf16_t*)wl;
                    LAS float* pre_r = (LAS float*)(wl + 2560);
                    LAS float* pre_i = (LAS float*)(wl + 2560 + 4096);
                    LAS float* xcf = (LAS float*)(wl + 2560 + 8192);
                    const int fr = lane & 15, fq = lane >> 4;
                    for (int un = gw; un < 64 + 2048; un += NGW) {
                        int b, hd, rowbase, nrows, t0; bool smp = un < 64;
                        if (smp) { b = un >> 3; hd = un & 7; rowbase = MP + b * TS; nrows = TS; t0 = 0; }
                        else { const int v = un - 64; const int ch = v & 31; hd = (v >> 5) & 7; b = v >> 8; t0 = ch * 128; rowbase = b * SEQ + t0; nrows = 128; }
                        const int cidx = l * AW + hd * 64 + lane;
                        const float br = INP(I_BRG)[cidx], bi = INP(I_BIG)[cidx];
                        const float c8sp = 8.0f * log1pf(__expf(-INP(I_LAM)[cidx]));
                        const float* caw = INP(I_CAW) + (size_t)l * 4 * AW + hd * 64 + lane;
                        const float cw0 = caw[0], cw1 = caw[AW], cw2 = caw[2 * AW], cw3 = caw[3 * AW], cb = INP(I_CAB)[cidx];
                        bf16x8 bR[4][2], bI[4][2];
#pragma unroll
                        for (int n = 0; n < 4; ++n)
#pragma unroll
                            for (int ks = 0; ks < 2; ++ks) { const size_t o_ = (size_t)(hd * 64 + n * 16 + fr) * 64 + ks * 32 + fq * 8;
                                bR[n][ks] = *(const bf16x8*)(GT_R + o_); bI[n][ks] = *(const bf16x8*)(GT_I + o_); }
                        float xm3 = 0.f, xm2 = 0.f, xm1 = 0.f;
                        if (smp) { const float* st = INP(I_SCA) + ((size_t)(l * BS + b) * 3) * AW + hd * 64 + lane; xm3 = st[0]; xm2 = st[AW]; xm1 = st[2 * AW]; }
                        else if (t0 > 0) { const bf16_t* zp = gZ + (size_t)(rowbase - 3) * INC + Z_XA + hd * 64 + lane; xm3 = bf2f(zp[0]); xm2 = bf2f(zp[INC]); xm1 = bf2f(zp[2 * INC]); }
                        float h = 0.f, pc = 1.f;
                        const bf16_t* zq = gZ + (size_t)(rowbase + (lane >> 3)) * INC + Z_XA + hd * 64 + (lane & 7) * 8;
                        unsigned* hp = (unsigned*)(HLOC + (size_t)rowbase * AW + hd * 64 + (lane & ~1)); unsigned* pp = (unsigned*)(PCUM + (size_t)rowbase * AW + hd * 64 + (lane & ~1));
                        LAS bf16_t* xraw = (LAS bf16_t*)pre_r;
                        u32x4 xn0 = *(const u32x4*)zq, xn1 = *(const u32x4*)(zq + (size_t)8 * INC);
                        for (int st = 0; st < nrows / 16; ++st) {
                            *(LAS u32x4*)(xraw + (lane >> 3) * 64 + (lane & 7) * 8) = xn0; *(LAS u32x4*)(xraw + ((lane >> 3) + 8) * 64 + (lane & 7) * 8) = xn1;
                            zq += (size_t)16 * INC;
                            if (st + 1 < nrows / 16) { xn0 = *(const u32x4*)zq; xn1 = *(const u32x4*)(zq + (size_t)8 * INC); }
                            LDS_WAIT();
#pragma unroll
                            for (int i = 0; i < 16; ++i) { const float xv = bf2f(xraw[i * 64 + lane]);
                                const float xc = cw0 * xm3 + cw1 * xm2 + cw2 * xm1 + cw3 * xv + cb; xm3 = xm2; xm2 = xm1; xm1 = xv; xcf[i * 64 + lane] = xc; tile[i * 72 + lane] = (bf16_t)f2bf(xc); }
                            LDS_WAIT();
                            const bf16x8 a0 = *(const LAS bf16x8*)(tile + fr * 72 + fq * 8), a1 = *(const LAS bf16x8*)(tile + fr * 72 + 32 + fq * 8);
#pragma unroll
                            for (int n = 0; n < 4; ++n) {
                                f32x4 ar = (f32x4){0.f, 0.f, 0.f, 0.f}, ai = (f32x4){0.f, 0.f, 0.f, 0.f};
                                ar = __builtin_amdgcn_mfma_f32_16x16x32_bf16(a0, bR[n][0], ar, 0, 0, 0); ar = __builtin_amdgcn_mfma_f32_16x16x32_bf16(a1, bR[n][1], ar, 0, 0, 0);
                                ai = __builtin_amdgcn_mfma_f32_16x16x32_bf16(a0, bI[n][0], ai, 0, 0, 0); ai = __builtin_amdgcn_mfma_f32_16x16x32_bf16(a1, bI[n][1], ai, 0, 0, 0);
#pragma unroll
                                for (int j = 0; j < 4; ++j) { pre_r[(fq * 4 + j) * 64 + n * 16 + fr] = ar[j]; pre_i[(fq * 4 + j) * 64 + n * 16 + fr] = ai[j]; }
                            }
                            LDS_WAIT();
#pragma unroll 2
                            for (int i = 0; i < 16; i += 2) {
                                const f32x2 pr = (f32x2){pre_r[i * 64 + lane], pre_r[(i + 1) * 64 + lane]} + br, pi = (f32x2){pre_i[i * 64 + lane], pre_i[(i + 1) * 64 + lane]} + bi;
                                const f32x2 xc2 = {xcf[i * 64 + lane], xcf[(i + 1) * 64 + lane]};
                                const f32x2 er = pr * (-1.4426950408889634f), ei = pi * (-1.4426950408889634f);
                                f32x2 dr, di; dr.x = __builtin_amdgcn_exp2f(er.x); dr.y = __builtin_amdgcn_exp2f(er.y); di.x = __builtin_amdgcn_exp2f(ei.x); di.y = __builtin_amdgcn_exp2f(ei.y);
                                dr = dr + 1.0f; di = di + 1.0f;
                                f32x2 r, gi; r.x = __builtin_amdgcn_rcpf(dr.x); r.y = __builtin_amdgcn_rcpf(dr.y); gi.x = __builtin_amdgcn_rcpf(di.x); gi.y = __builtin_amdgcn_rcpf(di.y);
                                const f32x2 la = r * (-c8sp); f32x2 a, om;
                                if (la.x > -0.125f && la.y > -0.125f) { const f32x2 x = la * 2.0f;
                                    om = -x * (x * (x * (x * (x * (x * 0.0013888889f + 0.0083333338f) + 0.041666668f) + 0.16666667f) + 0.5f) + 1.0f);
                                    a = la * (la * (la * (la * (la * 0.0083333338f + 0.041666668f) + 0.16666667f) + 0.5f) + 1.0f) + 1.0f; }
                                else { a.x = __expf(la.x); a.y = __expf(la.y); om.x = -expm1f(2.0f * la.x); om.y = -expm1f(2.0f * la.y); }
                                f32x2 bm; bm.x = __builtin_amdgcn_sqrtf(om.x); bm.y = __builtin_amdgcn_sqrtf(om.y);
                                const f32x2 b2 = bm * gi * xc2;
#pragma unroll
                                for (int k = 0; k < 2; ++k) {
                                    h = (k ? a.y : a.x) * h + (k ? b2.y : b2.x); pc = pc * (k ? a.y : a.x);
                                    const float hn = __builtin_bit_cast(float, __builtin_amdgcn_mov_dpp(__builtin_bit_cast(int, h), 0xB1, 0xf, 0xf, true)), pn = __builtin_bit_cast(float, __builtin_amdgcn_mov_dpp(__builtin_bit_cast(int, pc), 0xB1, 0xf, 0xf, true));
                                    if ((lane & 1) == 0) { *hp = pk2(h, hn); *pp = pk2(pc, pn); } hp += AW / 2; pp += AW / 2;
                                }
                            }
                            LDS_WAIT();
                        }
                        AGG[(size_t)un * 128 + lane] = pc; AGG[(size_t)un * 128 + 64 + lane] = h;
                    }
                }
                {
                    const float* cbw = INP(I_CBW) + (size_t)l * 3 * BW;
                    if (bid >= 8) for (int it = gt - 8 * NTHREADS; it < (MT / 8) * 32; it += NGT - 8 * NTHREADS) {
                        const int rb = it >> 5, c0 = (it & 31) * 8;
                        int b, t0, T, rowbase; const bool smp = rb >= MP / 8;
                        if (!smp) { b = rb >> 9; t0 = (rb & 511) * 8; T = SEQ; rowbase = rb * 8; } else { const int sbk = rb - MP / 8; b = sbk >> 2; t0 = (sbk & 3) * 8; T = TS; rowbase = MP + sbk * 8; }
                        u32x4 xq[10], cq[10], bq[8];
                        const bf16_t* zr = gZ + (size_t)rowbase * INC + c0;
#pragma unroll
                        for (int i = 0; i < 10; ++i) { if (i >= 2 || t0 > 0) { xq[i] = __builtin_nontemporal_load((const u32x4*)(zr + (ptrdiff_t)(i - 2) * INC + Z_XB)); cq[i] = __builtin_nontemporal_load((const u32x4*)(zr + (ptrdiff_t)(i - 2) * INC + Z_GC)); } else { xq[i] = (u32x4){0u, 0u, 0u, 0u}; cq[i] = (u32x4){0u, 0u, 0u, 0u}; } }
#pragma unroll
                        for (int i = 0; i < 8; ++i) bq[i] = __builtin_nontemporal_load((const u32x4*)(zr + (size_t)i * INC + Z_GB));
                        float w0[8], w1[8], w2[8], pm2[8], pm1[8];
#pragma unroll
                        for (int k = 0; k < 8; ++k) { w0[k] = cbw[c0 + k]; w1[k] = cbw[BW + c0 + k]; w2[k] = cbw[2 * BW + c0 + k]; }
                        {
                            const float a_[8] = {bflo(xq[0].x) * bflo(cq[0].x), bfhi(xq[0].x) * bfhi(cq[0].x), bflo(xq[0].y) * bflo(cq[0].y), bfhi(xq[0].y) * bfhi(cq[0].y), bflo(xq[0].z) * bflo(cq[0].z), bfhi(xq[0].z) * bfhi(cq[0].z), bflo(xq[0].w) * bflo(cq[0].w), bfhi(xq[0].w) * bfhi(cq[0].w)};
                            const float b_[8] = {bflo(xq[1].x) * bflo(cq[1].x), bfhi(xq[1].x) * bfhi(cq[1].x), bflo(xq[1].y) * bflo(cq[1].y), bfhi(xq[1].y) * bfhi(cq[1].y), bflo(xq[1].z) * bflo(cq[1].z), bfhi(xq[1].z) * bfhi(cq[1].z), bflo(xq[1].w) * bflo(cq[1].w), bfhi(xq[1].w) * bfhi(cq[1].w)};
#pragma unroll
                            for (int k = 0; k < 8; ++k) { pm2[k] = a_[k]; pm1[k] = b_[k]; }
                        }
                        if (t0 == 0 && smp) { const float* st = INP(I_SCB) + ((size_t)(l * BS + b) * 2) * BW + c0;
#pragma unroll
                            for (int k = 0; k < 8; ++k) { pm2[k] = st[k]; pm1[k] = st[BW + k]; } }
#pragma unroll
                        for (int i = 0; i < 8; ++i) {
                            const u32x4 xb = xq[i + 2], gc = cq[i + 2], gb = bq[i];
                            const float pv[8] = {bflo(xb.x) * bflo(gc.x), bfhi(xb.x) * bfhi(gc.x), bflo(xb.y) * bflo(gc.y), bfhi(xb.y) * bfhi(gc.y), bflo(xb.z) * bflo(gc.z), bfhi(xb.z) * bfhi(gc.z), bflo(xb.w) * bflo(gc.w), bfhi(xb.w) * bfhi(gc.w)};
                            const float gbv[8] = {bflo(gb.x), bfhi(gb.x), bflo(gb.y), bfhi(gb.y), bflo(gb.z), bfhi(gb.z), bflo(gb.w), bfhi(gb.w)};
                            float yv[8];
#pragma unroll
                            for (int k = 0; k < 8; ++k) { yv[k] = gbv[k] * (w0[k] * pm2[k] + w1[k] * pm1[k] + w2[k] * pv[k]); pm2[k] = pm1[k]; pm1[k] = pv[k]; }
                            u32x4 w; w.x = pk2(yv[0], yv[1]); w.y = pk2(yv[2], yv[3]); w.z = pk2(yv[4], yv[5]); w.w = pk2(yv[6], yv[7]);
                            *(u32x4*)(gY + (size_t)(rowbase + i) * D + 512 + c0) = w;
                        }
                        if (t0 + 8 == T) { float* o = out + (smp ? O_CBS : O_CBP) + ((size_t)(l * 8 + b) * 2) * BW + c0;
#pragma unroll
                            for (int k = 0; k < 8; ++k) { o[k] = pm2[k]; o[BW + k] = pm1[k]; } }
                    }
                }
            } else if (rep == 2) {
                LANE_STATE();
                {
                    LAS float* cr = (LAS float*)lds;
                    for (int un = bid; un < 8 + 256; un += G) {
                        int b, ch, rowbase, nrows; const bool smp = un < 8;
                        if (smp) { b = un; ch = 0; rowbase = MP + b * TS; nrows = TS; } else { const int v = un - 8; b = v >> 5; ch = v & 31; rowbase = b * SEQ + ch * 128; nrows = 128; }
                        {
                            const int c = tid, hd = c >> 6, ln = c & 63; float carry = 0.f;
                            if (smp) carry = INP(I_SHA)[(size_t)(l * BS + b) * AW + c];
                            else { const float* ag = AGG + (size_t)(64 + (b << 8) + (hd << 5)) * 128 + ln; for (int k = 0; k < ch; ++k) carry = ag[(size_t)k * 128] * carry + ag[(size_t)k * 128 + 64]; }
                            cr[c] = carry;
                        }
                        __syncthreads();
                        const int c0 = (tid & 63) * 8, rsub = tid >> 6;
                        const f32x4 ca = *(const LAS f32x4*)(cr + c0), cb = *(const LAS f32x4*)(cr + c0 + 4);
                        for (int p4 = 0; p4 < nrows / 8; p4 += 4) {
                            u32x4 hqv[4], pqv[4], gqv[4];
#pragma unroll
                            for (int q = 0; q < 4; ++q) { const size_t row = (size_t)(rowbase + (p4 + q) * 8 + rsub); hqv[q] = __builtin_nontemporal_load((const u32x4*)(HLOC + row * AW + c0)); pqv[q] = __builtin_nontemporal_load((const u32x4*)(PCUM + row * AW + c0)); gqv[q] = __builtin_nontemporal_load((const u32x4*)(gZ + row * INC + Z_GA + c0)); }
#pragma unroll
                            for (int q = 0; q < 4; ++q) {
                                const int rloc = (p4 + q) * 8 + rsub; const size_t row = (size_t)(rowbase + rloc);
                                const u32x4 hq = hqv[q], pq = pqv[q], gq = gqv[q];
                                const f32x4 h0 = (f32x4){bflo(hq.x), bfhi(hq.x), bflo(hq.y), bfhi(hq.y)}, h1 = (f32x4){bflo(hq.z), bfhi(hq.z), bflo(hq.w), bfhi(hq.w)}, p0 = (f32x4){bflo(pq.x), bfhi(pq.x), bflo(pq.y), bfhi(pq.y)}, p1 = (f32x4){bflo(pq.z), bfhi(pq.z), bflo(pq.w), bfhi(pq.w)};
                                const f32x4 a0 = h0 + p0 * ca, a1 = h1 + p1 * cb;
                                u32x4 w; w.x = pk2(gelu_t(bflo(gq.x)) * a0[0], gelu_t(bfhi(gq.x)) * a0[1]); w.y = pk2(gelu_t(bflo(gq.y)) * a0[2], gelu_t(bfhi(gq.y)) * a0[3]);
                                w.z = pk2(gelu_t(bflo(gq.z)) * a1[0], gelu_t(bfhi(gq.z)) * a1[1]); w.w = pk2(gelu_t(bflo(gq.w)) * a1[2], gelu_t(bfhi(gq.w)) * a1[3]);
                                *(u32x4*)(gY + row * D + c0) = w;
                                if ((smp || ch == 31) && rloc == nrows - 1) { float* o = out + (smp ? O_HAS : O_HAP) + (size_t)(l * 8 + b) * AW + c0; *(f32x4*)o = a0; *(f32x4*)(o + 4) = a1; }
                            }
                        }
                        if ((smp || ch == 31) && tid < 192) {
                            const int k = tid >> 6; const u32x4 xq = *(const u32x4*)(gZ + (size_t)(rowbase + nrows - 3 + k) * INC + Z_XA + c0);
                            float* o = out + (smp ? O_CAS : O_CAP) + ((size_t)(l * 8 + b) * 3 + k) * AW + c0;
                            *(f32x4*)o = (f32x4){bflo(xq.x), bfhi(xq.x), bflo(xq.y), bfhi(xq.y)}; *(f32x4*)(o + 4) = (f32x4){bflo(xq.z), bfhi(xq.z), bflo(xq.w), bfhi(xq.w)};
                        }
                        __syncthreads();
                    }
                }
            } else if (rep == 3 || rep == 8 || rep == 12) {
                LANE_STATE();
                if (rep == 12) {
                    const float* cfw = INP(I_CFW) + (size_t)l * 3 * DFF;
                    pg8::GSched S0; S0.init(MP / 256, D / 256, G, bid); pg8::Unit u0;
                    for (int i = 0; S0.next(i, u0); ++i) {
                        const int pm = u0.pm; if (pm >= 128 || tid >= DFF / 8) continue;
                        const int c0 = tid * 8, b = pm >> 4;
                        float w0[8], w1[8], w2[8], p2[8], p1[8], g0[8], g1[8], u0_[8], u1_[8];
#pragma unroll
                        for (int k = 0; k < 8; ++k) { w0[k] = cfw[c0 + k]; w1[k] = cfw[DFF + c0 + k]; w2[k] = cfw[2 * DFF + c0 + k]; p2[k] = 0.f; p1[k] = 0.f; }
                        if ((pm & 15) != 0) {
#pragma unroll
                            for (int k = 0; k < 8; ++k) { p2[k] = SBL[((size_t)(pm - 1) * 2 + 0) * DFF + c0 + k]; p1[k] = SBL[((size_t)(pm - 1) * 2 + 1) * DFF + c0 + k]; } }
#pragma unroll
                        for (int k = 0; k < 8; ++k) { g0[k] = SBG[((size_t)pm * 2 + 0) * DFF + c0 + k]; g1[k] = SBG[((size_t)pm * 2 + 1) * DFF + c0 + k]; u0_[k] = SBU[((size_t)pm * 2 + 0) * DFF + c0 + k]; u1_[k] = SBU[((size_t)pm * 2 + 1) * DFF + c0 + k]; }
                        float ha[8], hb[8];
#pragma unroll
                        for (int k = 0; k < 8; ++k) { ha[k] = silu(w0[k] * p2[k] + w1[k] * p1[k] + w2[k] * g0[k]) * u0_[k]; hb[k] = silu(w0[k] * p1[k] + w1[k] * g0[k] + w2[k] * g1[k]) * u1_[k]; }
                        u32x4 w; w.x = pk2(ha[0], ha[1]); w.y = pk2(ha[2], ha[3]); w.z = pk2(ha[4], ha[5]); w.w = pk2(ha[6], ha[7]);
                        *(u32x4*)(GU + (size_t)(pm * 256) * DFF + c0) = w;
                        w.x = pk2(hb[0], hb[1]); w.y = pk2(hb[2], hb[3]); w.z = pk2(hb[4], hb[5]); w.w = pk2(hb[6], hb[7]);
                        *(u32x4*)(GU + (size_t)(pm * 256 + 1) * DFF + c0) = w;
                        if ((pm & 15) == 15 && u0.pn == 0) { float* o = out + O_CFP + ((size_t)(l * 8 + b) * 2) * DFF + c0;
#pragma unroll
                            for (int k = 0; k < 8; ++k) { o[k] = SBL[((size_t)pm * 2 + 0) * DFF + c0 + k]; o[DFF + k] = SBL[((size_t)pm * 2 + 1) * DFF + c0 + k]; } }
                    }
                    asm volatile("s_waitcnt vmcnt(0)" ::: "memory"); __syncthreads();
                }
                GEMM_RES(rep == 3 ? 0 : (rep == 8 ? 1 : 2));
                { LANE_STATE();
                  const SG2 sg{rep == 12 ? GU + (size_t)MP * DFF : (rep == 3 ? gY : gO) + (size_t)MP * D, rep == 12 ? WDN_T : (rep == 3 ? WOUT_T : WO_T), rep == 12 ? DFF : D, rep == 12 ? DFF : D, rep == 12 ? DFF : D, D, XN + (size_t)MP * D, D, 1.f, 2, SSS(3 * l + (rep == 3 ? 1 : (rep == 8 ? 2 : 3)))};
                  sgemm2(lds, sg, bid, G, wave, tid); }
                if (l + 1 < DEPTH) { LANE_STATE(); if (bid >= 64) convert_layer(kp, ws, lds, l + 1, rep == 3 ? 0 : (rep == 8 ? 2 : 3), 4, gw - 64 * NWAVES, NGW - 64 * NWAVES, gt - 64 * NTHREADS, NGT - 64 * NTHREADS, lane, wave); }
            } else if (rep == 6) {
                LANE_STATE();
                for (int sub = 0; sub < 2; ++sub) {
                    pg8::GSched S; pg8::Gemm g; pg8::EpiSoftmax E;
                    if (sub == 0) { S.init(MP / 256, 4, G, bid); S.aPm = (size_t)256 * D * 2; S.aPn = 512; S.bPn = 512; S.bPm = (size_t)256 * D * 2; S.bShift = 4; g = pg8::Gemm{gQ, KBP, D, D, 256}; E.O = gP; E.ldc = D; E.smp = 0; }
                    else { S.init(1, 32, G, (bid + G - 64) % G); S.mode = 1; g = pg8::Gemm{gQ + (size_t)MP * D, KBS, D, D, 256}; E.O = PS; E.ldc = 8192; E.smp = 1; }
                    pg8::gemm_phase<pg8::EpiSoftmax, pg8::GSched, true>(lds, g, S, E, wave_s);
                }
            }
            if (rep == 6) { asm volatile("s_waitcnt vmcnt(0)" ::: "memory"); __syncthreads(); }
            else GRID_SYNC();
          }
        }
    }
    {
        LANE_STATE();
        const float* gain = INP(I_GFIN);
        f32x4 gv[4];
#pragma unroll
        for (int j = 0; j < 4; ++j) gv[j] = ((const f32x4*)gain)[lane + 64 * j];
        for (int m0 = gw; m0 < MT; m0 += 2 * NGW) {
            const int m1 = m0 + NGW; const bool two = m1 < MT; const int mb = two ? m1 : m0;
            const u32x2* xa = (const u32x2*)(XN + (size_t)m0 * D) + lane; const u32x2* xb = (const u32x2*)(XN + (size_t)mb * D) + lane;
            u32x2 pa[4], pb[4];
#pragma unroll
            for (int j = 0; j < 4; ++j) { pa[j] = __builtin_nontemporal_load(xa + 64 * j); pb[j] = __builtin_nontemporal_load(xb + 64 * j); }
            float ra, rb;
            { float qa = 0.f, qb = 0.f;
#pragma unroll
              for (int j = 0; j < 4; ++j) { const float a0 = bflo(pa[j].x), a1 = bfhi(pa[j].x), a2 = bflo(pa[j].y), a3 = bfhi(pa[j].y), b0 = bflo(pb[j].x), b1 = bfhi(pb[j].x), b2 = bflo(pb[j].y), b3 = bfhi(pb[j].y);
                  qa += (a0 * a0 + a1 * a1) + (a2 * a2 + a3 * a3); qb += (b0 * b0 + b1 * b1) + (b2 * b2 + b3 * b3); }
              if (m0 < MP) ra = ss_rstd(*(const f32x4*)(SSQ(6) + (size_t)m0 * 4)); else ra = 1.0f / sqrtf(wave_sum(qa, lane) * (1.f / D) + EPS);
              if (mb < MP) rb = ss_rstd(*(const f32x4*)(SSQ(6) + (size_t)mb * 4)); else rb = 1.0f / sqrtf(wave_sum(qb, lane) * (1.f / D) + EPS); }
            f32x4* ya = (f32x4*)(out + (size_t)m0 * D) + lane; f32x4* yb = (f32x4*)(out + (size_t)mb * D) + lane;
#pragma unroll
            for (int j = 0; j < 4; ++j) { __builtin_nontemporal_store((f32x4){bflo(pa[j].x), bfhi(pa[j].x), bflo(pa[j].y), bfhi(pa[j].y)} * ra * gv[j], ya + 64 * j); if (two) __builtin_nontemporal_store((f32x4){bflo(pb[j].x), bfhi(pb[j].x), bflo(pb[j].y), bfhi(pb[j].y)} * rb * gv[j], yb + 64 * j); }
        }
    }
}

extern "C" void kernel_launch(void* const* d_in, const int* in_sizes, int n_in, void* d_out, int out_size, void* d_ws, size_t ws_size, hipStream_t stream) {
    static int grid = 0;
    if (grid == 0) {
        if (n_in != N_IN || (size_t)out_size != O_END || ws_size < 512 * MiB) { fprintf(stderr, "kernel_launch: unexpected sizes n_in %d out %d ws %zu (need %zu)\n", n_in, out_size, ws_size, (size_t)(512 * MiB)); grid = -1; return; }
        int dev = 0, cus = 0, per_cu = 0;
        (void)hipGetDevice(&dev); (void)hipDeviceGetAttribute(&cus, hipDeviceAttributeMultiprocessorCount, dev);
        if (hipFuncSetAttribute((const void*)trunk_fwd, hipFuncAttributeMaxDynamicSharedMemorySize, LDS_BYTES) != hipSuccess) { fprintf(stderr, "kernel_launch: hipFuncSetAttribute failed\n"); grid = -1; return; }
        if (hipOccupancyMaxActiveBlocksPerMultiprocessor(&per_cu, (const void*)trunk_fwd, NTHREADS, LDS_BYTES) != hipSuccess || per_cu < 1) { fprintf(stderr, "kernel_launch: occupancy query gave %d\n", per_cu); per_cu = 1; }
        (void)hipGetLastError();
        grid = cus * 1;
        if (grid != 256) fprintf(stderr, "kernel_launch: note: %d CUs\n", grid);
    }
    if (grid < 0) return;
    Args a{};
    for (int i = 0; i < N_IN; ++i) a.in[i] = (const float*)d_in[i];
    a.out = (float*)d_out; a.ws = (unsigned char*)d_ws;
    void* kargs[] = {&a};
    hipError_t e = hipLaunchCooperativeKernel((const void*)trunk_fwd, dim3(grid), dim3(NTHREADS), kargs, LDS_BYTES, stream);
    if (e != hipSuccess) fprintf(stderr, "kernel_launch: cooperative launch failed: %s (grid %d)\n", hipGetErrorString(e), grid);
}
```
